# Optimizing an MI355X kernel written in HIP

```python
import math
import jax, jax.numpy as jnp
from jax import lax
import numpy as np

D_MODEL = 1024
BATCH = 4
SEQ = 8192
DEPTH = 2

GRID_W = 64
Q_BLOCK = 128
HEAD_DIM = 64
EPS = 1e-6
A_HEADS = 8
A_KV_HEADS = 2
A_GROUP = A_HEADS // A_KV_HEADS
A_WIDTH = A_HEADS * HEAD_DIM
A_KV_WIDTH = A_KV_HEADS * HEAD_DIM
ROPE_THETA = 10000.0
B_WIDTH = D_MODEL // 2
B_GROUPS = 8
CONV_WIDTH = 31
EVEN_IN = A_WIDTH + 2 * A_KV_WIDTH + 2 * B_WIDTH
EVEN_MIX = A_WIDTH + B_WIDTH
C_HEADS = 8
C_HEAD_DIM = D_MODEL // (2 * C_HEADS)
C_WIDTH = 2 * C_HEADS * C_HEAD_DIM
ODD_IN = 3 * C_WIDTH
REL_BUCKETS = 32
REL_MAX_DIST = 128
MOE_GROUPS = 4
MOE_PER_GROUP = 8
MOE_EXPERTS = MOE_GROUPS * MOE_PER_GROUP
MOE_TOPK = 2
MOE_HIDDEN = 512
MOE_BLOCK = 128
N_EVEN = (DEPTH + 1) // 2
N_ODD = DEPTH // 2

kernel_name = 'hybrid_gqa_conformer_diffattn_hmoe_encoder'


def _rmsnorm(x, g, eps=EPS):
    xf = x.astype(jnp.float32)
    y = xf * lax.rsqrt(jnp.mean(xf * xf, axis=-1, keepdims=True) + eps)
    return (y * g.astype(jnp.float32)).astype(x.dtype)


def _rope_1d(x, pos):
    m = x.shape[-1] // 2
    inv = ROPE_THETA ** (-jnp.arange(m, dtype=jnp.float32) / m)
    ang = pos.astype(jnp.float32)[:, None] * inv[None, :]
    cos = jnp.cos(ang)[:, None, :]
    sin = jnp.sin(ang)[:, None, :]
    xf = x.astype(jnp.float32)
    x1, x2 = xf[..., :m], xf[..., m:]
    return jnp.concatenate([x1 * cos - x2 * sin, x2 * cos + x1 * sin], axis=-1).astype(x.dtype)


def _grid_positions(seq_len):
    rows = seq_len // GRID_W
    r, c = jnp.meshgrid(jnp.arange(rows, dtype=jnp.int32), jnp.arange(GRID_W, dtype=jnp.int32), indexing='ij')
    return r.reshape(-1), c.reshape(-1)


def _axial_rope(x, row, col):
    half = x.shape[-1] // 2
    return jnp.concatenate([_rope_1d(x[..., :half], row), _rope_1d(x[..., half:], col)], axis=-1)


def _t5_bucket(rel):
    nb = REL_BUCKETS // 2
    max_exact = nb // 2
    ret = jnp.where(rel > 0, nb, 0).astype(jnp.int32)
    n = jnp.abs(rel)
    nf = jnp.maximum(n, 1).astype(jnp.float32)
    large = max_exact + (jnp.log(nf / max_exact) / math.log(REL_MAX_DIST / max_exact) * (nb - max_exact)).astype(jnp.int32)
    large = jnp.minimum(large, nb - 1)
    return ret + jnp.where(n < max_exact, n, large)


def _gqa_axial(q, k, v, q_norm, k_norm):
    B, S = q.shape[0], q.shape[1]
    row, col = _grid_positions(S)
    q = _axial_rope(_rmsnorm(q, q_norm), row, col)
    k = _axial_rope(_rmsnorm(k, k_norm), row, col)
    nb = S // Q_BLOCK
    qb = q.reshape(B, nb, Q_BLOCK, A_KV_HEADS, A_GROUP, HEAD_DIM).transpose(1, 0, 3, 4, 2, 5)
    kt = k.transpose(0, 2, 1, 3)
    vt = v.transpose(0, 2, 1, 3)
    scale = HEAD_DIM ** -0.5

    def block(qblk):
        s = jnp.einsum('bkgqd,bksd->bkgqs', qblk, kt, preferred_element_type=jnp.float32) * scale
        p = jax.nn.softmax(s, axis=-1)
        return jnp.einsum('bkgqs,bksd->bkgqd', p.astype(vt.dtype), vt)

    o = lax.map(block, qb)
    return o.transpose(1, 0, 4, 2, 3, 5).reshape(B, S, A_WIDTH)


def _conformer_conv(u, conv_w, conv_b, gn_g, gn_b):
    B, S = u.shape[0], u.shape[1]
    a, gate = jnp.split(u, 2, axis=-1)
    h = a * jax.nn.sigmoid(gate)
    h = lax.conv_general_dilated(h, conv_w[:, None, :].astype(h.dtype), window_strides=(1,),
                                 padding=[(CONV_WIDTH // 2, CONV_WIDTH // 2)],
                                 dimension_numbers=('NWC', 'WIO', 'NWC'),
                                 feature_group_count=B_WIDTH) + conv_b.astype(h.dtype)
    hf = h.reshape(B, S, B_GROUPS, B_WIDTH // B_GROUPS).astype(jnp.float32)
    mu = jnp.mean(hf, axis=-1, keepdims=True)
    var = jnp.mean(jnp.square(hf - mu), axis=-1, keepdims=True)
    hn = ((hf - mu) * lax.rsqrt(var + 1e-5)).reshape(B, S, B_WIDTH)
    hn = hn * gn_g.astype(jnp.float32) + gn_b.astype(jnp.float32)
    return jax.nn.silu(hn).astype(u.dtype)


def _even_mixer(h, w_in, q_norm, k_norm, conv_w, conv_b, gn_g, gn_b, w_out):
    B, S, _ = h.shape
    z = h @ w_in
    q, k, v, u = jnp.split(z, [A_WIDTH, A_WIDTH + A_KV_WIDTH, A_WIDTH + 2 * A_KV_WIDTH], axis=-1)
    ya = _gqa_axial(q.reshape(B, S, A_HEADS, HEAD_DIM), k.reshape(B, S, A_KV_HEADS, HEAD_DIM),
                    v.reshape(B, S, A_KV_HEADS, HEAD_DIM), q_norm, k_norm)
    yb = _conformer_conv(u, conv_w, conv_b, gn_g, gn_b)
    return jnp.concatenate([ya, yb], axis=-1) @ w_out


def _diff_attention(h, w_in, lq1, lk1, lq2, lk2, subln, w_out, rel_bias, layer_idx):
    B, S, _ = h.shape
    z = h @ w_in
    q, k, v = jnp.split(z, 3, axis=-1)
    q = q.reshape(B, S, C_HEADS, 2, C_HEAD_DIM)
    k = k.reshape(B, S, C_HEADS, 2, C_HEAD_DIM)
    v = v.reshape(B, S, C_HEADS, 2 * C_HEAD_DIM)
    lam_init = 0.8 - 0.6 * math.exp(-0.3 * layer_idx)
    lam = (jnp.exp(jnp.sum(lq1.astype(jnp.float32) * lk1.astype(jnp.float32)))
           - jnp.exp(jnp.sum(lq2.astype(jnp.float32) * lk2.astype(jnp.float32))) + lam_init)
    nb = S // Q_BLOCK
    qb = q.reshape(B, nb, Q_BLOCK, C_HEADS, 2, C_HEAD_DIM).transpose(1, 0, 3, 4, 2, 5)
    kt = k.transpose(0, 2, 3, 1, 4)
    vt = v.transpose(0, 2, 1, 3)
    kpos = jnp.arange(S, dtype=jnp.int32)
    scale = C_HEAD_DIM ** -0.5

    def block(args):
        qblk, i = args
        qpos = i * Q_BLOCK + jnp.arange(Q_BLOCK, dtype=jnp.int32)
        bias = rel_bias[_t5_bucket(kpos[None, :] - qpos[:, None])]
        bias = bias.astype(jnp.float32).transpose(2, 0, 1)
        s = jnp.einsum('bhcqd,bhcsd->bhcqs', qblk, kt, preferred_element_type=jnp.float32) * scale
        p = jax.nn.softmax(s + bias[None, :, None], axis=-1)
        a = p[:, :, 0] - lam * p[:, :, 1]
        return jnp.einsum('bhqs,bhsd->bhqd', a.astype(vt.dtype), vt)

    o = lax.map(block, (qb, jnp.arange(nb, dtype=jnp.int32)))
    o = o.transpose(1, 0, 3, 2, 4).reshape(B, S, C_HEADS, 2 * C_HEAD_DIM)
    o = _rmsnorm(o, subln, 1e-5) * (1.0 - lam_init)
    return o.reshape(B, S, C_WIDTH) @ w_out


def _hier_moe(h, w_group, b_group, w_expert, b_expert, w1, w3, w2):
    B, S, D = h.shape
    N = B * S
    xt = h.reshape(N, D)
    pg = jax.nn.softmax((xt @ w_group).astype(jnp.float32) + b_group.astype(jnp.float32), axis=-1)
    g_val, g_idx = lax.top_k(pg, 1)
    g_val, g_idx = g_val[:, 0], g_idx[:, 0]
    el = ((xt @ w_expert).astype(jnp.float32) + b_expert.astype(jnp.float32)).reshape(N, MOE_GROUPS, MOE_PER_GROUP)
    el_g = el[jnp.arange(N), g_idx]
    pe = jax.nn.softmax(el_g, axis=-1)
    e_val, e_idx = lax.top_k(pe, MOE_TOPK)
    gate = g_val[:, None] * e_val / jnp.sum(e_val, axis=-1, keepdims=True)
    expert_id = g_idx[:, None] * MOE_PER_GROUP + e_idx
    A = N * MOE_TOPK
    flat_e = expert_id.reshape(-1).astype(jnp.int32)
    flat_w = gate.reshape(-1)
    flat_tok = jnp.arange(A, dtype=jnp.int32) // MOE_TOPK
    order = jnp.argsort(flat_e)
    se = flat_e[order]
    counts = jnp.bincount(flat_e, length=MOE_EXPERTS).astype(jnp.int32)
    pcounts = (counts + MOE_BLOCK - 1) // MOE_BLOCK * MOE_BLOCK
    starts = jnp.cumsum(counts) - counts
    pends = jnp.cumsum(pcounts)
    pstarts = pends - pcounts
    dest = pstarts[se] + (jnp.arange(A, dtype=jnp.int32) - starts[se])
    P = A + MOE_EXPERTS * MOE_BLOCK
    n_blk = P // MOE_BLOCK
    buf_tok = jnp.full((P,), N, dtype=jnp.int32).at[dest].set(flat_tok[order])
    buf_w = jnp.zeros((P,), dtype=h.dtype).at[dest].set(flat_w[order].astype(h.dtype))
    blk_e = jnp.minimum(jnp.searchsorted(pends, jnp.arange(n_blk, dtype=jnp.int32) * MOE_BLOCK, side='right'),
                        MOE_EXPERTS - 1).astype(jnp.int32)
    xb = xt.at[buf_tok].get(mode='fill', fill_value=0).reshape(n_blk, MOE_BLOCK, D)

    def expert_block(args):
        xblk, e = args
        return (jax.nn.silu(xblk @ w1[e]) * (xblk @ w3[e])) @ w2[e]

    yb = lax.map(expert_block, (xb, blk_e)).reshape(P, D)
    y = jnp.zeros((N, D), dtype=h.dtype).at[buf_tok].add(yb * buf_w[:, None], mode='drop')
    return y.reshape(B, S, D)


def setup_inputs(seed: int = 0) -> dict:
    key = jax.random.key(seed)
    ks = jax.random.split(key, 32)
    f32 = jnp.float32

    def nrm(k, shape, scale):
        return jax.random.normal(k, shape, f32) * scale

    def gain(k, shape):
        return 1.0 + 0.02 * jax.random.normal(k, shape, f32)

    D = D_MODEL
    return {
        'x': jax.random.normal(ks[0], (BATCH, SEQ, D), f32),
        'norm_mix': gain(ks[1], (DEPTH, D)),
        'norm_ffn': gain(ks[2], (DEPTH, D)),
        'norm_final': gain(ks[3], (D,)),
        'ev_w_in': nrm(ks[4], (N_EVEN, D, EVEN_IN), D ** -0.5),
        'ev_q_norm': gain(ks[5], (N_EVEN, HEAD_DIM)),
        'ev_k_norm': gain(ks[6], (N_EVEN, HEAD_DIM)),
        'ev_conv_w': nrm(ks[7], (N_EVEN, CONV_WIDTH, B_WIDTH), CONV_WIDTH ** -0.5),
        'ev_conv_b': nrm(ks[8], (N_EVEN, B_WIDTH), 0.02),
        'ev_gn_g': gain(ks[9], (N_EVEN, B_WIDTH)),
        'ev_gn_b': nrm(ks[10], (N_EVEN, B_WIDTH), 0.02),
        'ev_w_out': nrm(ks[11], (N_EVEN, EVEN_MIX, D), EVEN_MIX ** -0.5),
        'od_w_in': nrm(ks[12], (N_ODD, D, ODD_IN), D ** -0.5),
        'od_lam_q1': nrm(ks[13], (N_ODD, C_HEAD_DIM), 0.1),
        'od_lam_k1': nrm(ks[14], (N_ODD, C_HEAD_DIM), 0.1),
        'od_lam_q2': nrm(ks[15], (N_ODD, C_HEAD_DIM), 0.1),
        'od_lam_k2': nrm(ks[16], (N_ODD, C_HEAD_DIM), 0.1),
        'od_subln': gain(ks[17], (N_ODD, 2 * C_HEAD_DIM)),
        'od_w_out': nrm(ks[18], (N_ODD, C_WIDTH, D), C_WIDTH ** -0.5),
        'rel_bias': nrm(ks[19], (REL_BUCKETS, C_HEADS), 0.5),
        'moe_w_group': nrm(ks[20], (DEPTH, D, MOE_GROUPS), D ** -0.5),
        'moe_b_group': nrm(ks[21], (DEPTH, MOE_GROUPS), 0.01),
        'moe_w_expert': nrm(ks[22], (DEPTH, D, MOE_EXPERTS), D ** -0.5),
        'moe_b_expert': nrm(ks[23], (DEPTH, MOE_EXPERTS), 0.01),
        'moe_w1': nrm(ks[24], (DEPTH, MOE_EXPERTS, D, MOE_HIDDEN), D ** -0.5),
        'moe_w3': nrm(ks[25], (DEPTH, MOE_EXPERTS, D, MOE_HIDDEN), D ** -0.5),
        'moe_w2': nrm(ks[26], (DEPTH, MOE_EXPERTS, MOE_HIDDEN, D), MOE_HIDDEN ** -0.5),
    }


def reference(x, norm_mix, norm_ffn, norm_final, ev_w_in, ev_q_norm, ev_k_norm, ev_conv_w, ev_conv_b,
              ev_gn_g, ev_gn_b, ev_w_out, od_w_in, od_lam_q1, od_lam_k1, od_lam_q2, od_lam_k2, od_subln,
              od_w_out, rel_bias, moe_w_group, moe_b_group, moe_w_expert, moe_b_expert, moe_w1, moe_w3, moe_w2):
    for l in range(DEPTH):
        h = _rmsnorm(x, norm_mix[l])
        if l % 2 == 0:
            j = l // 2
            x = x + _even_mixer(h, ev_w_in[j], ev_q_norm[j], ev_k_norm[j], ev_conv_w[j], ev_conv_b[j],
                                ev_gn_g[j], ev_gn_b[j], ev_w_out[j])
        else:
            j = l // 2
            x = x + _diff_attention(h, od_w_in[j], od_lam_q1[j], od_lam_k1[j], od_lam_q2[j], od_lam_k2[j],
                                    od_subln[j], od_w_out[j], rel_bias, l)
        h = _rmsnorm(x, norm_ffn[l])
        x = x + _hier_moe(h, moe_w_group[l], moe_b_group[l], moe_w_expert[l], moe_b_expert[l],
                          moe_w1[l], moe_w3[l], moe_w2[l])
    return _rmsnorm(x, norm_final)
```

```cpp
#include <hip/hip_runtime.h>
#include <cstdio>
#include <cstdint>

#ifndef MK_N_LAUNCHES
#define MK_N_LAUNCHES 1
#endif

#define GAS __attribute__((address_space(1)))
#define LAS __attribute__((address_space(3)))
typedef unsigned short bf16;
typedef unsigned v4u __attribute__((ext_vector_type(4)));
typedef unsigned v2u __attribute__((ext_vector_type(2)));
typedef float f32x4 __attribute__((ext_vector_type(4)));
typedef float f32x16 __attribute__((ext_vector_type(16)));
typedef short bf16x8 __attribute__((ext_vector_type(8)));
typedef short s16x4 __attribute__((ext_vector_type(4)));

constexpr int NTOK = 32768, DM = 1024, SEQ = 8192, NBATCH = 4;
constexpr int EV_IN = 1792, OD_IN = 3072;
constexpr int NEXP = 32, MOE_H = 512, LIST_CAP = 32768;
constexpr float C2 = 0.125f * 1.4426950408889634f;
constexpr float LOG2E = 1.4426950408889634f;
constexpr float LAM_INIT = 0.35550906759f;

constexpr size_t MiB = 1u << 20;
constexpr size_t WS_CTL = 0, CTL_ZERO_BYTES = 1 * MiB;
constexpr size_t WS_WIN0 = 1 * MiB, WS_WOUT0 = 5 * MiB, WS_WIN1 = 7 * MiB, WS_WOUT1 = 13 * MiB, WS_TBL = 15 * MiB;
constexpr size_t WS_W13 = 16 * MiB, WS_W2 = 80 * MiB;
constexpr size_t WS_HB = 112 * MiB;
constexpr size_t WS_Y = 176 * MiB;
constexpr size_t WS_Z0 = 240 * MiB, WS_QR = 352 * MiB, WS_KR = 384 * MiB;
constexpr size_t WS_Q1 = 240 * MiB, WS_K1 = 304 * MiB, WS_V1 = 368 * MiB, WS_OC1 = 432 * MiB, WS_OC0 = WS_HB;
constexpr size_t WS_H = 176 * MiB, WS_YS = 248 * MiB, WS_LIST = 392 * MiB, WS_TOKEP = 396 * MiB, WS_GATE = 396 * MiB + 512 * 1024;
constexpr size_t WS_END = 496 * MiB;
constexpr int TBL_COS = 0, TBL_SIN = 2048, TBL_BIAS = 4096, BIAS_STRIDE = 272;
constexpr int CW_BAR = 4096;
constexpr int CW_CNT = 16384;

constexpr int RING_BYTES = 131072;
constexpr int LDSCTL_OFF = RING_BYTES;
constexpr int LDS_BYTES = 147456;
constexpr int LC_BAR = 8;
constexpr int LC_TP = 16;
constexpr int LC_CNT = 64;
constexpr int LC_LCNT = 96;
constexpr int LC_LBASE = 128;

#define LDS_WAIT() asm volatile("s_waitcnt lgkmcnt(0)" ::: "memory")
#define VM_WAIT() asm volatile("s_waitcnt vmcnt(0)" ::: "memory")
#define RLX_AGENT __ATOMIC_RELAXED, __HIP_MEMORY_SCOPE_AGENT

__device__ __forceinline__ unsigned f2bf(float f) { unsigned u = __builtin_bit_cast(unsigned, f); return (u + 0x7fffu + ((u >> 16) & 1u)) >> 16; }
__device__ __forceinline__ unsigned pk2(float lo, float hi) { return f2bf(lo) | (f2bf(hi) << 16); }
__device__ __forceinline__ float bf2f(unsigned short b) { return __builtin_bit_cast(float, (unsigned)b << 16); }
__device__ __forceinline__ float wave_sum(float v) {
#pragma unroll
    for (int o = 1; o < 64; o <<= 1) v += __shfl_xor(v, o);
    return v;
}

namespace pg8 {
#define PG8_LAS __attribute__((address_space(3)))
typedef unsigned short bf16_t;
typedef short bf16x8 __attribute__((ext_vector_type(8)));
typedef float f32x4 __attribute__((ext_vector_type(4)));
typedef unsigned u32x4 __attribute__((ext_vector_type(4)));
constexpr int BM = 256, BK = 64, HALF = 128, HTB = HALF * BK * 2, STAGE_BYTES = 8 * HTB, NXCD = 8, WGM = 8;

__host__ __device__ __forceinline__ int lds_byte(int r, int c) { const int st = (r >> 4) * 2 + (c >> 5), rr = r & 15, cc = c & 31, ob = rr * 64 + cc * 2; return st * 1024 + (ob ^ (((ob >> 9) & 1) << 5)); }
__host__ __device__ __forceinline__ void stage_rc(int b, int& R, int& C) { const int st = b / 1024, sb = b % 1024, swz = sb ^ (((sb >> 9) & 1) << 5); R = (st >> 1) * 16 + swz / 64; C = (st & 1) * 32 + (swz % 64) / 2; }
__host__ __device__ __forceinline__ int perm32(int rho) { const int n = rho >> 4, i = rho & 15; return 8 * (i >> 2) + 4 * n + (i & 3); }

struct Unit { int pm, pn, e, rb; };
struct Gemm { const bf16_t* A; const bf16_t* Bt; int M, N, K; };

struct StaticOrder {
    int nM, nN, nwg, G, c;
    __device__ void init(int M, int N, int G_, int c_) { nM = M / BM; nN = N / BM; nwg = nM * nN; G = G_; c = c_; }
    __device__ bool next(int i, Unit& u) const {
        const long L = (long)i * G + c; if (L >= nwg) return false;
        int wgid = (int)L; { const int q = nwg / NXCD, r = nwg % NXCD, xcd = wgid % NXCD, off = wgid / NXCD; wgid = (xcd < r ? xcd * (q + 1) : r * (q + 1) + (xcd - r) * q) + off; }
        const int nig = WGM * nN, gid = wgid / nig, fm = gid * WGM, gsz = (nM - fm) < WGM ? (nM - fm) : WGM;
        u.pm = fm + ((wgid % nig) % gsz); u.pn = (wgid % nig) / gsz; u.e = 0; u.rb = 0; return true;
    }
    __device__ __forceinline__ unsigned arow(const Unit& u, int rr) const { return (unsigned)(u.pm * BM + rr); }
};

struct MoeOrder {
    const PG8_LAS int* tp; const PG8_LAS int* cn; const int* list; int G, c, nunits; bool gather;
    __device__ __forceinline__ bool next(int i, Unit& u) const {
        const int L = i * G + c; if (L >= nunits) return false;
        const int rbg = L >> 2, pnl = L & 3; int e = 0;
#pragma unroll
        for (int j = 1; j < 32; ++j) e += (tp[j] <= rbg) ? 1 : 0;
        u.pm = rbg; u.pn = e * 4 + pnl; u.e = e; u.rb = rbg - tp[e]; return true;
    }
    __device__ __forceinline__ unsigned arow(const Unit& u, int rr) const {
        if (!gather) return (unsigned)(u.pm * BM + rr);
        const int idx = u.rb * BM + rr; unsigned t = 0u;
        if (idx < cn[u.e]) t = (unsigned)list[(size_t)u.e * 32768 + idx];
        return t;
    }
};

__device__ __forceinline__ unsigned cvt_pk_bf16(float lo, float hi) { unsigned r; asm volatile("v_cvt_pk_bf16_f32 %0, %1, %2" : "=v"(r) : "v"(lo), "v"(hi)); return r; }

struct EpiBf16 {
    static constexpr bool PERM = true;
    bf16_t* O; int ldc; int split_cols; size_t split_stride; float scale0; int pn_mask;
    __device__ __forceinline__ void operator()(const f32x4 (&acc)[2][2][4][2], const Unit& u, int wr, int wc, int fr, int fq) const {
        const int row0 = u.pm * BM + wr * 64 + fr; int colt = (u.pn & pn_mask) * BM; bf16_t* base = O;
        float sc = 1.f; if (split_cols) { const int t = colt / split_cols; base += (size_t)t * split_stride; colt -= t * split_cols; if (t == 0) sc = scale0; }
        const int col0 = colt + wc * 32 + 8 * fq;
#pragma unroll
        for (int ai = 0; ai < 2; ++ai)
#pragma unroll
            for (int m = 0; m < 4; ++m) { bf16_t* rowp = base + (size_t)(row0 + ai * HALF + m * 16) * ldc + col0;
#pragma unroll
                for (int bj = 0; bj < 2; ++bj) { f32x4 v0 = acc[ai][bj][m][0] * sc, v1 = acc[ai][bj][m][1] * sc;
                    u32x4 w; w.x = cvt_pk_bf16(v0[0], v0[1]); w.y = cvt_pk_bf16(v0[2], v0[3]); w.z = cvt_pk_bf16(v1[0], v1[1]); w.w = cvt_pk_bf16(v1[2], v1[3]);
                    *(u32x4*)(rowp + bj * HALF) = w; } }
    }
};
struct EpiRes {
    static constexpr bool PERM = false;
    const float* base; float* out; int ldc;
    __device__ __forceinline__ void operator()(const f32x4 (&acc)[2][2][4][2], const Unit& u, int wr, int wc, int fr, int fq) const {
        const int row0 = u.pm * BM + wr * 64 + fr, col0 = u.pn * BM + wc * 32 + 4 * fq;
#pragma unroll
        for (int ai = 0; ai < 2; ++ai)
#pragma unroll
            for (int m = 0; m < 4; ++m) { const size_t off = (size_t)(row0 + ai * HALF + m * 16) * ldc + col0;
#pragma unroll
                for (int bj = 0; bj < 2; ++bj)
#pragma unroll
                    for (int n = 0; n < 2; ++n) { const f32x4 bs = *(const f32x4*)(base + off + bj * HALF + n * 16); *(f32x4*)(out + off + bj * HALF + n * 16) = bs + acc[ai][bj][m][n]; } }
    }
};
__device__ __forceinline__ float silu_mul(float a, float b) { return a * b * __builtin_amdgcn_rcpf(1.0f + __builtin_amdgcn_exp2f(-a * 1.4426950408889634f)); }
struct EpiSwiglu {
    static constexpr bool PERM = true;
    bf16_t* O;
    __device__ __forceinline__ void operator()(const f32x4 (&acc)[2][2][4][2], const Unit& u, int wr, int wc, int fr, int fq) const {
        const int row0 = u.pm * BM + wr * 64 + fr, col0 = (u.pn & 3) * 128 + wc * 32 + 8 * fq;
#pragma unroll
        for (int ai = 0; ai < 2; ++ai)
#pragma unroll
            for (int m = 0; m < 4; ++m) { bf16_t* rowp = O + (size_t)(row0 + ai * HALF + m * 16) * 512 + col0;
                const f32x4 a0 = acc[ai][0][m][0], a1 = acc[ai][0][m][1], b0 = acc[ai][1][m][0], b1 = acc[ai][1][m][1];
                u32x4 w; w.x = cvt_pk_bf16(silu_mul(a0[0], b0[0]), silu_mul(a0[1], b0[1])); w.y = cvt_pk_bf16(silu_mul(a0[2], b0[2]), silu_mul(a0[3], b0[3]));
                w.z = cvt_pk_bf16(silu_mul(a1[0], b1[0]), silu_mul(a1[1], b1[1])); w.w = cvt_pk_bf16(silu_mul(a1[2], b1[2]), silu_mul(a1[3], b1[3]));
                *(u32x4*)rowp = w; }
    }
};

template <class Epi, class Sched, bool ALIGN_EPI>
__device__ __forceinline__ void gemm_phase(PG8_LAS unsigned char* lds, const Gemm g, const Sched& S, const Epi& E) {
    const int tid = threadIdx.x, wid = __builtin_amdgcn_readfirstlane(tid >> 6), lane = tid & 63, wr = wid >> 2, wc = wid & 3, fr = lane & 15, fq = lane >> 4;
    const int K = g.K, nt = K / BK;
    int RA[2], CA[2]; unsigned voffB[2];
#pragma unroll
    for (int i = 0; i < 2; ++i) { int R, C; stage_rc(tid * 16 + i * 8192, R, C); RA[i] = R; CA[i] = C; const int Rb = Epi::PERM ? ((R & ~31) + perm32(R & 31)) : R; voffB[i] = (unsigned)(Rb * K + C) * 2u; }
    const size_t kstep = (size_t)(BK * 2);
    const size_t hstep = (size_t)HALF * K * 2;
    const size_t tstep = 2 * hstep;
    const unsigned ldsw = (unsigned)wid * 1024u;
    const int aoff = lds_byte(wr * 64 + fr, fq * 8), boff = lds_byte(wc * 32 + fr, fq * 8);
#define PG8_SA(b, h) (((b) * 2 + (h)) * HTB)
#define PG8_SB(b, h) ((4 + (b) * 2 + (h)) * HTB)
#define PG8_STAGE(bufoff, gbase, voff) do { _Pragma("unroll") for (int _i = 0; _i < 2; ++_i) \
        __builtin_amdgcn_global_load_lds((const unsigned*)((const char*)(gbase) + (voff)[_i]), (PG8_LAS unsigned*)(lds + (bufoff) + ldsw + _i * 8192), 16, 0, 0); } while (0)
#define PG8_LDA(dst, b, h) do { _Pragma("unroll") for (int m = 0; m < 4; ++m) _Pragma("unroll") for (int k = 0; k < 2; ++k) dst[m][k] = *(const PG8_LAS bf16x8*)(lds + PG8_SA(b, h) + aoff + m * 2048 + k * 1024); } while (0)
#define PG8_LDB(dst, b, h) do { _Pragma("unroll") for (int n = 0; n < 2; ++n) _Pragma("unroll") for (int k = 0; k < 2; ++k) dst[n][k] = *(const PG8_LAS bf16x8*)(lds + PG8_SB(b, h) + boff + n * 2048 + k * 1024); } while (0)
#define PG8_MMA(ai, bj, At, Bt) do { __builtin_amdgcn_s_setprio(1); _Pragma("unroll") for (int m = 0; m < 4; ++m) _Pragma("unroll") for (int n = 0; n < 2; ++n) _Pragma("unroll") for (int k = 0; k < 2; ++k) \
        acc[ai][bj][m][n] = __builtin_amdgcn_mfma_f32_16x16x32_bf16(Bt[n][k], At[m][k], acc[ai][bj][m][n], 0, 0, 0); __builtin_amdgcn_s_setprio(0); } while (0)
#define PG8_WAIT_V(n) asm volatile("s_waitcnt vmcnt(" #n ")" ::: "memory")
#define PG8_WAIT_L(n) asm volatile("s_waitcnt lgkmcnt(" #n ")" ::: "memory")
#define PG8_BAR __builtin_amdgcn_s_barrier()
#define PG8_SCHED __builtin_amdgcn_sched_barrier(0)
#define PG8_AOFF(dst, u) do { _Pragma("unroll") for (int _h = 0; _h < 2; ++_h) _Pragma("unroll") for (int _i = 0; _i < 2; ++_i) dst[_h][_i] = (S.arow(u, _h * HALF + RA[_i]) * (unsigned)K + (unsigned)CA[_i]) * 2u; } while (0)
    Unit cur, nxt; int ui = 0;
    if (!S.next(0, cur)) return;
    f32x4 acc[2][2][4][2];
#pragma unroll
    for (int a = 0; a < 2; ++a)
#pragma unroll
        for (int b = 0; b < 2; ++b)
#pragma unroll
            for (int m = 0; m < 4; ++m)
#pragma unroll
                for (int n = 0; n < 2; ++n) acc[a][b][m][n] = (f32x4){0.f, 0.f, 0.f, 0.f};
    bf16x8 At[4][2], B0[2][2], B1[2][2];
    unsigned offc[2][2], offn[2][2];
    PG8_AOFF(offc, cur);
    const char* const cA = (const char*)g.A; const char* cB = (const char*)g.Bt + (size_t)cur.pn * tstep;
    PG8_STAGE(PG8_SB(0, 0), cB, voffB); PG8_STAGE(PG8_SB(0, 1), cB + hstep, voffB); PG8_STAGE(PG8_SA(0, 0), cA, offc[0]); PG8_STAGE(PG8_SA(0, 1), cA, offc[1]);
    if (wr == 1) PG8_BAR;
    PG8_WAIT_V(2); PG8_BAR;
    PG8_STAGE(PG8_SB(1, 0), cB + kstep, voffB); PG8_STAGE(PG8_SA(1, 0), cA + kstep, offc[0]); PG8_STAGE(PG8_SB(1, 1), cB + hstep + kstep, voffB);
    PG8_WAIT_V(6); PG8_BAR;
    for (;;) {
        const bool has_next = S.next(ui + 1, nxt);
        if (has_next) { PG8_AOFF(offn, nxt); }
        else {
#pragma unroll
            for (int h = 0; h < 2; ++h)
#pragma unroll
                for (int i = 0; i < 2; ++i) offn[h][i] = offc[h][i]; }
        const char* nB = has_next ? (const char*)g.Bt + (size_t)nxt.pn * tstep : cB;
        for (int t = 0; t < nt; t += 2) {
            const bool last = (t == nt - 2);
            const char* a1 = cA + (size_t)(t + 1) * kstep;
            const char* a2 = last ? cA : cA + (size_t)(t + 2) * kstep; const char* b2 = last ? nB : cB + (size_t)(t + 2) * kstep;
            const char* a3 = a2 + kstep; const char* b3 = b2 + kstep;
            unsigned o2[2][2];
#pragma unroll
            for (int h = 0; h < 2; ++h)
#pragma unroll
                for (int i = 0; i < 2; ++i) o2[h][i] = last ? offn[h][i] : offc[h][i];
            PG8_LDB(B0, 0, 0); PG8_LDB(B1, 0, 1); PG8_SCHED; PG8_LDA(At, 0, 0); PG8_STAGE(PG8_SA(1, 1), a1, offc[1]);
            PG8_WAIT_V(8); PG8_WAIT_L(0); PG8_BAR; PG8_MMA(0, 0, At, B0); PG8_MMA(0, 1, At, B1); PG8_BAR; PG8_SCHED;
            PG8_LDA(At, 0, 1); PG8_STAGE(PG8_SB(0, 0), b2, voffB); PG8_STAGE(PG8_SB(0, 1), b2 + hstep, voffB); PG8_STAGE(PG8_SA(0, 0), a2, o2[0]);
            PG8_WAIT_V(8); PG8_WAIT_L(0); PG8_BAR; PG8_MMA(1, 0, At, B0); PG8_MMA(1, 1, At, B1); PG8_BAR; PG8_SCHED;
            PG8_LDB(B0, 1, 0); PG8_LDB(B1, 1, 1); PG8_SCHED; PG8_LDA(At, 1, 0); PG8_STAGE(PG8_SA(0, 1), a2, o2[1]);
            PG8_WAIT_V(8); PG8_WAIT_L(0); PG8_BAR; PG8_MMA(0, 0, At, B0); PG8_MMA(0, 1, At, B1); PG8_BAR; PG8_SCHED;
            PG8_LDA(At, 1, 1); PG8_STAGE(PG8_SB(1, 0), b3, voffB); PG8_STAGE(PG8_SB(1, 1), b3 + hstep, voffB); PG8_STAGE(PG8_SA(1, 0), a3, o2[0]);
            PG8_WAIT_V(8); PG8_WAIT_L(0); PG8_BAR; PG8_MMA(1, 0, At, B0); PG8_MMA(1, 1, At, B1); PG8_BAR; PG8_SCHED;
        }
        if constexpr (ALIGN_EPI) { if (wr == 0) PG8_BAR; }
        E(acc, cur, wr, wc, fr, fq);
        if (!has_next) break;
#pragma unroll
        for (int a = 0; a < 2; ++a)
#pragma unroll
            for (int b = 0; b < 2; ++b)
#pragma unroll
                for (int m = 0; m < 4; ++m)
#pragma unroll
                    for (int n = 0; n < 2; ++n) acc[a][b][m][n] = (f32x4){0.f, 0.f, 0.f, 0.f};
        cur = nxt; cB = nB; ++ui;
#pragma unroll
        for (int h = 0; h < 2; ++h)
#pragma unroll
            for (int i = 0; i < 2; ++i) offc[h][i] = offn[h][i];
        if constexpr (ALIGN_EPI) { if (wr == 1) PG8_BAR; }
    }
    PG8_WAIT_V(0);
    if constexpr (!ALIGN_EPI) { if (wr == 0) PG8_BAR; }
    PG8_BAR;
#undef PG8_SA
#undef PG8_SB
#undef PG8_STAGE
#undef PG8_LDA
#undef PG8_LDB
#undef PG8_MMA
#undef PG8_WAIT_V
#undef PG8_WAIT_L
#undef PG8_BAR
#undef PG8_SCHED
#undef PG8_AOFF
}
}

#define XB_TMO      128
#define XB_XCNT(j)  (256  + 64 * (j))
#define XB_XSUB(j)  (1280 + 64 * (j))
#define XB_XGEN(j)  (2304 + 64 * (j))
#define XB_TOP      3328
#define XB_TOPGEN   3392
#define XCD_BAR_WORDS 3456
#define XB_SPIN_CAP (1u << 18)

__device__ __forceinline__ unsigned xb_ld(unsigned* p)              { return __hip_atomic_load(p, __ATOMIC_RELAXED, __HIP_MEMORY_SCOPE_AGENT); }
__device__ __forceinline__ unsigned xb_add(unsigned* p, unsigned v) { return __hip_atomic_fetch_add(p, v, __ATOMIC_RELAXED, __HIP_MEMORY_SCOPE_AGENT); }
__device__ __forceinline__ unsigned xb_xcc_id() { return (unsigned)__builtin_amdgcn_s_getreg((3 << 11) | 20) & 0xFu; }
#define XB_SPIN(cond, bar) do { unsigned _sp = 0; while (cond) { __builtin_amdgcn_s_sleep(1); \
    if ((++_sp & 255u) == 0u) { if (xb_ld(&(bar)[XB_TMO])) break; if (_sp > XB_SPIN_CAP) { atomicAdd(&(bar)[XB_TMO], 1u); break; } } } } while (0)

struct XcdBarrier { unsigned* bar; unsigned x; volatile LAS unsigned* st; };

__device__ __forceinline__ XcdBarrier xcd_barrier_post(unsigned* bar, volatile LAS unsigned* st) {
    XcdBarrier b; b.bar = bar; b.x = xb_xcc_id(); b.st = st;
    if (threadIdx.x == 0) (void)xb_add(&bar[XB_XCNT(b.x)], 1u);
    return b;
}
__device__ __forceinline__ void xcd_barrier_complete(unsigned* bar, unsigned x, unsigned& nloc, unsigned& nx) {
    const unsigned G = gridDim.x * gridDim.y * gridDim.z;
    unsigned sum, cnt, mine, sp = 0u;
    for (;;) {
        sum = 0u; cnt = 0u; mine = 0u;
#pragma unroll
        for (unsigned j = 0; j < 16; ++j) { const unsigned c = xb_ld(&bar[XB_XCNT(j)]); sum += c; cnt += (c > 0u) ? 1u : 0u; mine = (j == x) ? c : mine; }
        if (sum == G) break;
        __builtin_amdgcn_s_sleep(1);
        if ((++sp & 255u) == 0u) { if (xb_ld(&bar[XB_TMO])) break; if (sp > XB_SPIN_CAP) { atomicAdd(&bar[XB_TMO], 1u); break; } }
    }
    nloc = mine > 0u ? mine : 1u; nx = cnt > 0u ? cnt : 1u;
}
__device__ __forceinline__ void xcd_barrier(const XcdBarrier& b) {
    asm volatile("s_waitcnt vmcnt(0)" ::: "memory");
    __syncthreads();
    if (threadIdx.x == 0) {
        unsigned* bar = b.bar;
        __builtin_amdgcn_s_waitcnt(0);
        unsigned nloc = b.st[0], nx = b.st[1];
        if (nloc == 0u) { xcd_barrier_complete(bar, b.x, nloc, nx); b.st[0] = nloc; b.st[1] = nx; }
        const unsigned old = xb_add(&bar[XB_XSUB(b.x)], 1u);
        const unsigned gen = old / nloc;
        if (old + 1u == (gen + 1u) * nloc) {
            __builtin_amdgcn_fence(__ATOMIC_RELEASE, "agent");
            asm volatile("s_waitcnt vmcnt(0)" ::: "memory");
            const unsigned og = xb_add(&bar[XB_TOP], 1u);
            const unsigned tg = og / nx;
            if (og + 1u == (tg + 1u) * nx) xb_add(&bar[XB_TOPGEN], 1u);
            else XB_SPIN(xb_ld(&bar[XB_TOPGEN]) == tg, bar);
            __builtin_amdgcn_fence(__ATOMIC_ACQUIRE, "agent");
            xb_add(&bar[XB_XGEN(b.x)], 1u);
            asm volatile("s_waitcnt vmcnt(0)" ::: "memory");
        } else {
            XB_SPIN(xb_ld(&bar[XB_XGEN(b.x)]) == gen, bar);
            __builtin_amdgcn_fence(__ATOMIC_ACQUIRE, "agent");
            asm volatile("s_waitcnt vmcnt(0)" ::: "memory");
        }
    }
    __syncthreads();
}

__device__ __forceinline__ void transpose_item(const float* W, int K, int N, bf16* WT, int kb, int nb, int dst_row0, LAS float* scr, int lane) {
    const int k0 = 64 * kb, n0 = 32 * nb;
#pragma unroll 8
    for (int i = 0; i < 32; ++i) { const int kk = 2 * i + (lane >> 5); scr[kk * 33 + (lane & 31)] = W[(size_t)(k0 + kk) * N + n0 + (lane & 31)]; }
    LDS_WAIT(); asm volatile("" ::: "memory");
    const int c = lane & 7;
#pragma unroll
    for (int j = 0; j < 4; ++j) { const int n = (lane >> 3) + 8 * j; const LAS float* s = scr + (8 * c) * 33 + n;
        v4u o; o.x = pk2(s[0 * 33], s[1 * 33]); o.y = pk2(s[2 * 33], s[3 * 33]); o.z = pk2(s[4 * 33], s[5 * 33]); o.w = pk2(s[6 * 33], s[7 * 33]);
        *(GAS v4u*)(WT + (size_t)(dst_row0 + n) * K + k0 + 8 * c) = o; }
    LDS_WAIT(); asm volatile("" ::: "memory");
}
__device__ __forceinline__ void transpose_plain(const float* W, int K, int N, bf16* WT, LAS float* scr, int gw, int ngw, int lane) {
    const int nblk = N / 32, nitems = (K / 64) * nblk;
    for (int it = gw; it < nitems; it += ngw) { const int kb = it / nblk, nb = it % nblk; transpose_item(W, K, N, WT, kb, nb, 32 * nb, scr, lane); }
}
__device__ __forceinline__ void transpose_moe(const float* w1, const float* w3, const float* w2, bf16* W13T, bf16* W2T, LAS float* scr, int gw, int ngw, int lane) {
    constexpr int I13 = 16 * 16, I2 = 8 * 32, IPE = 2 * I13 + I2;
    for (int it = gw; it < NEXP * IPE; it += ngw) {
        const int e = it / IPE; int r = it % IPE;
        if (r < 2 * I13) { const int which = r / I13; r %= I13; const int kb = r / 16, nb = r % 16, n0 = 32 * nb;
            const float* W = (which ? w3 : w1) + (size_t)e * 1024 * 512;
            transpose_item(W, 1024, 512, W13T + (size_t)e * 1024 * 1024, kb, nb, (n0 >> 7) * 256 + which * 128 + (n0 & 127), scr, lane);
        } else { r -= 2 * I13; const int kb = r / 32, nb = r % 32;
            transpose_item(w2 + (size_t)e * 512 * 1024, 512, 1024, W2T + (size_t)e * 1024 * 512, kb, nb, 32 * nb, scr, lane); }
    }
}
__device__ __forceinline__ void rms_row(const float* xrow, const float* g, f32x4 (&v)[4], int lane) {
    const GAS f32x4* xr = (const GAS f32x4*)xrow + lane; const GAS f32x4* gr = (const GAS f32x4*)g + lane;
    float s = 0.f;
#pragma unroll
    for (int j = 0; j < 4; ++j) { v[j] = xr[64 * j]; s += (v[j].x * v[j].x + v[j].y * v[j].y) + (v[j].z * v[j].z + v[j].w * v[j].w); }
    const float rstd = 1.0f / sqrtf(wave_sum(s) * (1.f / DM) + 1e-6f);
#pragma unroll
    for (int j = 0; j < 4; ++j) { const f32x4 gg = gr[64 * j]; v[j] = v[j] * rstd * gg; }
}
__device__ __forceinline__ void store_row_bf16(bf16* orow, const f32x4 (&v)[4], int lane) {
    GAS unsigned long long* o8 = (GAS unsigned long long*)orow + lane;
#pragma unroll
    for (int j = 0; j < 4; ++j) o8[64 * j] = (unsigned long long)pk2(v[j].x, v[j].y) | ((unsigned long long)pk2(v[j].z, v[j].w) << 32);
}

__device__ __forceinline__ int t5_bucket(int rel) {
    const int n = rel < 0 ? -rel : rel; int ret = rel > 0 ? 16 : 0;
    int v;
    if (n < 8) v = n;
    else { const float nf = (float)n; int large = 8 + (int)(logf(nf / 8.0f) / 2.772588722239781f * 8.0f); v = large < 15 ? large : 15; }
    return ret + v;
}

__device__ __forceinline__ int crow(int r, int hi) { return (r & 3) + 8 * (r >> 2) + 4 * hi; }
__device__ __forceinline__ unsigned cvtpk(float lo, float hi) { unsigned r; asm volatile("v_cvt_pk_bf16_f32 %0, %1, %2" : "=v"(r) : "v"(lo), "v"(hi)); return r; }
__device__ __forceinline__ s16x4 vtr(const LAS char* p) { typedef short v4i16_t __attribute__((ext_vector_type(4))); return __builtin_bit_cast(s16x4, __builtin_amdgcn_ds_read_tr16_b64_v4i16((LAS v4i16_t*)p)); }

template <int DV, bool BIAS>
__device__ __forceinline__ void attn_unit_v0(const bf16* Qp, int ldq, const bf16* Kp, int ldk, const bf16* Vp, int ldv, bf16* Op, int ldo, const LAS float* btbl, int q0, LAS unsigned char* lds) {
    const int tid = threadIdx.x, lane = tid & 63, r32 = lane & 31, hi = lane >> 5; const int wid = __builtin_amdgcn_readfirstlane(tid >> 6);
    constexpr int ND = DV / 32;
    LAS unsigned char* ldsK = lds; LAS unsigned char* ldsV = lds + 8192; LAS float* wsf = (LAS float*)(lds + 8192 + DV * 128) + wid * 64;
    bf16x8 qr[4];
#pragma unroll
    for (int d0 = 0; d0 < 4; ++d0) qr[d0] = *(const bf16x8*)(Qp + (size_t)(wid * 32 + r32) * ldq + d0 * 16 + hi * 8);
    f32x16 o[ND];
#pragma unroll
    for (int d = 0; d < ND; ++d)
#pragma unroll
        for (int r = 0; r < 16; ++r) o[d][r] = 0.f;
    float l = 0.f;
    const int qpos = q0 + wid * 32 + r32;
    const LAS char* kp0 = (const LAS char*)ldsK + hi * 1024 + r32 * 16;
    const LAS char* vp0 = (const LAS char*)ldsV + ((lane >> 4) & 1) * 32 + (lane & 3) * 8 + (4 * hi + ((lane & 15) >> 2)) * 64;
    for (int t = 0; t < SEQ / 64; ++t) {
        __syncthreads();
        {
            const v4u kv = *(const v4u*)(Kp + (size_t)(t * 64 + lane) * ldk + wid * 8);
            *(LAS v4u*)(ldsK + wid * 1024 + lane * 16) = kv;
#pragma unroll
            for (int pp = 0; pp < ND / 2; ++pp) { const int p = wid + 8 * pp, dq = p >> 2, rg = p & 3;
                const v4u vv = *(const v4u*)(Vp + (size_t)(t * 64 + 16 * rg + (lane >> 2)) * ldv + dq * 32 + (lane & 3) * 8);
                *(LAS v4u*)(ldsV + p * 1024 + lane * 16) = vv; }
        }
        __syncthreads();
        f32x16 p0, p1;
#pragma unroll
        for (int r = 0; r < 16; ++r) { p0[r] = 0.f; p1[r] = 0.f; }
#pragma unroll
        for (int d0 = 0; d0 < 4; ++d0) {
            const bf16x8 b0 = *(const LAS bf16x8*)(kp0 + d0 * 2048), b1 = *(const LAS bf16x8*)(kp0 + d0 * 2048 + 512);
            p0 = __builtin_amdgcn_mfma_f32_32x32x16_bf16(b0, qr[d0], p0, 0, 0, 0);
            p1 = __builtin_amdgcn_mfma_f32_32x32x16_bf16(b1, qr[d0], p1, 0, 0, 0);
        }
        if (BIAS) {
            const int base = t * 64 + 4 * hi - qpos;
#pragma unroll
            for (int r = 0; r < 16; ++r) { int rel = base + (r & 3) + 8 * (r >> 2);
                int i0 = rel < -128 ? -128 : (rel > 128 ? 128 : rel); int rel1 = rel + 32; int i1 = rel1 < -128 ? -128 : (rel1 > 128 ? 128 : rel1);
                p0[r] += btbl[i0 + 128]; p1[r] += btbl[i1 + 128]; }
        }
        float sacc = 0.f;
#pragma unroll
        for (int r = 0; r < 16; ++r) { p0[r] = __builtin_amdgcn_exp2f(p0[r]); p1[r] = __builtin_amdgcn_exp2f(p1[r]); sacc += p0[r] + p1[r]; }
        l += sacc;
        v4u pw[4];
#pragma unroll
        for (int k = 0; k < 2; ++k) {
            pw[k]     = (v4u){cvtpk(p0[8 * k + 0], p0[8 * k + 1]), cvtpk(p0[8 * k + 2], p0[8 * k + 3]), cvtpk(p0[8 * k + 4], p0[8 * k + 5]), cvtpk(p0[8 * k + 6], p0[8 * k + 7])};
            pw[2 + k] = (v4u){cvtpk(p1[8 * k + 0], p1[8 * k + 1]), cvtpk(p1[8 * k + 2], p1[8 * k + 3]), cvtpk(p1[8 * k + 4], p1[8 * k + 5]), cvtpk(p1[8 * k + 6], p1[8 * k + 7])};
        }
#pragma unroll
        for (int d0 = 0; d0 < ND; ++d0)
#pragma unroll
            for (int ks = 0; ks < 4; ++ks) {
                const s16x4 lo = vtr(vp0 + d0 * 4096 + ks * 1024), hh = vtr(vp0 + d0 * 4096 + ks * 1024 + 512);
                const bf16x8 vf = (bf16x8){lo[0], lo[1], lo[2], lo[3], hh[0], hh[1], hh[2], hh[3]};
                o[d0] = __builtin_amdgcn_mfma_f32_32x32x16_bf16(__builtin_bit_cast(bf16x8, pw[ks]), vf, o[d0], 0, 0, 0);
            }
    }
    l += __shfl_xor(l, 32);
    if (hi == 0) wsf[r32] = l;
    LDS_WAIT(); asm volatile("" ::: "memory");
#pragma unroll
    for (int r = 0; r < 16; ++r) { const int row = crow(r, hi); const float rl = 1.0f / wsf[row];
#pragma unroll
        for (int d0 = 0; d0 < ND; ++d0) Op[(size_t)(wid * 32 + row) * ldo + d0 * 32 + r32] = (bf16)f2bf(o[d0][r] * rl); }
    LDS_WAIT();
}

struct Args { const float* in[27]; float* out; unsigned char* ws; int ph_lo, ph_hi, li, pad; };

constexpr int NPHASE = 17;
constexpr int NWAVES = 8;

#define IN(k) (lo <= (k) && (k) < hi_ph)
#define SEAM(k) do { if (IN(k) && IN((k) + 1)) xcd_barrier(bar); } while (0)
template <int layer>
__device__ __forceinline__ void moe_block(const Args& args, LAS unsigned char* lds, const XcdBarrier& bar, int lo, int hi_ph) {
    volatile LAS unsigned* LC = (volatile LAS unsigned*)(lds + LDSCTL_OFF);
    const int tid = threadIdx.x, lane = tid & 63, wave = __builtin_amdgcn_readfirstlane(tid >> 6);
    const int G = gridDim.x, bx = blockIdx.x;
    const int gw = bx * NWAVES + wave, NGW = G * NWAVES;
    unsigned char* ws = args.ws;
    unsigned* ctl = (unsigned*)(ws + WS_CTL);
    float* xres = args.out;
    bf16* HB = (bf16*)(ws + WS_HB);
    {
        const int pb = layer == 0 ? 5 : 13;
        unsigned* gcnt = ctl + CW_CNT + layer * 64;
        int* list = (int*)(ws + WS_LIST); int* tokep = (int*)(ws + WS_TOKEP); float* gate = (float*)(ws + WS_GATE);
        if (IN(pb)) {
            const float* gf = args.in[2] + layer * DM;
            const float* Wg = args.in[20] + (size_t)layer * DM * 4; const float* bg = args.in[21] + layer * 4;
            const float* We = args.in[22] + (size_t)layer * DM * 32; const float* be = args.in[23] + layer * 32;
            for (int chunk = bx; chunk < NTOK / 128; chunk += G) {
                __syncthreads();
                if (tid < 32) LC[LC_LCNT + tid] = 0u;
                __syncthreads();
                int my_e0 = 0, my_e1 = 0; float my_g0 = 0.f, my_g1 = 0.f;
                for (int i = 0; i < 16; ++i) {
                    const int m = chunk * 128 + wave * 16 + i;
                    f32x4 v[4]; rms_row(xres + (size_t)m * DM, gf, v, lane); store_row_bf16(HB + (size_t)m * DM, v, lane);
                    float lg[4] = {0.f, 0.f, 0.f, 0.f}; float le[32];
#pragma unroll
                    for (int e = 0; e < 32; ++e) le[e] = 0.f;
#pragma unroll
                    for (int j = 0; j < 4; ++j)
#pragma unroll
                        for (int c = 0; c < 4; ++c) { const int k = 4 * lane + 256 * j + c; const float hv = v[j][c];
                            const f32x4 wg = *(const GAS f32x4*)(Wg + (size_t)k * 4);
                            lg[0] += hv * wg.x; lg[1] += hv * wg.y; lg[2] += hv * wg.z; lg[3] += hv * wg.w;
#pragma unroll
                            for (int q = 0; q < 8; ++q) { const f32x4 we = *(const GAS f32x4*)(We + (size_t)k * 32 + q * 4);
                                le[4 * q] += hv * we.x; le[4 * q + 1] += hv * we.y; le[4 * q + 2] += hv * we.z; le[4 * q + 3] += hv * we.w; } }
#pragma unroll
                    for (int e = 0; e < 4; ++e) lg[e] = wave_sum(lg[e]) + bg[e];
#pragma unroll
                    for (int e = 0; e < 32; ++e) le[e] = wave_sum(le[e]) + be[e];
                    int gi = 0; float gm = lg[0];
#pragma unroll
                    for (int e = 1; e < 4; ++e) if (lg[e] > gm) { gm = lg[e]; gi = e; }
                    float gs = 0.f;
#pragma unroll
                    for (int e = 0; e < 4; ++e) gs += __expf(lg[e] - gm);
                    const float gval = 1.0f / gs;
                    float ev[8];
#pragma unroll
                    for (int j = 0; j < 8; ++j) ev[j] = gi == 0 ? le[j] : (gi == 1 ? le[8 + j] : (gi == 2 ? le[16 + j] : le[24 + j]));
                    int i0 = 0; float m0 = ev[0];
#pragma unroll
                    for (int j = 1; j < 8; ++j) if (ev[j] > m0) { m0 = ev[j]; i0 = j; }
                    int i1 = -1; float m1 = -3.0e38f;
#pragma unroll
                    for (int j = 0; j < 8; ++j) if (j != i0 && ev[j] > m1) { m1 = ev[j]; i1 = j; }
                    const float t1 = __expf(m1 - m0); const float den = 1.0f / (1.0f + t1);
                    if (lane == i) { my_e0 = gi * 8 + i0; my_e1 = gi * 8 + i1; my_g0 = gval * den; my_g1 = gval * t1 * den; }
                }
                unsigned r0 = 0, r1 = 0;
                if (lane < 16) { r0 = atomicAdd((unsigned*)(LC + LC_LCNT + my_e0), 1u); r1 = atomicAdd((unsigned*)(LC + LC_LCNT + my_e1), 1u); }
                __syncthreads();
                if (tid < 32) { const unsigned c = LC[LC_LCNT + tid]; LC[LC_LBASE + tid] = c ? __hip_atomic_fetch_add(gcnt + tid, c, RLX_AGENT) : 0u; }
                __syncthreads();
                if (lane < 16) { const int m = chunk * 128 + wave * 16 + lane;
                    const unsigned p0 = LC[LC_LBASE + my_e0] + r0, p1 = LC[LC_LBASE + my_e1] + r1;
                    list[(size_t)my_e0 * LIST_CAP + p0] = m; list[(size_t)my_e1 * LIST_CAP + p1] = m;
                    tokep[2 * m] = my_e0 | (int)(p0 << 8); tokep[2 * m + 1] = my_e1 | (int)(p1 << 8);
                    gate[2 * m] = my_g0; gate[2 * m + 1] = my_g1; }
            }
        }
        SEAM(pb);
        if (IN(pb + 1) || IN(pb + 2) || IN(pb + 3)) {
            __syncthreads();
            if (tid == 0) { int acc = 0; for (int e = 0; e < 32; ++e) { const int c = (int)__hip_atomic_load(gcnt + e, RLX_AGENT); LC[LC_CNT + e] = (unsigned)c; LC[LC_TP + e] = (unsigned)acc; acc += (c + 255) >> 8; } LC[LC_TP + 32] = (unsigned)acc; }
            __syncthreads();
        }
        const LAS int* tp = (const LAS int*)(lds + LDSCTL_OFF) + LC_TP; const LAS int* cn = (const LAS int*)(lds + LDSCTL_OFF) + LC_CNT;
        if (IN(pb + 1)) {
            pg8::Gemm g{HB, (const bf16*)(ws + WS_W13), 0, 1024, DM};
            pg8::MoeOrder S{tp, cn, list, G, bx, tp[32] * 4, true};
            pg8::EpiSwiglu E{(bf16*)(ws + WS_H)};
            pg8::gemm_phase<pg8::EpiSwiglu, pg8::MoeOrder, true>(lds, g, S, E);
        }
        SEAM(pb + 1);
        if (IN(pb + 2)) {
            pg8::Gemm g{(const bf16*)(ws + WS_H), (const bf16*)(ws + WS_W2), 0, 1024, MOE_H};
            pg8::MoeOrder S{tp, cn, list, G, bx, tp[32] * 4, false};
            pg8::EpiBf16 E{(bf16*)(ws + WS_YS), DM, 0, 0, 1.f, 3};
            pg8::gemm_phase<pg8::EpiBf16, pg8::MoeOrder, true>(lds, g, S, E);
        }
        SEAM(pb + 2);
        if (IN(pb + 3)) {
            const bf16* YS = (const bf16*)(ws + WS_YS);
            if (layer == 0) { LAS float* scr = (LAS float*)(lds + wave * 16384);
                transpose_moe(args.in[24] + (size_t)NEXP * 1024 * 512, args.in[25] + (size_t)NEXP * 1024 * 512, args.in[26] + (size_t)NEXP * 1024 * 512, (bf16*)(ws + WS_W13), (bf16*)(ws + WS_W2), scr, gw, NGW, lane); }
            const float* gn = layer == 0 ? args.in[1] + DM : args.in[3];
            for (int m = gw; m < NTOK; m += NGW) {
                const int ep0 = tokep[2 * m], ep1 = tokep[2 * m + 1]; const float g0 = gate[2 * m], g1 = gate[2 * m + 1];
                const size_t s0 = (size_t)(tp[ep0 & 255] * 256 + (ep0 >> 8)), s1 = (size_t)(tp[ep1 & 255] * 256 + (ep1 >> 8));
                GAS f32x4* xr = (GAS f32x4*)(xres + (size_t)m * DM) + lane;
                const GAS v2u* y0 = (const GAS v2u*)(YS + s0 * DM) + lane; const GAS v2u* y1 = (const GAS v2u*)(YS + s1 * DM) + lane;
                f32x4 v[4]; float ss = 0.f;
#pragma unroll
                for (int j = 0; j < 4; ++j) { const v2u a = y0[64 * j], c = y1[64 * j]; f32x4 xv = xr[64 * j];
                    xv.x += g0 * __builtin_bit_cast(float, a.x << 16) + g1 * __builtin_bit_cast(float, c.x << 16);
                    xv.y += g0 * __builtin_bit_cast(float, a.x & 0xffff0000u) + g1 * __builtin_bit_cast(float, c.x & 0xffff0000u);
                    xv.z += g0 * __builtin_bit_cast(float, a.y << 16) + g1 * __builtin_bit_cast(float, c.y << 16);
                    xv.w += g0 * __builtin_bit_cast(float, a.y & 0xffff0000u) + g1 * __builtin_bit_cast(float, c.y & 0xffff0000u);
                    v[j] = xv; ss += (xv.x * xv.x + xv.y * xv.y) + (xv.z * xv.z + xv.w * xv.w); }
                const float rstd = 1.0f / sqrtf(wave_sum(ss) * (1.f / DM) + 1e-6f);
                const GAS f32x4* gr = (const GAS f32x4*)gn + lane;
                if (layer == 0) {
#pragma unroll
                    for (int j = 0; j < 4; ++j) xr[64 * j] = v[j];
#pragma unroll
                    for (int j = 0; j < 4; ++j) v[j] = v[j] * rstd * gr[64 * j];
                    store_row_bf16(HB + (size_t)m * DM, v, lane);
                } else {
#pragma unroll
                    for (int j = 0; j < 4; ++j) xr[64 * j] = v[j] * rstd * gr[64 * j];
                }
            }
        }
    }
}

__global__ void __launch_bounds__(NWAVES * 64, 2) mk_fwd(Args args) {
    extern __shared__ __attribute__((aligned(16))) unsigned char lds_raw[];
    LAS unsigned char* lds = (LAS unsigned char*)lds_raw;
    volatile LAS unsigned* LC = (volatile LAS unsigned*)(lds + LDSCTL_OFF);
    const int tid = threadIdx.x, lane = tid & 63, wave = __builtin_amdgcn_readfirstlane(tid >> 6);
    const int G = gridDim.x, bx = blockIdx.x;
    const int gw = bx * NWAVES + wave, NGW = G * NWAVES;
    unsigned char* ws = args.ws;
    unsigned* ctl = (unsigned*)(ws + WS_CTL);
    const float* x_in = args.in[0];
    float* xres = args.out;
    bf16* HB = (bf16*)(ws + WS_HB); bf16* Y = (bf16*)(ws + WS_Y);
    float* TBL = (float*)(ws + WS_TBL);

    for (int u = tid; u < (LDS_BYTES - LDSCTL_OFF) / 4; u += NWAVES * 64) LC[u] = 0u;
    __syncthreads();
    XcdBarrier bar; bar.bar = ctl + CW_BAR; bar.x = 0; bar.st = nullptr;
    if (MK_N_LAUNCHES == 1) bar = xcd_barrier_post(ctl + CW_BAR, LC + LC_BAR);
    const int lo = args.ph_lo, hi_ph = args.ph_hi;

    if (IN(0)) {
        LAS float* scr = (LAS float*)(lds + wave * 16384);
        transpose_plain(args.in[4], DM, EV_IN, (bf16*)(ws + WS_WIN0), scr, gw, NGW, lane);
        transpose_plain(args.in[11], DM, DM, (bf16*)(ws + WS_WOUT0), scr, gw, NGW, lane);
        transpose_plain(args.in[12], DM, OD_IN, (bf16*)(ws + WS_WIN1), scr, gw, NGW, lane);
        transpose_plain(args.in[18], DM, DM, (bf16*)(ws + WS_WOUT1), scr, gw, NGW, lane);
        transpose_moe(args.in[24], args.in[25], args.in[26], (bf16*)(ws + WS_W13), (bf16*)(ws + WS_W2), scr, gw, NGW, lane);
        for (int i = bx * 512 + tid; i < 2048; i += G * 512) { const int pos = i >> 4, f = i & 15;
            const float inv = exp2f(-(float)f * (13.287712379549449f / 16.0f));
            const float ang = (float)pos * inv; const float rev = ang * 0.15915494309189535f; const float fr = rev - floorf(rev);
            TBL[TBL_COS + i] = __builtin_amdgcn_cosf(fr); TBL[TBL_SIN + i] = __builtin_amdgcn_sinf(fr); }
        for (int i = bx * 512 + tid; i < 8 * 257; i += G * 512) { const int h = i / 257, j = i % 257;
            TBL[TBL_BIAS + h * BIAS_STRIDE + j] = args.in[19][t5_bucket(j - 128) * 8 + h] * LOG2E; }
        for (int m = gw; m < NTOK; m += NGW) { f32x4 v[4]; rms_row(x_in + (size_t)m * DM, args.in[1], v, lane); store_row_bf16(HB + (size_t)m * DM, v, lane); }
    }
    SEAM(0);
    if (IN(1)) {
        pg8::Gemm g{HB, (const bf16*)(ws + WS_WIN0), NTOK, EV_IN, DM}; pg8::StaticOrder S; S.init(NTOK, EV_IN, G, bx);
        pg8::EpiBf16 E{(bf16*)(ws + WS_Z0), EV_IN, 0, 0, 1.f, 0xffff};
        pg8::gemm_phase<pg8::EpiBf16, pg8::StaticOrder, true>(lds, g, S, E);
    }
    SEAM(1);
    if (IN(2)) {
        const bf16* Z0 = (const bf16*)(ws + WS_Z0); bf16* QR = (bf16*)(ws + WS_QR); bf16* KR = (bf16*)(ws + WS_KR);
        const float gq = args.in[5][lane], gk = args.in[6][lane];
        const int fi = lane & 15; const bool first = (lane & 16) == 0, isrow = lane < 32;
        for (int m = gw; m < NTOK; m += NGW) {
            const int s = m & (SEQ - 1); const int pos = isrow ? (s >> 6) : (s & 63);
            const float cs = TBL[TBL_COS + pos * 16 + fi], sn = TBL[TBL_SIN + pos * 16 + fi];
#pragma unroll
            for (int h = 0; h < 10; ++h) {
                const float xv = bf2f(Z0[(size_t)m * EV_IN + h * 64 + lane]);
                const float ss = wave_sum(xv * xv);
                const float y = xv * (1.0f / sqrtf(ss * (1.f / 64.f) + 1e-6f)) * (h < 8 ? gq : gk);
                const float p = __shfl_xor(y, 16);
                float o = first ? (y * cs - p * sn) : (y * cs + p * sn);
                if (h < 8) QR[(size_t)m * 512 + h * 64 + lane] = (bf16)f2bf(o * C2);
                else KR[(size_t)m * 128 + (h - 8) * 64 + lane] = (bf16)f2bf(o);
            }
        }
        LAS float* hbuf = (LAS float*)lds;
        for (int un = bx; un < NBATCH * 128 * 8; un += G) {
            const int grp = un & 7, tt = (un >> 3) & 127, b = un >> 10; const int t0 = tt * 64;
            __syncthreads();
            for (int idx = tid; idx < 94 * 64; idx += 512) { const int r = idx >> 6, c = idx & 63; const int s = t0 - 15 + r; float hv = 0.f;
                if (s >= 0 && s < SEQ) { const size_t ro = (size_t)(b * SEQ + s) * EV_IN; const float a = bf2f(Z0[ro + 768 + grp * 64 + c]), gt = bf2f(Z0[ro + 1280 + grp * 64 + c]);
                    hv = a / (1.0f + __expf(-gt)); }
                hbuf[idx] = hv; }
            __syncthreads();
            const int ch = grp * 64 + lane;
            float wreg[31];
#pragma unroll
            for (int j = 0; j < 31; ++j) wreg[j] = args.in[7][j * 512 + ch];
            float acc[8]; const float cb = args.in[8][ch];
#pragma unroll
            for (int i = 0; i < 8; ++i) acc[i] = cb;
#pragma unroll
            for (int r = 0; r < 38; ++r) { const float hv = hbuf[(wave * 8 + r) * 64 + lane];
#pragma unroll
                for (int i = 0; i < 8; ++i) { const int j = r - i; if (j >= 0 && j < 31) acc[i] += wreg[j] * hv; } }
            const float gg = args.in[9][ch], gb = args.in[10][ch];
#pragma unroll
            for (int i = 0; i < 8; ++i) { const float mu = wave_sum(acc[i]) * (1.f / 64.f); const float d = acc[i] - mu; const float var = wave_sum(d * d) * (1.f / 64.f);
                const float hn = d * (1.0f / sqrtf(var + 1e-5f)) * gg + gb; const float ov = hn / (1.0f + __expf(-hn));
                Y[(size_t)(b * SEQ + t0 + wave * 8 + i) * DM + 512 + ch] = (bf16)f2bf(ov); }
        }
    }
    SEAM(2);
    if (IN(3)) {
        const bf16* QR = (const bf16*)(ws + WS_QR); const bf16* KR = (const bf16*)(ws + WS_KR); const bf16* Z0 = (const bf16*)(ws + WS_Z0);
        for (int un = bx; un < NBATCH * 8 * 32; un += G) {
            const int qb = un & 31, h = (un >> 5) & 7, b = un >> 8, kvh = h >> 2;
            const size_t row0 = (size_t)b * SEQ + qb * 256;
            attn_unit_v0<64, false>(QR + row0 * 512 + h * 64, 512, KR + (size_t)b * SEQ * 128 + kvh * 64, 128, Z0 + (size_t)b * SEQ * EV_IN + 640 + kvh * 64, EV_IN,
                                   Y + row0 * DM + h * 64, DM, nullptr, qb * 256, lds);
        }
    }
    SEAM(3);
    if (IN(4)) {
        pg8::Gemm g{Y, (const bf16*)(ws + WS_WOUT0), NTOK, DM, DM}; pg8::StaticOrder S; S.init(NTOK, DM, G, bx);
        pg8::EpiRes E{x_in, xres, DM};
        pg8::gemm_phase<pg8::EpiRes, pg8::StaticOrder, true>(lds, g, S, E);
    }
    SEAM(4);

    moe_block<0>(args, lds, bar, lo, hi_ph);
    SEAM(8);
            if (IN(9)) {
                pg8::Gemm g{HB, (const bf16*)(ws + WS_WIN1), NTOK, OD_IN, DM}; pg8::StaticOrder S; S.init(NTOK, OD_IN, G, bx);
                pg8::EpiBf16 E{(bf16*)(ws + WS_Q1), DM, DM, (size_t)(WS_K1 - WS_Q1) / 2, C2, 0xffff};
                pg8::gemm_phase<pg8::EpiBf16, pg8::StaticOrder, true>(lds, g, S, E);
            }
            SEAM(9);
            if (IN(10)) {
                const bf16* Q1 = (const bf16*)(ws + WS_Q1); const bf16* K1 = (const bf16*)(ws + WS_K1); const bf16* V1 = (const bf16*)(ws + WS_V1);
                LAS float* btbl = (LAS float*)(lds + 65536);
                for (int un = bx; un < NBATCH * 8 * 2 * 32; un += G) {
                    const int qb = un & 31, c = (un >> 5) & 1, h = (un >> 6) & 7, b = un >> 9;
                    __syncthreads();
                    if (tid < 257) btbl[tid] = TBL[TBL_BIAS + h * BIAS_STRIDE + tid];
                    __syncthreads();
                    const size_t row0 = (size_t)b * SEQ + qb * 256, brow = (size_t)b * SEQ;
                    bf16* OC = (bf16*)(ws + (c ? WS_OC1 : WS_OC0));
                    attn_unit_v0<128, true>(Q1 + row0 * DM + h * 128 + c * 64, DM, K1 + brow * DM + h * 128 + c * 64, DM, V1 + brow * DM + h * 128, DM,
                                           OC + row0 * DM + h * 128, DM, btbl, qb * 256, lds);
                }
            }
            SEAM(10);
            if (IN(11)) {
                const bf16* OC0 = (const bf16*)(ws + WS_OC0); const bf16* OC1 = (const bf16*)(ws + WS_OC1);
                const float lam = __expf(wave_sum(args.in[13][lane] * args.in[14][lane])) - __expf(wave_sum(args.in[15][lane] * args.in[16][lane])) + LAM_INIT;
                float sg[16];
#pragma unroll
                for (int j = 0; j < 16; ++j) sg[j] = args.in[17][(lane & 7) * 16 + j] * (1.0f - LAM_INIT);
                for (int m = gw; m < NTOK; m += NGW) {
                    const GAS v4u* a = (const GAS v4u*)(OC0 + (size_t)m * DM) + lane * 2; const GAS v4u* c = (const GAS v4u*)(OC1 + (size_t)m * DM) + lane * 2;
                    float o[16]; float ss = 0.f;
#pragma unroll
                    for (int q = 0; q < 2; ++q) { const v4u av = a[q], cv = c[q];
#pragma unroll
                        for (int j = 0; j < 4; ++j) { const unsigned au = av[j], cu = cv[j];
                            const float lo = __builtin_bit_cast(float, au << 16) - lam * __builtin_bit_cast(float, cu << 16);
                            const float hh = __builtin_bit_cast(float, au & 0xffff0000u) - lam * __builtin_bit_cast(float, cu & 0xffff0000u);
                            o[q * 8 + 2 * j] = lo; o[q * 8 + 2 * j + 1] = hh; ss += lo * lo + hh * hh; } }
                    ss += __shfl_xor(ss, 1); ss += __shfl_xor(ss, 2); ss += __shfl_xor(ss, 4);
                    const float rstd = 1.0f / sqrtf(ss * (1.f / 128.f) + 1e-5f);
                    v4u w0, w1;
                    w0.x = pk2(o[0] * rstd * sg[0], o[1] * rstd * sg[1]); w0.y = pk2(o[2] * rstd * sg[2], o[3] * rstd * sg[3]); w0.z = pk2(o[4] * rstd * sg[4], o[5] * rstd * sg[5]); w0.w = pk2(o[6] * rstd * sg[6], o[7] * rstd * sg[7]);
                    w1.x = pk2(o[8] * rstd * sg[8], o[9] * rstd * sg[9]); w1.y = pk2(o[10] * rstd * sg[10], o[11] * rstd * sg[11]); w1.z = pk2(o[12] * rstd * sg[12], o[13] * rstd * sg[13]); w1.w = pk2(o[14] * rstd * sg[14], o[15] * rstd * sg[15]);
                    GAS v4u* yo = (GAS v4u*)(Y + (size_t)m * DM) + lane * 2; yo[0] = w0; yo[1] = w1;
                }
            }
            SEAM(11);
            if (IN(12)) {
                pg8::Gemm g{Y, (const bf16*)(ws + WS_WOUT1), NTOK, DM, DM}; pg8::StaticOrder S; S.init(NTOK, DM, G, bx);
                pg8::EpiRes E{xres, xres, DM};
                pg8::gemm_phase<pg8::EpiRes, pg8::StaticOrder, true>(lds, g, S, E);
            }
            SEAM(12);
    moe_block<1>(args, lds, bar, lo, hi_ph);
#undef IN
#undef SEAM
}

extern "C" void kernel_launch(void* const* d_in, const int* in_sizes, int n_in, void* d_out, int out_size, void* d_ws, size_t ws_size, hipStream_t stream) {
    static int grid = 0;
    if (grid == 0) {
        if (n_in != 27 || in_sizes[0] != NTOK * DM || out_size != NTOK * DM || ws_size < WS_END) { fprintf(stderr, "kernel_launch: unexpected shapes / workspace (n_in %d, ws %zu)\n", n_in, ws_size); grid = -1; return; }
        int dev = 0, cus = 0, per_cu = 0;
        if (hipGetDevice(&dev) != hipSuccess || hipDeviceGetAttribute(&cus, hipDeviceAttributeMultiprocessorCount, dev) != hipSuccess) { grid = -1; return; }
        if (hipFuncSetAttribute((const void*)mk_fwd, hipFuncAttributeMaxDynamicSharedMemorySize, LDS_BYTES) != hipSuccess) { fprintf(stderr, "kernel_launch: hipFuncSetAttribute failed\n"); grid = -1; return; }
        if (hipOccupancyMaxActiveBlocksPerMultiprocessor(&per_cu, (const void*)mk_fwd, NWAVES * 64, LDS_BYTES) != hipSuccess || per_cu < 1) { fprintf(stderr, "kernel_launch: occupancy query says %d\n", per_cu); }
        (void)hipGetLastError();
        grid = cus;
    }
    if (grid < 0) return;
    if (hipMemsetAsync((char*)d_ws + WS_CTL, 0, CTL_ZERO_BYTES, stream) != hipSuccess) return;
    Args a{};
    for (int i = 0; i < 27; ++i) a.in[i] = (const float*)d_in[i];
    a.out = (float*)d_out; a.ws = (unsigned char*)d_ws;
    if (MK_N_LAUNCHES == 1) { a.ph_lo = 0; a.ph_hi = NPHASE; a.li = 0; hipLaunchKernelGGL(mk_fwd, dim3(grid), dim3(NWAVES * 64), LDS_BYTES, stream, a); }
    else { for (int p = 0; p < NPHASE; ++p) { a.ph_lo = p; a.ph_hi = p + 1; a.li = p; hipLaunchKernelGGL(mk_fwd, dim3(grid), dim3(NWAVES * 64), LDS_BYTES, stream, a); } }
}
```

```cpp
#include <hip/hip_runtime.h>
#include <cstdio>
#include <cstdint>

#ifndef MK_N_LAUNCHES
#define MK_N_LAUNCHES 1
#endif

#ifndef ATTN_VER
#define ATTN_VER 1
#endif
#ifndef PROBE_MASK
#define PROBE_MASK 0u
#endif
#define REP(k) _Pragma("unroll") for (int rep_ = 0; rep_ < (MK_N_LAUNCHES == 1 ? (int)((PROBE_MASK >> (k)) & 1u) : 0) + 1; ++rep_)
#define GAS __attribute__((address_space(1)))
#define LAS __attribute__((address_space(3)))
typedef unsigned short bf16;
typedef unsigned v4u __attribute__((ext_vector_type(4)));
typedef unsigned v2u __attribute__((ext_vector_type(2)));
typedef float f32x4 __attribute__((ext_vector_type(4)));
typedef float f32x16 __attribute__((ext_vector_type(16)));
typedef short bf16x8 __attribute__((ext_vector_type(8)));
typedef short s16x4 __attribute__((ext_vector_type(4)));

constexpr int NTOK = 32768, DM = 1024, SEQ = 8192, NBATCH = 4;
constexpr int EV_IN = 1792, OD_IN = 3072;
constexpr int NEXP = 32, MOE_H = 512, LIST_CAP = 32768;
constexpr float C2 = 0.125f * 1.4426950408889634f;
constexpr float LOG2E = 1.4426950408889634f;
constexpr float LAM_INIT = 0.35550906759f;

constexpr size_t MiB = 1u << 20;
constexpr size_t WS_CTL = 0, CTL_ZERO_BYTES = 1 * MiB;
constexpr size_t WS_WIN0 = 1 * MiB, WS_WOUT0 = 5 * MiB, WS_WIN1 = 7 * MiB, WS_WOUT1 = 13 * MiB, WS_TBL = 15 * MiB;
constexpr size_t WS_W13 = 16 * MiB, WS_W2 = 80 * MiB;
constexpr size_t WS_HB = 112 * MiB;
constexpr size_t WS_Y = 176 * MiB;
constexpr size_t WS_Z0 = 240 * MiB, WS_QR = 352 * MiB, WS_KR = 384 * MiB;
constexpr size_t WS_Q1 = 240 * MiB, WS_K1 = 304 * MiB, WS_V1 = 368 * MiB, WS_OC1 = 432 * MiB, WS_OC0 = WS_HB;
constexpr size_t WS_H = 176 * MiB, WS_YS = 248 * MiB, WS_LIST = 392 * MiB, WS_TOKEP = 396 * MiB, WS_GATE = 396 * MiB + 512 * 1024;
constexpr size_t WS_END = 496 * MiB;
constexpr int TBL_COS = 0, TBL_SIN = 2048, TBL_BIAS = 4096, BIAS_STRIDE = 272;
constexpr int TBL_WR = 32768, WR_LAYER = 1024 * 48 + 64;
constexpr int CW_BAR = 4096;
constexpr int CW_CNT = 16384;

constexpr int RING_BYTES = 131072;
constexpr int LDSCTL_OFF = RING_BYTES;
constexpr int LDS_BYTES = 147456;
constexpr int LC_BAR = 8;
constexpr int LC_TP = 16;
constexpr int LC_CNT = 64;
constexpr int LC_LCNT = 96;
constexpr int LC_LBASE = 128;

#define LDS_WAIT() asm volatile("s_waitcnt lgkmcnt(0)" ::: "memory")
#define VM_WAIT() asm volatile("s_waitcnt vmcnt(0)" ::: "memory")
#define RLX_AGENT __ATOMIC_RELAXED, __HIP_MEMORY_SCOPE_AGENT

__device__ __forceinline__ unsigned f2bf(float f) { unsigned u = __builtin_bit_cast(unsigned, f); return (u + 0x7fffu + ((u >> 16) & 1u)) >> 16; }
__device__ __forceinline__ unsigned pk2(float lo, float hi) { return f2bf(lo) | (f2bf(hi) << 16); }
__device__ __forceinline__ float bf2f(unsigned short b) { return __builtin_bit_cast(float, (unsigned)b << 16); }
__device__ __forceinline__ float wave_sum(float v) {
#pragma unroll
    for (int o = 1; o < 64; o <<= 1) v += __shfl_xor(v, o);
    return v;
}

namespace pg8 {
#define PG8_LAS __attribute__((address_space(3)))
typedef unsigned short bf16_t;
typedef short bf16x8 __attribute__((ext_vector_type(8)));
typedef float f32x4 __attribute__((ext_vector_type(4)));
typedef unsigned u32x4 __attribute__((ext_vector_type(4)));
constexpr int BM = 256, BK = 64, HALF = 128, HTB = HALF * BK * 2, STAGE_BYTES = 8 * HTB, NXCD = 8, WGM = 8;

__host__ __device__ __forceinline__ int lds_byte(int r, int c) { const int st = (r >> 4) * 2 + (c >> 5), rr = r & 15, cc = c & 31, ob = rr * 64 + cc * 2; return st * 1024 + (ob ^ (((ob >> 9) & 1) << 5)); }
__host__ __device__ __forceinline__ void stage_rc(int b, int& R, int& C) { const int st = b / 1024, sb = b % 1024, swz = sb ^ (((sb >> 9) & 1) << 5); R = (st >> 1) * 16 + swz / 64; C = (st & 1) * 32 + (swz % 64) / 2; }
__host__ __device__ __forceinline__ int perm32(int rho) { const int n = rho >> 4, i = rho & 15; return 8 * (i >> 2) + 4 * n + (i & 3); }

struct Unit { int pm, pn, e, rb; };
struct Gemm { const bf16_t* A; const bf16_t* Bt; int M, N, K; };

struct StaticOrder {
    int nM, nN, nwg, G, c;
    __device__ void init(int M, int N, int G_, int c_) { nM = M / BM; nN = N / BM; nwg = nM * nN; G = G_; c = c_; }
    __device__ bool next(int i, Unit& u) const {
        const long L = (long)i * G + c; if (L >= nwg) return false;
        int wgid = (int)L; { const int q = nwg / NXCD, r = nwg % NXCD, xcd = wgid % NXCD, off = wgid / NXCD; wgid = (xcd < r ? xcd * (q + 1) : r * (q + 1) + (xcd - r) * q) + off; }
        const int nig = WGM * nN, gid = wgid / nig, fm = gid * WGM, gsz = (nM - fm) < WGM ? (nM - fm) : WGM;
        u.pm = fm + ((wgid % nig) % gsz); u.pn = (wgid % nig) / gsz; u.e = 0; u.rb = 0; return true;
    }
    __device__ __forceinline__ unsigned arow(const Unit& u, int rr) const { return (unsigned)(u.pm * BM + rr); }
};

struct MoeOrder {
    const PG8_LAS int* tp; const PG8_LAS int* cn; const int* list; int G, c, nunits; bool gather;
    __device__ __forceinline__ bool next(int i, Unit& u) const {
        const int L = i * G + c; if (L >= nunits) return false;
        const int rbg = L >> 2, pnl = L & 3; int e = 0;
#pragma unroll
        for (int j = 1; j < 32; ++j) e += (tp[j] <= rbg) ? 1 : 0;
        u.pm = rbg; u.pn = e * 4 + pnl; u.e = e; u.rb = rbg - tp[e]; return true;
    }
    __device__ __forceinline__ unsigned arow(const Unit& u, int rr) const {
        if (!gather) return (unsigned)(u.pm * BM + rr);
        const int idx = u.rb * BM + rr; unsigned t = 0u;
        if (idx < cn[u.e]) t = (unsigned)list[(size_t)u.e * 32768 + idx];
        return t;
    }
};

__device__ __forceinline__ unsigned cvt_pk_bf16(float lo, float hi) { unsigned r; asm volatile("v_cvt_pk_bf16_f32 %0, %1, %2" : "=v"(r) : "v"(lo), "v"(hi)); return r; }

struct EpiBf16 {
    static constexpr bool PERM = true;
    bf16_t* O; int ldc; int split_cols; size_t split_stride; float scale0; int pn_mask;
    __device__ __forceinline__ void operator()(const f32x4 (&acc)[2][2][4][2], const Unit& u, int wr, int wc, int fr, int fq) const {
        const int row0 = u.pm * BM + wr * 64 + fr; int colt = (u.pn & pn_mask) * BM; bf16_t* base = O;
        float sc = 1.f; if (split_cols) { const int t = colt / split_cols; base += (size_t)t * split_stride; colt -= t * split_cols; if (t == 0) sc = scale0; }
        const int col0 = colt + wc * 32 + 8 * fq;
#pragma unroll
        for (int ai = 0; ai < 2; ++ai)
#pragma unroll
            for (int m = 0; m < 4; ++m) { bf16_t* rowp = base + (size_t)(row0 + ai * HALF + m * 16) * ldc + col0;
#pragma unroll
                for (int bj = 0; bj < 2; ++bj) { f32x4 v0 = acc[ai][bj][m][0] * sc, v1 = acc[ai][bj][m][1] * sc;
                    u32x4 w; w.x = cvt_pk_bf16(v0[0], v0[1]); w.y = cvt_pk_bf16(v0[2], v0[3]); w.z = cvt_pk_bf16(v1[0], v1[1]); w.w = cvt_pk_bf16(v1[2], v1[3]);
                    *(u32x4*)(rowp + bj * HALF) = w; } }
    }
};
struct EpiRes {
    static constexpr bool PERM = false;
    const float* base; float* out; int ldc;
    __device__ __forceinline__ void operator()(const f32x4 (&acc)[2][2][4][2], const Unit& u, int wr, int wc, int fr, int fq) const {
        const int row0 = u.pm * BM + wr * 64 + fr, col0 = u.pn * BM + wc * 32 + 4 * fq;
#pragma unroll
        for (int ai = 0; ai < 2; ++ai)
#pragma unroll
            for (int m = 0; m < 4; ++m) { const size_t off = (size_t)(row0 + ai * HALF + m * 16) * ldc + col0;
#pragma unroll
                for (int bj = 0; bj < 2; ++bj)
#pragma unroll
                    for (int n = 0; n < 2; ++n) { const f32x4 bs = *(const f32x4*)(base + off + bj * HALF + n * 16); *(f32x4*)(out + off + bj * HALF + n * 16) = bs + acc[ai][bj][m][n]; } }
    }
};
__device__ __forceinline__ float silu_mul(float a, float b) { return a * b * __builtin_amdgcn_rcpf(1.0f + __builtin_amdgcn_exp2f(-a * 1.4426950408889634f)); }
struct EpiSwiglu {
    static constexpr bool PERM = true;
    bf16_t* O;
    __device__ __forceinline__ void operator()(const f32x4 (&acc)[2][2][4][2], const Unit& u, int wr, int wc, int fr, int fq) const {
        const int row0 = u.pm * BM + wr * 64 + fr, col0 = (u.pn & 3) * 128 + wc * 32 + 8 * fq;
#pragma unroll
        for (int ai = 0; ai < 2; ++ai)
#pragma unroll
            for (int m = 0; m < 4; ++m) { bf16_t* rowp = O + (size_t)(row0 + ai * HALF + m * 16) * 512 + col0;
                const f32x4 a0 = acc[ai][0][m][0], a1 = acc[ai][0][m][1], b0 = acc[ai][1][m][0], b1 = acc[ai][1][m][1];
                u32x4 w; w.x = cvt_pk_bf16(silu_mul(a0[0], b0[0]), silu_mul(a0[1], b0[1])); w.y = cvt_pk_bf16(silu_mul(a0[2], b0[2]), silu_mul(a0[3], b0[3]));
                w.z = cvt_pk_bf16(silu_mul(a1[0], b1[0]), silu_mul(a1[1], b1[1])); w.w = cvt_pk_bf16(silu_mul(a1[2], b1[2]), silu_mul(a1[3], b1[3]));
                *(u32x4*)rowp = w; }
    }
};

template <class Epi, class Sched, bool ALIGN_EPI>
__device__ __forceinline__ void gemm_phase(PG8_LAS unsigned char* lds, const Gemm g, const Sched& S, const Epi& E) {
    const int tid = threadIdx.x, wid = __builtin_amdgcn_readfirstlane(tid >> 6), lane = tid & 63, wr = wid >> 2, wc = wid & 3, fr = lane & 15, fq = lane >> 4;
    const int K = g.K, nt = K / BK;
    int RA[2], CA[2]; unsigned voffB[2];
#pragma unroll
    for (int i = 0; i < 2; ++i) { int R, C; stage_rc(tid * 16 + i * 8192, R, C); RA[i] = R; CA[i] = C; const int Rb = Epi::PERM ? ((R & ~31) + perm32(R & 31)) : R; voffB[i] = (unsigned)(Rb * K + C) * 2u; }
    const size_t kstep = (size_t)(BK * 2);
    const size_t hstep = (size_t)HALF * K * 2;
    const size_t tstep = 2 * hstep;
    const unsigned ldsw = (unsigned)wid * 1024u;
    const int aoff = lds_byte(wr * 64 + fr, fq * 8), boff = lds_byte(wc * 32 + fr, fq * 8);
#define PG8_SA(b, h) (((b) * 2 + (h)) * HTB)
#define PG8_SB(b, h) ((4 + (b) * 2 + (h)) * HTB)
#define PG8_STAGE(bufoff, gbase, voff) do { _Pragma("unroll") for (int _i = 0; _i < 2; ++_i) \
        __builtin_amdgcn_global_load_lds((const unsigned*)((const char*)(gbase) + (voff)[_i]), (PG8_LAS unsigned*)(lds + (bufoff) + ldsw + _i * 8192), 16, 0, 0); } while (0)
#define PG8_LDA(dst, b, h) do { _Pragma("unroll") for (int m = 0; m < 4; ++m) _Pragma("unroll") for (int k = 0; k < 2; ++k) dst[m][k] = *(const PG8_LAS bf16x8*)(lds + PG8_SA(b, h) + aoff + m * 2048 + k * 1024); } while (0)
#define PG8_LDB(dst, b, h) do { _Pragma("unroll") for (int n = 0; n < 2; ++n) _Pragma("unroll") for (int k = 0; k < 2; ++k) dst[n][k] = *(const PG8_LAS bf16x8*)(lds + PG8_SB(b, h) + boff + n * 2048 + k * 1024); } while (0)
#define PG8_MMA(ai, bj, At, Bt) do { __builtin_amdgcn_s_setprio(1); _Pragma("unroll") for (int m = 0; m < 4; ++m) _Pragma("unroll") for (int n = 0; n < 2; ++n) _Pragma("unroll") for (int k = 0; k < 2; ++k) \
        acc[ai][bj][m][n] = __builtin_amdgcn_mfma_f32_16x16x32_bf16(Bt[n][k], At[m][k], acc[ai][bj][m][n], 0, 0, 0); __builtin_amdgcn_s_setprio(0); } while (0)
#define PG8_WAIT_V(n) asm volatile("s_waitcnt vmcnt(" #n ")" ::: "memory")
#define PG8_WAIT_L(n) asm volatile("s_waitcnt lgkmcnt(" #n ")" ::: "memory")
#define PG8_BAR __builtin_amdgcn_s_barrier()
#define PG8_SCHED __builtin_amdgcn_sched_barrier(0)
#define PG8_AOFF(dst, u) do { _Pragma("unroll") for (int _h = 0; _h < 2; ++_h) _Pragma("unroll") for (int _i = 0; _i < 2; ++_i) dst[_h][_i] = (S.arow(u, _h * HALF + RA[_i]) * (unsigned)K + (unsigned)CA[_i]) * 2u; } while (0)
    Unit cur, nxt; int ui = 0;
    if (!S.next(0, cur)) return;
    f32x4 acc[2][2][4][2];
#pragma unroll
    for (int a = 0; a < 2; ++a)
#pragma unroll
        for (int b = 0; b < 2; ++b)
#pragma unroll
            for (int m = 0; m < 4; ++m)
#pragma unroll
                for (int n = 0; n < 2; ++n) acc[a][b][m][n] = (f32x4){0.f, 0.f, 0.f, 0.f};
    bf16x8 At[4][2], B0[2][2], B1[2][2];
    unsigned offc[2][2], offn[2][2];
    PG8_AOFF(offc, cur);
    const char* const cA = (const char*)g.A; const char* cB = (const char*)g.Bt + (size_t)cur.pn * tstep;
    PG8_STAGE(PG8_SB(0, 0), cB, voffB); PG8_STAGE(PG8_SB(0, 1), cB + hstep, voffB); PG8_STAGE(PG8_SA(0, 0), cA, offc[0]); PG8_STAGE(PG8_SA(0, 1), cA, offc[1]);
    if (wr == 1) PG8_BAR;
    PG8_WAIT_V(2); PG8_BAR;
    PG8_STAGE(PG8_SB(1, 0), cB + kstep, voffB); PG8_STAGE(PG8_SA(1, 0), cA + kstep, offc[0]); PG8_STAGE(PG8_SB(1, 1), cB + hstep + kstep, voffB);
    PG8_WAIT_V(6); PG8_BAR;
    for (;;) {
        const bool has_next = S.next(ui + 1, nxt);
        if (has_next) { PG8_AOFF(offn, nxt); }
        else {
#pragma unroll
            for (int h = 0; h < 2; ++h)
#pragma unroll
                for (int i = 0; i < 2; ++i) offn[h][i] = offc[h][i]; }
        const char* nB = has_next ? (const char*)g.Bt + (size_t)nxt.pn * tstep : cB;
        for (int t = 0; t < nt; t += 2) {
            const bool last = (t == nt - 2);
            const char* a1 = cA + (size_t)(t + 1) * kstep;
            const char* a2 = last ? cA : cA + (size_t)(t + 2) * kstep; const char* b2 = last ? nB : cB + (size_t)(t + 2) * kstep;
            const char* a3 = a2 + kstep; const char* b3 = b2 + kstep;
            unsigned o2[2][2];
#pragma unroll
            for (int h = 0; h < 2; ++h)
#pragma unroll
                for (int i = 0; i < 2; ++i) o2[h][i] = last ? offn[h][i] : offc[h][i];
            PG8_LDB(B0, 0, 0); PG8_LDB(B1, 0, 1); PG8_SCHED; PG8_LDA(At, 0, 0); PG8_STAGE(PG8_SA(1, 1), a1, offc[1]);
            PG8_WAIT_V(8); PG8_WAIT_L(0); PG8_BAR; PG8_MMA(0, 0, At, B0); PG8_MMA(0, 1, At, B1); PG8_BAR; PG8_SCHED;
            PG8_LDA(At, 0, 1); PG8_STAGE(PG8_SB(0, 0), b2, voffB); PG8_STAGE(PG8_SB(0, 1), b2 + hstep, voffB); PG8_STAGE(PG8_SA(0, 0), a2, o2[0]);
            PG8_WAIT_V(8); PG8_WAIT_L(0); PG8_BAR; PG8_MMA(1, 0, At, B0); PG8_MMA(1, 1, At, B1); PG8_BAR; PG8_SCHED;
            PG8_LDB(B0, 1, 0); PG8_LDB(B1, 1, 1); PG8_SCHED; PG8_LDA(At, 1, 0); PG8_STAGE(PG8_SA(0, 1), a2, o2[1]);
            PG8_WAIT_V(8); PG8_WAIT_L(0); PG8_BAR; PG8_MMA(0, 0, At, B0); PG8_MMA(0, 1, At, B1); PG8_BAR; PG8_SCHED;
            PG8_LDA(At, 1, 1); PG8_STAGE(PG8_SB(1, 0), b3, voffB); PG8_STAGE(PG8_SB(1, 1), b3 + hstep, voffB); PG8_STAGE(PG8_SA(1, 0), a3, o2[0]);
            PG8_WAIT_V(8); PG8_WAIT_L(0); PG8_BAR; PG8_MMA(1, 0, At, B0); PG8_MMA(1, 1, At, B1); PG8_BAR; PG8_SCHED;
        }
        if constexpr (ALIGN_EPI) { if (wr == 0) PG8_BAR; }
        E(acc, cur, wr, wc, fr, fq);
        if (!has_next) break;
#pragma unroll
        for (int a = 0; a < 2; ++a)
#pragma unroll
            for (int b = 0; b < 2; ++b)
#pragma unroll
                for (int m = 0; m < 4; ++m)
#pragma unroll
                    for (int n = 0; n < 2; ++n) acc[a][b][m][n] = (f32x4){0.f, 0.f, 0.f, 0.f};
        cur = nxt; cB = nB; ++ui;
#pragma unroll
        for (int h = 0; h < 2; ++h)
#pragma unroll
            for (int i = 0; i < 2; ++i) offc[h][i] = offn[h][i];
        if constexpr (ALIGN_EPI) { if (wr == 1) PG8_BAR; }
    }
    PG8_WAIT_V(0);
    if constexpr (!ALIGN_EPI) { if (wr == 0) PG8_BAR; }
    PG8_BAR;
#undef PG8_SA
#undef PG8_SB
#undef PG8_STAGE
#undef PG8_LDA
#undef PG8_LDB
#undef PG8_MMA
#undef PG8_WAIT_V
#undef PG8_WAIT_L
#undef PG8_BAR
#undef PG8_SCHED
#undef PG8_AOFF
}
}

#define XB_TMO      128
#define XB_XCNT(j)  (256  + 64 * (j))
#define XB_XSUB(j)  (1280 + 64 * (j))
#define XB_XGEN(j)  (2304 + 64 * (j))
#define XB_TOP      3328
#define XB_TOPGEN   3392
#define XCD_BAR_WORDS 3456
#define XB_SPIN_CAP (1u << 18)

__device__ __forceinline__ unsigned xb_ld(unsigned* p)              { return __hip_atomic_load(p, __ATOMIC_RELAXED, __HIP_MEMORY_SCOPE_AGENT); }
__device__ __forceinline__ unsigned xb_add(unsigned* p, unsigned v) { return __hip_atomic_fetch_add(p, v, __ATOMIC_RELAXED, __HIP_MEMORY_SCOPE_AGENT); }
__device__ __forceinline__ unsigned xb_xcc_id() { return (unsigned)__builtin_amdgcn_s_getreg((3 << 11) | 20) & 0xFu; }
#define XB_SPIN(cond, bar) do { unsigned _sp = 0; while (cond) { __builtin_amdgcn_s_sleep(1); \
    if ((++_sp & 255u) == 0u) { if (xb_ld(&(bar)[XB_TMO])) break; if (_sp > XB_SPIN_CAP) { atomicAdd(&(bar)[XB_TMO], 1u); break; } } } } while (0)

struct XcdBarrier { unsigned* bar; unsigned x; volatile LAS unsigned* st; };

__device__ __forceinline__ XcdBarrier xcd_barrier_post(unsigned* bar, volatile LAS unsigned* st) {
    XcdBarrier b; b.bar = bar; b.x = xb_xcc_id(); b.st = st;
    if (threadIdx.x == 0) (void)xb_add(&bar[XB_XCNT(b.x)], 1u);
    return b;
}
__device__ __forceinline__ void xcd_barrier_complete(unsigned* bar, unsigned x, unsigned& nloc, unsigned& nx) {
    const unsigned G = gridDim.x * gridDim.y * gridDim.z;
    unsigned sum, cnt, mine, sp = 0u;
    for (;;) {
        sum = 0u; cnt = 0u; mine = 0u;
#pragma unroll
        for (unsigned j = 0; j < 16; ++j) { const unsigned c = xb_ld(&bar[XB_XCNT(j)]); sum += c; cnt += (c > 0u) ? 1u : 0u; mine = (j == x) ? c : mine; }
        if (sum == G) break;
        __builtin_amdgcn_s_sleep(1);
        if ((++sp & 255u) == 0u) { if (xb_ld(&bar[XB_TMO])) break; if (sp > XB_SPIN_CAP) { atomicAdd(&bar[XB_TMO], 1u); break; } }
    }
    nloc = mine > 0u ? mine : 1u; nx = cnt > 0u ? cnt : 1u;
}
__device__ __forceinline__ void xcd_barrier(const XcdBarrier& b) {
    asm volatile("s_waitcnt vmcnt(0)" ::: "memory");
    __syncthreads();
    if (threadIdx.x == 0) {
        unsigned* bar = b.bar;
        __builtin_amdgcn_s_waitcnt(0);
        unsigned nloc = b.st[0], nx = b.st[1];
        if (nloc == 0u) { xcd_barrier_complete(bar, b.x, nloc, nx); b.st[0] = nloc; b.st[1] = nx; }
        const unsigned old = xb_add(&bar[XB_XSUB(b.x)], 1u);
        const unsigned gen = old / nloc;
        if (old + 1u == (gen + 1u) * nloc) {
            __builtin_amdgcn_fence(__ATOMIC_RELEASE, "agent");
            asm volatile("s_waitcnt vmcnt(0)" ::: "memory");
            const unsigned og = xb_add(&bar[XB_TOP], 1u);
            const unsigned tg = og / nx;
            if (og + 1u == (tg + 1u) * nx) xb_add(&bar[XB_TOPGEN], 1u);
            else XB_SPIN(xb_ld(&bar[XB_TOPGEN]) == tg, bar);
            __builtin_amdgcn_fence(__ATOMIC_ACQUIRE, "agent");
            xb_add(&bar[XB_XGEN(b.x)], 1u);
            asm volatile("s_waitcnt vmcnt(0)" ::: "memory");
        } else {
            XB_SPIN(xb_ld(&bar[XB_XGEN(b.x)]) == gen, bar);
            __builtin_amdgcn_fence(__ATOMIC_ACQUIRE, "agent");
            asm volatile("s_waitcnt vmcnt(0)" ::: "memory");
        }
    }
    __syncthreads();
}

__device__ __forceinline__ void transpose_item(const float* W, int K, int N, bf16* WT, int kb, int nb, int dst_row0, LAS float* scr, int lane) {
    const int k0 = 64 * kb, n0 = 32 * nb;
#pragma unroll 8
    for (int i = 0; i < 32; ++i) { const int kk = 2 * i + (lane >> 5); scr[kk * 33 + (lane & 31)] = W[(size_t)(k0 + kk) * N + n0 + (lane & 31)]; }
    LDS_WAIT(); asm volatile("" ::: "memory");
    const int c = lane & 7;
#pragma unroll
    for (int j = 0; j < 4; ++j) { const int n = (lane >> 3) + 8 * j; const LAS float* s = scr + (8 * c) * 33 + n;
        v4u o; o.x = pk2(s[0 * 33], s[1 * 33]); o.y = pk2(s[2 * 33], s[3 * 33]); o.z = pk2(s[4 * 33], s[5 * 33]); o.w = pk2(s[6 * 33], s[7 * 33]);
        *(GAS v4u*)(WT + (size_t)(dst_row0 + n) * K + k0 + 8 * c) = o; }
    LDS_WAIT(); asm volatile("" ::: "memory");
}
__device__ __forceinline__ void transpose_plain(const float* W, int K, int N, bf16* WT, LAS float* scr, int gw, int ngw, int lane) {
    const int nblk = N / 32, nitems = (K / 64) * nblk;
    for (int it = gw; it < nitems; it += ngw) { const int kb = it / nblk, nb = it % nblk; transpose_item(W, K, N, WT, kb, nb, 32 * nb, scr, lane); }
}
__device__ __forceinline__ void transpose_moe(const float* w1, const float* w3, const float* w2, bf16* W13T, bf16* W2T, LAS float* scr, int gw, int ngw, int lane) {
    constexpr int I13 = 16 * 16, I2 = 8 * 32, IPE = 2 * I13 + I2;
    for (int it = gw; it < NEXP * IPE; it += ngw) {
        const int e = it / IPE; int r = it % IPE;
        if (r < 2 * I13) { const int which = r / I13; r %= I13; const int kb = r / 16, nb = r % 16, n0 = 32 * nb;
            const float* W = (which ? w3 : w1) + (size_t)e * 1024 * 512;
            transpose_item(W, 1024, 512, W13T + (size_t)e * 1024 * 1024, kb, nb, (n0 >> 7) * 256 + which * 128 + (n0 & 127), scr, lane);
        } else { r -= 2 * I13; const int kb = r / 32, nb = r % 32;
            transpose_item(w2 + (size_t)e * 512 * 1024, 512, 1024, W2T + (size_t)e * 1024 * 512, kb, nb, 32 * nb, scr, lane); }
    }
}
__device__ __forceinline__ void rms_row(const float* xrow, const float* g, f32x4 (&v)[4], int lane) {
    const GAS f32x4* xr = (const GAS f32x4*)xrow + lane; const GAS f32x4* gr = (const GAS f32x4*)g + lane;
    float s = 0.f;
#pragma unroll
    for (int j = 0; j < 4; ++j) { v[j] = xr[64 * j]; s += (v[j].x * v[j].x + v[j].y * v[j].y) + (v[j].z * v[j].z + v[j].w * v[j].w); }
    const float rstd = 1.0f / sqrtf(wave_sum(s) * (1.f / DM) + 1e-6f);
#pragma unroll
    for (int j = 0; j < 4; ++j) { const f32x4 gg = gr[64 * j]; v[j] = v[j] * rstd * gg; }
}
__device__ __forceinline__ void store_row_bf16(bf16* orow, const f32x4 (&v)[4], int lane) {
    GAS unsigned long long* o8 = (GAS unsigned long long*)orow + lane;
#pragma unroll
    for (int j = 0; j < 4; ++j) o8[64 * j] = (unsigned long long)pk2(v[j].x, v[j].y) | ((unsigned long long)pk2(v[j].z, v[j].w) << 32);
}

__device__ __forceinline__ int t5_bucket(int rel) {
    const int n = rel < 0 ? -rel : rel; int ret = rel > 0 ? 16 : 0;
    int v;
    if (n < 8) v = n;
    else { const float nf = (float)n; int large = 8 + (int)(logf(nf / 8.0f) / 2.772588722239781f * 8.0f); v = large < 15 ? large : 15; }
    return ret + v;
}

__device__ __forceinline__ int crow(int r, int hi) { return (r & 3) + 8 * (r >> 2) + 4 * hi; }
__device__ __forceinline__ unsigned cvtpk(float lo, float hi) { unsigned r; asm volatile("v_cvt_pk_bf16_f32 %0, %1, %2" : "=v"(r) : "v"(lo), "v"(hi)); return r; }
__device__ __forceinline__ s16x4 vtr(const LAS char* p) { typedef short v4i16_t __attribute__((ext_vector_type(4))); return __builtin_bit_cast(s16x4, __builtin_amdgcn_ds_read_tr16_b64_v4i16((LAS v4i16_t*)p)); }

template <int DV, bool BIAS>
__device__ __forceinline__ void attn_unit_v0(const bf16* Qp, int ldq, const bf16* Kp, int ldk, const bf16* Vp, int ldv, bf16* Op, int ldo, const LAS float* btbl, int q0, LAS unsigned char* lds) {
    const int tid = threadIdx.x, lane = tid & 63, r32 = lane & 31, hi = lane >> 5; const int wid = __builtin_amdgcn_readfirstlane(tid >> 6);
    constexpr int ND = DV / 32;
    LAS unsigned char* ldsK = lds; LAS unsigned char* ldsV = lds + 8192; LAS float* wsf = (LAS float*)(lds + 8192 + DV * 128) + wid * 64;
    bf16x8 qr[4];
#pragma unroll
    for (int d0 = 0; d0 < 4; ++d0) qr[d0] = *(const bf16x8*)(Qp + (size_t)(wid * 32 + r32) * ldq + d0 * 16 + hi * 8);
    f32x16 o[ND];
#pragma unroll
    for (int d = 0; d < ND; ++d)
#pragma unroll
        for (int r = 0; r < 16; ++r) o[d][r] = 0.f;
    float l = 0.f;
    const int qpos = q0 + wid * 32 + r32;
    const LAS char* kp0 = (const LAS char*)ldsK + hi * 1024 + r32 * 16;
    const LAS char* vp0 = (const LAS char*)ldsV + ((lane >> 4) & 1) * 32 + (lane & 3) * 8 + (4 * hi + ((lane & 15) >> 2)) * 64;
    for (int t = 0; t < SEQ / 64; ++t) {
        __syncthreads();
        {
            const v4u kv = *(const v4u*)(Kp + (size_t)(t * 64 + lane) * ldk + wid * 8);
            *(LAS v4u*)(ldsK + wid * 1024 + lane * 16) = kv;
#pragma unroll
            for (int pp = 0; pp < ND / 2; ++pp) { const int p = wid + 8 * pp, dq = p >> 2, rg = p & 3;
                const v4u vv = *(const v4u*)(Vp + (size_t)(t * 64 + 16 * rg + (lane >> 2)) * ldv + dq * 32 + (lane & 3) * 8);
                *(LAS v4u*)(ldsV + p * 1024 + lane * 16) = vv; }
        }
        __syncthreads();
        f32x16 p0, p1;
#pragma unroll
        for (int r = 0; r < 16; ++r) { p0[r] = 0.f; p1[r] = 0.f; }
#pragma unroll
        for (int d0 = 0; d0 < 4; ++d0) {
            const bf16x8 b0 = *(const LAS bf16x8*)(kp0 + d0 * 2048), b1 = *(const LAS bf16x8*)(kp0 + d0 * 2048 + 512);
            p0 = __builtin_amdgcn_mfma_f32_32x32x16_bf16(b0, qr[d0], p0, 0, 0, 0);
            p1 = __builtin_amdgcn_mfma_f32_32x32x16_bf16(b1, qr[d0], p1, 0, 0, 0);
        }
        if (BIAS) {
            const int base = t * 64 + 4 * hi - qpos;
#pragma unroll
            for (int r = 0; r < 16; ++r) { int rel = base + (r & 3) + 8 * (r >> 2);
                int i0 = rel < -128 ? -128 : (rel > 128 ? 128 : rel); int rel1 = rel + 32; int i1 = rel1 < -128 ? -128 : (rel1 > 128 ? 128 : rel1);
                p0[r] += btbl[i0 + 128]; p1[r] += btbl[i1 + 128]; }
        }
        float sacc = 0.f;
#pragma unroll
        for (int r = 0; r < 16; ++r) { p0[r] = __builtin_amdgcn_exp2f(p0[r]); p1[r] = __builtin_amdgcn_exp2f(p1[r]); sacc += p0[r] + p1[r]; }
        l += sacc;
        v4u pw[4];
#pragma unroll
        for (int k = 0; k < 2; ++k) {
            pw[k]     = (v4u){cvtpk(p0[8 * k + 0], p0[8 * k + 1]), cvtpk(p0[8 * k + 2], p0[8 * k + 3]), cvtpk(p0[8 * k + 4], p0[8 * k + 5]), cvtpk(p0[8 * k + 6], p0[8 * k + 7])};
            pw[2 + k] = (v4u){cvtpk(p1[8 * k + 0], p1[8 * k + 1]), cvtpk(p1[8 * k + 2], p1[8 * k + 3]), cvtpk(p1[8 * k + 4], p1[8 * k + 5]), cvtpk(p1[8 * k + 6], p1[8 * k + 7])};
        }
#pragma unroll
        for (int d0 = 0; d0 < ND; ++d0)
#pragma unroll
            for (int ks = 0; ks < 4; ++ks) {
                const s16x4 lo = vtr(vp0 + d0 * 4096 + ks * 1024), hh = vtr(vp0 + d0 * 4096 + ks * 1024 + 512);
                const bf16x8 vf = (bf16x8){lo[0], lo[1], lo[2], lo[3], hh[0], hh[1], hh[2], hh[3]};
                o[d0] = __builtin_amdgcn_mfma_f32_32x32x16_bf16(__builtin_bit_cast(bf16x8, pw[ks]), vf, o[d0], 0, 0, 0);
            }
    }
    l += __shfl_xor(l, 32);
    if (hi == 0) wsf[r32] = l;
    LDS_WAIT(); asm volatile("" ::: "memory");
#pragma unroll
    for (int r = 0; r < 16; ++r) { const int row = crow(r, hi); const float rl = 1.0f / wsf[row];
#pragma unroll
        for (int d0 = 0; d0 < ND; ++d0) Op[(size_t)(wid * 32 + row) * ldo + d0 * 32 + r32] = (bf16)f2bf(o[d0][r] * rl); }
    LDS_WAIT();
}

namespace at1 {
#define SBAR() __builtin_amdgcn_sched_barrier(0)
#define PIN(x) asm volatile("" : "+v"(x))
template <int N> __device__ __forceinline__ void wait_bar() { asm volatile("s_waitcnt vmcnt(%0) lgkmcnt(0)\n\ts_barrier" :: "n"(N) : "memory"); }
__device__ __forceinline__ void glds16(const void* gsrc, unsigned lds_dst) { unsigned keep;
    asm volatile("s_mov_b32 %0, m0\n\ts_mov_b32 m0, %2\n\ts_nop 0\n\tglobal_load_lds_dwordx4 %1, off\n\ts_mov_b32 m0, %0" : "=&s"(keep) : "v"(gsrc), "s"(lds_dst) : "memory"); }
typedef float f32x2_t __attribute__((ext_vector_type(2))); typedef __bf16 bf16x2_t __attribute__((ext_vector_type(2)));
__device__ __forceinline__ unsigned cvtpk_s(float lo, float hi) { f32x2_t v = {lo, hi}; bf16x2_t b = __builtin_convertvector(v, bf16x2_t); return __builtin_bit_cast(unsigned, b); }
typedef const LAS char* lds_cptr;
__device__ __forceinline__ void kload2(bf16x8* kf, lds_cptr kp, int j) { kf[2 * j] = *(const LAS bf16x8*)(kp + j * 2048); kf[2 * j + 1] = *(const LAS bf16x8*)(kp + j * 2048 + 512); }

template <int DV, bool BIAS>
__device__ __forceinline__ void attn_unit(const bf16* Qp, int ldq, const bf16* __restrict__ Kp, int ldk, const bf16* __restrict__ Vp, int ldv, bf16* Op, int ldo, int q0, LAS unsigned char* lds) {
    constexpr int ND = DV / 32, NV = ND / 2, VSLOT = DV * 128, KSLOT = 8192, NT = SEQ / 64;
    constexpr int LDS_K = 0, LDS_V = 3 * KSLOT, LDS_WS = LDS_V + 3 * VSLOT, LDS_TBL = LDS_WS + 2048;
    const int tid = threadIdx.x, lane = tid & 63, r32 = lane & 31, hi = lane >> 5; const int wid = __builtin_amdgcn_readfirstlane(tid >> 6);
    const unsigned lds0 = (unsigned)(uintptr_t)lds;
    LAS float* wsf = (LAS float*)(lds + LDS_WS) + wid * 64;
    const LAS float* btbl = (const LAS float*)(lds + LDS_TBL);
    const bf16* ksrc = Kp + (size_t)lane * ldk + wid * 8;
    const bf16* vsrc0 = Vp + (size_t)(16 * (wid & 3) + (lane >> 2)) * ldv + (wid >> 2) * 32 + (lane & 3) * 8;
    const bf16* vsrc1 = vsrc0 + 64;
    const unsigned kdst = lds0 + LDS_K + wid * 1024, vdst = lds0 + LDS_V + wid * 1024;
#define DMA_K(t, s) glds16(ksrc + (size_t)(t) * 64 * ldk, (unsigned)__builtin_amdgcn_readfirstlane(kdst + (s) * KSLOT))
#define DMA_V(t, s) do { glds16(vsrc0 + (size_t)(t) * 64 * ldv, (unsigned)__builtin_amdgcn_readfirstlane(vdst + (s) * VSLOT)); \
        if (NV == 2) glds16(vsrc1 + (size_t)(t) * 64 * ldv, (unsigned)__builtin_amdgcn_readfirstlane(vdst + (s) * VSLOT + 8192)); } while (0)
    const lds_cptr kp0 = (lds_cptr)lds + LDS_K + hi * 1024 + r32 * 16;
    const lds_cptr vp0 = (lds_cptr)lds + LDS_V + ((lane >> 4) & 1) * 32 + (lane & 3) * 8 + (4 * hi + ((lane & 15) >> 2)) * 64;
    DMA_K(0, 0); DMA_V(0, 0); DMA_K(1, 1);
    bf16x8 qr[4];
#pragma unroll
    for (int d0 = 0; d0 < 4; ++d0) qr[d0] = *(const bf16x8*)(Qp + (size_t)(wid * 32 + r32) * ldq + d0 * 16 + hi * 8);
    float l_reg = 0.f; f32x16 o[ND];
#pragma unroll
    for (int d = 0; d < ND; ++d) o[d] = f32x16{};
    const f32x16 zero16 = f32x16{};
    const int qw = q0 + wid * 32, qpos = qw + r32;
    int tl = 0, tr = NT; float fL = 1.f;
    if (BIAS) { tl = (qw - 191 >= 0) ? ((qw - 191) >> 6) + 1 : 0; tr = (qw + 158) >> 6; fL = __builtin_amdgcn_exp2f(btbl[0]); }
    f32x16 pA0, pA1, pB0, pB1; bf16x8 kf[8]; s16x4 vlo[8], vhi[8]; v4u pw0, pw1, pw2, pw3;
    int s_prev = 0, s_cur = 0, s_next = 1;
#define ROT() do { s_prev = s_cur; s_cur = s_next; s_next = (s_next == 2) ? 0 : s_next + 1; } while (0)
#define ADD_BIAS(C0, C1, t) do { if (BIAS && (t) >= tl && (t) <= tr) { const int base_ = (t) * 64 + 4 * hi - qpos; \
        _Pragma("unroll") for (int r = 0; r < 16; ++r) { const int rel0 = base_ + (r & 3) + 8 * (r >> 2); const int rel1 = rel0 + 32; \
            const int i0 = (rel0 < -128 ? -128 : (rel0 > 128 ? 128 : rel0)) + 128, i1 = (rel1 < -128 ? -128 : (rel1 > 128 ? 128 : rel1)) + 128; \
            C0[r] += btbl[i0]; C1[r] += btbl[i1]; } } } while (0)
    DMA_K(2, 2);
    wait_bar<NV + 2>();
    {
#pragma unroll
        for (int j = 0; j < 4; ++j) kload2(kf, kp0, j);
        pA0 = __builtin_amdgcn_mfma_f32_32x32x16_bf16(kf[0], qr[0], zero16, 0, 0, 0); pA1 = __builtin_amdgcn_mfma_f32_32x32x16_bf16(kf[1], qr[0], zero16, 0, 0, 0);
#pragma unroll
        for (int d0 = 1; d0 < 4; ++d0) { pA0 = __builtin_amdgcn_mfma_f32_32x32x16_bf16(kf[2 * d0], qr[d0], pA0, 0, 0, 0); pA1 = __builtin_amdgcn_mfma_f32_32x32x16_bf16(kf[2 * d0 + 1], qr[d0], pA1, 0, 0, 0); }
        ADD_BIAS(pA0, pA1, 0);
#pragma unroll
        for (int r = 0; r < 16; ++r) { pA0[r] = __builtin_amdgcn_exp2f(pA0[r]); pA1[r] = __builtin_amdgcn_exp2f(pA1[r]); }
    }
    wait_bar<0>();
    DMA_K(3, 0); DMA_V(1, 1);
    ROT();
#pragma unroll
    for (int j = 0; j < 4; ++j) kload2(kf, kp0 + s_cur * KSLOT, j);
    wait_bar<1 + NV>();
#define PKW(P, B) cvtpk_s(P[B], P[B + 1])
#define PAF(k) __builtin_bit_cast(bf16x8, pw##k)
#define VFR(i) (bf16x8){vlo[i][0], vlo[i][1], vlo[i][2], vlo[i][3], vhi[i][0], vhi[i][1], vhi[i][2], vhi[i][3]}
#define MF(a, b, c) __builtin_amdgcn_mfma_f32_32x32x16_bf16(a, b, c, 0, 0, 0)
#define GAPA(MFS, A0, A1, A2, A3, W0, W1, PW) do { MFS; sacc += A0; sacc += A1; sacc += A2; sacc += A3; PIN(sacc); W0; W1; PIN(PW); SBAR(); } while (0)
#define EX(v) __builtin_amdgcn_exp2f(v)
#define GAPB4(MFS, X, B) do { MFS; X[B] = EX(X[B]); X[B + 1] = EX(X[B + 1]); X[B + 2] = EX(X[B + 2]); X[B + 3] = EX(X[B + 3]); PIN(X); SBAR(); } while (0)
#define GAPB2(MFS, X, B) do { MFS; X[B] = EX(X[B]); X[B + 1] = EX(X[B + 1]); PIN(X); SBAR(); } while (0)
#define VRD(f, s) do { vlo[s] = vtr(vp_ + (((f) >> 2) * 4096 + ((f) & 3) * 1024)); vhi[s] = vtr(vp_ + (((f) >> 2) * 4096 + ((f) & 3) * 1024 + 512)); } while (0)
#define KRD(G, j) do { if (G) { kload2(kf, kp0 + s_next * KSLOT, j); SBAR(); } } while (0)
#define FO(m) (ND == 2 ? (((m) >> 1) + 4 * ((m) & 1)) : ((((m) & 7) >> 2) + 2 * ((m) >> 3) + 4 * ((m) & 3)))
#define STEP(C0, C1, P0, P1, t, GK, GV, GL) do { SBAR(); \
    const lds_cptr vp_ = vp0 + s_prev * VSLOT; \
    VRD(FO(0), 0); SBAR(); float sacc = (P0[0] + P0[1]); \
    GAPA(C0 = MF(kf[0], qr[0], zero16), P0[2], P0[3], P0[4], P0[5],     pw0[0] = PKW(P0, 0), pw0[1] = PKW(P0, 2), pw0); \
    VRD(FO(1), 1); SBAR(); GAPA(C1 = MF(kf[1], qr[0], zero16), P0[6], P0[7], P0[8], P0[9],     pw0[2] = PKW(P0, 4), pw0[3] = PKW(P0, 6), pw0); \
    VRD(FO(2), 2); SBAR(); GAPA(C0 = MF(kf[2], qr[1], C0),   P0[10], P0[11], P0[12], P0[13], pw1[0] = PKW(P0, 8), pw1[1] = PKW(P0, 10), pw1); \
    VRD(FO(3), 3); SBAR(); GAPA(C1 = MF(kf[3], qr[1], C1),   P0[14], P0[15], P1[0], P1[1],   pw1[2] = PKW(P0, 12), pw1[3] = PKW(P0, 14), pw1); \
    VRD(FO(4), 4); SBAR(); GAPA(C0 = MF(kf[4], qr[2], C0),   P1[2], P1[3], P1[4], P1[5],     pw2[0] = PKW(P1, 0), pw2[1] = PKW(P1, 2), pw2); \
    VRD(FO(5), 5); SBAR(); GAPA(C1 = MF(kf[5], qr[2], C1),   P1[6], P1[7], P1[8], P1[9],     pw2[2] = PKW(P1, 4), pw2[3] = PKW(P1, 6), pw2); \
    VRD(FO(6), 6); SBAR(); GAPA(C0 = MF(kf[6], qr[3], C0),   P1[10], P1[11], P1[12], P1[13], pw3[0] = PKW(P1, 8), pw3[1] = PKW(P1, 10), pw3); \
    VRD(FO(7), 7); SBAR(); GAPA(C1 = MF(kf[7], qr[3], C1),   P1[14], P1[15], 0.f, 0.f,       pw3[2] = PKW(P1, 12), pw3[3] = PKW(P1, 14), pw3); \
    l_reg += sacc; \
    if (GK) { DMA_K((t) + 3, s_cur); } if (GV) { DMA_V((t) + 1, s_next); } \
    ADD_BIAS(C0, C1, t); \
    SBAR(); \
    if (ND == 2) { \
        GAPB4(o[0] = MF(PAF(0), VFR(0), o[0]), C0, 0); \
        GAPB4(o[1] = MF(PAF(0), VFR(1), o[1]), C0, 4); \
        KRD(GL, 0); GAPB4(o[0] = MF(PAF(1), VFR(2), o[0]), C0, 8); \
        KRD(GL, 1); GAPB4(o[1] = MF(PAF(1), VFR(3), o[1]), C0, 12); \
        KRD(GL, 2); GAPB4(o[0] = MF(PAF(2), VFR(4), o[0]), C1, 0); \
        KRD(GL, 3); GAPB4(o[1] = MF(PAF(2), VFR(5), o[1]), C1, 4); \
        GAPB4(o[0] = MF(PAF(3), VFR(6), o[0]), C1, 8); \
        GAPB4(o[1] = MF(PAF(3), VFR(7), o[1]), C1, 12); \
    } else { \
        GAPB2(o[0] = MF(PAF(0), VFR(0), o[0]), C0, 0);  VRD(FO(8), 0); SBAR(); \
        GAPB2(o[1] = MF(PAF(0), VFR(1), o[1]), C0, 2);  VRD(FO(9), 1); SBAR(); \
        GAPB2(o[ND - 2] = MF(PAF(0), VFR(2), o[ND - 2]), C0, 4);  VRD(FO(10), 2); SBAR(); \
        GAPB2(o[ND - 1] = MF(PAF(0), VFR(3), o[ND - 1]), C0, 6);  VRD(FO(11), 3); SBAR(); \
        GAPB2(o[0] = MF(PAF(1), VFR(4), o[0]), C0, 8);  VRD(FO(12), 4); SBAR(); \
        GAPB2(o[1] = MF(PAF(1), VFR(5), o[1]), C0, 10); VRD(FO(13), 5); SBAR(); \
        GAPB2(o[ND - 2] = MF(PAF(1), VFR(6), o[ND - 2]), C0, 12); VRD(FO(14), 6); SBAR(); \
        GAPB2(o[ND - 1] = MF(PAF(1), VFR(7), o[ND - 1]), C0, 14); VRD(FO(15), 7); SBAR(); \
        KRD(GL, 0); GAPB2(o[0] = MF(PAF(2), VFR(0), o[0]), C1, 0); \
        GAPB2(o[1] = MF(PAF(2), VFR(1), o[1]), C1, 2); \
        KRD(GL, 1); GAPB2(o[ND - 2] = MF(PAF(2), VFR(2), o[ND - 2]), C1, 4); \
        GAPB2(o[ND - 1] = MF(PAF(2), VFR(3), o[ND - 1]), C1, 6); \
        KRD(GL, 2); GAPB2(o[0] = MF(PAF(3), VFR(4), o[0]), C1, 8); \
        GAPB2(o[1] = MF(PAF(3), VFR(5), o[1]), C1, 10); \
        KRD(GL, 3); GAPB2(o[ND - 2] = MF(PAF(3), VFR(6), o[ND - 2]), C1, 12); \
        GAPB2(o[ND - 1] = MF(PAF(3), VFR(7), o[ND - 1]), C1, 14); \
    } \
    if (BIAS && (t) == tl) { l_reg *= fL; _Pragma("unroll") for (int d_ = 0; d_ < ND; ++d_) _Pragma("unroll") for (int r = 0; r < 16; ++r) o[d_][r] *= fL; } \
    } while (0)
    int t = 1;
    for (; t + 4 < NT; t += 2) {
        STEP(pB0, pB1, pA0, pA1, t, true, true, true);       wait_bar<1 + NV>(); ROT();
        STEP(pA0, pA1, pB0, pB1, t + 1, true, true, true);   wait_bar<1 + NV>(); ROT();
    }
    STEP(pB0, pB1, pA0, pA1, NT - 3, false, true, true);  wait_bar<NV>(); ROT();
    STEP(pA0, pA1, pB0, pB1, NT - 2, false, true, true);  wait_bar<0>();  ROT();
    STEP(pB0, pB1, pA0, pA1, NT - 1, false, false, false);
    {
        float sacc = pB0[0] + pB0[1];
#pragma unroll
        for (int r = 2; r < 16; ++r) sacc += pB0[r];
#pragma unroll
        for (int r = 0; r < 16; ++r) sacc += pB1[r];
        l_reg += sacc;
        pw0 = (v4u){PKW(pB0, 0), PKW(pB0, 2), PKW(pB0, 4), PKW(pB0, 6)}; pw1 = (v4u){PKW(pB0, 8), PKW(pB0, 10), PKW(pB0, 12), PKW(pB0, 14)};
        pw2 = (v4u){PKW(pB1, 0), PKW(pB1, 2), PKW(pB1, 4), PKW(pB1, 6)}; pw3 = (v4u){PKW(pB1, 8), PKW(pB1, 10), PKW(pB1, 12), PKW(pB1, 14)};
        const lds_cptr vp_ = vp0 + s_cur * VSLOT;
#pragma unroll
        for (int d0 = 0; d0 < ND; ++d0) {
            s16x4 a0 = vtr(vp_ + d0 * 4096), b0 = vtr(vp_ + d0 * 4096 + 512), a1 = vtr(vp_ + d0 * 4096 + 1024), b1 = vtr(vp_ + d0 * 4096 + 1536);
            s16x4 a2 = vtr(vp_ + d0 * 4096 + 2048), b2 = vtr(vp_ + d0 * 4096 + 2560), a3 = vtr(vp_ + d0 * 4096 + 3072), b3 = vtr(vp_ + d0 * 4096 + 3584);
            o[d0] = MF(PAF(0), ((bf16x8){a0[0], a0[1], a0[2], a0[3], b0[0], b0[1], b0[2], b0[3]}), o[d0]);
            o[d0] = MF(PAF(1), ((bf16x8){a1[0], a1[1], a1[2], a1[3], b1[0], b1[1], b1[2], b1[3]}), o[d0]);
            o[d0] = MF(PAF(2), ((bf16x8){a2[0], a2[1], a2[2], a2[3], b2[0], b2[1], b2[2], b2[3]}), o[d0]);
            o[d0] = MF(PAF(3), ((bf16x8){a3[0], a3[1], a3[2], a3[3], b3[0], b3[1], b3[2], b3[3]}), o[d0]);
        }
    }
    l_reg += __shfl_xor(l_reg, 32);
    if (hi == 0) wsf[r32] = l_reg;
    asm volatile("s_waitcnt lgkmcnt(0)\n\ts_barrier" ::: "memory");
    {
        LAS bf16* stg = (LAS bf16*)(lds) + wid * (32 * DV);
#pragma unroll
        for (int r = 0; r < 16; ++r) { const int orow = crow(r, hi); const float rl = __builtin_amdgcn_rcpf(wsf[orow]);
#pragma unroll
            for (int d0 = 0; d0 < ND; ++d0) stg[orow * DV + d0 * 32 + r32] = (bf16)f2bf(o[d0][r] * rl); }
        asm volatile("s_waitcnt lgkmcnt(0)" ::: "memory");
        constexpr int CPR = DV / 8;
#pragma unroll
        for (int i = 0; i < (32 * CPR) / 64; ++i) { const int row = i * (64 / CPR) + lane / CPR, ch = lane % CPR;
            const v4u v = *(const LAS v4u*)(stg + row * DV + ch * 8); *(v4u*)(Op + (size_t)(wid * 32 + row) * ldo + ch * 8) = v; }
    }
    asm volatile("s_waitcnt lgkmcnt(0)\n\ts_barrier" ::: "memory");
#undef DMA_K
#undef DMA_V
#undef ROT
#undef ADD_BIAS
#undef PKW
#undef PAF
#undef VFR
#undef MF
#undef GAPA
#undef EX
#undef GAPB4
#undef GAPB2
#undef VRD
#undef KRD
#undef FO
#undef STEP
}
#undef SBAR
#undef PIN
}

struct Args { const float* in[27]; float* out; unsigned char* ws; int ph_lo, ph_hi, li, pad; };

constexpr int NPHASE = 17;
constexpr int NWAVES = 8;

#define IN(k) (lo <= (k) && (k) < hi_ph)
#define SEAM(k) do { if (IN(k) && IN((k) + 1)) xcd_barrier(bar); } while (0)
template <int layer>
__device__ __forceinline__ void moe_block(const Args& args, LAS unsigned char* lds, const XcdBarrier& bar, int lo, int hi_ph) {
    volatile LAS unsigned* LC = (volatile LAS unsigned*)(lds + LDSCTL_OFF);
    const int tid = threadIdx.x, lane = tid & 63, wave = __builtin_amdgcn_readfirstlane(tid >> 6);
    const int G = gridDim.x, bx = blockIdx.x;
    const int gw = bx * NWAVES + wave, NGW = G * NWAVES;
    unsigned char* ws = args.ws;
    unsigned* ctl = (unsigned*)(ws + WS_CTL);
    float* xres = args.out;
    bf16* HB = (bf16*)(ws + WS_HB);
    {
        const int pb = layer == 0 ? 5 : 13;
        unsigned* const gcnt0 = ctl + CW_CNT + layer * 64;
        int* list = (int*)(ws + WS_LIST); int* tokep = (int*)(ws + WS_TOKEP); float* gate = (float*)(ws + WS_GATE);
        if (IN(pb)) REP(pb) {
            unsigned* gcnt = gcnt0 + ((MK_N_LAUNCHES == 1 ? (int)((PROBE_MASK >> pb) & 1u) : 0) - rep_) * 128;
            if (rep_ > 0) xcd_barrier(bar);
            const float* gf = args.in[2] + layer * DM;
            const float* WR = (const float*)(ws + WS_TBL) + TBL_WR + layer * WR_LAYER;
            for (int chunk = bx; chunk < NTOK / 128; chunk += G) {
                __syncthreads();
                if (tid < 32) LC[LC_LCNT + tid] = 0u;
                __syncthreads();
                int my_e0 = 0, my_e1 = 0; float my_g0 = 0.f, my_g1 = 0.f;
                {
                    const int ri = lane & 15, kq = lane >> 4; const int r0w = chunk * 128 + wave * 16;
                    const GAS float* xrow = (const GAS float*)(xres + (size_t)(r0w + ri) * DM) + 4 * kq;
                    const GAS float* wb = (const GAS float*)WR + (size_t)(4 * kq) * 48 + ri;
                    f32x4 acc0 = {0.f, 0.f, 0.f, 0.f}, acc1 = acc0, acc2 = acc0; float ss = 0.f;
#pragma unroll 4
                    for (int c = 0; c < 64; ++c) {
                        const f32x4 a4 = *(const GAS f32x4*)(xrow + 16 * c);
                        ss += (a4.x * a4.x + a4.y * a4.y) + (a4.z * a4.z + a4.w * a4.w);
                        const GAS float* wc = wb + (size_t)(16 * c) * 48;
#pragma unroll
                        for (int e = 0; e < 4; ++e) {
                            acc0 = __builtin_amdgcn_mfma_f32_16x16x4f32(a4[e], wc[e * 48], acc0, 0, 0, 0);
                            acc1 = __builtin_amdgcn_mfma_f32_16x16x4f32(a4[e], wc[e * 48 + 16], acc1, 0, 0, 0);
                            acc2 = __builtin_amdgcn_mfma_f32_16x16x4f32(a4[e], wc[e * 48 + 32], acc2, 0, 0, 0);
                        }
                    }
                    ss += __shfl_xor(ss, 16); ss += __shfl_xor(ss, 32);
                    const float rstd = 1.0f / sqrtf(ss * (1.f / DM) + 1e-6f);
                    LAS float* Lg = (LAS float*)(lds + wave * 4096);
#pragma unroll
                    for (int r = 0; r < 4; ++r) { Lg[(4 * kq + r) * 49 + ri] = acc0[r]; Lg[(4 * kq + r) * 49 + 16 + ri] = acc1[r]; Lg[(4 * kq + r) * 49 + 32 + ri] = acc2[r]; }
                    LDS_WAIT(); asm volatile("" ::: "memory");
                    if (lane < 16) {
                        const GAS float* bv = (const GAS float*)WR + 1024 * 48;
                        float lg[4], le[32];
#pragma unroll
                        for (int e = 0; e < 4; ++e) lg[e] = Lg[lane * 49 + e] * rstd + bv[e];
#pragma unroll
                        for (int e = 0; e < 32; ++e) le[e] = Lg[lane * 49 + 4 + e] * rstd + bv[4 + e];
                        int gi = 0; float gm = lg[0];
#pragma unroll
                        for (int e = 1; e < 4; ++e) if (lg[e] > gm) { gm = lg[e]; gi = e; }
                        float gs = 0.f;
#pragma unroll
                        for (int e = 0; e < 4; ++e) gs += __expf(lg[e] - gm);
                        const float gval = 1.0f / gs;
                        float ev[8];
#pragma unroll
                        for (int j = 0; j < 8; ++j) ev[j] = gi == 0 ? le[j] : (gi == 1 ? le[8 + j] : (gi == 2 ? le[16 + j] : le[24 + j]));
                        int i0 = 0; float m0 = ev[0];
#pragma unroll
                        for (int j = 1; j < 8; ++j) if (ev[j] > m0) { m0 = ev[j]; i0 = j; }
                        int i1 = -1; float m1 = -3.0e38f;
#pragma unroll
                        for (int j = 0; j < 8; ++j) if (j != i0 && ev[j] > m1) { m1 = ev[j]; i1 = j; }
                        const float t1 = __expf(m1 - m0); const float den = 1.0f / (1.0f + t1);
                        my_e0 = gi * 8 + i0; my_e1 = gi * 8 + i1; my_g0 = gval * den; my_g1 = gval * t1 * den;
                    }
                    for (int i = 0; i < 16; ++i) { const int m = r0w + i; f32x4 v[4]; rms_row(xres + (size_t)m * DM, gf, v, lane); store_row_bf16(HB + (size_t)m * DM, v, lane); }
                }
                unsigned r0 = 0, r1 = 0;
                if (lane < 16) { r0 = atomicAdd((unsigned*)(LC + LC_LCNT + my_e0), 1u); r1 = atomicAdd((unsigned*)(LC + LC_LCNT + my_e1), 1u); }
                __syncthreads();
                if (tid < 32) { const unsigned c = LC[LC_LCNT + tid]; LC[LC_LBASE + tid] = c ? __hip_atomic_fetch_add(gcnt + tid, c, RLX_AGENT) : 0u; }
                __syncthreads();
                if (lane < 16) { const int m = chunk * 128 + wave * 16 + lane;
                    const unsigned p0 = LC[LC_LBASE + my_e0] + r0, p1 = LC[LC_LBASE + my_e1] + r1;
                    list[(size_t)my_e0 * LIST_CAP + p0] = m; list[(size_t)my_e1 * LIST_CAP + p1] = m;
                    tokep[2 * m] = my_e0 | (int)(p0 << 8); tokep[2 * m + 1] = my_e1 | (int)(p1 << 8);
                    gate[2 * m] = my_g0; gate[2 * m + 1] = my_g1; }
            }
        }
        SEAM(pb);
        if (IN(pb + 1) || IN(pb + 2) || IN(pb + 3)) {
            __syncthreads();
            if (tid == 0) { int acc = 0; for (int e = 0; e < 32; ++e) { const int c = (int)__hip_atomic_load(gcnt0 + e, RLX_AGENT); LC[LC_CNT + e] = (unsigned)c; LC[LC_TP + e] = (unsigned)acc; acc += (c + 255) >> 8; } LC[LC_TP + 32] = (unsigned)acc; }
            __syncthreads();
        }
        const LAS int* tp = (const LAS int*)(lds + LDSCTL_OFF) + LC_TP; const LAS int* cn = (const LAS int*)(lds + LDSCTL_OFF) + LC_CNT;
        if (IN(pb + 1)) REP(pb + 1) {
            pg8::Gemm g{HB, (const bf16*)(ws + WS_W13), 0, 1024, DM};
            pg8::MoeOrder S{tp, cn, list, G, bx, tp[32] * 4, true};
            pg8::EpiSwiglu E{(bf16*)(ws + WS_H)};
            pg8::gemm_phase<pg8::EpiSwiglu, pg8::MoeOrder, true>(lds, g, S, E);
        }
        SEAM(pb + 1);
        if (IN(pb + 2)) REP(pb + 2) {
            pg8::Gemm g{(const bf16*)(ws + WS_H), (const bf16*)(ws + WS_W2), 0, 1024, MOE_H};
            pg8::MoeOrder S{tp, cn, list, G, bx, tp[32] * 4, false};
            pg8::EpiBf16 E{(bf16*)(ws + WS_YS), DM, 0, 0, 1.f, 3};
            pg8::gemm_phase<pg8::EpiBf16, pg8::MoeOrder, true>(lds, g, S, E);
        }
        SEAM(pb + 2);
        if (IN(pb + 3)) {
            const bf16* YS = (const bf16*)(ws + WS_YS);
            if (layer == 0) { LAS float* scr = (LAS float*)(lds + wave * 16384);
                transpose_moe(args.in[24] + (size_t)NEXP * 1024 * 512, args.in[25] + (size_t)NEXP * 1024 * 512, args.in[26] + (size_t)NEXP * 1024 * 512, (bf16*)(ws + WS_W13), (bf16*)(ws + WS_W2), scr, gw, NGW, lane); }
            const float* gn = layer == 0 ? args.in[1] + DM : args.in[3];
            for (int m = gw; m < NTOK; m += NGW) {
                const int ep0 = tokep[2 * m], ep1 = tokep[2 * m + 1]; const float g0 = gate[2 * m], g1 = gate[2 * m + 1];
                const size_t s0 = (size_t)(tp[ep0 & 255] * 256 + (ep0 >> 8)), s1 = (size_t)(tp[ep1 & 255] * 256 + (ep1 >> 8));
                GAS f32x4* xr = (GAS f32x4*)(xres + (size_t)m * DM) + lane;
                const GAS v2u* y0 = (const GAS v2u*)(YS + s0 * DM) + lane; const GAS v2u* y1 = (const GAS v2u*)(YS + s1 * DM) + lane;
                f32x4 v[4]; float ss = 0.f;
#pragma unroll
                for (int j = 0; j < 4; ++j) { const v2u a = y0[64 * j], c = y1[64 * j]; f32x4 xv = xr[64 * j];
                    xv.x += g0 * __builtin_bit_cast(float, a.x << 16) + g1 * __builtin_bit_cast(float, c.x << 16);
                    xv.y += g0 * __builtin_bit_cast(float, a.x & 0xffff0000u) + g1 * __builtin_bit_cast(float, c.x & 0xffff0000u);
                    xv.z += g0 * __builtin_bit_cast(float, a.y << 16) + g1 * __builtin_bit_cast(float, c.y << 16);
                    xv.w += g0 * __builtin_bit_cast(float, a.y & 0xffff0000u) + g1 * __builtin_bit_cast(float, c.y & 0xffff0000u);
                    v[j] = xv; ss += (xv.x * xv.x + xv.y * xv.y) + (xv.z * xv.z + xv.w * xv.w); }
                const float rstd = 1.0f / sqrtf(wave_sum(ss) * (1.f / DM) + 1e-6f);
                const GAS f32x4* gr = (const GAS f32x4*)gn + lane;
                if (layer == 0) {
#pragma unroll
                    for (int j = 0; j < 4; ++j) xr[64 * j] = v[j];
#pragma unroll
                    for (int j = 0; j < 4; ++j) v[j] = v[j] * rstd * gr[64 * j];
                    store_row_bf16(HB + (size_t)m * DM, v, lane);
                } else {
#pragma unroll
                    for (int j = 0; j < 4; ++j) xr[64 * j] = v[j] * rstd * gr[64 * j];
                }
            }
        }
    }
}

__global__ void __launch_bounds__(NWAVES * 64, 2) mk_fwd(Args args) {
    extern __shared__ __attribute__((aligned(16))) unsigned char lds_raw[];
    LAS unsigned char* lds = (LAS unsigned char*)lds_raw;
    volatile LAS unsigned* LC = (volatile LAS unsigned*)(lds + LDSCTL_OFF);
    const int tid = threadIdx.x, lane = tid & 63, wave = __builtin_amdgcn_readfirstlane(tid >> 6);
    const int G = gridDim.x, bx = blockIdx.x;
    const int gw = bx * NWAVES + wave, NGW = G * NWAVES;
    unsigned char* ws = args.ws;
    unsigned* ctl = (unsigned*)(ws + WS_CTL);
    const float* x_in = args.in[0];
    float* xres = args.out;
    bf16* HB = (bf16*)(ws + WS_HB); bf16* Y = (bf16*)(ws + WS_Y);
    float* TBL = (float*)(ws + WS_TBL);

    for (int u = tid; u < (LDS_BYTES - LDSCTL_OFF) / 4; u += NWAVES * 64) LC[u] = 0u;
    __syncthreads();
    XcdBarrier bar; bar.bar = ctl + CW_BAR; bar.x = 0; bar.st = nullptr;
    if (MK_N_LAUNCHES == 1) bar = xcd_barrier_post(ctl + CW_BAR, LC + LC_BAR);
    const int lo = args.ph_lo, hi_ph = args.ph_hi;

    if (IN(0)) REP(0) {
        LAS float* scr = (LAS float*)(lds + wave * 16384);
        transpose_plain(args.in[4], DM, EV_IN, (bf16*)(ws + WS_WIN0), scr, gw, NGW, lane);
        transpose_plain(args.in[11], DM, DM, (bf16*)(ws + WS_WOUT0), scr, gw, NGW, lane);
        transpose_plain(args.in[12], DM, OD_IN, (bf16*)(ws + WS_WIN1), scr, gw, NGW, lane);
        transpose_plain(args.in[18], DM, DM, (bf16*)(ws + WS_WOUT1), scr, gw, NGW, lane);
        transpose_moe(args.in[24], args.in[25], args.in[26], (bf16*)(ws + WS_W13), (bf16*)(ws + WS_W2), scr, gw, NGW, lane);
        for (int i = bx * 512 + tid; i < 2048; i += G * 512) { const int pos = i >> 4, f = i & 15;
            const float inv = exp2f(-(float)f * (13.287712379549449f / 16.0f));
            const float ang = (float)pos * inv; const float rev = ang * 0.15915494309189535f; const float fr = rev - floorf(rev);
            TBL[TBL_COS + i] = __builtin_amdgcn_cosf(fr); TBL[TBL_SIN + i] = __builtin_amdgcn_sinf(fr); }
        for (int i = bx * 512 + tid; i < 8 * 257; i += G * 512) { const int h = i / 257, j = i % 257;
            TBL[TBL_BIAS + h * BIAS_STRIDE + j] = args.in[19][t5_bucket(j - 128) * 8 + h] * LOG2E; }
        for (int i = bx * 512 + tid; i < 2 * 1024 * 48; i += G * 512) { const int l = i / (1024 * 48), r = i % (1024 * 48), k = r / 48, c = r % 48;
            float w = 0.f; if (c < 4) w = args.in[20][(size_t)l * 4096 + k * 4 + c]; else if (c < 36) w = args.in[22][(size_t)l * 32768 + k * 32 + (c - 4)];
            TBL[TBL_WR + l * WR_LAYER + r] = w * args.in[2][l * DM + k]; }
        for (int i = bx * 512 + tid; i < 2 * 48; i += G * 512) { const int l = i / 48, c = i % 48;
            TBL[TBL_WR + l * WR_LAYER + 1024 * 48 + c] = c < 4 ? args.in[21][l * 4 + c] : (c < 36 ? args.in[23][l * 32 + (c - 4)] : 0.f); }
        for (int m = gw; m < NTOK; m += NGW) { f32x4 v[4]; rms_row(x_in + (size_t)m * DM, args.in[1], v, lane); store_row_bf16(HB + (size_t)m * DM, v, lane); }
    }
    SEAM(0);
    if (IN(1)) REP(1) {
        pg8::Gemm g{HB, (const bf16*)(ws + WS_WIN0), NTOK, EV_IN, DM}; pg8::StaticOrder S; S.init(NTOK, EV_IN, G, bx);
        pg8::EpiBf16 E{(bf16*)(ws + WS_Z0), EV_IN, 0, 0, 1.f, 0xffff};
        pg8::gemm_phase<pg8::EpiBf16, pg8::StaticOrder, true>(lds, g, S, E);
    }
    SEAM(1);
    if (IN(2)) REP(2) {
        const bf16* Z0 = (const bf16*)(ws + WS_Z0); bf16* QR = (bf16*)(ws + WS_QR); bf16* KR = (bf16*)(ws + WS_KR);
        const float gq = args.in[5][lane], gk = args.in[6][lane];
        const int fi = lane & 15; const bool first = (lane & 16) == 0, isrow = lane < 32;
        for (int m = gw; m < NTOK; m += NGW) {
            const int s = m & (SEQ - 1); const int pos = isrow ? (s >> 6) : (s & 63);
            const float cs = TBL[TBL_COS + pos * 16 + fi], sn = TBL[TBL_SIN + pos * 16 + fi];
#pragma unroll
            for (int h = 0; h < 10; ++h) {
                const float xv = bf2f(Z0[(size_t)m * EV_IN + h * 64 + lane]);
                const float ss = wave_sum(xv * xv);
                const float y = xv * (1.0f / sqrtf(ss * (1.f / 64.f) + 1e-6f)) * (h < 8 ? gq : gk);
                const float p = __shfl_xor(y, 16);
                float o = first ? (y * cs - p * sn) : (y * cs + p * sn);
                if (h < 8) QR[(size_t)m * 512 + h * 64 + lane] = (bf16)f2bf(o * C2);
                else KR[(size_t)m * 128 + (h - 8) * 64 + lane] = (bf16)f2bf(o);
            }
        }
        LAS float* hbuf = (LAS float*)lds;
        for (int un = bx; un < NBATCH * 128 * 8; un += G) {
            const int grp = un & 7, tt = (un >> 3) & 127, b = un >> 10; const int t0 = tt * 64;
            __syncthreads();
            for (int idx = tid; idx < 94 * 64; idx += 512) { const int r = idx >> 6, c = idx & 63; const int s = t0 - 15 + r; float hv = 0.f;
                if (s >= 0 && s < SEQ) { const size_t ro = (size_t)(b * SEQ + s) * EV_IN; const float a = bf2f(Z0[ro + 768 + grp * 64 + c]), gt = bf2f(Z0[ro + 1280 + grp * 64 + c]);
                    hv = a / (1.0f + __expf(-gt)); }
                hbuf[idx] = hv; }
            __syncthreads();
            const int ch = grp * 64 + lane;
            float wreg[31];
#pragma unroll
            for (int j = 0; j < 31; ++j) wreg[j] = args.in[7][j * 512 + ch];
            float acc[8]; const float cb = args.in[8][ch];
#pragma unroll
            for (int i = 0; i < 8; ++i) acc[i] = cb;
#pragma unroll
            for (int r = 0; r < 38; ++r) { const float hv = hbuf[(wave * 8 + r) * 64 + lane];
#pragma unroll
                for (int i = 0; i < 8; ++i) { const int j = r - i; if (j >= 0 && j < 31) acc[i] += wreg[j] * hv; } }
            const float gg = args.in[9][ch], gb = args.in[10][ch];
#pragma unroll
            for (int i = 0; i < 8; ++i) { const float mu = wave_sum(acc[i]) * (1.f / 64.f); const float d = acc[i] - mu; const float var = wave_sum(d * d) * (1.f / 64.f);
                const float hn = d * (1.0f / sqrtf(var + 1e-5f)) * gg + gb; const float ov = hn / (1.0f + __expf(-hn));
                Y[(size_t)(b * SEQ + t0 + wave * 8 + i) * DM + 512 + ch] = (bf16)f2bf(ov); }
        }
    }
    SEAM(2);
    if (IN(3)) REP(3) {
        const bf16* QR = (const bf16*)(ws + WS_QR); const bf16* KR = (const bf16*)(ws + WS_KR); const bf16* Z0 = (const bf16*)(ws + WS_Z0);
        if (ATTN_VER == 0) {
        for (int un = bx; un < NBATCH * 8 * 32; un += G) {
            const int qb = un & 31, h = (un >> 5) & 7, b = un >> 8, kvh = h >> 2;
            const size_t row0 = (size_t)b * SEQ + qb * 256;
            attn_unit_v0<64, false>(QR + row0 * 512 + h * 64, 512, KR + (size_t)b * SEQ * 128 + kvh * 64, 128, Z0 + (size_t)b * SEQ * EV_IN + 640 + kvh * 64, EV_IN,
                                   Y + row0 * DM + h * 64, DM, nullptr, qb * 256, lds);
        }
        } else {
        constexpr int U = NBATCH * 8 * 32; const int upc = (U + G - 1) / G; const int vcu = (G % 8 == 0) ? (bx % 8) * (G / 8) + bx / 8 : bx;
        for (int i = 0; i < upc; ++i) { const int un = vcu * upc + i; if (un >= U) break;
            const int stream = un >> 7, b = stream >> 1, kvh = stream & 1, h = kvh * 4 + ((un >> 5) & 3), qb = un & 31;
            const size_t row0 = (size_t)b * SEQ + qb * 256;
            at1::attn_unit<64, false>(QR + row0 * 512 + h * 64, 512, KR + (size_t)b * SEQ * 128 + kvh * 64, 128, Z0 + (size_t)b * SEQ * EV_IN + 640 + kvh * 64, EV_IN,
                                      Y + row0 * DM + h * 64, DM, qb * 256, lds);
        }
        }
    }
    SEAM(3);
    if (IN(4)) REP(4) {
        pg8::Gemm g{Y, (const bf16*)(ws + WS_WOUT0), NTOK, DM, DM}; pg8::StaticOrder S; S.init(NTOK, DM, G, bx);
        pg8::EpiRes E{x_in, xres, DM};
        pg8::gemm_phase<pg8::EpiRes, pg8::StaticOrder, true>(lds, g, S, E);
    }
    SEAM(4);

    moe_block<0>(args, lds, bar, lo, hi_ph);
    SEAM(8);
            if (IN(9)) REP(9) {
                pg8::Gemm g{HB, (const bf16*)(ws + WS_WIN1), NTOK, OD_IN, DM}; pg8::StaticOrder S; S.init(NTOK, OD_IN, G, bx);
                pg8::EpiBf16 E{(bf16*)(ws + WS_Q1), DM, DM, (size_t)(WS_K1 - WS_Q1) / 2, C2, 0xffff};
                pg8::gemm_phase<pg8::EpiBf16, pg8::StaticOrder, true>(lds, g, S, E);
            }
            SEAM(9);
            if (IN(10)) REP(10) {
                const bf16* Q1 = (const bf16*)(ws + WS_Q1); const bf16* K1 = (const bf16*)(ws + WS_K1); const bf16* V1 = (const bf16*)(ws + WS_V1);
                if (ATTN_VER == 0) {
                LAS float* btbl = (LAS float*)(lds + 65536);
                for (int un = bx; un < NBATCH * 8 * 2 * 32; un += G) {
                    const int qb = un & 31, c = (un >> 5) & 1, h = (un >> 6) & 7, b = un >> 9;
                    __syncthreads();
                    if (tid < 257) btbl[tid] = TBL[TBL_BIAS + h * BIAS_STRIDE + tid];
                    __syncthreads();
                    const size_t row0 = (size_t)b * SEQ + qb * 256, brow = (size_t)b * SEQ;
                    bf16* OC = (bf16*)(ws + (c ? WS_OC1 : WS_OC0));
                    attn_unit_v0<128, true>(Q1 + row0 * DM + h * 128 + c * 64, DM, K1 + brow * DM + h * 128 + c * 64, DM, V1 + brow * DM + h * 128, DM,
                                           OC + row0 * DM + h * 128, DM, btbl, qb * 256, lds);
                }
                } else {
                constexpr int U = NBATCH * 8 * 2 * 32; const int upc = (U + G - 1) / G; const int vcu = (G % 8 == 0) ? (bx % 8) * (G / 8) + bx / 8 : bx;
                LAS float* btbl = (LAS float*)(lds + 3 * 8192 + 3 * 16384 + 2048);
                for (int i = 0; i < upc; ++i) {
                    int un = vcu * upc + i; if (un >= U) break;
                    if (G == 256) un = ((vcu >> 5) * 4 + (i >> 1)) * 64 + (i & 1) * 32 + (vcu & 31);
                    const int qb = un & 31, c = (un >> 5) & 1, h = (un >> 6) & 7, b = un >> 9;
                    if (tid < 257) btbl[tid] = TBL[TBL_BIAS + h * BIAS_STRIDE + tid] - TBL[TBL_BIAS + h * BIAS_STRIDE + 256];
                    __syncthreads();
                    const size_t row0 = (size_t)b * SEQ + qb * 256, brow = (size_t)b * SEQ;
                    bf16* OC = (bf16*)(ws + (c ? WS_OC1 : WS_OC0));
                    at1::attn_unit<128, true>(Q1 + row0 * DM + h * 128 + c * 64, DM, K1 + brow * DM + h * 128 + c * 64, DM, V1 + brow * DM + h * 128, DM,
                                              OC + row0 * DM + h * 128, DM, qb * 256, lds);
                }
                }
            }
            SEAM(10);
            if (IN(11)) REP(11) {
                const bf16* OC0 = (const bf16*)(ws + WS_OC0); const bf16* OC1 = (const bf16*)(ws + WS_OC1);
                const float lam = __expf(wave_sum(args.in[13][lane] * args.in[14][lane])) - __expf(wave_sum(args.in[15][lane] * args.in[16][lane])) + LAM_INIT;
                float sg[16];
#pragma unroll
                for (int j = 0; j < 16; ++j) sg[j] = args.in[17][(lane & 7) * 16 + j] * (1.0f - LAM_INIT);
                for (int m = gw; m < NTOK; m += NGW) {
                    const GAS v4u* a = (const GAS v4u*)(OC0 + (size_t)m * DM) + lane * 2; const GAS v4u* c = (const GAS v4u*)(OC1 + (size_t)m * DM) + lane * 2;
                    float o[16]; float ss = 0.f;
#pragma unroll
                    for (int q = 0; q < 2; ++q) { const v4u av = a[q], cv = c[q];
#pragma unroll
                        for (int j = 0; j < 4; ++j) { const unsigned au = av[j], cu = cv[j];
                            const float lo = __builtin_bit_cast(float, au << 16) - lam * __builtin_bit_cast(float, cu << 16);
                            const float hh = __builtin_bit_cast(float, au & 0xffff0000u) - lam * __builtin_bit_cast(float, cu & 0xffff0000u);
                            o[q * 8 + 2 * j] = lo; o[q * 8 + 2 * j + 1] = hh; ss += lo * lo + hh * hh; } }
                    ss += __shfl_xor(ss, 1); ss += __shfl_xor(ss, 2); ss += __shfl_xor(ss, 4);
                    const float rstd = 1.0f / sqrtf(ss * (1.f / 128.f) + 1e-5f);
                    v4u w0, w1;
                    w0.x = pk2(o[0] * rstd * sg[0], o[1] * rstd * sg[1]); w0.y = pk2(o[2] * rstd * sg[2], o[3] * rstd * sg[3]); w0.z = pk2(o[4] * rstd * sg[4], o[5] * rstd * sg[5]); w0.w = pk2(o[6] * rstd * sg[6], o[7] * rstd * sg[7]);
                    w1.x = pk2(o[8] * rstd * sg[8], o[9] * rstd * sg[9]); w1.y = pk2(o[10] * rstd * sg[10], o[11] * rstd * sg[11]); w1.z = pk2(o[12] * rstd * sg[12], o[13] * rstd * sg[13]); w1.w = pk2(o[14] * rstd * sg[14], o[15] * rstd * sg[15]);
                    GAS v4u* yo = (GAS v4u*)(Y + (size_t)m * DM) + lane * 2; yo[0] = w0; yo[1] = w1;
                }
            }
            SEAM(11);
            if (IN(12)) {
                pg8::Gemm g{Y, (const bf16*)(ws + WS_WOUT1), NTOK, DM, DM}; pg8::StaticOrder S; S.init(NTOK, DM, G, bx);
                pg8::EpiRes E{xres, xres, DM};
                pg8::gemm_phase<pg8::EpiRes, pg8::StaticOrder, true>(lds, g, S, E);
            }
            SEAM(12);
    moe_block<1>(args, lds, bar, lo, hi_ph);
#undef IN
#undef SEAM
}

extern "C" void kernel_launch(void* const* d_in, const int* in_sizes, int n_in, void* d_out, int out_size, void* d_ws, size_t ws_size, hipStream_t stream) {
    static int grid = 0;
    if (grid == 0) {
        if (n_in != 27 || in_sizes[0] != NTOK * DM || out_size != NTOK * DM || ws_size < WS_END) { fprintf(stderr, "kernel_launch: unexpected shapes / workspace (n_in %d, ws %zu)\n", n_in, ws_size); grid = -1; return; }
        int dev = 0, cus = 0, per_cu = 0;
        if (hipGetDevice(&dev) != hipSuccess || hipDeviceGetAttribute(&cus, hipDeviceAttributeMultiprocessorCount, dev) != hipSuccess) { grid = -1; return; }
        if (hipFuncSetAttribute((const void*)mk_fwd, hipFuncAttributeMaxDynamicSharedMemorySize, LDS_BYTES) != hipSuccess) { fprintf(stderr, "kernel_launch: hipFuncSetAttribute failed\n"); grid = -1; return; }
        if (hipOccupancyMaxActiveBlocksPerMultiprocessor(&per_cu, (const void*)mk_fwd, NWAVES * 64, LDS_BYTES) != hipSuccess || per_cu < 1) { fprintf(stderr, "kernel_launch: occupancy query says %d\n", per_cu); }
        (void)hipGetLastError();
        grid = cus;
    }
    if (grid < 0) return;
    if (hipMemsetAsync((char*)d_ws + WS_CTL, 0, CTL_ZERO_BYTES, stream) != hipSuccess) return;
    Args a{};
    for (int i = 0; i < 27; ++i) a.in[i] = (const float*)d_in[i];
    a.out = (float*)d_out; a.ws = (unsigned char*)d_ws;
    if (MK_N_LAUNCHES == 1) { a.ph_lo = 0; a.ph_hi = NPHASE; a.li = 0; hipLaunchKernelGGL(mk_fwd, dim3(grid), dim3(NWAVES * 64), LDS_BYTES, stream, a); }
    else { for (int p = 0; p < NPHASE; ++p) for (int r = 0; r < (int)((PROBE_MASK >> p) & 1u) + 1; ++r) { a.ph_lo = p; a.ph_hi = p + 1; a.li = p; hipLaunchKernelGGL(mk_fwd, dim3(grid), dim3(NWAVES * 64), LDS_BYTES, stream, a); } }
}
```

```cpp
#include <hip/hip_runtime.h>
#include <cstdio>
#include <cstdint>

#ifndef MK_N_LAUNCHES
#define MK_N_LAUNCHES 1
#endif

#ifndef ATTN_VER
#define ATTN_VER 1
#endif
#ifndef PROBE_ATT
#define PROBE_ATT -1
#endif
#ifndef PROBE_MASK
#define PROBE_MASK 0u
#endif
#define REP(k) _Pragma("unroll") for (int rep_ = 0; rep_ < (MK_N_LAUNCHES == 1 ? (int)((PROBE_MASK >> (k)) & 1u) : 0) + 1; ++rep_)
#define GAS __attribute__((address_space(1)))
#define LAS __attribute__((address_space(3)))
typedef unsigned short bf16;
typedef unsigned v4u __attribute__((ext_vector_type(4)));
typedef unsigned v2u __attribute__((ext_vector_type(2)));
typedef float f32x4 __attribute__((ext_vector_type(4)));
typedef float f32x16 __attribute__((ext_vector_type(16)));
typedef short bf16x8 __attribute__((ext_vector_type(8)));
typedef short s16x4 __attribute__((ext_vector_type(4)));

constexpr int NTOK = 32768, DM = 1024, SEQ = 8192, NBATCH = 4;
constexpr int EV_IN = 1792, OD_IN = 3072;
constexpr int NEXP = 32, MOE_H = 512, LIST_CAP = 32768;
constexpr float C2 = 0.125f * 1.4426950408889634f;
constexpr float LOG2E = 1.4426950408889634f;
constexpr float LAM_INIT = 0.35550906759f;

constexpr size_t MiB = 1u << 20;
constexpr size_t WS_CTL = 0, CTL_ZERO_BYTES = 1 * MiB;
constexpr size_t WS_WIN0 = 1 * MiB, WS_WOUT0 = 5 * MiB, WS_WIN1 = 7 * MiB, WS_WOUT1 = 13 * MiB, WS_TBL = 15 * MiB;
constexpr size_t WS_W13 = 16 * MiB, WS_W2 = 80 * MiB;
constexpr size_t WS_HB = 112 * MiB;
constexpr size_t WS_Y = 176 * MiB;
constexpr size_t WS_Z0 = 240 * MiB, WS_QR = 352 * MiB, WS_KR = 384 * MiB;
constexpr size_t WS_Q1 = 240 * MiB, WS_K1 = 304 * MiB, WS_V1 = 368 * MiB, WS_OC1 = 432 * MiB, WS_OC0 = WS_HB;
constexpr size_t WS_H = 176 * MiB, WS_YS = 248 * MiB, WS_LIST = 392 * MiB, WS_TOKEP = 396 * MiB, WS_GATE = 396 * MiB + 512 * 1024;
constexpr size_t WS_END = 496 * MiB;
constexpr int TBL_COS = 0, TBL_SIN = 2048, TBL_BIAS = 4096, BIAS_STRIDE = 272;
constexpr int TBL_WR = 32768, WR_LAYER = 1024 * 48 + 64;
constexpr int CW_BAR = 4096;
constexpr int CW_CNT = 16384;

constexpr int RING_BYTES = 131072;
constexpr int LDSCTL_OFF = RING_BYTES;
constexpr int LDS_BYTES = 147456;
constexpr int LC_BAR = 8;
constexpr int LC_TP = 16;
constexpr int LC_CNT = 64;
constexpr int LC_LCNT = 96;
constexpr int LC_LBASE = 128;

#define LDS_WAIT() asm volatile("s_waitcnt lgkmcnt(0)" ::: "memory")
#define VM_WAIT() asm volatile("s_waitcnt vmcnt(0)" ::: "memory")
#define RLX_AGENT __ATOMIC_RELAXED, __HIP_MEMORY_SCOPE_AGENT

__device__ __forceinline__ unsigned f2bf(float f) { unsigned u = __builtin_bit_cast(unsigned, f); return (u + 0x7fffu + ((u >> 16) & 1u)) >> 16; }
__device__ __forceinline__ unsigned pk2(float lo, float hi) { return f2bf(lo) | (f2bf(hi) << 16); }
__device__ __forceinline__ float bf2f(unsigned short b) { return __builtin_bit_cast(float, (unsigned)b << 16); }
template <int CTRL> __device__ __forceinline__ float dpp_mov(float v) { return __builtin_bit_cast(float, __builtin_amdgcn_update_dpp(0, __builtin_bit_cast(int, v), CTRL, 0xf, 0xf, true)); }
__device__ __forceinline__ float wave_sum(float v) {
    v += dpp_mov<0xB1>(v); v += dpp_mov<0x4E>(v); v += dpp_mov<0x141>(v); v += dpp_mov<0x140>(v);
    { auto rr = __builtin_amdgcn_permlane16_swap(__float_as_uint(v), __float_as_uint(v), false, false); v = __uint_as_float(rr[0]) + __uint_as_float(rr[1]); }
    { auto rr = __builtin_amdgcn_permlane32_swap(__float_as_uint(v), __float_as_uint(v), false, false); v = __uint_as_float(rr[0]) + __uint_as_float(rr[1]); }
    return v;
}

namespace pg8 {
#define PG8_LAS __attribute__((address_space(3)))
typedef unsigned short bf16_t;
typedef short bf16x8 __attribute__((ext_vector_type(8)));
typedef float f32x4 __attribute__((ext_vector_type(4)));
typedef unsigned u32x4 __attribute__((ext_vector_type(4)));
constexpr int BM = 256, BK = 64, HALF = 128, HTB = HALF * BK * 2, STAGE_BYTES = 8 * HTB, NXCD = 8, WGM = 8;

__host__ __device__ __forceinline__ int lds_byte(int r, int c) { const int st = (r >> 4) * 2 + (c >> 5), rr = r & 15, cc = c & 31, ob = rr * 64 + cc * 2; return st * 1024 + (ob ^ (((ob >> 9) & 1) << 5)); }
__host__ __device__ __forceinline__ void stage_rc(int b, int& R, int& C) { const int st = b / 1024, sb = b % 1024, swz = sb ^ (((sb >> 9) & 1) << 5); R = (st >> 1) * 16 + swz / 64; C = (st & 1) * 32 + (swz % 64) / 2; }
__host__ __device__ __forceinline__ int perm32(int rho) { const int n = rho >> 4, i = rho & 15; return 8 * (i >> 2) + 4 * n + (i & 3); }

struct Unit { int pm, pn, e, rb; };
struct Gemm { const bf16_t* A; const bf16_t* Bt; int M, N, K; };

struct StaticOrder {
    int nM, nN, nwg, G, c;
    __device__ void init(int M, int N, int G_, int c_) { nM = M / BM; nN = N / BM; nwg = nM * nN; G = G_; c = c_; }
    __device__ bool next(int i, Unit& u) const {
        const long L = (long)i * G + c; if (L >= nwg) return false;
        int wgid = (int)L; { const int q = nwg / NXCD, r = nwg % NXCD, xcd = wgid % NXCD, off = wgid / NXCD; wgid = (xcd < r ? xcd * (q + 1) : r * (q + 1) + (xcd - r) * q) + off; }
        const int nig = WGM * nN, gid = wgid / nig, fm = gid * WGM, gsz = (nM - fm) < WGM ? (nM - fm) : WGM;
        u.pm = fm + ((wgid % nig) % gsz); u.pn = (wgid % nig) / gsz; u.e = 0; u.rb = 0; return true;
    }
    __device__ __forceinline__ unsigned arow(const Unit& u, int rr) const { return (unsigned)(u.pm * BM + rr); }
};

struct MoeOrder {
    const PG8_LAS int* tp; const PG8_LAS int* cn; const int* list; int G, c, nunits; bool gather;
    __device__ __forceinline__ bool next(int i, Unit& u) const {
        const int L = i * G + c; if (L >= nunits) return false;
        const int rbg = L >> 2, pnl = L & 3; int e = 0;
#pragma unroll
        for (int j = 1; j < 32; ++j) e += (tp[j] <= rbg) ? 1 : 0;
        u.pm = rbg; u.pn = e * 4 + pnl; u.e = e; u.rb = rbg - tp[e]; return true;
    }
    __device__ __forceinline__ unsigned arow(const Unit& u, int rr) const {
        if (!gather) return (unsigned)(u.pm * BM + rr);
        const int idx = u.rb * BM + rr; unsigned t = 0u;
        if (idx < cn[u.e]) t = (unsigned)list[(size_t)u.e * 32768 + idx];
        return t;
    }
};

__device__ __forceinline__ unsigned cvt_pk_bf16(float lo, float hi) { unsigned r; asm volatile("v_cvt_pk_bf16_f32 %0, %1, %2" : "=v"(r) : "v"(lo), "v"(hi)); return r; }

struct EpiBf16 {
    static constexpr bool PERM = true;
    bf16_t* O; int ldc; int split_cols; size_t split_stride; float scale0; int pn_mask;
    __device__ __forceinline__ void operator()(const f32x4 (&acc)[2][2][4][2], const Unit& u, int wr, int wc, int fr, int fq) const {
        const int row0 = u.pm * BM + wr * 64 + fr; int colt = (u.pn & pn_mask) * BM; bf16_t* base = O;
        float sc = 1.f; if (split_cols) { const int t = colt / split_cols; base += (size_t)t * split_stride; colt -= t * split_cols; if (t == 0) sc = scale0; }
        const int col0 = colt + wc * 32 + 8 * fq;
#pragma unroll
        for (int ai = 0; ai < 2; ++ai)
#pragma unroll
            for (int m = 0; m < 4; ++m) { bf16_t* rowp = base + (size_t)(row0 + ai * HALF + m * 16) * ldc + col0;
#pragma unroll
                for (int bj = 0; bj < 2; ++bj) { f32x4 v0 = acc[ai][bj][m][0] * sc, v1 = acc[ai][bj][m][1] * sc;
                    u32x4 w; w.x = cvt_pk_bf16(v0[0], v0[1]); w.y = cvt_pk_bf16(v0[2], v0[3]); w.z = cvt_pk_bf16(v1[0], v1[1]); w.w = cvt_pk_bf16(v1[2], v1[3]);
                    *(u32x4*)(rowp + bj * HALF) = w; } }
    }
};
struct EpiRes {
    static constexpr bool PERM = false;
    const float* base; float* out; int ldc;
    __device__ __forceinline__ void operator()(const f32x4 (&acc)[2][2][4][2], const Unit& u, int wr, int wc, int fr, int fq) const {
        const int row0 = u.pm * BM + wr * 64 + fr, col0 = u.pn * BM + wc * 32 + 4 * fq;
#pragma unroll
        for (int ai = 0; ai < 2; ++ai)
#pragma unroll
            for (int m = 0; m < 4; ++m) { const size_t off = (size_t)(row0 + ai * HALF + m * 16) * ldc + col0;
#pragma unroll
                for (int bj = 0; bj < 2; ++bj)
#pragma unroll
                    for (int n = 0; n < 2; ++n) { const f32x4 bs = *(const f32x4*)(base + off + bj * HALF + n * 16); *(f32x4*)(out + off + bj * HALF + n * 16) = bs + acc[ai][bj][m][n]; } }
    }
};
__device__ __forceinline__ float silu_mul(float a, float b) { return a * b * __builtin_amdgcn_rcpf(1.0f + __builtin_amdgcn_exp2f(-a * 1.4426950408889634f)); }
struct EpiSwiglu {
    static constexpr bool PERM = true;
    bf16_t* O;
    __device__ __forceinline__ void operator()(const f32x4 (&acc)[2][2][4][2], const Unit& u, int wr, int wc, int fr, int fq) const {
        const int row0 = u.pm * BM + wr * 64 + fr, col0 = (u.pn & 3) * 128 + wc * 32 + 8 * fq;
#pragma unroll
        for (int ai = 0; ai < 2; ++ai)
#pragma unroll
            for (int m = 0; m < 4; ++m) { bf16_t* rowp = O + (size_t)(row0 + ai * HALF + m * 16) * 512 + col0;
                const f32x4 a0 = acc[ai][0][m][0], a1 = acc[ai][0][m][1], b0 = acc[ai][1][m][0], b1 = acc[ai][1][m][1];
                u32x4 w; w.x = cvt_pk_bf16(silu_mul(a0[0], b0[0]), silu_mul(a0[1], b0[1])); w.y = cvt_pk_bf16(silu_mul(a0[2], b0[2]), silu_mul(a0[3], b0[3]));
                w.z = cvt_pk_bf16(silu_mul(a1[0], b1[0]), silu_mul(a1[1], b1[1])); w.w = cvt_pk_bf16(silu_mul(a1[2], b1[2]), silu_mul(a1[3], b1[3]));
                *(u32x4*)rowp = w; }
    }
};

template <class Epi, class Sched, bool ALIGN_EPI>
__device__ __forceinline__ void gemm_phase(PG8_LAS unsigned char* lds, const Gemm g, const Sched& S, const Epi& E) {
    const int tid = threadIdx.x, wid = __builtin_amdgcn_readfirstlane(tid >> 6), lane = tid & 63, wr = wid >> 2, wc = wid & 3, fr = lane & 15, fq = lane >> 4;
    const int K = g.K, nt = K / BK;
    int RA[2], CA[2]; unsigned voffB[2];
#pragma unroll
    for (int i = 0; i < 2; ++i) { int R, C; stage_rc(tid * 16 + i * 8192, R, C); RA[i] = R; CA[i] = C; const int Rb = Epi::PERM ? ((R & ~31) + perm32(R & 31)) : R; voffB[i] = (unsigned)(Rb * K + C) * 2u; }
    const size_t kstep = (size_t)(BK * 2);
    const size_t hstep = (size_t)HALF * K * 2;
    const size_t tstep = 2 * hstep;
    const unsigned ldsw = (unsigned)wid * 1024u;
    const int aoff = lds_byte(wr * 64 + fr, fq * 8), boff = lds_byte(wc * 32 + fr, fq * 8);
#define PG8_SA(b, h) (((b) * 2 + (h)) * HTB)
#define PG8_SB(b, h) ((4 + (b) * 2 + (h)) * HTB)
#define PG8_STAGE(bufoff, gbase, voff) do { _Pragma("unroll") for (int _i = 0; _i < 2; ++_i) \
        __builtin_amdgcn_global_load_lds((const unsigned*)((const char*)(gbase) + (voff)[_i]), (PG8_LAS unsigned*)(lds + (bufoff) + ldsw + _i * 8192), 16, 0, 0); } while (0)
#define PG8_LDA(dst, b, h) do { _Pragma("unroll") for (int m = 0; m < 4; ++m) _Pragma("unroll") for (int k = 0; k < 2; ++k) dst[m][k] = *(const PG8_LAS bf16x8*)(lds + PG8_SA(b, h) + aoff + m * 2048 + k * 1024); } while (0)
#define PG8_LDB(dst, b, h) do { _Pragma("unroll") for (int n = 0; n < 2; ++n) _Pragma("unroll") for (int k = 0; k < 2; ++k) dst[n][k] = *(const PG8_LAS bf16x8*)(lds + PG8_SB(b, h) + boff + n * 2048 + k * 1024); } while (0)
#define PG8_MMA(ai, bj, At, Bt) do { __builtin_amdgcn_s_setprio(1); _Pragma("unroll") for (int m = 0; m < 4; ++m) _Pragma("unroll") for (int n = 0; n < 2; ++n) _Pragma("unroll") for (int k = 0; k < 2; ++k) \
        acc[ai][bj][m][n] = __builtin_amdgcn_mfma_f32_16x16x32_bf16(Bt[n][k], At[m][k], acc[ai][bj][m][n], 0, 0, 0); __builtin_amdgcn_s_setprio(0); } while (0)
#define PG8_WAIT_V(n) asm volatile("s_waitcnt vmcnt(" #n ")" ::: "memory")
#define PG8_WAIT_L(n) asm volatile("s_waitcnt lgkmcnt(" #n ")" ::: "memory")
#define PG8_BAR __builtin_amdgcn_s_barrier()
#define PG8_SCHED __builtin_amdgcn_sched_barrier(0)
#define PG8_AOFF(dst, u) do { _Pragma("unroll") for (int _h = 0; _h < 2; ++_h) _Pragma("unroll") for (int _i = 0; _i < 2; ++_i) dst[_h][_i] = (S.arow(u, _h * HALF + RA[_i]) * (unsigned)K + (unsigned)CA[_i]) * 2u; } while (0)
    Unit cur, nxt; int ui = 0;
    if (!S.next(0, cur)) return;
    f32x4 acc[2][2][4][2];
#pragma unroll
    for (int a = 0; a < 2; ++a)
#pragma unroll
        for (int b = 0; b < 2; ++b)
#pragma unroll
            for (int m = 0; m < 4; ++m)
#pragma unroll
                for (int n = 0; n < 2; ++n) acc[a][b][m][n] = (f32x4){0.f, 0.f, 0.f, 0.f};
    bf16x8 At[4][2], B0[2][2], B1[2][2];
    unsigned offc[2][2], offn[2][2];
    PG8_AOFF(offc, cur);
    const char* const cA = (const char*)g.A; const char* cB = (const char*)g.Bt + (size_t)cur.pn * tstep;
    PG8_STAGE(PG8_SB(0, 0), cB, voffB); PG8_STAGE(PG8_SB(0, 1), cB + hstep, voffB); PG8_STAGE(PG8_SA(0, 0), cA, offc[0]); PG8_STAGE(PG8_SA(0, 1), cA, offc[1]);
    if (wr == 1) PG8_BAR;
    PG8_WAIT_V(2); PG8_BAR;
    PG8_STAGE(PG8_SB(1, 0), cB + kstep, voffB); PG8_STAGE(PG8_SA(1, 0), cA + kstep, offc[0]); PG8_STAGE(PG8_SB(1, 1), cB + hstep + kstep, voffB);
    PG8_WAIT_V(6); PG8_BAR;
    for (;;) {
        const bool has_next = S.next(ui + 1, nxt);
        if (has_next) { PG8_AOFF(offn, nxt); }
        else {
#pragma unroll
            for (int h = 0; h < 2; ++h)
#pragma unroll
                for (int i = 0; i < 2; ++i) offn[h][i] = offc[h][i]; }
        const char* nB = has_next ? (const char*)g.Bt + (size_t)nxt.pn * tstep : cB;
        for (int t = 0; t < nt; t += 2) {
            const bool last = (t == nt - 2);
            const char* a1 = cA + (size_t)(t + 1) * kstep;
            const char* a2 = last ? cA : cA + (size_t)(t + 2) * kstep; const char* b2 = last ? nB : cB + (size_t)(t + 2) * kstep;
            const char* a3 = a2 + kstep; const char* b3 = b2 + kstep;
            unsigned o2[2][2];
#pragma unroll
            for (int h = 0; h < 2; ++h)
#pragma unroll
                for (int i = 0; i < 2; ++i) o2[h][i] = last ? offn[h][i] : offc[h][i];
            PG8_LDB(B0, 0, 0); PG8_LDB(B1, 0, 1); PG8_SCHED; PG8_LDA(At, 0, 0); PG8_STAGE(PG8_SA(1, 1), a1, offc[1]);
            PG8_WAIT_V(8); PG8_WAIT_L(0); PG8_BAR; PG8_MMA(0, 0, At, B0); PG8_MMA(0, 1, At, B1); PG8_BAR; PG8_SCHED;
            PG8_LDA(At, 0, 1); PG8_STAGE(PG8_SB(0, 0), b2, voffB); PG8_STAGE(PG8_SB(0, 1), b2 + hstep, voffB); PG8_STAGE(PG8_SA(0, 0), a2, o2[0]);
            PG8_WAIT_V(8); PG8_WAIT_L(0); PG8_BAR; PG8_MMA(1, 0, At, B0); PG8_MMA(1, 1, At, B1); PG8_BAR; PG8_SCHED;
            PG8_LDB(B0, 1, 0); PG8_LDB(B1, 1, 1); PG8_SCHED; PG8_LDA(At, 1, 0); PG8_STAGE(PG8_SA(0, 1), a2, o2[1]);
            PG8_WAIT_V(8); PG8_WAIT_L(0); PG8_BAR; PG8_MMA(0, 0, At, B0); PG8_MMA(0, 1, At, B1); PG8_BAR; PG8_SCHED;
            PG8_LDA(At, 1, 1); PG8_STAGE(PG8_SB(1, 0), b3, voffB); PG8_STAGE(PG8_SB(1, 1), b3 + hstep, voffB); PG8_STAGE(PG8_SA(1, 0), a3, o2[0]);
            PG8_WAIT_V(8); PG8_WAIT_L(0); PG8_BAR; PG8_MMA(1, 0, At, B0); PG8_MMA(1, 1, At, B1); PG8_BAR; PG8_SCHED;
        }
        if constexpr (ALIGN_EPI) { if (wr == 0) PG8_BAR; }
        E(acc, cur, wr, wc, fr, fq);
        if (!has_next) break;
#pragma unroll
        for (int a = 0; a < 2; ++a)
#pragma unroll
            for (int b = 0; b < 2; ++b)
#pragma unroll
                for (int m = 0; m < 4; ++m)
#pragma unroll
                    for (int n = 0; n < 2; ++n) acc[a][b][m][n] = (f32x4){0.f, 0.f, 0.f, 0.f};
        cur = nxt; cB = nB; ++ui;
#pragma unroll
        for (int h = 0; h < 2; ++h)
#pragma unroll
            for (int i = 0; i < 2; ++i) offc[h][i] = offn[h][i];
        if constexpr (ALIGN_EPI) { if (wr == 1) PG8_BAR; }
    }
    PG8_WAIT_V(0);
    if constexpr (!ALIGN_EPI) { if (wr == 0) PG8_BAR; }
    PG8_BAR;
#undef PG8_SA
#undef PG8_SB
#undef PG8_STAGE
#undef PG8_LDA
#undef PG8_LDB
#undef PG8_MMA
#undef PG8_WAIT_V
#undef PG8_WAIT_L
#undef PG8_BAR
#undef PG8_SCHED
#undef PG8_AOFF
}
}

#define XB_TMO      128
#define XB_XCNT(j)  (256  + 64 * (j))
#define XB_XSUB(j)  (1280 + 64 * (j))
#define XB_XGEN(j)  (2304 + 64 * (j))
#define XB_TOP      3328
#define XB_TOPGEN   3392
#define XCD_BAR_WORDS 3456
#define XB_SPIN_CAP (1u << 18)

__device__ __forceinline__ unsigned xb_ld(unsigned* p)              { return __hip_atomic_load(p, __ATOMIC_RELAXED, __HIP_MEMORY_SCOPE_AGENT); }
__device__ __forceinline__ unsigned xb_add(unsigned* p, unsigned v) { return __hip_atomic_fetch_add(p, v, __ATOMIC_RELAXED, __HIP_MEMORY_SCOPE_AGENT); }
__device__ __forceinline__ unsigned xb_xcc_id() { return (unsigned)__builtin_amdgcn_s_getreg((3 << 11) | 20) & 0xFu; }
#define XB_SPIN(cond, bar) do { unsigned _sp = 0; while (cond) { __builtin_amdgcn_s_sleep(1); \
    if ((++_sp & 255u) == 0u) { if (xb_ld(&(bar)[XB_TMO])) break; if (_sp > XB_SPIN_CAP) { atomicAdd(&(bar)[XB_TMO], 1u); break; } } } } while (0)

struct XcdBarrier { unsigned* bar; unsigned x; volatile LAS unsigned* st; };

__device__ __forceinline__ XcdBarrier xcd_barrier_post(unsigned* bar, volatile LAS unsigned* st) {
    XcdBarrier b; b.bar = bar; b.x = xb_xcc_id(); b.st = st;
    if (threadIdx.x == 0) (void)xb_add(&bar[XB_XCNT(b.x)], 1u);
    return b;
}
__device__ __forceinline__ void xcd_barrier_complete(unsigned* bar, unsigned x, unsigned& nloc, unsigned& nx) {
    const unsigned G = gridDim.x * gridDim.y * gridDim.z;
    unsigned sum, cnt, mine, sp = 0u;
    for (;;) {
        sum = 0u; cnt = 0u; mine = 0u;
#pragma unroll
        for (unsigned j = 0; j < 16; ++j) { const unsigned c = xb_ld(&bar[XB_XCNT(j)]); sum += c; cnt += (c > 0u) ? 1u : 0u; mine = (j == x) ? c : mine; }
        if (sum == G) break;
        __builtin_amdgcn_s_sleep(1);
        if ((++sp & 255u) == 0u) { if (xb_ld(&bar[XB_TMO])) break; if (sp > XB_SPIN_CAP) { atomicAdd(&bar[XB_TMO], 1u); break; } }
    }
    nloc = mine > 0u ? mine : 1u; nx = cnt > 0u ? cnt : 1u;
}
__device__ __forceinline__ void xcd_barrier(const XcdBarrier& b) {
    asm volatile("s_waitcnt vmcnt(0)" ::: "memory");
    __syncthreads();
    if (threadIdx.x == 0) {
        unsigned* bar = b.bar;
        __builtin_amdgcn_s_waitcnt(0);
        unsigned nloc = b.st[0], nx = b.st[1];
        if (nloc == 0u) { xcd_barrier_complete(bar, b.x, nloc, nx); b.st[0] = nloc; b.st[1] = nx; }
        const unsigned old = xb_add(&bar[XB_XSUB(b.x)], 1u);
        const unsigned gen = old / nloc;
        if (old + 1u == (gen + 1u) * nloc) {
            __builtin_amdgcn_fence(__ATOMIC_RELEASE, "agent");
            asm volatile("s_waitcnt vmcnt(0)" ::: "memory");
            const unsigned og = xb_add(&bar[XB_TOP], 1u);
            const unsigned tg = og / nx;
            if (og + 1u == (tg + 1u) * nx) xb_add(&bar[XB_TOPGEN], 1u);
            else XB_SPIN(xb_ld(&bar[XB_TOPGEN]) == tg, bar);
            __builtin_amdgcn_fence(__ATOMIC_ACQUIRE, "agent");
            xb_add(&bar[XB_XGEN(b.x)], 1u);
            asm volatile("s_waitcnt vmcnt(0)" ::: "memory");
        } else {
            XB_SPIN(xb_ld(&bar[XB_XGEN(b.x)]) == gen, bar);
            __builtin_amdgcn_fence(__ATOMIC_ACQUIRE, "agent");
            asm volatile("s_waitcnt vmcnt(0)" ::: "memory");
        }
    }
    __syncthreads();
}

__device__ __forceinline__ void transpose_item(const float* W, int K, int N, bf16* WT, int kb, int nb, int dst_row0, LAS float* scr, int lane) {
    const int k0 = 64 * kb, n0 = 32 * nb;
#pragma unroll 8
    for (int i = 0; i < 32; ++i) { const int kk = 2 * i + (lane >> 5); scr[kk * 33 + (lane & 31)] = W[(size_t)(k0 + kk) * N + n0 + (lane & 31)]; }
    LDS_WAIT(); asm volatile("" ::: "memory");
    const int c = lane & 7;
#pragma unroll
    for (int j = 0; j < 4; ++j) { const int n = (lane >> 3) + 8 * j; const LAS float* s = scr + (8 * c) * 33 + n;
        v4u o; o.x = pk2(s[0 * 33], s[1 * 33]); o.y = pk2(s[2 * 33], s[3 * 33]); o.z = pk2(s[4 * 33], s[5 * 33]); o.w = pk2(s[6 * 33], s[7 * 33]);
        *(GAS v4u*)(WT + (size_t)(dst_row0 + n) * K + k0 + 8 * c) = o; }
    LDS_WAIT(); asm volatile("" ::: "memory");
}
__device__ __forceinline__ void transpose_plain(const float* W, int K, int N, bf16* WT, LAS float* scr, int gw, int ngw, int lane) {
    const int nblk = N / 32, nitems = (K / 64) * nblk;
    for (int it = gw; it < nitems; it += ngw) { const int kb = it / nblk, nb = it % nblk; transpose_item(W, K, N, WT, kb, nb, 32 * nb, scr, lane); }
}
__device__ __forceinline__ void transpose_moe(const float* w1, const float* w3, const float* w2, bf16* W13T, bf16* W2T, LAS float* scr, int gw, int ngw, int lane) {
    constexpr int I13 = 16 * 16, I2 = 8 * 32, IPE = 2 * I13 + I2;
    for (int it = gw; it < NEXP * IPE; it += ngw) {
        const int e = it / IPE; int r = it % IPE;
        if (r < 2 * I13) { const int which = r / I13; r %= I13; const int kb = r / 16, nb = r % 16, n0 = 32 * nb;
            const float* W = (which ? w3 : w1) + (size_t)e * 1024 * 512;
            transpose_item(W, 1024, 512, W13T + (size_t)e * 1024 * 1024, kb, nb, (n0 >> 7) * 256 + which * 128 + (n0 & 127), scr, lane);
        } else { r -= 2 * I13; const int kb = r / 32, nb = r % 32;
            transpose_item(w2 + (size_t)e * 512 * 1024, 512, 1024, W2T + (size_t)e * 1024 * 512, kb, nb, 32 * nb, scr, lane); }
    }
}
__device__ __forceinline__ void rms_row(const float* xrow, const float* g, f32x4 (&v)[4], int lane) {
    const GAS f32x4* xr = (const GAS f32x4*)xrow + lane; const GAS f32x4* gr = (const GAS f32x4*)g + lane;
    float s = 0.f;
#pragma unroll
    for (int j = 0; j < 4; ++j) { v[j] = xr[64 * j]; s += (v[j].x * v[j].x + v[j].y * v[j].y) + (v[j].z * v[j].z + v[j].w * v[j].w); }
    const float rstd = 1.0f / sqrtf(wave_sum(s) * (1.f / DM) + 1e-6f);
#pragma unroll
    for (int j = 0; j < 4; ++j) { const f32x4 gg = gr[64 * j]; v[j] = v[j] * rstd * gg; }
}
__device__ __forceinline__ void store_row_bf16(bf16* orow, const f32x4 (&v)[4], int lane) {
    GAS unsigned long long* o8 = (GAS unsigned long long*)orow + lane;
#pragma unroll
    for (int j = 0; j < 4; ++j) o8[64 * j] = (unsigned long long)pk2(v[j].x, v[j].y) | ((unsigned long long)pk2(v[j].z, v[j].w) << 32);
}

__device__ __forceinline__ int t5_bucket(int rel) {
    const int n = rel < 0 ? -rel : rel; int ret = rel > 0 ? 16 : 0;
    int v;
    if (n < 8) v = n;
    else { const float nf = (float)n; int large = 8 + (int)(logf(nf / 8.0f) / 2.772588722239781f * 8.0f); v = large < 15 ? large : 15; }
    return ret + v;
}

__device__ __forceinline__ int crow(int r, int hi) { return (r & 3) + 8 * (r >> 2) + 4 * hi; }
__device__ __forceinline__ unsigned cvtpk(float lo, float hi) { unsigned r; asm volatile("v_cvt_pk_bf16_f32 %0, %1, %2" : "=v"(r) : "v"(lo), "v"(hi)); return r; }
__device__ __forceinline__ s16x4 vtr(const LAS char* p) { typedef short v4i16_t __attribute__((ext_vector_type(4))); return __builtin_bit_cast(s16x4, __builtin_amdgcn_ds_read_tr16_b64_v4i16((LAS v4i16_t*)p)); }

template <int DV, bool BIAS>
__device__ __forceinline__ void attn_unit_v0(const bf16* Qp, int ldq, const bf16* Kp, int ldk, const bf16* Vp, int ldv, bf16* Op, int ldo, const LAS float* btbl, int q0, LAS unsigned char* lds) {
    const int tid = threadIdx.x, lane = tid & 63, r32 = lane & 31, hi = lane >> 5; const int wid = __builtin_amdgcn_readfirstlane(tid >> 6);
    constexpr int ND = DV / 32;
    LAS unsigned char* ldsK = lds; LAS unsigned char* ldsV = lds + 8192; LAS float* wsf = (LAS float*)(lds + 8192 + DV * 128) + wid * 64;
    bf16x8 qr[4];
#pragma unroll
    for (int d0 = 0; d0 < 4; ++d0) qr[d0] = *(const bf16x8*)(Qp + (size_t)(wid * 32 + r32) * ldq + d0 * 16 + hi * 8);
    f32x16 o[ND];
#pragma unroll
    for (int d = 0; d < ND; ++d)
#pragma unroll
        for (int r = 0; r < 16; ++r) o[d][r] = 0.f;
    float l = 0.f;
    const int qpos = q0 + wid * 32 + r32;
    const LAS char* kp0 = (const LAS char*)ldsK + hi * 1024 + r32 * 16;
    const LAS char* vp0 = (const LAS char*)ldsV + ((lane >> 4) & 1) * 32 + (lane & 3) * 8 + (4 * hi + ((lane & 15) >> 2)) * 64;
    for (int t = 0; t < SEQ / 64; ++t) {
        __syncthreads();
        {
            const v4u kv = *(const v4u*)(Kp + (size_t)(t * 64 + lane) * ldk + wid * 8);
            *(LAS v4u*)(ldsK + wid * 1024 + lane * 16) = kv;
#pragma unroll
            for (int pp = 0; pp < ND / 2; ++pp) { const int p = wid + 8 * pp, dq = p >> 2, rg = p & 3;
                const v4u vv = *(const v4u*)(Vp + (size_t)(t * 64 + 16 * rg + (lane >> 2)) * ldv + dq * 32 + (lane & 3) * 8);
                *(LAS v4u*)(ldsV + p * 1024 + lane * 16) = vv; }
        }
        __syncthreads();
        f32x16 p0, p1;
#pragma unroll
        for (int r = 0; r < 16; ++r) { p0[r] = 0.f; p1[r] = 0.f; }
#pragma unroll
        for (int d0 = 0; d0 < 4; ++d0) {
            const bf16x8 b0 = *(const LAS bf16x8*)(kp0 + d0 * 2048), b1 = *(const LAS bf16x8*)(kp0 + d0 * 2048 + 512);
            p0 = __builtin_amdgcn_mfma_f32_32x32x16_bf16(b0, qr[d0], p0, 0, 0, 0);
            p1 = __builtin_amdgcn_mfma_f32_32x32x16_bf16(b1, qr[d0], p1, 0, 0, 0);
        }
        if (BIAS) {
            const int base = t * 64 + 4 * hi - qpos;
#pragma unroll
            for (int r = 0; r < 16; ++r) { int rel = base + (r & 3) + 8 * (r >> 2);
                int i0 = rel < -128 ? -128 : (rel > 128 ? 128 : rel); int rel1 = rel + 32; int i1 = rel1 < -128 ? -128 : (rel1 > 128 ? 128 : rel1);
                p0[r] += btbl[i0 + 128]; p1[r] += btbl[i1 + 128]; }
        }
        float sacc = 0.f;
#pragma unroll
        for (int r = 0; r < 16; ++r) { p0[r] = __builtin_amdgcn_exp2f(p0[r]); p1[r] = __builtin_amdgcn_exp2f(p1[r]); sacc += p0[r] + p1[r]; }
        l += sacc;
        v4u pw[4];
#pragma unroll
        for (int k = 0; k < 2; ++k) {
            pw[k]     = (v4u){cvtpk(p0[8 * k + 0], p0[8 * k + 1]), cvtpk(p0[8 * k + 2], p0[8 * k + 3]), cvtpk(p0[8 * k + 4], p0[8 * k + 5]), cvtpk(p0[8 * k + 6], p0[8 * k + 7])};
            pw[2 + k] = (v4u){cvtpk(p1[8 * k + 0], p1[8 * k + 1]), cvtpk(p1[8 * k + 2], p1[8 * k + 3]), cvtpk(p1[8 * k + 4], p1[8 * k + 5]), cvtpk(p1[8 * k + 6], p1[8 * k + 7])};
        }
#pragma unroll
        for (int d0 = 0; d0 < ND; ++d0)
#pragma unroll
            for (int ks = 0; ks < 4; ++ks) {
                const s16x4 lo = vtr(vp0 + d0 * 4096 + ks * 1024), hh = vtr(vp0 + d0 * 4096 + ks * 1024 + 512);
                const bf16x8 vf = (bf16x8){lo[0], lo[1], lo[2], lo[3], hh[0], hh[1], hh[2], hh[3]};
                o[d0] = __builtin_amdgcn_mfma_f32_32x32x16_bf16(__builtin_bit_cast(bf16x8, pw[ks]), vf, o[d0], 0, 0, 0);
            }
    }
    l += __shfl_xor(l, 32);
    if (hi == 0) wsf[r32] = l;
    LDS_WAIT(); asm volatile("" ::: "memory");
#pragma unroll
    for (int r = 0; r < 16; ++r) { const int row = crow(r, hi); const float rl = 1.0f / wsf[row];
#pragma unroll
        for (int d0 = 0; d0 < ND; ++d0) Op[(size_t)(wid * 32 + row) * ldo + d0 * 32 + r32] = (bf16)f2bf(o[d0][r] * rl); }
    LDS_WAIT();
}

namespace at1 {
#define SBAR() __builtin_amdgcn_sched_barrier(0)
#define PIN(x) asm volatile("" : "+v"(x))
template <int N, bool NOBAR = false> __device__ __forceinline__ void wait_bar() { if (NOBAR) asm volatile("s_waitcnt vmcnt(%0) lgkmcnt(0)" :: "n"(N) : "memory"); else asm volatile("s_waitcnt vmcnt(%0) lgkmcnt(0)\n\ts_barrier" :: "n"(N) : "memory"); }
__device__ __forceinline__ void glds16(const void* gsrc, unsigned lds_dst) { unsigned keep;
    asm volatile("s_mov_b32 %0, m0\n\ts_mov_b32 m0, %2\n\ts_nop 0\n\tglobal_load_lds_dwordx4 %1, off\n\ts_mov_b32 m0, %0" : "=&s"(keep) : "v"(gsrc), "s"(lds_dst) : "memory"); }
typedef float f32x2_t __attribute__((ext_vector_type(2))); typedef __bf16 bf16x2_t __attribute__((ext_vector_type(2)));
__device__ __forceinline__ unsigned cvtpk_s(float lo, float hi) { f32x2_t v = {lo, hi}; bf16x2_t b = __builtin_convertvector(v, bf16x2_t); return __builtin_bit_cast(unsigned, b); }
typedef const LAS char* lds_cptr;
__device__ __forceinline__ void kload2(bf16x8* kf, lds_cptr kp, int j) { kf[2 * j] = *(const LAS bf16x8*)(kp + j * 2048); kf[2 * j + 1] = *(const LAS bf16x8*)(kp + j * 2048 + 512); }

template <int DV, bool BIAS, int TEST = 0>
__device__ __forceinline__ void attn_unit(const bf16* Qp, int ldq, const bf16* __restrict__ Kp, int ldk, const bf16* __restrict__ Vp, int ldv, bf16* Op, int ldo, int q0, LAS unsigned char* lds) {
    constexpr int ND = DV / 32, NV = ND / 2, VSLOT = DV * 128, KSLOT = 8192, NT = SEQ / 64;
    constexpr int LDS_K = 0, LDS_V = 3 * KSLOT, LDS_WS = LDS_V + 3 * VSLOT, LDS_TBL = LDS_WS + 2048;
    const int tid = threadIdx.x, lane = tid & 63, r32 = lane & 31, hi = lane >> 5; const int wid = __builtin_amdgcn_readfirstlane(tid >> 6);
    const unsigned lds0 = (unsigned)(uintptr_t)lds;
    LAS float* wsf = (LAS float*)(lds + LDS_WS) + wid * 64;
    const LAS float* btbl = (const LAS float*)(lds + LDS_TBL);
    const bf16* ksrc = Kp + (size_t)lane * ldk + wid * 8;
    const bf16* vsrc0 = Vp + (size_t)(16 * (wid & 3) + (lane >> 2)) * ldv + (wid >> 2) * 32 + (lane & 3) * 8;
    const bf16* vsrc1 = vsrc0 + 64;
    const unsigned kdst = lds0 + LDS_K + wid * 1024, vdst = lds0 + LDS_V + wid * 1024;
#define DMA_K(t, s) if (!(TEST & 8)) glds16(ksrc + (size_t)(t) * 64 * ldk, (unsigned)__builtin_amdgcn_readfirstlane(kdst + (s) * KSLOT))
#define DMA_V(t, s) do { if (TEST & 8) break; glds16(vsrc0 + (size_t)(t) * 64 * ldv, (unsigned)__builtin_amdgcn_readfirstlane(vdst + (s) * VSLOT)); \
        if (NV == 2) glds16(vsrc1 + (size_t)(t) * 64 * ldv, (unsigned)__builtin_amdgcn_readfirstlane(vdst + (s) * VSLOT + 8192)); } while (0)
    const lds_cptr kp0 = (lds_cptr)lds + LDS_K + hi * 1024 + r32 * 16;
    const lds_cptr vp0 = (lds_cptr)lds + LDS_V + ((lane >> 4) & 1) * 32 + (lane & 3) * 8 + (4 * hi + ((lane & 15) >> 2)) * 64;
    DMA_K(0, 0); DMA_V(0, 0); DMA_K(1, 1);
    bf16x8 qr[4];
#pragma unroll
    for (int d0 = 0; d0 < 4; ++d0) qr[d0] = *(const bf16x8*)(Qp + (size_t)(wid * 32 + r32) * ldq + d0 * 16 + hi * 8);
    float l_reg = 0.f; f32x16 o[ND];
#pragma unroll
    for (int d = 0; d < ND; ++d) o[d] = f32x16{};
    const f32x16 zero16 = f32x16{};
    const int qw = q0 + wid * 32, qpos = qw + r32;
    int tl = 0, tr = NT; float fL = 1.f;
    if (BIAS) { tl = (qw - 191 >= 0) ? ((qw - 191) >> 6) + 1 : 0; tr = (qw + 158) >> 6; fL = __builtin_amdgcn_exp2f(btbl[0]); }
    f32x16 pA0, pA1, pB0, pB1; bf16x8 kf[8]; s16x4 vlo[8], vhi[8]; v4u pw0, pw1, pw2, pw3;
    if (TEST & 32) { pB0 = f32x16{}; pB1 = f32x16{}; }
    if (TEST & 64) { _Pragma("unroll") for (int i_ = 0; i_ < 8; ++i_) { vlo[i_] = (s16x4){1, 2, 3, 4}; vhi[i_] = (s16x4){4, 3, 2, 1}; } }
    int s_prev = 0, s_cur = 0, s_next = 1;
#define ROT() do { s_prev = s_cur; s_cur = s_next; s_next = (s_next == 2) ? 0 : s_next + 1; } while (0)
#define ADD_BIAS(C0, C1, t) do { if (BIAS && (t) >= tl && (t) <= tr) { const int base_ = (t) * 64 + 4 * hi - qpos; \
        _Pragma("unroll") for (int r = 0; r < 16; ++r) { const int rel0 = base_ + (r & 3) + 8 * (r >> 2); const int rel1 = rel0 + 32; \
            const int i0 = (rel0 < -128 ? -128 : (rel0 > 128 ? 128 : rel0)) + 128, i1 = (rel1 < -128 ? -128 : (rel1 > 128 ? 128 : rel1)) + 128; \
            C0[r] += btbl[i0]; C1[r] += btbl[i1]; } } } while (0)
    DMA_K(2, 2);
    wait_bar<NV + 2, (TEST & 16) != 0>();
    {
#pragma unroll
        for (int j = 0; j < 4; ++j) kload2(kf, kp0, j);
        pA0 = __builtin_amdgcn_mfma_f32_32x32x16_bf16(kf[0], qr[0], zero16, 0, 0, 0); pA1 = __builtin_amdgcn_mfma_f32_32x32x16_bf16(kf[1], qr[0], zero16, 0, 0, 0);
#pragma unroll
        for (int d0 = 1; d0 < 4; ++d0) { pA0 = __builtin_amdgcn_mfma_f32_32x32x16_bf16(kf[2 * d0], qr[d0], pA0, 0, 0, 0); pA1 = __builtin_amdgcn_mfma_f32_32x32x16_bf16(kf[2 * d0 + 1], qr[d0], pA1, 0, 0, 0); }
        ADD_BIAS(pA0, pA1, 0);
#pragma unroll
        for (int r = 0; r < 16; ++r) { pA0[r] = __builtin_amdgcn_exp2f(pA0[r]); pA1[r] = __builtin_amdgcn_exp2f(pA1[r]); }
    }
    wait_bar<0, (TEST & 16) != 0>();
    DMA_K(3, 0); DMA_V(1, 1);
    ROT();
#pragma unroll
    for (int j = 0; j < 4; ++j) kload2(kf, kp0 + s_cur * KSLOT, j);
    wait_bar<1 + NV, (TEST & 16) != 0>();
#define PKW(P, B) ((TEST & 256) ? 0x3f803f80u : cvtpk_s(P[B], P[B + 1]))
#define PAF(k) __builtin_bit_cast(bf16x8, pw##k)
#define VFR(i) (bf16x8){vlo[i][0], vlo[i][1], vlo[i][2], vlo[i][3], vhi[i][0], vhi[i][1], vhi[i][2], vhi[i][3]}
#define MF(a, b, c) __builtin_amdgcn_mfma_f32_32x32x16_bf16(a, b, c, 0, 0, 0)
#define GAPA(MFS, A0, A1, A2, A3, W0, W1, PW) do { if (!(TEST & 32)) { MFS; } if (!(TEST & 2)) { sacc += A0; sacc += A1; sacc += A2; sacc += A3; PIN(sacc); } W0; W1; PIN(PW); SBAR(); } while (0)
#define EX(v) ((TEST & 1) ? (v) : __builtin_amdgcn_exp2f(v))
#define GAPB4(MFS, X, B) do { if (!(TEST & 4)) { MFS; } X[B] = EX(X[B]); X[B + 1] = EX(X[B + 1]); X[B + 2] = EX(X[B + 2]); X[B + 3] = EX(X[B + 3]); PIN(X); SBAR(); } while (0)
#define GAPB2(MFS, X, B) do { if (!(TEST & 4)) { MFS; } X[B] = EX(X[B]); X[B + 1] = EX(X[B + 1]); PIN(X); SBAR(); } while (0)
#define VRD(f, s) do { if (TEST & 64) break; vlo[s] = vtr(vp_ + (((f) >> 2) * 4096 + ((f) & 3) * 1024)); vhi[s] = vtr(vp_ + (((f) >> 2) * 4096 + ((f) & 3) * 1024 + 512)); } while (0)
#define KRD(G, j) do { if ((G) && !(TEST & 128)) { kload2(kf, kp0 + s_next * KSLOT, j); SBAR(); } } while (0)
#define FO(m) (ND == 2 ? (((m) >> 1) + 4 * ((m) & 1)) : ((((m) & 7) >> 2) + 2 * ((m) >> 3) + 4 * ((m) & 3)))
#define STEP(C0, C1, P0, P1, t, GK, GV, GL) do { SBAR(); \
    const lds_cptr vp_ = vp0 + s_prev * VSLOT; \
    VRD(FO(0), 0); SBAR(); float sacc = (P0[0] + P0[1]); \
    GAPA(C0 = MF(kf[0], qr[0], zero16), P0[2], P0[3], P0[4], P0[5],     pw0[0] = PKW(P0, 0), pw0[1] = PKW(P0, 2), pw0); \
    VRD(FO(1), 1); SBAR(); GAPA(C1 = MF(kf[1], qr[0], zero16), P0[6], P0[7], P0[8], P0[9],     pw0[2] = PKW(P0, 4), pw0[3] = PKW(P0, 6), pw0); \
    VRD(FO(2), 2); SBAR(); GAPA(C0 = MF(kf[2], qr[1], C0),   P0[10], P0[11], P0[12], P0[13], pw1[0] = PKW(P0, 8), pw1[1] = PKW(P0, 10), pw1); \
    VRD(FO(3), 3); SBAR(); GAPA(C1 = MF(kf[3], qr[1], C1),   P0[14], P0[15], P1[0], P1[1],   pw1[2] = PKW(P0, 12), pw1[3] = PKW(P0, 14), pw1); \
    VRD(FO(4), 4); SBAR(); GAPA(C0 = MF(kf[4], qr[2], C0),   P1[2], P1[3], P1[4], P1[5],     pw2[0] = PKW(P1, 0), pw2[1] = PKW(P1, 2), pw2); \
    VRD(FO(5), 5); SBAR(); GAPA(C1 = MF(kf[5], qr[2], C1),   P1[6], P1[7], P1[8], P1[9],     pw2[2] = PKW(P1, 4), pw2[3] = PKW(P1, 6), pw2); \
    VRD(FO(6), 6); SBAR(); GAPA(C0 = MF(kf[6], qr[3], C0),   P1[10], P1[11], P1[12], P1[13], pw3[0] = PKW(P1, 8), pw3[1] = PKW(P1, 10), pw3); \
    VRD(FO(7), 7); SBAR(); GAPA(C1 = MF(kf[7], qr[3], C1),   P1[14], P1[15], 0.f, 0.f,       pw3[2] = PKW(P1, 12), pw3[3] = PKW(P1, 14), pw3); \
    l_reg += sacc; \
    if (GK) { DMA_K((t) + 3, s_cur); } if (GV) { DMA_V((t) + 1, s_next); } \
    ADD_BIAS(C0, C1, t); \
    SBAR(); \
    if (ND == 2) { \
        GAPB4(o[0] = MF(PAF(0), VFR(0), o[0]), C0, 0); \
        GAPB4(o[1] = MF(PAF(0), VFR(1), o[1]), C0, 4); \
        KRD(GL, 0); GAPB4(o[0] = MF(PAF(1), VFR(2), o[0]), C0, 8); \
        KRD(GL, 1); GAPB4(o[1] = MF(PAF(1), VFR(3), o[1]), C0, 12); \
        KRD(GL, 2); GAPB4(o[0] = MF(PAF(2), VFR(4), o[0]), C1, 0); \
        KRD(GL, 3); GAPB4(o[1] = MF(PAF(2), VFR(5), o[1]), C1, 4); \
        GAPB4(o[0] = MF(PAF(3), VFR(6), o[0]), C1, 8); \
        GAPB4(o[1] = MF(PAF(3), VFR(7), o[1]), C1, 12); \
    } else { \
        GAPB2(o[0] = MF(PAF(0), VFR(0), o[0]), C0, 0);  VRD(FO(8), 0); SBAR(); \
        GAPB2(o[1] = MF(PAF(0), VFR(1), o[1]), C0, 2);  VRD(FO(9), 1); SBAR(); \
        GAPB2(o[ND - 2] = MF(PAF(0), VFR(2), o[ND - 2]), C0, 4);  VRD(FO(10), 2); SBAR(); \
        GAPB2(o[ND - 1] = MF(PAF(0), VFR(3), o[ND - 1]), C0, 6);  VRD(FO(11), 3); SBAR(); \
        GAPB2(o[0] = MF(PAF(1), VFR(4), o[0]), C0, 8);  VRD(FO(12), 4); SBAR(); \
        GAPB2(o[1] = MF(PAF(1), VFR(5), o[1]), C0, 10); VRD(FO(13), 5); SBAR(); \
        GAPB2(o[ND - 2] = MF(PAF(1), VFR(6), o[ND - 2]), C0, 12); VRD(FO(14), 6); SBAR(); \
        GAPB2(o[ND - 1] = MF(PAF(1), VFR(7), o[ND - 1]), C0, 14); VRD(FO(15), 7); SBAR(); \
        KRD(GL, 0); GAPB2(o[0] = MF(PAF(2), VFR(0), o[0]), C1, 0); \
        GAPB2(o[1] = MF(PAF(2), VFR(1), o[1]), C1, 2); \
        KRD(GL, 1); GAPB2(o[ND - 2] = MF(PAF(2), VFR(2), o[ND - 2]), C1, 4); \
        GAPB2(o[ND - 1] = MF(PAF(2), VFR(3), o[ND - 1]), C1, 6); \
        KRD(GL, 2); GAPB2(o[0] = MF(PAF(3), VFR(4), o[0]), C1, 8); \
        GAPB2(o[1] = MF(PAF(3), VFR(5), o[1]), C1, 10); \
        KRD(GL, 3); GAPB2(o[ND - 2] = MF(PAF(3), VFR(6), o[ND - 2]), C1, 12); \
        GAPB2(o[ND - 1] = MF(PAF(3), VFR(7), o[ND - 1]), C1, 14); \
    } \
    if (BIAS && (t) == tl) { l_reg *= fL; _Pragma("unroll") for (int d_ = 0; d_ < ND; ++d_) _Pragma("unroll") for (int r = 0; r < 16; ++r) o[d_][r] *= fL; } \
    } while (0)
    int t = 1;
    for (; t + 4 < NT; t += 2) {
        STEP(pB0, pB1, pA0, pA1, t, true, true, true);       wait_bar<1 + NV, (TEST & 16) != 0>(); ROT();
        STEP(pA0, pA1, pB0, pB1, t + 1, true, true, true);   wait_bar<1 + NV, (TEST & 16) != 0>(); ROT();
    }
    STEP(pB0, pB1, pA0, pA1, NT - 3, false, true, true);  wait_bar<NV, (TEST & 16) != 0>(); ROT();
    STEP(pA0, pA1, pB0, pB1, NT - 2, false, true, true);  wait_bar<0, (TEST & 16) != 0>();  ROT();
    STEP(pB0, pB1, pA0, pA1, NT - 1, false, false, false);
    {
        float sacc = pB0[0] + pB0[1];
#pragma unroll
        for (int r = 2; r < 16; ++r) sacc += pB0[r];
#pragma unroll
        for (int r = 0; r < 16; ++r) sacc += pB1[r];
        l_reg += sacc;
        pw0 = (v4u){PKW(pB0, 0), PKW(pB0, 2), PKW(pB0, 4), PKW(pB0, 6)}; pw1 = (v4u){PKW(pB0, 8), PKW(pB0, 10), PKW(pB0, 12), PKW(pB0, 14)};
        pw2 = (v4u){PKW(pB1, 0), PKW(pB1, 2), PKW(pB1, 4), PKW(pB1, 6)}; pw3 = (v4u){PKW(pB1, 8), PKW(pB1, 10), PKW(pB1, 12), PKW(pB1, 14)};
        const lds_cptr vp_ = vp0 + s_cur * VSLOT;
#pragma unroll
        for (int d0 = 0; d0 < ND; ++d0) {
            s16x4 a0 = vtr(vp_ + d0 * 4096), b0 = vtr(vp_ + d0 * 4096 + 512), a1 = vtr(vp_ + d0 * 4096 + 1024), b1 = vtr(vp_ + d0 * 4096 + 1536);
            s16x4 a2 = vtr(vp_ + d0 * 4096 + 2048), b2 = vtr(vp_ + d0 * 4096 + 2560), a3 = vtr(vp_ + d0 * 4096 + 3072), b3 = vtr(vp_ + d0 * 4096 + 3584);
            o[d0] = MF(PAF(0), ((bf16x8){a0[0], a0[1], a0[2], a0[3], b0[0], b0[1], b0[2], b0[3]}), o[d0]);
            o[d0] = MF(PAF(1), ((bf16x8){a1[0], a1[1], a1[2], a1[3], b1[0], b1[1], b1[2], b1[3]}), o[d0]);
            o[d0] = MF(PAF(2), ((bf16x8){a2[0], a2[1], a2[2], a2[3], b2[0], b2[1], b2[2], b2[3]}), o[d0]);
            o[d0] = MF(PAF(3), ((bf16x8){a3[0], a3[1], a3[2], a3[3], b3[0], b3[1], b3[2], b3[3]}), o[d0]);
        }
    }
    l_reg += __shfl_xor(l_reg, 32);
    int lane_e = lane; asm volatile("" : "+v"(lane_e));
    const int r32e = lane_e & 31, hie = lane_e >> 5;
    if (hie == 0) wsf[r32e] = l_reg;
    asm volatile("s_waitcnt lgkmcnt(0)\n\ts_barrier" ::: "memory");
    {
        LAS bf16* stg = (LAS bf16*)(lds) + wid * (32 * DV);
#pragma unroll
        for (int r = 0; r < 16; ++r) { const int orow = crow(r, hie); const float rl = __builtin_amdgcn_rcpf(wsf[orow]);
#pragma unroll
            for (int d0 = 0; d0 < ND; ++d0) stg[orow * DV + d0 * 32 + r32e] = (bf16)f2bf(o[d0][r] * rl); }
        asm volatile("s_waitcnt lgkmcnt(0)" ::: "memory");
        constexpr int CPR = DV / 8;
#pragma unroll
        for (int i = 0; i < (32 * CPR) / 64; ++i) { const int row = i * (64 / CPR) + lane_e / CPR, ch = lane_e % CPR;
            const v4u v = *(const LAS v4u*)(stg + row * DV + ch * 8); *(v4u*)(Op + (size_t)(wid * 32 + row) * ldo + ch * 8) = v; }
    }
    asm volatile("s_waitcnt lgkmcnt(0)\n\ts_barrier" ::: "memory");
#undef DMA_K
#undef DMA_V
#undef ROT
#undef ADD_BIAS
#undef PKW
#undef PAF
#undef VFR
#undef MF
#undef GAPA
#undef EX
#undef GAPB4
#undef GAPB2
#undef VRD
#undef KRD
#undef FO
#undef STEP
}
#undef SBAR
#undef PIN
}

struct Args { const float* in[27]; float* out; unsigned char* ws; int ph_lo, ph_hi, li, pad; };

constexpr int NPHASE = 17;
constexpr int NWAVES = 8;

#define IN(k) (lo <= (k) && (k) < hi_ph)
#define SEAM(k) do { if (IN(k) && IN((k) + 1)) xcd_barrier(bar); } while (0)
template <int layer>
__device__ __forceinline__ void moe_block(const Args& args, LAS unsigned char* lds, const XcdBarrier& bar, int lo, int hi_ph) {
    volatile LAS unsigned* LC = (volatile LAS unsigned*)(lds + LDSCTL_OFF);
    const int tid = threadIdx.x, lane = tid & 63, wave = __builtin_amdgcn_readfirstlane(tid >> 6);
    const int G = gridDim.x, bx = blockIdx.x;
    const int gw = bx * NWAVES + wave, NGW = G * NWAVES;
    unsigned char* ws = args.ws;
    unsigned* ctl = (unsigned*)(ws + WS_CTL);
    float* xres = args.out;
    bf16* HB = (bf16*)(ws + WS_HB);
    {
        const int pb = layer == 0 ? 5 : 13;
        unsigned* const gcnt0 = ctl + CW_CNT + layer * 64;
        int* list = (int*)(ws + WS_LIST); int* tokep = (int*)(ws + WS_TOKEP); float* gate = (float*)(ws + WS_GATE);
        if (IN(pb)) REP(pb) {
            unsigned* gcnt = gcnt0 + ((MK_N_LAUNCHES == 1 ? (int)((PROBE_MASK >> pb) & 1u) : 0) - rep_) * 128;
            if (rep_ > 0) xcd_barrier(bar);
            const float* gf = args.in[2] + layer * DM;
            const float* WR = (const float*)(ws + WS_TBL) + TBL_WR + layer * WR_LAYER;
            for (int chunk = bx; chunk < NTOK / 128; chunk += G) {
                __syncthreads();
                if (tid < 32) LC[LC_LCNT + tid] = 0u;
                __syncthreads();
                int my_e0 = 0, my_e1 = 0; float my_g0 = 0.f, my_g1 = 0.f;
                {
                    const int ri = lane & 15, kq = lane >> 4; const int r0w = chunk * 128 + wave * 16;
                    const GAS float* xrow = (const GAS float*)(xres + (size_t)(r0w + ri) * DM) + 4 * kq;
                    const GAS float* wb = (const GAS float*)WR + (size_t)(4 * kq) * 48 + ri;
                    f32x4 acc0 = {0.f, 0.f, 0.f, 0.f}, acc1 = acc0, acc2 = acc0; float ss = 0.f;
                    f32x4 aA[4], aB[4]; float bA[48], bB[48];
#define RT_LOAD(a_, b_, g_) do { _Pragma("unroll") for (int c_ = 0; c_ < 4; ++c_) { a_[c_] = *(const GAS f32x4*)(xrow + 16 * (4 * (g_) + c_)); \
        const GAS float* wc_ = wb + (size_t)(16 * (4 * (g_) + c_)) * 48; _Pragma("unroll") for (int e_ = 0; e_ < 4; ++e_) { b_[c_ * 12 + e_ * 3] = wc_[e_ * 48]; b_[c_ * 12 + e_ * 3 + 1] = wc_[e_ * 48 + 16]; b_[c_ * 12 + e_ * 3 + 2] = wc_[e_ * 48 + 32]; } } } while (0)
#define RT_COMP(a_, b_) do { _Pragma("unroll") for (int c_ = 0; c_ < 4; ++c_) { ss += (a_[c_].x * a_[c_].x + a_[c_].y * a_[c_].y) + (a_[c_].z * a_[c_].z + a_[c_].w * a_[c_].w); \
        _Pragma("unroll") for (int e_ = 0; e_ < 4; ++e_) { acc0 = __builtin_amdgcn_mfma_f32_16x16x4f32(a_[c_][e_], b_[c_ * 12 + e_ * 3], acc0, 0, 0, 0); \
            acc1 = __builtin_amdgcn_mfma_f32_16x16x4f32(a_[c_][e_], b_[c_ * 12 + e_ * 3 + 1], acc1, 0, 0, 0); acc2 = __builtin_amdgcn_mfma_f32_16x16x4f32(a_[c_][e_], b_[c_ * 12 + e_ * 3 + 2], acc2, 0, 0, 0); } } } while (0)
                    RT_LOAD(aA, bA, 0);
#pragma unroll 1
                    for (int g = 0; g < 16; g += 2) {
                        RT_LOAD(aB, bB, g + 1);
                        RT_COMP(aA, bA);
                        if (g + 2 < 16) RT_LOAD(aA, bA, g + 2);
                        RT_COMP(aB, bB);
                    }
#undef RT_LOAD
#undef RT_COMP
                    ss += __shfl_xor(ss, 16); ss += __shfl_xor(ss, 32);
                    const float rstd = 1.0f / sqrtf(ss * (1.f / DM) + 1e-6f);
                    LAS float* Lg = (LAS float*)(lds + wave * 4096);
#pragma unroll
                    for (int r = 0; r < 4; ++r) { Lg[(4 * kq + r) * 49 + ri] = acc0[r]; Lg[(4 * kq + r) * 49 + 16 + ri] = acc1[r]; Lg[(4 * kq + r) * 49 + 32 + ri] = acc2[r]; }
                    LDS_WAIT(); asm volatile("" ::: "memory");
                    if (lane < 16) {
                        const GAS float* bv = (const GAS float*)WR + 1024 * 48;
                        float lg[4], le[32];
#pragma unroll
                        for (int e = 0; e < 4; ++e) lg[e] = Lg[lane * 49 + e] * rstd + bv[e];
#pragma unroll
                        for (int e = 0; e < 32; ++e) le[e] = Lg[lane * 49 + 4 + e] * rstd + bv[4 + e];
                        int gi = 0; float gm = lg[0];
#pragma unroll
                        for (int e = 1; e < 4; ++e) if (lg[e] > gm) { gm = lg[e]; gi = e; }
                        float gs = 0.f;
#pragma unroll
                        for (int e = 0; e < 4; ++e) gs += __expf(lg[e] - gm);
                        const float gval = 1.0f / gs;
                        float ev[8];
#pragma unroll
                        for (int j = 0; j < 8; ++j) ev[j] = gi == 0 ? le[j] : (gi == 1 ? le[8 + j] : (gi == 2 ? le[16 + j] : le[24 + j]));
                        int i0 = 0; float m0 = ev[0];
#pragma unroll
                        for (int j = 1; j < 8; ++j) if (ev[j] > m0) { m0 = ev[j]; i0 = j; }
                        int i1 = -1; float m1 = -3.0e38f;
#pragma unroll
                        for (int j = 0; j < 8; ++j) if (j != i0 && ev[j] > m1) { m1 = ev[j]; i1 = j; }
                        const float t1 = __expf(m1 - m0); const float den = 1.0f / (1.0f + t1);
                        my_e0 = gi * 8 + i0; my_e1 = gi * 8 + i1; my_g0 = gval * den; my_g1 = gval * t1 * den;
                    }
                    for (int i = 0; i < 16; ++i) { const int m = r0w + i; f32x4 v[4]; rms_row(xres + (size_t)m * DM, gf, v, lane); store_row_bf16(HB + (size_t)m * DM, v, lane); }
                }
                unsigned r0 = 0, r1 = 0;
                if (lane < 16) { r0 = atomicAdd((unsigned*)(LC + LC_LCNT + my_e0), 1u); r1 = atomicAdd((unsigned*)(LC + LC_LCNT + my_e1), 1u); }
                __syncthreads();
                if (tid < 32) { const unsigned c = LC[LC_LCNT + tid]; LC[LC_LBASE + tid] = c ? __hip_atomic_fetch_add(gcnt + tid, c, RLX_AGENT) : 0u; }
                __syncthreads();
                if (lane < 16) { const int m = chunk * 128 + wave * 16 + lane;
                    const unsigned p0 = LC[LC_LBASE + my_e0] + r0, p1 = LC[LC_LBASE + my_e1] + r1;
                    list[(size_t)my_e0 * LIST_CAP + p0] = m; list[(size_t)my_e1 * LIST_CAP + p1] = m;
                    tokep[2 * m] = my_e0 | (int)(p0 << 8); tokep[2 * m + 1] = my_e1 | (int)(p1 << 8);
                    gate[2 * m] = my_g0; gate[2 * m + 1] = my_g1; }
            }
        }
        SEAM(pb);
        if (IN(pb + 1) || IN(pb + 2) || IN(pb + 3)) {
            __syncthreads();
            if (tid == 0) { int acc = 0; for (int e = 0; e < 32; ++e) { const int c = (int)__hip_atomic_load(gcnt0 + e, RLX_AGENT); LC[LC_CNT + e] = (unsigned)c; LC[LC_TP + e] = (unsigned)acc; acc += (c + 255) >> 8; } LC[LC_TP + 32] = (unsigned)acc; }
            __syncthreads();
        }
        const LAS int* tp = (const LAS int*)(lds + LDSCTL_OFF) + LC_TP; const LAS int* cn = (const LAS int*)(lds + LDSCTL_OFF) + LC_CNT;
        if (IN(pb + 1)) REP(pb + 1) {
            pg8::Gemm g{HB, (const bf16*)(ws + WS_W13), 0, 1024, DM};
            pg8::MoeOrder S{tp, cn, list, G, bx, tp[32] * 4, true};
            pg8::EpiSwiglu E{(bf16*)(ws + WS_H)};
            pg8::gemm_phase<pg8::EpiSwiglu, pg8::MoeOrder, true>(lds, g, S, E);
        }
        SEAM(pb + 1);
        if (IN(pb + 2)) REP(pb + 2) {
            pg8::Gemm g{(const bf16*)(ws + WS_H), (const bf16*)(ws + WS_W2), 0, 1024, MOE_H};
            pg8::MoeOrder S{tp, cn, list, G, bx, tp[32] * 4, false};
            pg8::EpiBf16 E{(bf16*)(ws + WS_YS), DM, 0, 0, 1.f, 3};
            pg8::gemm_phase<pg8::EpiBf16, pg8::MoeOrder, true>(lds, g, S, E);
        }
        SEAM(pb + 2);
        if (IN(pb + 3)) {
            const bf16* YS = (const bf16*)(ws + WS_YS);
            if (layer == 0) { LAS float* scr = (LAS float*)(lds + wave * 16384);
                transpose_moe(args.in[24] + (size_t)NEXP * 1024 * 512, args.in[25] + (size_t)NEXP * 1024 * 512, args.in[26] + (size_t)NEXP * 1024 * 512, (bf16*)(ws + WS_W13), (bf16*)(ws + WS_W2), scr, gw, NGW, lane); }
            const float* gn = layer == 0 ? args.in[1] + DM : args.in[3];
            for (int m = gw; m < NTOK; m += NGW) {
                const int ep0 = tokep[2 * m], ep1 = tokep[2 * m + 1]; const float g0 = gate[2 * m], g1 = gate[2 * m + 1];
                const size_t s0 = (size_t)(tp[ep0 & 255] * 256 + (ep0 >> 8)), s1 = (size_t)(tp[ep1 & 255] * 256 + (ep1 >> 8));
                GAS f32x4* xr = (GAS f32x4*)(xres + (size_t)m * DM) + lane;
                const GAS v2u* y0 = (const GAS v2u*)(YS + s0 * DM) + lane; const GAS v2u* y1 = (const GAS v2u*)(YS + s1 * DM) + lane;
                f32x4 v[4]; float ss = 0.f;
#pragma unroll
                for (int j = 0; j < 4; ++j) { const v2u a = y0[64 * j], c = y1[64 * j]; f32x4 xv = xr[64 * j];
                    xv.x += g0 * __builtin_bit_cast(float, a.x << 16) + g1 * __builtin_bit_cast(float, c.x << 16);
                    xv.y += g0 * __builtin_bit_cast(float, a.x & 0xffff0000u) + g1 * __builtin_bit_cast(float, c.x & 0xffff0000u);
                    xv.z += g0 * __builtin_bit_cast(float, a.y << 16) + g1 * __builtin_bit_cast(float, c.y << 16);
                    xv.w += g0 * __builtin_bit_cast(float, a.y & 0xffff0000u) + g1 * __builtin_bit_cast(float, c.y & 0xffff0000u);
                    v[j] = xv; ss += (xv.x * xv.x + xv.y * xv.y) + (xv.z * xv.z + xv.w * xv.w); }
                const float rstd = 1.0f / sqrtf(wave_sum(ss) * (1.f / DM) + 1e-6f);
                const GAS f32x4* gr = (const GAS f32x4*)gn + lane;
                if (layer == 0) {
#pragma unroll
                    for (int j = 0; j < 4; ++j) xr[64 * j] = v[j];
#pragma unroll
                    for (int j = 0; j < 4; ++j) v[j] = v[j] * rstd * gr[64 * j];
                    store_row_bf16(HB + (size_t)m * DM, v, lane);
                } else {
#pragma unroll
                    for (int j = 0; j < 4; ++j) xr[64 * j] = v[j] * rstd * gr[64 * j];
                }
            }
        }
    }
}

__global__ void __launch_bounds__(NWAVES * 64, 2) mk_fwd(Args args) {
    extern __shared__ __attribute__((aligned(16))) unsigned char lds_raw[];
    LAS unsigned char* lds = (LAS unsigned char*)lds_raw;
    volatile LAS unsigned* LC = (volatile LAS unsigned*)(lds + LDSCTL_OFF);
    const int tid = threadIdx.x, lane = tid & 63, wave = __builtin_amdgcn_readfirstlane(tid >> 6);
    const int G = gridDim.x, bx = blockIdx.x;
    const int gw = bx * NWAVES + wave, NGW = G * NWAVES;
    unsigned char* ws = args.ws;
    unsigned* ctl = (unsigned*)(ws + WS_CTL);
    const float* x_in = args.in[0];
    float* xres = args.out;
    bf16* HB = (bf16*)(ws + WS_HB); bf16* Y = (bf16*)(ws + WS_Y);
    float* TBL = (float*)(ws + WS_TBL);

    for (int u = tid; u < (LDS_BYTES - LDSCTL_OFF) / 4; u += NWAVES * 64) LC[u] = 0u;
    __syncthreads();
    XcdBarrier bar; bar.bar = ctl + CW_BAR; bar.x = 0; bar.st = nullptr;
    if (MK_N_LAUNCHES == 1) bar = xcd_barrier_post(ctl + CW_BAR, LC + LC_BAR);
    const int lo = args.ph_lo, hi_ph = args.ph_hi;

    if (IN(0)) REP(0) {
        LAS float* scr = (LAS float*)(lds + wave * 16384);
        transpose_plain(args.in[4], DM, EV_IN, (bf16*)(ws + WS_WIN0), scr, gw, NGW, lane);
        transpose_plain(args.in[11], DM, DM, (bf16*)(ws + WS_WOUT0), scr, gw, NGW, lane);
        transpose_plain(args.in[12], DM, OD_IN, (bf16*)(ws + WS_WIN1), scr, gw, NGW, lane);
        transpose_plain(args.in[18], DM, DM, (bf16*)(ws + WS_WOUT1), scr, gw, NGW, lane);
        transpose_moe(args.in[24], args.in[25], args.in[26], (bf16*)(ws + WS_W13), (bf16*)(ws + WS_W2), scr, gw, NGW, lane);
        for (int i = bx * 512 + tid; i < 2048; i += G * 512) { const int pos = i >> 4, f = i & 15;
            const float inv = exp2f(-(float)f * (13.287712379549449f / 16.0f));
            const float ang = (float)pos * inv; const float rev = ang * 0.15915494309189535f; const float fr = rev - floorf(rev);
            TBL[TBL_COS + i] = __builtin_amdgcn_cosf(fr); TBL[TBL_SIN + i] = __builtin_amdgcn_sinf(fr); }
        for (int i = bx * 512 + tid; i < 8 * 257; i += G * 512) { const int h = i / 257, j = i % 257;
            TBL[TBL_BIAS + h * BIAS_STRIDE + j] = args.in[19][t5_bucket(j - 128) * 8 + h] * LOG2E; }
        for (int i = bx * 512 + tid; i < 2 * 1024 * 48; i += G * 512) { const int l = i / (1024 * 48), r = i % (1024 * 48), k = r / 48, c = r % 48;
            float w = 0.f; if (c < 4) w = args.in[20][(size_t)l * 4096 + k * 4 + c]; else if (c < 36) w = args.in[22][(size_t)l * 32768 + k * 32 + (c - 4)];
            TBL[TBL_WR + l * WR_LAYER + r] = w * args.in[2][l * DM + k]; }
        for (int i = bx * 512 + tid; i < 2 * 48; i += G * 512) { const int l = i / 48, c = i % 48;
            TBL[TBL_WR + l * WR_LAYER + 1024 * 48 + c] = c < 4 ? args.in[21][l * 4 + c] : (c < 36 ? args.in[23][l * 32 + (c - 4)] : 0.f); }
        for (int m = gw; m < NTOK; m += NGW) { f32x4 v[4]; rms_row(x_in + (size_t)m * DM, args.in[1], v, lane); store_row_bf16(HB + (size_t)m * DM, v, lane); }
    }
    SEAM(0);
    if (IN(1)) REP(1) {
        pg8::Gemm g{HB, (const bf16*)(ws + WS_WIN0), NTOK, EV_IN, DM}; pg8::StaticOrder S; S.init(NTOK, EV_IN, G, bx);
        pg8::EpiBf16 E{(bf16*)(ws + WS_Z0), EV_IN, 0, 0, 1.f, 0xffff};
        pg8::gemm_phase<pg8::EpiBf16, pg8::StaticOrder, true>(lds, g, S, E);
    }
    SEAM(1);
    if (IN(2)) REP(2) {
        const bf16* Z0 = (const bf16*)(ws + WS_Z0); bf16* QR = (bf16*)(ws + WS_QR); bf16* KR = (bf16*)(ws + WS_KR);
        const float gq = args.in[5][lane], gk = args.in[6][lane];
        const int fi = lane & 15; const bool first = (lane & 16) == 0, isrow = lane < 32;
        for (int m = gw; m < NTOK; m += NGW) {
            const int s = m & (SEQ - 1); const int pos = isrow ? (s >> 6) : (s & 63);
            const float cs = TBL[TBL_COS + pos * 16 + fi], sn = TBL[TBL_SIN + pos * 16 + fi];
#pragma unroll
            for (int h = 0; h < 10; ++h) {
                const float xv = bf2f(Z0[(size_t)m * EV_IN + h * 64 + lane]);
                const float ss = wave_sum(xv * xv);
                const float y = xv * (1.0f / sqrtf(ss * (1.f / 64.f) + 1e-6f)) * (h < 8 ? gq : gk);
                const float p = __shfl_xor(y, 16);
                float o = first ? (y * cs - p * sn) : (y * cs + p * sn);
                if (h < 8) QR[(size_t)m * 512 + h * 64 + lane] = (bf16)f2bf(o * C2);
                else KR[(size_t)m * 128 + (h - 8) * 64 + lane] = (bf16)f2bf(o);
            }
        }
        LAS float* hbuf = (LAS float*)lds;
        for (int un = bx; un < NBATCH * 64 * 8; un += G) {
            const int grp = un & 7, tt = (un >> 3) & 63, b = un >> 9; const int t0 = tt * 128;
            __syncthreads();
            for (int idx = tid; idx < 158 * 8; idx += 512) { const int r = idx >> 3, c8 = idx & 7; const int s = t0 - 15 + r;
                f32x4 h0 = {0.f, 0.f, 0.f, 0.f}, h1 = h0;
                if (s >= 0 && s < SEQ) { const size_t ro = (size_t)(b * SEQ + s) * EV_IN + grp * 64 + c8 * 8;
                    const v4u av = *(const GAS v4u*)(Z0 + ro + 768), gv = *(const GAS v4u*)(Z0 + ro + 1280);
#pragma unroll
                    for (int j = 0; j < 4; ++j) { const float a0 = __builtin_bit_cast(float, av[j] << 16), a1 = __builtin_bit_cast(float, av[j] & 0xffff0000u);
                        const float g0 = __builtin_bit_cast(float, gv[j] << 16), g1 = __builtin_bit_cast(float, gv[j] & 0xffff0000u);
                        const float x0 = a0 * __builtin_amdgcn_rcpf(1.0f + __builtin_amdgcn_exp2f(-g0 * LOG2E)), x1 = a1 * __builtin_amdgcn_rcpf(1.0f + __builtin_amdgcn_exp2f(-g1 * LOG2E));
                        if (j < 2) { h0[2 * j] = x0; h0[2 * j + 1] = x1; } else { h1[2 * j - 4] = x0; h1[2 * j - 3] = x1; } } }
                *(LAS f32x4*)(hbuf + r * 64 + c8 * 8) = h0; *(LAS f32x4*)(hbuf + r * 64 + c8 * 8 + 4) = h1; }
            __syncthreads();
            const int ch = grp * 64 + lane;
            float wreg[31];
#pragma unroll
            for (int j = 0; j < 31; ++j) wreg[j] = args.in[7][j * 512 + ch];
            float acc[16]; const float cb = args.in[8][ch];
#pragma unroll
            for (int i = 0; i < 16; ++i) acc[i] = cb;
#pragma unroll
            for (int r = 0; r < 46; ++r) { const float hv = hbuf[(wave * 16 + r) * 64 + lane];
#pragma unroll
                for (int i = 0; i < 16; ++i) { const int j = r - i; if (j >= 0 && j < 31) acc[i] += wreg[j] * hv; } }
            const float gg = args.in[9][ch], gb = args.in[10][ch];
#pragma unroll
            for (int i = 0; i < 16; ++i) { const float mu = wave_sum(acc[i]) * (1.f / 64.f); const float d = acc[i] - mu; const float var = wave_sum(d * d) * (1.f / 64.f);
                const float hn = d * (1.0f / sqrtf(var + 1e-5f)) * gg + gb; const float ov = hn * __builtin_amdgcn_rcpf(1.0f + __builtin_amdgcn_exp2f(-hn * LOG2E));
                Y[(size_t)(b * SEQ + t0 + wave * 16 + i) * DM + 512 + ch] = (bf16)f2bf(ov); }
        }
    }
    SEAM(2);
    if (IN(3)) REP(3) {
        const bf16* QR = (const bf16*)(ws + WS_QR); const bf16* KR = (const bf16*)(ws + WS_KR); const bf16* Z0 = (const bf16*)(ws + WS_Z0);
        if (ATTN_VER == 0) {
        for (int un = bx; un < NBATCH * 8 * 32; un += G) {
            const int qb = un & 31, h = (un >> 5) & 7, b = un >> 8, kvh = h >> 2;
            const size_t row0 = (size_t)b * SEQ + qb * 256;
            attn_unit_v0<64, false>(QR + row0 * 512 + h * 64, 512, KR + (size_t)b * SEQ * 128 + kvh * 64, 128, Z0 + (size_t)b * SEQ * EV_IN + 640 + kvh * 64, EV_IN,
                                   Y + row0 * DM + h * 64, DM, nullptr, qb * 256, lds);
        }
        } else {
        constexpr int U = NBATCH * 8 * 32; const int upc = (U + G - 1) / G; const int vcu = (G % 8 == 0) ? (bx % 8) * (G / 8) + bx / 8 : bx;
        for (int i = 0; i < upc; ++i) { const int un = vcu * upc + i; if (un >= U) break;
            const int stream = un >> 7, b = stream >> 1, kvh = stream & 1, h = kvh * 4 + ((un >> 5) & 3), qb = un & 31;
            const size_t row0 = (size_t)b * SEQ + qb * 256;
            at1::attn_unit<64, false>(QR + row0 * 512 + h * 64, 512, KR + (size_t)b * SEQ * 128 + kvh * 64, 128, Z0 + (size_t)b * SEQ * EV_IN + 640 + kvh * 64, EV_IN,
                                      Y + row0 * DM + h * 64, DM, qb * 256, lds);
        }
        }
    }
    SEAM(3);
    if (IN(4)) REP(4) {
        pg8::Gemm g{Y, (const bf16*)(ws + WS_WOUT0), NTOK, DM, DM}; pg8::StaticOrder S; S.init(NTOK, DM, G, bx);
        pg8::EpiRes E{x_in, xres, DM};
        pg8::gemm_phase<pg8::EpiRes, pg8::StaticOrder, true>(lds, g, S, E);
    }
    SEAM(4);

    moe_block<0>(args, lds, bar, lo, hi_ph);
    SEAM(8);
            if (IN(9)) REP(9) {
                pg8::Gemm g{HB, (const bf16*)(ws + WS_WIN1), NTOK, OD_IN, DM}; pg8::StaticOrder S; S.init(NTOK, OD_IN, G, bx);
                pg8::EpiBf16 E{(bf16*)(ws + WS_Q1), DM, DM, (size_t)(WS_K1 - WS_Q1) / 2, C2, 0xffff};
                pg8::gemm_phase<pg8::EpiBf16, pg8::StaticOrder, true>(lds, g, S, E);
            }
            SEAM(9);
            if (IN(10)) REP(10) {
                const bf16* Q1 = (const bf16*)(ws + WS_Q1); const bf16* K1 = (const bf16*)(ws + WS_K1); const bf16* V1 = (const bf16*)(ws + WS_V1);
                if (ATTN_VER == 0) {
                LAS float* btbl = (LAS float*)(lds + 65536);
                for (int un = bx; un < NBATCH * 8 * 2 * 32; un += G) {
                    const int qb = un & 31, c = (un >> 5) & 1, h = (un >> 6) & 7, b = un >> 9;
                    __syncthreads();
                    if (tid < 257) btbl[tid] = TBL[TBL_BIAS + h * BIAS_STRIDE + tid];
                    __syncthreads();
                    const size_t row0 = (size_t)b * SEQ + qb * 256, brow = (size_t)b * SEQ;
                    bf16* OC = (bf16*)(ws + (c ? WS_OC1 : WS_OC0));
                    attn_unit_v0<128, true>(Q1 + row0 * DM + h * 128 + c * 64, DM, K1 + brow * DM + h * 128 + c * 64, DM, V1 + brow * DM + h * 128, DM,
                                           OC + row0 * DM + h * 128, DM, btbl, qb * 256, lds);
                }
                } else {
                constexpr int U = NBATCH * 8 * 2 * 32; const int upc = (U + G - 1) / G; const int vcu = (G % 8 == 0) ? (bx % 8) * (G / 8) + bx / 8 : bx;
                LAS float* btbl = (LAS float*)(lds + 3 * 8192 + 3 * 16384 + 2048);
                for (int i = 0; i < upc; ++i) {
                    int un = vcu * upc + i; if (un >= U) break;
                    if (G == 256) un = ((vcu >> 5) * 4 + (i >> 1)) * 64 + (i & 1) * 32 + (vcu & 31);
                    const int qb = un & 31, c = (un >> 5) & 1, h = (un >> 6) & 7, b = un >> 9;
                    if (tid < 257) btbl[tid] = TBL[TBL_BIAS + h * BIAS_STRIDE + tid] - TBL[TBL_BIAS + h * BIAS_STRIDE + 256];
                    __syncthreads();
                    const size_t row0 = (size_t)b * SEQ + qb * 256, brow = (size_t)b * SEQ;
                    bf16* OC = (bf16*)(ws + (c ? WS_OC1 : WS_OC0));
                    at1::attn_unit<128, true>(Q1 + row0 * DM + h * 128 + c * 64, DM, K1 + brow * DM + h * 128 + c * 64, DM, V1 + brow * DM + h * 128, DM,
                                              OC + row0 * DM + h * 128, DM, qb * 256, lds);
                }
                }
            }
            SEAM(10);
            if (PROBE_ATT >= 0 && IN(10)) {
                const bf16* Q1 = (const bf16*)(ws + WS_Q1); const bf16* K1 = (const bf16*)(ws + WS_K1); const bf16* V1 = (const bf16*)(ws + WS_V1);
                constexpr int U = NBATCH * 8 * 2 * 32; const int upc = (U + G - 1) / G; const int vcu = (G % 8 == 0) ? (bx % 8) * (G / 8) + bx / 8 : bx;
                LAS float* btbl = (LAS float*)(lds + 3 * 8192 + 3 * 16384 + 2048);
                for (int i = 0; i < upc; ++i) {
                    int un = vcu * upc + i; if (un >= U) break;
                    if (G == 256) un = ((vcu >> 5) * 4 + (i >> 1)) * 64 + (i & 1) * 32 + (vcu & 31);
                    const int qb = un & 31, c = (un >> 5) & 1, h = (un >> 6) & 7, b = un >> 9;
                    if (tid < 257) btbl[tid] = TBL[TBL_BIAS + h * BIAS_STRIDE + tid] - TBL[TBL_BIAS + h * BIAS_STRIDE + 256];
                    __syncthreads();
                    const size_t row0 = (size_t)b * SEQ + qb * 256, brow = (size_t)b * SEQ;
                    at1::attn_unit<128, true, (PROBE_ATT >= 0 ? PROBE_ATT : 0)>(Q1 + row0 * DM + h * 128 + c * 64, DM, K1 + brow * DM + h * 128 + c * 64, DM, V1 + brow * DM + h * 128, DM,
                                              Y + row0 * DM + h * 128, DM, qb * 256, lds);
                }
                xcd_barrier(bar);
            }
            if (IN(11)) REP(11) {
                const bf16* OC0 = (const bf16*)(ws + WS_OC0); const bf16* OC1 = (const bf16*)(ws + WS_OC1);
                const float lam = __expf(wave_sum(args.in[13][lane] * args.in[14][lane])) - __expf(wave_sum(args.in[15][lane] * args.in[16][lane])) + LAM_INIT;
                float sg[16];
#pragma unroll
                for (int j = 0; j < 16; ++j) sg[j] = args.in[17][(lane & 7) * 16 + j] * (1.0f - LAM_INIT);
                for (int m = gw; m < NTOK; m += NGW) {
                    const GAS v4u* a = (const GAS v4u*)(OC0 + (size_t)m * DM) + lane * 2; const GAS v4u* c = (const GAS v4u*)(OC1 + (size_t)m * DM) + lane * 2;
                    float o[16]; float ss = 0.f;
#pragma unroll
                    for (int q = 0; q < 2; ++q) { const v4u av = a[q], cv = c[q];
#pragma unroll
                        for (int j = 0; j < 4; ++j) { const unsigned au = av[j], cu = cv[j];
                            const float lo = __builtin_bit_cast(float, au << 16) - lam * __builtin_bit_cast(float, cu << 16);
                            const float hh = __builtin_bit_cast(float, au & 0xffff0000u) - lam * __builtin_bit_cast(float, cu & 0xffff0000u);
                            o[q * 8 + 2 * j] = lo; o[q * 8 + 2 * j + 1] = hh; ss += lo * lo + hh * hh; } }
                    ss += __shfl_xor(ss, 1); ss += __shfl_xor(ss, 2); ss += __shfl_xor(ss, 4);
                    const float rstd = 1.0f / sqrtf(ss * (1.f / 128.f) + 1e-5f);
                    v4u w0, w1;
                    w0.x = pk2(o[0] * rstd * sg[0], o[1] * rstd * sg[1]); w0.y = pk2(o[2] * rstd * sg[2], o[3] * rstd * sg[3]); w0.z = pk2(o[4] * rstd * sg[4], o[5] * rstd * sg[5]); w0.w = pk2(o[6] * rstd * sg[6], o[7] * rstd * sg[7]);
                    w1.x = pk2(o[8] * rstd * sg[8], o[9] * rstd * sg[9]); w1.y = pk2(o[10] * rstd * sg[10], o[11] * rstd * sg[11]); w1.z = pk2(o[12] * rstd * sg[12], o[13] * rstd * sg[13]); w1.w = pk2(o[14] * rstd * sg[14], o[15] * rstd * sg[15]);
                    GAS v4u* yo = (GAS v4u*)(Y + (size_t)m * DM) + lane * 2; yo[0] = w0; yo[1] = w1;
                }
            }
            SEAM(11);
            if (IN(12)) {
                pg8::Gemm g{Y, (const bf16*)(ws + WS_WOUT1), NTOK, DM, DM}; pg8::StaticOrder S; S.init(NTOK, DM, G, bx);
                pg8::EpiRes E{xres, xres, DM};
                pg8::gemm_phase<pg8::EpiRes, pg8::StaticOrder, true>(lds, g, S, E);
            }
            SEAM(12);
    moe_block<1>(args, lds, bar, lo, hi_ph);
#undef IN
#undef SEAM
}

extern "C" void kernel_launch(void* const* d_in, const int* in_sizes, int n_in, void* d_out, int out_size, void* d_ws, size_t ws_size, hipStream_t stream) {
    static int grid = 0;
    if (grid == 0) {
        if (n_in != 27 || in_sizes[0] != NTOK * DM || out_size != NTOK * DM || ws_size < WS_END) { fprintf(stderr, "kernel_launch: unexpected shapes / workspace (n_in %d, ws %zu)\n", n_in, ws_size); grid = -1; return; }
        int dev = 0, cus = 0, per_cu = 0;
        if (hipGetDevice(&dev) != hipSuccess || hipDeviceGetAttribute(&cus, hipDeviceAttributeMultiprocessorCount, dev) != hipSuccess) { grid = -1; return; }
        if (hipFuncSetAttribute((const void*)mk_fwd, hipFuncAttributeMaxDynamicSharedMemorySize, LDS_BYTES) != hipSuccess) { fprintf(stderr, "kernel_launch: hipFuncSetAttribute failed\n"); grid = -1; return; }
        if (hipOccupancyMaxActiveBlocksPerMultiprocessor(&per_cu, (const void*)mk_fwd, NWAVES * 64, LDS_BYTES) != hipSuccess || per_cu < 1) { fprintf(stderr, "kernel_launch: occupancy query says %d\n", per_cu); }
        (void)hipGetLastError();
        grid = cus;
    }
    if (grid < 0) return;
    if (hipMemsetAsync((char*)d_ws + WS_CTL, 0, CTL_ZERO_BYTES, stream) != hipSuccess) return;
    Args a{};
    for (int i = 0; i < 27; ++i) a.in[i] = (const float*)d_in[i];
    a.out = (float*)d_out; a.ws = (unsigned char*)d_ws;
    if (MK_N_LAUNCHES == 1) { a.ph_lo = 0; a.ph_hi = NPHASE; a.li = 0; hipLaunchKernelGGL(mk_fwd, dim3(grid), dim3(NWAVES * 64), LDS_BYTES, stream, a); }
    else { for (int p = 0; p < NPHASE; ++p) for (int r = 0; r < (int)((PROBE_MASK >> p) & 1u) + 1; ++r) { a.ph_lo = p; a.ph_hi = p + 1; a.li = p; hipLaunchKernelGGL(mk_fwd, dim3(grid), dim3(NWAVES * 64), LDS_BYTES, stream, a); } }
}
```

```cpp
#include <hip/hip_runtime.h>
#include <cstdio>
#include <cstdint>

#ifndef MK_N_LAUNCHES
#define MK_N_LAUNCHES 1
#endif

#ifndef ATTN_VER
#define ATTN_VER 1
#endif
#ifndef PROBE_ATT
#define PROBE_ATT -1
#endif
#ifndef PROBE_MASK
#define PROBE_MASK 0u
#endif
#define REP(k) _Pragma("unroll") for (int rep_ = 0; rep_ < (MK_N_LAUNCHES == 1 ? (int)((PROBE_MASK >> (k)) & 1u) : 0) + 1; ++rep_)
#define GAS __attribute__((address_space(1)))
#define LAS __attribute__((address_space(3)))
typedef unsigned short bf16;
typedef unsigned v4u __attribute__((ext_vector_type(4)));
typedef unsigned v2u __attribute__((ext_vector_type(2)));
typedef float f32x4 __attribute__((ext_vector_type(4)));
typedef float f32x16 __attribute__((ext_vector_type(16)));
typedef short bf16x8 __attribute__((ext_vector_type(8)));
typedef short s16x4 __attribute__((ext_vector_type(4)));

constexpr int NTOK = 32768, DM = 1024, SEQ = 8192, NBATCH = 4;
constexpr int EV_IN = 1792, OD_IN = 3072;
constexpr int NEXP = 32, MOE_H = 512, LIST_CAP = 32768;
constexpr float C2 = 0.125f * 1.4426950408889634f;
constexpr float LOG2E = 1.4426950408889634f;
constexpr float LAM_INIT = 0.35550906759f;

constexpr size_t MiB = 1u << 20;
constexpr size_t WS_CTL = 0, CTL_ZERO_BYTES = 1 * MiB;
constexpr size_t WS_WIN0 = 1 * MiB, WS_WOUT0 = 5 * MiB, WS_WIN1 = 7 * MiB, WS_WOUT1 = 13 * MiB, WS_TBL = 15 * MiB;
constexpr size_t WS_W13 = 16 * MiB, WS_W2 = 80 * MiB;
constexpr size_t WS_HB = 112 * MiB;
constexpr size_t WS_Y = 176 * MiB;
constexpr size_t WS_Z0 = 240 * MiB, WS_QR = 352 * MiB, WS_KR = 384 * MiB;
constexpr size_t WS_Q1 = 240 * MiB, WS_K1 = 304 * MiB, WS_V1 = 368 * MiB, WS_OC1 = 432 * MiB, WS_OC0 = WS_HB;
constexpr size_t WS_H = 176 * MiB, WS_YS = 248 * MiB, WS_LIST = 392 * MiB, WS_TOKEP = 396 * MiB, WS_GATE = 396 * MiB + 512 * 1024;
constexpr size_t WS_END = 496 * MiB;
constexpr int TBL_COS = 0, TBL_SIN = 2048, TBL_BIAS = 4096, BIAS_STRIDE = 272;
constexpr int TBL_WR = 32768, WR_LAYER = 1024 * 48 + 64;
constexpr int CW_BAR = 4096;
constexpr int CW_CNT = 16384;

constexpr int RING_BYTES = 131072;
constexpr int LDS_BYTES = 147456;
constexpr int LDSCTL_OFF = LDS_BYTES - 1024;
constexpr int STASH_OFF = 78 * 1024;
constexpr int LC_BAR = 8;
constexpr int LC_TP = 16;
constexpr int LC_CNT = 64;
constexpr int LC_LCNT = 96;
constexpr int LC_LBASE = 128;
constexpr int LC_LP = 160;

#define LDS_WAIT() asm volatile("s_waitcnt lgkmcnt(0)" ::: "memory")
#define VM_WAIT() asm volatile("s_waitcnt vmcnt(0)" ::: "memory")
#define RLX_AGENT __ATOMIC_RELAXED, __HIP_MEMORY_SCOPE_AGENT

__device__ __forceinline__ unsigned f2bf(float f) { unsigned u = __builtin_bit_cast(unsigned, f); return (u + 0x7fffu + ((u >> 16) & 1u)) >> 16; }
__device__ __forceinline__ unsigned pk2(float lo, float hi) { return f2bf(lo) | (f2bf(hi) << 16); }
__device__ __forceinline__ float bf2f(unsigned short b) { return __builtin_bit_cast(float, (unsigned)b << 16); }
template <int CTRL> __device__ __forceinline__ float dpp_mov(float v) { return __builtin_bit_cast(float, __builtin_amdgcn_update_dpp(0, __builtin_bit_cast(int, v), CTRL, 0xf, 0xf, true)); }
__device__ __forceinline__ float wave_sum(float v) {
    v += dpp_mov<0xB1>(v); v += dpp_mov<0x4E>(v); v += dpp_mov<0x141>(v); v += dpp_mov<0x140>(v);
    { auto rr = __builtin_amdgcn_permlane16_swap(__float_as_uint(v), __float_as_uint(v), false, false); v = __uint_as_float(rr[0]) + __uint_as_float(rr[1]); }
    { auto rr = __builtin_amdgcn_permlane32_swap(__float_as_uint(v), __float_as_uint(v), false, false); v = __uint_as_float(rr[0]) + __uint_as_float(rr[1]); }
    return v;
}

namespace pg8 {
#define PG8_LAS __attribute__((address_space(3)))
typedef unsigned short bf16_t;
typedef short bf16x8 __attribute__((ext_vector_type(8)));
typedef float f32x4 __attribute__((ext_vector_type(4)));
typedef unsigned u32x4 __attribute__((ext_vector_type(4)));
constexpr int BM = 256, BK = 64, HALF = 128, HTB = HALF * BK * 2, STAGE_BYTES = 8 * HTB, NXCD = 8, WGM = 8;

__host__ __device__ __forceinline__ int lds_byte(int r, int c) { const int st = (r >> 4) * 2 + (c >> 5), rr = r & 15, cc = c & 31, ob = rr * 64 + cc * 2; return st * 1024 + (ob ^ (((ob >> 9) & 1) << 5)); }
__host__ __device__ __forceinline__ void stage_rc(int b, int& R, int& C) { const int st = b / 1024, sb = b % 1024, swz = sb ^ (((sb >> 9) & 1) << 5); R = (st >> 1) * 16 + swz / 64; C = (st & 1) * 32 + (swz % 64) / 2; }
__host__ __device__ __forceinline__ int perm32(int rho) { const int n = rho >> 4, i = rho & 15; return 8 * (i >> 2) + 4 * n + (i & 3); }

struct Unit { int pm, pn, e, rb; };
struct Gemm { const bf16_t* A; const bf16_t* Bt; int M, N, K; };

struct StaticOrder {
    int nM, nN, nwg, G, c;
    __device__ void init(int M, int N, int G_, int c_) { nM = M / BM; nN = N / BM; nwg = nM * nN; G = G_; c = c_; }
    __device__ bool next(int i, Unit& u) const {
        const long L = (long)i * G + c; if (L >= nwg) return false;
        int wgid = (int)L; { const int q = nwg / NXCD, r = nwg % NXCD, xcd = wgid % NXCD, off = wgid / NXCD; wgid = (xcd < r ? xcd * (q + 1) : r * (q + 1) + (xcd - r) * q) + off; }
        const int nig = WGM * nN, gid = wgid / nig, fm = gid * WGM, gsz = (nM - fm) < WGM ? (nM - fm) : WGM;
        u.pm = fm + ((wgid % nig) % gsz); u.pn = (wgid % nig) / gsz; u.e = 0; u.rb = 0; return true;
    }
    __device__ __forceinline__ unsigned arow(const Unit& u, int rr) const { return (unsigned)(u.pm * BM + rr); }
};

struct MoeOrder {
    const PG8_LAS int* tp; const PG8_LAS int* cn; const PG8_LAS int* lp; const int* list; int G, c, nunits; bool gather; bool xcd;
    __device__ __forceinline__ bool next(int i, Unit& u) const {
        int e_, rb_, pm_, pnl_; bool ok;
        if (xcd) {
            const int x = c & 7, y = c >> 3; const int uidx = i * 32 + y; ok = uidx < lp[4] * 4;
            const int rbl = uidx >> 2; pnl_ = uidx & 3; int j = 0;
#pragma unroll
            for (int q = 1; q < 4; ++q) j += (lp[q] <= rbl) ? 1 : 0;
            e_ = x + 8 * j; rb_ = rbl - lp[j]; pm_ = tp[e_] + rb_;
        } else {
            const int L = i * G + c; ok = L < nunits;
            const int rbg = L >> 2; pnl_ = L & 3; int e = 0;
#pragma unroll
            for (int j = 1; j < 32; ++j) e += (tp[j] <= rbg) ? 1 : 0;
            e_ = e; pm_ = rbg; rb_ = rbg - tp[e];
        }
        u.e = __builtin_amdgcn_readfirstlane(e_); u.rb = __builtin_amdgcn_readfirstlane(rb_); u.pm = __builtin_amdgcn_readfirstlane(pm_); u.pn = __builtin_amdgcn_readfirstlane(e_ * 4 + pnl_);
        return ok;
    }
    __device__ __forceinline__ unsigned arow(const Unit& u, int rr) const {
        if (!gather) return (unsigned)(u.pm * BM + rr);
        const int idx = u.rb * BM + rr; unsigned t = 0u;
        if (idx < cn[u.e]) t = (unsigned)list[(size_t)u.e * 32768 + idx];
        return t;
    }
};

__device__ __forceinline__ unsigned cvt_pk_bf16(float lo, float hi) { unsigned r; asm volatile("v_cvt_pk_bf16_f32 %0, %1, %2" : "=v"(r) : "v"(lo), "v"(hi)); return r; }

struct EpiBf16 {
    static constexpr bool PERM = true;
    bf16_t* O; int ldc; int split_cols; size_t split_stride; float scale0; int pn_mask;
    __device__ __forceinline__ void operator()(const f32x4 (&acc)[2][2][4][2], const Unit& u, int wr, int wc, int fr, int fq) const {
        const int row0 = u.pm * BM + wr * 64 + fr; int colt = (u.pn & pn_mask) * BM; bf16_t* base = O;
        float sc = 1.f; if (split_cols) { const int t = colt / split_cols; base += (size_t)t * split_stride; colt -= t * split_cols; if (t == 0) sc = scale0; }
        const int col0 = colt + wc * 32 + 8 * fq;
#pragma unroll
        for (int ai = 0; ai < 2; ++ai)
#pragma unroll
            for (int m = 0; m < 4; ++m) { bf16_t* rowp = base + (size_t)(row0 + ai * HALF + m * 16) * ldc + col0;
#pragma unroll
                for (int bj = 0; bj < 2; ++bj) { f32x4 v0 = acc[ai][bj][m][0] * sc, v1 = acc[ai][bj][m][1] * sc;
                    u32x4 w; w.x = cvt_pk_bf16(v0[0], v0[1]); w.y = cvt_pk_bf16(v0[2], v0[3]); w.z = cvt_pk_bf16(v1[0], v1[1]); w.w = cvt_pk_bf16(v1[2], v1[3]);
                    *(u32x4*)(rowp + bj * HALF) = w; } }
    }
};
struct EpiRes {
    static constexpr bool PERM = false;
    const float* base; float* out; int ldc;
    __device__ __forceinline__ void operator()(const f32x4 (&acc)[2][2][4][2], const Unit& u, int wr, int wc, int fr, int fq) const {
        const int row0 = u.pm * BM + wr * 64 + fr, col0 = u.pn * BM + wc * 32 + 4 * fq;
#pragma unroll
        for (int ai = 0; ai < 2; ++ai)
#pragma unroll
            for (int m = 0; m < 4; ++m) { const size_t off = (size_t)(row0 + ai * HALF + m * 16) * ldc + col0;
#pragma unroll
                for (int bj = 0; bj < 2; ++bj)
#pragma unroll
                    for (int n = 0; n < 2; ++n) { const f32x4 bs = *(const f32x4*)(base + off + bj * HALF + n * 16); *(f32x4*)(out + off + bj * HALF + n * 16) = bs + acc[ai][bj][m][n]; } }
    }
};
__device__ __forceinline__ float silu_mul(float a, float b) { return a * b * __builtin_amdgcn_rcpf(1.0f + __builtin_amdgcn_exp2f(-a * 1.4426950408889634f)); }
struct EpiSwiglu {
    static constexpr bool PERM = true;
    bf16_t* O;
    __device__ __forceinline__ void operator()(const f32x4 (&acc)[2][2][4][2], const Unit& u, int wr, int wc, int fr, int fq) const {
        const int row0 = u.pm * BM + wr * 64 + fr, col0 = (u.pn & 3) * 128 + wc * 32 + 8 * fq;
#pragma unroll
        for (int ai = 0; ai < 2; ++ai)
#pragma unroll
            for (int m = 0; m < 4; ++m) { bf16_t* rowp = O + (size_t)(row0 + ai * HALF + m * 16) * 512 + col0;
                const f32x4 a0 = acc[ai][0][m][0], a1 = acc[ai][0][m][1], b0 = acc[ai][1][m][0], b1 = acc[ai][1][m][1];
                u32x4 w; w.x = cvt_pk_bf16(silu_mul(a0[0], b0[0]), silu_mul(a0[1], b0[1])); w.y = cvt_pk_bf16(silu_mul(a0[2], b0[2]), silu_mul(a0[3], b0[3]));
                w.z = cvt_pk_bf16(silu_mul(a1[0], b1[0]), silu_mul(a1[1], b1[1])); w.w = cvt_pk_bf16(silu_mul(a1[2], b1[2]), silu_mul(a1[3], b1[3]));
                *(u32x4*)rowp = w; }
    }
};

template <class Epi, class Sched, bool ALIGN_EPI>
__device__ __forceinline__ void gemm_phase(PG8_LAS unsigned char* lds, const Gemm g, const Sched& S, const Epi& E) {
    const int tid = threadIdx.x, wid = __builtin_amdgcn_readfirstlane(tid >> 6), lane = tid & 63, wr = wid >> 2, wc = wid & 3, fr = lane & 15, fq = lane >> 4;
    const int K = g.K, nt = K / BK;
    int RA[2], CA[2]; unsigned voffB[2];
#pragma unroll
    for (int i = 0; i < 2; ++i) { int R, C; stage_rc(tid * 16 + i * 8192, R, C); RA[i] = R; CA[i] = C; const int Rb = Epi::PERM ? ((R & ~31) + perm32(R & 31)) : R; voffB[i] = (unsigned)(Rb * K + C) * 2u; }
    const size_t kstep = (size_t)(BK * 2);
    const size_t hstep = (size_t)HALF * K * 2;
    const size_t tstep = 2 * hstep;
    const unsigned ldsw = (unsigned)wid * 1024u;
    const int aoff = lds_byte(wr * 64 + fr, fq * 8), boff = lds_byte(wc * 32 + fr, fq * 8);
#define PG8_SA(b, h) (((b) * 2 + (h)) * HTB)
#define PG8_SB(b, h) ((4 + (b) * 2 + (h)) * HTB)
#define PG8_STAGE(bufoff, gbase, voff) do { _Pragma("unroll") for (int _i = 0; _i < 2; ++_i) \
        __builtin_amdgcn_global_load_lds((const unsigned*)((const char*)(gbase) + (voff)[_i]), (PG8_LAS unsigned*)(lds + (bufoff) + ldsw + _i * 8192), 16, 0, 0); } while (0)
#define PG8_LDA(dst, b, h) do { _Pragma("unroll") for (int m = 0; m < 4; ++m) _Pragma("unroll") for (int k = 0; k < 2; ++k) dst[m][k] = *(const PG8_LAS bf16x8*)(lds + PG8_SA(b, h) + aoff + m * 2048 + k * 1024); } while (0)
#define PG8_LDB(dst, b, h) do { _Pragma("unroll") for (int n = 0; n < 2; ++n) _Pragma("unroll") for (int k = 0; k < 2; ++k) dst[n][k] = *(const PG8_LAS bf16x8*)(lds + PG8_SB(b, h) + boff + n * 2048 + k * 1024); } while (0)
#define PG8_MMA(ai, bj, At, Bt) do { __builtin_amdgcn_s_setprio(1); _Pragma("unroll") for (int m = 0; m < 4; ++m) _Pragma("unroll") for (int n = 0; n < 2; ++n) _Pragma("unroll") for (int k = 0; k < 2; ++k) \
        acc[ai][bj][m][n] = __builtin_amdgcn_mfma_f32_16x16x32_bf16(Bt[n][k], At[m][k], acc[ai][bj][m][n], 0, 0, 0); __builtin_amdgcn_s_setprio(0); } while (0)
#define PG8_WAIT_V(n) asm volatile("s_waitcnt vmcnt(" #n ")" ::: "memory")
#define PG8_WAIT_L(n) asm volatile("s_waitcnt lgkmcnt(" #n ")" ::: "memory")
#define PG8_BAR __builtin_amdgcn_s_barrier()
#define PG8_SCHED __builtin_amdgcn_sched_barrier(0)
#define PG8_AOFF(dst, u) do { _Pragma("unroll") for (int _h = 0; _h < 2; ++_h) _Pragma("unroll") for (int _i = 0; _i < 2; ++_i) dst[_h][_i] = (S.arow(u, _h * HALF + RA[_i]) * (unsigned)K + (unsigned)CA[_i]) * 2u; } while (0)
    Unit cur, nxt; int ui = 0;
    if (!S.next(0, cur)) return;
    f32x4 acc[2][2][4][2];
#pragma unroll
    for (int a = 0; a < 2; ++a)
#pragma unroll
        for (int b = 0; b < 2; ++b)
#pragma unroll
            for (int m = 0; m < 4; ++m)
#pragma unroll
                for (int n = 0; n < 2; ++n) acc[a][b][m][n] = (f32x4){0.f, 0.f, 0.f, 0.f};
    bf16x8 At[4][2], B0[2][2], B1[2][2];
    unsigned offc[2][2], offn[2][2];
    PG8_AOFF(offc, cur);
    const char* const cA = (const char*)g.A; const char* cB = (const char*)g.Bt + (size_t)cur.pn * tstep;
    PG8_STAGE(PG8_SB(0, 0), cB, voffB); PG8_STAGE(PG8_SB(0, 1), cB + hstep, voffB); PG8_STAGE(PG8_SA(0, 0), cA, offc[0]); PG8_STAGE(PG8_SA(0, 1), cA, offc[1]);
    if (wr == 1) PG8_BAR;
    PG8_WAIT_V(2); PG8_BAR;
    PG8_STAGE(PG8_SB(1, 0), cB + kstep, voffB); PG8_STAGE(PG8_SA(1, 0), cA + kstep, offc[0]); PG8_STAGE(PG8_SB(1, 1), cB + hstep + kstep, voffB);
    PG8_WAIT_V(6); PG8_BAR;
    for (;;) {
        const bool has_next = S.next(ui + 1, nxt);
        if (has_next) { PG8_AOFF(offn, nxt); }
        else {
#pragma unroll
            for (int h = 0; h < 2; ++h)
#pragma unroll
                for (int i = 0; i < 2; ++i) offn[h][i] = offc[h][i]; }
        const char* nB = has_next ? (const char*)g.Bt + (size_t)nxt.pn * tstep : cB;
        for (int t = 0; t < nt; t += 2) {
            const bool last = (t == nt - 2);
            const char* a1 = cA + (size_t)(t + 1) * kstep;
            const char* a2 = last ? cA : cA + (size_t)(t + 2) * kstep; const char* b2 = last ? nB : cB + (size_t)(t + 2) * kstep;
            const char* a3 = a2 + kstep; const char* b3 = b2 + kstep;
            unsigned o2[2][2];
#pragma unroll
            for (int h = 0; h < 2; ++h)
#pragma unroll
                for (int i = 0; i < 2; ++i) o2[h][i] = last ? offn[h][i] : offc[h][i];
            PG8_LDB(B0, 0, 0); PG8_LDB(B1, 0, 1); PG8_SCHED; PG8_LDA(At, 0, 0); PG8_STAGE(PG8_SA(1, 1), a1, offc[1]);
            PG8_WAIT_V(8); PG8_WAIT_L(0); PG8_BAR; PG8_MMA(0, 0, At, B0); PG8_MMA(0, 1, At, B1); PG8_BAR; PG8_SCHED;
            PG8_LDA(At, 0, 1); PG8_STAGE(PG8_SB(0, 0), b2, voffB); PG8_STAGE(PG8_SB(0, 1), b2 + hstep, voffB); PG8_STAGE(PG8_SA(0, 0), a2, o2[0]);
            PG8_WAIT_V(8); PG8_WAIT_L(0); PG8_BAR; PG8_MMA(1, 0, At, B0); PG8_MMA(1, 1, At, B1); PG8_BAR; PG8_SCHED;
            PG8_LDB(B0, 1, 0); PG8_LDB(B1, 1, 1); PG8_SCHED; PG8_LDA(At, 1, 0); PG8_STAGE(PG8_SA(0, 1), a2, o2[1]);
            PG8_WAIT_V(8); PG8_WAIT_L(0); PG8_BAR; PG8_MMA(0, 0, At, B0); PG8_MMA(0, 1, At, B1); PG8_BAR; PG8_SCHED;
            PG8_LDA(At, 1, 1); PG8_STAGE(PG8_SB(1, 0), b3, voffB); PG8_STAGE(PG8_SB(1, 1), b3 + hstep, voffB); PG8_STAGE(PG8_SA(1, 0), a3, o2[0]);
            PG8_WAIT_V(8); PG8_WAIT_L(0); PG8_BAR; PG8_MMA(1, 0, At, B0); PG8_MMA(1, 1, At, B1); PG8_BAR; PG8_SCHED;
        }
        if constexpr (ALIGN_EPI) { if (wr == 0) PG8_BAR; }
        E(acc, cur, wr, wc, fr, fq);
        if (!has_next) break;
#pragma unroll
        for (int a = 0; a < 2; ++a)
#pragma unroll
            for (int b = 0; b < 2; ++b)
#pragma unroll
                for (int m = 0; m < 4; ++m)
#pragma unroll
                    for (int n = 0; n < 2; ++n) acc[a][b][m][n] = (f32x4){0.f, 0.f, 0.f, 0.f};
        cur = nxt; cB = nB; ++ui;
#pragma unroll
        for (int h = 0; h < 2; ++h)
#pragma unroll
            for (int i = 0; i < 2; ++i) offc[h][i] = offn[h][i];
        if constexpr (ALIGN_EPI) { if (wr == 1) PG8_BAR; }
    }
    PG8_WAIT_V(0);
    if constexpr (!ALIGN_EPI) { if (wr == 0) PG8_BAR; }
    PG8_BAR;
#undef PG8_SA
#undef PG8_SB
#undef PG8_STAGE
#undef PG8_LDA
#undef PG8_LDB
#undef PG8_MMA
#undef PG8_WAIT_V
#undef PG8_WAIT_L
#undef PG8_BAR
#undef PG8_SCHED
#undef PG8_AOFF
}
}

#define XB_TMO      128
#define XB_XCNT(j)  (256  + 64 * (j))
#define XB_XSUB(j)  (1280 + 64 * (j))
#define XB_XGEN(j)  (2304 + 64 * (j))
#define XB_TOP      3328
#define XB_TOPGEN   3392
#define XCD_BAR_WORDS 3456
#define XB_SPIN_CAP (1u << 18)

__device__ __forceinline__ unsigned xb_ld(unsigned* p)              { return __hip_atomic_load(p, __ATOMIC_RELAXED, __HIP_MEMORY_SCOPE_AGENT); }
__device__ __forceinline__ unsigned xb_add(unsigned* p, unsigned v) { return __hip_atomic_fetch_add(p, v, __ATOMIC_RELAXED, __HIP_MEMORY_SCOPE_AGENT); }
__device__ __forceinline__ unsigned xb_xcc_id() { return (unsigned)__builtin_amdgcn_s_getreg((3 << 11) | 20) & 0xFu; }
#define XB_SPIN(cond, bar) do { unsigned _sp = 0; while (cond) { __builtin_amdgcn_s_sleep(1); \
    if ((++_sp & 255u) == 0u) { if (xb_ld(&(bar)[XB_TMO])) break; if (_sp > XB_SPIN_CAP) { atomicAdd(&(bar)[XB_TMO], 1u); break; } } } } while (0)

struct XcdBarrier { unsigned* bar; unsigned x; volatile LAS unsigned* st; };

__device__ __forceinline__ XcdBarrier xcd_barrier_post(unsigned* bar, volatile LAS unsigned* st) {
    XcdBarrier b; b.bar = bar; b.x = xb_xcc_id(); b.st = st;
    if (threadIdx.x == 0) (void)xb_add(&bar[XB_XCNT(b.x)], 1u);
    return b;
}
__device__ __forceinline__ void xcd_barrier_complete(unsigned* bar, unsigned x, unsigned& nloc, unsigned& nx) {
    const unsigned G = gridDim.x * gridDim.y * gridDim.z;
    unsigned sum, cnt, mine, sp = 0u;
    for (;;) {
        sum = 0u; cnt = 0u; mine = 0u;
#pragma unroll
        for (unsigned j = 0; j < 16; ++j) { const unsigned c = xb_ld(&bar[XB_XCNT(j)]); sum += c; cnt += (c > 0u) ? 1u : 0u; mine = (j == x) ? c : mine; }
        if (sum == G) break;
        __builtin_amdgcn_s_sleep(1);
        if ((++sp & 255u) == 0u) { if (xb_ld(&bar[XB_TMO])) break; if (sp > XB_SPIN_CAP) { atomicAdd(&bar[XB_TMO], 1u); break; } }
    }
    nloc = mine > 0u ? mine : 1u; nx = cnt > 0u ? cnt : 1u;
}
__device__ __forceinline__ void xcd_barrier(const XcdBarrier& b) {
    asm volatile("s_waitcnt vmcnt(0)" ::: "memory");
    __syncthreads();
    if (threadIdx.x == 0) {
        unsigned* bar = b.bar;
        __builtin_amdgcn_s_waitcnt(0);
        unsigned nloc = b.st[0], nx = b.st[1];
        if (nloc == 0u) { xcd_barrier_complete(bar, b.x, nloc, nx); b.st[0] = nloc; b.st[1] = nx; }
        const unsigned old = xb_add(&bar[XB_XSUB(b.x)], 1u);
        const unsigned gen = old / nloc;
        if (old + 1u == (gen + 1u) * nloc) {
            __builtin_amdgcn_fence(__ATOMIC_RELEASE, "agent");
            asm volatile("s_waitcnt vmcnt(0)" ::: "memory");
            const unsigned og = xb_add(&bar[XB_TOP], 1u);
            const unsigned tg = og / nx;
            if (og + 1u == (tg + 1u) * nx) xb_add(&bar[XB_TOPGEN], 1u);
            else XB_SPIN(xb_ld(&bar[XB_TOPGEN]) == tg, bar);
            __builtin_amdgcn_fence(__ATOMIC_ACQUIRE, "agent");
            xb_add(&bar[XB_XGEN(b.x)], 1u);
            asm volatile("s_waitcnt vmcnt(0)" ::: "memory");
        } else {
            XB_SPIN(xb_ld(&bar[XB_XGEN(b.x)]) == gen, bar);
            __builtin_amdgcn_fence(__ATOMIC_ACQUIRE, "agent");
            asm volatile("s_waitcnt vmcnt(0)" ::: "memory");
        }
    }
    __syncthreads();
}

__device__ __forceinline__ void transpose_item(const float* W, int K, int N, bf16* WT, int kb, int nb, int dst_row0, LAS float* scr, int lane) {
    const int k0 = 64 * kb, n0 = 32 * nb;
#pragma unroll 8
    for (int i = 0; i < 32; ++i) { const int kk = 2 * i + (lane >> 5); scr[kk * 33 + (lane & 31)] = W[(size_t)(k0 + kk) * N + n0 + (lane & 31)]; }
    LDS_WAIT(); asm volatile("" ::: "memory");
    const int c = lane & 7;
#pragma unroll
    for (int j = 0; j < 4; ++j) { const int n = (lane >> 3) + 8 * j; const LAS float* s = scr + (8 * c) * 33 + n;
        v4u o; o.x = pk2(s[0 * 33], s[1 * 33]); o.y = pk2(s[2 * 33], s[3 * 33]); o.z = pk2(s[4 * 33], s[5 * 33]); o.w = pk2(s[6 * 33], s[7 * 33]);
        *(GAS v4u*)(WT + (size_t)(dst_row0 + n) * K + k0 + 8 * c) = o; }
    LDS_WAIT(); asm volatile("" ::: "memory");
}
__device__ __forceinline__ void transpose_plain(const float* W, int K, int N, bf16* WT, LAS float* scr, int gw, int ngw, int lane) {
    const int nblk = N / 32, nitems = (K / 64) * nblk;
    for (int it = gw; it < nitems; it += ngw) { const int kb = it / nblk, nb = it % nblk; transpose_item(W, K, N, WT, kb, nb, 32 * nb, scr, lane); }
}
__device__ __forceinline__ void transpose_moe(const float* w1, const float* w3, const float* w2, bf16* W13T, bf16* W2T, LAS float* scr, int gw, int ngw, int lane) {
    constexpr int I13 = 16 * 16, I2 = 8 * 32, IPE = 2 * I13 + I2;
    for (int it = gw; it < NEXP * IPE; it += ngw) {
        const int e = it / IPE; int r = it % IPE;
        if (r < 2 * I13) { const int which = r / I13; r %= I13; const int kb = r / 16, nb = r % 16, n0 = 32 * nb;
            const float* W = (which ? w3 : w1) + (size_t)e * 1024 * 512;
            transpose_item(W, 1024, 512, W13T + (size_t)e * 1024 * 1024, kb, nb, (n0 >> 7) * 256 + which * 128 + (n0 & 127), scr, lane);
        } else { r -= 2 * I13; const int kb = r / 32, nb = r % 32;
            transpose_item(w2 + (size_t)e * 512 * 1024, 512, 1024, W2T + (size_t)e * 1024 * 512, kb, nb, 32 * nb, scr, lane); }
    }
}
__device__ __forceinline__ void rms_row(const float* xrow, const float* g, f32x4 (&v)[4], int lane) {
    const GAS f32x4* xr = (const GAS f32x4*)xrow + lane; const GAS f32x4* gr = (const GAS f32x4*)g + lane;
    float s = 0.f;
#pragma unroll
    for (int j = 0; j < 4; ++j) { v[j] = xr[64 * j]; s += (v[j].x * v[j].x + v[j].y * v[j].y) + (v[j].z * v[j].z + v[j].w * v[j].w); }
    const float rstd = 1.0f / sqrtf(wave_sum(s) * (1.f / DM) + 1e-6f);
#pragma unroll
    for (int j = 0; j < 4; ++j) { const f32x4 gg = gr[64 * j]; v[j] = v[j] * rstd * gg; }
}
__device__ __forceinline__ void store_row_bf16(bf16* orow, const f32x4 (&v)[4], int lane) {
    GAS unsigned long long* o8 = (GAS unsigned long long*)orow + lane;
#pragma unroll
    for (int j = 0; j < 4; ++j) o8[64 * j] = (unsigned long long)pk2(v[j].x, v[j].y) | ((unsigned long long)pk2(v[j].z, v[j].w) << 32);
}

__device__ __forceinline__ int t5_bucket(int rel) {
    const int n = rel < 0 ? -rel : rel; int ret = rel > 0 ? 16 : 0;
    int v;
    if (n < 8) v = n;
    else { const float nf = (float)n; int large = 8 + (int)(logf(nf / 8.0f) / 2.772588722239781f * 8.0f); v = large < 15 ? large : 15; }
    return ret + v;
}

__device__ __forceinline__ int crow(int r, int hi) { return (r & 3) + 8 * (r >> 2) + 4 * hi; }
__device__ __forceinline__ unsigned cvtpk(float lo, float hi) { unsigned r; asm volatile("v_cvt_pk_bf16_f32 %0, %1, %2" : "=v"(r) : "v"(lo), "v"(hi)); return r; }
__device__ __forceinline__ s16x4 vtr(const LAS char* p) { typedef short v4i16_t __attribute__((ext_vector_type(4))); return __builtin_bit_cast(s16x4, __builtin_amdgcn_ds_read_tr16_b64_v4i16((LAS v4i16_t*)p)); }

template <int DV, bool BIAS>
__device__ __forceinline__ void attn_unit_v0(const bf16* Qp, int ldq, const bf16* Kp, int ldk, const bf16* Vp, int ldv, bf16* Op, int ldo, const LAS float* btbl, int q0, LAS unsigned char* lds) {
    const int tid = threadIdx.x, lane = tid & 63, r32 = lane & 31, hi = lane >> 5; const int wid = __builtin_amdgcn_readfirstlane(tid >> 6);
    constexpr int ND = DV / 32;
    LAS unsigned char* ldsK = lds; LAS unsigned char* ldsV = lds + 8192; LAS float* wsf = (LAS float*)(lds + 8192 + DV * 128) + wid * 64;
    bf16x8 qr[4];
#pragma unroll
    for (int d0 = 0; d0 < 4; ++d0) qr[d0] = *(const bf16x8*)(Qp + (size_t)(wid * 32 + r32) * ldq + d0 * 16 + hi * 8);
    f32x16 o[ND];
#pragma unroll
    for (int d = 0; d < ND; ++d)
#pragma unroll
        for (int r = 0; r < 16; ++r) o[d][r] = 0.f;
    float l = 0.f;
    const int qpos = q0 + wid * 32 + r32;
    const LAS char* kp0 = (const LAS char*)ldsK + hi * 1024 + r32 * 16;
    const LAS char* vp0 = (const LAS char*)ldsV + ((lane >> 4) & 1) * 32 + (lane & 3) * 8 + (4 * hi + ((lane & 15) >> 2)) * 64;
    for (int t = 0; t < SEQ / 64; ++t) {
        __syncthreads();
        {
            const v4u kv = *(const v4u*)(Kp + (size_t)(t * 64 + lane) * ldk + wid * 8);
            *(LAS v4u*)(ldsK + wid * 1024 + lane * 16) = kv;
#pragma unroll
            for (int pp = 0; pp < ND / 2; ++pp) { const int p = wid + 8 * pp, dq = p >> 2, rg = p & 3;
                const v4u vv = *(const v4u*)(Vp + (size_t)(t * 64 + 16 * rg + (lane >> 2)) * ldv + dq * 32 + (lane & 3) * 8);
                *(LAS v4u*)(ldsV + p * 1024 + lane * 16) = vv; }
        }
        __syncthreads();
        f32x16 p0, p1;
#pragma unroll
        for (int r = 0; r < 16; ++r) { p0[r] = 0.f; p1[r] = 0.f; }
#pragma unroll
        for (int d0 = 0; d0 < 4; ++d0) {
            const bf16x8 b0 = *(const LAS bf16x8*)(kp0 + d0 * 2048), b1 = *(const LAS bf16x8*)(kp0 + d0 * 2048 + 512);
            p0 = __builtin_amdgcn_mfma_f32_32x32x16_bf16(b0, qr[d0], p0, 0, 0, 0);
            p1 = __builtin_amdgcn_mfma_f32_32x32x16_bf16(b1, qr[d0], p1, 0, 0, 0);
        }
        if (BIAS) {
            const int base = t * 64 + 4 * hi - qpos;
#pragma unroll
            for (int r = 0; r < 16; ++r) { int rel = base + (r & 3) + 8 * (r >> 2);
                int i0 = rel < -128 ? -128 : (rel > 128 ? 128 : rel); int rel1 = rel + 32; int i1 = rel1 < -128 ? -128 : (rel1 > 128 ? 128 : rel1);
                p0[r] += btbl[i0 + 128]; p1[r] += btbl[i1 + 128]; }
        }
        float sacc = 0.f;
#pragma unroll
        for (int r = 0; r < 16; ++r) { p0[r] = __builtin_amdgcn_exp2f(p0[r]); p1[r] = __builtin_amdgcn_exp2f(p1[r]); sacc += p0[r] + p1[r]; }
        l += sacc;
        v4u pw[4];
#pragma unroll
        for (int k = 0; k < 2; ++k) {
            pw[k]     = (v4u){cvtpk(p0[8 * k + 0], p0[8 * k + 1]), cvtpk(p0[8 * k + 2], p0[8 * k + 3]), cvtpk(p0[8 * k + 4], p0[8 * k + 5]), cvtpk(p0[8 * k + 6], p0[8 * k + 7])};
            pw[2 + k] = (v4u){cvtpk(p1[8 * k + 0], p1[8 * k + 1]), cvtpk(p1[8 * k + 2], p1[8 * k + 3]), cvtpk(p1[8 * k + 4], p1[8 * k + 5]), cvtpk(p1[8 * k + 6], p1[8 * k + 7])};
        }
#pragma unroll
        for (int d0 = 0; d0 < ND; ++d0)
#pragma unroll
            for (int ks = 0; ks < 4; ++ks) {
                const s16x4 lo = vtr(vp0 + d0 * 4096 + ks * 1024), hh = vtr(vp0 + d0 * 4096 + ks * 1024 + 512);
                const bf16x8 vf = (bf16x8){lo[0], lo[1], lo[2], lo[3], hh[0], hh[1], hh[2], hh[3]};
                o[d0] = __builtin_amdgcn_mfma_f32_32x32x16_bf16(__builtin_bit_cast(bf16x8, pw[ks]), vf, o[d0], 0, 0, 0);
            }
    }
    l += __shfl_xor(l, 32);
    if (hi == 0) wsf[r32] = l;
    LDS_WAIT(); asm volatile("" ::: "memory");
#pragma unroll
    for (int r = 0; r < 16; ++r) { const int row = crow(r, hi); const float rl = 1.0f / wsf[row];
#pragma unroll
        for (int d0 = 0; d0 < ND; ++d0) Op[(size_t)(wid * 32 + row) * ldo + d0 * 32 + r32] = (bf16)f2bf(o[d0][r] * rl); }
    LDS_WAIT();
}

namespace at1 {
#define SBAR() __builtin_amdgcn_sched_barrier(0)
#define PIN(x) asm volatile("" : "+v"(x))
template <int N, bool NOBAR = false> __device__ __forceinline__ void wait_bar() { if (NOBAR) asm volatile("s_waitcnt vmcnt(%0) lgkmcnt(0)" :: "n"(N) : "memory"); else asm volatile("s_waitcnt vmcnt(%0) lgkmcnt(0)\n\ts_barrier" :: "n"(N) : "memory"); }
__device__ __forceinline__ void glds16(const void* gsrc, unsigned lds_dst) { unsigned keep;
    asm volatile("s_mov_b32 %0, m0\n\ts_mov_b32 m0, %2\n\ts_nop 0\n\tglobal_load_lds_dwordx4 %1, off\n\ts_mov_b32 m0, %0" : "=&s"(keep) : "v"(gsrc), "s"(lds_dst) : "memory"); }
typedef float f32x2_t __attribute__((ext_vector_type(2))); typedef __bf16 bf16x2_t __attribute__((ext_vector_type(2)));
__device__ __forceinline__ unsigned cvtpk_s(float lo, float hi) { f32x2_t v = {lo, hi}; bf16x2_t b = __builtin_convertvector(v, bf16x2_t); return __builtin_bit_cast(unsigned, b); }
typedef const LAS char* lds_cptr;
__device__ __forceinline__ void kload2(bf16x8* kf, lds_cptr kp, int j) { kf[2 * j] = *(const LAS bf16x8*)(kp + j * 2048); kf[2 * j + 1] = *(const LAS bf16x8*)(kp + j * 2048 + 512); }

template <int DV, bool BIAS, int TEST = 0, int MODE = 0>
__device__ __forceinline__ void attn_unit(const bf16* Qp, int ldq, const bf16* __restrict__ Kp, int ldk, const bf16* __restrict__ Vp, int ldv, bf16* Op, int ldo, int q0, LAS unsigned char* lds, const LAS float* sgt = nullptr) {
    constexpr int ND = DV / 32, NV = ND / 2, VSLOT = DV * 128, KSLOT = 8192, NT = SEQ / 64;
    constexpr int LDS_K = 0, LDS_V = 3 * KSLOT, LDS_WS = LDS_V + 3 * VSLOT, LDS_TBL = LDS_WS + 2048;
    const int tid = threadIdx.x, lane = tid & 63, r32 = lane & 31, hi = lane >> 5; const int wid = __builtin_amdgcn_readfirstlane(tid >> 6);
    const unsigned lds0 = (unsigned)(uintptr_t)lds;
    LAS float* wsf = (LAS float*)(lds + LDS_WS) + wid * 64;
    const LAS float* btbl = (const LAS float*)(lds + LDS_TBL);
    const bf16* ksrc = Kp + (size_t)lane * ldk + wid * 8;
    const bf16* vsrc0 = Vp + (size_t)(16 * (wid & 3) + (lane >> 2)) * ldv + (wid >> 2) * 32 + (lane & 3) * 8;
    const bf16* vsrc1 = vsrc0 + 64;
    const unsigned kdst = lds0 + LDS_K + wid * 1024, vdst = lds0 + LDS_V + wid * 1024;
#define DMA_K(t, s) if (!(TEST & 8)) glds16(ksrc + (size_t)(t) * 64 * ldk, (unsigned)__builtin_amdgcn_readfirstlane(kdst + (s) * KSLOT))
#define DMA_V(t, s) do { if (TEST & 8) break; glds16(vsrc0 + (size_t)(t) * 64 * ldv, (unsigned)__builtin_amdgcn_readfirstlane(vdst + (s) * VSLOT)); \
        if (NV == 2) glds16(vsrc1 + (size_t)(t) * 64 * ldv, (unsigned)__builtin_amdgcn_readfirstlane(vdst + (s) * VSLOT + 8192)); } while (0)
    const lds_cptr kp0 = (lds_cptr)lds + LDS_K + hi * 1024 + r32 * 16;
    const lds_cptr vp0 = (lds_cptr)lds + LDS_V + ((lane >> 4) & 1) * 32 + (lane & 3) * 8 + (4 * hi + ((lane & 15) >> 2)) * 64;
    DMA_K(0, 0); DMA_V(0, 0); DMA_K(1, 1);
    bf16x8 qr[4];
#pragma unroll
    for (int d0 = 0; d0 < 4; ++d0) qr[d0] = *(const bf16x8*)(Qp + (size_t)(wid * 32 + r32) * ldq + d0 * 16 + hi * 8);
    float l_reg = 0.f; f32x16 o[ND];
#pragma unroll
    for (int d = 0; d < ND; ++d) o[d] = f32x16{};
    const f32x16 zero16 = f32x16{};
    const int qw = q0 + wid * 32, qpos = qw + r32;
    int tl = 0, tr = NT; float fL = 1.f;
    if (BIAS) { tl = (qw - 191 >= 0) ? ((qw - 191) >> 6) + 1 : 0; tr = (qw + 158) >> 6; fL = __builtin_amdgcn_exp2f(btbl[0]); }
    f32x16 pA0, pA1, pB0, pB1; bf16x8 kf[8]; s16x4 vlo[8], vhi[8]; v4u pw0, pw1, pw2, pw3;
    if (TEST & 32) { pB0 = f32x16{}; pB1 = f32x16{}; }
    if (TEST & 64) { _Pragma("unroll") for (int i_ = 0; i_ < 8; ++i_) { vlo[i_] = (s16x4){1, 2, 3, 4}; vhi[i_] = (s16x4){4, 3, 2, 1}; } }
    int s_prev = 0, s_cur = 0, s_next = 1;
#define ROT() do { s_prev = s_cur; s_cur = s_next; s_next = (s_next == 2) ? 0 : s_next + 1; } while (0)
#define ADD_BIAS(C0, C1, t) do { if (BIAS && (t) >= tl && (t) <= tr) { const int base_ = (t) * 64 + 4 * hi - qpos; \
        _Pragma("unroll") for (int r = 0; r < 16; ++r) { const int rel0 = base_ + (r & 3) + 8 * (r >> 2); const int rel1 = rel0 + 32; \
            const int i0 = (rel0 < -128 ? -128 : (rel0 > 128 ? 128 : rel0)) + 128, i1 = (rel1 < -128 ? -128 : (rel1 > 128 ? 128 : rel1)) + 128; \
            C0[r] += btbl[i0]; C1[r] += btbl[i1]; } } } while (0)
    DMA_K(2, 2);
    wait_bar<NV + 2, (TEST & 16) != 0>();
    {
#pragma unroll
        for (int j = 0; j < 4; ++j) kload2(kf, kp0, j);
        pA0 = __builtin_amdgcn_mfma_f32_32x32x16_bf16(kf[0], qr[0], zero16, 0, 0, 0); pA1 = __builtin_amdgcn_mfma_f32_32x32x16_bf16(kf[1], qr[0], zero16, 0, 0, 0);
#pragma unroll
        for (int d0 = 1; d0 < 4; ++d0) { pA0 = __builtin_amdgcn_mfma_f32_32x32x16_bf16(kf[2 * d0], qr[d0], pA0, 0, 0, 0); pA1 = __builtin_amdgcn_mfma_f32_32x32x16_bf16(kf[2 * d0 + 1], qr[d0], pA1, 0, 0, 0); }
        ADD_BIAS(pA0, pA1, 0);
#pragma unroll
        for (int r = 0; r < 16; ++r) { pA0[r] = __builtin_amdgcn_exp2f(pA0[r]); pA1[r] = __builtin_amdgcn_exp2f(pA1[r]); }
    }
    wait_bar<0, (TEST & 16) != 0>();
    DMA_K(3, 0); DMA_V(1, 1);
    ROT();
#pragma unroll
    for (int j = 0; j < 4; ++j) kload2(kf, kp0 + s_cur * KSLOT, j);
    wait_bar<1 + NV, (TEST & 16) != 0>();
#define PKW(P, B) ((TEST & 256) ? 0x3f803f80u : cvtpk_s(P[B], P[B + 1]))
#define PAF(k) __builtin_bit_cast(bf16x8, pw##k)
#define VFR(i) (bf16x8){vlo[i][0], vlo[i][1], vlo[i][2], vlo[i][3], vhi[i][0], vhi[i][1], vhi[i][2], vhi[i][3]}
#define MF(a, b, c) __builtin_amdgcn_mfma_f32_32x32x16_bf16(a, b, c, 0, 0, 0)
#define GAPA(MFS, A0, A1, A2, A3, W0, W1, PW) do { if (!(TEST & 32)) { MFS; } if (!(TEST & 2)) { sacc += A0; sacc += A1; sacc += A2; sacc += A3; PIN(sacc); } W0; W1; PIN(PW); SBAR(); } while (0)
#define EX(v) ((TEST & 1) ? (v) : __builtin_amdgcn_exp2f(v))
#define GAPB4(MFS, X, B) do { if (!(TEST & 4)) { MFS; } X[B] = EX(X[B]); X[B + 1] = EX(X[B + 1]); X[B + 2] = EX(X[B + 2]); X[B + 3] = EX(X[B + 3]); PIN(X); SBAR(); } while (0)
#define GAPB2(MFS, X, B) do { if (!(TEST & 4)) { MFS; } X[B] = EX(X[B]); X[B + 1] = EX(X[B + 1]); PIN(X); SBAR(); } while (0)
#define VRD(f, s) do { if (TEST & 64) break; vlo[s] = vtr(vp_ + (((f) >> 2) * 4096 + ((f) & 3) * 1024)); vhi[s] = vtr(vp_ + (((f) >> 2) * 4096 + ((f) & 3) * 1024 + 512)); } while (0)
#define KRD(G, j) do { if ((G) && !(TEST & 128)) { kload2(kf, kp0 + s_next * KSLOT, j); SBAR(); } } while (0)
#define FO(m) (ND == 2 ? (((m) >> 1) + 4 * ((m) & 1)) : ((((m) & 7) >> 2) + 2 * ((m) >> 3) + 4 * ((m) & 3)))
#define STEP(C0, C1, P0, P1, t, GK, GV, GL) do { SBAR(); \
    const lds_cptr vp_ = vp0 + s_prev * VSLOT; \
    VRD(FO(0), 0); SBAR(); float sacc = (P0[0] + P0[1]); \
    GAPA(C0 = MF(kf[0], qr[0], zero16), P0[2], P0[3], P0[4], P0[5],     pw0[0] = PKW(P0, 0), pw0[1] = PKW(P0, 2), pw0); \
    VRD(FO(1), 1); SBAR(); GAPA(C1 = MF(kf[1], qr[0], zero16), P0[6], P0[7], P0[8], P0[9],     pw0[2] = PKW(P0, 4), pw0[3] = PKW(P0, 6), pw0); \
    VRD(FO(2), 2); SBAR(); GAPA(C0 = MF(kf[2], qr[1], C0),   P0[10], P0[11], P0[12], P0[13], pw1[0] = PKW(P0, 8), pw1[1] = PKW(P0, 10), pw1); \
    VRD(FO(3), 3); SBAR(); GAPA(C1 = MF(kf[3], qr[1], C1),   P0[14], P0[15], P1[0], P1[1],   pw1[2] = PKW(P0, 12), pw1[3] = PKW(P0, 14), pw1); \
    VRD(FO(4), 4); SBAR(); GAPA(C0 = MF(kf[4], qr[2], C0),   P1[2], P1[3], P1[4], P1[5],     pw2[0] = PKW(P1, 0), pw2[1] = PKW(P1, 2), pw2); \
    VRD(FO(5), 5); SBAR(); GAPA(C1 = MF(kf[5], qr[2], C1),   P1[6], P1[7], P1[8], P1[9],     pw2[2] = PKW(P1, 4), pw2[3] = PKW(P1, 6), pw2); \
    VRD(FO(6), 6); SBAR(); GAPA(C0 = MF(kf[6], qr[3], C0),   P1[10], P1[11], P1[12], P1[13], pw3[0] = PKW(P1, 8), pw3[1] = PKW(P1, 10), pw3); \
    VRD(FO(7), 7); SBAR(); GAPA(C1 = MF(kf[7], qr[3], C1),   P1[14], P1[15], 0.f, 0.f,       pw3[2] = PKW(P1, 12), pw3[3] = PKW(P1, 14), pw3); \
    l_reg += sacc; \
    if (GK) { DMA_K((t) + 3, s_cur); } if (GV) { DMA_V((t) + 1, s_next); } \
    ADD_BIAS(C0, C1, t); \
    SBAR(); \
    if (ND == 2) { \
        GAPB4(o[0] = MF(PAF(0), VFR(0), o[0]), C0, 0); \
        GAPB4(o[1] = MF(PAF(0), VFR(1), o[1]), C0, 4); \
        KRD(GL, 0); GAPB4(o[0] = MF(PAF(1), VFR(2), o[0]), C0, 8); \
        KRD(GL, 1); GAPB4(o[1] = MF(PAF(1), VFR(3), o[1]), C0, 12); \
        KRD(GL, 2); GAPB4(o[0] = MF(PAF(2), VFR(4), o[0]), C1, 0); \
        KRD(GL, 3); GAPB4(o[1] = MF(PAF(2), VFR(5), o[1]), C1, 4); \
        GAPB4(o[0] = MF(PAF(3), VFR(6), o[0]), C1, 8); \
        GAPB4(o[1] = MF(PAF(3), VFR(7), o[1]), C1, 12); \
    } else { \
        GAPB2(o[0] = MF(PAF(0), VFR(0), o[0]), C0, 0);  VRD(FO(8), 0); SBAR(); \
        GAPB2(o[1] = MF(PAF(0), VFR(1), o[1]), C0, 2);  VRD(FO(9), 1); SBAR(); \
        GAPB2(o[ND - 2] = MF(PAF(0), VFR(2), o[ND - 2]), C0, 4);  VRD(FO(10), 2); SBAR(); \
        GAPB2(o[ND - 1] = MF(PAF(0), VFR(3), o[ND - 1]), C0, 6);  VRD(FO(11), 3); SBAR(); \
        GAPB2(o[0] = MF(PAF(1), VFR(4), o[0]), C0, 8);  VRD(FO(12), 4); SBAR(); \
        GAPB2(o[1] = MF(PAF(1), VFR(5), o[1]), C0, 10); VRD(FO(13), 5); SBAR(); \
        GAPB2(o[ND - 2] = MF(PAF(1), VFR(6), o[ND - 2]), C0, 12); VRD(FO(14), 6); SBAR(); \
        GAPB2(o[ND - 1] = MF(PAF(1), VFR(7), o[ND - 1]), C0, 14); VRD(FO(15), 7); SBAR(); \
        KRD(GL, 0); GAPB2(o[0] = MF(PAF(2), VFR(0), o[0]), C1, 0); \
        GAPB2(o[1] = MF(PAF(2), VFR(1), o[1]), C1, 2); \
        KRD(GL, 1); GAPB2(o[ND - 2] = MF(PAF(2), VFR(2), o[ND - 2]), C1, 4); \
        GAPB2(o[ND - 1] = MF(PAF(2), VFR(3), o[ND - 1]), C1, 6); \
        KRD(GL, 2); GAPB2(o[0] = MF(PAF(3), VFR(4), o[0]), C1, 8); \
        GAPB2(o[1] = MF(PAF(3), VFR(5), o[1]), C1, 10); \
        KRD(GL, 3); GAPB2(o[ND - 2] = MF(PAF(3), VFR(6), o[ND - 2]), C1, 12); \
        GAPB2(o[ND - 1] = MF(PAF(3), VFR(7), o[ND - 1]), C1, 14); \
    } \
    if (BIAS && (t) == tl) { l_reg *= fL; _Pragma("unroll") for (int d_ = 0; d_ < ND; ++d_) _Pragma("unroll") for (int r = 0; r < 16; ++r) o[d_][r] *= fL; } \
    } while (0)
    int t = 1;
    for (; t + 4 < NT; t += 2) {
        STEP(pB0, pB1, pA0, pA1, t, true, true, true);       wait_bar<1 + NV, (TEST & 16) != 0>(); ROT();
        STEP(pA0, pA1, pB0, pB1, t + 1, true, true, true);   wait_bar<1 + NV, (TEST & 16) != 0>(); ROT();
    }
    STEP(pB0, pB1, pA0, pA1, NT - 3, false, true, true);  wait_bar<NV, (TEST & 16) != 0>(); ROT();
    STEP(pA0, pA1, pB0, pB1, NT - 2, false, true, true);  wait_bar<0, (TEST & 16) != 0>();  ROT();
    STEP(pB0, pB1, pA0, pA1, NT - 1, false, false, false);
    {
        float sacc = pB0[0] + pB0[1];
#pragma unroll
        for (int r = 2; r < 16; ++r) sacc += pB0[r];
#pragma unroll
        for (int r = 0; r < 16; ++r) sacc += pB1[r];
        l_reg += sacc;
        pw0 = (v4u){PKW(pB0, 0), PKW(pB0, 2), PKW(pB0, 4), PKW(pB0, 6)}; pw1 = (v4u){PKW(pB0, 8), PKW(pB0, 10), PKW(pB0, 12), PKW(pB0, 14)};
        pw2 = (v4u){PKW(pB1, 0), PKW(pB1, 2), PKW(pB1, 4), PKW(pB1, 6)}; pw3 = (v4u){PKW(pB1, 8), PKW(pB1, 10), PKW(pB1, 12), PKW(pB1, 14)};
        const lds_cptr vp_ = vp0 + s_cur * VSLOT;
#pragma unroll
        for (int d0 = 0; d0 < ND; ++d0) {
            s16x4 a0 = vtr(vp_ + d0 * 4096), b0 = vtr(vp_ + d0 * 4096 + 512), a1 = vtr(vp_ + d0 * 4096 + 1024), b1 = vtr(vp_ + d0 * 4096 + 1536);
            s16x4 a2 = vtr(vp_ + d0 * 4096 + 2048), b2 = vtr(vp_ + d0 * 4096 + 2560), a3 = vtr(vp_ + d0 * 4096 + 3072), b3 = vtr(vp_ + d0 * 4096 + 3584);
            o[d0] = MF(PAF(0), ((bf16x8){a0[0], a0[1], a0[2], a0[3], b0[0], b0[1], b0[2], b0[3]}), o[d0]);
            o[d0] = MF(PAF(1), ((bf16x8){a1[0], a1[1], a1[2], a1[3], b1[0], b1[1], b1[2], b1[3]}), o[d0]);
            o[d0] = MF(PAF(2), ((bf16x8){a2[0], a2[1], a2[2], a2[3], b2[0], b2[1], b2[2], b2[3]}), o[d0]);
            o[d0] = MF(PAF(3), ((bf16x8){a3[0], a3[1], a3[2], a3[3], b3[0], b3[1], b3[2], b3[3]}), o[d0]);
        }
    }
    l_reg += __shfl_xor(l_reg, 32);
    int lane_e = lane; asm volatile("" : "+v"(lane_e));
    const int r32e = lane_e & 31, hie = lane_e >> 5;
    if (hie == 0) wsf[r32e] = l_reg;
    asm volatile("s_waitcnt lgkmcnt(0)\n\ts_barrier" ::: "memory");
    {
        LAS bf16* stg = (LAS bf16*)(MODE == 1 ? lds + STASH_OFF : lds) + wid * (32 * DV);
#pragma unroll
        for (int r = 0; r < 16; ++r) { const int orow = crow(r, hie); const float rl = __builtin_amdgcn_rcpf(wsf[orow]);
#pragma unroll
            for (int d0 = 0; d0 < ND; ++d0) stg[orow * DV + d0 * 32 + r32e] = (bf16)f2bf(o[d0][r] * rl); }
        asm volatile("s_waitcnt lgkmcnt(0)" ::: "memory");
        if (MODE == 0) {
            constexpr int CPR = DV / 8;
#pragma unroll
            for (int i = 0; i < (32 * CPR) / 64; ++i) { const int row = i * (64 / CPR) + lane_e / CPR, ch = lane_e % CPR;
                const v4u v = *(const LAS v4u*)(stg + row * DV + ch * 8); *(v4u*)(Op + (size_t)(wid * 32 + row) * ldo + ch * 8) = v; }
        } else if (MODE == 2) {
            const int row = lane_e >> 1, half = lane_e & 1; const float lam = sgt[128];
            const LAS bf16* s1 = stg + row * DV + half * 64; const LAS bf16* s0 = (const LAS bf16*)(lds + STASH_OFF) + wid * (32 * DV) + row * DV + half * 64;
            float ov[64]; float ss = 0.f;
#pragma unroll
            for (int q = 0; q < 8; ++q) { const v4u a = *(const LAS v4u*)(s0 + q * 8), c = *(const LAS v4u*)(s1 + q * 8);
#pragma unroll
                for (int j = 0; j < 4; ++j) { const float lo = __builtin_bit_cast(float, a[j] << 16) - lam * __builtin_bit_cast(float, c[j] << 16);
                    const float hh = __builtin_bit_cast(float, a[j] & 0xffff0000u) - lam * __builtin_bit_cast(float, c[j] & 0xffff0000u);
                    ov[q * 8 + 2 * j] = lo; ov[q * 8 + 2 * j + 1] = hh; ss += lo * lo + hh * hh; } }
            ss += dpp_mov<0xB1>(ss);
            const float rstd = 1.0f / sqrtf(ss * (1.f / 128.f) + 1e-5f);
            bf16* yo = Op + (size_t)(wid * 32 + row) * ldo + half * 64;
#pragma unroll
            for (int q = 0; q < 8; ++q) { const f32x4 g0 = *(const LAS f32x4*)(sgt + half * 64 + q * 8), g1 = *(const LAS f32x4*)(sgt + half * 64 + q * 8 + 4);
                v4u w; w.x = pk2(ov[q * 8] * rstd * g0.x, ov[q * 8 + 1] * rstd * g0.y); w.y = pk2(ov[q * 8 + 2] * rstd * g0.z, ov[q * 8 + 3] * rstd * g0.w);
                w.z = pk2(ov[q * 8 + 4] * rstd * g1.x, ov[q * 8 + 5] * rstd * g1.y); w.w = pk2(ov[q * 8 + 6] * rstd * g1.z, ov[q * 8 + 7] * rstd * g1.w);
                *(v4u*)(yo + q * 8) = w; }
        }
    }
    asm volatile("s_waitcnt lgkmcnt(0)\n\ts_barrier" ::: "memory");
#undef DMA_K
#undef DMA_V
#undef ROT
#undef ADD_BIAS
#undef PKW
#undef PAF
#undef VFR
#undef MF
#undef GAPA
#undef EX
#undef GAPB4
#undef GAPB2
#undef VRD
#undef KRD
#undef FO
#undef STEP
}
#undef SBAR
#undef PIN
}

struct Args { const float* in[27]; float* out; unsigned char* ws; int ph_lo, ph_hi, li, pad; };

constexpr int NPHASE = 17;
constexpr int NWAVES = 8;

#define IN(k) (lo <= (k) && (k) < hi_ph)
#define SEAM(k) do { if (IN(k) && IN((k) + 1)) xcd_barrier(bar); } while (0)
template <int layer>
__device__ __forceinline__ void moe_block(const Args& args, LAS unsigned char* lds, const XcdBarrier& bar, int lo, int hi_ph) {
    volatile LAS unsigned* LC = (volatile LAS unsigned*)(lds + LDSCTL_OFF);
    const int tid = threadIdx.x, lane = tid & 63, wave = __builtin_amdgcn_readfirstlane(tid >> 6);
    const int G = gridDim.x, bx = blockIdx.x;
    const int gw = bx * NWAVES + wave, NGW = G * NWAVES;
    unsigned char* ws = args.ws;
    unsigned* ctl = (unsigned*)(ws + WS_CTL);
    float* xres = args.out;
    bf16* HB = (bf16*)(ws + WS_HB);
    {
        const int pb = layer == 0 ? 5 : 13;
        unsigned* const gcnt0 = ctl + CW_CNT + layer * 64;
        int* list = (int*)(ws + WS_LIST); int* tokep = (int*)(ws + WS_TOKEP); float* gate = (float*)(ws + WS_GATE);
        if (IN(pb)) REP(pb) {
            unsigned* gcnt = gcnt0 + ((MK_N_LAUNCHES == 1 ? (int)((PROBE_MASK >> pb) & 1u) : 0) - rep_) * 128;
            if (rep_ > 0) xcd_barrier(bar);
            const float* gf = args.in[2] + layer * DM;
            const float* WR = (const float*)(ws + WS_TBL) + TBL_WR + layer * WR_LAYER;
            for (int chunk = bx; chunk < NTOK / 128; chunk += G) {
                __syncthreads();
                if (tid < 32) LC[LC_LCNT + tid] = 0u;
                __syncthreads();
                int my_e0 = 0, my_e1 = 0; float my_g0 = 0.f, my_g1 = 0.f;
                {
                    const int ri = lane & 15, kq = lane >> 4; const int r0w = chunk * 128 + wave * 16;
                    const GAS float* xrow = (const GAS float*)(xres + (size_t)(r0w + ri) * DM) + 4 * kq;
                    const GAS float* wb = (const GAS float*)WR + (size_t)(4 * kq) * 48 + ri;
                    f32x4 acc0 = {0.f, 0.f, 0.f, 0.f}, acc1 = acc0, acc2 = acc0; float ss = 0.f;
                    f32x4 aA[4], aB[4]; float bA[48], bB[48];
#define RT_LOAD(a_, b_, g_) do { _Pragma("unroll") for (int c_ = 0; c_ < 4; ++c_) { a_[c_] = *(const GAS f32x4*)(xrow + 16 * (4 * (g_) + c_)); \
        const GAS float* wc_ = wb + (size_t)(16 * (4 * (g_) + c_)) * 48; _Pragma("unroll") for (int e_ = 0; e_ < 4; ++e_) { b_[c_ * 12 + e_ * 3] = wc_[e_ * 48]; b_[c_ * 12 + e_ * 3 + 1] = wc_[e_ * 48 + 16]; b_[c_ * 12 + e_ * 3 + 2] = wc_[e_ * 48 + 32]; } } } while (0)
#define RT_COMP(a_, b_) do { _Pragma("unroll") for (int c_ = 0; c_ < 4; ++c_) { ss += (a_[c_].x * a_[c_].x + a_[c_].y * a_[c_].y) + (a_[c_].z * a_[c_].z + a_[c_].w * a_[c_].w); \
        _Pragma("unroll") for (int e_ = 0; e_ < 4; ++e_) { acc0 = __builtin_amdgcn_mfma_f32_16x16x4f32(a_[c_][e_], b_[c_ * 12 + e_ * 3], acc0, 0, 0, 0); \
            acc1 = __builtin_amdgcn_mfma_f32_16x16x4f32(a_[c_][e_], b_[c_ * 12 + e_ * 3 + 1], acc1, 0, 0, 0); acc2 = __builtin_amdgcn_mfma_f32_16x16x4f32(a_[c_][e_], b_[c_ * 12 + e_ * 3 + 2], acc2, 0, 0, 0); } } } while (0)
                    RT_LOAD(aA, bA, 0);
#pragma unroll 1
                    for (int g = 0; g < 16; g += 2) {
                        RT_LOAD(aB, bB, g + 1);
                        RT_COMP(aA, bA);
                        if (g + 2 < 16) RT_LOAD(aA, bA, g + 2);
                        RT_COMP(aB, bB);
                    }
#undef RT_LOAD
#undef RT_COMP
                    ss += __shfl_xor(ss, 16); ss += __shfl_xor(ss, 32);
                    const float rstd = 1.0f / sqrtf(ss * (1.f / DM) + 1e-6f);
                    LAS float* Lg = (LAS float*)(lds + wave * 4096);
#pragma unroll
                    for (int r = 0; r < 4; ++r) { Lg[(4 * kq + r) * 49 + ri] = acc0[r]; Lg[(4 * kq + r) * 49 + 16 + ri] = acc1[r]; Lg[(4 * kq + r) * 49 + 32 + ri] = acc2[r]; }
                    LDS_WAIT(); asm volatile("" ::: "memory");
                    if (lane < 16) {
                        const GAS float* bv = (const GAS float*)WR + 1024 * 48;
                        float lg[4], le[32];
#pragma unroll
                        for (int e = 0; e < 4; ++e) lg[e] = Lg[lane * 49 + e] * rstd + bv[e];
#pragma unroll
                        for (int e = 0; e < 32; ++e) le[e] = Lg[lane * 49 + 4 + e] * rstd + bv[4 + e];
                        int gi = 0; float gm = lg[0];
#pragma unroll
                        for (int e = 1; e < 4; ++e) if (lg[e] > gm) { gm = lg[e]; gi = e; }
                        float gs = 0.f;
#pragma unroll
                        for (int e = 0; e < 4; ++e) gs += __expf(lg[e] - gm);
                        const float gval = 1.0f / gs;
                        float ev[8];
#pragma unroll
                        for (int j = 0; j < 8; ++j) ev[j] = gi == 0 ? le[j] : (gi == 1 ? le[8 + j] : (gi == 2 ? le[16 + j] : le[24 + j]));
                        int i0 = 0; float m0 = ev[0];
#pragma unroll
                        for (int j = 1; j < 8; ++j) if (ev[j] > m0) { m0 = ev[j]; i0 = j; }
                        int i1 = -1; float m1 = -3.0e38f;
#pragma unroll
                        for (int j = 0; j < 8; ++j) if (j != i0 && ev[j] > m1) { m1 = ev[j]; i1 = j; }
                        const float t1 = __expf(m1 - m0); const float den = 1.0f / (1.0f + t1);
                        my_e0 = gi * 8 + i0; my_e1 = gi * 8 + i1; my_g0 = gval * den; my_g1 = gval * t1 * den;
                    }
                    for (int i = 0; i < 16; ++i) { const int m = r0w + i; f32x4 v[4]; rms_row(xres + (size_t)m * DM, gf, v, lane); store_row_bf16(HB + (size_t)m * DM, v, lane); }
                }
                unsigned r0 = 0, r1 = 0;
                if (lane < 16) { r0 = atomicAdd((unsigned*)(LC + LC_LCNT + my_e0), 1u); r1 = atomicAdd((unsigned*)(LC + LC_LCNT + my_e1), 1u); }
                __syncthreads();
                if (tid < 32) { const unsigned c = LC[LC_LCNT + tid]; LC[LC_LBASE + tid] = c ? __hip_atomic_fetch_add(gcnt + tid, c, RLX_AGENT) : 0u; }
                __syncthreads();
                if (lane < 16) { const int m = chunk * 128 + wave * 16 + lane;
                    const unsigned p0 = LC[LC_LBASE + my_e0] + r0, p1 = LC[LC_LBASE + my_e1] + r1;
                    list[(size_t)my_e0 * LIST_CAP + p0] = m; list[(size_t)my_e1 * LIST_CAP + p1] = m;
                    tokep[2 * m] = my_e0 | (int)(p0 << 8); tokep[2 * m + 1] = my_e1 | (int)(p1 << 8);
                    gate[2 * m] = my_g0; gate[2 * m + 1] = my_g1; }
            }
        }
        SEAM(pb);
        if (IN(pb + 1) || IN(pb + 2) || IN(pb + 3)) {
            __syncthreads();
            if (tid == 0) { int acc = 0; for (int e = 0; e < 32; ++e) { const int c = (int)__hip_atomic_load(gcnt0 + e, RLX_AGENT); LC[LC_CNT + e] = (unsigned)c; LC[LC_TP + e] = (unsigned)acc; acc += (c + 255) >> 8; } LC[LC_TP + 32] = (unsigned)acc;
                int la = 0; for (int j = 0; j < 4; ++j) { LC[LC_LP + j] = (unsigned)la; la += ((int)LC[LC_CNT + (bx & 7) + 8 * j] + 255) >> 8; } LC[LC_LP + 4] = (unsigned)la; }
            __syncthreads();
        }
        const LAS int* tp = (const LAS int*)(lds + LDSCTL_OFF) + LC_TP; const LAS int* cn = (const LAS int*)(lds + LDSCTL_OFF) + LC_CNT; const LAS int* lp = (const LAS int*)(lds + LDSCTL_OFF) + LC_LP;
        if (IN(pb + 1)) REP(pb + 1) {
            pg8::Gemm g{HB, (const bf16*)(ws + WS_W13), 0, 1024, DM};
            pg8::MoeOrder S{tp, cn, lp, list, G, bx, tp[32] * 4, true, G == 256};
            pg8::EpiSwiglu E{(bf16*)(ws + WS_H)};
            pg8::gemm_phase<pg8::EpiSwiglu, pg8::MoeOrder, true>(lds, g, S, E);
        }
        SEAM(pb + 1);
        if (IN(pb + 2)) REP(pb + 2) {
            pg8::Gemm g{(const bf16*)(ws + WS_H), (const bf16*)(ws + WS_W2), 0, 1024, MOE_H};
            pg8::MoeOrder S{tp, cn, lp, list, G, bx, tp[32] * 4, false, G == 256};
            pg8::EpiBf16 E{(bf16*)(ws + WS_YS), DM, 0, 0, 1.f, 3};
            pg8::gemm_phase<pg8::EpiBf16, pg8::MoeOrder, true>(lds, g, S, E);
        }
        SEAM(pb + 2);
        if (IN(pb + 3)) {
            const bf16* YS = (const bf16*)(ws + WS_YS);
            if (layer == 0) { LAS float* scr = (LAS float*)(lds + wave * 16384);
                transpose_moe(args.in[24] + (size_t)NEXP * 1024 * 512, args.in[25] + (size_t)NEXP * 1024 * 512, args.in[26] + (size_t)NEXP * 1024 * 512, (bf16*)(ws + WS_W13), (bf16*)(ws + WS_W2), scr, gw, NGW, lane); }
            const float* gn = layer == 0 ? args.in[1] + DM : args.in[3];
            for (int m = gw; m < NTOK; m += NGW) {
                const int ep0 = tokep[2 * m], ep1 = tokep[2 * m + 1]; const float g0 = gate[2 * m], g1 = gate[2 * m + 1];
                const size_t s0 = (size_t)(tp[ep0 & 255] * 256 + (ep0 >> 8)), s1 = (size_t)(tp[ep1 & 255] * 256 + (ep1 >> 8));
                GAS f32x4* xr = (GAS f32x4*)(xres + (size_t)m * DM) + lane;
                const GAS v2u* y0 = (const GAS v2u*)(YS + s0 * DM) + lane; const GAS v2u* y1 = (const GAS v2u*)(YS + s1 * DM) + lane;
                f32x4 v[4]; float ss = 0.f;
#pragma unroll
                for (int j = 0; j < 4; ++j) { const v2u a = y0[64 * j], c = y1[64 * j]; f32x4 xv = xr[64 * j];
                    xv.x += g0 * __builtin_bit_cast(float, a.x << 16) + g1 * __builtin_bit_cast(float, c.x << 16);
                    xv.y += g0 * __builtin_bit_cast(float, a.x & 0xffff0000u) + g1 * __builtin_bit_cast(float, c.x & 0xffff0000u);
                    xv.z += g0 * __builtin_bit_cast(float, a.y << 16) + g1 * __builtin_bit_cast(float, c.y << 16);
                    xv.w += g0 * __builtin_bit_cast(float, a.y & 0xffff0000u) + g1 * __builtin_bit_cast(float, c.y & 0xffff0000u);
                    v[j] = xv; ss += (xv.x * xv.x + xv.y * xv.y) + (xv.z * xv.z + xv.w * xv.w); }
                const float rstd = 1.0f / sqrtf(wave_sum(ss) * (1.f / DM) + 1e-6f);
                const GAS f32x4* gr = (const GAS f32x4*)gn + lane;
                if (layer == 0) {
#pragma unroll
                    for (int j = 0; j < 4; ++j) xr[64 * j] = v[j];
#pragma unroll
                    for (int j = 0; j < 4; ++j) v[j] = v[j] * rstd * gr[64 * j];
                    store_row_bf16(HB + (size_t)m * DM, v, lane);
                } else {
#pragma unroll
                    for (int j = 0; j < 4; ++j) xr[64 * j] = v[j] * rstd * gr[64 * j];
                }
            }
        }
    }
}

__global__ void __launch_bounds__(NWAVES * 64, 2) mk_fwd(Args args) {
    extern __shared__ __attribute__((aligned(16))) unsigned char lds_raw[];
    LAS unsigned char* lds = (LAS unsigned char*)lds_raw;
    volatile LAS unsigned* LC = (volatile LAS unsigned*)(lds + LDSCTL_OFF);
    const int tid = threadIdx.x, lane = tid & 63, wave = __builtin_amdgcn_readfirstlane(tid >> 6);
    const int G = gridDim.x, bx = blockIdx.x;
    const int gw = bx * NWAVES + wave, NGW = G * NWAVES;
    unsigned char* ws = args.ws;
    unsigned* ctl = (unsigned*)(ws + WS_CTL);
    const float* x_in = args.in[0];
    float* xres = args.out;
    bf16* HB = (bf16*)(ws + WS_HB); bf16* Y = (bf16*)(ws + WS_Y);
    float* TBL = (float*)(ws + WS_TBL);

    for (int u = tid; u < (LDS_BYTES - LDSCTL_OFF) / 4; u += NWAVES * 64) LC[u] = 0u;
    __syncthreads();
    XcdBarrier bar; bar.bar = ctl + CW_BAR; bar.x = 0; bar.st = nullptr;
    if (MK_N_LAUNCHES == 1) bar = xcd_barrier_post(ctl + CW_BAR, LC + LC_BAR);
    const int lo = args.ph_lo, hi_ph = args.ph_hi;

    if (IN(0)) REP(0) {
        LAS float* scr = (LAS float*)(lds + wave * 16384);
        transpose_plain(args.in[4], DM, EV_IN, (bf16*)(ws + WS_WIN0), scr, gw, NGW, lane);
        transpose_plain(args.in[11], DM, DM, (bf16*)(ws + WS_WOUT0), scr, gw, NGW, lane);
        transpose_plain(args.in[12], DM, OD_IN, (bf16*)(ws + WS_WIN1), scr, gw, NGW, lane);
        transpose_plain(args.in[18], DM, DM, (bf16*)(ws + WS_WOUT1), scr, gw, NGW, lane);
        transpose_moe(args.in[24], args.in[25], args.in[26], (bf16*)(ws + WS_W13), (bf16*)(ws + WS_W2), scr, gw, NGW, lane);
        for (int i = bx * 512 + tid; i < 2048; i += G * 512) { const int pos = i >> 4, f = i & 15;
            const float inv = exp2f(-(float)f * (13.287712379549449f / 16.0f));
            const float ang = (float)pos * inv; const float rev = ang * 0.15915494309189535f; const float fr = rev - floorf(rev);
            TBL[TBL_COS + i] = __builtin_amdgcn_cosf(fr); TBL[TBL_SIN + i] = __builtin_amdgcn_sinf(fr); }
        for (int i = bx * 512 + tid; i < 8 * 257; i += G * 512) { const int h = i / 257, j = i % 257;
            TBL[TBL_BIAS + h * BIAS_STRIDE + j] = args.in[19][t5_bucket(j - 128) * 8 + h] * LOG2E; }
        for (int i = bx * 512 + tid; i < 2 * 1024 * 48; i += G * 512) { const int l = i / (1024 * 48), r = i % (1024 * 48), k = r / 48, c = r % 48;
            float w = 0.f; if (c < 4) w = args.in[20][(size_t)l * 4096 + k * 4 + c]; else if (c < 36) w = args.in[22][(size_t)l * 32768 + k * 32 + (c - 4)];
            TBL[TBL_WR + l * WR_LAYER + r] = w * args.in[2][l * DM + k]; }
        for (int i = bx * 512 + tid; i < 2 * 48; i += G * 512) { const int l = i / 48, c = i % 48;
            TBL[TBL_WR + l * WR_LAYER + 1024 * 48 + c] = c < 4 ? args.in[21][l * 4 + c] : (c < 36 ? args.in[23][l * 32 + (c - 4)] : 0.f); }
        for (int m = gw; m < NTOK; m += NGW) { f32x4 v[4]; rms_row(x_in + (size_t)m * DM, args.in[1], v, lane); store_row_bf16(HB + (size_t)m * DM, v, lane); }
    }
    SEAM(0);
    if (IN(1)) REP(1) {
        pg8::Gemm g{HB, (const bf16*)(ws + WS_WIN0), NTOK, EV_IN, DM}; pg8::StaticOrder S; S.init(NTOK, EV_IN, G, bx);
        pg8::EpiBf16 E{(bf16*)(ws + WS_Z0), EV_IN, 0, 0, 1.f, 0xffff};
        pg8::gemm_phase<pg8::EpiBf16, pg8::StaticOrder, true>(lds, g, S, E);
    }
    SEAM(1);
    if (IN(2)) REP(2) {
        const bf16* Z0 = (const bf16*)(ws + WS_Z0); bf16* QR = (bf16*)(ws + WS_QR); bf16* KR = (bf16*)(ws + WS_KR);
        const float gq = args.in[5][lane], gk = args.in[6][lane];
        const int fi = lane & 15; const bool first = (lane & 16) == 0, isrow = lane < 32;
        for (int m = gw; m < NTOK; m += NGW) {
            const int s = m & (SEQ - 1); const int pos = isrow ? (s >> 6) : (s & 63);
            const float cs = TBL[TBL_COS + pos * 16 + fi], sn = TBL[TBL_SIN + pos * 16 + fi];
#pragma unroll
            for (int h = 0; h < 10; ++h) {
                const float xv = bf2f(Z0[(size_t)m * EV_IN + h * 64 + lane]);
                const float ss = wave_sum(xv * xv);
                const float y = xv * (1.0f / sqrtf(ss * (1.f / 64.f) + 1e-6f)) * (h < 8 ? gq : gk);
                const float p = __shfl_xor(y, 16);
                float o = first ? (y * cs - p * sn) : (y * cs + p * sn);
                if (h < 8) QR[(size_t)m * 512 + h * 64 + lane] = (bf16)f2bf(o * C2);
                else KR[(size_t)m * 128 + (h - 8) * 64 + lane] = (bf16)f2bf(o);
            }
        }
        LAS float* hbuf = (LAS float*)lds;
        for (int un = bx; un < NBATCH * 64 * 8; un += G) {
            const int grp = un & 7, tt = (un >> 3) & 63, b = un >> 9; const int t0 = tt * 128;
            __syncthreads();
            for (int idx = tid; idx < 158 * 8; idx += 512) { const int r = idx >> 3, c8 = idx & 7; const int s = t0 - 15 + r;
                f32x4 h0 = {0.f, 0.f, 0.f, 0.f}, h1 = h0;
                if (s >= 0 && s < SEQ) { const size_t ro = (size_t)(b * SEQ + s) * EV_IN + grp * 64 + c8 * 8;
                    const v4u av = *(const GAS v4u*)(Z0 + ro + 768), gv = *(const GAS v4u*)(Z0 + ro + 1280);
#pragma unroll
                    for (int j = 0; j < 4; ++j) { const float a0 = __builtin_bit_cast(float, av[j] << 16), a1 = __builtin_bit_cast(float, av[j] & 0xffff0000u);
                        const float g0 = __builtin_bit_cast(float, gv[j] << 16), g1 = __builtin_bit_cast(float, gv[j] & 0xffff0000u);
                        const float x0 = a0 * __builtin_amdgcn_rcpf(1.0f + __builtin_amdgcn_exp2f(-g0 * LOG2E)), x1 = a1 * __builtin_amdgcn_rcpf(1.0f + __builtin_amdgcn_exp2f(-g1 * LOG2E));
                        if (j < 2) { h0[2 * j] = x0; h0[2 * j + 1] = x1; } else { h1[2 * j - 4] = x0; h1[2 * j - 3] = x1; } } }
                *(LAS f32x4*)(hbuf + r * 64 + c8 * 8) = h0; *(LAS f32x4*)(hbuf + r * 64 + c8 * 8 + 4) = h1; }
            __syncthreads();
            const int ch = grp * 64 + lane;
            float wreg[31];
#pragma unroll
            for (int j = 0; j < 31; ++j) wreg[j] = args.in[7][j * 512 + ch];
            float acc[16]; const float cb = args.in[8][ch];
#pragma unroll
            for (int i = 0; i < 16; ++i) acc[i] = cb;
#pragma unroll
            for (int r = 0; r < 46; ++r) { const float hv = hbuf[(wave * 16 + r) * 64 + lane];
#pragma unroll
                for (int i = 0; i < 16; ++i) { const int j = r - i; if (j >= 0 && j < 31) acc[i] += wreg[j] * hv; } }
            const float gg = args.in[9][ch], gb = args.in[10][ch];
#pragma unroll
            for (int i = 0; i < 16; ++i) { const float mu = wave_sum(acc[i]) * (1.f / 64.f); const float d = acc[i] - mu; const float var = wave_sum(d * d) * (1.f / 64.f);
                const float hn = d * (1.0f / sqrtf(var + 1e-5f)) * gg + gb; const float ov = hn * __builtin_amdgcn_rcpf(1.0f + __builtin_amdgcn_exp2f(-hn * LOG2E));
                Y[(size_t)(b * SEQ + t0 + wave * 16 + i) * DM + 512 + ch] = (bf16)f2bf(ov); }
        }
    }
    SEAM(2);
    if (IN(3)) REP(3) {
        const bf16* QR = (const bf16*)(ws + WS_QR); const bf16* KR = (const bf16*)(ws + WS_KR); const bf16* Z0 = (const bf16*)(ws + WS_Z0);
        if (ATTN_VER == 0) {
        for (int un = bx; un < NBATCH * 8 * 32; un += G) {
            const int qb = un & 31, h = (un >> 5) & 7, b = un >> 8, kvh = h >> 2;
            const size_t row0 = (size_t)b * SEQ + qb * 256;
            attn_unit_v0<64, false>(QR + row0 * 512 + h * 64, 512, KR + (size_t)b * SEQ * 128 + kvh * 64, 128, Z0 + (size_t)b * SEQ * EV_IN + 640 + kvh * 64, EV_IN,
                                   Y + row0 * DM + h * 64, DM, nullptr, qb * 256, lds);
        }
        } else {
        constexpr int U = NBATCH * 8 * 32; const int upc = (U + G - 1) / G; const int vcu = (G % 8 == 0) ? (bx % 8) * (G / 8) + bx / 8 : bx;
        for (int i = 0; i < upc; ++i) { const int un = vcu * upc + i; if (un >= U) break;
            const int stream = un >> 7, b = stream >> 1, kvh = stream & 1, h = kvh * 4 + ((un >> 5) & 3), qb = un & 31;
            const size_t row0 = (size_t)b * SEQ + qb * 256;
            at1::attn_unit<64, false>(QR + row0 * 512 + h * 64, 512, KR + (size_t)b * SEQ * 128 + kvh * 64, 128, Z0 + (size_t)b * SEQ * EV_IN + 640 + kvh * 64, EV_IN,
                                      Y + row0 * DM + h * 64, DM, qb * 256, lds);
        }
        }
    }
    SEAM(3);
    if (IN(4)) REP(4) {
        pg8::Gemm g{Y, (const bf16*)(ws + WS_WOUT0), NTOK, DM, DM}; pg8::StaticOrder S; S.init(NTOK, DM, G, bx);
        pg8::EpiRes E{x_in, xres, DM};
        pg8::gemm_phase<pg8::EpiRes, pg8::StaticOrder, true>(lds, g, S, E);
    }
    SEAM(4);

    moe_block<0>(args, lds, bar, lo, hi_ph);
    SEAM(8);
            if (IN(9)) REP(9) {
                pg8::Gemm g{HB, (const bf16*)(ws + WS_WIN1), NTOK, OD_IN, DM}; pg8::StaticOrder S; S.init(NTOK, OD_IN, G, bx);
                pg8::EpiBf16 E{(bf16*)(ws + WS_Q1), DM, DM, (size_t)(WS_K1 - WS_Q1) / 2, C2, 0xffff};
                pg8::gemm_phase<pg8::EpiBf16, pg8::StaticOrder, true>(lds, g, S, E);
            }
            SEAM(9);
            if (IN(10)) REP(10) {
                const bf16* Q1 = (const bf16*)(ws + WS_Q1); const bf16* K1 = (const bf16*)(ws + WS_K1); const bf16* V1 = (const bf16*)(ws + WS_V1);
                if (ATTN_VER == 0) {
                LAS float* btbl = (LAS float*)(lds + 65536);
                for (int un = bx; un < NBATCH * 8 * 2 * 32; un += G) {
                    const int qb = un & 31, c = (un >> 5) & 1, h = (un >> 6) & 7, b = un >> 9;
                    __syncthreads();
                    if (tid < 257) btbl[tid] = TBL[TBL_BIAS + h * BIAS_STRIDE + tid];
                    __syncthreads();
                    const size_t row0 = (size_t)b * SEQ + qb * 256, brow = (size_t)b * SEQ;
                    bf16* OC = (bf16*)(ws + (c ? WS_OC1 : WS_OC0));
                    attn_unit_v0<128, true>(Q1 + row0 * DM + h * 128 + c * 64, DM, K1 + brow * DM + h * 128 + c * 64, DM, V1 + brow * DM + h * 128, DM,
                                           OC + row0 * DM + h * 128, DM, btbl, qb * 256, lds);
                }
                } else {
                constexpr int UP = NBATCH * 8 * 32; const int upc = (UP + G - 1) / G; const int vcu = (G % 8 == 0) ? (bx % 8) * (G / 8) + bx / 8 : bx;
                LAS float* btbl = (LAS float*)(lds + 3 * 8192 + 3 * 16384 + 2048);
                LAS float* sgt = btbl + 272;
                __syncthreads();
                if (tid < 128) sgt[tid] = args.in[17][tid] * (1.0f - LAM_INIT);
                if (wave == 7) { const float lam = __expf(wave_sum(args.in[13][lane] * args.in[14][lane])) - __expf(wave_sum(args.in[15][lane] * args.in[16][lane])) + LAM_INIT; if (lane == 0) sgt[128] = lam; }
                for (int i = 0; i < upc; ++i) {
                    int up = vcu * upc + i; if (up >= UP) break;
                    if (G == 256) up = ((vcu >> 5) * 4 + i) * 32 + (vcu & 31);
                    const int qb = up & 31, h = (up >> 5) & 7, b = up >> 8;
                    __syncthreads();
                    if (tid < 257) btbl[tid] = TBL[TBL_BIAS + h * BIAS_STRIDE + tid] - TBL[TBL_BIAS + h * BIAS_STRIDE + 256];
                    __syncthreads();
                    const size_t row0 = (size_t)b * SEQ + qb * 256, brow = (size_t)b * SEQ;
                    at1::attn_unit<128, true, 0, 1>(Q1 + row0 * DM + h * 128, DM, K1 + brow * DM + h * 128, DM, V1 + brow * DM + h * 128, DM, nullptr, DM, qb * 256, lds, sgt);
                    at1::attn_unit<128, true, 0, 2>(Q1 + row0 * DM + h * 128 + 64, DM, K1 + brow * DM + h * 128 + 64, DM, V1 + brow * DM + h * 128, DM, Y + row0 * DM + h * 128, DM, qb * 256, lds, sgt);
                }
                }
            }
            SEAM(10);
            if (PROBE_ATT >= 0 && IN(10)) {
                const bf16* Q1 = (const bf16*)(ws + WS_Q1); const bf16* K1 = (const bf16*)(ws + WS_K1); const bf16* V1 = (const bf16*)(ws + WS_V1);
                constexpr int U = NBATCH * 8 * 2 * 32; const int upc = (U + G - 1) / G; const int vcu = (G % 8 == 0) ? (bx % 8) * (G / 8) + bx / 8 : bx;
                LAS float* btbl = (LAS float*)(lds + 3 * 8192 + 3 * 16384 + 2048);
                for (int i = 0; i < upc; ++i) {
                    int un = vcu * upc + i; if (un >= U) break;
                    if (G == 256) un = ((vcu >> 5) * 4 + (i >> 1)) * 64 + (i & 1) * 32 + (vcu & 31);
                    const int qb = un & 31, c = (un >> 5) & 1, h = (un >> 6) & 7, b = un >> 9;
                    if (tid < 257) btbl[tid] = TBL[TBL_BIAS + h * BIAS_STRIDE + tid] - TBL[TBL_BIAS + h * BIAS_STRIDE + 256];
                    __syncthreads();
                    const size_t row0 = (size_t)b * SEQ + qb * 256, brow = (size_t)b * SEQ;
                    at1::attn_unit<128, true, (PROBE_ATT >= 0 ? PROBE_ATT : 0)>(Q1 + row0 * DM + h * 128 + c * 64, DM, K1 + brow * DM + h * 128 + c * 64, DM, V1 + brow * DM + h * 128, DM,
                                              (bf16*)(ws + WS_OC1) + row0 * DM + h * 128, DM, qb * 256, lds);
                }
                xcd_barrier(bar);
            }
            if (IN(11) && ATTN_VER != 1) REP(11) {
                const bf16* OC0 = (const bf16*)(ws + WS_OC0); const bf16* OC1 = (const bf16*)(ws + WS_OC1);
                const float lam = __expf(wave_sum(args.in[13][lane] * args.in[14][lane])) - __expf(wave_sum(args.in[15][lane] * args.in[16][lane])) + LAM_INIT;
                float sg[16];
#pragma unroll
                for (int j = 0; j < 16; ++j) sg[j] = args.in[17][(lane & 7) * 16 + j] * (1.0f - LAM_INIT);
                for (int m = gw; m < NTOK; m += NGW) {
                    const GAS v4u* a = (const GAS v4u*)(OC0 + (size_t)m * DM) + lane * 2; const GAS v4u* c = (const GAS v4u*)(OC1 + (size_t)m * DM) + lane * 2;
                    float o[16]; float ss = 0.f;
#pragma unroll
                    for (int q = 0; q < 2; ++q) { const v4u av = a[q], cv = c[q];
#pragma unroll
                        for (int j = 0; j < 4; ++j) { const unsigned au = av[j], cu = cv[j];
                            const float lo = __builtin_bit_cast(float, au << 16) - lam * __builtin_bit_cast(float, cu << 16);
                            const float hh = __builtin_bit_cast(float, au & 0xffff0000u) - lam * __builtin_bit_cast(float, cu & 0xffff0000u);
                            o[q * 8 + 2 * j] = lo; o[q * 8 + 2 * j + 1] = hh; ss += lo * lo + hh * hh; } }
                    ss += __shfl_xor(ss, 1); ss += __shfl_xor(ss, 2); ss += __shfl_xor(ss, 4);
                    const float rstd = 1.0f / sqrtf(ss * (1.f / 128.f) + 1e-5f);
                    v4u w0, w1;
                    w0.x = pk2(o[0] * rstd * sg[0], o[1] * rstd * sg[1]); w0.y = pk2(o[2] * rstd * sg[2], o[3] * rstd * sg[3]); w0.z = pk2(o[4] * rstd * sg[4], o[5] * rstd * sg[5]); w0.w = pk2(o[6] * rstd * sg[6], o[7] * rstd * sg[7]);
                    w1.x = pk2(o[8] * rstd * sg[8], o[9] * rstd * sg[9]); w1.y = pk2(o[10] * rstd * sg[10], o[11] * rstd * sg[11]); w1.z = pk2(o[12] * rstd * sg[12], o[13] * rstd * sg[13]); w1.w = pk2(o[14] * rstd * sg[14], o[15] * rstd * sg[15]);
                    GAS v4u* yo = (GAS v4u*)(Y + (size_t)m * DM) + lane * 2; yo[0] = w0; yo[1] = w1;
                }
            }
            if (ATTN_VER != 1) SEAM(11);
            if (IN(12)) {
                pg8::Gemm g{Y, (const bf16*)(ws + WS_WOUT1), NTOK, DM, DM}; pg8::StaticOrder S; S.init(NTOK, DM, G, bx);
                pg8::EpiRes E{xres, xres, DM};
                pg8::gemm_phase<pg8::EpiRes, pg8::StaticOrder, true>(lds, g, S, E);
            }
            SEAM(12);
    moe_block<1>(args, lds, bar, lo, hi_ph);
#undef IN
#undef SEAM
}

extern "C" void kernel_launch(void* const* d_in, const int* in_sizes, int n_in, void* d_out, int out_size, void* d_ws, size_t ws_size, hipStream_t stream) {
    static int grid = 0;
    if (grid == 0) {
        if (n_in != 27 || in_sizes[0] != NTOK * DM || out_size != NTOK * DM || ws_size < WS_END) { fprintf(stderr, "kernel_launch: unexpected shapes / workspace (n_in %d, ws %zu)\n", n_in, ws_size); grid = -1; return; }
        int dev = 0, cus = 0, per_cu = 0;
        if (hipGetDevice(&dev) != hipSuccess || hipDeviceGetAttribute(&cus, hipDeviceAttributeMultiprocessorCount, dev) != hipSuccess) { grid = -1; return; }
        if (hipFuncSetAttribute((const void*)mk_fwd, hipFuncAttributeMaxDynamicSharedMemorySize, LDS_BYTES) != hipSuccess) { fprintf(stderr, "kernel_launch: hipFuncSetAttribute failed\n"); grid = -1; return; }
        if (hipOccupancyMaxActiveBlocksPerMultiprocessor(&per_cu, (const void*)mk_fwd, NWAVES * 64, LDS_BYTES) != hipSuccess || per_cu < 1) { fprintf(stderr, "kernel_launch: occupancy query says %d\n", per_cu); }
        (void)hipGetLastError();
        grid = cus;
    }
    if (grid < 0) return;
    if (hipMemsetAsync((char*)d_ws + WS_CTL, 0, CTL_ZERO_BYTES, stream) != hipSuccess) return;
    Args a{};
    for (int i = 0; i < 27; ++i) a.in[i] = (const float*)d_in[i];
    a.out = (float*)d_out; a.ws = (unsigned char*)d_ws;
    if (MK_N_LAUNCHES == 1) { a.ph_lo = 0; a.ph_hi = NPHASE; a.li = 0; hipLaunchKernelGGL(mk_fwd, dim3(grid), dim3(NWAVES * 64), LDS_BYTES, stream, a); }
    else { for (int p = 0; p < NPHASE; ++p) for (int r = 0; r < (int)((PROBE_MASK >> p) & 1u) + 1; ++r) { a.ph_lo = p; a.ph_hi = p + 1; a.li = p; hipLaunchKernelGGL(mk_fwd, dim3(grid), dim3(NWAVES * 64), LDS_BYTES, stream, a); } }
}
```

```cpp
#include <hip/hip_runtime.h>
#include <cstdio>
#include <cstdint>

#ifndef MK_N_LAUNCHES
#define MK_N_LAUNCHES 1
#endif

#ifndef ATTN_VER
#define ATTN_VER 1
#endif
#ifndef PROBE_ATT
#define PROBE_ATT -1
#endif
#ifndef QK_FP8
#define QK_FP8 1
#endif
#ifndef ATTN_L0_TEST
#define ATTN_L0_TEST 0
#endif
#ifndef PROBE_MASK
#define PROBE_MASK 0u
#endif
#define REP(k) _Pragma("unroll") for (int rep_ = 0; rep_ < (MK_N_LAUNCHES == 1 ? (int)((PROBE_MASK >> (k)) & 1u) : 0) + 1; ++rep_)
#define GAS __attribute__((address_space(1)))
#define LAS __attribute__((address_space(3)))
typedef unsigned short bf16;
typedef unsigned v4u __attribute__((ext_vector_type(4)));
typedef unsigned v2u __attribute__((ext_vector_type(2)));
typedef float f32x4 __attribute__((ext_vector_type(4)));
typedef float f32x16 __attribute__((ext_vector_type(16)));
typedef short bf16x8 __attribute__((ext_vector_type(8)));
typedef short s16x4 __attribute__((ext_vector_type(4)));

constexpr int NTOK = 32768, DM = 1024, SEQ = 8192, NBATCH = 4;
constexpr int EV_IN = 1792, OD_IN = 3072;
constexpr int NEXP = 32, MOE_H = 512, LIST_CAP = 32768;
constexpr float C2 = 0.125f * 1.4426950408889634f;
constexpr float LOG2E = 1.4426950408889634f;
constexpr float LAM_INIT = 0.35550906759f;

constexpr size_t MiB = 1u << 20;
constexpr size_t WS_CTL = 0, CTL_ZERO_BYTES = 1 * MiB;
constexpr size_t WS_WIN0 = 1 * MiB, WS_WOUT0 = 5 * MiB, WS_WIN1 = 7 * MiB, WS_WOUT1 = 13 * MiB, WS_TBL = 15 * MiB;
constexpr size_t WS_W13 = 16 * MiB, WS_W2 = 80 * MiB;
constexpr size_t WS_HB = 112 * MiB;
constexpr size_t WS_Y = 176 * MiB;
constexpr size_t WS_Z0 = 240 * MiB, WS_QR = 352 * MiB, WS_KR = 384 * MiB, WS_QR8 = 392 * MiB, WS_KR8 = 408 * MiB;
constexpr size_t WS_Q1 = 240 * MiB, WS_K1 = 304 * MiB, WS_V1 = 368 * MiB, WS_OC1 = 432 * MiB, WS_OC0 = WS_HB;
constexpr size_t WS_H = 176 * MiB, WS_YS = 248 * MiB, WS_LIST = 392 * MiB, WS_TOKEP = 396 * MiB, WS_GATE = 396 * MiB + 512 * 1024;
constexpr size_t WS_END = 496 * MiB;
constexpr int TBL_COS = 0, TBL_SIN = 2048, TBL_BIAS = 4096, BIAS_STRIDE = 272;
constexpr int TBL_WR = 32768, WR_LAYER = 1024 * 48 + 64;
constexpr int CW_BAR = 4096;
constexpr int CW_CNT = 16384;

constexpr int RING_BYTES = 131072;
constexpr int LDS_BYTES = 147456;
constexpr int LDSCTL_OFF = LDS_BYTES - 1024;
constexpr int STASH_OFF = 78 * 1024;
constexpr int LC_BAR = 8;
constexpr int LC_TP = 16;
constexpr int LC_CNT = 64;
constexpr int LC_LCNT = 96;
constexpr int LC_LBASE = 128;
constexpr int LC_LP = 160;

#define LDS_WAIT() asm volatile("s_waitcnt lgkmcnt(0)" ::: "memory")
#define VM_WAIT() asm volatile("s_waitcnt vmcnt(0)" ::: "memory")
#define RLX_AGENT __ATOMIC_RELAXED, __HIP_MEMORY_SCOPE_AGENT

__device__ __forceinline__ unsigned f2bf(float f) { unsigned u = __builtin_bit_cast(unsigned, f); return (u + 0x7fffu + ((u >> 16) & 1u)) >> 16; }
__device__ __forceinline__ unsigned pk2(float lo, float hi) { return f2bf(lo) | (f2bf(hi) << 16); }
__device__ __forceinline__ float bf2f(unsigned short b) { return __builtin_bit_cast(float, (unsigned)b << 16); }
template <int CTRL> __device__ __forceinline__ float dpp_mov(float v) { return __builtin_bit_cast(float, __builtin_amdgcn_update_dpp(0, __builtin_bit_cast(int, v), CTRL, 0xf, 0xf, true)); }
__device__ __forceinline__ float wave_sum(float v) {
    v += dpp_mov<0xB1>(v); v += dpp_mov<0x4E>(v); v += dpp_mov<0x141>(v); v += dpp_mov<0x140>(v);
    { auto rr = __builtin_amdgcn_permlane16_swap(__float_as_uint(v), __float_as_uint(v), false, false); v = __uint_as_float(rr[0]) + __uint_as_float(rr[1]); }
    { auto rr = __builtin_amdgcn_permlane32_swap(__float_as_uint(v), __float_as_uint(v), false, false); v = __uint_as_float(rr[0]) + __uint_as_float(rr[1]); }
    return v;
}


typedef int v8i __attribute__((ext_vector_type(8)));
__device__ __forceinline__ unsigned fp8_byte(float v) { return (unsigned)__builtin_amdgcn_cvt_pk_fp8_f32(v, v, 0, false) & 0xffu; }
__device__ __forceinline__ unsigned quad_pack_bytes(unsigned b) {
    const unsigned x0 = (unsigned)__builtin_amdgcn_update_dpp(0, (int)b, 0x00, 0xf, 0xf, true), x1 = (unsigned)__builtin_amdgcn_update_dpp(0, (int)b, 0x55, 0xf, 0xf, true);
    const unsigned x2 = (unsigned)__builtin_amdgcn_update_dpp(0, (int)b, 0xAA, 0xf, 0xf, true), x3 = (unsigned)__builtin_amdgcn_update_dpp(0, (int)b, 0xFF, 0xf, 0xf, true);
    return x0 | (x1 << 8) | (x2 << 16) | (x3 << 24);
}
namespace pg8 {
#define PG8_LAS __attribute__((address_space(3)))
typedef unsigned short bf16_t;
typedef short bf16x8 __attribute__((ext_vector_type(8)));
typedef float f32x4 __attribute__((ext_vector_type(4)));
typedef unsigned u32x4 __attribute__((ext_vector_type(4)));
constexpr int BM = 256, BK = 64, HALF = 128, HTB = HALF * BK * 2, STAGE_BYTES = 8 * HTB, NXCD = 8, WGM = 8;

__host__ __device__ __forceinline__ int lds_byte(int r, int c) { const int st = (r >> 4) * 2 + (c >> 5), rr = r & 15, cc = c & 31, ob = rr * 64 + cc * 2; return st * 1024 + (ob ^ (((ob >> 9) & 1) << 5)); }
__host__ __device__ __forceinline__ void stage_rc(int b, int& R, int& C) { const int st = b / 1024, sb = b % 1024, swz = sb ^ (((sb >> 9) & 1) << 5); R = (st >> 1) * 16 + swz / 64; C = (st & 1) * 32 + (swz % 64) / 2; }
__host__ __device__ __forceinline__ int perm32(int rho) { const int n = rho >> 4, i = rho & 15; return 8 * (i >> 2) + 4 * n + (i & 3); }

struct Unit { int pm, pn, e, rb; };
struct Gemm { const bf16_t* A; const bf16_t* Bt; int M, N, K; };

struct StaticOrder {
    int nM, nN, nwg, G, c;
    __device__ void init(int M, int N, int G_, int c_) { nM = M / BM; nN = N / BM; nwg = nM * nN; G = G_; c = c_; }
    __device__ bool next(int i, Unit& u) const {
        const long L = (long)i * G + c; if (L >= nwg) return false;
        int wgid = (int)L; { const int q = nwg / NXCD, r = nwg % NXCD, xcd = wgid % NXCD, off = wgid / NXCD; wgid = (xcd < r ? xcd * (q + 1) : r * (q + 1) + (xcd - r) * q) + off; }
        const int nig = WGM * nN, gid = wgid / nig, fm = gid * WGM, gsz = (nM - fm) < WGM ? (nM - fm) : WGM;
        u.pm = fm + ((wgid % nig) % gsz); u.pn = (wgid % nig) / gsz; u.e = 0; u.rb = 0; return true;
    }
    __device__ __forceinline__ unsigned arow(const Unit& u, int rr) const { return (unsigned)(u.pm * BM + rr); }
};

struct MoeOrder {
    const PG8_LAS int* tp; const PG8_LAS int* cn; const PG8_LAS int* lp; const int* list; int G, c, nunits; bool gather; bool xcd;
    __device__ __forceinline__ bool next(int i, Unit& u) const {
        int e_, rb_, pm_, pnl_; bool ok;
        if (xcd) {
            const int x = c & 7, y = c >> 3; const int uidx = i * 32 + y; ok = uidx < lp[4] * 4;
            const int rbl = uidx >> 2; pnl_ = uidx & 3; int j = 0;
#pragma unroll
            for (int q = 1; q < 4; ++q) j += (lp[q] <= rbl) ? 1 : 0;
            e_ = x + 8 * j; rb_ = rbl - lp[j]; pm_ = tp[e_] + rb_;
        } else {
            const int L = i * G + c; ok = L < nunits;
            const int rbg = L >> 2; pnl_ = L & 3; int e = 0;
#pragma unroll
            for (int j = 1; j < 32; ++j) e += (tp[j] <= rbg) ? 1 : 0;
            e_ = e; pm_ = rbg; rb_ = rbg - tp[e];
        }
        u.e = __builtin_amdgcn_readfirstlane(e_); u.rb = __builtin_amdgcn_readfirstlane(rb_); u.pm = __builtin_amdgcn_readfirstlane(pm_); u.pn = __builtin_amdgcn_readfirstlane(e_ * 4 + pnl_);
        return ok;
    }
    __device__ __forceinline__ unsigned arow(const Unit& u, int rr) const {
        if (!gather) return (unsigned)(u.pm * BM + rr);
        const int idx = u.rb * BM + rr; unsigned t = 0u;
        if (idx < cn[u.e]) t = (unsigned)list[(size_t)u.e * 32768 + idx];
        return t;
    }
};

__device__ __forceinline__ unsigned cvt_pk_bf16(float lo, float hi) { unsigned r; asm volatile("v_cvt_pk_bf16_f32 %0, %1, %2" : "=v"(r) : "v"(lo), "v"(hi)); return r; }

struct EpiBf16 {
    static constexpr bool PERM = true;
    bf16_t* O; int ldc; int split_cols; size_t split_stride; float scale0; int pn_mask;
    __device__ __forceinline__ void operator()(const f32x4 (&acc)[2][2][4][2], const Unit& u, int wr, int wc, int fr, int fq) const {
        const int row0 = u.pm * BM + wr * 64 + fr; int colt = (u.pn & pn_mask) * BM; bf16_t* base = O;
        float sc = 1.f; if (split_cols) { const int t = colt / split_cols; base += (size_t)t * split_stride; colt -= t * split_cols; if (t == 0) sc = scale0; }
        const int col0 = colt + wc * 32 + 8 * fq;
#pragma unroll
        for (int ai = 0; ai < 2; ++ai)
#pragma unroll
            for (int m = 0; m < 4; ++m) { bf16_t* rowp = base + (size_t)(row0 + ai * HALF + m * 16) * ldc + col0;
#pragma unroll
                for (int bj = 0; bj < 2; ++bj) { f32x4 v0 = acc[ai][bj][m][0] * sc, v1 = acc[ai][bj][m][1] * sc;
                    u32x4 w; w.x = cvt_pk_bf16(v0[0], v0[1]); w.y = cvt_pk_bf16(v0[2], v0[3]); w.z = cvt_pk_bf16(v1[0], v1[1]); w.w = cvt_pk_bf16(v1[2], v1[3]);
                    *(u32x4*)(rowp + bj * HALF) = w; } }
    }
};
struct EpiRes {
    static constexpr bool PERM = false;
    const float* base; float* out; int ldc;
    __device__ __forceinline__ void operator()(const f32x4 (&acc)[2][2][4][2], const Unit& u, int wr, int wc, int fr, int fq) const {
        const int row0 = u.pm * BM + wr * 64 + fr, col0 = u.pn * BM + wc * 32 + 4 * fq;
#pragma unroll
        for (int ai = 0; ai < 2; ++ai)
#pragma unroll
            for (int m = 0; m < 4; ++m) { const size_t off = (size_t)(row0 + ai * HALF + m * 16) * ldc + col0;
#pragma unroll
                for (int bj = 0; bj < 2; ++bj)
#pragma unroll
                    for (int n = 0; n < 2; ++n) { const f32x4 bs = *(const f32x4*)(base + off + bj * HALF + n * 16); *(f32x4*)(out + off + bj * HALF + n * 16) = bs + acc[ai][bj][m][n]; } }
    }
};
struct EpiQKV8 {
    static constexpr bool PERM = true;
    unsigned char* Q8; unsigned char* K8; bf16_t* V; float qscale;
    __device__ __forceinline__ void operator()(const f32x4 (&acc)[2][2][4][2], const Unit& u, int wr, int wc, int fr, int fq) const {
        const int row0 = u.pm * BM + wr * 64 + fr; const int colt = u.pn * BM; const int t = colt >> 10; const int col0 = (colt & 1023) + wc * 32 + 8 * fq;
        const float sc = t == 0 ? qscale : 1.0f;
#pragma unroll
        for (int ai = 0; ai < 2; ++ai)
#pragma unroll
            for (int m = 0; m < 4; ++m) { const size_t ro = (size_t)(row0 + ai * HALF + m * 16) * 1024 + col0;
#pragma unroll
                for (int bj = 0; bj < 2; ++bj) { const f32x4 v0 = acc[ai][bj][m][0] * sc, v1 = acc[ai][bj][m][1] * sc;
                    if (t == 2) { u32x4 w; w.x = cvt_pk_bf16(v0[0], v0[1]); w.y = cvt_pk_bf16(v0[2], v0[3]); w.z = cvt_pk_bf16(v1[0], v1[1]); w.w = cvt_pk_bf16(v1[2], v1[3]); *(u32x4*)(V + ro + bj * HALF) = w; }
                    else { int d0 = __builtin_amdgcn_cvt_pk_fp8_f32(v0[0], v0[1], 0, false); d0 = __builtin_amdgcn_cvt_pk_fp8_f32(v0[2], v0[3], d0, true);
                        int d1 = __builtin_amdgcn_cvt_pk_fp8_f32(v1[0], v1[1], 0, false); d1 = __builtin_amdgcn_cvt_pk_fp8_f32(v1[2], v1[3], d1, true);
                        typedef int i32x2 __attribute__((ext_vector_type(2)));
                        *(i32x2*)((t == 0 ? Q8 : K8) + ro + bj * HALF) = (i32x2){d0, d1}; } } }
    }
};
__device__ __forceinline__ float silu_mul(float a, float b) { return a * b * __builtin_amdgcn_rcpf(1.0f + __builtin_amdgcn_exp2f(-a * 1.4426950408889634f)); }
struct EpiSwiglu {
    static constexpr bool PERM = true;
    bf16_t* O;
    __device__ __forceinline__ void operator()(const f32x4 (&acc)[2][2][4][2], const Unit& u, int wr, int wc, int fr, int fq) const {
        const int row0 = u.pm * BM + wr * 64 + fr, col0 = (u.pn & 3) * 128 + wc * 32 + 8 * fq;
#pragma unroll
        for (int ai = 0; ai < 2; ++ai)
#pragma unroll
            for (int m = 0; m < 4; ++m) { bf16_t* rowp = O + (size_t)(row0 + ai * HALF + m * 16) * 512 + col0;
                const f32x4 a0 = acc[ai][0][m][0], a1 = acc[ai][0][m][1], b0 = acc[ai][1][m][0], b1 = acc[ai][1][m][1];
                u32x4 w; w.x = cvt_pk_bf16(silu_mul(a0[0], b0[0]), silu_mul(a0[1], b0[1])); w.y = cvt_pk_bf16(silu_mul(a0[2], b0[2]), silu_mul(a0[3], b0[3]));
                w.z = cvt_pk_bf16(silu_mul(a1[0], b1[0]), silu_mul(a1[1], b1[1])); w.w = cvt_pk_bf16(silu_mul(a1[2], b1[2]), silu_mul(a1[3], b1[3]));
                *(u32x4*)rowp = w; }
    }
};

template <class Epi, class Sched, bool ALIGN_EPI>
__device__ __forceinline__ void gemm_phase(PG8_LAS unsigned char* lds, const Gemm g, const Sched& S, const Epi& E) {
    const int tid = threadIdx.x, wid = __builtin_amdgcn_readfirstlane(tid >> 6), lane = tid & 63, wr = wid >> 2, wc = wid & 3, fr = lane & 15, fq = lane >> 4;
    const int K = g.K, nt = K / BK;
    int RA[2], CA[2]; unsigned voffB[2];
#pragma unroll
    for (int i = 0; i < 2; ++i) { int R, C; stage_rc(tid * 16 + i * 8192, R, C); RA[i] = R; CA[i] = C; const int Rb = Epi::PERM ? ((R & ~31) + perm32(R & 31)) : R; voffB[i] = (unsigned)(Rb * K + C) * 2u; }
    const size_t kstep = (size_t)(BK * 2);
    const size_t hstep = (size_t)HALF * K * 2;
    const size_t tstep = 2 * hstep;
    const unsigned ldsw = (unsigned)wid * 1024u;
    const int aoff = lds_byte(wr * 64 + fr, fq * 8), boff = lds_byte(wc * 32 + fr, fq * 8);
#define PG8_SA(b, h) (((b) * 2 + (h)) * HTB)
#define PG8_SB(b, h) ((4 + (b) * 2 + (h)) * HTB)
#define PG8_STAGE(bufoff, gbase, voff) do { _Pragma("unroll") for (int _i = 0; _i < 2; ++_i) \
        __builtin_amdgcn_global_load_lds((const unsigned*)((const char*)(gbase) + (voff)[_i]), (PG8_LAS unsigned*)(lds + (bufoff) + ldsw + _i * 8192), 16, 0, 0); } while (0)
#define PG8_LDA(dst, b, h) do { _Pragma("unroll") for (int m = 0; m < 4; ++m) _Pragma("unroll") for (int k = 0; k < 2; ++k) dst[m][k] = *(const PG8_LAS bf16x8*)(lds + PG8_SA(b, h) + aoff + m * 2048 + k * 1024); } while (0)
#define PG8_LDB(dst, b, h) do { _Pragma("unroll") for (int n = 0; n < 2; ++n) _Pragma("unroll") for (int k = 0; k < 2; ++k) dst[n][k] = *(const PG8_LAS bf16x8*)(lds + PG8_SB(b, h) + boff + n * 2048 + k * 1024); } while (0)
#define PG8_MMA(ai, bj, At, Bt) do { __builtin_amdgcn_s_setprio(1); _Pragma("unroll") for (int m = 0; m < 4; ++m) _Pragma("unroll") for (int n = 0; n < 2; ++n) _Pragma("unroll") for (int k = 0; k < 2; ++k) \
        acc[ai][bj][m][n] = __builtin_amdgcn_mfma_f32_16x16x32_bf16(Bt[n][k], At[m][k], acc[ai][bj][m][n], 0, 0, 0); __builtin_amdgcn_s_setprio(0); } while (0)
#define PG8_WAIT_V(n) asm volatile("s_waitcnt vmcnt(" #n ")" ::: "memory")
#define PG8_WAIT_L(n) asm volatile("s_waitcnt lgkmcnt(" #n ")" ::: "memory")
#define PG8_BAR __builtin_amdgcn_s_barrier()
#define PG8_SCHED __builtin_amdgcn_sched_barrier(0)
#define PG8_AOFF(dst, u) do { _Pragma("unroll") for (int _h = 0; _h < 2; ++_h) _Pragma("unroll") for (int _i = 0; _i < 2; ++_i) dst[_h][_i] = (S.arow(u, _h * HALF + RA[_i]) * (unsigned)K + (unsigned)CA[_i]) * 2u; } while (0)
    Unit cur, nxt; int ui = 0;
    if (!S.next(0, cur)) return;
    f32x4 acc[2][2][4][2];
#pragma unroll
    for (int a = 0; a < 2; ++a)
#pragma unroll
        for (int b = 0; b < 2; ++b)
#pragma unroll
            for (int m = 0; m < 4; ++m)
#pragma unroll
                for (int n = 0; n < 2; ++n) acc[a][b][m][n] = (f32x4){0.f, 0.f, 0.f, 0.f};
    bf16x8 At[4][2], B0[2][2], B1[2][2];
    unsigned offc[2][2], offn[2][2];
    PG8_AOFF(offc, cur);
    const char* const cA = (const char*)g.A; const char* cB = (const char*)g.Bt + (size_t)cur.pn * tstep;
    PG8_STAGE(PG8_SB(0, 0), cB, voffB); PG8_STAGE(PG8_SB(0, 1), cB + hstep, voffB); PG8_STAGE(PG8_SA(0, 0), cA, offc[0]); PG8_STAGE(PG8_SA(0, 1), cA, offc[1]);
    if (wr == 1) PG8_BAR;
    PG8_WAIT_V(2); PG8_BAR;
    PG8_STAGE(PG8_SB(1, 0), cB + kstep, voffB); PG8_STAGE(PG8_SA(1, 0), cA + kstep, offc[0]); PG8_STAGE(PG8_SB(1, 1), cB + hstep + kstep, voffB);
    PG8_WAIT_V(6); PG8_BAR;
    for (;;) {
        const bool has_next = S.next(ui + 1, nxt);
        if (has_next) { PG8_AOFF(offn, nxt); }
        else {
#pragma unroll
            for (int h = 0; h < 2; ++h)
#pragma unroll
                for (int i = 0; i < 2; ++i) offn[h][i] = offc[h][i]; }
        const char* nB = has_next ? (const char*)g.Bt + (size_t)nxt.pn * tstep : cB;
        for (int t = 0; t < nt; t += 2) {
            const bool last = (t == nt - 2);
            const char* a1 = cA + (size_t)(t + 1) * kstep;
            const char* a2 = last ? cA : cA + (size_t)(t + 2) * kstep; const char* b2 = last ? nB : cB + (size_t)(t + 2) * kstep;
            const char* a3 = a2 + kstep; const char* b3 = b2 + kstep;
            unsigned o2[2][2];
#pragma unroll
            for (int h = 0; h < 2; ++h)
#pragma unroll
                for (int i = 0; i < 2; ++i) o2[h][i] = last ? offn[h][i] : offc[h][i];
            PG8_LDB(B0, 0, 0); PG8_LDB(B1, 0, 1); PG8_SCHED; PG8_LDA(At, 0, 0); PG8_STAGE(PG8_SA(1, 1), a1, offc[1]);
            PG8_WAIT_V(8); PG8_WAIT_L(0); PG8_BAR; PG8_MMA(0, 0, At, B0); PG8_MMA(0, 1, At, B1); PG8_BAR; PG8_SCHED;
            PG8_LDA(At, 0, 1); PG8_STAGE(PG8_SB(0, 0), b2, voffB); PG8_STAGE(PG8_SB(0, 1), b2 + hstep, voffB); PG8_STAGE(PG8_SA(0, 0), a2, o2[0]);
            PG8_WAIT_V(8); PG8_WAIT_L(0); PG8_BAR; PG8_MMA(1, 0, At, B0); PG8_MMA(1, 1, At, B1); PG8_BAR; PG8_SCHED;
            PG8_LDB(B0, 1, 0); PG8_LDB(B1, 1, 1); PG8_SCHED; PG8_LDA(At, 1, 0); PG8_STAGE(PG8_SA(0, 1), a2, o2[1]);
            PG8_WAIT_V(8); PG8_WAIT_L(0); PG8_BAR; PG8_MMA(0, 0, At, B0); PG8_MMA(0, 1, At, B1); PG8_BAR; PG8_SCHED;
            PG8_LDA(At, 1, 1); PG8_STAGE(PG8_SB(1, 0), b3, voffB); PG8_STAGE(PG8_SB(1, 1), b3 + hstep, voffB); PG8_STAGE(PG8_SA(1, 0), a3, o2[0]);
            PG8_WAIT_V(8); PG8_WAIT_L(0); PG8_BAR; PG8_MMA(1, 0, At, B0); PG8_MMA(1, 1, At, B1); PG8_BAR; PG8_SCHED;
        }
        if constexpr (ALIGN_EPI) { if (wr == 0) PG8_BAR; }
        E(acc, cur, wr, wc, fr, fq);
        if (!has_next) break;
#pragma unroll
        for (int a = 0; a < 2; ++a)
#pragma unroll
            for (int b = 0; b < 2; ++b)
#pragma unroll
                for (int m = 0; m < 4; ++m)
#pragma unroll
                    for (int n = 0; n < 2; ++n) acc[a][b][m][n] = (f32x4){0.f, 0.f, 0.f, 0.f};
        cur = nxt; cB = nB; ++ui;
#pragma unroll
        for (int h = 0; h < 2; ++h)
#pragma unroll
            for (int i = 0; i < 2; ++i) offc[h][i] = offn[h][i];
        if constexpr (ALIGN_EPI) { if (wr == 1) PG8_BAR; }
    }
    PG8_WAIT_V(0);
    if constexpr (!ALIGN_EPI) { if (wr == 0) PG8_BAR; }
    PG8_BAR;
#undef PG8_SA
#undef PG8_SB
#undef PG8_STAGE
#undef PG8_LDA
#undef PG8_LDB
#undef PG8_MMA
#undef PG8_WAIT_V
#undef PG8_WAIT_L
#undef PG8_BAR
#undef PG8_SCHED
#undef PG8_AOFF
}
}

#define XB_TMO      128
#define XB_XCNT(j)  (256  + 64 * (j))
#define XB_XSUB(j)  (1280 + 64 * (j))
#define XB_XGEN(j)  (2304 + 64 * (j))
#define XB_TOP      3328
#define XB_TOPGEN   3392
#define XCD_BAR_WORDS 3456
#define XB_SPIN_CAP (1u << 18)

__device__ __forceinline__ unsigned xb_ld(unsigned* p)              { return __hip_atomic_load(p, __ATOMIC_RELAXED, __HIP_MEMORY_SCOPE_AGENT); }
__device__ __forceinline__ unsigned xb_add(unsigned* p, unsigned v) { return __hip_atomic_fetch_add(p, v, __ATOMIC_RELAXED, __HIP_MEMORY_SCOPE_AGENT); }
__device__ __forceinline__ unsigned xb_xcc_id() { return (unsigned)__builtin_amdgcn_s_getreg((3 << 11) | 20) & 0xFu; }
#define XB_SPIN(cond, bar) do { unsigned _sp = 0; while (cond) { __builtin_amdgcn_s_sleep(1); \
    if ((++_sp & 255u) == 0u) { if (xb_ld(&(bar)[XB_TMO])) break; if (_sp > XB_SPIN_CAP) { atomicAdd(&(bar)[XB_TMO], 1u); break; } } } } while (0)

struct XcdBarrier { unsigned* bar; unsigned x; volatile LAS unsigned* st; };

__device__ __forceinline__ XcdBarrier xcd_barrier_post(unsigned* bar, volatile LAS unsigned* st) {
    XcdBarrier b; b.bar = bar; b.x = xb_xcc_id(); b.st = st;
    if (threadIdx.x == 0) (void)xb_add(&bar[XB_XCNT(b.x)], 1u);
    return b;
}
__device__ __forceinline__ void xcd_barrier_complete(unsigned* bar, unsigned x, unsigned& nloc, unsigned& nx) {
    const unsigned G = gridDim.x * gridDim.y * gridDim.z;
    unsigned sum, cnt, mine, sp = 0u;
    for (;;) {
        sum = 0u; cnt = 0u; mine = 0u;
#pragma unroll
        for (unsigned j = 0; j < 16; ++j) { const unsigned c = xb_ld(&bar[XB_XCNT(j)]); sum += c; cnt += (c > 0u) ? 1u : 0u; mine = (j == x) ? c : mine; }
        if (sum == G) break;
        __builtin_amdgcn_s_sleep(1);
        if ((++sp & 255u) == 0u) { if (xb_ld(&bar[XB_TMO])) break; if (sp > XB_SPIN_CAP) { atomicAdd(&bar[XB_TMO], 1u); break; } }
    }
    nloc = mine > 0u ? mine : 1u; nx = cnt > 0u ? cnt : 1u;
}
__device__ __forceinline__ void xcd_barrier(const XcdBarrier& b) {
    asm volatile("s_waitcnt vmcnt(0)" ::: "memory");
    __syncthreads();
    if (threadIdx.x == 0) {
        unsigned* bar = b.bar;
        __builtin_amdgcn_s_waitcnt(0);
        unsigned nloc = b.st[0], nx = b.st[1];
        if (nloc == 0u) { xcd_barrier_complete(bar, b.x, nloc, nx); b.st[0] = nloc; b.st[1] = nx; }
        const unsigned old = xb_add(&bar[XB_XSUB(b.x)], 1u);
        const unsigned gen = old / nloc;
        if (old + 1u == (gen + 1u) * nloc) {
            __builtin_amdgcn_fence(__ATOMIC_RELEASE, "agent");
            asm volatile("s_waitcnt vmcnt(0)" ::: "memory");
            const unsigned og = xb_add(&bar[XB_TOP], 1u);
            const unsigned tg = og / nx;
            if (og + 1u == (tg + 1u) * nx) xb_add(&bar[XB_TOPGEN], 1u);
            else XB_SPIN(xb_ld(&bar[XB_TOPGEN]) == tg, bar);
            __builtin_amdgcn_fence(__ATOMIC_ACQUIRE, "agent");
            xb_add(&bar[XB_XGEN(b.x)], 1u);
            asm volatile("s_waitcnt vmcnt(0)" ::: "memory");
        } else {
            XB_SPIN(xb_ld(&bar[XB_XGEN(b.x)]) == gen, bar);
            __builtin_amdgcn_fence(__ATOMIC_ACQUIRE, "agent");
            asm volatile("s_waitcnt vmcnt(0)" ::: "memory");
        }
    }
    __syncthreads();
}

__device__ __forceinline__ void transpose_item(const float* W, int K, int N, bf16* WT, int kb, int nb, int dst_row0, LAS float* scr, int lane) {
    const int k0 = 64 * kb, n0 = 32 * nb;
#pragma unroll 8
    for (int i = 0; i < 32; ++i) { const int kk = 2 * i + (lane >> 5); scr[kk * 33 + (lane & 31)] = W[(size_t)(k0 + kk) * N + n0 + (lane & 31)]; }
    LDS_WAIT(); asm volatile("" ::: "memory");
    const int c = lane & 7;
#pragma unroll
    for (int j = 0; j < 4; ++j) { const int n = (lane >> 3) + 8 * j; const LAS float* s = scr + (8 * c) * 33 + n;
        v4u o; o.x = pk2(s[0 * 33], s[1 * 33]); o.y = pk2(s[2 * 33], s[3 * 33]); o.z = pk2(s[4 * 33], s[5 * 33]); o.w = pk2(s[6 * 33], s[7 * 33]);
        *(GAS v4u*)(WT + (size_t)(dst_row0 + n) * K + k0 + 8 * c) = o; }
    LDS_WAIT(); asm volatile("" ::: "memory");
}
__device__ __forceinline__ void transpose_plain(const float* W, int K, int N, bf16* WT, LAS float* scr, int gw, int ngw, int lane) {
    const int nblk = N / 32, nitems = (K / 64) * nblk;
    for (int it = gw; it < nitems; it += ngw) { const int kb = it / nblk, nb = it % nblk; transpose_item(W, K, N, WT, kb, nb, 32 * nb, scr, lane); }
}
__device__ __forceinline__ void transpose_moe(const float* w1, const float* w3, const float* w2, bf16* W13T, bf16* W2T, LAS float* scr, int gw, int ngw, int lane) {
    constexpr int I13 = 16 * 16, I2 = 8 * 32, IPE = 2 * I13 + I2;
    for (int it = gw; it < NEXP * IPE; it += ngw) {
        const int e = it / IPE; int r = it % IPE;
        if (r < 2 * I13) { const int which = r / I13; r %= I13; const int kb = r / 16, nb = r % 16, n0 = 32 * nb;
            const float* W = (which ? w3 : w1) + (size_t)e * 1024 * 512;
            transpose_item(W, 1024, 512, W13T + (size_t)e * 1024 * 1024, kb, nb, (n0 >> 7) * 256 + which * 128 + (n0 & 127), scr, lane);
        } else { r -= 2 * I13; const int kb = r / 32, nb = r % 32;
            transpose_item(w2 + (size_t)e * 512 * 1024, 512, 1024, W2T + (size_t)e * 1024 * 512, kb, nb, 32 * nb, scr, lane); }
    }
}
__device__ __forceinline__ void rms_row(const float* xrow, const float* g, f32x4 (&v)[4], int lane) {
    const GAS f32x4* xr = (const GAS f32x4*)xrow + lane; const GAS f32x4* gr = (const GAS f32x4*)g + lane;
    float s = 0.f;
#pragma unroll
    for (int j = 0; j < 4; ++j) { v[j] = xr[64 * j]; s += (v[j].x * v[j].x + v[j].y * v[j].y) + (v[j].z * v[j].z + v[j].w * v[j].w); }
    const float rstd = 1.0f / sqrtf(wave_sum(s) * (1.f / DM) + 1e-6f);
#pragma unroll
    for (int j = 0; j < 4; ++j) { const f32x4 gg = gr[64 * j]; v[j] = v[j] * rstd * gg; }
}
__device__ __forceinline__ void store_row_bf16(bf16* orow, const f32x4 (&v)[4], int lane) {
    GAS unsigned long long* o8 = (GAS unsigned long long*)orow + lane;
#pragma unroll
    for (int j = 0; j < 4; ++j) o8[64 * j] = (unsigned long long)pk2(v[j].x, v[j].y) | ((unsigned long long)pk2(v[j].z, v[j].w) << 32);
}

__device__ __forceinline__ int t5_bucket(int rel) {
    const int n = rel < 0 ? -rel : rel; int ret = rel > 0 ? 16 : 0;
    int v;
    if (n < 8) v = n;
    else { const float nf = (float)n; int large = 8 + (int)(logf(nf / 8.0f) / 2.772588722239781f * 8.0f); v = large < 15 ? large : 15; }
    return ret + v;
}

__device__ __forceinline__ int crow(int r, int hi) { return (r & 3) + 8 * (r >> 2) + 4 * hi; }
__device__ __forceinline__ unsigned cvtpk(float lo, float hi) { unsigned r; asm volatile("v_cvt_pk_bf16_f32 %0, %1, %2" : "=v"(r) : "v"(lo), "v"(hi)); return r; }
__device__ __forceinline__ s16x4 vtr(const LAS char* p) { typedef short v4i16_t __attribute__((ext_vector_type(4))); return __builtin_bit_cast(s16x4, __builtin_amdgcn_ds_read_tr16_b64_v4i16((LAS v4i16_t*)p)); }

template <int DV, bool BIAS, bool FP8 = false>
__device__ __forceinline__ void attn_unit_v0(const bf16* Qp, int ldq, const bf16* Kp, int ldk, const bf16* Vp, int ldv, bf16* Op, int ldo, const LAS float* btbl, int q0, LAS unsigned char* lds) {
    const int tid = threadIdx.x, lane = tid & 63, r32 = lane & 31, hi = lane >> 5; const int wid = __builtin_amdgcn_readfirstlane(tid >> 6);
    constexpr int ND = DV / 32;
    LAS unsigned char* ldsK = lds; LAS unsigned char* ldsV = lds + 8192; LAS float* wsf = (LAS float*)(lds + 8192 + DV * 128) + wid * 64;
    bf16x8 qr[4]; v8i q8 = {0, 0, 0, 0, 0, 0, 0, 0};
    if (FP8) { const v4u a = *(const v4u*)((const unsigned char*)Qp + (size_t)(wid * 32 + r32) * ldq + hi * 32), b = *(const v4u*)((const unsigned char*)Qp + (size_t)(wid * 32 + r32) * ldq + hi * 32 + 16);
        q8 = (v8i){(int)a.x, (int)a.y, (int)a.z, (int)a.w, (int)b.x, (int)b.y, (int)b.z, (int)b.w}; }
    else {
#pragma unroll
    for (int d0 = 0; d0 < 4; ++d0) qr[d0] = *(const bf16x8*)(Qp + (size_t)(wid * 32 + r32) * ldq + d0 * 16 + hi * 8); }
    f32x16 o[ND];
#pragma unroll
    for (int d = 0; d < ND; ++d)
#pragma unroll
        for (int r = 0; r < 16; ++r) o[d][r] = 0.f;
    float l = 0.f;
    const int qpos = q0 + wid * 32 + r32;
    const LAS char* kp0 = (const LAS char*)ldsK + hi * 1024 + r32 * 16;
    const LAS char* vp0 = (const LAS char*)ldsV + ((lane >> 4) & 1) * 32 + (lane & 3) * 8 + (4 * hi + ((lane & 15) >> 2)) * 64;
    for (int t = 0; t < SEQ / 64; ++t) {
        __syncthreads();
        {
            if (FP8) { if (wid < 4) { const v4u kv = *(const v4u*)((const unsigned char*)Kp + (size_t)(t * 64 + lane) * ldk + wid * 16); *(LAS v4u*)(ldsK + wid * 1024 + lane * 16) = kv; } }
            else { const v4u kv = *(const v4u*)(Kp + (size_t)(t * 64 + lane) * ldk + wid * 8);
            *(LAS v4u*)(ldsK + wid * 1024 + lane * 16) = kv; }
#pragma unroll
            for (int pp = 0; pp < ND / 2; ++pp) { const int p = wid + 8 * pp, dq = p >> 2, rg = p & 3;
                const v4u vv = *(const v4u*)(Vp + (size_t)(t * 64 + 16 * rg + (lane >> 2)) * ldv + dq * 32 + (lane & 3) * 8);
                *(LAS v4u*)(ldsV + p * 1024 + lane * 16) = vv; }
        }
        __syncthreads();
        f32x16 p0, p1;
#pragma unroll
        for (int r = 0; r < 16; ++r) { p0[r] = 0.f; p1[r] = 0.f; }
        if (FP8) {
            const LAS char* k8 = (const LAS char*)ldsK + hi * 2048 + r32 * 16;
            const v4u a0 = *(const LAS v4u*)(k8), a1 = *(const LAS v4u*)(k8 + 1024), b0 = *(const LAS v4u*)(k8 + 512), b1 = *(const LAS v4u*)(k8 + 1024 + 512);
            const v8i ka = (v8i){(int)a0.x, (int)a0.y, (int)a0.z, (int)a0.w, (int)a1.x, (int)a1.y, (int)a1.z, (int)a1.w};
            const v8i kb = (v8i){(int)b0.x, (int)b0.y, (int)b0.z, (int)b0.w, (int)b1.x, (int)b1.y, (int)b1.z, (int)b1.w};
            p0 = __builtin_amdgcn_mfma_scale_f32_32x32x64_f8f6f4(ka, q8, p0, 0, 0, 0, 0x7f7f7f7f, 0, 0x7c7c7c7c);
            p1 = __builtin_amdgcn_mfma_scale_f32_32x32x64_f8f6f4(kb, q8, p1, 0, 0, 0, 0x7f7f7f7f, 0, 0x7c7c7c7c);
        } else {
#pragma unroll
        for (int d0 = 0; d0 < 4; ++d0) {
            const bf16x8 b0 = *(const LAS bf16x8*)(kp0 + d0 * 2048), b1 = *(const LAS bf16x8*)(kp0 + d0 * 2048 + 512);
            p0 = __builtin_amdgcn_mfma_f32_32x32x16_bf16(b0, qr[d0], p0, 0, 0, 0);
            p1 = __builtin_amdgcn_mfma_f32_32x32x16_bf16(b1, qr[d0], p1, 0, 0, 0);
        } }
        if (BIAS) {
            const int base = t * 64 + 4 * hi - qpos;
#pragma unroll
            for (int r = 0; r < 16; ++r) { int rel = base + (r & 3) + 8 * (r >> 2);
                int i0 = rel < -128 ? -128 : (rel > 128 ? 128 : rel); int rel1 = rel + 32; int i1 = rel1 < -128 ? -128 : (rel1 > 128 ? 128 : rel1);
                p0[r] += btbl[i0 + 128]; p1[r] += btbl[i1 + 128]; }
        }
        float sacc = 0.f;
#pragma unroll
        for (int r = 0; r < 16; ++r) { p0[r] = __builtin_amdgcn_exp2f(p0[r]); p1[r] = __builtin_amdgcn_exp2f(p1[r]); sacc += p0[r] + p1[r]; }
        l += sacc;
        v4u pw[4];
#pragma unroll
        for (int k = 0; k < 2; ++k) {
            pw[k]     = (v4u){cvtpk(p0[8 * k + 0], p0[8 * k + 1]), cvtpk(p0[8 * k + 2], p0[8 * k + 3]), cvtpk(p0[8 * k + 4], p0[8 * k + 5]), cvtpk(p0[8 * k + 6], p0[8 * k + 7])};
            pw[2 + k] = (v4u){cvtpk(p1[8 * k + 0], p1[8 * k + 1]), cvtpk(p1[8 * k + 2], p1[8 * k + 3]), cvtpk(p1[8 * k + 4], p1[8 * k + 5]), cvtpk(p1[8 * k + 6], p1[8 * k + 7])};
        }
#pragma unroll
        for (int d0 = 0; d0 < ND; ++d0)
#pragma unroll
            for (int ks = 0; ks < 4; ++ks) {
                const s16x4 lo = vtr(vp0 + d0 * 4096 + ks * 1024), hh = vtr(vp0 + d0 * 4096 + ks * 1024 + 512);
                const bf16x8 vf = (bf16x8){lo[0], lo[1], lo[2], lo[3], hh[0], hh[1], hh[2], hh[3]};
                o[d0] = __builtin_amdgcn_mfma_f32_32x32x16_bf16(__builtin_bit_cast(bf16x8, pw[ks]), vf, o[d0], 0, 0, 0);
            }
    }
    l += __shfl_xor(l, 32);
    if (hi == 0) wsf[r32] = l;
    LDS_WAIT(); asm volatile("" ::: "memory");
#pragma unroll
    for (int r = 0; r < 16; ++r) { const int row = crow(r, hi); const float rl = 1.0f / wsf[row];
#pragma unroll
        for (int d0 = 0; d0 < ND; ++d0) Op[(size_t)(wid * 32 + row) * ldo + d0 * 32 + r32] = (bf16)f2bf(o[d0][r] * rl); }
    LDS_WAIT();
}

namespace at1 {
#define SBAR() __builtin_amdgcn_sched_barrier(0)
#define PIN(x) asm volatile("" : "+v"(x))
template <int N, bool NOBAR = false> __device__ __forceinline__ void wait_bar() { if (NOBAR) asm volatile("s_waitcnt vmcnt(%0) lgkmcnt(0)" :: "n"(N) : "memory"); else asm volatile("s_waitcnt vmcnt(%0) lgkmcnt(0)\n\ts_barrier" :: "n"(N) : "memory"); }
__device__ __forceinline__ void glds16(const void* gsrc, unsigned lds_dst) { unsigned keep;
    asm volatile("s_mov_b32 %0, m0\n\ts_mov_b32 m0, %2\n\ts_nop 0\n\tglobal_load_lds_dwordx4 %1, off\n\ts_mov_b32 m0, %0" : "=&s"(keep) : "v"(gsrc), "s"(lds_dst) : "memory"); }
typedef float f32x2_t __attribute__((ext_vector_type(2))); typedef __bf16 bf16x2_t __attribute__((ext_vector_type(2)));
__device__ __forceinline__ unsigned cvtpk_s(float lo, float hi) { f32x2_t v = {lo, hi}; bf16x2_t b = __builtin_convertvector(v, bf16x2_t); return __builtin_bit_cast(unsigned, b); }
typedef const LAS char* lds_cptr;
__device__ __forceinline__ void kload2(bf16x8* kf, lds_cptr kp, int j) { kf[2 * j] = *(const LAS bf16x8*)(kp + j * 2048); kf[2 * j + 1] = *(const LAS bf16x8*)(kp + j * 2048 + 512); }

template <int DV, bool FP8> __host__ __device__ constexpr int lds_ws_off() { return (3 * (FP8 ? 4096 : 8192) + 3 * DV * 128) > 512 * DV ? (3 * (FP8 ? 4096 : 8192) + 3 * DV * 128) : 512 * DV; }
template <int DV, bool FP8> __host__ __device__ constexpr int lds_tbl_off() { return lds_ws_off<DV, FP8>() + 2048; }
template <int DV, bool BIAS, int TEST = 0, int MODE = 0, bool FP8 = false>
__device__ __forceinline__ void attn_unit(const bf16* Qp, int ldq, const bf16* __restrict__ Kp, int ldk, const bf16* __restrict__ Vp, int ldv, bf16* Op, int ldo, int q0, LAS unsigned char* lds, const LAS float* sgt = nullptr) {
    constexpr int ND = DV / 32, NV = ND / 2, VSLOT = DV * 128, KSLOT = FP8 ? 4096 : 8192, NT = SEQ / 64;
    constexpr int LDS_K = 0, LDS_V = 3 * KSLOT, LDS_WS = lds_ws_off<DV, FP8>(), LDS_TBL = LDS_WS + 2048;
    static_assert(LDS_WS >= LDS_V + 3 * VSLOT && LDS_WS >= 512 * DV && LDS_TBL + 2048 <= STASH_OFF, "LDS map");
    const int tid = threadIdx.x, lane = tid & 63, r32 = lane & 31, hi = lane >> 5; const int wid = __builtin_amdgcn_readfirstlane(tid >> 6);
    const unsigned lds0 = (unsigned)(uintptr_t)lds;
    LAS float* wsf = (LAS float*)(lds + LDS_WS) + wid * 64;
    const LAS float* btbl = (const LAS float*)(lds + LDS_TBL);
    const unsigned char* ksrc = FP8 ? (const unsigned char*)Kp + (size_t)lane * ldk + (wid & 3) * 16 : (const unsigned char*)(Kp + (size_t)lane * ldk + wid * 8);
    const bf16* vsrc0 = Vp + (size_t)(16 * (wid & 3) + (lane >> 2)) * ldv + (wid >> 2) * 32 + (lane & 3) * 8;
    const bf16* vsrc1 = vsrc0 + 64;
    const unsigned kdst = lds0 + LDS_K + wid * 1024, vdst = lds0 + LDS_V + wid * 1024;
#define DMA_K(t, s) if (!(TEST & 8) && (!FP8 || wid < 4)) glds16(ksrc + (size_t)(t) * 64 * ldk * (FP8 ? 1 : 2), (unsigned)__builtin_amdgcn_readfirstlane(kdst + (s) * KSLOT))
#define DMA_V(t, s) do { if (TEST & 8) break; glds16(vsrc0 + (size_t)(t) * 64 * ldv, (unsigned)__builtin_amdgcn_readfirstlane(vdst + (s) * VSLOT)); \
        if (NV == 2) glds16(vsrc1 + (size_t)(t) * 64 * ldv, (unsigned)__builtin_amdgcn_readfirstlane(vdst + (s) * VSLOT + 8192)); } while (0)
    const lds_cptr kp0 = (lds_cptr)lds + LDS_K + hi * (FP8 ? 2048 : 1024) + r32 * 16;
    const lds_cptr vp0 = (lds_cptr)lds + LDS_V + ((lane >> 4) & 1) * 32 + (lane & 3) * 8 + (4 * hi + ((lane & 15) >> 2)) * 64;
    DMA_K(0, 0); DMA_V(0, 0); DMA_K(1, 1);
    bf16x8 qr[4]; v8i q8 = {0, 0, 0, 0, 0, 0, 0, 0};
    if (FP8) { const unsigned char* qb_ = (const unsigned char*)Qp + (size_t)(wid * 32 + r32) * ldq + hi * 32; const v4u a = *(const v4u*)qb_, b = *(const v4u*)(qb_ + 16);
        q8 = (v8i){(int)a.x, (int)a.y, (int)a.z, (int)a.w, (int)b.x, (int)b.y, (int)b.z, (int)b.w}; }
    else {
#pragma unroll
        for (int d0 = 0; d0 < 4; ++d0) qr[d0] = *(const bf16x8*)(Qp + (size_t)(wid * 32 + r32) * ldq + d0 * 16 + hi * 8); }
    float l_reg = 0.f; f32x16 o[ND];
#pragma unroll
    for (int d = 0; d < ND; ++d) o[d] = f32x16{};
    const f32x16 zero16 = f32x16{};
    const int qw = q0 + wid * 32, qpos = qw + r32;
    int tl = 0, tr = NT; float fL = 1.f;
    if (BIAS) { tl = (qw - 191 >= 0) ? ((qw - 191) >> 6) + 1 : 0; tr = (qw + 158) >> 6; fL = __builtin_amdgcn_exp2f(btbl[0]); }
    f32x16 pA0, pA1, pB0, pB1; bf16x8 kf[8]; v8i kf8[2]; s16x4 vlo[8], vhi[8]; v4u pw0, pw1, pw2, pw3;
#define KLOAD8(n, kp_) do { const v4u a_ = *(const LAS v4u*)((kp_) + (n) * 512), b_ = *(const LAS v4u*)((kp_) + (n) * 512 + 1024); kf8[n] = (v8i){(int)a_.x, (int)a_.y, (int)a_.z, (int)a_.w, (int)b_.x, (int)b_.y, (int)b_.z, (int)b_.w}; } while (0)
#define MF8(kf_, c_) __builtin_amdgcn_mfma_scale_f32_32x32x64_f8f6f4(kf_, q8, c_, 0, 0, 0, 0x7f7f7f7f, 0, 0x7c7c7c7c)
#define WAITB(N) do { if (FP8 && wid >= 4) wait_bar<(N) - 1, (TEST & 16) != 0>(); else wait_bar<(N), (TEST & 16) != 0>(); } while (0)
    if (TEST & 32) { pB0 = f32x16{}; pB1 = f32x16{}; }
    if (TEST & 64) { _Pragma("unroll") for (int i_ = 0; i_ < 8; ++i_) { vlo[i_] = (s16x4){1, 2, 3, 4}; vhi[i_] = (s16x4){4, 3, 2, 1}; } }
    int s_prev = 0, s_cur = 0, s_next = 1;
#define ROT() do { s_prev = s_cur; s_cur = s_next; s_next = (s_next == 2) ? 0 : s_next + 1; } while (0)
#define ADD_BIAS(C0, C1, t) do { if (BIAS && (t) >= tl && (t) <= tr) { const int base_ = (t) * 64 + 4 * hi - qpos; \
        _Pragma("unroll") for (int r = 0; r < 16; ++r) { const int rel0 = base_ + (r & 3) + 8 * (r >> 2); const int rel1 = rel0 + 32; \
            const int i0 = (rel0 < -128 ? -128 : (rel0 > 128 ? 128 : rel0)) + 128, i1 = (rel1 < -128 ? -128 : (rel1 > 128 ? 128 : rel1)) + 128; \
            C0[r] += btbl[i0]; C1[r] += btbl[i1]; } } } while (0)
    DMA_K(2, 2);
    if (FP8) wait_bar<0, (TEST & 16) != 0>(); else wait_bar<NV + 2, (TEST & 16) != 0>();
    {
        if (FP8) { KLOAD8(0, kp0); KLOAD8(1, kp0); pA0 = MF8(kf8[0], zero16); pA1 = MF8(kf8[1], zero16); }
        else {
#pragma unroll
        for (int j = 0; j < 4; ++j) kload2(kf, kp0, j);
        pA0 = __builtin_amdgcn_mfma_f32_32x32x16_bf16(kf[0], qr[0], zero16, 0, 0, 0); pA1 = __builtin_amdgcn_mfma_f32_32x32x16_bf16(kf[1], qr[0], zero16, 0, 0, 0);
#pragma unroll
        for (int d0 = 1; d0 < 4; ++d0) { pA0 = __builtin_amdgcn_mfma_f32_32x32x16_bf16(kf[2 * d0], qr[d0], pA0, 0, 0, 0); pA1 = __builtin_amdgcn_mfma_f32_32x32x16_bf16(kf[2 * d0 + 1], qr[d0], pA1, 0, 0, 0); } }
        ADD_BIAS(pA0, pA1, 0);
#pragma unroll
        for (int r = 0; r < 16; ++r) { pA0[r] = __builtin_amdgcn_exp2f(pA0[r]); pA1[r] = __builtin_amdgcn_exp2f(pA1[r]); }
    }
    wait_bar<0, (TEST & 16) != 0>();
    DMA_K(3, 0); DMA_V(1, 1);
    ROT();
    if (FP8) { KLOAD8(0, kp0 + s_cur * KSLOT); KLOAD8(1, kp0 + s_cur * KSLOT); }
    else {
#pragma unroll
    for (int j = 0; j < 4; ++j) kload2(kf, kp0 + s_cur * KSLOT, j); }
    WAITB(1 + NV);
#define PKW(P, B) ((TEST & 256) ? 0x3f803f80u : cvtpk_s(P[B], P[B + 1]))
#define PAF(k) __builtin_bit_cast(bf16x8, pw##k)
#define VFR(i) (bf16x8){vlo[i][0], vlo[i][1], vlo[i][2], vlo[i][3], vhi[i][0], vhi[i][1], vhi[i][2], vhi[i][3]}
#define MF(a, b, c) __builtin_amdgcn_mfma_f32_32x32x16_bf16(a, b, c, 0, 0, 0)
#define GAPA(MFS, A0, A1, A2, A3, W0, W1, PW) do { if (!(TEST & 32)) { MFS; } if (!(TEST & 2)) { sacc += A0; sacc += A1; sacc += A2; sacc += A3; PIN(sacc); } W0; W1; PIN(PW); SBAR(); } while (0)
#define EX(v) ((TEST & 1) ? (v) : __builtin_amdgcn_exp2f(v))
#define GAPB4(MFS, X, B) do { if (!(TEST & 4)) { MFS; } X[B] = EX(X[B]); X[B + 1] = EX(X[B + 1]); X[B + 2] = EX(X[B + 2]); X[B + 3] = EX(X[B + 3]); PIN(X); SBAR(); } while (0)
#define GAPB2(MFS, X, B) do { if (!(TEST & 4)) { MFS; } X[B] = EX(X[B]); X[B + 1] = EX(X[B + 1]); PIN(X); SBAR(); } while (0)
#define VRD(f, s) do { if (TEST & 64) break; vlo[s] = vtr(vp_ + (((f) >> 2) * 4096 + ((f) & 3) * 1024)); vhi[s] = vtr(vp_ + (((f) >> 2) * 4096 + ((f) & 3) * 1024 + 512)); } while (0)
#define KRD(G, j) do { if ((G) && !(TEST & 128)) { if (FP8) { if ((j) < 2) { KLOAD8(j, kp0 + s_next * KSLOT); } } else kload2(kf, kp0 + s_next * KSLOT, j); SBAR(); } } while (0)
#define FO(m) (ND == 2 ? (((m) >> 1) + 4 * ((m) & 1)) : ((((m) & 7) >> 2) + 2 * ((m) >> 3) + 4 * ((m) & 3)))
#define STEP(C0, C1, P0, P1, t, GK, GV, GL) do { SBAR(); \
    const lds_cptr vp_ = vp0 + s_prev * VSLOT; float sacc; \
    if (FP8) { \
      VRD(FO(0), 0); VRD(FO(1), 1); VRD(FO(2), 2); VRD(FO(3), 3); SBAR(); \
      if (!(TEST & 32)) C0 = MF8(kf8[0], zero16); \
      sacc = (P0[0] + P0[1]); if (!(TEST & 2)) { _Pragma("unroll") for (int r_ = 2; r_ < 16; ++r_) sacc += P0[r_]; PIN(sacc); } \
      pw0 = (v4u){PKW(P0, 0), PKW(P0, 2), PKW(P0, 4), PKW(P0, 6)}; pw1 = (v4u){PKW(P0, 8), PKW(P0, 10), PKW(P0, 12), PKW(P0, 14)}; PIN(pw0); PIN(pw1); SBAR(); \
      VRD(FO(4), 4); VRD(FO(5), 5); VRD(FO(6), 6); VRD(FO(7), 7); SBAR(); \
      if (!(TEST & 32)) C1 = MF8(kf8[1], zero16); \
      if (!(TEST & 2)) { _Pragma("unroll") for (int r_ = 0; r_ < 16; ++r_) sacc += P1[r_]; PIN(sacc); } \
      pw2 = (v4u){PKW(P1, 0), PKW(P1, 2), PKW(P1, 4), PKW(P1, 6)}; pw3 = (v4u){PKW(P1, 8), PKW(P1, 10), PKW(P1, 12), PKW(P1, 14)}; PIN(pw2); PIN(pw3); SBAR(); \
    } else { \
    VRD(FO(0), 0); SBAR(); sacc = (P0[0] + P0[1]); \
    GAPA(C0 = MF(kf[0], qr[0], zero16), P0[2], P0[3], P0[4], P0[5],     pw0[0] = PKW(P0, 0), pw0[1] = PKW(P0, 2), pw0); \
    VRD(FO(1), 1); SBAR(); GAPA(C1 = MF(kf[1], qr[0], zero16), P0[6], P0[7], P0[8], P0[9],     pw0[2] = PKW(P0, 4), pw0[3] = PKW(P0, 6), pw0); \
    VRD(FO(2), 2); SBAR(); GAPA(C0 = MF(kf[2], qr[1], C0),   P0[10], P0[11], P0[12], P0[13], pw1[0] = PKW(P0, 8), pw1[1] = PKW(P0, 10), pw1); \
    VRD(FO(3), 3); SBAR(); GAPA(C1 = MF(kf[3], qr[1], C1),   P0[14], P0[15], P1[0], P1[1],   pw1[2] = PKW(P0, 12), pw1[3] = PKW(P0, 14), pw1); \
    VRD(FO(4), 4); SBAR(); GAPA(C0 = MF(kf[4], qr[2], C0),   P1[2], P1[3], P1[4], P1[5],     pw2[0] = PKW(P1, 0), pw2[1] = PKW(P1, 2), pw2); \
    VRD(FO(5), 5); SBAR(); GAPA(C1 = MF(kf[5], qr[2], C1),   P1[6], P1[7], P1[8], P1[9],     pw2[2] = PKW(P1, 4), pw2[3] = PKW(P1, 6), pw2); \
    VRD(FO(6), 6); SBAR(); GAPA(C0 = MF(kf[6], qr[3], C0),   P1[10], P1[11], P1[12], P1[13], pw3[0] = PKW(P1, 8), pw3[1] = PKW(P1, 10), pw3); \
    VRD(FO(7), 7); SBAR(); GAPA(C1 = MF(kf[7], qr[3], C1),   P1[14], P1[15], 0.f, 0.f,       pw3[2] = PKW(P1, 12), pw3[3] = PKW(P1, 14), pw3); \
    } \
    l_reg += sacc; \
    if (GK) { DMA_K((t) + 3, s_cur); } if (GV) { DMA_V((t) + 1, s_next); } \
    ADD_BIAS(C0, C1, t); \
    SBAR(); \
    if (ND == 2) { \
        GAPB4(o[0] = MF(PAF(0), VFR(0), o[0]), C0, 0); \
        GAPB4(o[1] = MF(PAF(0), VFR(1), o[1]), C0, 4); \
        KRD(GL, 0); GAPB4(o[0] = MF(PAF(1), VFR(2), o[0]), C0, 8); \
        KRD(GL, 1); GAPB4(o[1] = MF(PAF(1), VFR(3), o[1]), C0, 12); \
        KRD(GL, 2); GAPB4(o[0] = MF(PAF(2), VFR(4), o[0]), C1, 0); \
        KRD(GL, 3); GAPB4(o[1] = MF(PAF(2), VFR(5), o[1]), C1, 4); \
        GAPB4(o[0] = MF(PAF(3), VFR(6), o[0]), C1, 8); \
        GAPB4(o[1] = MF(PAF(3), VFR(7), o[1]), C1, 12); \
    } else { \
        GAPB2(o[0] = MF(PAF(0), VFR(0), o[0]), C0, 0);  VRD(FO(8), 0); SBAR(); \
        GAPB2(o[1] = MF(PAF(0), VFR(1), o[1]), C0, 2);  VRD(FO(9), 1); SBAR(); \
        GAPB2(o[ND - 2] = MF(PAF(0), VFR(2), o[ND - 2]), C0, 4);  VRD(FO(10), 2); SBAR(); \
        GAPB2(o[ND - 1] = MF(PAF(0), VFR(3), o[ND - 1]), C0, 6);  VRD(FO(11), 3); SBAR(); \
        GAPB2(o[0] = MF(PAF(1), VFR(4), o[0]), C0, 8);  VRD(FO(12), 4); SBAR(); \
        GAPB2(o[1] = MF(PAF(1), VFR(5), o[1]), C0, 10); VRD(FO(13), 5); SBAR(); \
        GAPB2(o[ND - 2] = MF(PAF(1), VFR(6), o[ND - 2]), C0, 12); VRD(FO(14), 6); SBAR(); \
        GAPB2(o[ND - 1] = MF(PAF(1), VFR(7), o[ND - 1]), C0, 14); VRD(FO(15), 7); SBAR(); \
        KRD(GL, 0); GAPB2(o[0] = MF(PAF(2), VFR(0), o[0]), C1, 0); \
        GAPB2(o[1] = MF(PAF(2), VFR(1), o[1]), C1, 2); \
        KRD(GL, 1); GAPB2(o[ND - 2] = MF(PAF(2), VFR(2), o[ND - 2]), C1, 4); \
        GAPB2(o[ND - 1] = MF(PAF(2), VFR(3), o[ND - 1]), C1, 6); \
        KRD(GL, 2); GAPB2(o[0] = MF(PAF(3), VFR(4), o[0]), C1, 8); \
        GAPB2(o[1] = MF(PAF(3), VFR(5), o[1]), C1, 10); \
        KRD(GL, 3); GAPB2(o[ND - 2] = MF(PAF(3), VFR(6), o[ND - 2]), C1, 12); \
        GAPB2(o[ND - 1] = MF(PAF(3), VFR(7), o[ND - 1]), C1, 14); \
    } \
    if (BIAS && (t) == tl) { l_reg *= fL; _Pragma("unroll") for (int d_ = 0; d_ < ND; ++d_) _Pragma("unroll") for (int r = 0; r < 16; ++r) o[d_][r] *= fL; } \
    } while (0)
    int t = 1;
    for (; t + 4 < NT; t += 2) {
        STEP(pB0, pB1, pA0, pA1, t, true, true, true);       WAITB(1 + NV); ROT();
        STEP(pA0, pA1, pB0, pB1, t + 1, true, true, true);   WAITB(1 + NV); ROT();
    }
    STEP(pB0, pB1, pA0, pA1, NT - 3, false, true, true);  wait_bar<NV, (TEST & 16) != 0>(); ROT();
    STEP(pA0, pA1, pB0, pB1, NT - 2, false, true, true);  wait_bar<0, (TEST & 16) != 0>();  ROT();
    STEP(pB0, pB1, pA0, pA1, NT - 1, false, false, false);
    {
        float sacc = pB0[0] + pB0[1];
#pragma unroll
        for (int r = 2; r < 16; ++r) sacc += pB0[r];
#pragma unroll
        for (int r = 0; r < 16; ++r) sacc += pB1[r];
        l_reg += sacc;
        pw0 = (v4u){PKW(pB0, 0), PKW(pB0, 2), PKW(pB0, 4), PKW(pB0, 6)}; pw1 = (v4u){PKW(pB0, 8), PKW(pB0, 10), PKW(pB0, 12), PKW(pB0, 14)};
        pw2 = (v4u){PKW(pB1, 0), PKW(pB1, 2), PKW(pB1, 4), PKW(pB1, 6)}; pw3 = (v4u){PKW(pB1, 8), PKW(pB1, 10), PKW(pB1, 12), PKW(pB1, 14)};
        const lds_cptr vp_ = vp0 + s_cur * VSLOT;
#pragma unroll
        for (int d0 = 0; d0 < ND; ++d0) {
            s16x4 a0 = vtr(vp_ + d0 * 4096), b0 = vtr(vp_ + d0 * 4096 + 512), a1 = vtr(vp_ + d0 * 4096 + 1024), b1 = vtr(vp_ + d0 * 4096 + 1536);
            s16x4 a2 = vtr(vp_ + d0 * 4096 + 2048), b2 = vtr(vp_ + d0 * 4096 + 2560), a3 = vtr(vp_ + d0 * 4096 + 3072), b3 = vtr(vp_ + d0 * 4096 + 3584);
            o[d0] = MF(PAF(0), ((bf16x8){a0[0], a0[1], a0[2], a0[3], b0[0], b0[1], b0[2], b0[3]}), o[d0]);
            o[d0] = MF(PAF(1), ((bf16x8){a1[0], a1[1], a1[2], a1[3], b1[0], b1[1], b1[2], b1[3]}), o[d0]);
            o[d0] = MF(PAF(2), ((bf16x8){a2[0], a2[1], a2[2], a2[3], b2[0], b2[1], b2[2], b2[3]}), o[d0]);
            o[d0] = MF(PAF(3), ((bf16x8){a3[0], a3[1], a3[2], a3[3], b3[0], b3[1], b3[2], b3[3]}), o[d0]);
        }
    }
    l_reg += __shfl_xor(l_reg, 32);
    int lane_e = lane; asm volatile("" : "+v"(lane_e));
    const int r32e = lane_e & 31, hie = lane_e >> 5;
    if (hie == 0) wsf[r32e] = l_reg;
    asm volatile("s_waitcnt lgkmcnt(0)\n\ts_barrier" ::: "memory");
    {
        LAS bf16* stg = (LAS bf16*)(MODE == 1 ? lds + STASH_OFF : lds) + wid * (32 * DV);
#pragma unroll
        for (int r = 0; r < 16; ++r) { const int orow = crow(r, hie); const float rl = __builtin_amdgcn_rcpf(wsf[orow]);
#pragma unroll
            for (int d0 = 0; d0 < ND; ++d0) stg[orow * DV + d0 * 32 + r32e] = (bf16)f2bf(o[d0][r] * rl); }
        asm volatile("s_waitcnt lgkmcnt(0)" ::: "memory");
        if (MODE == 0) {
            constexpr int CPR = DV / 8;
#pragma unroll
            for (int i = 0; i < (32 * CPR) / 64; ++i) { const int row = i * (64 / CPR) + lane_e / CPR, ch = lane_e % CPR;
                const v4u v = *(const LAS v4u*)(stg + row * DV + ch * 8); *(v4u*)(Op + (size_t)(wid * 32 + row) * ldo + ch * 8) = v; }
        } else if (MODE == 2) {
            const int row = lane_e >> 1, half = lane_e & 1; const float lam = sgt[128];
            const LAS bf16* s1 = stg + row * DV + half * 64; const LAS bf16* s0 = (const LAS bf16*)(lds + STASH_OFF) + wid * (32 * DV) + row * DV + half * 64;
            float ov[64]; float ss = 0.f;
#pragma unroll
            for (int q = 0; q < 8; ++q) { const v4u a = *(const LAS v4u*)(s0 + q * 8), c = *(const LAS v4u*)(s1 + q * 8);
#pragma unroll
                for (int j = 0; j < 4; ++j) { const float lo = __builtin_bit_cast(float, a[j] << 16) - lam * __builtin_bit_cast(float, c[j] << 16);
                    const float hh = __builtin_bit_cast(float, a[j] & 0xffff0000u) - lam * __builtin_bit_cast(float, c[j] & 0xffff0000u);
                    ov[q * 8 + 2 * j] = lo; ov[q * 8 + 2 * j + 1] = hh; ss += lo * lo + hh * hh; } }
            ss += dpp_mov<0xB1>(ss);
            const float rstd = 1.0f / sqrtf(ss * (1.f / 128.f) + 1e-5f);
            bf16* yo = Op + (size_t)(wid * 32 + row) * ldo + half * 64;
#pragma unroll
            for (int q = 0; q < 8; ++q) { const f32x4 g0 = *(const LAS f32x4*)(sgt + half * 64 + q * 8), g1 = *(const LAS f32x4*)(sgt + half * 64 + q * 8 + 4);
                v4u w; w.x = pk2(ov[q * 8] * rstd * g0.x, ov[q * 8 + 1] * rstd * g0.y); w.y = pk2(ov[q * 8 + 2] * rstd * g0.z, ov[q * 8 + 3] * rstd * g0.w);
                w.z = pk2(ov[q * 8 + 4] * rstd * g1.x, ov[q * 8 + 5] * rstd * g1.y); w.w = pk2(ov[q * 8 + 6] * rstd * g1.z, ov[q * 8 + 7] * rstd * g1.w);
                *(v4u*)(yo + q * 8) = w; }
        }
    }
    asm volatile("s_waitcnt lgkmcnt(0)\n\ts_barrier" ::: "memory");
#undef KLOAD8
#undef MF8
#undef WAITB
#undef DMA_K
#undef DMA_V
#undef ROT
#undef ADD_BIAS
#undef PKW
#undef PAF
#undef VFR
#undef MF
#undef GAPA
#undef EX
#undef GAPB4
#undef GAPB2
#undef VRD
#undef KRD
#undef FO
#undef STEP
}
#undef SBAR
#undef PIN
}

struct Args { const float* in[27]; float* out; unsigned char* ws; int ph_lo, ph_hi, li, pad; };

constexpr int NPHASE = 17;
constexpr int NWAVES = 8;

#define IN(k) (lo <= (k) && (k) < hi_ph)
#define SEAM(k) do { if (IN(k) && IN((k) + 1)) xcd_barrier(bar); } while (0)
template <int layer>
__device__ __forceinline__ void moe_block(const Args& args, LAS unsigned char* lds, const XcdBarrier& bar, int lo, int hi_ph) {
    volatile LAS unsigned* LC = (volatile LAS unsigned*)(lds + LDSCTL_OFF);
    const int tid = threadIdx.x, lane = tid & 63, wave = __builtin_amdgcn_readfirstlane(tid >> 6);
    const int G = gridDim.x, bx = blockIdx.x;
    const int gw = bx * NWAVES + wave, NGW = G * NWAVES;
    unsigned char* ws = args.ws;
    unsigned* ctl = (unsigned*)(ws + WS_CTL);
    float* xres = args.out;
    bf16* HB = (bf16*)(ws + WS_HB);
    {
        const int pb = layer == 0 ? 5 : 13;
        unsigned* const gcnt0 = ctl + CW_CNT + layer * 64;
        int* list = (int*)(ws + WS_LIST); int* tokep = (int*)(ws + WS_TOKEP); float* gate = (float*)(ws + WS_GATE);
        if (IN(pb)) REP(pb) {
            unsigned* gcnt = gcnt0 + ((MK_N_LAUNCHES == 1 ? (int)((PROBE_MASK >> pb) & 1u) : 0) - rep_) * 128;
            if (rep_ > 0) xcd_barrier(bar);
            const float* gf = args.in[2] + layer * DM;
            const float* WR = (const float*)(ws + WS_TBL) + TBL_WR + layer * WR_LAYER;
            for (int chunk = bx; chunk < NTOK / 128; chunk += G) {
                __syncthreads();
                if (tid < 32) LC[LC_LCNT + tid] = 0u;
                __syncthreads();
                int my_e0 = 0, my_e1 = 0; float my_g0 = 0.f, my_g1 = 0.f;
                {
                    const int ri = lane & 15, kq = lane >> 4; const int r0w = chunk * 128 + wave * 16;
                    const GAS float* xrow = (const GAS float*)(xres + (size_t)(r0w + ri) * DM) + 4 * kq;
                    const GAS float* wb = (const GAS float*)WR + (size_t)(4 * kq) * 48 + ri;
                    f32x4 acc0 = {0.f, 0.f, 0.f, 0.f}, acc1 = acc0, acc2 = acc0; float ss = 0.f;
                    f32x4 aA[4], aB[4]; float bA[48], bB[48];
#define RT_LOAD(a_, b_, g_) do { _Pragma("unroll") for (int c_ = 0; c_ < 4; ++c_) { a_[c_] = *(const GAS f32x4*)(xrow + 16 * (4 * (g_) + c_)); \
        const GAS float* wc_ = wb + (size_t)(16 * (4 * (g_) + c_)) * 48; _Pragma("unroll") for (int e_ = 0; e_ < 4; ++e_) { b_[c_ * 12 + e_ * 3] = wc_[e_ * 48]; b_[c_ * 12 + e_ * 3 + 1] = wc_[e_ * 48 + 16]; b_[c_ * 12 + e_ * 3 + 2] = wc_[e_ * 48 + 32]; } } } while (0)
#define RT_COMP(a_, b_) do { _Pragma("unroll") for (int c_ = 0; c_ < 4; ++c_) { ss += (a_[c_].x * a_[c_].x + a_[c_].y * a_[c_].y) + (a_[c_].z * a_[c_].z + a_[c_].w * a_[c_].w); \
        _Pragma("unroll") for (int e_ = 0; e_ < 4; ++e_) { acc0 = __builtin_amdgcn_mfma_f32_16x16x4f32(a_[c_][e_], b_[c_ * 12 + e_ * 3], acc0, 0, 0, 0); \
            acc1 = __builtin_amdgcn_mfma_f32_16x16x4f32(a_[c_][e_], b_[c_ * 12 + e_ * 3 + 1], acc1, 0, 0, 0); acc2 = __builtin_amdgcn_mfma_f32_16x16x4f32(a_[c_][e_], b_[c_ * 12 + e_ * 3 + 2], acc2, 0, 0, 0); } } } while (0)
                    RT_LOAD(aA, bA, 0);
#pragma unroll 1
                    for (int g = 0; g < 16; g += 2) {
                        RT_LOAD(aB, bB, g + 1);
                        RT_COMP(aA, bA);
                        if (g + 2 < 16) RT_LOAD(aA, bA, g + 2);
                        RT_COMP(aB, bB);
                    }
#undef RT_LOAD
#undef RT_COMP
                    ss += __shfl_xor(ss, 16); ss += __shfl_xor(ss, 32);
                    const float rstd = 1.0f / sqrtf(ss * (1.f / DM) + 1e-6f);
                    LAS float* Lg = (LAS float*)(lds + wave * 4096);
#pragma unroll
                    for (int r = 0; r < 4; ++r) { Lg[(4 * kq + r) * 49 + ri] = acc0[r]; Lg[(4 * kq + r) * 49 + 16 + ri] = acc1[r]; Lg[(4 * kq + r) * 49 + 32 + ri] = acc2[r]; }
                    LDS_WAIT(); asm volatile("" ::: "memory");
                    if (lane < 16) {
                        const GAS float* bv = (const GAS float*)WR + 1024 * 48;
                        float lg[4], le[32];
#pragma unroll
                        for (int e = 0; e < 4; ++e) lg[e] = Lg[lane * 49 + e] * rstd + bv[e];
#pragma unroll
                        for (int e = 0; e < 32; ++e) le[e] = Lg[lane * 49 + 4 + e] * rstd + bv[4 + e];
                        int gi = 0; float gm = lg[0];
#pragma unroll
                        for (int e = 1; e < 4; ++e) if (lg[e] > gm) { gm = lg[e]; gi = e; }
                        float gs = 0.f;
#pragma unroll
                        for (int e = 0; e < 4; ++e) gs += __expf(lg[e] - gm);
                        const float gval = 1.0f / gs;
                        float ev[8];
#pragma unroll
                        for (int j = 0; j < 8; ++j) ev[j] = gi == 0 ? le[j] : (gi == 1 ? le[8 + j] : (gi == 2 ? le[16 + j] : le[24 + j]));
                        int i0 = 0; float m0 = ev[0];
#pragma unroll
                        for (int j = 1; j < 8; ++j) if (ev[j] > m0) { m0 = ev[j]; i0 = j; }
                        int i1 = -1; float m1 = -3.0e38f;
#pragma unroll
                        for (int j = 0; j < 8; ++j) if (j != i0 && ev[j] > m1) { m1 = ev[j]; i1 = j; }
                        const float t1 = __expf(m1 - m0); const float den = 1.0f / (1.0f + t1);
                        my_e0 = gi * 8 + i0; my_e1 = gi * 8 + i1; my_g0 = gval * den; my_g1 = gval * t1 * den;
                    }
                    for (int i = 0; i < 16; ++i) { const int m = r0w + i; f32x4 v[4]; rms_row(xres + (size_t)m * DM, gf, v, lane); store_row_bf16(HB + (size_t)m * DM, v, lane); }
                }
                unsigned r0 = 0, r1 = 0;
                if (lane < 16) { r0 = atomicAdd((unsigned*)(LC + LC_LCNT + my_e0), 1u); r1 = atomicAdd((unsigned*)(LC + LC_LCNT + my_e1), 1u); }
                __syncthreads();
                if (tid < 32) { const unsigned c = LC[LC_LCNT + tid]; LC[LC_LBASE + tid] = c ? __hip_atomic_fetch_add(gcnt + tid, c, RLX_AGENT) : 0u; }
                __syncthreads();
                if (lane < 16) { const int m = chunk * 128 + wave * 16 + lane;
                    const unsigned p0 = LC[LC_LBASE + my_e0] + r0, p1 = LC[LC_LBASE + my_e1] + r1;
                    list[(size_t)my_e0 * LIST_CAP + p0] = m; list[(size_t)my_e1 * LIST_CAP + p1] = m;
                    tokep[2 * m] = my_e0 | (int)(p0 << 8); tokep[2 * m + 1] = my_e1 | (int)(p1 << 8);
                    gate[2 * m] = my_g0; gate[2 * m + 1] = my_g1; }
            }
        }
        SEAM(pb);
        if (IN(pb + 1) || IN(pb + 2) || IN(pb + 3)) {
            __syncthreads();
            if (tid == 0) { int acc = 0; for (int e = 0; e < 32; ++e) { const int c = (int)__hip_atomic_load(gcnt0 + e, RLX_AGENT); LC[LC_CNT + e] = (unsigned)c; LC[LC_TP + e] = (unsigned)acc; acc += (c + 255) >> 8; } LC[LC_TP + 32] = (unsigned)acc;
                int la = 0; for (int j = 0; j < 4; ++j) { LC[LC_LP + j] = (unsigned)la; la += ((int)LC[LC_CNT + (bx & 7) + 8 * j] + 255) >> 8; } LC[LC_LP + 4] = (unsigned)la; }
            __syncthreads();
        }
        const LAS int* tp = (const LAS int*)(lds + LDSCTL_OFF) + LC_TP; const LAS int* cn = (const LAS int*)(lds + LDSCTL_OFF) + LC_CNT; const LAS int* lp = (const LAS int*)(lds + LDSCTL_OFF) + LC_LP;
        if (IN(pb + 1)) REP(pb + 1) {
            pg8::Gemm g{HB, (const bf16*)(ws + WS_W13), 0, 1024, DM};
            pg8::MoeOrder S{tp, cn, lp, list, G, bx, tp[32] * 4, true, G == 256};
            pg8::EpiSwiglu E{(bf16*)(ws + WS_H)};
            pg8::gemm_phase<pg8::EpiSwiglu, pg8::MoeOrder, true>(lds, g, S, E);
        }
        SEAM(pb + 1);
        if (IN(pb + 2)) REP(pb + 2) {
            pg8::Gemm g{(const bf16*)(ws + WS_H), (const bf16*)(ws + WS_W2), 0, 1024, MOE_H};
            pg8::MoeOrder S{tp, cn, lp, list, G, bx, tp[32] * 4, false, G == 256};
            pg8::EpiBf16 E{(bf16*)(ws + WS_YS), DM, 0, 0, 1.f, 3};
            pg8::gemm_phase<pg8::EpiBf16, pg8::MoeOrder, true>(lds, g, S, E);
        }
        SEAM(pb + 2);
        if (IN(pb + 3)) {
            const bf16* YS = (const bf16*)(ws + WS_YS);
            if (layer == 0) { LAS float* scr = (LAS float*)(lds + wave * 16384);
                transpose_moe(args.in[24] + (size_t)NEXP * 1024 * 512, args.in[25] + (size_t)NEXP * 1024 * 512, args.in[26] + (size_t)NEXP * 1024 * 512, (bf16*)(ws + WS_W13), (bf16*)(ws + WS_W2), scr, gw, NGW, lane); }
            const float* gn = layer == 0 ? args.in[1] + DM : args.in[3];
            for (int m = gw; m < NTOK; m += NGW) {
                const int ep0 = tokep[2 * m], ep1 = tokep[2 * m + 1]; const float g0 = gate[2 * m], g1 = gate[2 * m + 1];
                const size_t s0 = (size_t)(tp[ep0 & 255] * 256 + (ep0 >> 8)), s1 = (size_t)(tp[ep1 & 255] * 256 + (ep1 >> 8));
                GAS f32x4* xr = (GAS f32x4*)(xres + (size_t)m * DM) + lane;
                const GAS v2u* y0 = (const GAS v2u*)(YS + s0 * DM) + lane; const GAS v2u* y1 = (const GAS v2u*)(YS + s1 * DM) + lane;
                f32x4 v[4]; float ss = 0.f;
#pragma unroll
                for (int j = 0; j < 4; ++j) { const v2u a = y0[64 * j], c = y1[64 * j]; f32x4 xv = xr[64 * j];
                    xv.x += g0 * __builtin_bit_cast(float, a.x << 16) + g1 * __builtin_bit_cast(float, c.x << 16);
                    xv.y += g0 * __builtin_bit_cast(float, a.x & 0xffff0000u) + g1 * __builtin_bit_cast(float, c.x & 0xffff0000u);
                    xv.z += g0 * __builtin_bit_cast(float, a.y << 16) + g1 * __builtin_bit_cast(float, c.y << 16);
                    xv.w += g0 * __builtin_bit_cast(float, a.y & 0xffff0000u) + g1 * __builtin_bit_cast(float, c.y & 0xffff0000u);
                    v[j] = xv; ss += (xv.x * xv.x + xv.y * xv.y) + (xv.z * xv.z + xv.w * xv.w); }
                const float rstd = 1.0f / sqrtf(wave_sum(ss) * (1.f / DM) + 1e-6f);
                const GAS f32x4* gr = (const GAS f32x4*)gn + lane;
                if (layer == 0) {
#pragma unroll
                    for (int j = 0; j < 4; ++j) xr[64 * j] = v[j];
#pragma unroll
                    for (int j = 0; j < 4; ++j) v[j] = v[j] * rstd * gr[64 * j];
                    store_row_bf16(HB + (size_t)m * DM, v, lane);
                } else {
#pragma unroll
                    for (int j = 0; j < 4; ++j) xr[64 * j] = v[j] * rstd * gr[64 * j];
                }
            }
        }
    }
}

__global__ void __launch_bounds__(NWAVES * 64, 2) mk_fwd(Args args) {
    extern __shared__ __attribute__((aligned(16))) unsigned char lds_raw[];
    LAS unsigned char* lds = (LAS unsigned char*)lds_raw;
    volatile LAS unsigned* LC = (volatile LAS unsigned*)(lds + LDSCTL_OFF);
    const int tid = threadIdx.x, lane = tid & 63, wave = __builtin_amdgcn_readfirstlane(tid >> 6);
    const int G = gridDim.x, bx = blockIdx.x;
    const int gw = bx * NWAVES + wave, NGW = G * NWAVES;
    unsigned char* ws = args.ws;
    unsigned* ctl = (unsigned*)(ws + WS_CTL);
    const float* x_in = args.in[0];
    float* xres = args.out;
    bf16* HB = (bf16*)(ws + WS_HB); bf16* Y = (bf16*)(ws + WS_Y);
    float* TBL = (float*)(ws + WS_TBL);

    for (int u = tid; u < (LDS_BYTES - LDSCTL_OFF) / 4; u += NWAVES * 64) LC[u] = 0u;
    __syncthreads();
    XcdBarrier bar; bar.bar = ctl + CW_BAR; bar.x = 0; bar.st = nullptr;
    if (MK_N_LAUNCHES == 1) bar = xcd_barrier_post(ctl + CW_BAR, LC + LC_BAR);
    const int lo = args.ph_lo, hi_ph = args.ph_hi;

    if (IN(0)) REP(0) {
        LAS float* scr = (LAS float*)(lds + wave * 16384);
        transpose_plain(args.in[4], DM, EV_IN, (bf16*)(ws + WS_WIN0), scr, gw, NGW, lane);
        transpose_plain(args.in[11], DM, DM, (bf16*)(ws + WS_WOUT0), scr, gw, NGW, lane);
        transpose_plain(args.in[12], DM, OD_IN, (bf16*)(ws + WS_WIN1), scr, gw, NGW, lane);
        transpose_plain(args.in[18], DM, DM, (bf16*)(ws + WS_WOUT1), scr, gw, NGW, lane);
        transpose_moe(args.in[24], args.in[25], args.in[26], (bf16*)(ws + WS_W13), (bf16*)(ws + WS_W2), scr, gw, NGW, lane);
        for (int i = bx * 512 + tid; i < 2048; i += G * 512) { const int pos = i >> 4, f = i & 15;
            const float inv = exp2f(-(float)f * (13.287712379549449f / 16.0f));
            const float ang = (float)pos * inv; const float rev = ang * 0.15915494309189535f; const float fr = rev - floorf(rev);
            TBL[TBL_COS + i] = __builtin_amdgcn_cosf(fr); TBL[TBL_SIN + i] = __builtin_amdgcn_sinf(fr); }
        for (int i = bx * 512 + tid; i < 8 * 257; i += G * 512) { const int h = i / 257, j = i % 257;
            TBL[TBL_BIAS + h * BIAS_STRIDE + j] = args.in[19][t5_bucket(j - 128) * 8 + h] * LOG2E; }
        for (int i = bx * 512 + tid; i < 2 * 1024 * 48; i += G * 512) { const int l = i / (1024 * 48), r = i % (1024 * 48), k = r / 48, c = r % 48;
            float w = 0.f; if (c < 4) w = args.in[20][(size_t)l * 4096 + k * 4 + c]; else if (c < 36) w = args.in[22][(size_t)l * 32768 + k * 32 + (c - 4)];
            TBL[TBL_WR + l * WR_LAYER + r] = w * args.in[2][l * DM + k]; }
        for (int i = bx * 512 + tid; i < 2 * 48; i += G * 512) { const int l = i / 48, c = i % 48;
            TBL[TBL_WR + l * WR_LAYER + 1024 * 48 + c] = c < 4 ? args.in[21][l * 4 + c] : (c < 36 ? args.in[23][l * 32 + (c - 4)] : 0.f); }
        for (int m = gw; m < NTOK; m += NGW) { f32x4 v[4]; rms_row(x_in + (size_t)m * DM, args.in[1], v, lane); store_row_bf16(HB + (size_t)m * DM, v, lane); }
    }
    SEAM(0);
    if (IN(1)) REP(1) {
        pg8::Gemm g{HB, (const bf16*)(ws + WS_WIN0), NTOK, EV_IN, DM}; pg8::StaticOrder S; S.init(NTOK, EV_IN, G, bx);
        pg8::EpiBf16 E{(bf16*)(ws + WS_Z0), EV_IN, 0, 0, 1.f, 0xffff};
        pg8::gemm_phase<pg8::EpiBf16, pg8::StaticOrder, true>(lds, g, S, E);
    }
    SEAM(1);
    if (IN(2)) REP(2) {
        const bf16* Z0 = (const bf16*)(ws + WS_Z0); bf16* QR = (bf16*)(ws + WS_QR); bf16* KR = (bf16*)(ws + WS_KR);
        const float gq = args.in[5][lane], gk = args.in[6][lane];
        const int fi = lane & 15; const bool first = (lane & 16) == 0, isrow = lane < 32;
        for (int m = gw; m < NTOK; m += NGW) {
            const int s = m & (SEQ - 1); const int pos = isrow ? (s >> 6) : (s & 63);
            const float cs = TBL[TBL_COS + pos * 16 + fi], sn = TBL[TBL_SIN + pos * 16 + fi];
#pragma unroll
            for (int h = 0; h < 10; ++h) {
                const float xv = bf2f(Z0[(size_t)m * EV_IN + h * 64 + lane]);
                const float ss = wave_sum(xv * xv);
                const float y = xv * (1.0f / sqrtf(ss * (1.f / 64.f) + 1e-6f)) * (h < 8 ? gq : gk);
                const float p = __shfl_xor(y, 16);
                float o = first ? (y * cs - p * sn) : (y * cs + p * sn);
                if (!QK_FP8 || ATTN_VER != 1) { if (h < 8) QR[(size_t)m * 512 + h * 64 + lane] = (bf16)f2bf(o * C2);
                else KR[(size_t)m * 128 + (h - 8) * 64 + lane] = (bf16)f2bf(o); }
                if (QK_FP8) { const unsigned w = quad_pack_bytes(fp8_byte(h < 8 ? o * (C2 * 8.0f) : o));
                    if ((lane & 3) == 0) { if (h < 8) *(unsigned*)(ws + WS_QR8 + (size_t)m * 512 + h * 64 + lane) = w; else *(unsigned*)(ws + WS_KR8 + (size_t)m * 128 + (h - 8) * 64 + lane) = w; } }
            }
        }
        LAS float* hbuf = (LAS float*)lds;
        for (int un = bx; un < NBATCH * 64 * 8; un += G) {
            const int grp = un & 7, tt = (un >> 3) & 63, b = un >> 9; const int t0 = tt * 128;
            __syncthreads();
            for (int idx = tid; idx < 158 * 8; idx += 512) { const int r = idx >> 3, c8 = idx & 7; const int s = t0 - 15 + r;
                f32x4 h0 = {0.f, 0.f, 0.f, 0.f}, h1 = h0;
                if (s >= 0 && s < SEQ) { const size_t ro = (size_t)(b * SEQ + s) * EV_IN + grp * 64 + c8 * 8;
                    const v4u av = *(const GAS v4u*)(Z0 + ro + 768), gv = *(const GAS v4u*)(Z0 + ro + 1280);
#pragma unroll
                    for (int j = 0; j < 4; ++j) { const float a0 = __builtin_bit_cast(float, av[j] << 16), a1 = __builtin_bit_cast(float, av[j] & 0xffff0000u);
                        const float g0 = __builtin_bit_cast(float, gv[j] << 16), g1 = __builtin_bit_cast(float, gv[j] & 0xffff0000u);
                        const float x0 = a0 * __builtin_amdgcn_rcpf(1.0f + __builtin_amdgcn_exp2f(-g0 * LOG2E)), x1 = a1 * __builtin_amdgcn_rcpf(1.0f + __builtin_amdgcn_exp2f(-g1 * LOG2E));
                        if (j < 2) { h0[2 * j] = x0; h0[2 * j + 1] = x1; } else { h1[2 * j - 4] = x0; h1[2 * j - 3] = x1; } } }
                *(LAS f32x4*)(hbuf + r * 64 + c8 * 8) = h0; *(LAS f32x4*)(hbuf + r * 64 + c8 * 8 + 4) = h1; }
            __syncthreads();
            const int ch = grp * 64 + lane;
            float wreg[31];
#pragma unroll
            for (int j = 0; j < 31; ++j) wreg[j] = args.in[7][j * 512 + ch];
            float acc[16]; const float cb = args.in[8][ch];
#pragma unroll
            for (int i = 0; i < 16; ++i) acc[i] = cb;
#pragma unroll
            for (int r = 0; r < 46; ++r) { const float hv = hbuf[(wave * 16 + r) * 64 + lane];
#pragma unroll
                for (int i = 0; i < 16; ++i) { const int j = r - i; if (j >= 0 && j < 31) acc[i] += wreg[j] * hv; } }
            const float gg = args.in[9][ch], gb = args.in[10][ch];
#pragma unroll
            for (int i = 0; i < 16; ++i) { const float mu = wave_sum(acc[i]) * (1.f / 64.f); const float d = acc[i] - mu; const float var = wave_sum(d * d) * (1.f / 64.f);
                const float hn = d * (1.0f / sqrtf(var + 1e-5f)) * gg + gb; const float ov = hn * __builtin_amdgcn_rcpf(1.0f + __builtin_amdgcn_exp2f(-hn * LOG2E));
                Y[(size_t)(b * SEQ + t0 + wave * 16 + i) * DM + 512 + ch] = (bf16)f2bf(ov); }
        }
    }
    SEAM(2);
    if (IN(3)) REP(3) {
        const bf16* QR = (const bf16*)(ws + WS_QR); const bf16* KR = (const bf16*)(ws + WS_KR); const bf16* Z0 = (const bf16*)(ws + WS_Z0);
        if (ATTN_L0_TEST) {
        for (int un = bx; un < NBATCH * 8 * 32; un += G) {
            const int qb = un & 31, h = (un >> 5) & 7, b = un >> 8, kvh = h >> 2;
            const size_t row0 = (size_t)b * SEQ + qb * 256;
            attn_unit_v0<64, false, true>((const bf16*)(ws + WS_QR8 + row0 * 512 + h * 64), 512, (const bf16*)(ws + WS_KR8 + (size_t)b * SEQ * 128 + kvh * 64), 128, Z0 + (size_t)b * SEQ * EV_IN + 640 + kvh * 64, EV_IN,
                                   Y + row0 * DM + h * 64, DM, nullptr, qb * 256, lds);
        }
        } else if (ATTN_VER == 0) {
        for (int un = bx; un < NBATCH * 8 * 32; un += G) {
            const int qb = un & 31, h = (un >> 5) & 7, b = un >> 8, kvh = h >> 2;
            const size_t row0 = (size_t)b * SEQ + qb * 256;
            attn_unit_v0<64, false>(QR + row0 * 512 + h * 64, 512, KR + (size_t)b * SEQ * 128 + kvh * 64, 128, Z0 + (size_t)b * SEQ * EV_IN + 640 + kvh * 64, EV_IN,
                                   Y + row0 * DM + h * 64, DM, nullptr, qb * 256, lds);
        }
        } else {
        constexpr int U = NBATCH * 8 * 32; const int upc = (U + G - 1) / G; const int vcu = (G % 8 == 0) ? (bx % 8) * (G / 8) + bx / 8 : bx;
        for (int i = 0; i < upc; ++i) { const int un = vcu * upc + i; if (un >= U) break;
            const int stream = un >> 7, b = stream >> 1, kvh = stream & 1, h = kvh * 4 + ((un >> 5) & 3), qb = un & 31;
            const size_t row0 = (size_t)b * SEQ + qb * 256;
            if (QK_FP8) at1::attn_unit<64, false, 0, 0, true>((const bf16*)(ws + WS_QR8 + row0 * 512 + h * 64), 512, (const bf16*)(ws + WS_KR8 + (size_t)b * SEQ * 128 + kvh * 64), 128, Z0 + (size_t)b * SEQ * EV_IN + 640 + kvh * 64, EV_IN,
                                      Y + row0 * DM + h * 64, DM, qb * 256, lds);
            else at1::attn_unit<64, false>(QR + row0 * 512 + h * 64, 512, KR + (size_t)b * SEQ * 128 + kvh * 64, 128, Z0 + (size_t)b * SEQ * EV_IN + 640 + kvh * 64, EV_IN,
                                      Y + row0 * DM + h * 64, DM, qb * 256, lds);
        }
        }
    }
    SEAM(3);
    if (IN(4)) REP(4) {
        pg8::Gemm g{Y, (const bf16*)(ws + WS_WOUT0), NTOK, DM, DM}; pg8::StaticOrder S; S.init(NTOK, DM, G, bx);
        pg8::EpiRes E{x_in, xres, DM};
        pg8::gemm_phase<pg8::EpiRes, pg8::StaticOrder, true>(lds, g, S, E);
    }
    SEAM(4);

    moe_block<0>(args, lds, bar, lo, hi_ph);
    SEAM(8);
            if (IN(9)) REP(9) {
                pg8::Gemm g{HB, (const bf16*)(ws + WS_WIN1), NTOK, OD_IN, DM}; pg8::StaticOrder S; S.init(NTOK, OD_IN, G, bx);
                if (QK_FP8) { pg8::EpiQKV8 E{ws + WS_Q1, ws + WS_K1, (bf16*)(ws + WS_V1), C2 * 8.0f};
                    pg8::gemm_phase<pg8::EpiQKV8, pg8::StaticOrder, true>(lds, g, S, E); }
                else { pg8::EpiBf16 E{(bf16*)(ws + WS_Q1), DM, DM, (size_t)(WS_K1 - WS_Q1) / 2, C2, 0xffff};
                pg8::gemm_phase<pg8::EpiBf16, pg8::StaticOrder, true>(lds, g, S, E); }
            }
            SEAM(9);
            if (IN(10)) REP(10) {
                const bf16* Q1 = (const bf16*)(ws + WS_Q1); const bf16* K1 = (const bf16*)(ws + WS_K1); const bf16* V1 = (const bf16*)(ws + WS_V1);
                if (ATTN_VER == 0) {
                LAS float* btbl = (LAS float*)(lds + 65536);
                for (int un = bx; un < NBATCH * 8 * 2 * 32; un += G) {
                    const int qb = un & 31, c = (un >> 5) & 1, h = (un >> 6) & 7, b = un >> 9;
                    __syncthreads();
                    if (tid < 257) btbl[tid] = TBL[TBL_BIAS + h * BIAS_STRIDE + tid];
                    __syncthreads();
                    const size_t row0 = (size_t)b * SEQ + qb * 256, brow = (size_t)b * SEQ;
                    bf16* OC = (bf16*)(ws + (c ? WS_OC1 : WS_OC0));
                    attn_unit_v0<128, true>(Q1 + row0 * DM + h * 128 + c * 64, DM, K1 + brow * DM + h * 128 + c * 64, DM, V1 + brow * DM + h * 128, DM,
                                           OC + row0 * DM + h * 128, DM, btbl, qb * 256, lds);
                }
                } else {
                constexpr int UP = NBATCH * 8 * 32; const int upc = (UP + G - 1) / G; const int vcu = (G % 8 == 0) ? (bx % 8) * (G / 8) + bx / 8 : bx;
                LAS float* btbl = (LAS float*)(lds + at1::lds_tbl_off<128, QK_FP8 != 0>());
                LAS float* sgt = btbl + 272;
                __syncthreads();
                if (tid < 128) sgt[tid] = args.in[17][tid] * (1.0f - LAM_INIT);
                if (wave == 7) { const float lam = __expf(wave_sum(args.in[13][lane] * args.in[14][lane])) - __expf(wave_sum(args.in[15][lane] * args.in[16][lane])) + LAM_INIT; if (lane == 0) sgt[128] = lam; }
                for (int i = 0; i < upc; ++i) {
                    int up = vcu * upc + i; if (up >= UP) break;
                    if (G == 256) up = ((vcu >> 5) * 4 + i) * 32 + (vcu & 31);
                    const int qb = up & 31, h = (up >> 5) & 7, b = up >> 8;
                    __syncthreads();
                    if (tid < 257) btbl[tid] = TBL[TBL_BIAS + h * BIAS_STRIDE + tid] - TBL[TBL_BIAS + h * BIAS_STRIDE + 256];
                    __syncthreads();
                    const size_t row0 = (size_t)b * SEQ + qb * 256, brow = (size_t)b * SEQ;
                    if (QK_FP8) { const unsigned char* Q8 = ws + WS_Q1; const unsigned char* K8 = ws + WS_K1;
                    at1::attn_unit<128, true, 0, 1, true>((const bf16*)(Q8 + row0 * DM + h * 128), DM, (const bf16*)(K8 + brow * DM + h * 128), DM, V1 + brow * DM + h * 128, DM, nullptr, DM, qb * 256, lds, sgt);
                    at1::attn_unit<128, true, 0, 2, true>((const bf16*)(Q8 + row0 * DM + h * 128 + 64), DM, (const bf16*)(K8 + brow * DM + h * 128 + 64), DM, V1 + brow * DM + h * 128, DM, Y + row0 * DM + h * 128, DM, qb * 256, lds, sgt);
                    } else {
                    at1::attn_unit<128, true, 0, 1>(Q1 + row0 * DM + h * 128, DM, K1 + brow * DM + h * 128, DM, V1 + brow * DM + h * 128, DM, nullptr, DM, qb * 256, lds, sgt);
                    at1::attn_unit<128, true, 0, 2>(Q1 + row0 * DM + h * 128 + 64, DM, K1 + brow * DM + h * 128 + 64, DM, V1 + brow * DM + h * 128, DM, Y + row0 * DM + h * 128, DM, qb * 256, lds, sgt);
                    }
                }
                }
            }
            SEAM(10);
            if (PROBE_ATT >= 0 && IN(10)) {
                const bf16* Q1 = (const bf16*)(ws + WS_Q1); const bf16* K1 = (const bf16*)(ws + WS_K1); const bf16* V1 = (const bf16*)(ws + WS_V1);
                constexpr int U = NBATCH * 8 * 2 * 32; const int upc = (U + G - 1) / G; const int vcu = (G % 8 == 0) ? (bx % 8) * (G / 8) + bx / 8 : bx;
                LAS float* btbl = (LAS float*)(lds + 3 * 8192 + 3 * 16384 + 2048);
                for (int i = 0; i < upc; ++i) {
                    int un = vcu * upc + i; if (un >= U) break;
                    if (G == 256) un = ((vcu >> 5) * 4 + (i >> 1)) * 64 + (i & 1) * 32 + (vcu & 31);
                    const int qb = un & 31, c = (un >> 5) & 1, h = (un >> 6) & 7, b = un >> 9;
                    if (tid < 257) btbl[tid] = TBL[TBL_BIAS + h * BIAS_STRIDE + tid] - TBL[TBL_BIAS + h * BIAS_STRIDE + 256];
                    __syncthreads();
                    const size_t row0 = (size_t)b * SEQ + qb * 256, brow = (size_t)b * SEQ;
                    at1::attn_unit<128, true, (PROBE_ATT >= 0 ? PROBE_ATT : 0)>(Q1 + row0 * DM + h * 128 + c * 64, DM, K1 + brow * DM + h * 128 + c * 64, DM, V1 + brow * DM + h * 128, DM,
                                              (bf16*)(ws + WS_OC1) + row0 * DM + h * 128, DM, qb * 256, lds);
                }
                xcd_barrier(bar);
            }
            if (IN(11) && ATTN_VER != 1) REP(11) {
                const bf16* OC0 = (const bf16*)(ws + WS_OC0); const bf16* OC1 = (const bf16*)(ws + WS_OC1);
                const float lam = __expf(wave_sum(args.in[13][lane] * args.in[14][lane])) - __expf(wave_sum(args.in[15][lane] * args.in[16][lane])) + LAM_INIT;
                float sg[16];
#pragma unroll
                for (int j = 0; j < 16; ++j) sg[j] = args.in[17][(lane & 7) * 16 + j] * (1.0f - LAM_INIT);
                for (int m = gw; m < NTOK; m += NGW) {
                    const GAS v4u* a = (const GAS v4u*)(OC0 + (size_t)m * DM) + lane * 2; const GAS v4u* c = (const GAS v4u*)(OC1 + (size_t)m * DM) + lane * 2;
                    float o[16]; float ss = 0.f;
#pragma unroll
                    for (int q = 0; q < 2; ++q) { const v4u av = a[q], cv = c[q];
#pragma unroll
                        for (int j = 0; j < 4; ++j) { const unsigned au = av[j], cu = cv[j];
                            const float lo = __builtin_bit_cast(float, au << 16) - lam * __builtin_bit_cast(float, cu << 16);
                            const float hh = __builtin_bit_cast(float, au & 0xffff0000u) - lam * __builtin_bit_cast(float, cu & 0xffff0000u);
                            o[q * 8 + 2 * j] = lo; o[q * 8 + 2 * j + 1] = hh; ss += lo * lo + hh * hh; } }
                    ss += __shfl_xor(ss, 1); ss += __shfl_xor(ss, 2); ss += __shfl_xor(ss, 4);
                    const float rstd = 1.0f / sqrtf(ss * (1.f / 128.f) + 1e-5f);
                    v4u w0, w1;
                    w0.x = pk2(o[0] * rstd * sg[0], o[1] * rstd * sg[1]); w0.y = pk2(o[2] * rstd * sg[2], o[3] * rstd * sg[3]); w0.z = pk2(o[4] * rstd * sg[4], o[5] * rstd * sg[5]); w0.w = pk2(o[6] * rstd * sg[6], o[7] * rstd * sg[7]);
                    w1.x = pk2(o[8] * rstd * sg[8], o[9] * rstd * sg[9]); w1.y = pk2(o[10] * rstd * sg[10], o[11] * rstd * sg[11]); w1.z = pk2(o[12] * rstd * sg[12], o[13] * rstd * sg[13]); w1.w = pk2(o[14] * rstd * sg[14], o[15] * rstd * sg[15]);
                    GAS v4u* yo = (GAS v4u*)(Y + (size_t)m * DM) + lane * 2; yo[0] = w0; yo[1] = w1;
                }
            }
            if (ATTN_VER != 1) SEAM(11);
            if (IN(12)) {
                pg8::Gemm g{Y, (const bf16*)(ws + WS_WOUT1), NTOK, DM, DM}; pg8::StaticOrder S; S.init(NTOK, DM, G, bx);
                pg8::EpiRes E{xres, xres, DM};
                pg8::gemm_phase<pg8::EpiRes, pg8::StaticOrder, true>(lds, g, S, E);
            }
            SEAM(12);
    moe_block<1>(args, lds, bar, lo, hi_ph);
#undef IN
#undef SEAM
}

extern "C" void kernel_launch(void* const* d_in, const int* in_sizes, int n_in, void* d_out, int out_size, void* d_ws, size_t ws_size, hipStream_t stream) {
    static int grid = 0;
    if (grid == 0) {
        if (n_in != 27 || in_sizes[0] != NTOK * DM || out_size != NTOK * DM || ws_size < WS_END) { fprintf(stderr, "kernel_launch: unexpected shapes / workspace (n_in %d, ws %zu)\n", n_in, ws_size); grid = -1; return; }
        int dev = 0, cus = 0, per_cu = 0;
        if (hipGetDevice(&dev) != hipSuccess || hipDeviceGetAttribute(&cus, hipDeviceAttributeMultiprocessorCount, dev) != hipSuccess) { grid = -1; return; }
        if (hipFuncSetAttribute((const void*)mk_fwd, hipFuncAttributeMaxDynamicSharedMemorySize, LDS_BYTES) != hipSuccess) { fprintf(stderr, "kernel_launch: hipFuncSetAttribute failed\n"); grid = -1; return; }
        if (hipOccupancyMaxActiveBlocksPerMultiprocessor(&per_cu, (const void*)mk_fwd, NWAVES * 64, LDS_BYTES) != hipSuccess || per_cu < 1) { fprintf(stderr, "kernel_launch: occupancy query says %d\n", per_cu); }
        (void)hipGetLastError();
        grid = cus;
    }
    if (grid < 0) return;
    if (hipMemsetAsync((char*)d_ws + WS_CTL, 0, CTL_ZERO_BYTES, stream) != hipSuccess) return;
    Args a{};
    for (int i = 0; i < 27; ++i) a.in[i] = (const float*)d_in[i];
    a.out = (float*)d_out; a.ws = (unsigned char*)d_ws;
    if (MK_N_LAUNCHES == 1) { a.ph_lo = 0; a.ph_hi = NPHASE; a.li = 0; hipLaunchKernelGGL(mk_fwd, dim3(grid), dim3(NWAVES * 64), LDS_BYTES, stream, a); }
    else { for (int p = 0; p < NPHASE; ++p) for (int r = 0; r < (int)((PROBE_MASK >> p) & 1u) + 1; ++r) { a.ph_lo = p; a.ph_hi = p + 1; a.li = p; hipLaunchKernelGGL(mk_fwd, dim3(grid), dim3(NWAVES * 64), LDS_BYTES, stream, a); } }
}
```

```cpp
#include <hip/hip_runtime.h>
#include <cstdio>
#include <cstdint>

#ifndef MK_N_LAUNCHES
#define MK_N_LAUNCHES 1
#endif

#ifndef ATTN_VER
#define ATTN_VER 3
#endif
#ifndef PROBE_ATT
#define PROBE_ATT -1
#endif
#ifndef QK_FP8
#define QK_FP8 1
#endif
#ifndef ATTN_L0_TEST
#define ATTN_L0_TEST 0
#endif
#ifndef ATTN_L1_VER
#define ATTN_L1_VER 1
#endif
#ifndef PROBE_MASK
#define PROBE_MASK 0u
#endif
#define REP(k) _Pragma("unroll") for (int rep_ = 0; rep_ < (MK_N_LAUNCHES == 1 ? (int)((PROBE_MASK >> (k)) & 1u) : 0) + 1; ++rep_)
#define GAS __attribute__((address_space(1)))
#define LAS __attribute__((address_space(3)))
typedef unsigned short bf16;
typedef unsigned v4u __attribute__((ext_vector_type(4)));
typedef unsigned v2u __attribute__((ext_vector_type(2)));
typedef float f32x4 __attribute__((ext_vector_type(4)));
typedef float f32x16 __attribute__((ext_vector_type(16)));
typedef short bf16x8 __attribute__((ext_vector_type(8)));
typedef short s16x4 __attribute__((ext_vector_type(4)));

constexpr int NTOK = 32768, DM = 1024, SEQ = 8192, NBATCH = 4;
constexpr int EV_IN = 1792, OD_IN = 3072;
constexpr int NEXP = 32, MOE_H = 512, LIST_CAP = 32768;
constexpr float C2 = 0.125f * 1.4426950408889634f;
constexpr float LOG2E = 1.4426950408889634f;
constexpr float LAM_INIT = 0.35550906759f;

constexpr size_t MiB = 1u << 20;
constexpr size_t WS_CTL = 0, CTL_ZERO_BYTES = 1 * MiB;
constexpr size_t WS_WIN0 = 1 * MiB, WS_WOUT0 = 5 * MiB, WS_WIN1 = 7 * MiB, WS_WOUT1 = 13 * MiB, WS_TBL = 15 * MiB;
constexpr size_t WS_W13 = 16 * MiB, WS_W2 = 80 * MiB;
constexpr size_t WS_HB = 112 * MiB;
constexpr size_t WS_Y = 176 * MiB;
constexpr size_t WS_Z0 = 240 * MiB, WS_QR = 352 * MiB, WS_KR = 384 * MiB, WS_QR8 = 392 * MiB, WS_KR8 = 408 * MiB, WS_K8T0 = 408 * MiB, WS_V8T0 = 412 * MiB;
constexpr size_t WS_K8T1 = 304 * MiB, WS_V8T1 = 336 * MiB;
constexpr size_t WS_Q1 = 240 * MiB, WS_K1 = 304 * MiB, WS_V1 = 368 * MiB, WS_OC1 = 432 * MiB, WS_OC0 = WS_HB;
constexpr size_t WS_H = 176 * MiB, WS_YS = 248 * MiB, WS_LIST = 392 * MiB, WS_TOKEP = 396 * MiB, WS_GATE = 396 * MiB + 512 * 1024;
constexpr size_t WS_END = 496 * MiB;
constexpr int TBL_COS = 0, TBL_SIN = 2048, TBL_BIAS = 4096, BIAS_STRIDE = 272;
constexpr int TBL_WR = 32768, WR_LAYER = 1024 * 48 + 64;
constexpr int CW_BAR = 4096;
constexpr int CW_CNT = 16384;

constexpr int RING_BYTES = 131072;
constexpr int LDS_BYTES = 147456;
constexpr int LDSCTL_OFF = LDS_BYTES - 1024;
constexpr int STASH_OFF = 78 * 1024;
constexpr int LC_BAR = 8;
constexpr int LC_TP = 16;
constexpr int LC_CNT = 64;
constexpr int LC_LCNT = 96;
constexpr int LC_LBASE = 128;
constexpr int LC_LP = 160;

#define LDS_WAIT() asm volatile("s_waitcnt lgkmcnt(0)" ::: "memory")
#define VM_WAIT() asm volatile("s_waitcnt vmcnt(0)" ::: "memory")
#define RLX_AGENT __ATOMIC_RELAXED, __HIP_MEMORY_SCOPE_AGENT

__device__ __forceinline__ unsigned f2bf(float f) { unsigned u = __builtin_bit_cast(unsigned, f); return (u + 0x7fffu + ((u >> 16) & 1u)) >> 16; }
__device__ __forceinline__ unsigned pk2(float lo, float hi) { return f2bf(lo) | (f2bf(hi) << 16); }
__device__ __forceinline__ float bf2f(unsigned short b) { return __builtin_bit_cast(float, (unsigned)b << 16); }
template <int CTRL> __device__ __forceinline__ float dpp_mov(float v) { return __builtin_bit_cast(float, __builtin_amdgcn_update_dpp(0, __builtin_bit_cast(int, v), CTRL, 0xf, 0xf, true)); }
__device__ __forceinline__ float wave_sum(float v) {
    v += dpp_mov<0xB1>(v); v += dpp_mov<0x4E>(v); v += dpp_mov<0x141>(v); v += dpp_mov<0x140>(v);
    { auto rr = __builtin_amdgcn_permlane16_swap(__float_as_uint(v), __float_as_uint(v), false, false); v = __uint_as_float(rr[0]) + __uint_as_float(rr[1]); }
    { auto rr = __builtin_amdgcn_permlane32_swap(__float_as_uint(v), __float_as_uint(v), false, false); v = __uint_as_float(rr[0]) + __uint_as_float(rr[1]); }
    return v;
}


typedef int v8i __attribute__((ext_vector_type(8)));
__device__ __forceinline__ unsigned fp8_byte(float v) { return (unsigned)__builtin_amdgcn_cvt_pk_fp8_f32(v, v, 0, false) & 0xffu; }
__device__ __forceinline__ unsigned quad_pack_bytes(unsigned b) {
    const unsigned x0 = (unsigned)__builtin_amdgcn_update_dpp(0, (int)b, 0x00, 0xf, 0xf, true), x1 = (unsigned)__builtin_amdgcn_update_dpp(0, (int)b, 0x55, 0xf, 0xf, true);
    const unsigned x2 = (unsigned)__builtin_amdgcn_update_dpp(0, (int)b, 0xAA, 0xf, 0xf, true), x3 = (unsigned)__builtin_amdgcn_update_dpp(0, (int)b, 0xFF, 0xf, 0xf, true);
    return x0 | (x1 << 8) | (x2 << 16) | (x3 << 24);
}
namespace pg8 {
#define PG8_LAS __attribute__((address_space(3)))
typedef unsigned short bf16_t;
typedef short bf16x8 __attribute__((ext_vector_type(8)));
typedef float f32x4 __attribute__((ext_vector_type(4)));
typedef unsigned u32x4 __attribute__((ext_vector_type(4)));
constexpr int BM = 256, BK = 64, HALF = 128, HTB = HALF * BK * 2, STAGE_BYTES = 8 * HTB, NXCD = 8, WGM = 8;

__host__ __device__ __forceinline__ int lds_byte(int r, int c) { const int st = (r >> 4) * 2 + (c >> 5), rr = r & 15, cc = c & 31, ob = rr * 64 + cc * 2; return st * 1024 + (ob ^ (((ob >> 9) & 1) << 5)); }
__host__ __device__ __forceinline__ void stage_rc(int b, int& R, int& C) { const int st = b / 1024, sb = b % 1024, swz = sb ^ (((sb >> 9) & 1) << 5); R = (st >> 1) * 16 + swz / 64; C = (st & 1) * 32 + (swz % 64) / 2; }
__host__ __device__ __forceinline__ int perm32(int rho) { const int n = rho >> 4, i = rho & 15; return 8 * (i >> 2) + 4 * n + (i & 3); }

struct Unit { int pm, pn, e, rb; };
struct Gemm { const bf16_t* A; const bf16_t* Bt; int M, N, K; };

struct StaticOrder {
    int nM, nN, nwg, G, c;
    __device__ void init(int M, int N, int G_, int c_) { nM = M / BM; nN = N / BM; nwg = nM * nN; G = G_; c = c_; }
    __device__ bool next(int i, Unit& u) const {
        const long L = (long)i * G + c; if (L >= nwg) return false;
        int wgid = (int)L; { const int q = nwg / NXCD, r = nwg % NXCD, xcd = wgid % NXCD, off = wgid / NXCD; wgid = (xcd < r ? xcd * (q + 1) : r * (q + 1) + (xcd - r) * q) + off; }
        const int nig = WGM * nN, gid = wgid / nig, fm = gid * WGM, gsz = (nM - fm) < WGM ? (nM - fm) : WGM;
        u.pm = fm + ((wgid % nig) % gsz); u.pn = (wgid % nig) / gsz; u.e = 0; u.rb = 0; return true;
    }
    __device__ __forceinline__ unsigned arow(const Unit& u, int rr) const { return (unsigned)(u.pm * BM + rr); }
};

struct MoeOrder {
    const PG8_LAS int* tp; const PG8_LAS int* cn; const PG8_LAS int* lp; const int* list; int G, c, nunits; bool gather; bool xcd;
    __device__ __forceinline__ bool next(int i, Unit& u) const {
        int e_, rb_, pm_, pnl_; bool ok;
        if (xcd) {
            const int x = c & 7, y = c >> 3; const int uidx = i * 32 + y; ok = uidx < lp[4] * 4;
            const int rbl = uidx >> 2; pnl_ = uidx & 3; int j = 0;
#pragma unroll
            for (int q = 1; q < 4; ++q) j += (lp[q] <= rbl) ? 1 : 0;
            e_ = x + 8 * j; rb_ = rbl - lp[j]; pm_ = tp[e_] + rb_;
        } else {
            const int L = i * G + c; ok = L < nunits;
            const int rbg = L >> 2; pnl_ = L & 3; int e = 0;
#pragma unroll
            for (int j = 1; j < 32; ++j) e += (tp[j] <= rbg) ? 1 : 0;
            e_ = e; pm_ = rbg; rb_ = rbg - tp[e];
        }
        u.e = __builtin_amdgcn_readfirstlane(e_); u.rb = __builtin_amdgcn_readfirstlane(rb_); u.pm = __builtin_amdgcn_readfirstlane(pm_); u.pn = __builtin_amdgcn_readfirstlane(e_ * 4 + pnl_);
        return ok;
    }
    __device__ __forceinline__ unsigned arow(const Unit& u, int rr) const {
        if (!gather) return (unsigned)(u.pm * BM + rr);
        const int idx = u.rb * BM + rr; unsigned t = 0u;
        if (idx < cn[u.e]) t = (unsigned)list[(size_t)u.e * 32768 + idx];
        return t;
    }
};

__device__ __forceinline__ unsigned cvt_pk_bf16(float lo, float hi) { unsigned r; asm volatile("v_cvt_pk_bf16_f32 %0, %1, %2" : "=v"(r) : "v"(lo), "v"(hi)); return r; }

struct EpiBf16 {
    static constexpr bool PERM = true;
    bf16_t* O; int ldc; int split_cols; size_t split_stride; float scale0; int pn_mask;
    __device__ __forceinline__ void operator()(const f32x4 (&acc)[2][2][4][2], const Unit& u, int wr, int wc, int fr, int fq) const {
        const int row0 = u.pm * BM + wr * 64 + fr; int colt = (u.pn & pn_mask) * BM; bf16_t* base = O;
        float sc = 1.f; if (split_cols) { const int t = colt / split_cols; base += (size_t)t * split_stride; colt -= t * split_cols; if (t == 0) sc = scale0; }
        const int col0 = colt + wc * 32 + 8 * fq;
#pragma unroll
        for (int ai = 0; ai < 2; ++ai)
#pragma unroll
            for (int m = 0; m < 4; ++m) { bf16_t* rowp = base + (size_t)(row0 + ai * HALF + m * 16) * ldc + col0;
#pragma unroll
                for (int bj = 0; bj < 2; ++bj) { f32x4 v0 = acc[ai][bj][m][0] * sc, v1 = acc[ai][bj][m][1] * sc;
                    u32x4 w; w.x = cvt_pk_bf16(v0[0], v0[1]); w.y = cvt_pk_bf16(v0[2], v0[3]); w.z = cvt_pk_bf16(v1[0], v1[1]); w.w = cvt_pk_bf16(v1[2], v1[3]);
                    *(u32x4*)(rowp + bj * HALF) = w; } }
    }
};
struct EpiRes {
    static constexpr bool PERM = false;
    const float* base; float* out; int ldc;
    __device__ __forceinline__ void operator()(const f32x4 (&acc)[2][2][4][2], const Unit& u, int wr, int wc, int fr, int fq) const {
        const int row0 = u.pm * BM + wr * 64 + fr, col0 = u.pn * BM + wc * 32 + 4 * fq;
#pragma unroll
        for (int ai = 0; ai < 2; ++ai)
#pragma unroll
            for (int m = 0; m < 4; ++m) { const size_t off = (size_t)(row0 + ai * HALF + m * 16) * ldc + col0;
#pragma unroll
                for (int bj = 0; bj < 2; ++bj)
#pragma unroll
                    for (int n = 0; n < 2; ++n) { const f32x4 bs = *(const f32x4*)(base + off + bj * HALF + n * 16); *(f32x4*)(out + off + bj * HALF + n * 16) = bs + acc[ai][bj][m][n]; } }
    }
};
struct EpiQKV8 {
    static constexpr bool PERM = true;
    unsigned char* Q8; unsigned char* K8; bf16_t* V; float qscale; bool ktiled;
    __device__ __forceinline__ void operator()(const f32x4 (&acc)[2][2][4][2], const Unit& u, int wr, int wc, int fr, int fq) const {
        const int row0 = u.pm * BM + wr * 64 + fr; const int colt = u.pn * BM; const int t = colt >> 10; const int col0 = (colt & 1023) + wc * 32 + 8 * fq;
        const float sc = t == 0 ? qscale : 1.0f;
#pragma unroll
        for (int ai = 0; ai < 2; ++ai)
#pragma unroll
            for (int m = 0; m < 4; ++m) { const size_t ro = (size_t)(row0 + ai * HALF + m * 16) * 1024 + col0;
#pragma unroll
                for (int bj = 0; bj < 2; ++bj) { const f32x4 v0 = acc[ai][bj][m][0] * sc, v1 = acc[ai][bj][m][1] * sc;
                    if (t == 2) { u32x4 w; w.x = cvt_pk_bf16(v0[0], v0[1]); w.y = cvt_pk_bf16(v0[2], v0[3]); w.z = cvt_pk_bf16(v1[0], v1[1]); w.w = cvt_pk_bf16(v1[2], v1[3]);
                        if (ktiled) { const int mrow = row0 + ai * HALF + m * 16, n = col0 + bj * HALF; const int bh = (mrow >> 13) * 8 + (n >> 7), sq = mrow & 8191, d = n & 127;
                            *(u32x4*)(V + (((size_t)bh * 128 + (sq >> 6)) * 4 + (d >> 5)) * 2048 + (sq & 63) * 32 + (d & 31)) = w; }
                        else *(u32x4*)(V + ro + bj * HALF) = w; }
                    else { int d0 = __builtin_amdgcn_cvt_pk_fp8_f32(v0[0], v0[1], 0, false); d0 = __builtin_amdgcn_cvt_pk_fp8_f32(v0[2], v0[3], d0, true);
                        int d1 = __builtin_amdgcn_cvt_pk_fp8_f32(v1[0], v1[1], 0, false); d1 = __builtin_amdgcn_cvt_pk_fp8_f32(v1[2], v1[3], d1, true);
                        typedef int i32x2 __attribute__((ext_vector_type(2)));
                        if (t == 1 && ktiled) { const int mrow = row0 + ai * HALF + m * 16, n = col0 + bj * HALF; const int strm = ((mrow >> 13) * 8 + (n >> 7)) * 2 + ((n >> 6) & 1), sq = mrow & 8191, dd = n & 63;
                            *(i32x2*)(K8 + ((((size_t)strm * 128 + (sq >> 6)) * 4 + (dd >> 4)) * 64 + (sq & 63)) * 16 + (dd & 15)) = (i32x2){d0, d1}; }
                        else *(i32x2*)((t == 0 ? Q8 : K8) + ro + bj * HALF) = (i32x2){d0, d1}; } } }
    }
};
__device__ __forceinline__ float silu_mul(float a, float b) { return a * b * __builtin_amdgcn_rcpf(1.0f + __builtin_amdgcn_exp2f(-a * 1.4426950408889634f)); }
struct EpiSwiglu {
    static constexpr bool PERM = true;
    bf16_t* O;
    __device__ __forceinline__ void operator()(const f32x4 (&acc)[2][2][4][2], const Unit& u, int wr, int wc, int fr, int fq) const {
        const int row0 = u.pm * BM + wr * 64 + fr, col0 = (u.pn & 3) * 128 + wc * 32 + 8 * fq;
#pragma unroll
        for (int ai = 0; ai < 2; ++ai)
#pragma unroll
            for (int m = 0; m < 4; ++m) { bf16_t* rowp = O + (size_t)(row0 + ai * HALF + m * 16) * 512 + col0;
                const f32x4 a0 = acc[ai][0][m][0], a1 = acc[ai][0][m][1], b0 = acc[ai][1][m][0], b1 = acc[ai][1][m][1];
                u32x4 w; w.x = cvt_pk_bf16(silu_mul(a0[0], b0[0]), silu_mul(a0[1], b0[1])); w.y = cvt_pk_bf16(silu_mul(a0[2], b0[2]), silu_mul(a0[3], b0[3]));
                w.z = cvt_pk_bf16(silu_mul(a1[0], b1[0]), silu_mul(a1[1], b1[1])); w.w = cvt_pk_bf16(silu_mul(a1[2], b1[2]), silu_mul(a1[3], b1[3]));
                *(u32x4*)rowp = w; }
    }
};

template <class Epi, class Sched, bool ALIGN_EPI>
__device__ __forceinline__ void gemm_phase(PG8_LAS unsigned char* lds, const Gemm g, const Sched& S, const Epi& E) {
    const int tid = threadIdx.x, wid = __builtin_amdgcn_readfirstlane(tid >> 6), lane = tid & 63, wr = wid >> 2, wc = wid & 3, fr = lane & 15, fq = lane >> 4;
    const int K = g.K, nt = K / BK;
    int RA[2], CA[2]; unsigned voffB[2];
#pragma unroll
    for (int i = 0; i < 2; ++i) { int R, C; stage_rc(tid * 16 + i * 8192, R, C); RA[i] = R; CA[i] = C; const int Rb = Epi::PERM ? ((R & ~31) + perm32(R & 31)) : R; voffB[i] = (unsigned)(Rb * K + C) * 2u; }
    const size_t kstep = (size_t)(BK * 2);
    const size_t hstep = (size_t)HALF * K * 2;
    const size_t tstep = 2 * hstep;
    const unsigned ldsw = (unsigned)wid * 1024u;
    const int aoff = lds_byte(wr * 64 + fr, fq * 8), boff = lds_byte(wc * 32 + fr, fq * 8);
#define PG8_SA(b, h) (((b) * 2 + (h)) * HTB)
#define PG8_SB(b, h) ((4 + (b) * 2 + (h)) * HTB)
#define PG8_STAGE(bufoff, gbase, voff) do { _Pragma("unroll") for (int _i = 0; _i < 2; ++_i) \
        __builtin_amdgcn_global_load_lds((const unsigned*)((const char*)(gbase) + (voff)[_i]), (PG8_LAS unsigned*)(lds + (bufoff) + ldsw + _i * 8192), 16, 0, 0); } while (0)
#define PG8_LDA(dst, b, h) do { _Pragma("unroll") for (int m = 0; m < 4; ++m) _Pragma("unroll") for (int k = 0; k < 2; ++k) dst[m][k] = *(const PG8_LAS bf16x8*)(lds + PG8_SA(b, h) + aoff + m * 2048 + k * 1024); } while (0)
#define PG8_LDB(dst, b, h) do { _Pragma("unroll") for (int n = 0; n < 2; ++n) _Pragma("unroll") for (int k = 0; k < 2; ++k) dst[n][k] = *(const PG8_LAS bf16x8*)(lds + PG8_SB(b, h) + boff + n * 2048 + k * 1024); } while (0)
#define PG8_MMA(ai, bj, At, Bt) do { __builtin_amdgcn_s_setprio(1); _Pragma("unroll") for (int m = 0; m < 4; ++m) _Pragma("unroll") for (int n = 0; n < 2; ++n) _Pragma("unroll") for (int k = 0; k < 2; ++k) \
        acc[ai][bj][m][n] = __builtin_amdgcn_mfma_f32_16x16x32_bf16(Bt[n][k], At[m][k], acc[ai][bj][m][n], 0, 0, 0); __builtin_amdgcn_s_setprio(0); } while (0)
#define PG8_WAIT_V(n) asm volatile("s_waitcnt vmcnt(" #n ")" ::: "memory")
#define PG8_WAIT_L(n) asm volatile("s_waitcnt lgkmcnt(" #n ")" ::: "memory")
#define PG8_BAR __builtin_amdgcn_s_barrier()
#define PG8_SCHED __builtin_amdgcn_sched_barrier(0)
#define PG8_AOFF(dst, u) do { _Pragma("unroll") for (int _h = 0; _h < 2; ++_h) _Pragma("unroll") for (int _i = 0; _i < 2; ++_i) dst[_h][_i] = (S.arow(u, _h * HALF + RA[_i]) * (unsigned)K + (unsigned)CA[_i]) * 2u; } while (0)
    Unit cur, nxt; int ui = 0;
    if (!S.next(0, cur)) return;
    f32x4 acc[2][2][4][2];
#pragma unroll
    for (int a = 0; a < 2; ++a)
#pragma unroll
        for (int b = 0; b < 2; ++b)
#pragma unroll
            for (int m = 0; m < 4; ++m)
#pragma unroll
                for (int n = 0; n < 2; ++n) acc[a][b][m][n] = (f32x4){0.f, 0.f, 0.f, 0.f};
    bf16x8 At[4][2], B0[2][2], B1[2][2];
    unsigned offc[2][2], offn[2][2];
    PG8_AOFF(offc, cur);
    const char* const cA = (const char*)g.A; const char* cB = (const char*)g.Bt + (size_t)cur.pn * tstep;
    PG8_STAGE(PG8_SB(0, 0), cB, voffB); PG8_STAGE(PG8_SB(0, 1), cB + hstep, voffB); PG8_STAGE(PG8_SA(0, 0), cA, offc[0]); PG8_STAGE(PG8_SA(0, 1), cA, offc[1]);
    if (wr == 1) PG8_BAR;
    PG8_WAIT_V(2); PG8_BAR;
    PG8_STAGE(PG8_SB(1, 0), cB + kstep, voffB); PG8_STAGE(PG8_SA(1, 0), cA + kstep, offc[0]); PG8_STAGE(PG8_SB(1, 1), cB + hstep + kstep, voffB);
    PG8_WAIT_V(6); PG8_BAR;
    for (;;) {
        const bool has_next = S.next(ui + 1, nxt);
        if (has_next) { PG8_AOFF(offn, nxt); }
        else {
#pragma unroll
            for (int h = 0; h < 2; ++h)
#pragma unroll
                for (int i = 0; i < 2; ++i) offn[h][i] = offc[h][i]; }
        const char* nB = has_next ? (const char*)g.Bt + (size_t)nxt.pn * tstep : cB;
        for (int t = 0; t < nt; t += 2) {
            const bool last = (t == nt - 2);
            const char* a1 = cA + (size_t)(t + 1) * kstep;
            const char* a2 = last ? cA : cA + (size_t)(t + 2) * kstep; const char* b2 = last ? nB : cB + (size_t)(t + 2) * kstep;
            const char* a3 = a2 + kstep; const char* b3 = b2 + kstep;
            unsigned o2[2][2];
#pragma unroll
            for (int h = 0; h < 2; ++h)
#pragma unroll
                for (int i = 0; i < 2; ++i) o2[h][i] = last ? offn[h][i] : offc[h][i];
            PG8_LDB(B0, 0, 0); PG8_LDB(B1, 0, 1); PG8_SCHED; PG8_LDA(At, 0, 0); PG8_STAGE(PG8_SA(1, 1), a1, offc[1]);
            PG8_WAIT_V(8); PG8_WAIT_L(0); PG8_BAR; PG8_MMA(0, 0, At, B0); PG8_MMA(0, 1, At, B1); PG8_BAR; PG8_SCHED;
            PG8_LDA(At, 0, 1); PG8_STAGE(PG8_SB(0, 0), b2, voffB); PG8_STAGE(PG8_SB(0, 1), b2 + hstep, voffB); PG8_STAGE(PG8_SA(0, 0), a2, o2[0]);
            PG8_WAIT_V(8); PG8_WAIT_L(0); PG8_BAR; PG8_MMA(1, 0, At, B0); PG8_MMA(1, 1, At, B1); PG8_BAR; PG8_SCHED;
            PG8_LDB(B0, 1, 0); PG8_LDB(B1, 1, 1); PG8_SCHED; PG8_LDA(At, 1, 0); PG8_STAGE(PG8_SA(0, 1), a2, o2[1]);
            PG8_WAIT_V(8); PG8_WAIT_L(0); PG8_BAR; PG8_MMA(0, 0, At, B0); PG8_MMA(0, 1, At, B1); PG8_BAR; PG8_SCHED;
            PG8_LDA(At, 1, 1); PG8_STAGE(PG8_SB(1, 0), b3, voffB); PG8_STAGE(PG8_SB(1, 1), b3 + hstep, voffB); PG8_STAGE(PG8_SA(1, 0), a3, o2[0]);
            PG8_WAIT_V(8); PG8_WAIT_L(0); PG8_BAR; PG8_MMA(1, 0, At, B0); PG8_MMA(1, 1, At, B1); PG8_BAR; PG8_SCHED;
        }
        if constexpr (ALIGN_EPI) { if (wr == 0) PG8_BAR; }
        E(acc, cur, wr, wc, fr, fq);
        if (!has_next) break;
#pragma unroll
        for (int a = 0; a < 2; ++a)
#pragma unroll
            for (int b = 0; b < 2; ++b)
#pragma unroll
                for (int m = 0; m < 4; ++m)
#pragma unroll
                    for (int n = 0; n < 2; ++n) acc[a][b][m][n] = (f32x4){0.f, 0.f, 0.f, 0.f};
        cur = nxt; cB = nB; ++ui;
#pragma unroll
        for (int h = 0; h < 2; ++h)
#pragma unroll
            for (int i = 0; i < 2; ++i) offc[h][i] = offn[h][i];
        if constexpr (ALIGN_EPI) { if (wr == 1) PG8_BAR; }
    }
    PG8_WAIT_V(0);
    if constexpr (!ALIGN_EPI) { if (wr == 0) PG8_BAR; }
    PG8_BAR;
#undef PG8_SA
#undef PG8_SB
#undef PG8_STAGE
#undef PG8_LDA
#undef PG8_LDB
#undef PG8_MMA
#undef PG8_WAIT_V
#undef PG8_WAIT_L
#undef PG8_BAR
#undef PG8_SCHED
#undef PG8_AOFF
}
}

#define XB_TMO      128
#define XB_XCNT(j)  (256  + 64 * (j))
#define XB_XSUB(j)  (1280 + 64 * (j))
#define XB_XGEN(j)  (2304 + 64 * (j))
#define XB_TOP      3328
#define XB_TOPGEN   3392
#define XCD_BAR_WORDS 3456
#define XB_SPIN_CAP (1u << 18)

__device__ __forceinline__ unsigned xb_ld(unsigned* p)              { return __hip_atomic_load(p, __ATOMIC_RELAXED, __HIP_MEMORY_SCOPE_AGENT); }
__device__ __forceinline__ unsigned xb_add(unsigned* p, unsigned v) { return __hip_atomic_fetch_add(p, v, __ATOMIC_RELAXED, __HIP_MEMORY_SCOPE_AGENT); }
__device__ __forceinline__ unsigned xb_xcc_id() { return (unsigned)__builtin_amdgcn_s_getreg((3 << 11) | 20) & 0xFu; }
#define XB_SPIN(cond, bar) do { unsigned _sp = 0; while (cond) { __builtin_amdgcn_s_sleep(1); \
    if ((++_sp & 255u) == 0u) { if (xb_ld(&(bar)[XB_TMO])) break; if (_sp > XB_SPIN_CAP) { atomicAdd(&(bar)[XB_TMO], 1u); break; } } } } while (0)

struct XcdBarrier { unsigned* bar; unsigned x; volatile LAS unsigned* st; };

__device__ __forceinline__ XcdBarrier xcd_barrier_post(unsigned* bar, volatile LAS unsigned* st) {
    XcdBarrier b; b.bar = bar; b.x = xb_xcc_id(); b.st = st;
    if (threadIdx.x == 0) (void)xb_add(&bar[XB_XCNT(b.x)], 1u);
    return b;
}
__device__ __forceinline__ void xcd_barrier_complete(unsigned* bar, unsigned x, unsigned& nloc, unsigned& nx) {
    const unsigned G = gridDim.x * gridDim.y * gridDim.z;
    unsigned sum, cnt, mine, sp = 0u;
    for (;;) {
        sum = 0u; cnt = 0u; mine = 0u;
#pragma unroll
        for (unsigned j = 0; j < 16; ++j) { const unsigned c = xb_ld(&bar[XB_XCNT(j)]); sum += c; cnt += (c > 0u) ? 1u : 0u; mine = (j == x) ? c : mine; }
        if (sum == G) break;
        __builtin_amdgcn_s_sleep(1);
        if ((++sp & 255u) == 0u) { if (xb_ld(&bar[XB_TMO])) break; if (sp > XB_SPIN_CAP) { atomicAdd(&bar[XB_TMO], 1u); break; } }
    }
    nloc = mine > 0u ? mine : 1u; nx = cnt > 0u ? cnt : 1u;
}
__device__ __forceinline__ void xcd_barrier(const XcdBarrier& b) {
    asm volatile("s_waitcnt vmcnt(0)" ::: "memory");
    __syncthreads();
    if (threadIdx.x == 0) {
        unsigned* bar = b.bar;
        __builtin_amdgcn_s_waitcnt(0);
        unsigned nloc = b.st[0], nx = b.st[1];
        if (nloc == 0u) { xcd_barrier_complete(bar, b.x, nloc, nx); b.st[0] = nloc; b.st[1] = nx; }
        const unsigned old = xb_add(&bar[XB_XSUB(b.x)], 1u);
        const unsigned gen = old / nloc;
        if (old + 1u == (gen + 1u) * nloc) {
            __builtin_amdgcn_fence(__ATOMIC_RELEASE, "agent");
            asm volatile("s_waitcnt vmcnt(0)" ::: "memory");
            const unsigned og = xb_add(&bar[XB_TOP], 1u);
            const unsigned tg = og / nx;
            if (og + 1u == (tg + 1u) * nx) xb_add(&bar[XB_TOPGEN], 1u);
            else XB_SPIN(xb_ld(&bar[XB_TOPGEN]) == tg, bar);
            __builtin_amdgcn_fence(__ATOMIC_ACQUIRE, "agent");
            xb_add(&bar[XB_XGEN(b.x)], 1u);
            asm volatile("s_waitcnt vmcnt(0)" ::: "memory");
        } else {
            XB_SPIN(xb_ld(&bar[XB_XGEN(b.x)]) == gen, bar);
            __builtin_amdgcn_fence(__ATOMIC_ACQUIRE, "agent");
            asm volatile("s_waitcnt vmcnt(0)" ::: "memory");
        }
    }
    __syncthreads();
}

__device__ __forceinline__ void transpose_item(const float* W, int K, int N, bf16* WT, int kb, int nb, int dst_row0, LAS float* scr, int lane) {
    const int k0 = 64 * kb, n0 = 32 * nb;
#pragma unroll 8
    for (int i = 0; i < 32; ++i) { const int kk = 2 * i + (lane >> 5); scr[kk * 33 + (lane & 31)] = W[(size_t)(k0 + kk) * N + n0 + (lane & 31)]; }
    LDS_WAIT(); asm volatile("" ::: "memory");
    const int c = lane & 7;
#pragma unroll
    for (int j = 0; j < 4; ++j) { const int n = (lane >> 3) + 8 * j; const LAS float* s = scr + (8 * c) * 33 + n;
        v4u o; o.x = pk2(s[0 * 33], s[1 * 33]); o.y = pk2(s[2 * 33], s[3 * 33]); o.z = pk2(s[4 * 33], s[5 * 33]); o.w = pk2(s[6 * 33], s[7 * 33]);
        *(GAS v4u*)(WT + (size_t)(dst_row0 + n) * K + k0 + 8 * c) = o; }
    LDS_WAIT(); asm volatile("" ::: "memory");
}
__device__ __forceinline__ void transpose_plain(const float* W, int K, int N, bf16* WT, LAS float* scr, int gw, int ngw, int lane) {
    const int nblk = N / 32, nitems = (K / 64) * nblk;
    for (int it = gw; it < nitems; it += ngw) { const int kb = it / nblk, nb = it % nblk; transpose_item(W, K, N, WT, kb, nb, 32 * nb, scr, lane); }
}
__device__ __forceinline__ void transpose_moe(const float* w1, const float* w3, const float* w2, bf16* W13T, bf16* W2T, LAS float* scr, int gw, int ngw, int lane) {
    constexpr int I13 = 16 * 16, I2 = 8 * 32, IPE = 2 * I13 + I2;
    for (int it = gw; it < NEXP * IPE; it += ngw) {
        const int e = it / IPE; int r = it % IPE;
        if (r < 2 * I13) { const int which = r / I13; r %= I13; const int kb = r / 16, nb = r % 16, n0 = 32 * nb;
            const float* W = (which ? w3 : w1) + (size_t)e * 1024 * 512;
            transpose_item(W, 1024, 512, W13T + (size_t)e * 1024 * 1024, kb, nb, (n0 >> 7) * 256 + which * 128 + (n0 & 127), scr, lane);
        } else { r -= 2 * I13; const int kb = r / 32, nb = r % 32;
            transpose_item(w2 + (size_t)e * 512 * 1024, 512, 1024, W2T + (size_t)e * 1024 * 512, kb, nb, 32 * nb, scr, lane); }
    }
}
__device__ __forceinline__ void rms_row(const float* xrow, const float* g, f32x4 (&v)[4], int lane) {
    const GAS f32x4* xr = (const GAS f32x4*)xrow + lane; const GAS f32x4* gr = (const GAS f32x4*)g + lane;
    float s = 0.f;
#pragma unroll
    for (int j = 0; j < 4; ++j) { v[j] = xr[64 * j]; s += (v[j].x * v[j].x + v[j].y * v[j].y) + (v[j].z * v[j].z + v[j].w * v[j].w); }
    const float rstd = 1.0f / sqrtf(wave_sum(s) * (1.f / DM) + 1e-6f);
#pragma unroll
    for (int j = 0; j < 4; ++j) { const f32x4 gg = gr[64 * j]; v[j] = v[j] * rstd * gg; }
}
__device__ __forceinline__ void store_row_bf16(bf16* orow, const f32x4 (&v)[4], int lane) {
    GAS unsigned long long* o8 = (GAS unsigned long long*)orow + lane;
#pragma unroll
    for (int j = 0; j < 4; ++j) o8[64 * j] = (unsigned long long)pk2(v[j].x, v[j].y) | ((unsigned long long)pk2(v[j].z, v[j].w) << 32);
}

__device__ __forceinline__ int t5_bucket(int rel) {
    const int n = rel < 0 ? -rel : rel; int ret = rel > 0 ? 16 : 0;
    int v;
    if (n < 8) v = n;
    else { const float nf = (float)n; int large = 8 + (int)(logf(nf / 8.0f) / 2.772588722239781f * 8.0f); v = large < 15 ? large : 15; }
    return ret + v;
}

__device__ __forceinline__ int crow(int r, int hi) { return (r & 3) + 8 * (r >> 2) + 4 * hi; }
__device__ __forceinline__ unsigned cvtpk(float lo, float hi) { unsigned r; asm volatile("v_cvt_pk_bf16_f32 %0, %1, %2" : "=v"(r) : "v"(lo), "v"(hi)); return r; }
__device__ __forceinline__ s16x4 vtr(const LAS char* p) { typedef short v4i16_t __attribute__((ext_vector_type(4))); return __builtin_bit_cast(s16x4, __builtin_amdgcn_ds_read_tr16_b64_v4i16((LAS v4i16_t*)p)); }

template <int DV, bool BIAS, bool FP8 = false>
__device__ __forceinline__ void attn_unit_v0(const bf16* Qp, int ldq, const bf16* Kp, int ldk, const bf16* Vp, int ldv, bf16* Op, int ldo, const LAS float* btbl, int q0, LAS unsigned char* lds) {
    const int tid = threadIdx.x, lane = tid & 63, r32 = lane & 31, hi = lane >> 5; const int wid = __builtin_amdgcn_readfirstlane(tid >> 6);
    constexpr int ND = DV / 32;
    LAS unsigned char* ldsK = lds; LAS unsigned char* ldsV = lds + 8192; LAS float* wsf = (LAS float*)(lds + 8192 + DV * 128) + wid * 64;
    bf16x8 qr[4]; v8i q8 = {0, 0, 0, 0, 0, 0, 0, 0};
    if (FP8) { const v4u a = *(const v4u*)((const unsigned char*)Qp + (size_t)(wid * 32 + r32) * ldq + hi * 32), b = *(const v4u*)((const unsigned char*)Qp + (size_t)(wid * 32 + r32) * ldq + hi * 32 + 16);
        q8 = (v8i){(int)a.x, (int)a.y, (int)a.z, (int)a.w, (int)b.x, (int)b.y, (int)b.z, (int)b.w}; }
    else {
#pragma unroll
    for (int d0 = 0; d0 < 4; ++d0) qr[d0] = *(const bf16x8*)(Qp + (size_t)(wid * 32 + r32) * ldq + d0 * 16 + hi * 8); }
    f32x16 o[ND];
#pragma unroll
    for (int d = 0; d < ND; ++d)
#pragma unroll
        for (int r = 0; r < 16; ++r) o[d][r] = 0.f;
    float l = 0.f;
    const int qpos = q0 + wid * 32 + r32;
    const LAS char* kp0 = (const LAS char*)ldsK + hi * 1024 + r32 * 16;
    const LAS char* vp0 = (const LAS char*)ldsV + ((lane >> 4) & 1) * 32 + (lane & 3) * 8 + (4 * hi + ((lane & 15) >> 2)) * 64;
    for (int t = 0; t < SEQ / 64; ++t) {
        __syncthreads();
        {
            if (FP8) { if (wid < 4) { const v4u kv = *(const v4u*)((const unsigned char*)Kp + (size_t)(t * 64 + lane) * ldk + wid * 16); *(LAS v4u*)(ldsK + wid * 1024 + lane * 16) = kv; } }
            else { const v4u kv = *(const v4u*)(Kp + (size_t)(t * 64 + lane) * ldk + wid * 8);
            *(LAS v4u*)(ldsK + wid * 1024 + lane * 16) = kv; }
#pragma unroll
            for (int pp = 0; pp < ND / 2; ++pp) { const int p = wid + 8 * pp, dq = p >> 2, rg = p & 3;
                const v4u vv = *(const v4u*)(Vp + (size_t)(t * 64 + 16 * rg + (lane >> 2)) * ldv + dq * 32 + (lane & 3) * 8);
                *(LAS v4u*)(ldsV + p * 1024 + lane * 16) = vv; }
        }
        __syncthreads();
        f32x16 p0, p1;
#pragma unroll
        for (int r = 0; r < 16; ++r) { p0[r] = 0.f; p1[r] = 0.f; }
        if (FP8) {
            const LAS char* k8 = (const LAS char*)ldsK + hi * 2048 + r32 * 16;
            const v4u a0 = *(const LAS v4u*)(k8), a1 = *(const LAS v4u*)(k8 + 1024), b0 = *(const LAS v4u*)(k8 + 512), b1 = *(const LAS v4u*)(k8 + 1024 + 512);
            const v8i ka = (v8i){(int)a0.x, (int)a0.y, (int)a0.z, (int)a0.w, (int)a1.x, (int)a1.y, (int)a1.z, (int)a1.w};
            const v8i kb = (v8i){(int)b0.x, (int)b0.y, (int)b0.z, (int)b0.w, (int)b1.x, (int)b1.y, (int)b1.z, (int)b1.w};
            p0 = __builtin_amdgcn_mfma_scale_f32_32x32x64_f8f6f4(ka, q8, p0, 0, 0, 0, 0x7f7f7f7f, 0, 0x7c7c7c7c);
            p1 = __builtin_amdgcn_mfma_scale_f32_32x32x64_f8f6f4(kb, q8, p1, 0, 0, 0, 0x7f7f7f7f, 0, 0x7c7c7c7c);
        } else {
#pragma unroll
        for (int d0 = 0; d0 < 4; ++d0) {
            const bf16x8 b0 = *(const LAS bf16x8*)(kp0 + d0 * 2048), b1 = *(const LAS bf16x8*)(kp0 + d0 * 2048 + 512);
            p0 = __builtin_amdgcn_mfma_f32_32x32x16_bf16(b0, qr[d0], p0, 0, 0, 0);
            p1 = __builtin_amdgcn_mfma_f32_32x32x16_bf16(b1, qr[d0], p1, 0, 0, 0);
        } }
        if (BIAS) {
            const int base = t * 64 + 4 * hi - qpos;
#pragma unroll
            for (int r = 0; r < 16; ++r) { int rel = base + (r & 3) + 8 * (r >> 2);
                int i0 = rel < -128 ? -128 : (rel > 128 ? 128 : rel); int rel1 = rel + 32; int i1 = rel1 < -128 ? -128 : (rel1 > 128 ? 128 : rel1);
                p0[r] += btbl[i0 + 128]; p1[r] += btbl[i1 + 128]; }
        }
        float sacc = 0.f;
#pragma unroll
        for (int r = 0; r < 16; ++r) { p0[r] = __builtin_amdgcn_exp2f(p0[r]); p1[r] = __builtin_amdgcn_exp2f(p1[r]); sacc += p0[r] + p1[r]; }
        l += sacc;
        v4u pw[4];
#pragma unroll
        for (int k = 0; k < 2; ++k) {
            pw[k]     = (v4u){cvtpk(p0[8 * k + 0], p0[8 * k + 1]), cvtpk(p0[8 * k + 2], p0[8 * k + 3]), cvtpk(p0[8 * k + 4], p0[8 * k + 5]), cvtpk(p0[8 * k + 6], p0[8 * k + 7])};
            pw[2 + k] = (v4u){cvtpk(p1[8 * k + 0], p1[8 * k + 1]), cvtpk(p1[8 * k + 2], p1[8 * k + 3]), cvtpk(p1[8 * k + 4], p1[8 * k + 5]), cvtpk(p1[8 * k + 6], p1[8 * k + 7])};
        }
#pragma unroll
        for (int d0 = 0; d0 < ND; ++d0)
#pragma unroll
            for (int ks = 0; ks < 4; ++ks) {
                const s16x4 lo = vtr(vp0 + d0 * 4096 + ks * 1024), hh = vtr(vp0 + d0 * 4096 + ks * 1024 + 512);
                const bf16x8 vf = (bf16x8){lo[0], lo[1], lo[2], lo[3], hh[0], hh[1], hh[2], hh[3]};
                o[d0] = __builtin_amdgcn_mfma_f32_32x32x16_bf16(__builtin_bit_cast(bf16x8, pw[ks]), vf, o[d0], 0, 0, 0);
            }
    }
    l += __shfl_xor(l, 32);
    if (hi == 0) wsf[r32] = l;
    LDS_WAIT(); asm volatile("" ::: "memory");
#pragma unroll
    for (int r = 0; r < 16; ++r) { const int row = crow(r, hi); const float rl = 1.0f / wsf[row];
#pragma unroll
        for (int d0 = 0; d0 < ND; ++d0) Op[(size_t)(wid * 32 + row) * ldo + d0 * 32 + r32] = (bf16)f2bf(o[d0][r] * rl); }
    LDS_WAIT();
}

namespace at1 {
#define SBAR() __builtin_amdgcn_sched_barrier(0)
#define PIN(x) asm volatile("" : "+v"(x))
template <int N, bool NOBAR = false> __device__ __forceinline__ void wait_bar() { if (NOBAR) asm volatile("s_waitcnt vmcnt(%0) lgkmcnt(0)" :: "n"(N) : "memory"); else asm volatile("s_waitcnt vmcnt(%0) lgkmcnt(0)\n\ts_barrier" :: "n"(N) : "memory"); }
__device__ __forceinline__ void glds16(const void* gsrc, unsigned lds_dst) { unsigned keep;
    asm volatile("s_mov_b32 %0, m0\n\ts_mov_b32 m0, %2\n\ts_nop 0\n\tglobal_load_lds_dwordx4 %1, off\n\ts_mov_b32 m0, %0" : "=&s"(keep) : "v"(gsrc), "s"(lds_dst) : "memory"); }
typedef float f32x2_t __attribute__((ext_vector_type(2))); typedef __bf16 bf16x2_t __attribute__((ext_vector_type(2)));
__device__ __forceinline__ unsigned cvtpk_s(float lo, float hi) { f32x2_t v = {lo, hi}; bf16x2_t b = __builtin_convertvector(v, bf16x2_t); return __builtin_bit_cast(unsigned, b); }
typedef const LAS char* lds_cptr;
__device__ __forceinline__ void kload2(bf16x8* kf, lds_cptr kp, int j) { kf[2 * j] = *(const LAS bf16x8*)(kp + j * 2048); kf[2 * j + 1] = *(const LAS bf16x8*)(kp + j * 2048 + 512); }

template <int DV, bool FP8> __host__ __device__ constexpr int lds_ws_off() { return (3 * (FP8 ? 4096 : 8192) + 3 * DV * 128) > 512 * DV ? (3 * (FP8 ? 4096 : 8192) + 3 * DV * 128) : 512 * DV; }
template <int DV, bool FP8> __host__ __device__ constexpr int lds_tbl_off() { return lds_ws_off<DV, FP8>() + 2048; }
template <int DV, bool BIAS, int TEST = 0, int MODE = 0, bool FP8 = false, bool TILED = false>
__device__ __forceinline__ void attn_unit(const bf16* Qp, int ldq, const bf16* __restrict__ Kp, int ldk, const bf16* __restrict__ Vp, int ldv, bf16* Op, int ldo, int q0, LAS unsigned char* lds, const LAS float* sgt = nullptr) {
    constexpr int ND = DV / 32, NV = ND / 2, VSLOT = DV * 128, KSLOT = FP8 ? 4096 : 8192, NT = SEQ / 64;
    constexpr int LDS_K = 0, LDS_V = 3 * KSLOT, LDS_WS = lds_ws_off<DV, FP8>(), LDS_TBL = LDS_WS + 2048;
    static_assert(LDS_WS >= LDS_V + 3 * VSLOT && LDS_WS >= 512 * DV && LDS_TBL + 2048 <= STASH_OFF, "LDS map");
    const int tid = threadIdx.x, lane = tid & 63, r32 = lane & 31, hi = lane >> 5; const int wid = __builtin_amdgcn_readfirstlane(tid >> 6);
    const unsigned lds0 = (unsigned)(uintptr_t)lds;
    LAS float* wsf = (LAS float*)(lds + LDS_WS) + wid * 64;
    const LAS float* btbl = (const LAS float*)(lds + LDS_TBL);
    const unsigned char* ksrc = TILED ? (const unsigned char*)Kp + (wid & 3) * 1024 + lane * 16 : FP8 ? (const unsigned char*)Kp + (size_t)lane * ldk + (wid & 3) * 16 : (const unsigned char*)(Kp + (size_t)lane * ldk + wid * 8);
    const bf16* vsrc0 = TILED ? Vp + wid * 512 + lane * 8 : Vp + (size_t)(16 * (wid & 3) + (lane >> 2)) * ldv + (wid >> 2) * 32 + (lane & 3) * 8;
    const bf16* vsrc1 = TILED ? vsrc0 + 4096 : vsrc0 + 64;
    const unsigned kdst = lds0 + LDS_K + wid * 1024, vdst = lds0 + LDS_V + wid * 1024;
#define DMA_K(t, s) if (!(TEST & 8) && (!FP8 || wid < 4)) glds16(ksrc + (size_t)(t) * (TILED ? 4096 : 64 * ldk * (FP8 ? 1 : 2)), (unsigned)__builtin_amdgcn_readfirstlane(kdst + (s) * KSLOT))
#define DMA_V(t, s) do { if (TEST & 8) break; glds16(vsrc0 + (size_t)(t) * (TILED ? (size_t)(DV * 64) : (size_t)64 * ldv), (unsigned)__builtin_amdgcn_readfirstlane(vdst + (s) * VSLOT)); \
        if (NV == 2) glds16(vsrc1 + (size_t)(t) * (TILED ? (size_t)(DV * 64) : (size_t)64 * ldv), (unsigned)__builtin_amdgcn_readfirstlane(vdst + (s) * VSLOT + 8192)); } while (0)
    const lds_cptr kp0 = (lds_cptr)lds + LDS_K + hi * (FP8 ? 2048 : 1024) + r32 * 16;
    const lds_cptr vp0 = (lds_cptr)lds + LDS_V + ((lane >> 4) & 1) * 32 + (lane & 3) * 8 + (4 * hi + ((lane & 15) >> 2)) * 64;
    DMA_K(0, 0); DMA_V(0, 0); DMA_K(1, 1);
    bf16x8 qr[4]; v8i q8 = {0, 0, 0, 0, 0, 0, 0, 0};
    if (FP8) { const unsigned char* qb_ = (const unsigned char*)Qp + (size_t)(wid * 32 + r32) * ldq + hi * 32; const v4u a = *(const v4u*)qb_, b = *(const v4u*)(qb_ + 16);
        q8 = (v8i){(int)a.x, (int)a.y, (int)a.z, (int)a.w, (int)b.x, (int)b.y, (int)b.z, (int)b.w}; }
    else {
#pragma unroll
        for (int d0 = 0; d0 < 4; ++d0) qr[d0] = *(const bf16x8*)(Qp + (size_t)(wid * 32 + r32) * ldq + d0 * 16 + hi * 8); }
    float l_reg = 0.f; f32x16 o[ND];
#pragma unroll
    for (int d = 0; d < ND; ++d) o[d] = f32x16{};
    const f32x16 zero16 = f32x16{};
    const int qw = q0 + wid * 32, qpos = qw + r32;
    int tl = 0, tr = NT; float fL = 1.f;
    if (BIAS) { tl = (qw - 191 >= 0) ? ((qw - 191) >> 6) + 1 : 0; tr = (qw + 158) >> 6; fL = __builtin_amdgcn_exp2f(btbl[0]); }
    f32x16 pA0, pA1, pB0, pB1; bf16x8 kf[8]; v8i kf8[2]; s16x4 vlo[8], vhi[8]; v4u pw0, pw1, pw2, pw3;
#define KLOAD8(n, kp_) do { const v4u a_ = *(const LAS v4u*)((kp_) + (n) * 512), b_ = *(const LAS v4u*)((kp_) + (n) * 512 + 1024); kf8[n] = (v8i){(int)a_.x, (int)a_.y, (int)a_.z, (int)a_.w, (int)b_.x, (int)b_.y, (int)b_.z, (int)b_.w}; } while (0)
#define MF8(kf_, c_) __builtin_amdgcn_mfma_scale_f32_32x32x64_f8f6f4(kf_, q8, c_, 0, 0, 0, 0x7f7f7f7f, 0, 0x7c7c7c7c)
#define WAITB(N) do { if (FP8 && wid >= 4) wait_bar<(N) - 1, (TEST & 16) != 0>(); else wait_bar<(N), (TEST & 16) != 0>(); } while (0)
    if (TEST & 32) { pB0 = f32x16{}; pB1 = f32x16{}; }
    if (TEST & 64) { _Pragma("unroll") for (int i_ = 0; i_ < 8; ++i_) { vlo[i_] = (s16x4){1, 2, 3, 4}; vhi[i_] = (s16x4){4, 3, 2, 1}; } }
    int s_prev = 0, s_cur = 0, s_next = 1;
#define ROT() do { s_prev = s_cur; s_cur = s_next; s_next = (s_next == 2) ? 0 : s_next + 1; } while (0)
#define ADD_BIAS(C0, C1, t) do { if (BIAS && (t) >= tl && (t) <= tr) { const int base_ = (t) * 64 + 4 * hi - qpos; \
        _Pragma("unroll") for (int r = 0; r < 16; ++r) { const int rel0 = base_ + (r & 3) + 8 * (r >> 2); const int rel1 = rel0 + 32; \
            const int i0 = (rel0 < -128 ? -128 : (rel0 > 128 ? 128 : rel0)) + 128, i1 = (rel1 < -128 ? -128 : (rel1 > 128 ? 128 : rel1)) + 128; \
            C0[r] += btbl[i0]; C1[r] += btbl[i1]; } } } while (0)
    DMA_K(2, 2);
    if (FP8) wait_bar<0, (TEST & 16) != 0>(); else wait_bar<NV + 2, (TEST & 16) != 0>();
    {
        if (FP8) { KLOAD8(0, kp0); KLOAD8(1, kp0); pA0 = MF8(kf8[0], zero16); pA1 = MF8(kf8[1], zero16); }
        else {
#pragma unroll
        for (int j = 0; j < 4; ++j) kload2(kf, kp0, j);
        pA0 = __builtin_amdgcn_mfma_f32_32x32x16_bf16(kf[0], qr[0], zero16, 0, 0, 0); pA1 = __builtin_amdgcn_mfma_f32_32x32x16_bf16(kf[1], qr[0], zero16, 0, 0, 0);
#pragma unroll
        for (int d0 = 1; d0 < 4; ++d0) { pA0 = __builtin_amdgcn_mfma_f32_32x32x16_bf16(kf[2 * d0], qr[d0], pA0, 0, 0, 0); pA1 = __builtin_amdgcn_mfma_f32_32x32x16_bf16(kf[2 * d0 + 1], qr[d0], pA1, 0, 0, 0); } }
        ADD_BIAS(pA0, pA1, 0);
#pragma unroll
        for (int r = 0; r < 16; ++r) { pA0[r] = __builtin_amdgcn_exp2f(pA0[r]); pA1[r] = __builtin_amdgcn_exp2f(pA1[r]); }
    }
    wait_bar<0, (TEST & 16) != 0>();
    DMA_K(3, 0); DMA_V(1, 1);
    ROT();
    if (FP8) { KLOAD8(0, kp0 + s_cur * KSLOT); KLOAD8(1, kp0 + s_cur * KSLOT); }
    else {
#pragma unroll
    for (int j = 0; j < 4; ++j) kload2(kf, kp0 + s_cur * KSLOT, j); }
    WAITB(1 + NV);
#define PKW(P, B) ((TEST & 256) ? 0x3f803f80u : cvtpk_s(P[B], P[B + 1]))
#define PAF(k) __builtin_bit_cast(bf16x8, pw##k)
#define VFR(i) (bf16x8){vlo[i][0], vlo[i][1], vlo[i][2], vlo[i][3], vhi[i][0], vhi[i][1], vhi[i][2], vhi[i][3]}
#define MF(a, b, c) __builtin_amdgcn_mfma_f32_32x32x16_bf16(a, b, c, 0, 0, 0)
#define GAPA(MFS, A0, A1, A2, A3, W0, W1, PW) do { if (!(TEST & 32)) { MFS; } if (!(TEST & 2)) { sacc += A0; sacc += A1; sacc += A2; sacc += A3; PIN(sacc); } W0; W1; PIN(PW); SBAR(); } while (0)
#define EX(v) ((TEST & 1) ? (v) : __builtin_amdgcn_exp2f(v))
#define GAPB4(MFS, X, B) do { if (!(TEST & 4)) { MFS; } X[B] = EX(X[B]); X[B + 1] = EX(X[B + 1]); X[B + 2] = EX(X[B + 2]); X[B + 3] = EX(X[B + 3]); PIN(X); SBAR(); } while (0)
#define GAPB2(MFS, X, B) do { if (!(TEST & 4)) { MFS; } X[B] = EX(X[B]); X[B + 1] = EX(X[B + 1]); PIN(X); SBAR(); } while (0)
#define VRD(f, s) do { if (TEST & 64) break; vlo[s] = vtr(vp_ + (((f) >> 2) * 4096 + ((f) & 3) * 1024)); vhi[s] = vtr(vp_ + (((f) >> 2) * 4096 + ((f) & 3) * 1024 + 512)); } while (0)
#define KRD(G, j) do { if ((G) && !(TEST & 128)) { if (FP8) { if ((j) < 2) { KLOAD8(j, kp0 + s_next * KSLOT); } } else kload2(kf, kp0 + s_next * KSLOT, j); SBAR(); } } while (0)
#define FO(m) (ND == 2 ? (((m) >> 1) + 4 * ((m) & 1)) : ((((m) & 7) >> 2) + 2 * ((m) >> 3) + 4 * ((m) & 3)))
#define STEP(C0, C1, P0, P1, t, GK, GV, GL) do { SBAR(); \
    const lds_cptr vp_ = vp0 + s_prev * VSLOT; float sacc; \
    if (FP8) { \
      VRD(FO(0), 0); VRD(FO(1), 1); VRD(FO(2), 2); VRD(FO(3), 3); SBAR(); \
      if (!(TEST & 32)) C0 = MF8(kf8[0], zero16); \
      sacc = (P0[0] + P0[1]); if (!(TEST & 2)) { _Pragma("unroll") for (int r_ = 2; r_ < 16; ++r_) sacc += P0[r_]; PIN(sacc); } \
      pw0 = (v4u){PKW(P0, 0), PKW(P0, 2), PKW(P0, 4), PKW(P0, 6)}; pw1 = (v4u){PKW(P0, 8), PKW(P0, 10), PKW(P0, 12), PKW(P0, 14)}; PIN(pw0); PIN(pw1); SBAR(); \
      VRD(FO(4), 4); VRD(FO(5), 5); VRD(FO(6), 6); VRD(FO(7), 7); SBAR(); \
      if (!(TEST & 32)) C1 = MF8(kf8[1], zero16); \
      if (!(TEST & 2)) { _Pragma("unroll") for (int r_ = 0; r_ < 16; ++r_) sacc += P1[r_]; PIN(sacc); } \
      pw2 = (v4u){PKW(P1, 0), PKW(P1, 2), PKW(P1, 4), PKW(P1, 6)}; pw3 = (v4u){PKW(P1, 8), PKW(P1, 10), PKW(P1, 12), PKW(P1, 14)}; PIN(pw2); PIN(pw3); SBAR(); \
    } else { \
    VRD(FO(0), 0); SBAR(); sacc = (P0[0] + P0[1]); \
    GAPA(C0 = MF(kf[0], qr[0], zero16), P0[2], P0[3], P0[4], P0[5],     pw0[0] = PKW(P0, 0), pw0[1] = PKW(P0, 2), pw0); \
    VRD(FO(1), 1); SBAR(); GAPA(C1 = MF(kf[1], qr[0], zero16), P0[6], P0[7], P0[8], P0[9],     pw0[2] = PKW(P0, 4), pw0[3] = PKW(P0, 6), pw0); \
    VRD(FO(2), 2); SBAR(); GAPA(C0 = MF(kf[2], qr[1], C0),   P0[10], P0[11], P0[12], P0[13], pw1[0] = PKW(P0, 8), pw1[1] = PKW(P0, 10), pw1); \
    VRD(FO(3), 3); SBAR(); GAPA(C1 = MF(kf[3], qr[1], C1),   P0[14], P0[15], P1[0], P1[1],   pw1[2] = PKW(P0, 12), pw1[3] = PKW(P0, 14), pw1); \
    VRD(FO(4), 4); SBAR(); GAPA(C0 = MF(kf[4], qr[2], C0),   P1[2], P1[3], P1[4], P1[5],     pw2[0] = PKW(P1, 0), pw2[1] = PKW(P1, 2), pw2); \
    VRD(FO(5), 5); SBAR(); GAPA(C1 = MF(kf[5], qr[2], C1),   P1[6], P1[7], P1[8], P1[9],     pw2[2] = PKW(P1, 4), pw2[3] = PKW(P1, 6), pw2); \
    VRD(FO(6), 6); SBAR(); GAPA(C0 = MF(kf[6], qr[3], C0),   P1[10], P1[11], P1[12], P1[13], pw3[0] = PKW(P1, 8), pw3[1] = PKW(P1, 10), pw3); \
    VRD(FO(7), 7); SBAR(); GAPA(C1 = MF(kf[7], qr[3], C1),   P1[14], P1[15], 0.f, 0.f,       pw3[2] = PKW(P1, 12), pw3[3] = PKW(P1, 14), pw3); \
    } \
    l_reg += sacc; \
    if (GK) { DMA_K((t) + 3, s_cur); } if (GV) { DMA_V((t) + 1, s_next); } \
    ADD_BIAS(C0, C1, t); \
    SBAR(); \
    if (ND == 2) { \
        GAPB4(o[0] = MF(PAF(0), VFR(0), o[0]), C0, 0); \
        GAPB4(o[1] = MF(PAF(0), VFR(1), o[1]), C0, 4); \
        KRD(GL, 0); GAPB4(o[0] = MF(PAF(1), VFR(2), o[0]), C0, 8); \
        KRD(GL, 1); GAPB4(o[1] = MF(PAF(1), VFR(3), o[1]), C0, 12); \
        KRD(GL, 2); GAPB4(o[0] = MF(PAF(2), VFR(4), o[0]), C1, 0); \
        KRD(GL, 3); GAPB4(o[1] = MF(PAF(2), VFR(5), o[1]), C1, 4); \
        GAPB4(o[0] = MF(PAF(3), VFR(6), o[0]), C1, 8); \
        GAPB4(o[1] = MF(PAF(3), VFR(7), o[1]), C1, 12); \
    } else { \
        GAPB2(o[0] = MF(PAF(0), VFR(0), o[0]), C0, 0);  VRD(FO(8), 0); SBAR(); \
        GAPB2(o[1] = MF(PAF(0), VFR(1), o[1]), C0, 2);  VRD(FO(9), 1); SBAR(); \
        GAPB2(o[ND - 2] = MF(PAF(0), VFR(2), o[ND - 2]), C0, 4);  VRD(FO(10), 2); SBAR(); \
        GAPB2(o[ND - 1] = MF(PAF(0), VFR(3), o[ND - 1]), C0, 6);  VRD(FO(11), 3); SBAR(); \
        GAPB2(o[0] = MF(PAF(1), VFR(4), o[0]), C0, 8);  VRD(FO(12), 4); SBAR(); \
        GAPB2(o[1] = MF(PAF(1), VFR(5), o[1]), C0, 10); VRD(FO(13), 5); SBAR(); \
        GAPB2(o[ND - 2] = MF(PAF(1), VFR(6), o[ND - 2]), C0, 12); VRD(FO(14), 6); SBAR(); \
        GAPB2(o[ND - 1] = MF(PAF(1), VFR(7), o[ND - 1]), C0, 14); VRD(FO(15), 7); SBAR(); \
        KRD(GL, 0); GAPB2(o[0] = MF(PAF(2), VFR(0), o[0]), C1, 0); \
        GAPB2(o[1] = MF(PAF(2), VFR(1), o[1]), C1, 2); \
        KRD(GL, 1); GAPB2(o[ND - 2] = MF(PAF(2), VFR(2), o[ND - 2]), C1, 4); \
        GAPB2(o[ND - 1] = MF(PAF(2), VFR(3), o[ND - 1]), C1, 6); \
        KRD(GL, 2); GAPB2(o[0] = MF(PAF(3), VFR(4), o[0]), C1, 8); \
        GAPB2(o[1] = MF(PAF(3), VFR(5), o[1]), C1, 10); \
        KRD(GL, 3); GAPB2(o[ND - 2] = MF(PAF(3), VFR(6), o[ND - 2]), C1, 12); \
        GAPB2(o[ND - 1] = MF(PAF(3), VFR(7), o[ND - 1]), C1, 14); \
    } \
    if (BIAS && (t) == tl) { l_reg *= fL; _Pragma("unroll") for (int d_ = 0; d_ < ND; ++d_) _Pragma("unroll") for (int r = 0; r < 16; ++r) o[d_][r] *= fL; } \
    } while (0)
    int t = 1;
    for (; t + 4 < NT; t += 2) {
        STEP(pB0, pB1, pA0, pA1, t, true, true, true);       WAITB(1 + NV); ROT();
        STEP(pA0, pA1, pB0, pB1, t + 1, true, true, true);   WAITB(1 + NV); ROT();
    }
    STEP(pB0, pB1, pA0, pA1, NT - 3, false, true, true);  wait_bar<NV, (TEST & 16) != 0>(); ROT();
    STEP(pA0, pA1, pB0, pB1, NT - 2, false, true, true);  wait_bar<0, (TEST & 16) != 0>();  ROT();
    STEP(pB0, pB1, pA0, pA1, NT - 1, false, false, false);
    {
        float sacc = pB0[0] + pB0[1];
#pragma unroll
        for (int r = 2; r < 16; ++r) sacc += pB0[r];
#pragma unroll
        for (int r = 0; r < 16; ++r) sacc += pB1[r];
        l_reg += sacc;
        pw0 = (v4u){PKW(pB0, 0), PKW(pB0, 2), PKW(pB0, 4), PKW(pB0, 6)}; pw1 = (v4u){PKW(pB0, 8), PKW(pB0, 10), PKW(pB0, 12), PKW(pB0, 14)};
        pw2 = (v4u){PKW(pB1, 0), PKW(pB1, 2), PKW(pB1, 4), PKW(pB1, 6)}; pw3 = (v4u){PKW(pB1, 8), PKW(pB1, 10), PKW(pB1, 12), PKW(pB1, 14)};
        const lds_cptr vp_ = vp0 + s_cur * VSLOT;
#pragma unroll
        for (int d0 = 0; d0 < ND; ++d0) {
            s16x4 a0 = vtr(vp_ + d0 * 4096), b0 = vtr(vp_ + d0 * 4096 + 512), a1 = vtr(vp_ + d0 * 4096 + 1024), b1 = vtr(vp_ + d0 * 4096 + 1536);
            s16x4 a2 = vtr(vp_ + d0 * 4096 + 2048), b2 = vtr(vp_ + d0 * 4096 + 2560), a3 = vtr(vp_ + d0 * 4096 + 3072), b3 = vtr(vp_ + d0 * 4096 + 3584);
            o[d0] = MF(PAF(0), ((bf16x8){a0[0], a0[1], a0[2], a0[3], b0[0], b0[1], b0[2], b0[3]}), o[d0]);
            o[d0] = MF(PAF(1), ((bf16x8){a1[0], a1[1], a1[2], a1[3], b1[0], b1[1], b1[2], b1[3]}), o[d0]);
            o[d0] = MF(PAF(2), ((bf16x8){a2[0], a2[1], a2[2], a2[3], b2[0], b2[1], b2[2], b2[3]}), o[d0]);
            o[d0] = MF(PAF(3), ((bf16x8){a3[0], a3[1], a3[2], a3[3], b3[0], b3[1], b3[2], b3[3]}), o[d0]);
        }
    }
    l_reg += __shfl_xor(l_reg, 32);
    int lane_e = lane; asm volatile("" : "+v"(lane_e));
    const int r32e = lane_e & 31, hie = lane_e >> 5;
    if (hie == 0) wsf[r32e] = l_reg;
    asm volatile("s_waitcnt lgkmcnt(0)\n\ts_barrier" ::: "memory");
    {
        LAS bf16* stg = (LAS bf16*)(MODE == 1 ? lds + STASH_OFF : lds) + wid * (32 * DV);
#pragma unroll
        for (int r = 0; r < 16; ++r) { const int orow = crow(r, hie); const float rl = __builtin_amdgcn_rcpf(wsf[orow]);
#pragma unroll
            for (int d0 = 0; d0 < ND; ++d0) stg[orow * DV + d0 * 32 + r32e] = (bf16)f2bf(o[d0][r] * rl); }
        asm volatile("s_waitcnt lgkmcnt(0)" ::: "memory");
        if (MODE == 0) {
            constexpr int CPR = DV / 8;
#pragma unroll
            for (int i = 0; i < (32 * CPR) / 64; ++i) { const int row = i * (64 / CPR) + lane_e / CPR, ch = lane_e % CPR;
                const v4u v = *(const LAS v4u*)(stg + row * DV + ch * 8); *(v4u*)(Op + (size_t)(wid * 32 + row) * ldo + ch * 8) = v; }
        } else if (MODE == 2) {
            const int row = lane_e >> 1, half = lane_e & 1; const float lam = sgt[128];
            const LAS bf16* s1 = stg + row * DV + half * 64; const LAS bf16* s0 = (const LAS bf16*)(lds + STASH_OFF) + wid * (32 * DV) + row * DV + half * 64;
            float ov[64]; float ss = 0.f;
#pragma unroll
            for (int q = 0; q < 8; ++q) { const v4u a = *(const LAS v4u*)(s0 + q * 8), c = *(const LAS v4u*)(s1 + q * 8);
#pragma unroll
                for (int j = 0; j < 4; ++j) { const float lo = __builtin_bit_cast(float, a[j] << 16) - lam * __builtin_bit_cast(float, c[j] << 16);
                    const float hh = __builtin_bit_cast(float, a[j] & 0xffff0000u) - lam * __builtin_bit_cast(float, c[j] & 0xffff0000u);
                    ov[q * 8 + 2 * j] = lo; ov[q * 8 + 2 * j + 1] = hh; ss += lo * lo + hh * hh; } }
            ss += dpp_mov<0xB1>(ss);
            const float rstd = 1.0f / sqrtf(ss * (1.f / 128.f) + 1e-5f);
            bf16* yo = Op + (size_t)(wid * 32 + row) * ldo + half * 64;
#pragma unroll
            for (int q = 0; q < 8; ++q) { const f32x4 g0 = *(const LAS f32x4*)(sgt + half * 64 + q * 8), g1 = *(const LAS f32x4*)(sgt + half * 64 + q * 8 + 4);
                v4u w; w.x = pk2(ov[q * 8] * rstd * g0.x, ov[q * 8 + 1] * rstd * g0.y); w.y = pk2(ov[q * 8 + 2] * rstd * g0.z, ov[q * 8 + 3] * rstd * g0.w);
                w.z = pk2(ov[q * 8 + 4] * rstd * g1.x, ov[q * 8 + 5] * rstd * g1.y); w.w = pk2(ov[q * 8 + 6] * rstd * g1.z, ov[q * 8 + 7] * rstd * g1.w);
                *(v4u*)(yo + q * 8) = w; }
        }
    }
    asm volatile("s_waitcnt lgkmcnt(0)\n\ts_barrier" ::: "memory");
#undef KLOAD8
#undef MF8
#undef WAITB
#undef DMA_K
#undef DMA_V
#undef ROT
#undef ADD_BIAS
#undef PKW
#undef PAF
#undef VFR
#undef MF
#undef GAPA
#undef EX
#undef GAPB4
#undef GAPB2
#undef VRD
#undef KRD
#undef FO
#undef STEP
}
#undef SBAR
#undef PIN
}

namespace at3 {
#define SBAR() __builtin_amdgcn_sched_barrier(0)
#define PIN(x) asm volatile("" : "+v"(x))
using at1::glds16; using at1::wait_bar;
typedef const LAS char* lds_cptr; typedef short v2s __attribute__((ext_vector_type(2)));
template <int DV> __host__ __device__ constexpr int lds_ws_off() { return (3 * 4096 + 3 * DV * 64) > 512 * DV ? (3 * 4096 + 3 * DV * 64) : 512 * DV; }
template <int DV> __host__ __device__ constexpr int lds_tbl_off() { return lds_ws_off<DV>() + 2048; }
__device__ __forceinline__ void waitb(int n) { if (n == 0) wait_bar<0>(); else if (n == 1) wait_bar<1>(); else wait_bar<2>(); }
__device__ __forceinline__ v8i ld_frag(lds_cptr p, int second) { const v4u a = *(const LAS v4u*)p, b = *(const LAS v4u*)(p + second); return (v8i){(int)a.x, (int)a.y, (int)a.z, (int)a.w, (int)b.x, (int)b.y, (int)b.z, (int)b.w}; }

template <int DV, bool BIAS, int MODE>
__device__ __forceinline__ void attn_unit(const unsigned char* Qp, int ldq, const unsigned char* __restrict__ K8T, const unsigned char* __restrict__ V8T, bf16* Op, int ldo, int q0, LAS unsigned char* lds, const LAS float* sgt) {
    constexpr int ND = DV / 32, VT = DV * 64, KT = 4096, NT = SEQ / 64, NVP = VT / 1024;
    constexpr int LDS_K = 0, LDS_V = 3 * KT, LDS_WS = lds_ws_off<DV>(), LDS_TBL = LDS_WS + 2048;
    static_assert(LDS_WS >= LDS_V + 3 * VT && LDS_WS >= 512 * DV && LDS_TBL + 2048 <= STASH_OFF, "LDS map");
    const int tid = threadIdx.x, lane = tid & 63, r32 = lane & 31, hi = lane >> 5; const int wid = __builtin_amdgcn_readfirstlane(tid >> 6);
    const unsigned lds0 = (unsigned)(uintptr_t)lds;
    LAS float* wsf = (LAS float*)(lds + LDS_WS) + wid * 64;
    const LAS float* btbl = (const LAS float*)(lds + LDS_TBL);
    const bool doK = wid < 4, doV = (NVP == 8) || wid >= 4; const int vpc = (NVP == 8) ? wid : (wid & 3);
    const unsigned char* ksrc = K8T + (wid & 3) * 1024 + lane * 16; const unsigned char* vsrc = V8T + vpc * 1024 + lane * 16;
    const unsigned kdst = lds0 + LDS_K + (wid & 3) * 1024, vdst = lds0 + LDS_V + vpc * 1024;
    const int ndma = (doK ? 1 : 0) + (doV ? 1 : 0);
#define DMA_K(t, s) do { if (doK) glds16(ksrc + (size_t)(t) * KT, (unsigned)__builtin_amdgcn_readfirstlane(kdst + (s) * KT)); } while (0)
#define DMA_V(t, s) do { if (doV) glds16(vsrc + (size_t)(t) * VT, (unsigned)__builtin_amdgcn_readfirstlane(vdst + (s) * VT)); } while (0)
    const lds_cptr kp0 = (lds_cptr)lds + LDS_K + hi * 2048 + r32 * 16;
    const lds_cptr vq0 = (lds_cptr)lds + LDS_V + hi * (2 * DV * 16) + r32 * 16;
    DMA_K(0, 0); DMA_V(0, 0); DMA_K(1, 1);
    v8i q8;
    { const unsigned char* qb_ = Qp + (size_t)(wid * 32 + r32) * ldq + hi * 32; const v4u a = *(const v4u*)qb_, b = *(const v4u*)(qb_ + 16);
      q8 = (v8i){(int)a.x, (int)a.y, (int)a.z, (int)a.w, (int)b.x, (int)b.y, (int)b.z, (int)b.w}; }
    float l_reg = 0.f; f32x16 o[ND];
#pragma unroll
    for (int d = 0; d < ND; ++d) o[d] = f32x16{};
    const f32x16 zero16 = f32x16{};
    const int qw = q0 + wid * 32, qpos = qw + r32;
    int tl = 0, tr = NT; float fL = 1.f;
    if (BIAS) { tl = (qw - 191 >= 0) ? ((qw - 191) >> 6) + 1 : 0; tr = (qw + 158) >> 6; fL = __builtin_amdgcn_exp2f(btbl[0]); }
    f32x16 pA0, pA1, pB0, pB1; v8i kf8[2]; v8i vf[ND]; v8i pa; int sb = 127;
    int s_prev = 0, s_cur = 0, s_next = 1;
#define ROT() do { s_prev = s_cur; s_cur = s_next; s_next = (s_next == 2) ? 0 : s_next + 1; } while (0)
#define MFQK(kf_) __builtin_amdgcn_mfma_scale_f32_32x32x64_f8f6f4(kf_, q8, zero16, 0, 0, 0, 0x7f7f7f7f, 0, 0x7c7c7c7c)
#define MFPV(d_) o[d_] = __builtin_amdgcn_mfma_scale_f32_32x32x64_f8f6f4(pa, vf[d_], o[d_], 0, 0, 0, sb, 0, 0x7f7f7f7f)
#define ADD_BIAS(C0, C1, t) do { if (BIAS && (t) >= tl && (t) <= tr) { const int base_ = (t) * 64 + 4 * hi - qpos; \
        _Pragma("unroll") for (int r = 0; r < 16; ++r) { const int rel0 = base_ + (r & 3) + 8 * (r >> 2); const int rel1 = rel0 + 32; \
            const int i0 = (rel0 < -128 ? -128 : (rel0 > 128 ? 128 : rel0)) + 128, i1 = (rel1 < -128 ? -128 : (rel1 > 128 ? 128 : rel1)) + 128; \
            C0[r] += btbl[i0]; C1[r] += btbl[i1]; } } } while (0)
#define MX3(a, b, c) __builtin_fmaxf(__builtin_fmaxf((a), (b)), (c))
#define PMAX(P0, P1) do { float a_ = MX3(P0[0], P0[1], P1[0]), b_ = MX3(P0[2], P0[3], P1[1]); a_ = MX3(a_, P1[2], P1[3]); \
        _Pragma("unroll") for (int r = 4; r < 16; r += 4) { a_ = MX3(a_, P0[r], P0[r + 1]); b_ = MX3(b_, P0[r + 2], P0[r + 3]); a_ = MX3(a_, P1[r], P1[r + 1]); b_ = MX3(b_, P1[r + 2], P1[r + 3]); } \
        const int em_ = (int)(__float_as_uint(__builtin_fmaxf(a_, b_)) >> 23) - 7; sb = em_ < 1 ? 1 : em_; } while (0)
#define PCVT(P0, P1) do { const float scf_ = __uint_as_float((unsigned)sb << 23); \
        _Pragma("unroll") for (int k = 0; k < 4; ++k) { v2s w_ = {0, 0}; w_ = __builtin_amdgcn_cvt_scalef32_pk_fp8_f32(w_, P0[4 * k], P0[4 * k + 1], scf_, false); w_ = __builtin_amdgcn_cvt_scalef32_pk_fp8_f32(w_, P0[4 * k + 2], P0[4 * k + 3], scf_, true); pa[k] = __builtin_bit_cast(int, w_); } \
        _Pragma("unroll") for (int k = 0; k < 4; ++k) { v2s w_ = {0, 0}; w_ = __builtin_amdgcn_cvt_scalef32_pk_fp8_f32(w_, P1[4 * k], P1[4 * k + 1], scf_, false); w_ = __builtin_amdgcn_cvt_scalef32_pk_fp8_f32(w_, P1[4 * k + 2], P1[4 * k + 3], scf_, true); pa[4 + k] = __builtin_bit_cast(int, w_); } } while (0)
#define PSUM(P0, P1) do { float s0_ = P0[0] + P0[1], s1_ = P0[2] + P0[3], s2_ = P1[0] + P1[1], s3_ = P1[2] + P1[3]; \
        _Pragma("unroll") for (int r = 4; r < 16; r += 4) { s0_ += P0[r]; s1_ += P0[r + 1]; s2_ += P0[r + 2]; s3_ += P0[r + 3]; s0_ += P1[r]; s1_ += P1[r + 1]; s2_ += P1[r + 2]; s3_ += P1[r + 3]; } \
        l_reg += (s0_ + s1_) + (s2_ + s3_); } while (0)
#define EXPS(X, B, N) do { _Pragma("unroll") for (int r_ = 0; r_ < (N); ++r_) X[(B) + r_] = __builtin_amdgcn_exp2f(X[(B) + r_]); PIN(X); } while (0)
    DMA_K(2, 2);
    wait_bar<0>();
    kf8[0] = ld_frag(kp0, 1024); kf8[1] = ld_frag(kp0 + 512, 1024);
    pA0 = MFQK(kf8[0]); pA1 = MFQK(kf8[1]);
    ADD_BIAS(pA0, pA1, 0);
#pragma unroll
    for (int r = 0; r < 16; ++r) { pA0[r] = __builtin_amdgcn_exp2f(pA0[r]); pA1[r] = __builtin_amdgcn_exp2f(pA1[r]); }
    wait_bar<0>();
    DMA_K(3, 0); DMA_V(1, 1);
    ROT();
    kf8[0] = ld_frag(kp0 + s_cur * KT, 1024); kf8[1] = ld_frag(kp0 + s_cur * KT + 512, 1024);
    waitb(ndma);
#define STEP(C0, C1, P0, P1, t, GK, GV, GL) do { SBAR(); \
    const lds_cptr vp_ = vq0 + s_prev * VT; \
    _Pragma("unroll") for (int d_ = 0; d_ < ND; ++d_) vf[d_] = ld_frag(vp_ + d_ * 512, DV * 16); \
    SBAR(); \
    C0 = MFQK(kf8[0]); \
    PMAX(P0, P1); PIN(sb); SBAR(); \
    C1 = MFQK(kf8[1]); \
    PSUM(P0, P1); PIN(l_reg); PCVT(P0, P1); PIN(pa); SBAR(); \
    if (GK) { DMA_K((t) + 3, s_cur); } if (GV) { DMA_V((t) + 1, s_next); } \
    ADD_BIAS(C0, C1, t); \
    SBAR(); \
    if (ND == 2) { \
        MFPV(0); EXPS(C0, 0, 16); SBAR(); \
        if (GL) { kf8[0] = ld_frag(kp0 + s_next * KT, 1024); kf8[1] = ld_frag(kp0 + s_next * KT + 512, 1024); SBAR(); } \
        MFPV(1); EXPS(C1, 0, 16); SBAR(); \
    } else { \
        MFPV(0); EXPS(C0, 0, 8); SBAR(); \
        if (GL) { kf8[0] = ld_frag(kp0 + s_next * KT, 1024); SBAR(); } \
        MFPV(1); EXPS(C0, 8, 8); SBAR(); \
        if (GL) { kf8[1] = ld_frag(kp0 + s_next * KT + 512, 1024); SBAR(); } \
        MFPV(ND - 2); EXPS(C1, 0, 8); SBAR(); \
        MFPV(ND - 1); EXPS(C1, 8, 8); SBAR(); \
    } \
    if (BIAS && (t) == tl) { l_reg *= fL; _Pragma("unroll") for (int d_ = 0; d_ < ND; ++d_) _Pragma("unroll") for (int r = 0; r < 16; ++r) o[d_][r] *= fL; } \
    } while (0)
    int t = 1;
    for (; t + 4 < NT; t += 2) {
        STEP(pB0, pB1, pA0, pA1, t, true, true, true);       waitb(ndma); ROT();
        STEP(pA0, pA1, pB0, pB1, t + 1, true, true, true);   waitb(ndma); ROT();
    }
    STEP(pB0, pB1, pA0, pA1, NT - 3, false, true, true);  waitb(doV ? 1 : 0); ROT();
    STEP(pA0, pA1, pB0, pB1, NT - 2, false, true, true);  wait_bar<0>();  ROT();
    STEP(pB0, pB1, pA0, pA1, NT - 1, false, false, false);
    {
        const lds_cptr vp_ = vq0 + s_cur * VT;
#pragma unroll
        for (int d_ = 0; d_ < ND; ++d_) vf[d_] = ld_frag(vp_ + d_ * 512, DV * 16);
        PMAX(pB0, pB1); PSUM(pB0, pB1); PCVT(pB0, pB1);
#pragma unroll
        for (int d_ = 0; d_ < ND; ++d_) MFPV(d_);
    }
    l_reg += __shfl_xor(l_reg, 32);
    int lane_e = lane; asm volatile("" : "+v"(lane_e));
    const int r32e = lane_e & 31, hie = lane_e >> 5;
    if (hie == 0) wsf[r32e] = l_reg;
    asm volatile("s_waitcnt lgkmcnt(0)\n\ts_barrier" ::: "memory");
    {
        LAS bf16* stg = (LAS bf16*)(MODE == 1 ? lds + STASH_OFF : lds) + wid * (32 * DV);
#pragma unroll
        for (int r = 0; r < 16; ++r) { const int orow = crow(r, hie); const float rl = __builtin_amdgcn_rcpf(wsf[orow]);
#pragma unroll
            for (int d0 = 0; d0 < ND; ++d0) stg[orow * DV + d0 * 32 + r32e] = (bf16)f2bf(o[d0][r] * rl); }
        asm volatile("s_waitcnt lgkmcnt(0)" ::: "memory");
        if (MODE == 0) {
            constexpr int CPR = DV / 8;
#pragma unroll
            for (int i = 0; i < (32 * CPR) / 64; ++i) { const int row = i * (64 / CPR) + lane_e / CPR, ch = lane_e % CPR;
                const v4u v = *(const LAS v4u*)(stg + row * DV + ch * 8); *(v4u*)(Op + (size_t)(wid * 32 + row) * ldo + ch * 8) = v; }
        } else if (MODE == 2) {
            const int row = lane_e >> 1, half = lane_e & 1; const float lam = sgt[128];
            const LAS bf16* s1 = stg + row * DV + half * 64; const LAS bf16* s0 = (const LAS bf16*)(lds + STASH_OFF) + wid * (32 * DV) + row * DV + half * 64;
            float ov[64]; float ss = 0.f;
#pragma unroll
            for (int q = 0; q < 8; ++q) { const v4u a = *(const LAS v4u*)(s0 + q * 8), c = *(const LAS v4u*)(s1 + q * 8);
#pragma unroll
                for (int j = 0; j < 4; ++j) { const float lo = __builtin_bit_cast(float, a[j] << 16) - lam * __builtin_bit_cast(float, c[j] << 16);
                    const float hh = __builtin_bit_cast(float, a[j] & 0xffff0000u) - lam * __builtin_bit_cast(float, c[j] & 0xffff0000u);
                    ov[q * 8 + 2 * j] = lo; ov[q * 8 + 2 * j + 1] = hh; ss += lo * lo + hh * hh; } }
            ss += dpp_mov<0xB1>(ss);
            const float rstd = 1.0f / sqrtf(ss * (1.f / 128.f) + 1e-5f);
            bf16* yo = Op + (size_t)(wid * 32 + row) * ldo + half * 64;
#pragma unroll
            for (int q = 0; q < 8; ++q) { const f32x4 g0 = *(const LAS f32x4*)(sgt + half * 64 + q * 8), g1 = *(const LAS f32x4*)(sgt + half * 64 + q * 8 + 4);
                v4u w; w.x = pk2(ov[q * 8] * rstd * g0.x, ov[q * 8 + 1] * rstd * g0.y); w.y = pk2(ov[q * 8 + 2] * rstd * g0.z, ov[q * 8 + 3] * rstd * g0.w);
                w.z = pk2(ov[q * 8 + 4] * rstd * g1.x, ov[q * 8 + 5] * rstd * g1.y); w.w = pk2(ov[q * 8 + 6] * rstd * g1.z, ov[q * 8 + 7] * rstd * g1.w);
                *(v4u*)(yo + q * 8) = w; }
        }
    }
    asm volatile("s_waitcnt lgkmcnt(0)\n\ts_barrier" ::: "memory");
#undef DMA_K
#undef DMA_V
#undef ROT
#undef MFQK
#undef MFPV
#undef ADD_BIAS
#undef MX3
#undef PMAX
#undef PCVT
#undef PSUM
#undef EXPS
#undef STEP
}
#undef SBAR
#undef PIN
}

struct Args { const float* in[27]; float* out; unsigned char* ws; int ph_lo, ph_hi, li, pad; };

constexpr int NPHASE = 17;
constexpr int NWAVES = 8;

#define IN(k) (lo <= (k) && (k) < hi_ph)
#define SEAM(k) do { if (IN(k) && IN((k) + 1)) xcd_barrier(bar); } while (0)
template <int layer>
__device__ __forceinline__ void moe_block(const Args& args, LAS unsigned char* lds, const XcdBarrier& bar, int lo, int hi_ph) {
    volatile LAS unsigned* LC = (volatile LAS unsigned*)(lds + LDSCTL_OFF);
    const int tid = threadIdx.x, lane = tid & 63, wave = __builtin_amdgcn_readfirstlane(tid >> 6);
    const int G = gridDim.x, bx = blockIdx.x;
    const int gw = bx * NWAVES + wave, NGW = G * NWAVES;
    unsigned char* ws = args.ws;
    unsigned* ctl = (unsigned*)(ws + WS_CTL);
    float* xres = args.out;
    bf16* HB = (bf16*)(ws + WS_HB);
    {
        const int pb = layer == 0 ? 5 : 13;
        unsigned* const gcnt0 = ctl + CW_CNT + layer * 64;
        int* list = (int*)(ws + WS_LIST); int* tokep = (int*)(ws + WS_TOKEP); float* gate = (float*)(ws + WS_GATE);
        if (IN(pb)) REP(pb) {
            unsigned* gcnt = gcnt0 + ((MK_N_LAUNCHES == 1 ? (int)((PROBE_MASK >> pb) & 1u) : 0) - rep_) * 128;
            if (rep_ > 0) xcd_barrier(bar);
            const float* gf = args.in[2] + layer * DM;
            const float* WR = (const float*)(ws + WS_TBL) + TBL_WR + layer * WR_LAYER;
            for (int chunk = bx; chunk < NTOK / 128; chunk += G) {
                __syncthreads();
                if (tid < 32) LC[LC_LCNT + tid] = 0u;
                __syncthreads();
                int my_e0 = 0, my_e1 = 0; float my_g0 = 0.f, my_g1 = 0.f;
                {
                    const int ri = lane & 15, kq = lane >> 4; const int r0w = chunk * 128 + wave * 16;
                    const GAS float* xrow = (const GAS float*)(xres + (size_t)(r0w + ri) * DM) + 4 * kq;
                    const GAS float* wb = (const GAS float*)WR + (size_t)(4 * kq) * 48 + ri;
                    f32x4 acc0 = {0.f, 0.f, 0.f, 0.f}, acc1 = acc0, acc2 = acc0; float ss = 0.f;
                    f32x4 aA[4], aB[4]; float bA[48], bB[48];
#define RT_LOAD(a_, b_, g_) do { _Pragma("unroll") for (int c_ = 0; c_ < 4; ++c_) { a_[c_] = *(const GAS f32x4*)(xrow + 16 * (4 * (g_) + c_)); \
        const GAS float* wc_ = wb + (size_t)(16 * (4 * (g_) + c_)) * 48; _Pragma("unroll") for (int e_ = 0; e_ < 4; ++e_) { b_[c_ * 12 + e_ * 3] = wc_[e_ * 48]; b_[c_ * 12 + e_ * 3 + 1] = wc_[e_ * 48 + 16]; b_[c_ * 12 + e_ * 3 + 2] = wc_[e_ * 48 + 32]; } } } while (0)
#define RT_COMP(a_, b_) do { _Pragma("unroll") for (int c_ = 0; c_ < 4; ++c_) { ss += (a_[c_].x * a_[c_].x + a_[c_].y * a_[c_].y) + (a_[c_].z * a_[c_].z + a_[c_].w * a_[c_].w); \
        _Pragma("unroll") for (int e_ = 0; e_ < 4; ++e_) { acc0 = __builtin_amdgcn_mfma_f32_16x16x4f32(a_[c_][e_], b_[c_ * 12 + e_ * 3], acc0, 0, 0, 0); \
            acc1 = __builtin_amdgcn_mfma_f32_16x16x4f32(a_[c_][e_], b_[c_ * 12 + e_ * 3 + 1], acc1, 0, 0, 0); acc2 = __builtin_amdgcn_mfma_f32_16x16x4f32(a_[c_][e_], b_[c_ * 12 + e_ * 3 + 2], acc2, 0, 0, 0); } } } while (0)
                    RT_LOAD(aA, bA, 0);
#pragma unroll 1
                    for (int g = 0; g < 16; g += 2) {
                        RT_LOAD(aB, bB, g + 1);
                        RT_COMP(aA, bA);
                        if (g + 2 < 16) RT_LOAD(aA, bA, g + 2);
                        RT_COMP(aB, bB);
                    }
#undef RT_LOAD
#undef RT_COMP
                    ss += __shfl_xor(ss, 16); ss += __shfl_xor(ss, 32);
                    const float rstd = 1.0f / sqrtf(ss * (1.f / DM) + 1e-6f);
                    LAS float* Lg = (LAS float*)(lds + wave * 4096);
#pragma unroll
                    for (int r = 0; r < 4; ++r) { Lg[(4 * kq + r) * 49 + ri] = acc0[r]; Lg[(4 * kq + r) * 49 + 16 + ri] = acc1[r]; Lg[(4 * kq + r) * 49 + 32 + ri] = acc2[r]; }
                    LDS_WAIT(); asm volatile("" ::: "memory");
                    if (lane < 16) {
                        const GAS float* bv = (const GAS float*)WR + 1024 * 48;
                        float lg[4], le[32];
#pragma unroll
                        for (int e = 0; e < 4; ++e) lg[e] = Lg[lane * 49 + e] * rstd + bv[e];
#pragma unroll
                        for (int e = 0; e < 32; ++e) le[e] = Lg[lane * 49 + 4 + e] * rstd + bv[4 + e];
                        int gi = 0; float gm = lg[0];
#pragma unroll
                        for (int e = 1; e < 4; ++e) if (lg[e] > gm) { gm = lg[e]; gi = e; }
                        float gs = 0.f;
#pragma unroll
                        for (int e = 0; e < 4; ++e) gs += __expf(lg[e] - gm);
                        const float gval = 1.0f / gs;
                        float ev[8];
#pragma unroll
                        for (int j = 0; j < 8; ++j) ev[j] = gi == 0 ? le[j] : (gi == 1 ? le[8 + j] : (gi == 2 ? le[16 + j] : le[24 + j]));
                        int i0 = 0; float m0 = ev[0];
#pragma unroll
                        for (int j = 1; j < 8; ++j) if (ev[j] > m0) { m0 = ev[j]; i0 = j; }
                        int i1 = -1; float m1 = -3.0e38f;
#pragma unroll
                        for (int j = 0; j < 8; ++j) if (j != i0 && ev[j] > m1) { m1 = ev[j]; i1 = j; }
                        const float t1 = __expf(m1 - m0); const float den = 1.0f / (1.0f + t1);
                        my_e0 = gi * 8 + i0; my_e1 = gi * 8 + i1; my_g0 = gval * den; my_g1 = gval * t1 * den;
                    }
                    for (int i = 0; i < 16; ++i) { const int m = r0w + i; f32x4 v[4]; rms_row(xres + (size_t)m * DM, gf, v, lane); store_row_bf16(HB + (size_t)m * DM, v, lane); }
                }
                unsigned r0 = 0, r1 = 0;
                if (lane < 16) { r0 = atomicAdd((unsigned*)(LC + LC_LCNT + my_e0), 1u); r1 = atomicAdd((unsigned*)(LC + LC_LCNT + my_e1), 1u); }
                __syncthreads();
                if (tid < 32) { const unsigned c = LC[LC_LCNT + tid]; LC[LC_LBASE + tid] = c ? __hip_atomic_fetch_add(gcnt + tid, c, RLX_AGENT) : 0u; }
                __syncthreads();
                if (lane < 16) { const int m = chunk * 128 + wave * 16 + lane;
                    const unsigned p0 = LC[LC_LBASE + my_e0] + r0, p1 = LC[LC_LBASE + my_e1] + r1;
                    list[(size_t)my_e0 * LIST_CAP + p0] = m; list[(size_t)my_e1 * LIST_CAP + p1] = m;
                    tokep[2 * m] = my_e0 | (int)(p0 << 8); tokep[2 * m + 1] = my_e1 | (int)(p1 << 8);
                    gate[2 * m] = my_g0; gate[2 * m + 1] = my_g1; }
            }
        }
        SEAM(pb);
        if (IN(pb + 1) || IN(pb + 2) || IN(pb + 3)) {
            __syncthreads();
            if (tid == 0) { int acc = 0; for (int e = 0; e < 32; ++e) { const int c = (int)__hip_atomic_load(gcnt0 + e, RLX_AGENT); LC[LC_CNT + e] = (unsigned)c; LC[LC_TP + e] = (unsigned)acc; acc += (c + 255) >> 8; } LC[LC_TP + 32] = (unsigned)acc;
                int la = 0; for (int j = 0; j < 4; ++j) { LC[LC_LP + j] = (unsigned)la; la += ((int)LC[LC_CNT + (bx & 7) + 8 * j] + 255) >> 8; } LC[LC_LP + 4] = (unsigned)la; }
            __syncthreads();
        }
        const LAS int* tp = (const LAS int*)(lds + LDSCTL_OFF) + LC_TP; const LAS int* cn = (const LAS int*)(lds + LDSCTL_OFF) + LC_CNT; const LAS int* lp = (const LAS int*)(lds + LDSCTL_OFF) + LC_LP;
        if (IN(pb + 1)) REP(pb + 1) {
            pg8::Gemm g{HB, (const bf16*)(ws + WS_W13), 0, 1024, DM};
            pg8::MoeOrder S{tp, cn, lp, list, G, bx, tp[32] * 4, true, G == 256};
            pg8::EpiSwiglu E{(bf16*)(ws + WS_H)};
            pg8::gemm_phase<pg8::EpiSwiglu, pg8::MoeOrder, true>(lds, g, S, E);
        }
        SEAM(pb + 1);
        if (IN(pb + 2)) REP(pb + 2) {
            pg8::Gemm g{(const bf16*)(ws + WS_H), (const bf16*)(ws + WS_W2), 0, 1024, MOE_H};
            pg8::MoeOrder S{tp, cn, lp, list, G, bx, tp[32] * 4, false, G == 256};
            pg8::EpiBf16 E{(bf16*)(ws + WS_YS), DM, 0, 0, 1.f, 3};
            pg8::gemm_phase<pg8::EpiBf16, pg8::MoeOrder, true>(lds, g, S, E);
        }
        SEAM(pb + 2);
        if (IN(pb + 3)) {
            const bf16* YS = (const bf16*)(ws + WS_YS);
            if (layer == 0) { LAS float* scr = (LAS float*)(lds + wave * 16384);
                transpose_moe(args.in[24] + (size_t)NEXP * 1024 * 512, args.in[25] + (size_t)NEXP * 1024 * 512, args.in[26] + (size_t)NEXP * 1024 * 512, (bf16*)(ws + WS_W13), (bf16*)(ws + WS_W2), scr, gw, NGW, lane); }
            const float* gn = layer == 0 ? args.in[1] + DM : args.in[3];
            for (int m = gw; m < NTOK; m += NGW) {
                const int ep0 = tokep[2 * m], ep1 = tokep[2 * m + 1]; const float g0 = gate[2 * m], g1 = gate[2 * m + 1];
                const size_t s0 = (size_t)(tp[ep0 & 255] * 256 + (ep0 >> 8)), s1 = (size_t)(tp[ep1 & 255] * 256 + (ep1 >> 8));
                GAS f32x4* xr = (GAS f32x4*)(xres + (size_t)m * DM) + lane;
                const GAS v2u* y0 = (const GAS v2u*)(YS + s0 * DM) + lane; const GAS v2u* y1 = (const GAS v2u*)(YS + s1 * DM) + lane;
                f32x4 v[4]; float ss = 0.f;
#pragma unroll
                for (int j = 0; j < 4; ++j) { const v2u a = y0[64 * j], c = y1[64 * j]; f32x4 xv = xr[64 * j];
                    xv.x += g0 * __builtin_bit_cast(float, a.x << 16) + g1 * __builtin_bit_cast(float, c.x << 16);
                    xv.y += g0 * __builtin_bit_cast(float, a.x & 0xffff0000u) + g1 * __builtin_bit_cast(float, c.x & 0xffff0000u);
                    xv.z += g0 * __builtin_bit_cast(float, a.y << 16) + g1 * __builtin_bit_cast(float, c.y << 16);
                    xv.w += g0 * __builtin_bit_cast(float, a.y & 0xffff0000u) + g1 * __builtin_bit_cast(float, c.y & 0xffff0000u);
                    v[j] = xv; ss += (xv.x * xv.x + xv.y * xv.y) + (xv.z * xv.z + xv.w * xv.w); }
                const float rstd = 1.0f / sqrtf(wave_sum(ss) * (1.f / DM) + 1e-6f);
                const GAS f32x4* gr = (const GAS f32x4*)gn + lane;
                if (layer == 0) {
#pragma unroll
                    for (int j = 0; j < 4; ++j) xr[64 * j] = v[j];
#pragma unroll
                    for (int j = 0; j < 4; ++j) v[j] = v[j] * rstd * gr[64 * j];
                    store_row_bf16(HB + (size_t)m * DM, v, lane);
                } else {
#pragma unroll
                    for (int j = 0; j < 4; ++j) xr[64 * j] = v[j] * rstd * gr[64 * j];
                }
            }
        }
    }
}

__global__ void __launch_bounds__(NWAVES * 64, 2) mk_fwd(Args args) {
    extern __shared__ __attribute__((aligned(16))) unsigned char lds_raw[];
    LAS unsigned char* lds = (LAS unsigned char*)lds_raw;
    volatile LAS unsigned* LC = (volatile LAS unsigned*)(lds + LDSCTL_OFF);
    const int tid = threadIdx.x, lane = tid & 63, wave = __builtin_amdgcn_readfirstlane(tid >> 6);
    const int G = gridDim.x, bx = blockIdx.x;
    const int gw = bx * NWAVES + wave, NGW = G * NWAVES;
    unsigned char* ws = args.ws;
    unsigned* ctl = (unsigned*)(ws + WS_CTL);
    const float* x_in = args.in[0];
    float* xres = args.out;
    bf16* HB = (bf16*)(ws + WS_HB); bf16* Y = (bf16*)(ws + WS_Y);
    float* TBL = (float*)(ws + WS_TBL);

    for (int u = tid; u < (LDS_BYTES - LDSCTL_OFF) / 4; u += NWAVES * 64) LC[u] = 0u;
    __syncthreads();
    XcdBarrier bar; bar.bar = ctl + CW_BAR; bar.x = 0; bar.st = nullptr;
    if (MK_N_LAUNCHES == 1) bar = xcd_barrier_post(ctl + CW_BAR, LC + LC_BAR);
    const int lo = args.ph_lo, hi_ph = args.ph_hi;

    if (IN(0)) REP(0) {
        LAS float* scr = (LAS float*)(lds + wave * 16384);
        transpose_plain(args.in[4], DM, EV_IN, (bf16*)(ws + WS_WIN0), scr, gw, NGW, lane);
        transpose_plain(args.in[11], DM, DM, (bf16*)(ws + WS_WOUT0), scr, gw, NGW, lane);
        transpose_plain(args.in[12], DM, OD_IN, (bf16*)(ws + WS_WIN1), scr, gw, NGW, lane);
        transpose_plain(args.in[18], DM, DM, (bf16*)(ws + WS_WOUT1), scr, gw, NGW, lane);
        transpose_moe(args.in[24], args.in[25], args.in[26], (bf16*)(ws + WS_W13), (bf16*)(ws + WS_W2), scr, gw, NGW, lane);
        for (int i = bx * 512 + tid; i < 2048; i += G * 512) { const int pos = i >> 4, f = i & 15;
            const float inv = exp2f(-(float)f * (13.287712379549449f / 16.0f));
            const float ang = (float)pos * inv; const float rev = ang * 0.15915494309189535f; const float fr = rev - floorf(rev);
            TBL[TBL_COS + i] = __builtin_amdgcn_cosf(fr); TBL[TBL_SIN + i] = __builtin_amdgcn_sinf(fr); }
        for (int i = bx * 512 + tid; i < 8 * 257; i += G * 512) { const int h = i / 257, j = i % 257;
            TBL[TBL_BIAS + h * BIAS_STRIDE + j] = args.in[19][t5_bucket(j - 128) * 8 + h] * LOG2E; }
        for (int i = bx * 512 + tid; i < 2 * 1024 * 48; i += G * 512) { const int l = i / (1024 * 48), r = i % (1024 * 48), k = r / 48, c = r % 48;
            float w = 0.f; if (c < 4) w = args.in[20][(size_t)l * 4096 + k * 4 + c]; else if (c < 36) w = args.in[22][(size_t)l * 32768 + k * 32 + (c - 4)];
            TBL[TBL_WR + l * WR_LAYER + r] = w * args.in[2][l * DM + k]; }
        for (int i = bx * 512 + tid; i < 2 * 48; i += G * 512) { const int l = i / 48, c = i % 48;
            TBL[TBL_WR + l * WR_LAYER + 1024 * 48 + c] = c < 4 ? args.in[21][l * 4 + c] : (c < 36 ? args.in[23][l * 32 + (c - 4)] : 0.f); }
        for (int m = gw; m < NTOK; m += NGW) { f32x4 v[4]; rms_row(x_in + (size_t)m * DM, args.in[1], v, lane); store_row_bf16(HB + (size_t)m * DM, v, lane); }
    }
    SEAM(0);
    if (IN(1)) REP(1) {
        pg8::Gemm g{HB, (const bf16*)(ws + WS_WIN0), NTOK, EV_IN, DM}; pg8::StaticOrder S; S.init(NTOK, EV_IN, G, bx);
        pg8::EpiBf16 E{(bf16*)(ws + WS_Z0), EV_IN, 0, 0, 1.f, 0xffff};
        pg8::gemm_phase<pg8::EpiBf16, pg8::StaticOrder, true>(lds, g, S, E);
    }
    SEAM(1);
    if (IN(2)) REP(2) {
        const bf16* Z0 = (const bf16*)(ws + WS_Z0); bf16* QR = (bf16*)(ws + WS_QR); bf16* KR = (bf16*)(ws + WS_KR);
        if (QK_FP8 && (ATTN_VER == 1 || ATTN_VER == 3)) {
            for (int it = bx * 512 + tid; it < NTOK * 10; it += G * 512) {
                const bool isq = it < NTOK * 8; const int m = isq ? (it >> 3) : ((it - NTOK * 8) >> 1); const int hh = isq ? (it & 7) : 8 + ((it - NTOK * 8) & 1);
                const float* gn = isq ? args.in[5] : args.in[6];
                const GAS v4u* srcp = (const GAS v4u*)(Z0 + (size_t)m * EV_IN + hh * 64);
                float xv[64]; float ss = 0.f;
#pragma unroll
                for (int q = 0; q < 8; ++q) { const v4u a = srcp[q];
#pragma unroll
                    for (int j = 0; j < 4; ++j) { const float lo = __builtin_bit_cast(float, a[j] << 16), hh2 = __builtin_bit_cast(float, a[j] & 0xffff0000u); xv[q * 8 + 2 * j] = lo; xv[q * 8 + 2 * j + 1] = hh2; ss += lo * lo + hh2 * hh2; } }
                const float rs = (1.0f / sqrtf(ss * (1.f / 64.f) + 1e-6f)) * (isq ? C2 * 8.0f : 1.0f);
                const int sp = m & (SEQ - 1);
                unsigned wout[16];
#pragma unroll
                for (int half = 0; half < 2; ++half) { const int pos = half ? (sp & 63) : (sp >> 6);
                    const GAS f32x4* ct = (const GAS f32x4*)(TBL + TBL_COS + pos * 16); const GAS f32x4* st = (const GAS f32x4*)(TBL + TBL_SIN + pos * 16);
                    float ov[32];
#pragma unroll
                    for (int q = 0; q < 4; ++q) { const f32x4 cv = ct[q], sv = st[q];
#pragma unroll
                        for (int j = 0; j < 4; ++j) { const int i = q * 4 + j; const float a = xv[half * 32 + i] * rs * gn[half * 32 + i], b2 = xv[half * 32 + 16 + i] * rs * gn[half * 32 + 16 + i];
                            ov[i] = a * cv[j] - b2 * sv[j]; ov[16 + i] = b2 * cv[j] + a * sv[j]; } }
#pragma unroll
                    for (int q = 0; q < 8; ++q) { int d = __builtin_amdgcn_cvt_pk_fp8_f32(ov[4 * q], ov[4 * q + 1], 0, false); d = __builtin_amdgcn_cvt_pk_fp8_f32(ov[4 * q + 2], ov[4 * q + 3], d, true); wout[half * 8 + q] = (unsigned)d; } }
                if (!isq && ATTN_VER == 3) {
                    const int strm = (m >> 13) * 2 + (hh - 8); unsigned char* kb_ = ws + WS_K8T0 + ((((size_t)strm * 128 + (sp >> 6)) * 4) * 64 + (sp & 63)) * 16;
#pragma unroll
                    for (int q = 0; q < 4; ++q) *(GAS v4u*)(kb_ + q * 1024) = (v4u){wout[4 * q], wout[4 * q + 1], wout[4 * q + 2], wout[4 * q + 3]};
                } else {
                GAS v4u* dst = isq ? (GAS v4u*)(ws + WS_QR8 + (size_t)m * 512 + hh * 64) : (GAS v4u*)(ws + WS_KR8 + (size_t)m * 128 + (hh - 8) * 64);
#pragma unroll
                for (int q = 0; q < 4; ++q) dst[q] = (v4u){wout[4 * q], wout[4 * q + 1], wout[4 * q + 2], wout[4 * q + 3]};
                }
            }
            if (ATTN_VER == 3) {
                for (int it = bx * 512 + tid; it < 8 * 128 * 4 * 64; it += G * 512) { const int d = it & 63, c = (it >> 6) & 3, tt = (it >> 8) & 127, strm = it >> 15;
                    const bf16* vb_ = Z0 + ((size_t)(strm >> 1) * SEQ + tt * 64) * EV_IN + 640 + (strm & 1) * 64 + d; unsigned w4[4];
#pragma unroll
                    for (int q = 0; q < 4; ++q) { float f[4];
#pragma unroll
                        for (int j = 0; j < 4; ++j) { const int bb = q * 4 + j; const int key = 32 * (c & 1) + (bb & 3) + 8 * (bb >> 2) + 4 * (c >> 1); f[j] = bf2f(vb_[(size_t)key * EV_IN]); }
                        int dw = __builtin_amdgcn_cvt_pk_fp8_f32(f[0], f[1], 0, false); dw = __builtin_amdgcn_cvt_pk_fp8_f32(f[2], f[3], dw, true); w4[q] = (unsigned)dw; }
                    *(GAS v4u*)(ws + WS_V8T0 + (size_t)it * 16) = (v4u){w4[0], w4[1], w4[2], w4[3]}; }
            }
        } else {
        const float gq = args.in[5][lane], gk = args.in[6][lane];
        const int fi = lane & 15; const bool first = (lane & 16) == 0, isrow = lane < 32;
        for (int m = gw; m < NTOK; m += NGW) {
            const int s = m & (SEQ - 1); const int pos = isrow ? (s >> 6) : (s & 63);
            const float cs = TBL[TBL_COS + pos * 16 + fi], sn = TBL[TBL_SIN + pos * 16 + fi];
#pragma unroll
            for (int h = 0; h < 10; ++h) {
                const float xv = bf2f(Z0[(size_t)m * EV_IN + h * 64 + lane]);
                const float ss = wave_sum(xv * xv);
                const float y = xv * (1.0f / sqrtf(ss * (1.f / 64.f) + 1e-6f)) * (h < 8 ? gq : gk);
                const float p = __shfl_xor(y, 16);
                float o = first ? (y * cs - p * sn) : (y * cs + p * sn);
                if (!QK_FP8 || ATTN_VER != 1) { if (h < 8) QR[(size_t)m * 512 + h * 64 + lane] = (bf16)f2bf(o * C2);
                else KR[(size_t)m * 128 + (h - 8) * 64 + lane] = (bf16)f2bf(o); }
                if (QK_FP8) { const unsigned w = quad_pack_bytes(fp8_byte(h < 8 ? o * (C2 * 8.0f) : o));
                    if ((lane & 3) == 0) { if (h < 8) *(unsigned*)(ws + WS_QR8 + (size_t)m * 512 + h * 64 + lane) = w; else *(unsigned*)(ws + WS_KR8 + (size_t)m * 128 + (h - 8) * 64 + lane) = w; } }
            }
        }
        }
        LAS float* hbuf = (LAS float*)lds;
        for (int un = bx; un < NBATCH * 64 * 8; un += G) {
            const int grp = un & 7, tt = (un >> 3) & 63, b = un >> 9; const int t0 = tt * 128;
            __syncthreads();
            for (int idx = tid; idx < 158 * 8; idx += 512) { const int r = idx >> 3, c8 = idx & 7; const int s = t0 - 15 + r;
                f32x4 h0 = {0.f, 0.f, 0.f, 0.f}, h1 = h0;
                if (s >= 0 && s < SEQ) { const size_t ro = (size_t)(b * SEQ + s) * EV_IN + grp * 64 + c8 * 8;
                    const v4u av = *(const GAS v4u*)(Z0 + ro + 768), gv = *(const GAS v4u*)(Z0 + ro + 1280);
#pragma unroll
                    for (int j = 0; j < 4; ++j) { const float a0 = __builtin_bit_cast(float, av[j] << 16), a1 = __builtin_bit_cast(float, av[j] & 0xffff0000u);
                        const float g0 = __builtin_bit_cast(float, gv[j] << 16), g1 = __builtin_bit_cast(float, gv[j] & 0xffff0000u);
                        const float x0 = a0 * __builtin_amdgcn_rcpf(1.0f + __builtin_amdgcn_exp2f(-g0 * LOG2E)), x1 = a1 * __builtin_amdgcn_rcpf(1.0f + __builtin_amdgcn_exp2f(-g1 * LOG2E));
                        if (j < 2) { h0[2 * j] = x0; h0[2 * j + 1] = x1; } else { h1[2 * j - 4] = x0; h1[2 * j - 3] = x1; } } }
                *(LAS f32x4*)(hbuf + r * 64 + c8 * 8) = h0; *(LAS f32x4*)(hbuf + r * 64 + c8 * 8 + 4) = h1; }
            __syncthreads();
            const int ch = grp * 64 + lane;
            float wreg[31];
#pragma unroll
            for (int j = 0; j < 31; ++j) wreg[j] = args.in[7][j * 512 + ch];
            typedef float f32x2 __attribute__((ext_vector_type(2)));
            float acc[16]; const float cb = args.in[8][ch];
            {
                f32x2 he[23], ho[22];
#pragma unroll
                for (int k = 0; k < 23; ++k) { he[k].x = hbuf[(wave * 16 + 2 * k) * 64 + lane]; he[k].y = hbuf[(wave * 16 + 2 * k + 1) * 64 + lane]; }
#pragma unroll
                for (int k = 0; k < 22; ++k) { ho[k].x = he[k].y; ho[k].y = he[k + 1].x; }
                f32x2 a2[8];
#pragma unroll
                for (int p = 0; p < 8; ++p) a2[p] = (f32x2){cb, cb};
#pragma unroll
                for (int j = 0; j < 31; ++j) { const f32x2 wj = (f32x2){wreg[j], wreg[j]};
#pragma unroll
                    for (int p = 0; p < 8; ++p) { const int r = 2 * p + j; a2[p] = __builtin_elementwise_fma(wj, (r & 1) ? ho[r >> 1] : he[r >> 1], a2[p]); } }
#pragma unroll
                for (int p = 0; p < 8; ++p) { acc[2 * p] = a2[p].x; acc[2 * p + 1] = a2[p].y; }
            }
            const float gg = args.in[9][ch], gb = args.in[10][ch];
#pragma unroll
            for (int i = 0; i < 16; ++i) { const float mu = wave_sum(acc[i]) * (1.f / 64.f); const float d = acc[i] - mu; const float var = wave_sum(d * d) * (1.f / 64.f);
                const float hn = d * (1.0f / sqrtf(var + 1e-5f)) * gg + gb; const float ov = hn * __builtin_amdgcn_rcpf(1.0f + __builtin_amdgcn_exp2f(-hn * LOG2E));
                Y[(size_t)(b * SEQ + t0 + wave * 16 + i) * DM + 512 + ch] = (bf16)f2bf(ov); }
        }
    }
    SEAM(2);
    if (IN(3)) REP(3) {
        const bf16* QR = (const bf16*)(ws + WS_QR); const bf16* KR = (const bf16*)(ws + WS_KR); const bf16* Z0 = (const bf16*)(ws + WS_Z0);
        if (ATTN_L0_TEST) {
        for (int un = bx; un < NBATCH * 8 * 32; un += G) {
            const int qb = un & 31, h = (un >> 5) & 7, b = un >> 8, kvh = h >> 2;
            const size_t row0 = (size_t)b * SEQ + qb * 256;
            attn_unit_v0<64, false, true>((const bf16*)(ws + WS_QR8 + row0 * 512 + h * 64), 512, (const bf16*)(ws + WS_KR8 + (size_t)b * SEQ * 128 + kvh * 64), 128, Z0 + (size_t)b * SEQ * EV_IN + 640 + kvh * 64, EV_IN,
                                   Y + row0 * DM + h * 64, DM, nullptr, qb * 256, lds);
        }
        } else if (ATTN_VER == 0) {
        for (int un = bx; un < NBATCH * 8 * 32; un += G) {
            const int qb = un & 31, h = (un >> 5) & 7, b = un >> 8, kvh = h >> 2;
            const size_t row0 = (size_t)b * SEQ + qb * 256;
            attn_unit_v0<64, false>(QR + row0 * 512 + h * 64, 512, KR + (size_t)b * SEQ * 128 + kvh * 64, 128, Z0 + (size_t)b * SEQ * EV_IN + 640 + kvh * 64, EV_IN,
                                   Y + row0 * DM + h * 64, DM, nullptr, qb * 256, lds);
        }
        } else {
        constexpr int U = NBATCH * 8 * 32; const int upc = (U + G - 1) / G; const int vcu = (G % 8 == 0) ? (bx % 8) * (G / 8) + bx / 8 : bx;
        for (int i = 0; i < upc; ++i) { const int un = vcu * upc + i; if (un >= U) break;
            const int stream = un >> 7, b = stream >> 1, kvh = stream & 1, h = kvh * 4 + ((un >> 5) & 3), qb = un & 31;
            const size_t row0 = (size_t)b * SEQ + qb * 256;
            if (ATTN_VER == 3) at3::attn_unit<64, false, 0>(ws + WS_QR8 + row0 * 512 + h * 64, 512, ws + WS_K8T0 + (size_t)stream * 128 * 4096, ws + WS_V8T0 + (size_t)stream * 128 * 4096, Y + row0 * DM + h * 64, DM, qb * 256, lds, nullptr);
            else if (QK_FP8) at1::attn_unit<64, false, 0, 0, true>((const bf16*)(ws + WS_QR8 + row0 * 512 + h * 64), 512, (const bf16*)(ws + WS_KR8 + (size_t)b * SEQ * 128 + kvh * 64), 128, Z0 + (size_t)b * SEQ * EV_IN + 640 + kvh * 64, EV_IN,
                                      Y + row0 * DM + h * 64, DM, qb * 256, lds);
            else at1::attn_unit<64, false>(QR + row0 * 512 + h * 64, 512, KR + (size_t)b * SEQ * 128 + kvh * 64, 128, Z0 + (size_t)b * SEQ * EV_IN + 640 + kvh * 64, EV_IN,
                                      Y + row0 * DM + h * 64, DM, qb * 256, lds);
        }
        }
    }
    SEAM(3);
    if (IN(4)) REP(4) {
        pg8::Gemm g{Y, (const bf16*)(ws + WS_WOUT0), NTOK, DM, DM}; pg8::StaticOrder S; S.init(NTOK, DM, G, bx);
        pg8::EpiRes E{x_in, xres, DM};
        pg8::gemm_phase<pg8::EpiRes, pg8::StaticOrder, true>(lds, g, S, E);
    }
    SEAM(4);

    moe_block<0>(args, lds, bar, lo, hi_ph);
    SEAM(8);
            if (IN(9)) REP(9) {
                pg8::Gemm g{HB, (const bf16*)(ws + WS_WIN1), NTOK, OD_IN, DM}; pg8::StaticOrder S; S.init(NTOK, OD_IN, G, bx);
                if (QK_FP8) { pg8::EpiQKV8 E{ws + WS_Q1, ws + WS_K8T1, (bf16*)(ws + WS_V1), C2 * 8.0f, true};
                    pg8::gemm_phase<pg8::EpiQKV8, pg8::StaticOrder, true>(lds, g, S, E); }
                else { pg8::EpiBf16 E{(bf16*)(ws + WS_Q1), DM, DM, (size_t)(WS_K1 - WS_Q1) / 2, C2, 0xffff};
                pg8::gemm_phase<pg8::EpiBf16, pg8::StaticOrder, true>(lds, g, S, E); }
            }
            SEAM(9);
            if (ATTN_L1_VER == 3) {
            if (IN(10)) {
                const bf16* V1 = (const bf16*)(ws + WS_V1);
                for (int it = bx * 512 + tid; it < 32 * 128 * 4 * 128; it += G * 512) { const int d = it & 127, c = (it >> 7) & 3, tt = (it >> 9) & 127, bh = it >> 16;
                    const bf16* vb_ = V1 + ((size_t)(bh >> 3) * SEQ + tt * 64) * DM + (bh & 7) * 128 + d; unsigned w4[4];
#pragma unroll
                    for (int q = 0; q < 4; ++q) { float f[4];
#pragma unroll
                        for (int j = 0; j < 4; ++j) { const int bb = q * 4 + j; const int key = 32 * (c & 1) + (bb & 3) + 8 * (bb >> 2) + 4 * (c >> 1); f[j] = bf2f(vb_[(size_t)key * DM]); }
                        int dw = __builtin_amdgcn_cvt_pk_fp8_f32(f[0], f[1], 0, false); dw = __builtin_amdgcn_cvt_pk_fp8_f32(f[2], f[3], dw, true); w4[q] = (unsigned)dw; }
                    *(GAS v4u*)(ws + WS_V8T1 + (size_t)it * 16) = (v4u){w4[0], w4[1], w4[2], w4[3]}; }
            }
            SEAM(10);
            if (IN(11)) REP(11) {
                constexpr int UP = NBATCH * 8 * 32; const int upc = (UP + G - 1) / G; const int vcu = (G % 8 == 0) ? (bx % 8) * (G / 8) + bx / 8 : bx;
                LAS float* btbl = (LAS float*)(lds + at3::lds_tbl_off<128>());
                LAS float* sgt = btbl + 272;
                __syncthreads();
                if (tid < 128) sgt[tid] = args.in[17][tid] * (1.0f - LAM_INIT);
                if (wave == 7) { const float lam = __expf(wave_sum(args.in[13][lane] * args.in[14][lane])) - __expf(wave_sum(args.in[15][lane] * args.in[16][lane])) + LAM_INIT; if (lane == 0) sgt[128] = lam; }
                for (int i = 0; i < upc; ++i) {
                    int up = vcu * upc + i; if (up >= UP) break;
                    if (G == 256) up = ((vcu >> 5) * 4 + i) * 32 + (vcu & 31);
                    const int qb = up & 31, h = (up >> 5) & 7, b = up >> 8;
                    __syncthreads();
                    if (tid < 257) btbl[tid] = TBL[TBL_BIAS + h * BIAS_STRIDE + tid] - TBL[TBL_BIAS + h * BIAS_STRIDE + 256];
                    __syncthreads();
                    const size_t row0 = (size_t)b * SEQ + qb * 256; const int bh = b * 8 + h;
                    const unsigned char* Q8 = ws + WS_Q1 + row0 * DM + h * 128; const unsigned char* V8 = ws + WS_V8T1 + (size_t)bh * 128 * 8192;
                    at3::attn_unit<128, true, 1>(Q8, DM, ws + WS_K8T1 + (size_t)(bh * 2) * 128 * 4096, V8, nullptr, DM, qb * 256, lds, sgt);
                    at3::attn_unit<128, true, 2>(Q8 + 64, DM, ws + WS_K8T1 + (size_t)(bh * 2 + 1) * 128 * 4096, V8, Y + row0 * DM + h * 128, DM, qb * 256, lds, sgt);
                }
            }
            SEAM(11);
            } else {
            if (IN(10)) REP(10) {
                const bf16* Q1 = (const bf16*)(ws + WS_Q1); const bf16* K1 = (const bf16*)(ws + WS_K1); const bf16* V1 = (const bf16*)(ws + WS_V1);
                if (ATTN_L1_VER == 0) {
                LAS float* btbl = (LAS float*)(lds + 65536);
                for (int un = bx; un < NBATCH * 8 * 2 * 32; un += G) {
                    const int qb = un & 31, c = (un >> 5) & 1, h = (un >> 6) & 7, b = un >> 9;
                    __syncthreads();
                    if (tid < 257) btbl[tid] = TBL[TBL_BIAS + h * BIAS_STRIDE + tid];
                    __syncthreads();
                    const size_t row0 = (size_t)b * SEQ + qb * 256, brow = (size_t)b * SEQ;
                    bf16* OC = (bf16*)(ws + (c ? WS_OC1 : WS_OC0));
                    attn_unit_v0<128, true>(Q1 + row0 * DM + h * 128 + c * 64, DM, K1 + brow * DM + h * 128 + c * 64, DM, V1 + brow * DM + h * 128, DM,
                                           OC + row0 * DM + h * 128, DM, btbl, qb * 256, lds);
                }
                } else {
                constexpr int UP = NBATCH * 8 * 32; const int upc = (UP + G - 1) / G; const int vcu = (G % 8 == 0) ? (bx % 8) * (G / 8) + bx / 8 : bx;
                LAS float* btbl = (LAS float*)(lds + at1::lds_tbl_off<128, QK_FP8 != 0>());
                LAS float* sgt = btbl + 272;
                __syncthreads();
                if (tid < 128) sgt[tid] = args.in[17][tid] * (1.0f - LAM_INIT);
                if (wave == 7) { const float lam = __expf(wave_sum(args.in[13][lane] * args.in[14][lane])) - __expf(wave_sum(args.in[15][lane] * args.in[16][lane])) + LAM_INIT; if (lane == 0) sgt[128] = lam; }
                for (int i = 0; i < upc; ++i) {
                    int up = vcu * upc + i; if (up >= UP) break;
                    if (G == 256) up = ((vcu >> 5) * 4 + i) * 32 + (vcu & 31);
                    const int qb = up & 31, h = (up >> 5) & 7, b = up >> 8;
                    __syncthreads();
                    if (tid < 257) btbl[tid] = TBL[TBL_BIAS + h * BIAS_STRIDE + tid] - TBL[TBL_BIAS + h * BIAS_STRIDE + 256];
                    __syncthreads();
                    const size_t row0 = (size_t)b * SEQ + qb * 256, brow = (size_t)b * SEQ;
                    if (QK_FP8) { const unsigned char* Q8 = ws + WS_Q1; const unsigned char* K8 = ws + WS_K1;
                    const int bh = b * 8 + h; const bf16* VT = V1 + (size_t)bh * 128 * 8192; const unsigned char* KT0 = ws + WS_K8T1 + (size_t)(bh * 2) * 128 * 4096; (void)K8; (void)brow;
                    at1::attn_unit<128, true, 0, 1, true, true>((const bf16*)(Q8 + row0 * DM + h * 128), DM, (const bf16*)KT0, DM, VT, DM, nullptr, DM, qb * 256, lds, sgt);
                    at1::attn_unit<128, true, 0, 2, true, true>((const bf16*)(Q8 + row0 * DM + h * 128 + 64), DM, (const bf16*)(KT0 + 128 * 4096), DM, VT, DM, Y + row0 * DM + h * 128, DM, qb * 256, lds, sgt);
                    } else {
                    at1::attn_unit<128, true, 0, 1>(Q1 + row0 * DM + h * 128, DM, K1 + brow * DM + h * 128, DM, V1 + brow * DM + h * 128, DM, nullptr, DM, qb * 256, lds, sgt);
                    at1::attn_unit<128, true, 0, 2>(Q1 + row0 * DM + h * 128 + 64, DM, K1 + brow * DM + h * 128 + 64, DM, V1 + brow * DM + h * 128, DM, Y + row0 * DM + h * 128, DM, qb * 256, lds, sgt);
                    }
                }
                }
            }
            SEAM(10);
            if (PROBE_ATT >= 0 && IN(10)) {
                const bf16* Q1 = (const bf16*)(ws + WS_Q1); const bf16* K1 = (const bf16*)(ws + WS_K1); const bf16* V1 = (const bf16*)(ws + WS_V1);
                constexpr int U = NBATCH * 8 * 2 * 32; const int upc = (U + G - 1) / G; const int vcu = (G % 8 == 0) ? (bx % 8) * (G / 8) + bx / 8 : bx;
                LAS float* btbl = (LAS float*)(lds + 3 * 8192 + 3 * 16384 + 2048);
                for (int i = 0; i < upc; ++i) {
                    int un = vcu * upc + i; if (un >= U) break;
                    if (G == 256) un = ((vcu >> 5) * 4 + (i >> 1)) * 64 + (i & 1) * 32 + (vcu & 31);
                    const int qb = un & 31, c = (un >> 5) & 1, h = (un >> 6) & 7, b = un >> 9;
                    if (tid < 257) btbl[tid] = TBL[TBL_BIAS + h * BIAS_STRIDE + tid] - TBL[TBL_BIAS + h * BIAS_STRIDE + 256];
                    __syncthreads();
                    const size_t row0 = (size_t)b * SEQ + qb * 256, brow = (size_t)b * SEQ;
                    at1::attn_unit<128, true, (PROBE_ATT >= 0 ? PROBE_ATT : 0)>(Q1 + row0 * DM + h * 128 + c * 64, DM, K1 + brow * DM + h * 128 + c * 64, DM, V1 + brow * DM + h * 128, DM,
                                              (bf16*)(ws + WS_OC1) + row0 * DM + h * 128, DM, qb * 256, lds);
                }
                xcd_barrier(bar);
            }
            if (IN(11) && ATTN_L1_VER != 1) REP(11) {
                const bf16* OC0 = (const bf16*)(ws + WS_OC0); const bf16* OC1 = (const bf16*)(ws + WS_OC1);
                const float lam = __expf(wave_sum(args.in[13][lane] * args.in[14][lane])) - __expf(wave_sum(args.in[15][lane] * args.in[16][lane])) + LAM_INIT;
                float sg[16];
#pragma unroll
                for (int j = 0; j < 16; ++j) sg[j] = args.in[17][(lane & 7) * 16 + j] * (1.0f - LAM_INIT);
                for (int m = gw; m < NTOK; m += NGW) {
                    const GAS v4u* a = (const GAS v4u*)(OC0 + (size_t)m * DM) + lane * 2; const GAS v4u* c = (const GAS v4u*)(OC1 + (size_t)m * DM) + lane * 2;
                    float o[16]; float ss = 0.f;
#pragma unroll
                    for (int q = 0; q < 2; ++q) { const v4u av = a[q], cv = c[q];
#pragma unroll
                        for (int j = 0; j < 4; ++j) { const unsigned au = av[j], cu = cv[j];
                            const float lo = __builtin_bit_cast(float, au << 16) - lam * __builtin_bit_cast(float, cu << 16);
                            const float hh = __builtin_bit_cast(float, au & 0xffff0000u) - lam * __builtin_bit_cast(float, cu & 0xffff0000u);
                            o[q * 8 + 2 * j] = lo; o[q * 8 + 2 * j + 1] = hh; ss += lo * lo + hh * hh; } }
                    ss += __shfl_xor(ss, 1); ss += __shfl_xor(ss, 2); ss += __shfl_xor(ss, 4);
                    const float rstd = 1.0f / sqrtf(ss * (1.f / 128.f) + 1e-5f);
                    v4u w0, w1;
                    w0.x = pk2(o[0] * rstd * sg[0], o[1] * rstd * sg[1]); w0.y = pk2(o[2] * rstd * sg[2], o[3] * rstd * sg[3]); w0.z = pk2(o[4] * rstd * sg[4], o[5] * rstd * sg[5]); w0.w = pk2(o[6] * rstd * sg[6], o[7] * rstd * sg[7]);
                    w1.x = pk2(o[8] * rstd * sg[8], o[9] * rstd * sg[9]); w1.y = pk2(o[10] * rstd * sg[10], o[11] * rstd * sg[11]); w1.z = pk2(o[12] * rstd * sg[12], o[13] * rstd * sg[13]); w1.w = pk2(o[14] * rstd * sg[14], o[15] * rstd * sg[15]);
                    GAS v4u* yo = (GAS v4u*)(Y + (size_t)m * DM) + lane * 2; yo[0] = w0; yo[1] = w1;
                }
            }
            if (ATTN_L1_VER != 1) SEAM(11);
            }
            if (IN(12)) {
                pg8::Gemm g{Y, (const bf16*)(ws + WS_WOUT1), NTOK, DM, DM}; pg8::StaticOrder S; S.init(NTOK, DM, G, bx);
                pg8::EpiRes E{xres, xres, DM};
                pg8::gemm_phase<pg8::EpiRes, pg8::StaticOrder, true>(lds, g, S, E);
            }
            SEAM(12);
    moe_block<1>(args, lds, bar, lo, hi_ph);
#undef IN
#undef SEAM
}

extern "C" void kernel_launch(void* const* d_in, const int* in_sizes, int n_in, void* d_out, int out_size, void* d_ws, size_t ws_size, hipStream_t stream) {
    static int grid = 0;
    if (grid == 0) {
        if (n_in != 27 || in_sizes[0] != NTOK * DM || out_size != NTOK * DM || ws_size < WS_END) { fprintf(stderr, "kernel_launch: unexpected shapes / workspace (n_in %d, ws %zu)\n", n_in, ws_size); grid = -1; return; }
        int dev = 0, cus = 0, per_cu = 0;
        if (hipGetDevice(&dev) != hipSuccess || hipDeviceGetAttribute(&cus, hipDeviceAttributeMultiprocessorCount, dev) != hipSuccess) { grid = -1; return; }
        if (hipFuncSetAttribute((const void*)mk_fwd, hipFuncAttributeMaxDynamicSharedMemorySize, LDS_BYTES) != hipSuccess) { fprintf(stderr, "kernel_launch: hipFuncSetAttribute failed\n"); grid = -1; return; }
        if (hipOccupancyMaxActiveBlocksPerMultiprocessor(&per_cu, (const void*)mk_fwd, NWAVES * 64, LDS_BYTES) != hipSuccess || per_cu < 1) { fprintf(stderr, "kernel_launch: occupancy query says %d\n", per_cu); }
        (void)hipGetLastError();
        grid = cus;
    }
    if (grid < 0) return;
    if (hipMemsetAsync((char*)d_ws + WS_CTL, 0, CTL_ZERO_BYTES, stream) != hipSuccess) return;
    Args a{};
    for (int i = 0; i < 27; ++i) a.in[i] = (const float*)d_in[i];
    a.out = (float*)d_out; a.ws = (unsigned char*)d_ws;
    if (MK_N_LAUNCHES == 1) { a.ph_lo = 0; a.ph_hi = NPHASE; a.li = 0; hipLaunchKernelGGL(mk_fwd, dim3(grid), dim3(NWAVES * 64), LDS_BYTES, stream, a); }
    else { for (int p = 0; p < NPHASE; ++p) for (int r = 0; r < (int)((PROBE_MASK >> p) & 1u) + 1; ++r) { a.ph_lo = p; a.ph_hi = p + 1; a.li = p; hipLaunchKernelGGL(mk_fwd, dim3(grid), dim3(NWAVES * 64), LDS_BYTES, stream, a); } }
}
```

```cpp
#include <hip/hip_runtime.h>
#include <cstdio>
#include <cstdint>

#ifndef MK_N_LAUNCHES
#define MK_N_LAUNCHES 1
#endif

#ifndef ATTN_VER
#define ATTN_VER 3
#endif
#ifndef PROBE_ATT
#define PROBE_ATT -1
#endif
#ifndef QK_FP8
#define QK_FP8 1
#endif
#ifndef ATTN_L0_TEST
#define ATTN_L0_TEST 0
#endif
#ifndef ATTN_L1_VER
#define ATTN_L1_VER 1
#endif
#ifndef PROBE_MASK
#define PROBE_MASK 0u
#endif
#define REP(k) _Pragma("unroll") for (int rep_ = 0; rep_ < (MK_N_LAUNCHES == 1 ? (int)((PROBE_MASK >> (k)) & 1u) : 0) + 1; ++rep_)
#define GAS __attribute__((address_space(1)))
#define LAS __attribute__((address_space(3)))
typedef unsigned short bf16;
typedef unsigned v4u __attribute__((ext_vector_type(4)));
typedef unsigned v2u __attribute__((ext_vector_type(2)));
typedef float f32x4 __attribute__((ext_vector_type(4)));
typedef float f32x16 __attribute__((ext_vector_type(16)));
typedef short bf16x8 __attribute__((ext_vector_type(8)));
typedef short s16x4 __attribute__((ext_vector_type(4)));

constexpr int NTOK = 32768, DM = 1024, SEQ = 8192, NBATCH = 4;
constexpr int EV_IN = 1792, OD_IN = 3072;
constexpr int NEXP = 32, MOE_H = 512, LIST_CAP = 32768;
constexpr float C2 = 0.125f * 1.4426950408889634f;
constexpr float LOG2E = 1.4426950408889634f;
constexpr float LAM_INIT = 0.35550906759f;

constexpr size_t MiB = 1u << 20;
constexpr size_t WS_CTL = 0, CTL_ZERO_BYTES = 1 * MiB;
constexpr size_t WS_WIN0 = 1 * MiB, WS_WOUT0 = 5 * MiB, WS_WIN1 = 7 * MiB, WS_WOUT1 = 13 * MiB, WS_TBL = 15 * MiB;
constexpr size_t WS_W13 = 16 * MiB, WS_W2 = 80 * MiB;
constexpr size_t WS_HB = 112 * MiB;
constexpr size_t WS_Y = 176 * MiB;
constexpr size_t WS_Z0 = 240 * MiB, WS_QR = 352 * MiB, WS_KR = 384 * MiB, WS_QR8 = 392 * MiB, WS_KR8 = 408 * MiB, WS_K8T0 = 408 * MiB, WS_V8T0 = 412 * MiB;
constexpr size_t WS_K8T1 = 304 * MiB, WS_V8T1 = 336 * MiB;
constexpr size_t WS_Q1 = 240 * MiB, WS_K1 = 304 * MiB, WS_V1 = 368 * MiB, WS_OC1 = 432 * MiB, WS_OC0 = WS_HB;
constexpr size_t WS_H = 176 * MiB, WS_YS = 248 * MiB, WS_LIST = 392 * MiB, WS_TOKEP = 396 * MiB, WS_GATE = 396 * MiB + 512 * 1024;
constexpr size_t WS_END = 496 * MiB;
constexpr int TBL_COS = 0, TBL_SIN = 2048, TBL_BIAS = 4096, BIAS_STRIDE = 272;
constexpr int TBL_WR = 32768, WR_LAYER = 1024 * 48 + 64;
constexpr int CW_BAR = 4096;
constexpr int CW_CNT = 16384;

constexpr int RING_BYTES = 131072;
constexpr int LDS_BYTES = 147456;
constexpr int LDSCTL_OFF = LDS_BYTES - 1024;
constexpr int STASH_OFF = 78 * 1024;
constexpr int LC_BAR = 8;
constexpr int LC_TP = 16;
constexpr int LC_CNT = 64;
constexpr int LC_LCNT = 96;
constexpr int LC_LBASE = 128;
constexpr int LC_LP = 160;

#define LDS_WAIT() asm volatile("s_waitcnt lgkmcnt(0)" ::: "memory")
#define VM_WAIT() asm volatile("s_waitcnt vmcnt(0)" ::: "memory")
#define RLX_AGENT __ATOMIC_RELAXED, __HIP_MEMORY_SCOPE_AGENT

__device__ __forceinline__ unsigned f2bf(float f) { unsigned u = __builtin_bit_cast(unsigned, f); return (u + 0x7fffu + ((u >> 16) & 1u)) >> 16; }
__device__ __forceinline__ unsigned pk2(float lo, float hi) { return f2bf(lo) | (f2bf(hi) << 16); }
__device__ __forceinline__ float bf2f(unsigned short b) { return __builtin_bit_cast(float, (unsigned)b << 16); }
template <int CTRL> __device__ __forceinline__ float dpp_mov(float v) { return __builtin_bit_cast(float, __builtin_amdgcn_update_dpp(0, __builtin_bit_cast(int, v), CTRL, 0xf, 0xf, true)); }
__device__ __forceinline__ float wave_sum(float v) {
    v += dpp_mov<0xB1>(v); v += dpp_mov<0x4E>(v); v += dpp_mov<0x141>(v); v += dpp_mov<0x140>(v);
    { auto rr = __builtin_amdgcn_permlane16_swap(__float_as_uint(v), __float_as_uint(v), false, false); v = __uint_as_float(rr[0]) + __uint_as_float(rr[1]); }
    { auto rr = __builtin_amdgcn_permlane32_swap(__float_as_uint(v), __float_as_uint(v), false, false); v = __uint_as_float(rr[0]) + __uint_as_float(rr[1]); }
    return v;
}


typedef int v8i __attribute__((ext_vector_type(8)));
__device__ __forceinline__ unsigned fp8_byte(float v) { return (unsigned)__builtin_amdgcn_cvt_pk_fp8_f32(v, v, 0, false) & 0xffu; }
__device__ __forceinline__ unsigned quad_pack_bytes(unsigned b) {
    const unsigned x0 = (unsigned)__builtin_amdgcn_update_dpp(0, (int)b, 0x00, 0xf, 0xf, true), x1 = (unsigned)__builtin_amdgcn_update_dpp(0, (int)b, 0x55, 0xf, 0xf, true);
    const unsigned x2 = (unsigned)__builtin_amdgcn_update_dpp(0, (int)b, 0xAA, 0xf, 0xf, true), x3 = (unsigned)__builtin_amdgcn_update_dpp(0, (int)b, 0xFF, 0xf, 0xf, true);
    return x0 | (x1 << 8) | (x2 << 16) | (x3 << 24);
}
namespace pg8 {
#define PG8_LAS __attribute__((address_space(3)))
typedef unsigned short bf16_t;
typedef short bf16x8 __attribute__((ext_vector_type(8)));
typedef float f32x4 __attribute__((ext_vector_type(4)));
typedef unsigned u32x4 __attribute__((ext_vector_type(4)));
constexpr int BM = 256, BK = 64, HALF = 128, HTB = HALF * BK * 2, STAGE_BYTES = 8 * HTB, NXCD = 8, WGM = 8;

__host__ __device__ __forceinline__ int lds_byte(int r, int c) { const int st = (r >> 4) * 2 + (c >> 5), rr = r & 15, cc = c & 31, ob = rr * 64 + cc * 2; return st * 1024 + (ob ^ (((ob >> 9) & 1) << 5)); }
__host__ __device__ __forceinline__ void stage_rc(int b, int& R, int& C) { const int st = b / 1024, sb = b % 1024, swz = sb ^ (((sb >> 9) & 1) << 5); R = (st >> 1) * 16 + swz / 64; C = (st & 1) * 32 + (swz % 64) / 2; }
__host__ __device__ __forceinline__ int perm32(int rho) { const int n = rho >> 4, i = rho & 15; return 8 * (i >> 2) + 4 * n + (i & 3); }

struct Unit { int pm, pn, e, rb; };
struct Gemm { const bf16_t* A; const bf16_t* Bt; int M, N, K; };

struct StaticOrder {
    int nM, nN, nwg, G, c;
    __device__ void init(int M, int N, int G_, int c_) { nM = M / BM; nN = N / BM; nwg = nM * nN; G = G_; c = c_; }
    __device__ bool next(int i, Unit& u) const {
        const long L = (long)i * G + c; if (L >= nwg) return false;
        int wgid = (int)L; { const int q = nwg / NXCD, r = nwg % NXCD, xcd = wgid % NXCD, off = wgid / NXCD; wgid = (xcd < r ? xcd * (q + 1) : r * (q + 1) + (xcd - r) * q) + off; }
        const int nig = WGM * nN, gid = wgid / nig, fm = gid * WGM, gsz = (nM - fm) < WGM ? (nM - fm) : WGM;
        u.pm = fm + ((wgid % nig) % gsz); u.pn = (wgid % nig) / gsz; u.e = 0; u.rb = 0; return true;
    }
    __device__ __forceinline__ unsigned arow(const Unit& u, int rr) const { return (unsigned)(u.pm * BM + rr); }
};

struct MoeOrder {
    const PG8_LAS int* tp; const PG8_LAS int* cn; const PG8_LAS int* lp; const int* list; int G, c, nunits; bool gather; bool xcd;
    __device__ __forceinline__ bool next(int i, Unit& u) const {
        int e_, rb_, pm_, pnl_; bool ok;
        if (xcd) {
            const int x = c & 7, y = c >> 3; const int uidx = i * 32 + y; ok = uidx < lp[4] * 4;
            const int rbl = uidx >> 2; pnl_ = uidx & 3; int j = 0;
#pragma unroll
            for (int q = 1; q < 4; ++q) j += (lp[q] <= rbl) ? 1 : 0;
            e_ = x + 8 * j; rb_ = rbl - lp[j]; pm_ = tp[e_] + rb_;
        } else {
            const int L = i * G + c; ok = L < nunits;
            const int rbg = L >> 2; pnl_ = L & 3; int e = 0;
#pragma unroll
            for (int j = 1; j < 32; ++j) e += (tp[j] <= rbg) ? 1 : 0;
            e_ = e; pm_ = rbg; rb_ = rbg - tp[e];
        }
        u.e = __builtin_amdgcn_readfirstlane(e_); u.rb = __builtin_amdgcn_readfirstlane(rb_); u.pm = __builtin_amdgcn_readfirstlane(pm_); u.pn = __builtin_amdgcn_readfirstlane(e_ * 4 + pnl_);
        return ok;
    }
    __device__ __forceinline__ unsigned arow(const Unit& u, int rr) const {
        if (!gather) return (unsigned)(u.pm * BM + rr);
        const int idx = u.rb * BM + rr; unsigned t = 0u;
        if (idx < cn[u.e]) t = (unsigned)list[(size_t)u.e * 32768 + idx];
        return t;
    }
};

__device__ __forceinline__ unsigned cvt_pk_bf16(float lo, float hi) { unsigned r; asm volatile("v_cvt_pk_bf16_f32 %0, %1, %2" : "=v"(r) : "v"(lo), "v"(hi)); return r; }

struct EpiBf16 {
    static constexpr bool PERM = true;
    bf16_t* O; int ldc; int split_cols; size_t split_stride; float scale0; int pn_mask;
    __device__ __forceinline__ void operator()(const f32x4 (&acc)[2][2][4][2], const Unit& u, int wr, int wc, int fr, int fq) const {
        const int row0 = u.pm * BM + wr * 64 + fr; int colt = (u.pn & pn_mask) * BM; bf16_t* base = O;
        float sc = 1.f; if (split_cols) { const int t = colt / split_cols; base += (size_t)t * split_stride; colt -= t * split_cols; if (t == 0) sc = scale0; }
        const int col0 = colt + wc * 32 + 8 * fq;
#pragma unroll
        for (int ai = 0; ai < 2; ++ai)
#pragma unroll
            for (int m = 0; m < 4; ++m) { bf16_t* rowp = base + (size_t)(row0 + ai * HALF + m * 16) * ldc + col0;
#pragma unroll
                for (int bj = 0; bj < 2; ++bj) { f32x4 v0 = acc[ai][bj][m][0] * sc, v1 = acc[ai][bj][m][1] * sc;
                    u32x4 w; w.x = cvt_pk_bf16(v0[0], v0[1]); w.y = cvt_pk_bf16(v0[2], v0[3]); w.z = cvt_pk_bf16(v1[0], v1[1]); w.w = cvt_pk_bf16(v1[2], v1[3]);
                    *(u32x4*)(rowp + bj * HALF) = w; } }
    }
};
struct EpiRes {
    static constexpr bool PERM = false;
    const float* base; float* out; int ldc;
    __device__ __forceinline__ void operator()(const f32x4 (&acc)[2][2][4][2], const Unit& u, int wr, int wc, int fr, int fq) const {
        const int row0 = u.pm * BM + wr * 64 + fr, col0 = u.pn * BM + wc * 32 + 4 * fq;
#pragma unroll
        for (int ai = 0; ai < 2; ++ai)
#pragma unroll
            for (int m = 0; m < 4; ++m) { const size_t off = (size_t)(row0 + ai * HALF + m * 16) * ldc + col0;
#pragma unroll
                for (int bj = 0; bj < 2; ++bj)
#pragma unroll
                    for (int n = 0; n < 2; ++n) { const f32x4 bs = *(const f32x4*)(base + off + bj * HALF + n * 16); *(f32x4*)(out + off + bj * HALF + n * 16) = bs + acc[ai][bj][m][n]; } }
    }
};
struct EpiQKV8 {
    static constexpr bool PERM = true;
    unsigned char* Q8; unsigned char* K8; bf16_t* V; float qscale; bool ktiled;
    __device__ __forceinline__ void operator()(const f32x4 (&acc)[2][2][4][2], const Unit& u, int wr, int wc, int fr, int fq) const {
        const int row0 = u.pm * BM + wr * 64 + fr; const int colt = u.pn * BM; const int t = colt >> 10; const int col0 = (colt & 1023) + wc * 32 + 8 * fq;
        const float sc = t == 0 ? qscale : 1.0f;
#pragma unroll
        for (int ai = 0; ai < 2; ++ai)
#pragma unroll
            for (int m = 0; m < 4; ++m) { const size_t ro = (size_t)(row0 + ai * HALF + m * 16) * 1024 + col0;
#pragma unroll
                for (int bj = 0; bj < 2; ++bj) { const f32x4 v0 = acc[ai][bj][m][0] * sc, v1 = acc[ai][bj][m][1] * sc;
                    if (t == 2) { u32x4 w; w.x = cvt_pk_bf16(v0[0], v0[1]); w.y = cvt_pk_bf16(v0[2], v0[3]); w.z = cvt_pk_bf16(v1[0], v1[1]); w.w = cvt_pk_bf16(v1[2], v1[3]);
                        if (ktiled) { const int mrow = row0 + ai * HALF + m * 16, n = col0 + bj * HALF; const int bh = (mrow >> 13) * 8 + (n >> 7), sq = mrow & 8191, d = n & 127;
                            *(u32x4*)(V + (((size_t)bh * 128 + (sq >> 6)) * 4 + (d >> 5)) * 2048 + (sq & 63) * 32 + (d & 31)) = w; }
                        else *(u32x4*)(V + ro + bj * HALF) = w; }
                    else { int d0 = __builtin_amdgcn_cvt_pk_fp8_f32(v0[0], v0[1], 0, false); d0 = __builtin_amdgcn_cvt_pk_fp8_f32(v0[2], v0[3], d0, true);
                        int d1 = __builtin_amdgcn_cvt_pk_fp8_f32(v1[0], v1[1], 0, false); d1 = __builtin_amdgcn_cvt_pk_fp8_f32(v1[2], v1[3], d1, true);
                        typedef int i32x2 __attribute__((ext_vector_type(2)));
                        if (t == 1 && ktiled) { const int mrow = row0 + ai * HALF + m * 16, n = col0 + bj * HALF; const int strm = ((mrow >> 13) * 8 + (n >> 7)) * 2 + ((n >> 6) & 1), sq = mrow & 8191, dd = n & 63;
                            *(i32x2*)(K8 + ((((size_t)strm * 128 + (sq >> 6)) * 4 + (dd >> 4)) * 64 + (sq & 63)) * 16 + (dd & 15)) = (i32x2){d0, d1}; }
                        else *(i32x2*)((t == 0 ? Q8 : K8) + ro + bj * HALF) = (i32x2){d0, d1}; } } }
    }
};
__device__ __forceinline__ float silu_mul(float a, float b) { return a * b * __builtin_amdgcn_rcpf(1.0f + __builtin_amdgcn_exp2f(-a * 1.4426950408889634f)); }
struct EpiSwiglu {
    static constexpr bool PERM = true;
    bf16_t* O;
    __device__ __forceinline__ void operator()(const f32x4 (&acc)[2][2][4][2], const Unit& u, int wr, int wc, int fr, int fq) const {
        const int row0 = u.pm * BM + wr * 64 + fr, col0 = (u.pn & 3) * 128 + wc * 32 + 8 * fq;
#pragma unroll
        for (int ai = 0; ai < 2; ++ai)
#pragma unroll
            for (int m = 0; m < 4; ++m) { bf16_t* rowp = O + (size_t)(row0 + ai * HALF + m * 16) * 512 + col0;
                const f32x4 a0 = acc[ai][0][m][0], a1 = acc[ai][0][m][1], b0 = acc[ai][1][m][0], b1 = acc[ai][1][m][1];
                u32x4 w; w.x = cvt_pk_bf16(silu_mul(a0[0], b0[0]), silu_mul(a0[1], b0[1])); w.y = cvt_pk_bf16(silu_mul(a0[2], b0[2]), silu_mul(a0[3], b0[3]));
                w.z = cvt_pk_bf16(silu_mul(a1[0], b1[0]), silu_mul(a1[1], b1[1])); w.w = cvt_pk_bf16(silu_mul(a1[2], b1[2]), silu_mul(a1[3], b1[3]));
                *(u32x4*)rowp = w; }
    }
};

template <class Epi, class Sched, bool ALIGN_EPI>
__device__ __forceinline__ void gemm_phase(PG8_LAS unsigned char* lds, const Gemm g, const Sched& S, const Epi& E) {
    const int tid = threadIdx.x, wid = __builtin_amdgcn_readfirstlane(tid >> 6), lane = tid & 63, wr = wid >> 2, wc = wid & 3, fr = lane & 15, fq = lane >> 4;
    const int K = g.K, nt = K / BK;
    int RA[2], CA[2]; unsigned voffB[2];
#pragma unroll
    for (int i = 0; i < 2; ++i) { int R, C; stage_rc(tid * 16 + i * 8192, R, C); RA[i] = R; CA[i] = C; const int Rb = Epi::PERM ? ((R & ~31) + perm32(R & 31)) : R; voffB[i] = (unsigned)(Rb * K + C) * 2u; }
    const size_t kstep = (size_t)(BK * 2);
    const size_t hstep = (size_t)HALF * K * 2;
    const size_t tstep = 2 * hstep;
    const unsigned ldsw = (unsigned)wid * 1024u;
    const int aoff = lds_byte(wr * 64 + fr, fq * 8), boff = lds_byte(wc * 32 + fr, fq * 8);
#define PG8_SA(b, h) (((b) * 2 + (h)) * HTB)
#define PG8_SB(b, h) ((4 + (b) * 2 + (h)) * HTB)
#define PG8_STAGE(bufoff, gbase, voff) do { _Pragma("unroll") for (int _i = 0; _i < 2; ++_i) \
        __builtin_amdgcn_global_load_lds((const unsigned*)((const char*)(gbase) + (voff)[_i]), (PG8_LAS unsigned*)(lds + (bufoff) + ldsw + _i * 8192), 16, 0, 0); } while (0)
#define PG8_LDA(dst, b, h) do { _Pragma("unroll") for (int m = 0; m < 4; ++m) _Pragma("unroll") for (int k = 0; k < 2; ++k) dst[m][k] = *(const PG8_LAS bf16x8*)(lds + PG8_SA(b, h) + aoff + m * 2048 + k * 1024); } while (0)
#define PG8_LDB(dst, b, h) do { _Pragma("unroll") for (int n = 0; n < 2; ++n) _Pragma("unroll") for (int k = 0; k < 2; ++k) dst[n][k] = *(const PG8_LAS bf16x8*)(lds + PG8_SB(b, h) + boff + n * 2048 + k * 1024); } while (0)
#define PG8_MMA(ai, bj, At, Bt) do { __builtin_amdgcn_s_setprio(1); _Pragma("unroll") for (int m = 0; m < 4; ++m) _Pragma("unroll") for (int n = 0; n < 2; ++n) _Pragma("unroll") for (int k = 0; k < 2; ++k) \
        acc[ai][bj][m][n] = __builtin_amdgcn_mfma_f32_16x16x32_bf16(Bt[n][k], At[m][k], acc[ai][bj][m][n], 0, 0, 0); __builtin_amdgcn_s_setprio(0); } while (0)
#define PG8_WAIT_V(n) asm volatile("s_waitcnt vmcnt(" #n ")" ::: "memory")
#define PG8_WAIT_L(n) asm volatile("s_waitcnt lgkmcnt(" #n ")" ::: "memory")
#define PG8_BAR __builtin_amdgcn_s_barrier()
#define PG8_SCHED __builtin_amdgcn_sched_barrier(0)
#define PG8_AOFF(dst, u) do { _Pragma("unroll") for (int _h = 0; _h < 2; ++_h) _Pragma("unroll") for (int _i = 0; _i < 2; ++_i) dst[_h][_i] = (S.arow(u, _h * HALF + RA[_i]) * (unsigned)K + (unsigned)CA[_i]) * 2u; } while (0)
    Unit cur, nxt; int ui = 0;
    if (!S.next(0, cur)) return;
    f32x4 acc[2][2][4][2];
#pragma unroll
    for (int a = 0; a < 2; ++a)
#pragma unroll
        for (int b = 0; b < 2; ++b)
#pragma unroll
            for (int m = 0; m < 4; ++m)
#pragma unroll
                for (int n = 0; n < 2; ++n) acc[a][b][m][n] = (f32x4){0.f, 0.f, 0.f, 0.f};
    bf16x8 At[4][2], B0[2][2], B1[2][2];
    unsigned offc[2][2], offn[2][2];
    PG8_AOFF(offc, cur);
    const char* const cA = (const char*)g.A; const char* cB = (const char*)g.Bt + (size_t)cur.pn * tstep;
    PG8_STAGE(PG8_SB(0, 0), cB, voffB); PG8_STAGE(PG8_SB(0, 1), cB + hstep, voffB); PG8_STAGE(PG8_SA(0, 0), cA, offc[0]); PG8_STAGE(PG8_SA(0, 1), cA, offc[1]);
    if (wr == 1) PG8_BAR;
    PG8_WAIT_V(2); PG8_BAR;
    PG8_STAGE(PG8_SB(1, 0), cB + kstep, voffB); PG8_STAGE(PG8_SA(1, 0), cA + kstep, offc[0]); PG8_STAGE(PG8_SB(1, 1), cB + hstep + kstep, voffB);
    PG8_WAIT_V(6); PG8_BAR;
    for (;;) {
        const bool has_next = S.next(ui + 1, nxt);
        if (has_next) { PG8_AOFF(offn, nxt); }
        else {
#pragma unroll
            for (int h = 0; h < 2; ++h)
#pragma unroll
                for (int i = 0; i < 2; ++i) offn[h][i] = offc[h][i]; }
        const char* nB = has_next ? (const char*)g.Bt + (size_t)nxt.pn * tstep : cB;
        for (int t = 0; t < nt; t += 2) {
            const bool last = (t == nt - 2);
            const char* a1 = cA + (size_t)(t + 1) * kstep;
            const char* a2 = last ? cA : cA + (size_t)(t + 2) * kstep; const char* b2 = last ? nB : cB + (size_t)(t + 2) * kstep;
            const char* a3 = a2 + kstep; const char* b3 = b2 + kstep;
            unsigned o2[2][2];
#pragma unroll
            for (int h = 0; h < 2; ++h)
#pragma unroll
                for (int i = 0; i < 2; ++i) o2[h][i] = last ? offn[h][i] : offc[h][i];
            PG8_LDB(B0, 0, 0); PG8_LDB(B1, 0, 1); PG8_SCHED; PG8_LDA(At, 0, 0); PG8_STAGE(PG8_SA(1, 1), a1, offc[1]);
            PG8_WAIT_V(8); PG8_WAIT_L(0); PG8_BAR; PG8_MMA(0, 0, At, B0); PG8_MMA(0, 1, At, B1); PG8_BAR; PG8_SCHED;
            PG8_LDA(At, 0, 1); PG8_STAGE(PG8_SB(0, 0), b2, voffB); PG8_STAGE(PG8_SB(0, 1), b2 + hstep, voffB); PG8_STAGE(PG8_SA(0, 0), a2, o2[0]);
            PG8_WAIT_V(8); PG8_WAIT_L(0); PG8_BAR; PG8_MMA(1, 0, At, B0); PG8_MMA(1, 1, At, B1); PG8_BAR; PG8_SCHED;
            PG8_LDB(B0, 1, 0); PG8_LDB(B1, 1, 1); PG8_SCHED; PG8_LDA(At, 1, 0); PG8_STAGE(PG8_SA(0, 1), a2, o2[1]);
            PG8_WAIT_V(8); PG8_WAIT_L(0); PG8_BAR; PG8_MMA(0, 0, At, B0); PG8_MMA(0, 1, At, B1); PG8_BAR; PG8_SCHED;
            PG8_LDA(At, 1, 1); PG8_STAGE(PG8_SB(1, 0), b3, voffB); PG8_STAGE(PG8_SB(1, 1), b3 + hstep, voffB); PG8_STAGE(PG8_SA(1, 0), a3, o2[0]);
            PG8_WAIT_V(8); PG8_WAIT_L(0); PG8_BAR; PG8_MMA(1, 0, At, B0); PG8_MMA(1, 1, At, B1); PG8_BAR; PG8_SCHED;
        }
        if constexpr (ALIGN_EPI) { if (wr == 0) PG8_BAR; }
        E(acc, cur, wr, wc, fr, fq);
        if (!has_next) break;
#pragma unroll
        for (int a = 0; a < 2; ++a)
#pragma unroll
            for (int b = 0; b < 2; ++b)
#pragma unroll
                for (int m = 0; m < 4; ++m)
#pragma unroll
                    for (int n = 0; n < 2; ++n) acc[a][b][m][n] = (f32x4){0.f, 0.f, 0.f, 0.f};
        cur = nxt; cB = nB; ++ui;
#pragma unroll
        for (int h = 0; h < 2; ++h)
#pragma unroll
            for (int i = 0; i < 2; ++i) offc[h][i] = offn[h][i];
        if constexpr (ALIGN_EPI) { if (wr == 1) PG8_BAR; }
    }
    PG8_WAIT_V(0);
    if constexpr (!ALIGN_EPI) { if (wr == 0) PG8_BAR; }
    PG8_BAR;
#undef PG8_SA
#undef PG8_SB
#undef PG8_STAGE
#undef PG8_LDA
#undef PG8_LDB
#undef PG8_MMA
#undef PG8_WAIT_V
#undef PG8_WAIT_L
#undef PG8_BAR
#undef PG8_SCHED
#undef PG8_AOFF
}
}

#define XB_TMO      128
#define XB_XCNT(j)  (256  + 64 * (j))
#define XB_XSUB(j)  (1280 + 64 * (j))
#define XB_XGEN(j)  (2304 + 64 * (j))
#define XB_TOP      3328
#define XB_TOPGEN   3392
#define XCD_BAR_WORDS 3456
#define XB_SPIN_CAP (1u << 18)

__device__ __forceinline__ unsigned xb_ld(unsigned* p)              { return __hip_atomic_load(p, __ATOMIC_RELAXED, __HIP_MEMORY_SCOPE_AGENT); }
__device__ __forceinline__ unsigned xb_add(unsigned* p, unsigned v) { return __hip_atomic_fetch_add(p, v, __ATOMIC_RELAXED, __HIP_MEMORY_SCOPE_AGENT); }
__device__ __forceinline__ unsigned xb_xcc_id() { return (unsigned)__builtin_amdgcn_s_getreg((3 << 11) | 20) & 0xFu; }
#define XB_SPIN(cond, bar) do { unsigned _sp = 0; while (cond) { __builtin_amdgcn_s_sleep(1); \
    if ((++_sp & 255u) == 0u) { if (xb_ld(&(bar)[XB_TMO])) break; if (_sp > XB_SPIN_CAP) { atomicAdd(&(bar)[XB_TMO], 1u); break; } } } } while (0)

struct XcdBarrier { unsigned* bar; unsigned x; volatile LAS unsigned* st; };

__device__ __forceinline__ XcdBarrier xcd_barrier_post(unsigned* bar, volatile LAS unsigned* st) {
    XcdBarrier b; b.bar = bar; b.x = xb_xcc_id(); b.st = st;
    if (threadIdx.x == 0) (void)xb_add(&bar[XB_XCNT(b.x)], 1u);
    return b;
}
__device__ __forceinline__ void xcd_barrier_complete(unsigned* bar, unsigned x, unsigned& nloc, unsigned& nx) {
    const unsigned G = gridDim.x * gridDim.y * gridDim.z;
    unsigned sum, cnt, mine, sp = 0u;
    for (;;) {
        sum = 0u; cnt = 0u; mine = 0u;
#pragma unroll
        for (unsigned j = 0; j < 16; ++j) { const unsigned c = xb_ld(&bar[XB_XCNT(j)]); sum += c; cnt += (c > 0u) ? 1u : 0u; mine = (j == x) ? c : mine; }
        if (sum == G) break;
        __builtin_amdgcn_s_sleep(1);
        if ((++sp & 255u) == 0u) { if (xb_ld(&bar[XB_TMO])) break; if (sp > XB_SPIN_CAP) { atomicAdd(&bar[XB_TMO], 1u); break; } }
    }
    nloc = mine > 0u ? mine : 1u; nx = cnt > 0u ? cnt : 1u;
}
__device__ __forceinline__ void xcd_barrier(const XcdBarrier& b) {
    asm volatile("s_waitcnt vmcnt(0)" ::: "memory");
    __syncthreads();
    if (threadIdx.x == 0) {
        unsigned* bar = b.bar;
        __builtin_amdgcn_s_waitcnt(0);
        unsigned nloc = b.st[0], nx = b.st[1];
        if (nloc == 0u) { xcd_barrier_complete(bar, b.x, nloc, nx); b.st[0] = nloc; b.st[1] = nx; }
        const unsigned old = xb_add(&bar[XB_XSUB(b.x)], 1u);
        const unsigned gen = old / nloc;
        if (old + 1u == (gen + 1u) * nloc) {
            __builtin_amdgcn_fence(__ATOMIC_RELEASE, "agent");
            asm volatile("s_waitcnt vmcnt(0)" ::: "memory");
            const unsigned og = xb_add(&bar[XB_TOP], 1u);
            const unsigned tg = og / nx;
            if (og + 1u == (tg + 1u) * nx) xb_add(&bar[XB_TOPGEN], 1u);
            else XB_SPIN(xb_ld(&bar[XB_TOPGEN]) == tg, bar);
            __builtin_amdgcn_fence(__ATOMIC_ACQUIRE, "agent");
            xb_add(&bar[XB_XGEN(b.x)], 1u);
            asm volatile("s_waitcnt vmcnt(0)" ::: "memory");
        } else {
            XB_SPIN(xb_ld(&bar[XB_XGEN(b.x)]) == gen, bar);
            __builtin_amdgcn_fence(__ATOMIC_ACQUIRE, "agent");
            asm volatile("s_waitcnt vmcnt(0)" ::: "memory");
        }
    }
    __syncthreads();
}

__device__ __forceinline__ void transpose_item(const float* W, int K, int N, bf16* WT, int kb, int nb, int dst_row0, LAS float* scr, int lane) {
    const int k0 = 64 * kb, n0 = 32 * nb;
#pragma unroll 8
    for (int i = 0; i < 32; ++i) { const int kk = 2 * i + (lane >> 5); scr[kk * 33 + (lane & 31)] = W[(size_t)(k0 + kk) * N + n0 + (lane & 31)]; }
    LDS_WAIT(); asm volatile("" ::: "memory");
    const int c = lane & 7;
#pragma unroll
    for (int j = 0; j < 4; ++j) { const int n = (lane >> 3) + 8 * j; const LAS float* s = scr + (8 * c) * 33 + n;
        v4u o; o.x = pk2(s[0 * 33], s[1 * 33]); o.y = pk2(s[2 * 33], s[3 * 33]); o.z = pk2(s[4 * 33], s[5 * 33]); o.w = pk2(s[6 * 33], s[7 * 33]);
        *(GAS v4u*)(WT + (size_t)(dst_row0 + n) * K + k0 + 8 * c) = o; }
    LDS_WAIT(); asm volatile("" ::: "memory");
}
__device__ __forceinline__ void transpose_plain(const float* W, int K, int N, bf16* WT, LAS float* scr, int gw, int ngw, int lane) {
    const int nblk = N / 32, nitems = (K / 64) * nblk;
    for (int it = gw; it < nitems; it += ngw) { const int kb = it / nblk, nb = it % nblk; transpose_item(W, K, N, WT, kb, nb, 32 * nb, scr, lane); }
}
__device__ __forceinline__ void transpose_moe(const float* w1, const float* w3, const float* w2, bf16* W13T, bf16* W2T, LAS float* scr, int gw, int ngw, int lane) {
    constexpr int I13 = 16 * 16, I2 = 8 * 32, IPE = 2 * I13 + I2;
    for (int it = gw; it < NEXP * IPE; it += ngw) {
        const int e = it / IPE; int r = it % IPE;
        if (r < 2 * I13) { const int which = r / I13; r %= I13; const int kb = r / 16, nb = r % 16, n0 = 32 * nb;
            const float* W = (which ? w3 : w1) + (size_t)e * 1024 * 512;
            transpose_item(W, 1024, 512, W13T + (size_t)e * 1024 * 1024, kb, nb, (n0 >> 7) * 256 + which * 128 + (n0 & 127), scr, lane);
        } else { r -= 2 * I13; const int kb = r / 32, nb = r % 32;
            transpose_item(w2 + (size_t)e * 512 * 1024, 512, 1024, W2T + (size_t)e * 1024 * 512, kb, nb, 32 * nb, scr, lane); }
    }
}
__device__ __forceinline__ void rms_row(const float* xrow, const float* g, f32x4 (&v)[4], int lane) {
    const GAS f32x4* xr = (const GAS f32x4*)xrow + lane; const GAS f32x4* gr = (const GAS f32x4*)g + lane;
    float s = 0.f;
#pragma unroll
    for (int j = 0; j < 4; ++j) { v[j] = xr[64 * j]; s += (v[j].x * v[j].x + v[j].y * v[j].y) + (v[j].z * v[j].z + v[j].w * v[j].w); }
    const float rstd = 1.0f / sqrtf(wave_sum(s) * (1.f / DM) + 1e-6f);
#pragma unroll
    for (int j = 0; j < 4; ++j) { const f32x4 gg = gr[64 * j]; v[j] = v[j] * rstd * gg; }
}
__device__ __forceinline__ void store_row_bf16(bf16* orow, const f32x4 (&v)[4], int lane) {
    GAS unsigned long long* o8 = (GAS unsigned long long*)orow + lane;
#pragma unroll
    for (int j = 0; j < 4; ++j) o8[64 * j] = (unsigned long long)pk2(v[j].x, v[j].y) | ((unsigned long long)pk2(v[j].z, v[j].w) << 32);
}

__device__ __forceinline__ int t5_bucket(int rel) {
    const int n = rel < 0 ? -rel : rel; int ret = rel > 0 ? 16 : 0;
    int v;
    if (n < 8) v = n;
    else { const float nf = (float)n; int large = 8 + (int)(logf(nf / 8.0f) / 2.772588722239781f * 8.0f); v = large < 15 ? large : 15; }
    return ret + v;
}

__device__ __forceinline__ int crow(int r, int hi) { return (r & 3) + 8 * (r >> 2) + 4 * hi; }
__device__ __forceinline__ unsigned cvtpk(float lo, float hi) { unsigned r; asm volatile("v_cvt_pk_bf16_f32 %0, %1, %2" : "=v"(r) : "v"(lo), "v"(hi)); return r; }
__device__ __forceinline__ s16x4 vtr(const LAS char* p) { typedef short v4i16_t __attribute__((ext_vector_type(4))); return __builtin_bit_cast(s16x4, __builtin_amdgcn_ds_read_tr16_b64_v4i16((LAS v4i16_t*)p)); }

template <int DV, bool BIAS, bool FP8 = false>
__device__ __forceinline__ void attn_unit_v0(const bf16* Qp, int ldq, const bf16* Kp, int ldk, const bf16* Vp, int ldv, bf16* Op, int ldo, const LAS float* btbl, int q0, LAS unsigned char* lds) {
    const int tid = threadIdx.x, lane = tid & 63, r32 = lane & 31, hi = lane >> 5; const int wid = __builtin_amdgcn_readfirstlane(tid >> 6);
    constexpr int ND = DV / 32;
    LAS unsigned char* ldsK = lds; LAS unsigned char* ldsV = lds + 8192; LAS float* wsf = (LAS float*)(lds + 8192 + DV * 128) + wid * 64;
    bf16x8 qr[4]; v8i q8 = {0, 0, 0, 0, 0, 0, 0, 0};
    if (FP8) { const v4u a = *(const v4u*)((const unsigned char*)Qp + (size_t)(wid * 32 + r32) * ldq + hi * 32), b = *(const v4u*)((const unsigned char*)Qp + (size_t)(wid * 32 + r32) * ldq + hi * 32 + 16);
        q8 = (v8i){(int)a.x, (int)a.y, (int)a.z, (int)a.w, (int)b.x, (int)b.y, (int)b.z, (int)b.w}; }
    else {
#pragma unroll
    for (int d0 = 0; d0 < 4; ++d0) qr[d0] = *(const bf16x8*)(Qp + (size_t)(wid * 32 + r32) * ldq + d0 * 16 + hi * 8); }
    f32x16 o[ND];
#pragma unroll
    for (int d = 0; d < ND; ++d)
#pragma unroll
        for (int r = 0; r < 16; ++r) o[d][r] = 0.f;
    float l = 0.f;
    const int qpos = q0 + wid * 32 + r32;
    const LAS char* kp0 = (const LAS char*)ldsK + hi * 1024 + r32 * 16;
    const LAS char* vp0 = (const LAS char*)ldsV + ((lane >> 4) & 1) * 32 + (lane & 3) * 8 + (4 * hi + ((lane & 15) >> 2)) * 64;
    for (int t = 0; t < SEQ / 64; ++t) {
        __syncthreads();
        {
            if (FP8) { if (wid < 4) { const v4u kv = *(const v4u*)((const unsigned char*)Kp + (size_t)(t * 64 + lane) * ldk + wid * 16); *(LAS v4u*)(ldsK + wid * 1024 + lane * 16) = kv; } }
            else { const v4u kv = *(const v4u*)(Kp + (size_t)(t * 64 + lane) * ldk + wid * 8);
            *(LAS v4u*)(ldsK + wid * 1024 + lane * 16) = kv; }
#pragma unroll
            for (int pp = 0; pp < ND / 2; ++pp) { const int p = wid + 8 * pp, dq = p >> 2, rg = p & 3;
                const v4u vv = *(const v4u*)(Vp + (size_t)(t * 64 + 16 * rg + (lane >> 2)) * ldv + dq * 32 + (lane & 3) * 8);
                *(LAS v4u*)(ldsV + p * 1024 + lane * 16) = vv; }
        }
        __syncthreads();
        f32x16 p0, p1;
#pragma unroll
        for (int r = 0; r < 16; ++r) { p0[r] = 0.f; p1[r] = 0.f; }
        if (FP8) {
            const LAS char* k8 = (const LAS char*)ldsK + hi * 2048 + r32 * 16;
            const v4u a0 = *(const LAS v4u*)(k8), a1 = *(const LAS v4u*)(k8 + 1024), b0 = *(const LAS v4u*)(k8 + 512), b1 = *(const LAS v4u*)(k8 + 1024 + 512);
            const v8i ka = (v8i){(int)a0.x, (int)a0.y, (int)a0.z, (int)a0.w, (int)a1.x, (int)a1.y, (int)a1.z, (int)a1.w};
            const v8i kb = (v8i){(int)b0.x, (int)b0.y, (int)b0.z, (int)b0.w, (int)b1.x, (int)b1.y, (int)b1.z, (int)b1.w};
            p0 = __builtin_amdgcn_mfma_scale_f32_32x32x64_f8f6f4(ka, q8, p0, 0, 0, 0, 0x7f7f7f7f, 0, 0x7c7c7c7c);
            p1 = __builtin_amdgcn_mfma_scale_f32_32x32x64_f8f6f4(kb, q8, p1, 0, 0, 0, 0x7f7f7f7f, 0, 0x7c7c7c7c);
        } else {
#pragma unroll
        for (int d0 = 0; d0 < 4; ++d0) {
            const bf16x8 b0 = *(const LAS bf16x8*)(kp0 + d0 * 2048), b1 = *(const LAS bf16x8*)(kp0 + d0 * 2048 + 512);
            p0 = __builtin_amdgcn_mfma_f32_32x32x16_bf16(b0, qr[d0], p0, 0, 0, 0);
            p1 = __builtin_amdgcn_mfma_f32_32x32x16_bf16(b1, qr[d0], p1, 0, 0, 0);
        } }
        if (BIAS) {
            const int base = t * 64 + 4 * hi - qpos;
#pragma unroll
            for (int r = 0; r < 16; ++r) { int rel = base + (r & 3) + 8 * (r >> 2);
                int i0 = rel < -128 ? -128 : (rel > 128 ? 128 : rel); int rel1 = rel + 32; int i1 = rel1 < -128 ? -128 : (rel1 > 128 ? 128 : rel1);
                p0[r] += btbl[i0 + 128]; p1[r] += btbl[i1 + 128]; }
        }
        float sacc = 0.f;
#pragma unroll
        for (int r = 0; r < 16; ++r) { p0[r] = __builtin_amdgcn_exp2f(p0[r]); p1[r] = __builtin_amdgcn_exp2f(p1[r]); sacc += p0[r] + p1[r]; }
        l += sacc;
        v4u pw[4];
#pragma unroll
        for (int k = 0; k < 2; ++k) {
            pw[k]     = (v4u){cvtpk(p0[8 * k + 0], p0[8 * k + 1]), cvtpk(p0[8 * k + 2], p0[8 * k + 3]), cvtpk(p0[8 * k + 4], p0[8 * k + 5]), cvtpk(p0[8 * k + 6], p0[8 * k + 7])};
            pw[2 + k] = (v4u){cvtpk(p1[8 * k + 0], p1[8 * k + 1]), cvtpk(p1[8 * k + 2], p1[8 * k + 3]), cvtpk(p1[8 * k + 4], p1[8 * k + 5]), cvtpk(p1[8 * k + 6], p1[8 * k + 7])};
        }
#pragma unroll
        for (int d0 = 0; d0 < ND; ++d0)
#pragma unroll
            for (int ks = 0; ks < 4; ++ks) {
                const s16x4 lo = vtr(vp0 + d0 * 4096 + ks * 1024), hh = vtr(vp0 + d0 * 4096 + ks * 1024 + 512);
                const bf16x8 vf = (bf16x8){lo[0], lo[1], lo[2], lo[3], hh[0], hh[1], hh[2], hh[3]};
                o[d0] = __builtin_amdgcn_mfma_f32_32x32x16_bf16(__builtin_bit_cast(bf16x8, pw[ks]), vf, o[d0], 0, 0, 0);
            }
    }
    l += __shfl_xor(l, 32);
    if (hi == 0) wsf[r32] = l;
    LDS_WAIT(); asm volatile("" ::: "memory");
#pragma unroll
    for (int r = 0; r < 16; ++r) { const int row = crow(r, hi); const float rl = 1.0f / wsf[row];
#pragma unroll
        for (int d0 = 0; d0 < ND; ++d0) Op[(size_t)(wid * 32 + row) * ldo + d0 * 32 + r32] = (bf16)f2bf(o[d0][r] * rl); }
    LDS_WAIT();
}

namespace at1 {
#define SBAR() __builtin_amdgcn_sched_barrier(0)
#define PIN(x) asm volatile("" : "+v"(x))
template <int N, bool NOBAR = false> __device__ __forceinline__ void wait_bar() { if (NOBAR) asm volatile("s_waitcnt vmcnt(%0) lgkmcnt(0)" :: "n"(N) : "memory"); else asm volatile("s_waitcnt vmcnt(%0) lgkmcnt(0)\n\ts_barrier" :: "n"(N) : "memory"); }
__device__ __forceinline__ void glds16(const void* gsrc, unsigned lds_dst) { unsigned keep;
    asm volatile("s_mov_b32 %0, m0\n\ts_mov_b32 m0, %2\n\ts_nop 0\n\tglobal_load_lds_dwordx4 %1, off\n\ts_mov_b32 m0, %0" : "=&s"(keep) : "v"(gsrc), "s"(lds_dst) : "memory"); }
typedef float f32x2_t __attribute__((ext_vector_type(2))); typedef __bf16 bf16x2_t __attribute__((ext_vector_type(2)));
__device__ __forceinline__ unsigned cvtpk_s(float lo, float hi) { f32x2_t v = {lo, hi}; bf16x2_t b = __builtin_convertvector(v, bf16x2_t); return __builtin_bit_cast(unsigned, b); }
typedef const LAS char* lds_cptr;
__device__ __forceinline__ void kload2(bf16x8* kf, lds_cptr kp, int j) { kf[2 * j] = *(const LAS bf16x8*)(kp + j * 2048); kf[2 * j + 1] = *(const LAS bf16x8*)(kp + j * 2048 + 512); }

template <int DV, bool FP8> __host__ __device__ constexpr int lds_ws_off() { return (3 * (FP8 ? 4096 : 8192) + 3 * DV * 128) > 512 * DV ? (3 * (FP8 ? 4096 : 8192) + 3 * DV * 128) : 512 * DV; }
template <int DV, bool FP8> __host__ __device__ constexpr int lds_tbl_off() { return lds_ws_off<DV, FP8>() + 2048; }
template <int DV, bool BIAS, int TEST = 0, int MODE = 0, bool FP8 = false, bool TILED = false>
__device__ __forceinline__ void attn_unit(const bf16* Qp, int ldq, const bf16* __restrict__ Kp, int ldk, const bf16* __restrict__ Vp, int ldv, bf16* Op, int ldo, int q0, LAS unsigned char* lds, const LAS float* sgt = nullptr) {
    constexpr int ND = DV / 32, NV = ND / 2, VSLOT = DV * 128, KSLOT = FP8 ? 4096 : 8192, NT = SEQ / 64;
    constexpr int LDS_K = 0, LDS_V = 3 * KSLOT, LDS_WS = lds_ws_off<DV, FP8>(), LDS_TBL = LDS_WS + 2048;
    static_assert(LDS_WS >= LDS_V + 3 * VSLOT && LDS_WS >= 512 * DV && LDS_TBL + 2048 <= STASH_OFF, "LDS map");
    const int tid = threadIdx.x, lane = tid & 63, r32 = lane & 31, hi = lane >> 5; const int wid = __builtin_amdgcn_readfirstlane(tid >> 6);
    const unsigned lds0 = (unsigned)(uintptr_t)lds;
    LAS float* wsf = (LAS float*)(lds + LDS_WS) + wid * 64;
    const LAS float* btbl = (const LAS float*)(lds + LDS_TBL);
    const unsigned char* ksrc = TILED ? (const unsigned char*)Kp + (wid & 3) * 1024 + lane * 16 : FP8 ? (const unsigned char*)Kp + (size_t)lane * ldk + (wid & 3) * 16 : (const unsigned char*)(Kp + (size_t)lane * ldk + wid * 8);
    const bf16* vsrc0 = TILED ? Vp + wid * 512 + lane * 8 : Vp + (size_t)(16 * (wid & 3) + (lane >> 2)) * ldv + (wid >> 2) * 32 + (lane & 3) * 8;
    const bf16* vsrc1 = TILED ? vsrc0 + 4096 : vsrc0 + 64;
    const unsigned kdst = lds0 + LDS_K + wid * 1024, vdst = lds0 + LDS_V + wid * 1024;
#define DMA_K(t, s) if (!(TEST & 8) && (!FP8 || wid < 4)) glds16(ksrc + (size_t)(t) * (TILED ? 4096 : 64 * ldk * (FP8 ? 1 : 2)), (unsigned)__builtin_amdgcn_readfirstlane(kdst + (s) * KSLOT))
#define DMA_V(t, s) do { if (TEST & 8) break; glds16(vsrc0 + (size_t)(t) * (TILED ? (size_t)(DV * 64) : (size_t)64 * ldv), (unsigned)__builtin_amdgcn_readfirstlane(vdst + (s) * VSLOT)); \
        if (NV == 2) glds16(vsrc1 + (size_t)(t) * (TILED ? (size_t)(DV * 64) : (size_t)64 * ldv), (unsigned)__builtin_amdgcn_readfirstlane(vdst + (s) * VSLOT + 8192)); } while (0)
    const lds_cptr kp0 = (lds_cptr)lds + LDS_K + hi * (FP8 ? 2048 : 1024) + r32 * 16;
    const lds_cptr vp0 = (lds_cptr)lds + LDS_V + ((lane >> 4) & 1) * 32 + (lane & 3) * 8 + (4 * hi + ((lane & 15) >> 2)) * 64;
    DMA_K(0, 0); DMA_V(0, 0); DMA_K(1, 1);
    bf16x8 qr[4]; v8i q8 = {0, 0, 0, 0, 0, 0, 0, 0};
    if (FP8) { const unsigned char* qb_ = (const unsigned char*)Qp + (size_t)(wid * 32 + r32) * ldq + hi * 32; const v4u a = *(const v4u*)qb_, b = *(const v4u*)(qb_ + 16);
        q8 = (v8i){(int)a.x, (int)a.y, (int)a.z, (int)a.w, (int)b.x, (int)b.y, (int)b.z, (int)b.w}; }
    else {
#pragma unroll
        for (int d0 = 0; d0 < 4; ++d0) qr[d0] = *(const bf16x8*)(Qp + (size_t)(wid * 32 + r32) * ldq + d0 * 16 + hi * 8); }
    float l_reg = 0.f; f32x16 o[ND];
#pragma unroll
    for (int d = 0; d < ND; ++d) o[d] = f32x16{};
    const f32x16 zero16 = f32x16{};
    const int qw = q0 + wid * 32, qpos = qw + r32;
    int tl = 0, tr = NT; float fL = 1.f;
    if (BIAS) { tl = (qw - 191 >= 0) ? ((qw - 191) >> 6) + 1 : 0; tr = (qw + 158) >> 6; fL = __builtin_amdgcn_exp2f(btbl[0]); }
    f32x16 pA0, pA1, pB0, pB1; bf16x8 kf[8]; v8i kf8[2]; s16x4 vlo[8], vhi[8]; v4u pw0, pw1, pw2, pw3;
#define KLOAD8(n, kp_) do { const v4u a_ = *(const LAS v4u*)((kp_) + (n) * 512), b_ = *(const LAS v4u*)((kp_) + (n) * 512 + 1024); kf8[n] = (v8i){(int)a_.x, (int)a_.y, (int)a_.z, (int)a_.w, (int)b_.x, (int)b_.y, (int)b_.z, (int)b_.w}; } while (0)
#define MF8(kf_, c_) __builtin_amdgcn_mfma_scale_f32_32x32x64_f8f6f4(kf_, q8, c_, 0, 0, 0, 0x7f7f7f7f, 0, 0x7c7c7c7c)
#define WAITB(N) do { if (FP8 && wid >= 4) wait_bar<(N) - 1, (TEST & 16) != 0>(); else wait_bar<(N), (TEST & 16) != 0>(); } while (0)
    if (TEST & 32) { pB0 = f32x16{}; pB1 = f32x16{}; }
    if (TEST & 64) { _Pragma("unroll") for (int i_ = 0; i_ < 8; ++i_) { vlo[i_] = (s16x4){1, 2, 3, 4}; vhi[i_] = (s16x4){4, 3, 2, 1}; } }
    int s_prev = 0, s_cur = 0, s_next = 1;
#define ROT() do { s_prev = s_cur; s_cur = s_next; s_next = (s_next == 2) ? 0 : s_next + 1; } while (0)
#define ADD_BIAS(C0, C1, t) do { if (BIAS && (t) >= tl && (t) <= tr) { const int base_ = (t) * 64 + 4 * hi - qpos; \
        _Pragma("unroll") for (int r = 0; r < 16; ++r) { const int rel0 = base_ + (r & 3) + 8 * (r >> 2); const int rel1 = rel0 + 32; \
            const int i0 = (rel0 < -128 ? -128 : (rel0 > 128 ? 128 : rel0)) + 128, i1 = (rel1 < -128 ? -128 : (rel1 > 128 ? 128 : rel1)) + 128; \
            C0[r] += btbl[i0]; C1[r] += btbl[i1]; } } } while (0)
    DMA_K(2, 2);
    if (FP8) wait_bar<0, (TEST & 16) != 0>(); else wait_bar<NV + 2, (TEST & 16) != 0>();
    {
        if (FP8) { KLOAD8(0, kp0); KLOAD8(1, kp0); pA0 = MF8(kf8[0], zero16); pA1 = MF8(kf8[1], zero16); }
        else {
#pragma unroll
        for (int j = 0; j < 4; ++j) kload2(kf, kp0, j);
        pA0 = __builtin_amdgcn_mfma_f32_32x32x16_bf16(kf[0], qr[0], zero16, 0, 0, 0); pA1 = __builtin_amdgcn_mfma_f32_32x32x16_bf16(kf[1], qr[0], zero16, 0, 0, 0);
#pragma unroll
        for (int d0 = 1; d0 < 4; ++d0) { pA0 = __builtin_amdgcn_mfma_f32_32x32x16_bf16(kf[2 * d0], qr[d0], pA0, 0, 0, 0); pA1 = __builtin_amdgcn_mfma_f32_32x32x16_bf16(kf[2 * d0 + 1], qr[d0], pA1, 0, 0, 0); } }
        ADD_BIAS(pA0, pA1, 0);
#pragma unroll
        for (int r = 0; r < 16; ++r) { pA0[r] = __builtin_amdgcn_exp2f(pA0[r]); pA1[r] = __builtin_amdgcn_exp2f(pA1[r]); }
    }
    wait_bar<0, (TEST & 16) != 0>();
    DMA_K(3, 0); DMA_V(1, 1);
    ROT();
    if (FP8) { KLOAD8(0, kp0 + s_cur * KSLOT); KLOAD8(1, kp0 + s_cur * KSLOT); }
    else {
#pragma unroll
    for (int j = 0; j < 4; ++j) kload2(kf, kp0 + s_cur * KSLOT, j); }
    WAITB(1 + NV);
#define PKW(P, B) ((TEST & 256) ? 0x3f803f80u : cvtpk_s(P[B], P[B + 1]))
#define PAF(k) __builtin_bit_cast(bf16x8, pw##k)
#define VFR(i) (bf16x8){vlo[i][0], vlo[i][1], vlo[i][2], vlo[i][3], vhi[i][0], vhi[i][1], vhi[i][2], vhi[i][3]}
#define MF(a, b, c) __builtin_amdgcn_mfma_f32_32x32x16_bf16(a, b, c, 0, 0, 0)
#define GAPA(MFS, A0, A1, A2, A3, W0, W1, PW) do { if (!(TEST & 32)) { MFS; } if (!(TEST & 2)) { sacc += A0; sacc += A1; sacc += A2; sacc += A3; PIN(sacc); } W0; W1; PIN(PW); SBAR(); } while (0)
#define EX(v) ((TEST & 1) ? (v) : __builtin_amdgcn_exp2f(v))
#define GAPB4(MFS, X, B) do { if (!(TEST & 4)) { MFS; } X[B] = EX(X[B]); X[B + 1] = EX(X[B + 1]); X[B + 2] = EX(X[B + 2]); X[B + 3] = EX(X[B + 3]); PIN(X); SBAR(); } while (0)
#define GAPB2(MFS, X, B) do { if (!(TEST & 4)) { MFS; } X[B] = EX(X[B]); X[B + 1] = EX(X[B + 1]); PIN(X); SBAR(); } while (0)
#define VRD(f, s) do { if (TEST & 64) break; vlo[s] = vtr(vp_ + (((f) >> 2) * 4096 + ((f) & 3) * 1024)); vhi[s] = vtr(vp_ + (((f) >> 2) * 4096 + ((f) & 3) * 1024 + 512)); } while (0)
#define KRD(G, j) do { if ((G) && !(TEST & 128)) { if (FP8) { if ((j) < 2) { KLOAD8(j, kp0 + s_next * KSLOT); } } else kload2(kf, kp0 + s_next * KSLOT, j); SBAR(); } } while (0)
#define FO(m) (ND == 2 ? (((m) >> 1) + 4 * ((m) & 1)) : ((((m) & 7) >> 2) + 2 * ((m) >> 3) + 4 * ((m) & 3)))
#define STEP(C0, C1, P0, P1, t, GK, GV, GL) do { SBAR(); \
    const lds_cptr vp_ = vp0 + s_prev * VSLOT; float sacc; \
    if (FP8) { \
      VRD(FO(0), 0); VRD(FO(1), 1); VRD(FO(2), 2); VRD(FO(3), 3); SBAR(); \
      if (!(TEST & 32)) C0 = MF8(kf8[0], zero16); \
      SBAR();   \
      float sa_ = P0[0] + P0[1], sb_ = P0[2] + P0[3], sc_ = P0[4] + P0[5], sd_ = P0[6] + P0[7]; \
      if (!(TEST & 2)) { sa_ += P0[8]; sb_ += P0[9]; sc_ += P0[10]; sd_ += P0[11]; sa_ += P0[12]; sb_ += P0[13]; sc_ += P0[14]; sd_ += P0[15]; } \
      pw0 = (v4u){PKW(P0, 0), PKW(P0, 2), PKW(P0, 4), PKW(P0, 6)}; pw1 = (v4u){PKW(P0, 8), PKW(P0, 10), PKW(P0, 12), PKW(P0, 14)}; PIN(pw0); PIN(pw1); SBAR(); \
      VRD(FO(4), 4); VRD(FO(5), 5); VRD(FO(6), 6); VRD(FO(7), 7); SBAR(); \
      if (!(TEST & 32)) C1 = MF8(kf8[1], zero16); \
      SBAR(); \
      if (!(TEST & 2)) { sa_ += P1[0]; sb_ += P1[1]; sc_ += P1[2]; sd_ += P1[3]; sa_ += P1[4]; sb_ += P1[5]; sc_ += P1[6]; sd_ += P1[7]; \
                         sa_ += P1[8]; sb_ += P1[9]; sc_ += P1[10]; sd_ += P1[11]; sa_ += P1[12]; sb_ += P1[13]; sc_ += P1[14]; sd_ += P1[15]; } \
      sacc = (sa_ + sb_) + (sc_ + sd_); PIN(sacc); \
      pw2 = (v4u){PKW(P1, 0), PKW(P1, 2), PKW(P1, 4), PKW(P1, 6)}; pw3 = (v4u){PKW(P1, 8), PKW(P1, 10), PKW(P1, 12), PKW(P1, 14)}; PIN(pw2); PIN(pw3); SBAR(); \
    } else { \
    VRD(FO(0), 0); SBAR(); sacc = (P0[0] + P0[1]); \
    GAPA(C0 = MF(kf[0], qr[0], zero16), P0[2], P0[3], P0[4], P0[5],     pw0[0] = PKW(P0, 0), pw0[1] = PKW(P0, 2), pw0); \
    VRD(FO(1), 1); SBAR(); GAPA(C1 = MF(kf[1], qr[0], zero16), P0[6], P0[7], P0[8], P0[9],     pw0[2] = PKW(P0, 4), pw0[3] = PKW(P0, 6), pw0); \
    VRD(FO(2), 2); SBAR(); GAPA(C0 = MF(kf[2], qr[1], C0),   P0[10], P0[11], P0[12], P0[13], pw1[0] = PKW(P0, 8), pw1[1] = PKW(P0, 10), pw1); \
    VRD(FO(3), 3); SBAR(); GAPA(C1 = MF(kf[3], qr[1], C1),   P0[14], P0[15], P1[0], P1[1],   pw1[2] = PKW(P0, 12), pw1[3] = PKW(P0, 14), pw1); \
    VRD(FO(4), 4); SBAR(); GAPA(C0 = MF(kf[4], qr[2], C0),   P1[2], P1[3], P1[4], P1[5],     pw2[0] = PKW(P1, 0), pw2[1] = PKW(P1, 2), pw2); \
    VRD(FO(5), 5); SBAR(); GAPA(C1 = MF(kf[5], qr[2], C1),   P1[6], P1[7], P1[8], P1[9],     pw2[2] = PKW(P1, 4), pw2[3] = PKW(P1, 6), pw2); \
    VRD(FO(6), 6); SBAR(); GAPA(C0 = MF(kf[6], qr[3], C0),   P1[10], P1[11], P1[12], P1[13], pw3[0] = PKW(P1, 8), pw3[1] = PKW(P1, 10), pw3); \
    VRD(FO(7), 7); SBAR(); GAPA(C1 = MF(kf[7], qr[3], C1),   P1[14], P1[15], 0.f, 0.f,       pw3[2] = PKW(P1, 12), pw3[3] = PKW(P1, 14), pw3); \
    } \
    l_reg += sacc; \
    if (GK) { DMA_K((t) + 3, s_cur); } if (GV) { DMA_V((t) + 1, s_next); } \
    ADD_BIAS(C0, C1, t); \
    SBAR(); \
    if (ND == 2) { \
        GAPB4(o[0] = MF(PAF(0), VFR(0), o[0]), C0, 0); \
        GAPB4(o[1] = MF(PAF(0), VFR(1), o[1]), C0, 4); \
        KRD(GL, 0); GAPB4(o[0] = MF(PAF(1), VFR(2), o[0]), C0, 8); \
        KRD(GL, 1); GAPB4(o[1] = MF(PAF(1), VFR(3), o[1]), C0, 12); \
        KRD(GL, 2); GAPB4(o[0] = MF(PAF(2), VFR(4), o[0]), C1, 0); \
        KRD(GL, 3); GAPB4(o[1] = MF(PAF(2), VFR(5), o[1]), C1, 4); \
        GAPB4(o[0] = MF(PAF(3), VFR(6), o[0]), C1, 8); \
        GAPB4(o[1] = MF(PAF(3), VFR(7), o[1]), C1, 12); \
    } else { \
        GAPB2(o[0] = MF(PAF(0), VFR(0), o[0]), C0, 0);  VRD(FO(8), 0); SBAR(); \
        GAPB2(o[1] = MF(PAF(0), VFR(1), o[1]), C0, 2);  VRD(FO(9), 1); SBAR(); \
        GAPB2(o[ND - 2] = MF(PAF(0), VFR(2), o[ND - 2]), C0, 4);  VRD(FO(10), 2); SBAR(); \
        GAPB2(o[ND - 1] = MF(PAF(0), VFR(3), o[ND - 1]), C0, 6);  VRD(FO(11), 3); SBAR(); \
        GAPB2(o[0] = MF(PAF(1), VFR(4), o[0]), C0, 8);  VRD(FO(12), 4); SBAR(); \
        GAPB2(o[1] = MF(PAF(1), VFR(5), o[1]), C0, 10); VRD(FO(13), 5); SBAR(); \
        GAPB2(o[ND - 2] = MF(PAF(1), VFR(6), o[ND - 2]), C0, 12); VRD(FO(14), 6); SBAR(); \
        GAPB2(o[ND - 1] = MF(PAF(1), VFR(7), o[ND - 1]), C0, 14); VRD(FO(15), 7); SBAR(); \
        KRD(GL, 0); GAPB2(o[0] = MF(PAF(2), VFR(0), o[0]), C1, 0); \
        GAPB2(o[1] = MF(PAF(2), VFR(1), o[1]), C1, 2); \
        KRD(GL, 1); GAPB2(o[ND - 2] = MF(PAF(2), VFR(2), o[ND - 2]), C1, 4); \
        GAPB2(o[ND - 1] = MF(PAF(2), VFR(3), o[ND - 1]), C1, 6); \
        KRD(GL, 2); GAPB2(o[0] = MF(PAF(3), VFR(4), o[0]), C1, 8); \
        GAPB2(o[1] = MF(PAF(3), VFR(5), o[1]), C1, 10); \
        KRD(GL, 3); GAPB2(o[ND - 2] = MF(PAF(3), VFR(6), o[ND - 2]), C1, 12); \
        GAPB2(o[ND - 1] = MF(PAF(3), VFR(7), o[ND - 1]), C1, 14); \
    } \
    if (BIAS && (t) == tl) { l_reg *= fL; _Pragma("unroll") for (int d_ = 0; d_ < ND; ++d_) _Pragma("unroll") for (int r = 0; r < 16; ++r) o[d_][r] *= fL; } \
    } while (0)
    int t = 1;
    for (; t + 4 < NT; t += 2) {
        STEP(pB0, pB1, pA0, pA1, t, true, true, true);       WAITB(1 + NV); ROT();
        STEP(pA0, pA1, pB0, pB1, t + 1, true, true, true);   WAITB(1 + NV); ROT();
    }
    STEP(pB0, pB1, pA0, pA1, NT - 3, false, true, true);  wait_bar<NV, (TEST & 16) != 0>(); ROT();
    STEP(pA0, pA1, pB0, pB1, NT - 2, false, true, true);  wait_bar<0, (TEST & 16) != 0>();  ROT();
    STEP(pB0, pB1, pA0, pA1, NT - 1, false, false, false);
    {
        float sacc = pB0[0] + pB0[1];
#pragma unroll
        for (int r = 2; r < 16; ++r) sacc += pB0[r];
#pragma unroll
        for (int r = 0; r < 16; ++r) sacc += pB1[r];
        l_reg += sacc;
        pw0 = (v4u){PKW(pB0, 0), PKW(pB0, 2), PKW(pB0, 4), PKW(pB0, 6)}; pw1 = (v4u){PKW(pB0, 8), PKW(pB0, 10), PKW(pB0, 12), PKW(pB0, 14)};
        pw2 = (v4u){PKW(pB1, 0), PKW(pB1, 2), PKW(pB1, 4), PKW(pB1, 6)}; pw3 = (v4u){PKW(pB1, 8), PKW(pB1, 10), PKW(pB1, 12), PKW(pB1, 14)};
        const lds_cptr vp_ = vp0 + s_cur * VSLOT;
#pragma unroll
        for (int d0 = 0; d0 < ND; ++d0) {
            s16x4 a0 = vtr(vp_ + d0 * 4096), b0 = vtr(vp_ + d0 * 4096 + 512), a1 = vtr(vp_ + d0 * 4096 + 1024), b1 = vtr(vp_ + d0 * 4096 + 1536);
            s16x4 a2 = vtr(vp_ + d0 * 4096 + 2048), b2 = vtr(vp_ + d0 * 4096 + 2560), a3 = vtr(vp_ + d0 * 4096 + 3072), b3 = vtr(vp_ + d0 * 4096 + 3584);
            o[d0] = MF(PAF(0), ((bf16x8){a0[0], a0[1], a0[2], a0[3], b0[0], b0[1], b0[2], b0[3]}), o[d0]);
            o[d0] = MF(PAF(1), ((bf16x8){a1[0], a1[1], a1[2], a1[3], b1[0], b1[1], b1[2], b1[3]}), o[d0]);
            o[d0] = MF(PAF(2), ((bf16x8){a2[0], a2[1], a2[2], a2[3], b2[0], b2[1], b2[2], b2[3]}), o[d0]);
            o[d0] = MF(PAF(3), ((bf16x8){a3[0], a3[1], a3[2], a3[3], b3[0], b3[1], b3[2], b3[3]}), o[d0]);
        }
    }
    l_reg += __shfl_xor(l_reg, 32);
    int lane_e = lane; asm volatile("" : "+v"(lane_e));
    const int r32e = lane_e & 31, hie = lane_e >> 5;
    if (hie == 0) wsf[r32e] = l_reg;
    asm volatile("s_waitcnt lgkmcnt(0)\n\ts_barrier" ::: "memory");
    {
        LAS bf16* stg = (LAS bf16*)(MODE == 1 ? lds + STASH_OFF : lds) + wid * (32 * DV);
#pragma unroll
        for (int r = 0; r < 16; ++r) { const int orow = crow(r, hie); const float rl = __builtin_amdgcn_rcpf(wsf[orow]);
#pragma unroll
            for (int d0 = 0; d0 < ND; ++d0) stg[orow * DV + d0 * 32 + r32e] = (bf16)f2bf(o[d0][r] * rl); }
        asm volatile("s_waitcnt lgkmcnt(0)" ::: "memory");
        if (MODE == 0) {
            constexpr int CPR = DV / 8;
#pragma unroll
            for (int i = 0; i < (32 * CPR) / 64; ++i) { const int row = i * (64 / CPR) + lane_e / CPR, ch = lane_e % CPR;
                const v4u v = *(const LAS v4u*)(stg + row * DV + ch * 8); *(v4u*)(Op + (size_t)(wid * 32 + row) * ldo + ch * 8) = v; }
        } else if (MODE == 2) {
            const int row = lane_e >> 1, half = lane_e & 1; const float lam = sgt[128];
            const LAS bf16* s1 = stg + row * DV + half * 64; const LAS bf16* s0 = (const LAS bf16*)(lds + STASH_OFF) + wid * (32 * DV) + row * DV + half * 64;
            float ov[64]; float ss = 0.f;
#pragma unroll
            for (int q = 0; q < 8; ++q) { const v4u a = *(const LAS v4u*)(s0 + q * 8), c = *(const LAS v4u*)(s1 + q * 8);
#pragma unroll
                for (int j = 0; j < 4; ++j) { const float lo = __builtin_bit_cast(float, a[j] << 16) - lam * __builtin_bit_cast(float, c[j] << 16);
                    const float hh = __builtin_bit_cast(float, a[j] & 0xffff0000u) - lam * __builtin_bit_cast(float, c[j] & 0xffff0000u);
                    ov[q * 8 + 2 * j] = lo; ov[q * 8 + 2 * j + 1] = hh; ss += lo * lo + hh * hh; } }
            ss += dpp_mov<0xB1>(ss);
            const float rstd = 1.0f / sqrtf(ss * (1.f / 128.f) + 1e-5f);
            bf16* yo = Op + (size_t)(wid * 32 + row) * ldo + half * 64;
#pragma unroll
            for (int q = 0; q < 8; ++q) { const f32x4 g0 = *(const LAS f32x4*)(sgt + half * 64 + q * 8), g1 = *(const LAS f32x4*)(sgt + half * 64 + q * 8 + 4);
                v4u w; w.x = pk2(ov[q * 8] * rstd * g0.x, ov[q * 8 + 1] * rstd * g0.y); w.y = pk2(ov[q * 8 + 2] * rstd * g0.z, ov[q * 8 + 3] * rstd * g0.w);
                w.z = pk2(ov[q * 8 + 4] * rstd * g1.x, ov[q * 8 + 5] * rstd * g1.y); w.w = pk2(ov[q * 8 + 6] * rstd * g1.z, ov[q * 8 + 7] * rstd * g1.w);
                *(v4u*)(yo + q * 8) = w; }
        }
    }
    asm volatile("s_waitcnt lgkmcnt(0)\n\ts_barrier" ::: "memory");
#undef KLOAD8
#undef MF8
#undef WAITB
#undef DMA_K
#undef DMA_V
#undef ROT
#undef ADD_BIAS
#undef PKW
#undef PAF
#undef VFR
#undef MF
#undef GAPA
#undef EX
#undef GAPB4
#undef GAPB2
#undef VRD
#undef KRD
#undef FO
#undef STEP
}
#undef SBAR
#undef PIN
}

namespace at3 {
#define SBAR() __builtin_amdgcn_sched_barrier(0)
#define PIN(x) asm volatile("" : "+v"(x))
using at1::glds16; using at1::wait_bar;
typedef const LAS char* lds_cptr; typedef short v2s __attribute__((ext_vector_type(2)));
template <int DV> __host__ __device__ constexpr int lds_ws_off() { return (3 * 4096 + 3 * DV * 64) > 512 * DV ? (3 * 4096 + 3 * DV * 64) : 512 * DV; }
template <int DV> __host__ __device__ constexpr int lds_tbl_off() { return lds_ws_off<DV>() + 2048; }
__device__ __forceinline__ void waitb(int n) { if (n == 0) wait_bar<0>(); else if (n == 1) wait_bar<1>(); else wait_bar<2>(); }
__device__ __forceinline__ v8i ld_frag(lds_cptr p, int second) { const v4u a = *(const LAS v4u*)p, b = *(const LAS v4u*)(p + second); return (v8i){(int)a.x, (int)a.y, (int)a.z, (int)a.w, (int)b.x, (int)b.y, (int)b.z, (int)b.w}; }

template <int DV, bool BIAS, int MODE>
__device__ __forceinline__ void attn_unit(const unsigned char* Qp, int ldq, const unsigned char* __restrict__ K8T, const unsigned char* __restrict__ V8T, bf16* Op, int ldo, int q0, LAS unsigned char* lds, const LAS float* sgt) {
    constexpr int ND = DV / 32, VT = DV * 64, KT = 4096, NT = SEQ / 64, NVP = VT / 1024;
    constexpr int LDS_K = 0, LDS_V = 3 * KT, LDS_WS = lds_ws_off<DV>(), LDS_TBL = LDS_WS + 2048;
    static_assert(LDS_WS >= LDS_V + 3 * VT && LDS_WS >= 512 * DV && LDS_TBL + 2048 <= STASH_OFF, "LDS map");
    const int tid = threadIdx.x, lane = tid & 63, r32 = lane & 31, hi = lane >> 5; const int wid = __builtin_amdgcn_readfirstlane(tid >> 6);
    const unsigned lds0 = (unsigned)(uintptr_t)lds;
    LAS float* wsf = (LAS float*)(lds + LDS_WS) + wid * 64;
    const LAS float* btbl = (const LAS float*)(lds + LDS_TBL);
    const bool doK = wid < 4, doV = (NVP == 8) || wid >= 4; const int vpc = (NVP == 8) ? wid : (wid & 3);
    const unsigned char* ksrc = K8T + (wid & 3) * 1024 + lane * 16; const unsigned char* vsrc = V8T + vpc * 1024 + lane * 16;
    const unsigned kdst = lds0 + LDS_K + (wid & 3) * 1024, vdst = lds0 + LDS_V + vpc * 1024;
    const int ndma = (doK ? 1 : 0) + (doV ? 1 : 0);
#define DMA_K(t, s) do { if (doK) glds16(ksrc + (size_t)(t) * KT, (unsigned)__builtin_amdgcn_readfirstlane(kdst + (s) * KT)); } while (0)
#define DMA_V(t, s) do { if (doV) glds16(vsrc + (size_t)(t) * VT, (unsigned)__builtin_amdgcn_readfirstlane(vdst + (s) * VT)); } while (0)
    const lds_cptr kp0 = (lds_cptr)lds + LDS_K + hi * 2048 + r32 * 16;
    const lds_cptr vq0 = (lds_cptr)lds + LDS_V + hi * (2 * DV * 16) + r32 * 16;
    DMA_K(0, 0); DMA_V(0, 0); DMA_K(1, 1);
    v8i q8;
    { const unsigned char* qb_ = Qp + (size_t)(wid * 32 + r32) * ldq + hi * 32; const v4u a = *(const v4u*)qb_, b = *(const v4u*)(qb_ + 16);
      q8 = (v8i){(int)a.x, (int)a.y, (int)a.z, (int)a.w, (int)b.x, (int)b.y, (int)b.z, (int)b.w}; }
    f32x16 lacc = f32x16{}; f32x16 o[ND];
#pragma unroll
    for (int d = 0; d < ND; ++d) o[d] = f32x16{};
    const f32x16 zero16 = f32x16{};
    const v8i ones8 = {0x38383838, 0x38383838, 0x38383838, 0x38383838, 0x38383838, 0x38383838, 0x38383838, 0x38383838};
    const int qw = q0 + wid * 32, qpos = qw + r32;
    int tl = 0, tr = NT; float fL = 1.f;
    if (BIAS) { tl = (qw - 191 >= 0) ? ((qw - 191) >> 6) + 1 : 0; tr = (qw + 158) >> 6; fL = __builtin_amdgcn_exp2f(btbl[0]); }
    f32x16 pA0, pA1, pB0, pB1; v8i kf8[2]; v8i vf[ND]; v8i pa; int sb = 127;
    int s_prev = 0, s_cur = 0, s_next = 1;
#define ROT() do { s_prev = s_cur; s_cur = s_next; s_next = (s_next == 2) ? 0 : s_next + 1; } while (0)
#define MFQK(kf_) __builtin_amdgcn_mfma_scale_f32_32x32x64_f8f6f4(kf_, q8, zero16, 0, 0, 0, 0x7f7f7f7f, 0, 0x7c7c7c7c)
#define MFPV(d_) o[d_] = __builtin_amdgcn_mfma_scale_f32_32x32x64_f8f6f4(pa, vf[d_], o[d_], 0, 0, 0, sb, 0, 0x7f7f7f7f)
#define MFSUM() lacc = __builtin_amdgcn_mfma_scale_f32_32x32x64_f8f6f4(pa, ones8, lacc, 0, 0, 0, sb, 0, 0x7f7f7f7f)
#define ADD_BIAS(C0, C1, t) do { if (BIAS && (t) >= tl && (t) <= tr) { const int base_ = (t) * 64 + 4 * hi - qpos; \
        _Pragma("unroll") for (int r = 0; r < 16; ++r) { const int rel0 = base_ + (r & 3) + 8 * (r >> 2); const int rel1 = rel0 + 32; \
            const int i0 = (rel0 < -128 ? -128 : (rel0 > 128 ? 128 : rel0)) + 128, i1 = (rel1 < -128 ? -128 : (rel1 > 128 ? 128 : rel1)) + 128; \
            C0[r] += btbl[i0]; C1[r] += btbl[i1]; } } } while (0)
#define MX3(a, b, c) __builtin_fmaxf(__builtin_fmaxf((a), (b)), (c))
#define PMAX(P0, P1) do { float a_ = MX3(P0[0], P0[1], P1[0]), b_ = MX3(P0[2], P0[3], P1[1]); a_ = MX3(a_, P1[2], P1[3]); \
        _Pragma("unroll") for (int r = 4; r < 16; r += 4) { a_ = MX3(a_, P0[r], P0[r + 1]); b_ = MX3(b_, P0[r + 2], P0[r + 3]); a_ = MX3(a_, P1[r], P1[r + 1]); b_ = MX3(b_, P1[r + 2], P1[r + 3]); } \
        const int em_ = (int)(__float_as_uint(__builtin_fmaxf(a_, b_)) >> 23) - 7; sb = em_ < 1 ? 1 : em_; } while (0)
#define PCVT(P0, P1) do { const float scf_ = __uint_as_float((unsigned)sb << 23); \
        _Pragma("unroll") for (int k = 0; k < 4; ++k) { v2s w_ = {0, 0}; w_ = __builtin_amdgcn_cvt_scalef32_pk_fp8_f32(w_, P0[4 * k], P0[4 * k + 1], scf_, false); w_ = __builtin_amdgcn_cvt_scalef32_pk_fp8_f32(w_, P0[4 * k + 2], P0[4 * k + 3], scf_, true); pa[k] = __builtin_bit_cast(int, w_); } \
        _Pragma("unroll") for (int k = 0; k < 4; ++k) { v2s w_ = {0, 0}; w_ = __builtin_amdgcn_cvt_scalef32_pk_fp8_f32(w_, P1[4 * k], P1[4 * k + 1], scf_, false); w_ = __builtin_amdgcn_cvt_scalef32_pk_fp8_f32(w_, P1[4 * k + 2], P1[4 * k + 3], scf_, true); pa[4 + k] = __builtin_bit_cast(int, w_); } } while (0)
#define PSUM(P0, P1) do { float s0_ = P0[0] + P0[1], s1_ = P0[2] + P0[3], s2_ = P1[0] + P1[1], s3_ = P1[2] + P1[3]; \
        _Pragma("unroll") for (int r = 4; r < 16; r += 4) { s0_ += P0[r]; s1_ += P0[r + 1]; s2_ += P0[r + 2]; s3_ += P0[r + 3]; s0_ += P1[r]; s1_ += P1[r + 1]; s2_ += P1[r + 2]; s3_ += P1[r + 3]; } \
        l_reg += (s0_ + s1_) + (s2_ + s3_); } while (0)
#define EXPS(X, B, N) do { _Pragma("unroll") for (int r_ = 0; r_ < (N); ++r_) X[(B) + r_] = __builtin_amdgcn_exp2f(X[(B) + r_]); PIN(X); } while (0)
    DMA_K(2, 2);
    wait_bar<0>();
    kf8[0] = ld_frag(kp0, 1024); kf8[1] = ld_frag(kp0 + 512, 1024);
    pA0 = MFQK(kf8[0]); pA1 = MFQK(kf8[1]);
    ADD_BIAS(pA0, pA1, 0);
#pragma unroll
    for (int r = 0; r < 16; ++r) { pA0[r] = __builtin_amdgcn_exp2f(pA0[r]); pA1[r] = __builtin_amdgcn_exp2f(pA1[r]); }
    wait_bar<0>();
    DMA_K(3, 0); DMA_V(1, 1);
    ROT();
    kf8[0] = ld_frag(kp0 + s_cur * KT, 1024); kf8[1] = ld_frag(kp0 + s_cur * KT + 512, 1024);
    waitb(ndma);
#define STEP(C0, C1, P0, P1, t, GK, GV, GL) do { SBAR(); \
    const lds_cptr vp_ = vq0 + s_prev * VT; \
    _Pragma("unroll") for (int d_ = 0; d_ < ND; ++d_) vf[d_] = ld_frag(vp_ + d_ * 512, DV * 16); \
    SBAR(); \
    C0 = MFQK(kf8[0]); SBAR(); \
    PMAX(P0, P1); PIN(sb); SBAR(); \
    C1 = MFQK(kf8[1]); SBAR(); \
    PCVT(P0, P1); PIN(pa); SBAR(); \
    MFSUM(); SBAR(); \
    if (GK) { DMA_K((t) + 3, s_cur); } if (GV) { DMA_V((t) + 1, s_next); } \
    ADD_BIAS(C0, C1, t); \
    SBAR(); \
    if (ND == 2) { \
        MFPV(0); EXPS(C0, 0, 16); SBAR(); \
        if (GL) { kf8[0] = ld_frag(kp0 + s_next * KT, 1024); kf8[1] = ld_frag(kp0 + s_next * KT + 512, 1024); SBAR(); } \
        MFPV(1); EXPS(C1, 0, 16); SBAR(); \
    } else { \
        MFPV(0); EXPS(C0, 0, 8); SBAR(); \
        if (GL) { kf8[0] = ld_frag(kp0 + s_next * KT, 1024); SBAR(); } \
        MFPV(1); EXPS(C0, 8, 8); SBAR(); \
        if (GL) { kf8[1] = ld_frag(kp0 + s_next * KT + 512, 1024); SBAR(); } \
        MFPV(ND - 2); EXPS(C1, 0, 8); SBAR(); \
        MFPV(ND - 1); EXPS(C1, 8, 8); SBAR(); \
    } \
    if (BIAS && (t) == tl) { _Pragma("unroll") for (int r = 0; r < 16; ++r) lacc[r] *= fL; _Pragma("unroll") for (int d_ = 0; d_ < ND; ++d_) _Pragma("unroll") for (int r = 0; r < 16; ++r) o[d_][r] *= fL; } \
    } while (0)
    int t = 1;
    for (; t + 4 < NT; t += 2) {
        STEP(pB0, pB1, pA0, pA1, t, true, true, true);       waitb(ndma); ROT();
        STEP(pA0, pA1, pB0, pB1, t + 1, true, true, true);   waitb(ndma); ROT();
    }
    STEP(pB0, pB1, pA0, pA1, NT - 3, false, true, true);  waitb(doV ? 1 : 0); ROT();
    STEP(pA0, pA1, pB0, pB1, NT - 2, false, true, true);  wait_bar<0>();  ROT();
    STEP(pB0, pB1, pA0, pA1, NT - 1, false, false, false);
    {
        const lds_cptr vp_ = vq0 + s_cur * VT;
#pragma unroll
        for (int d_ = 0; d_ < ND; ++d_) vf[d_] = ld_frag(vp_ + d_ * 512, DV * 16);
        PMAX(pB0, pB1); PCVT(pB0, pB1); MFSUM();
#pragma unroll
        for (int d_ = 0; d_ < ND; ++d_) MFPV(d_);
    }
    int lane_e = lane; asm volatile("" : "+v"(lane_e));
    const int r32e = lane_e & 31, hie = lane_e >> 5;
    asm volatile("s_waitcnt lgkmcnt(0)\n\ts_barrier" ::: "memory");
    {
        LAS bf16* stg = (LAS bf16*)(MODE == 1 ? lds + STASH_OFF : lds) + wid * (32 * DV);
#pragma unroll
        for (int r = 0; r < 16; ++r) { const int orow = crow(r, hie); const float rl = __builtin_amdgcn_rcpf(lacc[r]);
#pragma unroll
            for (int d0 = 0; d0 < ND; ++d0) stg[orow * DV + d0 * 32 + r32e] = (bf16)f2bf(o[d0][r] * rl); }
        asm volatile("s_waitcnt lgkmcnt(0)" ::: "memory");
        if (MODE == 0) {
            constexpr int CPR = DV / 8;
#pragma unroll
            for (int i = 0; i < (32 * CPR) / 64; ++i) { const int row = i * (64 / CPR) + lane_e / CPR, ch = lane_e % CPR;
                const v4u v = *(const LAS v4u*)(stg + row * DV + ch * 8); *(v4u*)(Op + (size_t)(wid * 32 + row) * ldo + ch * 8) = v; }
        } else if (MODE == 2) {
            const int row = lane_e >> 1, half = lane_e & 1; const float lam = sgt[128];
            const LAS bf16* s1 = stg + row * DV + half * 64; const LAS bf16* s0 = (const LAS bf16*)(lds + STASH_OFF) + wid * (32 * DV) + row * DV + half * 64;
            float ov[64]; float ss = 0.f;
#pragma unroll
            for (int q = 0; q < 8; ++q) { const v4u a = *(const LAS v4u*)(s0 + q * 8), c = *(const LAS v4u*)(s1 + q * 8);
#pragma unroll
                for (int j = 0; j < 4; ++j) { const float lo = __builtin_bit_cast(float, a[j] << 16) - lam * __builtin_bit_cast(float, c[j] << 16);
                    const float hh = __builtin_bit_cast(float, a[j] & 0xffff0000u) - lam * __builtin_bit_cast(float, c[j] & 0xffff0000u);
                    ov[q * 8 + 2 * j] = lo; ov[q * 8 + 2 * j + 1] = hh; ss += lo * lo + hh * hh; } }
            ss += dpp_mov<0xB1>(ss);
            const float rstd = 1.0f / sqrtf(ss * (1.f / 128.f) + 1e-5f);
            bf16* yo = Op + (size_t)(wid * 32 + row) * ldo + half * 64;
#pragma unroll
            for (int q = 0; q < 8; ++q) { const f32x4 g0 = *(const LAS f32x4*)(sgt + half * 64 + q * 8), g1 = *(const LAS f32x4*)(sgt + half * 64 + q * 8 + 4);
                v4u w; w.x = pk2(ov[q * 8] * rstd * g0.x, ov[q * 8 + 1] * rstd * g0.y); w.y = pk2(ov[q * 8 + 2] * rstd * g0.z, ov[q * 8 + 3] * rstd * g0.w);
                w.z = pk2(ov[q * 8 + 4] * rstd * g1.x, ov[q * 8 + 5] * rstd * g1.y); w.w = pk2(ov[q * 8 + 6] * rstd * g1.z, ov[q * 8 + 7] * rstd * g1.w);
                *(v4u*)(yo + q * 8) = w; }
        }
    }
    asm volatile("s_waitcnt lgkmcnt(0)\n\ts_barrier" ::: "memory");
#undef DMA_K
#undef DMA_V
#undef ROT
#undef MFQK
#undef MFPV
#undef MFSUM
#undef ADD_BIAS
#undef MX3
#undef PMAX
#undef PCVT
#undef PSUM
#undef EXPS
#undef STEP
}
#undef SBAR
#undef PIN
}

struct Args { const float* in[27]; float* out; unsigned char* ws; int ph_lo, ph_hi, li, pad; };

constexpr int NPHASE = 17;
constexpr int NWAVES = 8;

#define IN(k) (lo <= (k) && (k) < hi_ph)
#define SEAM(k) do { if (IN(k) && IN((k) + 1)) xcd_barrier(bar); } while (0)
template <int layer>
__device__ __forceinline__ void moe_block(const Args& args, LAS unsigned char* lds, const XcdBarrier& bar, int lo, int hi_ph) {
    volatile LAS unsigned* LC = (volatile LAS unsigned*)(lds + LDSCTL_OFF);
    const int tid = threadIdx.x, lane = tid & 63, wave = __builtin_amdgcn_readfirstlane(tid >> 6);
    const int G = gridDim.x, bx = blockIdx.x;
    const int gw = bx * NWAVES + wave, NGW = G * NWAVES;
    unsigned char* ws = args.ws;
    unsigned* ctl = (unsigned*)(ws + WS_CTL);
    float* xres = args.out;
    bf16* HB = (bf16*)(ws + WS_HB);
    {
        const int pb = layer == 0 ? 5 : 13;
        unsigned* const gcnt0 = ctl + CW_CNT + layer * 64;
        int* list = (int*)(ws + WS_LIST); int* tokep = (int*)(ws + WS_TOKEP); float* gate = (float*)(ws + WS_GATE);
        if (IN(pb)) REP(pb) {
            unsigned* gcnt = gcnt0 + ((MK_N_LAUNCHES == 1 ? (int)((PROBE_MASK >> pb) & 1u) : 0) - rep_) * 128;
            if (rep_ > 0) xcd_barrier(bar);
            const float* gf = args.in[2] + layer * DM;
            const float* WR = (const float*)(ws + WS_TBL) + TBL_WR + layer * WR_LAYER;
            for (int chunk = bx; chunk < NTOK / 128; chunk += G) {
                __syncthreads();
                if (tid < 32) LC[LC_LCNT + tid] = 0u;
                __syncthreads();
                int my_e0 = 0, my_e1 = 0; float my_g0 = 0.f, my_g1 = 0.f;
                {
                    const int ri = lane & 15, kq = lane >> 4; const int r0w = chunk * 128 + wave * 16;
                    const GAS float* xrow = (const GAS float*)(xres + (size_t)(r0w + ri) * DM) + 4 * kq;
                    const GAS float* wb = (const GAS float*)WR + (size_t)(4 * kq) * 48 + ri;
                    f32x4 acc0 = {0.f, 0.f, 0.f, 0.f}, acc1 = acc0, acc2 = acc0; float ss = 0.f;
                    f32x4 aA[4], aB[4]; float bA[48], bB[48];
#define RT_LOAD(a_, b_, g_) do { _Pragma("unroll") for (int c_ = 0; c_ < 4; ++c_) { a_[c_] = *(const GAS f32x4*)(xrow + 16 * (4 * (g_) + c_)); \
        const GAS float* wc_ = wb + (size_t)(16 * (4 * (g_) + c_)) * 48; _Pragma("unroll") for (int e_ = 0; e_ < 4; ++e_) { b_[c_ * 12 + e_ * 3] = wc_[e_ * 48]; b_[c_ * 12 + e_ * 3 + 1] = wc_[e_ * 48 + 16]; b_[c_ * 12 + e_ * 3 + 2] = wc_[e_ * 48 + 32]; } } } while (0)
#define RT_COMP(a_, b_) do { _Pragma("unroll") for (int c_ = 0; c_ < 4; ++c_) { ss += (a_[c_].x * a_[c_].x + a_[c_].y * a_[c_].y) + (a_[c_].z * a_[c_].z + a_[c_].w * a_[c_].w); \
        _Pragma("unroll") for (int e_ = 0; e_ < 4; ++e_) { acc0 = __builtin_amdgcn_mfma_f32_16x16x4f32(a_[c_][e_], b_[c_ * 12 + e_ * 3], acc0, 0, 0, 0); \
            acc1 = __builtin_amdgcn_mfma_f32_16x16x4f32(a_[c_][e_], b_[c_ * 12 + e_ * 3 + 1], acc1, 0, 0, 0); acc2 = __builtin_amdgcn_mfma_f32_16x16x4f32(a_[c_][e_], b_[c_ * 12 + e_ * 3 + 2], acc2, 0, 0, 0); } } } while (0)
                    RT_LOAD(aA, bA, 0);
#pragma unroll 1
                    for (int g = 0; g < 16; g += 2) {
                        RT_LOAD(aB, bB, g + 1);
                        RT_COMP(aA, bA);
                        if (g + 2 < 16) RT_LOAD(aA, bA, g + 2);
                        RT_COMP(aB, bB);
                    }
#undef RT_LOAD
#undef RT_COMP
                    ss += __shfl_xor(ss, 16); ss += __shfl_xor(ss, 32);
                    const float rstd = 1.0f / sqrtf(ss * (1.f / DM) + 1e-6f);
                    LAS float* Lg = (LAS float*)(lds + wave * 4096);
#pragma unroll
                    for (int r = 0; r < 4; ++r) { Lg[(4 * kq + r) * 49 + ri] = acc0[r]; Lg[(4 * kq + r) * 49 + 16 + ri] = acc1[r]; Lg[(4 * kq + r) * 49 + 32 + ri] = acc2[r]; }
                    LDS_WAIT(); asm volatile("" ::: "memory");
                    if (lane < 16) {
                        const GAS float* bv = (const GAS float*)WR + 1024 * 48;
                        float lg[4], le[32];
#pragma unroll
                        for (int e = 0; e < 4; ++e) lg[e] = Lg[lane * 49 + e] * rstd + bv[e];
#pragma unroll
                        for (int e = 0; e < 32; ++e) le[e] = Lg[lane * 49 + 4 + e] * rstd + bv[4 + e];
                        int gi = 0; float gm = lg[0];
#pragma unroll
                        for (int e = 1; e < 4; ++e) if (lg[e] > gm) { gm = lg[e]; gi = e; }
                        float gs = 0.f;
#pragma unroll
                        for (int e = 0; e < 4; ++e) gs += __expf(lg[e] - gm);
                        const float gval = 1.0f / gs;
                        float ev[8];
#pragma unroll
                        for (int j = 0; j < 8; ++j) ev[j] = gi == 0 ? le[j] : (gi == 1 ? le[8 + j] : (gi == 2 ? le[16 + j] : le[24 + j]));
                        int i0 = 0; float m0 = ev[0];
#pragma unroll
                        for (int j = 1; j < 8; ++j) if (ev[j] > m0) { m0 = ev[j]; i0 = j; }
                        int i1 = -1; float m1 = -3.0e38f;
#pragma unroll
                        for (int j = 0; j < 8; ++j) if (j != i0 && ev[j] > m1) { m1 = ev[j]; i1 = j; }
                        const float t1 = __expf(m1 - m0); const float den = 1.0f / (1.0f + t1);
                        my_e0 = gi * 8 + i0; my_e1 = gi * 8 + i1; my_g0 = gval * den; my_g1 = gval * t1 * den;
                    }
                    for (int i = 0; i < 16; ++i) { const int m = r0w + i; f32x4 v[4]; rms_row(xres + (size_t)m * DM, gf, v, lane); store_row_bf16(HB + (size_t)m * DM, v, lane); }
                }
                unsigned r0 = 0, r1 = 0;
                if (lane < 16) { r0 = atomicAdd((unsigned*)(LC + LC_LCNT + my_e0), 1u); r1 = atomicAdd((unsigned*)(LC + LC_LCNT + my_e1), 1u); }
                __syncthreads();
                if (tid < 32) { const unsigned c = LC[LC_LCNT + tid]; LC[LC_LBASE + tid] = c ? __hip_atomic_fetch_add(gcnt + tid, c, RLX_AGENT) : 0u; }
                __syncthreads();
                if (lane < 16) { const int m = chunk * 128 + wave * 16 + lane;
                    const unsigned p0 = LC[LC_LBASE + my_e0] + r0, p1 = LC[LC_LBASE + my_e1] + r1;
                    list[(size_t)my_e0 * LIST_CAP + p0] = m; list[(size_t)my_e1 * LIST_CAP + p1] = m;
                    tokep[2 * m] = my_e0 | (int)(p0 << 8); tokep[2 * m + 1] = my_e1 | (int)(p1 << 8);
                    gate[2 * m] = my_g0; gate[2 * m + 1] = my_g1; }
            }
        }
        SEAM(pb);
        if (IN(pb + 1) || IN(pb + 2) || IN(pb + 3)) {
            __syncthreads();
            if (tid == 0) { int acc = 0; for (int e = 0; e < 32; ++e) { const int c = (int)__hip_atomic_load(gcnt0 + e, RLX_AGENT); LC[LC_CNT + e] = (unsigned)c; LC[LC_TP + e] = (unsigned)acc; acc += (c + 255) >> 8; } LC[LC_TP + 32] = (unsigned)acc;
                int la = 0; for (int j = 0; j < 4; ++j) { LC[LC_LP + j] = (unsigned)la; la += ((int)LC[LC_CNT + (bx & 7) + 8 * j] + 255) >> 8; } LC[LC_LP + 4] = (unsigned)la; }
            __syncthreads();
        }
        const LAS int* tp = (const LAS int*)(lds + LDSCTL_OFF) + LC_TP; const LAS int* cn = (const LAS int*)(lds + LDSCTL_OFF) + LC_CNT; const LAS int* lp = (const LAS int*)(lds + LDSCTL_OFF) + LC_LP;
        if (IN(pb + 1)) REP(pb + 1) {
            pg8::Gemm g{HB, (const bf16*)(ws + WS_W13), 0, 1024, DM};
            pg8::MoeOrder S{tp, cn, lp, list, G, bx, tp[32] * 4, true, G == 256};
            pg8::EpiSwiglu E{(bf16*)(ws + WS_H)};
            pg8::gemm_phase<pg8::EpiSwiglu, pg8::MoeOrder, true>(lds, g, S, E);
        }
        SEAM(pb + 1);
        if (IN(pb + 2)) REP(pb + 2) {
            pg8::Gemm g{(const bf16*)(ws + WS_H), (const bf16*)(ws + WS_W2), 0, 1024, MOE_H};
            pg8::MoeOrder S{tp, cn, lp, list, G, bx, tp[32] * 4, false, G == 256};
            pg8::EpiBf16 E{(bf16*)(ws + WS_YS), DM, 0, 0, 1.f, 3};
            pg8::gemm_phase<pg8::EpiBf16, pg8::MoeOrder, true>(lds, g, S, E);
        }
        SEAM(pb + 2);
        if (IN(pb + 3)) {
            const bf16* YS = (const bf16*)(ws + WS_YS);
            if (layer == 0) { LAS float* scr = (LAS float*)(lds + wave * 16384);
                transpose_moe(args.in[24] + (size_t)NEXP * 1024 * 512, args.in[25] + (size_t)NEXP * 1024 * 512, args.in[26] + (size_t)NEXP * 1024 * 512, (bf16*)(ws + WS_W13), (bf16*)(ws + WS_W2), scr, gw, NGW, lane); }
            const float* gn = layer == 0 ? args.in[1] + DM : args.in[3];
            for (int m = gw; m < NTOK; m += NGW) {
                const int ep0 = tokep[2 * m], ep1 = tokep[2 * m + 1]; const float g0 = gate[2 * m], g1 = gate[2 * m + 1];
                const size_t s0 = (size_t)(tp[ep0 & 255] * 256 + (ep0 >> 8)), s1 = (size_t)(tp[ep1 & 255] * 256 + (ep1 >> 8));
                GAS f32x4* xr = (GAS f32x4*)(xres + (size_t)m * DM) + lane;
                const GAS v2u* y0 = (const GAS v2u*)(YS + s0 * DM) + lane; const GAS v2u* y1 = (const GAS v2u*)(YS + s1 * DM) + lane;
                f32x4 v[4]; float ss = 0.f;
#pragma unroll
                for (int j = 0; j < 4; ++j) { const v2u a = y0[64 * j], c = y1[64 * j]; f32x4 xv = xr[64 * j];
                    xv.x += g0 * __builtin_bit_cast(float, a.x << 16) + g1 * __builtin_bit_cast(float, c.x << 16);
                    xv.y += g0 * __builtin_bit_cast(float, a.x & 0xffff0000u) + g1 * __builtin_bit_cast(float, c.x & 0xffff0000u);
                    xv.z += g0 * __builtin_bit_cast(float, a.y << 16) + g1 * __builtin_bit_cast(float, c.y << 16);
                    xv.w += g0 * __builtin_bit_cast(float, a.y & 0xffff0000u) + g1 * __builtin_bit_cast(float, c.y & 0xffff0000u);
                    v[j] = xv; ss += (xv.x * xv.x + xv.y * xv.y) + (xv.z * xv.z + xv.w * xv.w); }
                const float rstd = 1.0f / sqrtf(wave_sum(ss) * (1.f / DM) + 1e-6f);
                const GAS f32x4* gr = (const GAS f32x4*)gn + lane;
                if (layer == 0) {
#pragma unroll
                    for (int j = 0; j < 4; ++j) xr[64 * j] = v[j];
#pragma unroll
                    for (int j = 0; j < 4; ++j) v[j] = v[j] * rstd * gr[64 * j];
                    store_row_bf16(HB + (size_t)m * DM, v, lane);
                } else {
#pragma unroll
                    for (int j = 0; j < 4; ++j) xr[64 * j] = v[j] * rstd * gr[64 * j];
                }
            }
        }
    }
}

__global__ void __launch_bounds__(NWAVES * 64, 2) mk_fwd(Args args) {
    extern __shared__ __attribute__((aligned(16))) unsigned char lds_raw[];
    LAS unsigned char* lds = (LAS unsigned char*)lds_raw;
    volatile LAS unsigned* LC = (volatile LAS unsigned*)(lds + LDSCTL_OFF);
    const int tid = threadIdx.x, lane = tid & 63, wave = __builtin_amdgcn_readfirstlane(tid >> 6);
    const int G = gridDim.x, bx = blockIdx.x;
    const int gw = bx * NWAVES + wave, NGW = G * NWAVES;
    unsigned char* ws = args.ws;
    unsigned* ctl = (unsigned*)(ws + WS_CTL);
    const float* x_in = args.in[0];
    float* xres = args.out;
    bf16* HB = (bf16*)(ws + WS_HB); bf16* Y = (bf16*)(ws + WS_Y);
    float* TBL = (float*)(ws + WS_TBL);

    for (int u = tid; u < (LDS_BYTES - LDSCTL_OFF) / 4; u += NWAVES * 64) LC[u] = 0u;
    __syncthreads();
    XcdBarrier bar; bar.bar = ctl + CW_BAR; bar.x = 0; bar.st = nullptr;
    if (MK_N_LAUNCHES == 1) bar = xcd_barrier_post(ctl + CW_BAR, LC + LC_BAR);
    const int lo = args.ph_lo, hi_ph = args.ph_hi;

    if (IN(0)) REP(0) {
        LAS float* scr = (LAS float*)(lds + wave * 16384);
        transpose_plain(args.in[4], DM, EV_IN, (bf16*)(ws + WS_WIN0), scr, gw, NGW, lane);
        transpose_plain(args.in[11], DM, DM, (bf16*)(ws + WS_WOUT0), scr, gw, NGW, lane);
        transpose_plain(args.in[12], DM, OD_IN, (bf16*)(ws + WS_WIN1), scr, gw, NGW, lane);
        transpose_plain(args.in[18], DM, DM, (bf16*)(ws + WS_WOUT1), scr, gw, NGW, lane);
        transpose_moe(args.in[24], args.in[25], args.in[26], (bf16*)(ws + WS_W13), (bf16*)(ws + WS_W2), scr, gw, NGW, lane);
        for (int i = bx * 512 + tid; i < 2048; i += G * 512) { const int pos = i >> 4, f = i & 15;
            const float inv = exp2f(-(float)f * (13.287712379549449f / 16.0f));
            const float ang = (float)pos * inv; const float rev = ang * 0.15915494309189535f; const float fr = rev - floorf(rev);
            TBL[TBL_COS + i] = __builtin_amdgcn_cosf(fr); TBL[TBL_SIN + i] = __builtin_amdgcn_sinf(fr); }
        for (int i = bx * 512 + tid; i < 8 * 257; i += G * 512) { const int h = i / 257, j = i % 257;
            TBL[TBL_BIAS + h * BIAS_STRIDE + j] = args.in[19][t5_bucket(j - 128) * 8 + h] * LOG2E; }
        for (int i = bx * 512 + tid; i < 2 * 1024 * 48; i += G * 512) { const int l = i / (1024 * 48), r = i % (1024 * 48), k = r / 48, c = r % 48;
            float w = 0.f; if (c < 4) w = args.in[20][(size_t)l * 4096 + k * 4 + c]; else if (c < 36) w = args.in[22][(size_t)l * 32768 + k * 32 + (c - 4)];
            TBL[TBL_WR + l * WR_LAYER + r] = w * args.in[2][l * DM + k]; }
        for (int i = bx * 512 + tid; i < 2 * 48; i += G * 512) { const int l = i / 48, c = i % 48;
            TBL[TBL_WR + l * WR_LAYER + 1024 * 48 + c] = c < 4 ? args.in[21][l * 4 + c] : (c < 36 ? args.in[23][l * 32 + (c - 4)] : 0.f); }
        for (int m = gw; m < NTOK; m += NGW) { f32x4 v[4]; rms_row(x_in + (size_t)m * DM, args.in[1], v, lane); store_row_bf16(HB + (size_t)m * DM, v, lane); }
    }
    SEAM(0);
    if (IN(1)) REP(1) {
        pg8::Gemm g{HB, (const bf16*)(ws + WS_WIN0), NTOK, EV_IN, DM}; pg8::StaticOrder S; S.init(NTOK, EV_IN, G, bx);
        pg8::EpiBf16 E{(bf16*)(ws + WS_Z0), EV_IN, 0, 0, 1.f, 0xffff};
        pg8::gemm_phase<pg8::EpiBf16, pg8::StaticOrder, true>(lds, g, S, E);
    }
    SEAM(1);
    if (IN(2)) REP(2) {
        const bf16* Z0 = (const bf16*)(ws + WS_Z0); bf16* QR = (bf16*)(ws + WS_QR); bf16* KR = (bf16*)(ws + WS_KR);
        if (QK_FP8 && (ATTN_VER == 1 || ATTN_VER == 3)) {
            for (int it = bx * 512 + tid; it < NTOK * 10; it += G * 512) {
                const bool isq = it < NTOK * 8; const int m = isq ? (it >> 3) : ((it - NTOK * 8) >> 1); const int hh = isq ? (it & 7) : 8 + ((it - NTOK * 8) & 1);
                const float* gn = isq ? args.in[5] : args.in[6];
                const GAS v4u* srcp = (const GAS v4u*)(Z0 + (size_t)m * EV_IN + hh * 64);
                float xv[64]; float ss = 0.f;
#pragma unroll
                for (int q = 0; q < 8; ++q) { const v4u a = srcp[q];
#pragma unroll
                    for (int j = 0; j < 4; ++j) { const float lo = __builtin_bit_cast(float, a[j] << 16), hh2 = __builtin_bit_cast(float, a[j] & 0xffff0000u); xv[q * 8 + 2 * j] = lo; xv[q * 8 + 2 * j + 1] = hh2; ss += lo * lo + hh2 * hh2; } }
                const float rs = (1.0f / sqrtf(ss * (1.f / 64.f) + 1e-6f)) * (isq ? C2 * 8.0f : 1.0f);
                const int sp = m & (SEQ - 1);
                unsigned wout[16];
#pragma unroll
                for (int half = 0; half < 2; ++half) { const int pos = half ? (sp & 63) : (sp >> 6);
                    const GAS f32x4* ct = (const GAS f32x4*)(TBL + TBL_COS + pos * 16); const GAS f32x4* st = (const GAS f32x4*)(TBL + TBL_SIN + pos * 16);
                    float ov[32];
#pragma unroll
                    for (int q = 0; q < 4; ++q) { const f32x4 cv = ct[q], sv = st[q];
#pragma unroll
                        for (int j = 0; j < 4; ++j) { const int i = q * 4 + j; const float a = xv[half * 32 + i] * rs * gn[half * 32 + i], b2 = xv[half * 32 + 16 + i] * rs * gn[half * 32 + 16 + i];
                            ov[i] = a * cv[j] - b2 * sv[j]; ov[16 + i] = b2 * cv[j] + a * sv[j]; } }
#pragma unroll
                    for (int q = 0; q < 8; ++q) { int d = __builtin_amdgcn_cvt_pk_fp8_f32(ov[4 * q], ov[4 * q + 1], 0, false); d = __builtin_amdgcn_cvt_pk_fp8_f32(ov[4 * q + 2], ov[4 * q + 3], d, true); wout[half * 8 + q] = (unsigned)d; } }
                if (!isq && ATTN_VER == 3) {
                    const int strm = (m >> 13) * 2 + (hh - 8); unsigned char* kb_ = ws + WS_K8T0 + ((((size_t)strm * 128 + (sp >> 6)) * 4) * 64 + (sp & 63)) * 16;
#pragma unroll
                    for (int q = 0; q < 4; ++q) *(GAS v4u*)(kb_ + q * 1024) = (v4u){wout[4 * q], wout[4 * q + 1], wout[4 * q + 2], wout[4 * q + 3]};
                } else {
                GAS v4u* dst = isq ? (GAS v4u*)(ws + WS_QR8 + (size_t)m * 512 + hh * 64) : (GAS v4u*)(ws + WS_KR8 + (size_t)m * 128 + (hh - 8) * 64);
#pragma unroll
                for (int q = 0; q < 4; ++q) dst[q] = (v4u){wout[4 * q], wout[4 * q + 1], wout[4 * q + 2], wout[4 * q + 3]};
                }
            }
            if (ATTN_VER == 3) {
                for (int it = bx * 512 + tid; it < 8 * 128 * 4 * 64; it += G * 512) { const int d = it & 63, c = (it >> 6) & 3, tt = (it >> 8) & 127, strm = it >> 15;
                    const bf16* vb_ = Z0 + ((size_t)(strm >> 1) * SEQ + tt * 64) * EV_IN + 640 + (strm & 1) * 64 + d; unsigned w4[4];
#pragma unroll
                    for (int q = 0; q < 4; ++q) { float f[4];
#pragma unroll
                        for (int j = 0; j < 4; ++j) { const int bb = q * 4 + j; const int key = 32 * (c & 1) + (bb & 3) + 8 * (bb >> 2) + 4 * (c >> 1); f[j] = bf2f(vb_[(size_t)key * EV_IN]); }
                        int dw = __builtin_amdgcn_cvt_pk_fp8_f32(f[0], f[1], 0, false); dw = __builtin_amdgcn_cvt_pk_fp8_f32(f[2], f[3], dw, true); w4[q] = (unsigned)dw; }
                    *(GAS v4u*)(ws + WS_V8T0 + (size_t)it * 16) = (v4u){w4[0], w4[1], w4[2], w4[3]}; }
            }
        } else {
        const float gq = args.in[5][lane], gk = args.in[6][lane];
        const int fi = lane & 15; const bool first = (lane & 16) == 0, isrow = lane < 32;
        for (int m = gw; m < NTOK; m += NGW) {
            const int s = m & (SEQ - 1); const int pos = isrow ? (s >> 6) : (s & 63);
            const float cs = TBL[TBL_COS + pos * 16 + fi], sn = TBL[TBL_SIN + pos * 16 + fi];
#pragma unroll
            for (int h = 0; h < 10; ++h) {
                const float xv = bf2f(Z0[(size_t)m * EV_IN + h * 64 + lane]);
                const float ss = wave_sum(xv * xv);
                const float y = xv * (1.0f / sqrtf(ss * (1.f / 64.f) + 1e-6f)) * (h < 8 ? gq : gk);
                const float p = __shfl_xor(y, 16);
                float o = first ? (y * cs - p * sn) : (y * cs + p * sn);
                if (!QK_FP8 || ATTN_VER != 1) { if (h < 8) QR[(size_t)m * 512 + h * 64 + lane] = (bf16)f2bf(o * C2);
                else KR[(size_t)m * 128 + (h - 8) * 64 + lane] = (bf16)f2bf(o); }
                if (QK_FP8) { const unsigned w = quad_pack_bytes(fp8_byte(h < 8 ? o * (C2 * 8.0f) : o));
                    if ((lane & 3) == 0) { if (h < 8) *(unsigned*)(ws + WS_QR8 + (size_t)m * 512 + h * 64 + lane) = w; else *(unsigned*)(ws + WS_KR8 + (size_t)m * 128 + (h - 8) * 64 + lane) = w; } }
            }
        }
        }
        LAS float* hbuf = (LAS float*)lds;
        for (int un = bx; un < NBATCH * 64 * 8; un += G) {
            const int grp = un & 7, tt = (un >> 3) & 63, b = un >> 9; const int t0 = tt * 128;
            __syncthreads();
            for (int idx = tid; idx < 158 * 8; idx += 512) { const int r = idx >> 3, c8 = idx & 7; const int s = t0 - 15 + r;
                f32x4 h0 = {0.f, 0.f, 0.f, 0.f}, h1 = h0;
                if (s >= 0 && s < SEQ) { const size_t ro = (size_t)(b * SEQ + s) * EV_IN + grp * 64 + c8 * 8;
                    const v4u av = *(const GAS v4u*)(Z0 + ro + 768), gv = *(const GAS v4u*)(Z0 + ro + 1280);
#pragma unroll
                    for (int j = 0; j < 4; ++j) { const float a0 = __builtin_bit_cast(float, av[j] << 16), a1 = __builtin_bit_cast(float, av[j] & 0xffff0000u);
                        const float g0 = __builtin_bit_cast(float, gv[j] << 16), g1 = __builtin_bit_cast(float, gv[j] & 0xffff0000u);
                        const float x0 = a0 * __builtin_amdgcn_rcpf(1.0f + __builtin_amdgcn_exp2f(-g0 * LOG2E)), x1 = a1 * __builtin_amdgcn_rcpf(1.0f + __builtin_amdgcn_exp2f(-g1 * LOG2E));
                        if (j < 2) { h0[2 * j] = x0; h0[2 * j + 1] = x1; } else { h1[2 * j - 4] = x0; h1[2 * j - 3] = x1; } } }
                *(LAS f32x4*)(hbuf + r * 64 + c8 * 8) = h0; *(LAS f32x4*)(hbuf + r * 64 + c8 * 8 + 4) = h1; }
            __syncthreads();
            const int ch = grp * 64 + lane;
            float wreg[31];
#pragma unroll
            for (int j = 0; j < 31; ++j) wreg[j] = args.in[7][j * 512 + ch];
            typedef float f32x2 __attribute__((ext_vector_type(2)));
            float acc[16]; const float cb = args.in[8][ch];
            {
                f32x2 he[23], ho[22];
#pragma unroll
                for (int k = 0; k < 23; ++k) { he[k].x = hbuf[(wave * 16 + 2 * k) * 64 + lane]; he[k].y = hbuf[(wave * 16 + 2 * k + 1) * 64 + lane]; }
#pragma unroll
                for (int k = 0; k < 22; ++k) { ho[k].x = he[k].y; ho[k].y = he[k + 1].x; }
                f32x2 a2[8];
#pragma unroll
                for (int p = 0; p < 8; ++p) a2[p] = (f32x2){cb, cb};
#pragma unroll
                for (int j = 0; j < 31; ++j) { const f32x2 wj = (f32x2){wreg[j], wreg[j]};
#pragma unroll
                    for (int p = 0; p < 8; ++p) { const int r = 2 * p + j; a2[p] = __builtin_elementwise_fma(wj, (r & 1) ? ho[r >> 1] : he[r >> 1], a2[p]); } }
#pragma unroll
                for (int p = 0; p < 8; ++p) { acc[2 * p] = a2[p].x; acc[2 * p + 1] = a2[p].y; }
            }
            const float gg = args.in[9][ch], gb = args.in[10][ch];
#pragma unroll
            for (int i = 0; i < 16; ++i) { const float mu = wave_sum(acc[i]) * (1.f / 64.f); const float d = acc[i] - mu; const float var = wave_sum(d * d) * (1.f / 64.f);
                const float hn = d * (1.0f / sqrtf(var + 1e-5f)) * gg + gb; const float ov = hn * __builtin_amdgcn_rcpf(1.0f + __builtin_amdgcn_exp2f(-hn * LOG2E));
                Y[(size_t)(b * SEQ + t0 + wave * 16 + i) * DM + 512 + ch] = (bf16)f2bf(ov); }
        }
    }
    SEAM(2);
    if (IN(3)) REP(3) {
        const bf16* QR = (const bf16*)(ws + WS_QR); const bf16* KR = (const bf16*)(ws + WS_KR); const bf16* Z0 = (const bf16*)(ws + WS_Z0);
        if (ATTN_L0_TEST) {
        for (int un = bx; un < NBATCH * 8 * 32; un += G) {
            const int qb = un & 31, h = (un >> 5) & 7, b = un >> 8, kvh = h >> 2;
            const size_t row0 = (size_t)b * SEQ + qb * 256;
            attn_unit_v0<64, false, true>((const bf16*)(ws + WS_QR8 + row0 * 512 + h * 64), 512, (const bf16*)(ws + WS_KR8 + (size_t)b * SEQ * 128 + kvh * 64), 128, Z0 + (size_t)b * SEQ * EV_IN + 640 + kvh * 64, EV_IN,
                                   Y + row0 * DM + h * 64, DM, nullptr, qb * 256, lds);
        }
        } else if (ATTN_VER == 0) {
        for (int un = bx; un < NBATCH * 8 * 32; un += G) {
            const int qb = un & 31, h = (un >> 5) & 7, b = un >> 8, kvh = h >> 2;
            const size_t row0 = (size_t)b * SEQ + qb * 256;
            attn_unit_v0<64, false>(QR + row0 * 512 + h * 64, 512, KR + (size_t)b * SEQ * 128 + kvh * 64, 128, Z0 + (size_t)b * SEQ * EV_IN + 640 + kvh * 64, EV_IN,
                                   Y + row0 * DM + h * 64, DM, nullptr, qb * 256, lds);
        }
        } else {
        constexpr int U = NBATCH * 8 * 32; const int upc = (U + G - 1) / G; const int vcu = (G % 8 == 0) ? (bx % 8) * (G / 8) + bx / 8 : bx;
        for (int i = 0; i < upc; ++i) { const int un = vcu * upc + i; if (un >= U) break;
            const int stream = un >> 7, b = stream >> 1, kvh = stream & 1, h = kvh * 4 + ((un >> 5) & 3), qb = un & 31;
            const size_t row0 = (size_t)b * SEQ + qb * 256;
            if (ATTN_VER == 3) at3::attn_unit<64, false, 0>(ws + WS_QR8 + row0 * 512 + h * 64, 512, ws + WS_K8T0 + (size_t)stream * 128 * 4096, ws + WS_V8T0 + (size_t)stream * 128 * 4096, Y + row0 * DM + h * 64, DM, qb * 256, lds, nullptr);
            else if (QK_FP8) at1::attn_unit<64, false, 0, 0, true>((const bf16*)(ws + WS_QR8 + row0 * 512 + h * 64), 512, (const bf16*)(ws + WS_KR8 + (size_t)b * SEQ * 128 + kvh * 64), 128, Z0 + (size_t)b * SEQ * EV_IN + 640 + kvh * 64, EV_IN,
                                      Y + row0 * DM + h * 64, DM, qb * 256, lds);
            else at1::attn_unit<64, false>(QR + row0 * 512 + h * 64, 512, KR + (size_t)b * SEQ * 128 + kvh * 64, 128, Z0 + (size_t)b * SEQ * EV_IN + 640 + kvh * 64, EV_IN,
                                      Y + row0 * DM + h * 64, DM, qb * 256, lds);
        }
        }
    }
    SEAM(3);
    if (IN(4)) REP(4) {
        pg8::Gemm g{Y, (const bf16*)(ws + WS_WOUT0), NTOK, DM, DM}; pg8::StaticOrder S; S.init(NTOK, DM, G, bx);
        pg8::EpiRes E{x_in, xres, DM};
        pg8::gemm_phase<pg8::EpiRes, pg8::StaticOrder, true>(lds, g, S, E);
    }
    SEAM(4);

    moe_block<0>(args, lds, bar, lo, hi_ph);
    SEAM(8);
            if (IN(9)) REP(9) {
                pg8::Gemm g{HB, (const bf16*)(ws + WS_WIN1), NTOK, OD_IN, DM}; pg8::StaticOrder S; S.init(NTOK, OD_IN, G, bx);
                if (QK_FP8) { pg8::EpiQKV8 E{ws + WS_Q1, ws + WS_K8T1, (bf16*)(ws + WS_V1), C2 * 8.0f, true};
                    pg8::gemm_phase<pg8::EpiQKV8, pg8::StaticOrder, true>(lds, g, S, E); }
                else { pg8::EpiBf16 E{(bf16*)(ws + WS_Q1), DM, DM, (size_t)(WS_K1 - WS_Q1) / 2, C2, 0xffff};
                pg8::gemm_phase<pg8::EpiBf16, pg8::StaticOrder, true>(lds, g, S, E); }
            }
            SEAM(9);
            if (ATTN_L1_VER == 3) {
            if (IN(10)) {
                const bf16* V1 = (const bf16*)(ws + WS_V1);
                for (int it = bx * 512 + tid; it < 32 * 128 * 4 * 128; it += G * 512) { const int d = it & 127, c = (it >> 7) & 3, tt = (it >> 9) & 127, bh = it >> 16;
                    const bf16* vb_ = V1 + ((size_t)(bh >> 3) * SEQ + tt * 64) * DM + (bh & 7) * 128 + d; unsigned w4[4];
#pragma unroll
                    for (int q = 0; q < 4; ++q) { float f[4];
#pragma unroll
                        for (int j = 0; j < 4; ++j) { const int bb = q * 4 + j; const int key = 32 * (c & 1) + (bb & 3) + 8 * (bb >> 2) + 4 * (c >> 1); f[j] = bf2f(vb_[(size_t)key * DM]); }
                        int dw = __builtin_amdgcn_cvt_pk_fp8_f32(f[0], f[1], 0, false); dw = __builtin_amdgcn_cvt_pk_fp8_f32(f[2], f[3], dw, true); w4[q] = (unsigned)dw; }
                    *(GAS v4u*)(ws + WS_V8T1 + (size_t)it * 16) = (v4u){w4[0], w4[1], w4[2], w4[3]}; }
            }
            SEAM(10);
            if (IN(11)) REP(11) {
                constexpr int UP = NBATCH * 8 * 32; const int upc = (UP + G - 1) / G; const int vcu = (G % 8 == 0) ? (bx % 8) * (G / 8) + bx / 8 : bx;
                LAS float* btbl = (LAS float*)(lds + at3::lds_tbl_off<128>());
                LAS float* sgt = btbl + 272;
                __syncthreads();
                if (tid < 128) sgt[tid] = args.in[17][tid] * (1.0f - LAM_INIT);
                if (wave == 7) { const float lam = __expf(wave_sum(args.in[13][lane] * args.in[14][lane])) - __expf(wave_sum(args.in[15][lane] * args.in[16][lane])) + LAM_INIT; if (lane == 0) sgt[128] = lam; }
                for (int i = 0; i < upc; ++i) {
                    int up = vcu * upc + i; if (up >= UP) break;
                    if (G == 256) up = ((vcu >> 5) * 4 + i) * 32 + (vcu & 31);
                    const int qb = up & 31, h = (up >> 5) & 7, b = up >> 8;
                    __syncthreads();
                    if (tid < 257) btbl[tid] = TBL[TBL_BIAS + h * BIAS_STRIDE + tid] - TBL[TBL_BIAS + h * BIAS_STRIDE + 256];
                    __syncthreads();
                    const size_t row0 = (size_t)b * SEQ + qb * 256; const int bh = b * 8 + h;
                    const unsigned char* Q8 = ws + WS_Q1 + row0 * DM + h * 128; const unsigned char* V8 = ws + WS_V8T1 + (size_t)bh * 128 * 8192;
                    at3::attn_unit<128, true, 1>(Q8, DM, ws + WS_K8T1 + (size_t)(bh * 2) * 128 * 4096, V8, nullptr, DM, qb * 256, lds, sgt);
                    at3::attn_unit<128, true, 2>(Q8 + 64, DM, ws + WS_K8T1 + (size_t)(bh * 2 + 1) * 128 * 4096, V8, Y + row0 * DM + h * 128, DM, qb * 256, lds, sgt);
                }
            }
            SEAM(11);
            } else {
            if (IN(10)) REP(10) {
                const bf16* Q1 = (const bf16*)(ws + WS_Q1); const bf16* K1 = (const bf16*)(ws + WS_K1); const bf16* V1 = (const bf16*)(ws + WS_V1);
                if (ATTN_L1_VER == 0) {
                LAS float* btbl = (LAS float*)(lds + 65536);
                for (int un = bx; un < NBATCH * 8 * 2 * 32; un += G) {
                    const int qb = un & 31, c = (un >> 5) & 1, h = (un >> 6) & 7, b = un >> 9;
                    __syncthreads();
                    if (tid < 257) btbl[tid] = TBL[TBL_BIAS + h * BIAS_STRIDE + tid];
                    __syncthreads();
                    const size_t row0 = (size_t)b * SEQ + qb * 256, brow = (size_t)b * SEQ;
                    bf16* OC = (bf16*)(ws + (c ? WS_OC1 : WS_OC0));
                    attn_unit_v0<128, true>(Q1 + row0 * DM + h * 128 + c * 64, DM, K1 + brow * DM + h * 128 + c * 64, DM, V1 + brow * DM + h * 128, DM,
                                           OC + row0 * DM + h * 128, DM, btbl, qb * 256, lds);
                }
                } else {
                constexpr int UP = NBATCH * 8 * 32; const int upc = (UP + G - 1) / G; const int vcu = (G % 8 == 0) ? (bx % 8) * (G / 8) + bx / 8 : bx;
                LAS float* btbl = (LAS float*)(lds + at1::lds_tbl_off<128, QK_FP8 != 0>());
                LAS float* sgt = btbl + 272;
                __syncthreads();
                if (tid < 128) sgt[tid] = args.in[17][tid] * (1.0f - LAM_INIT);
                if (wave == 7) { const float lam = __expf(wave_sum(args.in[13][lane] * args.in[14][lane])) - __expf(wave_sum(args.in[15][lane] * args.in[16][lane])) + LAM_INIT; if (lane == 0) sgt[128] = lam; }
                for (int i = 0; i < upc; ++i) {
                    int up = vcu * upc + i; if (up >= UP) break;
                    if (G == 256) up = ((vcu >> 5) * 4 + i) * 32 + (vcu & 31);
                    const int qb = up & 31, h = (up >> 5) & 7, b = up >> 8;
                    __syncthreads();
                    if (tid < 257) btbl[tid] = TBL[TBL_BIAS + h * BIAS_STRIDE + tid] - TBL[TBL_BIAS + h * BIAS_STRIDE + 256];
                    __syncthreads();
                    const size_t row0 = (size_t)b * SEQ + qb * 256, brow = (size_t)b * SEQ;
                    if (QK_FP8) { const unsigned char* Q8 = ws + WS_Q1; const unsigned char* K8 = ws + WS_K1;
                    const int bh = b * 8 + h; const bf16* VT = V1 + (size_t)bh * 128 * 8192; const unsigned char* KT0 = ws + WS_K8T1 + (size_t)(bh * 2) * 128 * 4096; (void)K8; (void)brow;
                    at1::attn_unit<128, true, 0, 1, true, true>((const bf16*)(Q8 + row0 * DM + h * 128), DM, (const bf16*)KT0, DM, VT, DM, nullptr, DM, qb * 256, lds, sgt);
                    at1::attn_unit<128, true, 0, 2, true, true>((const bf16*)(Q8 + row0 * DM + h * 128 + 64), DM, (const bf16*)(KT0 + 128 * 4096), DM, VT, DM, Y + row0 * DM + h * 128, DM, qb * 256, lds, sgt);
                    } else {
                    at1::attn_unit<128, true, 0, 1>(Q1 + row0 * DM + h * 128, DM, K1 + brow * DM + h * 128, DM, V1 + brow * DM + h * 128, DM, nullptr, DM, qb * 256, lds, sgt);
                    at1::attn_unit<128, true, 0, 2>(Q1 + row0 * DM + h * 128 + 64, DM, K1 + brow * DM + h * 128 + 64, DM, V1 + brow * DM + h * 128, DM, Y + row0 * DM + h * 128, DM, qb * 256, lds, sgt);
                    }
                }
                }
            }
            SEAM(10);
            if (PROBE_ATT >= 0 && IN(10)) {
                const bf16* Q1 = (const bf16*)(ws + WS_Q1); const bf16* K1 = (const bf16*)(ws + WS_K1); const bf16* V1 = (const bf16*)(ws + WS_V1);
                constexpr int U = NBATCH * 8 * 2 * 32; const int upc = (U + G - 1) / G; const int vcu = (G % 8 == 0) ? (bx % 8) * (G / 8) + bx / 8 : bx;
                LAS float* btbl = (LAS float*)(lds + 3 * 8192 + 3 * 16384 + 2048);
                for (int i = 0; i < upc; ++i) {
                    int un = vcu * upc + i; if (un >= U) break;
                    if (G == 256) un = ((vcu >> 5) * 4 + (i >> 1)) * 64 + (i & 1) * 32 + (vcu & 31);
                    const int qb = un & 31, c = (un >> 5) & 1, h = (un >> 6) & 7, b = un >> 9;
                    if (tid < 257) btbl[tid] = TBL[TBL_BIAS + h * BIAS_STRIDE + tid] - TBL[TBL_BIAS + h * BIAS_STRIDE + 256];
                    __syncthreads();
                    const size_t row0 = (size_t)b * SEQ + qb * 256, brow = (size_t)b * SEQ;
                    at1::attn_unit<128, true, (PROBE_ATT >= 0 ? PROBE_ATT : 0)>(Q1 + row0 * DM + h * 128 + c * 64, DM, K1 + brow * DM + h * 128 + c * 64, DM, V1 + brow * DM + h * 128, DM,
                                              (bf16*)(ws + WS_OC1) + row0 * DM + h * 128, DM, qb * 256, lds);
                }
                xcd_barrier(bar);
            }
            if (IN(11) && ATTN_L1_VER != 1) REP(11) {
                const bf16* OC0 = (const bf16*)(ws + WS_OC0); const bf16* OC1 = (const bf16*)(ws + WS_OC1);
                const float lam = __expf(wave_sum(args.in[13][lane] * args.in[14][lane])) - __expf(wave_sum(args.in[15][lane] * args.in[16][lane])) + LAM_INIT;
                float sg[16];
#pragma unroll
                for (int j = 0; j < 16; ++j) sg[j] = args.in[17][(lane & 7) * 16 + j] * (1.0f - LAM_INIT);
                for (int m = gw; m < NTOK; m += NGW) {
                    const GAS v4u* a = (const GAS v4u*)(OC0 + (size_t)m * DM) + lane * 2; const GAS v4u* c = (const GAS v4u*)(OC1 + (size_t)m * DM) + lane * 2;
                    float o[16]; float ss = 0.f;
#pragma unroll
                    for (int q = 0; q < 2; ++q) { const v4u av = a[q], cv = c[q];
#pragma unroll
                        for (int j = 0; j < 4; ++j) { const unsigned au = av[j], cu = cv[j];
                            const float lo = __builtin_bit_cast(float, au << 16) - lam * __builtin_bit_cast(float, cu << 16);
                            const float hh = __builtin_bit_cast(float, au & 0xffff0000u) - lam * __builtin_bit_cast(float, cu & 0xffff0000u);
                            o[q * 8 + 2 * j] = lo; o[q * 8 + 2 * j + 1] = hh; ss += lo * lo + hh * hh; } }
                    ss += __shfl_xor(ss, 1); ss += __shfl_xor(ss, 2); ss += __shfl_xor(ss, 4);
                    const float rstd = 1.0f / sqrtf(ss * (1.f / 128.f) + 1e-5f);
                    v4u w0, w1;
                    w0.x = pk2(o[0] * rstd * sg[0], o[1] * rstd * sg[1]); w0.y = pk2(o[2] * rstd * sg[2], o[3] * rstd * sg[3]); w0.z = pk2(o[4] * rstd * sg[4], o[5] * rstd * sg[5]); w0.w = pk2(o[6] * rstd * sg[6], o[7] * rstd * sg[7]);
                    w1.x = pk2(o[8] * rstd * sg[8], o[9] * rstd * sg[9]); w1.y = pk2(o[10] * rstd * sg[10], o[11] * rstd * sg[11]); w1.z = pk2(o[12] * rstd * sg[12], o[13] * rstd * sg[13]); w1.w = pk2(o[14] * rstd * sg[14], o[15] * rstd * sg[15]);
                    GAS v4u* yo = (GAS v4u*)(Y + (size_t)m * DM) + lane * 2; yo[0] = w0; yo[1] = w1;
                }
            }
            if (ATTN_L1_VER != 1) SEAM(11);
            }
            if (IN(12)) {
                pg8::Gemm g{Y, (const bf16*)(ws + WS_WOUT1), NTOK, DM, DM}; pg8::StaticOrder S; S.init(NTOK, DM, G, bx);
                pg8::EpiRes E{xres, xres, DM};
                pg8::gemm_phase<pg8::EpiRes, pg8::StaticOrder, true>(lds, g, S, E);
            }
            SEAM(12);
    moe_block<1>(args, lds, bar, lo, hi_ph);
#undef IN
#undef SEAM
}

extern "C" void kernel_launch(void* const* d_in, const int* in_sizes, int n_in, void* d_out, int out_size, void* d_ws, size_t ws_size, hipStream_t stream) {
    static int grid = 0;
    if (grid == 0) {
        if (n_in != 27 || in_sizes[0] != NTOK * DM || out_size != NTOK * DM || ws_size < WS_END) { fprintf(stderr, "kernel_launch: unexpected shapes / workspace (n_in %d, ws %zu)\n", n_in, ws_size); grid = -1; return; }
        int dev = 0, cus = 0, per_cu = 0;
        if (hipGetDevice(&dev) != hipSuccess || hipDeviceGetAttribute(&cus, hipDeviceAttributeMultiprocessorCount, dev) != hipSuccess) { grid = -1; return; }
        if (hipFuncSetAttribute((const void*)mk_fwd, hipFuncAttributeMaxDynamicSharedMemorySize, LDS_BYTES) != hipSuccess) { fprintf(stderr, "kernel_launch: hipFuncSetAttribute failed\n"); grid = -1; return; }
        if (hipOccupancyMaxActiveBlocksPerMultiprocessor(&per_cu, (const void*)mk_fwd, NWAVES * 64, LDS_BYTES) != hipSuccess || per_cu < 1) { fprintf(stderr, "kernel_launch: occupancy query says %d\n", per_cu); }
        (void)hipGetLastError();
        grid = cus;
    }
    if (grid < 0) return;
    if (hipMemsetAsync((char*)d_ws + WS_CTL, 0, CTL_ZERO_BYTES, stream) != hipSuccess) return;
    Args a{};
    for (int i = 0; i < 27; ++i) a.in[i] = (const float*)d_in[i];
    a.out = (float*)d_out; a.ws = (unsigned char*)d_ws;
    if (MK_N_LAUNCHES == 1) { a.ph_lo = 0; a.ph_hi = NPHASE; a.li = 0; hipLaunchKernelGGL(mk_fwd, dim3(grid), dim3(NWAVES * 64), LDS_BYTES, stream, a); }
    else { for (int p = 0; p < NPHASE; ++p) for (int r = 0; r < (int)((PROBE_MASK >> p) & 1u) + 1; ++r) { a.ph_lo = p; a.ph_hi = p + 1; a.li = p; hipLaunchKernelGGL(mk_fwd, dim3(grid), dim3(NWAVES * 64), LDS_BYTES, stream, a); } }
}
```

```cpp
#include <hip/hip_runtime.h>
#include <cstdio>
#include <cstdint>

#ifndef MK_N_LAUNCHES
#define MK_N_LAUNCHES 1
#endif

#ifndef ATTN_VER
#define ATTN_VER 3
#endif
#ifndef PROBE_ATT
#define PROBE_ATT -1
#endif
#ifndef QK_FP8
#define QK_FP8 1
#endif
#ifndef ATTN_L0_TEST
#define ATTN_L0_TEST 0
#endif
#ifndef ATTN_L1_VER
#define ATTN_L1_VER 1
#endif
#ifndef MOE_FP8
#define MOE_FP8 1
#endif
#ifndef PROBE_MASK
#define PROBE_MASK 0u
#endif
#define REP(k) _Pragma("unroll") for (int rep_ = 0; rep_ < (MK_N_LAUNCHES == 1 ? (int)((PROBE_MASK >> (k)) & 1u) : 0) + 1; ++rep_)
#define GAS __attribute__((address_space(1)))
#define LAS __attribute__((address_space(3)))
typedef unsigned short bf16;
typedef unsigned v4u __attribute__((ext_vector_type(4)));
typedef unsigned v2u __attribute__((ext_vector_type(2)));
typedef float f32x4 __attribute__((ext_vector_type(4)));
typedef float f32x16 __attribute__((ext_vector_type(16)));
typedef short bf16x8 __attribute__((ext_vector_type(8)));
typedef short s16x4 __attribute__((ext_vector_type(4)));
typedef int v8i __attribute__((ext_vector_type(8)));

constexpr int NTOK = 32768, DM = 1024, SEQ = 8192, NBATCH = 4;
constexpr int EV_IN = 1792, OD_IN = 3072;
constexpr int NEXP = 32, MOE_H = 512, LIST_CAP = 32768;
constexpr float C2 = 0.125f * 1.4426950408889634f;
constexpr float LOG2E = 1.4426950408889634f;
constexpr float LAM_INIT = 0.35550906759f;

constexpr size_t MiB = 1u << 20;
constexpr size_t WS_CTL = 0, CTL_ZERO_BYTES = 1 * MiB;
constexpr size_t WS_WIN0 = 1 * MiB, WS_WOUT0 = 5 * MiB, WS_WIN1 = 7 * MiB, WS_WOUT1 = 13 * MiB, WS_TBL = 15 * MiB;
constexpr size_t WS_W13 = 16 * MiB, WS_W2 = 80 * MiB;
constexpr size_t WS_HB = 112 * MiB;
constexpr size_t WS_Y = 176 * MiB;
constexpr size_t WS_Z0 = 240 * MiB, WS_QR = 352 * MiB, WS_KR = 384 * MiB, WS_QR8 = 392 * MiB, WS_KR8 = 408 * MiB, WS_K8T0 = 408 * MiB, WS_V8T0 = 412 * MiB;
constexpr size_t WS_K8T1 = 304 * MiB, WS_V8T1 = 336 * MiB;
constexpr size_t WS_Q1 = 240 * MiB, WS_K1 = 304 * MiB, WS_V1 = 368 * MiB, WS_OC1 = 432 * MiB, WS_OC0 = WS_HB;
constexpr size_t WS_H = 176 * MiB, WS_YS = 248 * MiB, WS_LIST = 392 * MiB, WS_TOKEP = 396 * MiB, WS_GATE = 396 * MiB + 512 * 1024;
constexpr size_t WS_END = 496 * MiB;
constexpr int TBL_COS = 0, TBL_SIN = 2048, TBL_BIAS = 4096, BIAS_STRIDE = 272;
constexpr int TBL_WR = 32768, WR_LAYER = 1024 * 48 + 64;
constexpr int CW_BAR = 4096;
constexpr int CW_CNT = 16384;

constexpr int RING_BYTES = 131072;
constexpr int LDS_BYTES = 147456;
constexpr int LDSCTL_OFF = LDS_BYTES - 1024;
constexpr int STASH_OFF = 78 * 1024;
constexpr int LC_BAR = 8;
constexpr int LC_TP = 16;
constexpr int LC_CNT = 64;
constexpr int LC_LCNT = 96;
constexpr int LC_LBASE = 128;
constexpr int LC_LP = 160;

#define LDS_WAIT() asm volatile("s_waitcnt lgkmcnt(0)" ::: "memory")
#define VM_WAIT() asm volatile("s_waitcnt vmcnt(0)" ::: "memory")
#define RLX_AGENT __ATOMIC_RELAXED, __HIP_MEMORY_SCOPE_AGENT

__device__ __forceinline__ unsigned f2bf(float f) { unsigned u = __builtin_bit_cast(unsigned, f); return (u + 0x7fffu + ((u >> 16) & 1u)) >> 16; }
__device__ __forceinline__ unsigned pk2(float lo, float hi) { return f2bf(lo) | (f2bf(hi) << 16); }
__device__ __forceinline__ float bf2f(unsigned short b) { return __builtin_bit_cast(float, (unsigned)b << 16); }
template <int CTRL> __device__ __forceinline__ float dpp_mov(float v) { return __builtin_bit_cast(float, __builtin_amdgcn_update_dpp(0, __builtin_bit_cast(int, v), CTRL, 0xf, 0xf, true)); }
__device__ __forceinline__ float wave_sum(float v) {
    v += dpp_mov<0xB1>(v); v += dpp_mov<0x4E>(v); v += dpp_mov<0x141>(v); v += dpp_mov<0x140>(v);
    { auto rr = __builtin_amdgcn_permlane16_swap(__float_as_uint(v), __float_as_uint(v), false, false); v = __uint_as_float(rr[0]) + __uint_as_float(rr[1]); }
    { auto rr = __builtin_amdgcn_permlane32_swap(__float_as_uint(v), __float_as_uint(v), false, false); v = __uint_as_float(rr[0]) + __uint_as_float(rr[1]); }
    return v;
}


__device__ __forceinline__ unsigned fp8_byte(float v) { return (unsigned)__builtin_amdgcn_cvt_pk_fp8_f32(v, v, 0, false) & 0xffu; }
__device__ __forceinline__ unsigned quad_pack_bytes(unsigned b) {
    const unsigned x0 = (unsigned)__builtin_amdgcn_update_dpp(0, (int)b, 0x00, 0xf, 0xf, true), x1 = (unsigned)__builtin_amdgcn_update_dpp(0, (int)b, 0x55, 0xf, 0xf, true);
    const unsigned x2 = (unsigned)__builtin_amdgcn_update_dpp(0, (int)b, 0xAA, 0xf, 0xf, true), x3 = (unsigned)__builtin_amdgcn_update_dpp(0, (int)b, 0xFF, 0xf, 0xf, true);
    return x0 | (x1 << 8) | (x2 << 16) | (x3 << 24);
}
namespace pg8 {
#define PG8_LAS __attribute__((address_space(3)))
typedef unsigned short bf16_t;
typedef short bf16x8 __attribute__((ext_vector_type(8)));
typedef float f32x4 __attribute__((ext_vector_type(4)));
typedef unsigned u32x4 __attribute__((ext_vector_type(4)));
constexpr int BM = 256, BK = 64, HALF = 128, HTB = HALF * BK * 2, STAGE_BYTES = 8 * HTB, NXCD = 8, WGM = 8;

__host__ __device__ __forceinline__ int lds_byte(int r, int c) { const int st = (r >> 4) * 2 + (c >> 5), rr = r & 15, cc = c & 31, ob = rr * 64 + cc * 2; return st * 1024 + (ob ^ (((ob >> 9) & 1) << 5)); }
__host__ __device__ __forceinline__ void stage_rc(int b, int& R, int& C) { const int st = b / 1024, sb = b % 1024, swz = sb ^ (((sb >> 9) & 1) << 5); R = (st >> 1) * 16 + swz / 64; C = (st & 1) * 32 + (swz % 64) / 2; }
__host__ __device__ __forceinline__ int perm32(int rho) { const int n = rho >> 4, i = rho & 15; return 8 * (i >> 2) + 4 * n + (i & 3); }

struct Unit { int pm, pn, e, rb; };
struct Gemm { const bf16_t* A; const bf16_t* Bt; int M, N, K; };

struct StaticOrder {
    int nM, nN, nwg, G, c;
    __device__ void init(int M, int N, int G_, int c_) { nM = M / BM; nN = N / BM; nwg = nM * nN; G = G_; c = c_; }
    __device__ bool next(int i, Unit& u) const {
        const long L = (long)i * G + c; if (L >= nwg) return false;
        int wgid = (int)L; { const int q = nwg / NXCD, r = nwg % NXCD, xcd = wgid % NXCD, off = wgid / NXCD; wgid = (xcd < r ? xcd * (q + 1) : r * (q + 1) + (xcd - r) * q) + off; }
        const int nig = WGM * nN, gid = wgid / nig, fm = gid * WGM, gsz = (nM - fm) < WGM ? (nM - fm) : WGM;
        u.pm = fm + ((wgid % nig) % gsz); u.pn = (wgid % nig) / gsz; u.e = 0; u.rb = 0; return true;
    }
    __device__ __forceinline__ unsigned arow(const Unit& u, int rr) const { return (unsigned)(u.pm * BM + rr); }
};

struct MoeOrder {
    const PG8_LAS int* tp; const PG8_LAS int* cn; const PG8_LAS int* lp; const int* list; int G, c, nunits; bool gather; bool xcd;
    __device__ __forceinline__ bool next(int i, Unit& u) const {
        int e_, rb_, pm_, pnl_; bool ok;
        if (xcd) {
            const int x = c & 7, y = c >> 3; const int uidx = i * 32 + y; ok = uidx < lp[4] * 4;
            const int rbl = uidx >> 2; pnl_ = uidx & 3; int j = 0;
#pragma unroll
            for (int q = 1; q < 4; ++q) j += (lp[q] <= rbl) ? 1 : 0;
            e_ = x + 8 * j; rb_ = rbl - lp[j]; pm_ = tp[e_] + rb_;
        } else {
            const int L = i * G + c; ok = L < nunits;
            const int rbg = L >> 2; pnl_ = L & 3; int e = 0;
#pragma unroll
            for (int j = 1; j < 32; ++j) e += (tp[j] <= rbg) ? 1 : 0;
            e_ = e; pm_ = rbg; rb_ = rbg - tp[e];
        }
        u.e = __builtin_amdgcn_readfirstlane(e_); u.rb = __builtin_amdgcn_readfirstlane(rb_); u.pm = __builtin_amdgcn_readfirstlane(pm_); u.pn = __builtin_amdgcn_readfirstlane(e_ * 4 + pnl_);
        return ok;
    }
    __device__ __forceinline__ unsigned arow(const Unit& u, int rr) const {
        if (!gather) return (unsigned)(u.pm * BM + rr);
        const int idx = u.rb * BM + rr; unsigned t = 0u;
        if (idx < cn[u.e]) t = (unsigned)list[(size_t)u.e * 32768 + idx];
        return t;
    }
};

__device__ __forceinline__ unsigned cvt_pk_bf16(float lo, float hi) { unsigned r; asm volatile("v_cvt_pk_bf16_f32 %0, %1, %2" : "=v"(r) : "v"(lo), "v"(hi)); return r; }

struct EpiBf16 {
    static constexpr bool PERM = true;
    bf16_t* O; int ldc; int split_cols; size_t split_stride; float scale0; int pn_mask;
    __device__ __forceinline__ void operator()(const f32x4 (&acc)[2][2][4][2], const Unit& u, int wr, int wc, int fr, int fq) const {
        const int row0 = u.pm * BM + wr * 64 + fr; int colt = (u.pn & pn_mask) * BM; bf16_t* base = O;
        float sc = 1.f; if (split_cols) { const int t = colt / split_cols; base += (size_t)t * split_stride; colt -= t * split_cols; if (t == 0) sc = scale0; }
        const int col0 = colt + wc * 32 + 8 * fq;
#pragma unroll
        for (int ai = 0; ai < 2; ++ai)
#pragma unroll
            for (int m = 0; m < 4; ++m) { bf16_t* rowp = base + (size_t)(row0 + ai * HALF + m * 16) * ldc + col0;
#pragma unroll
                for (int bj = 0; bj < 2; ++bj) { f32x4 v0 = acc[ai][bj][m][0] * sc, v1 = acc[ai][bj][m][1] * sc;
                    u32x4 w; w.x = cvt_pk_bf16(v0[0], v0[1]); w.y = cvt_pk_bf16(v0[2], v0[3]); w.z = cvt_pk_bf16(v1[0], v1[1]); w.w = cvt_pk_bf16(v1[2], v1[3]);
                    *(u32x4*)(rowp + bj * HALF) = w; } }
    }
};
struct EpiRes {
    static constexpr bool PERM = false;
    const float* base; float* out; int ldc;
    __device__ __forceinline__ void operator()(const f32x4 (&acc)[2][2][4][2], const Unit& u, int wr, int wc, int fr, int fq) const {
        const int row0 = u.pm * BM + wr * 64 + fr, col0 = u.pn * BM + wc * 32 + 4 * fq;
#pragma unroll
        for (int ai = 0; ai < 2; ++ai)
#pragma unroll
            for (int m = 0; m < 4; ++m) { const size_t off = (size_t)(row0 + ai * HALF + m * 16) * ldc + col0;
#pragma unroll
                for (int bj = 0; bj < 2; ++bj)
#pragma unroll
                    for (int n = 0; n < 2; ++n) { const f32x4 bs = *(const f32x4*)(base + off + bj * HALF + n * 16); *(f32x4*)(out + off + bj * HALF + n * 16) = bs + acc[ai][bj][m][n]; } }
    }
};
struct EpiQKV8 {
    static constexpr bool PERM = true;
    unsigned char* Q8; unsigned char* K8; bf16_t* V; float qscale; bool ktiled;
    __device__ __forceinline__ void operator()(const f32x4 (&acc)[2][2][4][2], const Unit& u, int wr, int wc, int fr, int fq) const {
        const int row0 = u.pm * BM + wr * 64 + fr; const int colt = u.pn * BM; const int t = colt >> 10; const int col0 = (colt & 1023) + wc * 32 + 8 * fq;
        const float sc = t == 0 ? qscale : 1.0f;
#pragma unroll
        for (int ai = 0; ai < 2; ++ai)
#pragma unroll
            for (int m = 0; m < 4; ++m) { const size_t ro = (size_t)(row0 + ai * HALF + m * 16) * 1024 + col0;
#pragma unroll
                for (int bj = 0; bj < 2; ++bj) { const f32x4 v0 = acc[ai][bj][m][0] * sc, v1 = acc[ai][bj][m][1] * sc;
                    if (t == 2) { u32x4 w; w.x = cvt_pk_bf16(v0[0], v0[1]); w.y = cvt_pk_bf16(v0[2], v0[3]); w.z = cvt_pk_bf16(v1[0], v1[1]); w.w = cvt_pk_bf16(v1[2], v1[3]);
                        if (ktiled) { const int mrow = row0 + ai * HALF + m * 16, n = col0 + bj * HALF; const int bh = (mrow >> 13) * 8 + (n >> 7), sq = mrow & 8191, d = n & 127;
                            *(u32x4*)(V + (((size_t)bh * 128 + (sq >> 6)) * 4 + (d >> 5)) * 2048 + (sq & 63) * 32 + (d & 31)) = w; }
                        else *(u32x4*)(V + ro + bj * HALF) = w; }
                    else { int d0 = __builtin_amdgcn_cvt_pk_fp8_f32(v0[0], v0[1], 0, false); d0 = __builtin_amdgcn_cvt_pk_fp8_f32(v0[2], v0[3], d0, true);
                        int d1 = __builtin_amdgcn_cvt_pk_fp8_f32(v1[0], v1[1], 0, false); d1 = __builtin_amdgcn_cvt_pk_fp8_f32(v1[2], v1[3], d1, true);
                        typedef int i32x2 __attribute__((ext_vector_type(2)));
                        if (t == 1 && ktiled) { const int mrow = row0 + ai * HALF + m * 16, n = col0 + bj * HALF; const int strm = ((mrow >> 13) * 8 + (n >> 7)) * 2 + ((n >> 6) & 1), sq = mrow & 8191, dd = n & 63;
                            *(i32x2*)(K8 + ((((size_t)strm * 128 + (sq >> 6)) * 4 + (dd >> 4)) * 64 + (sq & 63)) * 16 + (dd & 15)) = (i32x2){d0, d1}; }
                        else *(i32x2*)((t == 0 ? Q8 : K8) + ro + bj * HALF) = (i32x2){d0, d1}; } } }
    }
};
__device__ __forceinline__ float silu_mul(float a, float b) { return a * b * __builtin_amdgcn_rcpf(1.0f + __builtin_amdgcn_exp2f(-a * 1.4426950408889634f)); }
struct EpiSwiglu {
    static constexpr bool PERM = true;
    bf16_t* O; bool f8;
    __device__ __forceinline__ void operator()(const f32x4 (&acc)[2][2][4][2], const Unit& u, int wr, int wc, int fr, int fq) const {
        const int row0 = u.pm * BM + wr * 64 + fr, col0 = (u.pn & 3) * 128 + wc * 32 + 8 * fq;
#pragma unroll
        for (int ai = 0; ai < 2; ++ai)
#pragma unroll
            for (int m = 0; m < 4; ++m) { const size_t ro = (size_t)(row0 + ai * HALF + m * 16) * 512 + col0;
                const f32x4 a0 = acc[ai][0][m][0], a1 = acc[ai][0][m][1], b0 = acc[ai][1][m][0], b1 = acc[ai][1][m][1];
                if (f8) { typedef unsigned u32x2 __attribute__((ext_vector_type(2)));
                    int d0 = __builtin_amdgcn_cvt_pk_fp8_f32(4.f * silu_mul(a0[0], b0[0]), 4.f * silu_mul(a0[1], b0[1]), 0, false); d0 = __builtin_amdgcn_cvt_pk_fp8_f32(4.f * silu_mul(a0[2], b0[2]), 4.f * silu_mul(a0[3], b0[3]), d0, true);
                    int d1 = __builtin_amdgcn_cvt_pk_fp8_f32(4.f * silu_mul(a1[0], b1[0]), 4.f * silu_mul(a1[1], b1[1]), 0, false); d1 = __builtin_amdgcn_cvt_pk_fp8_f32(4.f * silu_mul(a1[2], b1[2]), 4.f * silu_mul(a1[3], b1[3]), d1, true);
                    *(u32x2*)((unsigned char*)O + ro) = (u32x2){(unsigned)d0, (unsigned)d1};
                } else {
                u32x4 w; w.x = cvt_pk_bf16(silu_mul(a0[0], b0[0]), silu_mul(a0[1], b0[1])); w.y = cvt_pk_bf16(silu_mul(a0[2], b0[2]), silu_mul(a0[3], b0[3]));
                w.z = cvt_pk_bf16(silu_mul(a1[0], b1[0]), silu_mul(a1[1], b1[1])); w.w = cvt_pk_bf16(silu_mul(a1[2], b1[2]), silu_mul(a1[3], b1[3]));
                *(u32x4*)(O + ro) = w; } }
    }
};

template <class Epi, class Sched, bool ALIGN_EPI, bool F8 = false, int SCA = 127, int SCB = 127>
__device__ __forceinline__ void gemm_phase(PG8_LAS unsigned char* lds, const Gemm g, const Sched& S, const Epi& E) {
    const int tid = threadIdx.x, wid = __builtin_amdgcn_readfirstlane(tid >> 6), lane = tid & 63, wr = wid >> 2, wc = wid & 3, fr = lane & 15, fq = lane >> 4;
    const int K = g.K, nt = K / BK;
    int RA[2], CA[2]; unsigned voffB[2];
#pragma unroll
    for (int i = 0; i < 2; ++i) { int R, C; stage_rc(tid * 16 + i * 8192, R, C); RA[i] = R; CA[i] = C; const int Rb = Epi::PERM ? ((R & ~31) + perm32(R & 31)) : R; voffB[i] = (unsigned)(Rb * K + C) * 2u; }
    const size_t kstep = (size_t)(BK * 2);
    const size_t hstep = (size_t)HALF * K * 2;
    const size_t tstep = 2 * hstep;
    const unsigned ldsw = (unsigned)wid * 1024u;
    const int aoff = lds_byte(wr * 64 + fr, fq * 8), boff = lds_byte(wc * 32 + fr, fq * 8);
#define PG8_SA(b, h) (((b) * 2 + (h)) * HTB)
#define PG8_SB(b, h) ((4 + (b) * 2 + (h)) * HTB)
#define PG8_STAGE(bufoff, gbase, voff) do { _Pragma("unroll") for (int _i = 0; _i < 2; ++_i) \
        __builtin_amdgcn_global_load_lds((const unsigned*)((const char*)(gbase) + (voff)[_i]), (PG8_LAS unsigned*)(lds + (bufoff) + ldsw + _i * 8192), 16, 0, 0); } while (0)
#define PG8_LD8(p_) ({ typedef int v4i_ __attribute__((ext_vector_type(4))); const v4i_ lo_ = *(const PG8_LAS v4i_*)(p_), hi_ = *(const PG8_LAS v4i_*)((p_) + 1024); __builtin_shufflevector(lo_, hi_, 0, 1, 2, 3, 4, 5, 6, 7); })
#define PG8_LDA(dst, b, h) do { if (F8) { _Pragma("unroll") for (int m = 0; m < 4; ++m) dst##8[m] = PG8_LD8(lds + PG8_SA(b, h) + aoff + m * 2048); } \
        else { _Pragma("unroll") for (int m = 0; m < 4; ++m) _Pragma("unroll") for (int k = 0; k < 2; ++k) dst[m][k] = *(const PG8_LAS bf16x8*)(lds + PG8_SA(b, h) + aoff + m * 2048 + k * 1024); } } while (0)
#define PG8_LDB(dst, b, h) do { if (F8) { _Pragma("unroll") for (int n = 0; n < 2; ++n) dst##8[n] = PG8_LD8(lds + PG8_SB(b, h) + boff + n * 2048); } \
        else { _Pragma("unroll") for (int n = 0; n < 2; ++n) _Pragma("unroll") for (int k = 0; k < 2; ++k) dst[n][k] = *(const PG8_LAS bf16x8*)(lds + PG8_SB(b, h) + boff + n * 2048 + k * 1024); } } while (0)
#define PG8_MMA(ai, bj, At, Bt) do { __builtin_amdgcn_s_setprio(1); \
        if (F8) { _Pragma("unroll") for (int m = 0; m < 4; ++m) _Pragma("unroll") for (int n = 0; n < 2; ++n) \
            asm volatile("v_mfma_scale_f32_16x16x128_f8f6f4 %0, %1, %2, %0, %3, %4 op_sel_hi:[0,0,0]" : "+v"(acc[ai][bj][m][n]) : "v"(Bt##8[n]), "v"(At##8[m]), "v"(scb_), "v"(sca_)); } \
        else { _Pragma("unroll") for (int m = 0; m < 4; ++m) _Pragma("unroll") for (int n = 0; n < 2; ++n) _Pragma("unroll") for (int k = 0; k < 2; ++k) \
        acc[ai][bj][m][n] = __builtin_amdgcn_mfma_f32_16x16x32_bf16(Bt[n][k], At[m][k], acc[ai][bj][m][n], 0, 0, 0); } __builtin_amdgcn_s_setprio(0); } while (0)
#define PG8_WAIT_V(n) asm volatile("s_waitcnt vmcnt(" #n ")" ::: "memory")
#define PG8_WAIT_L(n) asm volatile("s_waitcnt lgkmcnt(" #n ")" ::: "memory")
#define PG8_BAR __builtin_amdgcn_s_barrier()
#define PG8_SCHED __builtin_amdgcn_sched_barrier(0)
#define PG8_AOFF(dst, u) do { _Pragma("unroll") for (int _h = 0; _h < 2; ++_h) _Pragma("unroll") for (int _i = 0; _i < 2; ++_i) dst[_h][_i] = (S.arow(u, _h * HALF + RA[_i]) * (unsigned)K + (unsigned)CA[_i]) * 2u; } while (0)
    Unit cur, nxt; int ui = 0;
    if (!S.next(0, cur)) return;
    f32x4 acc[2][2][4][2];
#pragma unroll
    for (int a = 0; a < 2; ++a)
#pragma unroll
        for (int b = 0; b < 2; ++b)
#pragma unroll
            for (int m = 0; m < 4; ++m)
#pragma unroll
                for (int n = 0; n < 2; ++n) acc[a][b][m][n] = (f32x4){0.f, 0.f, 0.f, 0.f};
    bf16x8 At[4][2], B0[2][2], B1[2][2]; v8i At8[4], B08[2], B18[2]; const int sca_ = SCA * 0x01010101, scb_ = SCB * 0x01010101;
    unsigned offc[2][2], offn[2][2];
    PG8_AOFF(offc, cur);
    const char* const cA = (const char*)g.A; const char* cB = (const char*)g.Bt + (size_t)cur.pn * tstep;
    PG8_STAGE(PG8_SB(0, 0), cB, voffB); PG8_STAGE(PG8_SB(0, 1), cB + hstep, voffB); PG8_STAGE(PG8_SA(0, 0), cA, offc[0]); PG8_STAGE(PG8_SA(0, 1), cA, offc[1]);
    if (wr == 1) PG8_BAR;
    PG8_WAIT_V(2); PG8_BAR;
    PG8_STAGE(PG8_SB(1, 0), cB + kstep, voffB); PG8_STAGE(PG8_SA(1, 0), cA + kstep, offc[0]); PG8_STAGE(PG8_SB(1, 1), cB + hstep + kstep, voffB);
    PG8_WAIT_V(6); PG8_BAR;
    for (;;) {
        const bool has_next = S.next(ui + 1, nxt);
        if (has_next) { PG8_AOFF(offn, nxt); }
        else {
#pragma unroll
            for (int h = 0; h < 2; ++h)
#pragma unroll
                for (int i = 0; i < 2; ++i) offn[h][i] = offc[h][i]; }
        const char* nB = has_next ? (const char*)g.Bt + (size_t)nxt.pn * tstep : cB;
        for (int t = 0; t < nt; t += 2) {
            const bool last = (t == nt - 2);
            const char* a1 = cA + (size_t)(t + 1) * kstep;
            const char* a2 = last ? cA : cA + (size_t)(t + 2) * kstep; const char* b2 = last ? nB : cB + (size_t)(t + 2) * kstep;
            const char* a3 = a2 + kstep; const char* b3 = b2 + kstep;
            unsigned o2[2][2];
#pragma unroll
            for (int h = 0; h < 2; ++h)
#pragma unroll
                for (int i = 0; i < 2; ++i) o2[h][i] = last ? offn[h][i] : offc[h][i];
            PG8_LDB(B0, 0, 0); PG8_LDB(B1, 0, 1); PG8_SCHED; PG8_LDA(At, 0, 0); PG8_STAGE(PG8_SA(1, 1), a1, offc[1]);
            PG8_WAIT_V(8); PG8_WAIT_L(0); PG8_BAR; PG8_MMA(0, 0, At, B0); PG8_MMA(0, 1, At, B1); PG8_BAR; PG8_SCHED;
            PG8_LDA(At, 0, 1); PG8_STAGE(PG8_SB(0, 0), b2, voffB); PG8_STAGE(PG8_SB(0, 1), b2 + hstep, voffB); PG8_STAGE(PG8_SA(0, 0), a2, o2[0]);
            PG8_WAIT_V(8); PG8_WAIT_L(0); PG8_BAR; PG8_MMA(1, 0, At, B0); PG8_MMA(1, 1, At, B1); PG8_BAR; PG8_SCHED;
            PG8_LDB(B0, 1, 0); PG8_LDB(B1, 1, 1); PG8_SCHED; PG8_LDA(At, 1, 0); PG8_STAGE(PG8_SA(0, 1), a2, o2[1]);
            PG8_WAIT_V(8); PG8_WAIT_L(0); PG8_BAR; PG8_MMA(0, 0, At, B0); PG8_MMA(0, 1, At, B1); PG8_BAR; PG8_SCHED;
            PG8_LDA(At, 1, 1); PG8_STAGE(PG8_SB(1, 0), b3, voffB); PG8_STAGE(PG8_SB(1, 1), b3 + hstep, voffB); PG8_STAGE(PG8_SA(1, 0), a3, o2[0]);
            PG8_WAIT_V(8); PG8_WAIT_L(0); PG8_BAR; PG8_MMA(1, 0, At, B0); PG8_MMA(1, 1, At, B1); PG8_BAR; PG8_SCHED;
        }
        if constexpr (ALIGN_EPI) { if (wr == 0) PG8_BAR; }
        if (F8) asm volatile("s_nop 15\n\ts_nop 15" ::: "memory");
        E(acc, cur, wr, wc, fr, fq);
        if (!has_next) break;
#pragma unroll
        for (int a = 0; a < 2; ++a)
#pragma unroll
            for (int b = 0; b < 2; ++b)
#pragma unroll
                for (int m = 0; m < 4; ++m)
#pragma unroll
                    for (int n = 0; n < 2; ++n) acc[a][b][m][n] = (f32x4){0.f, 0.f, 0.f, 0.f};
        cur = nxt; cB = nB; ++ui;
#pragma unroll
        for (int h = 0; h < 2; ++h)
#pragma unroll
            for (int i = 0; i < 2; ++i) offc[h][i] = offn[h][i];
        if constexpr (ALIGN_EPI) { if (wr == 1) PG8_BAR; }
    }
    PG8_WAIT_V(0);
    if constexpr (!ALIGN_EPI) { if (wr == 0) PG8_BAR; }
    PG8_BAR;
#undef PG8_SA
#undef PG8_SB
#undef PG8_STAGE
#undef PG8_LDA
#undef PG8_LDB
#undef PG8_MMA
#undef PG8_LD8
#undef PG8_WAIT_V
#undef PG8_WAIT_L
#undef PG8_BAR
#undef PG8_SCHED
#undef PG8_AOFF
}
}

#define XB_TMO      128
#define XB_XCNT(j)  (256  + 64 * (j))
#define XB_XSUB(j)  (1280 + 64 * (j))
#define XB_XGEN(j)  (2304 + 64 * (j))
#define XB_TOP      3328
#define XB_TOPGEN   3392
#define XCD_BAR_WORDS 3456
#define XB_SPIN_CAP (1u << 18)

__device__ __forceinline__ unsigned xb_ld(unsigned* p)              { return __hip_atomic_load(p, __ATOMIC_RELAXED, __HIP_MEMORY_SCOPE_AGENT); }
__device__ __forceinline__ unsigned xb_add(unsigned* p, unsigned v) { return __hip_atomic_fetch_add(p, v, __ATOMIC_RELAXED, __HIP_MEMORY_SCOPE_AGENT); }
__device__ __forceinline__ unsigned xb_xcc_id() { return (unsigned)__builtin_amdgcn_s_getreg((3 << 11) | 20) & 0xFu; }
#define XB_SPIN(cond, bar) do { unsigned _sp = 0; while (cond) { __builtin_amdgcn_s_sleep(1); \
    if ((++_sp & 255u) == 0u) { if (xb_ld(&(bar)[XB_TMO])) break; if (_sp > XB_SPIN_CAP) { atomicAdd(&(bar)[XB_TMO], 1u); break; } } } } while (0)

struct XcdBarrier { unsigned* bar; unsigned x; volatile LAS unsigned* st; };

__device__ __forceinline__ XcdBarrier xcd_barrier_post(unsigned* bar, volatile LAS unsigned* st) {
    XcdBarrier b; b.bar = bar; b.x = xb_xcc_id(); b.st = st;
    if (threadIdx.x == 0) (void)xb_add(&bar[XB_XCNT(b.x)], 1u);
    return b;
}
__device__ __forceinline__ void xcd_barrier_complete(unsigned* bar, unsigned x, unsigned& nloc, unsigned& nx) {
    const unsigned G = gridDim.x * gridDim.y * gridDim.z;
    unsigned sum, cnt, mine, sp = 0u;
    for (;;) {
        sum = 0u; cnt = 0u; mine = 0u;
#pragma unroll
        for (unsigned j = 0; j < 16; ++j) { const unsigned c = xb_ld(&bar[XB_XCNT(j)]); sum += c; cnt += (c > 0u) ? 1u : 0u; mine = (j == x) ? c : mine; }
        if (sum == G) break;
        __builtin_amdgcn_s_sleep(1);
        if ((++sp & 255u) == 0u) { if (xb_ld(&bar[XB_TMO])) break; if (sp > XB_SPIN_CAP) { atomicAdd(&bar[XB_TMO], 1u); break; } }
    }
    nloc = mine > 0u ? mine : 1u; nx = cnt > 0u ? cnt : 1u;
}
__device__ __forceinline__ void xcd_barrier(const XcdBarrier& b) {
    asm volatile("s_waitcnt vmcnt(0)" ::: "memory");
    __syncthreads();
    if (threadIdx.x == 0) {
        unsigned* bar = b.bar;
        __builtin_amdgcn_s_waitcnt(0);
        unsigned nloc = b.st[0], nx = b.st[1];
        if (nloc == 0u) { xcd_barrier_complete(bar, b.x, nloc, nx); b.st[0] = nloc; b.st[1] = nx; }
        const unsigned old = xb_add(&bar[XB_XSUB(b.x)], 1u);
        const unsigned gen = old / nloc;
        if (old + 1u == (gen + 1u) * nloc) {
            __builtin_amdgcn_fence(__ATOMIC_RELEASE, "agent");
            asm volatile("s_waitcnt vmcnt(0)" ::: "memory");
            const unsigned og = xb_add(&bar[XB_TOP], 1u);
            const unsigned tg = og / nx;
            if (og + 1u == (tg + 1u) * nx) xb_add(&bar[XB_TOPGEN], 1u);
            else XB_SPIN(xb_ld(&bar[XB_TOPGEN]) == tg, bar);
            __builtin_amdgcn_fence(__ATOMIC_ACQUIRE, "agent");
            xb_add(&bar[XB_XGEN(b.x)], 1u);
            asm volatile("s_waitcnt vmcnt(0)" ::: "memory");
        } else {
            XB_SPIN(xb_ld(&bar[XB_XGEN(b.x)]) == gen, bar);
            __builtin_amdgcn_fence(__ATOMIC_ACQUIRE, "agent");
            asm volatile("s_waitcnt vmcnt(0)" ::: "memory");
        }
    }
    __syncthreads();
}

template <bool F8 = false>
__device__ __forceinline__ void transpose_item(const float* W, int K, int N, bf16* WT, int kb, int nb, int dst_row0, LAS float* scr, int lane) {
    const int k0 = 64 * kb, n0 = 32 * nb;
#pragma unroll 8
    for (int i = 0; i < 32; ++i) { const int kk = 2 * i + (lane >> 5); scr[kk * 33 + (lane & 31)] = W[(size_t)(k0 + kk) * N + n0 + (lane & 31)]; }
    LDS_WAIT(); asm volatile("" ::: "memory");
    const int c = lane & 7;
#pragma unroll
    for (int j = 0; j < 4; ++j) { const int n = (lane >> 3) + 8 * j; const LAS float* s = scr + (8 * c) * 33 + n;
        if (F8) {
            int d0 = __builtin_amdgcn_cvt_pk_fp8_f32(s[0 * 33] * 32.f, s[1 * 33] * 32.f, 0, false); d0 = __builtin_amdgcn_cvt_pk_fp8_f32(s[2 * 33] * 32.f, s[3 * 33] * 32.f, d0, true);
            int d1 = __builtin_amdgcn_cvt_pk_fp8_f32(s[4 * 33] * 32.f, s[5 * 33] * 32.f, 0, false); d1 = __builtin_amdgcn_cvt_pk_fp8_f32(s[6 * 33] * 32.f, s[7 * 33] * 32.f, d1, true);
            *(GAS v2u*)((unsigned char*)WT + (size_t)(dst_row0 + n) * K + k0 + 8 * c) = (v2u){(unsigned)d0, (unsigned)d1};
        } else {
        v4u o; o.x = pk2(s[0 * 33], s[1 * 33]); o.y = pk2(s[2 * 33], s[3 * 33]); o.z = pk2(s[4 * 33], s[5 * 33]); o.w = pk2(s[6 * 33], s[7 * 33]);
        *(GAS v4u*)(WT + (size_t)(dst_row0 + n) * K + k0 + 8 * c) = o; } }
    LDS_WAIT(); asm volatile("" ::: "memory");
}
__device__ __forceinline__ void transpose_plain(const float* W, int K, int N, bf16* WT, LAS float* scr, int gw, int ngw, int lane) {
    const int nblk = N / 32, nitems = (K / 64) * nblk;
    for (int it = gw; it < nitems; it += ngw) { const int kb = it / nblk, nb = it % nblk; transpose_item(W, K, N, WT, kb, nb, 32 * nb, scr, lane); }
}
__device__ __forceinline__ void transpose_moe(const float* w1, const float* w3, const float* w2, bf16* W13T, bf16* W2T, LAS float* scr, int gw, int ngw, int lane) {
    constexpr int I13 = 16 * 16, I2 = 8 * 32, IPE = 2 * I13 + I2;
    for (int it = gw; it < NEXP * IPE; it += ngw) {
        const int e = it / IPE; int r = it % IPE;
        if (r < 2 * I13) { const int which = r / I13; r %= I13; const int kb = r / 16, nb = r % 16, n0 = 32 * nb;
            const float* W = (which ? w3 : w1) + (size_t)e * 1024 * 512;
            transpose_item<MOE_FP8 != 0>(W, 1024, 512, (bf16*)((unsigned char*)W13T + (size_t)e * 1024 * 1024 * (MOE_FP8 ? 1 : 2)), kb, nb, (n0 >> 7) * 256 + which * 128 + (n0 & 127), scr, lane);
        } else { r -= 2 * I13; const int kb = r / 32, nb = r % 32;
            transpose_item<MOE_FP8 != 0>(w2 + (size_t)e * 512 * 1024, 512, 1024, (bf16*)((unsigned char*)W2T + (size_t)e * 1024 * 512 * (MOE_FP8 ? 1 : 2)), kb, nb, 32 * nb, scr, lane); }
    }
}
__device__ __forceinline__ void rms_row(const float* xrow, const float* g, f32x4 (&v)[4], int lane) {
    const GAS f32x4* xr = (const GAS f32x4*)xrow + lane; const GAS f32x4* gr = (const GAS f32x4*)g + lane;
    float s = 0.f;
#pragma unroll
    for (int j = 0; j < 4; ++j) { v[j] = xr[64 * j]; s += (v[j].x * v[j].x + v[j].y * v[j].y) + (v[j].z * v[j].z + v[j].w * v[j].w); }
    const float rstd = 1.0f / sqrtf(wave_sum(s) * (1.f / DM) + 1e-6f);
#pragma unroll
    for (int j = 0; j < 4; ++j) { const f32x4 gg = gr[64 * j]; v[j] = v[j] * rstd * gg; }
}
__device__ __forceinline__ void store_row_bf16(bf16* orow, const f32x4 (&v)[4], int lane) {
    GAS unsigned long long* o8 = (GAS unsigned long long*)orow + lane;
#pragma unroll
    for (int j = 0; j < 4; ++j) o8[64 * j] = (unsigned long long)pk2(v[j].x, v[j].y) | ((unsigned long long)pk2(v[j].z, v[j].w) << 32);
}

__device__ __forceinline__ int t5_bucket(int rel) {
    const int n = rel < 0 ? -rel : rel; int ret = rel > 0 ? 16 : 0;
    int v;
    if (n < 8) v = n;
    else { const float nf = (float)n; int large = 8 + (int)(logf(nf / 8.0f) / 2.772588722239781f * 8.0f); v = large < 15 ? large : 15; }
    return ret + v;
}

__device__ __forceinline__ int crow(int r, int hi) { return (r & 3) + 8 * (r >> 2) + 4 * hi; }
__device__ __forceinline__ unsigned cvtpk(float lo, float hi) { unsigned r; asm volatile("v_cvt_pk_bf16_f32 %0, %1, %2" : "=v"(r) : "v"(lo), "v"(hi)); return r; }
__device__ __forceinline__ s16x4 vtr(const LAS char* p) { typedef short v4i16_t __attribute__((ext_vector_type(4))); return __builtin_bit_cast(s16x4, __builtin_amdgcn_ds_read_tr16_b64_v4i16((LAS v4i16_t*)p)); }

template <int DV, bool BIAS, bool FP8 = false>
__device__ __forceinline__ void attn_unit_v0(const bf16* Qp, int ldq, const bf16* Kp, int ldk, const bf16* Vp, int ldv, bf16* Op, int ldo, const LAS float* btbl, int q0, LAS unsigned char* lds) {
    const int tid = threadIdx.x, lane = tid & 63, r32 = lane & 31, hi = lane >> 5; const int wid = __builtin_amdgcn_readfirstlane(tid >> 6);
    constexpr int ND = DV / 32;
    LAS unsigned char* ldsK = lds; LAS unsigned char* ldsV = lds + 8192; LAS float* wsf = (LAS float*)(lds + 8192 + DV * 128) + wid * 64;
    bf16x8 qr[4]; v8i q8 = {0, 0, 0, 0, 0, 0, 0, 0};
    if (FP8) { const v4u a = *(const v4u*)((const unsigned char*)Qp + (size_t)(wid * 32 + r32) * ldq + hi * 32), b = *(const v4u*)((const unsigned char*)Qp + (size_t)(wid * 32 + r32) * ldq + hi * 32 + 16);
        q8 = (v8i){(int)a.x, (int)a.y, (int)a.z, (int)a.w, (int)b.x, (int)b.y, (int)b.z, (int)b.w}; }
    else {
#pragma unroll
    for (int d0 = 0; d0 < 4; ++d0) qr[d0] = *(const bf16x8*)(Qp + (size_t)(wid * 32 + r32) * ldq + d0 * 16 + hi * 8); }
    f32x16 o[ND];
#pragma unroll
    for (int d = 0; d < ND; ++d)
#pragma unroll
        for (int r = 0; r < 16; ++r) o[d][r] = 0.f;
    float l = 0.f;
    const int qpos = q0 + wid * 32 + r32;
    const LAS char* kp0 = (const LAS char*)ldsK + hi * 1024 + r32 * 16;
    const LAS char* vp0 = (const LAS char*)ldsV + ((lane >> 4) & 1) * 32 + (lane & 3) * 8 + (4 * hi + ((lane & 15) >> 2)) * 64;
    for (int t = 0; t < SEQ / 64; ++t) {
        __syncthreads();
        {
            if (FP8) { if (wid < 4) { const v4u kv = *(const v4u*)((const unsigned char*)Kp + (size_t)(t * 64 + lane) * ldk + wid * 16); *(LAS v4u*)(ldsK + wid * 1024 + lane * 16) = kv; } }
            else { const v4u kv = *(const v4u*)(Kp + (size_t)(t * 64 + lane) * ldk + wid * 8);
            *(LAS v4u*)(ldsK + wid * 1024 + lane * 16) = kv; }
#pragma unroll
            for (int pp = 0; pp < ND / 2; ++pp) { const int p = wid + 8 * pp, dq = p >> 2, rg = p & 3;
                const v4u vv = *(const v4u*)(Vp + (size_t)(t * 64 + 16 * rg + (lane >> 2)) * ldv + dq * 32 + (lane & 3) * 8);
                *(LAS v4u*)(ldsV + p * 1024 + lane * 16) = vv; }
        }
        __syncthreads();
        f32x16 p0, p1;
#pragma unroll
        for (int r = 0; r < 16; ++r) { p0[r] = 0.f; p1[r] = 0.f; }
        if (FP8) {
            const LAS char* k8 = (const LAS char*)ldsK + hi * 2048 + r32 * 16;
            const v4u a0 = *(const LAS v4u*)(k8), a1 = *(const LAS v4u*)(k8 + 1024), b0 = *(const LAS v4u*)(k8 + 512), b1 = *(const LAS v4u*)(k8 + 1024 + 512);
            const v8i ka = (v8i){(int)a0.x, (int)a0.y, (int)a0.z, (int)a0.w, (int)a1.x, (int)a1.y, (int)a1.z, (int)a1.w};
            const v8i kb = (v8i){(int)b0.x, (int)b0.y, (int)b0.z, (int)b0.w, (int)b1.x, (int)b1.y, (int)b1.z, (int)b1.w};
            p0 = __builtin_amdgcn_mfma_scale_f32_32x32x64_f8f6f4(ka, q8, p0, 0, 0, 0, 0x7f7f7f7f, 0, 0x7c7c7c7c);
            p1 = __builtin_amdgcn_mfma_scale_f32_32x32x64_f8f6f4(kb, q8, p1, 0, 0, 0, 0x7f7f7f7f, 0, 0x7c7c7c7c);
        } else {
#pragma unroll
        for (int d0 = 0; d0 < 4; ++d0) {
            const bf16x8 b0 = *(const LAS bf16x8*)(kp0 + d0 * 2048), b1 = *(const LAS bf16x8*)(kp0 + d0 * 2048 + 512);
            p0 = __builtin_amdgcn_mfma_f32_32x32x16_bf16(b0, qr[d0], p0, 0, 0, 0);
            p1 = __builtin_amdgcn_mfma_f32_32x32x16_bf16(b1, qr[d0], p1, 0, 0, 0);
        } }
        if (BIAS) {
            const int base = t * 64 + 4 * hi - qpos;
#pragma unroll
            for (int r = 0; r < 16; ++r) { int rel = base + (r & 3) + 8 * (r >> 2);
                int i0 = rel < -128 ? -128 : (rel > 128 ? 128 : rel); int rel1 = rel + 32; int i1 = rel1 < -128 ? -128 : (rel1 > 128 ? 128 : rel1);
                p0[r] += btbl[i0 + 128]; p1[r] += btbl[i1 + 128]; }
        }
        float sacc = 0.f;
#pragma unroll
        for (int r = 0; r < 16; ++r) { p0[r] = __builtin_amdgcn_exp2f(p0[r]); p1[r] = __builtin_amdgcn_exp2f(p1[r]); sacc += p0[r] + p1[r]; }
        l += sacc;
        v4u pw[4];
#pragma unroll
        for (int k = 0; k < 2; ++k) {
            pw[k]     = (v4u){cvtpk(p0[8 * k + 0], p0[8 * k + 1]), cvtpk(p0[8 * k + 2], p0[8 * k + 3]), cvtpk(p0[8 * k + 4], p0[8 * k + 5]), cvtpk(p0[8 * k + 6], p0[8 * k + 7])};
            pw[2 + k] = (v4u){cvtpk(p1[8 * k + 0], p1[8 * k + 1]), cvtpk(p1[8 * k + 2], p1[8 * k + 3]), cvtpk(p1[8 * k + 4], p1[8 * k + 5]), cvtpk(p1[8 * k + 6], p1[8 * k + 7])};
        }
#pragma unroll
        for (int d0 = 0; d0 < ND; ++d0)
#pragma unroll
            for (int ks = 0; ks < 4; ++ks) {
                const s16x4 lo = vtr(vp0 + d0 * 4096 + ks * 1024), hh = vtr(vp0 + d0 * 4096 + ks * 1024 + 512);
                const bf16x8 vf = (bf16x8){lo[0], lo[1], lo[2], lo[3], hh[0], hh[1], hh[2], hh[3]};
                o[d0] = __builtin_amdgcn_mfma_f32_32x32x16_bf16(__builtin_bit_cast(bf16x8, pw[ks]), vf, o[d0], 0, 0, 0);
            }
    }
    l += __shfl_xor(l, 32);
    if (hi == 0) wsf[r32] = l;
    LDS_WAIT(); asm volatile("" ::: "memory");
#pragma unroll
    for (int r = 0; r < 16; ++r) { const int row = crow(r, hi); const float rl = 1.0f / wsf[row];
#pragma unroll
        for (int d0 = 0; d0 < ND; ++d0) Op[(size_t)(wid * 32 + row) * ldo + d0 * 32 + r32] = (bf16)f2bf(o[d0][r] * rl); }
    LDS_WAIT();
}

namespace at1 {
#define SBAR() __builtin_amdgcn_sched_barrier(0)
#define PIN(x) asm volatile("" : "+v"(x))
template <int N, bool NOBAR = false> __device__ __forceinline__ void wait_bar() { if (NOBAR) asm volatile("s_waitcnt vmcnt(%0) lgkmcnt(0)" :: "n"(N) : "memory"); else asm volatile("s_waitcnt vmcnt(%0) lgkmcnt(0)\n\ts_barrier" :: "n"(N) : "memory"); }
__device__ __forceinline__ void glds16(const void* gsrc, unsigned lds_dst) { unsigned keep;
    asm volatile("s_mov_b32 %0, m0\n\ts_mov_b32 m0, %2\n\ts_nop 0\n\tglobal_load_lds_dwordx4 %1, off\n\ts_mov_b32 m0, %0" : "=&s"(keep) : "v"(gsrc), "s"(lds_dst) : "memory"); }
typedef float f32x2_t __attribute__((ext_vector_type(2))); typedef __bf16 bf16x2_t __attribute__((ext_vector_type(2)));
__device__ __forceinline__ unsigned cvtpk_s(float lo, float hi) { f32x2_t v = {lo, hi}; bf16x2_t b = __builtin_convertvector(v, bf16x2_t); return __builtin_bit_cast(unsigned, b); }
typedef const LAS char* lds_cptr;
__device__ __forceinline__ void kload2(bf16x8* kf, lds_cptr kp, int j) { kf[2 * j] = *(const LAS bf16x8*)(kp + j * 2048); kf[2 * j + 1] = *(const LAS bf16x8*)(kp + j * 2048 + 512); }

template <int DV, bool FP8> __host__ __device__ constexpr int lds_ws_off() { return (3 * (FP8 ? 4096 : 8192) + 3 * DV * 128) > 512 * DV ? (3 * (FP8 ? 4096 : 8192) + 3 * DV * 128) : 512 * DV; }
template <int DV, bool FP8> __host__ __device__ constexpr int lds_tbl_off() { return lds_ws_off<DV, FP8>() + 2048; }
template <int DV, bool BIAS, int TEST = 0, int MODE = 0, bool FP8 = false, bool TILED = false>
__device__ __forceinline__ void attn_unit(const bf16* Qp, int ldq, const bf16* __restrict__ Kp, int ldk, const bf16* __restrict__ Vp, int ldv, bf16* Op, int ldo, int q0, LAS unsigned char* lds, const LAS float* sgt = nullptr) {
    constexpr int ND = DV / 32, NV = ND / 2, VSLOT = DV * 128, KSLOT = FP8 ? 4096 : 8192, NT = SEQ / 64;
    constexpr int LDS_K = 0, LDS_V = 3 * KSLOT, LDS_WS = lds_ws_off<DV, FP8>(), LDS_TBL = LDS_WS + 2048;
    static_assert(LDS_WS >= LDS_V + 3 * VSLOT && LDS_WS >= 512 * DV && LDS_TBL + 2048 <= STASH_OFF, "LDS map");
    const int tid = threadIdx.x, lane = tid & 63, r32 = lane & 31, hi = lane >> 5; const int wid = __builtin_amdgcn_readfirstlane(tid >> 6);
    const unsigned lds0 = (unsigned)(uintptr_t)lds;
    LAS float* wsf = (LAS float*)(lds + LDS_WS) + wid * 64;
    const LAS float* btbl = (const LAS float*)(lds + LDS_TBL);
    const unsigned char* ksrc = TILED ? (const unsigned char*)Kp + (wid & 3) * 1024 + lane * 16 : FP8 ? (const unsigned char*)Kp + (size_t)lane * ldk + (wid & 3) * 16 : (const unsigned char*)(Kp + (size_t)lane * ldk + wid * 8);
    const bf16* vsrc0 = TILED ? Vp + wid * 512 + lane * 8 : Vp + (size_t)(16 * (wid & 3) + (lane >> 2)) * ldv + (wid >> 2) * 32 + (lane & 3) * 8;
    const bf16* vsrc1 = TILED ? vsrc0 + 4096 : vsrc0 + 64;
    const unsigned kdst = lds0 + LDS_K + wid * 1024, vdst = lds0 + LDS_V + wid * 1024;
#define DMA_K(t, s) if (!(TEST & 8) && (!FP8 || wid < 4)) glds16(ksrc + (size_t)(t) * (TILED ? 4096 : 64 * ldk * (FP8 ? 1 : 2)), (unsigned)__builtin_amdgcn_readfirstlane(kdst + (s) * KSLOT))
#define DMA_V(t, s) do { if (TEST & 8) break; glds16(vsrc0 + (size_t)(t) * (TILED ? (size_t)(DV * 64) : (size_t)64 * ldv), (unsigned)__builtin_amdgcn_readfirstlane(vdst + (s) * VSLOT)); \
        if (NV == 2) glds16(vsrc1 + (size_t)(t) * (TILED ? (size_t)(DV * 64) : (size_t)64 * ldv), (unsigned)__builtin_amdgcn_readfirstlane(vdst + (s) * VSLOT + 8192)); } while (0)
    const lds_cptr kp0 = (lds_cptr)lds + LDS_K + hi * (FP8 ? 2048 : 1024) + r32 * 16;
    const lds_cptr vp0 = (lds_cptr)lds + LDS_V + ((lane >> 4) & 1) * 32 + (lane & 3) * 8 + (4 * hi + ((lane & 15) >> 2)) * 64;
    DMA_K(0, 0); DMA_V(0, 0); DMA_K(1, 1);
    bf16x8 qr[4]; v8i q8 = {0, 0, 0, 0, 0, 0, 0, 0};
    if (FP8) { const unsigned char* qb_ = (const unsigned char*)Qp + (size_t)(wid * 32 + r32) * ldq + hi * 32; const v4u a = *(const v4u*)qb_, b = *(const v4u*)(qb_ + 16);
        q8 = (v8i){(int)a.x, (int)a.y, (int)a.z, (int)a.w, (int)b.x, (int)b.y, (int)b.z, (int)b.w}; }
    else {
#pragma unroll
        for (int d0 = 0; d0 < 4; ++d0) qr[d0] = *(const bf16x8*)(Qp + (size_t)(wid * 32 + r32) * ldq + d0 * 16 + hi * 8); }
    float l_reg = 0.f; f32x16 o[ND];
#pragma unroll
    for (int d = 0; d < ND; ++d) o[d] = f32x16{};
    const f32x16 zero16 = f32x16{};
    const int qw = q0 + wid * 32, qpos = qw + r32;
    int tl = 0, tr = NT; float fL = 1.f;
    if (BIAS) { tl = (qw - 191 >= 0) ? ((qw - 191) >> 6) + 1 : 0; tr = (qw + 158) >> 6; fL = __builtin_amdgcn_exp2f(btbl[0]); }
    f32x16 pA0, pA1, pB0, pB1; bf16x8 kf[8]; v8i kf8[2]; s16x4 vlo[8], vhi[8]; v4u pw0, pw1, pw2, pw3;
#define KLOAD8(n, kp_) do { const v4u a_ = *(const LAS v4u*)((kp_) + (n) * 512), b_ = *(const LAS v4u*)((kp_) + (n) * 512 + 1024); kf8[n] = (v8i){(int)a_.x, (int)a_.y, (int)a_.z, (int)a_.w, (int)b_.x, (int)b_.y, (int)b_.z, (int)b_.w}; } while (0)
#define MF8(kf_, c_) __builtin_amdgcn_mfma_scale_f32_32x32x64_f8f6f4(kf_, q8, c_, 0, 0, 0, 0x7f7f7f7f, 0, 0x7c7c7c7c)
#define WAITB(N) do { if (FP8 && wid >= 4) wait_bar<(N) - 1, (TEST & 16) != 0>(); else wait_bar<(N), (TEST & 16) != 0>(); } while (0)
    if (TEST & 32) { pB0 = f32x16{}; pB1 = f32x16{}; }
    if (TEST & 64) { _Pragma("unroll") for (int i_ = 0; i_ < 8; ++i_) { vlo[i_] = (s16x4){1, 2, 3, 4}; vhi[i_] = (s16x4){4, 3, 2, 1}; } }
    int s_prev = 0, s_cur = 0, s_next = 1;
#define ROT() do { s_prev = s_cur; s_cur = s_next; s_next = (s_next == 2) ? 0 : s_next + 1; } while (0)
#define ADD_BIAS(C0, C1, t) do { if (BIAS && (t) >= tl && (t) <= tr) { const int base_ = (t) * 64 + 4 * hi - qpos; \
        _Pragma("unroll") for (int r = 0; r < 16; ++r) { const int rel0 = base_ + (r & 3) + 8 * (r >> 2); const int rel1 = rel0 + 32; \
            const int i0 = (rel0 < -128 ? -128 : (rel0 > 128 ? 128 : rel0)) + 128, i1 = (rel1 < -128 ? -128 : (rel1 > 128 ? 128 : rel1)) + 128; \
            C0[r] += btbl[i0]; C1[r] += btbl[i1]; } } } while (0)
    DMA_K(2, 2);
    if (FP8) wait_bar<0, (TEST & 16) != 0>(); else wait_bar<NV + 2, (TEST & 16) != 0>();
    {
        if (FP8) { KLOAD8(0, kp0); KLOAD8(1, kp0); pA0 = MF8(kf8[0], zero16); pA1 = MF8(kf8[1], zero16); }
        else {
#pragma unroll
        for (int j = 0; j < 4; ++j) kload2(kf, kp0, j);
        pA0 = __builtin_amdgcn_mfma_f32_32x32x16_bf16(kf[0], qr[0], zero16, 0, 0, 0); pA1 = __builtin_amdgcn_mfma_f32_32x32x16_bf16(kf[1], qr[0], zero16, 0, 0, 0);
#pragma unroll
        for (int d0 = 1; d0 < 4; ++d0) { pA0 = __builtin_amdgcn_mfma_f32_32x32x16_bf16(kf[2 * d0], qr[d0], pA0, 0, 0, 0); pA1 = __builtin_amdgcn_mfma_f32_32x32x16_bf16(kf[2 * d0 + 1], qr[d0], pA1, 0, 0, 0); } }
        ADD_BIAS(pA0, pA1, 0);
#pragma unroll
        for (int r = 0; r < 16; ++r) { pA0[r] = __builtin_amdgcn_exp2f(pA0[r]); pA1[r] = __builtin_amdgcn_exp2f(pA1[r]); }
    }
    wait_bar<0, (TEST & 16) != 0>();
    DMA_K(3, 0); DMA_V(1, 1);
    ROT();
    if (FP8) { KLOAD8(0, kp0 + s_cur * KSLOT); KLOAD8(1, kp0 + s_cur * KSLOT); }
    else {
#pragma unroll
    for (int j = 0; j < 4; ++j) kload2(kf, kp0 + s_cur * KSLOT, j); }
    WAITB(1 + NV);
#define PKW(P, B) ((TEST & 256) ? 0x3f803f80u : cvtpk_s(P[B], P[B + 1]))
#define PAF(k) __builtin_bit_cast(bf16x8, pw##k)
#define VFR(i) (bf16x8){vlo[i][0], vlo[i][1], vlo[i][2], vlo[i][3], vhi[i][0], vhi[i][1], vhi[i][2], vhi[i][3]}
#define MF(a, b, c) __builtin_amdgcn_mfma_f32_32x32x16_bf16(a, b, c, 0, 0, 0)
#define GAPA(MFS, A0, A1, A2, A3, W0, W1, PW) do { if (!(TEST & 32)) { MFS; } if (!(TEST & 2)) { sacc += A0; sacc += A1; sacc += A2; sacc += A3; PIN(sacc); } W0; W1; PIN(PW); SBAR(); } while (0)
#define EX(v) ((TEST & 1) ? (v) : __builtin_amdgcn_exp2f(v))
#define GAPB4(MFS, X, B) do { if (!(TEST & 4)) { MFS; } X[B] = EX(X[B]); X[B + 1] = EX(X[B + 1]); X[B + 2] = EX(X[B + 2]); X[B + 3] = EX(X[B + 3]); PIN(X); SBAR(); } while (0)
#define GAPB2(MFS, X, B) do { if (!(TEST & 4)) { MFS; } X[B] = EX(X[B]); X[B + 1] = EX(X[B + 1]); PIN(X); SBAR(); } while (0)
#define VRD(f, s) do { if (TEST & 64) break; vlo[s] = vtr(vp_ + (((f) >> 2) * 4096 + ((f) & 3) * 1024)); vhi[s] = vtr(vp_ + (((f) >> 2) * 4096 + ((f) & 3) * 1024 + 512)); } while (0)
#define KRD(G, j) do { if ((G) && !(TEST & 128)) { if (FP8) { if ((j) < 2) { KLOAD8(j, kp0 + s_next * KSLOT); } } else kload2(kf, kp0 + s_next * KSLOT, j); SBAR(); } } while (0)
#define FO(m) (ND == 2 ? (((m) >> 1) + 4 * ((m) & 1)) : ((((m) & 7) >> 2) + 2 * ((m) >> 3) + 4 * ((m) & 3)))
#define STEP(C0, C1, P0, P1, t, GK, GV, GL) do { SBAR(); \
    const lds_cptr vp_ = vp0 + s_prev * VSLOT; float sacc; \
    if (FP8) { \
      VRD(FO(0), 0); VRD(FO(1), 1); VRD(FO(2), 2); VRD(FO(3), 3); SBAR(); \
      if (!(TEST & 32)) C0 = MF8(kf8[0], zero16); \
      SBAR();   \
      float sa_ = P0[0] + P0[1], sb_ = P0[2] + P0[3], sc_ = P0[4] + P0[5], sd_ = P0[6] + P0[7]; \
      if (!(TEST & 2)) { sa_ += P0[8]; sb_ += P0[9]; sc_ += P0[10]; sd_ += P0[11]; sa_ += P0[12]; sb_ += P0[13]; sc_ += P0[14]; sd_ += P0[15]; } \
      pw0 = (v4u){PKW(P0, 0), PKW(P0, 2), PKW(P0, 4), PKW(P0, 6)}; pw1 = (v4u){PKW(P0, 8), PKW(P0, 10), PKW(P0, 12), PKW(P0, 14)}; PIN(pw0); PIN(pw1); SBAR(); \
      VRD(FO(4), 4); VRD(FO(5), 5); VRD(FO(6), 6); VRD(FO(7), 7); SBAR(); \
      if (!(TEST & 32)) C1 = MF8(kf8[1], zero16); \
      SBAR(); \
      if (!(TEST & 2)) { sa_ += P1[0]; sb_ += P1[1]; sc_ += P1[2]; sd_ += P1[3]; sa_ += P1[4]; sb_ += P1[5]; sc_ += P1[6]; sd_ += P1[7]; \
                         sa_ += P1[8]; sb_ += P1[9]; sc_ += P1[10]; sd_ += P1[11]; sa_ += P1[12]; sb_ += P1[13]; sc_ += P1[14]; sd_ += P1[15]; } \
      sacc = (sa_ + sb_) + (sc_ + sd_); PIN(sacc); \
      pw2 = (v4u){PKW(P1, 0), PKW(P1, 2), PKW(P1, 4), PKW(P1, 6)}; pw3 = (v4u){PKW(P1, 8), PKW(P1, 10), PKW(P1, 12), PKW(P1, 14)}; PIN(pw2); PIN(pw3); SBAR(); \
    } else { \
    VRD(FO(0), 0); SBAR(); sacc = (P0[0] + P0[1]); \
    GAPA(C0 = MF(kf[0], qr[0], zero16), P0[2], P0[3], P0[4], P0[5],     pw0[0] = PKW(P0, 0), pw0[1] = PKW(P0, 2), pw0); \
    VRD(FO(1), 1); SBAR(); GAPA(C1 = MF(kf[1], qr[0], zero16), P0[6], P0[7], P0[8], P0[9],     pw0[2] = PKW(P0, 4), pw0[3] = PKW(P0, 6), pw0); \
    VRD(FO(2), 2); SBAR(); GAPA(C0 = MF(kf[2], qr[1], C0),   P0[10], P0[11], P0[12], P0[13], pw1[0] = PKW(P0, 8), pw1[1] = PKW(P0, 10), pw1); \
    VRD(FO(3), 3); SBAR(); GAPA(C1 = MF(kf[3], qr[1], C1),   P0[14], P0[15], P1[0], P1[1],   pw1[2] = PKW(P0, 12), pw1[3] = PKW(P0, 14), pw1); \
    VRD(FO(4), 4); SBAR(); GAPA(C0 = MF(kf[4], qr[2], C0),   P1[2], P1[3], P1[4], P1[5],     pw2[0] = PKW(P1, 0), pw2[1] = PKW(P1, 2), pw2); \
    VRD(FO(5), 5); SBAR(); GAPA(C1 = MF(kf[5], qr[2], C1),   P1[6], P1[7], P1[8], P1[9],     pw2[2] = PKW(P1, 4), pw2[3] = PKW(P1, 6), pw2); \
    VRD(FO(6), 6); SBAR(); GAPA(C0 = MF(kf[6], qr[3], C0),   P1[10], P1[11], P1[12], P1[13], pw3[0] = PKW(P1, 8), pw3[1] = PKW(P1, 10), pw3); \
    VRD(FO(7), 7); SBAR(); GAPA(C1 = MF(kf[7], qr[3], C1),   P1[14], P1[15], 0.f, 0.f,       pw3[2] = PKW(P1, 12), pw3[3] = PKW(P1, 14), pw3); \
    } \
    l_reg += sacc; \
    if (GK) { DMA_K((t) + 3, s_cur); } if (GV) { DMA_V((t) + 1, s_next); } \
    ADD_BIAS(C0, C1, t); \
    SBAR(); \
    if (ND == 2) { \
        GAPB4(o[0] = MF(PAF(0), VFR(0), o[0]), C0, 0); \
        GAPB4(o[1] = MF(PAF(0), VFR(1), o[1]), C0, 4); \
        KRD(GL, 0); GAPB4(o[0] = MF(PAF(1), VFR(2), o[0]), C0, 8); \
        KRD(GL, 1); GAPB4(o[1] = MF(PAF(1), VFR(3), o[1]), C0, 12); \
        KRD(GL, 2); GAPB4(o[0] = MF(PAF(2), VFR(4), o[0]), C1, 0); \
        KRD(GL, 3); GAPB4(o[1] = MF(PAF(2), VFR(5), o[1]), C1, 4); \
        GAPB4(o[0] = MF(PAF(3), VFR(6), o[0]), C1, 8); \
        GAPB4(o[1] = MF(PAF(3), VFR(7), o[1]), C1, 12); \
    } else { \
        GAPB2(o[0] = MF(PAF(0), VFR(0), o[0]), C0, 0);  VRD(FO(8), 0); SBAR(); \
        GAPB2(o[1] = MF(PAF(0), VFR(1), o[1]), C0, 2);  VRD(FO(9), 1); SBAR(); \
        GAPB2(o[ND - 2] = MF(PAF(0), VFR(2), o[ND - 2]), C0, 4);  VRD(FO(10), 2); SBAR(); \
        GAPB2(o[ND - 1] = MF(PAF(0), VFR(3), o[ND - 1]), C0, 6);  VRD(FO(11), 3); SBAR(); \
        GAPB2(o[0] = MF(PAF(1), VFR(4), o[0]), C0, 8);  VRD(FO(12), 4); SBAR(); \
        GAPB2(o[1] = MF(PAF(1), VFR(5), o[1]), C0, 10); VRD(FO(13), 5); SBAR(); \
        GAPB2(o[ND - 2] = MF(PAF(1), VFR(6), o[ND - 2]), C0, 12); VRD(FO(14), 6); SBAR(); \
        GAPB2(o[ND - 1] = MF(PAF(1), VFR(7), o[ND - 1]), C0, 14); VRD(FO(15), 7); SBAR(); \
        KRD(GL, 0); GAPB2(o[0] = MF(PAF(2), VFR(0), o[0]), C1, 0); \
        GAPB2(o[1] = MF(PAF(2), VFR(1), o[1]), C1, 2); \
        KRD(GL, 1); GAPB2(o[ND - 2] = MF(PAF(2), VFR(2), o[ND - 2]), C1, 4); \
        GAPB2(o[ND - 1] = MF(PAF(2), VFR(3), o[ND - 1]), C1, 6); \
        KRD(GL, 2); GAPB2(o[0] = MF(PAF(3), VFR(4), o[0]), C1, 8); \
        GAPB2(o[1] = MF(PAF(3), VFR(5), o[1]), C1, 10); \
        KRD(GL, 3); GAPB2(o[ND - 2] = MF(PAF(3), VFR(6), o[ND - 2]), C1, 12); \
        GAPB2(o[ND - 1] = MF(PAF(3), VFR(7), o[ND - 1]), C1, 14); \
    } \
    if (BIAS && (t) == tl) { l_reg *= fL; _Pragma("unroll") for (int d_ = 0; d_ < ND; ++d_) _Pragma("unroll") for (int r = 0; r < 16; ++r) o[d_][r] *= fL; } \
    } while (0)
    int t = 1;
    for (; t + 4 < NT; t += 2) {
        STEP(pB0, pB1, pA0, pA1, t, true, true, true);       WAITB(1 + NV); ROT();
        STEP(pA0, pA1, pB0, pB1, t + 1, true, true, true);   WAITB(1 + NV); ROT();
    }
    STEP(pB0, pB1, pA0, pA1, NT - 3, false, true, true);  wait_bar<NV, (TEST & 16) != 0>(); ROT();
    STEP(pA0, pA1, pB0, pB1, NT - 2, false, true, true);  wait_bar<0, (TEST & 16) != 0>();  ROT();
    STEP(pB0, pB1, pA0, pA1, NT - 1, false, false, false);
    {
        float sacc = pB0[0] + pB0[1];
#pragma unroll
        for (int r = 2; r < 16; ++r) sacc += pB0[r];
#pragma unroll
        for (int r = 0; r < 16; ++r) sacc += pB1[r];
        l_reg += sacc;
        pw0 = (v4u){PKW(pB0, 0), PKW(pB0, 2), PKW(pB0, 4), PKW(pB0, 6)}; pw1 = (v4u){PKW(pB0, 8), PKW(pB0, 10), PKW(pB0, 12), PKW(pB0, 14)};
        pw2 = (v4u){PKW(pB1, 0), PKW(pB1, 2), PKW(pB1, 4), PKW(pB1, 6)}; pw3 = (v4u){PKW(pB1, 8), PKW(pB1, 10), PKW(pB1, 12), PKW(pB1, 14)};
        const lds_cptr vp_ = vp0 + s_cur * VSLOT;
#pragma unroll
        for (int d0 = 0; d0 < ND; ++d0) {
            s16x4 a0 = vtr(vp_ + d0 * 4096), b0 = vtr(vp_ + d0 * 4096 + 512), a1 = vtr(vp_ + d0 * 4096 + 1024), b1 = vtr(vp_ + d0 * 4096 + 1536);
            s16x4 a2 = vtr(vp_ + d0 * 4096 + 2048), b2 = vtr(vp_ + d0 * 4096 + 2560), a3 = vtr(vp_ + d0 * 4096 + 3072), b3 = vtr(vp_ + d0 * 4096 + 3584);
            o[d0] = MF(PAF(0), ((bf16x8){a0[0], a0[1], a0[2], a0[3], b0[0], b0[1], b0[2], b0[3]}), o[d0]);
            o[d0] = MF(PAF(1), ((bf16x8){a1[0], a1[1], a1[2], a1[3], b1[0], b1[1], b1[2], b1[3]}), o[d0]);
            o[d0] = MF(PAF(2), ((bf16x8){a2[0], a2[1], a2[2], a2[3], b2[0], b2[1], b2[2], b2[3]}), o[d0]);
            o[d0] = MF(PAF(3), ((bf16x8){a3[0], a3[1], a3[2], a3[3], b3[0], b3[1], b3[2], b3[3]}), o[d0]);
        }
    }
    l_reg += __shfl_xor(l_reg, 32);
    int lane_e = lane; asm volatile("" : "+v"(lane_e));
    const int r32e = lane_e & 31, hie = lane_e >> 5;
    if (hie == 0) wsf[r32e] = l_reg;
    asm volatile("s_waitcnt lgkmcnt(0)\n\ts_barrier" ::: "memory");
    {
        LAS bf16* stg = (LAS bf16*)(MODE == 1 ? lds + STASH_OFF : lds) + wid * (32 * DV);
#pragma unroll
        for (int r = 0; r < 16; ++r) { const int orow = crow(r, hie); const float rl = __builtin_amdgcn_rcpf(wsf[orow]);
#pragma unroll
            for (int d0 = 0; d0 < ND; ++d0) stg[orow * DV + d0 * 32 + r32e] = (bf16)f2bf(o[d0][r] * rl); }
        asm volatile("s_waitcnt lgkmcnt(0)" ::: "memory");
        if (MODE == 0) {
            constexpr int CPR = DV / 8;
#pragma unroll
            for (int i = 0; i < (32 * CPR) / 64; ++i) { const int row = i * (64 / CPR) + lane_e / CPR, ch = lane_e % CPR;
                const v4u v = *(const LAS v4u*)(stg + row * DV + ch * 8); *(v4u*)(Op + (size_t)(wid * 32 + row) * ldo + ch * 8) = v; }
        } else if (MODE == 2) {
            const int row = lane_e >> 1, half = lane_e & 1; const float lam = sgt[128];
            const LAS bf16* s1 = stg + row * DV + half * 64; const LAS bf16* s0 = (const LAS bf16*)(lds + STASH_OFF) + wid * (32 * DV) + row * DV + half * 64;
            float ov[64]; float ss = 0.f;
#pragma unroll
            for (int q = 0; q < 8; ++q) { const v4u a = *(const LAS v4u*)(s0 + q * 8), c = *(const LAS v4u*)(s1 + q * 8);
#pragma unroll
                for (int j = 0; j < 4; ++j) { const float lo = __builtin_bit_cast(float, a[j] << 16) - lam * __builtin_bit_cast(float, c[j] << 16);
                    const float hh = __builtin_bit_cast(float, a[j] & 0xffff0000u) - lam * __builtin_bit_cast(float, c[j] & 0xffff0000u);
                    ov[q * 8 + 2 * j] = lo; ov[q * 8 + 2 * j + 1] = hh; ss += lo * lo + hh * hh; } }
            ss += dpp_mov<0xB1>(ss);
            const float rstd = 1.0f / sqrtf(ss * (1.f / 128.f) + 1e-5f);
            bf16* yo = Op + (size_t)(wid * 32 + row) * ldo + half * 64;
#pragma unroll
            for (int q = 0; q < 8; ++q) { const f32x4 g0 = *(const LAS f32x4*)(sgt + half * 64 + q * 8), g1 = *(const LAS f32x4*)(sgt + half * 64 + q * 8 + 4);
                v4u w; w.x = pk2(ov[q * 8] * rstd * g0.x, ov[q * 8 + 1] * rstd * g0.y); w.y = pk2(ov[q * 8 + 2] * rstd * g0.z, ov[q * 8 + 3] * rstd * g0.w);
                w.z = pk2(ov[q * 8 + 4] * rstd * g1.x, ov[q * 8 + 5] * rstd * g1.y); w.w = pk2(ov[q * 8 + 6] * rstd * g1.z, ov[q * 8 + 7] * rstd * g1.w);
                *(v4u*)(yo + q * 8) = w; }
        }
    }
    asm volatile("s_waitcnt lgkmcnt(0)\n\ts_barrier" ::: "memory");
#undef KLOAD8
#undef MF8
#undef WAITB
#undef DMA_K
#undef DMA_V
#undef ROT
#undef ADD_BIAS
#undef PKW
#undef PAF
#undef VFR
#undef MF
#undef GAPA
#undef EX
#undef GAPB4
#undef GAPB2
#undef VRD
#undef KRD
#undef FO
#undef STEP
}
#undef SBAR
#undef PIN
}

namespace at3 {
#define SBAR() __builtin_amdgcn_sched_barrier(0)
#define PIN(x) asm volatile("" : "+v"(x))
using at1::glds16; using at1::wait_bar;
typedef const LAS char* lds_cptr; typedef short v2s __attribute__((ext_vector_type(2)));
template <int DV> __host__ __device__ constexpr int lds_ws_off() { return (3 * 4096 + 3 * DV * 64) > 512 * DV ? (3 * 4096 + 3 * DV * 64) : 512 * DV; }
template <int DV> __host__ __device__ constexpr int lds_tbl_off() { return lds_ws_off<DV>() + 2048; }
__device__ __forceinline__ void waitb(int n) { if (n == 0) wait_bar<0>(); else if (n == 1) wait_bar<1>(); else wait_bar<2>(); }
__device__ __forceinline__ v8i ld_frag(lds_cptr p, int second) { const v4u a = *(const LAS v4u*)p, b = *(const LAS v4u*)(p + second); return (v8i){(int)a.x, (int)a.y, (int)a.z, (int)a.w, (int)b.x, (int)b.y, (int)b.z, (int)b.w}; }

template <int DV, bool BIAS, int MODE>
__device__ __forceinline__ void attn_unit(const unsigned char* Qp, int ldq, const unsigned char* __restrict__ K8T, const unsigned char* __restrict__ V8T, bf16* Op, int ldo, int q0, LAS unsigned char* lds, const LAS float* sgt) {
    constexpr int ND = DV / 32, VT = DV * 64, KT = 4096, NT = SEQ / 64, NVP = VT / 1024;
    constexpr int LDS_K = 0, LDS_V = 3 * KT, LDS_WS = lds_ws_off<DV>(), LDS_TBL = LDS_WS + 2048;
    static_assert(LDS_WS >= LDS_V + 3 * VT && LDS_WS >= 512 * DV && LDS_TBL + 2048 <= STASH_OFF, "LDS map");
    const int tid = threadIdx.x, lane = tid & 63, r32 = lane & 31, hi = lane >> 5; const int wid = __builtin_amdgcn_readfirstlane(tid >> 6);
    const unsigned lds0 = (unsigned)(uintptr_t)lds;
    LAS float* wsf = (LAS float*)(lds + LDS_WS) + wid * 64;
    const LAS float* btbl = (const LAS float*)(lds + LDS_TBL);
    const bool doK = wid < 4, doV = (NVP == 8) || wid >= 4; const int vpc = (NVP == 8) ? wid : (wid & 3);
    const unsigned char* ksrc = K8T + (wid & 3) * 1024 + lane * 16; const unsigned char* vsrc = V8T + vpc * 1024 + lane * 16;
    const unsigned kdst = lds0 + LDS_K + (wid & 3) * 1024, vdst = lds0 + LDS_V + vpc * 1024;
    const int ndma = (doK ? 1 : 0) + (doV ? 1 : 0);
#define DMA_K(t, s) do { if (doK) glds16(ksrc + (size_t)(t) * KT, (unsigned)__builtin_amdgcn_readfirstlane(kdst + (s) * KT)); } while (0)
#define DMA_V(t, s) do { if (doV) glds16(vsrc + (size_t)(t) * VT, (unsigned)__builtin_amdgcn_readfirstlane(vdst + (s) * VT)); } while (0)
    const lds_cptr kp0 = (lds_cptr)lds + LDS_K + hi * 2048 + r32 * 16;
    const lds_cptr vq0 = (lds_cptr)lds + LDS_V + hi * (2 * DV * 16) + r32 * 16;
    DMA_K(0, 0); DMA_V(0, 0); DMA_K(1, 1);
    v8i q8;
    { const unsigned char* qb_ = Qp + (size_t)(wid * 32 + r32) * ldq + hi * 32; const v4u a = *(const v4u*)qb_, b = *(const v4u*)(qb_ + 16);
      q8 = (v8i){(int)a.x, (int)a.y, (int)a.z, (int)a.w, (int)b.x, (int)b.y, (int)b.z, (int)b.w}; }
    f32x16 lacc = f32x16{}; f32x16 o[ND];
#pragma unroll
    for (int d = 0; d < ND; ++d) o[d] = f32x16{};
    const f32x16 zero16 = f32x16{};
    const v8i ones8 = {0x38383838, 0x38383838, 0x38383838, 0x38383838, 0x38383838, 0x38383838, 0x38383838, 0x38383838};
    const int qw = q0 + wid * 32, qpos = qw + r32;
    int tl = 0, tr = NT; float fL = 1.f;
    if (BIAS) { tl = (qw - 191 >= 0) ? ((qw - 191) >> 6) + 1 : 0; tr = (qw + 158) >> 6; fL = __builtin_amdgcn_exp2f(btbl[0]); }
    f32x16 pA0, pA1, pB0, pB1; v8i kf8[2]; v8i vf[ND]; v8i pa; int sb = 127;
    int s_prev = 0, s_cur = 0, s_next = 1;
#define ROT() do { s_prev = s_cur; s_cur = s_next; s_next = (s_next == 2) ? 0 : s_next + 1; } while (0)
#define MFQK(kf_) __builtin_amdgcn_mfma_scale_f32_32x32x64_f8f6f4(kf_, q8, zero16, 0, 0, 0, 0x7f7f7f7f, 0, 0x7c7c7c7c)
#define MFPV(d_) o[d_] = __builtin_amdgcn_mfma_scale_f32_32x32x64_f8f6f4(pa, vf[d_], o[d_], 0, 0, 0, sb, 0, 0x7f7f7f7f)
#define MFSUM() lacc = __builtin_amdgcn_mfma_scale_f32_32x32x64_f8f6f4(pa, ones8, lacc, 0, 0, 0, sb, 0, 0x7f7f7f7f)
#define ADD_BIAS(C0, C1, t) do { if (BIAS && (t) >= tl && (t) <= tr) { const int base_ = (t) * 64 + 4 * hi - qpos; \
        _Pragma("unroll") for (int r = 0; r < 16; ++r) { const int rel0 = base_ + (r & 3) + 8 * (r >> 2); const int rel1 = rel0 + 32; \
            const int i0 = (rel0 < -128 ? -128 : (rel0 > 128 ? 128 : rel0)) + 128, i1 = (rel1 < -128 ? -128 : (rel1 > 128 ? 128 : rel1)) + 128; \
            C0[r] += btbl[i0]; C1[r] += btbl[i1]; } } } while (0)
#define MX3(a, b, c) __builtin_fmaxf(__builtin_fmaxf((a), (b)), (c))
#define PMAX(P0, P1) do { float a_ = MX3(P0[0], P0[1], P1[0]), b_ = MX3(P0[2], P0[3], P1[1]); a_ = MX3(a_, P1[2], P1[3]); \
        _Pragma("unroll") for (int r = 4; r < 16; r += 4) { a_ = MX3(a_, P0[r], P0[r + 1]); b_ = MX3(b_, P0[r + 2], P0[r + 3]); a_ = MX3(a_, P1[r], P1[r + 1]); b_ = MX3(b_, P1[r + 2], P1[r + 3]); } \
        const int em_ = (int)(__float_as_uint(__builtin_fmaxf(a_, b_)) >> 23) - 7; sb = em_ < 1 ? 1 : em_; } while (0)
#define PCVT(P0, P1) do { const float scf_ = __uint_as_float((unsigned)sb << 23); \
        _Pragma("unroll") for (int k = 0; k < 4; ++k) { v2s w_ = {0, 0}; w_ = __builtin_amdgcn_cvt_scalef32_pk_fp8_f32(w_, P0[4 * k], P0[4 * k + 1], scf_, false); w_ = __builtin_amdgcn_cvt_scalef32_pk_fp8_f32(w_, P0[4 * k + 2], P0[4 * k + 3], scf_, true); pa[k] = __builtin_bit_cast(int, w_); } \
        _Pragma("unroll") for (int k = 0; k < 4; ++k) { v2s w_ = {0, 0}; w_ = __builtin_amdgcn_cvt_scalef32_pk_fp8_f32(w_, P1[4 * k], P1[4 * k + 1], scf_, false); w_ = __builtin_amdgcn_cvt_scalef32_pk_fp8_f32(w_, P1[4 * k + 2], P1[4 * k + 3], scf_, true); pa[4 + k] = __builtin_bit_cast(int, w_); } } while (0)
#define PSUM(P0, P1) do { float s0_ = P0[0] + P0[1], s1_ = P0[2] + P0[3], s2_ = P1[0] + P1[1], s3_ = P1[2] + P1[3]; \
        _Pragma("unroll") for (int r = 4; r < 16; r += 4) { s0_ += P0[r]; s1_ += P0[r + 1]; s2_ += P0[r + 2]; s3_ += P0[r + 3]; s0_ += P1[r]; s1_ += P1[r + 1]; s2_ += P1[r + 2]; s3_ += P1[r + 3]; } \
        l_reg += (s0_ + s1_) + (s2_ + s3_); } while (0)
#define EXPS(X, B, N) do { _Pragma("unroll") for (int r_ = 0; r_ < (N); ++r_) X[(B) + r_] = __builtin_amdgcn_exp2f(X[(B) + r_]); PIN(X); } while (0)
    DMA_K(2, 2);
    wait_bar<0>();
    kf8[0] = ld_frag(kp0, 1024); kf8[1] = ld_frag(kp0 + 512, 1024);
    pA0 = MFQK(kf8[0]); pA1 = MFQK(kf8[1]);
    ADD_BIAS(pA0, pA1, 0);
#pragma unroll
    for (int r = 0; r < 16; ++r) { pA0[r] = __builtin_amdgcn_exp2f(pA0[r]); pA1[r] = __builtin_amdgcn_exp2f(pA1[r]); }
    wait_bar<0>();
    DMA_K(3, 0); DMA_V(1, 1);
    ROT();
    kf8[0] = ld_frag(kp0 + s_cur * KT, 1024); kf8[1] = ld_frag(kp0 + s_cur * KT + 512, 1024);
    waitb(ndma);
#define STEP(C0, C1, P0, P1, t, GK, GV, GL) do { SBAR(); \
    const lds_cptr vp_ = vq0 + s_prev * VT; \
    _Pragma("unroll") for (int d_ = 0; d_ < ND; ++d_) vf[d_] = ld_frag(vp_ + d_ * 512, DV * 16); \
    SBAR(); \
    C0 = MFQK(kf8[0]); SBAR(); \
    PMAX(P0, P1); PIN(sb); SBAR(); \
    C1 = MFQK(kf8[1]); SBAR(); \
    PCVT(P0, P1); PIN(pa); SBAR(); \
    MFSUM(); SBAR(); \
    if (GK) { DMA_K((t) + 3, s_cur); } if (GV) { DMA_V((t) + 1, s_next); } \
    ADD_BIAS(C0, C1, t); \
    SBAR(); \
    if (ND == 2) { \
        MFPV(0); EXPS(C0, 0, 16); SBAR(); \
        if (GL) { kf8[0] = ld_frag(kp0 + s_next * KT, 1024); kf8[1] = ld_frag(kp0 + s_next * KT + 512, 1024); SBAR(); } \
        MFPV(1); EXPS(C1, 0, 16); SBAR(); \
    } else { \
        MFPV(0); EXPS(C0, 0, 8); SBAR(); \
        if (GL) { kf8[0] = ld_frag(kp0 + s_next * KT, 1024); SBAR(); } \
        MFPV(1); EXPS(C0, 8, 8); SBAR(); \
        if (GL) { kf8[1] = ld_frag(kp0 + s_next * KT + 512, 1024); SBAR(); } \
        MFPV(ND - 2); EXPS(C1, 0, 8); SBAR(); \
        MFPV(ND - 1); EXPS(C1, 8, 8); SBAR(); \
    } \
    if (BIAS && (t) == tl) { _Pragma("unroll") for (int r = 0; r < 16; ++r) lacc[r] *= fL; _Pragma("unroll") for (int d_ = 0; d_ < ND; ++d_) _Pragma("unroll") for (int r = 0; r < 16; ++r) o[d_][r] *= fL; } \
    } while (0)
    int t = 1;
    for (; t + 4 < NT; t += 2) {
        STEP(pB0, pB1, pA0, pA1, t, true, true, true);       waitb(ndma); ROT();
        STEP(pA0, pA1, pB0, pB1, t + 1, true, true, true);   waitb(ndma); ROT();
    }
    STEP(pB0, pB1, pA0, pA1, NT - 3, false, true, true);  waitb(doV ? 1 : 0); ROT();
    STEP(pA0, pA1, pB0, pB1, NT - 2, false, true, true);  wait_bar<0>();  ROT();
    STEP(pB0, pB1, pA0, pA1, NT - 1, false, false, false);
    {
        const lds_cptr vp_ = vq0 + s_cur * VT;
#pragma unroll
        for (int d_ = 0; d_ < ND; ++d_) vf[d_] = ld_frag(vp_ + d_ * 512, DV * 16);
        PMAX(pB0, pB1); PCVT(pB0, pB1); MFSUM();
#pragma unroll
        for (int d_ = 0; d_ < ND; ++d_) MFPV(d_);
    }
    int lane_e = lane; asm volatile("" : "+v"(lane_e));
    const int r32e = lane_e & 31, hie = lane_e >> 5;
    asm volatile("s_waitcnt lgkmcnt(0)\n\ts_barrier" ::: "memory");
    {
        LAS bf16* stg = (LAS bf16*)(MODE == 1 ? lds + STASH_OFF : lds) + wid * (32 * DV);
#pragma unroll
        for (int r = 0; r < 16; ++r) { const int orow = crow(r, hie); const float rl = __builtin_amdgcn_rcpf(lacc[r]);
#pragma unroll
            for (int d0 = 0; d0 < ND; ++d0) stg[orow * DV + d0 * 32 + r32e] = (bf16)f2bf(o[d0][r] * rl); }
        asm volatile("s_waitcnt lgkmcnt(0)" ::: "memory");
        if (MODE == 0) {
            constexpr int CPR = DV / 8;
#pragma unroll
            for (int i = 0; i < (32 * CPR) / 64; ++i) { const int row = i * (64 / CPR) + lane_e / CPR, ch = lane_e % CPR;
                const v4u v = *(const LAS v4u*)(stg + row * DV + ch * 8); *(v4u*)(Op + (size_t)(wid * 32 + row) * ldo + ch * 8) = v; }
        } else if (MODE == 2) {
            const int row = lane_e >> 1, half = lane_e & 1; const float lam = sgt[128];
            const LAS bf16* s1 = stg + row * DV + half * 64; const LAS bf16* s0 = (const LAS bf16*)(lds + STASH_OFF) + wid * (32 * DV) + row * DV + half * 64;
            float ov[64]; float ss = 0.f;
#pragma unroll
            for (int q = 0; q < 8; ++q) { const v4u a = *(const LAS v4u*)(s0 + q * 8), c = *(const LAS v4u*)(s1 + q * 8);
#pragma unroll
                for (int j = 0; j < 4; ++j) { const float lo = __builtin_bit_cast(float, a[j] << 16) - lam * __builtin_bit_cast(float, c[j] << 16);
                    const float hh = __builtin_bit_cast(float, a[j] & 0xffff0000u) - lam * __builtin_bit_cast(float, c[j] & 0xffff0000u);
                    ov[q * 8 + 2 * j] = lo; ov[q * 8 + 2 * j + 1] = hh; ss += lo * lo + hh * hh; } }
            ss += dpp_mov<0xB1>(ss);
            const float rstd = 1.0f / sqrtf(ss * (1.f / 128.f) + 1e-5f);
            bf16* yo = Op + (size_t)(wid * 32 + row) * ldo + half * 64;
#pragma unroll
            for (int q = 0; q < 8; ++q) { const f32x4 g0 = *(const LAS f32x4*)(sgt + half * 64 + q * 8), g1 = *(const LAS f32x4*)(sgt + half * 64 + q * 8 + 4);
                v4u w; w.x = pk2(ov[q * 8] * rstd * g0.x, ov[q * 8 + 1] * rstd * g0.y); w.y = pk2(ov[q * 8 + 2] * rstd * g0.z, ov[q * 8 + 3] * rstd * g0.w);
                w.z = pk2(ov[q * 8 + 4] * rstd * g1.x, ov[q * 8 + 5] * rstd * g1.y); w.w = pk2(ov[q * 8 + 6] * rstd * g1.z, ov[q * 8 + 7] * rstd * g1.w);
                *(v4u*)(yo + q * 8) = w; }
        }
    }
    asm volatile("s_waitcnt lgkmcnt(0)\n\ts_barrier" ::: "memory");
#undef DMA_K
#undef DMA_V
#undef ROT
#undef MFQK
#undef MFPV
#undef MFSUM
#undef ADD_BIAS
#undef MX3
#undef PMAX
#undef PCVT
#undef PSUM
#undef EXPS
#undef STEP
}
#undef SBAR
#undef PIN
}

struct Args { const float* in[27]; float* out; unsigned char* ws; int ph_lo, ph_hi, li, pad; };

constexpr int NPHASE = 17;
constexpr int NWAVES = 8;

#define IN(k) (lo <= (k) && (k) < hi_ph)
#define SEAM(k) do { if (IN(k) && IN((k) + 1)) xcd_barrier(bar); } while (0)
template <int layer>
__device__ __forceinline__ void moe_block(const Args& args, LAS unsigned char* lds, const XcdBarrier& bar, int lo, int hi_ph) {
    volatile LAS unsigned* LC = (volatile LAS unsigned*)(lds + LDSCTL_OFF);
    const int tid = threadIdx.x, lane = tid & 63, wave = __builtin_amdgcn_readfirstlane(tid >> 6);
    const int G = gridDim.x, bx = blockIdx.x;
    const int gw = bx * NWAVES + wave, NGW = G * NWAVES;
    unsigned char* ws = args.ws;
    unsigned* ctl = (unsigned*)(ws + WS_CTL);
    float* xres = args.out;
    bf16* HB = (bf16*)(ws + WS_HB);
    {
        const int pb = layer == 0 ? 5 : 13;
        unsigned* const gcnt0 = ctl + CW_CNT + layer * 64;
        int* list = (int*)(ws + WS_LIST); int* tokep = (int*)(ws + WS_TOKEP); float* gate = (float*)(ws + WS_GATE);
        if (IN(pb)) REP(pb) {
            unsigned* gcnt = gcnt0 + ((MK_N_LAUNCHES == 1 ? (int)((PROBE_MASK >> pb) & 1u) : 0) - rep_) * 128;
            if (rep_ > 0) xcd_barrier(bar);
            const float* gf = args.in[2] + layer * DM;
            const float* WR = (const float*)(ws + WS_TBL) + TBL_WR + layer * WR_LAYER;
            for (int chunk = bx; chunk < NTOK / 128; chunk += G) {
                __syncthreads();
                if (tid < 32) LC[LC_LCNT + tid] = 0u;
                __syncthreads();
                int my_e0 = 0, my_e1 = 0; float my_g0 = 0.f, my_g1 = 0.f;
                {
                    const int ri = lane & 15, kq = lane >> 4; const int r0w = chunk * 128 + wave * 16;
                    const GAS float* xrow = (const GAS float*)(xres + (size_t)(r0w + ri) * DM) + 4 * kq;
                    const GAS float* wb = (const GAS float*)WR + (size_t)(4 * kq) * 48 + ri;
                    f32x4 acc0 = {0.f, 0.f, 0.f, 0.f}, acc1 = acc0, acc2 = acc0; float ss = 0.f;
                    f32x4 aA[4], aB[4]; float bA[48], bB[48];
#define RT_LOAD(a_, b_, g_) do { _Pragma("unroll") for (int c_ = 0; c_ < 4; ++c_) { a_[c_] = *(const GAS f32x4*)(xrow + 16 * (4 * (g_) + c_)); \
        const GAS float* wc_ = wb + (size_t)(16 * (4 * (g_) + c_)) * 48; _Pragma("unroll") for (int e_ = 0; e_ < 4; ++e_) { b_[c_ * 12 + e_ * 3] = wc_[e_ * 48]; b_[c_ * 12 + e_ * 3 + 1] = wc_[e_ * 48 + 16]; b_[c_ * 12 + e_ * 3 + 2] = wc_[e_ * 48 + 32]; } } } while (0)
#define RT_COMP(a_, b_) do { _Pragma("unroll") for (int c_ = 0; c_ < 4; ++c_) { ss += (a_[c_].x * a_[c_].x + a_[c_].y * a_[c_].y) + (a_[c_].z * a_[c_].z + a_[c_].w * a_[c_].w); \
        _Pragma("unroll") for (int e_ = 0; e_ < 4; ++e_) { acc0 = __builtin_amdgcn_mfma_f32_16x16x4f32(a_[c_][e_], b_[c_ * 12 + e_ * 3], acc0, 0, 0, 0); \
            acc1 = __builtin_amdgcn_mfma_f32_16x16x4f32(a_[c_][e_], b_[c_ * 12 + e_ * 3 + 1], acc1, 0, 0, 0); acc2 = __builtin_amdgcn_mfma_f32_16x16x4f32(a_[c_][e_], b_[c_ * 12 + e_ * 3 + 2], acc2, 0, 0, 0); } } } while (0)
                    RT_LOAD(aA, bA, 0);
#pragma unroll 1
                    for (int g = 0; g < 16; g += 2) {
                        RT_LOAD(aB, bB, g + 1);
                        RT_COMP(aA, bA);
                        if (g + 2 < 16) RT_LOAD(aA, bA, g + 2);
                        RT_COMP(aB, bB);
                    }
#undef RT_LOAD
#undef RT_COMP
                    ss += __shfl_xor(ss, 16); ss += __shfl_xor(ss, 32);
                    const float rstd = 1.0f / sqrtf(ss * (1.f / DM) + 1e-6f);
                    LAS float* Lg = (LAS float*)(lds + wave * 4096);
#pragma unroll
                    for (int r = 0; r < 4; ++r) { Lg[(4 * kq + r) * 49 + ri] = acc0[r]; Lg[(4 * kq + r) * 49 + 16 + ri] = acc1[r]; Lg[(4 * kq + r) * 49 + 32 + ri] = acc2[r]; }
                    LDS_WAIT(); asm volatile("" ::: "memory");
                    if (lane < 16) {
                        const GAS float* bv = (const GAS float*)WR + 1024 * 48;
                        float lg[4], le[32];
#pragma unroll
                        for (int e = 0; e < 4; ++e) lg[e] = Lg[lane * 49 + e] * rstd + bv[e];
#pragma unroll
                        for (int e = 0; e < 32; ++e) le[e] = Lg[lane * 49 + 4 + e] * rstd + bv[4 + e];
                        int gi = 0; float gm = lg[0];
#pragma unroll
                        for (int e = 1; e < 4; ++e) if (lg[e] > gm) { gm = lg[e]; gi = e; }
                        float gs = 0.f;
#pragma unroll
                        for (int e = 0; e < 4; ++e) gs += __expf(lg[e] - gm);
                        const float gval = 1.0f / gs;
                        float ev[8];
#pragma unroll
                        for (int j = 0; j < 8; ++j) ev[j] = gi == 0 ? le[j] : (gi == 1 ? le[8 + j] : (gi == 2 ? le[16 + j] : le[24 + j]));
                        int i0 = 0; float m0 = ev[0];
#pragma unroll
                        for (int j = 1; j < 8; ++j) if (ev[j] > m0) { m0 = ev[j]; i0 = j; }
                        int i1 = -1; float m1 = -3.0e38f;
#pragma unroll
                        for (int j = 0; j < 8; ++j) if (j != i0 && ev[j] > m1) { m1 = ev[j]; i1 = j; }
                        const float t1 = __expf(m1 - m0); const float den = 1.0f / (1.0f + t1);
                        my_e0 = gi * 8 + i0; my_e1 = gi * 8 + i1; my_g0 = gval * den; my_g1 = gval * t1 * den;
                    }
                    for (int i = 0; i < 16; ++i) { const int m = r0w + i; f32x4 v[4]; rms_row(xres + (size_t)m * DM, gf, v, lane);
                        if (MOE_FP8) {
#pragma unroll
                            for (int j = 0; j < 4; ++j) { int d = __builtin_amdgcn_cvt_pk_fp8_f32(v[j].x, v[j].y, 0, false); d = __builtin_amdgcn_cvt_pk_fp8_f32(v[j].z, v[j].w, d, true); *(GAS unsigned*)((unsigned char*)HB + (size_t)m * DM + 4 * lane + 256 * j) = (unsigned)d; }
                        } else store_row_bf16(HB + (size_t)m * DM, v, lane); }
                }
                unsigned r0 = 0, r1 = 0;
                if (lane < 16) { r0 = atomicAdd((unsigned*)(LC + LC_LCNT + my_e0), 1u); r1 = atomicAdd((unsigned*)(LC + LC_LCNT + my_e1), 1u); }
                __syncthreads();
                if (tid < 32) { const unsigned c = LC[LC_LCNT + tid]; LC[LC_LBASE + tid] = c ? __hip_atomic_fetch_add(gcnt + tid, c, RLX_AGENT) : 0u; }
                __syncthreads();
                if (lane < 16) { const int m = chunk * 128 + wave * 16 + lane;
                    const unsigned p0 = LC[LC_LBASE + my_e0] + r0, p1 = LC[LC_LBASE + my_e1] + r1;
                    list[(size_t)my_e0 * LIST_CAP + p0] = m; list[(size_t)my_e1 * LIST_CAP + p1] = m;
                    tokep[2 * m] = my_e0 | (int)(p0 << 8); tokep[2 * m + 1] = my_e1 | (int)(p1 << 8);
                    gate[2 * m] = my_g0; gate[2 * m + 1] = my_g1; }
            }
        }
        SEAM(pb);
        if (IN(pb + 1) || IN(pb + 2) || IN(pb + 3)) {
            __syncthreads();
            if (tid == 0) { int acc = 0; for (int e = 0; e < 32; ++e) { const int c = (int)__hip_atomic_load(gcnt0 + e, RLX_AGENT); LC[LC_CNT + e] = (unsigned)c; LC[LC_TP + e] = (unsigned)acc; acc += (c + 255) >> 8; } LC[LC_TP + 32] = (unsigned)acc;
                int la = 0; for (int j = 0; j < 4; ++j) { LC[LC_LP + j] = (unsigned)la; la += ((int)LC[LC_CNT + (bx & 7) + 8 * j] + 255) >> 8; } LC[LC_LP + 4] = (unsigned)la; }
            __syncthreads();
        }
        const LAS int* tp = (const LAS int*)(lds + LDSCTL_OFF) + LC_TP; const LAS int* cn = (const LAS int*)(lds + LDSCTL_OFF) + LC_CNT; const LAS int* lp = (const LAS int*)(lds + LDSCTL_OFF) + LC_LP;
        if (IN(pb + 1)) REP(pb + 1) {
            pg8::Gemm g{HB, (const bf16*)(ws + WS_W13), 0, 1024, MOE_FP8 ? DM / 2 : DM};
            pg8::MoeOrder S{tp, cn, lp, list, G, bx, tp[32] * 4, true, G == 256};
            pg8::EpiSwiglu E{(bf16*)(ws + WS_H), MOE_FP8 != 0};
            if (MOE_FP8) pg8::gemm_phase<pg8::EpiSwiglu, pg8::MoeOrder, true, true, 127, 122>(lds, g, S, E);
            else pg8::gemm_phase<pg8::EpiSwiglu, pg8::MoeOrder, true>(lds, g, S, E);
        }
        SEAM(pb + 1);
        if (IN(pb + 2)) REP(pb + 2) {
            pg8::Gemm g{(const bf16*)(ws + WS_H), (const bf16*)(ws + WS_W2), 0, 1024, MOE_FP8 ? MOE_H / 2 : MOE_H};
            pg8::MoeOrder S{tp, cn, lp, list, G, bx, tp[32] * 4, false, G == 256};
            pg8::EpiBf16 E{(bf16*)(ws + WS_YS), DM, 0, 0, 1.f, 3};
            if (MOE_FP8) pg8::gemm_phase<pg8::EpiBf16, pg8::MoeOrder, true, true, 125, 122>(lds, g, S, E);
            else pg8::gemm_phase<pg8::EpiBf16, pg8::MoeOrder, true>(lds, g, S, E);
        }
        SEAM(pb + 2);
        if (IN(pb + 3)) {
            const bf16* YS = (const bf16*)(ws + WS_YS);
            if (layer == 0) { LAS float* scr = (LAS float*)(lds + wave * 16384);
                transpose_moe(args.in[24] + (size_t)NEXP * 1024 * 512, args.in[25] + (size_t)NEXP * 1024 * 512, args.in[26] + (size_t)NEXP * 1024 * 512, (bf16*)(ws + WS_W13), (bf16*)(ws + WS_W2), scr, gw, NGW, lane); }
            const float* gn = layer == 0 ? args.in[1] + DM : args.in[3];
            for (int m = gw; m < NTOK; m += NGW) {
                const int ep0 = tokep[2 * m], ep1 = tokep[2 * m + 1]; const float g0 = gate[2 * m], g1 = gate[2 * m + 1];
                const size_t s0 = (size_t)(tp[ep0 & 255] * 256 + (ep0 >> 8)), s1 = (size_t)(tp[ep1 & 255] * 256 + (ep1 >> 8));
                GAS f32x4* xr = (GAS f32x4*)(xres + (size_t)m * DM) + lane;
                const GAS v2u* y0 = (const GAS v2u*)(YS + s0 * DM) + lane; const GAS v2u* y1 = (const GAS v2u*)(YS + s1 * DM) + lane;
                f32x4 v[4]; float ss = 0.f;
#pragma unroll
                for (int j = 0; j < 4; ++j) { const v2u a = y0[64 * j], c = y1[64 * j]; f32x4 xv = xr[64 * j];
                    xv.x += g0 * __builtin_bit_cast(float, a.x << 16) + g1 * __builtin_bit_cast(float, c.x << 16);
                    xv.y += g0 * __builtin_bit_cast(float, a.x & 0xffff0000u) + g1 * __builtin_bit_cast(float, c.x & 0xffff0000u);
                    xv.z += g0 * __builtin_bit_cast(float, a.y << 16) + g1 * __builtin_bit_cast(float, c.y << 16);
                    xv.w += g0 * __builtin_bit_cast(float, a.y & 0xffff0000u) + g1 * __builtin_bit_cast(float, c.y & 0xffff0000u);
                    v[j] = xv; ss += (xv.x * xv.x + xv.y * xv.y) + (xv.z * xv.z + xv.w * xv.w); }
                const float rstd = 1.0f / sqrtf(wave_sum(ss) * (1.f / DM) + 1e-6f);
                const GAS f32x4* gr = (const GAS f32x4*)gn + lane;
                if (layer == 0) {
#pragma unroll
                    for (int j = 0; j < 4; ++j) xr[64 * j] = v[j];
#pragma unroll
                    for (int j = 0; j < 4; ++j) v[j] = v[j] * rstd * gr[64 * j];
                    store_row_bf16(HB + (size_t)m * DM, v, lane);
                } else {
#pragma unroll
                    for (int j = 0; j < 4; ++j) xr[64 * j] = v[j] * rstd * gr[64 * j];
                }
            }
        }
    }
}

__global__ void __launch_bounds__(NWAVES * 64, 2) mk_fwd(Args args) {
    extern __shared__ __attribute__((aligned(16))) unsigned char lds_raw[];
    LAS unsigned char* lds = (LAS unsigned char*)lds_raw;
    volatile LAS unsigned* LC = (volatile LAS unsigned*)(lds + LDSCTL_OFF);
    const int tid = threadIdx.x, lane = tid & 63, wave = __builtin_amdgcn_readfirstlane(tid >> 6);
    const int G = gridDim.x, bx = blockIdx.x;
    const int gw = bx * NWAVES + wave, NGW = G * NWAVES;
    unsigned char* ws = args.ws;
    unsigned* ctl = (unsigned*)(ws + WS_CTL);
    const float* x_in = args.in[0];
    float* xres = args.out;
    bf16* HB = (bf16*)(ws + WS_HB); bf16* Y = (bf16*)(ws + WS_Y);
    float* TBL = (float*)(ws + WS_TBL);

    for (int u = tid; u < (LDS_BYTES - LDSCTL_OFF) / 4; u += NWAVES * 64) LC[u] = 0u;
    __syncthreads();
    XcdBarrier bar; bar.bar = ctl + CW_BAR; bar.x = 0; bar.st = nullptr;
    if (MK_N_LAUNCHES == 1) bar = xcd_barrier_post(ctl + CW_BAR, LC + LC_BAR);
    const int lo = args.ph_lo, hi_ph = args.ph_hi;

    if (IN(0)) REP(0) {
        LAS float* scr = (LAS float*)(lds + wave * 16384);
        transpose_plain(args.in[4], DM, EV_IN, (bf16*)(ws + WS_WIN0), scr, gw, NGW, lane);
        transpose_plain(args.in[11], DM, DM, (bf16*)(ws + WS_WOUT0), scr, gw, NGW, lane);
        transpose_plain(args.in[12], DM, OD_IN, (bf16*)(ws + WS_WIN1), scr, gw, NGW, lane);
        transpose_plain(args.in[18], DM, DM, (bf16*)(ws + WS_WOUT1), scr, gw, NGW, lane);
        transpose_moe(args.in[24], args.in[25], args.in[26], (bf16*)(ws + WS_W13), (bf16*)(ws + WS_W2), scr, gw, NGW, lane);
        for (int i = bx * 512 + tid; i < 2048; i += G * 512) { const int pos = i >> 4, f = i & 15;
            const float inv = exp2f(-(float)f * (13.287712379549449f / 16.0f));
            const float ang = (float)pos * inv; const float rev = ang * 0.15915494309189535f; const float fr = rev - floorf(rev);
            TBL[TBL_COS + i] = __builtin_amdgcn_cosf(fr); TBL[TBL_SIN + i] = __builtin_amdgcn_sinf(fr); }
        for (int i = bx * 512 + tid; i < 8 * 257; i += G * 512) { const int h = i / 257, j = i % 257;
            TBL[TBL_BIAS + h * BIAS_STRIDE + j] = args.in[19][t5_bucket(j - 128) * 8 + h] * LOG2E; }
        for (int i = bx * 512 + tid; i < 2 * 1024 * 48; i += G * 512) { const int l = i / (1024 * 48), r = i % (1024 * 48), k = r / 48, c = r % 48;
            float w = 0.f; if (c < 4) w = args.in[20][(size_t)l * 4096 + k * 4 + c]; else if (c < 36) w = args.in[22][(size_t)l * 32768 + k * 32 + (c - 4)];
            TBL[TBL_WR + l * WR_LAYER + r] = w * args.in[2][l * DM + k]; }
        for (int i = bx * 512 + tid; i < 2 * 48; i += G * 512) { const int l = i / 48, c = i % 48;
            TBL[TBL_WR + l * WR_LAYER + 1024 * 48 + c] = c < 4 ? args.in[21][l * 4 + c] : (c < 36 ? args.in[23][l * 32 + (c - 4)] : 0.f); }
        for (int m = gw; m < NTOK; m += NGW) { f32x4 v[4]; rms_row(x_in + (size_t)m * DM, args.in[1], v, lane); store_row_bf16(HB + (size_t)m * DM, v, lane); }
    }
    SEAM(0);
    if (IN(1)) REP(1) {
        pg8::Gemm g{HB, (const bf16*)(ws + WS_WIN0), NTOK, EV_IN, DM}; pg8::StaticOrder S; S.init(NTOK, EV_IN, G, bx);
        pg8::EpiBf16 E{(bf16*)(ws + WS_Z0), EV_IN, 0, 0, 1.f, 0xffff};
        pg8::gemm_phase<pg8::EpiBf16, pg8::StaticOrder, true>(lds, g, S, E);
    }
    SEAM(1);
    if (IN(2)) REP(2) {
        const bf16* Z0 = (const bf16*)(ws + WS_Z0); bf16* QR = (bf16*)(ws + WS_QR); bf16* KR = (bf16*)(ws + WS_KR);
        if (QK_FP8 && (ATTN_VER == 1 || ATTN_VER == 3)) {
            for (int it = bx * 512 + tid; it < NTOK * 10; it += G * 512) {
                const bool isq = it < NTOK * 8; const int m = isq ? (it >> 3) : ((it - NTOK * 8) >> 1); const int hh = isq ? (it & 7) : 8 + ((it - NTOK * 8) & 1);
                const float* gn = isq ? args.in[5] : args.in[6];
                const GAS v4u* srcp = (const GAS v4u*)(Z0 + (size_t)m * EV_IN + hh * 64);
                float xv[64]; float ss = 0.f;
#pragma unroll
                for (int q = 0; q < 8; ++q) { const v4u a = srcp[q];
#pragma unroll
                    for (int j = 0; j < 4; ++j) { const float lo = __builtin_bit_cast(float, a[j] << 16), hh2 = __builtin_bit_cast(float, a[j] & 0xffff0000u); xv[q * 8 + 2 * j] = lo; xv[q * 8 + 2 * j + 1] = hh2; ss += lo * lo + hh2 * hh2; } }
                const float rs = (1.0f / sqrtf(ss * (1.f / 64.f) + 1e-6f)) * (isq ? C2 * 8.0f : 1.0f);
                const int sp = m & (SEQ - 1);
                unsigned wout[16];
#pragma unroll
                for (int half = 0; half < 2; ++half) { const int pos = half ? (sp & 63) : (sp >> 6);
                    const GAS f32x4* ct = (const GAS f32x4*)(TBL + TBL_COS + pos * 16); const GAS f32x4* st = (const GAS f32x4*)(TBL + TBL_SIN + pos * 16);
                    float ov[32];
#pragma unroll
                    for (int q = 0; q < 4; ++q) { const f32x4 cv = ct[q], sv = st[q];
#pragma unroll
                        for (int j = 0; j < 4; ++j) { const int i = q * 4 + j; const float a = xv[half * 32 + i] * rs * gn[half * 32 + i], b2 = xv[half * 32 + 16 + i] * rs * gn[half * 32 + 16 + i];
                            ov[i] = a * cv[j] - b2 * sv[j]; ov[16 + i] = b2 * cv[j] + a * sv[j]; } }
#pragma unroll
                    for (int q = 0; q < 8; ++q) { int d = __builtin_amdgcn_cvt_pk_fp8_f32(ov[4 * q], ov[4 * q + 1], 0, false); d = __builtin_amdgcn_cvt_pk_fp8_f32(ov[4 * q + 2], ov[4 * q + 3], d, true); wout[half * 8 + q] = (unsigned)d; } }
                if (!isq && ATTN_VER == 3) {
                    const int strm = (m >> 13) * 2 + (hh - 8); unsigned char* kb_ = ws + WS_K8T0 + ((((size_t)strm * 128 + (sp >> 6)) * 4) * 64 + (sp & 63)) * 16;
#pragma unroll
                    for (int q = 0; q < 4; ++q) *(GAS v4u*)(kb_ + q * 1024) = (v4u){wout[4 * q], wout[4 * q + 1], wout[4 * q + 2], wout[4 * q + 3]};
                } else {
                GAS v4u* dst = isq ? (GAS v4u*)(ws + WS_QR8 + (size_t)m * 512 + hh * 64) : (GAS v4u*)(ws + WS_KR8 + (size_t)m * 128 + (hh - 8) * 64);
#pragma unroll
                for (int q = 0; q < 4; ++q) dst[q] = (v4u){wout[4 * q], wout[4 * q + 1], wout[4 * q + 2], wout[4 * q + 3]};
                }
            }
            if (ATTN_VER == 3) {
                for (int it = bx * 512 + tid; it < 8 * 128 * 4 * 64; it += G * 512) { const int d = it & 63, c = (it >> 6) & 3, tt = (it >> 8) & 127, strm = it >> 15;
                    const bf16* vb_ = Z0 + ((size_t)(strm >> 1) * SEQ + tt * 64) * EV_IN + 640 + (strm & 1) * 64 + d; unsigned w4[4];
#pragma unroll
                    for (int q = 0; q < 4; ++q) { float f[4];
#pragma unroll
                        for (int j = 0; j < 4; ++j) { const int bb = q * 4 + j; const int key = 32 * (c & 1) + (bb & 3) + 8 * (bb >> 2) + 4 * (c >> 1); f[j] = bf2f(vb_[(size_t)key * EV_IN]); }
                        int dw = __builtin_amdgcn_cvt_pk_fp8_f32(f[0], f[1], 0, false); dw = __builtin_amdgcn_cvt_pk_fp8_f32(f[2], f[3], dw, true); w4[q] = (unsigned)dw; }
                    *(GAS v4u*)(ws + WS_V8T0 + (size_t)it * 16) = (v4u){w4[0], w4[1], w4[2], w4[3]}; }
            }
        } else {
        const float gq = args.in[5][lane], gk = args.in[6][lane];
        const int fi = lane & 15; const bool first = (lane & 16) == 0, isrow = lane < 32;
        for (int m = gw; m < NTOK; m += NGW) {
            const int s = m & (SEQ - 1); const int pos = isrow ? (s >> 6) : (s & 63);
            const float cs = TBL[TBL_COS + pos * 16 + fi], sn = TBL[TBL_SIN + pos * 16 + fi];
#pragma unroll
            for (int h = 0; h < 10; ++h) {
                const float xv = bf2f(Z0[(size_t)m * EV_IN + h * 64 + lane]);
                const float ss = wave_sum(xv * xv);
                const float y = xv * (1.0f / sqrtf(ss * (1.f / 64.f) + 1e-6f)) * (h < 8 ? gq : gk);
                const float p = __shfl_xor(y, 16);
                float o = first ? (y * cs - p * sn) : (y * cs + p * sn);
                if (!QK_FP8 || ATTN_VER != 1) { if (h < 8) QR[(size_t)m * 512 + h * 64 + lane] = (bf16)f2bf(o * C2);
                else KR[(size_t)m * 128 + (h - 8) * 64 + lane] = (bf16)f2bf(o); }
                if (QK_FP8) { const unsigned w = quad_pack_bytes(fp8_byte(h < 8 ? o * (C2 * 8.0f) : o));
                    if ((lane & 3) == 0) { if (h < 8) *(unsigned*)(ws + WS_QR8 + (size_t)m * 512 + h * 64 + lane) = w; else *(unsigned*)(ws + WS_KR8 + (size_t)m * 128 + (h - 8) * 64 + lane) = w; } }
            }
        }
        }
        LAS float* hbuf = (LAS float*)lds;
        for (int un = bx; un < NBATCH * 64 * 8; un += G) {
            const int grp = un & 7, tt = (un >> 3) & 63, b = un >> 9; const int t0 = tt * 128;
            __syncthreads();
            for (int idx = tid; idx < 158 * 8; idx += 512) { const int r = idx >> 3, c8 = idx & 7; const int s = t0 - 15 + r;
                f32x4 h0 = {0.f, 0.f, 0.f, 0.f}, h1 = h0;
                if (s >= 0 && s < SEQ) { const size_t ro = (size_t)(b * SEQ + s) * EV_IN + grp * 64 + c8 * 8;
                    const v4u av = *(const GAS v4u*)(Z0 + ro + 768), gv = *(const GAS v4u*)(Z0 + ro + 1280);
#pragma unroll
                    for (int j = 0; j < 4; ++j) { const float a0 = __builtin_bit_cast(float, av[j] << 16), a1 = __builtin_bit_cast(float, av[j] & 0xffff0000u);
                        const float g0 = __builtin_bit_cast(float, gv[j] << 16), g1 = __builtin_bit_cast(float, gv[j] & 0xffff0000u);
                        const float x0 = a0 * __builtin_amdgcn_rcpf(1.0f + __builtin_amdgcn_exp2f(-g0 * LOG2E)), x1 = a1 * __builtin_amdgcn_rcpf(1.0f + __builtin_amdgcn_exp2f(-g1 * LOG2E));
                        if (j < 2) { h0[2 * j] = x0; h0[2 * j + 1] = x1; } else { h1[2 * j - 4] = x0; h1[2 * j - 3] = x1; } } }
                *(LAS f32x4*)(hbuf + r * 64 + c8 * 8) = h0; *(LAS f32x4*)(hbuf + r * 64 + c8 * 8 + 4) = h1; }
            __syncthreads();
            const int ch = grp * 64 + lane;
            float wreg[31];
#pragma unroll
            for (int j = 0; j < 31; ++j) wreg[j] = args.in[7][j * 512 + ch];
            typedef float f32x2 __attribute__((ext_vector_type(2)));
            float acc[16]; const float cb = args.in[8][ch];
            {
                f32x2 he[23], ho[22];
#pragma unroll
                for (int k = 0; k < 23; ++k) { he[k].x = hbuf[(wave * 16 + 2 * k) * 64 + lane]; he[k].y = hbuf[(wave * 16 + 2 * k + 1) * 64 + lane]; }
#pragma unroll
                for (int k = 0; k < 22; ++k) { ho[k].x = he[k].y; ho[k].y = he[k + 1].x; }
                f32x2 a2[8];
#pragma unroll
                for (int p = 0; p < 8; ++p) a2[p] = (f32x2){cb, cb};
#pragma unroll
                for (int j = 0; j < 31; ++j) { const f32x2 wj = (f32x2){wreg[j], wreg[j]};
#pragma unroll
                    for (int p = 0; p < 8; ++p) { const int r = 2 * p + j; a2[p] = __builtin_elementwise_fma(wj, (r & 1) ? ho[r >> 1] : he[r >> 1], a2[p]); } }
#pragma unroll
                for (int p = 0; p < 8; ++p) { acc[2 * p] = a2[p].x; acc[2 * p + 1] = a2[p].y; }
            }
            const float gg = args.in[9][ch], gb = args.in[10][ch];
#pragma unroll
            for (int i = 0; i < 16; ++i) { const float mu = wave_sum(acc[i]) * (1.f / 64.f); const float d = acc[i] - mu; const float var = wave_sum(d * d) * (1.f / 64.f);
                const float hn = d * (1.0f / sqrtf(var + 1e-5f)) * gg + gb; const float ov = hn * __builtin_amdgcn_rcpf(1.0f + __builtin_amdgcn_exp2f(-hn * LOG2E));
                Y[(size_t)(b * SEQ + t0 + wave * 16 + i) * DM + 512 + ch] = (bf16)f2bf(ov); }
        }
    }
    SEAM(2);
    if (IN(3)) REP(3) {
        const bf16* QR = (const bf16*)(ws + WS_QR); const bf16* KR = (const bf16*)(ws + WS_KR); const bf16* Z0 = (const bf16*)(ws + WS_Z0);
        if (ATTN_L0_TEST) {
        for (int un = bx; un < NBATCH * 8 * 32; un += G) {
            const int qb = un & 31, h = (un >> 5) & 7, b = un >> 8, kvh = h >> 2;
            const size_t row0 = (size_t)b * SEQ + qb * 256;
            attn_unit_v0<64, false, true>((const bf16*)(ws + WS_QR8 + row0 * 512 + h * 64), 512, (const bf16*)(ws + WS_KR8 + (size_t)b * SEQ * 128 + kvh * 64), 128, Z0 + (size_t)b * SEQ * EV_IN + 640 + kvh * 64, EV_IN,
                                   Y + row0 * DM + h * 64, DM, nullptr, qb * 256, lds);
        }
        } else if (ATTN_VER == 0) {
        for (int un = bx; un < NBATCH * 8 * 32; un += G) {
            const int qb = un & 31, h = (un >> 5) & 7, b = un >> 8, kvh = h >> 2;
            const size_t row0 = (size_t)b * SEQ + qb * 256;
            attn_unit_v0<64, false>(QR + row0 * 512 + h * 64, 512, KR + (size_t)b * SEQ * 128 + kvh * 64, 128, Z0 + (size_t)b * SEQ * EV_IN + 640 + kvh * 64, EV_IN,
                                   Y + row0 * DM + h * 64, DM, nullptr, qb * 256, lds);
        }
        } else {
        constexpr int U = NBATCH * 8 * 32; const int upc = (U + G - 1) / G; const int vcu = (G % 8 == 0) ? (bx % 8) * (G / 8) + bx / 8 : bx;
        for (int i = 0; i < upc; ++i) { const int un = vcu * upc + i; if (un >= U) break;
            const int stream = un >> 7, b = stream >> 1, kvh = stream & 1, h = kvh * 4 + ((un >> 5) & 3), qb = un & 31;
            const size_t row0 = (size_t)b * SEQ + qb * 256;
            if (ATTN_VER == 3) at3::attn_unit<64, false, 0>(ws + WS_QR8 + row0 * 512 + h * 64, 512, ws + WS_K8T0 + (size_t)stream * 128 * 4096, ws + WS_V8T0 + (size_t)stream * 128 * 4096, Y + row0 * DM + h * 64, DM, qb * 256, lds, nullptr);
            else if (QK_FP8) at1::attn_unit<64, false, 0, 0, true>((const bf16*)(ws + WS_QR8 + row0 * 512 + h * 64), 512, (const bf16*)(ws + WS_KR8 + (size_t)b * SEQ * 128 + kvh * 64), 128, Z0 + (size_t)b * SEQ * EV_IN + 640 + kvh * 64, EV_IN,
                                      Y + row0 * DM + h * 64, DM, qb * 256, lds);
            else at1::attn_unit<64, false>(QR + row0 * 512 + h * 64, 512, KR + (size_t)b * SEQ * 128 + kvh * 64, 128, Z0 + (size_t)b * SEQ * EV_IN + 640 + kvh * 64, EV_IN,
                                      Y + row0 * DM + h * 64, DM, qb * 256, lds);
        }
        }
    }
    SEAM(3);
    if (IN(4)) REP(4) {
        pg8::Gemm g{Y, (const bf16*)(ws + WS_WOUT0), NTOK, DM, DM}; pg8::StaticOrder S; S.init(NTOK, DM, G, bx);
        pg8::EpiRes E{x_in, xres, DM};
        pg8::gemm_phase<pg8::EpiRes, pg8::StaticOrder, true>(lds, g, S, E);
    }
    SEAM(4);

    moe_block<0>(args, lds, bar, lo, hi_ph);
    SEAM(8);
            if (IN(9)) REP(9) {
                pg8::Gemm g{HB, (const bf16*)(ws + WS_WIN1), NTOK, OD_IN, DM}; pg8::StaticOrder S; S.init(NTOK, OD_IN, G, bx);
                if (QK_FP8) { pg8::EpiQKV8 E{ws + WS_Q1, ws + WS_K8T1, (bf16*)(ws + WS_V1), C2 * 8.0f, true};
                    pg8::gemm_phase<pg8::EpiQKV8, pg8::StaticOrder, true>(lds, g, S, E); }
                else { pg8::EpiBf16 E{(bf16*)(ws + WS_Q1), DM, DM, (size_t)(WS_K1 - WS_Q1) / 2, C2, 0xffff};
                pg8::gemm_phase<pg8::EpiBf16, pg8::StaticOrder, true>(lds, g, S, E); }
            }
            SEAM(9);
            if (ATTN_L1_VER == 3) {
            if (IN(10)) {
                const bf16* V1 = (const bf16*)(ws + WS_V1);
                for (int it = bx * 512 + tid; it < 32 * 128 * 4 * 128; it += G * 512) { const int d = it & 127, c = (it >> 7) & 3, tt = (it >> 9) & 127, bh = it >> 16;
                    const bf16* vb_ = V1 + ((size_t)(bh >> 3) * SEQ + tt * 64) * DM + (bh & 7) * 128 + d; unsigned w4[4];
#pragma unroll
                    for (int q = 0; q < 4; ++q) { float f[4];
#pragma unroll
                        for (int j = 0; j < 4; ++j) { const int bb = q * 4 + j; const int key = 32 * (c & 1) + (bb & 3) + 8 * (bb >> 2) + 4 * (c >> 1); f[j] = bf2f(vb_[(size_t)key * DM]); }
                        int dw = __builtin_amdgcn_cvt_pk_fp8_f32(f[0], f[1], 0, false); dw = __builtin_amdgcn_cvt_pk_fp8_f32(f[2], f[3], dw, true); w4[q] = (unsigned)dw; }
                    *(GAS v4u*)(ws + WS_V8T1 + (size_t)it * 16) = (v4u){w4[0], w4[1], w4[2], w4[3]}; }
            }
            SEAM(10);
            if (IN(11)) REP(11) {
                constexpr int UP = NBATCH * 8 * 32; const int upc = (UP + G - 1) / G; const int vcu = (G % 8 == 0) ? (bx % 8) * (G / 8) + bx / 8 : bx;
                LAS float* btbl = (LAS float*)(lds + at3::lds_tbl_off<128>());
                LAS float* sgt = btbl + 272;
                __syncthreads();
                if (tid < 128) sgt[tid] = args.in[17][tid] * (1.0f - LAM_INIT);
                if (wave == 7) { const float lam = __expf(wave_sum(args.in[13][lane] * args.in[14][lane])) - __expf(wave_sum(args.in[15][lane] * args.in[16][lane])) + LAM_INIT; if (lane == 0) sgt[128] = lam; }
                for (int i = 0; i < upc; ++i) {
                    int up = vcu * upc + i; if (up >= UP) break;
                    if (G == 256) up = ((vcu >> 5) * 4 + i) * 32 + (vcu & 31);
                    const int qb = up & 31, h = (up >> 5) & 7, b = up >> 8;
                    __syncthreads();
                    if (tid < 257) btbl[tid] = TBL[TBL_BIAS + h * BIAS_STRIDE + tid] - TBL[TBL_BIAS + h * BIAS_STRIDE + 256];
                    __syncthreads();
                    const size_t row0 = (size_t)b * SEQ + qb * 256; const int bh = b * 8 + h;
                    const unsigned char* Q8 = ws + WS_Q1 + row0 * DM + h * 128; const unsigned char* V8 = ws + WS_V8T1 + (size_t)bh * 128 * 8192;
                    at3::attn_unit<128, true, 1>(Q8, DM, ws + WS_K8T1 + (size_t)(bh * 2) * 128 * 4096, V8, nullptr, DM, qb * 256, lds, sgt);
                    at3::attn_unit<128, true, 2>(Q8 + 64, DM, ws + WS_K8T1 + (size_t)(bh * 2 + 1) * 128 * 4096, V8, Y + row0 * DM + h * 128, DM, qb * 256, lds, sgt);
                }
            }
            SEAM(11);
            } else {
            if (IN(10)) REP(10) {
                const bf16* Q1 = (const bf16*)(ws + WS_Q1); const bf16* K1 = (const bf16*)(ws + WS_K1); const bf16* V1 = (const bf16*)(ws + WS_V1);
                if (ATTN_L1_VER == 0) {
                LAS float* btbl = (LAS float*)(lds + 65536);
                for (int un = bx; un < NBATCH * 8 * 2 * 32; un += G) {
                    const int qb = un & 31, c = (un >> 5) & 1, h = (un >> 6) & 7, b = un >> 9;
                    __syncthreads();
                    if (tid < 257) btbl[tid] = TBL[TBL_BIAS + h * BIAS_STRIDE + tid];
                    __syncthreads();
                    const size_t row0 = (size_t)b * SEQ + qb * 256, brow = (size_t)b * SEQ;
                    bf16* OC = (bf16*)(ws + (c ? WS_OC1 : WS_OC0));
                    attn_unit_v0<128, true>(Q1 + row0 * DM + h * 128 + c * 64, DM, K1 + brow * DM + h * 128 + c * 64, DM, V1 + brow * DM + h * 128, DM,
                                           OC + row0 * DM + h * 128, DM, btbl, qb * 256, lds);
                }
                } else {
                constexpr int UP = NBATCH * 8 * 32; const int upc = (UP + G - 1) / G; const int vcu = (G % 8 == 0) ? (bx % 8) * (G / 8) + bx / 8 : bx;
                LAS float* btbl = (LAS float*)(lds + at1::lds_tbl_off<128, QK_FP8 != 0>());
                LAS float* sgt = btbl + 272;
                __syncthreads();
                if (tid < 128) sgt[tid] = args.in[17][tid] * (1.0f - LAM_INIT);
                if (wave == 7) { const float lam = __expf(wave_sum(args.in[13][lane] * args.in[14][lane])) - __expf(wave_sum(args.in[15][lane] * args.in[16][lane])) + LAM_INIT; if (lane == 0) sgt[128] = lam; }
                for (int i = 0; i < upc; ++i) {
                    int up = vcu * upc + i; if (up >= UP) break;
                    if (G == 256) up = ((vcu >> 5) * 4 + i) * 32 + (vcu & 31);
                    const int qb = up & 31, h = (up >> 5) & 7, b = up >> 8;
                    __syncthreads();
                    if (tid < 257) btbl[tid] = TBL[TBL_BIAS + h * BIAS_STRIDE + tid] - TBL[TBL_BIAS + h * BIAS_STRIDE + 256];
                    __syncthreads();
                    const size_t row0 = (size_t)b * SEQ + qb * 256, brow = (size_t)b * SEQ;
                    if (QK_FP8) { const unsigned char* Q8 = ws + WS_Q1; const unsigned char* K8 = ws + WS_K1;
                    const int bh = b * 8 + h; const bf16* VT = V1 + (size_t)bh * 128 * 8192; const unsigned char* KT0 = ws + WS_K8T1 + (size_t)(bh * 2) * 128 * 4096; (void)K8; (void)brow;
                    at1::attn_unit<128, true, 0, 1, true, true>((const bf16*)(Q8 + row0 * DM + h * 128), DM, (const bf16*)KT0, DM, VT, DM, nullptr, DM, qb * 256, lds, sgt);
                    at1::attn_unit<128, true, 0, 2, true, true>((const bf16*)(Q8 + row0 * DM + h * 128 + 64), DM, (const bf16*)(KT0 + 128 * 4096), DM, VT, DM, Y + row0 * DM + h * 128, DM, qb * 256, lds, sgt);
                    } else {
                    at1::attn_unit<128, true, 0, 1>(Q1 + row0 * DM + h * 128, DM, K1 + brow * DM + h * 128, DM, V1 + brow * DM + h * 128, DM, nullptr, DM, qb * 256, lds, sgt);
                    at1::attn_unit<128, true, 0, 2>(Q1 + row0 * DM + h * 128 + 64, DM, K1 + brow * DM + h * 128 + 64, DM, V1 + brow * DM + h * 128, DM, Y + row0 * DM + h * 128, DM, qb * 256, lds, sgt);
                    }
                }
                }
            }
            SEAM(10);
            if (PROBE_ATT >= 0 && IN(10)) {
                const bf16* Q1 = (const bf16*)(ws + WS_Q1); const bf16* K1 = (const bf16*)(ws + WS_K1); const bf16* V1 = (const bf16*)(ws + WS_V1);
                constexpr int U = NBATCH * 8 * 2 * 32; const int upc = (U + G - 1) / G; const int vcu = (G % 8 == 0) ? (bx % 8) * (G / 8) + bx / 8 : bx;
                LAS float* btbl = (LAS float*)(lds + 3 * 8192 + 3 * 16384 + 2048);
                for (int i = 0; i < upc; ++i) {
                    int un = vcu * upc + i; if (un >= U) break;
                    if (G == 256) un = ((vcu >> 5) * 4 + (i >> 1)) * 64 + (i & 1) * 32 + (vcu & 31);
                    const int qb = un & 31, c = (un >> 5) & 1, h = (un >> 6) & 7, b = un >> 9;
                    if (tid < 257) btbl[tid] = TBL[TBL_BIAS + h * BIAS_STRIDE + tid] - TBL[TBL_BIAS + h * BIAS_STRIDE + 256];
                    __syncthreads();
                    const size_t row0 = (size_t)b * SEQ + qb * 256, brow = (size_t)b * SEQ;
                    at1::attn_unit<128, true, (PROBE_ATT >= 0 ? PROBE_ATT : 0)>(Q1 + row0 * DM + h * 128 + c * 64, DM, K1 + brow * DM + h * 128 + c * 64, DM, V1 + brow * DM + h * 128, DM,
                                              (bf16*)(ws + WS_OC1) + row0 * DM + h * 128, DM, qb * 256, lds);
                }
                xcd_barrier(bar);
            }
            if (IN(11) && ATTN_L1_VER != 1) REP(11) {
                const bf16* OC0 = (const bf16*)(ws + WS_OC0); const bf16* OC1 = (const bf16*)(ws + WS_OC1);
                const float lam = __expf(wave_sum(args.in[13][lane] * args.in[14][lane])) - __expf(wave_sum(args.in[15][lane] * args.in[16][lane])) + LAM_INIT;
                float sg[16];
#pragma unroll
                for (int j = 0; j < 16; ++j) sg[j] = args.in[17][(lane & 7) * 16 + j] * (1.0f - LAM_INIT);
                for (int m = gw; m < NTOK; m += NGW) {
                    const GAS v4u* a = (const GAS v4u*)(OC0 + (size_t)m * DM) + lane * 2; const GAS v4u* c = (const GAS v4u*)(OC1 + (size_t)m * DM) + lane * 2;
                    float o[16]; float ss = 0.f;
#pragma unroll
                    for (int q = 0; q < 2; ++q) { const v4u av = a[q], cv = c[q];
#pragma unroll
                        for (int j = 0; j < 4; ++j) { const unsigned au = av[j], cu = cv[j];
                            const float lo = __builtin_bit_cast(float, au << 16) - lam * __builtin_bit_cast(float, cu << 16);
                            const float hh = __builtin_bit_cast(float, au & 0xffff0000u) - lam * __builtin_bit_cast(float, cu & 0xffff0000u);
                            o[q * 8 + 2 * j] = lo; o[q * 8 + 2 * j + 1] = hh; ss += lo * lo + hh * hh; } }
                    ss += __shfl_xor(ss, 1); ss += __shfl_xor(ss, 2); ss += __shfl_xor(ss, 4);
                    const float rstd = 1.0f / sqrtf(ss * (1.f / 128.f) + 1e-5f);
                    v4u w0, w1;
                    w0.x = pk2(o[0] * rstd * sg[0], o[1] * rstd * sg[1]); w0.y = pk2(o[2] * rstd * sg[2], o[3] * rstd * sg[3]); w0.z = pk2(o[4] * rstd * sg[4], o[5] * rstd * sg[5]); w0.w = pk2(o[6] * rstd * sg[6], o[7] * rstd * sg[7]);
                    w1.x = pk2(o[8] * rstd * sg[8], o[9] * rstd * sg[9]); w1.y = pk2(o[10] * rstd * sg[10], o[11] * rstd * sg[11]); w1.z = pk2(o[12] * rstd * sg[12], o[13] * rstd * sg[13]); w1.w = pk2(o[14] * rstd * sg[14], o[15] * rstd * sg[15]);
                    GAS v4u* yo = (GAS v4u*)(Y + (size_t)m * DM) + lane * 2; yo[0] = w0; yo[1] = w1;
                }
            }
            if (ATTN_L1_VER != 1) SEAM(11);
            }
            if (IN(12)) {
                pg8::Gemm g{Y, (const bf16*)(ws + WS_WOUT1), NTOK, DM, DM}; pg8::StaticOrder S; S.init(NTOK, DM, G, bx);
                pg8::EpiRes E{xres, xres, DM};
                pg8::gemm_phase<pg8::EpiRes, pg8::StaticOrder, true>(lds, g, S, E);
            }
            SEAM(12);
    moe_block<1>(args, lds, bar, lo, hi_ph);
#undef IN
#undef SEAM
}

extern "C" void kernel_launch(void* const* d_in, const int* in_sizes, int n_in, void* d_out, int out_size, void* d_ws, size_t ws_size, hipStream_t stream) {
    static int grid = 0;
    if (grid == 0) {
        if (n_in != 27 || in_sizes[0] != NTOK * DM || out_size != NTOK * DM || ws_size < WS_END) { fprintf(stderr, "kernel_launch: unexpected shapes / workspace (n_in %d, ws %zu)\n", n_in, ws_size); grid = -1; return; }
        int dev = 0, cus = 0, per_cu = 0;
        if (hipGetDevice(&dev) != hipSuccess || hipDeviceGetAttribute(&cus, hipDeviceAttributeMultiprocessorCount, dev) != hipSuccess) { grid = -1; return; }
        if (hipFuncSetAttribute((const void*)mk_fwd, hipFuncAttributeMaxDynamicSharedMemorySize, LDS_BYTES) != hipSuccess) { fprintf(stderr, "kernel_launch: hipFuncSetAttribute failed\n"); grid = -1; return; }
        if (hipOccupancyMaxActiveBlocksPerMultiprocessor(&per_cu, (const void*)mk_fwd, NWAVES * 64, LDS_BYTES) != hipSuccess || per_cu < 1) { fprintf(stderr, "kernel_launch: occupancy query says %d\n", per_cu); }
        (void)hipGetLastError();
        grid = cus;
    }
    if (grid < 0) return;
    if (hipMemsetAsync((char*)d_ws + WS_CTL, 0, CTL_ZERO_BYTES, stream) != hipSuccess) return;
    Args a{};
    for (int i = 0; i < 27; ++i) a.in[i] = (const float*)d_in[i];
    a.out = (float*)d_out; a.ws = (unsigned char*)d_ws;
    if (MK_N_LAUNCHES == 1) { a.ph_lo = 0; a.ph_hi = NPHASE; a.li = 0; hipLaunchKernelGGL(mk_fwd, dim3(grid), dim3(NWAVES * 64), LDS_BYTES, stream, a); }
    else { for (int p = 0; p < NPHASE; ++p) for (int r = 0; r < (int)((PROBE_MASK >> p) & 1u) + 1; ++r) { a.ph_lo = p; a.ph_hi = p + 1; a.li = p; hipLaunchKernelGGL(mk_fwd, dim3(grid), dim3(NWAVES * 64), LDS_BYTES, stream, a); } }
}
```

```cpp
#include <hip/hip_runtime.h>
#include <cstdio>
#include <cstdint>

#ifndef MK_N_LAUNCHES
#define MK_N_LAUNCHES 1
#endif

#ifndef ATTN_VER
#define ATTN_VER 3
#endif
#ifndef PROBE_ATT
#define PROBE_ATT -1
#endif
#ifndef QK_FP8
#define QK_FP8 1
#endif
#ifndef ATTN_L0_TEST
#define ATTN_L0_TEST 0
#endif
#ifndef ATTN_L1_VER
#define ATTN_L1_VER 1
#endif
#ifndef MOE_FP8
#define MOE_FP8 1
#endif
#ifndef PROBE_MASK
#define PROBE_MASK 0u
#endif
#define REP(k) _Pragma("unroll") for (int rep_ = 0; rep_ < (MK_N_LAUNCHES == 1 ? (int)((PROBE_MASK >> (k)) & 1u) : 0) + 1; ++rep_)
#define GAS __attribute__((address_space(1)))
#define LAS __attribute__((address_space(3)))
typedef unsigned short bf16;
typedef unsigned v4u __attribute__((ext_vector_type(4)));
typedef unsigned v2u __attribute__((ext_vector_type(2)));
typedef float f32x4 __attribute__((ext_vector_type(4)));
typedef float f32x16 __attribute__((ext_vector_type(16)));
typedef short bf16x8 __attribute__((ext_vector_type(8)));
typedef short s16x4 __attribute__((ext_vector_type(4)));
typedef int v8i __attribute__((ext_vector_type(8)));

constexpr int NTOK = 32768, DM = 1024, SEQ = 8192, NBATCH = 4;
constexpr int EV_IN = 1792, OD_IN = 3072;
constexpr int NEXP = 32, MOE_H = 512, LIST_CAP = 32768;
constexpr float C2 = 0.125f * 1.4426950408889634f;
constexpr float LOG2E = 1.4426950408889634f;
constexpr float LAM_INIT = 0.35550906759f;

constexpr size_t MiB = 1u << 20;
constexpr size_t WS_CTL = 0, CTL_ZERO_BYTES = 1 * MiB;
constexpr size_t WS_WIN0 = 1 * MiB, WS_WOUT0 = 5 * MiB, WS_WIN1 = 7 * MiB, WS_WOUT1 = 13 * MiB, WS_TBL = 15 * MiB;
constexpr size_t WS_W13 = 16 * MiB, WS_W2 = 80 * MiB;
constexpr size_t WS_HB = 112 * MiB;
constexpr size_t WS_Y = 176 * MiB;
constexpr size_t WS_Z0 = 240 * MiB, WS_QR = 352 * MiB, WS_KR = 384 * MiB, WS_QR8 = 392 * MiB, WS_KR8 = 408 * MiB, WS_K8T0 = 408 * MiB, WS_V8T0 = 412 * MiB;
constexpr size_t WS_K8T1 = 304 * MiB, WS_V8T1 = 336 * MiB;
constexpr size_t WS_Q1 = 240 * MiB, WS_K1 = 304 * MiB, WS_V1 = 368 * MiB, WS_OC1 = 432 * MiB, WS_OC0 = WS_HB;
constexpr size_t WS_H = 176 * MiB, WS_YS = 248 * MiB, WS_LIST = 392 * MiB, WS_TOKEP = 396 * MiB, WS_GATE = 396 * MiB + 512 * 1024;
constexpr size_t WS_XB = 432 * MiB;
constexpr size_t WS_END = 496 * MiB;
constexpr int TBL_COS = 0, TBL_SIN = 2048, TBL_BIAS = 4096, BIAS_STRIDE = 272;
constexpr int TBL_WR = 32768, WR_LAYER = 1024 * 48 + 64;
constexpr int CW_BAR = 4096;
constexpr int CW_CNT = 16384;

constexpr int RING_BYTES = 131072;
constexpr int LDS_BYTES = 147456;
constexpr int LDSCTL_OFF = LDS_BYTES - 1024;
constexpr int STASH_OFF = 78 * 1024;
constexpr int LC_BAR = 8;
constexpr int LC_TP = 16;
constexpr int LC_CNT = 64;
constexpr int LC_LCNT = 96;
constexpr int LC_LBASE = 128;
constexpr int LC_LP = 160;

#define LDS_WAIT() asm volatile("s_waitcnt lgkmcnt(0)" ::: "memory")
#define VM_WAIT() asm volatile("s_waitcnt vmcnt(0)" ::: "memory")
#define RLX_AGENT __ATOMIC_RELAXED, __HIP_MEMORY_SCOPE_AGENT

__device__ __forceinline__ unsigned f2bf(float f) { unsigned u = __builtin_bit_cast(unsigned, f); return (u + 0x7fffu + ((u >> 16) & 1u)) >> 16; }
__device__ __forceinline__ unsigned pk2(float lo, float hi) { return f2bf(lo) | (f2bf(hi) << 16); }
__device__ __forceinline__ float bf2f(unsigned short b) { return __builtin_bit_cast(float, (unsigned)b << 16); }
template <int CTRL> __device__ __forceinline__ float dpp_mov(float v) { return __builtin_bit_cast(float, __builtin_amdgcn_update_dpp(0, __builtin_bit_cast(int, v), CTRL, 0xf, 0xf, true)); }
__device__ __forceinline__ float wave_sum(float v) {
    v += dpp_mov<0xB1>(v); v += dpp_mov<0x4E>(v); v += dpp_mov<0x141>(v); v += dpp_mov<0x140>(v);
    { auto rr = __builtin_amdgcn_permlane16_swap(__float_as_uint(v), __float_as_uint(v), false, false); v = __uint_as_float(rr[0]) + __uint_as_float(rr[1]); }
    { auto rr = __builtin_amdgcn_permlane32_swap(__float_as_uint(v), __float_as_uint(v), false, false); v = __uint_as_float(rr[0]) + __uint_as_float(rr[1]); }
    return v;
}


__device__ __forceinline__ unsigned fp8_byte(float v) { return (unsigned)__builtin_amdgcn_cvt_pk_fp8_f32(v, v, 0, false) & 0xffu; }
__device__ __forceinline__ unsigned quad_pack_bytes(unsigned b) {
    const unsigned x0 = (unsigned)__builtin_amdgcn_update_dpp(0, (int)b, 0x00, 0xf, 0xf, true), x1 = (unsigned)__builtin_amdgcn_update_dpp(0, (int)b, 0x55, 0xf, 0xf, true);
    const unsigned x2 = (unsigned)__builtin_amdgcn_update_dpp(0, (int)b, 0xAA, 0xf, 0xf, true), x3 = (unsigned)__builtin_amdgcn_update_dpp(0, (int)b, 0xFF, 0xf, 0xf, true);
    return x0 | (x1 << 8) | (x2 << 16) | (x3 << 24);
}
namespace pg8 {
#define PG8_LAS __attribute__((address_space(3)))
typedef unsigned short bf16_t;
typedef short bf16x8 __attribute__((ext_vector_type(8)));
typedef float f32x4 __attribute__((ext_vector_type(4)));
typedef unsigned u32x4 __attribute__((ext_vector_type(4)));
constexpr int BM = 256, BK = 64, HALF = 128, HTB = HALF * BK * 2, STAGE_BYTES = 8 * HTB, NXCD = 8, WGM = 8;

__host__ __device__ __forceinline__ int lds_byte(int r, int c) { const int st = (r >> 4) * 2 + (c >> 5), rr = r & 15, cc = c & 31, ob = rr * 64 + cc * 2; return st * 1024 + (ob ^ (((ob >> 9) & 1) << 5)); }
__host__ __device__ __forceinline__ void stage_rc(int b, int& R, int& C) { const int st = b / 1024, sb = b % 1024, swz = sb ^ (((sb >> 9) & 1) << 5); R = (st >> 1) * 16 + swz / 64; C = (st & 1) * 32 + (swz % 64) / 2; }
__host__ __device__ __forceinline__ int perm32(int rho) { const int n = rho >> 4, i = rho & 15; return 8 * (i >> 2) + 4 * n + (i & 3); }

struct Unit { int pm, pn, e, rb; };
struct Gemm { const bf16_t* A; const bf16_t* Bt; int M, N, K; };

struct StaticOrder {
    int nM, nN, nwg, G, c;
    __device__ void init(int M, int N, int G_, int c_) { nM = M / BM; nN = N / BM; nwg = nM * nN; G = G_; c = c_; }
    __device__ bool next(int i, Unit& u) const {
        const long L = (long)i * G + c; if (L >= nwg) return false;
        int wgid = (int)L; { const int q = nwg / NXCD, r = nwg % NXCD, xcd = wgid % NXCD, off = wgid / NXCD; wgid = (xcd < r ? xcd * (q + 1) : r * (q + 1) + (xcd - r) * q) + off; }
        const int nig = WGM * nN, gid = wgid / nig, fm = gid * WGM, gsz = (nM - fm) < WGM ? (nM - fm) : WGM;
        u.pm = fm + ((wgid % nig) % gsz); u.pn = (wgid % nig) / gsz; u.e = 0; u.rb = 0; return true;
    }
    __device__ __forceinline__ unsigned arow(const Unit& u, int rr) const { return (unsigned)(u.pm * BM + rr); }
};

struct MoeOrder {
    const PG8_LAS int* tp; const PG8_LAS int* cn; const PG8_LAS int* lp; const int* list; int G, c, nunits; bool gather; bool xcd;
    __device__ __forceinline__ bool next(int i, Unit& u) const {
        int e_, rb_, pm_, pnl_; bool ok;
        if (xcd) {
            const int x = c & 7, y = c >> 3; const int uidx = i * 32 + y; ok = uidx < lp[4] * 4;
            const int rbl = uidx >> 2; pnl_ = uidx & 3; int j = 0;
#pragma unroll
            for (int q = 1; q < 4; ++q) j += (lp[q] <= rbl) ? 1 : 0;
            e_ = x + 8 * j; rb_ = rbl - lp[j]; pm_ = tp[e_] + rb_;
        } else {
            const int L = i * G + c; ok = L < nunits;
            const int rbg = L >> 2; pnl_ = L & 3; int e = 0;
#pragma unroll
            for (int j = 1; j < 32; ++j) e += (tp[j] <= rbg) ? 1 : 0;
            e_ = e; pm_ = rbg; rb_ = rbg - tp[e];
        }
        u.e = __builtin_amdgcn_readfirstlane(e_); u.rb = __builtin_amdgcn_readfirstlane(rb_); u.pm = __builtin_amdgcn_readfirstlane(pm_); u.pn = __builtin_amdgcn_readfirstlane(e_ * 4 + pnl_);
        return ok;
    }
    __device__ __forceinline__ unsigned arow(const Unit& u, int rr) const {
        if (!gather) return (unsigned)(u.pm * BM + rr);
        const int idx = u.rb * BM + rr; unsigned t = 0u;
        if (idx < cn[u.e]) t = (unsigned)list[(size_t)u.e * 32768 + idx];
        return t;
    }
};

__device__ __forceinline__ unsigned cvt_pk_bf16(float lo, float hi) { unsigned r; asm volatile("v_cvt_pk_bf16_f32 %0, %1, %2" : "=v"(r) : "v"(lo), "v"(hi)); return r; }

struct EpiBf16 {
    static constexpr bool PERM = true;
    bf16_t* O; int ldc; int split_cols; size_t split_stride; float scale0; int pn_mask; bool f8;
    __device__ __forceinline__ void operator()(const f32x4 (&acc)[2][2][4][2], const Unit& u, int wr, int wc, int fr, int fq) const {
        const int row0 = u.pm * BM + wr * 64 + fr; int colt = (u.pn & pn_mask) * BM; bf16_t* base = O;
        float sc = 1.f; if (split_cols) { const int t = colt / split_cols; base += (size_t)t * split_stride; colt -= t * split_cols; if (t == 0) sc = scale0; }
        if (f8) sc = 8.0f;
        const int col0 = colt + wc * 32 + 8 * fq;
#pragma unroll
        for (int ai = 0; ai < 2; ++ai)
#pragma unroll
            for (int m = 0; m < 4; ++m) { const size_t ro = (size_t)(row0 + ai * HALF + m * 16) * ldc + col0;
#pragma unroll
                for (int bj = 0; bj < 2; ++bj) { f32x4 v0 = acc[ai][bj][m][0] * sc, v1 = acc[ai][bj][m][1] * sc;
                    if (f8) { typedef unsigned u32x2 __attribute__((ext_vector_type(2)));
                        int d0 = __builtin_amdgcn_cvt_pk_fp8_f32(v0[0], v0[1], 0, false); d0 = __builtin_amdgcn_cvt_pk_fp8_f32(v0[2], v0[3], d0, true);
                        int d1 = __builtin_amdgcn_cvt_pk_fp8_f32(v1[0], v1[1], 0, false); d1 = __builtin_amdgcn_cvt_pk_fp8_f32(v1[2], v1[3], d1, true);
                        *(u32x2*)((unsigned char*)base + ro + bj * HALF) = (u32x2){(unsigned)d0, (unsigned)d1};
                    } else {
                    u32x4 w; w.x = cvt_pk_bf16(v0[0], v0[1]); w.y = cvt_pk_bf16(v0[2], v0[3]); w.z = cvt_pk_bf16(v1[0], v1[1]); w.w = cvt_pk_bf16(v1[2], v1[3]);
                    *(u32x4*)(base + ro + bj * HALF) = w; } } }
    }
};
struct EpiRes {
    static constexpr bool PERM = true;
    const float* base32; const bf16_t* base16; bf16_t* out; int ldc;
    __device__ __forceinline__ void operator()(const f32x4 (&acc)[2][2][4][2], const Unit& u, int wr, int wc, int fr, int fq) const {
        const int row0 = u.pm * BM + wr * 64 + fr, col0 = u.pn * BM + wc * 32 + 8 * fq;
#pragma unroll
        for (int ai = 0; ai < 2; ++ai)
#pragma unroll
            for (int m = 0; m < 4; ++m) { const size_t off = (size_t)(row0 + ai * HALF + m * 16) * ldc + col0;
#pragma unroll
                for (int bj = 0; bj < 2; ++bj) { f32x4 b0, b1;
                    if (base32) { b0 = *(const f32x4*)(base32 + off + bj * HALF); b1 = *(const f32x4*)(base32 + off + bj * HALF + 4); }
                    else { const u32x4 w = *(const u32x4*)(base16 + off + bj * HALF);
                        b0 = (f32x4){__builtin_bit_cast(float, w.x << 16), __builtin_bit_cast(float, w.x & 0xffff0000u), __builtin_bit_cast(float, w.y << 16), __builtin_bit_cast(float, w.y & 0xffff0000u)};
                        b1 = (f32x4){__builtin_bit_cast(float, w.z << 16), __builtin_bit_cast(float, w.z & 0xffff0000u), __builtin_bit_cast(float, w.w << 16), __builtin_bit_cast(float, w.w & 0xffff0000u)}; }
                    const f32x4 v0 = b0 + acc[ai][bj][m][0], v1 = b1 + acc[ai][bj][m][1];
                    u32x4 o; o.x = cvt_pk_bf16(v0[0], v0[1]); o.y = cvt_pk_bf16(v0[2], v0[3]); o.z = cvt_pk_bf16(v1[0], v1[1]); o.w = cvt_pk_bf16(v1[2], v1[3]);
                    *(u32x4*)(out + off + bj * HALF) = o; } }
    }
};
struct EpiQKV8 {
    static constexpr bool PERM = true;
    unsigned char* Q8; unsigned char* K8; bf16_t* V; float qscale; bool ktiled;
    __device__ __forceinline__ void operator()(const f32x4 (&acc)[2][2][4][2], const Unit& u, int wr, int wc, int fr, int fq) const {
        const int row0 = u.pm * BM + wr * 64 + fr; const int colt = u.pn * BM; const int t = colt >> 10; const int col0 = (colt & 1023) + wc * 32 + 8 * fq;
        const float sc = t == 0 ? qscale : 1.0f;
#pragma unroll
        for (int ai = 0; ai < 2; ++ai)
#pragma unroll
            for (int m = 0; m < 4; ++m) { const size_t ro = (size_t)(row0 + ai * HALF + m * 16) * 1024 + col0;
#pragma unroll
                for (int bj = 0; bj < 2; ++bj) { const f32x4 v0 = acc[ai][bj][m][0] * sc, v1 = acc[ai][bj][m][1] * sc;
                    if (t == 2) { u32x4 w; w.x = cvt_pk_bf16(v0[0], v0[1]); w.y = cvt_pk_bf16(v0[2], v0[3]); w.z = cvt_pk_bf16(v1[0], v1[1]); w.w = cvt_pk_bf16(v1[2], v1[3]);
                        if (ktiled) { const int mrow = row0 + ai * HALF + m * 16, n = col0 + bj * HALF; const int bh = (mrow >> 13) * 8 + (n >> 7), sq = mrow & 8191, d = n & 127;
                            *(u32x4*)(V + (((size_t)bh * 128 + (sq >> 6)) * 4 + (d >> 5)) * 2048 + (sq & 63) * 32 + (d & 31)) = w; }
                        else *(u32x4*)(V + ro + bj * HALF) = w; }
                    else { int d0 = __builtin_amdgcn_cvt_pk_fp8_f32(v0[0], v0[1], 0, false); d0 = __builtin_amdgcn_cvt_pk_fp8_f32(v0[2], v0[3], d0, true);
                        int d1 = __builtin_amdgcn_cvt_pk_fp8_f32(v1[0], v1[1], 0, false); d1 = __builtin_amdgcn_cvt_pk_fp8_f32(v1[2], v1[3], d1, true);
                        typedef int i32x2 __attribute__((ext_vector_type(2)));
                        if (t == 1 && ktiled) { const int mrow = row0 + ai * HALF + m * 16, n = col0 + bj * HALF; const int strm = ((mrow >> 13) * 8 + (n >> 7)) * 2 + ((n >> 6) & 1), sq = mrow & 8191, dd = n & 63;
                            *(i32x2*)(K8 + ((((size_t)strm * 128 + (sq >> 6)) * 4 + (dd >> 4)) * 64 + (sq & 63)) * 16 + (dd & 15)) = (i32x2){d0, d1}; }
                        else *(i32x2*)((t == 0 ? Q8 : K8) + ro + bj * HALF) = (i32x2){d0, d1}; } } }
    }
};
__device__ __forceinline__ float silu_mul(float a, float b) { return a * b * __builtin_amdgcn_rcpf(1.0f + __builtin_amdgcn_exp2f(-a * 1.4426950408889634f)); }
struct EpiSwiglu {
    static constexpr bool PERM = true;
    bf16_t* O; bool f8;
    __device__ __forceinline__ void operator()(const f32x4 (&acc)[2][2][4][2], const Unit& u, int wr, int wc, int fr, int fq) const {
        const int row0 = u.pm * BM + wr * 64 + fr, col0 = (u.pn & 3) * 128 + wc * 32 + 8 * fq;
#pragma unroll
        for (int ai = 0; ai < 2; ++ai)
#pragma unroll
            for (int m = 0; m < 4; ++m) { const size_t ro = (size_t)(row0 + ai * HALF + m * 16) * 512 + col0;
                const f32x4 a0 = acc[ai][0][m][0], a1 = acc[ai][0][m][1], b0 = acc[ai][1][m][0], b1 = acc[ai][1][m][1];
                if (f8) { typedef unsigned u32x2 __attribute__((ext_vector_type(2)));
                    int d0 = __builtin_amdgcn_cvt_pk_fp8_f32(4.f * silu_mul(a0[0], b0[0]), 4.f * silu_mul(a0[1], b0[1]), 0, false); d0 = __builtin_amdgcn_cvt_pk_fp8_f32(4.f * silu_mul(a0[2], b0[2]), 4.f * silu_mul(a0[3], b0[3]), d0, true);
                    int d1 = __builtin_amdgcn_cvt_pk_fp8_f32(4.f * silu_mul(a1[0], b1[0]), 4.f * silu_mul(a1[1], b1[1]), 0, false); d1 = __builtin_amdgcn_cvt_pk_fp8_f32(4.f * silu_mul(a1[2], b1[2]), 4.f * silu_mul(a1[3], b1[3]), d1, true);
                    *(u32x2*)((unsigned char*)O + ro) = (u32x2){(unsigned)d0, (unsigned)d1};
                } else {
                u32x4 w; w.x = cvt_pk_bf16(silu_mul(a0[0], b0[0]), silu_mul(a0[1], b0[1])); w.y = cvt_pk_bf16(silu_mul(a0[2], b0[2]), silu_mul(a0[3], b0[3]));
                w.z = cvt_pk_bf16(silu_mul(a1[0], b1[0]), silu_mul(a1[1], b1[1])); w.w = cvt_pk_bf16(silu_mul(a1[2], b1[2]), silu_mul(a1[3], b1[3]));
                *(u32x4*)(O + ro) = w; } }
    }
};

template <class Epi, class Sched, bool ALIGN_EPI, bool F8 = false, int SCA = 127, int SCB = 127>
__device__ __forceinline__ void gemm_phase(PG8_LAS unsigned char* lds, const Gemm g, const Sched& S, const Epi& E) {
    const int tid = threadIdx.x, wid = __builtin_amdgcn_readfirstlane(tid >> 6), lane = tid & 63, wr = wid >> 2, wc = wid & 3, fr = lane & 15, fq = lane >> 4;
    const int K = g.K, nt = K / BK;
    int RA[2], CA[2]; unsigned voffB[2];
#pragma unroll
    for (int i = 0; i < 2; ++i) { int R, C; stage_rc(tid * 16 + i * 8192, R, C); RA[i] = R; CA[i] = C; const int Rb = Epi::PERM ? ((R & ~31) + perm32(R & 31)) : R; voffB[i] = (unsigned)(Rb * K + C) * 2u; }
    const size_t kstep = (size_t)(BK * 2);
    const size_t hstep = (size_t)HALF * K * 2;
    const size_t tstep = 2 * hstep;
    const unsigned ldsw = (unsigned)wid * 1024u;
    const int aoff = lds_byte(wr * 64 + fr, fq * 8), boff = lds_byte(wc * 32 + fr, fq * 8);
#define PG8_SA(b, h) (((b) * 2 + (h)) * HTB)
#define PG8_SB(b, h) ((4 + (b) * 2 + (h)) * HTB)
#define PG8_STAGE(bufoff, gbase, voff) do { _Pragma("unroll") for (int _i = 0; _i < 2; ++_i) \
        __builtin_amdgcn_global_load_lds((const unsigned*)((const char*)(gbase) + (voff)[_i]), (PG8_LAS unsigned*)(lds + (bufoff) + ldsw + _i * 8192), 16, 0, 0); } while (0)
#define PG8_LD8(p_) ({ typedef int v4i_ __attribute__((ext_vector_type(4))); const v4i_ lo_ = *(const PG8_LAS v4i_*)(p_), hi_ = *(const PG8_LAS v4i_*)((p_) + 1024); __builtin_shufflevector(lo_, hi_, 0, 1, 2, 3, 4, 5, 6, 7); })
#define PG8_LDA(dst, b, h) do { if (F8) { _Pragma("unroll") for (int m = 0; m < 4; ++m) dst##8[m] = PG8_LD8(lds + PG8_SA(b, h) + aoff + m * 2048); } \
        else { _Pragma("unroll") for (int m = 0; m < 4; ++m) _Pragma("unroll") for (int k = 0; k < 2; ++k) dst[m][k] = *(const PG8_LAS bf16x8*)(lds + PG8_SA(b, h) + aoff + m * 2048 + k * 1024); } } while (0)
#define PG8_LDB(dst, b, h) do { if (F8) { _Pragma("unroll") for (int n = 0; n < 2; ++n) dst##8[n] = PG8_LD8(lds + PG8_SB(b, h) + boff + n * 2048); } \
        else { _Pragma("unroll") for (int n = 0; n < 2; ++n) _Pragma("unroll") for (int k = 0; k < 2; ++k) dst[n][k] = *(const PG8_LAS bf16x8*)(lds + PG8_SB(b, h) + boff + n * 2048 + k * 1024); } } while (0)
#define PG8_MMA(ai, bj, At, Bt) do { __builtin_amdgcn_s_setprio(1); \
        if (F8) { _Pragma("unroll") for (int m = 0; m < 4; ++m) _Pragma("unroll") for (int n = 0; n < 2; ++n) \
            asm volatile("v_mfma_scale_f32_16x16x128_f8f6f4 %0, %1, %2, %0, %3, %4 op_sel_hi:[0,0,0]" : "+v"(acc[ai][bj][m][n]) : "v"(Bt##8[n]), "v"(At##8[m]), "v"(scb_), "v"(sca_)); } \
        else { _Pragma("unroll") for (int m = 0; m < 4; ++m) _Pragma("unroll") for (int n = 0; n < 2; ++n) _Pragma("unroll") for (int k = 0; k < 2; ++k) \
        acc[ai][bj][m][n] = __builtin_amdgcn_mfma_f32_16x16x32_bf16(Bt[n][k], At[m][k], acc[ai][bj][m][n], 0, 0, 0); } __builtin_amdgcn_s_setprio(0); } while (0)
#define PG8_WAIT_V(n) asm volatile("s_waitcnt vmcnt(" #n ")" ::: "memory")
#define PG8_WAIT_L(n) asm volatile("s_waitcnt lgkmcnt(" #n ")" ::: "memory")
#define PG8_BAR __builtin_amdgcn_s_barrier()
#define PG8_SCHED __builtin_amdgcn_sched_barrier(0)
#define PG8_AOFF(dst, u) do { _Pragma("unroll") for (int _h = 0; _h < 2; ++_h) _Pragma("unroll") for (int _i = 0; _i < 2; ++_i) dst[_h][_i] = (S.arow(u, _h * HALF + RA[_i]) * (unsigned)K + (unsigned)CA[_i]) * 2u; } while (0)
    Unit cur, nxt; int ui = 0;
    if (!S.next(0, cur)) return;
    f32x4 acc[2][2][4][2];
#pragma unroll
    for (int a = 0; a < 2; ++a)
#pragma unroll
        for (int b = 0; b < 2; ++b)
#pragma unroll
            for (int m = 0; m < 4; ++m)
#pragma unroll
                for (int n = 0; n < 2; ++n) acc[a][b][m][n] = (f32x4){0.f, 0.f, 0.f, 0.f};
    bf16x8 At[4][2], B0[2][2], B1[2][2]; v8i At8[4], B08[2], B18[2]; const int sca_ = SCA * 0x01010101, scb_ = SCB * 0x01010101;
    unsigned offc[2][2], offn[2][2];
    PG8_AOFF(offc, cur);
    const char* const cA = (const char*)g.A; const char* cB = (const char*)g.Bt + (size_t)cur.pn * tstep;
    PG8_STAGE(PG8_SB(0, 0), cB, voffB); PG8_STAGE(PG8_SB(0, 1), cB + hstep, voffB); PG8_STAGE(PG8_SA(0, 0), cA, offc[0]); PG8_STAGE(PG8_SA(0, 1), cA, offc[1]);
    if (wr == 1) PG8_BAR;
    PG8_WAIT_V(2); PG8_BAR;
    PG8_STAGE(PG8_SB(1, 0), cB + kstep, voffB); PG8_STAGE(PG8_SA(1, 0), cA + kstep, offc[0]); PG8_STAGE(PG8_SB(1, 1), cB + hstep + kstep, voffB);
    PG8_WAIT_V(6); PG8_BAR;
    for (;;) {
        const bool has_next = S.next(ui + 1, nxt);
        if (has_next) { PG8_AOFF(offn, nxt); }
        else {
#pragma unroll
            for (int h = 0; h < 2; ++h)
#pragma unroll
                for (int i = 0; i < 2; ++i) offn[h][i] = offc[h][i]; }
        const char* nB = has_next ? (const char*)g.Bt + (size_t)nxt.pn * tstep : cB;
        for (int t = 0; t < nt; t += 2) {
            const bool last = (t == nt - 2);
            const char* a1 = cA + (size_t)(t + 1) * kstep;
            const char* a2 = last ? cA : cA + (size_t)(t + 2) * kstep; const char* b2 = last ? nB : cB + (size_t)(t + 2) * kstep;
            const char* a3 = a2 + kstep; const char* b3 = b2 + kstep;
            unsigned o2[2][2];
#pragma unroll
            for (int h = 0; h < 2; ++h)
#pragma unroll
                for (int i = 0; i < 2; ++i) o2[h][i] = last ? offn[h][i] : offc[h][i];
            PG8_LDB(B0, 0, 0); PG8_LDB(B1, 0, 1); PG8_SCHED; PG8_LDA(At, 0, 0); PG8_STAGE(PG8_SA(1, 1), a1, offc[1]);
            PG8_WAIT_V(8); PG8_WAIT_L(0); PG8_BAR; PG8_MMA(0, 0, At, B0); PG8_MMA(0, 1, At, B1); PG8_BAR; PG8_SCHED;
            PG8_LDA(At, 0, 1); PG8_STAGE(PG8_SB(0, 0), b2, voffB); PG8_STAGE(PG8_SB(0, 1), b2 + hstep, voffB); PG8_STAGE(PG8_SA(0, 0), a2, o2[0]);
            PG8_WAIT_V(8); PG8_WAIT_L(0); PG8_BAR; PG8_MMA(1, 0, At, B0); PG8_MMA(1, 1, At, B1); PG8_BAR; PG8_SCHED;
            PG8_LDB(B0, 1, 0); PG8_LDB(B1, 1, 1); PG8_SCHED; PG8_LDA(At, 1, 0); PG8_STAGE(PG8_SA(0, 1), a2, o2[1]);
            PG8_WAIT_V(8); PG8_WAIT_L(0); PG8_BAR; PG8_MMA(0, 0, At, B0); PG8_MMA(0, 1, At, B1); PG8_BAR; PG8_SCHED;
            PG8_LDA(At, 1, 1); PG8_STAGE(PG8_SB(1, 0), b3, voffB); PG8_STAGE(PG8_SB(1, 1), b3 + hstep, voffB); PG8_STAGE(PG8_SA(1, 0), a3, o2[0]);
            PG8_WAIT_V(8); PG8_WAIT_L(0); PG8_BAR; PG8_MMA(1, 0, At, B0); PG8_MMA(1, 1, At, B1); PG8_BAR; PG8_SCHED;
        }
        if constexpr (ALIGN_EPI) { if (wr == 0) PG8_BAR; }
        if (F8) asm volatile("s_nop 15\n\ts_nop 15" ::: "memory");
        E(acc, cur, wr, wc, fr, fq);
        if (!has_next) break;
#pragma unroll
        for (int a = 0; a < 2; ++a)
#pragma unroll
            for (int b = 0; b < 2; ++b)
#pragma unroll
                for (int m = 0; m < 4; ++m)
#pragma unroll
                    for (int n = 0; n < 2; ++n) acc[a][b][m][n] = (f32x4){0.f, 0.f, 0.f, 0.f};
        cur = nxt; cB = nB; ++ui;
#pragma unroll
        for (int h = 0; h < 2; ++h)
#pragma unroll
            for (int i = 0; i < 2; ++i) offc[h][i] = offn[h][i];
        if constexpr (ALIGN_EPI) { if (wr == 1) PG8_BAR; }
    }
    PG8_WAIT_V(0);
    if constexpr (!ALIGN_EPI) { if (wr == 0) PG8_BAR; }
    PG8_BAR;
#undef PG8_SA
#undef PG8_SB
#undef PG8_STAGE
#undef PG8_LDA
#undef PG8_LDB
#undef PG8_MMA
#undef PG8_LD8
#undef PG8_WAIT_V
#undef PG8_WAIT_L
#undef PG8_BAR
#undef PG8_SCHED
#undef PG8_AOFF
}
}

#define XB_TMO      128
#define XB_XCNT(j)  (256  + 64 * (j))
#define XB_XSUB(j)  (1280 + 64 * (j))
#define XB_XGEN(j)  (2304 + 64 * (j))
#define XB_TOP      3328
#define XB_TOPGEN   3392
#define XCD_BAR_WORDS 3456
#define XB_SPIN_CAP (1u << 18)

__device__ __forceinline__ unsigned xb_ld(unsigned* p)              { return __hip_atomic_load(p, __ATOMIC_RELAXED, __HIP_MEMORY_SCOPE_AGENT); }
__device__ __forceinline__ unsigned xb_add(unsigned* p, unsigned v) { return __hip_atomic_fetch_add(p, v, __ATOMIC_RELAXED, __HIP_MEMORY_SCOPE_AGENT); }
__device__ __forceinline__ unsigned xb_xcc_id() { return (unsigned)__builtin_amdgcn_s_getreg((3 << 11) | 20) & 0xFu; }
#define XB_SPIN(cond, bar) do { unsigned _sp = 0; while (cond) { __builtin_amdgcn_s_sleep(1); \
    if ((++_sp & 255u) == 0u) { if (xb_ld(&(bar)[XB_TMO])) break; if (_sp > XB_SPIN_CAP) { atomicAdd(&(bar)[XB_TMO], 1u); break; } } } } while (0)

struct XcdBarrier { unsigned* bar; unsigned x; volatile LAS unsigned* st; };

__device__ __forceinline__ XcdBarrier xcd_barrier_post(unsigned* bar, volatile LAS unsigned* st) {
    XcdBarrier b; b.bar = bar; b.x = xb_xcc_id(); b.st = st;
    if (threadIdx.x == 0) (void)xb_add(&bar[XB_XCNT(b.x)], 1u);
    return b;
}
__device__ __forceinline__ void xcd_barrier_complete(unsigned* bar, unsigned x, unsigned& nloc, unsigned& nx) {
    const unsigned G = gridDim.x * gridDim.y * gridDim.z;
    unsigned sum, cnt, mine, sp = 0u;
    for (;;) {
        sum = 0u; cnt = 0u; mine = 0u;
#pragma unroll
        for (unsigned j = 0; j < 16; ++j) { const unsigned c = xb_ld(&bar[XB_XCNT(j)]); sum += c; cnt += (c > 0u) ? 1u : 0u; mine = (j == x) ? c : mine; }
        if (sum == G) break;
        __builtin_amdgcn_s_sleep(1);
        if ((++sp & 255u) == 0u) { if (xb_ld(&bar[XB_TMO])) break; if (sp > XB_SPIN_CAP) { atomicAdd(&bar[XB_TMO], 1u); break; } }
    }
    nloc = mine > 0u ? mine : 1u; nx = cnt > 0u ? cnt : 1u;
}
__device__ __forceinline__ void xcd_barrier(const XcdBarrier& b) {
    asm volatile("s_waitcnt vmcnt(0)" ::: "memory");
    __syncthreads();
    if (threadIdx.x == 0) {
        unsigned* bar = b.bar;
        __builtin_amdgcn_s_waitcnt(0);
        unsigned nloc = b.st[0], nx = b.st[1];
        if (nloc == 0u) { xcd_barrier_complete(bar, b.x, nloc, nx); b.st[0] = nloc; b.st[1] = nx; }
        const unsigned old = xb_add(&bar[XB_XSUB(b.x)], 1u);
        const unsigned gen = old / nloc;
        if (old + 1u == (gen + 1u) * nloc) {
            __builtin_amdgcn_fence(__ATOMIC_RELEASE, "agent");
            asm volatile("s_waitcnt vmcnt(0)" ::: "memory");
            const unsigned og = xb_add(&bar[XB_TOP], 1u);
            const unsigned tg = og / nx;
            if (og + 1u == (tg + 1u) * nx) xb_add(&bar[XB_TOPGEN], 1u);
            else XB_SPIN(xb_ld(&bar[XB_TOPGEN]) == tg, bar);
            __builtin_amdgcn_fence(__ATOMIC_ACQUIRE, "agent");
            xb_add(&bar[XB_XGEN(b.x)], 1u);
            asm volatile("s_waitcnt vmcnt(0)" ::: "memory");
        } else {
            XB_SPIN(xb_ld(&bar[XB_XGEN(b.x)]) == gen, bar);
            __builtin_amdgcn_fence(__ATOMIC_ACQUIRE, "agent");
            asm volatile("s_waitcnt vmcnt(0)" ::: "memory");
        }
    }
    __syncthreads();
}

template <bool F8 = false>
__device__ __forceinline__ void transpose_item(const float* W, int K, int N, bf16* WT, int kb, int nb, int dst_row0, LAS float* scr, int lane) {
    const int k0 = 64 * kb, n0 = 32 * nb;
#pragma unroll 8
    for (int i = 0; i < 32; ++i) { const int kk = 2 * i + (lane >> 5); scr[kk * 33 + (lane & 31)] = W[(size_t)(k0 + kk) * N + n0 + (lane & 31)]; }
    LDS_WAIT(); asm volatile("" ::: "memory");
    const int c = lane & 7;
#pragma unroll
    for (int j = 0; j < 4; ++j) { const int n = (lane >> 3) + 8 * j; const LAS float* s = scr + (8 * c) * 33 + n;
        if (F8) {
            int d0 = __builtin_amdgcn_cvt_pk_fp8_f32(s[0 * 33] * 32.f, s[1 * 33] * 32.f, 0, false); d0 = __builtin_amdgcn_cvt_pk_fp8_f32(s[2 * 33] * 32.f, s[3 * 33] * 32.f, d0, true);
            int d1 = __builtin_amdgcn_cvt_pk_fp8_f32(s[4 * 33] * 32.f, s[5 * 33] * 32.f, 0, false); d1 = __builtin_amdgcn_cvt_pk_fp8_f32(s[6 * 33] * 32.f, s[7 * 33] * 32.f, d1, true);
            *(GAS v2u*)((unsigned char*)WT + (size_t)(dst_row0 + n) * K + k0 + 8 * c) = (v2u){(unsigned)d0, (unsigned)d1};
        } else {
        v4u o; o.x = pk2(s[0 * 33], s[1 * 33]); o.y = pk2(s[2 * 33], s[3 * 33]); o.z = pk2(s[4 * 33], s[5 * 33]); o.w = pk2(s[6 * 33], s[7 * 33]);
        *(GAS v4u*)(WT + (size_t)(dst_row0 + n) * K + k0 + 8 * c) = o; } }
    LDS_WAIT(); asm volatile("" ::: "memory");
}
__device__ __forceinline__ void transpose_plain(const float* W, int K, int N, bf16* WT, LAS float* scr, int gw, int ngw, int lane) {
    const int nblk = N / 32, nitems = (K / 64) * nblk;
    for (int it = gw; it < nitems; it += ngw) { const int kb = it / nblk, nb = it % nblk; transpose_item(W, K, N, WT, kb, nb, 32 * nb, scr, lane); }
}
__device__ __forceinline__ void transpose_moe(const float* w1, const float* w3, const float* w2, bf16* W13T, bf16* W2T, LAS float* scr, int gw, int ngw, int lane) {
    constexpr int I13 = 16 * 16, I2 = 8 * 32, IPE = 2 * I13 + I2;
    for (int it = gw; it < NEXP * IPE; it += ngw) {
        const int e = it / IPE; int r = it % IPE;
        if (r < 2 * I13) { const int which = r / I13; r %= I13; const int kb = r / 16, nb = r % 16, n0 = 32 * nb;
            const float* W = (which ? w3 : w1) + (size_t)e * 1024 * 512;
            transpose_item<MOE_FP8 != 0>(W, 1024, 512, (bf16*)((unsigned char*)W13T + (size_t)e * 1024 * 1024 * (MOE_FP8 ? 1 : 2)), kb, nb, (n0 >> 7) * 256 + which * 128 + (n0 & 127), scr, lane);
        } else { r -= 2 * I13; const int kb = r / 32, nb = r % 32;
            transpose_item<MOE_FP8 != 0>(w2 + (size_t)e * 512 * 1024, 512, 1024, (bf16*)((unsigned char*)W2T + (size_t)e * 1024 * 512 * (MOE_FP8 ? 1 : 2)), kb, nb, 32 * nb, scr, lane); }
    }
}
__device__ __forceinline__ void rms_row(const float* xrow, const float* g, f32x4 (&v)[4], int lane) {
    const GAS f32x4* xr = (const GAS f32x4*)xrow + lane; const GAS f32x4* gr = (const GAS f32x4*)g + lane;
    float s = 0.f;
#pragma unroll
    for (int j = 0; j < 4; ++j) { v[j] = xr[64 * j]; s += (v[j].x * v[j].x + v[j].y * v[j].y) + (v[j].z * v[j].z + v[j].w * v[j].w); }
    const float rstd = 1.0f / sqrtf(wave_sum(s) * (1.f / DM) + 1e-6f);
#pragma unroll
    for (int j = 0; j < 4; ++j) { const f32x4 gg = gr[64 * j]; v[j] = v[j] * rstd * gg; }
}
__device__ __forceinline__ void rms_row_b16(const bf16* xrow, const float* g, f32x4 (&v)[4], int lane) {
    const GAS v2u* xr = (const GAS v2u*)xrow + lane; const GAS f32x4* gr = (const GAS f32x4*)g + lane;
    float s = 0.f;
#pragma unroll
    for (int j = 0; j < 4; ++j) { const v2u w = xr[64 * j]; v[j] = (f32x4){__builtin_bit_cast(float, w.x << 16), __builtin_bit_cast(float, w.x & 0xffff0000u), __builtin_bit_cast(float, w.y << 16), __builtin_bit_cast(float, w.y & 0xffff0000u)};
        s += (v[j].x * v[j].x + v[j].y * v[j].y) + (v[j].z * v[j].z + v[j].w * v[j].w); }
    const float rstd = 1.0f / sqrtf(wave_sum(s) * (1.f / DM) + 1e-6f);
#pragma unroll
    for (int j = 0; j < 4; ++j) { const f32x4 gg = gr[64 * j]; v[j] = v[j] * rstd * gg; }
}
__device__ __forceinline__ void store_row_bf16(bf16* orow, const f32x4 (&v)[4], int lane) {
    GAS unsigned long long* o8 = (GAS unsigned long long*)orow + lane;
#pragma unroll
    for (int j = 0; j < 4; ++j) o8[64 * j] = (unsigned long long)pk2(v[j].x, v[j].y) | ((unsigned long long)pk2(v[j].z, v[j].w) << 32);
}

__device__ __forceinline__ int t5_bucket(int rel) {
    const int n = rel < 0 ? -rel : rel; int ret = rel > 0 ? 16 : 0;
    int v;
    if (n < 8) v = n;
    else { const float nf = (float)n; int large = 8 + (int)(logf(nf / 8.0f) / 2.772588722239781f * 8.0f); v = large < 15 ? large : 15; }
    return ret + v;
}

__device__ __forceinline__ int crow(int r, int hi) { return (r & 3) + 8 * (r >> 2) + 4 * hi; }
__device__ __forceinline__ unsigned cvtpk(float lo, float hi) { unsigned r; asm volatile("v_cvt_pk_bf16_f32 %0, %1, %2" : "=v"(r) : "v"(lo), "v"(hi)); return r; }
__device__ __forceinline__ s16x4 vtr(const LAS char* p) { typedef short v4i16_t __attribute__((ext_vector_type(4))); return __builtin_bit_cast(s16x4, __builtin_amdgcn_ds_read_tr16_b64_v4i16((LAS v4i16_t*)p)); }

template <int DV, bool BIAS, bool FP8 = false>
__device__ __forceinline__ void attn_unit_v0(const bf16* Qp, int ldq, const bf16* Kp, int ldk, const bf16* Vp, int ldv, bf16* Op, int ldo, const LAS float* btbl, int q0, LAS unsigned char* lds) {
    const int tid = threadIdx.x, lane = tid & 63, r32 = lane & 31, hi = lane >> 5; const int wid = __builtin_amdgcn_readfirstlane(tid >> 6);
    constexpr int ND = DV / 32;
    LAS unsigned char* ldsK = lds; LAS unsigned char* ldsV = lds + 8192; LAS float* wsf = (LAS float*)(lds + 8192 + DV * 128) + wid * 64;
    bf16x8 qr[4]; v8i q8 = {0, 0, 0, 0, 0, 0, 0, 0};
    if (FP8) { const v4u a = *(const v4u*)((const unsigned char*)Qp + (size_t)(wid * 32 + r32) * ldq + hi * 32), b = *(const v4u*)((const unsigned char*)Qp + (size_t)(wid * 32 + r32) * ldq + hi * 32 + 16);
        q8 = (v8i){(int)a.x, (int)a.y, (int)a.z, (int)a.w, (int)b.x, (int)b.y, (int)b.z, (int)b.w}; }
    else {
#pragma unroll
    for (int d0 = 0; d0 < 4; ++d0) qr[d0] = *(const bf16x8*)(Qp + (size_t)(wid * 32 + r32) * ldq + d0 * 16 + hi * 8); }
    f32x16 o[ND];
#pragma unroll
    for (int d = 0; d < ND; ++d)
#pragma unroll
        for (int r = 0; r < 16; ++r) o[d][r] = 0.f;
    float l = 0.f;
    const int qpos = q0 + wid * 32 + r32;
    const LAS char* kp0 = (const LAS char*)ldsK + hi * 1024 + r32 * 16;
    const LAS char* vp0 = (const LAS char*)ldsV + ((lane >> 4) & 1) * 32 + (lane & 3) * 8 + (4 * hi + ((lane & 15) >> 2)) * 64;
    for (int t = 0; t < SEQ / 64; ++t) {
        __syncthreads();
        {
            if (FP8) { if (wid < 4) { const v4u kv = *(const v4u*)((const unsigned char*)Kp + (size_t)(t * 64 + lane) * ldk + wid * 16); *(LAS v4u*)(ldsK + wid * 1024 + lane * 16) = kv; } }
            else { const v4u kv = *(const v4u*)(Kp + (size_t)(t * 64 + lane) * ldk + wid * 8);
            *(LAS v4u*)(ldsK + wid * 1024 + lane * 16) = kv; }
#pragma unroll
            for (int pp = 0; pp < ND / 2; ++pp) { const int p = wid + 8 * pp, dq = p >> 2, rg = p & 3;
                const v4u vv = *(const v4u*)(Vp + (size_t)(t * 64 + 16 * rg + (lane >> 2)) * ldv + dq * 32 + (lane & 3) * 8);
                *(LAS v4u*)(ldsV + p * 1024 + lane * 16) = vv; }
        }
        __syncthreads();
        f32x16 p0, p1;
#pragma unroll
        for (int r = 0; r < 16; ++r) { p0[r] = 0.f; p1[r] = 0.f; }
        if (FP8) {
            const LAS char* k8 = (const LAS char*)ldsK + hi * 2048 + r32 * 16;
            const v4u a0 = *(const LAS v4u*)(k8), a1 = *(const LAS v4u*)(k8 + 1024), b0 = *(const LAS v4u*)(k8 + 512), b1 = *(const LAS v4u*)(k8 + 1024 + 512);
            const v8i ka = (v8i){(int)a0.x, (int)a0.y, (int)a0.z, (int)a0.w, (int)a1.x, (int)a1.y, (int)a1.z, (int)a1.w};
            const v8i kb = (v8i){(int)b0.x, (int)b0.y, (int)b0.z, (int)b0.w, (int)b1.x, (int)b1.y, (int)b1.z, (int)b1.w};
            p0 = __builtin_amdgcn_mfma_scale_f32_32x32x64_f8f6f4(ka, q8, p0, 0, 0, 0, 0x7f7f7f7f, 0, 0x7c7c7c7c);
            p1 = __builtin_amdgcn_mfma_scale_f32_32x32x64_f8f6f4(kb, q8, p1, 0, 0, 0, 0x7f7f7f7f, 0, 0x7c7c7c7c);
        } else {
#pragma unroll
        for (int d0 = 0; d0 < 4; ++d0) {
            const bf16x8 b0 = *(const LAS bf16x8*)(kp0 + d0 * 2048), b1 = *(const LAS bf16x8*)(kp0 + d0 * 2048 + 512);
            p0 = __builtin_amdgcn_mfma_f32_32x32x16_bf16(b0, qr[d0], p0, 0, 0, 0);
            p1 = __builtin_amdgcn_mfma_f32_32x32x16_bf16(b1, qr[d0], p1, 0, 0, 0);
        } }
        if (BIAS) {
            const int base = t * 64 + 4 * hi - qpos;
#pragma unroll
            for (int r = 0; r < 16; ++r) { int rel = base + (r & 3) + 8 * (r >> 2);
                int i0 = rel < -128 ? -128 : (rel > 128 ? 128 : rel); int rel1 = rel + 32; int i1 = rel1 < -128 ? -128 : (rel1 > 128 ? 128 : rel1);
                p0[r] += btbl[i0 + 128]; p1[r] += btbl[i1 + 128]; }
        }
        float sacc = 0.f;
#pragma unroll
        for (int r = 0; r < 16; ++r) { p0[r] = __builtin_amdgcn_exp2f(p0[r]); p1[r] = __builtin_amdgcn_exp2f(p1[r]); sacc += p0[r] + p1[r]; }
        l += sacc;
        v4u pw[4];
#pragma unroll
        for (int k = 0; k < 2; ++k) {
            pw[k]     = (v4u){cvtpk(p0[8 * k + 0], p0[8 * k + 1]), cvtpk(p0[8 * k + 2], p0[8 * k + 3]), cvtpk(p0[8 * k + 4], p0[8 * k + 5]), cvtpk(p0[8 * k + 6], p0[8 * k + 7])};
            pw[2 + k] = (v4u){cvtpk(p1[8 * k + 0], p1[8 * k + 1]), cvtpk(p1[8 * k + 2], p1[8 * k + 3]), cvtpk(p1[8 * k + 4], p1[8 * k + 5]), cvtpk(p1[8 * k + 6], p1[8 * k + 7])};
        }
#pragma unroll
        for (int d0 = 0; d0 < ND; ++d0)
#pragma unroll
            for (int ks = 0; ks < 4; ++ks) {
                const s16x4 lo = vtr(vp0 + d0 * 4096 + ks * 1024), hh = vtr(vp0 + d0 * 4096 + ks * 1024 + 512);
                const bf16x8 vf = (bf16x8){lo[0], lo[1], lo[2], lo[3], hh[0], hh[1], hh[2], hh[3]};
                o[d0] = __builtin_amdgcn_mfma_f32_32x32x16_bf16(__builtin_bit_cast(bf16x8, pw[ks]), vf, o[d0], 0, 0, 0);
            }
    }
    l += __shfl_xor(l, 32);
    if (hi == 0) wsf[r32] = l;
    LDS_WAIT(); asm volatile("" ::: "memory");
#pragma unroll
    for (int r = 0; r < 16; ++r) { const int row = crow(r, hi); const float rl = 1.0f / wsf[row];
#pragma unroll
        for (int d0 = 0; d0 < ND; ++d0) Op[(size_t)(wid * 32 + row) * ldo + d0 * 32 + r32] = (bf16)f2bf(o[d0][r] * rl); }
    LDS_WAIT();
}

namespace at1 {
#define SBAR() __builtin_amdgcn_sched_barrier(0)
#define PIN(x) asm volatile("" : "+v"(x))
template <int N, bool NOBAR = false> __device__ __forceinline__ void wait_bar() { if (NOBAR) asm volatile("s_waitcnt vmcnt(%0) lgkmcnt(0)" :: "n"(N) : "memory"); else asm volatile("s_waitcnt vmcnt(%0) lgkmcnt(0)\n\ts_barrier" :: "n"(N) : "memory"); }
__device__ __forceinline__ void glds16(const void* gsrc, unsigned lds_dst) { unsigned keep;
    asm volatile("s_mov_b32 %0, m0\n\ts_mov_b32 m0, %2\n\ts_nop 0\n\tglobal_load_lds_dwordx4 %1, off\n\ts_mov_b32 m0, %0" : "=&s"(keep) : "v"(gsrc), "s"(lds_dst) : "memory"); }
typedef float f32x2_t __attribute__((ext_vector_type(2))); typedef __bf16 bf16x2_t __attribute__((ext_vector_type(2)));
__device__ __forceinline__ unsigned cvtpk_s(float lo, float hi) { f32x2_t v = {lo, hi}; bf16x2_t b = __builtin_convertvector(v, bf16x2_t); return __builtin_bit_cast(unsigned, b); }
typedef const LAS char* lds_cptr;
__device__ __forceinline__ void kload2(bf16x8* kf, lds_cptr kp, int j) { kf[2 * j] = *(const LAS bf16x8*)(kp + j * 2048); kf[2 * j + 1] = *(const LAS bf16x8*)(kp + j * 2048 + 512); }

template <int DV, bool FP8> __host__ __device__ constexpr int lds_ws_off() { return (3 * (FP8 ? 4096 : 8192) + 3 * DV * 128) > 512 * DV ? (3 * (FP8 ? 4096 : 8192) + 3 * DV * 128) : 512 * DV; }
template <int DV, bool FP8> __host__ __device__ constexpr int lds_tbl_off() { return lds_ws_off<DV, FP8>() + 2048; }
template <int DV, bool BIAS, int TEST = 0, int MODE = 0, bool FP8 = false, bool TILED = false>
__device__ __forceinline__ void attn_unit(const bf16* Qp, int ldq, const bf16* __restrict__ Kp, int ldk, const bf16* __restrict__ Vp, int ldv, bf16* Op, int ldo, int q0, LAS unsigned char* lds, const LAS float* sgt = nullptr) {
    constexpr int ND = DV / 32, NV = ND / 2, VSLOT = DV * 128, KSLOT = FP8 ? 4096 : 8192, NT = SEQ / 64;
    constexpr int LDS_K = 0, LDS_V = 3 * KSLOT, LDS_WS = lds_ws_off<DV, FP8>(), LDS_TBL = LDS_WS + 2048;
    static_assert(LDS_WS >= LDS_V + 3 * VSLOT && LDS_WS >= 512 * DV && LDS_TBL + 2048 <= STASH_OFF, "LDS map");
    const int tid = threadIdx.x, lane = tid & 63, r32 = lane & 31, hi = lane >> 5; const int wid = __builtin_amdgcn_readfirstlane(tid >> 6);
    const unsigned lds0 = (unsigned)(uintptr_t)lds;
    LAS float* wsf = (LAS float*)(lds + LDS_WS) + wid * 64;
    const LAS float* btbl = (const LAS float*)(lds + LDS_TBL);
    const unsigned char* ksrc = TILED ? (const unsigned char*)Kp + (wid & 3) * 1024 + lane * 16 : FP8 ? (const unsigned char*)Kp + (size_t)lane * ldk + (wid & 3) * 16 : (const unsigned char*)(Kp + (size_t)lane * ldk + wid * 8);
    const bf16* vsrc0 = TILED ? Vp + wid * 512 + lane * 8 : Vp + (size_t)(16 * (wid & 3) + (lane >> 2)) * ldv + (wid >> 2) * 32 + (lane & 3) * 8;
    const bf16* vsrc1 = TILED ? vsrc0 + 4096 : vsrc0 + 64;
    const unsigned kdst = lds0 + LDS_K + wid * 1024, vdst = lds0 + LDS_V + wid * 1024;
#define DMA_K(t, s) if (!(TEST & 8) && (!FP8 || wid < 4)) glds16(ksrc + (size_t)(t) * (TILED ? 4096 : 64 * ldk * (FP8 ? 1 : 2)), (unsigned)__builtin_amdgcn_readfirstlane(kdst + (s) * KSLOT))
#define DMA_V(t, s) do { if (TEST & 8) break; glds16(vsrc0 + (size_t)(t) * (TILED ? (size_t)(DV * 64) : (size_t)64 * ldv), (unsigned)__builtin_amdgcn_readfirstlane(vdst + (s) * VSLOT)); \
        if (NV == 2) glds16(vsrc1 + (size_t)(t) * (TILED ? (size_t)(DV * 64) : (size_t)64 * ldv), (unsigned)__builtin_amdgcn_readfirstlane(vdst + (s) * VSLOT + 8192)); } while (0)
    const lds_cptr kp0 = (lds_cptr)lds + LDS_K + hi * (FP8 ? 2048 : 1024) + r32 * 16;
    const lds_cptr vp0 = (lds_cptr)lds + LDS_V + ((lane >> 4) & 1) * 32 + (lane & 3) * 8 + (4 * hi + ((lane & 15) >> 2)) * 64;
    DMA_K(0, 0); DMA_V(0, 0); DMA_K(1, 1);
    bf16x8 qr[4]; v8i q8 = {0, 0, 0, 0, 0, 0, 0, 0};
    if (FP8) { const unsigned char* qb_ = (const unsigned char*)Qp + (size_t)(wid * 32 + r32) * ldq + hi * 32; const v4u a = *(const v4u*)qb_, b = *(const v4u*)(qb_ + 16);
        q8 = (v8i){(int)a.x, (int)a.y, (int)a.z, (int)a.w, (int)b.x, (int)b.y, (int)b.z, (int)b.w}; }
    else {
#pragma unroll
        for (int d0 = 0; d0 < 4; ++d0) qr[d0] = *(const bf16x8*)(Qp + (size_t)(wid * 32 + r32) * ldq + d0 * 16 + hi * 8); }
    float l_reg = 0.f; f32x16 o[ND];
#pragma unroll
    for (int d = 0; d < ND; ++d) o[d] = f32x16{};
    const f32x16 zero16 = f32x16{};
    const int qw = q0 + wid * 32, qpos = qw + r32;
    int tl = 0, tr = NT; float fL = 1.f;
    if (BIAS) { tl = (qw - 191 >= 0) ? ((qw - 191) >> 6) + 1 : 0; tr = (qw + 158) >> 6; fL = __builtin_amdgcn_exp2f(btbl[0]); }
    f32x16 pA0, pA1, pB0, pB1; bf16x8 kf[8]; v8i kf8[2]; s16x4 vlo[8], vhi[8]; v4u pw0, pw1, pw2, pw3;
#define KLOAD8(n, kp_) do { const v4u a_ = *(const LAS v4u*)((kp_) + (n) * 512), b_ = *(const LAS v4u*)((kp_) + (n) * 512 + 1024); kf8[n] = (v8i){(int)a_.x, (int)a_.y, (int)a_.z, (int)a_.w, (int)b_.x, (int)b_.y, (int)b_.z, (int)b_.w}; } while (0)
#define MF8(kf_, c_) __builtin_amdgcn_mfma_scale_f32_32x32x64_f8f6f4(kf_, q8, c_, 0, 0, 0, 0x7f7f7f7f, 0, 0x7c7c7c7c)
#define WAITB(N) do { if (FP8 && wid >= 4) wait_bar<(N) - 1, (TEST & 16) != 0>(); else wait_bar<(N), (TEST & 16) != 0>(); } while (0)
    if (TEST & 32) { pB0 = f32x16{}; pB1 = f32x16{}; }
    if (TEST & 64) { _Pragma("unroll") for (int i_ = 0; i_ < 8; ++i_) { vlo[i_] = (s16x4){1, 2, 3, 4}; vhi[i_] = (s16x4){4, 3, 2, 1}; } }
    int s_prev = 0, s_cur = 0, s_next = 1;
#define ROT() do { s_prev = s_cur; s_cur = s_next; s_next = (s_next == 2) ? 0 : s_next + 1; } while (0)
#define ADD_BIAS(C0, C1, t) do { if (BIAS && (t) >= tl && (t) <= tr) { const int base_ = (t) * 64 + 4 * hi - qpos; \
        _Pragma("unroll") for (int r = 0; r < 16; ++r) { const int rel0 = base_ + (r & 3) + 8 * (r >> 2); const int rel1 = rel0 + 32; \
            const int i0 = (rel0 < -128 ? -128 : (rel0 > 128 ? 128 : rel0)) + 128, i1 = (rel1 < -128 ? -128 : (rel1 > 128 ? 128 : rel1)) + 128; \
            C0[r] += btbl[i0]; C1[r] += btbl[i1]; } } } while (0)
    DMA_K(2, 2);
    if (FP8) wait_bar<0, (TEST & 16) != 0>(); else wait_bar<NV + 2, (TEST & 16) != 0>();
    {
        if (FP8) { KLOAD8(0, kp0); KLOAD8(1, kp0); pA0 = MF8(kf8[0], zero16); pA1 = MF8(kf8[1], zero16); }
        else {
#pragma unroll
        for (int j = 0; j < 4; ++j) kload2(kf, kp0, j);
        pA0 = __builtin_amdgcn_mfma_f32_32x32x16_bf16(kf[0], qr[0], zero16, 0, 0, 0); pA1 = __builtin_amdgcn_mfma_f32_32x32x16_bf16(kf[1], qr[0], zero16, 0, 0, 0);
#pragma unroll
        for (int d0 = 1; d0 < 4; ++d0) { pA0 = __builtin_amdgcn_mfma_f32_32x32x16_bf16(kf[2 * d0], qr[d0], pA0, 0, 0, 0); pA1 = __builtin_amdgcn_mfma_f32_32x32x16_bf16(kf[2 * d0 + 1], qr[d0], pA1, 0, 0, 0); } }
        ADD_BIAS(pA0, pA1, 0);
#pragma unroll
        for (int r = 0; r < 16; ++r) { pA0[r] = __builtin_amdgcn_exp2f(pA0[r]); pA1[r] = __builtin_amdgcn_exp2f(pA1[r]); }
    }
    wait_bar<0, (TEST & 16) != 0>();
    DMA_K(3, 0); DMA_V(1, 1);
    ROT();
    if (FP8) { KLOAD8(0, kp0 + s_cur * KSLOT); KLOAD8(1, kp0 + s_cur * KSLOT); }
    else {
#pragma unroll
    for (int j = 0; j < 4; ++j) kload2(kf, kp0 + s_cur * KSLOT, j); }
    WAITB(1 + NV);
#define PKW(P, B) ((TEST & 256) ? 0x3f803f80u : cvtpk_s(P[B], P[B + 1]))
#define PAF(k) __builtin_bit_cast(bf16x8, pw##k)
#define VFR(i) (bf16x8){vlo[i][0], vlo[i][1], vlo[i][2], vlo[i][3], vhi[i][0], vhi[i][1], vhi[i][2], vhi[i][3]}
#define MF(a, b, c) __builtin_amdgcn_mfma_f32_32x32x16_bf16(a, b, c, 0, 0, 0)
#define GAPA(MFS, A0, A1, A2, A3, W0, W1, PW) do { if (!(TEST & 32)) { MFS; } if (!(TEST & 2)) { sacc += A0; sacc += A1; sacc += A2; sacc += A3; PIN(sacc); } W0; W1; PIN(PW); SBAR(); } while (0)
#define EX(v) ((TEST & 1) ? (v) : __builtin_amdgcn_exp2f(v))
#define GAPB4(MFS, X, B) do { if (!(TEST & 4)) { MFS; } X[B] = EX(X[B]); X[B + 1] = EX(X[B + 1]); X[B + 2] = EX(X[B + 2]); X[B + 3] = EX(X[B + 3]); PIN(X); SBAR(); } while (0)
#define GAPB2(MFS, X, B) do { if (!(TEST & 4)) { MFS; } X[B] = EX(X[B]); X[B + 1] = EX(X[B + 1]); PIN(X); SBAR(); } while (0)
#define VRD(f, s) do { if (TEST & 64) break; vlo[s] = vtr(vp_ + (((f) >> 2) * 4096 + ((f) & 3) * 1024)); vhi[s] = vtr(vp_ + (((f) >> 2) * 4096 + ((f) & 3) * 1024 + 512)); } while (0)
#define KRD(G, j) do { if ((G) && !(TEST & 128)) { if (FP8) { if ((j) < 2) { KLOAD8(j, kp0 + s_next * KSLOT); } } else kload2(kf, kp0 + s_next * KSLOT, j); SBAR(); } } while (0)
#define FO(m) (ND == 2 ? (((m) >> 1) + 4 * ((m) & 1)) : ((((m) & 7) >> 2) + 2 * ((m) >> 3) + 4 * ((m) & 3)))
#define STEP(C0, C1, P0, P1, t, GK, GV, GL) do { SBAR(); \
    const lds_cptr vp_ = vp0 + s_prev * VSLOT; float sacc; \
    if (FP8) { \
      VRD(FO(0), 0); VRD(FO(1), 1); VRD(FO(2), 2); VRD(FO(3), 3); SBAR(); \
      if (!(TEST & 32)) C0 = MF8(kf8[0], zero16); \
      SBAR();   \
      float sa_ = P0[0] + P0[1], sb_ = P0[2] + P0[3], sc_ = P0[4] + P0[5], sd_ = P0[6] + P0[7]; \
      if (!(TEST & 2)) { sa_ += P0[8]; sb_ += P0[9]; sc_ += P0[10]; sd_ += P0[11]; sa_ += P0[12]; sb_ += P0[13]; sc_ += P0[14]; sd_ += P0[15]; } \
      pw0 = (v4u){PKW(P0, 0), PKW(P0, 2), PKW(P0, 4), PKW(P0, 6)}; pw1 = (v4u){PKW(P0, 8), PKW(P0, 10), PKW(P0, 12), PKW(P0, 14)}; PIN(pw0); PIN(pw1); SBAR(); \
      VRD(FO(4), 4); VRD(FO(5), 5); VRD(FO(6), 6); VRD(FO(7), 7); SBAR(); \
      if (!(TEST & 32)) C1 = MF8(kf8[1], zero16); \
      SBAR(); \
      if (!(TEST & 2)) { sa_ += P1[0]; sb_ += P1[1]; sc_ += P1[2]; sd_ += P1[3]; sa_ += P1[4]; sb_ += P1[5]; sc_ += P1[6]; sd_ += P1[7]; \
                         sa_ += P1[8]; sb_ += P1[9]; sc_ += P1[10]; sd_ += P1[11]; sa_ += P1[12]; sb_ += P1[13]; sc_ += P1[14]; sd_ += P1[15]; } \
      sacc = (sa_ + sb_) + (sc_ + sd_); PIN(sacc); \
      pw2 = (v4u){PKW(P1, 0), PKW(P1, 2), PKW(P1, 4), PKW(P1, 6)}; pw3 = (v4u){PKW(P1, 8), PKW(P1, 10), PKW(P1, 12), PKW(P1, 14)}; PIN(pw2); PIN(pw3); SBAR(); \
    } else { \
    VRD(FO(0), 0); SBAR(); sacc = (P0[0] + P0[1]); \
    GAPA(C0 = MF(kf[0], qr[0], zero16), P0[2], P0[3], P0[4], P0[5],     pw0[0] = PKW(P0, 0), pw0[1] = PKW(P0, 2), pw0); \
    VRD(FO(1), 1); SBAR(); GAPA(C1 = MF(kf[1], qr[0], zero16), P0[6], P0[7], P0[8], P0[9],     pw0[2] = PKW(P0, 4), pw0[3] = PKW(P0, 6), pw0); \
    VRD(FO(2), 2); SBAR(); GAPA(C0 = MF(kf[2], qr[1], C0),   P0[10], P0[11], P0[12], P0[13], pw1[0] = PKW(P0, 8), pw1[1] = PKW(P0, 10), pw1); \
    VRD(FO(3), 3); SBAR(); GAPA(C1 = MF(kf[3], qr[1], C1),   P0[14], P0[15], P1[0], P1[1],   pw1[2] = PKW(P0, 12), pw1[3] = PKW(P0, 14), pw1); \
    VRD(FO(4), 4); SBAR(); GAPA(C0 = MF(kf[4], qr[2], C0),   P1[2], P1[3], P1[4], P1[5],     pw2[0] = PKW(P1, 0), pw2[1] = PKW(P1, 2), pw2); \
    VRD(FO(5), 5); SBAR(); GAPA(C1 = MF(kf[5], qr[2], C1),   P1[6], P1[7], P1[8], P1[9],     pw2[2] = PKW(P1, 4), pw2[3] = PKW(P1, 6), pw2); \
    VRD(FO(6), 6); SBAR(); GAPA(C0 = MF(kf[6], qr[3], C0),   P1[10], P1[11], P1[12], P1[13], pw3[0] = PKW(P1, 8), pw3[1] = PKW(P1, 10), pw3); \
    VRD(FO(7), 7); SBAR(); GAPA(C1 = MF(kf[7], qr[3], C1),   P1[14], P1[15], 0.f, 0.f,       pw3[2] = PKW(P1, 12), pw3[3] = PKW(P1, 14), pw3); \
    } \
    l_reg += sacc; \
    if (GK) { DMA_K((t) + 3, s_cur); } if (GV) { DMA_V((t) + 1, s_next); } \
    ADD_BIAS(C0, C1, t); \
    SBAR(); \
    if (ND == 2) { \
        GAPB4(o[0] = MF(PAF(0), VFR(0), o[0]), C0, 0); \
        GAPB4(o[1] = MF(PAF(0), VFR(1), o[1]), C0, 4); \
        KRD(GL, 0); GAPB4(o[0] = MF(PAF(1), VFR(2), o[0]), C0, 8); \
        KRD(GL, 1); GAPB4(o[1] = MF(PAF(1), VFR(3), o[1]), C0, 12); \
        KRD(GL, 2); GAPB4(o[0] = MF(PAF(2), VFR(4), o[0]), C1, 0); \
        KRD(GL, 3); GAPB4(o[1] = MF(PAF(2), VFR(5), o[1]), C1, 4); \
        GAPB4(o[0] = MF(PAF(3), VFR(6), o[0]), C1, 8); \
        GAPB4(o[1] = MF(PAF(3), VFR(7), o[1]), C1, 12); \
    } else { \
        GAPB2(o[0] = MF(PAF(0), VFR(0), o[0]), C0, 0);  VRD(FO(8), 0); SBAR(); \
        GAPB2(o[1] = MF(PAF(0), VFR(1), o[1]), C0, 2);  VRD(FO(9), 1); SBAR(); \
        GAPB2(o[ND - 2] = MF(PAF(0), VFR(2), o[ND - 2]), C0, 4);  VRD(FO(10), 2); SBAR(); \
        GAPB2(o[ND - 1] = MF(PAF(0), VFR(3), o[ND - 1]), C0, 6);  VRD(FO(11), 3); SBAR(); \
        GAPB2(o[0] = MF(PAF(1), VFR(4), o[0]), C0, 8);  VRD(FO(12), 4); SBAR(); \
        GAPB2(o[1] = MF(PAF(1), VFR(5), o[1]), C0, 10); VRD(FO(13), 5); SBAR(); \
        GAPB2(o[ND - 2] = MF(PAF(1), VFR(6), o[ND - 2]), C0, 12); VRD(FO(14), 6); SBAR(); \
        GAPB2(o[ND - 1] = MF(PAF(1), VFR(7), o[ND - 1]), C0, 14); VRD(FO(15), 7); SBAR(); \
        KRD(GL, 0); GAPB2(o[0] = MF(PAF(2), VFR(0), o[0]), C1, 0); \
        GAPB2(o[1] = MF(PAF(2), VFR(1), o[1]), C1, 2); \
        KRD(GL, 1); GAPB2(o[ND - 2] = MF(PAF(2), VFR(2), o[ND - 2]), C1, 4); \
        GAPB2(o[ND - 1] = MF(PAF(2), VFR(3), o[ND - 1]), C1, 6); \
        KRD(GL, 2); GAPB2(o[0] = MF(PAF(3), VFR(4), o[0]), C1, 8); \
        GAPB2(o[1] = MF(PAF(3), VFR(5), o[1]), C1, 10); \
        KRD(GL, 3); GAPB2(o[ND - 2] = MF(PAF(3), VFR(6), o[ND - 2]), C1, 12); \
        GAPB2(o[ND - 1] = MF(PAF(3), VFR(7), o[ND - 1]), C1, 14); \
    } \
    if (BIAS && (t) == tl) { l_reg *= fL; _Pragma("unroll") for (int d_ = 0; d_ < ND; ++d_) _Pragma("unroll") for (int r = 0; r < 16; ++r) o[d_][r] *= fL; } \
    } while (0)
    int t = 1;
    for (; t + 4 < NT; t += 2) {
        STEP(pB0, pB1, pA0, pA1, t, true, true, true);       WAITB(1 + NV); ROT();
        STEP(pA0, pA1, pB0, pB1, t + 1, true, true, true);   WAITB(1 + NV); ROT();
    }
    STEP(pB0, pB1, pA0, pA1, NT - 3, false, true, true);  wait_bar<NV, (TEST & 16) != 0>(); ROT();
    STEP(pA0, pA1, pB0, pB1, NT - 2, false, true, true);  wait_bar<0, (TEST & 16) != 0>();  ROT();
    STEP(pB0, pB1, pA0, pA1, NT - 1, false, false, false);
    {
        float sacc = pB0[0] + pB0[1];
#pragma unroll
        for (int r = 2; r < 16; ++r) sacc += pB0[r];
#pragma unroll
        for (int r = 0; r < 16; ++r) sacc += pB1[r];
        l_reg += sacc;
        pw0 = (v4u){PKW(pB0, 0), PKW(pB0, 2), PKW(pB0, 4), PKW(pB0, 6)}; pw1 = (v4u){PKW(pB0, 8), PKW(pB0, 10), PKW(pB0, 12), PKW(pB0, 14)};
        pw2 = (v4u){PKW(pB1, 0), PKW(pB1, 2), PKW(pB1, 4), PKW(pB1, 6)}; pw3 = (v4u){PKW(pB1, 8), PKW(pB1, 10), PKW(pB1, 12), PKW(pB1, 14)};
        const lds_cptr vp_ = vp0 + s_cur * VSLOT;
#pragma unroll
        for (int d0 = 0; d0 < ND; ++d0) {
            s16x4 a0 = vtr(vp_ + d0 * 4096), b0 = vtr(vp_ + d0 * 4096 + 512), a1 = vtr(vp_ + d0 * 4096 + 1024), b1 = vtr(vp_ + d0 * 4096 + 1536);
            s16x4 a2 = vtr(vp_ + d0 * 4096 + 2048), b2 = vtr(vp_ + d0 * 4096 + 2560), a3 = vtr(vp_ + d0 * 4096 + 3072), b3 = vtr(vp_ + d0 * 4096 + 3584);
            o[d0] = MF(PAF(0), ((bf16x8){a0[0], a0[1], a0[2], a0[3], b0[0], b0[1], b0[2], b0[3]}), o[d0]);
            o[d0] = MF(PAF(1), ((bf16x8){a1[0], a1[1], a1[2], a1[3], b1[0], b1[1], b1[2], b1[3]}), o[d0]);
            o[d0] = MF(PAF(2), ((bf16x8){a2[0], a2[1], a2[2], a2[3], b2[0], b2[1], b2[2], b2[3]}), o[d0]);
            o[d0] = MF(PAF(3), ((bf16x8){a3[0], a3[1], a3[2], a3[3], b3[0], b3[1], b3[2], b3[3]}), o[d0]);
        }
    }
    l_reg += __shfl_xor(l_reg, 32);
    int lane_e = lane; asm volatile("" : "+v"(lane_e));
    const int r32e = lane_e & 31, hie = lane_e >> 5;
    if (hie == 0) wsf[r32e] = l_reg;
    asm volatile("s_waitcnt lgkmcnt(0)\n\ts_barrier" ::: "memory");
    {
        LAS bf16* stg = (LAS bf16*)(MODE == 1 ? lds + STASH_OFF : lds) + wid * (32 * DV);
#pragma unroll
        for (int r = 0; r < 16; ++r) { const int orow = crow(r, hie); const float rl = __builtin_amdgcn_rcpf(wsf[orow]);
#pragma unroll
            for (int d0 = 0; d0 < ND; ++d0) stg[orow * DV + d0 * 32 + r32e] = (bf16)f2bf(o[d0][r] * rl); }
        asm volatile("s_waitcnt lgkmcnt(0)" ::: "memory");
        if (MODE == 0) {
            constexpr int CPR = DV / 8;
#pragma unroll
            for (int i = 0; i < (32 * CPR) / 64; ++i) { const int row = i * (64 / CPR) + lane_e / CPR, ch = lane_e % CPR;
                const v4u v = *(const LAS v4u*)(stg + row * DV + ch * 8); *(v4u*)(Op + (size_t)(wid * 32 + row) * ldo + ch * 8) = v; }
        } else if (MODE == 2) {
            const int row = lane_e >> 1, half = lane_e & 1; const float lam = sgt[128];
            const LAS bf16* s1 = stg + row * DV + half * 64; const LAS bf16* s0 = (const LAS bf16*)(lds + STASH_OFF) + wid * (32 * DV) + row * DV + half * 64;
            float ov[64]; float ss = 0.f;
#pragma unroll
            for (int q = 0; q < 8; ++q) { const v4u a = *(const LAS v4u*)(s0 + q * 8), c = *(const LAS v4u*)(s1 + q * 8);
#pragma unroll
                for (int j = 0; j < 4; ++j) { const float lo = __builtin_bit_cast(float, a[j] << 16) - lam * __builtin_bit_cast(float, c[j] << 16);
                    const float hh = __builtin_bit_cast(float, a[j] & 0xffff0000u) - lam * __builtin_bit_cast(float, c[j] & 0xffff0000u);
                    ov[q * 8 + 2 * j] = lo; ov[q * 8 + 2 * j + 1] = hh; ss += lo * lo + hh * hh; } }
            ss += dpp_mov<0xB1>(ss);
            const float rstd = 1.0f / sqrtf(ss * (1.f / 128.f) + 1e-5f);
            bf16* yo = Op + (size_t)(wid * 32 + row) * ldo + half * 64;
#pragma unroll
            for (int q = 0; q < 8; ++q) { const f32x4 g0 = *(const LAS f32x4*)(sgt + half * 64 + q * 8), g1 = *(const LAS f32x4*)(sgt + half * 64 + q * 8 + 4);
                v4u w; w.x = pk2(ov[q * 8] * rstd * g0.x, ov[q * 8 + 1] * rstd * g0.y); w.y = pk2(ov[q * 8 + 2] * rstd * g0.z, ov[q * 8 + 3] * rstd * g0.w);
                w.z = pk2(ov[q * 8 + 4] * rstd * g1.x, ov[q * 8 + 5] * rstd * g1.y); w.w = pk2(ov[q * 8 + 6] * rstd * g1.z, ov[q * 8 + 7] * rstd * g1.w);
                *(v4u*)(yo + q * 8) = w; }
        }
    }
    asm volatile("s_waitcnt lgkmcnt(0)\n\ts_barrier" ::: "memory");
#undef KLOAD8
#undef MF8
#undef WAITB
#undef DMA_K
#undef DMA_V
#undef ROT
#undef ADD_BIAS
#undef PKW
#undef PAF
#undef VFR
#undef MF
#undef GAPA
#undef EX
#undef GAPB4
#undef GAPB2
#undef VRD
#undef KRD
#undef FO
#undef STEP
}
#undef SBAR
#undef PIN
}

namespace at3 {
#define SBAR() __builtin_amdgcn_sched_barrier(0)
#define PIN(x) asm volatile("" : "+v"(x))
using at1::glds16; using at1::wait_bar;
typedef const LAS char* lds_cptr; typedef short v2s __attribute__((ext_vector_type(2)));
template <int DV> __host__ __device__ constexpr int lds_ws_off() { return (3 * 4096 + 3 * DV * 64) > 512 * DV ? (3 * 4096 + 3 * DV * 64) : 512 * DV; }
template <int DV> __host__ __device__ constexpr int lds_tbl_off() { return lds_ws_off<DV>() + 2048; }
__device__ __forceinline__ void waitb(int n) { if (n == 0) wait_bar<0>(); else if (n == 1) wait_bar<1>(); else wait_bar<2>(); }
__device__ __forceinline__ v8i ld_frag(lds_cptr p, int second) { const v4u a = *(const LAS v4u*)p, b = *(const LAS v4u*)(p + second); return (v8i){(int)a.x, (int)a.y, (int)a.z, (int)a.w, (int)b.x, (int)b.y, (int)b.z, (int)b.w}; }

template <int DV, bool BIAS, int MODE>
__device__ __forceinline__ void attn_unit(const unsigned char* Qp, int ldq, const unsigned char* __restrict__ K8T, const unsigned char* __restrict__ V8T, bf16* Op, int ldo, int q0, LAS unsigned char* lds, const LAS float* sgt) {
    constexpr int ND = DV / 32, VT = DV * 64, KT = 4096, NT = SEQ / 64, NVP = VT / 1024;
    constexpr int LDS_K = 0, LDS_V = 3 * KT, LDS_WS = lds_ws_off<DV>(), LDS_TBL = LDS_WS + 2048;
    static_assert(LDS_WS >= LDS_V + 3 * VT && LDS_WS >= 512 * DV && LDS_TBL + 2048 <= STASH_OFF, "LDS map");
    const int tid = threadIdx.x, lane = tid & 63, r32 = lane & 31, hi = lane >> 5; const int wid = __builtin_amdgcn_readfirstlane(tid >> 6);
    const unsigned lds0 = (unsigned)(uintptr_t)lds;
    LAS float* wsf = (LAS float*)(lds + LDS_WS) + wid * 64;
    const LAS float* btbl = (const LAS float*)(lds + LDS_TBL);
    const bool doK = wid < 4, doV = (NVP == 8) || wid >= 4; const int vpc = (NVP == 8) ? wid : (wid & 3);
    const unsigned char* ksrc = K8T + (wid & 3) * 1024 + lane * 16; const unsigned char* vsrc = V8T + vpc * 1024 + lane * 16;
    const unsigned kdst = lds0 + LDS_K + (wid & 3) * 1024, vdst = lds0 + LDS_V + vpc * 1024;
    const int ndma = (doK ? 1 : 0) + (doV ? 1 : 0);
#define DMA_K(t, s) do { if (doK) glds16(ksrc + (size_t)(t) * KT, (unsigned)__builtin_amdgcn_readfirstlane(kdst + (s) * KT)); } while (0)
#define DMA_V(t, s) do { if (doV) glds16(vsrc + (size_t)(t) * VT, (unsigned)__builtin_amdgcn_readfirstlane(vdst + (s) * VT)); } while (0)
    const lds_cptr kp0 = (lds_cptr)lds + LDS_K + hi * 2048 + r32 * 16;
    const lds_cptr vq0 = (lds_cptr)lds + LDS_V + hi * (2 * DV * 16) + r32 * 16;
    DMA_K(0, 0); DMA_V(0, 0); DMA_K(1, 1);
    v8i q8;
    { const unsigned char* qb_ = Qp + (size_t)(wid * 32 + r32) * ldq + hi * 32; const v4u a = *(const v4u*)qb_, b = *(const v4u*)(qb_ + 16);
      q8 = (v8i){(int)a.x, (int)a.y, (int)a.z, (int)a.w, (int)b.x, (int)b.y, (int)b.z, (int)b.w}; }
    f32x16 lacc = f32x16{}; f32x16 o[ND];
#pragma unroll
    for (int d = 0; d < ND; ++d) o[d] = f32x16{};
    const f32x16 zero16 = f32x16{};
    const v8i ones8 = {0x38383838, 0x38383838, 0x38383838, 0x38383838, 0x38383838, 0x38383838, 0x38383838, 0x38383838};
    const int qw = q0 + wid * 32, qpos = qw + r32;
    int tl = 0, tr = NT; float fL = 1.f;
    if (BIAS) { tl = (qw - 191 >= 0) ? ((qw - 191) >> 6) + 1 : 0; tr = (qw + 158) >> 6; fL = __builtin_amdgcn_exp2f(btbl[0]); }
    f32x16 pA0, pA1, pB0, pB1; v8i kf8[2]; v8i vf[ND]; v8i pa; int sb = 127;
    int s_prev = 0, s_cur = 0, s_next = 1;
#define ROT() do { s_prev = s_cur; s_cur = s_next; s_next = (s_next == 2) ? 0 : s_next + 1; } while (0)
#define MFQK(kf_) __builtin_amdgcn_mfma_scale_f32_32x32x64_f8f6f4(kf_, q8, zero16, 0, 0, 0, 0x7f7f7f7f, 0, 0x7c7c7c7c)
#define MFPV(d_) o[d_] = __builtin_amdgcn_mfma_scale_f32_32x32x64_f8f6f4(pa, vf[d_], o[d_], 0, 0, 0, sb, 0, 0x7f7f7f7f)
#define MFSUM() lacc = __builtin_amdgcn_mfma_scale_f32_32x32x64_f8f6f4(pa, ones8, lacc, 0, 0, 0, sb, 0, 0x7f7f7f7f)
#define ADD_BIAS(C0, C1, t) do { if (BIAS && (t) >= tl && (t) <= tr) { const int base_ = (t) * 64 + 4 * hi - qpos; \
        _Pragma("unroll") for (int r = 0; r < 16; ++r) { const int rel0 = base_ + (r & 3) + 8 * (r >> 2); const int rel1 = rel0 + 32; \
            const int i0 = (rel0 < -128 ? -128 : (rel0 > 128 ? 128 : rel0)) + 128, i1 = (rel1 < -128 ? -128 : (rel1 > 128 ? 128 : rel1)) + 128; \
            C0[r] += btbl[i0]; C1[r] += btbl[i1]; } } } while (0)
#define MX3(a, b, c) __builtin_fmaxf(__builtin_fmaxf((a), (b)), (c))
#define PMAX(P0, P1) do { float a_ = MX3(P0[0], P0[1], P1[0]), b_ = MX3(P0[2], P0[3], P1[1]); a_ = MX3(a_, P1[2], P1[3]); \
        _Pragma("unroll") for (int r = 4; r < 16; r += 4) { a_ = MX3(a_, P0[r], P0[r + 1]); b_ = MX3(b_, P0[r + 2], P0[r + 3]); a_ = MX3(a_, P1[r], P1[r + 1]); b_ = MX3(b_, P1[r + 2], P1[r + 3]); } \
        const int em_ = (int)(__float_as_uint(__builtin_fmaxf(a_, b_)) >> 23) - 7; sb = em_ < 1 ? 1 : em_; } while (0)
#define PCVT(P0, P1) do { const float scf_ = __uint_as_float((unsigned)sb << 23); \
        _Pragma("unroll") for (int k = 0; k < 4; ++k) { v2s w_ = {0, 0}; w_ = __builtin_amdgcn_cvt_scalef32_pk_fp8_f32(w_, P0[4 * k], P0[4 * k + 1], scf_, false); w_ = __builtin_amdgcn_cvt_scalef32_pk_fp8_f32(w_, P0[4 * k + 2], P0[4 * k + 3], scf_, true); pa[k] = __builtin_bit_cast(int, w_); } \
        _Pragma("unroll") for (int k = 0; k < 4; ++k) { v2s w_ = {0, 0}; w_ = __builtin_amdgcn_cvt_scalef32_pk_fp8_f32(w_, P1[4 * k], P1[4 * k + 1], scf_, false); w_ = __builtin_amdgcn_cvt_scalef32_pk_fp8_f32(w_, P1[4 * k + 2], P1[4 * k + 3], scf_, true); pa[4 + k] = __builtin_bit_cast(int, w_); } } while (0)
#define PSUM(P0, P1) do { float s0_ = P0[0] + P0[1], s1_ = P0[2] + P0[3], s2_ = P1[0] + P1[1], s3_ = P1[2] + P1[3]; \
        _Pragma("unroll") for (int r = 4; r < 16; r += 4) { s0_ += P0[r]; s1_ += P0[r + 1]; s2_ += P0[r + 2]; s3_ += P0[r + 3]; s0_ += P1[r]; s1_ += P1[r + 1]; s2_ += P1[r + 2]; s3_ += P1[r + 3]; } \
        l_reg += (s0_ + s1_) + (s2_ + s3_); } while (0)
#define EXPS(X, B, N) do { _Pragma("unroll") for (int r_ = 0; r_ < (N); ++r_) X[(B) + r_] = __builtin_amdgcn_exp2f(X[(B) + r_]); PIN(X); } while (0)
    DMA_K(2, 2);
    wait_bar<0>();
    kf8[0] = ld_frag(kp0, 1024); kf8[1] = ld_frag(kp0 + 512, 1024);
    pA0 = MFQK(kf8[0]); pA1 = MFQK(kf8[1]);
    ADD_BIAS(pA0, pA1, 0);
#pragma unroll
    for (int r = 0; r < 16; ++r) { pA0[r] = __builtin_amdgcn_exp2f(pA0[r]); pA1[r] = __builtin_amdgcn_exp2f(pA1[r]); }
    wait_bar<0>();
    DMA_K(3, 0); DMA_V(1, 1);
    ROT();
    kf8[0] = ld_frag(kp0 + s_cur * KT, 1024); kf8[1] = ld_frag(kp0 + s_cur * KT + 512, 1024);
    waitb(ndma);
#define STEP(C0, C1, P0, P1, t, GK, GV, GL) do { SBAR(); \
    const lds_cptr vp_ = vq0 + s_prev * VT; \
    _Pragma("unroll") for (int d_ = 0; d_ < ND; ++d_) vf[d_] = ld_frag(vp_ + d_ * 512, DV * 16); \
    SBAR(); \
    C0 = MFQK(kf8[0]); SBAR(); \
    PMAX(P0, P1); PIN(sb); SBAR(); \
    C1 = MFQK(kf8[1]); SBAR(); \
    PCVT(P0, P1); PIN(pa); SBAR(); \
    MFSUM(); SBAR(); \
    if (GK) { DMA_K((t) + 3, s_cur); } if (GV) { DMA_V((t) + 1, s_next); } \
    ADD_BIAS(C0, C1, t); \
    SBAR(); \
    if (ND == 2) { \
        MFPV(0); EXPS(C0, 0, 16); SBAR(); \
        if (GL) { kf8[0] = ld_frag(kp0 + s_next * KT, 1024); kf8[1] = ld_frag(kp0 + s_next * KT + 512, 1024); SBAR(); } \
        MFPV(1); EXPS(C1, 0, 16); SBAR(); \
    } else { \
        MFPV(0); EXPS(C0, 0, 8); SBAR(); \
        if (GL) { kf8[0] = ld_frag(kp0 + s_next * KT, 1024); SBAR(); } \
        MFPV(1); EXPS(C0, 8, 8); SBAR(); \
        if (GL) { kf8[1] = ld_frag(kp0 + s_next * KT + 512, 1024); SBAR(); } \
        MFPV(ND - 2); EXPS(C1, 0, 8); SBAR(); \
        MFPV(ND - 1); EXPS(C1, 8, 8); SBAR(); \
    } \
    if (BIAS && (t) == tl) { _Pragma("unroll") for (int r = 0; r < 16; ++r) lacc[r] *= fL; _Pragma("unroll") for (int d_ = 0; d_ < ND; ++d_) _Pragma("unroll") for (int r = 0; r < 16; ++r) o[d_][r] *= fL; } \
    } while (0)
    int t = 1;
    for (; t + 4 < NT; t += 2) {
        STEP(pB0, pB1, pA0, pA1, t, true, true, true);       waitb(ndma); ROT();
        STEP(pA0, pA1, pB0, pB1, t + 1, true, true, true);   waitb(ndma); ROT();
    }
    STEP(pB0, pB1, pA0, pA1, NT - 3, false, true, true);  waitb(doV ? 1 : 0); ROT();
    STEP(pA0, pA1, pB0, pB1, NT - 2, false, true, true);  wait_bar<0>();  ROT();
    STEP(pB0, pB1, pA0, pA1, NT - 1, false, false, false);
    {
        const lds_cptr vp_ = vq0 + s_cur * VT;
#pragma unroll
        for (int d_ = 0; d_ < ND; ++d_) vf[d_] = ld_frag(vp_ + d_ * 512, DV * 16);
        PMAX(pB0, pB1); PCVT(pB0, pB1); MFSUM();
#pragma unroll
        for (int d_ = 0; d_ < ND; ++d_) MFPV(d_);
    }
    int lane_e = lane; asm volatile("" : "+v"(lane_e));
    const int r32e = lane_e & 31, hie = lane_e >> 5;
    asm volatile("s_waitcnt lgkmcnt(0)\n\ts_barrier" ::: "memory");
    {
        LAS bf16* stg = (LAS bf16*)(MODE == 1 ? lds + STASH_OFF : lds) + wid * (32 * DV);
#pragma unroll
        for (int r = 0; r < 16; ++r) { const int orow = crow(r, hie); const float rl = __builtin_amdgcn_rcpf(lacc[r]);
#pragma unroll
            for (int d0 = 0; d0 < ND; ++d0) stg[orow * DV + d0 * 32 + r32e] = (bf16)f2bf(o[d0][r] * rl); }
        asm volatile("s_waitcnt lgkmcnt(0)" ::: "memory");
        if (MODE == 0) {
            constexpr int CPR = DV / 8;
#pragma unroll
            for (int i = 0; i < (32 * CPR) / 64; ++i) { const int row = i * (64 / CPR) + lane_e / CPR, ch = lane_e % CPR;
                const v4u v = *(const LAS v4u*)(stg + row * DV + ch * 8); *(v4u*)(Op + (size_t)(wid * 32 + row) * ldo + ch * 8) = v; }
        } else if (MODE == 2) {
            const int row = lane_e >> 1, half = lane_e & 1; const float lam = sgt[128];
            const LAS bf16* s1 = stg + row * DV + half * 64; const LAS bf16* s0 = (const LAS bf16*)(lds + STASH_OFF) + wid * (32 * DV) + row * DV + half * 64;
            float ov[64]; float ss = 0.f;
#pragma unroll
            for (int q = 0; q < 8; ++q) { const v4u a = *(const LAS v4u*)(s0 + q * 8), c = *(const LAS v4u*)(s1 + q * 8);
#pragma unroll
                for (int j = 0; j < 4; ++j) { const float lo = __builtin_bit_cast(float, a[j] << 16) - lam * __builtin_bit_cast(float, c[j] << 16);
                    const float hh = __builtin_bit_cast(float, a[j] & 0xffff0000u) - lam * __builtin_bit_cast(float, c[j] & 0xffff0000u);
                    ov[q * 8 + 2 * j] = lo; ov[q * 8 + 2 * j + 1] = hh; ss += lo * lo + hh * hh; } }
            ss += dpp_mov<0xB1>(ss);
            const float rstd = 1.0f / sqrtf(ss * (1.f / 128.f) + 1e-5f);
            bf16* yo = Op + (size_t)(wid * 32 + row) * ldo + half * 64;
#pragma unroll
            for (int q = 0; q < 8; ++q) { const f32x4 g0 = *(const LAS f32x4*)(sgt + half * 64 + q * 8), g1 = *(const LAS f32x4*)(sgt + half * 64 + q * 8 + 4);
                v4u w; w.x = pk2(ov[q * 8] * rstd * g0.x, ov[q * 8 + 1] * rstd * g0.y); w.y = pk2(ov[q * 8 + 2] * rstd * g0.z, ov[q * 8 + 3] * rstd * g0.w);
                w.z = pk2(ov[q * 8 + 4] * rstd * g1.x, ov[q * 8 + 5] * rstd * g1.y); w.w = pk2(ov[q * 8 + 6] * rstd * g1.z, ov[q * 8 + 7] * rstd * g1.w);
                *(v4u*)(yo + q * 8) = w; }
        }
    }
    asm volatile("s_waitcnt lgkmcnt(0)\n\ts_barrier" ::: "memory");
#undef DMA_K
#undef DMA_V
#undef ROT
#undef MFQK
#undef MFPV
#undef MFSUM
#undef ADD_BIAS
#undef MX3
#undef PMAX
#undef PCVT
#undef PSUM
#undef EXPS
#undef STEP
}
#undef SBAR
#undef PIN
}

struct Args { const float* in[27]; float* out; unsigned char* ws; int ph_lo, ph_hi, li, pad; };

constexpr int NPHASE = 17;
constexpr int NWAVES = 8;

#define IN(k) (lo <= (k) && (k) < hi_ph)
#define SEAM(k) do { if (IN(k) && IN((k) + 1)) xcd_barrier(bar); } while (0)
template <int layer>
__device__ __forceinline__ void moe_block(const Args& args, LAS unsigned char* lds, const XcdBarrier& bar, int lo, int hi_ph) {
    volatile LAS unsigned* LC = (volatile LAS unsigned*)(lds + LDSCTL_OFF);
    const int tid = threadIdx.x, lane = tid & 63, wave = __builtin_amdgcn_readfirstlane(tid >> 6);
    const int G = gridDim.x, bx = blockIdx.x;
    const int gw = bx * NWAVES + wave, NGW = G * NWAVES;
    unsigned char* ws = args.ws;
    unsigned* ctl = (unsigned*)(ws + WS_CTL);
    float* xres = args.out;
    bf16* XB = (bf16*)(ws + WS_XB);
    bf16* HB = (bf16*)(ws + WS_HB);
    {
        const int pb = layer == 0 ? 5 : 13;
        unsigned* const gcnt0 = ctl + CW_CNT + layer * 64;
        int* list = (int*)(ws + WS_LIST); int* tokep = (int*)(ws + WS_TOKEP); float* gate = (float*)(ws + WS_GATE);
        if (IN(pb)) REP(pb) {
            unsigned* gcnt = gcnt0 + ((MK_N_LAUNCHES == 1 ? (int)((PROBE_MASK >> pb) & 1u) : 0) - rep_) * 128;
            if (rep_ > 0) xcd_barrier(bar);
            const float* gf = args.in[2] + layer * DM;
            const float* WR = (const float*)(ws + WS_TBL) + TBL_WR + layer * WR_LAYER;
            for (int chunk = bx; chunk < NTOK / 128; chunk += G) {
                __syncthreads();
                if (tid < 32) LC[LC_LCNT + tid] = 0u;
                __syncthreads();
                int my_e0 = 0, my_e1 = 0; float my_g0 = 0.f, my_g1 = 0.f;
                {
                    const int ri = lane & 15, kq = lane >> 4; const int r0w = chunk * 128 + wave * 16;
                    const GAS bf16* xrow = (const GAS bf16*)(XB + (size_t)(r0w + ri) * DM) + 4 * kq;
                    const GAS float* wb = (const GAS float*)WR + (size_t)(4 * kq) * 48 + ri;
                    f32x4 acc0 = {0.f, 0.f, 0.f, 0.f}, acc1 = acc0, acc2 = acc0; float ss = 0.f;
                    f32x4 aA[4], aB[4]; float bA[48], bB[48];
#define RT_LOAD(a_, b_, g_) do { _Pragma("unroll") for (int c_ = 0; c_ < 4; ++c_) { { const v2u w_ = *(const GAS v2u*)(xrow + 16 * (4 * (g_) + c_)); a_[c_] = (f32x4){__builtin_bit_cast(float, w_.x << 16), __builtin_bit_cast(float, w_.x & 0xffff0000u), __builtin_bit_cast(float, w_.y << 16), __builtin_bit_cast(float, w_.y & 0xffff0000u)}; } \
        const GAS float* wc_ = wb + (size_t)(16 * (4 * (g_) + c_)) * 48; _Pragma("unroll") for (int e_ = 0; e_ < 4; ++e_) { b_[c_ * 12 + e_ * 3] = wc_[e_ * 48]; b_[c_ * 12 + e_ * 3 + 1] = wc_[e_ * 48 + 16]; b_[c_ * 12 + e_ * 3 + 2] = wc_[e_ * 48 + 32]; } } } while (0)
#define RT_COMP(a_, b_) do { _Pragma("unroll") for (int c_ = 0; c_ < 4; ++c_) { ss += (a_[c_].x * a_[c_].x + a_[c_].y * a_[c_].y) + (a_[c_].z * a_[c_].z + a_[c_].w * a_[c_].w); \
        _Pragma("unroll") for (int e_ = 0; e_ < 4; ++e_) { acc0 = __builtin_amdgcn_mfma_f32_16x16x4f32(a_[c_][e_], b_[c_ * 12 + e_ * 3], acc0, 0, 0, 0); \
            acc1 = __builtin_amdgcn_mfma_f32_16x16x4f32(a_[c_][e_], b_[c_ * 12 + e_ * 3 + 1], acc1, 0, 0, 0); acc2 = __builtin_amdgcn_mfma_f32_16x16x4f32(a_[c_][e_], b_[c_ * 12 + e_ * 3 + 2], acc2, 0, 0, 0); } } } while (0)
                    RT_LOAD(aA, bA, 0);
#pragma unroll 1
                    for (int g = 0; g < 16; g += 2) {
                        RT_LOAD(aB, bB, g + 1);
                        RT_COMP(aA, bA);
                        if (g + 2 < 16) RT_LOAD(aA, bA, g + 2);
                        RT_COMP(aB, bB);
                    }
#undef RT_LOAD
#undef RT_COMP
                    ss += __shfl_xor(ss, 16); ss += __shfl_xor(ss, 32);
                    const float rstd = 1.0f / sqrtf(ss * (1.f / DM) + 1e-6f);
                    LAS float* Lg = (LAS float*)(lds + wave * 4096);
#pragma unroll
                    for (int r = 0; r < 4; ++r) { Lg[(4 * kq + r) * 49 + ri] = acc0[r]; Lg[(4 * kq + r) * 49 + 16 + ri] = acc1[r]; Lg[(4 * kq + r) * 49 + 32 + ri] = acc2[r]; }
                    LDS_WAIT(); asm volatile("" ::: "memory");
                    if (lane < 16) {
                        const GAS float* bv = (const GAS float*)WR + 1024 * 48;
                        float lg[4], le[32];
#pragma unroll
                        for (int e = 0; e < 4; ++e) lg[e] = Lg[lane * 49 + e] * rstd + bv[e];
#pragma unroll
                        for (int e = 0; e < 32; ++e) le[e] = Lg[lane * 49 + 4 + e] * rstd + bv[4 + e];
                        int gi = 0; float gm = lg[0];
#pragma unroll
                        for (int e = 1; e < 4; ++e) if (lg[e] > gm) { gm = lg[e]; gi = e; }
                        float gs = 0.f;
#pragma unroll
                        for (int e = 0; e < 4; ++e) gs += __expf(lg[e] - gm);
                        const float gval = 1.0f / gs;
                        float ev[8];
#pragma unroll
                        for (int j = 0; j < 8; ++j) ev[j] = gi == 0 ? le[j] : (gi == 1 ? le[8 + j] : (gi == 2 ? le[16 + j] : le[24 + j]));
                        int i0 = 0; float m0 = ev[0];
#pragma unroll
                        for (int j = 1; j < 8; ++j) if (ev[j] > m0) { m0 = ev[j]; i0 = j; }
                        int i1 = -1; float m1 = -3.0e38f;
#pragma unroll
                        for (int j = 0; j < 8; ++j) if (j != i0 && ev[j] > m1) { m1 = ev[j]; i1 = j; }
                        const float t1 = __expf(m1 - m0); const float den = 1.0f / (1.0f + t1);
                        my_e0 = gi * 8 + i0; my_e1 = gi * 8 + i1; my_g0 = gval * den; my_g1 = gval * t1 * den;
                    }
                    for (int i = 0; i < 16; ++i) { const int m = r0w + i; f32x4 v[4]; rms_row_b16(XB + (size_t)m * DM, gf, v, lane);
                        if (MOE_FP8) {
#pragma unroll
                            for (int j = 0; j < 4; ++j) { int d = __builtin_amdgcn_cvt_pk_fp8_f32(v[j].x, v[j].y, 0, false); d = __builtin_amdgcn_cvt_pk_fp8_f32(v[j].z, v[j].w, d, true); *(GAS unsigned*)((unsigned char*)HB + (size_t)m * DM + 4 * lane + 256 * j) = (unsigned)d; }
                        } else store_row_bf16(HB + (size_t)m * DM, v, lane); }
                }
                unsigned r0 = 0, r1 = 0;
                if (lane < 16) { r0 = atomicAdd((unsigned*)(LC + LC_LCNT + my_e0), 1u); r1 = atomicAdd((unsigned*)(LC + LC_LCNT + my_e1), 1u); }
                __syncthreads();
                if (tid < 32) { const unsigned c = LC[LC_LCNT + tid]; LC[LC_LBASE + tid] = c ? __hip_atomic_fetch_add(gcnt + tid, c, RLX_AGENT) : 0u; }
                __syncthreads();
                if (lane < 16) { const int m = chunk * 128 + wave * 16 + lane;
                    const unsigned p0 = LC[LC_LBASE + my_e0] + r0, p1 = LC[LC_LBASE + my_e1] + r1;
                    list[(size_t)my_e0 * LIST_CAP + p0] = m; list[(size_t)my_e1 * LIST_CAP + p1] = m;
                    tokep[2 * m] = my_e0 | (int)(p0 << 8); tokep[2 * m + 1] = my_e1 | (int)(p1 << 8);
                    gate[2 * m] = my_g0; gate[2 * m + 1] = my_g1; }
            }
        }
        SEAM(pb);
        if (IN(pb + 1) || IN(pb + 2) || IN(pb + 3)) {
            __syncthreads();
            if (tid == 0) { int acc = 0; for (int e = 0; e < 32; ++e) { const int c = (int)__hip_atomic_load(gcnt0 + e, RLX_AGENT); LC[LC_CNT + e] = (unsigned)c; LC[LC_TP + e] = (unsigned)acc; acc += (c + 255) >> 8; } LC[LC_TP + 32] = (unsigned)acc;
                int la = 0; for (int j = 0; j < 4; ++j) { LC[LC_LP + j] = (unsigned)la; la += ((int)LC[LC_CNT + (bx & 7) + 8 * j] + 255) >> 8; } LC[LC_LP + 4] = (unsigned)la; }
            __syncthreads();
        }
        const LAS int* tp = (const LAS int*)(lds + LDSCTL_OFF) + LC_TP; const LAS int* cn = (const LAS int*)(lds + LDSCTL_OFF) + LC_CNT; const LAS int* lp = (const LAS int*)(lds + LDSCTL_OFF) + LC_LP;
        if (IN(pb + 1)) REP(pb + 1) {
            pg8::Gemm g{HB, (const bf16*)(ws + WS_W13), 0, 1024, MOE_FP8 ? DM / 2 : DM};
            pg8::MoeOrder S{tp, cn, lp, list, G, bx, tp[32] * 4, true, G == 256};
            pg8::EpiSwiglu E{(bf16*)(ws + WS_H), MOE_FP8 != 0};
            if (MOE_FP8) pg8::gemm_phase<pg8::EpiSwiglu, pg8::MoeOrder, true, true, 127, 122>(lds, g, S, E);
            else pg8::gemm_phase<pg8::EpiSwiglu, pg8::MoeOrder, true>(lds, g, S, E);
        }
        SEAM(pb + 1);
        if (IN(pb + 2)) REP(pb + 2) {
            pg8::Gemm g{(const bf16*)(ws + WS_H), (const bf16*)(ws + WS_W2), 0, 1024, MOE_FP8 ? MOE_H / 2 : MOE_H};
            pg8::MoeOrder S{tp, cn, lp, list, G, bx, tp[32] * 4, false, G == 256};
            pg8::EpiBf16 E{(bf16*)(ws + WS_YS), DM, 0, 0, 1.f, 3, MOE_FP8 != 0};
            if (MOE_FP8) pg8::gemm_phase<pg8::EpiBf16, pg8::MoeOrder, true, true, 125, 122>(lds, g, S, E);
            else pg8::gemm_phase<pg8::EpiBf16, pg8::MoeOrder, true>(lds, g, S, E);
        }
        SEAM(pb + 2);
        if (IN(pb + 3)) {
            const bf16* YS = (const bf16*)(ws + WS_YS);
            if (layer == 0) { LAS float* scr = (LAS float*)(lds + wave * 16384);
                transpose_moe(args.in[24] + (size_t)NEXP * 1024 * 512, args.in[25] + (size_t)NEXP * 1024 * 512, args.in[26] + (size_t)NEXP * 1024 * 512, (bf16*)(ws + WS_W13), (bf16*)(ws + WS_W2), scr, gw, NGW, lane); }
            const float* gn = layer == 0 ? args.in[1] + DM : args.in[3];
            for (int m = gw; m < NTOK; m += NGW) {
                const int ep0 = tokep[2 * m], ep1 = tokep[2 * m + 1]; const float g0 = gate[2 * m], g1 = gate[2 * m + 1];
                const size_t s0 = (size_t)(tp[ep0 & 255] * 256 + (ep0 >> 8)), s1 = (size_t)(tp[ep1 & 255] * 256 + (ep1 >> 8));
                GAS f32x4* xr = (GAS f32x4*)(xres + (size_t)m * DM) + lane; GAS v2u* xb = (GAS v2u*)(XB + (size_t)m * DM) + lane;
                const GAS v2u* y0 = (const GAS v2u*)(YS + s0 * DM) + lane; const GAS v2u* y1 = (const GAS v2u*)(YS + s1 * DM) + lane;
                const GAS unsigned* z0 = (const GAS unsigned*)((const unsigned char*)YS + s0 * DM) + lane; const GAS unsigned* z1 = (const GAS unsigned*)((const unsigned char*)YS + s1 * DM) + lane;
                f32x4 v[4]; float ss = 0.f;
#pragma unroll
                for (int j = 0; j < 4; ++j) { const v2u xw = xb[64 * j]; f32x4 xv = (f32x4){__builtin_bit_cast(float, xw.x << 16), __builtin_bit_cast(float, xw.x & 0xffff0000u), __builtin_bit_cast(float, xw.y << 16), __builtin_bit_cast(float, xw.y & 0xffff0000u)};
                    if (MOE_FP8) { typedef float f32x2_ __attribute__((ext_vector_type(2))); const unsigned a = z0[64 * j], c = z1[64 * j]; const float h0 = g0 * 0.125f, h1 = g1 * 0.125f;
                        const f32x2_ al = __builtin_amdgcn_cvt_pk_f32_fp8((int)a, false), ah = __builtin_amdgcn_cvt_pk_f32_fp8((int)a, true), cl = __builtin_amdgcn_cvt_pk_f32_fp8((int)c, false), ch = __builtin_amdgcn_cvt_pk_f32_fp8((int)c, true);
                        xv.x += h0 * al.x + h1 * cl.x; xv.y += h0 * al.y + h1 * cl.y; xv.z += h0 * ah.x + h1 * ch.x; xv.w += h0 * ah.y + h1 * ch.y;
                    } else { const v2u a = y0[64 * j], c = y1[64 * j];
                    xv.x += g0 * __builtin_bit_cast(float, a.x << 16) + g1 * __builtin_bit_cast(float, c.x << 16);
                    xv.y += g0 * __builtin_bit_cast(float, a.x & 0xffff0000u) + g1 * __builtin_bit_cast(float, c.x & 0xffff0000u);
                    xv.z += g0 * __builtin_bit_cast(float, a.y << 16) + g1 * __builtin_bit_cast(float, c.y << 16);
                    xv.w += g0 * __builtin_bit_cast(float, a.y & 0xffff0000u) + g1 * __builtin_bit_cast(float, c.y & 0xffff0000u); }
                    v[j] = xv; ss += (xv.x * xv.x + xv.y * xv.y) + (xv.z * xv.z + xv.w * xv.w); }
                const float rstd = 1.0f / sqrtf(wave_sum(ss) * (1.f / DM) + 1e-6f);
                const GAS f32x4* gr = (const GAS f32x4*)gn + lane;
                if (layer == 0) {
#pragma unroll
                    for (int j = 0; j < 4; ++j) xb[64 * j] = (v2u){pk2(v[j].x, v[j].y), pk2(v[j].z, v[j].w)};
#pragma unroll
                    for (int j = 0; j < 4; ++j) v[j] = v[j] * rstd * gr[64 * j];
                    store_row_bf16(HB + (size_t)m * DM, v, lane);
                } else {
#pragma unroll
                    for (int j = 0; j < 4; ++j) xr[64 * j] = v[j] * rstd * gr[64 * j];
                }
            }
        }
    }
}

__global__ void __launch_bounds__(NWAVES * 64, 2) mk_fwd(Args args) {
    extern __shared__ __attribute__((aligned(16))) unsigned char lds_raw[];
    LAS unsigned char* lds = (LAS unsigned char*)lds_raw;
    volatile LAS unsigned* LC = (volatile LAS unsigned*)(lds + LDSCTL_OFF);
    const int tid = threadIdx.x, lane = tid & 63, wave = __builtin_amdgcn_readfirstlane(tid >> 6);
    const int G = gridDim.x, bx = blockIdx.x;
    const int gw = bx * NWAVES + wave, NGW = G * NWAVES;
    unsigned char* ws = args.ws;
    unsigned* ctl = (unsigned*)(ws + WS_CTL);
    const float* x_in = args.in[0];
    float* xres = args.out;
    bf16* XB = (bf16*)(ws + WS_XB);
    bf16* HB = (bf16*)(ws + WS_HB); bf16* Y = (bf16*)(ws + WS_Y);
    float* TBL = (float*)(ws + WS_TBL);

    for (int u = tid; u < (LDS_BYTES - LDSCTL_OFF) / 4; u += NWAVES * 64) LC[u] = 0u;
    __syncthreads();
    XcdBarrier bar; bar.bar = ctl + CW_BAR; bar.x = 0; bar.st = nullptr;
    if (MK_N_LAUNCHES == 1) bar = xcd_barrier_post(ctl + CW_BAR, LC + LC_BAR);
    const int lo = args.ph_lo, hi_ph = args.ph_hi;

    if (IN(0)) REP(0) {
        LAS float* scr = (LAS float*)(lds + wave * 16384);
        transpose_plain(args.in[4], DM, EV_IN, (bf16*)(ws + WS_WIN0), scr, gw, NGW, lane);
        transpose_plain(args.in[11], DM, DM, (bf16*)(ws + WS_WOUT0), scr, gw, NGW, lane);
        transpose_plain(args.in[12], DM, OD_IN, (bf16*)(ws + WS_WIN1), scr, gw, NGW, lane);
        transpose_plain(args.in[18], DM, DM, (bf16*)(ws + WS_WOUT1), scr, gw, NGW, lane);
        transpose_moe(args.in[24], args.in[25], args.in[26], (bf16*)(ws + WS_W13), (bf16*)(ws + WS_W2), scr, gw, NGW, lane);
        for (int i = bx * 512 + tid; i < 2048; i += G * 512) { const int pos = i >> 4, f = i & 15;
            const float inv = exp2f(-(float)f * (13.287712379549449f / 16.0f));
            const float ang = (float)pos * inv; const float rev = ang * 0.15915494309189535f; const float fr = rev - floorf(rev);
            TBL[TBL_COS + i] = __builtin_amdgcn_cosf(fr); TBL[TBL_SIN + i] = __builtin_amdgcn_sinf(fr); }
        for (int i = bx * 512 + tid; i < 8 * 257; i += G * 512) { const int h = i / 257, j = i % 257;
            TBL[TBL_BIAS + h * BIAS_STRIDE + j] = args.in[19][t5_bucket(j - 128) * 8 + h] * LOG2E; }
        for (int i = bx * 512 + tid; i < 2 * 1024 * 48; i += G * 512) { const int l = i / (1024 * 48), r = i % (1024 * 48), k = r / 48, c = r % 48;
            float w = 0.f; if (c < 4) w = args.in[20][(size_t)l * 4096 + k * 4 + c]; else if (c < 36) w = args.in[22][(size_t)l * 32768 + k * 32 + (c - 4)];
            TBL[TBL_WR + l * WR_LAYER + r] = w * args.in[2][l * DM + k]; }
        for (int i = bx * 512 + tid; i < 2 * 48; i += G * 512) { const int l = i / 48, c = i % 48;
            TBL[TBL_WR + l * WR_LAYER + 1024 * 48 + c] = c < 4 ? args.in[21][l * 4 + c] : (c < 36 ? args.in[23][l * 32 + (c - 4)] : 0.f); }
        for (int m = gw; m < NTOK; m += NGW) { f32x4 v[4]; rms_row(x_in + (size_t)m * DM, args.in[1], v, lane); store_row_bf16(HB + (size_t)m * DM, v, lane); }
    }
    SEAM(0);
    if (IN(1)) REP(1) {
        pg8::Gemm g{HB, (const bf16*)(ws + WS_WIN0), NTOK, EV_IN, DM}; pg8::StaticOrder S; S.init(NTOK, EV_IN, G, bx);
        pg8::EpiBf16 E{(bf16*)(ws + WS_Z0), EV_IN, 0, 0, 1.f, 0xffff, false};
        pg8::gemm_phase<pg8::EpiBf16, pg8::StaticOrder, true>(lds, g, S, E);
    }
    SEAM(1);
    if (IN(2)) REP(2) {
        const bf16* Z0 = (const bf16*)(ws + WS_Z0); bf16* QR = (bf16*)(ws + WS_QR); bf16* KR = (bf16*)(ws + WS_KR);
        if (QK_FP8 && (ATTN_VER == 1 || ATTN_VER == 3)) {
            for (int it = bx * 512 + tid; it < NTOK * 10; it += G * 512) {
                const bool isq = it < NTOK * 8; const int m = isq ? (it >> 3) : ((it - NTOK * 8) >> 1); const int hh = isq ? (it & 7) : 8 + ((it - NTOK * 8) & 1);
                const float* gn = isq ? args.in[5] : args.in[6];
                const GAS v4u* srcp = (const GAS v4u*)(Z0 + (size_t)m * EV_IN + hh * 64);
                float xv[64]; float ss = 0.f;
#pragma unroll
                for (int q = 0; q < 8; ++q) { const v4u a = srcp[q];
#pragma unroll
                    for (int j = 0; j < 4; ++j) { const float lo = __builtin_bit_cast(float, a[j] << 16), hh2 = __builtin_bit_cast(float, a[j] & 0xffff0000u); xv[q * 8 + 2 * j] = lo; xv[q * 8 + 2 * j + 1] = hh2; ss += lo * lo + hh2 * hh2; } }
                const float rs = (1.0f / sqrtf(ss * (1.f / 64.f) + 1e-6f)) * (isq ? C2 * 8.0f : 1.0f);
                const int sp = m & (SEQ - 1);
                unsigned wout[16];
#pragma unroll
                for (int half = 0; half < 2; ++half) { const int pos = half ? (sp & 63) : (sp >> 6);
                    const GAS f32x4* ct = (const GAS f32x4*)(TBL + TBL_COS + pos * 16); const GAS f32x4* st = (const GAS f32x4*)(TBL + TBL_SIN + pos * 16);
                    float ov[32];
#pragma unroll
                    for (int q = 0; q < 4; ++q) { const f32x4 cv = ct[q], sv = st[q];
#pragma unroll
                        for (int j = 0; j < 4; ++j) { const int i = q * 4 + j; const float a = xv[half * 32 + i] * rs * gn[half * 32 + i], b2 = xv[half * 32 + 16 + i] * rs * gn[half * 32 + 16 + i];
                            ov[i] = a * cv[j] - b2 * sv[j]; ov[16 + i] = b2 * cv[j] + a * sv[j]; } }
#pragma unroll
                    for (int q = 0; q < 8; ++q) { int d = __builtin_amdgcn_cvt_pk_fp8_f32(ov[4 * q], ov[4 * q + 1], 0, false); d = __builtin_amdgcn_cvt_pk_fp8_f32(ov[4 * q + 2], ov[4 * q + 3], d, true); wout[half * 8 + q] = (unsigned)d; } }
                if (!isq && ATTN_VER == 3) {
                    const int strm = (m >> 13) * 2 + (hh - 8); unsigned char* kb_ = ws + WS_K8T0 + ((((size_t)strm * 128 + (sp >> 6)) * 4) * 64 + (sp & 63)) * 16;
#pragma unroll
                    for (int q = 0; q < 4; ++q) *(GAS v4u*)(kb_ + q * 1024) = (v4u){wout[4 * q], wout[4 * q + 1], wout[4 * q + 2], wout[4 * q + 3]};
                } else {
                GAS v4u* dst = isq ? (GAS v4u*)(ws + WS_QR8 + (size_t)m * 512 + hh * 64) : (GAS v4u*)(ws + WS_KR8 + (size_t)m * 128 + (hh - 8) * 64);
#pragma unroll
                for (int q = 0; q < 4; ++q) dst[q] = (v4u){wout[4 * q], wout[4 * q + 1], wout[4 * q + 2], wout[4 * q + 3]};
                }
            }
            if (ATTN_VER == 3) {
                for (int it = bx * 512 + tid; it < 8 * 128 * 4 * 64; it += G * 512) { const int d = it & 63, c = (it >> 6) & 3, tt = (it >> 8) & 127, strm = it >> 15;
                    const bf16* vb_ = Z0 + ((size_t)(strm >> 1) * SEQ + tt * 64) * EV_IN + 640 + (strm & 1) * 64 + d; unsigned w4[4];
#pragma unroll
                    for (int q = 0; q < 4; ++q) { float f[4];
#pragma unroll
                        for (int j = 0; j < 4; ++j) { const int bb = q * 4 + j; const int key = 32 * (c & 1) + (bb & 3) + 8 * (bb >> 2) + 4 * (c >> 1); f[j] = bf2f(vb_[(size_t)key * EV_IN]); }
                        int dw = __builtin_amdgcn_cvt_pk_fp8_f32(f[0], f[1], 0, false); dw = __builtin_amdgcn_cvt_pk_fp8_f32(f[2], f[3], dw, true); w4[q] = (unsigned)dw; }
                    *(GAS v4u*)(ws + WS_V8T0 + (size_t)it * 16) = (v4u){w4[0], w4[1], w4[2], w4[3]}; }
            }
        } else {
        const float gq = args.in[5][lane], gk = args.in[6][lane];
        const int fi = lane & 15; const bool first = (lane & 16) == 0, isrow = lane < 32;
        for (int m = gw; m < NTOK; m += NGW) {
            const int s = m & (SEQ - 1); const int pos = isrow ? (s >> 6) : (s & 63);
            const float cs = TBL[TBL_COS + pos * 16 + fi], sn = TBL[TBL_SIN + pos * 16 + fi];
#pragma unroll
            for (int h = 0; h < 10; ++h) {
                const float xv = bf2f(Z0[(size_t)m * EV_IN + h * 64 + lane]);
                const float ss = wave_sum(xv * xv);
                const float y = xv * (1.0f / sqrtf(ss * (1.f / 64.f) + 1e-6f)) * (h < 8 ? gq : gk);
                const float p = __shfl_xor(y, 16);
                float o = first ? (y * cs - p * sn) : (y * cs + p * sn);
                if (!QK_FP8 || ATTN_VER != 1) { if (h < 8) QR[(size_t)m * 512 + h * 64 + lane] = (bf16)f2bf(o * C2);
                else KR[(size_t)m * 128 + (h - 8) * 64 + lane] = (bf16)f2bf(o); }
                if (QK_FP8) { const unsigned w = quad_pack_bytes(fp8_byte(h < 8 ? o * (C2 * 8.0f) : o));
                    if ((lane & 3) == 0) { if (h < 8) *(unsigned*)(ws + WS_QR8 + (size_t)m * 512 + h * 64 + lane) = w; else *(unsigned*)(ws + WS_KR8 + (size_t)m * 128 + (h - 8) * 64 + lane) = w; } }
            }
        }
        }
        LAS float* hbuf = (LAS float*)lds;
        for (int un = bx; un < NBATCH * 64 * 8; un += G) {
            const int grp = un & 7, tt = (un >> 3) & 63, b = un >> 9; const int t0 = tt * 128;
            __syncthreads();
            for (int idx = tid; idx < 158 * 8; idx += 512) { const int r = idx >> 3, c8 = idx & 7; const int s = t0 - 15 + r;
                f32x4 h0 = {0.f, 0.f, 0.f, 0.f}, h1 = h0;
                if (s >= 0 && s < SEQ) { const size_t ro = (size_t)(b * SEQ + s) * EV_IN + grp * 64 + c8 * 8;
                    const v4u av = *(const GAS v4u*)(Z0 + ro + 768), gv = *(const GAS v4u*)(Z0 + ro + 1280);
#pragma unroll
                    for (int j = 0; j < 4; ++j) { const float a0 = __builtin_bit_cast(float, av[j] << 16), a1 = __builtin_bit_cast(float, av[j] & 0xffff0000u);
                        const float g0 = __builtin_bit_cast(float, gv[j] << 16), g1 = __builtin_bit_cast(float, gv[j] & 0xffff0000u);
                        const float x0 = a0 * __builtin_amdgcn_rcpf(1.0f + __builtin_amdgcn_exp2f(-g0 * LOG2E)), x1 = a1 * __builtin_amdgcn_rcpf(1.0f + __builtin_amdgcn_exp2f(-g1 * LOG2E));
                        if (j < 2) { h0[2 * j] = x0; h0[2 * j + 1] = x1; } else { h1[2 * j - 4] = x0; h1[2 * j - 3] = x1; } } }
                *(LAS f32x4*)(hbuf + r * 64 + c8 * 8) = h0; *(LAS f32x4*)(hbuf + r * 64 + c8 * 8 + 4) = h1; }
            __syncthreads();
            const int ch = grp * 64 + lane;
            float wreg[31];
#pragma unroll
            for (int j = 0; j < 31; ++j) wreg[j] = args.in[7][j * 512 + ch];
            typedef float f32x2 __attribute__((ext_vector_type(2)));
            float acc[16]; const float cb = args.in[8][ch];
            {
                f32x2 he[23], ho[22];
#pragma unroll
                for (int k = 0; k < 23; ++k) { he[k].x = hbuf[(wave * 16 + 2 * k) * 64 + lane]; he[k].y = hbuf[(wave * 16 + 2 * k + 1) * 64 + lane]; }
#pragma unroll
                for (int k = 0; k < 22; ++k) { ho[k].x = he[k].y; ho[k].y = he[k + 1].x; }
                f32x2 a2[8];
#pragma unroll
                for (int p = 0; p < 8; ++p) a2[p] = (f32x2){cb, cb};
#pragma unroll
                for (int j = 0; j < 31; ++j) { const f32x2 wj = (f32x2){wreg[j], wreg[j]};
#pragma unroll
                    for (int p = 0; p < 8; ++p) { const int r = 2 * p + j; a2[p] = __builtin_elementwise_fma(wj, (r & 1) ? ho[r >> 1] : he[r >> 1], a2[p]); } }
#pragma unroll
                for (int p = 0; p < 8; ++p) { acc[2 * p] = a2[p].x; acc[2 * p + 1] = a2[p].y; }
            }
            const float gg = args.in[9][ch], gb = args.in[10][ch];
#pragma unroll
            for (int i = 0; i < 16; ++i) { const float mu = wave_sum(acc[i]) * (1.f / 64.f); const float d = acc[i] - mu; const float var = wave_sum(d * d) * (1.f / 64.f);
                const float hn = d * (1.0f / sqrtf(var + 1e-5f)) * gg + gb; const float ov = hn * __builtin_amdgcn_rcpf(1.0f + __builtin_amdgcn_exp2f(-hn * LOG2E));
                Y[(size_t)(b * SEQ + t0 + wave * 16 + i) * DM + 512 + ch] = (bf16)f2bf(ov); }
        }
    }
    SEAM(2);
    if (IN(3)) REP(3) {
        const bf16* QR = (const bf16*)(ws + WS_QR); const bf16* KR = (const bf16*)(ws + WS_KR); const bf16* Z0 = (const bf16*)(ws + WS_Z0);
        if (ATTN_L0_TEST) {
        for (int un = bx; un < NBATCH * 8 * 32; un += G) {
            const int qb = un & 31, h = (un >> 5) & 7, b = un >> 8, kvh = h >> 2;
            const size_t row0 = (size_t)b * SEQ + qb * 256;
            attn_unit_v0<64, false, true>((const bf16*)(ws + WS_QR8 + row0 * 512 + h * 64), 512, (const bf16*)(ws + WS_KR8 + (size_t)b * SEQ * 128 + kvh * 64), 128, Z0 + (size_t)b * SEQ * EV_IN + 640 + kvh * 64, EV_IN,
                                   Y + row0 * DM + h * 64, DM, nullptr, qb * 256, lds);
        }
        } else if (ATTN_VER == 0) {
        for (int un = bx; un < NBATCH * 8 * 32; un += G) {
            const int qb = un & 31, h = (un >> 5) & 7, b = un >> 8, kvh = h >> 2;
            const size_t row0 = (size_t)b * SEQ + qb * 256;
            attn_unit_v0<64, false>(QR + row0 * 512 + h * 64, 512, KR + (size_t)b * SEQ * 128 + kvh * 64, 128, Z0 + (size_t)b * SEQ * EV_IN + 640 + kvh * 64, EV_IN,
                                   Y + row0 * DM + h * 64, DM, nullptr, qb * 256, lds);
        }
        } else {
        constexpr int U = NBATCH * 8 * 32; const int upc = (U + G - 1) / G; const int vcu = (G % 8 == 0) ? (bx % 8) * (G / 8) + bx / 8 : bx;
        for (int i = 0; i < upc; ++i) { const int un = vcu * upc + i; if (un >= U) break;
            const int stream = un >> 7, b = stream >> 1, kvh = stream & 1, h = kvh * 4 + ((un >> 5) & 3), qb = un & 31;
            const size_t row0 = (size_t)b * SEQ + qb * 256;
            if (ATTN_VER == 3) at3::attn_unit<64, false, 0>(ws + WS_QR8 + row0 * 512 + h * 64, 512, ws + WS_K8T0 + (size_t)stream * 128 * 4096, ws + WS_V8T0 + (size_t)stream * 128 * 4096, Y + row0 * DM + h * 64, DM, qb * 256, lds, nullptr);
            else if (QK_FP8) at1::attn_unit<64, false, 0, 0, true>((const bf16*)(ws + WS_QR8 + row0 * 512 + h * 64), 512, (const bf16*)(ws + WS_KR8 + (size_t)b * SEQ * 128 + kvh * 64), 128, Z0 + (size_t)b * SEQ * EV_IN + 640 + kvh * 64, EV_IN,
                                      Y + row0 * DM + h * 64, DM, qb * 256, lds);
            else at1::attn_unit<64, false>(QR + row0 * 512 + h * 64, 512, KR + (size_t)b * SEQ * 128 + kvh * 64, 128, Z0 + (size_t)b * SEQ * EV_IN + 640 + kvh * 64, EV_IN,
                                      Y + row0 * DM + h * 64, DM, qb * 256, lds);
        }
        }
    }
    SEAM(3);
    if (IN(4)) REP(4) {
        pg8::Gemm g{Y, (const bf16*)(ws + WS_WOUT0), NTOK, DM, DM}; pg8::StaticOrder S; S.init(NTOK, DM, G, bx);
        pg8::EpiRes E{x_in, nullptr, XB, DM};
        pg8::gemm_phase<pg8::EpiRes, pg8::StaticOrder, true>(lds, g, S, E);
    }
    SEAM(4);

    moe_block<0>(args, lds, bar, lo, hi_ph);
    SEAM(8);
            if (IN(9)) REP(9) {
                pg8::Gemm g{HB, (const bf16*)(ws + WS_WIN1), NTOK, OD_IN, DM}; pg8::StaticOrder S; S.init(NTOK, OD_IN, G, bx);
                if (QK_FP8) { pg8::EpiQKV8 E{ws + WS_Q1, ws + WS_K8T1, (bf16*)(ws + WS_V1), C2 * 8.0f, true};
                    pg8::gemm_phase<pg8::EpiQKV8, pg8::StaticOrder, true>(lds, g, S, E); }
                else { pg8::EpiBf16 E{(bf16*)(ws + WS_Q1), DM, DM, (size_t)(WS_K1 - WS_Q1) / 2, C2, 0xffff, false};
                pg8::gemm_phase<pg8::EpiBf16, pg8::StaticOrder, true>(lds, g, S, E); }
            }
            SEAM(9);
            if (ATTN_L1_VER == 3) {
            if (IN(10)) {
                const bf16* V1 = (const bf16*)(ws + WS_V1);
                for (int it = bx * 512 + tid; it < 32 * 128 * 4 * 128; it += G * 512) { const int d = it & 127, c = (it >> 7) & 3, tt = (it >> 9) & 127, bh = it >> 16;
                    const bf16* vb_ = V1 + ((size_t)(bh >> 3) * SEQ + tt * 64) * DM + (bh & 7) * 128 + d; unsigned w4[4];
#pragma unroll
                    for (int q = 0; q < 4; ++q) { float f[4];
#pragma unroll
                        for (int j = 0; j < 4; ++j) { const int bb = q * 4 + j; const int key = 32 * (c & 1) + (bb & 3) + 8 * (bb >> 2) + 4 * (c >> 1); f[j] = bf2f(vb_[(size_t)key * DM]); }
                        int dw = __builtin_amdgcn_cvt_pk_fp8_f32(f[0], f[1], 0, false); dw = __builtin_amdgcn_cvt_pk_fp8_f32(f[2], f[3], dw, true); w4[q] = (unsigned)dw; }
                    *(GAS v4u*)(ws + WS_V8T1 + (size_t)it * 16) = (v4u){w4[0], w4[1], w4[2], w4[3]}; }
            }
            SEAM(10);
            if (IN(11)) REP(11) {
                constexpr int UP = NBATCH * 8 * 32; const int upc = (UP + G - 1) / G; const int vcu = (G % 8 == 0) ? (bx % 8) * (G / 8) + bx / 8 : bx;
                LAS float* btbl = (LAS float*)(lds + at3::lds_tbl_off<128>());
                LAS float* sgt = btbl + 272;
                __syncthreads();
                if (tid < 128) sgt[tid] = args.in[17][tid] * (1.0f - LAM_INIT);
                if (wave == 7) { const float lam = __expf(wave_sum(args.in[13][lane] * args.in[14][lane])) - __expf(wave_sum(args.in[15][lane] * args.in[16][lane])) + LAM_INIT; if (lane == 0) sgt[128] = lam; }
                for (int i = 0; i < upc; ++i) {
                    int up = vcu * upc + i; if (up >= UP) break;
                    if (G == 256) up = ((vcu >> 5) * 4 + i) * 32 + (vcu & 31);
                    const int qb = up & 31, h = (up >> 5) & 7, b = up >> 8;
                    __syncthreads();
                    if (tid < 257) btbl[tid] = TBL[TBL_BIAS + h * BIAS_STRIDE + tid] - TBL[TBL_BIAS + h * BIAS_STRIDE + 256];
                    __syncthreads();
                    const size_t row0 = (size_t)b * SEQ + qb * 256; const int bh = b * 8 + h;
                    const unsigned char* Q8 = ws + WS_Q1 + row0 * DM + h * 128; const unsigned char* V8 = ws + WS_V8T1 + (size_t)bh * 128 * 8192;
                    at3::attn_unit<128, true, 1>(Q8, DM, ws + WS_K8T1 + (size_t)(bh * 2) * 128 * 4096, V8, nullptr, DM, qb * 256, lds, sgt);
                    at3::attn_unit<128, true, 2>(Q8 + 64, DM, ws + WS_K8T1 + (size_t)(bh * 2 + 1) * 128 * 4096, V8, Y + row0 * DM + h * 128, DM, qb * 256, lds, sgt);
                }
            }
            SEAM(11);
            } else {
            if (IN(10)) REP(10) {
                const bf16* Q1 = (const bf16*)(ws + WS_Q1); const bf16* K1 = (const bf16*)(ws + WS_K1); const bf16* V1 = (const bf16*)(ws + WS_V1);
                if (ATTN_L1_VER == 0) {
                LAS float* btbl = (LAS float*)(lds + 65536);
                for (int un = bx; un < NBATCH * 8 * 2 * 32; un += G) {
                    const int qb = un & 31, c = (un >> 5) & 1, h = (un >> 6) & 7, b = un >> 9;
                    __syncthreads();
                    if (tid < 257) btbl[tid] = TBL[TBL_BIAS + h * BIAS_STRIDE + tid];
                    __syncthreads();
                    const size_t row0 = (size_t)b * SEQ + qb * 256, brow = (size_t)b * SEQ;
                    bf16* OC = (bf16*)(ws + (c ? WS_OC1 : WS_OC0));
                    attn_unit_v0<128, true>(Q1 + row0 * DM + h * 128 + c * 64, DM, K1 + brow * DM + h * 128 + c * 64, DM, V1 + brow * DM + h * 128, DM,
                                           OC + row0 * DM + h * 128, DM, btbl, qb * 256, lds);
                }
                } else {
                constexpr int UP = NBATCH * 8 * 32; const int upc = (UP + G - 1) / G; const int vcu = (G % 8 == 0) ? (bx % 8) * (G / 8) + bx / 8 : bx;
                LAS float* btbl = (LAS float*)(lds + at1::lds_tbl_off<128, QK_FP8 != 0>());
                LAS float* sgt = btbl + 272;
                __syncthreads();
                if (tid < 128) sgt[tid] = args.in[17][tid] * (1.0f - LAM_INIT);
                if (wave == 7) { const float lam = __expf(wave_sum(args.in[13][lane] * args.in[14][lane])) - __expf(wave_sum(args.in[15][lane] * args.in[16][lane])) + LAM_INIT; if (lane == 0) sgt[128] = lam; }
                for (int i = 0; i < upc; ++i) {
                    int up = vcu * upc + i; if (up >= UP) break;
                    if (G == 256) up = ((vcu >> 5) * 4 + i) * 32 + (vcu & 31);
                    const int qb = up & 31, h = (up >> 5) & 7, b = up >> 8;
                    __syncthreads();
                    if (tid < 257) btbl[tid] = TBL[TBL_BIAS + h * BIAS_STRIDE + tid] - TBL[TBL_BIAS + h * BIAS_STRIDE + 256];
                    __syncthreads();
                    const size_t row0 = (size_t)b * SEQ + qb * 256, brow = (size_t)b * SEQ;
                    if (QK_FP8) { const unsigned char* Q8 = ws + WS_Q1; const unsigned char* K8 = ws + WS_K1;
                    const int bh = b * 8 + h; const bf16* VT = V1 + (size_t)bh * 128 * 8192; const unsigned char* KT0 = ws + WS_K8T1 + (size_t)(bh * 2) * 128 * 4096; (void)K8; (void)brow;
                    at1::attn_unit<128, true, 0, 1, true, true>((const bf16*)(Q8 + row0 * DM + h * 128), DM, (const bf16*)KT0, DM, VT, DM, nullptr, DM, qb * 256, lds, sgt);
                    at1::attn_unit<128, true, 0, 2, true, true>((const bf16*)(Q8 + row0 * DM + h * 128 + 64), DM, (const bf16*)(KT0 + 128 * 4096), DM, VT, DM, Y + row0 * DM + h * 128, DM, qb * 256, lds, sgt);
                    } else {
                    at1::attn_unit<128, true, 0, 1>(Q1 + row0 * DM + h * 128, DM, K1 + brow * DM + h * 128, DM, V1 + brow * DM + h * 128, DM, nullptr, DM, qb * 256, lds, sgt);
                    at1::attn_unit<128, true, 0, 2>(Q1 + row0 * DM + h * 128 + 64, DM, K1 + brow * DM + h * 128 + 64, DM, V1 + brow * DM + h * 128, DM, Y + row0 * DM + h * 128, DM, qb * 256, lds, sgt);
                    }
                }
                }
            }
            SEAM(10);
            if (PROBE_ATT >= 0 && IN(10)) {
                const bf16* Q1 = (const bf16*)(ws + WS_Q1); const bf16* K1 = (const bf16*)(ws + WS_K1); const bf16* V1 = (const bf16*)(ws + WS_V1);
                constexpr int U = NBATCH * 8 * 2 * 32; const int upc = (U + G - 1) / G; const int vcu = (G % 8 == 0) ? (bx % 8) * (G / 8) + bx / 8 : bx;
                LAS float* btbl = (LAS float*)(lds + 3 * 8192 + 3 * 16384 + 2048);
                for (int i = 0; i < upc; ++i) {
                    int un = vcu * upc + i; if (un >= U) break;
                    if (G == 256) un = ((vcu >> 5) * 4 + (i >> 1)) * 64 + (i & 1) * 32 + (vcu & 31);
                    const int qb = un & 31, c = (un >> 5) & 1, h = (un >> 6) & 7, b = un >> 9;
                    if (tid < 257) btbl[tid] = TBL[TBL_BIAS + h * BIAS_STRIDE + tid] - TBL[TBL_BIAS + h * BIAS_STRIDE + 256];
                    __syncthreads();
                    const size_t row0 = (size_t)b * SEQ + qb * 256, brow = (size_t)b * SEQ;
                    at1::attn_unit<128, true, (PROBE_ATT >= 0 ? PROBE_ATT : 0)>(Q1 + row0 * DM + h * 128 + c * 64, DM, K1 + brow * DM + h * 128 + c * 64, DM, V1 + brow * DM + h * 128, DM,
                                              (bf16*)(ws + WS_OC1) + row0 * DM + h * 128, DM, qb * 256, lds);
                }
                xcd_barrier(bar);
            }
            if (IN(11) && ATTN_L1_VER != 1) REP(11) {
                const bf16* OC0 = (const bf16*)(ws + WS_OC0); const bf16* OC1 = (const bf16*)(ws + WS_OC1);
                const float lam = __expf(wave_sum(args.in[13][lane] * args.in[14][lane])) - __expf(wave_sum(args.in[15][lane] * args.in[16][lane])) + LAM_INIT;
                float sg[16];
#pragma unroll
                for (int j = 0; j < 16; ++j) sg[j] = args.in[17][(lane & 7) * 16 + j] * (1.0f - LAM_INIT);
                for (int m = gw; m < NTOK; m += NGW) {
                    const GAS v4u* a = (const GAS v4u*)(OC0 + (size_t)m * DM) + lane * 2; const GAS v4u* c = (const GAS v4u*)(OC1 + (size_t)m * DM) + lane * 2;
                    float o[16]; float ss = 0.f;
#pragma unroll
                    for (int q = 0; q < 2; ++q) { const v4u av = a[q], cv = c[q];
#pragma unroll
                        for (int j = 0; j < 4; ++j) { const unsigned au = av[j], cu = cv[j];
                            const float lo = __builtin_bit_cast(float, au << 16) - lam * __builtin_bit_cast(float, cu << 16);
                            const float hh = __builtin_bit_cast(float, au & 0xffff0000u) - lam * __builtin_bit_cast(float, cu & 0xffff0000u);
                            o[q * 8 + 2 * j] = lo; o[q * 8 + 2 * j + 1] = hh; ss += lo * lo + hh * hh; } }
                    ss += __shfl_xor(ss, 1); ss += __shfl_xor(ss, 2); ss += __shfl_xor(ss, 4);
                    const float rstd = 1.0f / sqrtf(ss * (1.f / 128.f) + 1e-5f);
                    v4u w0, w1;
                    w0.x = pk2(o[0] * rstd * sg[0], o[1] * rstd * sg[1]); w0.y = pk2(o[2] * rstd * sg[2], o[3] * rstd * sg[3]); w0.z = pk2(o[4] * rstd * sg[4], o[5] * rstd * sg[5]); w0.w = pk2(o[6] * rstd * sg[6], o[7] * rstd * sg[7]);
                    w1.x = pk2(o[8] * rstd * sg[8], o[9] * rstd * sg[9]); w1.y = pk2(o[10] * rstd * sg[10], o[11] * rstd * sg[11]); w1.z = pk2(o[12] * rstd * sg[12], o[13] * rstd * sg[13]); w1.w = pk2(o[14] * rstd * sg[14], o[15] * rstd * sg[15]);
                    GAS v4u* yo = (GAS v4u*)(Y + (size_t)m * DM) + lane * 2; yo[0] = w0; yo[1] = w1;
                }
            }
            if (ATTN_L1_VER != 1) SEAM(11);
            }
            if (IN(12)) {
                pg8::Gemm g{Y, (const bf16*)(ws + WS_WOUT1), NTOK, DM, DM}; pg8::StaticOrder S; S.init(NTOK, DM, G, bx);
                pg8::EpiRes E{nullptr, XB, XB, DM};
                pg8::gemm_phase<pg8::EpiRes, pg8::StaticOrder, true>(lds, g, S, E);
            }
            SEAM(12);
    moe_block<1>(args, lds, bar, lo, hi_ph);
#undef IN
#undef SEAM
}

extern "C" void kernel_launch(void* const* d_in, const int* in_sizes, int n_in, void* d_out, int out_size, void* d_ws, size_t ws_size, hipStream_t stream) {
    static int grid = 0;
    if (grid == 0) {
        if (n_in != 27 || in_sizes[0] != NTOK * DM || out_size != NTOK * DM || ws_size < WS_END) { fprintf(stderr, "kernel_launch: unexpected shapes / workspace (n_in %d, ws %zu)\n", n_in, ws_size); grid = -1; return; }
        int dev = 0, cus = 0, per_cu = 0;
        if (hipGetDevice(&dev) != hipSuccess || hipDeviceGetAttribute(&cus, hipDeviceAttributeMultiprocessorCount, dev) != hipSuccess) { grid = -1; return; }
        if (hipFuncSetAttribute((const void*)mk_fwd, hipFuncAttributeMaxDynamicSharedMemorySize, LDS_BYTES) != hipSuccess) { fprintf(stderr, "kernel_launch: hipFuncSetAttribute failed\n"); grid = -1; return; }
        if (hipOccupancyMaxActiveBlocksPerMultiprocessor(&per_cu, (const void*)mk_fwd, NWAVES * 64, LDS_BYTES) != hipSuccess || per_cu < 1) { fprintf(stderr, "kernel_launch: occupancy query says %d\n", per_cu); }
        (void)hipGetLastError();
        grid = cus;
    }
    if (grid < 0) return;
    if (hipMemsetAsync((char*)d_ws + WS_CTL, 0, CTL_ZERO_BYTES, stream) != hipSuccess) return;
    Args a{};
    for (int i = 0; i < 27; ++i) a.in[i] = (const float*)d_in[i];
    a.out = (float*)d_out; a.ws = (unsigned char*)d_ws;
    if (MK_N_LAUNCHES == 1) { a.ph_lo = 0; a.ph_hi = NPHASE; a.li = 0; hipLaunchKernelGGL(mk_fwd, dim3(grid), dim3(NWAVES * 64), LDS_BYTES, stream, a); }
    else { for (int p = 0; p < NPHASE; ++p) for (int r = 0; r < (int)((PROBE_MASK >> p) & 1u) + 1; ++r) { a.ph_lo = p; a.ph_hi = p + 1; a.li = p; hipLaunchKernelGGL(mk_fwd, dim3(grid), dim3(NWAVES * 64), LDS_BYTES, stream, a); } }
}
```

```cpp
#include <hip/hip_runtime.h>
#include <cstdio>
#include <cstdint>

#ifndef MK_N_LAUNCHES
#define MK_N_LAUNCHES 1
#endif

#ifndef ATTN_VER
#define ATTN_VER 3
#endif
#ifndef PROBE_ATT
#define PROBE_ATT -1
#endif
#ifndef QK_FP8
#define QK_FP8 1
#endif
#ifndef ATTN_L0_TEST
#define ATTN_L0_TEST 0
#endif
#ifndef ATTN_L1_VER
#define ATTN_L1_VER 3
#endif
#ifndef MOE_FP8
#define MOE_FP8 1
#endif
#ifndef PROBE_MASK
#define PROBE_MASK 0u
#endif
#define REP(k) _Pragma("unroll") for (int rep_ = 0; rep_ < (MK_N_LAUNCHES == 1 ? (int)((PROBE_MASK >> (k)) & 1u) : 0) + 1; ++rep_)
#define GAS __attribute__((address_space(1)))
#define LAS __attribute__((address_space(3)))
typedef unsigned short bf16;
typedef unsigned v4u __attribute__((ext_vector_type(4)));
typedef unsigned v2u __attribute__((ext_vector_type(2)));
typedef float f32x4 __attribute__((ext_vector_type(4)));
typedef float f32x16 __attribute__((ext_vector_type(16)));
typedef short bf16x8 __attribute__((ext_vector_type(8)));
typedef short s16x4 __attribute__((ext_vector_type(4)));
typedef int v8i __attribute__((ext_vector_type(8)));

constexpr int NTOK = 32768, DM = 1024, SEQ = 8192, NBATCH = 4;
constexpr int EV_IN = 1792, OD_IN = 3072;
constexpr int NEXP = 32, MOE_H = 512, LIST_CAP = 32768;
constexpr float C2 = 0.125f * 1.4426950408889634f;
constexpr float LOG2E = 1.4426950408889634f;
constexpr float LAM_INIT = 0.35550906759f;

constexpr size_t MiB = 1u << 20;
constexpr size_t WS_CTL = 0, CTL_ZERO_BYTES = 1 * MiB;
constexpr size_t WS_WIN0 = 1 * MiB, WS_WOUT0 = 5 * MiB, WS_WIN1 = 7 * MiB, WS_WOUT1 = 13 * MiB, WS_TBL = 15 * MiB;
constexpr size_t WS_W13 = 16 * MiB, WS_W2 = 80 * MiB;
constexpr size_t WS_HB = 112 * MiB;
constexpr size_t WS_Y = 176 * MiB;
constexpr size_t WS_Z0 = 240 * MiB, WS_QR = 352 * MiB, WS_KR = 384 * MiB, WS_QR8 = 392 * MiB, WS_KR8 = 408 * MiB, WS_K8T0 = 408 * MiB, WS_V8T0 = 412 * MiB;
constexpr size_t WS_K8T1 = 304 * MiB, WS_V8T1 = 336 * MiB;
constexpr size_t WS_Q1 = 240 * MiB, WS_K1 = 304 * MiB, WS_V1 = 368 * MiB, WS_OC1 = 432 * MiB, WS_OC0 = WS_HB;
constexpr size_t WS_H = 176 * MiB, WS_YS = 248 * MiB, WS_LIST = 392 * MiB, WS_TOKEP = 396 * MiB, WS_GATE = 396 * MiB + 512 * 1024;
constexpr size_t WS_XB = 432 * MiB;
constexpr size_t WS_END = 496 * MiB;
constexpr int TBL_COS = 0, TBL_SIN = 2048, TBL_BIAS = 4096, BIAS_STRIDE = 272;
constexpr int TBL_WR = 32768, WR_LAYER = 1024 * 48 + 64;
constexpr int CW_BAR = 4096;
constexpr int CW_CNT = 16384;

constexpr int RING_BYTES = 131072;
constexpr int LDS_BYTES = 147456;
constexpr int LDSCTL_OFF = LDS_BYTES - 1024;
constexpr int STASH_OFF = 78 * 1024;
constexpr int LC_BAR = 8;
constexpr int LC_TP = 16;
constexpr int LC_CNT = 64;
constexpr int LC_LCNT = 96;
constexpr int LC_LBASE = 128;
constexpr int LC_LP = 160;

#define LDS_WAIT() asm volatile("s_waitcnt lgkmcnt(0)" ::: "memory")
#define VM_WAIT() asm volatile("s_waitcnt vmcnt(0)" ::: "memory")
#define RLX_AGENT __ATOMIC_RELAXED, __HIP_MEMORY_SCOPE_AGENT

__device__ __forceinline__ unsigned f2bf(float f) { unsigned u = __builtin_bit_cast(unsigned, f); return (u + 0x7fffu + ((u >> 16) & 1u)) >> 16; }
__device__ __forceinline__ unsigned pk2(float lo, float hi) { return f2bf(lo) | (f2bf(hi) << 16); }
__device__ __forceinline__ float bf2f(unsigned short b) { return __builtin_bit_cast(float, (unsigned)b << 16); }
template <int CTRL> __device__ __forceinline__ float dpp_mov(float v) { return __builtin_bit_cast(float, __builtin_amdgcn_update_dpp(0, __builtin_bit_cast(int, v), CTRL, 0xf, 0xf, true)); }
__device__ __forceinline__ float wave_sum(float v) {
    v += dpp_mov<0xB1>(v); v += dpp_mov<0x4E>(v); v += dpp_mov<0x141>(v); v += dpp_mov<0x140>(v);
    { auto rr = __builtin_amdgcn_permlane16_swap(__float_as_uint(v), __float_as_uint(v), false, false); v = __uint_as_float(rr[0]) + __uint_as_float(rr[1]); }
    { auto rr = __builtin_amdgcn_permlane32_swap(__float_as_uint(v), __float_as_uint(v), false, false); v = __uint_as_float(rr[0]) + __uint_as_float(rr[1]); }
    return v;
}


__device__ __forceinline__ unsigned fp8_byte(float v) { return (unsigned)__builtin_amdgcn_cvt_pk_fp8_f32(v, v, 0, false) & 0xffu; }
__device__ __forceinline__ unsigned quad_pack_bytes(unsigned b) {
    const unsigned x0 = (unsigned)__builtin_amdgcn_update_dpp(0, (int)b, 0x00, 0xf, 0xf, true), x1 = (unsigned)__builtin_amdgcn_update_dpp(0, (int)b, 0x55, 0xf, 0xf, true);
    const unsigned x2 = (unsigned)__builtin_amdgcn_update_dpp(0, (int)b, 0xAA, 0xf, 0xf, true), x3 = (unsigned)__builtin_amdgcn_update_dpp(0, (int)b, 0xFF, 0xf, 0xf, true);
    return x0 | (x1 << 8) | (x2 << 16) | (x3 << 24);
}
namespace pg8 {
#define PG8_LAS __attribute__((address_space(3)))
typedef unsigned short bf16_t;
typedef short bf16x8 __attribute__((ext_vector_type(8)));
typedef float f32x4 __attribute__((ext_vector_type(4)));
typedef unsigned u32x4 __attribute__((ext_vector_type(4)));
constexpr int BM = 256, BK = 64, HALF = 128, HTB = HALF * BK * 2, STAGE_BYTES = 8 * HTB, NXCD = 8, WGM = 8;

__host__ __device__ __forceinline__ int lds_byte(int r, int c) { const int st = (r >> 4) * 2 + (c >> 5), rr = r & 15, cc = c & 31, ob = rr * 64 + cc * 2; return st * 1024 + (ob ^ (((ob >> 9) & 1) << 5)); }
__host__ __device__ __forceinline__ void stage_rc(int b, int& R, int& C) { const int st = b / 1024, sb = b % 1024, swz = sb ^ (((sb >> 9) & 1) << 5); R = (st >> 1) * 16 + swz / 64; C = (st & 1) * 32 + (swz % 64) / 2; }
__host__ __device__ __forceinline__ int perm32(int rho) { const int n = rho >> 4, i = rho & 15; return 8 * (i >> 2) + 4 * n + (i & 3); }

struct Unit { int pm, pn, e, rb; };
struct Gemm { const bf16_t* A; const bf16_t* Bt; int M, N, K; };

struct StaticOrder {
    int nM, nN, nwg, G, c;
    __device__ void init(int M, int N, int G_, int c_) { nM = M / BM; nN = N / BM; nwg = nM * nN; G = G_; c = c_; }
    __device__ bool next(int i, Unit& u) const {
        const long L = (long)i * G + c; if (L >= nwg) return false;
        int wgid = (int)L; { const int q = nwg / NXCD, r = nwg % NXCD, xcd = wgid % NXCD, off = wgid / NXCD; wgid = (xcd < r ? xcd * (q + 1) : r * (q + 1) + (xcd - r) * q) + off; }
        const int nig = WGM * nN, gid = wgid / nig, fm = gid * WGM, gsz = (nM - fm) < WGM ? (nM - fm) : WGM;
        u.pm = fm + ((wgid % nig) % gsz); u.pn = (wgid % nig) / gsz; u.e = 0; u.rb = 0; return true;
    }
    __device__ __forceinline__ unsigned arow(const Unit& u, int rr) const { return (unsigned)(u.pm * BM + rr); }
};

struct MoeOrder {
    const PG8_LAS int* tp; const PG8_LAS int* cn; const PG8_LAS int* lp; const int* list; int G, c, nunits; bool gather; bool xcd;
    __device__ __forceinline__ bool next(int i, Unit& u) const {
        int e_, rb_, pm_, pnl_; bool ok;
        if (xcd) {
            const int x = c & 7, y = c >> 3; const int uidx = i * 32 + y; ok = uidx < lp[4] * 4;
            const int rbl = uidx >> 2; pnl_ = uidx & 3; int j = 0;
#pragma unroll
            for (int q = 1; q < 4; ++q) j += (lp[q] <= rbl) ? 1 : 0;
            e_ = x + 8 * j; rb_ = rbl - lp[j]; pm_ = tp[e_] + rb_;
        } else {
            const int L = i * G + c; ok = L < nunits;
            const int rbg = L >> 2; pnl_ = L & 3; int e = 0;
#pragma unroll
            for (int j = 1; j < 32; ++j) e += (tp[j] <= rbg) ? 1 : 0;
            e_ = e; pm_ = rbg; rb_ = rbg - tp[e];
        }
        u.e = __builtin_amdgcn_readfirstlane(e_); u.rb = __builtin_amdgcn_readfirstlane(rb_); u.pm = __builtin_amdgcn_readfirstlane(pm_); u.pn = __builtin_amdgcn_readfirstlane(e_ * 4 + pnl_);
        return ok;
    }
    __device__ __forceinline__ unsigned arow(const Unit& u, int rr) const {
        if (!gather) return (unsigned)(u.pm * BM + rr);
        const int idx = u.rb * BM + rr; unsigned t = 0u;
        if (idx < cn[u.e]) t = (unsigned)list[(size_t)u.e * 32768 + idx];
        return t;
    }
};

__device__ __forceinline__ unsigned cvt_pk_bf16(float lo, float hi) { unsigned r; asm volatile("v_cvt_pk_bf16_f32 %0, %1, %2" : "=v"(r) : "v"(lo), "v"(hi)); return r; }

struct EpiBf16 {
    static constexpr bool PERM = true;
    bf16_t* O; int ldc; int split_cols; size_t split_stride; float scale0; int pn_mask; bool f8;
    __device__ __forceinline__ void operator()(const f32x4 (&acc)[2][2][4][2], const Unit& u, int wr, int wc, int fr, int fq) const {
        const int row0 = u.pm * BM + wr * 64 + fr; int colt = (u.pn & pn_mask) * BM; bf16_t* base = O;
        float sc = 1.f; if (split_cols) { const int t = colt / split_cols; base += (size_t)t * split_stride; colt -= t * split_cols; if (t == 0) sc = scale0; }
        if (f8) sc = 8.0f;
        const int col0 = colt + wc * 32 + 8 * fq;
#pragma unroll
        for (int ai = 0; ai < 2; ++ai)
#pragma unroll
            for (int m = 0; m < 4; ++m) { const size_t ro = (size_t)(row0 + ai * HALF + m * 16) * ldc + col0;
#pragma unroll
                for (int bj = 0; bj < 2; ++bj) { f32x4 v0 = acc[ai][bj][m][0] * sc, v1 = acc[ai][bj][m][1] * sc;
                    if (f8) { typedef unsigned u32x2 __attribute__((ext_vector_type(2)));
                        int d0 = __builtin_amdgcn_cvt_pk_fp8_f32(v0[0], v0[1], 0, false); d0 = __builtin_amdgcn_cvt_pk_fp8_f32(v0[2], v0[3], d0, true);
                        int d1 = __builtin_amdgcn_cvt_pk_fp8_f32(v1[0], v1[1], 0, false); d1 = __builtin_amdgcn_cvt_pk_fp8_f32(v1[2], v1[3], d1, true);
                        *(u32x2*)((unsigned char*)base + ro + bj * HALF) = (u32x2){(unsigned)d0, (unsigned)d1};
                    } else {
                    u32x4 w; w.x = cvt_pk_bf16(v0[0], v0[1]); w.y = cvt_pk_bf16(v0[2], v0[3]); w.z = cvt_pk_bf16(v1[0], v1[1]); w.w = cvt_pk_bf16(v1[2], v1[3]);
                    *(u32x4*)(base + ro + bj * HALF) = w; } } }
    }
};
struct EpiRes {
    static constexpr bool PERM = true;
    const float* base32; const bf16_t* base16; bf16_t* out; int ldc;
    __device__ __forceinline__ void operator()(const f32x4 (&acc)[2][2][4][2], const Unit& u, int wr, int wc, int fr, int fq) const {
        const int row0 = u.pm * BM + wr * 64 + fr, col0 = u.pn * BM + wc * 32 + 8 * fq;
#pragma unroll
        for (int ai = 0; ai < 2; ++ai)
#pragma unroll
            for (int m = 0; m < 4; ++m) { const size_t off = (size_t)(row0 + ai * HALF + m * 16) * ldc + col0;
#pragma unroll
                for (int bj = 0; bj < 2; ++bj) { f32x4 b0, b1;
                    if (base32) { b0 = *(const f32x4*)(base32 + off + bj * HALF); b1 = *(const f32x4*)(base32 + off + bj * HALF + 4); }
                    else { const u32x4 w = *(const u32x4*)(base16 + off + bj * HALF);
                        b0 = (f32x4){__builtin_bit_cast(float, w.x << 16), __builtin_bit_cast(float, w.x & 0xffff0000u), __builtin_bit_cast(float, w.y << 16), __builtin_bit_cast(float, w.y & 0xffff0000u)};
                        b1 = (f32x4){__builtin_bit_cast(float, w.z << 16), __builtin_bit_cast(float, w.z & 0xffff0000u), __builtin_bit_cast(float, w.w << 16), __builtin_bit_cast(float, w.w & 0xffff0000u)}; }
                    const f32x4 v0 = b0 + acc[ai][bj][m][0], v1 = b1 + acc[ai][bj][m][1];
                    u32x4 o; o.x = cvt_pk_bf16(v0[0], v0[1]); o.y = cvt_pk_bf16(v0[2], v0[3]); o.z = cvt_pk_bf16(v1[0], v1[1]); o.w = cvt_pk_bf16(v1[2], v1[3]);
                    *(u32x4*)(out + off + bj * HALF) = o; } }
    }
};
struct EpiQKV8 {
    static constexpr bool PERM = true;
    unsigned char* Q8; unsigned char* K8; bf16_t* V; float qscale; bool ktiled;
    __device__ __forceinline__ void operator()(const f32x4 (&acc)[2][2][4][2], const Unit& u, int wr, int wc, int fr, int fq) const {
        const int row0 = u.pm * BM + wr * 64 + fr; const int colt = u.pn * BM; const int t = colt >> 10; const int col0 = (colt & 1023) + wc * 32 + 8 * fq;
        const float sc = t == 0 ? qscale : 1.0f;
#pragma unroll
        for (int ai = 0; ai < 2; ++ai)
#pragma unroll
            for (int m = 0; m < 4; ++m) { const size_t ro = (size_t)(row0 + ai * HALF + m * 16) * 1024 + col0;
#pragma unroll
                for (int bj = 0; bj < 2; ++bj) { const f32x4 v0 = acc[ai][bj][m][0] * sc, v1 = acc[ai][bj][m][1] * sc;
                    if (t == 2) { u32x4 w; w.x = cvt_pk_bf16(v0[0], v0[1]); w.y = cvt_pk_bf16(v0[2], v0[3]); w.z = cvt_pk_bf16(v1[0], v1[1]); w.w = cvt_pk_bf16(v1[2], v1[3]);
                        if (ktiled) { const int mrow = row0 + ai * HALF + m * 16, n = col0 + bj * HALF; const int bh = (mrow >> 13) * 8 + (n >> 7), sq = mrow & 8191, d = n & 127;
                            *(u32x4*)(V + (((size_t)bh * 128 + (sq >> 6)) * 4 + (d >> 5)) * 2048 + (sq & 63) * 32 + (d & 31)) = w; }
                        else *(u32x4*)(V + ro + bj * HALF) = w; }
                    else { int d0 = __builtin_amdgcn_cvt_pk_fp8_f32(v0[0], v0[1], 0, false); d0 = __builtin_amdgcn_cvt_pk_fp8_f32(v0[2], v0[3], d0, true);
                        int d1 = __builtin_amdgcn_cvt_pk_fp8_f32(v1[0], v1[1], 0, false); d1 = __builtin_amdgcn_cvt_pk_fp8_f32(v1[2], v1[3], d1, true);
                        typedef int i32x2 __attribute__((ext_vector_type(2)));
                        if (t == 1 && ktiled) { const int mrow = row0 + ai * HALF + m * 16, n = col0 + bj * HALF; const int strm = ((mrow >> 13) * 8 + (n >> 7)) * 2 + ((n >> 6) & 1), sq = mrow & 8191, dd = n & 63;
                            *(i32x2*)(K8 + ((((size_t)strm * 128 + (sq >> 6)) * 4 + (dd >> 4)) * 64 + (sq & 63)) * 16 + (dd & 15)) = (i32x2){d0, d1}; }
                        else *(i32x2*)((t == 0 ? Q8 : K8) + ro + bj * HALF) = (i32x2){d0, d1}; } } }
    }
};
__device__ __forceinline__ float silu_mul(float a, float b) { return a * b * __builtin_amdgcn_rcpf(1.0f + __builtin_amdgcn_exp2f(-a * 1.4426950408889634f)); }
struct EpiSwiglu {
    static constexpr bool PERM = true;
    bf16_t* O; bool f8;
    __device__ __forceinline__ void operator()(const f32x4 (&acc)[2][2][4][2], const Unit& u, int wr, int wc, int fr, int fq) const {
        const int row0 = u.pm * BM + wr * 64 + fr, col0 = (u.pn & 3) * 128 + wc * 32 + 8 * fq;
#pragma unroll
        for (int ai = 0; ai < 2; ++ai)
#pragma unroll
            for (int m = 0; m < 4; ++m) { const size_t ro = (size_t)(row0 + ai * HALF + m * 16) * 512 + col0;
                const f32x4 a0 = acc[ai][0][m][0], a1 = acc[ai][0][m][1], b0 = acc[ai][1][m][0], b1 = acc[ai][1][m][1];
                if (f8) { typedef unsigned u32x2 __attribute__((ext_vector_type(2)));
                    int d0 = __builtin_amdgcn_cvt_pk_fp8_f32(4.f * silu_mul(a0[0], b0[0]), 4.f * silu_mul(a0[1], b0[1]), 0, false); d0 = __builtin_amdgcn_cvt_pk_fp8_f32(4.f * silu_mul(a0[2], b0[2]), 4.f * silu_mul(a0[3], b0[3]), d0, true);
                    int d1 = __builtin_amdgcn_cvt_pk_fp8_f32(4.f * silu_mul(a1[0], b1[0]), 4.f * silu_mul(a1[1], b1[1]), 0, false); d1 = __builtin_amdgcn_cvt_pk_fp8_f32(4.f * silu_mul(a1[2], b1[2]), 4.f * silu_mul(a1[3], b1[3]), d1, true);
                    *(u32x2*)((unsigned char*)O + ro) = (u32x2){(unsigned)d0, (unsigned)d1};
                } else {
                u32x4 w; w.x = cvt_pk_bf16(silu_mul(a0[0], b0[0]), silu_mul(a0[1], b0[1])); w.y = cvt_pk_bf16(silu_mul(a0[2], b0[2]), silu_mul(a0[3], b0[3]));
                w.z = cvt_pk_bf16(silu_mul(a1[0], b1[0]), silu_mul(a1[1], b1[1])); w.w = cvt_pk_bf16(silu_mul(a1[2], b1[2]), silu_mul(a1[3], b1[3]));
                *(u32x4*)(O + ro) = w; } }
    }
};

template <class Epi, class Sched, bool ALIGN_EPI, bool F8 = false, int SCA = 127, int SCB = 127>
__device__ __forceinline__ void gemm_phase(PG8_LAS unsigned char* lds, const Gemm g, const Sched& S, const Epi& E) {
    const int tid = threadIdx.x, wid = __builtin_amdgcn_readfirstlane(tid >> 6), lane = tid & 63, wr = wid >> 2, wc = wid & 3, fr = lane & 15, fq = lane >> 4;
    const int K = g.K, nt = K / BK;
    int RA[2], CA[2]; unsigned voffB[2];
#pragma unroll
    for (int i = 0; i < 2; ++i) { int R, C; stage_rc(tid * 16 + i * 8192, R, C); RA[i] = R; CA[i] = C; const int Rb = Epi::PERM ? ((R & ~31) + perm32(R & 31)) : R; voffB[i] = (unsigned)(Rb * K + C) * 2u; }
    const size_t kstep = (size_t)(BK * 2);
    const size_t hstep = (size_t)HALF * K * 2;
    const size_t tstep = 2 * hstep;
    const unsigned ldsw = (unsigned)wid * 1024u;
    const int aoff = lds_byte(wr * 64 + fr, fq * 8), boff = lds_byte(wc * 32 + fr, fq * 8);
#define PG8_SA(b, h) (((b) * 2 + (h)) * HTB)
#define PG8_SB(b, h) ((4 + (b) * 2 + (h)) * HTB)
#define PG8_STAGE(bufoff, gbase, voff) do { _Pragma("unroll") for (int _i = 0; _i < 2; ++_i) \
        __builtin_amdgcn_global_load_lds((const unsigned*)((const char*)(gbase) + (voff)[_i]), (PG8_LAS unsigned*)(lds + (bufoff) + ldsw + _i * 8192), 16, 0, 0); } while (0)
#define PG8_LD8(p_) ({ typedef int v4i_ __attribute__((ext_vector_type(4))); const v4i_ lo_ = *(const PG8_LAS v4i_*)(p_), hi_ = *(const PG8_LAS v4i_*)((p_) + 1024); __builtin_shufflevector(lo_, hi_, 0, 1, 2, 3, 4, 5, 6, 7); })
#define PG8_LDA(dst, b, h) do { if (F8) { _Pragma("unroll") for (int m = 0; m < 4; ++m) dst##8[m] = PG8_LD8(lds + PG8_SA(b, h) + aoff + m * 2048); } \
        else { _Pragma("unroll") for (int m = 0; m < 4; ++m) _Pragma("unroll") for (int k = 0; k < 2; ++k) dst[m][k] = *(const PG8_LAS bf16x8*)(lds + PG8_SA(b, h) + aoff + m * 2048 + k * 1024); } } while (0)
#define PG8_LDB(dst, b, h) do { if (F8) { _Pragma("unroll") for (int n = 0; n < 2; ++n) dst##8[n] = PG8_LD8(lds + PG8_SB(b, h) + boff + n * 2048); } \
        else { _Pragma("unroll") for (int n = 0; n < 2; ++n) _Pragma("unroll") for (int k = 0; k < 2; ++k) dst[n][k] = *(const PG8_LAS bf16x8*)(lds + PG8_SB(b, h) + boff + n * 2048 + k * 1024); } } while (0)
#define PG8_MMA(ai, bj, At, Bt) do { __builtin_amdgcn_s_setprio(1); \
        if (F8) { _Pragma("unroll") for (int m = 0; m < 4; ++m) _Pragma("unroll") for (int n = 0; n < 2; ++n) \
            asm volatile("v_mfma_scale_f32_16x16x128_f8f6f4 %0, %1, %2, %0, %3, %4 op_sel_hi:[0,0,0]" : "+v"(acc[ai][bj][m][n]) : "v"(Bt##8[n]), "v"(At##8[m]), "v"(scb_), "v"(sca_)); } \
        else { _Pragma("unroll") for (int m = 0; m < 4; ++m) _Pragma("unroll") for (int n = 0; n < 2; ++n) _Pragma("unroll") for (int k = 0; k < 2; ++k) \
        acc[ai][bj][m][n] = __builtin_amdgcn_mfma_f32_16x16x32_bf16(Bt[n][k], At[m][k], acc[ai][bj][m][n], 0, 0, 0); } __builtin_amdgcn_s_setprio(0); } while (0)
#define PG8_WAIT_V(n) asm volatile("s_waitcnt vmcnt(" #n ")" ::: "memory")
#define PG8_WAIT_L(n) asm volatile("s_waitcnt lgkmcnt(" #n ")" ::: "memory")
#define PG8_BAR __builtin_amdgcn_s_barrier()
#define PG8_SCHED __builtin_amdgcn_sched_barrier(0)
#define PG8_AOFF(dst, u) do { _Pragma("unroll") for (int _h = 0; _h < 2; ++_h) _Pragma("unroll") for (int _i = 0; _i < 2; ++_i) dst[_h][_i] = (S.arow(u, _h * HALF + RA[_i]) * (unsigned)K + (unsigned)CA[_i]) * 2u; } while (0)
    Unit cur, nxt; int ui = 0;
    if (!S.next(0, cur)) return;
    f32x4 acc[2][2][4][2];
#pragma unroll
    for (int a = 0; a < 2; ++a)
#pragma unroll
        for (int b = 0; b < 2; ++b)
#pragma unroll
            for (int m = 0; m < 4; ++m)
#pragma unroll
                for (int n = 0; n < 2; ++n) acc[a][b][m][n] = (f32x4){0.f, 0.f, 0.f, 0.f};
    bf16x8 At[4][2], B0[2][2], B1[2][2]; v8i At8[4], B08[2], B18[2]; const int sca_ = SCA * 0x01010101, scb_ = SCB * 0x01010101;
    unsigned offc[2][2], offn[2][2];
    PG8_AOFF(offc, cur);
    const char* const cA = (const char*)g.A; const char* cB = (const char*)g.Bt + (size_t)cur.pn * tstep;
    PG8_STAGE(PG8_SB(0, 0), cB, voffB); PG8_STAGE(PG8_SB(0, 1), cB + hstep, voffB); PG8_STAGE(PG8_SA(0, 0), cA, offc[0]); PG8_STAGE(PG8_SA(0, 1), cA, offc[1]);
    if (wr == 1) PG8_BAR;
    PG8_WAIT_V(2); PG8_BAR;
    PG8_STAGE(PG8_SB(1, 0), cB + kstep, voffB); PG8_STAGE(PG8_SA(1, 0), cA + kstep, offc[0]); PG8_STAGE(PG8_SB(1, 1), cB + hstep + kstep, voffB);
    PG8_WAIT_V(6); PG8_BAR;
    for (;;) {
        const bool has_next = S.next(ui + 1, nxt);
        if (has_next) { PG8_AOFF(offn, nxt); }
        else {
#pragma unroll
            for (int h = 0; h < 2; ++h)
#pragma unroll
                for (int i = 0; i < 2; ++i) offn[h][i] = offc[h][i]; }
        const char* nB = has_next ? (const char*)g.Bt + (size_t)nxt.pn * tstep : cB;
        for (int t = 0; t < nt; t += 2) {
            const bool last = (t == nt - 2);
            const char* a1 = cA + (size_t)(t + 1) * kstep;
            const char* a2 = last ? cA : cA + (size_t)(t + 2) * kstep; const char* b2 = last ? nB : cB + (size_t)(t + 2) * kstep;
            const char* a3 = a2 + kstep; const char* b3 = b2 + kstep;
            unsigned o2[2][2];
#pragma unroll
            for (int h = 0; h < 2; ++h)
#pragma unroll
                for (int i = 0; i < 2; ++i) o2[h][i] = last ? offn[h][i] : offc[h][i];
            PG8_LDB(B0, 0, 0); PG8_LDB(B1, 0, 1); PG8_SCHED; PG8_LDA(At, 0, 0); PG8_STAGE(PG8_SA(1, 1), a1, offc[1]);
            PG8_WAIT_V(8); PG8_WAIT_L(0); PG8_BAR; PG8_MMA(0, 0, At, B0); PG8_MMA(0, 1, At, B1); PG8_BAR; PG8_SCHED;
            PG8_LDA(At, 0, 1); PG8_STAGE(PG8_SB(0, 0), b2, voffB); PG8_STAGE(PG8_SB(0, 1), b2 + hstep, voffB); PG8_STAGE(PG8_SA(0, 0), a2, o2[0]);
            PG8_WAIT_V(8); PG8_WAIT_L(0); PG8_BAR; PG8_MMA(1, 0, At, B0); PG8_MMA(1, 1, At, B1); PG8_BAR; PG8_SCHED;
            PG8_LDB(B0, 1, 0); PG8_LDB(B1, 1, 1); PG8_SCHED; PG8_LDA(At, 1, 0); PG8_STAGE(PG8_SA(0, 1), a2, o2[1]);
            PG8_WAIT_V(8); PG8_WAIT_L(0); PG8_BAR; PG8_MMA(0, 0, At, B0); PG8_MMA(0, 1, At, B1); PG8_BAR; PG8_SCHED;
            PG8_LDA(At, 1, 1); PG8_STAGE(PG8_SB(1, 0), b3, voffB); PG8_STAGE(PG8_SB(1, 1), b3 + hstep, voffB); PG8_STAGE(PG8_SA(1, 0), a3, o2[0]);
            PG8_WAIT_V(8); PG8_WAIT_L(0); PG8_BAR; PG8_MMA(1, 0, At, B0); PG8_MMA(1, 1, At, B1); PG8_BAR; PG8_SCHED;
        }
        if constexpr (ALIGN_EPI) { if (wr == 0) PG8_BAR; }
        if (F8) asm volatile("s_nop 15\n\ts_nop 15" ::: "memory");
        E(acc, cur, wr, wc, fr, fq);
        if (!has_next) break;
#pragma unroll
        for (int a = 0; a < 2; ++a)
#pragma unroll
            for (int b = 0; b < 2; ++b)
#pragma unroll
                for (int m = 0; m < 4; ++m)
#pragma unroll
                    for (int n = 0; n < 2; ++n) acc[a][b][m][n] = (f32x4){0.f, 0.f, 0.f, 0.f};
        cur = nxt; cB = nB; ++ui;
#pragma unroll
        for (int h = 0; h < 2; ++h)
#pragma unroll
            for (int i = 0; i < 2; ++i) offc[h][i] = offn[h][i];
        if constexpr (ALIGN_EPI) { if (wr == 1) PG8_BAR; }
    }
    PG8_WAIT_V(0);
    if constexpr (!ALIGN_EPI) { if (wr == 0) PG8_BAR; }
    PG8_BAR;
#undef PG8_SA
#undef PG8_SB
#undef PG8_STAGE
#undef PG8_LDA
#undef PG8_LDB
#undef PG8_MMA
#undef PG8_LD8
#undef PG8_WAIT_V
#undef PG8_WAIT_L
#undef PG8_BAR
#undef PG8_SCHED
#undef PG8_AOFF
}
}

#define XB_TMO      128
#define XB_XCNT(j)  (256  + 64 * (j))
#define XB_XSUB(j)  (1280 + 64 * (j))
#define XB_XGEN(j)  (2304 + 64 * (j))
#define XB_TOP      3328
#define XB_TOPGEN   3392
#define XCD_BAR_WORDS 3456
#define XB_SPIN_CAP (1u << 18)

__device__ __forceinline__ unsigned xb_ld(unsigned* p)              { return __hip_atomic_load(p, __ATOMIC_RELAXED, __HIP_MEMORY_SCOPE_AGENT); }
__device__ __forceinline__ unsigned xb_add(unsigned* p, unsigned v) { return __hip_atomic_fetch_add(p, v, __ATOMIC_RELAXED, __HIP_MEMORY_SCOPE_AGENT); }
__device__ __forceinline__ unsigned xb_xcc_id() { return (unsigned)__builtin_amdgcn_s_getreg((3 << 11) | 20) & 0xFu; }
#define XB_SPIN(cond, bar) do { unsigned _sp = 0; while (cond) { __builtin_amdgcn_s_sleep(1); \
    if ((++_sp & 255u) == 0u) { if (xb_ld(&(bar)[XB_TMO])) break; if (_sp > XB_SPIN_CAP) { atomicAdd(&(bar)[XB_TMO], 1u); break; } } } } while (0)

struct XcdBarrier { unsigned* bar; unsigned x; volatile LAS unsigned* st; };

__device__ __forceinline__ XcdBarrier xcd_barrier_post(unsigned* bar, volatile LAS unsigned* st) {
    XcdBarrier b; b.bar = bar; b.x = xb_xcc_id(); b.st = st;
    if (threadIdx.x == 0) (void)xb_add(&bar[XB_XCNT(b.x)], 1u);
    return b;
}
__device__ __forceinline__ void xcd_barrier_complete(unsigned* bar, unsigned x, unsigned& nloc, unsigned& nx) {
    const unsigned G = gridDim.x * gridDim.y * gridDim.z;
    unsigned sum, cnt, mine, sp = 0u;
    for (;;) {
        sum = 0u; cnt = 0u; mine = 0u;
#pragma unroll
        for (unsigned j = 0; j < 16; ++j) { const unsigned c = xb_ld(&bar[XB_XCNT(j)]); sum += c; cnt += (c > 0u) ? 1u : 0u; mine = (j == x) ? c : mine; }
        if (sum == G) break;
        __builtin_amdgcn_s_sleep(1);
        if ((++sp & 255u) == 0u) { if (xb_ld(&bar[XB_TMO])) break; if (sp > XB_SPIN_CAP) { atomicAdd(&bar[XB_TMO], 1u); break; } }
    }
    nloc = mine > 0u ? mine : 1u; nx = cnt > 0u ? cnt : 1u;
}
__device__ __forceinline__ void xcd_barrier(const XcdBarrier& b) {
    asm volatile("s_waitcnt vmcnt(0)" ::: "memory");
    __syncthreads();
    if (threadIdx.x == 0) {
        unsigned* bar = b.bar;
        __builtin_amdgcn_s_waitcnt(0);
        unsigned nloc = b.st[0], nx = b.st[1];
        if (nloc == 0u) { xcd_barrier_complete(bar, b.x, nloc, nx); b.st[0] = nloc; b.st[1] = nx; }
        const unsigned old = xb_add(&bar[XB_XSUB(b.x)], 1u);
        const unsigned gen = old / nloc;
        if (old + 1u == (gen + 1u) * nloc) {
            __builtin_amdgcn_fence(__ATOMIC_RELEASE, "agent");
            asm volatile("s_waitcnt vmcnt(0)" ::: "memory");
            const unsigned og = xb_add(&bar[XB_TOP], 1u);
            const unsigned tg = og / nx;
            if (og + 1u == (tg + 1u) * nx) xb_add(&bar[XB_TOPGEN], 1u);
            else XB_SPIN(xb_ld(&bar[XB_TOPGEN]) == tg, bar);
            __builtin_amdgcn_fence(__ATOMIC_ACQUIRE, "agent");
            xb_add(&bar[XB_XGEN(b.x)], 1u);
            asm volatile("s_waitcnt vmcnt(0)" ::: "memory");
        } else {
            XB_SPIN(xb_ld(&bar[XB_XGEN(b.x)]) == gen, bar);
            __builtin_amdgcn_fence(__ATOMIC_ACQUIRE, "agent");
            asm volatile("s_waitcnt vmcnt(0)" ::: "memory");
        }
    }
    __syncthreads();
}

template <bool F8 = false>
__device__ __forceinline__ void transpose_item(const float* W, int K, int N, bf16* WT, int kb, int nb, int dst_row0, LAS float* scr, int lane) {
    const int k0 = 64 * kb, n0 = 32 * nb;
#pragma unroll 8
    for (int i = 0; i < 32; ++i) { const int kk = 2 * i + (lane >> 5); scr[kk * 33 + (lane & 31)] = W[(size_t)(k0 + kk) * N + n0 + (lane & 31)]; }
    LDS_WAIT(); asm volatile("" ::: "memory");
    const int c = lane & 7;
#pragma unroll
    for (int j = 0; j < 4; ++j) { const int n = (lane >> 3) + 8 * j; const LAS float* s = scr + (8 * c) * 33 + n;
        if (F8) {
            int d0 = __builtin_amdgcn_cvt_pk_fp8_f32(s[0 * 33] * 32.f, s[1 * 33] * 32.f, 0, false); d0 = __builtin_amdgcn_cvt_pk_fp8_f32(s[2 * 33] * 32.f, s[3 * 33] * 32.f, d0, true);
            int d1 = __builtin_amdgcn_cvt_pk_fp8_f32(s[4 * 33] * 32.f, s[5 * 33] * 32.f, 0, false); d1 = __builtin_amdgcn_cvt_pk_fp8_f32(s[6 * 33] * 32.f, s[7 * 33] * 32.f, d1, true);
            *(GAS v2u*)((unsigned char*)WT + (size_t)(dst_row0 + n) * K + k0 + 8 * c) = (v2u){(unsigned)d0, (unsigned)d1};
        } else {
        v4u o; o.x = pk2(s[0 * 33], s[1 * 33]); o.y = pk2(s[2 * 33], s[3 * 33]); o.z = pk2(s[4 * 33], s[5 * 33]); o.w = pk2(s[6 * 33], s[7 * 33]);
        *(GAS v4u*)(WT + (size_t)(dst_row0 + n) * K + k0 + 8 * c) = o; } }
    LDS_WAIT(); asm volatile("" ::: "memory");
}
__device__ __forceinline__ void transpose_plain(const float* W, int K, int N, bf16* WT, LAS float* scr, int gw, int ngw, int lane) {
    const int nblk = N / 32, nitems = (K / 64) * nblk;
    for (int it = gw; it < nitems; it += ngw) { const int kb = it / nblk, nb = it % nblk; transpose_item(W, K, N, WT, kb, nb, 32 * nb, scr, lane); }
}
__device__ __forceinline__ void transpose_moe(const float* w1, const float* w3, const float* w2, bf16* W13T, bf16* W2T, LAS float* scr, int gw, int ngw, int lane) {
    constexpr int I13 = 16 * 16, I2 = 8 * 32, IPE = 2 * I13 + I2;
    for (int it = gw; it < NEXP * IPE; it += ngw) {
        const int e = it / IPE; int r = it % IPE;
        if (r < 2 * I13) { const int which = r / I13; r %= I13; const int kb = r / 16, nb = r % 16, n0 = 32 * nb;
            const float* W = (which ? w3 : w1) + (size_t)e * 1024 * 512;
            transpose_item<MOE_FP8 != 0>(W, 1024, 512, (bf16*)((unsigned char*)W13T + (size_t)e * 1024 * 1024 * (MOE_FP8 ? 1 : 2)), kb, nb, (n0 >> 7) * 256 + which * 128 + (n0 & 127), scr, lane);
        } else { r -= 2 * I13; const int kb = r / 32, nb = r % 32;
            transpose_item<MOE_FP8 != 0>(w2 + (size_t)e * 512 * 1024, 512, 1024, (bf16*)((unsigned char*)W2T + (size_t)e * 1024 * 512 * (MOE_FP8 ? 1 : 2)), kb, nb, 32 * nb, scr, lane); }
    }
}
__device__ __forceinline__ void rms_row(const float* xrow, const float* g, f32x4 (&v)[4], int lane) {
    const GAS f32x4* xr = (const GAS f32x4*)xrow + lane; const GAS f32x4* gr = (const GAS f32x4*)g + lane;
    float s = 0.f;
#pragma unroll
    for (int j = 0; j < 4; ++j) { v[j] = xr[64 * j]; s += (v[j].x * v[j].x + v[j].y * v[j].y) + (v[j].z * v[j].z + v[j].w * v[j].w); }
    const float rstd = 1.0f / sqrtf(wave_sum(s) * (1.f / DM) + 1e-6f);
#pragma unroll
    for (int j = 0; j < 4; ++j) { const f32x4 gg = gr[64 * j]; v[j] = v[j] * rstd * gg; }
}
__device__ __forceinline__ void rms_row_b16(const bf16* xrow, const float* g, f32x4 (&v)[4], int lane) {
    const GAS v2u* xr = (const GAS v2u*)xrow + lane; const GAS f32x4* gr = (const GAS f32x4*)g + lane;
    float s = 0.f;
#pragma unroll
    for (int j = 0; j < 4; ++j) { const v2u w = xr[64 * j]; v[j] = (f32x4){__builtin_bit_cast(float, w.x << 16), __builtin_bit_cast(float, w.x & 0xffff0000u), __builtin_bit_cast(float, w.y << 16), __builtin_bit_cast(float, w.y & 0xffff0000u)};
        s += (v[j].x * v[j].x + v[j].y * v[j].y) + (v[j].z * v[j].z + v[j].w * v[j].w); }
    const float rstd = 1.0f / sqrtf(wave_sum(s) * (1.f / DM) + 1e-6f);
#pragma unroll
    for (int j = 0; j < 4; ++j) { const f32x4 gg = gr[64 * j]; v[j] = v[j] * rstd * gg; }
}
__device__ __forceinline__ void store_row_bf16(bf16* orow, const f32x4 (&v)[4], int lane) {
    GAS unsigned long long* o8 = (GAS unsigned long long*)orow + lane;
#pragma unroll
    for (int j = 0; j < 4; ++j) o8[64 * j] = (unsigned long long)pk2(v[j].x, v[j].y) | ((unsigned long long)pk2(v[j].z, v[j].w) << 32);
}

__device__ __forceinline__ int t5_bucket(int rel) {
    const int n = rel < 0 ? -rel : rel; int ret = rel > 0 ? 16 : 0;
    int v;
    if (n < 8) v = n;
    else { const float nf = (float)n; int large = 8 + (int)(logf(nf / 8.0f) / 2.772588722239781f * 8.0f); v = large < 15 ? large : 15; }
    return ret + v;
}

__device__ __forceinline__ int crow(int r, int hi) { return (r & 3) + 8 * (r >> 2) + 4 * hi; }
__device__ __forceinline__ unsigned cvtpk(float lo, float hi) { unsigned r; asm volatile("v_cvt_pk_bf16_f32 %0, %1, %2" : "=v"(r) : "v"(lo), "v"(hi)); return r; }
__device__ __forceinline__ s16x4 vtr(const LAS char* p) { typedef short v4i16_t __attribute__((ext_vector_type(4))); return __builtin_bit_cast(s16x4, __builtin_amdgcn_ds_read_tr16_b64_v4i16((LAS v4i16_t*)p)); }

template <int DV, bool BIAS, bool FP8 = false>
__device__ __forceinline__ void attn_unit_v0(const bf16* Qp, int ldq, const bf16* Kp, int ldk, const bf16* Vp, int ldv, bf16* Op, int ldo, const LAS float* btbl, int q0, LAS unsigned char* lds) {
    const int tid = threadIdx.x, lane = tid & 63, r32 = lane & 31, hi = lane >> 5; const int wid = __builtin_amdgcn_readfirstlane(tid >> 6);
    constexpr int ND = DV / 32;
    LAS unsigned char* ldsK = lds; LAS unsigned char* ldsV = lds + 8192; LAS float* wsf = (LAS float*)(lds + 8192 + DV * 128) + wid * 64;
    bf16x8 qr[4]; v8i q8 = {0, 0, 0, 0, 0, 0, 0, 0};
    if (FP8) { const v4u a = *(const v4u*)((const unsigned char*)Qp + (size_t)(wid * 32 + r32) * ldq + hi * 32), b = *(const v4u*)((const unsigned char*)Qp + (size_t)(wid * 32 + r32) * ldq + hi * 32 + 16);
        q8 = (v8i){(int)a.x, (int)a.y, (int)a.z, (int)a.w, (int)b.x, (int)b.y, (int)b.z, (int)b.w}; }
    else {
#pragma unroll
    for (int d0 = 0; d0 < 4; ++d0) qr[d0] = *(const bf16x8*)(Qp + (size_t)(wid * 32 + r32) * ldq + d0 * 16 + hi * 8); }
    f32x16 o[ND];
#pragma unroll
    for (int d = 0; d < ND; ++d)
#pragma unroll
        for (int r = 0; r < 16; ++r) o[d][r] = 0.f;
    float l = 0.f;
    const int qpos = q0 + wid * 32 + r32;
    const LAS char* kp0 = (const LAS char*)ldsK + hi * 1024 + r32 * 16;
    const LAS char* vp0 = (const LAS char*)ldsV + ((lane >> 4) & 1) * 32 + (lane & 3) * 8 + (4 * hi + ((lane & 15) >> 2)) * 64;
    for (int t = 0; t < SEQ / 64; ++t) {
        __syncthreads();
        {
            if (FP8) { if (wid < 4) { const v4u kv = *(const v4u*)((const unsigned char*)Kp + (size_t)(t * 64 + lane) * ldk + wid * 16); *(LAS v4u*)(ldsK + wid * 1024 + lane * 16) = kv; } }
            else { const v4u kv = *(const v4u*)(Kp + (size_t)(t * 64 + lane) * ldk + wid * 8);
            *(LAS v4u*)(ldsK + wid * 1024 + lane * 16) = kv; }
#pragma unroll
            for (int pp = 0; pp < ND / 2; ++pp) { const int p = wid + 8 * pp, dq = p >> 2, rg = p & 3;
                const v4u vv = *(const v4u*)(Vp + (size_t)(t * 64 + 16 * rg + (lane >> 2)) * ldv + dq * 32 + (lane & 3) * 8);
                *(LAS v4u*)(ldsV + p * 1024 + lane * 16) = vv; }
        }
        __syncthreads();
        f32x16 p0, p1;
#pragma unroll
        for (int r = 0; r < 16; ++r) { p0[r] = 0.f; p1[r] = 0.f; }
        if (FP8) {
            const LAS char* k8 = (const LAS char*)ldsK + hi * 2048 + r32 * 16;
            const v4u a0 = *(const LAS v4u*)(k8), a1 = *(const LAS v4u*)(k8 + 1024), b0 = *(const LAS v4u*)(k8 + 512), b1 = *(const LAS v4u*)(k8 + 1024 + 512);
            const v8i ka = (v8i){(int)a0.x, (int)a0.y, (int)a0.z, (int)a0.w, (int)a1.x, (int)a1.y, (int)a1.z, (int)a1.w};
            const v8i kb = (v8i){(int)b0.x, (int)b0.y, (int)b0.z, (int)b0.w, (int)b1.x, (int)b1.y, (int)b1.z, (int)b1.w};
            p0 = __builtin_amdgcn_mfma_scale_f32_32x32x64_f8f6f4(ka, q8, p0, 0, 0, 0, 0x7f7f7f7f, 0, 0x7c7c7c7c);
            p1 = __builtin_amdgcn_mfma_scale_f32_32x32x64_f8f6f4(kb, q8, p1, 0, 0, 0, 0x7f7f7f7f, 0, 0x7c7c7c7c);
        } else {
#pragma unroll
        for (int d0 = 0; d0 < 4; ++d0) {
            const bf16x8 b0 = *(const LAS bf16x8*)(kp0 + d0 * 2048), b1 = *(const LAS bf16x8*)(kp0 + d0 * 2048 + 512);
            p0 = __builtin_amdgcn_mfma_f32_32x32x16_bf16(b0, qr[d0], p0, 0, 0, 0);
            p1 = __builtin_amdgcn_mfma_f32_32x32x16_bf16(b1, qr[d0], p1, 0, 0, 0);
        } }
        if (BIAS) {
            const int base = t * 64 + 4 * hi - qpos;
#pragma unroll
            for (int r = 0; r < 16; ++r) { int rel = base + (r & 3) + 8 * (r >> 2);
                int i0 = rel < -128 ? -128 : (rel > 128 ? 128 : rel); int rel1 = rel + 32; int i1 = rel1 < -128 ? -128 : (rel1 > 128 ? 128 : rel1);
                p0[r] += btbl[i0 + 128]; p1[r] += btbl[i1 + 128]; }
        }
        float sacc = 0.f;
#pragma unroll
        for (int r = 0; r < 16; ++r) { p0[r] = __builtin_amdgcn_exp2f(p0[r]); p1[r] = __builtin_amdgcn_exp2f(p1[r]); sacc += p0[r] + p1[r]; }
        l += sacc;
        v4u pw[4];
#pragma unroll
        for (int k = 0; k < 2; ++k) {
            pw[k]     = (v4u){cvtpk(p0[8 * k + 0], p0[8 * k + 1]), cvtpk(p0[8 * k + 2], p0[8 * k + 3]), cvtpk(p0[8 * k + 4], p0[8 * k + 5]), cvtpk(p0[8 * k + 6], p0[8 * k + 7])};
            pw[2 + k] = (v4u){cvtpk(p1[8 * k + 0], p1[8 * k + 1]), cvtpk(p1[8 * k + 2], p1[8 * k + 3]), cvtpk(p1[8 * k + 4], p1[8 * k + 5]), cvtpk(p1[8 * k + 6], p1[8 * k + 7])};
        }
#pragma unroll
        for (int d0 = 0; d0 < ND; ++d0)
#pragma unroll
            for (int ks = 0; ks < 4; ++ks) {
                const s16x4 lo = vtr(vp0 + d0 * 4096 + ks * 1024), hh = vtr(vp0 + d0 * 4096 + ks * 1024 + 512);
                const bf16x8 vf = (bf16x8){lo[0], lo[1], lo[2], lo[3], hh[0], hh[1], hh[2], hh[3]};
                o[d0] = __builtin_amdgcn_mfma_f32_32x32x16_bf16(__builtin_bit_cast(bf16x8, pw[ks]), vf, o[d0], 0, 0, 0);
            }
    }
    l += __shfl_xor(l, 32);
    if (hi == 0) wsf[r32] = l;
    LDS_WAIT(); asm volatile("" ::: "memory");
#pragma unroll
    for (int r = 0; r < 16; ++r) { const int row = crow(r, hi); const float rl = 1.0f / wsf[row];
#pragma unroll
        for (int d0 = 0; d0 < ND; ++d0) Op[(size_t)(wid * 32 + row) * ldo + d0 * 32 + r32] = (bf16)f2bf(o[d0][r] * rl); }
    LDS_WAIT();
}

namespace at1 {
#define SBAR() __builtin_amdgcn_sched_barrier(0)
#define PIN(x) asm volatile("" : "+v"(x))
template <int N, bool NOBAR = false> __device__ __forceinline__ void wait_bar() { if (NOBAR) asm volatile("s_waitcnt vmcnt(%0) lgkmcnt(0)" :: "n"(N) : "memory"); else asm volatile("s_waitcnt vmcnt(%0) lgkmcnt(0)\n\ts_barrier" :: "n"(N) : "memory"); }
__device__ __forceinline__ void glds16(const void* gsrc, unsigned lds_dst) { unsigned keep;
    asm volatile("s_mov_b32 %0, m0\n\ts_mov_b32 m0, %2\n\ts_nop 0\n\tglobal_load_lds_dwordx4 %1, off\n\ts_mov_b32 m0, %0" : "=&s"(keep) : "v"(gsrc), "s"(lds_dst) : "memory"); }
typedef float f32x2_t __attribute__((ext_vector_type(2))); typedef __bf16 bf16x2_t __attribute__((ext_vector_type(2)));
__device__ __forceinline__ unsigned cvtpk_s(float lo, float hi) { f32x2_t v = {lo, hi}; bf16x2_t b = __builtin_convertvector(v, bf16x2_t); return __builtin_bit_cast(unsigned, b); }
typedef const LAS char* lds_cptr;
__device__ __forceinline__ void kload2(bf16x8* kf, lds_cptr kp, int j) { kf[2 * j] = *(const LAS bf16x8*)(kp + j * 2048); kf[2 * j + 1] = *(const LAS bf16x8*)(kp + j * 2048 + 512); }

template <int DV, bool FP8> __host__ __device__ constexpr int lds_ws_off() { return (3 * (FP8 ? 4096 : 8192) + 3 * DV * 128) > 512 * DV ? (3 * (FP8 ? 4096 : 8192) + 3 * DV * 128) : 512 * DV; }
template <int DV, bool FP8> __host__ __device__ constexpr int lds_tbl_off() { return lds_ws_off<DV, FP8>() + 2048; }
template <int DV, bool BIAS, int TEST = 0, int MODE = 0, bool FP8 = false, bool TILED = false>
__device__ __forceinline__ void attn_unit(const bf16* Qp, int ldq, const bf16* __restrict__ Kp, int ldk, const bf16* __restrict__ Vp, int ldv, bf16* Op, int ldo, int q0, LAS unsigned char* lds, const LAS float* sgt = nullptr) {
    constexpr int ND = DV / 32, NV = ND / 2, VSLOT = DV * 128, KSLOT = FP8 ? 4096 : 8192, NT = SEQ / 64;
    constexpr int LDS_K = 0, LDS_V = 3 * KSLOT, LDS_WS = lds_ws_off<DV, FP8>(), LDS_TBL = LDS_WS + 2048;
    static_assert(LDS_WS >= LDS_V + 3 * VSLOT && LDS_WS >= 512 * DV && LDS_TBL + 2048 <= STASH_OFF, "LDS map");
    const int tid = threadIdx.x, lane = tid & 63, r32 = lane & 31, hi = lane >> 5; const int wid = __builtin_amdgcn_readfirstlane(tid >> 6);
    const unsigned lds0 = (unsigned)(uintptr_t)lds;
    LAS float* wsf = (LAS float*)(lds + LDS_WS) + wid * 64;
    const LAS float* btbl = (const LAS float*)(lds + LDS_TBL);
    const unsigned char* ksrc = TILED ? (const unsigned char*)Kp + (wid & 3) * 1024 + lane * 16 : FP8 ? (const unsigned char*)Kp + (size_t)lane * ldk + (wid & 3) * 16 : (const unsigned char*)(Kp + (size_t)lane * ldk + wid * 8);
    const bf16* vsrc0 = TILED ? Vp + wid * 512 + lane * 8 : Vp + (size_t)(16 * (wid & 3) + (lane >> 2)) * ldv + (wid >> 2) * 32 + (lane & 3) * 8;
    const bf16* vsrc1 = TILED ? vsrc0 + 4096 : vsrc0 + 64;
    const unsigned kdst = lds0 + LDS_K + wid * 1024, vdst = lds0 + LDS_V + wid * 1024;
#define DMA_K(t, s) if (!(TEST & 8) && (!FP8 || wid < 4)) glds16(ksrc + (size_t)(t) * (TILED ? 4096 : 64 * ldk * (FP8 ? 1 : 2)), (unsigned)__builtin_amdgcn_readfirstlane(kdst + (s) * KSLOT))
#define DMA_V(t, s) do { if (TEST & 8) break; glds16(vsrc0 + (size_t)(t) * (TILED ? (size_t)(DV * 64) : (size_t)64 * ldv), (unsigned)__builtin_amdgcn_readfirstlane(vdst + (s) * VSLOT)); \
        if (NV == 2) glds16(vsrc1 + (size_t)(t) * (TILED ? (size_t)(DV * 64) : (size_t)64 * ldv), (unsigned)__builtin_amdgcn_readfirstlane(vdst + (s) * VSLOT + 8192)); } while (0)
    const lds_cptr kp0 = (lds_cptr)lds + LDS_K + hi * (FP8 ? 2048 : 1024) + r32 * 16;
    const lds_cptr vp0 = (lds_cptr)lds + LDS_V + ((lane >> 4) & 1) * 32 + (lane & 3) * 8 + (4 * hi + ((lane & 15) >> 2)) * 64;
    DMA_K(0, 0); DMA_V(0, 0); DMA_K(1, 1);
    bf16x8 qr[4]; v8i q8 = {0, 0, 0, 0, 0, 0, 0, 0};
    if (FP8) { const unsigned char* qb_ = (const unsigned char*)Qp + (size_t)(wid * 32 + r32) * ldq + hi * 32; const v4u a = *(const v4u*)qb_, b = *(const v4u*)(qb_ + 16);
        q8 = (v8i){(int)a.x, (int)a.y, (int)a.z, (int)a.w, (int)b.x, (int)b.y, (int)b.z, (int)b.w}; }
    else {
#pragma unroll
        for (int d0 = 0; d0 < 4; ++d0) qr[d0] = *(const bf16x8*)(Qp + (size_t)(wid * 32 + r32) * ldq + d0 * 16 + hi * 8); }
    float l_reg = 0.f; f32x16 o[ND];
#pragma unroll
    for (int d = 0; d < ND; ++d) o[d] = f32x16{};
    const f32x16 zero16 = f32x16{};
    const int qw = q0 + wid * 32, qpos = qw + r32;
    int tl = 0, tr = NT; float fL = 1.f;
    if (BIAS) { tl = (qw - 191 >= 0) ? ((qw - 191) >> 6) + 1 : 0; tr = (qw + 158) >> 6; fL = __builtin_amdgcn_exp2f(btbl[0]); }
    f32x16 pA0, pA1, pB0, pB1; bf16x8 kf[8]; v8i kf8[2]; s16x4 vlo[8], vhi[8]; v4u pw0, pw1, pw2, pw3;
#define KLOAD8(n, kp_) do { const v4u a_ = *(const LAS v4u*)((kp_) + (n) * 512), b_ = *(const LAS v4u*)((kp_) + (n) * 512 + 1024); kf8[n] = (v8i){(int)a_.x, (int)a_.y, (int)a_.z, (int)a_.w, (int)b_.x, (int)b_.y, (int)b_.z, (int)b_.w}; } while (0)
#define MF8(kf_, c_) __builtin_amdgcn_mfma_scale_f32_32x32x64_f8f6f4(kf_, q8, c_, 0, 0, 0, 0x7f7f7f7f, 0, 0x7c7c7c7c)
#define WAITB(N) do { if (FP8 && wid >= 4) wait_bar<(N) - 1, (TEST & 16) != 0>(); else wait_bar<(N), (TEST & 16) != 0>(); } while (0)
    if (TEST & 32) { pB0 = f32x16{}; pB1 = f32x16{}; }
    if (TEST & 64) { _Pragma("unroll") for (int i_ = 0; i_ < 8; ++i_) { vlo[i_] = (s16x4){1, 2, 3, 4}; vhi[i_] = (s16x4){4, 3, 2, 1}; } }
    int s_prev = 0, s_cur = 0, s_next = 1;
#define ROT() do { s_prev = s_cur; s_cur = s_next; s_next = (s_next == 2) ? 0 : s_next + 1; } while (0)
#define ADD_BIAS(C0, C1, t) do { if (BIAS && (t) >= tl && (t) <= tr) { const int base_ = (t) * 64 + 4 * hi - qpos; \
        _Pragma("unroll") for (int r = 0; r < 16; ++r) { const int rel0 = base_ + (r & 3) + 8 * (r >> 2); const int rel1 = rel0 + 32; \
            const int i0 = (rel0 < -128 ? -128 : (rel0 > 128 ? 128 : rel0)) + 128, i1 = (rel1 < -128 ? -128 : (rel1 > 128 ? 128 : rel1)) + 128; \
            C0[r] += btbl[i0]; C1[r] += btbl[i1]; } } } while (0)
    DMA_K(2, 2);
    if (FP8) wait_bar<0, (TEST & 16) != 0>(); else wait_bar<NV + 2, (TEST & 16) != 0>();
    {
        if (FP8) { KLOAD8(0, kp0); KLOAD8(1, kp0); pA0 = MF8(kf8[0], zero16); pA1 = MF8(kf8[1], zero16); }
        else {
#pragma unroll
        for (int j = 0; j < 4; ++j) kload2(kf, kp0, j);
        pA0 = __builtin_amdgcn_mfma_f32_32x32x16_bf16(kf[0], qr[0], zero16, 0, 0, 0); pA1 = __builtin_amdgcn_mfma_f32_32x32x16_bf16(kf[1], qr[0], zero16, 0, 0, 0);
#pragma unroll
        for (int d0 = 1; d0 < 4; ++d0) { pA0 = __builtin_amdgcn_mfma_f32_32x32x16_bf16(kf[2 * d0], qr[d0], pA0, 0, 0, 0); pA1 = __builtin_amdgcn_mfma_f32_32x32x16_bf16(kf[2 * d0 + 1], qr[d0], pA1, 0, 0, 0); } }
        ADD_BIAS(pA0, pA1, 0);
#pragma unroll
        for (int r = 0; r < 16; ++r) { pA0[r] = __builtin_amdgcn_exp2f(pA0[r]); pA1[r] = __builtin_amdgcn_exp2f(pA1[r]); }
    }
    wait_bar<0, (TEST & 16) != 0>();
    DMA_K(3, 0); DMA_V(1, 1);
    ROT();
    if (FP8) { KLOAD8(0, kp0 + s_cur * KSLOT); KLOAD8(1, kp0 + s_cur * KSLOT); }
    else {
#pragma unroll
    for (int j = 0; j < 4; ++j) kload2(kf, kp0 + s_cur * KSLOT, j); }
    WAITB(1 + NV);
#define PKW(P, B) ((TEST & 256) ? 0x3f803f80u : cvtpk_s(P[B], P[B + 1]))
#define PAF(k) __builtin_bit_cast(bf16x8, pw##k)
#define VFR(i) (bf16x8){vlo[i][0], vlo[i][1], vlo[i][2], vlo[i][3], vhi[i][0], vhi[i][1], vhi[i][2], vhi[i][3]}
#define MF(a, b, c) __builtin_amdgcn_mfma_f32_32x32x16_bf16(a, b, c, 0, 0, 0)
#define GAPA(MFS, A0, A1, A2, A3, W0, W1, PW) do { if (!(TEST & 32)) { MFS; } if (!(TEST & 2)) { sacc += A0; sacc += A1; sacc += A2; sacc += A3; PIN(sacc); } W0; W1; PIN(PW); SBAR(); } while (0)
#define EX(v) ((TEST & 1) ? (v) : __builtin_amdgcn_exp2f(v))
#define GAPB4(MFS, X, B) do { if (!(TEST & 4)) { MFS; } X[B] = EX(X[B]); X[B + 1] = EX(X[B + 1]); X[B + 2] = EX(X[B + 2]); X[B + 3] = EX(X[B + 3]); PIN(X); SBAR(); } while (0)
#define GAPB2(MFS, X, B) do { if (!(TEST & 4)) { MFS; } X[B] = EX(X[B]); X[B + 1] = EX(X[B + 1]); PIN(X); SBAR(); } while (0)
#define VRD(f, s) do { if (TEST & 64) break; vlo[s] = vtr(vp_ + (((f) >> 2) * 4096 + ((f) & 3) * 1024)); vhi[s] = vtr(vp_ + (((f) >> 2) * 4096 + ((f) & 3) * 1024 + 512)); } while (0)
#define KRD(G, j) do { if ((G) && !(TEST & 128)) { if (FP8) { if ((j) < 2) { KLOAD8(j, kp0 + s_next * KSLOT); } } else kload2(kf, kp0 + s_next * KSLOT, j); SBAR(); } } while (0)
#define FO(m) (ND == 2 ? (((m) >> 1) + 4 * ((m) & 1)) : ((((m) & 7) >> 2) + 2 * ((m) >> 3) + 4 * ((m) & 3)))
#define STEP(C0, C1, P0, P1, t, GK, GV, GL) do { SBAR(); \
    const lds_cptr vp_ = vp0 + s_prev * VSLOT; float sacc; \
    if (FP8) { \
      VRD(FO(0), 0); VRD(FO(1), 1); VRD(FO(2), 2); VRD(FO(3), 3); SBAR(); \
      if (!(TEST & 32)) C0 = MF8(kf8[0], zero16); \
      SBAR();   \
      float sa_ = P0[0] + P0[1], sb_ = P0[2] + P0[3], sc_ = P0[4] + P0[5], sd_ = P0[6] + P0[7]; \
      if (!(TEST & 2)) { sa_ += P0[8]; sb_ += P0[9]; sc_ += P0[10]; sd_ += P0[11]; sa_ += P0[12]; sb_ += P0[13]; sc_ += P0[14]; sd_ += P0[15]; } \
      pw0 = (v4u){PKW(P0, 0), PKW(P0, 2), PKW(P0, 4), PKW(P0, 6)}; pw1 = (v4u){PKW(P0, 8), PKW(P0, 10), PKW(P0, 12), PKW(P0, 14)}; PIN(pw0); PIN(pw1); SBAR(); \
      VRD(FO(4), 4); VRD(FO(5), 5); VRD(FO(6), 6); VRD(FO(7), 7); SBAR(); \
      if (!(TEST & 32)) C1 = MF8(kf8[1], zero16); \
      SBAR(); \
      if (!(TEST & 2)) { sa_ += P1[0]; sb_ += P1[1]; sc_ += P1[2]; sd_ += P1[3]; sa_ += P1[4]; sb_ += P1[5]; sc_ += P1[6]; sd_ += P1[7]; \
                         sa_ += P1[8]; sb_ += P1[9]; sc_ += P1[10]; sd_ += P1[11]; sa_ += P1[12]; sb_ += P1[13]; sc_ += P1[14]; sd_ += P1[15]; } \
      sacc = (sa_ + sb_) + (sc_ + sd_); PIN(sacc); \
      pw2 = (v4u){PKW(P1, 0), PKW(P1, 2), PKW(P1, 4), PKW(P1, 6)}; pw3 = (v4u){PKW(P1, 8), PKW(P1, 10), PKW(P1, 12), PKW(P1, 14)}; PIN(pw2); PIN(pw3); SBAR(); \
    } else { \
    VRD(FO(0), 0); SBAR(); sacc = (P0[0] + P0[1]); \
    GAPA(C0 = MF(kf[0], qr[0], zero16), P0[2], P0[3], P0[4], P0[5],     pw0[0] = PKW(P0, 0), pw0[1] = PKW(P0, 2), pw0); \
    VRD(FO(1), 1); SBAR(); GAPA(C1 = MF(kf[1], qr[0], zero16), P0[6], P0[7], P0[8], P0[9],     pw0[2] = PKW(P0, 4), pw0[3] = PKW(P0, 6), pw0); \
    VRD(FO(2), 2); SBAR(); GAPA(C0 = MF(kf[2], qr[1], C0),   P0[10], P0[11], P0[12], P0[13], pw1[0] = PKW(P0, 8), pw1[1] = PKW(P0, 10), pw1); \
    VRD(FO(3), 3); SBAR(); GAPA(C1 = MF(kf[3], qr[1], C1),   P0[14], P0[15], P1[0], P1[1],   pw1[2] = PKW(P0, 12), pw1[3] = PKW(P0, 14), pw1); \
    VRD(FO(4), 4); SBAR(); GAPA(C0 = MF(kf[4], qr[2], C0),   P1[2], P1[3], P1[4], P1[5],     pw2[0] = PKW(P1, 0), pw2[1] = PKW(P1, 2), pw2); \
    VRD(FO(5), 5); SBAR(); GAPA(C1 = MF(kf[5], qr[2], C1),   P1[6], P1[7], P1[8], P1[9],     pw2[2] = PKW(P1, 4), pw2[3] = PKW(P1, 6), pw2); \
    VRD(FO(6), 6); SBAR(); GAPA(C0 = MF(kf[6], qr[3], C0),   P1[10], P1[11], P1[12], P1[13], pw3[0] = PKW(P1, 8), pw3[1] = PKW(P1, 10), pw3); \
    VRD(FO(7), 7); SBAR(); GAPA(C1 = MF(kf[7], qr[3], C1),   P1[14], P1[15], 0.f, 0.f,       pw3[2] = PKW(P1, 12), pw3[3] = PKW(P1, 14), pw3); \
    } \
    l_reg += sacc; \
    if (GK) { DMA_K((t) + 3, s_cur); } if (GV) { DMA_V((t) + 1, s_next); } \
    ADD_BIAS(C0, C1, t); \
    SBAR(); \
    if (ND == 2) { \
        GAPB4(o[0] = MF(PAF(0), VFR(0), o[0]), C0, 0); \
        GAPB4(o[1] = MF(PAF(0), VFR(1), o[1]), C0, 4); \
        KRD(GL, 0); GAPB4(o[0] = MF(PAF(1), VFR(2), o[0]), C0, 8); \
        KRD(GL, 1); GAPB4(o[1] = MF(PAF(1), VFR(3), o[1]), C0, 12); \
        KRD(GL, 2); GAPB4(o[0] = MF(PAF(2), VFR(4), o[0]), C1, 0); \
        KRD(GL, 3); GAPB4(o[1] = MF(PAF(2), VFR(5), o[1]), C1, 4); \
        GAPB4(o[0] = MF(PAF(3), VFR(6), o[0]), C1, 8); \
        GAPB4(o[1] = MF(PAF(3), VFR(7), o[1]), C1, 12); \
    } else { \
        GAPB2(o[0] = MF(PAF(0), VFR(0), o[0]), C0, 0);  VRD(FO(8), 0); SBAR(); \
        GAPB2(o[1] = MF(PAF(0), VFR(1), o[1]), C0, 2);  VRD(FO(9), 1); SBAR(); \
        GAPB2(o[ND - 2] = MF(PAF(0), VFR(2), o[ND - 2]), C0, 4);  VRD(FO(10), 2); SBAR(); \
        GAPB2(o[ND - 1] = MF(PAF(0), VFR(3), o[ND - 1]), C0, 6);  VRD(FO(11), 3); SBAR(); \
        GAPB2(o[0] = MF(PAF(1), VFR(4), o[0]), C0, 8);  VRD(FO(12), 4); SBAR(); \
        GAPB2(o[1] = MF(PAF(1), VFR(5), o[1]), C0, 10); VRD(FO(13), 5); SBAR(); \
        GAPB2(o[ND - 2] = MF(PAF(1), VFR(6), o[ND - 2]), C0, 12); VRD(FO(14), 6); SBAR(); \
        GAPB2(o[ND - 1] = MF(PAF(1), VFR(7), o[ND - 1]), C0, 14); VRD(FO(15), 7); SBAR(); \
        KRD(GL, 0); GAPB2(o[0] = MF(PAF(2), VFR(0), o[0]), C1, 0); \
        GAPB2(o[1] = MF(PAF(2), VFR(1), o[1]), C1, 2); \
        KRD(GL, 1); GAPB2(o[ND - 2] = MF(PAF(2), VFR(2), o[ND - 2]), C1, 4); \
        GAPB2(o[ND - 1] = MF(PAF(2), VFR(3), o[ND - 1]), C1, 6); \
        KRD(GL, 2); GAPB2(o[0] = MF(PAF(3), VFR(4), o[0]), C1, 8); \
        GAPB2(o[1] = MF(PAF(3), VFR(5), o[1]), C1, 10); \
        KRD(GL, 3); GAPB2(o[ND - 2] = MF(PAF(3), VFR(6), o[ND - 2]), C1, 12); \
        GAPB2(o[ND - 1] = MF(PAF(3), VFR(7), o[ND - 1]), C1, 14); \
    } \
    if (BIAS && (t) == tl) { l_reg *= fL; _Pragma("unroll") for (int d_ = 0; d_ < ND; ++d_) _Pragma("unroll") for (int r = 0; r < 16; ++r) o[d_][r] *= fL; } \
    } while (0)
    int t = 1;
    for (; t + 4 < NT; t += 2) {
        STEP(pB0, pB1, pA0, pA1, t, true, true, true);       WAITB(1 + NV); ROT();
        STEP(pA0, pA1, pB0, pB1, t + 1, true, true, true);   WAITB(1 + NV); ROT();
    }
    STEP(pB0, pB1, pA0, pA1, NT - 3, false, true, true);  wait_bar<NV, (TEST & 16) != 0>(); ROT();
    STEP(pA0, pA1, pB0, pB1, NT - 2, false, true, true);  wait_bar<0, (TEST & 16) != 0>();  ROT();
    STEP(pB0, pB1, pA0, pA1, NT - 1, false, false, false);
    {
        float sacc = pB0[0] + pB0[1];
#pragma unroll
        for (int r = 2; r < 16; ++r) sacc += pB0[r];
#pragma unroll
        for (int r = 0; r < 16; ++r) sacc += pB1[r];
        l_reg += sacc;
        pw0 = (v4u){PKW(pB0, 0), PKW(pB0, 2), PKW(pB0, 4), PKW(pB0, 6)}; pw1 = (v4u){PKW(pB0, 8), PKW(pB0, 10), PKW(pB0, 12), PKW(pB0, 14)};
        pw2 = (v4u){PKW(pB1, 0), PKW(pB1, 2), PKW(pB1, 4), PKW(pB1, 6)}; pw3 = (v4u){PKW(pB1, 8), PKW(pB1, 10), PKW(pB1, 12), PKW(pB1, 14)};
        const lds_cptr vp_ = vp0 + s_cur * VSLOT;
#pragma unroll
        for (int d0 = 0; d0 < ND; ++d0) {
            s16x4 a0 = vtr(vp_ + d0 * 4096), b0 = vtr(vp_ + d0 * 4096 + 512), a1 = vtr(vp_ + d0 * 4096 + 1024), b1 = vtr(vp_ + d0 * 4096 + 1536);
            s16x4 a2 = vtr(vp_ + d0 * 4096 + 2048), b2 = vtr(vp_ + d0 * 4096 + 2560), a3 = vtr(vp_ + d0 * 4096 + 3072), b3 = vtr(vp_ + d0 * 4096 + 3584);
            o[d0] = MF(PAF(0), ((bf16x8){a0[0], a0[1], a0[2], a0[3], b0[0], b0[1], b0[2], b0[3]}), o[d0]);
            o[d0] = MF(PAF(1), ((bf16x8){a1[0], a1[1], a1[2], a1[3], b1[0], b1[1], b1[2], b1[3]}), o[d0]);
            o[d0] = MF(PAF(2), ((bf16x8){a2[0], a2[1], a2[2], a2[3], b2[0], b2[1], b2[2], b2[3]}), o[d0]);
            o[d0] = MF(PAF(3), ((bf16x8){a3[0], a3[1], a3[2], a3[3], b3[0], b3[1], b3[2], b3[3]}), o[d0]);
        }
    }
    l_reg += __shfl_xor(l_reg, 32);
    int lane_e = lane; asm volatile("" : "+v"(lane_e));
    const int r32e = lane_e & 31, hie = lane_e >> 5;
    if (hie == 0) wsf[r32e] = l_reg;
    asm volatile("s_waitcnt lgkmcnt(0)\n\ts_barrier" ::: "memory");
    {
        LAS bf16* stg = (LAS bf16*)(MODE == 1 ? lds + STASH_OFF : lds) + wid * (32 * DV);
#pragma unroll
        for (int r = 0; r < 16; ++r) { const int orow = crow(r, hie); const float rl = __builtin_amdgcn_rcpf(wsf[orow]);
#pragma unroll
            for (int d0 = 0; d0 < ND; ++d0) stg[orow * DV + d0 * 32 + r32e] = (bf16)f2bf(o[d0][r] * rl); }
        asm volatile("s_waitcnt lgkmcnt(0)" ::: "memory");
        if (MODE == 0) {
            constexpr int CPR = DV / 8;
#pragma unroll
            for (int i = 0; i < (32 * CPR) / 64; ++i) { const int row = i * (64 / CPR) + lane_e / CPR, ch = lane_e % CPR;
                const v4u v = *(const LAS v4u*)(stg + row * DV + ch * 8); *(v4u*)(Op + (size_t)(wid * 32 + row) * ldo + ch * 8) = v; }
        } else if (MODE == 2) {
            const int row = lane_e >> 1, half = lane_e & 1; const float lam = sgt[128];
            const LAS bf16* s1 = stg + row * DV + half * 64; const LAS bf16* s0 = (const LAS bf16*)(lds + STASH_OFF) + wid * (32 * DV) + row * DV + half * 64;
            float ov[64]; float ss = 0.f;
#pragma unroll
            for (int q = 0; q < 8; ++q) { const v4u a = *(const LAS v4u*)(s0 + q * 8), c = *(const LAS v4u*)(s1 + q * 8);
#pragma unroll
                for (int j = 0; j < 4; ++j) { const float lo = __builtin_bit_cast(float, a[j] << 16) - lam * __builtin_bit_cast(float, c[j] << 16);
                    const float hh = __builtin_bit_cast(float, a[j] & 0xffff0000u) - lam * __builtin_bit_cast(float, c[j] & 0xffff0000u);
                    ov[q * 8 + 2 * j] = lo; ov[q * 8 + 2 * j + 1] = hh; ss += lo * lo + hh * hh; } }
            ss += dpp_mov<0xB1>(ss);
            const float rstd = 1.0f / sqrtf(ss * (1.f / 128.f) + 1e-5f);
            bf16* yo = Op + (size_t)(wid * 32 + row) * ldo + half * 64;
#pragma unroll
            for (int q = 0; q < 8; ++q) { const f32x4 g0 = *(const LAS f32x4*)(sgt + half * 64 + q * 8), g1 = *(const LAS f32x4*)(sgt + half * 64 + q * 8 + 4);
                v4u w; w.x = pk2(ov[q * 8] * rstd * g0.x, ov[q * 8 + 1] * rstd * g0.y); w.y = pk2(ov[q * 8 + 2] * rstd * g0.z, ov[q * 8 + 3] * rstd * g0.w);
                w.z = pk2(ov[q * 8 + 4] * rstd * g1.x, ov[q * 8 + 5] * rstd * g1.y); w.w = pk2(ov[q * 8 + 6] * rstd * g1.z, ov[q * 8 + 7] * rstd * g1.w);
                *(v4u*)(yo + q * 8) = w; }
        }
    }
    asm volatile("s_waitcnt lgkmcnt(0)\n\ts_barrier" ::: "memory");
#undef KLOAD8
#undef MF8
#undef WAITB
#undef DMA_K
#undef DMA_V
#undef ROT
#undef ADD_BIAS
#undef PKW
#undef PAF
#undef VFR
#undef MF
#undef GAPA
#undef EX
#undef GAPB4
#undef GAPB2
#undef VRD
#undef KRD
#undef FO
#undef STEP
}
#undef SBAR
#undef PIN
}

namespace at3 {
#define SBAR() __builtin_amdgcn_sched_barrier(0)
#define PIN(x) asm volatile("" : "+v"(x))
using at1::glds16; using at1::wait_bar;
typedef const LAS char* lds_cptr; typedef short v2s __attribute__((ext_vector_type(2)));
template <int DV> __host__ __device__ constexpr int lds_ws_off() { return (3 * 4096 + 3 * DV * 64) > 512 * DV ? (3 * 4096 + 3 * DV * 64) : 512 * DV; }
template <int DV> __host__ __device__ constexpr int lds_tbl_off() { return lds_ws_off<DV>() + 2048; }
__device__ __forceinline__ void waitb(int n) { if (n == 0) wait_bar<0>(); else if (n == 1) wait_bar<1>(); else wait_bar<2>(); }
__device__ __forceinline__ v8i ld_frag(lds_cptr p, int second) { const v4u a = *(const LAS v4u*)p, b = *(const LAS v4u*)(p + second); return (v8i){(int)a.x, (int)a.y, (int)a.z, (int)a.w, (int)b.x, (int)b.y, (int)b.z, (int)b.w}; }

template <int DV, bool BIAS, int MODE>
__device__ __forceinline__ void attn_unit(const unsigned char* Qp, int ldq, const unsigned char* __restrict__ K8T, const unsigned char* __restrict__ V8T, bf16* Op, int ldo, int q0, LAS unsigned char* lds, const LAS float* sgt) {
    constexpr int ND = DV / 32, VT = DV * 64, KT = 4096, NT = SEQ / 64, NVP = VT / 1024;
    constexpr int LDS_K = 0, LDS_V = 3 * KT, LDS_WS = lds_ws_off<DV>(), LDS_TBL = LDS_WS + 2048;
    static_assert(LDS_WS >= LDS_V + 3 * VT && LDS_WS >= 512 * DV && LDS_TBL + 2048 <= STASH_OFF, "LDS map");
    const int tid = threadIdx.x, lane = tid & 63, r32 = lane & 31, hi = lane >> 5; const int wid = __builtin_amdgcn_readfirstlane(tid >> 6);
    const unsigned lds0 = (unsigned)(uintptr_t)lds;
    LAS float* wsf = (LAS float*)(lds + LDS_WS) + wid * 64;
    const LAS float* btbl = (const LAS float*)(lds + LDS_TBL);
    const bool doK = wid < 4, doV = (NVP == 8) || wid >= 4; const int vpc = (NVP == 8) ? wid : (wid & 3);
    const unsigned char* ksrc = K8T + (wid & 3) * 1024 + lane * 16; const unsigned char* vsrc = V8T + vpc * 1024 + lane * 16;
    const unsigned kdst = lds0 + LDS_K + (wid & 3) * 1024, vdst = lds0 + LDS_V + vpc * 1024;
    const int ndma = (doK ? 1 : 0) + (doV ? 1 : 0);
#define DMA_K(t, s) do { if (doK) glds16(ksrc + (size_t)(t) * KT, (unsigned)__builtin_amdgcn_readfirstlane(kdst + (s) * KT)); } while (0)
#define DMA_V(t, s) do { if (doV) glds16(vsrc + (size_t)(t) * VT, (unsigned)__builtin_amdgcn_readfirstlane(vdst + (s) * VT)); } while (0)
    const lds_cptr kp0 = (lds_cptr)lds + LDS_K + hi * 2048 + r32 * 16;
    const lds_cptr vq0 = (lds_cptr)lds + LDS_V + hi * (2 * DV * 16) + r32 * 16;
    DMA_K(0, 0); DMA_V(0, 0); DMA_K(1, 1);
    v8i q8;
    { const unsigned char* qb_ = Qp + (size_t)(wid * 32 + r32) * ldq + hi * 32; const v4u a = *(const v4u*)qb_, b = *(const v4u*)(qb_ + 16);
      q8 = (v8i){(int)a.x, (int)a.y, (int)a.z, (int)a.w, (int)b.x, (int)b.y, (int)b.z, (int)b.w}; }
    f32x16 lacc = f32x16{}; f32x16 o[ND];
#pragma unroll
    for (int d = 0; d < ND; ++d) o[d] = f32x16{};
    const f32x16 zero16 = f32x16{};
    const v8i ones8 = {0x38383838, 0x38383838, 0x38383838, 0x38383838, 0x38383838, 0x38383838, 0x38383838, 0x38383838};
    const int qw = q0 + wid * 32, qpos = qw + r32;
    int tl = 0, tr = NT; float fL = 1.f;
    if (BIAS) { tl = (qw - 191 >= 0) ? ((qw - 191) >> 6) + 1 : 0; tr = (qw + 158) >> 6; fL = __builtin_amdgcn_exp2f(btbl[0]); }
    f32x16 pA0, pA1, pB0, pB1; v8i kf8[2]; v8i vf[ND]; v8i pa; int sb = 127;
    int s_prev = 0, s_cur = 0, s_next = 1;
#define ROT() do { s_prev = s_cur; s_cur = s_next; s_next = (s_next == 2) ? 0 : s_next + 1; } while (0)
#define MFQK(kf_) __builtin_amdgcn_mfma_scale_f32_32x32x64_f8f6f4(kf_, q8, zero16, 0, 0, 0, 0x7f7f7f7f, 0, 0x7c7c7c7c)
#define MFPV(d_) o[d_] = __builtin_amdgcn_mfma_scale_f32_32x32x64_f8f6f4(pa, vf[d_], o[d_], 0, 0, 0, sb, 0, 0x7f7f7f7f)
#define MFSUM() lacc = __builtin_amdgcn_mfma_scale_f32_32x32x64_f8f6f4(pa, ones8, lacc, 0, 0, 0, sb, 0, 0x7f7f7f7f)
#define ADD_BIAS(C0, C1, t) do { if (BIAS && (t) >= tl && (t) <= tr) { const int base_ = (t) * 64 + 4 * hi - qpos; \
        _Pragma("unroll") for (int r = 0; r < 16; ++r) { const int rel0 = base_ + (r & 3) + 8 * (r >> 2); const int rel1 = rel0 + 32; \
            const int i0 = (rel0 < -128 ? -128 : (rel0 > 128 ? 128 : rel0)) + 128, i1 = (rel1 < -128 ? -128 : (rel1 > 128 ? 128 : rel1)) + 128; \
            C0[r] += btbl[i0]; C1[r] += btbl[i1]; } } } while (0)
#define MX3(a, b, c) __builtin_fmaxf(__builtin_fmaxf((a), (b)), (c))
#define PMAX(P0, P1) do { float a_ = MX3(P0[0], P0[1], P1[0]), b_ = MX3(P0[2], P0[3], P1[1]); a_ = MX3(a_, P1[2], P1[3]); \
        _Pragma("unroll") for (int r = 4; r < 16; r += 4) { a_ = MX3(a_, P0[r], P0[r + 1]); b_ = MX3(b_, P0[r + 2], P0[r + 3]); a_ = MX3(a_, P1[r], P1[r + 1]); b_ = MX3(b_, P1[r + 2], P1[r + 3]); } \
        float mx_ = __builtin_fmaxf(a_, b_); { auto rr_ = __builtin_amdgcn_permlane32_swap(__float_as_uint(mx_), __float_as_uint(mx_), false, false); mx_ = __builtin_fmaxf(__uint_as_float(rr_[0]), __uint_as_float(rr_[1])); } \
        const int em_ = (int)(__float_as_uint(mx_) >> 23) - 7; sb = em_ < 1 ? 1 : em_; } while (0)
#define PCVT(P0, P1) do { const float scf_ = __uint_as_float((unsigned)sb << 23); \
        _Pragma("unroll") for (int k = 0; k < 4; ++k) { v2s w_ = {0, 0}; w_ = __builtin_amdgcn_cvt_scalef32_pk_fp8_f32(w_, P0[4 * k], P0[4 * k + 1], scf_, false); w_ = __builtin_amdgcn_cvt_scalef32_pk_fp8_f32(w_, P0[4 * k + 2], P0[4 * k + 3], scf_, true); pa[k] = __builtin_bit_cast(int, w_); } \
        _Pragma("unroll") for (int k = 0; k < 4; ++k) { v2s w_ = {0, 0}; w_ = __builtin_amdgcn_cvt_scalef32_pk_fp8_f32(w_, P1[4 * k], P1[4 * k + 1], scf_, false); w_ = __builtin_amdgcn_cvt_scalef32_pk_fp8_f32(w_, P1[4 * k + 2], P1[4 * k + 3], scf_, true); pa[4 + k] = __builtin_bit_cast(int, w_); } } while (0)
#define PSUM(P0, P1) do { float s0_ = P0[0] + P0[1], s1_ = P0[2] + P0[3], s2_ = P1[0] + P1[1], s3_ = P1[2] + P1[3]; \
        _Pragma("unroll") for (int r = 4; r < 16; r += 4) { s0_ += P0[r]; s1_ += P0[r + 1]; s2_ += P0[r + 2]; s3_ += P0[r + 3]; s0_ += P1[r]; s1_ += P1[r + 1]; s2_ += P1[r + 2]; s3_ += P1[r + 3]; } \
        l_reg += (s0_ + s1_) + (s2_ + s3_); } while (0)
#define EXPS(X, B, N) do { _Pragma("unroll") for (int r_ = 0; r_ < (N); ++r_) X[(B) + r_] = __builtin_amdgcn_exp2f(X[(B) + r_]); PIN(X); } while (0)
    DMA_K(2, 2);
    wait_bar<0>();
    kf8[0] = ld_frag(kp0, 1024); kf8[1] = ld_frag(kp0 + 512, 1024);
    pA0 = MFQK(kf8[0]); pA1 = MFQK(kf8[1]);
    ADD_BIAS(pA0, pA1, 0);
#pragma unroll
    for (int r = 0; r < 16; ++r) { pA0[r] = __builtin_amdgcn_exp2f(pA0[r]); pA1[r] = __builtin_amdgcn_exp2f(pA1[r]); }
    wait_bar<0>();
    DMA_K(3, 0); DMA_V(1, 1);
    ROT();
    kf8[0] = ld_frag(kp0 + s_cur * KT, 1024); kf8[1] = ld_frag(kp0 + s_cur * KT + 512, 1024);
    waitb(ndma);
#define STEP(C0, C1, P0, P1, t, GK, GV, GL) do { SBAR(); \
    const lds_cptr vp_ = vq0 + s_prev * VT; \
    _Pragma("unroll") for (int d_ = 0; d_ < ND; ++d_) vf[d_] = ld_frag(vp_ + d_ * 512, DV * 16); \
    SBAR(); \
    C0 = MFQK(kf8[0]); SBAR(); \
    PMAX(P0, P1); PIN(sb); SBAR(); \
    C1 = MFQK(kf8[1]); SBAR(); \
    PCVT(P0, P1); PIN(pa); SBAR(); \
    MFSUM(); SBAR(); \
    if (GK) { DMA_K((t) + 3, s_cur); } if (GV) { DMA_V((t) + 1, s_next); } \
    ADD_BIAS(C0, C1, t); \
    SBAR(); \
    if (ND == 2) { \
        MFPV(0); EXPS(C0, 0, 16); SBAR(); \
        if (GL) { kf8[0] = ld_frag(kp0 + s_next * KT, 1024); kf8[1] = ld_frag(kp0 + s_next * KT + 512, 1024); SBAR(); } \
        MFPV(1); EXPS(C1, 0, 16); SBAR(); \
    } else { \
        MFPV(0); EXPS(C0, 0, 8); SBAR(); \
        if (GL) { kf8[0] = ld_frag(kp0 + s_next * KT, 1024); SBAR(); } \
        MFPV(1); EXPS(C0, 8, 8); SBAR(); \
        if (GL) { kf8[1] = ld_frag(kp0 + s_next * KT + 512, 1024); SBAR(); } \
        MFPV(ND - 2); EXPS(C1, 0, 8); SBAR(); \
        MFPV(ND - 1); EXPS(C1, 8, 8); SBAR(); \
    } \
    if (BIAS && (t) == tl) { _Pragma("unroll") for (int r = 0; r < 16; ++r) lacc[r] *= fL; _Pragma("unroll") for (int d_ = 0; d_ < ND; ++d_) _Pragma("unroll") for (int r = 0; r < 16; ++r) o[d_][r] *= fL; } \
    } while (0)
    int t = 1;
    for (; t + 4 < NT; t += 2) {
        STEP(pB0, pB1, pA0, pA1, t, true, true, true);       waitb(ndma); ROT();
        STEP(pA0, pA1, pB0, pB1, t + 1, true, true, true);   waitb(ndma); ROT();
    }
    STEP(pB0, pB1, pA0, pA1, NT - 3, false, true, true);  waitb(doV ? 1 : 0); ROT();
    STEP(pA0, pA1, pB0, pB1, NT - 2, false, true, true);  wait_bar<0>();  ROT();
    STEP(pB0, pB1, pA0, pA1, NT - 1, false, false, false);
    {
        const lds_cptr vp_ = vq0 + s_cur * VT;
#pragma unroll
        for (int d_ = 0; d_ < ND; ++d_) vf[d_] = ld_frag(vp_ + d_ * 512, DV * 16);
        PMAX(pB0, pB1); PCVT(pB0, pB1); MFSUM();
#pragma unroll
        for (int d_ = 0; d_ < ND; ++d_) MFPV(d_);
    }
    int lane_e = lane; asm volatile("" : "+v"(lane_e));
    const int r32e = lane_e & 31, hie = lane_e >> 5;
    asm volatile("s_waitcnt lgkmcnt(0)\n\ts_barrier" ::: "memory");
    {
        LAS bf16* stg = (LAS bf16*)(MODE == 1 ? lds + STASH_OFF : lds) + wid * (32 * DV);
#pragma unroll
        for (int r = 0; r < 16; ++r) { const int orow = crow(r, hie); const float rl = __builtin_amdgcn_rcpf(lacc[r]);
#pragma unroll
            for (int d0 = 0; d0 < ND; ++d0) stg[orow * DV + d0 * 32 + r32e] = (bf16)f2bf(o[d0][r] * rl); }
        asm volatile("s_waitcnt lgkmcnt(0)" ::: "memory");
        if (MODE == 0) {
            constexpr int CPR = DV / 8;
#pragma unroll
            for (int i = 0; i < (32 * CPR) / 64; ++i) { const int row = i * (64 / CPR) + lane_e / CPR, ch = lane_e % CPR;
                const v4u v = *(const LAS v4u*)(stg + row * DV + ch * 8); *(v4u*)(Op + (size_t)(wid * 32 + row) * ldo + ch * 8) = v; }
        } else if (MODE == 2) {
            const int row = lane_e >> 1, half = lane_e & 1; const float lam = sgt[128];
            const LAS bf16* s1 = stg + row * DV + half * 64; const LAS bf16* s0 = (const LAS bf16*)(lds + STASH_OFF) + wid * (32 * DV) + row * DV + half * 64;
            float ov[64]; float ss = 0.f;
#pragma unroll
            for (int q = 0; q < 8; ++q) { const v4u a = *(const LAS v4u*)(s0 + q * 8), c = *(const LAS v4u*)(s1 + q * 8);
#pragma unroll
                for (int j = 0; j < 4; ++j) { const float lo = __builtin_bit_cast(float, a[j] << 16) - lam * __builtin_bit_cast(float, c[j] << 16);
                    const float hh = __builtin_bit_cast(float, a[j] & 0xffff0000u) - lam * __builtin_bit_cast(float, c[j] & 0xffff0000u);
                    ov[q * 8 + 2 * j] = lo; ov[q * 8 + 2 * j + 1] = hh; ss += lo * lo + hh * hh; } }
            ss += dpp_mov<0xB1>(ss);
            const float rstd = 1.0f / sqrtf(ss * (1.f / 128.f) + 1e-5f);
            bf16* yo = Op + (size_t)(wid * 32 + row) * ldo + half * 64;
#pragma unroll
            for (int q = 0; q < 8; ++q) { const f32x4 g0 = *(const LAS f32x4*)(sgt + half * 64 + q * 8), g1 = *(const LAS f32x4*)(sgt + half * 64 + q * 8 + 4);
                v4u w; w.x = pk2(ov[q * 8] * rstd * g0.x, ov[q * 8 + 1] * rstd * g0.y); w.y = pk2(ov[q * 8 + 2] * rstd * g0.z, ov[q * 8 + 3] * rstd * g0.w);
                w.z = pk2(ov[q * 8 + 4] * rstd * g1.x, ov[q * 8 + 5] * rstd * g1.y); w.w = pk2(ov[q * 8 + 6] * rstd * g1.z, ov[q * 8 + 7] * rstd * g1.w);
                *(v4u*)(yo + q * 8) = w; }
        }
    }
    asm volatile("s_waitcnt lgkmcnt(0)\n\ts_barrier" ::: "memory");
#undef DMA_K
#undef DMA_V
#undef ROT
#undef MFQK
#undef MFPV
#undef MFSUM
#undef ADD_BIAS
#undef MX3
#undef PMAX
#undef PCVT
#undef PSUM
#undef EXPS
#undef STEP
}
#undef SBAR
#undef PIN
}

struct Args { const float* in[27]; float* out; unsigned char* ws; int ph_lo, ph_hi, li, pad; };

constexpr int NPHASE = 17;
constexpr int NWAVES = 8;

#define IN(k) (lo <= (k) && (k) < hi_ph)
#define SEAM(k) do { if (IN(k) && IN((k) + 1)) xcd_barrier(bar); } while (0)
template <int layer>
__device__ __forceinline__ void moe_block(const Args& args, LAS unsigned char* lds, const XcdBarrier& bar, int lo, int hi_ph) {
    volatile LAS unsigned* LC = (volatile LAS unsigned*)(lds + LDSCTL_OFF);
    const int tid = threadIdx.x, lane = tid & 63, wave = __builtin_amdgcn_readfirstlane(tid >> 6);
    const int G = gridDim.x, bx = blockIdx.x;
    const int gw = bx * NWAVES + wave, NGW = G * NWAVES;
    unsigned char* ws = args.ws;
    unsigned* ctl = (unsigned*)(ws + WS_CTL);
    float* xres = args.out;
    bf16* XB = (bf16*)(ws + WS_XB);
    bf16* HB = (bf16*)(ws + WS_HB);
    {
        const int pb = layer == 0 ? 5 : 13;
        unsigned* const gcnt0 = ctl + CW_CNT + layer * 64;
        int* list = (int*)(ws + WS_LIST); int* tokep = (int*)(ws + WS_TOKEP); float* gate = (float*)(ws + WS_GATE);
        if (IN(pb)) REP(pb) {
            unsigned* gcnt = gcnt0 + ((MK_N_LAUNCHES == 1 ? (int)((PROBE_MASK >> pb) & 1u) : 0) - rep_) * 128;
            if (rep_ > 0) xcd_barrier(bar);
            const float* gf = args.in[2] + layer * DM;
            const float* WR = (const float*)(ws + WS_TBL) + TBL_WR + layer * WR_LAYER;
            for (int chunk = bx; chunk < NTOK / 128; chunk += G) {
                __syncthreads();
                if (tid < 32) LC[LC_LCNT + tid] = 0u;
                __syncthreads();
                int my_e0 = 0, my_e1 = 0; float my_g0 = 0.f, my_g1 = 0.f;
                {
                    const int ri = lane & 15, kq = lane >> 4; const int r0w = chunk * 128 + wave * 16;
                    const GAS bf16* xrow = (const GAS bf16*)(XB + (size_t)(r0w + ri) * DM) + 4 * kq;
                    const GAS float* wb = (const GAS float*)WR + (size_t)(4 * kq) * 48 + ri;
                    f32x4 acc0 = {0.f, 0.f, 0.f, 0.f}, acc1 = acc0, acc2 = acc0; float ss = 0.f;
                    f32x4 aA[4], aB[4]; float bA[48], bB[48];
#define RT_LOAD(a_, b_, g_) do { _Pragma("unroll") for (int c_ = 0; c_ < 4; ++c_) { { const v2u w_ = *(const GAS v2u*)(xrow + 16 * (4 * (g_) + c_)); a_[c_] = (f32x4){__builtin_bit_cast(float, w_.x << 16), __builtin_bit_cast(float, w_.x & 0xffff0000u), __builtin_bit_cast(float, w_.y << 16), __builtin_bit_cast(float, w_.y & 0xffff0000u)}; } \
        const GAS float* wc_ = wb + (size_t)(16 * (4 * (g_) + c_)) * 48; _Pragma("unroll") for (int e_ = 0; e_ < 4; ++e_) { b_[c_ * 12 + e_ * 3] = wc_[e_ * 48]; b_[c_ * 12 + e_ * 3 + 1] = wc_[e_ * 48 + 16]; b_[c_ * 12 + e_ * 3 + 2] = wc_[e_ * 48 + 32]; } } } while (0)
#define RT_COMP(a_, b_) do { _Pragma("unroll") for (int c_ = 0; c_ < 4; ++c_) { ss += (a_[c_].x * a_[c_].x + a_[c_].y * a_[c_].y) + (a_[c_].z * a_[c_].z + a_[c_].w * a_[c_].w); \
        _Pragma("unroll") for (int e_ = 0; e_ < 4; ++e_) { acc0 = __builtin_amdgcn_mfma_f32_16x16x4f32(a_[c_][e_], b_[c_ * 12 + e_ * 3], acc0, 0, 0, 0); \
            acc1 = __builtin_amdgcn_mfma_f32_16x16x4f32(a_[c_][e_], b_[c_ * 12 + e_ * 3 + 1], acc1, 0, 0, 0); acc2 = __builtin_amdgcn_mfma_f32_16x16x4f32(a_[c_][e_], b_[c_ * 12 + e_ * 3 + 2], acc2, 0, 0, 0); } } } while (0)
                    RT_LOAD(aA, bA, 0);
#pragma unroll 1
                    for (int g = 0; g < 16; g += 2) {
                        RT_LOAD(aB, bB, g + 1);
                        RT_COMP(aA, bA);
                        if (g + 2 < 16) RT_LOAD(aA, bA, g + 2);
                        RT_COMP(aB, bB);
                    }
#undef RT_LOAD
#undef RT_COMP
                    ss += __shfl_xor(ss, 16); ss += __shfl_xor(ss, 32);
                    const float rstd = 1.0f / sqrtf(ss * (1.f / DM) + 1e-6f);
                    LAS float* Lg = (LAS float*)(lds + wave * 4096);
#pragma unroll
                    for (int r = 0; r < 4; ++r) { Lg[(4 * kq + r) * 49 + ri] = acc0[r]; Lg[(4 * kq + r) * 49 + 16 + ri] = acc1[r]; Lg[(4 * kq + r) * 49 + 32 + ri] = acc2[r]; }
                    LDS_WAIT(); asm volatile("" ::: "memory");
                    if (lane < 16) {
                        const GAS float* bv = (const GAS float*)WR + 1024 * 48;
                        float lg[4], le[32];
#pragma unroll
                        for (int e = 0; e < 4; ++e) lg[e] = Lg[lane * 49 + e] * rstd + bv[e];
#pragma unroll
                        for (int e = 0; e < 32; ++e) le[e] = Lg[lane * 49 + 4 + e] * rstd + bv[4 + e];
                        int gi = 0; float gm = lg[0];
#pragma unroll
                        for (int e = 1; e < 4; ++e) if (lg[e] > gm) { gm = lg[e]; gi = e; }
                        float gs = 0.f;
#pragma unroll
                        for (int e = 0; e < 4; ++e) gs += __expf(lg[e] - gm);
                        const float gval = 1.0f / gs;
                        float ev[8];
#pragma unroll
                        for (int j = 0; j < 8; ++j) ev[j] = gi == 0 ? le[j] : (gi == 1 ? le[8 + j] : (gi == 2 ? le[16 + j] : le[24 + j]));
                        int i0 = 0; float m0 = ev[0];
#pragma unroll
                        for (int j = 1; j < 8; ++j) if (ev[j] > m0) { m0 = ev[j]; i0 = j; }
                        int i1 = -1; float m1 = -3.0e38f;
#pragma unroll
                        for (int j = 0; j < 8; ++j) if (j != i0 && ev[j] > m1) { m1 = ev[j]; i1 = j; }
                        const float t1 = __expf(m1 - m0); const float den = 1.0f / (1.0f + t1);
                        my_e0 = gi * 8 + i0; my_e1 = gi * 8 + i1; my_g0 = gval * den; my_g1 = gval * t1 * den;
                    }
                    for (int i = 0; i < 16; ++i) { const int m = r0w + i; f32x4 v[4]; rms_row_b16(XB + (size_t)m * DM, gf, v, lane);
                        if (MOE_FP8) {
#pragma unroll
                            for (int j = 0; j < 4; ++j) { int d = __builtin_amdgcn_cvt_pk_fp8_f32(v[j].x, v[j].y, 0, false); d = __builtin_amdgcn_cvt_pk_fp8_f32(v[j].z, v[j].w, d, true); *(GAS unsigned*)((unsigned char*)HB + (size_t)m * DM + 4 * lane + 256 * j) = (unsigned)d; }
                        } else store_row_bf16(HB + (size_t)m * DM, v, lane); }
                }
                unsigned r0 = 0, r1 = 0;
                if (lane < 16) { r0 = atomicAdd((unsigned*)(LC + LC_LCNT + my_e0), 1u); r1 = atomicAdd((unsigned*)(LC + LC_LCNT + my_e1), 1u); }
                __syncthreads();
                if (tid < 32) { const unsigned c = LC[LC_LCNT + tid]; LC[LC_LBASE + tid] = c ? __hip_atomic_fetch_add(gcnt + tid, c, RLX_AGENT) : 0u; }
                __syncthreads();
                if (lane < 16) { const int m = chunk * 128 + wave * 16 + lane;
                    const unsigned p0 = LC[LC_LBASE + my_e0] + r0, p1 = LC[LC_LBASE + my_e1] + r1;
                    list[(size_t)my_e0 * LIST_CAP + p0] = m; list[(size_t)my_e1 * LIST_CAP + p1] = m;
                    tokep[2 * m] = my_e0 | (int)(p0 << 8); tokep[2 * m + 1] = my_e1 | (int)(p1 << 8);
                    gate[2 * m] = my_g0; gate[2 * m + 1] = my_g1; }
            }
        }
        SEAM(pb);
        if (IN(pb + 1) || IN(pb + 2) || IN(pb + 3)) {
            __syncthreads();
            if (tid == 0) { int acc = 0; for (int e = 0; e < 32; ++e) { const int c = (int)__hip_atomic_load(gcnt0 + e, RLX_AGENT); LC[LC_CNT + e] = (unsigned)c; LC[LC_TP + e] = (unsigned)acc; acc += (c + 255) >> 8; } LC[LC_TP + 32] = (unsigned)acc;
                int la = 0; for (int j = 0; j < 4; ++j) { LC[LC_LP + j] = (unsigned)la; la += ((int)LC[LC_CNT + (bx & 7) + 8 * j] + 255) >> 8; } LC[LC_LP + 4] = (unsigned)la; }
            __syncthreads();
        }
        const LAS int* tp = (const LAS int*)(lds + LDSCTL_OFF) + LC_TP; const LAS int* cn = (const LAS int*)(lds + LDSCTL_OFF) + LC_CNT; const LAS int* lp = (const LAS int*)(lds + LDSCTL_OFF) + LC_LP;
        if (IN(pb + 1)) REP(pb + 1) {
            pg8::Gemm g{HB, (const bf16*)(ws + WS_W13), 0, 1024, MOE_FP8 ? DM / 2 : DM};
            pg8::MoeOrder S{tp, cn, lp, list, G, bx, tp[32] * 4, true, G == 256};
            pg8::EpiSwiglu E{(bf16*)(ws + WS_H), MOE_FP8 != 0};
            if (MOE_FP8) pg8::gemm_phase<pg8::EpiSwiglu, pg8::MoeOrder, true, true, 127, 122>(lds, g, S, E);
            else pg8::gemm_phase<pg8::EpiSwiglu, pg8::MoeOrder, true>(lds, g, S, E);
        }
        SEAM(pb + 1);
        if (IN(pb + 2)) REP(pb + 2) {
            pg8::Gemm g{(const bf16*)(ws + WS_H), (const bf16*)(ws + WS_W2), 0, 1024, MOE_FP8 ? MOE_H / 2 : MOE_H};
            pg8::MoeOrder S{tp, cn, lp, list, G, bx, tp[32] * 4, false, G == 256};
            pg8::EpiBf16 E{(bf16*)(ws + WS_YS), DM, 0, 0, 1.f, 3, MOE_FP8 != 0};
            if (MOE_FP8) pg8::gemm_phase<pg8::EpiBf16, pg8::MoeOrder, true, true, 125, 122>(lds, g, S, E);
            else pg8::gemm_phase<pg8::EpiBf16, pg8::MoeOrder, true>(lds, g, S, E);
        }
        SEAM(pb + 2);
        if (IN(pb + 3)) {
            const bf16* YS = (const bf16*)(ws + WS_YS);
            if (layer == 0) { LAS float* scr = (LAS float*)(lds + wave * 16384);
                transpose_moe(args.in[24] + (size_t)NEXP * 1024 * 512, args.in[25] + (size_t)NEXP * 1024 * 512, args.in[26] + (size_t)NEXP * 1024 * 512, (bf16*)(ws + WS_W13), (bf16*)(ws + WS_W2), scr, gw, NGW, lane); }
            const float* gn = layer == 0 ? args.in[1] + DM : args.in[3];
            for (int m = gw; m < NTOK; m += NGW) {
                const int ep0 = tokep[2 * m], ep1 = tokep[2 * m + 1]; const float g0 = gate[2 * m], g1 = gate[2 * m + 1];
                const size_t s0 = (size_t)(tp[ep0 & 255] * 256 + (ep0 >> 8)), s1 = (size_t)(tp[ep1 & 255] * 256 + (ep1 >> 8));
                GAS f32x4* xr = (GAS f32x4*)(xres + (size_t)m * DM) + lane; GAS v2u* xb = (GAS v2u*)(XB + (size_t)m * DM) + lane;
                const GAS v2u* y0 = (const GAS v2u*)(YS + s0 * DM) + lane; const GAS v2u* y1 = (const GAS v2u*)(YS + s1 * DM) + lane;
                const GAS unsigned* z0 = (const GAS unsigned*)((const unsigned char*)YS + s0 * DM) + lane; const GAS unsigned* z1 = (const GAS unsigned*)((const unsigned char*)YS + s1 * DM) + lane;
                f32x4 v[4]; float ss = 0.f;
#pragma unroll
                for (int j = 0; j < 4; ++j) { const v2u xw = xb[64 * j]; f32x4 xv = (f32x4){__builtin_bit_cast(float, xw.x << 16), __builtin_bit_cast(float, xw.x & 0xffff0000u), __builtin_bit_cast(float, xw.y << 16), __builtin_bit_cast(float, xw.y & 0xffff0000u)};
                    if (MOE_FP8) { typedef float f32x2_ __attribute__((ext_vector_type(2))); const unsigned a = z0[64 * j], c = z1[64 * j]; const float h0 = g0 * 0.125f, h1 = g1 * 0.125f;
                        const f32x2_ al = __builtin_amdgcn_cvt_pk_f32_fp8((int)a, false), ah = __builtin_amdgcn_cvt_pk_f32_fp8((int)a, true), cl = __builtin_amdgcn_cvt_pk_f32_fp8((int)c, false), ch = __builtin_amdgcn_cvt_pk_f32_fp8((int)c, true);
                        xv.x += h0 * al.x + h1 * cl.x; xv.y += h0 * al.y + h1 * cl.y; xv.z += h0 * ah.x + h1 * ch.x; xv.w += h0 * ah.y + h1 * ch.y;
                    } else { const v2u a = y0[64 * j], c = y1[64 * j];
                    xv.x += g0 * __builtin_bit_cast(float, a.x << 16) + g1 * __builtin_bit_cast(float, c.x << 16);
                    xv.y += g0 * __builtin_bit_cast(float, a.x & 0xffff0000u) + g1 * __builtin_bit_cast(float, c.x & 0xffff0000u);
                    xv.z += g0 * __builtin_bit_cast(float, a.y << 16) + g1 * __builtin_bit_cast(float, c.y << 16);
                    xv.w += g0 * __builtin_bit_cast(float, a.y & 0xffff0000u) + g1 * __builtin_bit_cast(float, c.y & 0xffff0000u); }
                    v[j] = xv; ss += (xv.x * xv.x + xv.y * xv.y) + (xv.z * xv.z + xv.w * xv.w); }
                const float rstd = 1.0f / sqrtf(wave_sum(ss) * (1.f / DM) + 1e-6f);
                const GAS f32x4* gr = (const GAS f32x4*)gn + lane;
                if (layer == 0) {
#pragma unroll
                    for (int j = 0; j < 4; ++j) xb[64 * j] = (v2u){pk2(v[j].x, v[j].y), pk2(v[j].z, v[j].w)};
#pragma unroll
                    for (int j = 0; j < 4; ++j) v[j] = v[j] * rstd * gr[64 * j];
                    store_row_bf16(HB + (size_t)m * DM, v, lane);
                } else {
#pragma unroll
                    for (int j = 0; j < 4; ++j) xr[64 * j] = v[j] * rstd * gr[64 * j];
                }
            }
        }
    }
}

__global__ void __launch_bounds__(NWAVES * 64, 2) mk_fwd(Args args) {
    extern __shared__ __attribute__((aligned(16))) unsigned char lds_raw[];
    LAS unsigned char* lds = (LAS unsigned char*)lds_raw;
    volatile LAS unsigned* LC = (volatile LAS unsigned*)(lds + LDSCTL_OFF);
    const int tid = threadIdx.x, lane = tid & 63, wave = __builtin_amdgcn_readfirstlane(tid >> 6);
    const int G = gridDim.x, bx = blockIdx.x;
    const int gw = bx * NWAVES + wave, NGW = G * NWAVES;
    unsigned char* ws = args.ws;
    unsigned* ctl = (unsigned*)(ws + WS_CTL);
    const float* x_in = args.in[0];
    float* xres = args.out;
    bf16* XB = (bf16*)(ws + WS_XB);
    bf16* HB = (bf16*)(ws + WS_HB); bf16* Y = (bf16*)(ws + WS_Y);
    float* TBL = (float*)(ws + WS_TBL);

    for (int u = tid; u < (LDS_BYTES - LDSCTL_OFF) / 4; u += NWAVES * 64) LC[u] = 0u;
    __syncthreads();
    XcdBarrier bar; bar.bar = ctl + CW_BAR; bar.x = 0; bar.st = nullptr;
    if (MK_N_LAUNCHES == 1) bar = xcd_barrier_post(ctl + CW_BAR, LC + LC_BAR);
    const int lo = args.ph_lo, hi_ph = args.ph_hi;

    if (IN(0)) REP(0) {
        LAS float* scr = (LAS float*)(lds + wave * 16384);
        transpose_plain(args.in[4], DM, EV_IN, (bf16*)(ws + WS_WIN0), scr, gw, NGW, lane);
        transpose_plain(args.in[11], DM, DM, (bf16*)(ws + WS_WOUT0), scr, gw, NGW, lane);
        transpose_plain(args.in[12], DM, OD_IN, (bf16*)(ws + WS_WIN1), scr, gw, NGW, lane);
        transpose_plain(args.in[18], DM, DM, (bf16*)(ws + WS_WOUT1), scr, gw, NGW, lane);
        transpose_moe(args.in[24], args.in[25], args.in[26], (bf16*)(ws + WS_W13), (bf16*)(ws + WS_W2), scr, gw, NGW, lane);
        for (int i = bx * 512 + tid; i < 2048; i += G * 512) { const int pos = i >> 4, f = i & 15;
            const float inv = exp2f(-(float)f * (13.287712379549449f / 16.0f));
            const float ang = (float)pos * inv; const float rev = ang * 0.15915494309189535f; const float fr = rev - floorf(rev);
            TBL[TBL_COS + i] = __builtin_amdgcn_cosf(fr); TBL[TBL_SIN + i] = __builtin_amdgcn_sinf(fr); }
        for (int i = bx * 512 + tid; i < 8 * 257; i += G * 512) { const int h = i / 257, j = i % 257;
            TBL[TBL_BIAS + h * BIAS_STRIDE + j] = args.in[19][t5_bucket(j - 128) * 8 + h] * LOG2E; }
        for (int i = bx * 512 + tid; i < 2 * 1024 * 48; i += G * 512) { const int l = i / (1024 * 48), r = i % (1024 * 48), k = r / 48, c = r % 48;
            float w = 0.f; if (c < 4) w = args.in[20][(size_t)l * 4096 + k * 4 + c]; else if (c < 36) w = args.in[22][(size_t)l * 32768 + k * 32 + (c - 4)];
            TBL[TBL_WR + l * WR_LAYER + r] = w * args.in[2][l * DM + k]; }
        for (int i = bx * 512 + tid; i < 2 * 48; i += G * 512) { const int l = i / 48, c = i % 48;
            TBL[TBL_WR + l * WR_LAYER + 1024 * 48 + c] = c < 4 ? args.in[21][l * 4 + c] : (c < 36 ? args.in[23][l * 32 + (c - 4)] : 0.f); }
        for (int m = gw; m < NTOK; m += NGW) { f32x4 v[4]; rms_row(x_in + (size_t)m * DM, args.in[1], v, lane); store_row_bf16(HB + (size_t)m * DM, v, lane); }
    }
    SEAM(0);
    if (IN(1)) REP(1) {
        pg8::Gemm g{HB, (const bf16*)(ws + WS_WIN0), NTOK, EV_IN, DM}; pg8::StaticOrder S; S.init(NTOK, EV_IN, G, bx);
        pg8::EpiBf16 E{(bf16*)(ws + WS_Z0), EV_IN, 0, 0, 1.f, 0xffff, false};
        pg8::gemm_phase<pg8::EpiBf16, pg8::StaticOrder, true>(lds, g, S, E);
    }
    SEAM(1);
    if (IN(2)) REP(2) {
        const bf16* Z0 = (const bf16*)(ws + WS_Z0); bf16* QR = (bf16*)(ws + WS_QR); bf16* KR = (bf16*)(ws + WS_KR);
        if (QK_FP8 && (ATTN_VER == 1 || ATTN_VER == 3)) {
            for (int it = bx * 512 + tid; it < NTOK * 10; it += G * 512) {
                const bool isq = it < NTOK * 8; const int m = isq ? (it >> 3) : ((it - NTOK * 8) >> 1); const int hh = isq ? (it & 7) : 8 + ((it - NTOK * 8) & 1);
                const float* gn = isq ? args.in[5] : args.in[6];
                const GAS v4u* srcp = (const GAS v4u*)(Z0 + (size_t)m * EV_IN + hh * 64);
                float xv[64]; float ss = 0.f;
#pragma unroll
                for (int q = 0; q < 8; ++q) { const v4u a = srcp[q];
#pragma unroll
                    for (int j = 0; j < 4; ++j) { const float lo = __builtin_bit_cast(float, a[j] << 16), hh2 = __builtin_bit_cast(float, a[j] & 0xffff0000u); xv[q * 8 + 2 * j] = lo; xv[q * 8 + 2 * j + 1] = hh2; ss += lo * lo + hh2 * hh2; } }
                const float rs = (1.0f / sqrtf(ss * (1.f / 64.f) + 1e-6f)) * (isq ? C2 * 8.0f : 1.0f);
                const int sp = m & (SEQ - 1);
                unsigned wout[16];
#pragma unroll
                for (int half = 0; half < 2; ++half) { const int pos = half ? (sp & 63) : (sp >> 6);
                    const GAS f32x4* ct = (const GAS f32x4*)(TBL + TBL_COS + pos * 16); const GAS f32x4* st = (const GAS f32x4*)(TBL + TBL_SIN + pos * 16);
                    float ov[32];
#pragma unroll
                    for (int q = 0; q < 4; ++q) { const f32x4 cv = ct[q], sv = st[q];
#pragma unroll
                        for (int j = 0; j < 4; ++j) { const int i = q * 4 + j; const float a = xv[half * 32 + i] * rs * gn[half * 32 + i], b2 = xv[half * 32 + 16 + i] * rs * gn[half * 32 + 16 + i];
                            ov[i] = a * cv[j] - b2 * sv[j]; ov[16 + i] = b2 * cv[j] + a * sv[j]; } }
#pragma unroll
                    for (int q = 0; q < 8; ++q) { int d = __builtin_amdgcn_cvt_pk_fp8_f32(ov[4 * q], ov[4 * q + 1], 0, false); d = __builtin_amdgcn_cvt_pk_fp8_f32(ov[4 * q + 2], ov[4 * q + 3], d, true); wout[half * 8 + q] = (unsigned)d; } }
                if (!isq && ATTN_VER == 3) {
                    const int strm = (m >> 13) * 2 + (hh - 8); unsigned char* kb_ = ws + WS_K8T0 + ((((size_t)strm * 128 + (sp >> 6)) * 4) * 64 + (sp & 63)) * 16;
#pragma unroll
                    for (int q = 0; q < 4; ++q) *(GAS v4u*)(kb_ + q * 1024) = (v4u){wout[4 * q], wout[4 * q + 1], wout[4 * q + 2], wout[4 * q + 3]};
                } else {
                GAS v4u* dst = isq ? (GAS v4u*)(ws + WS_QR8 + (size_t)m * 512 + hh * 64) : (GAS v4u*)(ws + WS_KR8 + (size_t)m * 128 + (hh - 8) * 64);
#pragma unroll
                for (int q = 0; q < 4; ++q) dst[q] = (v4u){wout[4 * q], wout[4 * q + 1], wout[4 * q + 2], wout[4 * q + 3]};
                }
            }
            if (ATTN_VER == 3) {
                for (int it = bx * 512 + tid; it < 8 * 128 * 4 * 64; it += G * 512) { const int d = it & 63, c = (it >> 6) & 3, tt = (it >> 8) & 127, strm = it >> 15;
                    const bf16* vb_ = Z0 + ((size_t)(strm >> 1) * SEQ + tt * 64) * EV_IN + 640 + (strm & 1) * 64 + d; unsigned w4[4];
#pragma unroll
                    for (int q = 0; q < 4; ++q) { float f[4];
#pragma unroll
                        for (int j = 0; j < 4; ++j) { const int bb = q * 4 + j; const int key = 32 * (c & 1) + (bb & 3) + 8 * (bb >> 2) + 4 * (c >> 1); f[j] = bf2f(vb_[(size_t)key * EV_IN]); }
                        int dw = __builtin_amdgcn_cvt_pk_fp8_f32(f[0], f[1], 0, false); dw = __builtin_amdgcn_cvt_pk_fp8_f32(f[2], f[3], dw, true); w4[q] = (unsigned)dw; }
                    *(GAS v4u*)(ws + WS_V8T0 + (size_t)it * 16) = (v4u){w4[0], w4[1], w4[2], w4[3]}; }
            }
        } else {
        const float gq = args.in[5][lane], gk = args.in[6][lane];
        const int fi = lane & 15; const bool first = (lane & 16) == 0, isrow = lane < 32;
        for (int m = gw; m < NTOK; m += NGW) {
            const int s = m & (SEQ - 1); const int pos = isrow ? (s >> 6) : (s & 63);
            const float cs = TBL[TBL_COS + pos * 16 + fi], sn = TBL[TBL_SIN + pos * 16 + fi];
#pragma unroll
            for (int h = 0; h < 10; ++h) {
                const float xv = bf2f(Z0[(size_t)m * EV_IN + h * 64 + lane]);
                const float ss = wave_sum(xv * xv);
                const float y = xv * (1.0f / sqrtf(ss * (1.f / 64.f) + 1e-6f)) * (h < 8 ? gq : gk);
                const float p = __shfl_xor(y, 16);
                float o = first ? (y * cs - p * sn) : (y * cs + p * sn);
                if (!QK_FP8 || ATTN_VER != 1) { if (h < 8) QR[(size_t)m * 512 + h * 64 + lane] = (bf16)f2bf(o * C2);
                else KR[(size_t)m * 128 + (h - 8) * 64 + lane] = (bf16)f2bf(o); }
                if (QK_FP8) { const unsigned w = quad_pack_bytes(fp8_byte(h < 8 ? o * (C2 * 8.0f) : o));
                    if ((lane & 3) == 0) { if (h < 8) *(unsigned*)(ws + WS_QR8 + (size_t)m * 512 + h * 64 + lane) = w; else *(unsigned*)(ws + WS_KR8 + (size_t)m * 128 + (h - 8) * 64 + lane) = w; } }
            }
        }
        }
        LAS float* hbuf = (LAS float*)lds;
        for (int un = bx; un < NBATCH * 64 * 8; un += G) {
            const int grp = un & 7, tt = (un >> 3) & 63, b = un >> 9; const int t0 = tt * 128;
            __syncthreads();
            for (int idx = tid; idx < 158 * 8; idx += 512) { const int r = idx >> 3, c8 = idx & 7; const int s = t0 - 15 + r;
                f32x4 h0 = {0.f, 0.f, 0.f, 0.f}, h1 = h0;
                if (s >= 0 && s < SEQ) { const size_t ro = (size_t)(b * SEQ + s) * EV_IN + grp * 64 + c8 * 8;
                    const v4u av = *(const GAS v4u*)(Z0 + ro + 768), gv = *(const GAS v4u*)(Z0 + ro + 1280);
#pragma unroll
                    for (int j = 0; j < 4; ++j) { const float a0 = __builtin_bit_cast(float, av[j] << 16), a1 = __builtin_bit_cast(float, av[j] & 0xffff0000u);
                        const float g0 = __builtin_bit_cast(float, gv[j] << 16), g1 = __builtin_bit_cast(float, gv[j] & 0xffff0000u);
                        const float x0 = a0 * __builtin_amdgcn_rcpf(1.0f + __builtin_amdgcn_exp2f(-g0 * LOG2E)), x1 = a1 * __builtin_amdgcn_rcpf(1.0f + __builtin_amdgcn_exp2f(-g1 * LOG2E));
                        if (j < 2) { h0[2 * j] = x0; h0[2 * j + 1] = x1; } else { h1[2 * j - 4] = x0; h1[2 * j - 3] = x1; } } }
                *(LAS f32x4*)(hbuf + r * 64 + c8 * 8) = h0; *(LAS f32x4*)(hbuf + r * 64 + c8 * 8 + 4) = h1; }
            __syncthreads();
            const int ch = grp * 64 + lane;
            float wreg[31];
#pragma unroll
            for (int j = 0; j < 31; ++j) wreg[j] = args.in[7][j * 512 + ch];
            typedef float f32x2 __attribute__((ext_vector_type(2)));
            float acc[16]; const float cb = args.in[8][ch];
            {
                f32x2 he[23], ho[22];
#pragma unroll
                for (int k = 0; k < 23; ++k) { he[k].x = hbuf[(wave * 16 + 2 * k) * 64 + lane]; he[k].y = hbuf[(wave * 16 + 2 * k + 1) * 64 + lane]; }
#pragma unroll
                for (int k = 0; k < 22; ++k) { ho[k].x = he[k].y; ho[k].y = he[k + 1].x; }
                f32x2 a2[8];
#pragma unroll
                for (int p = 0; p < 8; ++p) a2[p] = (f32x2){cb, cb};
#pragma unroll
                for (int j = 0; j < 31; ++j) { const f32x2 wj = (f32x2){wreg[j], wreg[j]};
#pragma unroll
                    for (int p = 0; p < 8; ++p) { const int r = 2 * p + j; a2[p] = __builtin_elementwise_fma(wj, (r & 1) ? ho[r >> 1] : he[r >> 1], a2[p]); } }
#pragma unroll
                for (int p = 0; p < 8; ++p) { acc[2 * p] = a2[p].x; acc[2 * p + 1] = a2[p].y; }
            }
            const float gg = args.in[9][ch], gb = args.in[10][ch];
#pragma unroll
            for (int i = 0; i < 16; ++i) { const float mu = wave_sum(acc[i]) * (1.f / 64.f); const float d = acc[i] - mu; const float var = wave_sum(d * d) * (1.f / 64.f);
                const float hn = d * (1.0f / sqrtf(var + 1e-5f)) * gg + gb; const float ov = hn * __builtin_amdgcn_rcpf(1.0f + __builtin_amdgcn_exp2f(-hn * LOG2E));
                Y[(size_t)(b * SEQ + t0 + wave * 16 + i) * DM + 512 + ch] = (bf16)f2bf(ov); }
        }
    }
    SEAM(2);
    if (IN(3)) REP(3) {
        const bf16* QR = (const bf16*)(ws + WS_QR); const bf16* KR = (const bf16*)(ws + WS_KR); const bf16* Z0 = (const bf16*)(ws + WS_Z0);
        if (ATTN_L0_TEST) {
        for (int un = bx; un < NBATCH * 8 * 32; un += G) {
            const int qb = un & 31, h = (un >> 5) & 7, b = un >> 8, kvh = h >> 2;
            const size_t row0 = (size_t)b * SEQ + qb * 256;
            attn_unit_v0<64, false, true>((const bf16*)(ws + WS_QR8 + row0 * 512 + h * 64), 512, (const bf16*)(ws + WS_KR8 + (size_t)b * SEQ * 128 + kvh * 64), 128, Z0 + (size_t)b * SEQ * EV_IN + 640 + kvh * 64, EV_IN,
                                   Y + row0 * DM + h * 64, DM, nullptr, qb * 256, lds);
        }
        } else if (ATTN_VER == 0) {
        for (int un = bx; un < NBATCH * 8 * 32; un += G) {
            const int qb = un & 31, h = (un >> 5) & 7, b = un >> 8, kvh = h >> 2;
            const size_t row0 = (size_t)b * SEQ + qb * 256;
            attn_unit_v0<64, false>(QR + row0 * 512 + h * 64, 512, KR + (size_t)b * SEQ * 128 + kvh * 64, 128, Z0 + (size_t)b * SEQ * EV_IN + 640 + kvh * 64, EV_IN,
                                   Y + row0 * DM + h * 64, DM, nullptr, qb * 256, lds);
        }
        } else {
        constexpr int U = NBATCH * 8 * 32; const int upc = (U + G - 1) / G; const int vcu = (G % 8 == 0) ? (bx % 8) * (G / 8) + bx / 8 : bx;
        for (int i = 0; i < upc; ++i) { const int un = vcu * upc + i; if (un >= U) break;
            const int stream = un >> 7, b = stream >> 1, kvh = stream & 1, h = kvh * 4 + ((un >> 5) & 3), qb = un & 31;
            const size_t row0 = (size_t)b * SEQ + qb * 256;
            if (ATTN_VER == 3) at3::attn_unit<64, false, 0>(ws + WS_QR8 + row0 * 512 + h * 64, 512, ws + WS_K8T0 + (size_t)stream * 128 * 4096, ws + WS_V8T0 + (size_t)stream * 128 * 4096, Y + row0 * DM + h * 64, DM, qb * 256, lds, nullptr);
            else if (QK_FP8) at1::attn_unit<64, false, 0, 0, true>((const bf16*)(ws + WS_QR8 + row0 * 512 + h * 64), 512, (const bf16*)(ws + WS_KR8 + (size_t)b * SEQ * 128 + kvh * 64), 128, Z0 + (size_t)b * SEQ * EV_IN + 640 + kvh * 64, EV_IN,
                                      Y + row0 * DM + h * 64, DM, qb * 256, lds);
            else at1::attn_unit<64, false>(QR + row0 * 512 + h * 64, 512, KR + (size_t)b * SEQ * 128 + kvh * 64, 128, Z0 + (size_t)b * SEQ * EV_IN + 640 + kvh * 64, EV_IN,
                                      Y + row0 * DM + h * 64, DM, qb * 256, lds);
        }
        }
    }
    SEAM(3);
    if (IN(4)) REP(4) {
        pg8::Gemm g{Y, (const bf16*)(ws + WS_WOUT0), NTOK, DM, DM}; pg8::StaticOrder S; S.init(NTOK, DM, G, bx);
        pg8::EpiRes E{x_in, nullptr, XB, DM};
        pg8::gemm_phase<pg8::EpiRes, pg8::StaticOrder, true>(lds, g, S, E);
    }
    SEAM(4);

    moe_block<0>(args, lds, bar, lo, hi_ph);
    SEAM(8);
            if (IN(9)) REP(9) {
                pg8::Gemm g{HB, (const bf16*)(ws + WS_WIN1), NTOK, OD_IN, DM}; pg8::StaticOrder S; S.init(NTOK, OD_IN, G, bx);
                if (QK_FP8) { pg8::EpiQKV8 E{ws + WS_Q1, ws + WS_K8T1, (bf16*)(ws + WS_V1), C2 * 8.0f, true};
                    pg8::gemm_phase<pg8::EpiQKV8, pg8::StaticOrder, true>(lds, g, S, E); }
                else { pg8::EpiBf16 E{(bf16*)(ws + WS_Q1), DM, DM, (size_t)(WS_K1 - WS_Q1) / 2, C2, 0xffff, false};
                pg8::gemm_phase<pg8::EpiBf16, pg8::StaticOrder, true>(lds, g, S, E); }
            }
            SEAM(9);
            if (ATTN_L1_VER == 3) {
            if (IN(10)) {
                const bf16* V1 = (const bf16*)(ws + WS_V1);
                for (int it = bx * 512 + tid; it < 32 * 128 * 4 * 128; it += G * 512) { const int d = it & 127, c = (it >> 7) & 3, tt = (it >> 9) & 127, bh = it >> 16;
                    const bf16* vb_ = V1 + (((size_t)bh * 128 + tt) * 4 + (d >> 5)) * 2048 + (d & 31); unsigned w4[4];
#pragma unroll
                    for (int q = 0; q < 4; ++q) { float f[4];
#pragma unroll
                        for (int j = 0; j < 4; ++j) { const int bb = q * 4 + j; const int key = 32 * (c & 1) + (bb & 3) + 8 * (bb >> 2) + 4 * (c >> 1); f[j] = bf2f(vb_[(size_t)key * 32]); }
                        int dw = __builtin_amdgcn_cvt_pk_fp8_f32(f[0], f[1], 0, false); dw = __builtin_amdgcn_cvt_pk_fp8_f32(f[2], f[3], dw, true); w4[q] = (unsigned)dw; }
                    *(GAS v4u*)(ws + WS_V8T1 + (size_t)it * 16) = (v4u){w4[0], w4[1], w4[2], w4[3]}; }
            }
            SEAM(10);
            if (IN(11)) REP(11) {
                constexpr int UP = NBATCH * 8 * 32; const int upc = (UP + G - 1) / G; const int vcu = (G % 8 == 0) ? (bx % 8) * (G / 8) + bx / 8 : bx;
                LAS float* btbl = (LAS float*)(lds + at3::lds_tbl_off<128>());
                LAS float* sgt = btbl + 272;
                __syncthreads();
                if (tid < 128) sgt[tid] = args.in[17][tid] * (1.0f - LAM_INIT);
                if (wave == 7) { const float lam = __expf(wave_sum(args.in[13][lane] * args.in[14][lane])) - __expf(wave_sum(args.in[15][lane] * args.in[16][lane])) + LAM_INIT; if (lane == 0) sgt[128] = lam; }
                for (int i = 0; i < upc; ++i) {
                    int up = vcu * upc + i; if (up >= UP) break;
                    if (G == 256) up = ((vcu >> 5) * 4 + i) * 32 + (vcu & 31);
                    const int qb = up & 31, h = (up >> 5) & 7, b = up >> 8;
                    __syncthreads();
                    if (tid < 257) btbl[tid] = TBL[TBL_BIAS + h * BIAS_STRIDE + tid] - TBL[TBL_BIAS + h * BIAS_STRIDE + 256];
                    __syncthreads();
                    const size_t row0 = (size_t)b * SEQ + qb * 256; const int bh = b * 8 + h;
                    const unsigned char* Q8 = ws + WS_Q1 + row0 * DM + h * 128; const unsigned char* V8 = ws + WS_V8T1 + (size_t)bh * 128 * 8192;
                    at3::attn_unit<128, true, 1>(Q8, DM, ws + WS_K8T1 + (size_t)(bh * 2) * 128 * 4096, V8, nullptr, DM, qb * 256, lds, sgt);
                    at3::attn_unit<128, true, 2>(Q8 + 64, DM, ws + WS_K8T1 + (size_t)(bh * 2 + 1) * 128 * 4096, V8, Y + row0 * DM + h * 128, DM, qb * 256, lds, sgt);
                }
            }
            SEAM(11);
            } else {
            if (IN(10)) REP(10) {
                const bf16* Q1 = (const bf16*)(ws + WS_Q1); const bf16* K1 = (const bf16*)(ws + WS_K1); const bf16* V1 = (const bf16*)(ws + WS_V1);
                if (ATTN_L1_VER == 0) {
                LAS float* btbl = (LAS float*)(lds + 65536);
                for (int un = bx; un < NBATCH * 8 * 2 * 32; un += G) {
                    const int qb = un & 31, c = (un >> 5) & 1, h = (un >> 6) & 7, b = un >> 9;
                    __syncthreads();
                    if (tid < 257) btbl[tid] = TBL[TBL_BIAS + h * BIAS_STRIDE + tid];
                    __syncthreads();
                    const size_t row0 = (size_t)b * SEQ + qb * 256, brow = (size_t)b * SEQ;
                    bf16* OC = (bf16*)(ws + (c ? WS_OC1 : WS_OC0));
                    attn_unit_v0<128, true>(Q1 + row0 * DM + h * 128 + c * 64, DM, K1 + brow * DM + h * 128 + c * 64, DM, V1 + brow * DM + h * 128, DM,
                                           OC + row0 * DM + h * 128, DM, btbl, qb * 256, lds);
                }
                } else {
                constexpr int UP = NBATCH * 8 * 32; const int upc = (UP + G - 1) / G; const int vcu = (G % 8 == 0) ? (bx % 8) * (G / 8) + bx / 8 : bx;
                LAS float* btbl = (LAS float*)(lds + at1::lds_tbl_off<128, QK_FP8 != 0>());
                LAS float* sgt = btbl + 272;
                __syncthreads();
                if (tid < 128) sgt[tid] = args.in[17][tid] * (1.0f - LAM_INIT);
                if (wave == 7) { const float lam = __expf(wave_sum(args.in[13][lane] * args.in[14][lane])) - __expf(wave_sum(args.in[15][lane] * args.in[16][lane])) + LAM_INIT; if (lane == 0) sgt[128] = lam; }
                for (int i = 0; i < upc; ++i) {
                    int up = vcu * upc + i; if (up >= UP) break;
                    if (G == 256) up = ((vcu >> 5) * 4 + i) * 32 + (vcu & 31);
                    const int qb = up & 31, h = (up >> 5) & 7, b = up >> 8;
                    __syncthreads();
                    if (tid < 257) btbl[tid] = TBL[TBL_BIAS + h * BIAS_STRIDE + tid] - TBL[TBL_BIAS + h * BIAS_STRIDE + 256];
                    __syncthreads();
                    const size_t row0 = (size_t)b * SEQ + qb * 256, brow = (size_t)b * SEQ;
                    if (QK_FP8) { const unsigned char* Q8 = ws + WS_Q1; const unsigned char* K8 = ws + WS_K1;
                    const int bh = b * 8 + h; const bf16* VT = V1 + (size_t)bh * 128 * 8192; const unsigned char* KT0 = ws + WS_K8T1 + (size_t)(bh * 2) * 128 * 4096; (void)K8; (void)brow;
                    at1::attn_unit<128, true, 0, 1, true, true>((const bf16*)(Q8 + row0 * DM + h * 128), DM, (const bf16*)KT0, DM, VT, DM, nullptr, DM, qb * 256, lds, sgt);
                    at1::attn_unit<128, true, 0, 2, true, true>((const bf16*)(Q8 + row0 * DM + h * 128 + 64), DM, (const bf16*)(KT0 + 128 * 4096), DM, VT, DM, Y + row0 * DM + h * 128, DM, qb * 256, lds, sgt);
                    } else {
                    at1::attn_unit<128, true, 0, 1>(Q1 + row0 * DM + h * 128, DM, K1 + brow * DM + h * 128, DM, V1 + brow * DM + h * 128, DM, nullptr, DM, qb * 256, lds, sgt);
                    at1::attn_unit<128, true, 0, 2>(Q1 + row0 * DM + h * 128 + 64, DM, K1 + brow * DM + h * 128 + 64, DM, V1 + brow * DM + h * 128, DM, Y + row0 * DM + h * 128, DM, qb * 256, lds, sgt);
                    }
                }
                }
            }
            SEAM(10);
            if (PROBE_ATT >= 0 && IN(10)) {
                const bf16* Q1 = (const bf16*)(ws + WS_Q1); const bf16* K1 = (const bf16*)(ws + WS_K1); const bf16* V1 = (const bf16*)(ws + WS_V1);
                constexpr int U = NBATCH * 8 * 2 * 32; const int upc = (U + G - 1) / G; const int vcu = (G % 8 == 0) ? (bx % 8) * (G / 8) + bx / 8 : bx;
                LAS float* btbl = (LAS float*)(lds + 3 * 8192 + 3 * 16384 + 2048);
                for (int i = 0; i < upc; ++i) {
                    int un = vcu * upc + i; if (un >= U) break;
                    if (G == 256) un = ((vcu >> 5) * 4 + (i >> 1)) * 64 + (i & 1) * 32 + (vcu & 31);
                    const int qb = un & 31, c = (un >> 5) & 1, h = (un >> 6) & 7, b = un >> 9;
                    if (tid < 257) btbl[tid] = TBL[TBL_BIAS + h * BIAS_STRIDE + tid] - TBL[TBL_BIAS + h * BIAS_STRIDE + 256];
                    __syncthreads();
                    const size_t row0 = (size_t)b * SEQ + qb * 256, brow = (size_t)b * SEQ;
                    at1::attn_unit<128, true, (PROBE_ATT >= 0 ? PROBE_ATT : 0)>(Q1 + row0 * DM + h * 128 + c * 64, DM, K1 + brow * DM + h * 128 + c * 64, DM, V1 + brow * DM + h * 128, DM,
                                              (bf16*)(ws + WS_OC1) + row0 * DM + h * 128, DM, qb * 256, lds);
                }
                xcd_barrier(bar);
            }
            if (IN(11) && ATTN_L1_VER != 1) REP(11) {
                const bf16* OC0 = (const bf16*)(ws + WS_OC0); const bf16* OC1 = (const bf16*)(ws + WS_OC1);
                const float lam = __expf(wave_sum(args.in[13][lane] * args.in[14][lane])) - __expf(wave_sum(args.in[15][lane] * args.in[16][lane])) + LAM_INIT;
                float sg[16];
#pragma unroll
                for (int j = 0; j < 16; ++j) sg[j] = args.in[17][(lane & 7) * 16 + j] * (1.0f - LAM_INIT);
                for (int m = gw; m < NTOK; m += NGW) {
                    const GAS v4u* a = (const GAS v4u*)(OC0 + (size_t)m * DM) + lane * 2; const GAS v4u* c = (const GAS v4u*)(OC1 + (size_t)m * DM) + lane * 2;
                    float o[16]; float ss = 0.f;
#pragma unroll
                    for (int q = 0; q < 2; ++q) { const v4u av = a[q], cv = c[q];
#pragma unroll
                        for (int j = 0; j < 4; ++j) { const unsigned au = av[j], cu = cv[j];
                            const float lo = __builtin_bit_cast(float, au << 16) - lam * __builtin_bit_cast(float, cu << 16);
                            const float hh = __builtin_bit_cast(float, au & 0xffff0000u) - lam * __builtin_bit_cast(float, cu & 0xffff0000u);
                            o[q * 8 + 2 * j] = lo; o[q * 8 + 2 * j + 1] = hh; ss += lo * lo + hh * hh; } }
                    ss += __shfl_xor(ss, 1); ss += __shfl_xor(ss, 2); ss += __shfl_xor(ss, 4);
                    const float rstd = 1.0f / sqrtf(ss * (1.f / 128.f) + 1e-5f);
                    v4u w0, w1;
                    w0.x = pk2(o[0] * rstd * sg[0], o[1] * rstd * sg[1]); w0.y = pk2(o[2] * rstd * sg[2], o[3] * rstd * sg[3]); w0.z = pk2(o[4] * rstd * sg[4], o[5] * rstd * sg[5]); w0.w = pk2(o[6] * rstd * sg[6], o[7] * rstd * sg[7]);
                    w1.x = pk2(o[8] * rstd * sg[8], o[9] * rstd * sg[9]); w1.y = pk2(o[10] * rstd * sg[10], o[11] * rstd * sg[11]); w1.z = pk2(o[12] * rstd * sg[12], o[13] * rstd * sg[13]); w1.w = pk2(o[14] * rstd * sg[14], o[15] * rstd * sg[15]);
                    GAS v4u* yo = (GAS v4u*)(Y + (size_t)m * DM) + lane * 2; yo[0] = w0; yo[1] = w1;
                }
            }
            if (ATTN_L1_VER != 1) SEAM(11);
            }
            if (IN(12)) {
                pg8::Gemm g{Y, (const bf16*)(ws + WS_WOUT1), NTOK, DM, DM}; pg8::StaticOrder S; S.init(NTOK, DM, G, bx);
                pg8::EpiRes E{nullptr, XB, XB, DM};
                pg8::gemm_phase<pg8::EpiRes, pg8::StaticOrder, true>(lds, g, S, E);
            }
            SEAM(12);
    moe_block<1>(args, lds, bar, lo, hi_ph);
#undef IN
#undef SEAM
}

extern "C" void kernel_launch(void* const* d_in, const int* in_sizes, int n_in, void* d_out, int out_size, void* d_ws, size_t ws_size, hipStream_t stream) {
    static int grid = 0;
    if (grid == 0) {
        if (n_in != 27 || in_sizes[0] != NTOK * DM || out_size != NTOK * DM || ws_size < WS_END) { fprintf(stderr, "kernel_launch: unexpected shapes / workspace (n_in %d, ws %zu)\n", n_in, ws_size); grid = -1; return; }
        int dev = 0, cus = 0, per_cu = 0;
        if (hipGetDevice(&dev) != hipSuccess || hipDeviceGetAttribute(&cus, hipDeviceAttributeMultiprocessorCount, dev) != hipSuccess) { grid = -1; return; }
        if (hipFuncSetAttribute((const void*)mk_fwd, hipFuncAttributeMaxDynamicSharedMemorySize, LDS_BYTES) != hipSuccess) { fprintf(stderr, "kernel_launch: hipFuncSetAttribute failed\n"); grid = -1; return; }
        if (hipOccupancyMaxActiveBlocksPerMultiprocessor(&per_cu, (const void*)mk_fwd, NWAVES * 64, LDS_BYTES) != hipSuccess || per_cu < 1) { fprintf(stderr, "kernel_launch: occupancy query says %d\n", per_cu); }
        (void)hipGetLastError();
        grid = cus;
    }
    if (grid < 0) return;
    if (hipMemsetAsync((char*)d_ws + WS_CTL, 0, CTL_ZERO_BYTES, stream) != hipSuccess) return;
    Args a{};
    for (int i = 0; i < 27; ++i) a.in[i] = (const float*)d_in[i];
    a.out = (float*)d_out; a.ws = (unsigned char*)d_ws;
    if (MK_N_LAUNCHES == 1) { a.ph_lo = 0; a.ph_hi = NPHASE; a.li = 0; hipLaunchKernelGGL(mk_fwd, dim3(grid), dim3(NWAVES * 64), LDS_BYTES, stream, a); }
    else { for (int p = 0; p < NPHASE; ++p) for (int r = 0; r < (int)((PROBE_MASK >> p) & 1u) + 1; ++r) { a.ph_lo = p; a.ph_hi = p + 1; a.li = p; hipLaunchKernelGGL(mk_fwd, dim3(grid), dim3(NWAVES * 64), LDS_BYTES, stream, a); } }
}
```

```cpp
#include <hip/hip_runtime.h>
#include <cstdio>
#include <cstdint>

#ifndef MK_N_LAUNCHES
#define MK_N_LAUNCHES 1
#endif

#ifndef ATTN_VER
#define ATTN_VER 3
#endif
#ifndef PROBE_ATT
#define PROBE_ATT -1
#endif
#ifndef QK_FP8
#define QK_FP8 1
#endif
#ifndef ATTN_L0_TEST
#define ATTN_L0_TEST 0
#endif
#ifndef ATTN_L1_VER
#define ATTN_L1_VER 3
#endif
#ifndef MOE_FP8
#define MOE_FP8 1
#endif
#ifndef IN1_FP8
#define IN1_FP8 1
#endif
#ifndef PROBE_MASK
#define PROBE_MASK 0u
#endif
#define REP(k) _Pragma("unroll") for (int rep_ = 0; rep_ < (MK_N_LAUNCHES == 1 ? (int)((PROBE_MASK >> (k)) & 1u) : 0) + 1; ++rep_)
#define GAS __attribute__((address_space(1)))
#define LAS __attribute__((address_space(3)))
typedef unsigned short bf16;
typedef unsigned v4u __attribute__((ext_vector_type(4)));
typedef unsigned v2u __attribute__((ext_vector_type(2)));
typedef float f32x4 __attribute__((ext_vector_type(4)));
typedef float f32x16 __attribute__((ext_vector_type(16)));
typedef short bf16x8 __attribute__((ext_vector_type(8)));
typedef short s16x4 __attribute__((ext_vector_type(4)));
typedef int v8i __attribute__((ext_vector_type(8)));

constexpr int NTOK = 32768, DM = 1024, SEQ = 8192, NBATCH = 4;
constexpr int EV_IN = 1792, OD_IN = 3072;
constexpr int NEXP = 32, MOE_H = 512, LIST_CAP = 32768;
constexpr float C2 = 0.125f * 1.4426950408889634f;
constexpr float LOG2E = 1.4426950408889634f;
constexpr float LAM_INIT = 0.35550906759f;

constexpr size_t MiB = 1u << 20;
constexpr size_t WS_CTL = 0, CTL_ZERO_BYTES = 1 * MiB;
constexpr size_t WS_WIN0 = 1 * MiB, WS_WOUT0 = 5 * MiB, WS_WIN1 = 7 * MiB, WS_WOUT1 = 13 * MiB, WS_TBL = 15 * MiB;
constexpr size_t WS_W13 = 16 * MiB, WS_W2 = 80 * MiB;
constexpr size_t WS_HB = 112 * MiB;
constexpr size_t WS_Y = 176 * MiB;
constexpr size_t WS_Z0 = 240 * MiB, WS_QR = 352 * MiB, WS_KR = 384 * MiB, WS_QR8 = 392 * MiB, WS_KR8 = 408 * MiB, WS_K8T0 = 408 * MiB, WS_V8T0 = 412 * MiB;
constexpr size_t WS_K8T1 = 304 * MiB, WS_V8T1 = 336 * MiB;
constexpr size_t WS_Q1 = 240 * MiB, WS_K1 = 304 * MiB, WS_V1 = 368 * MiB, WS_OC1 = 432 * MiB, WS_OC0 = WS_HB;
constexpr size_t WS_H = 176 * MiB, WS_YS = 248 * MiB, WS_LIST = 392 * MiB, WS_TOKEP = 396 * MiB, WS_GATE = 396 * MiB + 512 * 1024;
constexpr size_t WS_XB = 432 * MiB;
constexpr size_t WS_END = 496 * MiB;
constexpr int TBL_COS = 0, TBL_SIN = 2048, TBL_BIAS = 4096, BIAS_STRIDE = 272;
constexpr int TBL_WR = 32768, WR_LAYER = 1024 * 48 + 64;
constexpr int CW_BAR = 4096;
constexpr int CW_CNT = 16384;

constexpr int RING_BYTES = 131072;
constexpr int LDS_BYTES = 147456;
constexpr int LDSCTL_OFF = LDS_BYTES - 1024;
constexpr int STASH_OFF = 78 * 1024;
constexpr int LC_BAR = 8;
constexpr int LC_TP = 16;
constexpr int LC_CNT = 64;
constexpr int LC_LCNT = 96;
constexpr int LC_LBASE = 128;
constexpr int LC_LP = 160;

#define LDS_WAIT() asm volatile("s_waitcnt lgkmcnt(0)" ::: "memory")
#define VM_WAIT() asm volatile("s_waitcnt vmcnt(0)" ::: "memory")
#define RLX_AGENT __ATOMIC_RELAXED, __HIP_MEMORY_SCOPE_AGENT

__device__ __forceinline__ unsigned f2bf(float f) { unsigned u = __builtin_bit_cast(unsigned, f); return (u + 0x7fffu + ((u >> 16) & 1u)) >> 16; }
__device__ __forceinline__ unsigned pk2(float lo, float hi) { return f2bf(lo) | (f2bf(hi) << 16); }
__device__ __forceinline__ float bf2f(unsigned short b) { return __builtin_bit_cast(float, (unsigned)b << 16); }
template <int CTRL> __device__ __forceinline__ float dpp_mov(float v) { return __builtin_bit_cast(float, __builtin_amdgcn_update_dpp(0, __builtin_bit_cast(int, v), CTRL, 0xf, 0xf, true)); }
__device__ __forceinline__ float wave_sum(float v) {
    v += dpp_mov<0xB1>(v); v += dpp_mov<0x4E>(v); v += dpp_mov<0x141>(v); v += dpp_mov<0x140>(v);
    { auto rr = __builtin_amdgcn_permlane16_swap(__float_as_uint(v), __float_as_uint(v), false, false); v = __uint_as_float(rr[0]) + __uint_as_float(rr[1]); }
    { auto rr = __builtin_amdgcn_permlane32_swap(__float_as_uint(v), __float_as_uint(v), false, false); v = __uint_as_float(rr[0]) + __uint_as_float(rr[1]); }
    return v;
}


__device__ __forceinline__ unsigned fp8_byte(float v) { return (unsigned)__builtin_amdgcn_cvt_pk_fp8_f32(v, v, 0, false) & 0xffu; }
__device__ __forceinline__ unsigned quad_pack_bytes(unsigned b) {
    const unsigned x0 = (unsigned)__builtin_amdgcn_update_dpp(0, (int)b, 0x00, 0xf, 0xf, true), x1 = (unsigned)__builtin_amdgcn_update_dpp(0, (int)b, 0x55, 0xf, 0xf, true);
    const unsigned x2 = (unsigned)__builtin_amdgcn_update_dpp(0, (int)b, 0xAA, 0xf, 0xf, true), x3 = (unsigned)__builtin_amdgcn_update_dpp(0, (int)b, 0xFF, 0xf, 0xf, true);
    return x0 | (x1 << 8) | (x2 << 16) | (x3 << 24);
}
namespace pg8 {
#define PG8_LAS __attribute__((address_space(3)))
typedef unsigned short bf16_t;
typedef short bf16x8 __attribute__((ext_vector_type(8)));
typedef float f32x4 __attribute__((ext_vector_type(4)));
typedef unsigned u32x4 __attribute__((ext_vector_type(4)));
constexpr int BM = 256, BK = 64, HALF = 128, HTB = HALF * BK * 2, STAGE_BYTES = 8 * HTB, NXCD = 8, WGM = 8;

__host__ __device__ __forceinline__ int lds_byte(int r, int c) { const int st = (r >> 4) * 2 + (c >> 5), rr = r & 15, cc = c & 31, ob = rr * 64 + cc * 2; return st * 1024 + (ob ^ (((ob >> 9) & 1) << 5)); }
__host__ __device__ __forceinline__ void stage_rc(int b, int& R, int& C) { const int st = b / 1024, sb = b % 1024, swz = sb ^ (((sb >> 9) & 1) << 5); R = (st >> 1) * 16 + swz / 64; C = (st & 1) * 32 + (swz % 64) / 2; }
__host__ __device__ __forceinline__ int perm32(int rho) { const int n = rho >> 4, i = rho & 15; return 8 * (i >> 2) + 4 * n + (i & 3); }

struct Unit { int pm, pn, e, rb; };
struct Gemm { const bf16_t* A; const bf16_t* Bt; int M, N, K; };

struct StaticOrder {
    int nM, nN, nwg, G, c;
    __device__ void init(int M, int N, int G_, int c_) { nM = M / BM; nN = N / BM; nwg = nM * nN; G = G_; c = c_; }
    __device__ bool next(int i, Unit& u) const {
        const long L = (long)i * G + c; if (L >= nwg) return false;
        int wgid = (int)L; { const int q = nwg / NXCD, r = nwg % NXCD, xcd = wgid % NXCD, off = wgid / NXCD; wgid = (xcd < r ? xcd * (q + 1) : r * (q + 1) + (xcd - r) * q) + off; }
        const int nig = WGM * nN, gid = wgid / nig, fm = gid * WGM, gsz = (nM - fm) < WGM ? (nM - fm) : WGM;
        u.pm = fm + ((wgid % nig) % gsz); u.pn = (wgid % nig) / gsz; u.e = 0; u.rb = 0; return true;
    }
    __device__ __forceinline__ unsigned arow(const Unit& u, int rr) const { return (unsigned)(u.pm * BM + rr); }
};

struct MoeOrder {
    const PG8_LAS int* tp; const PG8_LAS int* cn; const PG8_LAS int* lp; const int* list; int G, c, nunits; bool gather; bool xcd;
    __device__ __forceinline__ bool next(int i, Unit& u) const {
        int e_, rb_, pm_, pnl_; bool ok;
        if (xcd) {
            const int x = c & 7, y = c >> 3; const int uidx = i * 32 + y; ok = uidx < lp[4] * 4;
            const int rbl = uidx >> 2; pnl_ = uidx & 3; int j = 0;
#pragma unroll
            for (int q = 1; q < 4; ++q) j += (lp[q] <= rbl) ? 1 : 0;
            e_ = x + 8 * j; rb_ = rbl - lp[j]; pm_ = tp[e_] + rb_;
        } else {
            const int L = i * G + c; ok = L < nunits;
            const int rbg = L >> 2; pnl_ = L & 3; int e = 0;
#pragma unroll
            for (int j = 1; j < 32; ++j) e += (tp[j] <= rbg) ? 1 : 0;
            e_ = e; pm_ = rbg; rb_ = rbg - tp[e];
        }
        u.e = __builtin_amdgcn_readfirstlane(e_); u.rb = __builtin_amdgcn_readfirstlane(rb_); u.pm = __builtin_amdgcn_readfirstlane(pm_); u.pn = __builtin_amdgcn_readfirstlane(e_ * 4 + pnl_);
        return ok;
    }
    __device__ __forceinline__ unsigned arow(const Unit& u, int rr) const {
        if (!gather) return (unsigned)(u.pm * BM + rr);
        const int idx = u.rb * BM + rr; unsigned t = 0u;
        if (idx < cn[u.e]) t = (unsigned)list[(size_t)u.e * 32768 + idx];
        return t;
    }
};

__device__ __forceinline__ unsigned cvt_pk_bf16(float lo, float hi) { unsigned r; asm volatile("v_cvt_pk_bf16_f32 %0, %1, %2" : "=v"(r) : "v"(lo), "v"(hi)); return r; }

struct EpiBf16 {
    static constexpr bool PERM = true;
    bf16_t* O; int ldc; int split_cols; size_t split_stride; float scale0; int pn_mask; bool f8;
    __device__ __forceinline__ void operator()(const f32x4 (&acc)[2][2][4][2], const Unit& u, int wr, int wc, int fr, int fq) const {
        const int row0 = u.pm * BM + wr * 64 + fr; int colt = (u.pn & pn_mask) * BM; bf16_t* base = O;
        float sc = 1.f; if (split_cols) { const int t = colt / split_cols; base += (size_t)t * split_stride; colt -= t * split_cols; if (t == 0) sc = scale0; }
        if (f8) sc = 8.0f;
        const int col0 = colt + wc * 32 + 8 * fq;
#pragma unroll
        for (int ai = 0; ai < 2; ++ai)
#pragma unroll
            for (int m = 0; m < 4; ++m) { const size_t ro = (size_t)(row0 + ai * HALF + m * 16) * ldc + col0;
#pragma unroll
                for (int bj = 0; bj < 2; ++bj) { f32x4 v0 = acc[ai][bj][m][0] * sc, v1 = acc[ai][bj][m][1] * sc;
                    if (f8) { typedef unsigned u32x2 __attribute__((ext_vector_type(2)));
                        int d0 = __builtin_amdgcn_cvt_pk_fp8_f32(v0[0], v0[1], 0, false); d0 = __builtin_amdgcn_cvt_pk_fp8_f32(v0[2], v0[3], d0, true);
                        int d1 = __builtin_amdgcn_cvt_pk_fp8_f32(v1[0], v1[1], 0, false); d1 = __builtin_amdgcn_cvt_pk_fp8_f32(v1[2], v1[3], d1, true);
                        *(u32x2*)((unsigned char*)base + ro + bj * HALF) = (u32x2){(unsigned)d0, (unsigned)d1};
                    } else {
                    u32x4 w; w.x = cvt_pk_bf16(v0[0], v0[1]); w.y = cvt_pk_bf16(v0[2], v0[3]); w.z = cvt_pk_bf16(v1[0], v1[1]); w.w = cvt_pk_bf16(v1[2], v1[3]);
                    *(u32x4*)(base + ro + bj * HALF) = w; } } }
    }
};
struct EpiRes {
    static constexpr bool PERM = true;
    const float* base32; const bf16_t* base16; bf16_t* out; int ldc;
    __device__ __forceinline__ void operator()(const f32x4 (&acc)[2][2][4][2], const Unit& u, int wr, int wc, int fr, int fq) const {
        const int row0 = u.pm * BM + wr * 64 + fr, col0 = u.pn * BM + wc * 32 + 8 * fq;
#pragma unroll
        for (int ai = 0; ai < 2; ++ai)
#pragma unroll
            for (int m = 0; m < 4; ++m) { const size_t off = (size_t)(row0 + ai * HALF + m * 16) * ldc + col0;
#pragma unroll
                for (int bj = 0; bj < 2; ++bj) { f32x4 b0, b1;
                    if (base32) { b0 = *(const f32x4*)(base32 + off + bj * HALF); b1 = *(const f32x4*)(base32 + off + bj * HALF + 4); }
                    else { const u32x4 w = *(const u32x4*)(base16 + off + bj * HALF);
                        b0 = (f32x4){__builtin_bit_cast(float, w.x << 16), __builtin_bit_cast(float, w.x & 0xffff0000u), __builtin_bit_cast(float, w.y << 16), __builtin_bit_cast(float, w.y & 0xffff0000u)};
                        b1 = (f32x4){__builtin_bit_cast(float, w.z << 16), __builtin_bit_cast(float, w.z & 0xffff0000u), __builtin_bit_cast(float, w.w << 16), __builtin_bit_cast(float, w.w & 0xffff0000u)}; }
                    const f32x4 v0 = b0 + acc[ai][bj][m][0], v1 = b1 + acc[ai][bj][m][1];
                    u32x4 o; o.x = cvt_pk_bf16(v0[0], v0[1]); o.y = cvt_pk_bf16(v0[2], v0[3]); o.z = cvt_pk_bf16(v1[0], v1[1]); o.w = cvt_pk_bf16(v1[2], v1[3]);
                    *(u32x4*)(out + off + bj * HALF) = o; } }
    }
};
struct EpiQKV8 {
    static constexpr bool PERM = true;
    unsigned char* Q8; unsigned char* K8; bf16_t* V; float qscale; bool ktiled;
    __device__ __forceinline__ void operator()(const f32x4 (&acc)[2][2][4][2], const Unit& u, int wr, int wc, int fr, int fq) const {
        const int row0 = u.pm * BM + wr * 64 + fr; const int colt = u.pn * BM; const int t = colt >> 10; const int col0 = (colt & 1023) + wc * 32 + 8 * fq;
        const float sc = t == 0 ? qscale : 1.0f;
#pragma unroll
        for (int ai = 0; ai < 2; ++ai)
#pragma unroll
            for (int m = 0; m < 4; ++m) { const size_t ro = (size_t)(row0 + ai * HALF + m * 16) * 1024 + col0;
#pragma unroll
                for (int bj = 0; bj < 2; ++bj) { const f32x4 v0 = acc[ai][bj][m][0] * sc, v1 = acc[ai][bj][m][1] * sc;
                    if (t == 2) { u32x4 w; w.x = cvt_pk_bf16(v0[0], v0[1]); w.y = cvt_pk_bf16(v0[2], v0[3]); w.z = cvt_pk_bf16(v1[0], v1[1]); w.w = cvt_pk_bf16(v1[2], v1[3]);
                        if (ktiled) { const int mrow = row0 + ai * HALF + m * 16, n = col0 + bj * HALF; const int bh = (mrow >> 13) * 8 + (n >> 7), sq = mrow & 8191, d = n & 127;
                            *(u32x4*)(V + (((size_t)bh * 128 + (sq >> 6)) * 4 + (d >> 5)) * 2048 + (sq & 63) * 32 + (d & 31)) = w; }
                        else *(u32x4*)(V + ro + bj * HALF) = w; }
                    else { int d0 = __builtin_amdgcn_cvt_pk_fp8_f32(v0[0], v0[1], 0, false); d0 = __builtin_amdgcn_cvt_pk_fp8_f32(v0[2], v0[3], d0, true);
                        int d1 = __builtin_amdgcn_cvt_pk_fp8_f32(v1[0], v1[1], 0, false); d1 = __builtin_amdgcn_cvt_pk_fp8_f32(v1[2], v1[3], d1, true);
                        typedef int i32x2 __attribute__((ext_vector_type(2)));
                        if (t == 1 && ktiled) { const int mrow = row0 + ai * HALF + m * 16, n = col0 + bj * HALF; const int strm = ((mrow >> 13) * 8 + (n >> 7)) * 2 + ((n >> 6) & 1), sq = mrow & 8191, dd = n & 63;
                            *(i32x2*)(K8 + ((((size_t)strm * 128 + (sq >> 6)) * 4 + (dd >> 4)) * 64 + (sq & 63)) * 16 + (dd & 15)) = (i32x2){d0, d1}; }
                        else *(i32x2*)((t == 0 ? Q8 : K8) + ro + bj * HALF) = (i32x2){d0, d1}; } } }
    }
};
__device__ __forceinline__ float silu_mul(float a, float b) { return a * b * __builtin_amdgcn_rcpf(1.0f + __builtin_amdgcn_exp2f(-a * 1.4426950408889634f)); }
struct EpiSwiglu {
    static constexpr bool PERM = true;
    bf16_t* O; bool f8;
    __device__ __forceinline__ void operator()(const f32x4 (&acc)[2][2][4][2], const Unit& u, int wr, int wc, int fr, int fq) const {
        const int row0 = u.pm * BM + wr * 64 + fr, col0 = (u.pn & 3) * 128 + wc * 32 + 8 * fq;
#pragma unroll
        for (int ai = 0; ai < 2; ++ai)
#pragma unroll
            for (int m = 0; m < 4; ++m) { const size_t ro = (size_t)(row0 + ai * HALF + m * 16) * 512 + col0;
                const f32x4 a0 = acc[ai][0][m][0], a1 = acc[ai][0][m][1], b0 = acc[ai][1][m][0], b1 = acc[ai][1][m][1];
                if (f8) { typedef unsigned u32x2 __attribute__((ext_vector_type(2)));
                    int d0 = __builtin_amdgcn_cvt_pk_fp8_f32(4.f * silu_mul(a0[0], b0[0]), 4.f * silu_mul(a0[1], b0[1]), 0, false); d0 = __builtin_amdgcn_cvt_pk_fp8_f32(4.f * silu_mul(a0[2], b0[2]), 4.f * silu_mul(a0[3], b0[3]), d0, true);
                    int d1 = __builtin_amdgcn_cvt_pk_fp8_f32(4.f * silu_mul(a1[0], b1[0]), 4.f * silu_mul(a1[1], b1[1]), 0, false); d1 = __builtin_amdgcn_cvt_pk_fp8_f32(4.f * silu_mul(a1[2], b1[2]), 4.f * silu_mul(a1[3], b1[3]), d1, true);
                    *(u32x2*)((unsigned char*)O + ro) = (u32x2){(unsigned)d0, (unsigned)d1};
                } else {
                u32x4 w; w.x = cvt_pk_bf16(silu_mul(a0[0], b0[0]), silu_mul(a0[1], b0[1])); w.y = cvt_pk_bf16(silu_mul(a0[2], b0[2]), silu_mul(a0[3], b0[3]));
                w.z = cvt_pk_bf16(silu_mul(a1[0], b1[0]), silu_mul(a1[1], b1[1])); w.w = cvt_pk_bf16(silu_mul(a1[2], b1[2]), silu_mul(a1[3], b1[3]));
                *(u32x4*)(O + ro) = w; } }
    }
};

template <class Epi, class Sched, bool ALIGN_EPI, bool F8 = false, int SCA = 127, int SCB = 127>
__device__ __forceinline__ void gemm_phase(PG8_LAS unsigned char* lds, const Gemm g, const Sched& S, const Epi& E) {
    const int tid = threadIdx.x, wid = __builtin_amdgcn_readfirstlane(tid >> 6), lane = tid & 63, wr = wid >> 2, wc = wid & 3, fr = lane & 15, fq = lane >> 4;
    const int K = g.K, nt = K / BK;
    int RA[2], CA[2]; unsigned voffB[2];
#pragma unroll
    for (int i = 0; i < 2; ++i) { int R, C; stage_rc(tid * 16 + i * 8192, R, C); RA[i] = R; CA[i] = C; const int Rb = Epi::PERM ? ((R & ~31) + perm32(R & 31)) : R; voffB[i] = (unsigned)(Rb * K + C) * 2u; }
    const size_t kstep = (size_t)(BK * 2);
    const size_t hstep = (size_t)HALF * K * 2;
    const size_t tstep = 2 * hstep;
    const unsigned ldsw = (unsigned)wid * 1024u;
    const int aoff = lds_byte(wr * 64 + fr, fq * 8), boff = lds_byte(wc * 32 + fr, fq * 8);
#define PG8_SA(b, h) (((b) * 2 + (h)) * HTB)
#define PG8_SB(b, h) ((4 + (b) * 2 + (h)) * HTB)
#define PG8_STAGE(bufoff, gbase, voff) do { _Pragma("unroll") for (int _i = 0; _i < 2; ++_i) \
        __builtin_amdgcn_global_load_lds((const unsigned*)((const char*)(gbase) + (voff)[_i]), (PG8_LAS unsigned*)(lds + (bufoff) + ldsw + _i * 8192), 16, 0, 0); } while (0)
#define PG8_LD8(p_) ({ typedef int v4i_ __attribute__((ext_vector_type(4))); const v4i_ lo_ = *(const PG8_LAS v4i_*)(p_), hi_ = *(const PG8_LAS v4i_*)((p_) + 1024); __builtin_shufflevector(lo_, hi_, 0, 1, 2, 3, 4, 5, 6, 7); })
#define PG8_LDA(dst, b, h) do { if (F8) { _Pragma("unroll") for (int m = 0; m < 4; ++m) dst##8[m] = PG8_LD8(lds + PG8_SA(b, h) + aoff + m * 2048); } \
        else { _Pragma("unroll") for (int m = 0; m < 4; ++m) _Pragma("unroll") for (int k = 0; k < 2; ++k) dst[m][k] = *(const PG8_LAS bf16x8*)(lds + PG8_SA(b, h) + aoff + m * 2048 + k * 1024); } } while (0)
#define PG8_LDB(dst, b, h) do { if (F8) { _Pragma("unroll") for (int n = 0; n < 2; ++n) dst##8[n] = PG8_LD8(lds + PG8_SB(b, h) + boff + n * 2048); } \
        else { _Pragma("unroll") for (int n = 0; n < 2; ++n) _Pragma("unroll") for (int k = 0; k < 2; ++k) dst[n][k] = *(const PG8_LAS bf16x8*)(lds + PG8_SB(b, h) + boff + n * 2048 + k * 1024); } } while (0)
#define PG8_MMA(ai, bj, At, Bt) do { __builtin_amdgcn_s_setprio(1); \
        if (F8) { _Pragma("unroll") for (int m = 0; m < 4; ++m) _Pragma("unroll") for (int n = 0; n < 2; ++n) \
            asm volatile("v_mfma_scale_f32_16x16x128_f8f6f4 %0, %1, %2, %0, %3, %4 op_sel_hi:[0,0,0]" : "+v"(acc[ai][bj][m][n]) : "v"(Bt##8[n]), "v"(At##8[m]), "v"(scb_), "v"(sca_)); } \
        else { _Pragma("unroll") for (int m = 0; m < 4; ++m) _Pragma("unroll") for (int n = 0; n < 2; ++n) _Pragma("unroll") for (int k = 0; k < 2; ++k) \
        acc[ai][bj][m][n] = __builtin_amdgcn_mfma_f32_16x16x32_bf16(Bt[n][k], At[m][k], acc[ai][bj][m][n], 0, 0, 0); } __builtin_amdgcn_s_setprio(0); } while (0)
#define PG8_WAIT_V(n) asm volatile("s_waitcnt vmcnt(" #n ")" ::: "memory")
#define PG8_WAIT_L(n) asm volatile("s_waitcnt lgkmcnt(" #n ")" ::: "memory")
#define PG8_BAR __builtin_amdgcn_s_barrier()
#define PG8_SCHED __builtin_amdgcn_sched_barrier(0)
#define PG8_AOFF(dst, u) do { _Pragma("unroll") for (int _h = 0; _h < 2; ++_h) _Pragma("unroll") for (int _i = 0; _i < 2; ++_i) dst[_h][_i] = (S.arow(u, _h * HALF + RA[_i]) * (unsigned)K + (unsigned)CA[_i]) * 2u; } while (0)
    Unit cur, nxt; int ui = 0;
    if (!S.next(0, cur)) return;
    f32x4 acc[2][2][4][2];
#pragma unroll
    for (int a = 0; a < 2; ++a)
#pragma unroll
        for (int b = 0; b < 2; ++b)
#pragma unroll
            for (int m = 0; m < 4; ++m)
#pragma unroll
                for (int n = 0; n < 2; ++n) acc[a][b][m][n] = (f32x4){0.f, 0.f, 0.f, 0.f};
    bf16x8 At[4][2], B0[2][2], B1[2][2]; v8i At8[4], B08[2], B18[2]; const int sca_ = SCA * 0x01010101, scb_ = SCB * 0x01010101;
    unsigned offc[2][2], offn[2][2];
    PG8_AOFF(offc, cur);
    const char* const cA = (const char*)g.A; const char* cB = (const char*)g.Bt + (size_t)cur.pn * tstep;
    PG8_STAGE(PG8_SB(0, 0), cB, voffB); PG8_STAGE(PG8_SB(0, 1), cB + hstep, voffB); PG8_STAGE(PG8_SA(0, 0), cA, offc[0]); PG8_STAGE(PG8_SA(0, 1), cA, offc[1]);
    if (wr == 1) PG8_BAR;
    PG8_WAIT_V(2); PG8_BAR;
    PG8_STAGE(PG8_SB(1, 0), cB + kstep, voffB); PG8_STAGE(PG8_SA(1, 0), cA + kstep, offc[0]); PG8_STAGE(PG8_SB(1, 1), cB + hstep + kstep, voffB);
    PG8_WAIT_V(6); PG8_BAR;
    for (;;) {
        const bool has_next = S.next(ui + 1, nxt);
        if (has_next) { PG8_AOFF(offn, nxt); }
        else {
#pragma unroll
            for (int h = 0; h < 2; ++h)
#pragma unroll
                for (int i = 0; i < 2; ++i) offn[h][i] = offc[h][i]; }
        const char* nB = has_next ? (const char*)g.Bt + (size_t)nxt.pn * tstep : cB;
        for (int t = 0; t < nt; t += 2) {
            const bool last = (t == nt - 2);
            const char* a1 = cA + (size_t)(t + 1) * kstep;
            const char* a2 = last ? cA : cA + (size_t)(t + 2) * kstep; const char* b2 = last ? nB : cB + (size_t)(t + 2) * kstep;
            const char* a3 = a2 + kstep; const char* b3 = b2 + kstep;
            unsigned o2[2][2];
#pragma unroll
            for (int h = 0; h < 2; ++h)
#pragma unroll
                for (int i = 0; i < 2; ++i) o2[h][i] = last ? offn[h][i] : offc[h][i];
            PG8_LDB(B0, 0, 0); PG8_LDB(B1, 0, 1); PG8_SCHED; PG8_LDA(At, 0, 0); PG8_STAGE(PG8_SA(1, 1), a1, offc[1]);
            PG8_WAIT_V(8); PG8_WAIT_L(0); PG8_BAR; PG8_MMA(0, 0, At, B0); PG8_MMA(0, 1, At, B1); PG8_BAR; PG8_SCHED;
            PG8_LDA(At, 0, 1); PG8_STAGE(PG8_SB(0, 0), b2, voffB); PG8_STAGE(PG8_SB(0, 1), b2 + hstep, voffB); PG8_STAGE(PG8_SA(0, 0), a2, o2[0]);
            PG8_WAIT_V(8); PG8_WAIT_L(0); PG8_BAR; PG8_MMA(1, 0, At, B0); PG8_MMA(1, 1, At, B1); PG8_BAR; PG8_SCHED;
            PG8_LDB(B0, 1, 0); PG8_LDB(B1, 1, 1); PG8_SCHED; PG8_LDA(At, 1, 0); PG8_STAGE(PG8_SA(0, 1), a2, o2[1]);
            PG8_WAIT_V(8); PG8_WAIT_L(0); PG8_BAR; PG8_MMA(0, 0, At, B0); PG8_MMA(0, 1, At, B1); PG8_BAR; PG8_SCHED;
            PG8_LDA(At, 1, 1); PG8_STAGE(PG8_SB(1, 0), b3, voffB); PG8_STAGE(PG8_SB(1, 1), b3 + hstep, voffB); PG8_STAGE(PG8_SA(1, 0), a3, o2[0]);
            PG8_WAIT_V(8); PG8_WAIT_L(0); PG8_BAR; PG8_MMA(1, 0, At, B0); PG8_MMA(1, 1, At, B1); PG8_BAR; PG8_SCHED;
        }
        if constexpr (ALIGN_EPI) { if (wr == 0) PG8_BAR; }
        if (F8) asm volatile("s_nop 15\n\ts_nop 15" ::: "memory");
        E(acc, cur, wr, wc, fr, fq);
        if (!has_next) break;
#pragma unroll
        for (int a = 0; a < 2; ++a)
#pragma unroll
            for (int b = 0; b < 2; ++b)
#pragma unroll
                for (int m = 0; m < 4; ++m)
#pragma unroll
                    for (int n = 0; n < 2; ++n) acc[a][b][m][n] = (f32x4){0.f, 0.f, 0.f, 0.f};
        cur = nxt; cB = nB; ++ui;
#pragma unroll
        for (int h = 0; h < 2; ++h)
#pragma unroll
            for (int i = 0; i < 2; ++i) offc[h][i] = offn[h][i];
        if constexpr (ALIGN_EPI) { if (wr == 1) PG8_BAR; }
    }
    PG8_WAIT_V(0);
    if constexpr (!ALIGN_EPI) { if (wr == 0) PG8_BAR; }
    PG8_BAR;
#undef PG8_SA
#undef PG8_SB
#undef PG8_STAGE
#undef PG8_LDA
#undef PG8_LDB
#undef PG8_MMA
#undef PG8_LD8
#undef PG8_WAIT_V
#undef PG8_WAIT_L
#undef PG8_BAR
#undef PG8_SCHED
#undef PG8_AOFF
}
}

#define XB_TMO      128
#define XB_XCNT(j)  (256  + 64 * (j))
#define XB_XSUB(j)  (1280 + 64 * (j))
#define XB_XGEN(j)  (2304 + 64 * (j))
#define XB_TOP      3328
#define XB_TOPGEN   3392
#define XCD_BAR_WORDS 3456
#define XB_SPIN_CAP (1u << 18)

__device__ __forceinline__ unsigned xb_ld(unsigned* p)              { return __hip_atomic_load(p, __ATOMIC_RELAXED, __HIP_MEMORY_SCOPE_AGENT); }
__device__ __forceinline__ unsigned xb_add(unsigned* p, unsigned v) { return __hip_atomic_fetch_add(p, v, __ATOMIC_RELAXED, __HIP_MEMORY_SCOPE_AGENT); }
__device__ __forceinline__ unsigned xb_xcc_id() { return (unsigned)__builtin_amdgcn_s_getreg((3 << 11) | 20) & 0xFu; }
#define XB_SPIN(cond, bar) do { unsigned _sp = 0; while (cond) { __builtin_amdgcn_s_sleep(1); \
    if ((++_sp & 255u) == 0u) { if (xb_ld(&(bar)[XB_TMO])) break; if (_sp > XB_SPIN_CAP) { atomicAdd(&(bar)[XB_TMO], 1u); break; } } } } while (0)

struct XcdBarrier { unsigned* bar; unsigned x; volatile LAS unsigned* st; };

__device__ __forceinline__ XcdBarrier xcd_barrier_post(unsigned* bar, volatile LAS unsigned* st) {
    XcdBarrier b; b.bar = bar; b.x = xb_xcc_id(); b.st = st;
    if (threadIdx.x == 0) (void)xb_add(&bar[XB_XCNT(b.x)], 1u);
    return b;
}
__device__ __forceinline__ void xcd_barrier_complete(unsigned* bar, unsigned x, unsigned& nloc, unsigned& nx) {
    const unsigned G = gridDim.x * gridDim.y * gridDim.z;
    unsigned sum, cnt, mine, sp = 0u;
    for (;;) {
        sum = 0u; cnt = 0u; mine = 0u;
#pragma unroll
        for (unsigned j = 0; j < 16; ++j) { const unsigned c = xb_ld(&bar[XB_XCNT(j)]); sum += c; cnt += (c > 0u) ? 1u : 0u; mine = (j == x) ? c : mine; }
        if (sum == G) break;
        __builtin_amdgcn_s_sleep(1);
        if ((++sp & 255u) == 0u) { if (xb_ld(&bar[XB_TMO])) break; if (sp > XB_SPIN_CAP) { atomicAdd(&bar[XB_TMO], 1u); break; } }
    }
    nloc = mine > 0u ? mine : 1u; nx = cnt > 0u ? cnt : 1u;
}
__device__ __forceinline__ void xcd_barrier(const XcdBarrier& b) {
    asm volatile("s_waitcnt vmcnt(0)" ::: "memory");
    __syncthreads();
    if (threadIdx.x == 0) {
        unsigned* bar = b.bar;
        __builtin_amdgcn_s_waitcnt(0);
        unsigned nloc = b.st[0], nx = b.st[1];
        if (nloc == 0u) { xcd_barrier_complete(bar, b.x, nloc, nx); b.st[0] = nloc; b.st[1] = nx; }
        const unsigned old = xb_add(&bar[XB_XSUB(b.x)], 1u);
        const unsigned gen = old / nloc;
        if (old + 1u == (gen + 1u) * nloc) {
            __builtin_amdgcn_fence(__ATOMIC_RELEASE, "agent");
            asm volatile("s_waitcnt vmcnt(0)" ::: "memory");
            const unsigned og = xb_add(&bar[XB_TOP], 1u);
            const unsigned tg = og / nx;
            if (og + 1u == (tg + 1u) * nx) xb_add(&bar[XB_TOPGEN], 1u);
            else XB_SPIN(xb_ld(&bar[XB_TOPGEN]) == tg, bar);
            __builtin_amdgcn_fence(__ATOMIC_ACQUIRE, "agent");
            xb_add(&bar[XB_XGEN(b.x)], 1u);
            asm volatile("s_waitcnt vmcnt(0)" ::: "memory");
        } else {
            XB_SPIN(xb_ld(&bar[XB_XGEN(b.x)]) == gen, bar);
            __builtin_amdgcn_fence(__ATOMIC_ACQUIRE, "agent");
            asm volatile("s_waitcnt vmcnt(0)" ::: "memory");
        }
    }
    __syncthreads();
}

template <bool F8 = false>
__device__ __forceinline__ void transpose_item(const float* W, int K, int N, bf16* WT, int kb, int nb, int dst_row0, LAS float* scr, int lane) {
    const int k0 = 64 * kb, n0 = 32 * nb;
#pragma unroll 8
    for (int i = 0; i < 32; ++i) { const int kk = 2 * i + (lane >> 5); scr[kk * 33 + (lane & 31)] = W[(size_t)(k0 + kk) * N + n0 + (lane & 31)]; }
    LDS_WAIT(); asm volatile("" ::: "memory");
    const int c = lane & 7;
#pragma unroll
    for (int j = 0; j < 4; ++j) { const int n = (lane >> 3) + 8 * j; const LAS float* s = scr + (8 * c) * 33 + n;
        if (F8) {
            int d0 = __builtin_amdgcn_cvt_pk_fp8_f32(s[0 * 33] * 32.f, s[1 * 33] * 32.f, 0, false); d0 = __builtin_amdgcn_cvt_pk_fp8_f32(s[2 * 33] * 32.f, s[3 * 33] * 32.f, d0, true);
            int d1 = __builtin_amdgcn_cvt_pk_fp8_f32(s[4 * 33] * 32.f, s[5 * 33] * 32.f, 0, false); d1 = __builtin_amdgcn_cvt_pk_fp8_f32(s[6 * 33] * 32.f, s[7 * 33] * 32.f, d1, true);
            *(GAS v2u*)((unsigned char*)WT + (size_t)(dst_row0 + n) * K + k0 + 8 * c) = (v2u){(unsigned)d0, (unsigned)d1};
        } else {
        v4u o; o.x = pk2(s[0 * 33], s[1 * 33]); o.y = pk2(s[2 * 33], s[3 * 33]); o.z = pk2(s[4 * 33], s[5 * 33]); o.w = pk2(s[6 * 33], s[7 * 33]);
        *(GAS v4u*)(WT + (size_t)(dst_row0 + n) * K + k0 + 8 * c) = o; } }
    LDS_WAIT(); asm volatile("" ::: "memory");
}
template <bool F8 = false>
__device__ __forceinline__ void transpose_plain(const float* W, int K, int N, bf16* WT, LAS float* scr, int gw, int ngw, int lane) {
    const int nblk = N / 32, nitems = (K / 64) * nblk;
    for (int it = gw; it < nitems; it += ngw) { const int kb = it / nblk, nb = it % nblk; transpose_item<F8>(W, K, N, WT, kb, nb, 32 * nb, scr, lane); }
}
__device__ __forceinline__ void transpose_moe(const float* w1, const float* w3, const float* w2, bf16* W13T, bf16* W2T, LAS float* scr, int gw, int ngw, int lane) {
    constexpr int I13 = 16 * 16, I2 = 8 * 32, IPE = 2 * I13 + I2;
    for (int it = gw; it < NEXP * IPE; it += ngw) {
        const int e = it / IPE; int r = it % IPE;
        if (r < 2 * I13) { const int which = r / I13; r %= I13; const int kb = r / 16, nb = r % 16, n0 = 32 * nb;
            const float* W = (which ? w3 : w1) + (size_t)e * 1024 * 512;
            transpose_item<MOE_FP8 != 0>(W, 1024, 512, (bf16*)((unsigned char*)W13T + (size_t)e * 1024 * 1024 * (MOE_FP8 ? 1 : 2)), kb, nb, (n0 >> 7) * 256 + which * 128 + (n0 & 127), scr, lane);
        } else { r -= 2 * I13; const int kb = r / 32, nb = r % 32;
            transpose_item<MOE_FP8 != 0>(w2 + (size_t)e * 512 * 1024, 512, 1024, (bf16*)((unsigned char*)W2T + (size_t)e * 1024 * 512 * (MOE_FP8 ? 1 : 2)), kb, nb, 32 * nb, scr, lane); }
    }
}
__device__ __forceinline__ void rms_row(const float* xrow, const float* g, f32x4 (&v)[4], int lane) {
    const GAS f32x4* xr = (const GAS f32x4*)xrow + lane; const GAS f32x4* gr = (const GAS f32x4*)g + lane;
    float s = 0.f;
#pragma unroll
    for (int j = 0; j < 4; ++j) { v[j] = xr[64 * j]; s += (v[j].x * v[j].x + v[j].y * v[j].y) + (v[j].z * v[j].z + v[j].w * v[j].w); }
    const float rstd = 1.0f / sqrtf(wave_sum(s) * (1.f / DM) + 1e-6f);
#pragma unroll
    for (int j = 0; j < 4; ++j) { const f32x4 gg = gr[64 * j]; v[j] = v[j] * rstd * gg; }
}
__device__ __forceinline__ void rms_row_b16(const bf16* xrow, const float* g, f32x4 (&v)[4], int lane) {
    const GAS v2u* xr = (const GAS v2u*)xrow + lane; const GAS f32x4* gr = (const GAS f32x4*)g + lane;
    float s = 0.f;
#pragma unroll
    for (int j = 0; j < 4; ++j) { const v2u w = xr[64 * j]; v[j] = (f32x4){__builtin_bit_cast(float, w.x << 16), __builtin_bit_cast(float, w.x & 0xffff0000u), __builtin_bit_cast(float, w.y << 16), __builtin_bit_cast(float, w.y & 0xffff0000u)};
        s += (v[j].x * v[j].x + v[j].y * v[j].y) + (v[j].z * v[j].z + v[j].w * v[j].w); }
    const float rstd = 1.0f / sqrtf(wave_sum(s) * (1.f / DM) + 1e-6f);
#pragma unroll
    for (int j = 0; j < 4; ++j) { const f32x4 gg = gr[64 * j]; v[j] = v[j] * rstd * gg; }
}
__device__ __forceinline__ void store_row_bf16(bf16* orow, const f32x4 (&v)[4], int lane) {
    GAS unsigned long long* o8 = (GAS unsigned long long*)orow + lane;
#pragma unroll
    for (int j = 0; j < 4; ++j) o8[64 * j] = (unsigned long long)pk2(v[j].x, v[j].y) | ((unsigned long long)pk2(v[j].z, v[j].w) << 32);
}

__device__ __forceinline__ int t5_bucket(int rel) {
    const int n = rel < 0 ? -rel : rel; int ret = rel > 0 ? 16 : 0;
    int v;
    if (n < 8) v = n;
    else { const float nf = (float)n; int large = 8 + (int)(logf(nf / 8.0f) / 2.772588722239781f * 8.0f); v = large < 15 ? large : 15; }
    return ret + v;
}

__device__ __forceinline__ int crow(int r, int hi) { return (r & 3) + 8 * (r >> 2) + 4 * hi; }
__device__ __forceinline__ unsigned cvtpk(float lo, float hi) { unsigned r; asm volatile("v_cvt_pk_bf16_f32 %0, %1, %2" : "=v"(r) : "v"(lo), "v"(hi)); return r; }
__device__ __forceinline__ s16x4 vtr(const LAS char* p) { typedef short v4i16_t __attribute__((ext_vector_type(4))); return __builtin_bit_cast(s16x4, __builtin_amdgcn_ds_read_tr16_b64_v4i16((LAS v4i16_t*)p)); }

template <int DV, bool BIAS, bool FP8 = false>
__device__ __forceinline__ void attn_unit_v0(const bf16* Qp, int ldq, const bf16* Kp, int ldk, const bf16* Vp, int ldv, bf16* Op, int ldo, const LAS float* btbl, int q0, LAS unsigned char* lds) {
    const int tid = threadIdx.x, lane = tid & 63, r32 = lane & 31, hi = lane >> 5; const int wid = __builtin_amdgcn_readfirstlane(tid >> 6);
    constexpr int ND = DV / 32;
    LAS unsigned char* ldsK = lds; LAS unsigned char* ldsV = lds + 8192; LAS float* wsf = (LAS float*)(lds + 8192 + DV * 128) + wid * 64;
    bf16x8 qr[4]; v8i q8 = {0, 0, 0, 0, 0, 0, 0, 0};
    if (FP8) { const v4u a = *(const v4u*)((const unsigned char*)Qp + (size_t)(wid * 32 + r32) * ldq + hi * 32), b = *(const v4u*)((const unsigned char*)Qp + (size_t)(wid * 32 + r32) * ldq + hi * 32 + 16);
        q8 = (v8i){(int)a.x, (int)a.y, (int)a.z, (int)a.w, (int)b.x, (int)b.y, (int)b.z, (int)b.w}; }
    else {
#pragma unroll
    for (int d0 = 0; d0 < 4; ++d0) qr[d0] = *(const bf16x8*)(Qp + (size_t)(wid * 32 + r32) * ldq + d0 * 16 + hi * 8); }
    f32x16 o[ND];
#pragma unroll
    for (int d = 0; d < ND; ++d)
#pragma unroll
        for (int r = 0; r < 16; ++r) o[d][r] = 0.f;
    float l = 0.f;
    const int qpos = q0 + wid * 32 + r32;
    const LAS char* kp0 = (const LAS char*)ldsK + hi * 1024 + r32 * 16;
    const LAS char* vp0 = (const LAS char*)ldsV + ((lane >> 4) & 1) * 32 + (lane & 3) * 8 + (4 * hi + ((lane & 15) >> 2)) * 64;
    for (int t = 0; t < SEQ / 64; ++t) {
        __syncthreads();
        {
            if (FP8) { if (wid < 4) { const v4u kv = *(const v4u*)((const unsigned char*)Kp + (size_t)(t * 64 + lane) * ldk + wid * 16); *(LAS v4u*)(ldsK + wid * 1024 + lane * 16) = kv; } }
            else { const v4u kv = *(const v4u*)(Kp + (size_t)(t * 64 + lane) * ldk + wid * 8);
            *(LAS v4u*)(ldsK + wid * 1024 + lane * 16) = kv; }
#pragma unroll
            for (int pp = 0; pp < ND / 2; ++pp) { const int p = wid + 8 * pp, dq = p >> 2, rg = p & 3;
                const v4u vv = *(const v4u*)(Vp + (size_t)(t * 64 + 16 * rg + (lane >> 2)) * ldv + dq * 32 + (lane & 3) * 8);
                *(LAS v4u*)(ldsV + p * 1024 + lane * 16) = vv; }
        }
        __syncthreads();
        f32x16 p0, p1;
#pragma unroll
        for (int r = 0; r < 16; ++r) { p0[r] = 0.f; p1[r] = 0.f; }
        if (FP8) {
            const LAS char* k8 = (const LAS char*)ldsK + hi * 2048 + r32 * 16;
            const v4u a0 = *(const LAS v4u*)(k8), a1 = *(const LAS v4u*)(k8 + 1024), b0 = *(const LAS v4u*)(k8 + 512), b1 = *(const LAS v4u*)(k8 + 1024 + 512);
            const v8i ka = (v8i){(int)a0.x, (int)a0.y, (int)a0.z, (int)a0.w, (int)a1.x, (int)a1.y, (int)a1.z, (int)a1.w};
            const v8i kb = (v8i){(int)b0.x, (int)b0.y, (int)b0.z, (int)b0.w, (int)b1.x, (int)b1.y, (int)b1.z, (int)b1.w};
            p0 = __builtin_amdgcn_mfma_scale_f32_32x32x64_f8f6f4(ka, q8, p0, 0, 0, 0, 0x7f7f7f7f, 0, 0x7c7c7c7c);
            p1 = __builtin_amdgcn_mfma_scale_f32_32x32x64_f8f6f4(kb, q8, p1, 0, 0, 0, 0x7f7f7f7f, 0, 0x7c7c7c7c);
        } else {
#pragma unroll
        for (int d0 = 0; d0 < 4; ++d0) {
            const bf16x8 b0 = *(const LAS bf16x8*)(kp0 + d0 * 2048), b1 = *(const LAS bf16x8*)(kp0 + d0 * 2048 + 512);
            p0 = __builtin_amdgcn_mfma_f32_32x32x16_bf16(b0, qr[d0], p0, 0, 0, 0);
            p1 = __builtin_amdgcn_mfma_f32_32x32x16_bf16(b1, qr[d0], p1, 0, 0, 0);
        } }
        if (BIAS) {
            const int base = t * 64 + 4 * hi - qpos;
#pragma unroll
            for (int r = 0; r < 16; ++r) { int rel = base + (r & 3) + 8 * (r >> 2);
                int i0 = rel < -128 ? -128 : (rel > 128 ? 128 : rel); int rel1 = rel + 32; int i1 = rel1 < -128 ? -128 : (rel1 > 128 ? 128 : rel1);
                p0[r] += btbl[i0 + 128]; p1[r] += btbl[i1 + 128]; }
        }
        float sacc = 0.f;
#pragma unroll
        for (int r = 0; r < 16; ++r) { p0[r] = __builtin_amdgcn_exp2f(p0[r]); p1[r] = __builtin_amdgcn_exp2f(p1[r]); sacc += p0[r] + p1[r]; }
        l += sacc;
        v4u pw[4];
#pragma unroll
        for (int k = 0; k < 2; ++k) {
            pw[k]     = (v4u){cvtpk(p0[8 * k + 0], p0[8 * k + 1]), cvtpk(p0[8 * k + 2], p0[8 * k + 3]), cvtpk(p0[8 * k + 4], p0[8 * k + 5]), cvtpk(p0[8 * k + 6], p0[8 * k + 7])};
            pw[2 + k] = (v4u){cvtpk(p1[8 * k + 0], p1[8 * k + 1]), cvtpk(p1[8 * k + 2], p1[8 * k + 3]), cvtpk(p1[8 * k + 4], p1[8 * k + 5]), cvtpk(p1[8 * k + 6], p1[8 * k + 7])};
        }
#pragma unroll
        for (int d0 = 0; d0 < ND; ++d0)
#pragma unroll
            for (int ks = 0; ks < 4; ++ks) {
                const s16x4 lo = vtr(vp0 + d0 * 4096 + ks * 1024), hh = vtr(vp0 + d0 * 4096 + ks * 1024 + 512);
                const bf16x8 vf = (bf16x8){lo[0], lo[1], lo[2], lo[3], hh[0], hh[1], hh[2], hh[3]};
                o[d0] = __builtin_amdgcn_mfma_f32_32x32x16_bf16(__builtin_bit_cast(bf16x8, pw[ks]), vf, o[d0], 0, 0, 0);
            }
    }
    l += __shfl_xor(l, 32);
    if (hi == 0) wsf[r32] = l;
    LDS_WAIT(); asm volatile("" ::: "memory");
#pragma unroll
    for (int r = 0; r < 16; ++r) { const int row = crow(r, hi); const float rl = 1.0f / wsf[row];
#pragma unroll
        for (int d0 = 0; d0 < ND; ++d0) Op[(size_t)(wid * 32 + row) * ldo + d0 * 32 + r32] = (bf16)f2bf(o[d0][r] * rl); }
    LDS_WAIT();
}

namespace at1 {
#define SBAR() __builtin_amdgcn_sched_barrier(0)
#define PIN(x) asm volatile("" : "+v"(x))
template <int N, bool NOBAR = false> __device__ __forceinline__ void wait_bar() { if (NOBAR) asm volatile("s_waitcnt vmcnt(%0) lgkmcnt(0)" :: "n"(N) : "memory"); else asm volatile("s_waitcnt vmcnt(%0) lgkmcnt(0)\n\ts_barrier" :: "n"(N) : "memory"); }
__device__ __forceinline__ void glds16(const void* gsrc, unsigned lds_dst) { unsigned keep;
    asm volatile("s_mov_b32 %0, m0\n\ts_mov_b32 m0, %2\n\ts_nop 0\n\tglobal_load_lds_dwordx4 %1, off\n\ts_mov_b32 m0, %0" : "=&s"(keep) : "v"(gsrc), "s"(lds_dst) : "memory"); }
typedef float f32x2_t __attribute__((ext_vector_type(2))); typedef __bf16 bf16x2_t __attribute__((ext_vector_type(2)));
__device__ __forceinline__ unsigned cvtpk_s(float lo, float hi) { f32x2_t v = {lo, hi}; bf16x2_t b = __builtin_convertvector(v, bf16x2_t); return __builtin_bit_cast(unsigned, b); }
typedef const LAS char* lds_cptr;
__device__ __forceinline__ void kload2(bf16x8* kf, lds_cptr kp, int j) { kf[2 * j] = *(const LAS bf16x8*)(kp + j * 2048); kf[2 * j + 1] = *(const LAS bf16x8*)(kp + j * 2048 + 512); }

template <int DV, bool FP8> __host__ __device__ constexpr int lds_ws_off() { return (3 * (FP8 ? 4096 : 8192) + 3 * DV * 128) > 512 * DV ? (3 * (FP8 ? 4096 : 8192) + 3 * DV * 128) : 512 * DV; }
template <int DV, bool FP8> __host__ __device__ constexpr int lds_tbl_off() { return lds_ws_off<DV, FP8>() + 2048; }
template <int DV, bool BIAS, int TEST = 0, int MODE = 0, bool FP8 = false, bool TILED = false>
__device__ __forceinline__ void attn_unit(const bf16* Qp, int ldq, const bf16* __restrict__ Kp, int ldk, const bf16* __restrict__ Vp, int ldv, bf16* Op, int ldo, int q0, LAS unsigned char* lds, const LAS float* sgt = nullptr) {
    constexpr int ND = DV / 32, NV = ND / 2, VSLOT = DV * 128, KSLOT = FP8 ? 4096 : 8192, NT = SEQ / 64;
    constexpr int LDS_K = 0, LDS_V = 3 * KSLOT, LDS_WS = lds_ws_off<DV, FP8>(), LDS_TBL = LDS_WS + 2048;
    static_assert(LDS_WS >= LDS_V + 3 * VSLOT && LDS_WS >= 512 * DV && LDS_TBL + 2048 <= STASH_OFF, "LDS map");
    const int tid = threadIdx.x, lane = tid & 63, r32 = lane & 31, hi = lane >> 5; const int wid = __builtin_amdgcn_readfirstlane(tid >> 6);
    const unsigned lds0 = (unsigned)(uintptr_t)lds;
    LAS float* wsf = (LAS float*)(lds + LDS_WS) + wid * 64;
    const LAS float* btbl = (const LAS float*)(lds + LDS_TBL);
    const unsigned char* ksrc = TILED ? (const unsigned char*)Kp + (wid & 3) * 1024 + lane * 16 : FP8 ? (const unsigned char*)Kp + (size_t)lane * ldk + (wid & 3) * 16 : (const unsigned char*)(Kp + (size_t)lane * ldk + wid * 8);
    const bf16* vsrc0 = TILED ? Vp + wid * 512 + lane * 8 : Vp + (size_t)(16 * (wid & 3) + (lane >> 2)) * ldv + (wid >> 2) * 32 + (lane & 3) * 8;
    const bf16* vsrc1 = TILED ? vsrc0 + 4096 : vsrc0 + 64;
    const unsigned kdst = lds0 + LDS_K + wid * 1024, vdst = lds0 + LDS_V + wid * 1024;
#define DMA_K(t, s) if (!(TEST & 8) && (!FP8 || wid < 4)) glds16(ksrc + (size_t)(t) * (TILED ? 4096 : 64 * ldk * (FP8 ? 1 : 2)), (unsigned)__builtin_amdgcn_readfirstlane(kdst + (s) * KSLOT))
#define DMA_V(t, s) do { if (TEST & 8) break; glds16(vsrc0 + (size_t)(t) * (TILED ? (size_t)(DV * 64) : (size_t)64 * ldv), (unsigned)__builtin_amdgcn_readfirstlane(vdst + (s) * VSLOT)); \
        if (NV == 2) glds16(vsrc1 + (size_t)(t) * (TILED ? (size_t)(DV * 64) : (size_t)64 * ldv), (unsigned)__builtin_amdgcn_readfirstlane(vdst + (s) * VSLOT + 8192)); } while (0)
    const lds_cptr kp0 = (lds_cptr)lds + LDS_K + hi * (FP8 ? 2048 : 1024) + r32 * 16;
    const lds_cptr vp0 = (lds_cptr)lds + LDS_V + ((lane >> 4) & 1) * 32 + (lane & 3) * 8 + (4 * hi + ((lane & 15) >> 2)) * 64;
    DMA_K(0, 0); DMA_V(0, 0); DMA_K(1, 1);
    bf16x8 qr[4]; v8i q8 = {0, 0, 0, 0, 0, 0, 0, 0};
    if (FP8) { const unsigned char* qb_ = (const unsigned char*)Qp + (size_t)(wid * 32 + r32) * ldq + hi * 32; const v4u a = *(const v4u*)qb_, b = *(const v4u*)(qb_ + 16);
        q8 = (v8i){(int)a.x, (int)a.y, (int)a.z, (int)a.w, (int)b.x, (int)b.y, (int)b.z, (int)b.w}; }
    else {
#pragma unroll
        for (int d0 = 0; d0 < 4; ++d0) qr[d0] = *(const bf16x8*)(Qp + (size_t)(wid * 32 + r32) * ldq + d0 * 16 + hi * 8); }
    float l_reg = 0.f; f32x16 o[ND];
#pragma unroll
    for (int d = 0; d < ND; ++d) o[d] = f32x16{};
    const f32x16 zero16 = f32x16{};
    const int qw = q0 + wid * 32, qpos = qw + r32;
    int tl = 0, tr = NT; float fL = 1.f;
    if (BIAS) { tl = (qw - 191 >= 0) ? ((qw - 191) >> 6) + 1 : 0; tr = (qw + 158) >> 6; fL = __builtin_amdgcn_exp2f(btbl[0]); }
    f32x16 pA0, pA1, pB0, pB1; bf16x8 kf[8]; v8i kf8[2]; s16x4 vlo[8], vhi[8]; v4u pw0, pw1, pw2, pw3;
#define KLOAD8(n, kp_) do { const v4u a_ = *(const LAS v4u*)((kp_) + (n) * 512), b_ = *(const LAS v4u*)((kp_) + (n) * 512 + 1024); kf8[n] = (v8i){(int)a_.x, (int)a_.y, (int)a_.z, (int)a_.w, (int)b_.x, (int)b_.y, (int)b_.z, (int)b_.w}; } while (0)
#define MF8(kf_, c_) __builtin_amdgcn_mfma_scale_f32_32x32x64_f8f6f4(kf_, q8, c_, 0, 0, 0, 0x7f7f7f7f, 0, 0x7c7c7c7c)
#define WAITB(N) do { if (FP8 && wid >= 4) wait_bar<(N) - 1, (TEST & 16) != 0>(); else wait_bar<(N), (TEST & 16) != 0>(); } while (0)
    if (TEST & 32) { pB0 = f32x16{}; pB1 = f32x16{}; }
    if (TEST & 64) { _Pragma("unroll") for (int i_ = 0; i_ < 8; ++i_) { vlo[i_] = (s16x4){1, 2, 3, 4}; vhi[i_] = (s16x4){4, 3, 2, 1}; } }
    int s_prev = 0, s_cur = 0, s_next = 1;
#define ROT() do { s_prev = s_cur; s_cur = s_next; s_next = (s_next == 2) ? 0 : s_next + 1; } while (0)
#define ADD_BIAS(C0, C1, t) do { if (BIAS && (t) >= tl && (t) <= tr) { const int base_ = (t) * 64 + 4 * hi - qpos; \
        _Pragma("unroll") for (int r = 0; r < 16; ++r) { const int rel0 = base_ + (r & 3) + 8 * (r >> 2); const int rel1 = rel0 + 32; \
            const int i0 = (rel0 < -128 ? -128 : (rel0 > 128 ? 128 : rel0)) + 128, i1 = (rel1 < -128 ? -128 : (rel1 > 128 ? 128 : rel1)) + 128; \
            C0[r] += btbl[i0]; C1[r] += btbl[i1]; } } } while (0)
    DMA_K(2, 2);
    if (FP8) wait_bar<0, (TEST & 16) != 0>(); else wait_bar<NV + 2, (TEST & 16) != 0>();
    {
        if (FP8) { KLOAD8(0, kp0); KLOAD8(1, kp0); pA0 = MF8(kf8[0], zero16); pA1 = MF8(kf8[1], zero16); }
        else {
#pragma unroll
        for (int j = 0; j < 4; ++j) kload2(kf, kp0, j);
        pA0 = __builtin_amdgcn_mfma_f32_32x32x16_bf16(kf[0], qr[0], zero16, 0, 0, 0); pA1 = __builtin_amdgcn_mfma_f32_32x32x16_bf16(kf[1], qr[0], zero16, 0, 0, 0);
#pragma unroll
        for (int d0 = 1; d0 < 4; ++d0) { pA0 = __builtin_amdgcn_mfma_f32_32x32x16_bf16(kf[2 * d0], qr[d0], pA0, 0, 0, 0); pA1 = __builtin_amdgcn_mfma_f32_32x32x16_bf16(kf[2 * d0 + 1], qr[d0], pA1, 0, 0, 0); } }
        ADD_BIAS(pA0, pA1, 0);
#pragma unroll
        for (int r = 0; r < 16; ++r) { pA0[r] = __builtin_amdgcn_exp2f(pA0[r]); pA1[r] = __builtin_amdgcn_exp2f(pA1[r]); }
    }
    wait_bar<0, (TEST & 16) != 0>();
    DMA_K(3, 0); DMA_V(1, 1);
    ROT();
    if (FP8) { KLOAD8(0, kp0 + s_cur * KSLOT); KLOAD8(1, kp0 + s_cur * KSLOT); }
    else {
#pragma unroll
    for (int j = 0; j < 4; ++j) kload2(kf, kp0 + s_cur * KSLOT, j); }
    WAITB(1 + NV);
#define PKW(P, B) ((TEST & 256) ? 0x3f803f80u : cvtpk_s(P[B], P[B + 1]))
#define PAF(k) __builtin_bit_cast(bf16x8, pw##k)
#define VFR(i) (bf16x8){vlo[i][0], vlo[i][1], vlo[i][2], vlo[i][3], vhi[i][0], vhi[i][1], vhi[i][2], vhi[i][3]}
#define MF(a, b, c) __builtin_amdgcn_mfma_f32_32x32x16_bf16(a, b, c, 0, 0, 0)
#define GAPA(MFS, A0, A1, A2, A3, W0, W1, PW) do { if (!(TEST & 32)) { MFS; } if (!(TEST & 2)) { sacc += A0; sacc += A1; sacc += A2; sacc += A3; PIN(sacc); } W0; W1; PIN(PW); SBAR(); } while (0)
#define EX(v) ((TEST & 1) ? (v) : __builtin_amdgcn_exp2f(v))
#define GAPB4(MFS, X, B) do { if (!(TEST & 4)) { MFS; } X[B] = EX(X[B]); X[B + 1] = EX(X[B + 1]); X[B + 2] = EX(X[B + 2]); X[B + 3] = EX(X[B + 3]); PIN(X); SBAR(); } while (0)
#define GAPB2(MFS, X, B) do { if (!(TEST & 4)) { MFS; } X[B] = EX(X[B]); X[B + 1] = EX(X[B + 1]); PIN(X); SBAR(); } while (0)
#define VRD(f, s) do { if (TEST & 64) break; vlo[s] = vtr(vp_ + (((f) >> 2) * 4096 + ((f) & 3) * 1024)); vhi[s] = vtr(vp_ + (((f) >> 2) * 4096 + ((f) & 3) * 1024 + 512)); } while (0)
#define KRD(G, j) do { if ((G) && !(TEST & 128)) { if (FP8) { if ((j) < 2) { KLOAD8(j, kp0 + s_next * KSLOT); } } else kload2(kf, kp0 + s_next * KSLOT, j); SBAR(); } } while (0)
#define FO(m) (ND == 2 ? (((m) >> 1) + 4 * ((m) & 1)) : ((((m) & 7) >> 2) + 2 * ((m) >> 3) + 4 * ((m) & 3)))
#define STEP(C0, C1, P0, P1, t, GK, GV, GL) do { SBAR(); \
    const lds_cptr vp_ = vp0 + s_prev * VSLOT; float sacc; \
    if (FP8) { \
      VRD(FO(0), 0); VRD(FO(1), 1); VRD(FO(2), 2); VRD(FO(3), 3); SBAR(); \
      if (!(TEST & 32)) C0 = MF8(kf8[0], zero16); \
      SBAR();   \
      float sa_ = P0[0] + P0[1], sb_ = P0[2] + P0[3], sc_ = P0[4] + P0[5], sd_ = P0[6] + P0[7]; \
      if (!(TEST & 2)) { sa_ += P0[8]; sb_ += P0[9]; sc_ += P0[10]; sd_ += P0[11]; sa_ += P0[12]; sb_ += P0[13]; sc_ += P0[14]; sd_ += P0[15]; } \
      pw0 = (v4u){PKW(P0, 0), PKW(P0, 2), PKW(P0, 4), PKW(P0, 6)}; pw1 = (v4u){PKW(P0, 8), PKW(P0, 10), PKW(P0, 12), PKW(P0, 14)}; PIN(pw0); PIN(pw1); SBAR(); \
      VRD(FO(4), 4); VRD(FO(5), 5); VRD(FO(6), 6); VRD(FO(7), 7); SBAR(); \
      if (!(TEST & 32)) C1 = MF8(kf8[1], zero16); \
      SBAR(); \
      if (!(TEST & 2)) { sa_ += P1[0]; sb_ += P1[1]; sc_ += P1[2]; sd_ += P1[3]; sa_ += P1[4]; sb_ += P1[5]; sc_ += P1[6]; sd_ += P1[7]; \
                         sa_ += P1[8]; sb_ += P1[9]; sc_ += P1[10]; sd_ += P1[11]; sa_ += P1[12]; sb_ += P1[13]; sc_ += P1[14]; sd_ += P1[15]; } \
      sacc = (sa_ + sb_) + (sc_ + sd_); PIN(sacc); \
      pw2 = (v4u){PKW(P1, 0), PKW(P1, 2), PKW(P1, 4), PKW(P1, 6)}; pw3 = (v4u){PKW(P1, 8), PKW(P1, 10), PKW(P1, 12), PKW(P1, 14)}; PIN(pw2); PIN(pw3); SBAR(); \
    } else { \
    VRD(FO(0), 0); SBAR(); sacc = (P0[0] + P0[1]); \
    GAPA(C0 = MF(kf[0], qr[0], zero16), P0[2], P0[3], P0[4], P0[5],     pw0[0] = PKW(P0, 0), pw0[1] = PKW(P0, 2), pw0); \
    VRD(FO(1), 1); SBAR(); GAPA(C1 = MF(kf[1], qr[0], zero16), P0[6], P0[7], P0[8], P0[9],     pw0[2] = PKW(P0, 4), pw0[3] = PKW(P0, 6), pw0); \
    VRD(FO(2), 2); SBAR(); GAPA(C0 = MF(kf[2], qr[1], C0),   P0[10], P0[11], P0[12], P0[13], pw1[0] = PKW(P0, 8), pw1[1] = PKW(P0, 10), pw1); \
    VRD(FO(3), 3); SBAR(); GAPA(C1 = MF(kf[3], qr[1], C1),   P0[14], P0[15], P1[0], P1[1],   pw1[2] = PKW(P0, 12), pw1[3] = PKW(P0, 14), pw1); \
    VRD(FO(4), 4); SBAR(); GAPA(C0 = MF(kf[4], qr[2], C0),   P1[2], P1[3], P1[4], P1[5],     pw2[0] = PKW(P1, 0), pw2[1] = PKW(P1, 2), pw2); \
    VRD(FO(5), 5); SBAR(); GAPA(C1 = MF(kf[5], qr[2], C1),   P1[6], P1[7], P1[8], P1[9],     pw2[2] = PKW(P1, 4), pw2[3] = PKW(P1, 6), pw2); \
    VRD(FO(6), 6); SBAR(); GAPA(C0 = MF(kf[6], qr[3], C0),   P1[10], P1[11], P1[12], P1[13], pw3[0] = PKW(P1, 8), pw3[1] = PKW(P1, 10), pw3); \
    VRD(FO(7), 7); SBAR(); GAPA(C1 = MF(kf[7], qr[3], C1),   P1[14], P1[15], 0.f, 0.f,       pw3[2] = PKW(P1, 12), pw3[3] = PKW(P1, 14), pw3); \
    } \
    l_reg += sacc; \
    if (GK) { DMA_K((t) + 3, s_cur); } if (GV) { DMA_V((t) + 1, s_next); } \
    ADD_BIAS(C0, C1, t); \
    SBAR(); \
    if (ND == 2) { \
        GAPB4(o[0] = MF(PAF(0), VFR(0), o[0]), C0, 0); \
        GAPB4(o[1] = MF(PAF(0), VFR(1), o[1]), C0, 4); \
        KRD(GL, 0); GAPB4(o[0] = MF(PAF(1), VFR(2), o[0]), C0, 8); \
        KRD(GL, 1); GAPB4(o[1] = MF(PAF(1), VFR(3), o[1]), C0, 12); \
        KRD(GL, 2); GAPB4(o[0] = MF(PAF(2), VFR(4), o[0]), C1, 0); \
        KRD(GL, 3); GAPB4(o[1] = MF(PAF(2), VFR(5), o[1]), C1, 4); \
        GAPB4(o[0] = MF(PAF(3), VFR(6), o[0]), C1, 8); \
        GAPB4(o[1] = MF(PAF(3), VFR(7), o[1]), C1, 12); \
    } else { \
        GAPB2(o[0] = MF(PAF(0), VFR(0), o[0]), C0, 0);  VRD(FO(8), 0); SBAR(); \
        GAPB2(o[1] = MF(PAF(0), VFR(1), o[1]), C0, 2);  VRD(FO(9), 1); SBAR(); \
        GAPB2(o[ND - 2] = MF(PAF(0), VFR(2), o[ND - 2]), C0, 4);  VRD(FO(10), 2); SBAR(); \
        GAPB2(o[ND - 1] = MF(PAF(0), VFR(3), o[ND - 1]), C0, 6);  VRD(FO(11), 3); SBAR(); \
        GAPB2(o[0] = MF(PAF(1), VFR(4), o[0]), C0, 8);  VRD(FO(12), 4); SBAR(); \
        GAPB2(o[1] = MF(PAF(1), VFR(5), o[1]), C0, 10); VRD(FO(13), 5); SBAR(); \
        GAPB2(o[ND - 2] = MF(PAF(1), VFR(6), o[ND - 2]), C0, 12); VRD(FO(14), 6); SBAR(); \
        GAPB2(o[ND - 1] = MF(PAF(1), VFR(7), o[ND - 1]), C0, 14); VRD(FO(15), 7); SBAR(); \
        KRD(GL, 0); GAPB2(o[0] = MF(PAF(2), VFR(0), o[0]), C1, 0); \
        GAPB2(o[1] = MF(PAF(2), VFR(1), o[1]), C1, 2); \
        KRD(GL, 1); GAPB2(o[ND - 2] = MF(PAF(2), VFR(2), o[ND - 2]), C1, 4); \
        GAPB2(o[ND - 1] = MF(PAF(2), VFR(3), o[ND - 1]), C1, 6); \
        KRD(GL, 2); GAPB2(o[0] = MF(PAF(3), VFR(4), o[0]), C1, 8); \
        GAPB2(o[1] = MF(PAF(3), VFR(5), o[1]), C1, 10); \
        KRD(GL, 3); GAPB2(o[ND - 2] = MF(PAF(3), VFR(6), o[ND - 2]), C1, 12); \
        GAPB2(o[ND - 1] = MF(PAF(3), VFR(7), o[ND - 1]), C1, 14); \
    } \
    if (BIAS && (t) == tl) { l_reg *= fL; _Pragma("unroll") for (int d_ = 0; d_ < ND; ++d_) _Pragma("unroll") for (int r = 0; r < 16; ++r) o[d_][r] *= fL; } \
    } while (0)
    int t = 1;
    for (; t + 4 < NT; t += 2) {
        STEP(pB0, pB1, pA0, pA1, t, true, true, true);       WAITB(1 + NV); ROT();
        STEP(pA0, pA1, pB0, pB1, t + 1, true, true, true);   WAITB(1 + NV); ROT();
    }
    STEP(pB0, pB1, pA0, pA1, NT - 3, false, true, true);  wait_bar<NV, (TEST & 16) != 0>(); ROT();
    STEP(pA0, pA1, pB0, pB1, NT - 2, false, true, true);  wait_bar<0, (TEST & 16) != 0>();  ROT();
    STEP(pB0, pB1, pA0, pA1, NT - 1, false, false, false);
    {
        float sacc = pB0[0] + pB0[1];
#pragma unroll
        for (int r = 2; r < 16; ++r) sacc += pB0[r];
#pragma unroll
        for (int r = 0; r < 16; ++r) sacc += pB1[r];
        l_reg += sacc;
        pw0 = (v4u){PKW(pB0, 0), PKW(pB0, 2), PKW(pB0, 4), PKW(pB0, 6)}; pw1 = (v4u){PKW(pB0, 8), PKW(pB0, 10), PKW(pB0, 12), PKW(pB0, 14)};
        pw2 = (v4u){PKW(pB1, 0), PKW(pB1, 2), PKW(pB1, 4), PKW(pB1, 6)}; pw3 = (v4u){PKW(pB1, 8), PKW(pB1, 10), PKW(pB1, 12), PKW(pB1, 14)};
        const lds_cptr vp_ = vp0 + s_cur * VSLOT;
#pragma unroll
        for (int d0 = 0; d0 < ND; ++d0) {
            s16x4 a0 = vtr(vp_ + d0 * 4096), b0 = vtr(vp_ + d0 * 4096 + 512), a1 = vtr(vp_ + d0 * 4096 + 1024), b1 = vtr(vp_ + d0 * 4096 + 1536);
            s16x4 a2 = vtr(vp_ + d0 * 4096 + 2048), b2 = vtr(vp_ + d0 * 4096 + 2560), a3 = vtr(vp_ + d0 * 4096 + 3072), b3 = vtr(vp_ + d0 * 4096 + 3584);
            o[d0] = MF(PAF(0), ((bf16x8){a0[0], a0[1], a0[2], a0[3], b0[0], b0[1], b0[2], b0[3]}), o[d0]);
            o[d0] = MF(PAF(1), ((bf16x8){a1[0], a1[1], a1[2], a1[3], b1[0], b1[1], b1[2], b1[3]}), o[d0]);
            o[d0] = MF(PAF(2), ((bf16x8){a2[0], a2[1], a2[2], a2[3], b2[0], b2[1], b2[2], b2[3]}), o[d0]);
            o[d0] = MF(PAF(3), ((bf16x8){a3[0], a3[1], a3[2], a3[3], b3[0], b3[1], b3[2], b3[3]}), o[d0]);
        }
    }
    l_reg += __shfl_xor(l_reg, 32);
    int lane_e = lane; asm volatile("" : "+v"(lane_e));
    const int r32e = lane_e & 31, hie = lane_e >> 5;
    if (hie == 0) wsf[r32e] = l_reg;
    asm volatile("s_waitcnt lgkmcnt(0)\n\ts_barrier" ::: "memory");
    {
        LAS bf16* stg = (LAS bf16*)(MODE == 1 ? lds + STASH_OFF : lds) + wid * (32 * DV);
#pragma unroll
        for (int r = 0; r < 16; ++r) { const int orow = crow(r, hie); const float rl = __builtin_amdgcn_rcpf(wsf[orow]);
#pragma unroll
            for (int d0 = 0; d0 < ND; ++d0) stg[orow * DV + d0 * 32 + r32e] = (bf16)f2bf(o[d0][r] * rl); }
        asm volatile("s_waitcnt lgkmcnt(0)" ::: "memory");
        if (MODE == 0) {
            constexpr int CPR = DV / 8;
#pragma unroll
            for (int i = 0; i < (32 * CPR) / 64; ++i) { const int row = i * (64 / CPR) + lane_e / CPR, ch = lane_e % CPR;
                const v4u v = *(const LAS v4u*)(stg + row * DV + ch * 8); *(v4u*)(Op + (size_t)(wid * 32 + row) * ldo + ch * 8) = v; }
        } else if (MODE == 2) {
            const int row = lane_e >> 1, half = lane_e & 1; const float lam = sgt[128];
            const LAS bf16* s1 = stg + row * DV + half * 64; const LAS bf16* s0 = (const LAS bf16*)(lds + STASH_OFF) + wid * (32 * DV) + row * DV + half * 64;
            float ov[64]; float ss = 0.f;
#pragma unroll
            for (int q = 0; q < 8; ++q) { const v4u a = *(const LAS v4u*)(s0 + q * 8), c = *(const LAS v4u*)(s1 + q * 8);
#pragma unroll
                for (int j = 0; j < 4; ++j) { const float lo = __builtin_bit_cast(float, a[j] << 16) - lam * __builtin_bit_cast(float, c[j] << 16);
                    const float hh = __builtin_bit_cast(float, a[j] & 0xffff0000u) - lam * __builtin_bit_cast(float, c[j] & 0xffff0000u);
                    ov[q * 8 + 2 * j] = lo; ov[q * 8 + 2 * j + 1] = hh; ss += lo * lo + hh * hh; } }
            ss += dpp_mov<0xB1>(ss);
            const float rstd = 1.0f / sqrtf(ss * (1.f / 128.f) + 1e-5f);
            bf16* yo = Op + (size_t)(wid * 32 + row) * ldo + half * 64;
#pragma unroll
            for (int q = 0; q < 8; ++q) { const f32x4 g0 = *(const LAS f32x4*)(sgt + half * 64 + q * 8), g1 = *(const LAS f32x4*)(sgt + half * 64 + q * 8 + 4);
                v4u w; w.x = pk2(ov[q * 8] * rstd * g0.x, ov[q * 8 + 1] * rstd * g0.y); w.y = pk2(ov[q * 8 + 2] * rstd * g0.z, ov[q * 8 + 3] * rstd * g0.w);
                w.z = pk2(ov[q * 8 + 4] * rstd * g1.x, ov[q * 8 + 5] * rstd * g1.y); w.w = pk2(ov[q * 8 + 6] * rstd * g1.z, ov[q * 8 + 7] * rstd * g1.w);
                *(v4u*)(yo + q * 8) = w; }
        }
    }
    asm volatile("s_waitcnt lgkmcnt(0)\n\ts_barrier" ::: "memory");
#undef KLOAD8
#undef MF8
#undef WAITB
#undef DMA_K
#undef DMA_V
#undef ROT
#undef ADD_BIAS
#undef PKW
#undef PAF
#undef VFR
#undef MF
#undef GAPA
#undef EX
#undef GAPB4
#undef GAPB2
#undef VRD
#undef KRD
#undef FO
#undef STEP
}
#undef SBAR
#undef PIN
}

namespace at3 {
#define SBAR() __builtin_amdgcn_sched_barrier(0)
#define PIN(x) asm volatile("" : "+v"(x))
using at1::glds16; using at1::wait_bar;
typedef const LAS char* lds_cptr; typedef short v2s __attribute__((ext_vector_type(2)));
template <int DV> __host__ __device__ constexpr int lds_ws_off() { return (3 * 4096 + 3 * DV * 64) > 512 * DV ? (3 * 4096 + 3 * DV * 64) : 512 * DV; }
template <int DV> __host__ __device__ constexpr int lds_tbl_off() { return lds_ws_off<DV>() + 2048; }
__device__ __forceinline__ void waitb(int n) { if (n == 0) wait_bar<0>(); else if (n == 1) wait_bar<1>(); else wait_bar<2>(); }
__device__ __forceinline__ v8i ld_frag(lds_cptr p, int second) { const v4u a = *(const LAS v4u*)p, b = *(const LAS v4u*)(p + second); return (v8i){(int)a.x, (int)a.y, (int)a.z, (int)a.w, (int)b.x, (int)b.y, (int)b.z, (int)b.w}; }

template <int DV, bool BIAS, int MODE>
__device__ __forceinline__ void attn_unit(const unsigned char* Qp, int ldq, const unsigned char* __restrict__ K8T, const unsigned char* __restrict__ V8T, bf16* Op, int ldo, int q0, LAS unsigned char* lds, const LAS float* sgt) {
    constexpr int ND = DV / 32, VT = DV * 64, KT = 4096, NT = SEQ / 64, NVP = VT / 1024;
    constexpr int LDS_K = 0, LDS_V = 3 * KT, LDS_WS = lds_ws_off<DV>(), LDS_TBL = LDS_WS + 2048;
    static_assert(LDS_WS >= LDS_V + 3 * VT && LDS_WS >= 512 * DV && LDS_TBL + 2048 <= STASH_OFF, "LDS map");
    const int tid = threadIdx.x, lane = tid & 63, r32 = lane & 31, hi = lane >> 5; const int wid = __builtin_amdgcn_readfirstlane(tid >> 6);
    const unsigned lds0 = (unsigned)(uintptr_t)lds;
    LAS float* wsf = (LAS float*)(lds + LDS_WS) + wid * 64;
    const LAS float* btbl = (const LAS float*)(lds + LDS_TBL);
    const bool doK = wid < 4, doV = (NVP == 8) || wid >= 4; const int vpc = (NVP == 8) ? wid : (wid & 3);
    const unsigned char* ksrc = K8T + (wid & 3) * 1024 + lane * 16; const unsigned char* vsrc = V8T + vpc * 1024 + lane * 16;
    const unsigned kdst = lds0 + LDS_K + (wid & 3) * 1024, vdst = lds0 + LDS_V + vpc * 1024;
    const int ndma = (doK ? 1 : 0) + (doV ? 1 : 0);
#define DMA_K(t, s) do { if (doK) glds16(ksrc + (size_t)(t) * KT, (unsigned)__builtin_amdgcn_readfirstlane(kdst + (s) * KT)); } while (0)
#define DMA_V(t, s) do { if (doV) glds16(vsrc + (size_t)(t) * VT, (unsigned)__builtin_amdgcn_readfirstlane(vdst + (s) * VT)); } while (0)
    const lds_cptr kp0 = (lds_cptr)lds + LDS_K + hi * 2048 + r32 * 16;
    const lds_cptr vq0 = (lds_cptr)lds + LDS_V + hi * (2 * DV * 16) + r32 * 16;
    DMA_K(0, 0); DMA_V(0, 0); DMA_K(1, 1);
    v8i q8;
    { const unsigned char* qb_ = Qp + (size_t)(wid * 32 + r32) * ldq + hi * 32; const v4u a = *(const v4u*)qb_, b = *(const v4u*)(qb_ + 16);
      q8 = (v8i){(int)a.x, (int)a.y, (int)a.z, (int)a.w, (int)b.x, (int)b.y, (int)b.z, (int)b.w}; }
    f32x16 lacc = f32x16{}; f32x16 o[ND];
#pragma unroll
    for (int d = 0; d < ND; ++d) o[d] = f32x16{};
    const f32x16 zero16 = f32x16{};
    const v8i ones8 = {0x38383838, 0x38383838, 0x38383838, 0x38383838, 0x38383838, 0x38383838, 0x38383838, 0x38383838};
    const int qw = q0 + wid * 32, qpos = qw + r32;
    int tl = 0, tr = NT; float fL = 1.f;
    if (BIAS) { tl = (qw - 191 >= 0) ? ((qw - 191) >> 6) + 1 : 0; tr = (qw + 158) >> 6; fL = __builtin_amdgcn_exp2f(btbl[0]); }
    f32x16 pA0, pA1, pB0, pB1; v8i kf8[2]; v8i vf[ND]; v8i pa; int sb = 127;
    int s_prev = 0, s_cur = 0, s_next = 1;
#define ROT() do { s_prev = s_cur; s_cur = s_next; s_next = (s_next == 2) ? 0 : s_next + 1; } while (0)
#define MFQK(kf_) __builtin_amdgcn_mfma_scale_f32_32x32x64_f8f6f4(kf_, q8, zero16, 0, 0, 0, 0x7f7f7f7f, 0, 0x7c7c7c7c)
#define MFPV(d_) o[d_] = __builtin_amdgcn_mfma_scale_f32_32x32x64_f8f6f4(pa, vf[d_], o[d_], 0, 0, 0, sb, 0, 0x7f7f7f7f)
#define MFSUM() lacc = __builtin_amdgcn_mfma_scale_f32_32x32x64_f8f6f4(pa, ones8, lacc, 0, 0, 0, sb, 0, 0x7f7f7f7f)
#define ADD_BIAS(C0, C1, t) do { if (BIAS && (t) >= tl && (t) <= tr) { const int base_ = (t) * 64 + 4 * hi - qpos; \
        _Pragma("unroll") for (int r = 0; r < 16; ++r) { const int rel0 = base_ + (r & 3) + 8 * (r >> 2); const int rel1 = rel0 + 32; \
            const int i0 = (rel0 < -128 ? -128 : (rel0 > 128 ? 128 : rel0)) + 128, i1 = (rel1 < -128 ? -128 : (rel1 > 128 ? 128 : rel1)) + 128; \
            C0[r] += btbl[i0]; C1[r] += btbl[i1]; } } } while (0)
#define MX3(a, b, c) __builtin_fmaxf(__builtin_fmaxf((a), (b)), (c))
#define PMAX(P0, P1) do { float a_ = MX3(P0[0], P0[1], P1[0]), b_ = MX3(P0[2], P0[3], P1[1]); a_ = MX3(a_, P1[2], P1[3]); \
        _Pragma("unroll") for (int r = 4; r < 16; r += 4) { a_ = MX3(a_, P0[r], P0[r + 1]); b_ = MX3(b_, P0[r + 2], P0[r + 3]); a_ = MX3(a_, P1[r], P1[r + 1]); b_ = MX3(b_, P1[r + 2], P1[r + 3]); } \
        float mx_ = __builtin_fmaxf(a_, b_); { auto rr_ = __builtin_amdgcn_permlane32_swap(__float_as_uint(mx_), __float_as_uint(mx_), false, false); mx_ = __builtin_fmaxf(__uint_as_float(rr_[0]), __uint_as_float(rr_[1])); } \
        const int em_ = (int)(__float_as_uint(mx_) >> 23) - 7; sb = em_ < 1 ? 1 : em_; } while (0)
#define PCVT(P0, P1) do { const float scf_ = __uint_as_float((unsigned)sb << 23); \
        _Pragma("unroll") for (int k = 0; k < 4; ++k) { v2s w_ = {0, 0}; w_ = __builtin_amdgcn_cvt_scalef32_pk_fp8_f32(w_, P0[4 * k], P0[4 * k + 1], scf_, false); w_ = __builtin_amdgcn_cvt_scalef32_pk_fp8_f32(w_, P0[4 * k + 2], P0[4 * k + 3], scf_, true); pa[k] = __builtin_bit_cast(int, w_); } \
        _Pragma("unroll") for (int k = 0; k < 4; ++k) { v2s w_ = {0, 0}; w_ = __builtin_amdgcn_cvt_scalef32_pk_fp8_f32(w_, P1[4 * k], P1[4 * k + 1], scf_, false); w_ = __builtin_amdgcn_cvt_scalef32_pk_fp8_f32(w_, P1[4 * k + 2], P1[4 * k + 3], scf_, true); pa[4 + k] = __builtin_bit_cast(int, w_); } } while (0)
#define PSUM(P0, P1) do { float s0_ = P0[0] + P0[1], s1_ = P0[2] + P0[3], s2_ = P1[0] + P1[1], s3_ = P1[2] + P1[3]; \
        _Pragma("unroll") for (int r = 4; r < 16; r += 4) { s0_ += P0[r]; s1_ += P0[r + 1]; s2_ += P0[r + 2]; s3_ += P0[r + 3]; s0_ += P1[r]; s1_ += P1[r + 1]; s2_ += P1[r + 2]; s3_ += P1[r + 3]; } \
        l_reg += (s0_ + s1_) + (s2_ + s3_); } while (0)
#define EXPS(X, B, N) do { _Pragma("unroll") for (int r_ = 0; r_ < (N); ++r_) X[(B) + r_] = __builtin_amdgcn_exp2f(X[(B) + r_]); PIN(X); } while (0)
    DMA_K(2, 2);
    wait_bar<0>();
    kf8[0] = ld_frag(kp0, 1024); kf8[1] = ld_frag(kp0 + 512, 1024);
    pA0 = MFQK(kf8[0]); pA1 = MFQK(kf8[1]);
    ADD_BIAS(pA0, pA1, 0);
#pragma unroll
    for (int r = 0; r < 16; ++r) { pA0[r] = __builtin_amdgcn_exp2f(pA0[r]); pA1[r] = __builtin_amdgcn_exp2f(pA1[r]); }
    wait_bar<0>();
    DMA_K(3, 0); DMA_V(1, 1);
    ROT();
    kf8[0] = ld_frag(kp0 + s_cur * KT, 1024); kf8[1] = ld_frag(kp0 + s_cur * KT + 512, 1024);
    waitb(ndma);
#define STEP(C0, C1, P0, P1, t, GK, GV, GL) do { SBAR(); \
    const lds_cptr vp_ = vq0 + s_prev * VT; \
    _Pragma("unroll") for (int d_ = 0; d_ < ND; ++d_) vf[d_] = ld_frag(vp_ + d_ * 512, DV * 16); \
    SBAR(); \
    C0 = MFQK(kf8[0]); SBAR(); \
    PMAX(P0, P1); PIN(sb); SBAR(); \
    C1 = MFQK(kf8[1]); SBAR(); \
    PCVT(P0, P1); PIN(pa); SBAR(); \
    MFSUM(); SBAR(); \
    if (GK) { DMA_K((t) + 3, s_cur); } if (GV) { DMA_V((t) + 1, s_next); } \
    ADD_BIAS(C0, C1, t); \
    SBAR(); \
    if (ND == 2) { \
        MFPV(0); EXPS(C0, 0, 16); SBAR(); \
        if (GL) { kf8[0] = ld_frag(kp0 + s_next * KT, 1024); kf8[1] = ld_frag(kp0 + s_next * KT + 512, 1024); SBAR(); } \
        MFPV(1); EXPS(C1, 0, 16); SBAR(); \
    } else { \
        MFPV(0); EXPS(C0, 0, 8); SBAR(); \
        if (GL) { kf8[0] = ld_frag(kp0 + s_next * KT, 1024); SBAR(); } \
        MFPV(1); EXPS(C0, 8, 8); SBAR(); \
        if (GL) { kf8[1] = ld_frag(kp0 + s_next * KT + 512, 1024); SBAR(); } \
        MFPV(ND - 2); EXPS(C1, 0, 8); SBAR(); \
        MFPV(ND - 1); EXPS(C1, 8, 8); SBAR(); \
    } \
    if (BIAS && (t) == tl) { _Pragma("unroll") for (int r = 0; r < 16; ++r) lacc[r] *= fL; _Pragma("unroll") for (int d_ = 0; d_ < ND; ++d_) _Pragma("unroll") for (int r = 0; r < 16; ++r) o[d_][r] *= fL; } \
    } while (0)
    int t = 1;
    for (; t + 4 < NT; t += 2) {
        STEP(pB0, pB1, pA0, pA1, t, true, true, true);       waitb(ndma); ROT();
        STEP(pA0, pA1, pB0, pB1, t + 1, true, true, true);   waitb(ndma); ROT();
    }
    STEP(pB0, pB1, pA0, pA1, NT - 3, false, true, true);  waitb(doV ? 1 : 0); ROT();
    STEP(pA0, pA1, pB0, pB1, NT - 2, false, true, true);  wait_bar<0>();  ROT();
    STEP(pB0, pB1, pA0, pA1, NT - 1, false, false, false);
    {
        const lds_cptr vp_ = vq0 + s_cur * VT;
#pragma unroll
        for (int d_ = 0; d_ < ND; ++d_) vf[d_] = ld_frag(vp_ + d_ * 512, DV * 16);
        PMAX(pB0, pB1); PCVT(pB0, pB1); MFSUM();
#pragma unroll
        for (int d_ = 0; d_ < ND; ++d_) MFPV(d_);
    }
    int lane_e = lane; asm volatile("" : "+v"(lane_e));
    const int r32e = lane_e & 31, hie = lane_e >> 5;
    asm volatile("s_waitcnt lgkmcnt(0)\n\ts_barrier" ::: "memory");
    {
        LAS bf16* stg = (LAS bf16*)(MODE == 1 ? lds + STASH_OFF : lds) + wid * (32 * DV);
#pragma unroll
        for (int r = 0; r < 16; ++r) { const int orow = crow(r, hie); const float rl = __builtin_amdgcn_rcpf(lacc[r]);
#pragma unroll
            for (int d0 = 0; d0 < ND; ++d0) stg[orow * DV + d0 * 32 + r32e] = (bf16)f2bf(o[d0][r] * rl); }
        asm volatile("s_waitcnt lgkmcnt(0)" ::: "memory");
        if (MODE == 0) {
            constexpr int CPR = DV / 8;
#pragma unroll
            for (int i = 0; i < (32 * CPR) / 64; ++i) { const int row = i * (64 / CPR) + lane_e / CPR, ch = lane_e % CPR;
                const v4u v = *(const LAS v4u*)(stg + row * DV + ch * 8); *(v4u*)(Op + (size_t)(wid * 32 + row) * ldo + ch * 8) = v; }
        } else if (MODE == 2) {
            const int row = lane_e >> 1, half = lane_e & 1; const float lam = sgt[128];
            const LAS bf16* s1 = stg + row * DV + half * 64; const LAS bf16* s0 = (const LAS bf16*)(lds + STASH_OFF) + wid * (32 * DV) + row * DV + half * 64;
            float ov[64]; float ss = 0.f;
#pragma unroll
            for (int q = 0; q < 8; ++q) { const v4u a = *(const LAS v4u*)(s0 + q * 8), c = *(const LAS v4u*)(s1 + q * 8);
#pragma unroll
                for (int j = 0; j < 4; ++j) { const float lo = __builtin_bit_cast(float, a[j] << 16) - lam * __builtin_bit_cast(float, c[j] << 16);
                    const float hh = __builtin_bit_cast(float, a[j] & 0xffff0000u) - lam * __builtin_bit_cast(float, c[j] & 0xffff0000u);
                    ov[q * 8 + 2 * j] = lo; ov[q * 8 + 2 * j + 1] = hh; ss += lo * lo + hh * hh; } }
            ss += dpp_mov<0xB1>(ss);
            const float rstd = 1.0f / sqrtf(ss * (1.f / 128.f) + 1e-5f);
            bf16* yo = Op + (size_t)(wid * 32 + row) * ldo + half * 64;
#pragma unroll
            for (int q = 0; q < 8; ++q) { const f32x4 g0 = *(const LAS f32x4*)(sgt + half * 64 + q * 8), g1 = *(const LAS f32x4*)(sgt + half * 64 + q * 8 + 4);
                v4u w; w.x = pk2(ov[q * 8] * rstd * g0.x, ov[q * 8 + 1] * rstd * g0.y); w.y = pk2(ov[q * 8 + 2] * rstd * g0.z, ov[q * 8 + 3] * rstd * g0.w);
                w.z = pk2(ov[q * 8 + 4] * rstd * g1.x, ov[q * 8 + 5] * rstd * g1.y); w.w = pk2(ov[q * 8 + 6] * rstd * g1.z, ov[q * 8 + 7] * rstd * g1.w);
                *(v4u*)(yo + q * 8) = w; }
        }
    }
    asm volatile("s_waitcnt lgkmcnt(0)\n\ts_barrier" ::: "memory");
#undef DMA_K
#undef DMA_V
#undef ROT
#undef MFQK
#undef MFPV
#undef MFSUM
#undef ADD_BIAS
#undef MX3
#undef PMAX
#undef PCVT
#undef PSUM
#undef EXPS
#undef STEP
}
#undef SBAR
#undef PIN
}

struct Args { const float* in[27]; float* out; unsigned char* ws; int ph_lo, ph_hi, li, pad; };

constexpr int NPHASE = 17;
constexpr int NWAVES = 8;

#define IN(k) (lo <= (k) && (k) < hi_ph)
#define SEAM(k) do { if (IN(k) && IN((k) + 1)) xcd_barrier(bar); } while (0)
template <int layer>
__device__ __forceinline__ void moe_block(const Args& args, LAS unsigned char* lds, const XcdBarrier& bar, int lo, int hi_ph) {
    volatile LAS unsigned* LC = (volatile LAS unsigned*)(lds + LDSCTL_OFF);
    const int tid = threadIdx.x, lane = tid & 63, wave = __builtin_amdgcn_readfirstlane(tid >> 6);
    const int G = gridDim.x, bx = blockIdx.x;
    const int gw = bx * NWAVES + wave, NGW = G * NWAVES;
    unsigned char* ws = args.ws;
    unsigned* ctl = (unsigned*)(ws + WS_CTL);
    float* xres = args.out;
    bf16* XB = (bf16*)(ws + WS_XB);
    bf16* HB = (bf16*)(ws + WS_HB);
    {
        const int pb = layer == 0 ? 5 : 13;
        unsigned* const gcnt0 = ctl + CW_CNT + layer * 64;
        int* list = (int*)(ws + WS_LIST); int* tokep = (int*)(ws + WS_TOKEP); float* gate = (float*)(ws + WS_GATE);
        if (IN(pb)) REP(pb) {
            unsigned* gcnt = gcnt0 + ((MK_N_LAUNCHES == 1 ? (int)((PROBE_MASK >> pb) & 1u) : 0) - rep_) * 128;
            if (rep_ > 0) xcd_barrier(bar);
            const float* gf = args.in[2] + layer * DM;
            const float* WR = (const float*)(ws + WS_TBL) + TBL_WR + layer * WR_LAYER;
            for (int chunk = bx; chunk < NTOK / 128; chunk += G) {
                __syncthreads();
                if (tid < 32) LC[LC_LCNT + tid] = 0u;
                __syncthreads();
                int my_e0 = 0, my_e1 = 0; float my_g0 = 0.f, my_g1 = 0.f;
                {
                    const int ri = lane & 15, kq = lane >> 4; const int r0w = chunk * 128 + wave * 16;
                    const GAS bf16* xrow = (const GAS bf16*)(XB + (size_t)(r0w + ri) * DM) + 4 * kq;
                    const GAS float* wb = (const GAS float*)WR + (size_t)(4 * kq) * 48 + ri;
                    f32x4 acc0 = {0.f, 0.f, 0.f, 0.f}, acc1 = acc0, acc2 = acc0; float ss = 0.f;
                    f32x4 aA[4], aB[4]; float bA[48], bB[48];
#define RT_LOAD(a_, b_, g_) do { _Pragma("unroll") for (int c_ = 0; c_ < 4; ++c_) { { const v2u w_ = *(const GAS v2u*)(xrow + 16 * (4 * (g_) + c_)); a_[c_] = (f32x4){__builtin_bit_cast(float, w_.x << 16), __builtin_bit_cast(float, w_.x & 0xffff0000u), __builtin_bit_cast(float, w_.y << 16), __builtin_bit_cast(float, w_.y & 0xffff0000u)}; } \
        const GAS float* wc_ = wb + (size_t)(16 * (4 * (g_) + c_)) * 48; _Pragma("unroll") for (int e_ = 0; e_ < 4; ++e_) { b_[c_ * 12 + e_ * 3] = wc_[e_ * 48]; b_[c_ * 12 + e_ * 3 + 1] = wc_[e_ * 48 + 16]; b_[c_ * 12 + e_ * 3 + 2] = wc_[e_ * 48 + 32]; } } } while (0)
#define RT_COMP(a_, b_) do { _Pragma("unroll") for (int c_ = 0; c_ < 4; ++c_) { ss += (a_[c_].x * a_[c_].x + a_[c_].y * a_[c_].y) + (a_[c_].z * a_[c_].z + a_[c_].w * a_[c_].w); \
        _Pragma("unroll") for (int e_ = 0; e_ < 4; ++e_) { acc0 = __builtin_amdgcn_mfma_f32_16x16x4f32(a_[c_][e_], b_[c_ * 12 + e_ * 3], acc0, 0, 0, 0); \
            acc1 = __builtin_amdgcn_mfma_f32_16x16x4f32(a_[c_][e_], b_[c_ * 12 + e_ * 3 + 1], acc1, 0, 0, 0); acc2 = __builtin_amdgcn_mfma_f32_16x16x4f32(a_[c_][e_], b_[c_ * 12 + e_ * 3 + 2], acc2, 0, 0, 0); } } } while (0)
                    RT_LOAD(aA, bA, 0);
#pragma unroll 1
                    for (int g = 0; g < 16; g += 2) {
                        RT_LOAD(aB, bB, g + 1);
                        RT_COMP(aA, bA);
                        if (g + 2 < 16) RT_LOAD(aA, bA, g + 2);
                        RT_COMP(aB, bB);
                    }
#undef RT_LOAD
#undef RT_COMP
                    ss += __shfl_xor(ss, 16); ss += __shfl_xor(ss, 32);
                    const float rstd = 1.0f / sqrtf(ss * (1.f / DM) + 1e-6f);
                    LAS float* Lg = (LAS float*)(lds + wave * 4096);
#pragma unroll
                    for (int r = 0; r < 4; ++r) { Lg[(4 * kq + r) * 49 + ri] = acc0[r]; Lg[(4 * kq + r) * 49 + 16 + ri] = acc1[r]; Lg[(4 * kq + r) * 49 + 32 + ri] = acc2[r]; }
                    LDS_WAIT(); asm volatile("" ::: "memory");
                    if (lane < 16) {
                        const GAS float* bv = (const GAS float*)WR + 1024 * 48;
                        float lg[4], le[32];
#pragma unroll
                        for (int e = 0; e < 4; ++e) lg[e] = Lg[lane * 49 + e] * rstd + bv[e];
#pragma unroll
                        for (int e = 0; e < 32; ++e) le[e] = Lg[lane * 49 + 4 + e] * rstd + bv[4 + e];
                        int gi = 0; float gm = lg[0];
#pragma unroll
                        for (int e = 1; e < 4; ++e) if (lg[e] > gm) { gm = lg[e]; gi = e; }
                        float gs = 0.f;
#pragma unroll
                        for (int e = 0; e < 4; ++e) gs += __expf(lg[e] - gm);
                        const float gval = 1.0f / gs;
                        float ev[8];
#pragma unroll
                        for (int j = 0; j < 8; ++j) ev[j] = gi == 0 ? le[j] : (gi == 1 ? le[8 + j] : (gi == 2 ? le[16 + j] : le[24 + j]));
                        int i0 = 0; float m0 = ev[0];
#pragma unroll
                        for (int j = 1; j < 8; ++j) if (ev[j] > m0) { m0 = ev[j]; i0 = j; }
                        int i1 = -1; float m1 = -3.0e38f;
#pragma unroll
                        for (int j = 0; j < 8; ++j) if (j != i0 && ev[j] > m1) { m1 = ev[j]; i1 = j; }
                        const float t1 = __expf(m1 - m0); const float den = 1.0f / (1.0f + t1);
                        my_e0 = gi * 8 + i0; my_e1 = gi * 8 + i1; my_g0 = gval * den; my_g1 = gval * t1 * den;
                    }
                    for (int i = 0; i < 16; ++i) { const int m = r0w + i; f32x4 v[4]; rms_row_b16(XB + (size_t)m * DM, gf, v, lane);
                        if (MOE_FP8) {
#pragma unroll
                            for (int j = 0; j < 4; ++j) { int d = __builtin_amdgcn_cvt_pk_fp8_f32(v[j].x, v[j].y, 0, false); d = __builtin_amdgcn_cvt_pk_fp8_f32(v[j].z, v[j].w, d, true); *(GAS unsigned*)((unsigned char*)HB + (size_t)m * DM + 4 * lane + 256 * j) = (unsigned)d; }
                        } else store_row_bf16(HB + (size_t)m * DM, v, lane); }
                }
                unsigned r0 = 0, r1 = 0;
                if (lane < 16) { r0 = atomicAdd((unsigned*)(LC + LC_LCNT + my_e0), 1u); r1 = atomicAdd((unsigned*)(LC + LC_LCNT + my_e1), 1u); }
                __syncthreads();
                if (tid < 32) { const unsigned c = LC[LC_LCNT + tid]; LC[LC_LBASE + tid] = c ? __hip_atomic_fetch_add(gcnt + tid, c, RLX_AGENT) : 0u; }
                __syncthreads();
                if (lane < 16) { const int m = chunk * 128 + wave * 16 + lane;
                    const unsigned p0 = LC[LC_LBASE + my_e0] + r0, p1 = LC[LC_LBASE + my_e1] + r1;
                    list[(size_t)my_e0 * LIST_CAP + p0] = m; list[(size_t)my_e1 * LIST_CAP + p1] = m;
                    tokep[2 * m] = my_e0 | (int)(p0 << 8); tokep[2 * m + 1] = my_e1 | (int)(p1 << 8);
                    gate[2 * m] = my_g0; gate[2 * m + 1] = my_g1; }
            }
        }
        SEAM(pb);
        if (IN(pb + 1) || IN(pb + 2) || IN(pb + 3)) {
            __syncthreads();
            if (tid == 0) { int acc = 0; for (int e = 0; e < 32; ++e) { const int c = (int)__hip_atomic_load(gcnt0 + e, RLX_AGENT); LC[LC_CNT + e] = (unsigned)c; LC[LC_TP + e] = (unsigned)acc; acc += (c + 255) >> 8; } LC[LC_TP + 32] = (unsigned)acc;
                int la = 0; for (int j = 0; j < 4; ++j) { LC[LC_LP + j] = (unsigned)la; la += ((int)LC[LC_CNT + (bx & 7) + 8 * j] + 255) >> 8; } LC[LC_LP + 4] = (unsigned)la; }
            __syncthreads();
        }
        const LAS int* tp = (const LAS int*)(lds + LDSCTL_OFF) + LC_TP; const LAS int* cn = (const LAS int*)(lds + LDSCTL_OFF) + LC_CNT; const LAS int* lp = (const LAS int*)(lds + LDSCTL_OFF) + LC_LP;
        if (IN(pb + 1)) REP(pb + 1) {
            pg8::Gemm g{HB, (const bf16*)(ws + WS_W13), 0, 1024, MOE_FP8 ? DM / 2 : DM};
            pg8::MoeOrder S{tp, cn, lp, list, G, bx, tp[32] * 4, true, G == 256};
            pg8::EpiSwiglu E{(bf16*)(ws + WS_H), MOE_FP8 != 0};
            if (MOE_FP8) pg8::gemm_phase<pg8::EpiSwiglu, pg8::MoeOrder, true, true, 127, 122>(lds, g, S, E);
            else pg8::gemm_phase<pg8::EpiSwiglu, pg8::MoeOrder, true>(lds, g, S, E);
        }
        SEAM(pb + 1);
        if (IN(pb + 2)) REP(pb + 2) {
            pg8::Gemm g{(const bf16*)(ws + WS_H), (const bf16*)(ws + WS_W2), 0, 1024, MOE_FP8 ? MOE_H / 2 : MOE_H};
            pg8::MoeOrder S{tp, cn, lp, list, G, bx, tp[32] * 4, false, G == 256};
            pg8::EpiBf16 E{(bf16*)(ws + WS_YS), DM, 0, 0, 1.f, 3, MOE_FP8 != 0};
            if (MOE_FP8) pg8::gemm_phase<pg8::EpiBf16, pg8::MoeOrder, true, true, 125, 122>(lds, g, S, E);
            else pg8::gemm_phase<pg8::EpiBf16, pg8::MoeOrder, true>(lds, g, S, E);
        }
        SEAM(pb + 2);
        if (IN(pb + 3)) {
            const bf16* YS = (const bf16*)(ws + WS_YS);
            if (layer == 0) { LAS float* scr = (LAS float*)(lds + wave * 16384);
                transpose_moe(args.in[24] + (size_t)NEXP * 1024 * 512, args.in[25] + (size_t)NEXP * 1024 * 512, args.in[26] + (size_t)NEXP * 1024 * 512, (bf16*)(ws + WS_W13), (bf16*)(ws + WS_W2), scr, gw, NGW, lane); }
            const float* gn = layer == 0 ? args.in[1] + DM : args.in[3];
            for (int m = gw; m < NTOK; m += NGW) {
                const int ep0 = tokep[2 * m], ep1 = tokep[2 * m + 1]; const float g0 = gate[2 * m], g1 = gate[2 * m + 1];
                const size_t s0 = (size_t)(tp[ep0 & 255] * 256 + (ep0 >> 8)), s1 = (size_t)(tp[ep1 & 255] * 256 + (ep1 >> 8));
                GAS f32x4* xr = (GAS f32x4*)(xres + (size_t)m * DM) + lane; GAS v2u* xb = (GAS v2u*)(XB + (size_t)m * DM) + lane;
                const GAS v2u* y0 = (const GAS v2u*)(YS + s0 * DM) + lane; const GAS v2u* y1 = (const GAS v2u*)(YS + s1 * DM) + lane;
                const GAS unsigned* z0 = (const GAS unsigned*)((const unsigned char*)YS + s0 * DM) + lane; const GAS unsigned* z1 = (const GAS unsigned*)((const unsigned char*)YS + s1 * DM) + lane;
                f32x4 v[4]; float ss = 0.f;
#pragma unroll
                for (int j = 0; j < 4; ++j) { const v2u xw = xb[64 * j]; f32x4 xv = (f32x4){__builtin_bit_cast(float, xw.x << 16), __builtin_bit_cast(float, xw.x & 0xffff0000u), __builtin_bit_cast(float, xw.y << 16), __builtin_bit_cast(float, xw.y & 0xffff0000u)};
                    if (MOE_FP8) { typedef float f32x2_ __attribute__((ext_vector_type(2))); const unsigned a = z0[64 * j], c = z1[64 * j]; const float h0 = g0 * 0.125f, h1 = g1 * 0.125f;
                        const f32x2_ al = __builtin_amdgcn_cvt_pk_f32_fp8((int)a, false), ah = __builtin_amdgcn_cvt_pk_f32_fp8((int)a, true), cl = __builtin_amdgcn_cvt_pk_f32_fp8((int)c, false), ch = __builtin_amdgcn_cvt_pk_f32_fp8((int)c, true);
                        xv.x += h0 * al.x + h1 * cl.x; xv.y += h0 * al.y + h1 * cl.y; xv.z += h0 * ah.x + h1 * ch.x; xv.w += h0 * ah.y + h1 * ch.y;
                    } else { const v2u a = y0[64 * j], c = y1[64 * j];
                    xv.x += g0 * __builtin_bit_cast(float, a.x << 16) + g1 * __builtin_bit_cast(float, c.x << 16);
                    xv.y += g0 * __builtin_bit_cast(float, a.x & 0xffff0000u) + g1 * __builtin_bit_cast(float, c.x & 0xffff0000u);
                    xv.z += g0 * __builtin_bit_cast(float, a.y << 16) + g1 * __builtin_bit_cast(float, c.y << 16);
                    xv.w += g0 * __builtin_bit_cast(float, a.y & 0xffff0000u) + g1 * __builtin_bit_cast(float, c.y & 0xffff0000u); }
                    v[j] = xv; ss += (xv.x * xv.x + xv.y * xv.y) + (xv.z * xv.z + xv.w * xv.w); }
                const float rstd = 1.0f / sqrtf(wave_sum(ss) * (1.f / DM) + 1e-6f);
                const GAS f32x4* gr = (const GAS f32x4*)gn + lane;
                if (layer == 0) {
#pragma unroll
                    for (int j = 0; j < 4; ++j) xb[64 * j] = (v2u){pk2(v[j].x, v[j].y), pk2(v[j].z, v[j].w)};
#pragma unroll
                    for (int j = 0; j < 4; ++j) v[j] = v[j] * rstd * gr[64 * j];
                    if (IN1_FP8) {
#pragma unroll
                        for (int j = 0; j < 4; ++j) { int d = __builtin_amdgcn_cvt_pk_fp8_f32(v[j].x, v[j].y, 0, false); d = __builtin_amdgcn_cvt_pk_fp8_f32(v[j].z, v[j].w, d, true); *(GAS unsigned*)((unsigned char*)HB + (size_t)m * DM + 4 * lane + 256 * j) = (unsigned)d; }
                    } else store_row_bf16(HB + (size_t)m * DM, v, lane);
                } else {
#pragma unroll
                    for (int j = 0; j < 4; ++j) xr[64 * j] = v[j] * rstd * gr[64 * j];
                }
            }
        }
    }
}

__global__ void __launch_bounds__(NWAVES * 64, 2) mk_fwd(Args args) {
    extern __shared__ __attribute__((aligned(16))) unsigned char lds_raw[];
    LAS unsigned char* lds = (LAS unsigned char*)lds_raw;
    volatile LAS unsigned* LC = (volatile LAS unsigned*)(lds + LDSCTL_OFF);
    const int tid = threadIdx.x, lane = tid & 63, wave = __builtin_amdgcn_readfirstlane(tid >> 6);
    const int G = gridDim.x, bx = blockIdx.x;
    const int gw = bx * NWAVES + wave, NGW = G * NWAVES;
    unsigned char* ws = args.ws;
    unsigned* ctl = (unsigned*)(ws + WS_CTL);
    const float* x_in = args.in[0];
    float* xres = args.out;
    bf16* XB = (bf16*)(ws + WS_XB);
    bf16* HB = (bf16*)(ws + WS_HB); bf16* Y = (bf16*)(ws + WS_Y);
    float* TBL = (float*)(ws + WS_TBL);

    for (int u = tid; u < (LDS_BYTES - LDSCTL_OFF) / 4; u += NWAVES * 64) LC[u] = 0u;
    __syncthreads();
    XcdBarrier bar; bar.bar = ctl + CW_BAR; bar.x = 0; bar.st = nullptr;
    if (MK_N_LAUNCHES == 1) bar = xcd_barrier_post(ctl + CW_BAR, LC + LC_BAR);
    const int lo = args.ph_lo, hi_ph = args.ph_hi;

    if (IN(0)) REP(0) {
        LAS float* scr = (LAS float*)(lds + wave * 16384);
        transpose_plain(args.in[4], DM, EV_IN, (bf16*)(ws + WS_WIN0), scr, gw, NGW, lane);
        transpose_plain(args.in[11], DM, DM, (bf16*)(ws + WS_WOUT0), scr, gw, NGW, lane);
        transpose_plain<IN1_FP8 != 0>(args.in[12], DM, OD_IN, (bf16*)(ws + WS_WIN1), scr, gw, NGW, lane);
        transpose_plain(args.in[18], DM, DM, (bf16*)(ws + WS_WOUT1), scr, gw, NGW, lane);
        transpose_moe(args.in[24], args.in[25], args.in[26], (bf16*)(ws + WS_W13), (bf16*)(ws + WS_W2), scr, gw, NGW, lane);
        for (int i = bx * 512 + tid; i < 2048; i += G * 512) { const int pos = i >> 4, f = i & 15;
            const float inv = exp2f(-(float)f * (13.287712379549449f / 16.0f));
            const float ang = (float)pos * inv; const float rev = ang * 0.15915494309189535f; const float fr = rev - floorf(rev);
            TBL[TBL_COS + i] = __builtin_amdgcn_cosf(fr); TBL[TBL_SIN + i] = __builtin_amdgcn_sinf(fr); }
        for (int i = bx * 512 + tid; i < 8 * 257; i += G * 512) { const int h = i / 257, j = i % 257;
            TBL[TBL_BIAS + h * BIAS_STRIDE + j] = args.in[19][t5_bucket(j - 128) * 8 + h] * LOG2E; }
        for (int i = bx * 512 + tid; i < 2 * 1024 * 48; i += G * 512) { const int l = i / (1024 * 48), r = i % (1024 * 48), k = r / 48, c = r % 48;
            float w = 0.f; if (c < 4) w = args.in[20][(size_t)l * 4096 + k * 4 + c]; else if (c < 36) w = args.in[22][(size_t)l * 32768 + k * 32 + (c - 4)];
            TBL[TBL_WR + l * WR_LAYER + r] = w * args.in[2][l * DM + k]; }
        for (int i = bx * 512 + tid; i < 2 * 48; i += G * 512) { const int l = i / 48, c = i % 48;
            TBL[TBL_WR + l * WR_LAYER + 1024 * 48 + c] = c < 4 ? args.in[21][l * 4 + c] : (c < 36 ? args.in[23][l * 32 + (c - 4)] : 0.f); }
        for (int m = gw; m < NTOK; m += NGW) { f32x4 v[4]; rms_row(x_in + (size_t)m * DM, args.in[1], v, lane); store_row_bf16(HB + (size_t)m * DM, v, lane); }
    }
    SEAM(0);
    if (IN(1)) REP(1) {
        pg8::Gemm g{HB, (const bf16*)(ws + WS_WIN0), NTOK, EV_IN, DM}; pg8::StaticOrder S; S.init(NTOK, EV_IN, G, bx);
        pg8::EpiBf16 E{(bf16*)(ws + WS_Z0), EV_IN, 0, 0, 1.f, 0xffff, false};
        pg8::gemm_phase<pg8::EpiBf16, pg8::StaticOrder, true>(lds, g, S, E);
    }
    SEAM(1);
    if (IN(2)) REP(2) {
        const bf16* Z0 = (const bf16*)(ws + WS_Z0); bf16* QR = (bf16*)(ws + WS_QR); bf16* KR = (bf16*)(ws + WS_KR);
        if (QK_FP8 && (ATTN_VER == 1 || ATTN_VER == 3)) {
            for (int it = bx * 512 + tid; it < NTOK * 10; it += G * 512) {
                const bool isq = it < NTOK * 8; const int m = isq ? (it >> 3) : ((it - NTOK * 8) >> 1); const int hh = isq ? (it & 7) : 8 + ((it - NTOK * 8) & 1);
                const float* gn = isq ? args.in[5] : args.in[6];
                const GAS v4u* srcp = (const GAS v4u*)(Z0 + (size_t)m * EV_IN + hh * 64);
                float xv[64]; float ss = 0.f;
#pragma unroll
                for (int q = 0; q < 8; ++q) { const v4u a = srcp[q];
#pragma unroll
                    for (int j = 0; j < 4; ++j) { const float lo = __builtin_bit_cast(float, a[j] << 16), hh2 = __builtin_bit_cast(float, a[j] & 0xffff0000u); xv[q * 8 + 2 * j] = lo; xv[q * 8 + 2 * j + 1] = hh2; ss += lo * lo + hh2 * hh2; } }
                const float rs = (1.0f / sqrtf(ss * (1.f / 64.f) + 1e-6f)) * (isq ? C2 * 8.0f : 1.0f);
                const int sp = m & (SEQ - 1);
                unsigned wout[16];
#pragma unroll
                for (int half = 0; half < 2; ++half) { const int pos = half ? (sp & 63) : (sp >> 6);
                    const GAS f32x4* ct = (const GAS f32x4*)(TBL + TBL_COS + pos * 16); const GAS f32x4* st = (const GAS f32x4*)(TBL + TBL_SIN + pos * 16);
                    float ov[32];
#pragma unroll
                    for (int q = 0; q < 4; ++q) { const f32x4 cv = ct[q], sv = st[q];
#pragma unroll
                        for (int j = 0; j < 4; ++j) { const int i = q * 4 + j; const float a = xv[half * 32 + i] * rs * gn[half * 32 + i], b2 = xv[half * 32 + 16 + i] * rs * gn[half * 32 + 16 + i];
                            ov[i] = a * cv[j] - b2 * sv[j]; ov[16 + i] = b2 * cv[j] + a * sv[j]; } }
#pragma unroll
                    for (int q = 0; q < 8; ++q) { int d = __builtin_amdgcn_cvt_pk_fp8_f32(ov[4 * q], ov[4 * q + 1], 0, false); d = __builtin_amdgcn_cvt_pk_fp8_f32(ov[4 * q + 2], ov[4 * q + 3], d, true); wout[half * 8 + q] = (unsigned)d; } }
                if (!isq && ATTN_VER == 3) {
                    const int strm = (m >> 13) * 2 + (hh - 8); unsigned char* kb_ = ws + WS_K8T0 + ((((size_t)strm * 128 + (sp >> 6)) * 4) * 64 + (sp & 63)) * 16;
#pragma unroll
                    for (int q = 0; q < 4; ++q) *(GAS v4u*)(kb_ + q * 1024) = (v4u){wout[4 * q], wout[4 * q + 1], wout[4 * q + 2], wout[4 * q + 3]};
                } else {
                GAS v4u* dst = isq ? (GAS v4u*)(ws + WS_QR8 + (size_t)m * 512 + hh * 64) : (GAS v4u*)(ws + WS_KR8 + (size_t)m * 128 + (hh - 8) * 64);
#pragma unroll
                for (int q = 0; q < 4; ++q) dst[q] = (v4u){wout[4 * q], wout[4 * q + 1], wout[4 * q + 2], wout[4 * q + 3]};
                }
            }
            if (ATTN_VER == 3) {
                for (int it = bx * 512 + tid; it < 8 * 128 * 4 * 64; it += G * 512) { const int d = it & 63, c = (it >> 6) & 3, tt = (it >> 8) & 127, strm = it >> 15;
                    const bf16* vb_ = Z0 + ((size_t)(strm >> 1) * SEQ + tt * 64) * EV_IN + 640 + (strm & 1) * 64 + d; unsigned w4[4];
#pragma unroll
                    for (int q = 0; q < 4; ++q) { float f[4];
#pragma unroll
                        for (int j = 0; j < 4; ++j) { const int bb = q * 4 + j; const int key = 32 * (c & 1) + (bb & 3) + 8 * (bb >> 2) + 4 * (c >> 1); f[j] = bf2f(vb_[(size_t)key * EV_IN]); }
                        int dw = __builtin_amdgcn_cvt_pk_fp8_f32(f[0], f[1], 0, false); dw = __builtin_amdgcn_cvt_pk_fp8_f32(f[2], f[3], dw, true); w4[q] = (unsigned)dw; }
                    *(GAS v4u*)(ws + WS_V8T0 + (size_t)it * 16) = (v4u){w4[0], w4[1], w4[2], w4[3]}; }
            }
        } else {
        const float gq = args.in[5][lane], gk = args.in[6][lane];
        const int fi = lane & 15; const bool first = (lane & 16) == 0, isrow = lane < 32;
        for (int m = gw; m < NTOK; m += NGW) {
            const int s = m & (SEQ - 1); const int pos = isrow ? (s >> 6) : (s & 63);
            const float cs = TBL[TBL_COS + pos * 16 + fi], sn = TBL[TBL_SIN + pos * 16 + fi];
#pragma unroll
            for (int h = 0; h < 10; ++h) {
                const float xv = bf2f(Z0[(size_t)m * EV_IN + h * 64 + lane]);
                const float ss = wave_sum(xv * xv);
                const float y = xv * (1.0f / sqrtf(ss * (1.f / 64.f) + 1e-6f)) * (h < 8 ? gq : gk);
                const float p = __shfl_xor(y, 16);
                float o = first ? (y * cs - p * sn) : (y * cs + p * sn);
                if (!QK_FP8 || ATTN_VER != 1) { if (h < 8) QR[(size_t)m * 512 + h * 64 + lane] = (bf16)f2bf(o * C2);
                else KR[(size_t)m * 128 + (h - 8) * 64 + lane] = (bf16)f2bf(o); }
                if (QK_FP8) { const unsigned w = quad_pack_bytes(fp8_byte(h < 8 ? o * (C2 * 8.0f) : o));
                    if ((lane & 3) == 0) { if (h < 8) *(unsigned*)(ws + WS_QR8 + (size_t)m * 512 + h * 64 + lane) = w; else *(unsigned*)(ws + WS_KR8 + (size_t)m * 128 + (h - 8) * 64 + lane) = w; } }
            }
        }
        }
        LAS float* hbuf = (LAS float*)lds;
        for (int un = bx; un < NBATCH * 64 * 8; un += G) {
            const int grp = un & 7, tt = (un >> 3) & 63, b = un >> 9; const int t0 = tt * 128;
            __syncthreads();
            for (int idx = tid; idx < 158 * 8; idx += 512) { const int r = idx >> 3, c8 = idx & 7; const int s = t0 - 15 + r;
                f32x4 h0 = {0.f, 0.f, 0.f, 0.f}, h1 = h0;
                if (s >= 0 && s < SEQ) { const size_t ro = (size_t)(b * SEQ + s) * EV_IN + grp * 64 + c8 * 8;
                    const v4u av = *(const GAS v4u*)(Z0 + ro + 768), gv = *(const GAS v4u*)(Z0 + ro + 1280);
#pragma unroll
                    for (int j = 0; j < 4; ++j) { const float a0 = __builtin_bit_cast(float, av[j] << 16), a1 = __builtin_bit_cast(float, av[j] & 0xffff0000u);
                        const float g0 = __builtin_bit_cast(float, gv[j] << 16), g1 = __builtin_bit_cast(float, gv[j] & 0xffff0000u);
                        const float x0 = a0 * __builtin_amdgcn_rcpf(1.0f + __builtin_amdgcn_exp2f(-g0 * LOG2E)), x1 = a1 * __builtin_amdgcn_rcpf(1.0f + __builtin_amdgcn_exp2f(-g1 * LOG2E));
                        if (j < 2) { h0[2 * j] = x0; h0[2 * j + 1] = x1; } else { h1[2 * j - 4] = x0; h1[2 * j - 3] = x1; } } }
                *(LAS f32x4*)(hbuf + r * 64 + c8 * 8) = h0; *(LAS f32x4*)(hbuf + r * 64 + c8 * 8 + 4) = h1; }
            __syncthreads();
            const int ch = grp * 64 + lane;
            float wreg[31];
#pragma unroll
            for (int j = 0; j < 31; ++j) wreg[j] = args.in[7][j * 512 + ch];
            typedef float f32x2 __attribute__((ext_vector_type(2)));
            float acc[16]; const float cb = args.in[8][ch];
            {
                f32x2 he[23], ho[22];
#pragma unroll
                for (int k = 0; k < 23; ++k) { he[k].x = hbuf[(wave * 16 + 2 * k) * 64 + lane]; he[k].y = hbuf[(wave * 16 + 2 * k + 1) * 64 + lane]; }
#pragma unroll
                for (int k = 0; k < 22; ++k) { ho[k].x = he[k].y; ho[k].y = he[k + 1].x; }
                f32x2 a2[8];
#pragma unroll
                for (int p = 0; p < 8; ++p) a2[p] = (f32x2){cb, cb};
#pragma unroll
                for (int j = 0; j < 31; ++j) { const f32x2 wj = (f32x2){wreg[j], wreg[j]};
#pragma unroll
                    for (int p = 0; p < 8; ++p) { const int r = 2 * p + j; a2[p] = __builtin_elementwise_fma(wj, (r & 1) ? ho[r >> 1] : he[r >> 1], a2[p]); } }
#pragma unroll
                for (int p = 0; p < 8; ++p) { acc[2 * p] = a2[p].x; acc[2 * p + 1] = a2[p].y; }
            }
            const float gg = args.in[9][ch], gb = args.in[10][ch];
#pragma unroll
            for (int i = 0; i < 16; ++i) { const float mu = wave_sum(acc[i]) * (1.f / 64.f); const float d = acc[i] - mu; const float var = wave_sum(d * d) * (1.f / 64.f);
                const float hn = d * (1.0f / sqrtf(var + 1e-5f)) * gg + gb; const float ov = hn * __builtin_amdgcn_rcpf(1.0f + __builtin_amdgcn_exp2f(-hn * LOG2E));
                Y[(size_t)(b * SEQ + t0 + wave * 16 + i) * DM + 512 + ch] = (bf16)f2bf(ov); }
        }
    }
    SEAM(2);
    if (IN(3)) REP(3) {
        const bf16* QR = (const bf16*)(ws + WS_QR); const bf16* KR = (const bf16*)(ws + WS_KR); const bf16* Z0 = (const bf16*)(ws + WS_Z0);
        if (ATTN_L0_TEST) {
        for (int un = bx; un < NBATCH * 8 * 32; un += G) {
            const int qb = un & 31, h = (un >> 5) & 7, b = un >> 8, kvh = h >> 2;
            const size_t row0 = (size_t)b * SEQ + qb * 256;
            attn_unit_v0<64, false, true>((const bf16*)(ws + WS_QR8 + row0 * 512 + h * 64), 512, (const bf16*)(ws + WS_KR8 + (size_t)b * SEQ * 128 + kvh * 64), 128, Z0 + (size_t)b * SEQ * EV_IN + 640 + kvh * 64, EV_IN,
                                   Y + row0 * DM + h * 64, DM, nullptr, qb * 256, lds);
        }
        } else if (ATTN_VER == 0) {
        for (int un = bx; un < NBATCH * 8 * 32; un += G) {
            const int qb = un & 31, h = (un >> 5) & 7, b = un >> 8, kvh = h >> 2;
            const size_t row0 = (size_t)b * SEQ + qb * 256;
            attn_unit_v0<64, false>(QR + row0 * 512 + h * 64, 512, KR + (size_t)b * SEQ * 128 + kvh * 64, 128, Z0 + (size_t)b * SEQ * EV_IN + 640 + kvh * 64, EV_IN,
                                   Y + row0 * DM + h * 64, DM, nullptr, qb * 256, lds);
        }
        } else {
        constexpr int U = NBATCH * 8 * 32; const int upc = (U + G - 1) / G; const int vcu = (G % 8 == 0) ? (bx % 8) * (G / 8) + bx / 8 : bx;
        for (int i = 0; i < upc; ++i) { const int un = vcu * upc + i; if (un >= U) break;
            const int stream = un >> 7, b = stream >> 1, kvh = stream & 1, h = kvh * 4 + ((un >> 5) & 3), qb = un & 31;
            const size_t row0 = (size_t)b * SEQ + qb * 256;
            if (ATTN_VER == 3) at3::attn_unit<64, false, 0>(ws + WS_QR8 + row0 * 512 + h * 64, 512, ws + WS_K8T0 + (size_t)stream * 128 * 4096, ws + WS_V8T0 + (size_t)stream * 128 * 4096, Y + row0 * DM + h * 64, DM, qb * 256, lds, nullptr);
            else if (QK_FP8) at1::attn_unit<64, false, 0, 0, true>((const bf16*)(ws + WS_QR8 + row0 * 512 + h * 64), 512, (const bf16*)(ws + WS_KR8 + (size_t)b * SEQ * 128 + kvh * 64), 128, Z0 + (size_t)b * SEQ * EV_IN + 640 + kvh * 64, EV_IN,
                                      Y + row0 * DM + h * 64, DM, qb * 256, lds);
            else at1::attn_unit<64, false>(QR + row0 * 512 + h * 64, 512, KR + (size_t)b * SEQ * 128 + kvh * 64, 128, Z0 + (size_t)b * SEQ * EV_IN + 640 + kvh * 64, EV_IN,
                                      Y + row0 * DM + h * 64, DM, qb * 256, lds);
        }
        }
    }
    SEAM(3);
    if (IN(4)) REP(4) {
        pg8::Gemm g{Y, (const bf16*)(ws + WS_WOUT0), NTOK, DM, DM}; pg8::StaticOrder S; S.init(NTOK, DM, G, bx);
        pg8::EpiRes E{x_in, nullptr, XB, DM};
        pg8::gemm_phase<pg8::EpiRes, pg8::StaticOrder, true>(lds, g, S, E);
    }
    SEAM(4);

    moe_block<0>(args, lds, bar, lo, hi_ph);
    SEAM(8);
            if (IN(9)) REP(9) {
                pg8::Gemm g{HB, (const bf16*)(ws + WS_WIN1), NTOK, OD_IN, IN1_FP8 ? DM / 2 : DM}; pg8::StaticOrder S; S.init(NTOK, OD_IN, G, bx);
                if (QK_FP8) { pg8::EpiQKV8 E{ws + WS_Q1, ws + WS_K8T1, (bf16*)(ws + WS_V1), C2 * 8.0f, true};
                    if (IN1_FP8) pg8::gemm_phase<pg8::EpiQKV8, pg8::StaticOrder, true, true, 127, 122>(lds, g, S, E);
                    else pg8::gemm_phase<pg8::EpiQKV8, pg8::StaticOrder, true>(lds, g, S, E); }
                else { pg8::EpiBf16 E{(bf16*)(ws + WS_Q1), DM, DM, (size_t)(WS_K1 - WS_Q1) / 2, C2, 0xffff, false};
                pg8::gemm_phase<pg8::EpiBf16, pg8::StaticOrder, true>(lds, g, S, E); }
            }
            SEAM(9);
            if (ATTN_L1_VER == 3) {
            if (IN(10)) {
                const bf16* V1 = (const bf16*)(ws + WS_V1);
                for (int it = bx * 512 + tid; it < 32 * 128 * 4 * 128; it += G * 512) { const int d = it & 127, c = (it >> 7) & 3, tt = (it >> 9) & 127, bh = it >> 16;
                    const bf16* vb_ = V1 + (((size_t)bh * 128 + tt) * 4 + (d >> 5)) * 2048 + (d & 31); unsigned w4[4];
#pragma unroll
                    for (int q = 0; q < 4; ++q) { float f[4];
#pragma unroll
                        for (int j = 0; j < 4; ++j) { const int bb = q * 4 + j; const int key = 32 * (c & 1) + (bb & 3) + 8 * (bb >> 2) + 4 * (c >> 1); f[j] = bf2f(vb_[(size_t)key * 32]); }
                        int dw = __builtin_amdgcn_cvt_pk_fp8_f32(f[0], f[1], 0, false); dw = __builtin_amdgcn_cvt_pk_fp8_f32(f[2], f[3], dw, true); w4[q] = (unsigned)dw; }
                    *(GAS v4u*)(ws + WS_V8T1 + (size_t)it * 16) = (v4u){w4[0], w4[1], w4[2], w4[3]}; }
            }
            SEAM(10);
            if (IN(11)) REP(11) {
                constexpr int UP = NBATCH * 8 * 32; const int upc = (UP + G - 1) / G; const int vcu = (G % 8 == 0) ? (bx % 8) * (G / 8) + bx / 8 : bx;
                LAS float* btbl = (LAS float*)(lds + at3::lds_tbl_off<128>());
                LAS float* sgt = btbl + 272;
                __syncthreads();
                if (tid < 128) sgt[tid] = args.in[17][tid] * (1.0f - LAM_INIT);
                if (wave == 7) { const float lam = __expf(wave_sum(args.in[13][lane] * args.in[14][lane])) - __expf(wave_sum(args.in[15][lane] * args.in[16][lane])) + LAM_INIT; if (lane == 0) sgt[128] = lam; }
                for (int i = 0; i < upc; ++i) {
                    int up = vcu * upc + i; if (up >= UP) break;
                    if (G == 256) up = ((vcu >> 5) * 4 + i) * 32 + (vcu & 31);
                    const int qb = up & 31, h = (up >> 5) & 7, b = up >> 8;
                    __syncthreads();
                    if (tid < 257) btbl[tid] = TBL[TBL_BIAS + h * BIAS_STRIDE + tid] - TBL[TBL_BIAS + h * BIAS_STRIDE + 256];
                    __syncthreads();
                    const size_t row0 = (size_t)b * SEQ + qb * 256; const int bh = b * 8 + h;
                    const unsigned char* Q8 = ws + WS_Q1 + row0 * DM + h * 128; const unsigned char* V8 = ws + WS_V8T1 + (size_t)bh * 128 * 8192;
                    at3::attn_unit<128, true, 1>(Q8, DM, ws + WS_K8T1 + (size_t)(bh * 2) * 128 * 4096, V8, nullptr, DM, qb * 256, lds, sgt);
                    at3::attn_unit<128, true, 2>(Q8 + 64, DM, ws + WS_K8T1 + (size_t)(bh * 2 + 1) * 128 * 4096, V8, Y + row0 * DM + h * 128, DM, qb * 256, lds, sgt);
                }
            }
            SEAM(11);
            } else {
            if (IN(10)) REP(10) {
                const bf16* Q1 = (const bf16*)(ws + WS_Q1); const bf16* K1 = (const bf16*)(ws + WS_K1); const bf16* V1 = (const bf16*)(ws + WS_V1);
                if (ATTN_L1_VER == 0) {
                LAS float* btbl = (LAS float*)(lds + 65536);
                for (int un = bx; un < NBATCH * 8 * 2 * 32; un += G) {
                    const int qb = un & 31, c = (un >> 5) & 1, h = (un >> 6) & 7, b = un >> 9;
                    __syncthreads();
                    if (tid < 257) btbl[tid] = TBL[TBL_BIAS + h * BIAS_STRIDE + tid];
                    __syncthreads();
                    const size_t row0 = (size_t)b * SEQ + qb * 256, brow = (size_t)b * SEQ;
                    bf16* OC = (bf16*)(ws + (c ? WS_OC1 : WS_OC0));
                    attn_unit_v0<128, true>(Q1 + row0 * DM + h * 128 + c * 64, DM, K1 + brow * DM + h * 128 + c * 64, DM, V1 + brow * DM + h * 128, DM,
                                           OC + row0 * DM + h * 128, DM, btbl, qb * 256, lds);
                }
                } else {
                constexpr int UP = NBATCH * 8 * 32; const int upc = (UP + G - 1) / G; const int vcu = (G % 8 == 0) ? (bx % 8) * (G / 8) + bx / 8 : bx;
                LAS float* btbl = (LAS float*)(lds + at1::lds_tbl_off<128, QK_FP8 != 0>());
                LAS float* sgt = btbl + 272;
                __syncthreads();
                if (tid < 128) sgt[tid] = args.in[17][tid] * (1.0f - LAM_INIT);
                if (wave == 7) { const float lam = __expf(wave_sum(args.in[13][lane] * args.in[14][lane])) - __expf(wave_sum(args.in[15][lane] * args.in[16][lane])) + LAM_INIT; if (lane == 0) sgt[128] = lam; }
                for (int i = 0; i < upc; ++i) {
                    int up = vcu * upc + i; if (up >= UP) break;
                    if (G == 256) up = ((vcu >> 5) * 4 + i) * 32 + (vcu & 31);
                    const int qb = up & 31, h = (up >> 5) & 7, b = up >> 8;
                    __syncthreads();
                    if (tid < 257) btbl[tid] = TBL[TBL_BIAS + h * BIAS_STRIDE + tid] - TBL[TBL_BIAS + h * BIAS_STRIDE + 256];
                    __syncthreads();
                    const size_t row0 = (size_t)b * SEQ + qb * 256, brow = (size_t)b * SEQ;
                    if (QK_FP8) { const unsigned char* Q8 = ws + WS_Q1; const unsigned char* K8 = ws + WS_K1;
                    const int bh = b * 8 + h; const bf16* VT = V1 + (size_t)bh * 128 * 8192; const unsigned char* KT0 = ws + WS_K8T1 + (size_t)(bh * 2) * 128 * 4096; (void)K8; (void)brow;
                    at1::attn_unit<128, true, 0, 1, true, true>((const bf16*)(Q8 + row0 * DM + h * 128), DM, (const bf16*)KT0, DM, VT, DM, nullptr, DM, qb * 256, lds, sgt);
                    at1::attn_unit<128, true, 0, 2, true, true>((const bf16*)(Q8 + row0 * DM + h * 128 + 64), DM, (const bf16*)(KT0 + 128 * 4096), DM, VT, DM, Y + row0 * DM + h * 128, DM, qb * 256, lds, sgt);
                    } else {
                    at1::attn_unit<128, true, 0, 1>(Q1 + row0 * DM + h * 128, DM, K1 + brow * DM + h * 128, DM, V1 + brow * DM + h * 128, DM, nullptr, DM, qb * 256, lds, sgt);
                    at1::attn_unit<128, true, 0, 2>(Q1 + row0 * DM + h * 128 + 64, DM, K1 + brow * DM + h * 128 + 64, DM, V1 + brow * DM + h * 128, DM, Y + row0 * DM + h * 128, DM, qb * 256, lds, sgt);
                    }
                }
                }
            }
            SEAM(10);
            if (PROBE_ATT >= 0 && IN(10)) {
                const bf16* Q1 = (const bf16*)(ws + WS_Q1); const bf16* K1 = (const bf16*)(ws + WS_K1); const bf16* V1 = (const bf16*)(ws + WS_V1);
                constexpr int U = NBATCH * 8 * 2 * 32; const int upc = (U + G - 1) / G; const int vcu = (G % 8 == 0) ? (bx % 8) * (G / 8) + bx / 8 : bx;
                LAS float* btbl = (LAS float*)(lds + 3 * 8192 + 3 * 16384 + 2048);
                for (int i = 0; i < upc; ++i) {
                    int un = vcu * upc + i; if (un >= U) break;
                    if (G == 256) un = ((vcu >> 5) * 4 + (i >> 1)) * 64 + (i & 1) * 32 + (vcu & 31);
                    const int qb = un & 31, c = (un >> 5) & 1, h = (un >> 6) & 7, b = un >> 9;
                    if (tid < 257) btbl[tid] = TBL[TBL_BIAS + h * BIAS_STRIDE + tid] - TBL[TBL_BIAS + h * BIAS_STRIDE + 256];
                    __syncthreads();
                    const size_t row0 = (size_t)b * SEQ + qb * 256, brow = (size_t)b * SEQ;
                    at1::attn_unit<128, true, (PROBE_ATT >= 0 ? PROBE_ATT : 0)>(Q1 + row0 * DM + h * 128 + c * 64, DM, K1 + brow * DM + h * 128 + c * 64, DM, V1 + brow * DM + h * 128, DM,
                                              (bf16*)(ws + WS_OC1) + row0 * DM + h * 128, DM, qb * 256, lds);
                }
                xcd_barrier(bar);
            }
            if (IN(11) && ATTN_L1_VER != 1) REP(11) {
                const bf16* OC0 = (const bf16*)(ws + WS_OC0); const bf16* OC1 = (const bf16*)(ws + WS_OC1);
                const float lam = __expf(wave_sum(args.in[13][lane] * args.in[14][lane])) - __expf(wave_sum(args.in[15][lane] * args.in[16][lane])) + LAM_INIT;
                float sg[16];
#pragma unroll
                for (int j = 0; j < 16; ++j) sg[j] = args.in[17][(lane & 7) * 16 + j] * (1.0f - LAM_INIT);
                for (int m = gw; m < NTOK; m += NGW) {
                    const GAS v4u* a = (const GAS v4u*)(OC0 + (size_t)m * DM) + lane * 2; const GAS v4u* c = (const GAS v4u*)(OC1 + (size_t)m * DM) + lane * 2;
                    float o[16]; float ss = 0.f;
#pragma unroll
                    for (int q = 0; q < 2; ++q) { const v4u av = a[q], cv = c[q];
#pragma unroll
                        for (int j = 0; j < 4; ++j) { const unsigned au = av[j], cu = cv[j];
                            const float lo = __builtin_bit_cast(float, au << 16) - lam * __builtin_bit_cast(float, cu << 16);
                            const float hh = __builtin_bit_cast(float, au & 0xffff0000u) - lam * __builtin_bit_cast(float, cu & 0xffff0000u);
                            o[q * 8 + 2 * j] = lo; o[q * 8 + 2 * j + 1] = hh; ss += lo * lo + hh * hh; } }
                    ss += __shfl_xor(ss, 1); ss += __shfl_xor(ss, 2); ss += __shfl_xor(ss, 4);
                    const float rstd = 1.0f / sqrtf(ss * (1.f / 128.f) + 1e-5f);
                    v4u w0, w1;
                    w0.x = pk2(o[0] * rstd * sg[0], o[1] * rstd * sg[1]); w0.y = pk2(o[2] * rstd * sg[2], o[3] * rstd * sg[3]); w0.z = pk2(o[4] * rstd * sg[4], o[5] * rstd * sg[5]); w0.w = pk2(o[6] * rstd * sg[6], o[7] * rstd * sg[7]);
                    w1.x = pk2(o[8] * rstd * sg[8], o[9] * rstd * sg[9]); w1.y = pk2(o[10] * rstd * sg[10], o[11] * rstd * sg[11]); w1.z = pk2(o[12] * rstd * sg[12], o[13] * rstd * sg[13]); w1.w = pk2(o[14] * rstd * sg[14], o[15] * rstd * sg[15]);
                    GAS v4u* yo = (GAS v4u*)(Y + (size_t)m * DM) + lane * 2; yo[0] = w0; yo[1] = w1;
                }
            }
            if (ATTN_L1_VER != 1) SEAM(11);
            }
            if (IN(12)) {
                pg8::Gemm g{Y, (const bf16*)(ws + WS_WOUT1), NTOK, DM, DM}; pg8::StaticOrder S; S.init(NTOK, DM, G, bx);
                pg8::EpiRes E{nullptr, XB, XB, DM};
                pg8::gemm_phase<pg8::EpiRes, pg8::StaticOrder, true>(lds, g, S, E);
            }
            SEAM(12);
    moe_block<1>(args, lds, bar, lo, hi_ph);
#undef IN
#undef SEAM
}

extern "C" void kernel_launch(void* const* d_in, const int* in_sizes, int n_in, void* d_out, int out_size, void* d_ws, size_t ws_size, hipStream_t stream) {
    static int grid = 0;
    if (grid == 0) {
        if (n_in != 27 || in_sizes[0] != NTOK * DM || out_size != NTOK * DM || ws_size < WS_END) { fprintf(stderr, "kernel_launch: unexpected shapes / workspace (n_in %d, ws %zu)\n", n_in, ws_size); grid = -1; return; }
        int dev = 0, cus = 0, per_cu = 0;
        if (hipGetDevice(&dev) != hipSuccess || hipDeviceGetAttribute(&cus, hipDeviceAttributeMultiprocessorCount, dev) != hipSuccess) { grid = -1; return; }
        if (hipFuncSetAttribute((const void*)mk_fwd, hipFuncAttributeMaxDynamicSharedMemorySize, LDS_BYTES) != hipSuccess) { fprintf(stderr, "kernel_launch: hipFuncSetAttribute failed\n"); grid = -1; return; }
        if (hipOccupancyMaxActiveBlocksPerMultiprocessor(&per_cu, (const void*)mk_fwd, NWAVES * 64, LDS_BYTES) != hipSuccess || per_cu < 1) { fprintf(stderr, "kernel_launch: occupancy query says %d\n", per_cu); }
        (void)hipGetLastError();
        grid = cus;
    }
    if (grid < 0) return;
    if (hipMemsetAsync((char*)d_ws + WS_CTL, 0, CTL_ZERO_BYTES, stream) != hipSuccess) return;
    Args a{};
    for (int i = 0; i < 27; ++i) a.in[i] = (const float*)d_in[i];
    a.out = (float*)d_out; a.ws = (unsigned char*)d_ws;
    if (MK_N_LAUNCHES == 1) { a.ph_lo = 0; a.ph_hi = NPHASE; a.li = 0; hipLaunchKernelGGL(mk_fwd, dim3(grid), dim3(NWAVES * 64), LDS_BYTES, stream, a); }
    else { for (int p = 0; p < NPHASE; ++p) for (int r = 0; r < (int)((PROBE_MASK >> p) & 1u) + 1; ++r) { a.ph_lo = p; a.ph_hi = p + 1; a.li = p; hipLaunchKernelGGL(mk_fwd, dim3(grid), dim3(NWAVES * 64), LDS_BYTES, stream, a); } }
}
```

```cpp
#include <hip/hip_runtime.h>
#include <cstdio>
#include <cstdint>

#ifndef MK_N_LAUNCHES
#define MK_N_LAUNCHES 1
#endif

#ifndef ATTN_VER
#define ATTN_VER 3
#endif
#ifndef PROBE_ATT
#define PROBE_ATT -1
#endif
#ifndef QK_FP8
#define QK_FP8 1
#endif
#ifndef ATTN_L0_TEST
#define ATTN_L0_TEST 0
#endif
#ifndef ATTN_L1_VER
#define ATTN_L1_VER 3
#endif
#ifndef MOE_FP8
#define MOE_FP8 1
#endif
#ifndef IN1_FP8
#define IN1_FP8 1
#endif
#ifndef PROBE_MASK
#define PROBE_MASK 0u
#endif
#define REP(k) _Pragma("unroll") for (int rep_ = 0; rep_ < (MK_N_LAUNCHES == 1 ? (int)((PROBE_MASK >> (k)) & 1u) : 0) + 1; ++rep_)
#define GAS __attribute__((address_space(1)))
#define LAS __attribute__((address_space(3)))
typedef unsigned short bf16;
typedef unsigned v4u __attribute__((ext_vector_type(4)));
typedef unsigned v2u __attribute__((ext_vector_type(2)));
typedef float f32x4 __attribute__((ext_vector_type(4)));
typedef float f32x16 __attribute__((ext_vector_type(16)));
typedef short bf16x8 __attribute__((ext_vector_type(8)));
typedef short s16x4 __attribute__((ext_vector_type(4)));
typedef int v8i __attribute__((ext_vector_type(8)));

constexpr int NTOK = 32768, DM = 1024, SEQ = 8192, NBATCH = 4;
constexpr int EV_IN = 1792, OD_IN = 3072;
constexpr int NEXP = 32, MOE_H = 512, LIST_CAP = 32768;
constexpr float C2 = 0.125f * 1.4426950408889634f;
constexpr float LOG2E = 1.4426950408889634f;
constexpr float LAM_INIT = 0.35550906759f;

constexpr size_t MiB = 1u << 20;
constexpr size_t WS_CTL = 0, CTL_ZERO_BYTES = 1 * MiB;
constexpr size_t WS_WIN0 = 1 * MiB, WS_WOUT0 = 5 * MiB, WS_WIN1 = 7 * MiB, WS_WOUT1 = 13 * MiB, WS_TBL = 15 * MiB;
constexpr size_t WS_W13 = 16 * MiB, WS_W2 = 80 * MiB;
constexpr size_t WS_HB = 112 * MiB;
constexpr size_t WS_Y = 176 * MiB;
constexpr size_t WS_Z0 = 240 * MiB, WS_QR = 352 * MiB, WS_KR = 384 * MiB, WS_QR8 = 392 * MiB, WS_KR8 = 408 * MiB, WS_K8T0 = 408 * MiB, WS_V8T0 = 412 * MiB;
constexpr size_t WS_K8T1 = 304 * MiB, WS_V8T1 = 336 * MiB;
constexpr size_t WS_Q1 = 240 * MiB, WS_K1 = 304 * MiB, WS_V1 = 368 * MiB, WS_OC1 = 432 * MiB, WS_OC0 = WS_HB;
constexpr size_t WS_H = 176 * MiB, WS_YS = 248 * MiB, WS_LIST = 392 * MiB, WS_TOKEP = 396 * MiB, WS_GATE = 396 * MiB + 512 * 1024;
constexpr size_t WS_XB = 432 * MiB;
constexpr size_t WS_END = 496 * MiB;
constexpr int TBL_COS = 0, TBL_SIN = 2048, TBL_BIAS = 4096, BIAS_STRIDE = 272;
constexpr int TBL_WR = 32768, WR_LAYER = 1024 * 48 + 64;
constexpr int CW_BAR = 4096;
constexpr int CW_CNT = 16384;

constexpr int RING_BYTES = 131072;
constexpr int LDS_BYTES = 147456;
constexpr int LDSCTL_OFF = LDS_BYTES - 1024;
constexpr int STASH_OFF = 78 * 1024;
constexpr int LC_BAR = 8;
constexpr int LC_TP = 16;
constexpr int LC_CNT = 64;
constexpr int LC_LCNT = 96;
constexpr int LC_LBASE = 128;
constexpr int LC_LP = 160;

#define LDS_WAIT() asm volatile("s_waitcnt lgkmcnt(0)" ::: "memory")
#define VM_WAIT() asm volatile("s_waitcnt vmcnt(0)" ::: "memory")
#define RLX_AGENT __ATOMIC_RELAXED, __HIP_MEMORY_SCOPE_AGENT

__device__ __forceinline__ unsigned f2bf(float f) { unsigned u = __builtin_bit_cast(unsigned, f); return (u + 0x7fffu + ((u >> 16) & 1u)) >> 16; }
__device__ __forceinline__ unsigned pk2(float lo, float hi) { return f2bf(lo) | (f2bf(hi) << 16); }
__device__ __forceinline__ float bf2f(unsigned short b) { return __builtin_bit_cast(float, (unsigned)b << 16); }
template <int CTRL> __device__ __forceinline__ float dpp_mov(float v) { return __builtin_bit_cast(float, __builtin_amdgcn_update_dpp(0, __builtin_bit_cast(int, v), CTRL, 0xf, 0xf, true)); }
__device__ __forceinline__ float wave_sum(float v) {
    v += dpp_mov<0xB1>(v); v += dpp_mov<0x4E>(v); v += dpp_mov<0x141>(v); v += dpp_mov<0x140>(v);
    { auto rr = __builtin_amdgcn_permlane16_swap(__float_as_uint(v), __float_as_uint(v), false, false); v = __uint_as_float(rr[0]) + __uint_as_float(rr[1]); }
    { auto rr = __builtin_amdgcn_permlane32_swap(__float_as_uint(v), __float_as_uint(v), false, false); v = __uint_as_float(rr[0]) + __uint_as_float(rr[1]); }
    return v;
}


__device__ __forceinline__ unsigned fp8_byte(float v) { return (unsigned)__builtin_amdgcn_cvt_pk_fp8_f32(v, v, 0, false) & 0xffu; }
__device__ __forceinline__ unsigned quad_pack_bytes(unsigned b) {
    const unsigned x0 = (unsigned)__builtin_amdgcn_update_dpp(0, (int)b, 0x00, 0xf, 0xf, true), x1 = (unsigned)__builtin_amdgcn_update_dpp(0, (int)b, 0x55, 0xf, 0xf, true);
    const unsigned x2 = (unsigned)__builtin_amdgcn_update_dpp(0, (int)b, 0xAA, 0xf, 0xf, true), x3 = (unsigned)__builtin_amdgcn_update_dpp(0, (int)b, 0xFF, 0xf, 0xf, true);
    return x0 | (x1 << 8) | (x2 << 16) | (x3 << 24);
}
namespace pg8 {
#define PG8_LAS __attribute__((address_space(3)))
typedef unsigned short bf16_t;
typedef short bf16x8 __attribute__((ext_vector_type(8)));
typedef float f32x4 __attribute__((ext_vector_type(4)));
typedef unsigned u32x4 __attribute__((ext_vector_type(4)));
constexpr int BM = 256, BK = 64, HALF = 128, HTB = HALF * BK * 2, STAGE_BYTES = 8 * HTB, NXCD = 8, WGM = 8;

__host__ __device__ __forceinline__ int lds_byte(int r, int c) { const int st = (r >> 4) * 2 + (c >> 5), rr = r & 15, cc = c & 31, ob = rr * 64 + cc * 2; return st * 1024 + (ob ^ (((ob >> 9) & 1) << 5)); }
__host__ __device__ __forceinline__ void stage_rc(int b, int& R, int& C) { const int st = b / 1024, sb = b % 1024, swz = sb ^ (((sb >> 9) & 1) << 5); R = (st >> 1) * 16 + swz / 64; C = (st & 1) * 32 + (swz % 64) / 2; }
__host__ __device__ __forceinline__ int perm32(int rho) { const int n = rho >> 4, i = rho & 15; return 8 * (i >> 2) + 4 * n + (i & 3); }

struct Unit { int pm, pn, e, rb; };
struct Gemm { const bf16_t* A; const bf16_t* Bt; int M, N, K; };

struct StaticOrder {
    int nM, nN, nwg, G, c;
    __device__ void init(int M, int N, int G_, int c_) { nM = M / BM; nN = N / BM; nwg = nM * nN; G = G_; c = c_; }
    __device__ bool next(int i, Unit& u) const {
        const long L = (long)i * G + c; if (L >= nwg) return false;
        int wgid = (int)L; { const int q = nwg / NXCD, r = nwg % NXCD, xcd = wgid % NXCD, off = wgid / NXCD; wgid = (xcd < r ? xcd * (q + 1) : r * (q + 1) + (xcd - r) * q) + off; }
        const int nig = WGM * nN, gid = wgid / nig, fm = gid * WGM, gsz = (nM - fm) < WGM ? (nM - fm) : WGM;
        u.pm = fm + ((wgid % nig) % gsz); u.pn = (wgid % nig) / gsz; u.e = 0; u.rb = 0; return true;
    }
    __device__ __forceinline__ unsigned arow(const Unit& u, int rr) const { return (unsigned)(u.pm * BM + rr); }
};

struct MoeOrder {
    const PG8_LAS int* tp; const PG8_LAS int* cn; const PG8_LAS int* lp; const int* list; int G, c, nunits; bool gather; bool xcd;
    __device__ __forceinline__ bool next(int i, Unit& u) const {
        int e_, rb_, pm_, pnl_; bool ok;
        if (xcd) {
            const int x = c & 7, y = c >> 3; const int uidx = i * 32 + y; ok = uidx < lp[4] * 4;
            const int rbl = uidx >> 2; pnl_ = uidx & 3; int j = 0;
#pragma unroll
            for (int q = 1; q < 4; ++q) j += (lp[q] <= rbl) ? 1 : 0;
            e_ = x + 8 * j; rb_ = rbl - lp[j]; pm_ = tp[e_] + rb_;
        } else {
            const int L = i * G + c; ok = L < nunits;
            const int rbg = L >> 2; pnl_ = L & 3; int e = 0;
#pragma unroll
            for (int j = 1; j < 32; ++j) e += (tp[j] <= rbg) ? 1 : 0;
            e_ = e; pm_ = rbg; rb_ = rbg - tp[e];
        }
        u.e = __builtin_amdgcn_readfirstlane(e_); u.rb = __builtin_amdgcn_readfirstlane(rb_); u.pm = __builtin_amdgcn_readfirstlane(pm_); u.pn = __builtin_amdgcn_readfirstlane(e_ * 4 + pnl_);
        return ok;
    }
    __device__ __forceinline__ unsigned arow(const Unit& u, int rr) const {
        if (!gather) return (unsigned)(u.pm * BM + rr);
        const int idx = u.rb * BM + rr; unsigned t = 0u;
        if (idx < cn[u.e]) t = (unsigned)list[(size_t)u.e * 32768 + idx];
        return t;
    }
};

__device__ __forceinline__ unsigned cvt_pk_bf16(float lo, float hi) { unsigned r; asm volatile("v_cvt_pk_bf16_f32 %0, %1, %2" : "=v"(r) : "v"(lo), "v"(hi)); return r; }

struct EpiBf16 {
    static constexpr bool PERM = true;
    bf16_t* O; int ldc; int split_cols; size_t split_stride; float scale0; int pn_mask; bool f8;
    __device__ __forceinline__ void operator()(const f32x4 (&acc)[2][2][4][2], const Unit& u, int wr, int wc, int fr, int fq) const {
        const int row0 = u.pm * BM + wr * 64 + fr; int colt = (u.pn & pn_mask) * BM; bf16_t* base = O;
        float sc = 1.f; if (split_cols) { const int t = colt / split_cols; base += (size_t)t * split_stride; colt -= t * split_cols; if (t == 0) sc = scale0; }
        if (f8) sc = 8.0f;
        const int col0 = colt + wc * 32 + 8 * fq;
#pragma unroll
        for (int ai = 0; ai < 2; ++ai)
#pragma unroll
            for (int m = 0; m < 4; ++m) { const size_t ro = (size_t)(row0 + ai * HALF + m * 16) * ldc + col0;
#pragma unroll
                for (int bj = 0; bj < 2; ++bj) { f32x4 v0 = acc[ai][bj][m][0] * sc, v1 = acc[ai][bj][m][1] * sc;
                    if (f8) { typedef unsigned u32x2 __attribute__((ext_vector_type(2)));
                        int d0 = __builtin_amdgcn_cvt_pk_fp8_f32(v0[0], v0[1], 0, false); d0 = __builtin_amdgcn_cvt_pk_fp8_f32(v0[2], v0[3], d0, true);
                        int d1 = __builtin_amdgcn_cvt_pk_fp8_f32(v1[0], v1[1], 0, false); d1 = __builtin_amdgcn_cvt_pk_fp8_f32(v1[2], v1[3], d1, true);
                        *(u32x2*)((unsigned char*)base + ro + bj * HALF) = (u32x2){(unsigned)d0, (unsigned)d1};
                    } else {
                    u32x4 w; w.x = cvt_pk_bf16(v0[0], v0[1]); w.y = cvt_pk_bf16(v0[2], v0[3]); w.z = cvt_pk_bf16(v1[0], v1[1]); w.w = cvt_pk_bf16(v1[2], v1[3]);
                    *(u32x4*)(base + ro + bj * HALF) = w; } } }
    }
};
struct EpiRes {
    static constexpr bool PERM = true;
    const float* base32; const bf16_t* base16; bf16_t* out; int ldc;
    __device__ __forceinline__ void operator()(const f32x4 (&acc)[2][2][4][2], const Unit& u, int wr, int wc, int fr, int fq) const {
        const int row0 = u.pm * BM + wr * 64 + fr, col0 = u.pn * BM + wc * 32 + 8 * fq;
#pragma unroll
        for (int ai = 0; ai < 2; ++ai)
#pragma unroll
            for (int m = 0; m < 4; ++m) { const size_t off = (size_t)(row0 + ai * HALF + m * 16) * ldc + col0;
#pragma unroll
                for (int bj = 0; bj < 2; ++bj) { f32x4 b0, b1;
                    if (base32) { b0 = *(const f32x4*)(base32 + off + bj * HALF); b1 = *(const f32x4*)(base32 + off + bj * HALF + 4); }
                    else { const u32x4 w = *(const u32x4*)(base16 + off + bj * HALF);
                        b0 = (f32x4){__builtin_bit_cast(float, w.x << 16), __builtin_bit_cast(float, w.x & 0xffff0000u), __builtin_bit_cast(float, w.y << 16), __builtin_bit_cast(float, w.y & 0xffff0000u)};
                        b1 = (f32x4){__builtin_bit_cast(float, w.z << 16), __builtin_bit_cast(float, w.z & 0xffff0000u), __builtin_bit_cast(float, w.w << 16), __builtin_bit_cast(float, w.w & 0xffff0000u)}; }
                    const f32x4 v0 = b0 + acc[ai][bj][m][0], v1 = b1 + acc[ai][bj][m][1];
                    u32x4 o; o.x = cvt_pk_bf16(v0[0], v0[1]); o.y = cvt_pk_bf16(v0[2], v0[3]); o.z = cvt_pk_bf16(v1[0], v1[1]); o.w = cvt_pk_bf16(v1[2], v1[3]);
                    *(u32x4*)(out + off + bj * HALF) = o; } }
    }
};
struct EpiQKV8 {
    static constexpr bool PERM = true;
    unsigned char* Q8; unsigned char* K8; bf16_t* V; float qscale; bool ktiled;
    __device__ __forceinline__ void operator()(const f32x4 (&acc)[2][2][4][2], const Unit& u, int wr, int wc, int fr, int fq) const {
        const int row0 = u.pm * BM + wr * 64 + fr; const int colt = u.pn * BM; const int t = colt >> 10; const int col0 = (colt & 1023) + wc * 32 + 8 * fq;
        const float sc = t == 0 ? qscale : 1.0f;
#pragma unroll
        for (int ai = 0; ai < 2; ++ai)
#pragma unroll
            for (int m = 0; m < 4; ++m) { const size_t ro = (size_t)(row0 + ai * HALF + m * 16) * 1024 + col0;
#pragma unroll
                for (int bj = 0; bj < 2; ++bj) { const f32x4 v0 = acc[ai][bj][m][0] * sc, v1 = acc[ai][bj][m][1] * sc;
                    if (t == 2) { u32x4 w; w.x = cvt_pk_bf16(v0[0], v0[1]); w.y = cvt_pk_bf16(v0[2], v0[3]); w.z = cvt_pk_bf16(v1[0], v1[1]); w.w = cvt_pk_bf16(v1[2], v1[3]);
                        if (ktiled) { const int mrow = row0 + ai * HALF + m * 16, n = col0 + bj * HALF; const int bh = (mrow >> 13) * 8 + (n >> 7), sq = mrow & 8191, d = n & 127;
                            *(u32x4*)(V + (((size_t)bh * 128 + (sq >> 6)) * 4 + (d >> 5)) * 2048 + (sq & 63) * 32 + (d & 31)) = w; }
                        else *(u32x4*)(V + ro + bj * HALF) = w; }
                    else { int d0 = __builtin_amdgcn_cvt_pk_fp8_f32(v0[0], v0[1], 0, false); d0 = __builtin_amdgcn_cvt_pk_fp8_f32(v0[2], v0[3], d0, true);
                        int d1 = __builtin_amdgcn_cvt_pk_fp8_f32(v1[0], v1[1], 0, false); d1 = __builtin_amdgcn_cvt_pk_fp8_f32(v1[2], v1[3], d1, true);
                        typedef int i32x2 __attribute__((ext_vector_type(2)));
                        if (t == 1 && ktiled) { const int mrow = row0 + ai * HALF + m * 16, n = col0 + bj * HALF; const int strm = ((mrow >> 13) * 8 + (n >> 7)) * 2 + ((n >> 6) & 1), sq = mrow & 8191, dd = n & 63;
                            *(i32x2*)(K8 + ((((size_t)strm * 128 + (sq >> 6)) * 4 + (dd >> 4)) * 64 + (sq & 63)) * 16 + (dd & 15)) = (i32x2){d0, d1}; }
                        else *(i32x2*)((t == 0 ? Q8 : K8) + ro + bj * HALF) = (i32x2){d0, d1}; } } }
    }
};
__device__ __forceinline__ float silu_mul(float a, float b) { return a * b * __builtin_amdgcn_rcpf(1.0f + __builtin_amdgcn_exp2f(-a * 1.4426950408889634f)); }
struct EpiSwiglu {
    static constexpr bool PERM = true;
    bf16_t* O; bool f8;
    __device__ __forceinline__ void operator()(const f32x4 (&acc)[2][2][4][2], const Unit& u, int wr, int wc, int fr, int fq) const {
        const int row0 = u.pm * BM + wr * 64 + fr, col0 = (u.pn & 3) * 128 + wc * 32 + 8 * fq;
#pragma unroll
        for (int ai = 0; ai < 2; ++ai)
#pragma unroll
            for (int m = 0; m < 4; ++m) { const size_t ro = (size_t)(row0 + ai * HALF + m * 16) * 512 + col0;
                const f32x4 a0 = acc[ai][0][m][0], a1 = acc[ai][0][m][1], b0 = acc[ai][1][m][0], b1 = acc[ai][1][m][1];
                if (f8) { typedef unsigned u32x2 __attribute__((ext_vector_type(2)));
                    int d0 = __builtin_amdgcn_cvt_pk_fp8_f32(4.f * silu_mul(a0[0], b0[0]), 4.f * silu_mul(a0[1], b0[1]), 0, false); d0 = __builtin_amdgcn_cvt_pk_fp8_f32(4.f * silu_mul(a0[2], b0[2]), 4.f * silu_mul(a0[3], b0[3]), d0, true);
                    int d1 = __builtin_amdgcn_cvt_pk_fp8_f32(4.f * silu_mul(a1[0], b1[0]), 4.f * silu_mul(a1[1], b1[1]), 0, false); d1 = __builtin_amdgcn_cvt_pk_fp8_f32(4.f * silu_mul(a1[2], b1[2]), 4.f * silu_mul(a1[3], b1[3]), d1, true);
                    *(u32x2*)((unsigned char*)O + ro) = (u32x2){(unsigned)d0, (unsigned)d1};
                } else {
                u32x4 w; w.x = cvt_pk_bf16(silu_mul(a0[0], b0[0]), silu_mul(a0[1], b0[1])); w.y = cvt_pk_bf16(silu_mul(a0[2], b0[2]), silu_mul(a0[3], b0[3]));
                w.z = cvt_pk_bf16(silu_mul(a1[0], b1[0]), silu_mul(a1[1], b1[1])); w.w = cvt_pk_bf16(silu_mul(a1[2], b1[2]), silu_mul(a1[3], b1[3]));
                *(u32x4*)(O + ro) = w; } }
    }
};

template <class Epi, class Sched, bool ALIGN_EPI, bool F8 = false, int SCA = 127, int SCB = 127>
__device__ __forceinline__ void gemm_phase(PG8_LAS unsigned char* lds, const Gemm g, const Sched& S, const Epi& E) {
    const int tid = threadIdx.x, wid = __builtin_amdgcn_readfirstlane(tid >> 6), lane = tid & 63, wr = wid >> 2, wc = wid & 3, fr = lane & 15, fq = lane >> 4;
    const int K = g.K, nt = K / BK;
    int RA[2], CA[2]; unsigned voffB[2];
#pragma unroll
    for (int i = 0; i < 2; ++i) { int R, C; stage_rc(tid * 16 + i * 8192, R, C); RA[i] = R; CA[i] = C; const int Rb = Epi::PERM ? ((R & ~31) + perm32(R & 31)) : R; voffB[i] = (unsigned)(Rb * K + C) * 2u; }
    const size_t kstep = (size_t)(BK * 2);
    const size_t hstep = (size_t)HALF * K * 2;
    const size_t tstep = 2 * hstep;
    const unsigned ldsw = (unsigned)wid * 1024u;
    const int aoff = lds_byte(wr * 64 + fr, fq * 8), boff = lds_byte(wc * 32 + fr, fq * 8);
#define PG8_SA(b, h) (((b) * 2 + (h)) * HTB)
#define PG8_SB(b, h) ((4 + (b) * 2 + (h)) * HTB)
#define PG8_STAGE(bufoff, gbase, voff) do { _Pragma("unroll") for (int _i = 0; _i < 2; ++_i) \
        __builtin_amdgcn_global_load_lds((const unsigned*)((const char*)(gbase) + (voff)[_i]), (PG8_LAS unsigned*)(lds + (bufoff) + ldsw + _i * 8192), 16, 0, 0); } while (0)
#define PG8_LD8(p_) ({ typedef int v4i_ __attribute__((ext_vector_type(4))); const v4i_ lo_ = *(const PG8_LAS v4i_*)(p_), hi_ = *(const PG8_LAS v4i_*)((p_) + 1024); __builtin_shufflevector(lo_, hi_, 0, 1, 2, 3, 4, 5, 6, 7); })
#define PG8_LDA(dst, b, h) do { if (F8) { _Pragma("unroll") for (int m = 0; m < 4; ++m) dst##8[m] = PG8_LD8(lds + PG8_SA(b, h) + aoff + m * 2048); } \
        else { _Pragma("unroll") for (int m = 0; m < 4; ++m) _Pragma("unroll") for (int k = 0; k < 2; ++k) dst[m][k] = *(const PG8_LAS bf16x8*)(lds + PG8_SA(b, h) + aoff + m * 2048 + k * 1024); } } while (0)
#define PG8_LDB(dst, b, h) do { if (F8) { _Pragma("unroll") for (int n = 0; n < 2; ++n) dst##8[n] = PG8_LD8(lds + PG8_SB(b, h) + boff + n * 2048); } \
        else { _Pragma("unroll") for (int n = 0; n < 2; ++n) _Pragma("unroll") for (int k = 0; k < 2; ++k) dst[n][k] = *(const PG8_LAS bf16x8*)(lds + PG8_SB(b, h) + boff + n * 2048 + k * 1024); } } while (0)
#define PG8_MMA(ai, bj, At, Bt) do { __builtin_amdgcn_s_setprio(1); \
        if (F8) { _Pragma("unroll") for (int m = 0; m < 4; ++m) _Pragma("unroll") for (int n = 0; n < 2; ++n) \
            asm volatile("v_mfma_scale_f32_16x16x128_f8f6f4 %0, %1, %2, %0, %3, %4 op_sel_hi:[0,0,0]" : "+v"(acc[ai][bj][m][n]) : "v"(Bt##8[n]), "v"(At##8[m]), "v"(scb_), "v"(sca_)); } \
        else { _Pragma("unroll") for (int m = 0; m < 4; ++m) _Pragma("unroll") for (int n = 0; n < 2; ++n) _Pragma("unroll") for (int k = 0; k < 2; ++k) \
        acc[ai][bj][m][n] = __builtin_amdgcn_mfma_f32_16x16x32_bf16(Bt[n][k], At[m][k], acc[ai][bj][m][n], 0, 0, 0); } __builtin_amdgcn_s_setprio(0); } while (0)
#define PG8_WAIT_V(n) asm volatile("s_waitcnt vmcnt(" #n ")" ::: "memory")
#define PG8_WAIT_L(n) asm volatile("s_waitcnt lgkmcnt(" #n ")" ::: "memory")
#define PG8_BAR __builtin_amdgcn_s_barrier()
#define PG8_SCHED __builtin_amdgcn_sched_barrier(0)
#define PG8_AOFF(dst, u) do { _Pragma("unroll") for (int _h = 0; _h < 2; ++_h) _Pragma("unroll") for (int _i = 0; _i < 2; ++_i) dst[_h][_i] = (S.arow(u, _h * HALF + RA[_i]) * (unsigned)K + (unsigned)CA[_i]) * 2u; } while (0)
    Unit cur, nxt; int ui = 0;
    if (!S.next(0, cur)) return;
    f32x4 acc[2][2][4][2];
#pragma unroll
    for (int a = 0; a < 2; ++a)
#pragma unroll
        for (int b = 0; b < 2; ++b)
#pragma unroll
            for (int m = 0; m < 4; ++m)
#pragma unroll
                for (int n = 0; n < 2; ++n) acc[a][b][m][n] = (f32x4){0.f, 0.f, 0.f, 0.f};
    bf16x8 At[4][2], B0[2][2], B1[2][2]; v8i At8[4], B08[2], B18[2]; const int sca_ = SCA * 0x01010101, scb_ = SCB * 0x01010101;
    unsigned offc[2][2], offn[2][2];
    PG8_AOFF(offc, cur);
    const char* const cA = (const char*)g.A; const char* cB = (const char*)g.Bt + (size_t)cur.pn * tstep;
    PG8_STAGE(PG8_SB(0, 0), cB, voffB); PG8_STAGE(PG8_SB(0, 1), cB + hstep, voffB); PG8_STAGE(PG8_SA(0, 0), cA, offc[0]); PG8_STAGE(PG8_SA(0, 1), cA, offc[1]);
    if (wr == 1) PG8_BAR;
    PG8_WAIT_V(2); PG8_BAR;
    PG8_STAGE(PG8_SB(1, 0), cB + kstep, voffB); PG8_STAGE(PG8_SA(1, 0), cA + kstep, offc[0]); PG8_STAGE(PG8_SB(1, 1), cB + hstep + kstep, voffB);
    PG8_WAIT_V(6); PG8_BAR;
    for (;;) {
        const bool has_next = S.next(ui + 1, nxt);
        if (has_next) { PG8_AOFF(offn, nxt); }
        else {
#pragma unroll
            for (int h = 0; h < 2; ++h)
#pragma unroll
                for (int i = 0; i < 2; ++i) offn[h][i] = offc[h][i]; }
        const char* nB = has_next ? (const char*)g.Bt + (size_t)nxt.pn * tstep : cB;
        for (int t = 0; t < nt; t += 2) {
            const bool last = (t == nt - 2);
            const char* a1 = cA + (size_t)(t + 1) * kstep;
            const char* a2 = last ? cA : cA + (size_t)(t + 2) * kstep; const char* b2 = last ? nB : cB + (size_t)(t + 2) * kstep;
            const char* a3 = a2 + kstep; const char* b3 = b2 + kstep;
            unsigned o2[2][2];
#pragma unroll
            for (int h = 0; h < 2; ++h)
#pragma unroll
                for (int i = 0; i < 2; ++i) o2[h][i] = last ? offn[h][i] : offc[h][i];
            PG8_LDB(B0, 0, 0); PG8_LDB(B1, 0, 1); PG8_SCHED; PG8_LDA(At, 0, 0); PG8_STAGE(PG8_SA(1, 1), a1, offc[1]);
            PG8_WAIT_V(8); PG8_WAIT_L(0); PG8_BAR; PG8_MMA(0, 0, At, B0); PG8_MMA(0, 1, At, B1); PG8_BAR; PG8_SCHED;
            PG8_LDA(At, 0, 1); PG8_STAGE(PG8_SB(0, 0), b2, voffB); PG8_STAGE(PG8_SB(0, 1), b2 + hstep, voffB); PG8_STAGE(PG8_SA(0, 0), a2, o2[0]);
            PG8_WAIT_V(8); PG8_WAIT_L(0); PG8_BAR; PG8_MMA(1, 0, At, B0); PG8_MMA(1, 1, At, B1); PG8_BAR; PG8_SCHED;
            PG8_LDB(B0, 1, 0); PG8_LDB(B1, 1, 1); PG8_SCHED; PG8_LDA(At, 1, 0); PG8_STAGE(PG8_SA(0, 1), a2, o2[1]);
            PG8_WAIT_V(8); PG8_WAIT_L(0); PG8_BAR; PG8_MMA(0, 0, At, B0); PG8_MMA(0, 1, At, B1); PG8_BAR; PG8_SCHED;
            PG8_LDA(At, 1, 1); PG8_STAGE(PG8_SB(1, 0), b3, voffB); PG8_STAGE(PG8_SB(1, 1), b3 + hstep, voffB); PG8_STAGE(PG8_SA(1, 0), a3, o2[0]);
            PG8_WAIT_V(8); PG8_WAIT_L(0); PG8_BAR; PG8_MMA(1, 0, At, B0); PG8_MMA(1, 1, At, B1); PG8_BAR; PG8_SCHED;
        }
        if constexpr (ALIGN_EPI) { if (wr == 0) PG8_BAR; }
        if (F8) asm volatile("s_nop 15\n\ts_nop 15" ::: "memory");
        E(acc, cur, wr, wc, fr, fq);
        if (!has_next) break;
#pragma unroll
        for (int a = 0; a < 2; ++a)
#pragma unroll
            for (int b = 0; b < 2; ++b)
#pragma unroll
                for (int m = 0; m < 4; ++m)
#pragma unroll
                    for (int n = 0; n < 2; ++n) acc[a][b][m][n] = (f32x4){0.f, 0.f, 0.f, 0.f};
        cur = nxt; cB = nB; ++ui;
#pragma unroll
        for (int h = 0; h < 2; ++h)
#pragma unroll
            for (int i = 0; i < 2; ++i) offc[h][i] = offn[h][i];
        if constexpr (ALIGN_EPI) { if (wr == 1) PG8_BAR; }
    }
    PG8_WAIT_V(0);
    if constexpr (!ALIGN_EPI) { if (wr == 0) PG8_BAR; }
    PG8_BAR;
#undef PG8_SA
#undef PG8_SB
#undef PG8_STAGE
#undef PG8_LDA
#undef PG8_LDB
#undef PG8_MMA
#undef PG8_LD8
#undef PG8_WAIT_V
#undef PG8_WAIT_L
#undef PG8_BAR
#undef PG8_SCHED
#undef PG8_AOFF
}
}

#define XB_TMO      128
#define XB_XCNT(j)  (256  + 64 * (j))
#define XB_XSUB(j)  (1280 + 64 * (j))
#define XB_XGEN(j)  (2304 + 64 * (j))
#define XB_TOP      3328
#define XB_TOPGEN   3392
#define XCD_BAR_WORDS 3456
#define XB_SPIN_CAP (1u << 18)

__device__ __forceinline__ unsigned xb_ld(unsigned* p)              { return __hip_atomic_load(p, __ATOMIC_RELAXED, __HIP_MEMORY_SCOPE_AGENT); }
__device__ __forceinline__ unsigned xb_add(unsigned* p, unsigned v) { return __hip_atomic_fetch_add(p, v, __ATOMIC_RELAXED, __HIP_MEMORY_SCOPE_AGENT); }
__device__ __forceinline__ unsigned xb_xcc_id() { return (unsigned)__builtin_amdgcn_s_getreg((3 << 11) | 20) & 0xFu; }
#define XB_SPIN(cond, bar) do { unsigned _sp = 0; while (cond) { __builtin_amdgcn_s_sleep(1); \
    if ((++_sp & 255u) == 0u) { if (xb_ld(&(bar)[XB_TMO])) break; if (_sp > XB_SPIN_CAP) { atomicAdd(&(bar)[XB_TMO], 1u); break; } } } } while (0)

struct XcdBarrier { unsigned* bar; unsigned x; volatile LAS unsigned* st; };

__device__ __forceinline__ XcdBarrier xcd_barrier_post(unsigned* bar, volatile LAS unsigned* st) {
    XcdBarrier b; b.bar = bar; b.x = xb_xcc_id(); b.st = st;
    if (threadIdx.x == 0) (void)xb_add(&bar[XB_XCNT(b.x)], 1u);
    return b;
}
__device__ __forceinline__ void xcd_barrier_complete(unsigned* bar, unsigned x, unsigned& nloc, unsigned& nx) {
    const unsigned G = gridDim.x * gridDim.y * gridDim.z;
    unsigned sum, cnt, mine, sp = 0u;
    for (;;) {
        sum = 0u; cnt = 0u; mine = 0u;
#pragma unroll
        for (unsigned j = 0; j < 16; ++j) { const unsigned c = xb_ld(&bar[XB_XCNT(j)]); sum += c; cnt += (c > 0u) ? 1u : 0u; mine = (j == x) ? c : mine; }
        if (sum == G) break;
        __builtin_amdgcn_s_sleep(1);
        if ((++sp & 255u) == 0u) { if (xb_ld(&bar[XB_TMO])) break; if (sp > XB_SPIN_CAP) { atomicAdd(&bar[XB_TMO], 1u); break; } }
    }
    nloc = mine > 0u ? mine : 1u; nx = cnt > 0u ? cnt : 1u;
}
__device__ __forceinline__ void xcd_barrier(const XcdBarrier& b) {
    asm volatile("s_waitcnt vmcnt(0)" ::: "memory");
    __syncthreads();
    if (threadIdx.x == 0) {
        unsigned* bar = b.bar;
        __builtin_amdgcn_s_waitcnt(0);
        unsigned nloc = b.st[0], nx = b.st[1];
        if (nloc == 0u) { xcd_barrier_complete(bar, b.x, nloc, nx); b.st[0] = nloc; b.st[1] = nx; }
        const unsigned old = xb_add(&bar[XB_XSUB(b.x)], 1u);
        const unsigned gen = old / nloc;
        if (old + 1u == (gen + 1u) * nloc) {
            __builtin_amdgcn_fence(__ATOMIC_RELEASE, "agent");
            asm volatile("s_waitcnt vmcnt(0)" ::: "memory");
            const unsigned og = xb_add(&bar[XB_TOP], 1u);
            const unsigned tg = og / nx;
            if (og + 1u == (tg + 1u) * nx) xb_add(&bar[XB_TOPGEN], 1u);
            else XB_SPIN(xb_ld(&bar[XB_TOPGEN]) == tg, bar);
            __builtin_amdgcn_fence(__ATOMIC_ACQUIRE, "agent");
            xb_add(&bar[XB_XGEN(b.x)], 1u);
            asm volatile("s_waitcnt vmcnt(0)" ::: "memory");
        } else {
            XB_SPIN(xb_ld(&bar[XB_XGEN(b.x)]) == gen, bar);
            __builtin_amdgcn_fence(__ATOMIC_ACQUIRE, "agent");
            asm volatile("s_waitcnt vmcnt(0)" ::: "memory");
        }
    }
    __syncthreads();
}

template <bool F8 = false>
__device__ __forceinline__ void transpose_item(const float* W, int K, int N, bf16* WT, int kb, int nb, int dst_row0, LAS float* scr, int lane) {
    const int k0 = 64 * kb, n0 = 32 * nb;
#pragma unroll 8
    for (int i = 0; i < 32; ++i) { const int kk = 2 * i + (lane >> 5); scr[kk * 33 + (lane & 31)] = W[(size_t)(k0 + kk) * N + n0 + (lane & 31)]; }
    LDS_WAIT(); asm volatile("" ::: "memory");
    const int c = lane & 7;
#pragma unroll
    for (int j = 0; j < 4; ++j) { const int n = (lane >> 3) + 8 * j; const LAS float* s = scr + (8 * c) * 33 + n;
        if (F8) {
            int d0 = __builtin_amdgcn_cvt_pk_fp8_f32(s[0 * 33] * 32.f, s[1 * 33] * 32.f, 0, false); d0 = __builtin_amdgcn_cvt_pk_fp8_f32(s[2 * 33] * 32.f, s[3 * 33] * 32.f, d0, true);
            int d1 = __builtin_amdgcn_cvt_pk_fp8_f32(s[4 * 33] * 32.f, s[5 * 33] * 32.f, 0, false); d1 = __builtin_amdgcn_cvt_pk_fp8_f32(s[6 * 33] * 32.f, s[7 * 33] * 32.f, d1, true);
            *(GAS v2u*)((unsigned char*)WT + (size_t)(dst_row0 + n) * K + k0 + 8 * c) = (v2u){(unsigned)d0, (unsigned)d1};
        } else {
        v4u o; o.x = pk2(s[0 * 33], s[1 * 33]); o.y = pk2(s[2 * 33], s[3 * 33]); o.z = pk2(s[4 * 33], s[5 * 33]); o.w = pk2(s[6 * 33], s[7 * 33]);
        *(GAS v4u*)(WT + (size_t)(dst_row0 + n) * K + k0 + 8 * c) = o; } }
    LDS_WAIT(); asm volatile("" ::: "memory");
}
template <bool F8 = false>
__device__ __forceinline__ void transpose_plain(const float* W, int K, int N, bf16* WT, LAS float* scr, int gw, int ngw, int lane) {
    const int nblk = N / 32, nitems = (K / 64) * nblk;
    for (int it = gw; it < nitems; it += ngw) { const int kb = it / nblk, nb = it % nblk; transpose_item<F8>(W, K, N, WT, kb, nb, 32 * nb, scr, lane); }
}
__device__ __forceinline__ void transpose_moe(const float* w1, const float* w3, const float* w2, bf16* W13T, bf16* W2T, LAS float* scr, int gw, int ngw, int lane) {
    constexpr int I13 = 16 * 16, I2 = 8 * 32, IPE = 2 * I13 + I2;
    for (int it = gw; it < NEXP * IPE; it += ngw) {
        const int e = it / IPE; int r = it % IPE;
        if (r < 2 * I13) { const int which = r / I13; r %= I13; const int kb = r / 16, nb = r % 16, n0 = 32 * nb;
            const float* W = (which ? w3 : w1) + (size_t)e * 1024 * 512;
            transpose_item<MOE_FP8 != 0>(W, 1024, 512, (bf16*)((unsigned char*)W13T + (size_t)e * 1024 * 1024 * (MOE_FP8 ? 1 : 2)), kb, nb, (n0 >> 7) * 256 + which * 128 + (n0 & 127), scr, lane);
        } else { r -= 2 * I13; const int kb = r / 32, nb = r % 32;
            transpose_item<MOE_FP8 != 0>(w2 + (size_t)e * 512 * 1024, 512, 1024, (bf16*)((unsigned char*)W2T + (size_t)e * 1024 * 512 * (MOE_FP8 ? 1 : 2)), kb, nb, 32 * nb, scr, lane); }
    }
}
__device__ __forceinline__ void rms_row(const float* xrow, const float* g, f32x4 (&v)[4], int lane) {
    const GAS f32x4* xr = (const GAS f32x4*)xrow + lane; const GAS f32x4* gr = (const GAS f32x4*)g + lane;
    float s = 0.f;
#pragma unroll
    for (int j = 0; j < 4; ++j) { v[j] = xr[64 * j]; s += (v[j].x * v[j].x + v[j].y * v[j].y) + (v[j].z * v[j].z + v[j].w * v[j].w); }
    const float rstd = 1.0f / sqrtf(wave_sum(s) * (1.f / DM) + 1e-6f);
#pragma unroll
    for (int j = 0; j < 4; ++j) { const f32x4 gg = gr[64 * j]; v[j] = v[j] * rstd * gg; }
}
__device__ __forceinline__ void rms_row_b16(const bf16* xrow, const float* g, f32x4 (&v)[4], int lane) {
    const GAS v2u* xr = (const GAS v2u*)xrow + lane; const GAS f32x4* gr = (const GAS f32x4*)g + lane;
    float s = 0.f;
#pragma unroll
    for (int j = 0; j < 4; ++j) { const v2u w = xr[64 * j]; v[j] = (f32x4){__builtin_bit_cast(float, w.x << 16), __builtin_bit_cast(float, w.x & 0xffff0000u), __builtin_bit_cast(float, w.y << 16), __builtin_bit_cast(float, w.y & 0xffff0000u)};
        s += (v[j].x * v[j].x + v[j].y * v[j].y) + (v[j].z * v[j].z + v[j].w * v[j].w); }
    const float rstd = 1.0f / sqrtf(wave_sum(s) * (1.f / DM) + 1e-6f);
#pragma unroll
    for (int j = 0; j < 4; ++j) { const f32x4 gg = gr[64 * j]; v[j] = v[j] * rstd * gg; }
}
__device__ __forceinline__ void store_row_bf16(bf16* orow, const f32x4 (&v)[4], int lane) {
    GAS unsigned long long* o8 = (GAS unsigned long long*)orow + lane;
#pragma unroll
    for (int j = 0; j < 4; ++j) o8[64 * j] = (unsigned long long)pk2(v[j].x, v[j].y) | ((unsigned long long)pk2(v[j].z, v[j].w) << 32);
}

__device__ __forceinline__ int t5_bucket(int rel) {
    const int n = rel < 0 ? -rel : rel; int ret = rel > 0 ? 16 : 0;
    int v;
    if (n < 8) v = n;
    else { const float nf = (float)n; int large = 8 + (int)(logf(nf / 8.0f) / 2.772588722239781f * 8.0f); v = large < 15 ? large : 15; }
    return ret + v;
}

__device__ __forceinline__ int crow(int r, int hi) { return (r & 3) + 8 * (r >> 2) + 4 * hi; }
__device__ __forceinline__ unsigned cvtpk(float lo, float hi) { unsigned r; asm volatile("v_cvt_pk_bf16_f32 %0, %1, %2" : "=v"(r) : "v"(lo), "v"(hi)); return r; }
__device__ __forceinline__ s16x4 vtr(const LAS char* p) { typedef short v4i16_t __attribute__((ext_vector_type(4))); return __builtin_bit_cast(s16x4, __builtin_amdgcn_ds_read_tr16_b64_v4i16((LAS v4i16_t*)p)); }

template <int DV, bool BIAS, bool FP8 = false>
__device__ __forceinline__ void attn_unit_v0(const bf16* Qp, int ldq, const bf16* Kp, int ldk, const bf16* Vp, int ldv, bf16* Op, int ldo, const LAS float* btbl, int q0, LAS unsigned char* lds) {
    const int tid = threadIdx.x, lane = tid & 63, r32 = lane & 31, hi = lane >> 5; const int wid = __builtin_amdgcn_readfirstlane(tid >> 6);
    constexpr int ND = DV / 32;
    LAS unsigned char* ldsK = lds; LAS unsigned char* ldsV = lds + 8192; LAS float* wsf = (LAS float*)(lds + 8192 + DV * 128) + wid * 64;
    bf16x8 qr[4]; v8i q8 = {0, 0, 0, 0, 0, 0, 0, 0};
    if (FP8) { const v4u a = *(const v4u*)((const unsigned char*)Qp + (size_t)(wid * 32 + r32) * ldq + hi * 32), b = *(const v4u*)((const unsigned char*)Qp + (size_t)(wid * 32 + r32) * ldq + hi * 32 + 16);
        q8 = (v8i){(int)a.x, (int)a.y, (int)a.z, (int)a.w, (int)b.x, (int)b.y, (int)b.z, (int)b.w}; }
    else {
#pragma unroll
    for (int d0 = 0; d0 < 4; ++d0) qr[d0] = *(const bf16x8*)(Qp + (size_t)(wid * 32 + r32) * ldq + d0 * 16 + hi * 8); }
    f32x16 o[ND];
#pragma unroll
    for (int d = 0; d < ND; ++d)
#pragma unroll
        for (int r = 0; r < 16; ++r) o[d][r] = 0.f;
    float l = 0.f;
    const int qpos = q0 + wid * 32 + r32;
    const LAS char* kp0 = (const LAS char*)ldsK + hi * 1024 + r32 * 16;
    const LAS char* vp0 = (const LAS char*)ldsV + ((lane >> 4) & 1) * 32 + (lane & 3) * 8 + (4 * hi + ((lane & 15) >> 2)) * 64;
    for (int t = 0; t < SEQ / 64; ++t) {
        __syncthreads();
        {
            if (FP8) { if (wid < 4) { const v4u kv = *(const v4u*)((const unsigned char*)Kp + (size_t)(t * 64 + lane) * ldk + wid * 16); *(LAS v4u*)(ldsK + wid * 1024 + lane * 16) = kv; } }
            else { const v4u kv = *(const v4u*)(Kp + (size_t)(t * 64 + lane) * ldk + wid * 8);
            *(LAS v4u*)(ldsK + wid * 1024 + lane * 16) = kv; }
#pragma unroll
            for (int pp = 0; pp < ND / 2; ++pp) { const int p = wid + 8 * pp, dq = p >> 2, rg = p & 3;
                const v4u vv = *(const v4u*)(Vp + (size_t)(t * 64 + 16 * rg + (lane >> 2)) * ldv + dq * 32 + (lane & 3) * 8);
                *(LAS v4u*)(ldsV + p * 1024 + lane * 16) = vv; }
        }
        __syncthreads();
        f32x16 p0, p1;
#pragma unroll
        for (int r = 0; r < 16; ++r) { p0[r] = 0.f; p1[r] = 0.f; }
        if (FP8) {
            const LAS char* k8 = (const LAS char*)ldsK + hi * 2048 + r32 * 16;
            const v4u a0 = *(const LAS v4u*)(k8), a1 = *(const LAS v4u*)(k8 + 1024), b0 = *(const LAS v4u*)(k8 + 512), b1 = *(const LAS v4u*)(k8 + 1024 + 512);
            const v8i ka = (v8i){(int)a0.x, (int)a0.y, (int)a0.z, (int)a0.w, (int)a1.x, (int)a1.y, (int)a1.z, (int)a1.w};
            const v8i kb = (v8i){(int)b0.x, (int)b0.y, (int)b0.z, (int)b0.w, (int)b1.x, (int)b1.y, (int)b1.z, (int)b1.w};
            p0 = __builtin_amdgcn_mfma_scale_f32_32x32x64_f8f6f4(ka, q8, p0, 0, 0, 0, 0x7f7f7f7f, 0, 0x7c7c7c7c);
            p1 = __builtin_amdgcn_mfma_scale_f32_32x32x64_f8f6f4(kb, q8, p1, 0, 0, 0, 0x7f7f7f7f, 0, 0x7c7c7c7c);
        } else {
#pragma unroll
        for (int d0 = 0; d0 < 4; ++d0) {
            const bf16x8 b0 = *(const LAS bf16x8*)(kp0 + d0 * 2048), b1 = *(const LAS bf16x8*)(kp0 + d0 * 2048 + 512);
            p0 = __builtin_amdgcn_mfma_f32_32x32x16_bf16(b0, qr[d0], p0, 0, 0, 0);
            p1 = __builtin_amdgcn_mfma_f32_32x32x16_bf16(b1, qr[d0], p1, 0, 0, 0);
        } }
        if (BIAS) {
            const int base = t * 64 + 4 * hi - qpos;
#pragma unroll
            for (int r = 0; r < 16; ++r) { int rel = base + (r & 3) + 8 * (r >> 2);
                int i0 = rel < -128 ? -128 : (rel > 128 ? 128 : rel); int rel1 = rel + 32; int i1 = rel1 < -128 ? -128 : (rel1 > 128 ? 128 : rel1);
                p0[r] += btbl[i0 + 128]; p1[r] += btbl[i1 + 128]; }
        }
        float sacc = 0.f;
#pragma unroll
        for (int r = 0; r < 16; ++r) { p0[r] = __builtin_amdgcn_exp2f(p0[r]); p1[r] = __builtin_amdgcn_exp2f(p1[r]); sacc += p0[r] + p1[r]; }
        l += sacc;
        v4u pw[4];
#pragma unroll
        for (int k = 0; k < 2; ++k) {
            pw[k]     = (v4u){cvtpk(p0[8 * k + 0], p0[8 * k + 1]), cvtpk(p0[8 * k + 2], p0[8 * k + 3]), cvtpk(p0[8 * k + 4], p0[8 * k + 5]), cvtpk(p0[8 * k + 6], p0[8 * k + 7])};
            pw[2 + k] = (v4u){cvtpk(p1[8 * k + 0], p1[8 * k + 1]), cvtpk(p1[8 * k + 2], p1[8 * k + 3]), cvtpk(p1[8 * k + 4], p1[8 * k + 5]), cvtpk(p1[8 * k + 6], p1[8 * k + 7])};
        }
#pragma unroll
        for (int d0 = 0; d0 < ND; ++d0)
#pragma unroll
            for (int ks = 0; ks < 4; ++ks) {
                const s16x4 lo = vtr(vp0 + d0 * 4096 + ks * 1024), hh = vtr(vp0 + d0 * 4096 + ks * 1024 + 512);
                const bf16x8 vf = (bf16x8){lo[0], lo[1], lo[2], lo[3], hh[0], hh[1], hh[2], hh[3]};
                o[d0] = __builtin_amdgcn_mfma_f32_32x32x16_bf16(__builtin_bit_cast(bf16x8, pw[ks]), vf, o[d0], 0, 0, 0);
            }
    }
    l += __shfl_xor(l, 32);
    if (hi == 0) wsf[r32] = l;
    LDS_WAIT(); asm volatile("" ::: "memory");
#pragma unroll
    for (int r = 0; r < 16; ++r) { const int row = crow(r, hi); const float rl = 1.0f / wsf[row];
#pragma unroll
        for (int d0 = 0; d0 < ND; ++d0) Op[(size_t)(wid * 32 + row) * ldo + d0 * 32 + r32] = (bf16)f2bf(o[d0][r] * rl); }
    LDS_WAIT();
}

namespace at1 {
#define SBAR() __builtin_amdgcn_sched_barrier(0)
#define PIN(x) asm volatile("" : "+v"(x))
template <int N, bool NOBAR = false> __device__ __forceinline__ void wait_bar() { if (NOBAR) asm volatile("s_waitcnt vmcnt(%0) lgkmcnt(0)" :: "n"(N) : "memory"); else asm volatile("s_waitcnt vmcnt(%0) lgkmcnt(0)\n\ts_barrier" :: "n"(N) : "memory"); }
__device__ __forceinline__ void glds16(const void* gsrc, unsigned lds_dst) { unsigned keep;
    asm volatile("s_mov_b32 %0, m0\n\ts_mov_b32 m0, %2\n\ts_nop 0\n\tglobal_load_lds_dwordx4 %1, off\n\ts_mov_b32 m0, %0" : "=&s"(keep) : "v"(gsrc), "s"(lds_dst) : "memory"); }
typedef float f32x2_t __attribute__((ext_vector_type(2))); typedef __bf16 bf16x2_t __attribute__((ext_vector_type(2)));
__device__ __forceinline__ unsigned cvtpk_s(float lo, float hi) { f32x2_t v = {lo, hi}; bf16x2_t b = __builtin_convertvector(v, bf16x2_t); return __builtin_bit_cast(unsigned, b); }
typedef const LAS char* lds_cptr;
__device__ __forceinline__ void kload2(bf16x8* kf, lds_cptr kp, int j) { kf[2 * j] = *(const LAS bf16x8*)(kp + j * 2048); kf[2 * j + 1] = *(const LAS bf16x8*)(kp + j * 2048 + 512); }

template <int DV, bool FP8> __host__ __device__ constexpr int lds_ws_off() { return (3 * (FP8 ? 4096 : 8192) + 3 * DV * 128) > 512 * DV ? (3 * (FP8 ? 4096 : 8192) + 3 * DV * 128) : 512 * DV; }
template <int DV, bool FP8> __host__ __device__ constexpr int lds_tbl_off() { return lds_ws_off<DV, FP8>() + 2048; }
template <int DV, bool BIAS, int TEST = 0, int MODE = 0, bool FP8 = false, bool TILED = false>
__device__ __forceinline__ void attn_unit(const bf16* Qp, int ldq, const bf16* __restrict__ Kp, int ldk, const bf16* __restrict__ Vp, int ldv, bf16* Op, int ldo, int q0, LAS unsigned char* lds, const LAS float* sgt = nullptr) {
    constexpr int ND = DV / 32, NV = ND / 2, VSLOT = DV * 128, KSLOT = FP8 ? 4096 : 8192, NT = SEQ / 64;
    constexpr int LDS_K = 0, LDS_V = 3 * KSLOT, LDS_WS = lds_ws_off<DV, FP8>(), LDS_TBL = LDS_WS + 2048;
    static_assert(LDS_WS >= LDS_V + 3 * VSLOT && LDS_WS >= 512 * DV && LDS_TBL + 2048 <= STASH_OFF, "LDS map");
    const int tid = threadIdx.x, lane = tid & 63, r32 = lane & 31, hi = lane >> 5; const int wid = __builtin_amdgcn_readfirstlane(tid >> 6);
    const unsigned lds0 = (unsigned)(uintptr_t)lds;
    LAS float* wsf = (LAS float*)(lds + LDS_WS) + wid * 64;
    const LAS float* btbl = (const LAS float*)(lds + LDS_TBL);
    const unsigned char* ksrc = TILED ? (const unsigned char*)Kp + (wid & 3) * 1024 + lane * 16 : FP8 ? (const unsigned char*)Kp + (size_t)lane * ldk + (wid & 3) * 16 : (const unsigned char*)(Kp + (size_t)lane * ldk + wid * 8);
    const bf16* vsrc0 = TILED ? Vp + wid * 512 + lane * 8 : Vp + (size_t)(16 * (wid & 3) + (lane >> 2)) * ldv + (wid >> 2) * 32 + (lane & 3) * 8;
    const bf16* vsrc1 = TILED ? vsrc0 + 4096 : vsrc0 + 64;
    const unsigned kdst = lds0 + LDS_K + wid * 1024, vdst = lds0 + LDS_V + wid * 1024;
#define DMA_K(t, s) if (!(TEST & 8) && (!FP8 || wid < 4)) glds16(ksrc + (size_t)(t) * (TILED ? 4096 : 64 * ldk * (FP8 ? 1 : 2)), (unsigned)__builtin_amdgcn_readfirstlane(kdst + (s) * KSLOT))
#define DMA_V(t, s) do { if (TEST & 8) break; glds16(vsrc0 + (size_t)(t) * (TILED ? (size_t)(DV * 64) : (size_t)64 * ldv), (unsigned)__builtin_amdgcn_readfirstlane(vdst + (s) * VSLOT)); \
        if (NV == 2) glds16(vsrc1 + (size_t)(t) * (TILED ? (size_t)(DV * 64) : (size_t)64 * ldv), (unsigned)__builtin_amdgcn_readfirstlane(vdst + (s) * VSLOT + 8192)); } while (0)
    const lds_cptr kp0 = (lds_cptr)lds + LDS_K + hi * (FP8 ? 2048 : 1024) + r32 * 16;
    const lds_cptr vp0 = (lds_cptr)lds + LDS_V + ((lane >> 4) & 1) * 32 + (lane & 3) * 8 + (4 * hi + ((lane & 15) >> 2)) * 64;
    DMA_K(0, 0); DMA_V(0, 0); DMA_K(1, 1);
    bf16x8 qr[4]; v8i q8 = {0, 0, 0, 0, 0, 0, 0, 0};
    if (FP8) { const unsigned char* qb_ = (const unsigned char*)Qp + (size_t)(wid * 32 + r32) * ldq + hi * 32; const v4u a = *(const v4u*)qb_, b = *(const v4u*)(qb_ + 16);
        q8 = (v8i){(int)a.x, (int)a.y, (int)a.z, (int)a.w, (int)b.x, (int)b.y, (int)b.z, (int)b.w}; }
    else {
#pragma unroll
        for (int d0 = 0; d0 < 4; ++d0) qr[d0] = *(const bf16x8*)(Qp + (size_t)(wid * 32 + r32) * ldq + d0 * 16 + hi * 8); }
    float l_reg = 0.f; f32x16 o[ND];
#pragma unroll
    for (int d = 0; d < ND; ++d) o[d] = f32x16{};
    const f32x16 zero16 = f32x16{};
    const int qw = q0 + wid * 32, qpos = qw + r32;
    int tl = 0, tr = NT; float fL = 1.f;
    if (BIAS) { tl = (qw - 191 >= 0) ? ((qw - 191) >> 6) + 1 : 0; tr = (qw + 158) >> 6; fL = __builtin_amdgcn_exp2f(btbl[0]); }
    f32x16 pA0, pA1, pB0, pB1; bf16x8 kf[8]; v8i kf8[2]; s16x4 vlo[8], vhi[8]; v4u pw0, pw1, pw2, pw3;
#define KLOAD8(n, kp_) do { const v4u a_ = *(const LAS v4u*)((kp_) + (n) * 512), b_ = *(const LAS v4u*)((kp_) + (n) * 512 + 1024); kf8[n] = (v8i){(int)a_.x, (int)a_.y, (int)a_.z, (int)a_.w, (int)b_.x, (int)b_.y, (int)b_.z, (int)b_.w}; } while (0)
#define MF8(kf_, c_) __builtin_amdgcn_mfma_scale_f32_32x32x64_f8f6f4(kf_, q8, c_, 0, 0, 0, 0x7f7f7f7f, 0, 0x7c7c7c7c)
#define WAITB(N) do { if (FP8 && wid >= 4) wait_bar<(N) - 1, (TEST & 16) != 0>(); else wait_bar<(N), (TEST & 16) != 0>(); } while (0)
    if (TEST & 32) { pB0 = f32x16{}; pB1 = f32x16{}; }
    if (TEST & 64) { _Pragma("unroll") for (int i_ = 0; i_ < 8; ++i_) { vlo[i_] = (s16x4){1, 2, 3, 4}; vhi[i_] = (s16x4){4, 3, 2, 1}; } }
    int s_prev = 0, s_cur = 0, s_next = 1;
#define ROT() do { s_prev = s_cur; s_cur = s_next; s_next = (s_next == 2) ? 0 : s_next + 1; } while (0)
#define ADD_BIAS(C0, C1, t) do { if (BIAS && (t) >= tl && (t) <= tr) { const int base_ = (t) * 64 + 4 * hi - qpos; \
        _Pragma("unroll") for (int r = 0; r < 16; ++r) { const int rel0 = base_ + (r & 3) + 8 * (r >> 2); const int rel1 = rel0 + 32; \
            const int i0 = (rel0 < -128 ? -128 : (rel0 > 128 ? 128 : rel0)) + 128, i1 = (rel1 < -128 ? -128 : (rel1 > 128 ? 128 : rel1)) + 128; \
            C0[r] += btbl[i0]; C1[r] += btbl[i1]; } } } while (0)
    DMA_K(2, 2);
    if (FP8) wait_bar<0, (TEST & 16) != 0>(); else wait_bar<NV + 2, (TEST & 16) != 0>();
    {
        if (FP8) { KLOAD8(0, kp0); KLOAD8(1, kp0); pA0 = MF8(kf8[0], zero16); pA1 = MF8(kf8[1], zero16); }
        else {
#pragma unroll
        for (int j = 0; j < 4; ++j) kload2(kf, kp0, j);
        pA0 = __builtin_amdgcn_mfma_f32_32x32x16_bf16(kf[0], qr[0], zero16, 0, 0, 0); pA1 = __builtin_amdgcn_mfma_f32_32x32x16_bf16(kf[1], qr[0], zero16, 0, 0, 0);
#pragma unroll
        for (int d0 = 1; d0 < 4; ++d0) { pA0 = __builtin_amdgcn_mfma_f32_32x32x16_bf16(kf[2 * d0], qr[d0], pA0, 0, 0, 0); pA1 = __builtin_amdgcn_mfma_f32_32x32x16_bf16(kf[2 * d0 + 1], qr[d0], pA1, 0, 0, 0); } }
        ADD_BIAS(pA0, pA1, 0);
#pragma unroll
        for (int r = 0; r < 16; ++r) { pA0[r] = __builtin_amdgcn_exp2f(pA0[r]); pA1[r] = __builtin_amdgcn_exp2f(pA1[r]); }
    }
    wait_bar<0, (TEST & 16) != 0>();
    DMA_K(3, 0); DMA_V(1, 1);
    ROT();
    if (FP8) { KLOAD8(0, kp0 + s_cur * KSLOT); KLOAD8(1, kp0 + s_cur * KSLOT); }
    else {
#pragma unroll
    for (int j = 0; j < 4; ++j) kload2(kf, kp0 + s_cur * KSLOT, j); }
    WAITB(1 + NV);
#define PKW(P, B) ((TEST & 256) ? 0x3f803f80u : cvtpk_s(P[B], P[B + 1]))
#define PAF(k) __builtin_bit_cast(bf16x8, pw##k)
#define VFR(i) (bf16x8){vlo[i][0], vlo[i][1], vlo[i][2], vlo[i][3], vhi[i][0], vhi[i][1], vhi[i][2], vhi[i][3]}
#define MF(a, b, c) __builtin_amdgcn_mfma_f32_32x32x16_bf16(a, b, c, 0, 0, 0)
#define GAPA(MFS, A0, A1, A2, A3, W0, W1, PW) do { if (!(TEST & 32)) { MFS; } if (!(TEST & 2)) { sacc += A0; sacc += A1; sacc += A2; sacc += A3; PIN(sacc); } W0; W1; PIN(PW); SBAR(); } while (0)
#define EX(v) ((TEST & 1) ? (v) : __builtin_amdgcn_exp2f(v))
#define GAPB4(MFS, X, B) do { if (!(TEST & 4)) { MFS; } X[B] = EX(X[B]); X[B + 1] = EX(X[B + 1]); X[B + 2] = EX(X[B + 2]); X[B + 3] = EX(X[B + 3]); PIN(X); SBAR(); } while (0)
#define GAPB2(MFS, X, B) do { if (!(TEST & 4)) { MFS; } X[B] = EX(X[B]); X[B + 1] = EX(X[B + 1]); PIN(X); SBAR(); } while (0)
#define VRD(f, s) do { if (TEST & 64) break; vlo[s] = vtr(vp_ + (((f) >> 2) * 4096 + ((f) & 3) * 1024)); vhi[s] = vtr(vp_ + (((f) >> 2) * 4096 + ((f) & 3) * 1024 + 512)); } while (0)
#define KRD(G, j) do { if ((G) && !(TEST & 128)) { if (FP8) { if ((j) < 2) { KLOAD8(j, kp0 + s_next * KSLOT); } } else kload2(kf, kp0 + s_next * KSLOT, j); SBAR(); } } while (0)
#define FO(m) (ND == 2 ? (((m) >> 1) + 4 * ((m) & 1)) : ((((m) & 7) >> 2) + 2 * ((m) >> 3) + 4 * ((m) & 3)))
#define STEP(C0, C1, P0, P1, t, GK, GV, GL) do { SBAR(); \
    const lds_cptr vp_ = vp0 + s_prev * VSLOT; float sacc; \
    if (FP8) { \
      VRD(FO(0), 0); VRD(FO(1), 1); VRD(FO(2), 2); VRD(FO(3), 3); SBAR(); \
      if (!(TEST & 32)) C0 = MF8(kf8[0], zero16); \
      SBAR();   \
      float sa_ = P0[0] + P0[1], sb_ = P0[2] + P0[3], sc_ = P0[4] + P0[5], sd_ = P0[6] + P0[7]; \
      if (!(TEST & 2)) { sa_ += P0[8]; sb_ += P0[9]; sc_ += P0[10]; sd_ += P0[11]; sa_ += P0[12]; sb_ += P0[13]; sc_ += P0[14]; sd_ += P0[15]; } \
      pw0 = (v4u){PKW(P0, 0), PKW(P0, 2), PKW(P0, 4), PKW(P0, 6)}; pw1 = (v4u){PKW(P0, 8), PKW(P0, 10), PKW(P0, 12), PKW(P0, 14)}; PIN(pw0); PIN(pw1); SBAR(); \
      VRD(FO(4), 4); VRD(FO(5), 5); VRD(FO(6), 6); VRD(FO(7), 7); SBAR(); \
      if (!(TEST & 32)) C1 = MF8(kf8[1], zero16); \
      SBAR(); \
      if (!(TEST & 2)) { sa_ += P1[0]; sb_ += P1[1]; sc_ += P1[2]; sd_ += P1[3]; sa_ += P1[4]; sb_ += P1[5]; sc_ += P1[6]; sd_ += P1[7]; \
                         sa_ += P1[8]; sb_ += P1[9]; sc_ += P1[10]; sd_ += P1[11]; sa_ += P1[12]; sb_ += P1[13]; sc_ += P1[14]; sd_ += P1[15]; } \
      sacc = (sa_ + sb_) + (sc_ + sd_); PIN(sacc); \
      pw2 = (v4u){PKW(P1, 0), PKW(P1, 2), PKW(P1, 4), PKW(P1, 6)}; pw3 = (v4u){PKW(P1, 8), PKW(P1, 10), PKW(P1, 12), PKW(P1, 14)}; PIN(pw2); PIN(pw3); SBAR(); \
    } else { \
    VRD(FO(0), 0); SBAR(); sacc = (P0[0] + P0[1]); \
    GAPA(C0 = MF(kf[0], qr[0], zero16), P0[2], P0[3], P0[4], P0[5],     pw0[0] = PKW(P0, 0), pw0[1] = PKW(P0, 2), pw0); \
    VRD(FO(1), 1); SBAR(); GAPA(C1 = MF(kf[1], qr[0], zero16), P0[6], P0[7], P0[8], P0[9],     pw0[2] = PKW(P0, 4), pw0[3] = PKW(P0, 6), pw0); \
    VRD(FO(2), 2); SBAR(); GAPA(C0 = MF(kf[2], qr[1], C0),   P0[10], P0[11], P0[12], P0[13], pw1[0] = PKW(P0, 8), pw1[1] = PKW(P0, 10), pw1); \
    VRD(FO(3), 3); SBAR(); GAPA(C1 = MF(kf[3], qr[1], C1),   P0[14], P0[15], P1[0], P1[1],   pw1[2] = PKW(P0, 12), pw1[3] = PKW(P0, 14), pw1); \
    VRD(FO(4), 4); SBAR(); GAPA(C0 = MF(kf[4], qr[2], C0),   P1[2], P1[3], P1[4], P1[5],     pw2[0] = PKW(P1, 0), pw2[1] = PKW(P1, 2), pw2); \
    VRD(FO(5), 5); SBAR(); GAPA(C1 = MF(kf[5], qr[2], C1),   P1[6], P1[7], P1[8], P1[9],     pw2[2] = PKW(P1, 4), pw2[3] = PKW(P1, 6), pw2); \
    VRD(FO(6), 6); SBAR(); GAPA(C0 = MF(kf[6], qr[3], C0),   P1[10], P1[11], P1[12], P1[13], pw3[0] = PKW(P1, 8), pw3[1] = PKW(P1, 10), pw3); \
    VRD(FO(7), 7); SBAR(); GAPA(C1 = MF(kf[7], qr[3], C1),   P1[14], P1[15], 0.f, 0.f,       pw3[2] = PKW(P1, 12), pw3[3] = PKW(P1, 14), pw3); \
    } \
    l_reg += sacc; \
    if (GK) { DMA_K((t) + 3, s_cur); } if (GV) { DMA_V((t) + 1, s_next); } \
    ADD_BIAS(C0, C1, t); \
    SBAR(); \
    if (ND == 2) { \
        GAPB4(o[0] = MF(PAF(0), VFR(0), o[0]), C0, 0); \
        GAPB4(o[1] = MF(PAF(0), VFR(1), o[1]), C0, 4); \
        KRD(GL, 0); GAPB4(o[0] = MF(PAF(1), VFR(2), o[0]), C0, 8); \
        KRD(GL, 1); GAPB4(o[1] = MF(PAF(1), VFR(3), o[1]), C0, 12); \
        KRD(GL, 2); GAPB4(o[0] = MF(PAF(2), VFR(4), o[0]), C1, 0); \
        KRD(GL, 3); GAPB4(o[1] = MF(PAF(2), VFR(5), o[1]), C1, 4); \
        GAPB4(o[0] = MF(PAF(3), VFR(6), o[0]), C1, 8); \
        GAPB4(o[1] = MF(PAF(3), VFR(7), o[1]), C1, 12); \
    } else { \
        GAPB2(o[0] = MF(PAF(0), VFR(0), o[0]), C0, 0);  VRD(FO(8), 0); SBAR(); \
        GAPB2(o[1] = MF(PAF(0), VFR(1), o[1]), C0, 2);  VRD(FO(9), 1); SBAR(); \
        GAPB2(o[ND - 2] = MF(PAF(0), VFR(2), o[ND - 2]), C0, 4);  VRD(FO(10), 2); SBAR(); \
        GAPB2(o[ND - 1] = MF(PAF(0), VFR(3), o[ND - 1]), C0, 6);  VRD(FO(11), 3); SBAR(); \
        GAPB2(o[0] = MF(PAF(1), VFR(4), o[0]), C0, 8);  VRD(FO(12), 4); SBAR(); \
        GAPB2(o[1] = MF(PAF(1), VFR(5), o[1]), C0, 10); VRD(FO(13), 5); SBAR(); \
        GAPB2(o[ND - 2] = MF(PAF(1), VFR(6), o[ND - 2]), C0, 12); VRD(FO(14), 6); SBAR(); \
        GAPB2(o[ND - 1] = MF(PAF(1), VFR(7), o[ND - 1]), C0, 14); VRD(FO(15), 7); SBAR(); \
        KRD(GL, 0); GAPB2(o[0] = MF(PAF(2), VFR(0), o[0]), C1, 0); \
        GAPB2(o[1] = MF(PAF(2), VFR(1), o[1]), C1, 2); \
        KRD(GL, 1); GAPB2(o[ND - 2] = MF(PAF(2), VFR(2), o[ND - 2]), C1, 4); \
        GAPB2(o[ND - 1] = MF(PAF(2), VFR(3), o[ND - 1]), C1, 6); \
        KRD(GL, 2); GAPB2(o[0] = MF(PAF(3), VFR(4), o[0]), C1, 8); \
        GAPB2(o[1] = MF(PAF(3), VFR(5), o[1]), C1, 10); \
        KRD(GL, 3); GAPB2(o[ND - 2] = MF(PAF(3), VFR(6), o[ND - 2]), C1, 12); \
        GAPB2(o[ND - 1] = MF(PAF(3), VFR(7), o[ND - 1]), C1, 14); \
    } \
    if (BIAS && (t) == tl) { l_reg *= fL; _Pragma("unroll") for (int d_ = 0; d_ < ND; ++d_) _Pragma("unroll") for (int r = 0; r < 16; ++r) o[d_][r] *= fL; } \
    } while (0)
    int t = 1;
    for (; t + 4 < NT; t += 2) {
        STEP(pB0, pB1, pA0, pA1, t, true, true, true);       WAITB(1 + NV); ROT();
        STEP(pA0, pA1, pB0, pB1, t + 1, true, true, true);   WAITB(1 + NV); ROT();
    }
    STEP(pB0, pB1, pA0, pA1, NT - 3, false, true, true);  wait_bar<NV, (TEST & 16) != 0>(); ROT();
    STEP(pA0, pA1, pB0, pB1, NT - 2, false, true, true);  wait_bar<0, (TEST & 16) != 0>();  ROT();
    STEP(pB0, pB1, pA0, pA1, NT - 1, false, false, false);
    {
        float sacc = pB0[0] + pB0[1];
#pragma unroll
        for (int r = 2; r < 16; ++r) sacc += pB0[r];
#pragma unroll
        for (int r = 0; r < 16; ++r) sacc += pB1[r];
        l_reg += sacc;
        pw0 = (v4u){PKW(pB0, 0), PKW(pB0, 2), PKW(pB0, 4), PKW(pB0, 6)}; pw1 = (v4u){PKW(pB0, 8), PKW(pB0, 10), PKW(pB0, 12), PKW(pB0, 14)};
        pw2 = (v4u){PKW(pB1, 0), PKW(pB1, 2), PKW(pB1, 4), PKW(pB1, 6)}; pw3 = (v4u){PKW(pB1, 8), PKW(pB1, 10), PKW(pB1, 12), PKW(pB1, 14)};
        const lds_cptr vp_ = vp0 + s_cur * VSLOT;
#pragma unroll
        for (int d0 = 0; d0 < ND; ++d0) {
            s16x4 a0 = vtr(vp_ + d0 * 4096), b0 = vtr(vp_ + d0 * 4096 + 512), a1 = vtr(vp_ + d0 * 4096 + 1024), b1 = vtr(vp_ + d0 * 4096 + 1536);
            s16x4 a2 = vtr(vp_ + d0 * 4096 + 2048), b2 = vtr(vp_ + d0 * 4096 + 2560), a3 = vtr(vp_ + d0 * 4096 + 3072), b3 = vtr(vp_ + d0 * 4096 + 3584);
            o[d0] = MF(PAF(0), ((bf16x8){a0[0], a0[1], a0[2], a0[3], b0[0], b0[1], b0[2], b0[3]}), o[d0]);
            o[d0] = MF(PAF(1), ((bf16x8){a1[0], a1[1], a1[2], a1[3], b1[0], b1[1], b1[2], b1[3]}), o[d0]);
            o[d0] = MF(PAF(2), ((bf16x8){a2[0], a2[1], a2[2], a2[3], b2[0], b2[1], b2[2], b2[3]}), o[d0]);
            o[d0] = MF(PAF(3), ((bf16x8){a3[0], a3[1], a3[2], a3[3], b3[0], b3[1], b3[2], b3[3]}), o[d0]);
        }
    }
    l_reg += __shfl_xor(l_reg, 32);
    int lane_e = lane; asm volatile("" : "+v"(lane_e));
    const int r32e = lane_e & 31, hie = lane_e >> 5;
    if (hie == 0) wsf[r32e] = l_reg;
    asm volatile("s_waitcnt lgkmcnt(0)\n\ts_barrier" ::: "memory");
    {
        LAS bf16* stg = (LAS bf16*)(MODE == 1 ? lds + STASH_OFF : lds) + wid * (32 * DV);
#pragma unroll
        for (int r = 0; r < 16; ++r) { const int orow = crow(r, hie); const float rl = __builtin_amdgcn_rcpf(wsf[orow]);
#pragma unroll
            for (int d0 = 0; d0 < ND; ++d0) stg[orow * DV + d0 * 32 + r32e] = (bf16)f2bf(o[d0][r] * rl); }
        asm volatile("s_waitcnt lgkmcnt(0)" ::: "memory");
        if (MODE == 0) {
            constexpr int CPR = DV / 8;
#pragma unroll
            for (int i = 0; i < (32 * CPR) / 64; ++i) { const int row = i * (64 / CPR) + lane_e / CPR, ch = lane_e % CPR;
                const v4u v = *(const LAS v4u*)(stg + row * DV + ch * 8); *(v4u*)(Op + (size_t)(wid * 32 + row) * ldo + ch * 8) = v; }
        } else if (MODE == 2) {
            const int row = lane_e >> 1, half = lane_e & 1; const float lam = sgt[128];
            const LAS bf16* s1 = stg + row * DV + half * 64; const LAS bf16* s0 = (const LAS bf16*)(lds + STASH_OFF) + wid * (32 * DV) + row * DV + half * 64;
            float ov[64]; float ss = 0.f;
#pragma unroll
            for (int q = 0; q < 8; ++q) { const v4u a = *(const LAS v4u*)(s0 + q * 8), c = *(const LAS v4u*)(s1 + q * 8);
#pragma unroll
                for (int j = 0; j < 4; ++j) { const float lo = __builtin_bit_cast(float, a[j] << 16) - lam * __builtin_bit_cast(float, c[j] << 16);
                    const float hh = __builtin_bit_cast(float, a[j] & 0xffff0000u) - lam * __builtin_bit_cast(float, c[j] & 0xffff0000u);
                    ov[q * 8 + 2 * j] = lo; ov[q * 8 + 2 * j + 1] = hh; ss += lo * lo + hh * hh; } }
            ss += dpp_mov<0xB1>(ss);
            const float rstd = 1.0f / sqrtf(ss * (1.f / 128.f) + 1e-5f);
            bf16* yo = Op + (size_t)(wid * 32 + row) * ldo + half * 64;
#pragma unroll
            for (int q = 0; q < 8; ++q) { const f32x4 g0 = *(const LAS f32x4*)(sgt + half * 64 + q * 8), g1 = *(const LAS f32x4*)(sgt + half * 64 + q * 8 + 4);
                v4u w; w.x = pk2(ov[q * 8] * rstd * g0.x, ov[q * 8 + 1] * rstd * g0.y); w.y = pk2(ov[q * 8 + 2] * rstd * g0.z, ov[q * 8 + 3] * rstd * g0.w);
                w.z = pk2(ov[q * 8 + 4] * rstd * g1.x, ov[q * 8 + 5] * rstd * g1.y); w.w = pk2(ov[q * 8 + 6] * rstd * g1.z, ov[q * 8 + 7] * rstd * g1.w);
                *(v4u*)(yo + q * 8) = w; }
        }
    }
    asm volatile("s_waitcnt lgkmcnt(0)\n\ts_barrier" ::: "memory");
#undef KLOAD8
#undef MF8
#undef WAITB
#undef DMA_K
#undef DMA_V
#undef ROT
#undef ADD_BIAS
#undef PKW
#undef PAF
#undef VFR
#undef MF
#undef GAPA
#undef EX
#undef GAPB4
#undef GAPB2
#undef VRD
#undef KRD
#undef FO
#undef STEP
}
#undef SBAR
#undef PIN
}

namespace at3 {
#define SBAR() __builtin_amdgcn_sched_barrier(0)
#define PIN(x) asm volatile("" : "+v"(x))
using at1::glds16; using at1::wait_bar;
typedef const LAS char* lds_cptr; typedef short v2s __attribute__((ext_vector_type(2)));
template <int DV> __host__ __device__ constexpr int lds_ws_off() { return (3 * 4096 + 3 * DV * 64) > 512 * DV ? (3 * 4096 + 3 * DV * 64) : 512 * DV; }
template <int DV> __host__ __device__ constexpr int lds_tbl_off() { return lds_ws_off<DV>() + 2048; }
__device__ __forceinline__ void waitb(int n) { if (n == 0) wait_bar<0>(); else if (n == 1) wait_bar<1>(); else wait_bar<2>(); }
__device__ __forceinline__ v8i ld_frag(lds_cptr p, int second) { const v4u a = *(const LAS v4u*)p, b = *(const LAS v4u*)(p + second); return (v8i){(int)a.x, (int)a.y, (int)a.z, (int)a.w, (int)b.x, (int)b.y, (int)b.z, (int)b.w}; }

template <int DV, bool BIAS, int MODE>
__device__ __forceinline__ void attn_unit(const unsigned char* Qp, int ldq, const unsigned char* __restrict__ K8T, const unsigned char* __restrict__ V8T, bf16* Op, int ldo, int q0, LAS unsigned char* lds, const LAS float* sgt) {
    constexpr int ND = DV / 32, VT = DV * 64, KT = 4096, NT = SEQ / 64, NVP = VT / 1024;
    constexpr int LDS_K = 0, LDS_V = 3 * KT, LDS_WS = lds_ws_off<DV>(), LDS_TBL = LDS_WS + 2048;
    static_assert(LDS_WS >= LDS_V + 3 * VT && LDS_WS >= 512 * DV && LDS_TBL + 2048 <= STASH_OFF, "LDS map");
    const int tid = threadIdx.x, lane = tid & 63, r32 = lane & 31, hi = lane >> 5; const int wid = __builtin_amdgcn_readfirstlane(tid >> 6);
    const unsigned lds0 = (unsigned)(uintptr_t)lds;
    LAS float* wsf = (LAS float*)(lds + LDS_WS) + wid * 64;
    const LAS float* btbl = (const LAS float*)(lds + LDS_TBL);
    const bool doK = wid < 4, doV = (NVP == 8) || wid >= 4; const int vpc = (NVP == 8) ? wid : (wid & 3);
    const unsigned char* ksrc = K8T + (wid & 3) * 1024 + lane * 16; const unsigned char* vsrc = V8T + vpc * 1024 + lane * 16;
    const unsigned kdst = lds0 + LDS_K + (wid & 3) * 1024, vdst = lds0 + LDS_V + vpc * 1024;
    const int ndma = (doK ? 1 : 0) + (doV ? 1 : 0);
#define DMA_K(t, s) do { if (doK) glds16(ksrc + (size_t)(t) * KT, (unsigned)__builtin_amdgcn_readfirstlane(kdst + (s) * KT)); } while (0)
#define DMA_V(t, s) do { if (doV) glds16(vsrc + (size_t)(t) * VT, (unsigned)__builtin_amdgcn_readfirstlane(vdst + (s) * VT)); } while (0)
    const lds_cptr kp0 = (lds_cptr)lds + LDS_K + hi * 2048 + r32 * 16;
    const lds_cptr vq0 = (lds_cptr)lds + LDS_V + hi * (2 * DV * 16) + r32 * 16;
    DMA_K(0, 0); DMA_V(0, 0); DMA_K(1, 1);
    v8i q8;
    { const unsigned char* qb_ = Qp + (size_t)(wid * 32 + r32) * ldq + hi * 32; const v4u a = *(const v4u*)qb_, b = *(const v4u*)(qb_ + 16);
      q8 = (v8i){(int)a.x, (int)a.y, (int)a.z, (int)a.w, (int)b.x, (int)b.y, (int)b.z, (int)b.w}; }
    f32x16 lacc = f32x16{}; f32x16 o[ND];
#pragma unroll
    for (int d = 0; d < ND; ++d) o[d] = f32x16{};
    const f32x16 zero16 = f32x16{};
    const v8i ones8 = {0x38383838, 0x38383838, 0x38383838, 0x38383838, 0x38383838, 0x38383838, 0x38383838, 0x38383838};
    const int qw = q0 + wid * 32, qpos = qw + r32;
    int tl = 0, tr = NT; float fL = 1.f;
    if (BIAS) { tl = (qw - 191 >= 0) ? ((qw - 191) >> 6) + 1 : 0; tr = (qw + 158) >> 6; fL = __builtin_amdgcn_exp2f(btbl[0]); }
    f32x16 pA0, pA1, pB0, pB1; v8i kf8[2]; v8i vf[ND]; v8i pa; int sb = 127;
    int s_prev = 0, s_cur = 0, s_next = 1;
#define ROT() do { s_prev = s_cur; s_cur = s_next; s_next = (s_next == 2) ? 0 : s_next + 1; } while (0)
#define MFQK(kf_) __builtin_amdgcn_mfma_scale_f32_32x32x64_f8f6f4(kf_, q8, zero16, 0, 0, 0, 0x7f7f7f7f, 0, 0x7c7c7c7c)
#define MFPV(d_) o[d_] = __builtin_amdgcn_mfma_scale_f32_32x32x64_f8f6f4(pa, vf[d_], o[d_], 0, 0, 0, sb, 0, 0x7f7f7f7f)
#define MFSUM() lacc = __builtin_amdgcn_mfma_scale_f32_32x32x64_f8f6f4(pa, ones8, lacc, 0, 0, 0, sb, 0, 0x7f7f7f7f)
#define ADD_BIAS(C0, C1, t) do { if (BIAS && (t) >= tl && (t) <= tr) { const int base_ = (t) * 64 + 4 * hi - qpos; \
        _Pragma("unroll") for (int r = 0; r < 16; ++r) { const int rel0 = base_ + (r & 3) + 8 * (r >> 2); const int rel1 = rel0 + 32; \
            const int i0 = (rel0 < -128 ? -128 : (rel0 > 128 ? 128 : rel0)) + 128, i1 = (rel1 < -128 ? -128 : (rel1 > 128 ? 128 : rel1)) + 128; \
            C0[r] += btbl[i0]; C1[r] += btbl[i1]; } } } while (0)
#define MX3(a, b, c) __builtin_fmaxf(__builtin_fmaxf((a), (b)), (c))
#define PMAX(P0, P1) do { float a_ = MX3(P0[0], P0[1], P1[0]), b_ = MX3(P0[2], P0[3], P1[1]); a_ = MX3(a_, P1[2], P1[3]); \
        _Pragma("unroll") for (int r = 4; r < 16; r += 4) { a_ = MX3(a_, P0[r], P0[r + 1]); b_ = MX3(b_, P0[r + 2], P0[r + 3]); a_ = MX3(a_, P1[r], P1[r + 1]); b_ = MX3(b_, P1[r + 2], P1[r + 3]); } \
        float mx_ = __builtin_fmaxf(a_, b_); { auto rr_ = __builtin_amdgcn_permlane32_swap(__float_as_uint(mx_), __float_as_uint(mx_), false, false); mx_ = __builtin_fmaxf(__uint_as_float(rr_[0]), __uint_as_float(rr_[1])); } \
        const int em_ = (int)(__float_as_uint(mx_) >> 23) - 7; sb = em_ < 1 ? 1 : em_; } while (0)
#define PCVT(P0, P1) do { const float scf_ = __uint_as_float((unsigned)sb << 23); \
        _Pragma("unroll") for (int k = 0; k < 4; ++k) { v2s w_ = {0, 0}; w_ = __builtin_amdgcn_cvt_scalef32_pk_fp8_f32(w_, P0[4 * k], P0[4 * k + 1], scf_, false); w_ = __builtin_amdgcn_cvt_scalef32_pk_fp8_f32(w_, P0[4 * k + 2], P0[4 * k + 3], scf_, true); pa[k] = __builtin_bit_cast(int, w_); } \
        _Pragma("unroll") for (int k = 0; k < 4; ++k) { v2s w_ = {0, 0}; w_ = __builtin_amdgcn_cvt_scalef32_pk_fp8_f32(w_, P1[4 * k], P1[4 * k + 1], scf_, false); w_ = __builtin_amdgcn_cvt_scalef32_pk_fp8_f32(w_, P1[4 * k + 2], P1[4 * k + 3], scf_, true); pa[4 + k] = __builtin_bit_cast(int, w_); } } while (0)
#define PSUM(P0, P1) do { float s0_ = P0[0] + P0[1], s1_ = P0[2] + P0[3], s2_ = P1[0] + P1[1], s3_ = P1[2] + P1[3]; \
        _Pragma("unroll") for (int r = 4; r < 16; r += 4) { s0_ += P0[r]; s1_ += P0[r + 1]; s2_ += P0[r + 2]; s3_ += P0[r + 3]; s0_ += P1[r]; s1_ += P1[r + 1]; s2_ += P1[r + 2]; s3_ += P1[r + 3]; } \
        l_reg += (s0_ + s1_) + (s2_ + s3_); } while (0)
#define EXPS(X, B, N) do { _Pragma("unroll") for (int r_ = 0; r_ < (N); ++r_) X[(B) + r_] = __builtin_amdgcn_exp2f(X[(B) + r_]); PIN(X); } while (0)
    DMA_K(2, 2);
    wait_bar<0>();
    kf8[0] = ld_frag(kp0, 1024); kf8[1] = ld_frag(kp0 + 512, 1024);
    pA0 = MFQK(kf8[0]); pA1 = MFQK(kf8[1]);
    ADD_BIAS(pA0, pA1, 0);
#pragma unroll
    for (int r = 0; r < 16; ++r) { pA0[r] = __builtin_amdgcn_exp2f(pA0[r]); pA1[r] = __builtin_amdgcn_exp2f(pA1[r]); }
    wait_bar<0>();
    DMA_K(3, 0); DMA_V(1, 1);
    ROT();
    kf8[0] = ld_frag(kp0 + s_cur * KT, 1024); kf8[1] = ld_frag(kp0 + s_cur * KT + 512, 1024);
    waitb(ndma);
#define STEP(C0, C1, P0, P1, t, GK, GV, GL) do { SBAR(); \
    const lds_cptr vp_ = vq0 + s_prev * VT; \
    _Pragma("unroll") for (int d_ = 0; d_ < ND; ++d_) vf[d_] = ld_frag(vp_ + d_ * 512, DV * 16); \
    SBAR(); \
    C0 = MFQK(kf8[0]); SBAR(); \
    PMAX(P0, P1); PIN(sb); SBAR(); \
    C1 = MFQK(kf8[1]); SBAR(); \
    PCVT(P0, P1); PIN(pa); SBAR(); \
    MFSUM(); SBAR(); \
    if (GK) { DMA_K((t) + 3, s_cur); } if (GV) { DMA_V((t) + 1, s_next); } \
    ADD_BIAS(C0, C1, t); \
    SBAR(); \
    if (ND == 2) { \
        MFPV(0); EXPS(C0, 0, 16); SBAR(); \
        if (GL) { kf8[0] = ld_frag(kp0 + s_next * KT, 1024); kf8[1] = ld_frag(kp0 + s_next * KT + 512, 1024); SBAR(); } \
        MFPV(1); EXPS(C1, 0, 16); SBAR(); \
    } else { \
        MFPV(0); EXPS(C0, 0, 8); SBAR(); \
        if (GL) { kf8[0] = ld_frag(kp0 + s_next * KT, 1024); SBAR(); } \
        MFPV(1); EXPS(C0, 8, 8); SBAR(); \
        if (GL) { kf8[1] = ld_frag(kp0 + s_next * KT + 512, 1024); SBAR(); } \
        MFPV(ND - 2); EXPS(C1, 0, 8); SBAR(); \
        MFPV(ND - 1); EXPS(C1, 8, 8); SBAR(); \
    } \
    if (BIAS && (t) == tl) { _Pragma("unroll") for (int r = 0; r < 16; ++r) lacc[r] *= fL; _Pragma("unroll") for (int d_ = 0; d_ < ND; ++d_) _Pragma("unroll") for (int r = 0; r < 16; ++r) o[d_][r] *= fL; } \
    } while (0)
    int t = 1;
    for (; t + 4 < NT; t += 2) {
        STEP(pB0, pB1, pA0, pA1, t, true, true, true);       waitb(ndma); ROT();
        STEP(pA0, pA1, pB0, pB1, t + 1, true, true, true);   waitb(ndma); ROT();
    }
    STEP(pB0, pB1, pA0, pA1, NT - 3, false, true, true);  waitb(doV ? 1 : 0); ROT();
    STEP(pA0, pA1, pB0, pB1, NT - 2, false, true, true);  wait_bar<0>();  ROT();
    STEP(pB0, pB1, pA0, pA1, NT - 1, false, false, false);
    {
        const lds_cptr vp_ = vq0 + s_cur * VT;
#pragma unroll
        for (int d_ = 0; d_ < ND; ++d_) vf[d_] = ld_frag(vp_ + d_ * 512, DV * 16);
        PMAX(pB0, pB1); PCVT(pB0, pB1); MFSUM();
#pragma unroll
        for (int d_ = 0; d_ < ND; ++d_) MFPV(d_);
    }
    int lane_e = lane; asm volatile("" : "+v"(lane_e));
    const int r32e = lane_e & 31, hie = lane_e >> 5;
    asm volatile("s_waitcnt lgkmcnt(0)\n\ts_barrier" ::: "memory");
    {
        LAS bf16* stg = (LAS bf16*)(MODE == 1 ? lds + STASH_OFF : lds) + wid * (32 * DV);
#pragma unroll
        for (int r = 0; r < 16; ++r) { const int orow = crow(r, hie); const float rl = __builtin_amdgcn_rcpf(lacc[r]);
#pragma unroll
            for (int d0 = 0; d0 < ND; ++d0) stg[orow * DV + d0 * 32 + r32e] = (bf16)f2bf(o[d0][r] * rl); }
        asm volatile("s_waitcnt lgkmcnt(0)" ::: "memory");
        if (MODE == 0) {
            constexpr int CPR = DV / 8;
#pragma unroll
            for (int i = 0; i < (32 * CPR) / 64; ++i) { const int row = i * (64 / CPR) + lane_e / CPR, ch = lane_e % CPR;
                const v4u v = *(const LAS v4u*)(stg + row * DV + ch * 8); *(v4u*)(Op + (size_t)(wid * 32 + row) * ldo + ch * 8) = v; }
        } else if (MODE == 2) {
            const int row = lane_e >> 1, half = lane_e & 1; const float lam = sgt[128];
            const LAS bf16* s1 = stg + row * DV + half * 64; const LAS bf16* s0 = (const LAS bf16*)(lds + STASH_OFF) + wid * (32 * DV) + row * DV + half * 64;
            float ov[64]; float ss = 0.f;
#pragma unroll
            for (int q = 0; q < 8; ++q) { const v4u a = *(const LAS v4u*)(s0 + q * 8), c = *(const LAS v4u*)(s1 + q * 8);
#pragma unroll
                for (int j = 0; j < 4; ++j) { const float lo = __builtin_bit_cast(float, a[j] << 16) - lam * __builtin_bit_cast(float, c[j] << 16);
                    const float hh = __builtin_bit_cast(float, a[j] & 0xffff0000u) - lam * __builtin_bit_cast(float, c[j] & 0xffff0000u);
                    ov[q * 8 + 2 * j] = lo; ov[q * 8 + 2 * j + 1] = hh; ss += lo * lo + hh * hh; } }
            ss += dpp_mov<0xB1>(ss);
            const float rstd = 1.0f / sqrtf(ss * (1.f / 128.f) + 1e-5f);
            bf16* yo = Op + (size_t)(wid * 32 + row) * ldo + half * 64;
#pragma unroll
            for (int q = 0; q < 8; ++q) { const f32x4 g0 = *(const LAS f32x4*)(sgt + half * 64 + q * 8), g1 = *(const LAS f32x4*)(sgt + half * 64 + q * 8 + 4);
                v4u w; w.x = pk2(ov[q * 8] * rstd * g0.x, ov[q * 8 + 1] * rstd * g0.y); w.y = pk2(ov[q * 8 + 2] * rstd * g0.z, ov[q * 8 + 3] * rstd * g0.w);
                w.z = pk2(ov[q * 8 + 4] * rstd * g1.x, ov[q * 8 + 5] * rstd * g1.y); w.w = pk2(ov[q * 8 + 6] * rstd * g1.z, ov[q * 8 + 7] * rstd * g1.w);
                *(v4u*)(yo + q * 8) = w; }
        }
    }
    asm volatile("s_waitcnt lgkmcnt(0)\n\ts_barrier" ::: "memory");
#undef DMA_K
#undef DMA_V
#undef ROT
#undef MFQK
#undef MFPV
#undef MFSUM
#undef ADD_BIAS
#undef MX3
#undef PMAX
#undef PCVT
#undef PSUM
#undef EXPS
#undef STEP
}
#undef SBAR
#undef PIN
}

struct Args { const float* in[27]; float* out; unsigned char* ws; int ph_lo, ph_hi, li, pad; };

constexpr int NPHASE = 17;
constexpr int NWAVES = 8;

#define IN(k) (lo <= (k) && (k) < hi_ph)
#define SEAM(k) do { if (IN(k) && IN((k) + 1)) xcd_barrier(bar); } while (0)
template <int layer>
__device__ __forceinline__ void moe_block(const Args& args, LAS unsigned char* lds, const XcdBarrier& bar, int lo, int hi_ph) {
    volatile LAS unsigned* LC = (volatile LAS unsigned*)(lds + LDSCTL_OFF);
    const int tid = threadIdx.x, lane = tid & 63, wave = __builtin_amdgcn_readfirstlane(tid >> 6);
    const int G = gridDim.x, bx = blockIdx.x;
    const int gw = bx * NWAVES + wave, NGW = G * NWAVES;
    unsigned char* ws = args.ws;
    unsigned* ctl = (unsigned*)(ws + WS_CTL);
    float* xres = args.out;
    bf16* XB = (bf16*)(ws + WS_XB);
    bf16* HB = (bf16*)(ws + WS_HB);
    {
        const int pb = layer == 0 ? 5 : 13;
        unsigned* const gcnt0 = ctl + CW_CNT + layer * 64;
        int* list = (int*)(ws + WS_LIST); int* tokep = (int*)(ws + WS_TOKEP); float* gate = (float*)(ws + WS_GATE);
        if (IN(pb)) REP(pb) {
            unsigned* gcnt = gcnt0 + ((MK_N_LAUNCHES == 1 ? (int)((PROBE_MASK >> pb) & 1u) : 0) - rep_) * 128;
            if (rep_ > 0) xcd_barrier(bar);
            const float* gf = args.in[2] + layer * DM;
            const float* WR = (const float*)(ws + WS_TBL) + TBL_WR + layer * WR_LAYER;
            for (int chunk = bx; chunk < NTOK / 128; chunk += G) {
                __syncthreads();
                if (tid < 32) LC[LC_LCNT + tid] = 0u;
                __syncthreads();
                int my_e0 = 0, my_e1 = 0; float my_g0 = 0.f, my_g1 = 0.f;
                {
                    const int ri = lane & 15, kq = lane >> 4; const int r0w = chunk * 128 + wave * 16;
                    const GAS bf16* xrow = (const GAS bf16*)(XB + (size_t)(r0w + ri) * DM) + 8 * kq;
                    const GAS bf16* wth = (const GAS bf16*)((const unsigned char*)(ws + WS_TBL) + 614400) + (size_t)(layer * 2) * 49152 + ri * 1024 + 8 * kq; const GAS bf16* wtl = wth + 49152;
                    f32x4 acc0 = {0.f, 0.f, 0.f, 0.f}, acc1 = acc0, acc2 = acc0; float ss = 0.f;
                    bf16x8 aA[2], aB[2], bA[12], bB[12];
#define RT_LOAD(a_, b_, g_) do { _Pragma("unroll") for (int c_ = 0; c_ < 2; ++c_) { const int cc_ = 2 * (g_) + c_; a_[c_] = *(const GAS bf16x8*)(xrow + 32 * cc_); \
        _Pragma("unroll") for (int t_ = 0; t_ < 3; ++t_) { b_[c_ * 6 + t_ * 2] = *(const GAS bf16x8*)(wth + t_ * 16384 + 32 * cc_); b_[c_ * 6 + t_ * 2 + 1] = *(const GAS bf16x8*)(wtl + t_ * 16384 + 32 * cc_); } } } while (0)
#define RT_COMP(a_, b_) do { _Pragma("unroll") for (int c_ = 0; c_ < 2; ++c_) { const v4u aw_ = __builtin_bit_cast(v4u, a_[c_]); \
        _Pragma("unroll") for (int j_ = 0; j_ < 4; ++j_) { const float lo_ = __builtin_bit_cast(float, aw_[j_] << 16), hi_ = __builtin_bit_cast(float, aw_[j_] & 0xffff0000u); ss += lo_ * lo_ + hi_ * hi_; } \
        acc0 = __builtin_amdgcn_mfma_f32_16x16x32_bf16(a_[c_], b_[c_ * 6], acc0, 0, 0, 0); acc0 = __builtin_amdgcn_mfma_f32_16x16x32_bf16(a_[c_], b_[c_ * 6 + 1], acc0, 0, 0, 0); \
        acc1 = __builtin_amdgcn_mfma_f32_16x16x32_bf16(a_[c_], b_[c_ * 6 + 2], acc1, 0, 0, 0); acc1 = __builtin_amdgcn_mfma_f32_16x16x32_bf16(a_[c_], b_[c_ * 6 + 3], acc1, 0, 0, 0); \
        acc2 = __builtin_amdgcn_mfma_f32_16x16x32_bf16(a_[c_], b_[c_ * 6 + 4], acc2, 0, 0, 0); acc2 = __builtin_amdgcn_mfma_f32_16x16x32_bf16(a_[c_], b_[c_ * 6 + 5], acc2, 0, 0, 0); } } while (0)
                    RT_LOAD(aA, bA, 0);
#pragma unroll 1
                    for (int g = 0; g < 16; g += 2) {
                        RT_LOAD(aB, bB, g + 1);
                        RT_COMP(aA, bA);
                        if (g + 2 < 16) RT_LOAD(aA, bA, g + 2);
                        RT_COMP(aB, bB);
                    }
#undef RT_LOAD
#undef RT_COMP
                    ss += __shfl_xor(ss, 16); ss += __shfl_xor(ss, 32);
                    const float rstd = 1.0f / sqrtf(ss * (1.f / DM) + 1e-6f);
                    LAS float* Lg = (LAS float*)(lds + wave * 4096);
#pragma unroll
                    for (int r = 0; r < 4; ++r) { Lg[(4 * kq + r) * 49 + ri] = acc0[r]; Lg[(4 * kq + r) * 49 + 16 + ri] = acc1[r]; Lg[(4 * kq + r) * 49 + 32 + ri] = acc2[r]; }
                    LDS_WAIT(); asm volatile("" ::: "memory");
                    if (lane < 16) {
                        const GAS float* bv = (const GAS float*)WR + 1024 * 48;
                        float lg[4], le[32];
#pragma unroll
                        for (int e = 0; e < 4; ++e) lg[e] = Lg[lane * 49 + e] * rstd + bv[e];
#pragma unroll
                        for (int e = 0; e < 32; ++e) le[e] = Lg[lane * 49 + 4 + e] * rstd + bv[4 + e];
                        int gi = 0; float gm = lg[0];
#pragma unroll
                        for (int e = 1; e < 4; ++e) if (lg[e] > gm) { gm = lg[e]; gi = e; }
                        float gs = 0.f;
#pragma unroll
                        for (int e = 0; e < 4; ++e) gs += __expf(lg[e] - gm);
                        const float gval = 1.0f / gs;
                        float ev[8];
#pragma unroll
                        for (int j = 0; j < 8; ++j) ev[j] = gi == 0 ? le[j] : (gi == 1 ? le[8 + j] : (gi == 2 ? le[16 + j] : le[24 + j]));
                        int i0 = 0; float m0 = ev[0];
#pragma unroll
                        for (int j = 1; j < 8; ++j) if (ev[j] > m0) { m0 = ev[j]; i0 = j; }
                        int i1 = -1; float m1 = -3.0e38f;
#pragma unroll
                        for (int j = 0; j < 8; ++j) if (j != i0 && ev[j] > m1) { m1 = ev[j]; i1 = j; }
                        const float t1 = __expf(m1 - m0); const float den = 1.0f / (1.0f + t1);
                        my_e0 = gi * 8 + i0; my_e1 = gi * 8 + i1; my_g0 = gval * den; my_g1 = gval * t1 * den;
                    }
                    for (int i = 0; i < 16; ++i) { const int m = r0w + i; f32x4 v[4]; rms_row_b16(XB + (size_t)m * DM, gf, v, lane);
                        if (MOE_FP8) {
#pragma unroll
                            for (int j = 0; j < 4; ++j) { int d = __builtin_amdgcn_cvt_pk_fp8_f32(v[j].x, v[j].y, 0, false); d = __builtin_amdgcn_cvt_pk_fp8_f32(v[j].z, v[j].w, d, true); *(GAS unsigned*)((unsigned char*)HB + (size_t)m * DM + 4 * lane + 256 * j) = (unsigned)d; }
                        } else store_row_bf16(HB + (size_t)m * DM, v, lane); }
                }
                unsigned r0 = 0, r1 = 0;
                if (lane < 16) { r0 = atomicAdd((unsigned*)(LC + LC_LCNT + my_e0), 1u); r1 = atomicAdd((unsigned*)(LC + LC_LCNT + my_e1), 1u); }
                __syncthreads();
                if (tid < 32) { const unsigned c = LC[LC_LCNT + tid]; LC[LC_LBASE + tid] = c ? __hip_atomic_fetch_add(gcnt + tid, c, RLX_AGENT) : 0u; }
                __syncthreads();
                if (lane < 16) { const int m = chunk * 128 + wave * 16 + lane;
                    const unsigned p0 = LC[LC_LBASE + my_e0] + r0, p1 = LC[LC_LBASE + my_e1] + r1;
                    list[(size_t)my_e0 * LIST_CAP + p0] = m; list[(size_t)my_e1 * LIST_CAP + p1] = m;
                    tokep[2 * m] = my_e0 | (int)(p0 << 8); tokep[2 * m + 1] = my_e1 | (int)(p1 << 8);
                    gate[2 * m] = my_g0; gate[2 * m + 1] = my_g1; }
            }
        }
        SEAM(pb);
        if (IN(pb + 1) || IN(pb + 2) || IN(pb + 3)) {
            __syncthreads();
            if (tid == 0) { int acc = 0; for (int e = 0; e < 32; ++e) { const int c = (int)__hip_atomic_load(gcnt0 + e, RLX_AGENT); LC[LC_CNT + e] = (unsigned)c; LC[LC_TP + e] = (unsigned)acc; acc += (c + 255) >> 8; } LC[LC_TP + 32] = (unsigned)acc;
                int la = 0; for (int j = 0; j < 4; ++j) { LC[LC_LP + j] = (unsigned)la; la += ((int)LC[LC_CNT + (bx & 7) + 8 * j] + 255) >> 8; } LC[LC_LP + 4] = (unsigned)la; }
            __syncthreads();
        }
        const LAS int* tp = (const LAS int*)(lds + LDSCTL_OFF) + LC_TP; const LAS int* cn = (const LAS int*)(lds + LDSCTL_OFF) + LC_CNT; const LAS int* lp = (const LAS int*)(lds + LDSCTL_OFF) + LC_LP;
        if (IN(pb + 1)) REP(pb + 1) {
            pg8::Gemm g{HB, (const bf16*)(ws + WS_W13), 0, 1024, MOE_FP8 ? DM / 2 : DM};
            pg8::MoeOrder S{tp, cn, lp, list, G, bx, tp[32] * 4, true, G == 256};
            pg8::EpiSwiglu E{(bf16*)(ws + WS_H), MOE_FP8 != 0};
            if (MOE_FP8) pg8::gemm_phase<pg8::EpiSwiglu, pg8::MoeOrder, true, true, 127, 122>(lds, g, S, E);
            else pg8::gemm_phase<pg8::EpiSwiglu, pg8::MoeOrder, true>(lds, g, S, E);
        }
        SEAM(pb + 1);
        if (IN(pb + 2)) REP(pb + 2) {
            pg8::Gemm g{(const bf16*)(ws + WS_H), (const bf16*)(ws + WS_W2), 0, 1024, MOE_FP8 ? MOE_H / 2 : MOE_H};
            pg8::MoeOrder S{tp, cn, lp, list, G, bx, tp[32] * 4, false, G == 256};
            pg8::EpiBf16 E{(bf16*)(ws + WS_YS), DM, 0, 0, 1.f, 3, MOE_FP8 != 0};
            if (MOE_FP8) pg8::gemm_phase<pg8::EpiBf16, pg8::MoeOrder, true, true, 125, 122>(lds, g, S, E);
            else pg8::gemm_phase<pg8::EpiBf16, pg8::MoeOrder, true>(lds, g, S, E);
        }
        SEAM(pb + 2);
        if (IN(pb + 3)) {
            const bf16* YS = (const bf16*)(ws + WS_YS);
            if (layer == 0) { LAS float* scr = (LAS float*)(lds + wave * 16384);
                transpose_moe(args.in[24] + (size_t)NEXP * 1024 * 512, args.in[25] + (size_t)NEXP * 1024 * 512, args.in[26] + (size_t)NEXP * 1024 * 512, (bf16*)(ws + WS_W13), (bf16*)(ws + WS_W2), scr, gw, NGW, lane); }
            const float* gn = layer == 0 ? args.in[1] + DM : args.in[3];
            for (int m = gw; m < NTOK; m += NGW) {
                const int ep0 = tokep[2 * m], ep1 = tokep[2 * m + 1]; const float g0 = gate[2 * m], g1 = gate[2 * m + 1];
                const size_t s0 = (size_t)(tp[ep0 & 255] * 256 + (ep0 >> 8)), s1 = (size_t)(tp[ep1 & 255] * 256 + (ep1 >> 8));
                GAS f32x4* xr = (GAS f32x4*)(xres + (size_t)m * DM) + lane; GAS v2u* xb = (GAS v2u*)(XB + (size_t)m * DM) + lane;
                const GAS v2u* y0 = (const GAS v2u*)(YS + s0 * DM) + lane; const GAS v2u* y1 = (const GAS v2u*)(YS + s1 * DM) + lane;
                const GAS unsigned* z0 = (const GAS unsigned*)((const unsigned char*)YS + s0 * DM) + lane; const GAS unsigned* z1 = (const GAS unsigned*)((const unsigned char*)YS + s1 * DM) + lane;
                f32x4 v[4]; float ss = 0.f;
#pragma unroll
                for (int j = 0; j < 4; ++j) { const v2u xw = xb[64 * j]; f32x4 xv = (f32x4){__builtin_bit_cast(float, xw.x << 16), __builtin_bit_cast(float, xw.x & 0xffff0000u), __builtin_bit_cast(float, xw.y << 16), __builtin_bit_cast(float, xw.y & 0xffff0000u)};
                    if (MOE_FP8) { typedef float f32x2_ __attribute__((ext_vector_type(2))); const unsigned a = z0[64 * j], c = z1[64 * j]; const float h0 = g0 * 0.125f, h1 = g1 * 0.125f;
                        const f32x2_ al = __builtin_amdgcn_cvt_pk_f32_fp8((int)a, false), ah = __builtin_amdgcn_cvt_pk_f32_fp8((int)a, true), cl = __builtin_amdgcn_cvt_pk_f32_fp8((int)c, false), ch = __builtin_amdgcn_cvt_pk_f32_fp8((int)c, true);
                        xv.x += h0 * al.x + h1 * cl.x; xv.y += h0 * al.y + h1 * cl.y; xv.z += h0 * ah.x + h1 * ch.x; xv.w += h0 * ah.y + h1 * ch.y;
                    } else { const v2u a = y0[64 * j], c = y1[64 * j];
                    xv.x += g0 * __builtin_bit_cast(float, a.x << 16) + g1 * __builtin_bit_cast(float, c.x << 16);
                    xv.y += g0 * __builtin_bit_cast(float, a.x & 0xffff0000u) + g1 * __builtin_bit_cast(float, c.x & 0xffff0000u);
                    xv.z += g0 * __builtin_bit_cast(float, a.y << 16) + g1 * __builtin_bit_cast(float, c.y << 16);
                    xv.w += g0 * __builtin_bit_cast(float, a.y & 0xffff0000u) + g1 * __builtin_bit_cast(float, c.y & 0xffff0000u); }
                    v[j] = xv; ss += (xv.x * xv.x + xv.y * xv.y) + (xv.z * xv.z + xv.w * xv.w); }
                const float rstd = 1.0f / sqrtf(wave_sum(ss) * (1.f / DM) + 1e-6f);
                const GAS f32x4* gr = (const GAS f32x4*)gn + lane;
                if (layer == 0) {
#pragma unroll
                    for (int j = 0; j < 4; ++j) xb[64 * j] = (v2u){pk2(v[j].x, v[j].y), pk2(v[j].z, v[j].w)};
#pragma unroll
                    for (int j = 0; j < 4; ++j) v[j] = v[j] * rstd * gr[64 * j];
                    if (IN1_FP8) {
#pragma unroll
                        for (int j = 0; j < 4; ++j) { int d = __builtin_amdgcn_cvt_pk_fp8_f32(v[j].x, v[j].y, 0, false); d = __builtin_amdgcn_cvt_pk_fp8_f32(v[j].z, v[j].w, d, true); *(GAS unsigned*)((unsigned char*)HB + (size_t)m * DM + 4 * lane + 256 * j) = (unsigned)d; }
                    } else store_row_bf16(HB + (size_t)m * DM, v, lane);
                } else {
#pragma unroll
                    for (int j = 0; j < 4; ++j) xr[64 * j] = v[j] * rstd * gr[64 * j];
                }
            }
        }
    }
}

__global__ void __launch_bounds__(NWAVES * 64, 2) mk_fwd(Args args) {
    extern __shared__ __attribute__((aligned(16))) unsigned char lds_raw[];
    LAS unsigned char* lds = (LAS unsigned char*)lds_raw;
    volatile LAS unsigned* LC = (volatile LAS unsigned*)(lds + LDSCTL_OFF);
    const int tid = threadIdx.x, lane = tid & 63, wave = __builtin_amdgcn_readfirstlane(tid >> 6);
    const int G = gridDim.x, bx = blockIdx.x;
    const int gw = bx * NWAVES + wave, NGW = G * NWAVES;
    unsigned char* ws = args.ws;
    unsigned* ctl = (unsigned*)(ws + WS_CTL);
    const float* x_in = args.in[0];
    float* xres = args.out;
    bf16* XB = (bf16*)(ws + WS_XB);
    bf16* HB = (bf16*)(ws + WS_HB); bf16* Y = (bf16*)(ws + WS_Y);
    float* TBL = (float*)(ws + WS_TBL);

    for (int u = tid; u < (LDS_BYTES - LDSCTL_OFF) / 4; u += NWAVES * 64) LC[u] = 0u;
    __syncthreads();
    XcdBarrier bar; bar.bar = ctl + CW_BAR; bar.x = 0; bar.st = nullptr;
    if (MK_N_LAUNCHES == 1) bar = xcd_barrier_post(ctl + CW_BAR, LC + LC_BAR);
    const int lo = args.ph_lo, hi_ph = args.ph_hi;

    if (IN(0)) REP(0) {
        LAS float* scr = (LAS float*)(lds + wave * 16384);
        transpose_plain(args.in[4], DM, EV_IN, (bf16*)(ws + WS_WIN0), scr, gw, NGW, lane);
        transpose_plain(args.in[11], DM, DM, (bf16*)(ws + WS_WOUT0), scr, gw, NGW, lane);
        transpose_plain<IN1_FP8 != 0>(args.in[12], DM, OD_IN, (bf16*)(ws + WS_WIN1), scr, gw, NGW, lane);
        transpose_plain(args.in[18], DM, DM, (bf16*)(ws + WS_WOUT1), scr, gw, NGW, lane);
        transpose_moe(args.in[24], args.in[25], args.in[26], (bf16*)(ws + WS_W13), (bf16*)(ws + WS_W2), scr, gw, NGW, lane);
        for (int i = bx * 512 + tid; i < 2048; i += G * 512) { const int pos = i >> 4, f = i & 15;
            const float inv = exp2f(-(float)f * (13.287712379549449f / 16.0f));
            const float ang = (float)pos * inv; const float rev = ang * 0.15915494309189535f; const float fr = rev - floorf(rev);
            TBL[TBL_COS + i] = __builtin_amdgcn_cosf(fr); TBL[TBL_SIN + i] = __builtin_amdgcn_sinf(fr); }
        for (int i = bx * 512 + tid; i < 8 * 257; i += G * 512) { const int h = i / 257, j = i % 257;
            TBL[TBL_BIAS + h * BIAS_STRIDE + j] = args.in[19][t5_bucket(j - 128) * 8 + h] * LOG2E; }
        for (int i = bx * 512 + tid; i < 2 * 1024 * 48; i += G * 512) { const int l = i / (1024 * 48), r = i % (1024 * 48), k = r / 48, c = r % 48;
            float w = 0.f; if (c < 4) w = args.in[20][(size_t)l * 4096 + k * 4 + c]; else if (c < 36) w = args.in[22][(size_t)l * 32768 + k * 32 + (c - 4)];
            TBL[TBL_WR + l * WR_LAYER + r] = w * args.in[2][l * DM + k]; }
        {
            bf16* TBH = (bf16*)((unsigned char*)TBL + 614400);
            for (int i = bx * 512 + tid; i < 2 * 48 * 1024; i += G * 512) { const int l = i / (48 * 1024), r = i % (48 * 1024), c = r >> 10, k = r & 1023;
                float w = 0.f; if (c < 4) w = args.in[20][(size_t)l * 4096 + k * 4 + c]; else if (c < 36) w = args.in[22][(size_t)l * 32768 + k * 32 + (c - 4)];
                w *= args.in[2][l * DM + k]; const unsigned hb = f2bf(w); const float rem = w - bf2f((unsigned short)hb);
                TBH[(size_t)(l * 2) * 49152 + r] = (bf16)hb; TBH[(size_t)(l * 2 + 1) * 49152 + r] = (bf16)f2bf(rem); }
        }
        for (int i = bx * 512 + tid; i < 2 * 48; i += G * 512) { const int l = i / 48, c = i % 48;
            TBL[TBL_WR + l * WR_LAYER + 1024 * 48 + c] = c < 4 ? args.in[21][l * 4 + c] : (c < 36 ? args.in[23][l * 32 + (c - 4)] : 0.f); }
        for (int m = gw; m < NTOK; m += NGW) { f32x4 v[4]; rms_row(x_in + (size_t)m * DM, args.in[1], v, lane); store_row_bf16(HB + (size_t)m * DM, v, lane); }
    }
    SEAM(0);
    if (IN(1)) REP(1) {
        pg8::Gemm g{HB, (const bf16*)(ws + WS_WIN0), NTOK, EV_IN, DM}; pg8::StaticOrder S; S.init(NTOK, EV_IN, G, bx);
        pg8::EpiBf16 E{(bf16*)(ws + WS_Z0), EV_IN, 0, 0, 1.f, 0xffff, false};
        pg8::gemm_phase<pg8::EpiBf16, pg8::StaticOrder, true>(lds, g, S, E);
    }
    SEAM(1);
    if (IN(2)) REP(2) {
        const bf16* Z0 = (const bf16*)(ws + WS_Z0); bf16* QR = (bf16*)(ws + WS_QR); bf16* KR = (bf16*)(ws + WS_KR);
        if (QK_FP8 && (ATTN_VER == 1 || ATTN_VER == 3)) {
            for (int it = bx * 512 + tid; it < NTOK * 10; it += G * 512) {
                const bool isq = it < NTOK * 8; const int m = isq ? (it >> 3) : ((it - NTOK * 8) >> 1); const int hh = isq ? (it & 7) : 8 + ((it - NTOK * 8) & 1);
                const float* gn = isq ? args.in[5] : args.in[6];
                const GAS v4u* srcp = (const GAS v4u*)(Z0 + (size_t)m * EV_IN + hh * 64);
                float xv[64]; float ss = 0.f;
#pragma unroll
                for (int q = 0; q < 8; ++q) { const v4u a = srcp[q];
#pragma unroll
                    for (int j = 0; j < 4; ++j) { const float lo = __builtin_bit_cast(float, a[j] << 16), hh2 = __builtin_bit_cast(float, a[j] & 0xffff0000u); xv[q * 8 + 2 * j] = lo; xv[q * 8 + 2 * j + 1] = hh2; ss += lo * lo + hh2 * hh2; } }
                const float rs = (1.0f / sqrtf(ss * (1.f / 64.f) + 1e-6f)) * (isq ? C2 * 8.0f : 1.0f);
                const int sp = m & (SEQ - 1);
                unsigned wout[16];
#pragma unroll
                for (int half = 0; half < 2; ++half) { const int pos = half ? (sp & 63) : (sp >> 6);
                    const GAS f32x4* ct = (const GAS f32x4*)(TBL + TBL_COS + pos * 16); const GAS f32x4* st = (const GAS f32x4*)(TBL + TBL_SIN + pos * 16);
                    float ov[32];
#pragma unroll
                    for (int q = 0; q < 4; ++q) { const f32x4 cv = ct[q], sv = st[q];
#pragma unroll
                        for (int j = 0; j < 4; ++j) { const int i = q * 4 + j; const float a = xv[half * 32 + i] * rs * gn[half * 32 + i], b2 = xv[half * 32 + 16 + i] * rs * gn[half * 32 + 16 + i];
                            ov[i] = a * cv[j] - b2 * sv[j]; ov[16 + i] = b2 * cv[j] + a * sv[j]; } }
#pragma unroll
                    for (int q = 0; q < 8; ++q) { int d = __builtin_amdgcn_cvt_pk_fp8_f32(ov[4 * q], ov[4 * q + 1], 0, false); d = __builtin_amdgcn_cvt_pk_fp8_f32(ov[4 * q + 2], ov[4 * q + 3], d, true); wout[half * 8 + q] = (unsigned)d; } }
                if (!isq && ATTN_VER == 3) {
                    const int strm = (m >> 13) * 2 + (hh - 8); unsigned char* kb_ = ws + WS_K8T0 + ((((size_t)strm * 128 + (sp >> 6)) * 4) * 64 + (sp & 63)) * 16;
#pragma unroll
                    for (int q = 0; q < 4; ++q) *(GAS v4u*)(kb_ + q * 1024) = (v4u){wout[4 * q], wout[4 * q + 1], wout[4 * q + 2], wout[4 * q + 3]};
                } else {
                GAS v4u* dst = isq ? (GAS v4u*)(ws + WS_QR8 + (size_t)m * 512 + hh * 64) : (GAS v4u*)(ws + WS_KR8 + (size_t)m * 128 + (hh - 8) * 64);
#pragma unroll
                for (int q = 0; q < 4; ++q) dst[q] = (v4u){wout[4 * q], wout[4 * q + 1], wout[4 * q + 2], wout[4 * q + 3]};
                }
            }
            if (ATTN_VER == 3) {
                for (int it = bx * 512 + tid; it < 8 * 128 * 4 * 64; it += G * 512) { const int d = it & 63, c = (it >> 6) & 3, tt = (it >> 8) & 127, strm = it >> 15;
                    const bf16* vb_ = Z0 + ((size_t)(strm >> 1) * SEQ + tt * 64) * EV_IN + 640 + (strm & 1) * 64 + d; unsigned w4[4];
#pragma unroll
                    for (int q = 0; q < 4; ++q) { float f[4];
#pragma unroll
                        for (int j = 0; j < 4; ++j) { const int bb = q * 4 + j; const int key = 32 * (c & 1) + (bb & 3) + 8 * (bb >> 2) + 4 * (c >> 1); f[j] = bf2f(vb_[(size_t)key * EV_IN]); }
                        int dw = __builtin_amdgcn_cvt_pk_fp8_f32(f[0], f[1], 0, false); dw = __builtin_amdgcn_cvt_pk_fp8_f32(f[2], f[3], dw, true); w4[q] = (unsigned)dw; }
                    *(GAS v4u*)(ws + WS_V8T0 + (size_t)it * 16) = (v4u){w4[0], w4[1], w4[2], w4[3]}; }
            }
        } else {
        const float gq = args.in[5][lane], gk = args.in[6][lane];
        const int fi = lane & 15; const bool first = (lane & 16) == 0, isrow = lane < 32;
        for (int m = gw; m < NTOK; m += NGW) {
            const int s = m & (SEQ - 1); const int pos = isrow ? (s >> 6) : (s & 63);
            const float cs = TBL[TBL_COS + pos * 16 + fi], sn = TBL[TBL_SIN + pos * 16 + fi];
#pragma unroll
            for (int h = 0; h < 10; ++h) {
                const float xv = bf2f(Z0[(size_t)m * EV_IN + h * 64 + lane]);
                const float ss = wave_sum(xv * xv);
                const float y = xv * (1.0f / sqrtf(ss * (1.f / 64.f) + 1e-6f)) * (h < 8 ? gq : gk);
                const float p = __shfl_xor(y, 16);
                float o = first ? (y * cs - p * sn) : (y * cs + p * sn);
                if (!QK_FP8 || ATTN_VER != 1) { if (h < 8) QR[(size_t)m * 512 + h * 64 + lane] = (bf16)f2bf(o * C2);
                else KR[(size_t)m * 128 + (h - 8) * 64 + lane] = (bf16)f2bf(o); }
                if (QK_FP8) { const unsigned w = quad_pack_bytes(fp8_byte(h < 8 ? o * (C2 * 8.0f) : o));
                    if ((lane & 3) == 0) { if (h < 8) *(unsigned*)(ws + WS_QR8 + (size_t)m * 512 + h * 64 + lane) = w; else *(unsigned*)(ws + WS_KR8 + (size_t)m * 128 + (h - 8) * 64 + lane) = w; } }
            }
        }
        }
        LAS float* hbuf = (LAS float*)lds;
        for (int un = bx; un < NBATCH * 64 * 8; un += G) {
            const int grp = un & 7, tt = (un >> 3) & 63, b = un >> 9; const int t0 = tt * 128;
            __syncthreads();
            for (int idx = tid; idx < 158 * 8; idx += 512) { const int r = idx >> 3, c8 = idx & 7; const int s = t0 - 15 + r;
                f32x4 h0 = {0.f, 0.f, 0.f, 0.f}, h1 = h0;
                if (s >= 0 && s < SEQ) { const size_t ro = (size_t)(b * SEQ + s) * EV_IN + grp * 64 + c8 * 8;
                    const v4u av = *(const GAS v4u*)(Z0 + ro + 768), gv = *(const GAS v4u*)(Z0 + ro + 1280);
#pragma unroll
                    for (int j = 0; j < 4; ++j) { const float a0 = __builtin_bit_cast(float, av[j] << 16), a1 = __builtin_bit_cast(float, av[j] & 0xffff0000u);
                        const float g0 = __builtin_bit_cast(float, gv[j] << 16), g1 = __builtin_bit_cast(float, gv[j] & 0xffff0000u);
                        const float x0 = a0 * __builtin_amdgcn_rcpf(1.0f + __builtin_amdgcn_exp2f(-g0 * LOG2E)), x1 = a1 * __builtin_amdgcn_rcpf(1.0f + __builtin_amdgcn_exp2f(-g1 * LOG2E));
                        if (j < 2) { h0[2 * j] = x0; h0[2 * j + 1] = x1; } else { h1[2 * j - 4] = x0; h1[2 * j - 3] = x1; } } }
                *(LAS f32x4*)(hbuf + r * 64 + c8 * 8) = h0; *(LAS f32x4*)(hbuf + r * 64 + c8 * 8 + 4) = h1; }
            __syncthreads();
            const int ch = grp * 64 + lane;
            float wreg[31];
#pragma unroll
            for (int j = 0; j < 31; ++j) wreg[j] = args.in[7][j * 512 + ch];
            typedef float f32x2 __attribute__((ext_vector_type(2)));
            float acc[16]; const float cb = args.in[8][ch];
            {
                f32x2 he[23], ho[22];
#pragma unroll
                for (int k = 0; k < 23; ++k) { he[k].x = hbuf[(wave * 16 + 2 * k) * 64 + lane]; he[k].y = hbuf[(wave * 16 + 2 * k + 1) * 64 + lane]; }
#pragma unroll
                for (int k = 0; k < 22; ++k) { ho[k].x = he[k].y; ho[k].y = he[k + 1].x; }
                f32x2 a2[8];
#pragma unroll
                for (int p = 0; p < 8; ++p) a2[p] = (f32x2){cb, cb};
#pragma unroll
                for (int j = 0; j < 31; ++j) { const f32x2 wj = (f32x2){wreg[j], wreg[j]};
#pragma unroll
                    for (int p = 0; p < 8; ++p) { const int r = 2 * p + j; a2[p] = __builtin_elementwise_fma(wj, (r & 1) ? ho[r >> 1] : he[r >> 1], a2[p]); } }
#pragma unroll
                for (int p = 0; p < 8; ++p) { acc[2 * p] = a2[p].x; acc[2 * p + 1] = a2[p].y; }
            }
            const float gg = args.in[9][ch], gb = args.in[10][ch];
#pragma unroll
            for (int i = 0; i < 16; ++i) { const float mu = wave_sum(acc[i]) * (1.f / 64.f); const float d = acc[i] - mu; const float var = wave_sum(d * d) * (1.f / 64.f);
                const float hn = d * (1.0f / sqrtf(var + 1e-5f)) * gg + gb; const float ov = hn * __builtin_amdgcn_rcpf(1.0f + __builtin_amdgcn_exp2f(-hn * LOG2E));
                Y[(size_t)(b * SEQ + t0 + wave * 16 + i) * DM + 512 + ch] = (bf16)f2bf(ov); }
        }
    }
    SEAM(2);
    if (IN(3)) REP(3) {
        const bf16* QR = (const bf16*)(ws + WS_QR); const bf16* KR = (const bf16*)(ws + WS_KR); const bf16* Z0 = (const bf16*)(ws + WS_Z0);
        if (ATTN_L0_TEST) {
        for (int un = bx; un < NBATCH * 8 * 32; un += G) {
            const int qb = un & 31, h = (un >> 5) & 7, b = un >> 8, kvh = h >> 2;
            const size_t row0 = (size_t)b * SEQ + qb * 256;
            attn_unit_v0<64, false, true>((const bf16*)(ws + WS_QR8 + row0 * 512 + h * 64), 512, (const bf16*)(ws + WS_KR8 + (size_t)b * SEQ * 128 + kvh * 64), 128, Z0 + (size_t)b * SEQ * EV_IN + 640 + kvh * 64, EV_IN,
                                   Y + row0 * DM + h * 64, DM, nullptr, qb * 256, lds);
        }
        } else if (ATTN_VER == 0) {
        for (int un = bx; un < NBATCH * 8 * 32; un += G) {
            const int qb = un & 31, h = (un >> 5) & 7, b = un >> 8, kvh = h >> 2;
            const size_t row0 = (size_t)b * SEQ + qb * 256;
            attn_unit_v0<64, false>(QR + row0 * 512 + h * 64, 512, KR + (size_t)b * SEQ * 128 + kvh * 64, 128, Z0 + (size_t)b * SEQ * EV_IN + 640 + kvh * 64, EV_IN,
                                   Y + row0 * DM + h * 64, DM, nullptr, qb * 256, lds);
        }
        } else {
        constexpr int U = NBATCH * 8 * 32; const int upc = (U + G - 1) / G; const int vcu = (G % 8 == 0) ? (bx % 8) * (G / 8) + bx / 8 : bx;
        for (int i = 0; i < upc; ++i) { const int un = vcu * upc + i; if (un >= U) break;
            const int stream = un >> 7, b = stream >> 1, kvh = stream & 1, h = kvh * 4 + ((un >> 5) & 3), qb = un & 31;
            const size_t row0 = (size_t)b * SEQ + qb * 256;
            if (ATTN_VER == 3) at3::attn_unit<64, false, 0>(ws + WS_QR8 + row0 * 512 + h * 64, 512, ws + WS_K8T0 + (size_t)stream * 128 * 4096, ws + WS_V8T0 + (size_t)stream * 128 * 4096, Y + row0 * DM + h * 64, DM, qb * 256, lds, nullptr);
            else if (QK_FP8) at1::attn_unit<64, false, 0, 0, true>((const bf16*)(ws + WS_QR8 + row0 * 512 + h * 64), 512, (const bf16*)(ws + WS_KR8 + (size_t)b * SEQ * 128 + kvh * 64), 128, Z0 + (size_t)b * SEQ * EV_IN + 640 + kvh * 64, EV_IN,
                                      Y + row0 * DM + h * 64, DM, qb * 256, lds);
            else at1::attn_unit<64, false>(QR + row0 * 512 + h * 64, 512, KR + (size_t)b * SEQ * 128 + kvh * 64, 128, Z0 + (size_t)b * SEQ * EV_IN + 640 + kvh * 64, EV_IN,
                                      Y + row0 * DM + h * 64, DM, qb * 256, lds);
        }
        }
    }
    SEAM(3);
    if (IN(4)) REP(4) {
        pg8::Gemm g{Y, (const bf16*)(ws + WS_WOUT0), NTOK, DM, DM}; pg8::StaticOrder S; S.init(NTOK, DM, G, bx);
        pg8::EpiRes E{x_in, nullptr, XB, DM};
        pg8::gemm_phase<pg8::EpiRes, pg8::StaticOrder, true>(lds, g, S, E);
    }
    SEAM(4);

    moe_block<0>(args, lds, bar, lo, hi_ph);
    SEAM(8);
            if (IN(9)) REP(9) {
                pg8::Gemm g{HB, (const bf16*)(ws + WS_WIN1), NTOK, OD_IN, IN1_FP8 ? DM / 2 : DM}; pg8::StaticOrder S; S.init(NTOK, OD_IN, G, bx);
                if (QK_FP8) { pg8::EpiQKV8 E{ws + WS_Q1, ws + WS_K8T1, (bf16*)(ws + WS_V1), C2 * 8.0f, true};
                    if (IN1_FP8) pg8::gemm_phase<pg8::EpiQKV8, pg8::StaticOrder, true, true, 127, 122>(lds, g, S, E);
                    else pg8::gemm_phase<pg8::EpiQKV8, pg8::StaticOrder, true>(lds, g, S, E); }
                else { pg8::EpiBf16 E{(bf16*)(ws + WS_Q1), DM, DM, (size_t)(WS_K1 - WS_Q1) / 2, C2, 0xffff, false};
                pg8::gemm_phase<pg8::EpiBf16, pg8::StaticOrder, true>(lds, g, S, E); }
            }
            SEAM(9);
            if (ATTN_L1_VER == 3) {
            if (IN(10)) {
                const bf16* V1 = (const bf16*)(ws + WS_V1);
                for (int it = bx * 512 + tid; it < 32 * 128 * 4 * 128; it += G * 512) { const int d = it & 127, c = (it >> 7) & 3, tt = (it >> 9) & 127, bh = it >> 16;
                    const bf16* vb_ = V1 + (((size_t)bh * 128 + tt) * 4 + (d >> 5)) * 2048 + (d & 31); unsigned w4[4];
#pragma unroll
                    for (int q = 0; q < 4; ++q) { float f[4];
#pragma unroll
                        for (int j = 0; j < 4; ++j) { const int bb = q * 4 + j; const int key = 32 * (c & 1) + (bb & 3) + 8 * (bb >> 2) + 4 * (c >> 1); f[j] = bf2f(vb_[(size_t)key * 32]); }
                        int dw = __builtin_amdgcn_cvt_pk_fp8_f32(f[0], f[1], 0, false); dw = __builtin_amdgcn_cvt_pk_fp8_f32(f[2], f[3], dw, true); w4[q] = (unsigned)dw; }
                    *(GAS v4u*)(ws + WS_V8T1 + (size_t)it * 16) = (v4u){w4[0], w4[1], w4[2], w4[3]}; }
            }
            SEAM(10);
            if (IN(11)) REP(11) {
                constexpr int UP = NBATCH * 8 * 32; const int upc = (UP + G - 1) / G; const int vcu = (G % 8 == 0) ? (bx % 8) * (G / 8) + bx / 8 : bx;
                LAS float* btbl = (LAS float*)(lds + at3::lds_tbl_off<128>());
                LAS float* sgt = btbl + 272;
                __syncthreads();
                if (tid < 128) sgt[tid] = args.in[17][tid] * (1.0f - LAM_INIT);
                if (wave == 7) { const float lam = __expf(wave_sum(args.in[13][lane] * args.in[14][lane])) - __expf(wave_sum(args.in[15][lane] * args.in[16][lane])) + LAM_INIT; if (lane == 0) sgt[128] = lam; }
                for (int i = 0; i < upc; ++i) {
                    int up = vcu * upc + i; if (up >= UP) break;
                    if (G == 256) up = ((vcu >> 5) * 4 + i) * 32 + (vcu & 31);
                    const int qb = up & 31, h = (up >> 5) & 7, b = up >> 8;
                    __syncthreads();
                    if (tid < 257) btbl[tid] = TBL[TBL_BIAS + h * BIAS_STRIDE + tid] - TBL[TBL_BIAS + h * BIAS_STRIDE + 256];
                    __syncthreads();
                    const size_t row0 = (size_t)b * SEQ + qb * 256; const int bh = b * 8 + h;
                    const unsigned char* Q8 = ws + WS_Q1 + row0 * DM + h * 128; const unsigned char* V8 = ws + WS_V8T1 + (size_t)bh * 128 * 8192;
                    at3::attn_unit<128, true, 1>(Q8, DM, ws + WS_K8T1 + (size_t)(bh * 2) * 128 * 4096, V8, nullptr, DM, qb * 256, lds, sgt);
                    at3::attn_unit<128, true, 2>(Q8 + 64, DM, ws + WS_K8T1 + (size_t)(bh * 2 + 1) * 128 * 4096, V8, Y + row0 * DM + h * 128, DM, qb * 256, lds, sgt);
                }
            }
            SEAM(11);
            } else {
            if (IN(10)) REP(10) {
                const bf16* Q1 = (const bf16*)(ws + WS_Q1); const bf16* K1 = (const bf16*)(ws + WS_K1); const bf16* V1 = (const bf16*)(ws + WS_V1);
                if (ATTN_L1_VER == 0) {
                LAS float* btbl = (LAS float*)(lds + 65536);
                for (int un = bx; un < NBATCH * 8 * 2 * 32; un += G) {
                    const int qb = un & 31, c = (un >> 5) & 1, h = (un >> 6) & 7, b = un >> 9;
                    __syncthreads();
                    if (tid < 257) btbl[tid] = TBL[TBL_BIAS + h * BIAS_STRIDE + tid];
                    __syncthreads();
                    const size_t row0 = (size_t)b * SEQ + qb * 256, brow = (size_t)b * SEQ;
                    bf16* OC = (bf16*)(ws + (c ? WS_OC1 : WS_OC0));
                    attn_unit_v0<128, true>(Q1 + row0 * DM + h * 128 + c * 64, DM, K1 + brow * DM + h * 128 + c * 64, DM, V1 + brow * DM + h * 128, DM,
                                           OC + row0 * DM + h * 128, DM, btbl, qb * 256, lds);
                }
                } else {
                constexpr int UP = NBATCH * 8 * 32; const int upc = (UP + G - 1) / G; const int vcu = (G % 8 == 0) ? (bx % 8) * (G / 8) + bx / 8 : bx;
                LAS float* btbl = (LAS float*)(lds + at1::lds_tbl_off<128, QK_FP8 != 0>());
                LAS float* sgt = btbl + 272;
                __syncthreads();
                if (tid < 128) sgt[tid] = args.in[17][tid] * (1.0f - LAM_INIT);
                if (wave == 7) { const float lam = __expf(wave_sum(args.in[13][lane] * args.in[14][lane])) - __expf(wave_sum(args.in[15][lane] * args.in[16][lane])) + LAM_INIT; if (lane == 0) sgt[128] = lam; }
                for (int i = 0; i < upc; ++i) {
                    int up = vcu * upc + i; if (up >= UP) break;
                    if (G == 256) up = ((vcu >> 5) * 4 + i) * 32 + (vcu & 31);
                    const int qb = up & 31, h = (up >> 5) & 7, b = up >> 8;
                    __syncthreads();
                    if (tid < 257) btbl[tid] = TBL[TBL_BIAS + h * BIAS_STRIDE + tid] - TBL[TBL_BIAS + h * BIAS_STRIDE + 256];
                    __syncthreads();
                    const size_t row0 = (size_t)b * SEQ + qb * 256, brow = (size_t)b * SEQ;
                    if (QK_FP8) { const unsigned char* Q8 = ws + WS_Q1; const unsigned char* K8 = ws + WS_K1;
                    const int bh = b * 8 + h; const bf16* VT = V1 + (size_t)bh * 128 * 8192; const unsigned char* KT0 = ws + WS_K8T1 + (size_t)(bh * 2) * 128 * 4096; (void)K8; (void)brow;
                    at1::attn_unit<128, true, 0, 1, true, true>((const bf16*)(Q8 + row0 * DM + h * 128), DM, (const bf16*)KT0, DM, VT, DM, nullptr, DM, qb * 256, lds, sgt);
                    at1::attn_unit<128, true, 0, 2, true, true>((const bf16*)(Q8 + row0 * DM + h * 128 + 64), DM, (const bf16*)(KT0 + 128 * 4096), DM, VT, DM, Y + row0 * DM + h * 128, DM, qb * 256, lds, sgt);
                    } else {
                    at1::attn_unit<128, true, 0, 1>(Q1 + row0 * DM + h * 128, DM, K1 + brow * DM + h * 128, DM, V1 + brow * DM + h * 128, DM, nullptr, DM, qb * 256, lds, sgt);
                    at1::attn_unit<128, true, 0, 2>(Q1 + row0 * DM + h * 128 + 64, DM, K1 + brow * DM + h * 128 + 64, DM, V1 + brow * DM + h * 128, DM, Y + row0 * DM + h * 128, DM, qb * 256, lds, sgt);
                    }
                }
                }
            }
            SEAM(10);
            if (PROBE_ATT >= 0 && IN(10)) {
                const bf16* Q1 = (const bf16*)(ws + WS_Q1); const bf16* K1 = (const bf16*)(ws + WS_K1); const bf16* V1 = (const bf16*)(ws + WS_V1);
                constexpr int U = NBATCH * 8 * 2 * 32; const int upc = (U + G - 1) / G; const int vcu = (G % 8 == 0) ? (bx % 8) * (G / 8) + bx / 8 : bx;
                LAS float* btbl = (LAS float*)(lds + 3 * 8192 + 3 * 16384 + 2048);
                for (int i = 0; i < upc; ++i) {
                    int un = vcu * upc + i; if (un >= U) break;
                    if (G == 256) un = ((vcu >> 5) * 4 + (i >> 1)) * 64 + (i & 1) * 32 + (vcu & 31);
                    const int qb = un & 31, c = (un >> 5) & 1, h = (un >> 6) & 7, b = un >> 9;
                    if (tid < 257) btbl[tid] = TBL[TBL_BIAS + h * BIAS_STRIDE + tid] - TBL[TBL_BIAS + h * BIAS_STRIDE + 256];
                    __syncthreads();
                    const size_t row0 = (size_t)b * SEQ + qb * 256, brow = (size_t)b * SEQ;
                    at1::attn_unit<128, true, (PROBE_ATT >= 0 ? PROBE_ATT : 0)>(Q1 + row0 * DM + h * 128 + c * 64, DM, K1 + brow * DM + h * 128 + c * 64, DM, V1 + brow * DM + h * 128, DM,
                                              (bf16*)(ws + WS_OC1) + row0 * DM + h * 128, DM, qb * 256, lds);
                }
                xcd_barrier(bar);
            }
            if (IN(11) && ATTN_L1_VER != 1) REP(11) {
                const bf16* OC0 = (const bf16*)(ws + WS_OC0); const bf16* OC1 = (const bf16*)(ws + WS_OC1);
                const float lam = __expf(wave_sum(args.in[13][lane] * args.in[14][lane])) - __expf(wave_sum(args.in[15][lane] * args.in[16][lane])) + LAM_INIT;
                float sg[16];
#pragma unroll
                for (int j = 0; j < 16; ++j) sg[j] = args.in[17][(lane & 7) * 16 + j] * (1.0f - LAM_INIT);
                for (int m = gw; m < NTOK; m += NGW) {
                    const GAS v4u* a = (const GAS v4u*)(OC0 + (size_t)m * DM) + lane * 2; const GAS v4u* c = (const GAS v4u*)(OC1 + (size_t)m * DM) + lane * 2;
                    float o[16]; float ss = 0.f;
#pragma unroll
                    for (int q = 0; q < 2; ++q) { const v4u av = a[q], cv = c[q];
#pragma unroll
                        for (int j = 0; j < 4; ++j) { const unsigned au = av[j], cu = cv[j];
                            const float lo = __builtin_bit_cast(float, au << 16) - lam * __builtin_bit_cast(float, cu << 16);
                            const float hh = __builtin_bit_cast(float, au & 0xffff0000u) - lam * __builtin_bit_cast(float, cu & 0xffff0000u);
                            o[q * 8 + 2 * j] = lo; o[q * 8 + 2 * j + 1] = hh; ss += lo * lo + hh * hh; } }
                    ss += __shfl_xor(ss, 1); ss += __shfl_xor(ss, 2); ss += __shfl_xor(ss, 4);
                    const float rstd = 1.0f / sqrtf(ss * (1.f / 128.f) + 1e-5f);
                    v4u w0, w1;
                    w0.x = pk2(o[0] * rstd * sg[0], o[1] * rstd * sg[1]); w0.y = pk2(o[2] * rstd * sg[2], o[3] * rstd * sg[3]); w0.z = pk2(o[4] * rstd * sg[4], o[5] * rstd * sg[5]); w0.w = pk2(o[6] * rstd * sg[6], o[7] * rstd * sg[7]);
                    w1.x = pk2(o[8] * rstd * sg[8], o[9] * rstd * sg[9]); w1.y = pk2(o[10] * rstd * sg[10], o[11] * rstd * sg[11]); w1.z = pk2(o[12] * rstd * sg[12], o[13] * rstd * sg[13]); w1.w = pk2(o[14] * rstd * sg[14], o[15] * rstd * sg[15]);
                    GAS v4u* yo = (GAS v4u*)(Y + (size_t)m * DM) + lane * 2; yo[0] = w0; yo[1] = w1;
                }
            }
            if (ATTN_L1_VER != 1) SEAM(11);
            }
            if (IN(12)) {
                pg8::Gemm g{Y, (const bf16*)(ws + WS_WOUT1), NTOK, DM, DM}; pg8::StaticOrder S; S.init(NTOK, DM, G, bx);
                pg8::EpiRes E{nullptr, XB, XB, DM};
                pg8::gemm_phase<pg8::EpiRes, pg8::StaticOrder, true>(lds, g, S, E);
            }
            SEAM(12);
    moe_block<1>(args, lds, bar, lo, hi_ph);
#undef IN
#undef SEAM
}

extern "C" void kernel_launch(void* const* d_in, const int* in_sizes, int n_in, void* d_out, int out_size, void* d_ws, size_t ws_size, hipStream_t stream) {
    static int grid = 0;
    if (grid == 0) {
        if (n_in != 27 || in_sizes[0] != NTOK * DM || out_size != NTOK * DM || ws_size < WS_END) { fprintf(stderr, "kernel_launch: unexpected shapes / workspace (n_in %d, ws %zu)\n", n_in, ws_size); grid = -1; return; }
        int dev = 0, cus = 0, per_cu = 0;
        if (hipGetDevice(&dev) != hipSuccess || hipDeviceGetAttribute(&cus, hipDeviceAttributeMultiprocessorCount, dev) != hipSuccess) { grid = -1; return; }
        if (hipFuncSetAttribute((const void*)mk_fwd, hipFuncAttributeMaxDynamicSharedMemorySize, LDS_BYTES) != hipSuccess) { fprintf(stderr, "kernel_launch: hipFuncSetAttribute failed\n"); grid = -1; return; }
        if (hipOccupancyMaxActiveBlocksPerMultiprocessor(&per_cu, (const void*)mk_fwd, NWAVES * 64, LDS_BYTES) != hipSuccess || per_cu < 1) { fprintf(stderr, "kernel_launch: occupancy query says %d\n", per_cu); }
        (void)hipGetLastError();
        grid = cus;
    }
    if (grid < 0) return;
    if (hipMemsetAsync((char*)d_ws + WS_CTL, 0, CTL_ZERO_BYTES, stream) != hipSuccess) return;
    Args a{};
    for (int i = 0; i < 27; ++i) a.in[i] = (const float*)d_in[i];
    a.out = (float*)d_out; a.ws = (unsigned char*)d_ws;
    if (MK_N_LAUNCHES == 1) { a.ph_lo = 0; a.ph_hi = NPHASE; a.li = 0; hipLaunchKernelGGL(mk_fwd, dim3(grid), dim3(NWAVES * 64), LDS_BYTES, stream, a); }
    else { for (int p = 0; p < NPHASE; ++p) for (int r = 0; r < (int)((PROBE_MASK >> p) & 1u) + 1; ++r) { a.ph_lo = p; a.ph_hi = p + 1; a.li = p; hipLaunchKernelGGL(mk_fwd, dim3(grid), dim3(NWAVES * 64), LDS_BYTES, stream, a); } }
}
```

```cpp
#include <hip/hip_runtime.h>
#include <cstdio>
#include <cstdint>

#ifndef MK_N_LAUNCHES
#define MK_N_LAUNCHES 1
#endif

#ifndef ATTN_VER
#define ATTN_VER 3
#endif
#ifndef PROBE_ATT
#define PROBE_ATT -1
#endif
#ifndef QK_FP8
#define QK_FP8 1
#endif
#ifndef ATTN_L0_TEST
#define ATTN_L0_TEST 0
#endif
#ifndef ATTN_L1_VER
#define ATTN_L1_VER 3
#endif
#ifndef MOE_FP8
#define MOE_FP8 1
#endif
#ifndef IN1_FP8
#define IN1_FP8 1
#endif
#ifndef ROUTER_LDSW
#define ROUTER_LDSW 1
#endif
#ifndef PROBE_MASK
#define PROBE_MASK 0u
#endif
#define REP(k) _Pragma("unroll") for (int rep_ = 0; rep_ < (MK_N_LAUNCHES == 1 ? (int)((PROBE_MASK >> (k)) & 1u) : 0) + 1; ++rep_)
#define GAS __attribute__((address_space(1)))
#define LAS __attribute__((address_space(3)))
typedef unsigned short bf16;
typedef unsigned v4u __attribute__((ext_vector_type(4)));
typedef unsigned v2u __attribute__((ext_vector_type(2)));
typedef float f32x4 __attribute__((ext_vector_type(4)));
typedef float f32x16 __attribute__((ext_vector_type(16)));
typedef short bf16x8 __attribute__((ext_vector_type(8)));
typedef short s16x4 __attribute__((ext_vector_type(4)));
typedef int v8i __attribute__((ext_vector_type(8)));

constexpr int NTOK = 32768, DM = 1024, SEQ = 8192, NBATCH = 4;
constexpr int EV_IN = 1792, OD_IN = 3072;
constexpr int NEXP = 32, MOE_H = 512, LIST_CAP = 32768;
constexpr float C2 = 0.125f * 1.4426950408889634f;
constexpr float LOG2E = 1.4426950408889634f;
constexpr float LAM_INIT = 0.35550906759f;

constexpr size_t MiB = 1u << 20;
constexpr size_t WS_CTL = 0, CTL_ZERO_BYTES = 1 * MiB;
constexpr size_t WS_WIN0 = 1 * MiB, WS_WOUT0 = 5 * MiB, WS_WIN1 = 7 * MiB, WS_WOUT1 = 13 * MiB, WS_TBL = 15 * MiB;
constexpr size_t WS_W13 = 16 * MiB, WS_W2 = 80 * MiB;
constexpr size_t WS_HB = 112 * MiB;
constexpr size_t WS_Y = 176 * MiB;
constexpr size_t WS_Z0 = 240 * MiB, WS_QR = 352 * MiB, WS_KR = 384 * MiB, WS_QR8 = 392 * MiB, WS_KR8 = 408 * MiB, WS_K8T0 = 408 * MiB, WS_V8T0 = 412 * MiB;
constexpr size_t WS_K8T1 = 304 * MiB, WS_V8T1 = 336 * MiB;
constexpr size_t WS_Q1 = 240 * MiB, WS_K1 = 304 * MiB, WS_V1 = 368 * MiB, WS_OC1 = 432 * MiB, WS_OC0 = WS_HB;
constexpr size_t WS_H = 176 * MiB, WS_YS = 248 * MiB, WS_LIST = 392 * MiB, WS_TOKEP = 396 * MiB, WS_GATE = 396 * MiB + 512 * 1024;
constexpr size_t WS_XB = 432 * MiB;
constexpr size_t WS_END = 496 * MiB;
constexpr int TBL_COS = 0, TBL_SIN = 2048, TBL_BIAS = 4096, BIAS_STRIDE = 272;
constexpr int TBL_WR = 32768, WR_LAYER = 1024 * 48 + 64;
constexpr int CW_BAR = 4096;
constexpr int CW_CNT = 16384;

constexpr int RING_BYTES = 131072;
constexpr int LDS_BYTES = 147456;
constexpr int LDSCTL_OFF = LDS_BYTES - 1024;
constexpr int STASH_OFF = 78 * 1024;
constexpr int LC_BAR = 8;
constexpr int LC_TP = 16;
constexpr int LC_CNT = 64;
constexpr int LC_LCNT = 96;
constexpr int LC_LBASE = 128;
constexpr int LC_LP = 160;

#define LDS_WAIT() asm volatile("s_waitcnt lgkmcnt(0)" ::: "memory")
#define VM_WAIT() asm volatile("s_waitcnt vmcnt(0)" ::: "memory")
#define RLX_AGENT __ATOMIC_RELAXED, __HIP_MEMORY_SCOPE_AGENT

__device__ __forceinline__ unsigned f2bf(float f) { unsigned u = __builtin_bit_cast(unsigned, f); return (u + 0x7fffu + ((u >> 16) & 1u)) >> 16; }
__device__ __forceinline__ unsigned pk2(float lo, float hi) { return f2bf(lo) | (f2bf(hi) << 16); }
__device__ __forceinline__ float bf2f(unsigned short b) { return __builtin_bit_cast(float, (unsigned)b << 16); }
template <int CTRL> __device__ __forceinline__ float dpp_mov(float v) { return __builtin_bit_cast(float, __builtin_amdgcn_update_dpp(0, __builtin_bit_cast(int, v), CTRL, 0xf, 0xf, true)); }
__device__ __forceinline__ float wave_sum(float v) {
    v += dpp_mov<0xB1>(v); v += dpp_mov<0x4E>(v); v += dpp_mov<0x141>(v); v += dpp_mov<0x140>(v);
    { auto rr = __builtin_amdgcn_permlane16_swap(__float_as_uint(v), __float_as_uint(v), false, false); v = __uint_as_float(rr[0]) + __uint_as_float(rr[1]); }
    { auto rr = __builtin_amdgcn_permlane32_swap(__float_as_uint(v), __float_as_uint(v), false, false); v = __uint_as_float(rr[0]) + __uint_as_float(rr[1]); }
    return v;
}


__device__ __forceinline__ unsigned fp8_byte(float v) { return (unsigned)__builtin_amdgcn_cvt_pk_fp8_f32(v, v, 0, false) & 0xffu; }
__device__ __forceinline__ unsigned quad_pack_bytes(unsigned b) {
    const unsigned x0 = (unsigned)__builtin_amdgcn_update_dpp(0, (int)b, 0x00, 0xf, 0xf, true), x1 = (unsigned)__builtin_amdgcn_update_dpp(0, (int)b, 0x55, 0xf, 0xf, true);
    const unsigned x2 = (unsigned)__builtin_amdgcn_update_dpp(0, (int)b, 0xAA, 0xf, 0xf, true), x3 = (unsigned)__builtin_amdgcn_update_dpp(0, (int)b, 0xFF, 0xf, 0xf, true);
    return x0 | (x1 << 8) | (x2 << 16) | (x3 << 24);
}
namespace pg8 {
#define PG8_LAS __attribute__((address_space(3)))
typedef unsigned short bf16_t;
typedef short bf16x8 __attribute__((ext_vector_type(8)));
typedef float f32x4 __attribute__((ext_vector_type(4)));
typedef unsigned u32x4 __attribute__((ext_vector_type(4)));
constexpr int BM = 256, BK = 64, HALF = 128, HTB = HALF * BK * 2, STAGE_BYTES = 8 * HTB, NXCD = 8, WGM = 8;

__host__ __device__ __forceinline__ int lds_byte(int r, int c) { const int st = (r >> 4) * 2 + (c >> 5), rr = r & 15, cc = c & 31, ob = rr * 64 + cc * 2; return st * 1024 + (ob ^ (((ob >> 9) & 1) << 5)); }
__host__ __device__ __forceinline__ void stage_rc(int b, int& R, int& C) { const int st = b / 1024, sb = b % 1024, swz = sb ^ (((sb >> 9) & 1) << 5); R = (st >> 1) * 16 + swz / 64; C = (st & 1) * 32 + (swz % 64) / 2; }
__host__ __device__ __forceinline__ int perm32(int rho) { const int n = rho >> 4, i = rho & 15; return 8 * (i >> 2) + 4 * n + (i & 3); }

struct Unit { int pm, pn, e, rb; };
struct Gemm { const bf16_t* A; const bf16_t* Bt; int M, N, K; };

struct StaticOrder {
    int nM, nN, nwg, G, c;
    __device__ void init(int M, int N, int G_, int c_) { nM = M / BM; nN = N / BM; nwg = nM * nN; G = G_; c = c_; }
    __device__ bool next(int i, Unit& u) const {
        const long L = (long)i * G + c; if (L >= nwg) return false;
        int wgid = (int)L; { const int q = nwg / NXCD, r = nwg % NXCD, xcd = wgid % NXCD, off = wgid / NXCD; wgid = (xcd < r ? xcd * (q + 1) : r * (q + 1) + (xcd - r) * q) + off; }
        const int nig = WGM * nN, gid = wgid / nig, fm = gid * WGM, gsz = (nM - fm) < WGM ? (nM - fm) : WGM;
        u.pm = fm + ((wgid % nig) % gsz); u.pn = (wgid % nig) / gsz; u.e = 0; u.rb = 0; return true;
    }
    __device__ __forceinline__ unsigned arow(const Unit& u, int rr) const { return (unsigned)(u.pm * BM + rr); }
};

struct MoeOrder {
    const PG8_LAS int* tp; const PG8_LAS int* cn; const PG8_LAS int* lp; const int* list; int G, c, nunits; bool gather; bool xcd;
    __device__ __forceinline__ bool next(int i, Unit& u) const {
        int e_, rb_, pm_, pnl_; bool ok;
        if (xcd) {
            const int x = c & 7, y = c >> 3; const int uidx = i * 32 + y; ok = uidx < lp[4] * 4;
            const int rbl = uidx >> 2; pnl_ = uidx & 3; int j = 0;
#pragma unroll
            for (int q = 1; q < 4; ++q) j += (lp[q] <= rbl) ? 1 : 0;
            e_ = x + 8 * j; rb_ = rbl - lp[j]; pm_ = tp[e_] + rb_;
        } else {
            const int L = i * G + c; ok = L < nunits;
            const int rbg = L >> 2; pnl_ = L & 3; int e = 0;
#pragma unroll
            for (int j = 1; j < 32; ++j) e += (tp[j] <= rbg) ? 1 : 0;
            e_ = e; pm_ = rbg; rb_ = rbg - tp[e];
        }
        u.e = __builtin_amdgcn_readfirstlane(e_); u.rb = __builtin_amdgcn_readfirstlane(rb_); u.pm = __builtin_amdgcn_readfirstlane(pm_); u.pn = __builtin_amdgcn_readfirstlane(e_ * 4 + pnl_);
        return ok;
    }
    __device__ __forceinline__ unsigned arow(const Unit& u, int rr) const {
        if (!gather) return (unsigned)(u.pm * BM + rr);
        const int idx = u.rb * BM + rr; unsigned t = 0u;
        if (idx < cn[u.e]) t = (unsigned)list[(size_t)u.e * 32768 + idx];
        return t;
    }
};

__device__ __forceinline__ unsigned cvt_pk_bf16(float lo, float hi) { unsigned r; asm volatile("v_cvt_pk_bf16_f32 %0, %1, %2" : "=v"(r) : "v"(lo), "v"(hi)); return r; }

struct EpiBf16 {
    static constexpr bool PERM = true;
    bf16_t* O; int ldc; int split_cols; size_t split_stride; float scale0; int pn_mask; bool f8;
    __device__ __forceinline__ void operator()(const f32x4 (&acc)[2][2][4][2], const Unit& u, int wr, int wc, int fr, int fq) const {
        const int row0 = u.pm * BM + wr * 64 + fr; int colt = (u.pn & pn_mask) * BM; bf16_t* base = O;
        float sc = 1.f; if (split_cols) { const int t = colt / split_cols; base += (size_t)t * split_stride; colt -= t * split_cols; if (t == 0) sc = scale0; }
        if (f8) sc = 8.0f;
        const int col0 = colt + wc * 32 + 8 * fq;
#pragma unroll
        for (int ai = 0; ai < 2; ++ai)
#pragma unroll
            for (int m = 0; m < 4; ++m) { const size_t ro = (size_t)(row0 + ai * HALF + m * 16) * ldc + col0;
#pragma unroll
                for (int bj = 0; bj < 2; ++bj) { f32x4 v0 = acc[ai][bj][m][0] * sc, v1 = acc[ai][bj][m][1] * sc;
                    if (f8) { typedef unsigned u32x2 __attribute__((ext_vector_type(2)));
                        int d0 = __builtin_amdgcn_cvt_pk_fp8_f32(v0[0], v0[1], 0, false); d0 = __builtin_amdgcn_cvt_pk_fp8_f32(v0[2], v0[3], d0, true);
                        int d1 = __builtin_amdgcn_cvt_pk_fp8_f32(v1[0], v1[1], 0, false); d1 = __builtin_amdgcn_cvt_pk_fp8_f32(v1[2], v1[3], d1, true);
                        *(u32x2*)((unsigned char*)base + ro + bj * HALF) = (u32x2){(unsigned)d0, (unsigned)d1};
                    } else {
                    u32x4 w; w.x = cvt_pk_bf16(v0[0], v0[1]); w.y = cvt_pk_bf16(v0[2], v0[3]); w.z = cvt_pk_bf16(v1[0], v1[1]); w.w = cvt_pk_bf16(v1[2], v1[3]);
                    *(u32x4*)(base + ro + bj * HALF) = w; } } }
    }
};
struct EpiRes {
    static constexpr bool PERM = true;
    const float* base32; const bf16_t* base16; bf16_t* out; int ldc;
    __device__ __forceinline__ void operator()(const f32x4 (&acc)[2][2][4][2], const Unit& u, int wr, int wc, int fr, int fq) const {
        const int row0 = u.pm * BM + wr * 64 + fr, col0 = u.pn * BM + wc * 32 + 8 * fq;
#pragma unroll
        for (int ai = 0; ai < 2; ++ai)
#pragma unroll
            for (int m = 0; m < 4; ++m) { const size_t off = (size_t)(row0 + ai * HALF + m * 16) * ldc + col0;
#pragma unroll
                for (int bj = 0; bj < 2; ++bj) { f32x4 b0, b1;
                    if (base32) { b0 = *(const f32x4*)(base32 + off + bj * HALF); b1 = *(const f32x4*)(base32 + off + bj * HALF + 4); }
                    else { const u32x4 w = *(const u32x4*)(base16 + off + bj * HALF);
                        b0 = (f32x4){__builtin_bit_cast(float, w.x << 16), __builtin_bit_cast(float, w.x & 0xffff0000u), __builtin_bit_cast(float, w.y << 16), __builtin_bit_cast(float, w.y & 0xffff0000u)};
                        b1 = (f32x4){__builtin_bit_cast(float, w.z << 16), __builtin_bit_cast(float, w.z & 0xffff0000u), __builtin_bit_cast(float, w.w << 16), __builtin_bit_cast(float, w.w & 0xffff0000u)}; }
                    const f32x4 v0 = b0 + acc[ai][bj][m][0], v1 = b1 + acc[ai][bj][m][1];
                    u32x4 o; o.x = cvt_pk_bf16(v0[0], v0[1]); o.y = cvt_pk_bf16(v0[2], v0[3]); o.z = cvt_pk_bf16(v1[0], v1[1]); o.w = cvt_pk_bf16(v1[2], v1[3]);
                    *(u32x4*)(out + off + bj * HALF) = o; } }
    }
};
struct EpiQKV8 {
    static constexpr bool PERM = true;
    unsigned char* Q8; unsigned char* K8; bf16_t* V; float qscale; bool ktiled;
    __device__ __forceinline__ void operator()(const f32x4 (&acc)[2][2][4][2], const Unit& u, int wr, int wc, int fr, int fq) const {
        const int row0 = u.pm * BM + wr * 64 + fr; const int colt = u.pn * BM; const int t = colt >> 10; const int col0 = (colt & 1023) + wc * 32 + 8 * fq;
        const float sc = t == 0 ? qscale : 1.0f;
#pragma unroll
        for (int ai = 0; ai < 2; ++ai)
#pragma unroll
            for (int m = 0; m < 4; ++m) { const size_t ro = (size_t)(row0 + ai * HALF + m * 16) * 1024 + col0;
#pragma unroll
                for (int bj = 0; bj < 2; ++bj) { const f32x4 v0 = acc[ai][bj][m][0] * sc, v1 = acc[ai][bj][m][1] * sc;
                    if (t == 2) { u32x4 w; w.x = cvt_pk_bf16(v0[0], v0[1]); w.y = cvt_pk_bf16(v0[2], v0[3]); w.z = cvt_pk_bf16(v1[0], v1[1]); w.w = cvt_pk_bf16(v1[2], v1[3]);
                        if (ktiled) { const int mrow = row0 + ai * HALF + m * 16, n = col0 + bj * HALF; const int bh = (mrow >> 13) * 8 + (n >> 7), sq = mrow & 8191, d = n & 127;
                            *(u32x4*)(V + (((size_t)bh * 128 + (sq >> 6)) * 4 + (d >> 5)) * 2048 + (sq & 63) * 32 + (d & 31)) = w; }
                        else *(u32x4*)(V + ro + bj * HALF) = w; }
                    else { int d0 = __builtin_amdgcn_cvt_pk_fp8_f32(v0[0], v0[1], 0, false); d0 = __builtin_amdgcn_cvt_pk_fp8_f32(v0[2], v0[3], d0, true);
                        int d1 = __builtin_amdgcn_cvt_pk_fp8_f32(v1[0], v1[1], 0, false); d1 = __builtin_amdgcn_cvt_pk_fp8_f32(v1[2], v1[3], d1, true);
                        typedef int i32x2 __attribute__((ext_vector_type(2)));
                        if (t == 1 && ktiled) { const int mrow = row0 + ai * HALF + m * 16, n = col0 + bj * HALF; const int strm = ((mrow >> 13) * 8 + (n >> 7)) * 2 + ((n >> 6) & 1), sq = mrow & 8191, dd = n & 63;
                            *(i32x2*)(K8 + ((((size_t)strm * 128 + (sq >> 6)) * 4 + (dd >> 4)) * 64 + (sq & 63)) * 16 + (dd & 15)) = (i32x2){d0, d1}; }
                        else *(i32x2*)((t == 0 ? Q8 : K8) + ro + bj * HALF) = (i32x2){d0, d1}; } } }
    }
};
__device__ __forceinline__ float silu_mul(float a, float b) { return a * b * __builtin_amdgcn_rcpf(1.0f + __builtin_amdgcn_exp2f(-a * 1.4426950408889634f)); }
struct EpiSwiglu {
    static constexpr bool PERM = true;
    bf16_t* O; bool f8;
    __device__ __forceinline__ void operator()(const f32x4 (&acc)[2][2][4][2], const Unit& u, int wr, int wc, int fr, int fq) const {
        const int row0 = u.pm * BM + wr * 64 + fr, col0 = (u.pn & 3) * 128 + wc * 32 + 8 * fq;
#pragma unroll
        for (int ai = 0; ai < 2; ++ai)
#pragma unroll
            for (int m = 0; m < 4; ++m) { const size_t ro = (size_t)(row0 + ai * HALF + m * 16) * 512 + col0;
                const f32x4 a0 = acc[ai][0][m][0], a1 = acc[ai][0][m][1], b0 = acc[ai][1][m][0], b1 = acc[ai][1][m][1];
                if (f8) { typedef unsigned u32x2 __attribute__((ext_vector_type(2)));
                    int d0 = __builtin_amdgcn_cvt_pk_fp8_f32(4.f * silu_mul(a0[0], b0[0]), 4.f * silu_mul(a0[1], b0[1]), 0, false); d0 = __builtin_amdgcn_cvt_pk_fp8_f32(4.f * silu_mul(a0[2], b0[2]), 4.f * silu_mul(a0[3], b0[3]), d0, true);
                    int d1 = __builtin_amdgcn_cvt_pk_fp8_f32(4.f * silu_mul(a1[0], b1[0]), 4.f * silu_mul(a1[1], b1[1]), 0, false); d1 = __builtin_amdgcn_cvt_pk_fp8_f32(4.f * silu_mul(a1[2], b1[2]), 4.f * silu_mul(a1[3], b1[3]), d1, true);
                    *(u32x2*)((unsigned char*)O + ro) = (u32x2){(unsigned)d0, (unsigned)d1};
                } else {
                u32x4 w; w.x = cvt_pk_bf16(silu_mul(a0[0], b0[0]), silu_mul(a0[1], b0[1])); w.y = cvt_pk_bf16(silu_mul(a0[2], b0[2]), silu_mul(a0[3], b0[3]));
                w.z = cvt_pk_bf16(silu_mul(a1[0], b1[0]), silu_mul(a1[1], b1[1])); w.w = cvt_pk_bf16(silu_mul(a1[2], b1[2]), silu_mul(a1[3], b1[3]));
                *(u32x4*)(O + ro) = w; } }
    }
};

template <class Epi, class Sched, bool ALIGN_EPI, bool F8 = false, int SCA = 127, int SCB = 127>
__device__ __forceinline__ void gemm_phase(PG8_LAS unsigned char* lds, const Gemm g, const Sched& S, const Epi& E) {
    const int tid = threadIdx.x, wid = __builtin_amdgcn_readfirstlane(tid >> 6), lane = tid & 63, wr = wid >> 2, wc = wid & 3, fr = lane & 15, fq = lane >> 4;
    const int K = g.K, nt = K / BK;
    int RA[2], CA[2]; unsigned voffB[2];
#pragma unroll
    for (int i = 0; i < 2; ++i) { int R, C; stage_rc(tid * 16 + i * 8192, R, C); RA[i] = R; CA[i] = C; const int Rb = Epi::PERM ? ((R & ~31) + perm32(R & 31)) : R; voffB[i] = (unsigned)(Rb * K + C) * 2u; }
    const size_t kstep = (size_t)(BK * 2);
    const size_t hstep = (size_t)HALF * K * 2;
    const size_t tstep = 2 * hstep;
    const unsigned ldsw = (unsigned)wid * 1024u;
    const int aoff = lds_byte(wr * 64 + fr, fq * 8), boff = lds_byte(wc * 32 + fr, fq * 8);
#define PG8_SA(b, h) (((b) * 2 + (h)) * HTB)
#define PG8_SB(b, h) ((4 + (b) * 2 + (h)) * HTB)
#define PG8_STAGE(bufoff, gbase, voff) do { _Pragma("unroll") for (int _i = 0; _i < 2; ++_i) \
        __builtin_amdgcn_global_load_lds((const unsigned*)((const char*)(gbase) + (voff)[_i]), (PG8_LAS unsigned*)(lds + (bufoff) + ldsw + _i * 8192), 16, 0, 0); } while (0)
#define PG8_LD8(p_) ({ typedef int v4i_ __attribute__((ext_vector_type(4))); const v4i_ lo_ = *(const PG8_LAS v4i_*)(p_), hi_ = *(const PG8_LAS v4i_*)((p_) + 1024); __builtin_shufflevector(lo_, hi_, 0, 1, 2, 3, 4, 5, 6, 7); })
#define PG8_LDA(dst, b, h) do { if (F8) { _Pragma("unroll") for (int m = 0; m < 4; ++m) dst##8[m] = PG8_LD8(lds + PG8_SA(b, h) + aoff + m * 2048); } \
        else { _Pragma("unroll") for (int m = 0; m < 4; ++m) _Pragma("unroll") for (int k = 0; k < 2; ++k) dst[m][k] = *(const PG8_LAS bf16x8*)(lds + PG8_SA(b, h) + aoff + m * 2048 + k * 1024); } } while (0)
#define PG8_LDB(dst, b, h) do { if (F8) { _Pragma("unroll") for (int n = 0; n < 2; ++n) dst##8[n] = PG8_LD8(lds + PG8_SB(b, h) + boff + n * 2048); } \
        else { _Pragma("unroll") for (int n = 0; n < 2; ++n) _Pragma("unroll") for (int k = 0; k < 2; ++k) dst[n][k] = *(const PG8_LAS bf16x8*)(lds + PG8_SB(b, h) + boff + n * 2048 + k * 1024); } } while (0)
#define PG8_MMA(ai, bj, At, Bt) do { __builtin_amdgcn_s_setprio(1); \
        if (F8) { _Pragma("unroll") for (int m = 0; m < 4; ++m) _Pragma("unroll") for (int n = 0; n < 2; ++n) \
            asm volatile("v_mfma_scale_f32_16x16x128_f8f6f4 %0, %1, %2, %0, %3, %4 op_sel_hi:[0,0,0]" : "+v"(acc[ai][bj][m][n]) : "v"(Bt##8[n]), "v"(At##8[m]), "v"(scb_), "v"(sca_)); } \
        else { _Pragma("unroll") for (int m = 0; m < 4; ++m) _Pragma("unroll") for (int n = 0; n < 2; ++n) _Pragma("unroll") for (int k = 0; k < 2; ++k) \
        acc[ai][bj][m][n] = __builtin_amdgcn_mfma_f32_16x16x32_bf16(Bt[n][k], At[m][k], acc[ai][bj][m][n], 0, 0, 0); } __builtin_amdgcn_s_setprio(0); } while (0)
#define PG8_WAIT_V(n) asm volatile("s_waitcnt vmcnt(" #n ")" ::: "memory")
#define PG8_WAIT_L(n) asm volatile("s_waitcnt lgkmcnt(" #n ")" ::: "memory")
#define PG8_BAR __builtin_amdgcn_s_barrier()
#define PG8_SCHED __builtin_amdgcn_sched_barrier(0)
#define PG8_AOFF(dst, u) do { _Pragma("unroll") for (int _h = 0; _h < 2; ++_h) _Pragma("unroll") for (int _i = 0; _i < 2; ++_i) dst[_h][_i] = (S.arow(u, _h * HALF + RA[_i]) * (unsigned)K + (unsigned)CA[_i]) * 2u; } while (0)
    Unit cur, nxt; int ui = 0;
    if (!S.next(0, cur)) return;
    f32x4 acc[2][2][4][2];
#pragma unroll
    for (int a = 0; a < 2; ++a)
#pragma unroll
        for (int b = 0; b < 2; ++b)
#pragma unroll
            for (int m = 0; m < 4; ++m)
#pragma unroll
                for (int n = 0; n < 2; ++n) acc[a][b][m][n] = (f32x4){0.f, 0.f, 0.f, 0.f};
    bf16x8 At[4][2], B0[2][2], B1[2][2]; v8i At8[4], B08[2], B18[2]; const int sca_ = SCA * 0x01010101, scb_ = SCB * 0x01010101;
    unsigned offc[2][2], offn[2][2];
    PG8_AOFF(offc, cur);
    const char* const cA = (const char*)g.A; const char* cB = (const char*)g.Bt + (size_t)cur.pn * tstep;
    PG8_STAGE(PG8_SB(0, 0), cB, voffB); PG8_STAGE(PG8_SB(0, 1), cB + hstep, voffB); PG8_STAGE(PG8_SA(0, 0), cA, offc[0]); PG8_STAGE(PG8_SA(0, 1), cA, offc[1]);
    if (wr == 1) PG8_BAR;
    PG8_WAIT_V(2); PG8_BAR;
    PG8_STAGE(PG8_SB(1, 0), cB + kstep, voffB); PG8_STAGE(PG8_SA(1, 0), cA + kstep, offc[0]); PG8_STAGE(PG8_SB(1, 1), cB + hstep + kstep, voffB);
    PG8_WAIT_V(6); PG8_BAR;
    for (;;) {
        const bool has_next = S.next(ui + 1, nxt);
        if (has_next) { PG8_AOFF(offn, nxt); }
        else {
#pragma unroll
            for (int h = 0; h < 2; ++h)
#pragma unroll
                for (int i = 0; i < 2; ++i) offn[h][i] = offc[h][i]; }
        const char* nB = has_next ? (const char*)g.Bt + (size_t)nxt.pn * tstep : cB;
        for (int t = 0; t < nt; t += 2) {
            const bool last = (t == nt - 2);
            const char* a1 = cA + (size_t)(t + 1) * kstep;
            const char* a2 = last ? cA : cA + (size_t)(t + 2) * kstep; const char* b2 = last ? nB : cB + (size_t)(t + 2) * kstep;
            const char* a3 = a2 + kstep; const char* b3 = b2 + kstep;
            unsigned o2[2][2];
#pragma unroll
            for (int h = 0; h < 2; ++h)
#pragma unroll
                for (int i = 0; i < 2; ++i) o2[h][i] = last ? offn[h][i] : offc[h][i];
            PG8_LDB(B0, 0, 0); PG8_LDB(B1, 0, 1); PG8_SCHED; PG8_LDA(At, 0, 0); PG8_STAGE(PG8_SA(1, 1), a1, offc[1]);
            PG8_WAIT_V(8); PG8_WAIT_L(0); PG8_BAR; PG8_MMA(0, 0, At, B0); PG8_MMA(0, 1, At, B1); PG8_BAR; PG8_SCHED;
            PG8_LDA(At, 0, 1); PG8_STAGE(PG8_SB(0, 0), b2, voffB); PG8_STAGE(PG8_SB(0, 1), b2 + hstep, voffB); PG8_STAGE(PG8_SA(0, 0), a2, o2[0]);
            PG8_WAIT_V(8); PG8_WAIT_L(0); PG8_BAR; PG8_MMA(1, 0, At, B0); PG8_MMA(1, 1, At, B1); PG8_BAR; PG8_SCHED;
            PG8_LDB(B0, 1, 0); PG8_LDB(B1, 1, 1); PG8_SCHED; PG8_LDA(At, 1, 0); PG8_STAGE(PG8_SA(0, 1), a2, o2[1]);
            PG8_WAIT_V(8); PG8_WAIT_L(0); PG8_BAR; PG8_MMA(0, 0, At, B0); PG8_MMA(0, 1, At, B1); PG8_BAR; PG8_SCHED;
            PG8_LDA(At, 1, 1); PG8_STAGE(PG8_SB(1, 0), b3, voffB); PG8_STAGE(PG8_SB(1, 1), b3 + hstep, voffB); PG8_STAGE(PG8_SA(1, 0), a3, o2[0]);
            PG8_WAIT_V(8); PG8_WAIT_L(0); PG8_BAR; PG8_MMA(1, 0, At, B0); PG8_MMA(1, 1, At, B1); PG8_BAR; PG8_SCHED;
        }
        if constexpr (ALIGN_EPI) { if (wr == 0) PG8_BAR; }
        if (F8) asm volatile("s_nop 15\n\ts_nop 15" ::: "memory");
        E(acc, cur, wr, wc, fr, fq);
        if (!has_next) break;
#pragma unroll
        for (int a = 0; a < 2; ++a)
#pragma unroll
            for (int b = 0; b < 2; ++b)
#pragma unroll
                for (int m = 0; m < 4; ++m)
#pragma unroll
                    for (int n = 0; n < 2; ++n) acc[a][b][m][n] = (f32x4){0.f, 0.f, 0.f, 0.f};
        cur = nxt; cB = nB; ++ui;
#pragma unroll
        for (int h = 0; h < 2; ++h)
#pragma unroll
            for (int i = 0; i < 2; ++i) offc[h][i] = offn[h][i];
        if constexpr (ALIGN_EPI) { if (wr == 1) PG8_BAR; }
    }
    PG8_WAIT_V(0);
    if constexpr (!ALIGN_EPI) { if (wr == 0) PG8_BAR; }
    PG8_BAR;
#undef PG8_SA
#undef PG8_SB
#undef PG8_STAGE
#undef PG8_LDA
#undef PG8_LDB
#undef PG8_MMA
#undef PG8_LD8
#undef PG8_WAIT_V
#undef PG8_WAIT_L
#undef PG8_BAR
#undef PG8_SCHED
#undef PG8_AOFF
}
}

#define XB_TMO      128
#define XB_XCNT(j)  (256  + 64 * (j))
#define XB_XSUB(j)  (1280 + 64 * (j))
#define XB_XGEN(j)  (2304 + 64 * (j))
#define XB_TOP      3328
#define XB_TOPGEN   3392
#define XCD_BAR_WORDS 3456
#define XB_SPIN_CAP (1u << 18)

__device__ __forceinline__ unsigned xb_ld(unsigned* p)              { return __hip_atomic_load(p, __ATOMIC_RELAXED, __HIP_MEMORY_SCOPE_AGENT); }
__device__ __forceinline__ unsigned xb_add(unsigned* p, unsigned v) { return __hip_atomic_fetch_add(p, v, __ATOMIC_RELAXED, __HIP_MEMORY_SCOPE_AGENT); }
__device__ __forceinline__ unsigned xb_xcc_id() { return (unsigned)__builtin_amdgcn_s_getreg((3 << 11) | 20) & 0xFu; }
#define XB_SPIN(cond, bar) do { unsigned _sp = 0; while (cond) { __builtin_amdgcn_s_sleep(1); \
    if ((++_sp & 255u) == 0u) { if (xb_ld(&(bar)[XB_TMO])) break; if (_sp > XB_SPIN_CAP) { atomicAdd(&(bar)[XB_TMO], 1u); break; } } } } while (0)

struct XcdBarrier { unsigned* bar; unsigned x; volatile LAS unsigned* st; };

__device__ __forceinline__ XcdBarrier xcd_barrier_post(unsigned* bar, volatile LAS unsigned* st) {
    XcdBarrier b; b.bar = bar; b.x = xb_xcc_id(); b.st = st;
    if (threadIdx.x == 0) (void)xb_add(&bar[XB_XCNT(b.x)], 1u);
    return b;
}
__device__ __forceinline__ void xcd_barrier_complete(unsigned* bar, unsigned x, unsigned& nloc, unsigned& nx) {
    const unsigned G = gridDim.x * gridDim.y * gridDim.z;
    unsigned sum, cnt, mine, sp = 0u;
    for (;;) {
        sum = 0u; cnt = 0u; mine = 0u;
#pragma unroll
        for (unsigned j = 0; j < 16; ++j) { const unsigned c = xb_ld(&bar[XB_XCNT(j)]); sum += c; cnt += (c > 0u) ? 1u : 0u; mine = (j == x) ? c : mine; }
        if (sum == G) break;
        __builtin_amdgcn_s_sleep(1);
        if ((++sp & 255u) == 0u) { if (xb_ld(&bar[XB_TMO])) break; if (sp > XB_SPIN_CAP) { atomicAdd(&bar[XB_TMO], 1u); break; } }
    }
    nloc = mine > 0u ? mine : 1u; nx = cnt > 0u ? cnt : 1u;
}
__device__ __forceinline__ void xcd_barrier(const XcdBarrier& b) {
    asm volatile("s_waitcnt vmcnt(0)" ::: "memory");
    __syncthreads();
    if (threadIdx.x == 0) {
        unsigned* bar = b.bar;
        __builtin_amdgcn_s_waitcnt(0);
        unsigned nloc = b.st[0], nx = b.st[1];
        if (nloc == 0u) { xcd_barrier_complete(bar, b.x, nloc, nx); b.st[0] = nloc; b.st[1] = nx; }
        const unsigned old = xb_add(&bar[XB_XSUB(b.x)], 1u);
        const unsigned gen = old / nloc;
        if (old + 1u == (gen + 1u) * nloc) {
            __builtin_amdgcn_fence(__ATOMIC_RELEASE, "agent");
            asm volatile("s_waitcnt vmcnt(0)" ::: "memory");
            const unsigned og = xb_add(&bar[XB_TOP], 1u);
            const unsigned tg = og / nx;
            if (og + 1u == (tg + 1u) * nx) xb_add(&bar[XB_TOPGEN], 1u);
            else XB_SPIN(xb_ld(&bar[XB_TOPGEN]) == tg, bar);
            __builtin_amdgcn_fence(__ATOMIC_ACQUIRE, "agent");
            xb_add(&bar[XB_XGEN(b.x)], 1u);
            asm volatile("s_waitcnt vmcnt(0)" ::: "memory");
        } else {
            XB_SPIN(xb_ld(&bar[XB_XGEN(b.x)]) == gen, bar);
            __builtin_amdgcn_fence(__ATOMIC_ACQUIRE, "agent");
            asm volatile("s_waitcnt vmcnt(0)" ::: "memory");
        }
    }
    __syncthreads();
}

template <bool F8 = false>
__device__ __forceinline__ void transpose_item(const float* W, int K, int N, bf16* WT, int kb, int nb, int dst_row0, LAS float* scr, int lane) {
    const int k0 = 64 * kb, n0 = 32 * nb;
#pragma unroll 8
    for (int i = 0; i < 32; ++i) { const int kk = 2 * i + (lane >> 5); scr[kk * 33 + (lane & 31)] = W[(size_t)(k0 + kk) * N + n0 + (lane & 31)]; }
    LDS_WAIT(); asm volatile("" ::: "memory");
    const int c = lane & 7;
#pragma unroll
    for (int j = 0; j < 4; ++j) { const int n = (lane >> 3) + 8 * j; const LAS float* s = scr + (8 * c) * 33 + n;
        if (F8) {
            int d0 = __builtin_amdgcn_cvt_pk_fp8_f32(s[0 * 33] * 32.f, s[1 * 33] * 32.f, 0, false); d0 = __builtin_amdgcn_cvt_pk_fp8_f32(s[2 * 33] * 32.f, s[3 * 33] * 32.f, d0, true);
            int d1 = __builtin_amdgcn_cvt_pk_fp8_f32(s[4 * 33] * 32.f, s[5 * 33] * 32.f, 0, false); d1 = __builtin_amdgcn_cvt_pk_fp8_f32(s[6 * 33] * 32.f, s[7 * 33] * 32.f, d1, true);
            *(GAS v2u*)((unsigned char*)WT + (size_t)(dst_row0 + n) * K + k0 + 8 * c) = (v2u){(unsigned)d0, (unsigned)d1};
        } else {
        v4u o; o.x = pk2(s[0 * 33], s[1 * 33]); o.y = pk2(s[2 * 33], s[3 * 33]); o.z = pk2(s[4 * 33], s[5 * 33]); o.w = pk2(s[6 * 33], s[7 * 33]);
        *(GAS v4u*)(WT + (size_t)(dst_row0 + n) * K + k0 + 8 * c) = o; } }
    LDS_WAIT(); asm volatile("" ::: "memory");
}
template <bool F8 = false>
__device__ __forceinline__ void transpose_plain(const float* W, int K, int N, bf16* WT, LAS float* scr, int gw, int ngw, int lane) {
    const int nblk = N / 32, nitems = (K / 64) * nblk;
    for (int it = gw; it < nitems; it += ngw) { const int kb = it / nblk, nb = it % nblk; transpose_item<F8>(W, K, N, WT, kb, nb, 32 * nb, scr, lane); }
}
__device__ __forceinline__ void transpose_moe(const float* w1, const float* w3, const float* w2, bf16* W13T, bf16* W2T, LAS float* scr, int gw, int ngw, int lane) {
    constexpr int I13 = 16 * 16, I2 = 8 * 32, IPE = 2 * I13 + I2;
    for (int it = gw; it < NEXP * IPE; it += ngw) {
        const int e = it / IPE; int r = it % IPE;
        if (r < 2 * I13) { const int which = r / I13; r %= I13; const int kb = r / 16, nb = r % 16, n0 = 32 * nb;
            const float* W = (which ? w3 : w1) + (size_t)e * 1024 * 512;
            transpose_item<MOE_FP8 != 0>(W, 1024, 512, (bf16*)((unsigned char*)W13T + (size_t)e * 1024 * 1024 * (MOE_FP8 ? 1 : 2)), kb, nb, (n0 >> 7) * 256 + which * 128 + (n0 & 127), scr, lane);
        } else { r -= 2 * I13; const int kb = r / 32, nb = r % 32;
            transpose_item<MOE_FP8 != 0>(w2 + (size_t)e * 512 * 1024, 512, 1024, (bf16*)((unsigned char*)W2T + (size_t)e * 1024 * 512 * (MOE_FP8 ? 1 : 2)), kb, nb, 32 * nb, scr, lane); }
    }
}
__device__ __forceinline__ void rms_row(const float* xrow, const float* g, f32x4 (&v)[4], int lane) {
    const GAS f32x4* xr = (const GAS f32x4*)xrow + lane; const GAS f32x4* gr = (const GAS f32x4*)g + lane;
    float s = 0.f;
#pragma unroll
    for (int j = 0; j < 4; ++j) { v[j] = xr[64 * j]; s += (v[j].x * v[j].x + v[j].y * v[j].y) + (v[j].z * v[j].z + v[j].w * v[j].w); }
    const float rstd = 1.0f / sqrtf(wave_sum(s) * (1.f / DM) + 1e-6f);
#pragma unroll
    for (int j = 0; j < 4; ++j) { const f32x4 gg = gr[64 * j]; v[j] = v[j] * rstd * gg; }
}
__device__ __forceinline__ void rms_row_b16(const bf16* xrow, const float* g, f32x4 (&v)[4], int lane) {
    const GAS v2u* xr = (const GAS v2u*)xrow + lane; const GAS f32x4* gr = (const GAS f32x4*)g + lane;
    float s = 0.f;
#pragma unroll
    for (int j = 0; j < 4; ++j) { const v2u w = xr[64 * j]; v[j] = (f32x4){__builtin_bit_cast(float, w.x << 16), __builtin_bit_cast(float, w.x & 0xffff0000u), __builtin_bit_cast(float, w.y << 16), __builtin_bit_cast(float, w.y & 0xffff0000u)};
        s += (v[j].x * v[j].x + v[j].y * v[j].y) + (v[j].z * v[j].z + v[j].w * v[j].w); }
    const float rstd = 1.0f / sqrtf(wave_sum(s) * (1.f / DM) + 1e-6f);
#pragma unroll
    for (int j = 0; j < 4; ++j) { const f32x4 gg = gr[64 * j]; v[j] = v[j] * rstd * gg; }
}
__device__ __forceinline__ void store_row_bf16(bf16* orow, const f32x4 (&v)[4], int lane) {
    GAS unsigned long long* o8 = (GAS unsigned long long*)orow + lane;
#pragma unroll
    for (int j = 0; j < 4; ++j) o8[64 * j] = (unsigned long long)pk2(v[j].x, v[j].y) | ((unsigned long long)pk2(v[j].z, v[j].w) << 32);
}

__device__ __forceinline__ int t5_bucket(int rel) {
    const int n = rel < 0 ? -rel : rel; int ret = rel > 0 ? 16 : 0;
    int v;
    if (n < 8) v = n;
    else { const float nf = (float)n; int large = 8 + (int)(logf(nf / 8.0f) / 2.772588722239781f * 8.0f); v = large < 15 ? large : 15; }
    return ret + v;
}

__device__ __forceinline__ int crow(int r, int hi) { return (r & 3) + 8 * (r >> 2) + 4 * hi; }
__device__ __forceinline__ unsigned cvtpk(float lo, float hi) { unsigned r; asm volatile("v_cvt_pk_bf16_f32 %0, %1, %2" : "=v"(r) : "v"(lo), "v"(hi)); return r; }
__device__ __forceinline__ s16x4 vtr(const LAS char* p) { typedef short v4i16_t __attribute__((ext_vector_type(4))); return __builtin_bit_cast(s16x4, __builtin_amdgcn_ds_read_tr16_b64_v4i16((LAS v4i16_t*)p)); }

template <int DV, bool BIAS, bool FP8 = false>
__device__ __forceinline__ void attn_unit_v0(const bf16* Qp, int ldq, const bf16* Kp, int ldk, const bf16* Vp, int ldv, bf16* Op, int ldo, const LAS float* btbl, int q0, LAS unsigned char* lds) {
    const int tid = threadIdx.x, lane = tid & 63, r32 = lane & 31, hi = lane >> 5; const int wid = __builtin_amdgcn_readfirstlane(tid >> 6);
    constexpr int ND = DV / 32;
    LAS unsigned char* ldsK = lds; LAS unsigned char* ldsV = lds + 8192; LAS float* wsf = (LAS float*)(lds + 8192 + DV * 128) + wid * 64;
    bf16x8 qr[4]; v8i q8 = {0, 0, 0, 0, 0, 0, 0, 0};
    if (FP8) { const v4u a = *(const v4u*)((const unsigned char*)Qp + (size_t)(wid * 32 + r32) * ldq + hi * 32), b = *(const v4u*)((const unsigned char*)Qp + (size_t)(wid * 32 + r32) * ldq + hi * 32 + 16);
        q8 = (v8i){(int)a.x, (int)a.y, (int)a.z, (int)a.w, (int)b.x, (int)b.y, (int)b.z, (int)b.w}; }
    else {
#pragma unroll
    for (int d0 = 0; d0 < 4; ++d0) qr[d0] = *(const bf16x8*)(Qp + (size_t)(wid * 32 + r32) * ldq + d0 * 16 + hi * 8); }
    f32x16 o[ND];
#pragma unroll
    for (int d = 0; d < ND; ++d)
#pragma unroll
        for (int r = 0; r < 16; ++r) o[d][r] = 0.f;
    float l = 0.f;
    const int qpos = q0 + wid * 32 + r32;
    const LAS char* kp0 = (const LAS char*)ldsK + hi * 1024 + r32 * 16;
    const LAS char* vp0 = (const LAS char*)ldsV + ((lane >> 4) & 1) * 32 + (lane & 3) * 8 + (4 * hi + ((lane & 15) >> 2)) * 64;
    for (int t = 0; t < SEQ / 64; ++t) {
        __syncthreads();
        {
            if (FP8) { if (wid < 4) { const v4u kv = *(const v4u*)((const unsigned char*)Kp + (size_t)(t * 64 + lane) * ldk + wid * 16); *(LAS v4u*)(ldsK + wid * 1024 + lane * 16) = kv; } }
            else { const v4u kv = *(const v4u*)(Kp + (size_t)(t * 64 + lane) * ldk + wid * 8);
            *(LAS v4u*)(ldsK + wid * 1024 + lane * 16) = kv; }
#pragma unroll
            for (int pp = 0; pp < ND / 2; ++pp) { const int p = wid + 8 * pp, dq = p >> 2, rg = p & 3;
                const v4u vv = *(const v4u*)(Vp + (size_t)(t * 64 + 16 * rg + (lane >> 2)) * ldv + dq * 32 + (lane & 3) * 8);
                *(LAS v4u*)(ldsV + p * 1024 + lane * 16) = vv; }
        }
        __syncthreads();
        f32x16 p0, p1;
#pragma unroll
        for (int r = 0; r < 16; ++r) { p0[r] = 0.f; p1[r] = 0.f; }
        if (FP8) {
            const LAS char* k8 = (const LAS char*)ldsK + hi * 2048 + r32 * 16;
            const v4u a0 = *(const LAS v4u*)(k8), a1 = *(const LAS v4u*)(k8 + 1024), b0 = *(const LAS v4u*)(k8 + 512), b1 = *(const LAS v4u*)(k8 + 1024 + 512);
            const v8i ka = (v8i){(int)a0.x, (int)a0.y, (int)a0.z, (int)a0.w, (int)a1.x, (int)a1.y, (int)a1.z, (int)a1.w};
            const v8i kb = (v8i){(int)b0.x, (int)b0.y, (int)b0.z, (int)b0.w, (int)b1.x, (int)b1.y, (int)b1.z, (int)b1.w};
            p0 = __builtin_amdgcn_mfma_scale_f32_32x32x64_f8f6f4(ka, q8, p0, 0, 0, 0, 0x7f7f7f7f, 0, 0x7c7c7c7c);
            p1 = __builtin_amdgcn_mfma_scale_f32_32x32x64_f8f6f4(kb, q8, p1, 0, 0, 0, 0x7f7f7f7f, 0, 0x7c7c7c7c);
        } else {
#pragma unroll
        for (int d0 = 0; d0 < 4; ++d0) {
            const bf16x8 b0 = *(const LAS bf16x8*)(kp0 + d0 * 2048), b1 = *(const LAS bf16x8*)(kp0 + d0 * 2048 + 512);
            p0 = __builtin_amdgcn_mfma_f32_32x32x16_bf16(b0, qr[d0], p0, 0, 0, 0);
            p1 = __builtin_amdgcn_mfma_f32_32x32x16_bf16(b1, qr[d0], p1, 0, 0, 0);
        } }
        if (BIAS) {
            const int base = t * 64 + 4 * hi - qpos;
#pragma unroll
            for (int r = 0; r < 16; ++r) { int rel = base + (r & 3) + 8 * (r >> 2);
                int i0 = rel < -128 ? -128 : (rel > 128 ? 128 : rel); int rel1 = rel + 32; int i1 = rel1 < -128 ? -128 : (rel1 > 128 ? 128 : rel1);
                p0[r] += btbl[i0 + 128]; p1[r] += btbl[i1 + 128]; }
        }
        float sacc = 0.f;
#pragma unroll
        for (int r = 0; r < 16; ++r) { p0[r] = __builtin_amdgcn_exp2f(p0[r]); p1[r] = __builtin_amdgcn_exp2f(p1[r]); sacc += p0[r] + p1[r]; }
        l += sacc;
        v4u pw[4];
#pragma unroll
        for (int k = 0; k < 2; ++k) {
            pw[k]     = (v4u){cvtpk(p0[8 * k + 0], p0[8 * k + 1]), cvtpk(p0[8 * k + 2], p0[8 * k + 3]), cvtpk(p0[8 * k + 4], p0[8 * k + 5]), cvtpk(p0[8 * k + 6], p0[8 * k + 7])};
            pw[2 + k] = (v4u){cvtpk(p1[8 * k + 0], p1[8 * k + 1]), cvtpk(p1[8 * k + 2], p1[8 * k + 3]), cvtpk(p1[8 * k + 4], p1[8 * k + 5]), cvtpk(p1[8 * k + 6], p1[8 * k + 7])};
        }
#pragma unroll
        for (int d0 = 0; d0 < ND; ++d0)
#pragma unroll
            for (int ks = 0; ks < 4; ++ks) {
                const s16x4 lo = vtr(vp0 + d0 * 4096 + ks * 1024), hh = vtr(vp0 + d0 * 4096 + ks * 1024 + 512);
                const bf16x8 vf = (bf16x8){lo[0], lo[1], lo[2], lo[3], hh[0], hh[1], hh[2], hh[3]};
                o[d0] = __builtin_amdgcn_mfma_f32_32x32x16_bf16(__builtin_bit_cast(bf16x8, pw[ks]), vf, o[d0], 0, 0, 0);
            }
    }
    l += __shfl_xor(l, 32);
    if (hi == 0) wsf[r32] = l;
    LDS_WAIT(); asm volatile("" ::: "memory");
#pragma unroll
    for (int r = 0; r < 16; ++r) { const int row = crow(r, hi); const float rl = 1.0f / wsf[row];
#pragma unroll
        for (int d0 = 0; d0 < ND; ++d0) Op[(size_t)(wid * 32 + row) * ldo + d0 * 32 + r32] = (bf16)f2bf(o[d0][r] * rl); }
    LDS_WAIT();
}

namespace at1 {
#define SBAR() __builtin_amdgcn_sched_barrier(0)
#define PIN(x) asm volatile("" : "+v"(x))
template <int N, bool NOBAR = false> __device__ __forceinline__ void wait_bar() { if (NOBAR) asm volatile("s_waitcnt vmcnt(%0) lgkmcnt(0)" :: "n"(N) : "memory"); else asm volatile("s_waitcnt vmcnt(%0) lgkmcnt(0)\n\ts_barrier" :: "n"(N) : "memory"); }
__device__ __forceinline__ void glds16(const void* gsrc, unsigned lds_dst) { unsigned keep;
    asm volatile("s_mov_b32 %0, m0\n\ts_mov_b32 m0, %2\n\ts_nop 0\n\tglobal_load_lds_dwordx4 %1, off\n\ts_mov_b32 m0, %0" : "=&s"(keep) : "v"(gsrc), "s"(lds_dst) : "memory"); }
typedef float f32x2_t __attribute__((ext_vector_type(2))); typedef __bf16 bf16x2_t __attribute__((ext_vector_type(2)));
__device__ __forceinline__ unsigned cvtpk_s(float lo, float hi) { f32x2_t v = {lo, hi}; bf16x2_t b = __builtin_convertvector(v, bf16x2_t); return __builtin_bit_cast(unsigned, b); }
typedef const LAS char* lds_cptr;
__device__ __forceinline__ void kload2(bf16x8* kf, lds_cptr kp, int j) { kf[2 * j] = *(const LAS bf16x8*)(kp + j * 2048); kf[2 * j + 1] = *(const LAS bf16x8*)(kp + j * 2048 + 512); }

template <int DV, bool FP8> __host__ __device__ constexpr int lds_ws_off() { return (3 * (FP8 ? 4096 : 8192) + 3 * DV * 128) > 512 * DV ? (3 * (FP8 ? 4096 : 8192) + 3 * DV * 128) : 512 * DV; }
template <int DV, bool FP8> __host__ __device__ constexpr int lds_tbl_off() { return lds_ws_off<DV, FP8>() + 2048; }
template <int DV, bool BIAS, int TEST = 0, int MODE = 0, bool FP8 = false, bool TILED = false>
__device__ __forceinline__ void attn_unit(const bf16* Qp, int ldq, const bf16* __restrict__ Kp, int ldk, const bf16* __restrict__ Vp, int ldv, bf16* Op, int ldo, int q0, LAS unsigned char* lds, const LAS float* sgt = nullptr) {
    constexpr int ND = DV / 32, NV = ND / 2, VSLOT = DV * 128, KSLOT = FP8 ? 4096 : 8192, NT = SEQ / 64;
    constexpr int LDS_K = 0, LDS_V = 3 * KSLOT, LDS_WS = lds_ws_off<DV, FP8>(), LDS_TBL = LDS_WS + 2048;
    static_assert(LDS_WS >= LDS_V + 3 * VSLOT && LDS_WS >= 512 * DV && LDS_TBL + 2048 <= STASH_OFF, "LDS map");
    const int tid = threadIdx.x, lane = tid & 63, r32 = lane & 31, hi = lane >> 5; const int wid = __builtin_amdgcn_readfirstlane(tid >> 6);
    const unsigned lds0 = (unsigned)(uintptr_t)lds;
    LAS float* wsf = (LAS float*)(lds + LDS_WS) + wid * 64;
    const LAS float* btbl = (const LAS float*)(lds + LDS_TBL);
    const unsigned char* ksrc = TILED ? (const unsigned char*)Kp + (wid & 3) * 1024 + lane * 16 : FP8 ? (const unsigned char*)Kp + (size_t)lane * ldk + (wid & 3) * 16 : (const unsigned char*)(Kp + (size_t)lane * ldk + wid * 8);
    const bf16* vsrc0 = TILED ? Vp + wid * 512 + lane * 8 : Vp + (size_t)(16 * (wid & 3) + (lane >> 2)) * ldv + (wid >> 2) * 32 + (lane & 3) * 8;
    const bf16* vsrc1 = TILED ? vsrc0 + 4096 : vsrc0 + 64;
    const unsigned kdst = lds0 + LDS_K + wid * 1024, vdst = lds0 + LDS_V + wid * 1024;
#define DMA_K(t, s) if (!(TEST & 8) && (!FP8 || wid < 4)) glds16(ksrc + (size_t)(t) * (TILED ? 4096 : 64 * ldk * (FP8 ? 1 : 2)), (unsigned)__builtin_amdgcn_readfirstlane(kdst + (s) * KSLOT))
#define DMA_V(t, s) do { if (TEST & 8) break; glds16(vsrc0 + (size_t)(t) * (TILED ? (size_t)(DV * 64) : (size_t)64 * ldv), (unsigned)__builtin_amdgcn_readfirstlane(vdst + (s) * VSLOT)); \
        if (NV == 2) glds16(vsrc1 + (size_t)(t) * (TILED ? (size_t)(DV * 64) : (size_t)64 * ldv), (unsigned)__builtin_amdgcn_readfirstlane(vdst + (s) * VSLOT + 8192)); } while (0)
    const lds_cptr kp0 = (lds_cptr)lds + LDS_K + hi * (FP8 ? 2048 : 1024) + r32 * 16;
    const lds_cptr vp0 = (lds_cptr)lds + LDS_V + ((lane >> 4) & 1) * 32 + (lane & 3) * 8 + (4 * hi + ((lane & 15) >> 2)) * 64;
    DMA_K(0, 0); DMA_V(0, 0); DMA_K(1, 1);
    bf16x8 qr[4]; v8i q8 = {0, 0, 0, 0, 0, 0, 0, 0};
    if (FP8) { const unsigned char* qb_ = (const unsigned char*)Qp + (size_t)(wid * 32 + r32) * ldq + hi * 32; const v4u a = *(const v4u*)qb_, b = *(const v4u*)(qb_ + 16);
        q8 = (v8i){(int)a.x, (int)a.y, (int)a.z, (int)a.w, (int)b.x, (int)b.y, (int)b.z, (int)b.w}; }
    else {
#pragma unroll
        for (int d0 = 0; d0 < 4; ++d0) qr[d0] = *(const bf16x8*)(Qp + (size_t)(wid * 32 + r32) * ldq + d0 * 16 + hi * 8); }
    float l_reg = 0.f; f32x16 o[ND];
#pragma unroll
    for (int d = 0; d < ND; ++d) o[d] = f32x16{};
    const f32x16 zero16 = f32x16{};
    const int qw = q0 + wid * 32, qpos = qw + r32;
    int tl = 0, tr = NT; float fL = 1.f;
    if (BIAS) { tl = (qw - 191 >= 0) ? ((qw - 191) >> 6) + 1 : 0; tr = (qw + 158) >> 6; fL = __builtin_amdgcn_exp2f(btbl[0]); }
    f32x16 pA0, pA1, pB0, pB1; bf16x8 kf[8]; v8i kf8[2]; s16x4 vlo[8], vhi[8]; v4u pw0, pw1, pw2, pw3;
#define KLOAD8(n, kp_) do { const v4u a_ = *(const LAS v4u*)((kp_) + (n) * 512), b_ = *(const LAS v4u*)((kp_) + (n) * 512 + 1024); kf8[n] = (v8i){(int)a_.x, (int)a_.y, (int)a_.z, (int)a_.w, (int)b_.x, (int)b_.y, (int)b_.z, (int)b_.w}; } while (0)
#define MF8(kf_, c_) __builtin_amdgcn_mfma_scale_f32_32x32x64_f8f6f4(kf_, q8, c_, 0, 0, 0, 0x7f7f7f7f, 0, 0x7c7c7c7c)
#define WAITB(N) do { if (FP8 && wid >= 4) wait_bar<(N) - 1, (TEST & 16) != 0>(); else wait_bar<(N), (TEST & 16) != 0>(); } while (0)
    if (TEST & 32) { pB0 = f32x16{}; pB1 = f32x16{}; }
    if (TEST & 64) { _Pragma("unroll") for (int i_ = 0; i_ < 8; ++i_) { vlo[i_] = (s16x4){1, 2, 3, 4}; vhi[i_] = (s16x4){4, 3, 2, 1}; } }
    int s_prev = 0, s_cur = 0, s_next = 1;
#define ROT() do { s_prev = s_cur; s_cur = s_next; s_next = (s_next == 2) ? 0 : s_next + 1; } while (0)
#define ADD_BIAS(C0, C1, t) do { if (BIAS && (t) >= tl && (t) <= tr) { const int base_ = (t) * 64 + 4 * hi - qpos; \
        _Pragma("unroll") for (int r = 0; r < 16; ++r) { const int rel0 = base_ + (r & 3) + 8 * (r >> 2); const int rel1 = rel0 + 32; \
            const int i0 = (rel0 < -128 ? -128 : (rel0 > 128 ? 128 : rel0)) + 128, i1 = (rel1 < -128 ? -128 : (rel1 > 128 ? 128 : rel1)) + 128; \
            C0[r] += btbl[i0]; C1[r] += btbl[i1]; } } } while (0)
    DMA_K(2, 2);
    if (FP8) wait_bar<0, (TEST & 16) != 0>(); else wait_bar<NV + 2, (TEST & 16) != 0>();
    {
        if (FP8) { KLOAD8(0, kp0); KLOAD8(1, kp0); pA0 = MF8(kf8[0], zero16); pA1 = MF8(kf8[1], zero16); }
        else {
#pragma unroll
        for (int j = 0; j < 4; ++j) kload2(kf, kp0, j);
        pA0 = __builtin_amdgcn_mfma_f32_32x32x16_bf16(kf[0], qr[0], zero16, 0, 0, 0); pA1 = __builtin_amdgcn_mfma_f32_32x32x16_bf16(kf[1], qr[0], zero16, 0, 0, 0);
#pragma unroll
        for (int d0 = 1; d0 < 4; ++d0) { pA0 = __builtin_amdgcn_mfma_f32_32x32x16_bf16(kf[2 * d0], qr[d0], pA0, 0, 0, 0); pA1 = __builtin_amdgcn_mfma_f32_32x32x16_bf16(kf[2 * d0 + 1], qr[d0], pA1, 0, 0, 0); } }
        ADD_BIAS(pA0, pA1, 0);
#pragma unroll
        for (int r = 0; r < 16; ++r) { pA0[r] = __builtin_amdgcn_exp2f(pA0[r]); pA1[r] = __builtin_amdgcn_exp2f(pA1[r]); }
    }
    wait_bar<0, (TEST & 16) != 0>();
    DMA_K(3, 0); DMA_V(1, 1);
    ROT();
    if (FP8) { KLOAD8(0, kp0 + s_cur * KSLOT); KLOAD8(1, kp0 + s_cur * KSLOT); }
    else {
#pragma unroll
    for (int j = 0; j < 4; ++j) kload2(kf, kp0 + s_cur * KSLOT, j); }
    WAITB(1 + NV);
#define PKW(P, B) ((TEST & 256) ? 0x3f803f80u : cvtpk_s(P[B], P[B + 1]))
#define PAF(k) __builtin_bit_cast(bf16x8, pw##k)
#define VFR(i) (bf16x8){vlo[i][0], vlo[i][1], vlo[i][2], vlo[i][3], vhi[i][0], vhi[i][1], vhi[i][2], vhi[i][3]}
#define MF(a, b, c) __builtin_amdgcn_mfma_f32_32x32x16_bf16(a, b, c, 0, 0, 0)
#define GAPA(MFS, A0, A1, A2, A3, W0, W1, PW) do { if (!(TEST & 32)) { MFS; } if (!(TEST & 2)) { sacc += A0; sacc += A1; sacc += A2; sacc += A3; PIN(sacc); } W0; W1; PIN(PW); SBAR(); } while (0)
#define EX(v) ((TEST & 1) ? (v) : __builtin_amdgcn_exp2f(v))
#define GAPB4(MFS, X, B) do { if (!(TEST & 4)) { MFS; } X[B] = EX(X[B]); X[B + 1] = EX(X[B + 1]); X[B + 2] = EX(X[B + 2]); X[B + 3] = EX(X[B + 3]); PIN(X); SBAR(); } while (0)
#define GAPB2(MFS, X, B) do { if (!(TEST & 4)) { MFS; } X[B] = EX(X[B]); X[B + 1] = EX(X[B + 1]); PIN(X); SBAR(); } while (0)
#define VRD(f, s) do { if (TEST & 64) break; vlo[s] = vtr(vp_ + (((f) >> 2) * 4096 + ((f) & 3) * 1024)); vhi[s] = vtr(vp_ + (((f) >> 2) * 4096 + ((f) & 3) * 1024 + 512)); } while (0)
#define KRD(G, j) do { if ((G) && !(TEST & 128)) { if (FP8) { if ((j) < 2) { KLOAD8(j, kp0 + s_next * KSLOT); } } else kload2(kf, kp0 + s_next * KSLOT, j); SBAR(); } } while (0)
#define FO(m) (ND == 2 ? (((m) >> 1) + 4 * ((m) & 1)) : ((((m) & 7) >> 2) + 2 * ((m) >> 3) + 4 * ((m) & 3)))
#define STEP(C0, C1, P0, P1, t, GK, GV, GL) do { SBAR(); \
    const lds_cptr vp_ = vp0 + s_prev * VSLOT; float sacc; \
    if (FP8) { \
      VRD(FO(0), 0); VRD(FO(1), 1); VRD(FO(2), 2); VRD(FO(3), 3); SBAR(); \
      if (!(TEST & 32)) C0 = MF8(kf8[0], zero16); \
      SBAR();   \
      float sa_ = P0[0] + P0[1], sb_ = P0[2] + P0[3], sc_ = P0[4] + P0[5], sd_ = P0[6] + P0[7]; \
      if (!(TEST & 2)) { sa_ += P0[8]; sb_ += P0[9]; sc_ += P0[10]; sd_ += P0[11]; sa_ += P0[12]; sb_ += P0[13]; sc_ += P0[14]; sd_ += P0[15]; } \
      pw0 = (v4u){PKW(P0, 0), PKW(P0, 2), PKW(P0, 4), PKW(P0, 6)}; pw1 = (v4u){PKW(P0, 8), PKW(P0, 10), PKW(P0, 12), PKW(P0, 14)}; PIN(pw0); PIN(pw1); SBAR(); \
      VRD(FO(4), 4); VRD(FO(5), 5); VRD(FO(6), 6); VRD(FO(7), 7); SBAR(); \
      if (!(TEST & 32)) C1 = MF8(kf8[1], zero16); \
      SBAR(); \
      if (!(TEST & 2)) { sa_ += P1[0]; sb_ += P1[1]; sc_ += P1[2]; sd_ += P1[3]; sa_ += P1[4]; sb_ += P1[5]; sc_ += P1[6]; sd_ += P1[7]; \
                         sa_ += P1[8]; sb_ += P1[9]; sc_ += P1[10]; sd_ += P1[11]; sa_ += P1[12]; sb_ += P1[13]; sc_ += P1[14]; sd_ += P1[15]; } \
      sacc = (sa_ + sb_) + (sc_ + sd_); PIN(sacc); \
      pw2 = (v4u){PKW(P1, 0), PKW(P1, 2), PKW(P1, 4), PKW(P1, 6)}; pw3 = (v4u){PKW(P1, 8), PKW(P1, 10), PKW(P1, 12), PKW(P1, 14)}; PIN(pw2); PIN(pw3); SBAR(); \
    } else { \
    VRD(FO(0), 0); SBAR(); sacc = (P0[0] + P0[1]); \
    GAPA(C0 = MF(kf[0], qr[0], zero16), P0[2], P0[3], P0[4], P0[5],     pw0[0] = PKW(P0, 0), pw0[1] = PKW(P0, 2), pw0); \
    VRD(FO(1), 1); SBAR(); GAPA(C1 = MF(kf[1], qr[0], zero16), P0[6], P0[7], P0[8], P0[9],     pw0[2] = PKW(P0, 4), pw0[3] = PKW(P0, 6), pw0); \
    VRD(FO(2), 2); SBAR(); GAPA(C0 = MF(kf[2], qr[1], C0),   P0[10], P0[11], P0[12], P0[13], pw1[0] = PKW(P0, 8), pw1[1] = PKW(P0, 10), pw1); \
    VRD(FO(3), 3); SBAR(); GAPA(C1 = MF(kf[3], qr[1], C1),   P0[14], P0[15], P1[0], P1[1],   pw1[2] = PKW(P0, 12), pw1[3] = PKW(P0, 14), pw1); \
    VRD(FO(4), 4); SBAR(); GAPA(C0 = MF(kf[4], qr[2], C0),   P1[2], P1[3], P1[4], P1[5],     pw2[0] = PKW(P1, 0), pw2[1] = PKW(P1, 2), pw2); \
    VRD(FO(5), 5); SBAR(); GAPA(C1 = MF(kf[5], qr[2], C1),   P1[6], P1[7], P1[8], P1[9],     pw2[2] = PKW(P1, 4), pw2[3] = PKW(P1, 6), pw2); \
    VRD(FO(6), 6); SBAR(); GAPA(C0 = MF(kf[6], qr[3], C0),   P1[10], P1[11], P1[12], P1[13], pw3[0] = PKW(P1, 8), pw3[1] = PKW(P1, 10), pw3); \
    VRD(FO(7), 7); SBAR(); GAPA(C1 = MF(kf[7], qr[3], C1),   P1[14], P1[15], 0.f, 0.f,       pw3[2] = PKW(P1, 12), pw3[3] = PKW(P1, 14), pw3); \
    } \
    l_reg += sacc; \
    if (GK) { DMA_K((t) + 3, s_cur); } if (GV) { DMA_V((t) + 1, s_next); } \
    ADD_BIAS(C0, C1, t); \
    SBAR(); \
    if (ND == 2) { \
        GAPB4(o[0] = MF(PAF(0), VFR(0), o[0]), C0, 0); \
        GAPB4(o[1] = MF(PAF(0), VFR(1), o[1]), C0, 4); \
        KRD(GL, 0); GAPB4(o[0] = MF(PAF(1), VFR(2), o[0]), C0, 8); \
        KRD(GL, 1); GAPB4(o[1] = MF(PAF(1), VFR(3), o[1]), C0, 12); \
        KRD(GL, 2); GAPB4(o[0] = MF(PAF(2), VFR(4), o[0]), C1, 0); \
        KRD(GL, 3); GAPB4(o[1] = MF(PAF(2), VFR(5), o[1]), C1, 4); \
        GAPB4(o[0] = MF(PAF(3), VFR(6), o[0]), C1, 8); \
        GAPB4(o[1] = MF(PAF(3), VFR(7), o[1]), C1, 12); \
    } else { \
        GAPB2(o[0] = MF(PAF(0), VFR(0), o[0]), C0, 0);  VRD(FO(8), 0); SBAR(); \
        GAPB2(o[1] = MF(PAF(0), VFR(1), o[1]), C0, 2);  VRD(FO(9), 1); SBAR(); \
        GAPB2(o[ND - 2] = MF(PAF(0), VFR(2), o[ND - 2]), C0, 4);  VRD(FO(10), 2); SBAR(); \
        GAPB2(o[ND - 1] = MF(PAF(0), VFR(3), o[ND - 1]), C0, 6);  VRD(FO(11), 3); SBAR(); \
        GAPB2(o[0] = MF(PAF(1), VFR(4), o[0]), C0, 8);  VRD(FO(12), 4); SBAR(); \
        GAPB2(o[1] = MF(PAF(1), VFR(5), o[1]), C0, 10); VRD(FO(13), 5); SBAR(); \
        GAPB2(o[ND - 2] = MF(PAF(1), VFR(6), o[ND - 2]), C0, 12); VRD(FO(14), 6); SBAR(); \
        GAPB2(o[ND - 1] = MF(PAF(1), VFR(7), o[ND - 1]), C0, 14); VRD(FO(15), 7); SBAR(); \
        KRD(GL, 0); GAPB2(o[0] = MF(PAF(2), VFR(0), o[0]), C1, 0); \
        GAPB2(o[1] = MF(PAF(2), VFR(1), o[1]), C1, 2); \
        KRD(GL, 1); GAPB2(o[ND - 2] = MF(PAF(2), VFR(2), o[ND - 2]), C1, 4); \
        GAPB2(o[ND - 1] = MF(PAF(2), VFR(3), o[ND - 1]), C1, 6); \
        KRD(GL, 2); GAPB2(o[0] = MF(PAF(3), VFR(4), o[0]), C1, 8); \
        GAPB2(o[1] = MF(PAF(3), VFR(5), o[1]), C1, 10); \
        KRD(GL, 3); GAPB2(o[ND - 2] = MF(PAF(3), VFR(6), o[ND - 2]), C1, 12); \
        GAPB2(o[ND - 1] = MF(PAF(3), VFR(7), o[ND - 1]), C1, 14); \
    } \
    if (BIAS && (t) == tl) { l_reg *= fL; _Pragma("unroll") for (int d_ = 0; d_ < ND; ++d_) _Pragma("unroll") for (int r = 0; r < 16; ++r) o[d_][r] *= fL; } \
    } while (0)
    int t = 1;
    for (; t + 4 < NT; t += 2) {
        STEP(pB0, pB1, pA0, pA1, t, true, true, true);       WAITB(1 + NV); ROT();
        STEP(pA0, pA1, pB0, pB1, t + 1, true, true, true);   WAITB(1 + NV); ROT();
    }
    STEP(pB0, pB1, pA0, pA1, NT - 3, false, true, true);  wait_bar<NV, (TEST & 16) != 0>(); ROT();
    STEP(pA0, pA1, pB0, pB1, NT - 2, false, true, true);  wait_bar<0, (TEST & 16) != 0>();  ROT();
    STEP(pB0, pB1, pA0, pA1, NT - 1, false, false, false);
    {
        float sacc = pB0[0] + pB0[1];
#pragma unroll
        for (int r = 2; r < 16; ++r) sacc += pB0[r];
#pragma unroll
        for (int r = 0; r < 16; ++r) sacc += pB1[r];
        l_reg += sacc;
        pw0 = (v4u){PKW(pB0, 0), PKW(pB0, 2), PKW(pB0, 4), PKW(pB0, 6)}; pw1 = (v4u){PKW(pB0, 8), PKW(pB0, 10), PKW(pB0, 12), PKW(pB0, 14)};
        pw2 = (v4u){PKW(pB1, 0), PKW(pB1, 2), PKW(pB1, 4), PKW(pB1, 6)}; pw3 = (v4u){PKW(pB1, 8), PKW(pB1, 10), PKW(pB1, 12), PKW(pB1, 14)};
        const lds_cptr vp_ = vp0 + s_cur * VSLOT;
#pragma unroll
        for (int d0 = 0; d0 < ND; ++d0) {
            s16x4 a0 = vtr(vp_ + d0 * 4096), b0 = vtr(vp_ + d0 * 4096 + 512), a1 = vtr(vp_ + d0 * 4096 + 1024), b1 = vtr(vp_ + d0 * 4096 + 1536);
            s16x4 a2 = vtr(vp_ + d0 * 4096 + 2048), b2 = vtr(vp_ + d0 * 4096 + 2560), a3 = vtr(vp_ + d0 * 4096 + 3072), b3 = vtr(vp_ + d0 * 4096 + 3584);
            o[d0] = MF(PAF(0), ((bf16x8){a0[0], a0[1], a0[2], a0[3], b0[0], b0[1], b0[2], b0[3]}), o[d0]);
            o[d0] = MF(PAF(1), ((bf16x8){a1[0], a1[1], a1[2], a1[3], b1[0], b1[1], b1[2], b1[3]}), o[d0]);
            o[d0] = MF(PAF(2), ((bf16x8){a2[0], a2[1], a2[2], a2[3], b2[0], b2[1], b2[2], b2[3]}), o[d0]);
            o[d0] = MF(PAF(3), ((bf16x8){a3[0], a3[1], a3[2], a3[3], b3[0], b3[1], b3[2], b3[3]}), o[d0]);
        }
    }
    l_reg += __shfl_xor(l_reg, 32);
    int lane_e = lane; asm volatile("" : "+v"(lane_e));
    const int r32e = lane_e & 31, hie = lane_e >> 5;
    if (hie == 0) wsf[r32e] = l_reg;
    asm volatile("s_waitcnt lgkmcnt(0)\n\ts_barrier" ::: "memory");
    {
        LAS bf16* stg = (LAS bf16*)(MODE == 1 ? lds + STASH_OFF : lds) + wid * (32 * DV);
#pragma unroll
        for (int r = 0; r < 16; ++r) { const int orow = crow(r, hie); const float rl = __builtin_amdgcn_rcpf(wsf[orow]);
#pragma unroll
            for (int d0 = 0; d0 < ND; ++d0) stg[orow * DV + d0 * 32 + r32e] = (bf16)f2bf(o[d0][r] * rl); }
        asm volatile("s_waitcnt lgkmcnt(0)" ::: "memory");
        if (MODE == 0) {
            constexpr int CPR = DV / 8;
#pragma unroll
            for (int i = 0; i < (32 * CPR) / 64; ++i) { const int row = i * (64 / CPR) + lane_e / CPR, ch = lane_e % CPR;
                const v4u v = *(const LAS v4u*)(stg + row * DV + ch * 8); *(v4u*)(Op + (size_t)(wid * 32 + row) * ldo + ch * 8) = v; }
        } else if (MODE == 2) {
            const int row = lane_e >> 1, half = lane_e & 1; const float lam = sgt[128];
            const LAS bf16* s1 = stg + row * DV + half * 64; const LAS bf16* s0 = (const LAS bf16*)(lds + STASH_OFF) + wid * (32 * DV) + row * DV + half * 64;
            float ov[64]; float ss = 0.f;
#pragma unroll
            for (int q = 0; q < 8; ++q) { const v4u a = *(const LAS v4u*)(s0 + q * 8), c = *(const LAS v4u*)(s1 + q * 8);
#pragma unroll
                for (int j = 0; j < 4; ++j) { const float lo = __builtin_bit_cast(float, a[j] << 16) - lam * __builtin_bit_cast(float, c[j] << 16);
                    const float hh = __builtin_bit_cast(float, a[j] & 0xffff0000u) - lam * __builtin_bit_cast(float, c[j] & 0xffff0000u);
                    ov[q * 8 + 2 * j] = lo; ov[q * 8 + 2 * j + 1] = hh; ss += lo * lo + hh * hh; } }
            ss += dpp_mov<0xB1>(ss);
            const float rstd = 1.0f / sqrtf(ss * (1.f / 128.f) + 1e-5f);
            bf16* yo = Op + (size_t)(wid * 32 + row) * ldo + half * 64;
#pragma unroll
            for (int q = 0; q < 8; ++q) { const f32x4 g0 = *(const LAS f32x4*)(sgt + half * 64 + q * 8), g1 = *(const LAS f32x4*)(sgt + half * 64 + q * 8 + 4);
                v4u w; w.x = pk2(ov[q * 8] * rstd * g0.x, ov[q * 8 + 1] * rstd * g0.y); w.y = pk2(ov[q * 8 + 2] * rstd * g0.z, ov[q * 8 + 3] * rstd * g0.w);
                w.z = pk2(ov[q * 8 + 4] * rstd * g1.x, ov[q * 8 + 5] * rstd * g1.y); w.w = pk2(ov[q * 8 + 6] * rstd * g1.z, ov[q * 8 + 7] * rstd * g1.w);
                *(v4u*)(yo + q * 8) = w; }
        }
    }
    asm volatile("s_waitcnt lgkmcnt(0)\n\ts_barrier" ::: "memory");
#undef KLOAD8
#undef MF8
#undef WAITB
#undef DMA_K
#undef DMA_V
#undef ROT
#undef ADD_BIAS
#undef PKW
#undef PAF
#undef VFR
#undef MF
#undef GAPA
#undef EX
#undef GAPB4
#undef GAPB2
#undef VRD
#undef KRD
#undef FO
#undef STEP
}
#undef SBAR
#undef PIN
}

namespace at3 {
#define SBAR() __builtin_amdgcn_sched_barrier(0)
#define PIN(x) asm volatile("" : "+v"(x))
using at1::glds16; using at1::wait_bar;
typedef const LAS char* lds_cptr; typedef short v2s __attribute__((ext_vector_type(2)));
template <int DV> __host__ __device__ constexpr int lds_ws_off() { return (3 * 4096 + 3 * DV * 64) > 512 * DV ? (3 * 4096 + 3 * DV * 64) : 512 * DV; }
template <int DV> __host__ __device__ constexpr int lds_tbl_off() { return lds_ws_off<DV>() + 2048; }
__device__ __forceinline__ void waitb(int n) { if (n == 0) wait_bar<0>(); else if (n == 1) wait_bar<1>(); else wait_bar<2>(); }
__device__ __forceinline__ v8i ld_frag(lds_cptr p, int second) { const v4u a = *(const LAS v4u*)p, b = *(const LAS v4u*)(p + second); return (v8i){(int)a.x, (int)a.y, (int)a.z, (int)a.w, (int)b.x, (int)b.y, (int)b.z, (int)b.w}; }

template <int DV, bool BIAS, int MODE>
__device__ __forceinline__ void attn_unit(const unsigned char* Qp, int ldq, const unsigned char* __restrict__ K8T, const unsigned char* __restrict__ V8T, bf16* Op, int ldo, int q0, LAS unsigned char* lds, const LAS float* sgt) {
    constexpr int ND = DV / 32, VT = DV * 64, KT = 4096, NT = SEQ / 64, NVP = VT / 1024;
    constexpr int LDS_K = 0, LDS_V = 3 * KT, LDS_WS = lds_ws_off<DV>(), LDS_TBL = LDS_WS + 2048;
    static_assert(LDS_WS >= LDS_V + 3 * VT && LDS_WS >= 512 * DV && LDS_TBL + 2048 <= STASH_OFF, "LDS map");
    const int tid = threadIdx.x, lane = tid & 63, r32 = lane & 31, hi = lane >> 5; const int wid = __builtin_amdgcn_readfirstlane(tid >> 6);
    const unsigned lds0 = (unsigned)(uintptr_t)lds;
    LAS float* wsf = (LAS float*)(lds + LDS_WS) + wid * 64;
    const LAS float* btbl = (const LAS float*)(lds + LDS_TBL);
    const bool doK = wid < 4, doV = (NVP == 8) || wid >= 4; const int vpc = (NVP == 8) ? wid : (wid & 3);
    const unsigned char* ksrc = K8T + (wid & 3) * 1024 + lane * 16; const unsigned char* vsrc = V8T + vpc * 1024 + lane * 16;
    const unsigned kdst = lds0 + LDS_K + (wid & 3) * 1024, vdst = lds0 + LDS_V + vpc * 1024;
    const int ndma = (doK ? 1 : 0) + (doV ? 1 : 0);
#define DMA_K(t, s) do { if (doK) glds16(ksrc + (size_t)(t) * KT, (unsigned)__builtin_amdgcn_readfirstlane(kdst + (s) * KT)); } while (0)
#define DMA_V(t, s) do { if (doV) glds16(vsrc + (size_t)(t) * VT, (unsigned)__builtin_amdgcn_readfirstlane(vdst + (s) * VT)); } while (0)
    const lds_cptr kp0 = (lds_cptr)lds + LDS_K + hi * 2048 + r32 * 16;
    const lds_cptr vq0 = (lds_cptr)lds + LDS_V + hi * (2 * DV * 16) + r32 * 16;
    DMA_K(0, 0); DMA_V(0, 0); DMA_K(1, 1);
    v8i q8;
    { const unsigned char* qb_ = Qp + (size_t)(wid * 32 + r32) * ldq + hi * 32; const v4u a = *(const v4u*)qb_, b = *(const v4u*)(qb_ + 16);
      q8 = (v8i){(int)a.x, (int)a.y, (int)a.z, (int)a.w, (int)b.x, (int)b.y, (int)b.z, (int)b.w}; }
    f32x16 lacc = f32x16{}; f32x16 o[ND];
#pragma unroll
    for (int d = 0; d < ND; ++d) o[d] = f32x16{};
    const f32x16 zero16 = f32x16{};
    const v8i ones8 = {0x38383838, 0x38383838, 0x38383838, 0x38383838, 0x38383838, 0x38383838, 0x38383838, 0x38383838};
    const int qw = q0 + wid * 32, qpos = qw + r32;
    int tl = 0, tr = NT; float fL = 1.f;
    if (BIAS) { tl = (qw - 191 >= 0) ? ((qw - 191) >> 6) + 1 : 0; tr = (qw + 158) >> 6; fL = __builtin_amdgcn_exp2f(btbl[0]); }
    f32x16 pA0, pA1, pB0, pB1; v8i kf8[2]; v8i vf[ND]; v8i pa; int sb = 127;
    int s_prev = 0, s_cur = 0, s_next = 1;
#define ROT() do { s_prev = s_cur; s_cur = s_next; s_next = (s_next == 2) ? 0 : s_next + 1; } while (0)
#define MFQK(kf_) __builtin_amdgcn_mfma_scale_f32_32x32x64_f8f6f4(kf_, q8, zero16, 0, 0, 0, 0x7f7f7f7f, 0, 0x7c7c7c7c)
#define MFPV(d_) o[d_] = __builtin_amdgcn_mfma_scale_f32_32x32x64_f8f6f4(pa, vf[d_], o[d_], 0, 0, 0, sb, 0, 0x7f7f7f7f)
#define MFSUM() lacc = __builtin_amdgcn_mfma_scale_f32_32x32x64_f8f6f4(pa, ones8, lacc, 0, 0, 0, sb, 0, 0x7f7f7f7f)
#define ADD_BIAS(C0, C1, t) do { if (BIAS && (t) >= tl && (t) <= tr) { const int base_ = (t) * 64 + 4 * hi - qpos; \
        _Pragma("unroll") for (int r = 0; r < 16; ++r) { const int rel0 = base_ + (r & 3) + 8 * (r >> 2); const int rel1 = rel0 + 32; \
            const int i0 = (rel0 < -128 ? -128 : (rel0 > 128 ? 128 : rel0)) + 128, i1 = (rel1 < -128 ? -128 : (rel1 > 128 ? 128 : rel1)) + 128; \
            C0[r] += btbl[i0]; C1[r] += btbl[i1]; } } } while (0)
#define MX3(a, b, c) __builtin_fmaxf(__builtin_fmaxf((a), (b)), (c))
#define PMAX(P0, P1) do { float a_ = MX3(P0[0], P0[1], P1[0]), b_ = MX3(P0[2], P0[3], P1[1]); a_ = MX3(a_, P1[2], P1[3]); \
        _Pragma("unroll") for (int r = 4; r < 16; r += 4) { a_ = MX3(a_, P0[r], P0[r + 1]); b_ = MX3(b_, P0[r + 2], P0[r + 3]); a_ = MX3(a_, P1[r], P1[r + 1]); b_ = MX3(b_, P1[r + 2], P1[r + 3]); } \
        float mx_ = __builtin_fmaxf(a_, b_); { auto rr_ = __builtin_amdgcn_permlane32_swap(__float_as_uint(mx_), __float_as_uint(mx_), false, false); mx_ = __builtin_fmaxf(__uint_as_float(rr_[0]), __uint_as_float(rr_[1])); } \
        const int em_ = (int)(__float_as_uint(mx_) >> 23) - 7; sb = em_ < 1 ? 1 : em_; } while (0)
#define PCVT(P0, P1) do { const float scf_ = __uint_as_float((unsigned)sb << 23); \
        _Pragma("unroll") for (int k = 0; k < 4; ++k) { v2s w_ = {0, 0}; w_ = __builtin_amdgcn_cvt_scalef32_pk_fp8_f32(w_, P0[4 * k], P0[4 * k + 1], scf_, false); w_ = __builtin_amdgcn_cvt_scalef32_pk_fp8_f32(w_, P0[4 * k + 2], P0[4 * k + 3], scf_, true); pa[k] = __builtin_bit_cast(int, w_); } \
        _Pragma("unroll") for (int k = 0; k < 4; ++k) { v2s w_ = {0, 0}; w_ = __builtin_amdgcn_cvt_scalef32_pk_fp8_f32(w_, P1[4 * k], P1[4 * k + 1], scf_, false); w_ = __builtin_amdgcn_cvt_scalef32_pk_fp8_f32(w_, P1[4 * k + 2], P1[4 * k + 3], scf_, true); pa[4 + k] = __builtin_bit_cast(int, w_); } } while (0)
#define PSUM(P0, P1) do { float s0_ = P0[0] + P0[1], s1_ = P0[2] + P0[3], s2_ = P1[0] + P1[1], s3_ = P1[2] + P1[3]; \
        _Pragma("unroll") for (int r = 4; r < 16; r += 4) { s0_ += P0[r]; s1_ += P0[r + 1]; s2_ += P0[r + 2]; s3_ += P0[r + 3]; s0_ += P1[r]; s1_ += P1[r + 1]; s2_ += P1[r + 2]; s3_ += P1[r + 3]; } \
        l_reg += (s0_ + s1_) + (s2_ + s3_); } while (0)
#define EXPS(X, B, N) do { _Pragma("unroll") for (int r_ = 0; r_ < (N); ++r_) X[(B) + r_] = __builtin_amdgcn_exp2f(X[(B) + r_]); PIN(X); } while (0)
    DMA_K(2, 2);
    wait_bar<0>();
    kf8[0] = ld_frag(kp0, 1024); kf8[1] = ld_frag(kp0 + 512, 1024);
    pA0 = MFQK(kf8[0]); pA1 = MFQK(kf8[1]);
    ADD_BIAS(pA0, pA1, 0);
#pragma unroll
    for (int r = 0; r < 16; ++r) { pA0[r] = __builtin_amdgcn_exp2f(pA0[r]); pA1[r] = __builtin_amdgcn_exp2f(pA1[r]); }
    wait_bar<0>();
    DMA_K(3, 0); DMA_V(1, 1);
    ROT();
    kf8[0] = ld_frag(kp0 + s_cur * KT, 1024); kf8[1] = ld_frag(kp0 + s_cur * KT + 512, 1024);
    waitb(ndma);
#define STEP(C0, C1, P0, P1, t, GK, GV, GL) do { SBAR(); \
    const lds_cptr vp_ = vq0 + s_prev * VT; \
    _Pragma("unroll") for (int d_ = 0; d_ < ND; ++d_) vf[d_] = ld_frag(vp_ + d_ * 512, DV * 16); \
    SBAR(); \
    C0 = MFQK(kf8[0]); SBAR(); \
    PMAX(P0, P1); PIN(sb); SBAR(); \
    C1 = MFQK(kf8[1]); SBAR(); \
    PCVT(P0, P1); PIN(pa); SBAR(); \
    MFSUM(); SBAR(); \
    if (GK) { DMA_K((t) + 3, s_cur); } if (GV) { DMA_V((t) + 1, s_next); } \
    ADD_BIAS(C0, C1, t); \
    SBAR(); \
    if (ND == 2) { \
        MFPV(0); EXPS(C0, 0, 16); SBAR(); \
        if (GL) { kf8[0] = ld_frag(kp0 + s_next * KT, 1024); kf8[1] = ld_frag(kp0 + s_next * KT + 512, 1024); SBAR(); } \
        MFPV(1); EXPS(C1, 0, 16); SBAR(); \
    } else { \
        MFPV(0); EXPS(C0, 0, 8); SBAR(); \
        if (GL) { kf8[0] = ld_frag(kp0 + s_next * KT, 1024); SBAR(); } \
        MFPV(1); EXPS(C0, 8, 8); SBAR(); \
        if (GL) { kf8[1] = ld_frag(kp0 + s_next * KT + 512, 1024); SBAR(); } \
        MFPV(ND - 2); EXPS(C1, 0, 8); SBAR(); \
        MFPV(ND - 1); EXPS(C1, 8, 8); SBAR(); \
    } \
    if (BIAS && (t) == tl) { _Pragma("unroll") for (int r = 0; r < 16; ++r) lacc[r] *= fL; _Pragma("unroll") for (int d_ = 0; d_ < ND; ++d_) _Pragma("unroll") for (int r = 0; r < 16; ++r) o[d_][r] *= fL; } \
    } while (0)
    int t = 1;
    for (; t + 4 < NT; t += 2) {
        STEP(pB0, pB1, pA0, pA1, t, true, true, true);       waitb(ndma); ROT();
        STEP(pA0, pA1, pB0, pB1, t + 1, true, true, true);   waitb(ndma); ROT();
    }
    STEP(pB0, pB1, pA0, pA1, NT - 3, false, true, true);  waitb(doV ? 1 : 0); ROT();
    STEP(pA0, pA1, pB0, pB1, NT - 2, false, true, true);  wait_bar<0>();  ROT();
    STEP(pB0, pB1, pA0, pA1, NT - 1, false, false, false);
    {
        const lds_cptr vp_ = vq0 + s_cur * VT;
#pragma unroll
        for (int d_ = 0; d_ < ND; ++d_) vf[d_] = ld_frag(vp_ + d_ * 512, DV * 16);
        PMAX(pB0, pB1); PCVT(pB0, pB1); MFSUM();
#pragma unroll
        for (int d_ = 0; d_ < ND; ++d_) MFPV(d_);
    }
    int lane_e = lane; asm volatile("" : "+v"(lane_e));
    const int r32e = lane_e & 31, hie = lane_e >> 5;
    asm volatile("s_waitcnt lgkmcnt(0)\n\ts_barrier" ::: "memory");
    {
        LAS bf16* stg = (LAS bf16*)(MODE == 1 ? lds + STASH_OFF : lds) + wid * (32 * DV);
#pragma unroll
        for (int r = 0; r < 16; ++r) { const int orow = crow(r, hie); const float rl = __builtin_amdgcn_rcpf(lacc[r]);
#pragma unroll
            for (int d0 = 0; d0 < ND; ++d0) stg[orow * DV + d0 * 32 + r32e] = (bf16)f2bf(o[d0][r] * rl); }
        asm volatile("s_waitcnt lgkmcnt(0)" ::: "memory");
        if (MODE == 0) {
            constexpr int CPR = DV / 8;
#pragma unroll
            for (int i = 0; i < (32 * CPR) / 64; ++i) { const int row = i * (64 / CPR) + lane_e / CPR, ch = lane_e % CPR;
                const v4u v = *(const LAS v4u*)(stg + row * DV + ch * 8); *(v4u*)(Op + (size_t)(wid * 32 + row) * ldo + ch * 8) = v; }
        } else if (MODE == 2) {
            const int row = lane_e >> 1, half = lane_e & 1; const float lam = sgt[128];
            const LAS bf16* s1 = stg + row * DV + half * 64; const LAS bf16* s0 = (const LAS bf16*)(lds + STASH_OFF) + wid * (32 * DV) + row * DV + half * 64;
            float ov[64]; float ss = 0.f;
#pragma unroll
            for (int q = 0; q < 8; ++q) { const v4u a = *(const LAS v4u*)(s0 + q * 8), c = *(const LAS v4u*)(s1 + q * 8);
#pragma unroll
                for (int j = 0; j < 4; ++j) { const float lo = __builtin_bit_cast(float, a[j] << 16) - lam * __builtin_bit_cast(float, c[j] << 16);
                    const float hh = __builtin_bit_cast(float, a[j] & 0xffff0000u) - lam * __builtin_bit_cast(float, c[j] & 0xffff0000u);
                    ov[q * 8 + 2 * j] = lo; ov[q * 8 + 2 * j + 1] = hh; ss += lo * lo + hh * hh; } }
            ss += dpp_mov<0xB1>(ss);
            const float rstd = 1.0f / sqrtf(ss * (1.f / 128.f) + 1e-5f);
            bf16* yo = Op + (size_t)(wid * 32 + row) * ldo + half * 64;
#pragma unroll
            for (int q = 0; q < 8; ++q) { const f32x4 g0 = *(const LAS f32x4*)(sgt + half * 64 + q * 8), g1 = *(const LAS f32x4*)(sgt + half * 64 + q * 8 + 4);
                v4u w; w.x = pk2(ov[q * 8] * rstd * g0.x, ov[q * 8 + 1] * rstd * g0.y); w.y = pk2(ov[q * 8 + 2] * rstd * g0.z, ov[q * 8 + 3] * rstd * g0.w);
                w.z = pk2(ov[q * 8 + 4] * rstd * g1.x, ov[q * 8 + 5] * rstd * g1.y); w.w = pk2(ov[q * 8 + 6] * rstd * g1.z, ov[q * 8 + 7] * rstd * g1.w);
                *(v4u*)(yo + q * 8) = w; }
        }
    }
    asm volatile("s_waitcnt lgkmcnt(0)\n\ts_barrier" ::: "memory");
#undef DMA_K
#undef DMA_V
#undef ROT
#undef MFQK
#undef MFPV
#undef MFSUM
#undef ADD_BIAS
#undef MX3
#undef PMAX
#undef PCVT
#undef PSUM
#undef EXPS
#undef STEP
}
#undef SBAR
#undef PIN
}

struct Args { const float* in[27]; float* out; unsigned char* ws; int ph_lo, ph_hi, li, pad; };

constexpr int NPHASE = 17;
constexpr int NWAVES = 8;

#define IN(k) (lo <= (k) && (k) < hi_ph)
#define SEAM(k) do { if (IN(k) && IN((k) + 1)) xcd_barrier(bar); } while (0)
template <int layer>
__device__ __forceinline__ void moe_block(const Args& args, LAS unsigned char* lds, const XcdBarrier& bar, int lo, int hi_ph) {
    volatile LAS unsigned* LC = (volatile LAS unsigned*)(lds + LDSCTL_OFF);
    const int tid = threadIdx.x, lane = tid & 63, wave = __builtin_amdgcn_readfirstlane(tid >> 6);
    const int G = gridDim.x, bx = blockIdx.x;
    const int gw = bx * NWAVES + wave, NGW = G * NWAVES;
    unsigned char* ws = args.ws;
    unsigned* ctl = (unsigned*)(ws + WS_CTL);
    float* xres = args.out;
    bf16* XB = (bf16*)(ws + WS_XB);
    bf16* HB = (bf16*)(ws + WS_HB);
    {
        const int pb = layer == 0 ? 5 : 13;
        unsigned* const gcnt0 = ctl + CW_CNT + layer * 64;
        int* list = (int*)(ws + WS_LIST); int* tokep = (int*)(ws + WS_TOKEP); float* gate = (float*)(ws + WS_GATE);
        if (IN(pb)) REP(pb) {
            unsigned* gcnt = gcnt0 + ((MK_N_LAUNCHES == 1 ? (int)((PROBE_MASK >> pb) & 1u) : 0) - rep_) * 128;
            if (rep_ > 0) xcd_barrier(bar);
            const float* gf = args.in[2] + layer * DM;
            const float* WR = (const float*)(ws + WS_TBL) + TBL_WR + layer * WR_LAYER;
            for (int chunk = bx; chunk < NTOK / 128; chunk += G) {
                __syncthreads();
                if (tid < 32) LC[LC_LCNT + tid] = 0u;
                __syncthreads();
                int my_e0 = 0, my_e1 = 0; float my_g0 = 0.f, my_g1 = 0.f;
                {
                    const int ri = lane & 15, kq = lane >> 4; const int r0w = chunk * 128 + wave * 16;
                    const GAS bf16* xrow = (const GAS bf16*)(XB + (size_t)(r0w + ri) * DM) + 8 * kq;
                    const GAS bf16* wth = (const GAS bf16*)((const unsigned char*)(ws + WS_TBL) + 614400) + (size_t)(layer * 2) * 49152 + ri * 1024 + 8 * kq; const GAS bf16* wtl = wth + 49152;
                    f32x4 acc0 = {0.f, 0.f, 0.f, 0.f}, acc1 = acc0, acc2 = acc0; float ss = 0.f;
                    bf16x8 aA[2], aB[2], bA[12], bB[12];
#define RT_LOAD(a_, b_, g_) do { _Pragma("unroll") for (int c_ = 0; c_ < 2; ++c_) { const int cc_ = 2 * (g_) + c_; a_[c_] = *(const GAS bf16x8*)(xrow + 32 * cc_); \
        _Pragma("unroll") for (int t_ = 0; t_ < 3; ++t_) { b_[c_ * 6 + t_ * 2] = *(const GAS bf16x8*)(wth + t_ * 16384 + 32 * cc_); b_[c_ * 6 + t_ * 2 + 1] = *(const GAS bf16x8*)(wtl + t_ * 16384 + 32 * cc_); } } } while (0)
#define RT_COMP(a_, b_) do { _Pragma("unroll") for (int c_ = 0; c_ < 2; ++c_) { const v4u aw_ = __builtin_bit_cast(v4u, a_[c_]); \
        _Pragma("unroll") for (int j_ = 0; j_ < 4; ++j_) { const float lo_ = __builtin_bit_cast(float, aw_[j_] << 16), hi_ = __builtin_bit_cast(float, aw_[j_] & 0xffff0000u); ss += lo_ * lo_ + hi_ * hi_; } \
        acc0 = __builtin_amdgcn_mfma_f32_16x16x32_bf16(a_[c_], b_[c_ * 6], acc0, 0, 0, 0); acc0 = __builtin_amdgcn_mfma_f32_16x16x32_bf16(a_[c_], b_[c_ * 6 + 1], acc0, 0, 0, 0); \
        acc1 = __builtin_amdgcn_mfma_f32_16x16x32_bf16(a_[c_], b_[c_ * 6 + 2], acc1, 0, 0, 0); acc1 = __builtin_amdgcn_mfma_f32_16x16x32_bf16(a_[c_], b_[c_ * 6 + 3], acc1, 0, 0, 0); \
        acc2 = __builtin_amdgcn_mfma_f32_16x16x32_bf16(a_[c_], b_[c_ * 6 + 4], acc2, 0, 0, 0); acc2 = __builtin_amdgcn_mfma_f32_16x16x32_bf16(a_[c_], b_[c_ * 6 + 5], acc2, 0, 0, 0); } } while (0)
                    if (ROUTER_LDSW) {
                        constexpr int RS = 1040;
                        const unsigned lds0 = (unsigned)(uintptr_t)lds;
                        const unsigned char* tb = (const unsigned char*)(ws + WS_TBL) + 614400 + (size_t)(layer * 2) * 49152 * 2;
                        const LAS unsigned char* bp = lds + ri * RS + kq * 256;
#pragma unroll 1
                        for (int half = 0; half < 2; ++half) {
                            __syncthreads();
#pragma unroll
                            for (int j = 0; j < 12; ++j) { const int R = wave * 12 + j; at1::glds16(tb + (size_t)R * 2048 + half * 1024 + lane * 16, (unsigned)__builtin_amdgcn_readfirstlane(lds0 + R * RS)); }
                            bf16x8 xa[16];
#pragma unroll
                            for (int cc = 0; cc < 16; ++cc) xa[cc] = *(const GAS bf16x8*)(xrow + half * 512 + 32 * cc);
                            asm volatile("s_waitcnt vmcnt(0)" ::: "memory");
                            __syncthreads();
#pragma unroll
                            for (int cc = 0; cc < 16; ++cc) {
                                const v4u aw_ = __builtin_bit_cast(v4u, xa[cc]);
#pragma unroll
                                for (int j_ = 0; j_ < 4; ++j_) { const float lo_ = __builtin_bit_cast(float, aw_[j_] << 16), hi_ = __builtin_bit_cast(float, aw_[j_] & 0xffff0000u); ss += lo_ * lo_ + hi_ * hi_; }
                                const LAS unsigned char* p = bp + cc * 16;
                                acc0 = __builtin_amdgcn_mfma_f32_16x16x32_bf16(xa[cc], *(const LAS bf16x8*)(p), acc0, 0, 0, 0);               acc0 = __builtin_amdgcn_mfma_f32_16x16x32_bf16(xa[cc], *(const LAS bf16x8*)(p + 48 * RS), acc0, 0, 0, 0);
                                acc1 = __builtin_amdgcn_mfma_f32_16x16x32_bf16(xa[cc], *(const LAS bf16x8*)(p + 16 * RS), acc1, 0, 0, 0);     acc1 = __builtin_amdgcn_mfma_f32_16x16x32_bf16(xa[cc], *(const LAS bf16x8*)(p + 64 * RS), acc1, 0, 0, 0);
                                acc2 = __builtin_amdgcn_mfma_f32_16x16x32_bf16(xa[cc], *(const LAS bf16x8*)(p + 32 * RS), acc2, 0, 0, 0);     acc2 = __builtin_amdgcn_mfma_f32_16x16x32_bf16(xa[cc], *(const LAS bf16x8*)(p + 80 * RS), acc2, 0, 0, 0);
                            }
                        }
                        __syncthreads();
                    } else {
                    RT_LOAD(aA, bA, 0);
#pragma unroll 1
                    for (int g = 0; g < 16; g += 2) {
                        RT_LOAD(aB, bB, g + 1);
                        RT_COMP(aA, bA);
                        if (g + 2 < 16) RT_LOAD(aA, bA, g + 2);
                        RT_COMP(aB, bB);
                    }
                    }
#undef RT_LOAD
#undef RT_COMP
                    ss += __shfl_xor(ss, 16); ss += __shfl_xor(ss, 32);
                    const float rstd = 1.0f / sqrtf(ss * (1.f / DM) + 1e-6f);
                    LAS float* Lg = (LAS float*)(lds + wave * 4096);
#pragma unroll
                    for (int r = 0; r < 4; ++r) { Lg[(4 * kq + r) * 49 + ri] = acc0[r]; Lg[(4 * kq + r) * 49 + 16 + ri] = acc1[r]; Lg[(4 * kq + r) * 49 + 32 + ri] = acc2[r]; }
                    LDS_WAIT(); asm volatile("" ::: "memory");
                    if (lane < 16) {
                        const GAS float* bv = (const GAS float*)WR + 1024 * 48;
                        float lg[4], le[32];
#pragma unroll
                        for (int e = 0; e < 4; ++e) lg[e] = Lg[lane * 49 + e] * rstd + bv[e];
#pragma unroll
                        for (int e = 0; e < 32; ++e) le[e] = Lg[lane * 49 + 4 + e] * rstd + bv[4 + e];
                        int gi = 0; float gm = lg[0];
#pragma unroll
                        for (int e = 1; e < 4; ++e) if (lg[e] > gm) { gm = lg[e]; gi = e; }
                        float gs = 0.f;
#pragma unroll
                        for (int e = 0; e < 4; ++e) gs += __expf(lg[e] - gm);
                        const float gval = 1.0f / gs;
                        float ev[8];
#pragma unroll
                        for (int j = 0; j < 8; ++j) ev[j] = gi == 0 ? le[j] : (gi == 1 ? le[8 + j] : (gi == 2 ? le[16 + j] : le[24 + j]));
                        int i0 = 0; float m0 = ev[0];
#pragma unroll
                        for (int j = 1; j < 8; ++j) if (ev[j] > m0) { m0 = ev[j]; i0 = j; }
                        int i1 = -1; float m1 = -3.0e38f;
#pragma unroll
                        for (int j = 0; j < 8; ++j) if (j != i0 && ev[j] > m1) { m1 = ev[j]; i1 = j; }
                        const float t1 = __expf(m1 - m0); const float den = 1.0f / (1.0f + t1);
                        my_e0 = gi * 8 + i0; my_e1 = gi * 8 + i1; my_g0 = gval * den; my_g1 = gval * t1 * den;
                    }
                    for (int i = 0; i < 16; ++i) { const int m = r0w + i; f32x4 v[4]; rms_row_b16(XB + (size_t)m * DM, gf, v, lane);
                        if (MOE_FP8) {
#pragma unroll
                            for (int j = 0; j < 4; ++j) { int d = __builtin_amdgcn_cvt_pk_fp8_f32(v[j].x, v[j].y, 0, false); d = __builtin_amdgcn_cvt_pk_fp8_f32(v[j].z, v[j].w, d, true); *(GAS unsigned*)((unsigned char*)HB + (size_t)m * DM + 4 * lane + 256 * j) = (unsigned)d; }
                        } else store_row_bf16(HB + (size_t)m * DM, v, lane); }
                }
                unsigned r0 = 0, r1 = 0;
                if (lane < 16) { r0 = atomicAdd((unsigned*)(LC + LC_LCNT + my_e0), 1u); r1 = atomicAdd((unsigned*)(LC + LC_LCNT + my_e1), 1u); }
                __syncthreads();
                if (tid < 32) { const unsigned c = LC[LC_LCNT + tid]; LC[LC_LBASE + tid] = c ? __hip_atomic_fetch_add(gcnt + tid, c, RLX_AGENT) : 0u; }
                __syncthreads();
                if (lane < 16) { const int m = chunk * 128 + wave * 16 + lane;
                    const unsigned p0 = LC[LC_LBASE + my_e0] + r0, p1 = LC[LC_LBASE + my_e1] + r1;
                    list[(size_t)my_e0 * LIST_CAP + p0] = m; list[(size_t)my_e1 * LIST_CAP + p1] = m;
                    tokep[2 * m] = my_e0 | (int)(p0 << 8); tokep[2 * m + 1] = my_e1 | (int)(p1 << 8);
                    gate[2 * m] = my_g0; gate[2 * m + 1] = my_g1; }
            }
        }
        SEAM(pb);
        if (IN(pb + 1) || IN(pb + 2) || IN(pb + 3)) {
            __syncthreads();
            if (tid == 0) { int acc = 0; for (int e = 0; e < 32; ++e) { const int c = (int)__hip_atomic_load(gcnt0 + e, RLX_AGENT); LC[LC_CNT + e] = (unsigned)c; LC[LC_TP + e] = (unsigned)acc; acc += (c + 255) >> 8; } LC[LC_TP + 32] = (unsigned)acc;
                int la = 0; for (int j = 0; j < 4; ++j) { LC[LC_LP + j] = (unsigned)la; la += ((int)LC[LC_CNT + (bx & 7) + 8 * j] + 255) >> 8; } LC[LC_LP + 4] = (unsigned)la; }
            __syncthreads();
        }
        const LAS int* tp = (const LAS int*)(lds + LDSCTL_OFF) + LC_TP; const LAS int* cn = (const LAS int*)(lds + LDSCTL_OFF) + LC_CNT; const LAS int* lp = (const LAS int*)(lds + LDSCTL_OFF) + LC_LP;
        if (IN(pb + 1)) REP(pb + 1) {
            pg8::Gemm g{HB, (const bf16*)(ws + WS_W13), 0, 1024, MOE_FP8 ? DM / 2 : DM};
            pg8::MoeOrder S{tp, cn, lp, list, G, bx, tp[32] * 4, true, G == 256};
            pg8::EpiSwiglu E{(bf16*)(ws + WS_H), MOE_FP8 != 0};
            if (MOE_FP8) pg8::gemm_phase<pg8::EpiSwiglu, pg8::MoeOrder, true, true, 127, 122>(lds, g, S, E);
            else pg8::gemm_phase<pg8::EpiSwiglu, pg8::MoeOrder, true>(lds, g, S, E);
        }
        SEAM(pb + 1);
        if (IN(pb + 2)) REP(pb + 2) {
            pg8::Gemm g{(const bf16*)(ws + WS_H), (const bf16*)(ws + WS_W2), 0, 1024, MOE_FP8 ? MOE_H / 2 : MOE_H};
            pg8::MoeOrder S{tp, cn, lp, list, G, bx, tp[32] * 4, false, G == 256};
            pg8::EpiBf16 E{(bf16*)(ws + WS_YS), DM, 0, 0, 1.f, 3, MOE_FP8 != 0};
            if (MOE_FP8) pg8::gemm_phase<pg8::EpiBf16, pg8::MoeOrder, true, true, 125, 122>(lds, g, S, E);
            else pg8::gemm_phase<pg8::EpiBf16, pg8::MoeOrder, true>(lds, g, S, E);
        }
        SEAM(pb + 2);
        if (IN(pb + 3)) {
            const bf16* YS = (const bf16*)(ws + WS_YS);
            if (layer == 0) { LAS float* scr = (LAS float*)(lds + wave * 16384);
                transpose_moe(args.in[24] + (size_t)NEXP * 1024 * 512, args.in[25] + (size_t)NEXP * 1024 * 512, args.in[26] + (size_t)NEXP * 1024 * 512, (bf16*)(ws + WS_W13), (bf16*)(ws + WS_W2), scr, gw, NGW, lane); }
            const float* gn = layer == 0 ? args.in[1] + DM : args.in[3];
            for (int m = gw; m < NTOK; m += NGW) {
                const int ep0 = tokep[2 * m], ep1 = tokep[2 * m + 1]; const float g0 = gate[2 * m], g1 = gate[2 * m + 1];
                const size_t s0 = (size_t)(tp[ep0 & 255] * 256 + (ep0 >> 8)), s1 = (size_t)(tp[ep1 & 255] * 256 + (ep1 >> 8));
                GAS f32x4* xr = (GAS f32x4*)(xres + (size_t)m * DM) + lane; GAS v2u* xb = (GAS v2u*)(XB + (size_t)m * DM) + lane;
                const GAS v2u* y0 = (const GAS v2u*)(YS + s0 * DM) + lane; const GAS v2u* y1 = (const GAS v2u*)(YS + s1 * DM) + lane;
                const GAS unsigned* z0 = (const GAS unsigned*)((const unsigned char*)YS + s0 * DM) + lane; const GAS unsigned* z1 = (const GAS unsigned*)((const unsigned char*)YS + s1 * DM) + lane;
                f32x4 v[4]; float ss = 0.f;
#pragma unroll
                for (int j = 0; j < 4; ++j) { const v2u xw = xb[64 * j]; f32x4 xv = (f32x4){__builtin_bit_cast(float, xw.x << 16), __builtin_bit_cast(float, xw.x & 0xffff0000u), __builtin_bit_cast(float, xw.y << 16), __builtin_bit_cast(float, xw.y & 0xffff0000u)};
                    if (MOE_FP8) { typedef float f32x2_ __attribute__((ext_vector_type(2))); const unsigned a = z0[64 * j], c = z1[64 * j]; const float h0 = g0 * 0.125f, h1 = g1 * 0.125f;
                        const f32x2_ al = __builtin_amdgcn_cvt_pk_f32_fp8((int)a, false), ah = __builtin_amdgcn_cvt_pk_f32_fp8((int)a, true), cl = __builtin_amdgcn_cvt_pk_f32_fp8((int)c, false), ch = __builtin_amdgcn_cvt_pk_f32_fp8((int)c, true);
                        xv.x += h0 * al.x + h1 * cl.x; xv.y += h0 * al.y + h1 * cl.y; xv.z += h0 * ah.x + h1 * ch.x; xv.w += h0 * ah.y + h1 * ch.y;
                    } else { const v2u a = y0[64 * j], c = y1[64 * j];
                    xv.x += g0 * __builtin_bit_cast(float, a.x << 16) + g1 * __builtin_bit_cast(float, c.x << 16);
                    xv.y += g0 * __builtin_bit_cast(float, a.x & 0xffff0000u) + g1 * __builtin_bit_cast(float, c.x & 0xffff0000u);
                    xv.z += g0 * __builtin_bit_cast(float, a.y << 16) + g1 * __builtin_bit_cast(float, c.y << 16);
                    xv.w += g0 * __builtin_bit_cast(float, a.y & 0xffff0000u) + g1 * __builtin_bit_cast(float, c.y & 0xffff0000u); }
                    v[j] = xv; ss += (xv.x * xv.x + xv.y * xv.y) + (xv.z * xv.z + xv.w * xv.w); }
                const float rstd = 1.0f / sqrtf(wave_sum(ss) * (1.f / DM) + 1e-6f);
                const GAS f32x4* gr = (const GAS f32x4*)gn + lane;
                if (layer == 0) {
#pragma unroll
                    for (int j = 0; j < 4; ++j) xb[64 * j] = (v2u){pk2(v[j].x, v[j].y), pk2(v[j].z, v[j].w)};
#pragma unroll
                    for (int j = 0; j < 4; ++j) v[j] = v[j] * rstd * gr[64 * j];
                    if (IN1_FP8) {
#pragma unroll
                        for (int j = 0; j < 4; ++j) { int d = __builtin_amdgcn_cvt_pk_fp8_f32(v[j].x, v[j].y, 0, false); d = __builtin_amdgcn_cvt_pk_fp8_f32(v[j].z, v[j].w, d, true); *(GAS unsigned*)((unsigned char*)HB + (size_t)m * DM + 4 * lane + 256 * j) = (unsigned)d; }
                    } else store_row_bf16(HB + (size_t)m * DM, v, lane);
                } else {
#pragma unroll
                    for (int j = 0; j < 4; ++j) xr[64 * j] = v[j] * rstd * gr[64 * j];
                }
            }
        }
    }
}

__global__ void __launch_bounds__(NWAVES * 64, 2) mk_fwd(Args args) {
    extern __shared__ __attribute__((aligned(16))) unsigned char lds_raw[];
    LAS unsigned char* lds = (LAS unsigned char*)lds_raw;
    volatile LAS unsigned* LC = (volatile LAS unsigned*)(lds + LDSCTL_OFF);
    const int tid = threadIdx.x, lane = tid & 63, wave = __builtin_amdgcn_readfirstlane(tid >> 6);
    const int G = gridDim.x, bx = blockIdx.x;
    const int gw = bx * NWAVES + wave, NGW = G * NWAVES;
    unsigned char* ws = args.ws;
    unsigned* ctl = (unsigned*)(ws + WS_CTL);
    const float* x_in = args.in[0];
    float* xres = args.out;
    bf16* XB = (bf16*)(ws + WS_XB);
    bf16* HB = (bf16*)(ws + WS_HB); bf16* Y = (bf16*)(ws + WS_Y);
    float* TBL = (float*)(ws + WS_TBL);

    for (int u = tid; u < (LDS_BYTES - LDSCTL_OFF) / 4; u += NWAVES * 64) LC[u] = 0u;
    __syncthreads();
    XcdBarrier bar; bar.bar = ctl + CW_BAR; bar.x = 0; bar.st = nullptr;
    if (MK_N_LAUNCHES == 1) bar = xcd_barrier_post(ctl + CW_BAR, LC + LC_BAR);
    const int lo = args.ph_lo, hi_ph = args.ph_hi;

    if (IN(0)) REP(0) {
        LAS float* scr = (LAS float*)(lds + wave * 16384);
        transpose_plain(args.in[4], DM, EV_IN, (bf16*)(ws + WS_WIN0), scr, gw, NGW, lane);
        transpose_plain(args.in[11], DM, DM, (bf16*)(ws + WS_WOUT0), scr, gw, NGW, lane);
        transpose_plain<IN1_FP8 != 0>(args.in[12], DM, OD_IN, (bf16*)(ws + WS_WIN1), scr, gw, NGW, lane);
        transpose_plain(args.in[18], DM, DM, (bf16*)(ws + WS_WOUT1), scr, gw, NGW, lane);
        transpose_moe(args.in[24], args.in[25], args.in[26], (bf16*)(ws + WS_W13), (bf16*)(ws + WS_W2), scr, gw, NGW, lane);
        for (int i = bx * 512 + tid; i < 2048; i += G * 512) { const int pos = i >> 4, f = i & 15;
            const float inv = exp2f(-(float)f * (13.287712379549449f / 16.0f));
            const float ang = (float)pos * inv; const float rev = ang * 0.15915494309189535f; const float fr = rev - floorf(rev);
            TBL[TBL_COS + i] = __builtin_amdgcn_cosf(fr); TBL[TBL_SIN + i] = __builtin_amdgcn_sinf(fr); }
        for (int i = bx * 512 + tid; i < 8 * 257; i += G * 512) { const int h = i / 257, j = i % 257;
            TBL[TBL_BIAS + h * BIAS_STRIDE + j] = args.in[19][t5_bucket(j - 128) * 8 + h] * LOG2E; }
        for (int i = bx * 512 + tid; i < 2 * 1024 * 48; i += G * 512) { const int l = i / (1024 * 48), r = i % (1024 * 48), k = r / 48, c = r % 48;
            float w = 0.f; if (c < 4) w = args.in[20][(size_t)l * 4096 + k * 4 + c]; else if (c < 36) w = args.in[22][(size_t)l * 32768 + k * 32 + (c - 4)];
            TBL[TBL_WR + l * WR_LAYER + r] = w * args.in[2][l * DM + k]; }
        {
            bf16* TBH = (bf16*)((unsigned char*)TBL + 614400);
            for (int i = bx * 512 + tid; i < 2 * 48 * 1024; i += G * 512) { const int l = i / (48 * 1024), r = i % (48 * 1024), c = r >> 10; int k = r & 1023;
                if (ROUTER_LDSW) { const int q = k & 511; k = (k & 512) + ((q >> 3) & 15) * 32 + (q >> 7) * 8 + (q & 7); }
                float w = 0.f; if (c < 4) w = args.in[20][(size_t)l * 4096 + k * 4 + c]; else if (c < 36) w = args.in[22][(size_t)l * 32768 + k * 32 + (c - 4)];
                w *= args.in[2][l * DM + k]; const unsigned hb = f2bf(w); const float rem = w - bf2f((unsigned short)hb);
                TBH[(size_t)(l * 2) * 49152 + r] = (bf16)hb; TBH[(size_t)(l * 2 + 1) * 49152 + r] = (bf16)f2bf(rem); }
        }
        for (int i = bx * 512 + tid; i < 2 * 48; i += G * 512) { const int l = i / 48, c = i % 48;
            TBL[TBL_WR + l * WR_LAYER + 1024 * 48 + c] = c < 4 ? args.in[21][l * 4 + c] : (c < 36 ? args.in[23][l * 32 + (c - 4)] : 0.f); }
        for (int m = gw; m < NTOK; m += NGW) { f32x4 v[4]; rms_row(x_in + (size_t)m * DM, args.in[1], v, lane); store_row_bf16(HB + (size_t)m * DM, v, lane); }
    }
    SEAM(0);
    if (IN(1)) REP(1) {
        pg8::Gemm g{HB, (const bf16*)(ws + WS_WIN0), NTOK, EV_IN, DM}; pg8::StaticOrder S; S.init(NTOK, EV_IN, G, bx);
        pg8::EpiBf16 E{(bf16*)(ws + WS_Z0), EV_IN, 0, 0, 1.f, 0xffff, false};
        pg8::gemm_phase<pg8::EpiBf16, pg8::StaticOrder, true>(lds, g, S, E);
    }
    SEAM(1);
    if (IN(2)) REP(2) {
        const bf16* Z0 = (const bf16*)(ws + WS_Z0); bf16* QR = (bf16*)(ws + WS_QR); bf16* KR = (bf16*)(ws + WS_KR);
        if (QK_FP8 && (ATTN_VER == 1 || ATTN_VER == 3)) {
            for (int it = bx * 512 + tid; it < NTOK * 10; it += G * 512) {
                const bool isq = it < NTOK * 8; const int m = isq ? (it >> 3) : ((it - NTOK * 8) >> 1); const int hh = isq ? (it & 7) : 8 + ((it - NTOK * 8) & 1);
                const float* gn = isq ? args.in[5] : args.in[6];
                const GAS v4u* srcp = (const GAS v4u*)(Z0 + (size_t)m * EV_IN + hh * 64);
                float xv[64]; float ss = 0.f;
#pragma unroll
                for (int q = 0; q < 8; ++q) { const v4u a = srcp[q];
#pragma unroll
                    for (int j = 0; j < 4; ++j) { const float lo = __builtin_bit_cast(float, a[j] << 16), hh2 = __builtin_bit_cast(float, a[j] & 0xffff0000u); xv[q * 8 + 2 * j] = lo; xv[q * 8 + 2 * j + 1] = hh2; ss += lo * lo + hh2 * hh2; } }
                const float rs = (1.0f / sqrtf(ss * (1.f / 64.f) + 1e-6f)) * (isq ? C2 * 8.0f : 1.0f);
                const int sp = m & (SEQ - 1);
                unsigned wout[16];
#pragma unroll
                for (int half = 0; half < 2; ++half) { const int pos = half ? (sp & 63) : (sp >> 6);
                    const GAS f32x4* ct = (const GAS f32x4*)(TBL + TBL_COS + pos * 16); const GAS f32x4* st = (const GAS f32x4*)(TBL + TBL_SIN + pos * 16);
                    float ov[32];
#pragma unroll
                    for (int q = 0; q < 4; ++q) { const f32x4 cv = ct[q], sv = st[q];
#pragma unroll
                        for (int j = 0; j < 4; ++j) { const int i = q * 4 + j; const float a = xv[half * 32 + i] * rs * gn[half * 32 + i], b2 = xv[half * 32 + 16 + i] * rs * gn[half * 32 + 16 + i];
                            ov[i] = a * cv[j] - b2 * sv[j]; ov[16 + i] = b2 * cv[j] + a * sv[j]; } }
#pragma unroll
                    for (int q = 0; q < 8; ++q) { int d = __builtin_amdgcn_cvt_pk_fp8_f32(ov[4 * q], ov[4 * q + 1], 0, false); d = __builtin_amdgcn_cvt_pk_fp8_f32(ov[4 * q + 2], ov[4 * q + 3], d, true); wout[half * 8 + q] = (unsigned)d; } }
                if (!isq && ATTN_VER == 3) {
                    const int strm = (m >> 13) * 2 + (hh - 8); unsigned char* kb_ = ws + WS_K8T0 + ((((size_t)strm * 128 + (sp >> 6)) * 4) * 64 + (sp & 63)) * 16;
#pragma unroll
                    for (int q = 0; q < 4; ++q) *(GAS v4u*)(kb_ + q * 1024) = (v4u){wout[4 * q], wout[4 * q + 1], wout[4 * q + 2], wout[4 * q + 3]};
                } else {
                GAS v4u* dst = isq ? (GAS v4u*)(ws + WS_QR8 + (size_t)m * 512 + hh * 64) : (GAS v4u*)(ws + WS_KR8 + (size_t)m * 128 + (hh - 8) * 64);
#pragma unroll
                for (int q = 0; q < 4; ++q) dst[q] = (v4u){wout[4 * q], wout[4 * q + 1], wout[4 * q + 2], wout[4 * q + 3]};
                }
            }
            if (ATTN_VER == 3) {
                for (int it = bx * 512 + tid; it < 8 * 128 * 4 * 64; it += G * 512) { const int d = it & 63, c = (it >> 6) & 3, tt = (it >> 8) & 127, strm = it >> 15;
                    const bf16* vb_ = Z0 + ((size_t)(strm >> 1) * SEQ + tt * 64) * EV_IN + 640 + (strm & 1) * 64 + d; unsigned w4[4];
#pragma unroll
                    for (int q = 0; q < 4; ++q) { float f[4];
#pragma unroll
                        for (int j = 0; j < 4; ++j) { const int bb = q * 4 + j; const int key = 32 * (c & 1) + (bb & 3) + 8 * (bb >> 2) + 4 * (c >> 1); f[j] = bf2f(vb_[(size_t)key * EV_IN]); }
                        int dw = __builtin_amdgcn_cvt_pk_fp8_f32(f[0], f[1], 0, false); dw = __builtin_amdgcn_cvt_pk_fp8_f32(f[2], f[3], dw, true); w4[q] = (unsigned)dw; }
                    *(GAS v4u*)(ws + WS_V8T0 + (size_t)it * 16) = (v4u){w4[0], w4[1], w4[2], w4[3]}; }
            }
        } else {
        const float gq = args.in[5][lane], gk = args.in[6][lane];
        const int fi = lane & 15; const bool first = (lane & 16) == 0, isrow = lane < 32;
        for (int m = gw; m < NTOK; m += NGW) {
            const int s = m & (SEQ - 1); const int pos = isrow ? (s >> 6) : (s & 63);
            const float cs = TBL[TBL_COS + pos * 16 + fi], sn = TBL[TBL_SIN + pos * 16 + fi];
#pragma unroll
            for (int h = 0; h < 10; ++h) {
                const float xv = bf2f(Z0[(size_t)m * EV_IN + h * 64 + lane]);
                const float ss = wave_sum(xv * xv);
                const float y = xv * (1.0f / sqrtf(ss * (1.f / 64.f) + 1e-6f)) * (h < 8 ? gq : gk);
                const float p = __shfl_xor(y, 16);
                float o = first ? (y * cs - p * sn) : (y * cs + p * sn);
                if (!QK_FP8 || ATTN_VER != 1) { if (h < 8) QR[(size_t)m * 512 + h * 64 + lane] = (bf16)f2bf(o * C2);
                else KR[(size_t)m * 128 + (h - 8) * 64 + lane] = (bf16)f2bf(o); }
                if (QK_FP8) { const unsigned w = quad_pack_bytes(fp8_byte(h < 8 ? o * (C2 * 8.0f) : o));
                    if ((lane & 3) == 0) { if (h < 8) *(unsigned*)(ws + WS_QR8 + (size_t)m * 512 + h * 64 + lane) = w; else *(unsigned*)(ws + WS_KR8 + (size_t)m * 128 + (h - 8) * 64 + lane) = w; } }
            }
        }
        }
        LAS float* hbuf = (LAS float*)lds;
        for (int un = bx; un < NBATCH * 64 * 8; un += G) {
            const int grp = un & 7, tt = (un >> 3) & 63, b = un >> 9; const int t0 = tt * 128;
            __syncthreads();
            for (int idx = tid; idx < 158 * 8; idx += 512) { const int r = idx >> 3, c8 = idx & 7; const int s = t0 - 15 + r;
                f32x4 h0 = {0.f, 0.f, 0.f, 0.f}, h1 = h0;
                if (s >= 0 && s < SEQ) { const size_t ro = (size_t)(b * SEQ + s) * EV_IN + grp * 64 + c8 * 8;
                    const v4u av = *(const GAS v4u*)(Z0 + ro + 768), gv = *(const GAS v4u*)(Z0 + ro + 1280);
#pragma unroll
                    for (int j = 0; j < 4; ++j) { const float a0 = __builtin_bit_cast(float, av[j] << 16), a1 = __builtin_bit_cast(float, av[j] & 0xffff0000u);
                        const float g0 = __builtin_bit_cast(float, gv[j] << 16), g1 = __builtin_bit_cast(float, gv[j] & 0xffff0000u);
                        const float x0 = a0 * __builtin_amdgcn_rcpf(1.0f + __builtin_amdgcn_exp2f(-g0 * LOG2E)), x1 = a1 * __builtin_amdgcn_rcpf(1.0f + __builtin_amdgcn_exp2f(-g1 * LOG2E));
                        if (j < 2) { h0[2 * j] = x0; h0[2 * j + 1] = x1; } else { h1[2 * j - 4] = x0; h1[2 * j - 3] = x1; } } }
                *(LAS f32x4*)(hbuf + r * 64 + c8 * 8) = h0; *(LAS f32x4*)(hbuf + r * 64 + c8 * 8 + 4) = h1; }
            __syncthreads();
            const int ch = grp * 64 + lane;
            float wreg[31];
#pragma unroll
            for (int j = 0; j < 31; ++j) wreg[j] = args.in[7][j * 512 + ch];
            typedef float f32x2 __attribute__((ext_vector_type(2)));
            float acc[16]; const float cb = args.in[8][ch];
            {
                f32x2 he[23], ho[22];
#pragma unroll
                for (int k = 0; k < 23; ++k) { he[k].x = hbuf[(wave * 16 + 2 * k) * 64 + lane]; he[k].y = hbuf[(wave * 16 + 2 * k + 1) * 64 + lane]; }
#pragma unroll
                for (int k = 0; k < 22; ++k) { ho[k].x = he[k].y; ho[k].y = he[k + 1].x; }
                f32x2 a2[8];
#pragma unroll
                for (int p = 0; p < 8; ++p) a2[p] = (f32x2){cb, cb};
#pragma unroll
                for (int j = 0; j < 31; ++j) { const f32x2 wj = (f32x2){wreg[j], wreg[j]};
#pragma unroll
                    for (int p = 0; p < 8; ++p) { const int r = 2 * p + j; a2[p] = __builtin_elementwise_fma(wj, (r & 1) ? ho[r >> 1] : he[r >> 1], a2[p]); } }
#pragma unroll
                for (int p = 0; p < 8; ++p) { acc[2 * p] = a2[p].x; acc[2 * p + 1] = a2[p].y; }
            }
            const float gg = args.in[9][ch], gb = args.in[10][ch];
#pragma unroll
            for (int i = 0; i < 16; ++i) { const float mu = wave_sum(acc[i]) * (1.f / 64.f); const float d = acc[i] - mu; const float var = wave_sum(d * d) * (1.f / 64.f);
                const float hn = d * (1.0f / sqrtf(var + 1e-5f)) * gg + gb; const float ov = hn * __builtin_amdgcn_rcpf(1.0f + __builtin_amdgcn_exp2f(-hn * LOG2E));
                Y[(size_t)(b * SEQ + t0 + wave * 16 + i) * DM + 512 + ch] = (bf16)f2bf(ov); }
        }
    }
    SEAM(2);
    if (IN(3)) REP(3) {
        const bf16* QR = (const bf16*)(ws + WS_QR); const bf16* KR = (const bf16*)(ws + WS_KR); const bf16* Z0 = (const bf16*)(ws + WS_Z0);
        if (ATTN_L0_TEST) {
        for (int un = bx; un < NBATCH * 8 * 32; un += G) {
            const int qb = un & 31, h = (un >> 5) & 7, b = un >> 8, kvh = h >> 2;
            const size_t row0 = (size_t)b * SEQ + qb * 256;
            attn_unit_v0<64, false, true>((const bf16*)(ws + WS_QR8 + row0 * 512 + h * 64), 512, (const bf16*)(ws + WS_KR8 + (size_t)b * SEQ * 128 + kvh * 64), 128, Z0 + (size_t)b * SEQ * EV_IN + 640 + kvh * 64, EV_IN,
                                   Y + row0 * DM + h * 64, DM, nullptr, qb * 256, lds);
        }
        } else if (ATTN_VER == 0) {
        for (int un = bx; un < NBATCH * 8 * 32; un += G) {
            const int qb = un & 31, h = (un >> 5) & 7, b = un >> 8, kvh = h >> 2;
            const size_t row0 = (size_t)b * SEQ + qb * 256;
            attn_unit_v0<64, false>(QR + row0 * 512 + h * 64, 512, KR + (size_t)b * SEQ * 128 + kvh * 64, 128, Z0 + (size_t)b * SEQ * EV_IN + 640 + kvh * 64, EV_IN,
                                   Y + row0 * DM + h * 64, DM, nullptr, qb * 256, lds);
        }
        } else {
        constexpr int U = NBATCH * 8 * 32; const int upc = (U + G - 1) / G; const int vcu = (G % 8 == 0) ? (bx % 8) * (G / 8) + bx / 8 : bx;
        for (int i = 0; i < upc; ++i) { const int un = vcu * upc + i; if (un >= U) break;
            const int stream = un >> 7, b = stream >> 1, kvh = stream & 1, h = kvh * 4 + ((un >> 5) & 3), qb = un & 31;
            const size_t row0 = (size_t)b * SEQ + qb * 256;
            if (ATTN_VER == 3) at3::attn_unit<64, false, 0>(ws + WS_QR8 + row0 * 512 + h * 64, 512, ws + WS_K8T0 + (size_t)stream * 128 * 4096, ws + WS_V8T0 + (size_t)stream * 128 * 4096, Y + row0 * DM + h * 64, DM, qb * 256, lds, nullptr);
            else if (QK_FP8) at1::attn_unit<64, false, 0, 0, true>((const bf16*)(ws + WS_QR8 + row0 * 512 + h * 64), 512, (const bf16*)(ws + WS_KR8 + (size_t)b * SEQ * 128 + kvh * 64), 128, Z0 + (size_t)b * SEQ * EV_IN + 640 + kvh * 64, EV_IN,
                                      Y + row0 * DM + h * 64, DM, qb * 256, lds);
            else at1::attn_unit<64, false>(QR + row0 * 512 + h * 64, 512, KR + (size_t)b * SEQ * 128 + kvh * 64, 128, Z0 + (size_t)b * SEQ * EV_IN + 640 + kvh * 64, EV_IN,
                                      Y + row0 * DM + h * 64, DM, qb * 256, lds);
        }
        }
    }
    SEAM(3);
    if (IN(4)) REP(4) {
        pg8::Gemm g{Y, (const bf16*)(ws + WS_WOUT0), NTOK, DM, DM}; pg8::StaticOrder S; S.init(NTOK, DM, G, bx);
        pg8::EpiRes E{x_in, nullptr, XB, DM};
        pg8::gemm_phase<pg8::EpiRes, pg8::StaticOrder, true>(lds, g, S, E);
    }
    SEAM(4);

    moe_block<0>(args, lds, bar, lo, hi_ph);
    SEAM(8);
            if (IN(9)) REP(9) {
                pg8::Gemm g{HB, (const bf16*)(ws + WS_WIN1), NTOK, OD_IN, IN1_FP8 ? DM / 2 : DM}; pg8::StaticOrder S; S.init(NTOK, OD_IN, G, bx);
                if (QK_FP8) { pg8::EpiQKV8 E{ws + WS_Q1, ws + WS_K8T1, (bf16*)(ws + WS_V1), C2 * 8.0f, true};
                    if (IN1_FP8) pg8::gemm_phase<pg8::EpiQKV8, pg8::StaticOrder, true, true, 127, 122>(lds, g, S, E);
                    else pg8::gemm_phase<pg8::EpiQKV8, pg8::StaticOrder, true>(lds, g, S, E); }
                else { pg8::EpiBf16 E{(bf16*)(ws + WS_Q1), DM, DM, (size_t)(WS_K1 - WS_Q1) / 2, C2, 0xffff, false};
                pg8::gemm_phase<pg8::EpiBf16, pg8::StaticOrder, true>(lds, g, S, E); }
            }
            SEAM(9);
            if (ATTN_L1_VER == 3) {
            if (IN(10)) {
                const bf16* V1 = (const bf16*)(ws + WS_V1);
                for (int it = bx * 512 + tid; it < 32 * 128 * 4 * 128; it += G * 512) { const int d = it & 127, c = (it >> 7) & 3, tt = (it >> 9) & 127, bh = it >> 16;
                    const bf16* vb_ = V1 + (((size_t)bh * 128 + tt) * 4 + (d >> 5)) * 2048 + (d & 31); unsigned w4[4];
#pragma unroll
                    for (int q = 0; q < 4; ++q) { float f[4];
#pragma unroll
                        for (int j = 0; j < 4; ++j) { const int bb = q * 4 + j; const int key = 32 * (c & 1) + (bb & 3) + 8 * (bb >> 2) + 4 * (c >> 1); f[j] = bf2f(vb_[(size_t)key * 32]); }
                        int dw = __builtin_amdgcn_cvt_pk_fp8_f32(f[0], f[1], 0, false); dw = __builtin_amdgcn_cvt_pk_fp8_f32(f[2], f[3], dw, true); w4[q] = (unsigned)dw; }
                    *(GAS v4u*)(ws + WS_V8T1 + (size_t)it * 16) = (v4u){w4[0], w4[1], w4[2], w4[3]}; }
            }
            SEAM(10);
            if (IN(11)) REP(11) {
                constexpr int UP = NBATCH * 8 * 32; const int upc = (UP + G - 1) / G; const int vcu = (G % 8 == 0) ? (bx % 8) * (G / 8) + bx / 8 : bx;
                LAS float* btbl = (LAS float*)(lds + at3::lds_tbl_off<128>());
                LAS float* sgt = btbl + 272;
                __syncthreads();
                if (tid < 128) sgt[tid] = args.in[17][tid] * (1.0f - LAM_INIT);
                if (wave == 7) { const float lam = __expf(wave_sum(args.in[13][lane] * args.in[14][lane])) - __expf(wave_sum(args.in[15][lane] * args.in[16][lane])) + LAM_INIT; if (lane == 0) sgt[128] = lam; }
                for (int i = 0; i < upc; ++i) {
                    int up = vcu * upc + i; if (up >= UP) break;
                    if (G == 256) up = ((vcu >> 5) * 4 + i) * 32 + (vcu & 31);
                    const int qb = up & 31, h = (up >> 5) & 7, b = up >> 8;
                    __syncthreads();
                    if (tid < 257) btbl[tid] = TBL[TBL_BIAS + h * BIAS_STRIDE + tid] - TBL[TBL_BIAS + h * BIAS_STRIDE + 256];
                    __syncthreads();
                    const size_t row0 = (size_t)b * SEQ + qb * 256; const int bh = b * 8 + h;
                    const unsigned char* Q8 = ws + WS_Q1 + row0 * DM + h * 128; const unsigned char* V8 = ws + WS_V8T1 + (size_t)bh * 128 * 8192;
                    at3::attn_unit<128, true, 1>(Q8, DM, ws + WS_K8T1 + (size_t)(bh * 2) * 128 * 4096, V8, nullptr, DM, qb * 256, lds, sgt);
                    at3::attn_unit<128, true, 2>(Q8 + 64, DM, ws + WS_K8T1 + (size_t)(bh * 2 + 1) * 128 * 4096, V8, Y + row0 * DM + h * 128, DM, qb * 256, lds, sgt);
                }
            }
            SEAM(11);
            } else {
            if (IN(10)) REP(10) {
                const bf16* Q1 = (const bf16*)(ws + WS_Q1); const bf16* K1 = (const bf16*)(ws + WS_K1); const bf16* V1 = (const bf16*)(ws + WS_V1);
                if (ATTN_L1_VER == 0) {
                LAS float* btbl = (LAS float*)(lds + 65536);
                for (int un = bx; un < NBATCH * 8 * 2 * 32; un += G) {
                    const int qb = un & 31, c = (un >> 5) & 1, h = (un >> 6) & 7, b = un >> 9;
                    __syncthreads();
                    if (tid < 257) btbl[tid] = TBL[TBL_BIAS + h * BIAS_STRIDE + tid];
                    __syncthreads();
                    const size_t row0 = (size_t)b * SEQ + qb * 256, brow = (size_t)b * SEQ;
                    bf16* OC = (bf16*)(ws + (c ? WS_OC1 : WS_OC0));
                    attn_unit_v0<128, true>(Q1 + row0 * DM + h * 128 + c * 64, DM, K1 + brow * DM + h * 128 + c * 64, DM, V1 + brow * DM + h * 128, DM,
                                           OC + row0 * DM + h * 128, DM, btbl, qb * 256, lds);
                }
                } else {
                constexpr int UP = NBATCH * 8 * 32; const int upc = (UP + G - 1) / G; const int vcu = (G % 8 == 0) ? (bx % 8) * (G / 8) + bx / 8 : bx;
                LAS float* btbl = (LAS float*)(lds + at1::lds_tbl_off<128, QK_FP8 != 0>());
                LAS float* sgt = btbl + 272;
                __syncthreads();
                if (tid < 128) sgt[tid] = args.in[17][tid] * (1.0f - LAM_INIT);
                if (wave == 7) { const float lam = __expf(wave_sum(args.in[13][lane] * args.in[14][lane])) - __expf(wave_sum(args.in[15][lane] * args.in[16][lane])) + LAM_INIT; if (lane == 0) sgt[128] = lam; }
                for (int i = 0; i < upc; ++i) {
                    int up = vcu * upc + i; if (up >= UP) break;
                    if (G == 256) up = ((vcu >> 5) * 4 + i) * 32 + (vcu & 31);
                    const int qb = up & 31, h = (up >> 5) & 7, b = up >> 8;
                    __syncthreads();
                    if (tid < 257) btbl[tid] = TBL[TBL_BIAS + h * BIAS_STRIDE + tid] - TBL[TBL_BIAS + h * BIAS_STRIDE + 256];
                    __syncthreads();
                    const size_t row0 = (size_t)b * SEQ + qb * 256, brow = (size_t)b * SEQ;
                    if (QK_FP8) { const unsigned char* Q8 = ws + WS_Q1; const unsigned char* K8 = ws + WS_K1;
                    const int bh = b * 8 + h; const bf16* VT = V1 + (size_t)bh * 128 * 8192; const unsigned char* KT0 = ws + WS_K8T1 + (size_t)(bh * 2) * 128 * 4096; (void)K8; (void)brow;
                    at1::attn_unit<128, true, 0, 1, true, true>((const bf16*)(Q8 + row0 * DM + h * 128), DM, (const bf16*)KT0, DM, VT, DM, nullptr, DM, qb * 256, lds, sgt);
                    at1::attn_unit<128, true, 0, 2, true, true>((const bf16*)(Q8 + row0 * DM + h * 128 + 64), DM, (const bf16*)(KT0 + 128 * 4096), DM, VT, DM, Y + row0 * DM + h * 128, DM, qb * 256, lds, sgt);
                    } else {
                    at1::attn_unit<128, true, 0, 1>(Q1 + row0 * DM + h * 128, DM, K1 + brow * DM + h * 128, DM, V1 + brow * DM + h * 128, DM, nullptr, DM, qb * 256, lds, sgt);
                    at1::attn_unit<128, true, 0, 2>(Q1 + row0 * DM + h * 128 + 64, DM, K1 + brow * DM + h * 128 + 64, DM, V1 + brow * DM + h * 128, DM, Y + row0 * DM + h * 128, DM, qb * 256, lds, sgt);
                    }
                }
                }
            }
            SEAM(10);
            if (PROBE_ATT >= 0 && IN(10)) {
                const bf16* Q1 = (const bf16*)(ws + WS_Q1); const bf16* K1 = (const bf16*)(ws + WS_K1); const bf16* V1 = (const bf16*)(ws + WS_V1);
                constexpr int U = NBATCH * 8 * 2 * 32; const int upc = (U + G - 1) / G; const int vcu = (G % 8 == 0) ? (bx % 8) * (G / 8) + bx / 8 : bx;
                LAS float* btbl = (LAS float*)(lds + 3 * 8192 + 3 * 16384 + 2048);
                for (int i = 0; i < upc; ++i) {
                    int un = vcu * upc + i; if (un >= U) break;
                    if (G == 256) un = ((vcu >> 5) * 4 + (i >> 1)) * 64 + (i & 1) * 32 + (vcu & 31);
                    const int qb = un & 31, c = (un >> 5) & 1, h = (un >> 6) & 7, b = un >> 9;
                    if (tid < 257) btbl[tid] = TBL[TBL_BIAS + h * BIAS_STRIDE + tid] - TBL[TBL_BIAS + h * BIAS_STRIDE + 256];
                    __syncthreads();
                    const size_t row0 = (size_t)b * SEQ + qb * 256, brow = (size_t)b * SEQ;
                    at1::attn_unit<128, true, (PROBE_ATT >= 0 ? PROBE_ATT : 0)>(Q1 + row0 * DM + h * 128 + c * 64, DM, K1 + brow * DM + h * 128 + c * 64, DM, V1 + brow * DM + h * 128, DM,
                                              (bf16*)(ws + WS_OC1) + row0 * DM + h * 128, DM, qb * 256, lds);
                }
                xcd_barrier(bar);
            }
            if (IN(11) && ATTN_L1_VER != 1) REP(11) {
                const bf16* OC0 = (const bf16*)(ws + WS_OC0); const bf16* OC1 = (const bf16*)(ws + WS_OC1);
                const float lam = __expf(wave_sum(args.in[13][lane] * args.in[14][lane])) - __expf(wave_sum(args.in[15][lane] * args.in[16][lane])) + LAM_INIT;
                float sg[16];
#pragma unroll
                for (int j = 0; j < 16; ++j) sg[j] = args.in[17][(lane & 7) * 16 + j] * (1.0f - LAM_INIT);
                for (int m = gw; m < NTOK; m += NGW) {
                    const GAS v4u* a = (const GAS v4u*)(OC0 + (size_t)m * DM) + lane * 2; const GAS v4u* c = (const GAS v4u*)(OC1 + (size_t)m * DM) + lane * 2;
                    float o[16]; float ss = 0.f;
#pragma unroll
                    for (int q = 0; q < 2; ++q) { const v4u av = a[q], cv = c[q];
#pragma unroll
                        for (int j = 0; j < 4; ++j) { const unsigned au = av[j], cu = cv[j];
                            const float lo = __builtin_bit_cast(float, au << 16) - lam * __builtin_bit_cast(float, cu << 16);
                            const float hh = __builtin_bit_cast(float, au & 0xffff0000u) - lam * __builtin_bit_cast(float, cu & 0xffff0000u);
                            o[q * 8 + 2 * j] = lo; o[q * 8 + 2 * j + 1] = hh; ss += lo * lo + hh * hh; } }
                    ss += __shfl_xor(ss, 1); ss += __shfl_xor(ss, 2); ss += __shfl_xor(ss, 4);
                    const float rstd = 1.0f / sqrtf(ss * (1.f / 128.f) + 1e-5f);
                    v4u w0, w1;
                    w0.x = pk2(o[0] * rstd * sg[0], o[1] * rstd * sg[1]); w0.y = pk2(o[2] * rstd * sg[2], o[3] * rstd * sg[3]); w0.z = pk2(o[4] * rstd * sg[4], o[5] * rstd * sg[5]); w0.w = pk2(o[6] * rstd * sg[6], o[7] * rstd * sg[7]);
                    w1.x = pk2(o[8] * rstd * sg[8], o[9] * rstd * sg[9]); w1.y = pk2(o[10] * rstd * sg[10], o[11] * rstd * sg[11]); w1.z = pk2(o[12] * rstd * sg[12], o[13] * rstd * sg[13]); w1.w = pk2(o[14] * rstd * sg[14], o[15] * rstd * sg[15]);
                    GAS v4u* yo = (GAS v4u*)(Y + (size_t)m * DM) + lane * 2; yo[0] = w0; yo[1] = w1;
                }
            }
            if (ATTN_L1_VER != 1) SEAM(11);
            }
            if (IN(12)) {
                pg8::Gemm g{Y, (const bf16*)(ws + WS_WOUT1), NTOK, DM, DM}; pg8::StaticOrder S; S.init(NTOK, DM, G, bx);
                pg8::EpiRes E{nullptr, XB, XB, DM};
                pg8::gemm_phase<pg8::EpiRes, pg8::StaticOrder, true>(lds, g, S, E);
            }
            SEAM(12);
    moe_block<1>(args, lds, bar, lo, hi_ph);
#undef IN
#undef SEAM
}

extern "C" void kernel_launch(void* const* d_in, const int* in_sizes, int n_in, void* d_out, int out_size, void* d_ws, size_t ws_size, hipStream_t stream) {
    static int grid = 0;
    if (grid == 0) {
        if (n_in != 27 || in_sizes[0] != NTOK * DM || out_size != NTOK * DM || ws_size < WS_END) { fprintf(stderr, "kernel_launch: unexpected shapes / workspace (n_in %d, ws %zu)\n", n_in, ws_size); grid = -1; return; }
        int dev = 0, cus = 0, per_cu = 0;
        if (hipGetDevice(&dev) != hipSuccess || hipDeviceGetAttribute(&cus, hipDeviceAttributeMultiprocessorCount, dev) != hipSuccess) { grid = -1; return; }
        if (hipFuncSetAttribute((const void*)mk_fwd, hipFuncAttributeMaxDynamicSharedMemorySize, LDS_BYTES) != hipSuccess) { fprintf(stderr, "kernel_launch: hipFuncSetAttribute failed\n"); grid = -1; return; }
        if (hipOccupancyMaxActiveBlocksPerMultiprocessor(&per_cu, (const void*)mk_fwd, NWAVES * 64, LDS_BYTES) != hipSuccess || per_cu < 1) { fprintf(stderr, "kernel_launch: occupancy query says %d\n", per_cu); }
        (void)hipGetLastError();
        grid = cus;
    }
    if (grid < 0) return;
    if (hipMemsetAsync((char*)d_ws + WS_CTL, 0, CTL_ZERO_BYTES, stream) != hipSuccess) return;
    Args a{};
    for (int i = 0; i < 27; ++i) a.in[i] = (const float*)d_in[i];
    a.out = (float*)d_out; a.ws = (unsigned char*)d_ws;
    if (MK_N_LAUNCHES == 1) { a.ph_lo = 0; a.ph_hi = NPHASE; a.li = 0; hipLaunchKernelGGL(mk_fwd, dim3(grid), dim3(NWAVES * 64), LDS_BYTES, stream, a); }
    else { for (int p = 0; p < NPHASE; ++p) for (int r = 0; r < (int)((PROBE_MASK >> p) & 1u) + 1; ++r) { a.ph_lo = p; a.ph_hi = p + 1; a.li = p; hipLaunchKernelGGL(mk_fwd, dim3(grid), dim3(NWAVES * 64), LDS_BYTES, stream, a); } }
}
```

```cpp
#include <hip/hip_runtime.h>
#include <cstdio>
#include <cstdint>

#ifndef MK_N_LAUNCHES
#define MK_N_LAUNCHES 1
#endif

#ifndef ATTN_VER
#define ATTN_VER 3
#endif
#ifndef PROBE_ATT
#define PROBE_ATT -1
#endif
#ifndef QK_FP8
#define QK_FP8 1
#endif
#ifndef ATTN_L0_TEST
#define ATTN_L0_TEST 0
#endif
#ifndef ATTN_L1_VER
#define ATTN_L1_VER 3
#endif
#ifndef MOE_FP8
#define MOE_FP8 1
#endif
#ifndef IN1_FP8
#define IN1_FP8 1
#endif
#ifndef ROUTER_LDSW
#define ROUTER_LDSW 1
#endif
#ifndef PROBE_MASK
#define PROBE_MASK 0u
#endif
#define REP(k) _Pragma("unroll") for (int rep_ = 0; rep_ < (MK_N_LAUNCHES == 1 ? (int)((PROBE_MASK >> (k)) & 1u) : 0) + 1; ++rep_)
#define GAS __attribute__((address_space(1)))
#define LAS __attribute__((address_space(3)))
typedef unsigned short bf16;
typedef unsigned v4u __attribute__((ext_vector_type(4)));
typedef unsigned v2u __attribute__((ext_vector_type(2)));
typedef float f32x4 __attribute__((ext_vector_type(4)));
typedef float f32x16 __attribute__((ext_vector_type(16)));
typedef short bf16x8 __attribute__((ext_vector_type(8)));
typedef short s16x4 __attribute__((ext_vector_type(4)));
typedef int v8i __attribute__((ext_vector_type(8)));

constexpr int NTOK = 32768, DM = 1024, SEQ = 8192, NBATCH = 4;
constexpr int EV_IN = 1792, OD_IN = 3072;
constexpr int NEXP = 32, MOE_H = 512, LIST_CAP = 32768;
constexpr float C2 = 0.125f * 1.4426950408889634f;
constexpr float LOG2E = 1.4426950408889634f;
constexpr float LAM_INIT = 0.35550906759f;

constexpr size_t MiB = 1u << 20;
constexpr size_t WS_CTL = 0, CTL_ZERO_BYTES = 1 * MiB;
constexpr size_t WS_WIN0 = 1 * MiB, WS_WOUT0 = 5 * MiB, WS_WIN1 = 7 * MiB, WS_WOUT1 = 13 * MiB, WS_TBL = 15 * MiB;
constexpr size_t WS_W13 = 16 * MiB, WS_W2 = 80 * MiB;
constexpr size_t WS_HB = 112 * MiB;
constexpr size_t WS_Y = 176 * MiB;
constexpr size_t WS_Z0 = 240 * MiB, WS_QR = 352 * MiB, WS_KR = 384 * MiB, WS_QR8 = 392 * MiB, WS_KR8 = 408 * MiB, WS_K8T0 = 408 * MiB, WS_V8T0 = 412 * MiB;
constexpr size_t WS_K8T1 = 304 * MiB, WS_V8T1 = 336 * MiB;
constexpr size_t WS_Q1 = 240 * MiB, WS_K1 = 304 * MiB, WS_V1 = 368 * MiB, WS_OC1 = 432 * MiB, WS_OC0 = WS_HB;
constexpr size_t WS_H = 176 * MiB, WS_YS = 248 * MiB, WS_LIST = 392 * MiB, WS_TOKEP = 396 * MiB, WS_GATE = 396 * MiB + 512 * 1024;
constexpr size_t WS_XB = 432 * MiB;
constexpr size_t WS_END = 496 * MiB;
constexpr int TBL_COS = 0, TBL_SIN = 2048, TBL_BIAS = 4096, BIAS_STRIDE = 272;
constexpr int TBL_WR = 32768, WR_LAYER = 1024 * 48 + 64;
constexpr int CW_BAR = 4096;
constexpr int CW_CNT = 16384;

constexpr int RING_BYTES = 131072;
constexpr int LDS_BYTES = 147456;
constexpr int LDSCTL_OFF = LDS_BYTES - 1024;
constexpr int STASH_OFF = 78 * 1024;
constexpr int LC_BAR = 8;
constexpr int LC_TP = 16;
constexpr int LC_CNT = 64;
constexpr int LC_LCNT = 96;
constexpr int LC_LBASE = 128;
constexpr int LC_LP = 160;

#define LDS_WAIT() asm volatile("s_waitcnt lgkmcnt(0)" ::: "memory")
#define VM_WAIT() asm volatile("s_waitcnt vmcnt(0)" ::: "memory")
#define RLX_AGENT __ATOMIC_RELAXED, __HIP_MEMORY_SCOPE_AGENT

__device__ __forceinline__ unsigned f2bf(float f) { unsigned u = __builtin_bit_cast(unsigned, f); return (u + 0x7fffu + ((u >> 16) & 1u)) >> 16; }
__device__ __forceinline__ unsigned pk2(float lo, float hi) { return f2bf(lo) | (f2bf(hi) << 16); }
__device__ __forceinline__ float bf2f(unsigned short b) { return __builtin_bit_cast(float, (unsigned)b << 16); }
template <int CTRL> __device__ __forceinline__ float dpp_mov(float v) { return __builtin_bit_cast(float, __builtin_amdgcn_update_dpp(0, __builtin_bit_cast(int, v), CTRL, 0xf, 0xf, true)); }
__device__ __forceinline__ float wave_sum(float v) {
    v += dpp_mov<0xB1>(v); v += dpp_mov<0x4E>(v); v += dpp_mov<0x141>(v); v += dpp_mov<0x140>(v);
    { auto rr = __builtin_amdgcn_permlane16_swap(__float_as_uint(v), __float_as_uint(v), false, false); v = __uint_as_float(rr[0]) + __uint_as_float(rr[1]); }
    { auto rr = __builtin_amdgcn_permlane32_swap(__float_as_uint(v), __float_as_uint(v), false, false); v = __uint_as_float(rr[0]) + __uint_as_float(rr[1]); }
    return v;
}


__device__ __forceinline__ unsigned fp8_byte(float v) { return (unsigned)__builtin_amdgcn_cvt_pk_fp8_f32(v, v, 0, false) & 0xffu; }
__device__ __forceinline__ unsigned quad_pack_bytes(unsigned b) {
    const unsigned x0 = (unsigned)__builtin_amdgcn_update_dpp(0, (int)b, 0x00, 0xf, 0xf, true), x1 = (unsigned)__builtin_amdgcn_update_dpp(0, (int)b, 0x55, 0xf, 0xf, true);
    const unsigned x2 = (unsigned)__builtin_amdgcn_update_dpp(0, (int)b, 0xAA, 0xf, 0xf, true), x3 = (unsigned)__builtin_amdgcn_update_dpp(0, (int)b, 0xFF, 0xf, 0xf, true);
    return x0 | (x1 << 8) | (x2 << 16) | (x3 << 24);
}
namespace pg8 {
#define PG8_LAS __attribute__((address_space(3)))
typedef unsigned short bf16_t;
typedef short bf16x8 __attribute__((ext_vector_type(8)));
typedef float f32x4 __attribute__((ext_vector_type(4)));
typedef unsigned u32x4 __attribute__((ext_vector_type(4)));
constexpr int BM = 256, BK = 64, HALF = 128, HTB = HALF * BK * 2, STAGE_BYTES = 8 * HTB, NXCD = 8, WGM = 8;

__host__ __device__ __forceinline__ int lds_byte(int r, int c) { const int st = (r >> 4) * 2 + (c >> 5), rr = r & 15, cc = c & 31, ob = rr * 64 + cc * 2; return st * 1024 + (ob ^ (((ob >> 9) & 1) << 5)); }
__host__ __device__ __forceinline__ void stage_rc(int b, int& R, int& C) { const int st = b / 1024, sb = b % 1024, swz = sb ^ (((sb >> 9) & 1) << 5); R = (st >> 1) * 16 + swz / 64; C = (st & 1) * 32 + (swz % 64) / 2; }
__host__ __device__ __forceinline__ int perm32(int rho) { const int n = rho >> 4, i = rho & 15; return 8 * (i >> 2) + 4 * n + (i & 3); }

struct Unit { int pm, pn, e, rb; };
struct Gemm { const bf16_t* A; const bf16_t* Bt; int M, N, K; };

struct StaticOrder {
    int nM, nN, nwg, G, c;
    __device__ void init(int M, int N, int G_, int c_) { nM = M / BM; nN = N / BM; nwg = nM * nN; G = G_; c = c_; }
    __device__ bool next(int i, Unit& u) const {
        const long L = (long)i * G + c; if (L >= nwg) return false;
        int wgid = (int)L; { const int q = nwg / NXCD, r = nwg % NXCD, xcd = wgid % NXCD, off = wgid / NXCD; wgid = (xcd < r ? xcd * (q + 1) : r * (q + 1) + (xcd - r) * q) + off; }
        const int nig = WGM * nN, gid = wgid / nig, fm = gid * WGM, gsz = (nM - fm) < WGM ? (nM - fm) : WGM;
        u.pm = fm + ((wgid % nig) % gsz); u.pn = (wgid % nig) / gsz; u.e = 0; u.rb = 0; return true;
    }
    __device__ __forceinline__ unsigned arow(const Unit& u, int rr) const { return (unsigned)(u.pm * BM + rr); }
};

struct MoeOrder {
    const PG8_LAS int* tp; const PG8_LAS int* cn; const PG8_LAS int* lp; const int* list; int G, c, nunits; bool gather; bool xcd;
    __device__ __forceinline__ bool next(int i, Unit& u) const {
        int e_, rb_, pm_, pnl_; bool ok;
        if (xcd) {
            const int x = c & 7, y = c >> 3; const int uidx = i * 32 + y; ok = uidx < lp[4] * 4;
            const int rbl = uidx >> 2; pnl_ = uidx & 3; int j = 0;
#pragma unroll
            for (int q = 1; q < 4; ++q) j += (lp[q] <= rbl) ? 1 : 0;
            e_ = x + 8 * j; rb_ = rbl - lp[j]; pm_ = tp[e_] + rb_;
        } else {
            const int L = i * G + c; ok = L < nunits;
            const int rbg = L >> 2; pnl_ = L & 3; int e = 0;
#pragma unroll
            for (int j = 1; j < 32; ++j) e += (tp[j] <= rbg) ? 1 : 0;
            e_ = e; pm_ = rbg; rb_ = rbg - tp[e];
        }
        u.e = __builtin_amdgcn_readfirstlane(e_); u.rb = __builtin_amdgcn_readfirstlane(rb_); u.pm = __builtin_amdgcn_readfirstlane(pm_); u.pn = __builtin_amdgcn_readfirstlane(e_ * 4 + pnl_);
        return ok;
    }
    __device__ __forceinline__ unsigned arow(const Unit& u, int rr) const {
        if (!gather) return (unsigned)(u.pm * BM + rr);
        const int idx = u.rb * BM + rr; unsigned t = 0u;
        if (idx < cn[u.e]) t = (unsigned)list[(size_t)u.e * 32768 + idx];
        return t;
    }
};

__device__ __forceinline__ unsigned cvt_pk_bf16(float lo, float hi) { unsigned r; asm volatile("v_cvt_pk_bf16_f32 %0, %1, %2" : "=v"(r) : "v"(lo), "v"(hi)); return r; }

struct EpiBf16 {
    static constexpr bool PERM = true;
    bf16_t* O; int ldc; int split_cols; size_t split_stride; float scale0; int pn_mask; bool f8;
    __device__ __forceinline__ void operator()(const f32x4 (&acc)[2][2][4][2], const Unit& u, int wr, int wc, int fr, int fq) const {
        const int row0 = u.pm * BM + wr * 64 + fr; int colt = (u.pn & pn_mask) * BM; bf16_t* base = O;
        float sc = 1.f; if (split_cols) { const int t = colt / split_cols; base += (size_t)t * split_stride; colt -= t * split_cols; if (t == 0) sc = scale0; }
        if (f8) sc = 8.0f;
        const int col0 = colt + wc * 32 + 8 * fq;
#pragma unroll
        for (int ai = 0; ai < 2; ++ai)
#pragma unroll
            for (int m = 0; m < 4; ++m) { const size_t ro = (size_t)(row0 + ai * HALF + m * 16) * ldc + col0;
#pragma unroll
                for (int bj = 0; bj < 2; ++bj) { f32x4 v0 = acc[ai][bj][m][0] * sc, v1 = acc[ai][bj][m][1] * sc;
                    if (f8) { typedef unsigned u32x2 __attribute__((ext_vector_type(2)));
                        int d0 = __builtin_amdgcn_cvt_pk_fp8_f32(v0[0], v0[1], 0, false); d0 = __builtin_amdgcn_cvt_pk_fp8_f32(v0[2], v0[3], d0, true);
                        int d1 = __builtin_amdgcn_cvt_pk_fp8_f32(v1[0], v1[1], 0, false); d1 = __builtin_amdgcn_cvt_pk_fp8_f32(v1[2], v1[3], d1, true);
                        *(u32x2*)((unsigned char*)base + ro + bj * HALF) = (u32x2){(unsigned)d0, (unsigned)d1};
                    } else {
                    u32x4 w; w.x = cvt_pk_bf16(v0[0], v0[1]); w.y = cvt_pk_bf16(v0[2], v0[3]); w.z = cvt_pk_bf16(v1[0], v1[1]); w.w = cvt_pk_bf16(v1[2], v1[3]);
                    *(u32x4*)(base + ro + bj * HALF) = w; } } }
    }
};
struct EpiRes {
    static constexpr bool PERM = true;
    const float* base32; const bf16_t* base16; bf16_t* out; int ldc;
    __device__ __forceinline__ void operator()(const f32x4 (&acc)[2][2][4][2], const Unit& u, int wr, int wc, int fr, int fq) const {
        const int row0 = u.pm * BM + wr * 64 + fr, col0 = u.pn * BM + wc * 32 + 8 * fq;
#pragma unroll
        for (int ai = 0; ai < 2; ++ai)
#pragma unroll
            for (int m = 0; m < 4; ++m) { const size_t off = (size_t)(row0 + ai * HALF + m * 16) * ldc + col0;
#pragma unroll
                for (int bj = 0; bj < 2; ++bj) { f32x4 b0, b1;
                    if (base32) { b0 = *(const f32x4*)(base32 + off + bj * HALF); b1 = *(const f32x4*)(base32 + off + bj * HALF + 4); }
                    else { const u32x4 w = *(const u32x4*)(base16 + off + bj * HALF);
                        b0 = (f32x4){__builtin_bit_cast(float, w.x << 16), __builtin_bit_cast(float, w.x & 0xffff0000u), __builtin_bit_cast(float, w.y << 16), __builtin_bit_cast(float, w.y & 0xffff0000u)};
                        b1 = (f32x4){__builtin_bit_cast(float, w.z << 16), __builtin_bit_cast(float, w.z & 0xffff0000u), __builtin_bit_cast(float, w.w << 16), __builtin_bit_cast(float, w.w & 0xffff0000u)}; }
                    const f32x4 v0 = b0 + acc[ai][bj][m][0], v1 = b1 + acc[ai][bj][m][1];
                    u32x4 o; o.x = cvt_pk_bf16(v0[0], v0[1]); o.y = cvt_pk_bf16(v0[2], v0[3]); o.z = cvt_pk_bf16(v1[0], v1[1]); o.w = cvt_pk_bf16(v1[2], v1[3]);
                    *(u32x4*)(out + off + bj * HALF) = o; } }
    }
};
struct EpiQKV8 {
    static constexpr bool PERM = true;
    unsigned char* Q8; unsigned char* K8; bf16_t* V; float qscale; bool ktiled;
    __device__ __forceinline__ void operator()(const f32x4 (&acc)[2][2][4][2], const Unit& u, int wr, int wc, int fr, int fq) const {
        const int row0 = u.pm * BM + wr * 64 + fr; const int colt = u.pn * BM; const int t = colt >> 10; const int col0 = (colt & 1023) + wc * 32 + 8 * fq;
        const float sc = t == 0 ? qscale : 1.0f;
#pragma unroll
        for (int ai = 0; ai < 2; ++ai)
#pragma unroll
            for (int m = 0; m < 4; ++m) { const size_t ro = (size_t)(row0 + ai * HALF + m * 16) * 1024 + col0;
#pragma unroll
                for (int bj = 0; bj < 2; ++bj) { const f32x4 v0 = acc[ai][bj][m][0] * sc, v1 = acc[ai][bj][m][1] * sc;
                    if (t == 2) { u32x4 w; w.x = cvt_pk_bf16(v0[0], v0[1]); w.y = cvt_pk_bf16(v0[2], v0[3]); w.z = cvt_pk_bf16(v1[0], v1[1]); w.w = cvt_pk_bf16(v1[2], v1[3]);
                        if (ktiled) { const int mrow = row0 + ai * HALF + m * 16, n = col0 + bj * HALF; const int bh = (mrow >> 13) * 8 + (n >> 7), sq = mrow & 8191, d = n & 127;
                            *(u32x4*)(V + (((size_t)bh * 128 + (sq >> 6)) * 4 + (d >> 5)) * 2048 + (sq & 63) * 32 + (d & 31)) = w; }
                        else *(u32x4*)(V + ro + bj * HALF) = w; }
                    else { int d0 = __builtin_amdgcn_cvt_pk_fp8_f32(v0[0], v0[1], 0, false); d0 = __builtin_amdgcn_cvt_pk_fp8_f32(v0[2], v0[3], d0, true);
                        int d1 = __builtin_amdgcn_cvt_pk_fp8_f32(v1[0], v1[1], 0, false); d1 = __builtin_amdgcn_cvt_pk_fp8_f32(v1[2], v1[3], d1, true);
                        typedef int i32x2 __attribute__((ext_vector_type(2)));
                        if (t == 1 && ktiled) { const int mrow = row0 + ai * HALF + m * 16, n = col0 + bj * HALF; const int strm = ((mrow >> 13) * 8 + (n >> 7)) * 2 + ((n >> 6) & 1), sq = mrow & 8191, dd = n & 63;
                            *(i32x2*)(K8 + ((((size_t)strm * 128 + (sq >> 6)) * 4 + (dd >> 4)) * 64 + (sq & 63)) * 16 + (dd & 15)) = (i32x2){d0, d1}; }
                        else *(i32x2*)((t == 0 ? Q8 : K8) + ro + bj * HALF) = (i32x2){d0, d1}; } } }
    }
};
__device__ __forceinline__ float silu_mul(float a, float b) { return a * b * __builtin_amdgcn_rcpf(1.0f + __builtin_amdgcn_exp2f(-a * 1.4426950408889634f)); }
struct EpiSwiglu {
    static constexpr bool PERM = true;
    bf16_t* O; bool f8;
    __device__ __forceinline__ void operator()(const f32x4 (&acc)[2][2][4][2], const Unit& u, int wr, int wc, int fr, int fq) const {
        const int row0 = u.pm * BM + wr * 64 + fr, col0 = (u.pn & 3) * 128 + wc * 32 + 8 * fq;
#pragma unroll
        for (int ai = 0; ai < 2; ++ai)
#pragma unroll
            for (int m = 0; m < 4; ++m) { const size_t ro = (size_t)(row0 + ai * HALF + m * 16) * 512 + col0;
                const f32x4 a0 = acc[ai][0][m][0], a1 = acc[ai][0][m][1], b0 = acc[ai][1][m][0], b1 = acc[ai][1][m][1];
                if (f8) { typedef unsigned u32x2 __attribute__((ext_vector_type(2)));
                    int d0 = __builtin_amdgcn_cvt_pk_fp8_f32(4.f * silu_mul(a0[0], b0[0]), 4.f * silu_mul(a0[1], b0[1]), 0, false); d0 = __builtin_amdgcn_cvt_pk_fp8_f32(4.f * silu_mul(a0[2], b0[2]), 4.f * silu_mul(a0[3], b0[3]), d0, true);
                    int d1 = __builtin_amdgcn_cvt_pk_fp8_f32(4.f * silu_mul(a1[0], b1[0]), 4.f * silu_mul(a1[1], b1[1]), 0, false); d1 = __builtin_amdgcn_cvt_pk_fp8_f32(4.f * silu_mul(a1[2], b1[2]), 4.f * silu_mul(a1[3], b1[3]), d1, true);
                    *(u32x2*)((unsigned char*)O + ro) = (u32x2){(unsigned)d0, (unsigned)d1};
                } else {
                u32x4 w; w.x = cvt_pk_bf16(silu_mul(a0[0], b0[0]), silu_mul(a0[1], b0[1])); w.y = cvt_pk_bf16(silu_mul(a0[2], b0[2]), silu_mul(a0[3], b0[3]));
                w.z = cvt_pk_bf16(silu_mul(a1[0], b1[0]), silu_mul(a1[1], b1[1])); w.w = cvt_pk_bf16(silu_mul(a1[2], b1[2]), silu_mul(a1[3], b1[3]));
                *(u32x4*)(O + ro) = w; } }
    }
};

template <class Epi, class Sched, bool ALIGN_EPI, bool F8 = false, int SCA = 127, int SCB = 127>
__device__ __forceinline__ void gemm_phase(PG8_LAS unsigned char* lds, const Gemm g, const Sched& S, const Epi& E) {
    const int tid = threadIdx.x, wid = __builtin_amdgcn_readfirstlane(tid >> 6), lane = tid & 63, wr = wid >> 2, wc = wid & 3, fr = lane & 15, fq = lane >> 4;
    const int K = g.K, nt = K / BK;
    int RA[2], CA[2]; unsigned voffB[2];
#pragma unroll
    for (int i = 0; i < 2; ++i) { int R, C; stage_rc(tid * 16 + i * 8192, R, C); RA[i] = R; CA[i] = C; const int Rb = Epi::PERM ? ((R & ~31) + perm32(R & 31)) : R; voffB[i] = (unsigned)(Rb * K + C) * 2u; }
    const size_t kstep = (size_t)(BK * 2);
    const size_t hstep = (size_t)HALF * K * 2;
    const size_t tstep = 2 * hstep;
    const unsigned ldsw = (unsigned)wid * 1024u;
    const int aoff = lds_byte(wr * 64 + fr, fq * 8), boff = lds_byte(wc * 32 + fr, fq * 8);
#define PG8_SA(b, h) (((b) * 2 + (h)) * HTB)
#define PG8_SB(b, h) ((4 + (b) * 2 + (h)) * HTB)
#define PG8_STAGE(bufoff, gbase, voff) do { _Pragma("unroll") for (int _i = 0; _i < 2; ++_i) \
        __builtin_amdgcn_global_load_lds((const unsigned*)((const char*)(gbase) + (voff)[_i]), (PG8_LAS unsigned*)(lds + (bufoff) + ldsw + _i * 8192), 16, 0, 0); } while (0)
#define PG8_LD8(p_) ({ typedef int v4i_ __attribute__((ext_vector_type(4))); const v4i_ lo_ = *(const PG8_LAS v4i_*)(p_), hi_ = *(const PG8_LAS v4i_*)((p_) + 1024); __builtin_shufflevector(lo_, hi_, 0, 1, 2, 3, 4, 5, 6, 7); })
#define PG8_LDA(dst, b, h) do { if (F8) { _Pragma("unroll") for (int m = 0; m < 4; ++m) dst##8[m] = PG8_LD8(lds + PG8_SA(b, h) + aoff + m * 2048); } \
        else { _Pragma("unroll") for (int m = 0; m < 4; ++m) _Pragma("unroll") for (int k = 0; k < 2; ++k) dst[m][k] = *(const PG8_LAS bf16x8*)(lds + PG8_SA(b, h) + aoff + m * 2048 + k * 1024); } } while (0)
#define PG8_LDB(dst, b, h) do { if (F8) { _Pragma("unroll") for (int n = 0; n < 2; ++n) dst##8[n] = PG8_LD8(lds + PG8_SB(b, h) + boff + n * 2048); } \
        else { _Pragma("unroll") for (int n = 0; n < 2; ++n) _Pragma("unroll") for (int k = 0; k < 2; ++k) dst[n][k] = *(const PG8_LAS bf16x8*)(lds + PG8_SB(b, h) + boff + n * 2048 + k * 1024); } } while (0)
#define PG8_MMA(ai, bj, At, Bt) do { __builtin_amdgcn_s_setprio(1); \
        if (F8) { _Pragma("unroll") for (int m = 0; m < 4; ++m) _Pragma("unroll") for (int n = 0; n < 2; ++n) \
            asm volatile("v_mfma_scale_f32_16x16x128_f8f6f4 %0, %1, %2, %0, %3, %4 op_sel_hi:[0,0,0]" : "+v"(acc[ai][bj][m][n]) : "v"(Bt##8[n]), "v"(At##8[m]), "v"(scb_), "v"(sca_)); } \
        else { _Pragma("unroll") for (int m = 0; m < 4; ++m) _Pragma("unroll") for (int n = 0; n < 2; ++n) _Pragma("unroll") for (int k = 0; k < 2; ++k) \
        acc[ai][bj][m][n] = __builtin_amdgcn_mfma_f32_16x16x32_bf16(Bt[n][k], At[m][k], acc[ai][bj][m][n], 0, 0, 0); } __builtin_amdgcn_s_setprio(0); } while (0)
#define PG8_WAIT_V(n) asm volatile("s_waitcnt vmcnt(" #n ")" ::: "memory")
#define PG8_WAIT_L(n) asm volatile("s_waitcnt lgkmcnt(" #n ")" ::: "memory")
#define PG8_BAR __builtin_amdgcn_s_barrier()
#define PG8_SCHED __builtin_amdgcn_sched_barrier(0)
#define PG8_AOFF(dst, u) do { _Pragma("unroll") for (int _h = 0; _h < 2; ++_h) _Pragma("unroll") for (int _i = 0; _i < 2; ++_i) dst[_h][_i] = (S.arow(u, _h * HALF + RA[_i]) * (unsigned)K + (unsigned)CA[_i]) * 2u; } while (0)
    Unit cur, nxt; int ui = 0;
    if (!S.next(0, cur)) return;
    f32x4 acc[2][2][4][2];
#pragma unroll
    for (int a = 0; a < 2; ++a)
#pragma unroll
        for (int b = 0; b < 2; ++b)
#pragma unroll
            for (int m = 0; m < 4; ++m)
#pragma unroll
                for (int n = 0; n < 2; ++n) acc[a][b][m][n] = (f32x4){0.f, 0.f, 0.f, 0.f};
    bf16x8 At[4][2], B0[2][2], B1[2][2]; v8i At8[4], B08[2], B18[2]; const int sca_ = SCA * 0x01010101, scb_ = SCB * 0x01010101;
    unsigned offc[2][2], offn[2][2];
    PG8_AOFF(offc, cur);
    const char* const cA = (const char*)g.A; const char* cB = (const char*)g.Bt + (size_t)cur.pn * tstep;
    PG8_STAGE(PG8_SB(0, 0), cB, voffB); PG8_STAGE(PG8_SB(0, 1), cB + hstep, voffB); PG8_STAGE(PG8_SA(0, 0), cA, offc[0]); PG8_STAGE(PG8_SA(0, 1), cA, offc[1]);
    if (wr == 1) PG8_BAR;
    PG8_WAIT_V(2); PG8_BAR;
    PG8_STAGE(PG8_SB(1, 0), cB + kstep, voffB); PG8_STAGE(PG8_SA(1, 0), cA + kstep, offc[0]); PG8_STAGE(PG8_SB(1, 1), cB + hstep + kstep, voffB);
    PG8_WAIT_V(6); PG8_BAR;
    for (;;) {
        const bool has_next = S.next(ui + 1, nxt);
        if (has_next) { PG8_AOFF(offn, nxt); }
        else {
#pragma unroll
            for (int h = 0; h < 2; ++h)
#pragma unroll
                for (int i = 0; i < 2; ++i) offn[h][i] = offc[h][i]; }
        const char* nB = has_next ? (const char*)g.Bt + (size_t)nxt.pn * tstep : cB;
        for (int t = 0; t < nt; t += 2) {
            const bool last = (t == nt - 2);
            const char* a1 = cA + (size_t)(t + 1) * kstep;
            const char* a2 = last ? cA : cA + (size_t)(t + 2) * kstep; const char* b2 = last ? nB : cB + (size_t)(t + 2) * kstep;
            const char* a3 = a2 + kstep; const char* b3 = b2 + kstep;
            unsigned o2[2][2];
#pragma unroll
            for (int h = 0; h < 2; ++h)
#pragma unroll
                for (int i = 0; i < 2; ++i) o2[h][i] = last ? offn[h][i] : offc[h][i];
            PG8_LDB(B0, 0, 0); PG8_LDB(B1, 0, 1); PG8_SCHED; PG8_LDA(At, 0, 0); PG8_STAGE(PG8_SA(1, 1), a1, offc[1]);
            PG8_WAIT_V(8); PG8_WAIT_L(0); PG8_BAR; PG8_MMA(0, 0, At, B0); PG8_MMA(0, 1, At, B1); PG8_BAR; PG8_SCHED;
            PG8_LDA(At, 0, 1); PG8_STAGE(PG8_SB(0, 0), b2, voffB); PG8_STAGE(PG8_SB(0, 1), b2 + hstep, voffB); PG8_STAGE(PG8_SA(0, 0), a2, o2[0]);
            PG8_WAIT_V(8); PG8_WAIT_L(0); PG8_BAR; PG8_MMA(1, 0, At, B0); PG8_MMA(1, 1, At, B1); PG8_BAR; PG8_SCHED;
            PG8_LDB(B0, 1, 0); PG8_LDB(B1, 1, 1); PG8_SCHED; PG8_LDA(At, 1, 0); PG8_STAGE(PG8_SA(0, 1), a2, o2[1]);
            PG8_WAIT_V(8); PG8_WAIT_L(0); PG8_BAR; PG8_MMA(0, 0, At, B0); PG8_MMA(0, 1, At, B1); PG8_BAR; PG8_SCHED;
            PG8_LDA(At, 1, 1); PG8_STAGE(PG8_SB(1, 0), b3, voffB); PG8_STAGE(PG8_SB(1, 1), b3 + hstep, voffB); PG8_STAGE(PG8_SA(1, 0), a3, o2[0]);
            PG8_WAIT_V(8); PG8_WAIT_L(0); PG8_BAR; PG8_MMA(1, 0, At, B0); PG8_MMA(1, 1, At, B1); PG8_BAR; PG8_SCHED;
        }
        if constexpr (ALIGN_EPI) { if (wr == 0) PG8_BAR; }
        if (F8) asm volatile("s_nop 15\n\ts_nop 15" ::: "memory");
        E(acc, cur, wr, wc, fr, fq);
        if (!has_next) break;
#pragma unroll
        for (int a = 0; a < 2; ++a)
#pragma unroll
            for (int b = 0; b < 2; ++b)
#pragma unroll
                for (int m = 0; m < 4; ++m)
#pragma unroll
                    for (int n = 0; n < 2; ++n) acc[a][b][m][n] = (f32x4){0.f, 0.f, 0.f, 0.f};
        cur = nxt; cB = nB; ++ui;
#pragma unroll
        for (int h = 0; h < 2; ++h)
#pragma unroll
            for (int i = 0; i < 2; ++i) offc[h][i] = offn[h][i];
        if constexpr (ALIGN_EPI) { if (wr == 1) PG8_BAR; }
    }
    PG8_WAIT_V(0);
    if constexpr (!ALIGN_EPI) { if (wr == 0) PG8_BAR; }
    PG8_BAR;
#undef PG8_SA
#undef PG8_SB
#undef PG8_STAGE
#undef PG8_LDA
#undef PG8_LDB
#undef PG8_MMA
#undef PG8_LD8
#undef PG8_WAIT_V
#undef PG8_WAIT_L
#undef PG8_BAR
#undef PG8_SCHED
#undef PG8_AOFF
}
}

#define XB_TMO      128
#define XB_XCNT(j)  (256  + 64 * (j))
#define XB_XSUB(j)  (1280 + 64 * (j))
#define XB_XGEN(j)  (2304 + 64 * (j))
#define XB_TOP      3328
#define XB_TOPGEN   3392
#define XCD_BAR_WORDS 3456
#define XB_SPIN_CAP (1u << 18)

__device__ __forceinline__ unsigned xb_ld(unsigned* p)              { return __hip_atomic_load(p, __ATOMIC_RELAXED, __HIP_MEMORY_SCOPE_AGENT); }
__device__ __forceinline__ unsigned xb_add(unsigned* p, unsigned v) { return __hip_atomic_fetch_add(p, v, __ATOMIC_RELAXED, __HIP_MEMORY_SCOPE_AGENT); }
__device__ __forceinline__ unsigned xb_xcc_id() { return (unsigned)__builtin_amdgcn_s_getreg((3 << 11) | 20) & 0xFu; }
#define XB_SPIN(cond, bar) do { unsigned _sp = 0; while (cond) { __builtin_amdgcn_s_sleep(1); \
    if ((++_sp & 255u) == 0u) { if (xb_ld(&(bar)[XB_TMO])) break; if (_sp > XB_SPIN_CAP) { atomicAdd(&(bar)[XB_TMO], 1u); break; } } } } while (0)

struct XcdBarrier { unsigned* bar; unsigned x; volatile LAS unsigned* st; };

__device__ __forceinline__ XcdBarrier xcd_barrier_post(unsigned* bar, volatile LAS unsigned* st) {
    XcdBarrier b; b.bar = bar; b.x = xb_xcc_id(); b.st = st;
    if (threadIdx.x == 0) (void)xb_add(&bar[XB_XCNT(b.x)], 1u);
    return b;
}
__device__ __forceinline__ void xcd_barrier_complete(unsigned* bar, unsigned x, unsigned& nloc, unsigned& nx) {
    const unsigned G = gridDim.x * gridDim.y * gridDim.z;
    unsigned sum, cnt, mine, sp = 0u;
    for (;;) {
        sum = 0u; cnt = 0u; mine = 0u;
#pragma unroll
        for (unsigned j = 0; j < 16; ++j) { const unsigned c = xb_ld(&bar[XB_XCNT(j)]); sum += c; cnt += (c > 0u) ? 1u : 0u; mine = (j == x) ? c : mine; }
        if (sum == G) break;
        __builtin_amdgcn_s_sleep(1);
        if ((++sp & 255u) == 0u) { if (xb_ld(&bar[XB_TMO])) break; if (sp > XB_SPIN_CAP) { atomicAdd(&bar[XB_TMO], 1u); break; } }
    }
    nloc = mine > 0u ? mine : 1u; nx = cnt > 0u ? cnt : 1u;
}
__device__ __forceinline__ void xcd_barrier(const XcdBarrier& b) {
    asm volatile("s_waitcnt vmcnt(0)" ::: "memory");
    __syncthreads();
    if (threadIdx.x == 0) {
        unsigned* bar = b.bar;
        __builtin_amdgcn_s_waitcnt(0);
        unsigned nloc = b.st[0], nx = b.st[1];
        if (nloc == 0u) { xcd_barrier_complete(bar, b.x, nloc, nx); b.st[0] = nloc; b.st[1] = nx; }
        const unsigned old = xb_add(&bar[XB_XSUB(b.x)], 1u);
        const unsigned gen = old / nloc;
        if (old + 1u == (gen + 1u) * nloc) {
            __builtin_amdgcn_fence(__ATOMIC_RELEASE, "agent");
            asm volatile("s_waitcnt vmcnt(0)" ::: "memory");
            const unsigned og = xb_add(&bar[XB_TOP], 1u);
            const unsigned tg = og / nx;
            if (og + 1u == (tg + 1u) * nx) xb_add(&bar[XB_TOPGEN], 1u);
            else XB_SPIN(xb_ld(&bar[XB_TOPGEN]) == tg, bar);
            __builtin_amdgcn_fence(__ATOMIC_ACQUIRE, "agent");
            xb_add(&bar[XB_XGEN(b.x)], 1u);
            asm volatile("s_waitcnt vmcnt(0)" ::: "memory");
        } else {
            XB_SPIN(xb_ld(&bar[XB_XGEN(b.x)]) == gen, bar);
            __builtin_amdgcn_fence(__ATOMIC_ACQUIRE, "agent");
            asm volatile("s_waitcnt vmcnt(0)" ::: "memory");
        }
    }
    __syncthreads();
}

template <bool F8 = false>
__device__ __forceinline__ void transpose_item(const float* W, int K, int N, bf16* WT, int kb, int nb, int dst_row0, LAS float* scr, int lane) {
    const int k0 = 64 * kb, n0 = 32 * nb;
#pragma unroll 8
    for (int i = 0; i < 32; ++i) { const int kk = 2 * i + (lane >> 5); scr[kk * 33 + (lane & 31)] = W[(size_t)(k0 + kk) * N + n0 + (lane & 31)]; }
    LDS_WAIT(); asm volatile("" ::: "memory");
    const int c = lane & 7;
#pragma unroll
    for (int j = 0; j < 4; ++j) { const int n = (lane >> 3) + 8 * j; const LAS float* s = scr + (8 * c) * 33 + n;
        if (F8) {
            int d0 = __builtin_amdgcn_cvt_pk_fp8_f32(s[0 * 33] * 32.f, s[1 * 33] * 32.f, 0, false); d0 = __builtin_amdgcn_cvt_pk_fp8_f32(s[2 * 33] * 32.f, s[3 * 33] * 32.f, d0, true);
            int d1 = __builtin_amdgcn_cvt_pk_fp8_f32(s[4 * 33] * 32.f, s[5 * 33] * 32.f, 0, false); d1 = __builtin_amdgcn_cvt_pk_fp8_f32(s[6 * 33] * 32.f, s[7 * 33] * 32.f, d1, true);
            *(GAS v2u*)((unsigned char*)WT + (size_t)(dst_row0 + n) * K + k0 + 8 * c) = (v2u){(unsigned)d0, (unsigned)d1};
        } else {
        v4u o; o.x = pk2(s[0 * 33], s[1 * 33]); o.y = pk2(s[2 * 33], s[3 * 33]); o.z = pk2(s[4 * 33], s[5 * 33]); o.w = pk2(s[6 * 33], s[7 * 33]);
        *(GAS v4u*)(WT + (size_t)(dst_row0 + n) * K + k0 + 8 * c) = o; } }
    LDS_WAIT(); asm volatile("" ::: "memory");
}
template <bool F8 = false>
__device__ __forceinline__ void transpose_plain(const float* W, int K, int N, bf16* WT, LAS float* scr, int gw, int ngw, int lane) {
    const int nblk = N / 32, nitems = (K / 64) * nblk;
    for (int it = gw; it < nitems; it += ngw) { const int kb = it / nblk, nb = it % nblk; transpose_item<F8>(W, K, N, WT, kb, nb, 32 * nb, scr, lane); }
}
__device__ __forceinline__ void transpose_moe(const float* w1, const float* w3, const float* w2, bf16* W13T, bf16* W2T, LAS float* scr, int gw, int ngw, int lane) {
    constexpr int I13 = 16 * 16, I2 = 8 * 32, IPE = 2 * I13 + I2;
    for (int it = gw; it < NEXP * IPE; it += ngw) {
        const int e = it / IPE; int r = it % IPE;
        if (r < 2 * I13) { const int which = r / I13; r %= I13; const int kb = r / 16, nb = r % 16, n0 = 32 * nb;
            const float* W = (which ? w3 : w1) + (size_t)e * 1024 * 512;
            transpose_item<MOE_FP8 != 0>(W, 1024, 512, (bf16*)((unsigned char*)W13T + (size_t)e * 1024 * 1024 * (MOE_FP8 ? 1 : 2)), kb, nb, (n0 >> 7) * 256 + which * 128 + (n0 & 127), scr, lane);
        } else { r -= 2 * I13; const int kb = r / 32, nb = r % 32;
            transpose_item<MOE_FP8 != 0>(w2 + (size_t)e * 512 * 1024, 512, 1024, (bf16*)((unsigned char*)W2T + (size_t)e * 1024 * 512 * (MOE_FP8 ? 1 : 2)), kb, nb, 32 * nb, scr, lane); }
    }
}
__device__ __forceinline__ void rms_row(const float* xrow, const float* g, f32x4 (&v)[4], int lane) {
    const GAS f32x4* xr = (const GAS f32x4*)xrow + lane; const GAS f32x4* gr = (const GAS f32x4*)g + lane;
    float s = 0.f;
#pragma unroll
    for (int j = 0; j < 4; ++j) { v[j] = xr[64 * j]; s += (v[j].x * v[j].x + v[j].y * v[j].y) + (v[j].z * v[j].z + v[j].w * v[j].w); }
    const float rstd = 1.0f / sqrtf(wave_sum(s) * (1.f / DM) + 1e-6f);
#pragma unroll
    for (int j = 0; j < 4; ++j) { const f32x4 gg = gr[64 * j]; v[j] = v[j] * rstd * gg; }
}
__device__ __forceinline__ void rms_row_b16(const bf16* xrow, const float* g, f32x4 (&v)[4], int lane) {
    const GAS v2u* xr = (const GAS v2u*)xrow + lane; const GAS f32x4* gr = (const GAS f32x4*)g + lane;
    float s = 0.f;
#pragma unroll
    for (int j = 0; j < 4; ++j) { const v2u w = xr[64 * j]; v[j] = (f32x4){__builtin_bit_cast(float, w.x << 16), __builtin_bit_cast(float, w.x & 0xffff0000u), __builtin_bit_cast(float, w.y << 16), __builtin_bit_cast(float, w.y & 0xffff0000u)};
        s += (v[j].x * v[j].x + v[j].y * v[j].y) + (v[j].z * v[j].z + v[j].w * v[j].w); }
    const float rstd = 1.0f / sqrtf(wave_sum(s) * (1.f / DM) + 1e-6f);
#pragma unroll
    for (int j = 0; j < 4; ++j) { const f32x4 gg = gr[64 * j]; v[j] = v[j] * rstd * gg; }
}
__device__ __forceinline__ void store_row_bf16(bf16* orow, const f32x4 (&v)[4], int lane) {
    GAS unsigned long long* o8 = (GAS unsigned long long*)orow + lane;
#pragma unroll
    for (int j = 0; j < 4; ++j) o8[64 * j] = (unsigned long long)pk2(v[j].x, v[j].y) | ((unsigned long long)pk2(v[j].z, v[j].w) << 32);
}

__device__ __forceinline__ int t5_bucket(int rel) {
    const int n = rel < 0 ? -rel : rel; int ret = rel > 0 ? 16 : 0;
    int v;
    if (n < 8) v = n;
    else { const float nf = (float)n; int large = 8 + (int)(logf(nf / 8.0f) / 2.772588722239781f * 8.0f); v = large < 15 ? large : 15; }
    return ret + v;
}

__device__ __forceinline__ int crow(int r, int hi) { return (r & 3) + 8 * (r >> 2) + 4 * hi; }
__device__ __forceinline__ unsigned cvtpk(float lo, float hi) { unsigned r; asm volatile("v_cvt_pk_bf16_f32 %0, %1, %2" : "=v"(r) : "v"(lo), "v"(hi)); return r; }
__device__ __forceinline__ s16x4 vtr(const LAS char* p) { typedef short v4i16_t __attribute__((ext_vector_type(4))); return __builtin_bit_cast(s16x4, __builtin_amdgcn_ds_read_tr16_b64_v4i16((LAS v4i16_t*)p)); }

template <int DV, bool BIAS, bool FP8 = false>
__device__ __forceinline__ void attn_unit_v0(const bf16* Qp, int ldq, const bf16* Kp, int ldk, const bf16* Vp, int ldv, bf16* Op, int ldo, const LAS float* btbl, int q0, LAS unsigned char* lds) {
    const int tid = threadIdx.x, lane = tid & 63, r32 = lane & 31, hi = lane >> 5; const int wid = __builtin_amdgcn_readfirstlane(tid >> 6);
    constexpr int ND = DV / 32;
    LAS unsigned char* ldsK = lds; LAS unsigned char* ldsV = lds + 8192; LAS float* wsf = (LAS float*)(lds + 8192 + DV * 128) + wid * 64;
    bf16x8 qr[4]; v8i q8 = {0, 0, 0, 0, 0, 0, 0, 0};
    if (FP8) { const v4u a = *(const v4u*)((const unsigned char*)Qp + (size_t)(wid * 32 + r32) * ldq + hi * 32), b = *(const v4u*)((const unsigned char*)Qp + (size_t)(wid * 32 + r32) * ldq + hi * 32 + 16);
        q8 = (v8i){(int)a.x, (int)a.y, (int)a.z, (int)a.w, (int)b.x, (int)b.y, (int)b.z, (int)b.w}; }
    else {
#pragma unroll
    for (int d0 = 0; d0 < 4; ++d0) qr[d0] = *(const bf16x8*)(Qp + (size_t)(wid * 32 + r32) * ldq + d0 * 16 + hi * 8); }
    f32x16 o[ND];
#pragma unroll
    for (int d = 0; d < ND; ++d)
#pragma unroll
        for (int r = 0; r < 16; ++r) o[d][r] = 0.f;
    float l = 0.f;
    const int qpos = q0 + wid * 32 + r32;
    const LAS char* kp0 = (const LAS char*)ldsK + hi * 1024 + r32 * 16;
    const LAS char* vp0 = (const LAS char*)ldsV + ((lane >> 4) & 1) * 32 + (lane & 3) * 8 + (4 * hi + ((lane & 15) >> 2)) * 64;
    for (int t = 0; t < SEQ / 64; ++t) {
        __syncthreads();
        {
            if (FP8) { if (wid < 4) { const v4u kv = *(const v4u*)((const unsigned char*)Kp + (size_t)(t * 64 + lane) * ldk + wid * 16); *(LAS v4u*)(ldsK + wid * 1024 + lane * 16) = kv; } }
            else { const v4u kv = *(const v4u*)(Kp + (size_t)(t * 64 + lane) * ldk + wid * 8);
            *(LAS v4u*)(ldsK + wid * 1024 + lane * 16) = kv; }
#pragma unroll
            for (int pp = 0; pp < ND / 2; ++pp) { const int p = wid + 8 * pp, dq = p >> 2, rg = p & 3;
                const v4u vv = *(const v4u*)(Vp + (size_t)(t * 64 + 16 * rg + (lane >> 2)) * ldv + dq * 32 + (lane & 3) * 8);
                *(LAS v4u*)(ldsV + p * 1024 + lane * 16) = vv; }
        }
        __syncthreads();
        f32x16 p0, p1;
#pragma unroll
        for (int r = 0; r < 16; ++r) { p0[r] = 0.f; p1[r] = 0.f; }
        if (FP8) {
            const LAS char* k8 = (const LAS char*)ldsK + hi * 2048 + r32 * 16;
            const v4u a0 = *(const LAS v4u*)(k8), a1 = *(const LAS v4u*)(k8 + 1024), b0 = *(const LAS v4u*)(k8 + 512), b1 = *(const LAS v4u*)(k8 + 1024 + 512);
            const v8i ka = (v8i){(int)a0.x, (int)a0.y, (int)a0.z, (int)a0.w, (int)a1.x, (int)a1.y, (int)a1.z, (int)a1.w};
            const v8i kb = (v8i){(int)b0.x, (int)b0.y, (int)b0.z, (int)b0.w, (int)b1.x, (int)b1.y, (int)b1.z, (int)b1.w};
            p0 = __builtin_amdgcn_mfma_scale_f32_32x32x64_f8f6f4(ka, q8, p0, 0, 0, 0, 0x7f7f7f7f, 0, 0x7c7c7c7c);
            p1 = __builtin_amdgcn_mfma_scale_f32_32x32x64_f8f6f4(kb, q8, p1, 0, 0, 0, 0x7f7f7f7f, 0, 0x7c7c7c7c);
        } else {
#pragma unroll
        for (int d0 = 0; d0 < 4; ++d0) {
            const bf16x8 b0 = *(const LAS bf16x8*)(kp0 + d0 * 2048), b1 = *(const LAS bf16x8*)(kp0 + d0 * 2048 + 512);
            p0 = __builtin_amdgcn_mfma_f32_32x32x16_bf16(b0, qr[d0], p0, 0, 0, 0);
            p1 = __builtin_amdgcn_mfma_f32_32x32x16_bf16(b1, qr[d0], p1, 0, 0, 0);
        } }
        if (BIAS) {
            const int base = t * 64 + 4 * hi - qpos;
#pragma unroll
            for (int r = 0; r < 16; ++r) { int rel = base + (r & 3) + 8 * (r >> 2);
                int i0 = rel < -128 ? -128 : (rel > 128 ? 128 : rel); int rel1 = rel + 32; int i1 = rel1 < -128 ? -128 : (rel1 > 128 ? 128 : rel1);
                p0[r] += btbl[i0 + 128]; p1[r] += btbl[i1 + 128]; }
        }
        float sacc = 0.f;
#pragma unroll
        for (int r = 0; r < 16; ++r) { p0[r] = __builtin_amdgcn_exp2f(p0[r]); p1[r] = __builtin_amdgcn_exp2f(p1[r]); sacc += p0[r] + p1[r]; }
        l += sacc;
        v4u pw[4];
#pragma unroll
        for (int k = 0; k < 2; ++k) {
            pw[k]     = (v4u){cvtpk(p0[8 * k + 0], p0[8 * k + 1]), cvtpk(p0[8 * k + 2], p0[8 * k + 3]), cvtpk(p0[8 * k + 4], p0[8 * k + 5]), cvtpk(p0[8 * k + 6], p0[8 * k + 7])};
            pw[2 + k] = (v4u){cvtpk(p1[8 * k + 0], p1[8 * k + 1]), cvtpk(p1[8 * k + 2], p1[8 * k + 3]), cvtpk(p1[8 * k + 4], p1[8 * k + 5]), cvtpk(p1[8 * k + 6], p1[8 * k + 7])};
        }
#pragma unroll
        for (int d0 = 0; d0 < ND; ++d0)
#pragma unroll
            for (int ks = 0; ks < 4; ++ks) {
                const s16x4 lo = vtr(vp0 + d0 * 4096 + ks * 1024), hh = vtr(vp0 + d0 * 4096 + ks * 1024 + 512);
                const bf16x8 vf = (bf16x8){lo[0], lo[1], lo[2], lo[3], hh[0], hh[1], hh[2], hh[3]};
                o[d0] = __builtin_amdgcn_mfma_f32_32x32x16_bf16(__builtin_bit_cast(bf16x8, pw[ks]), vf, o[d0], 0, 0, 0);
            }
    }
    l += __shfl_xor(l, 32);
    if (hi == 0) wsf[r32] = l;
    LDS_WAIT(); asm volatile("" ::: "memory");
#pragma unroll
    for (int r = 0; r < 16; ++r) { const int row = crow(r, hi); const float rl = 1.0f / wsf[row];
#pragma unroll
        for (int d0 = 0; d0 < ND; ++d0) Op[(size_t)(wid * 32 + row) * ldo + d0 * 32 + r32] = (bf16)f2bf(o[d0][r] * rl); }
    LDS_WAIT();
}

namespace at1 {
#define SBAR() __builtin_amdgcn_sched_barrier(0)
#define PIN(x) asm volatile("" : "+v"(x))
template <int N, bool NOBAR = false> __device__ __forceinline__ void wait_bar() { if (NOBAR) asm volatile("s_waitcnt vmcnt(%0) lgkmcnt(0)" :: "n"(N) : "memory"); else asm volatile("s_waitcnt vmcnt(%0) lgkmcnt(0)\n\ts_barrier" :: "n"(N) : "memory"); }
__device__ __forceinline__ void glds16(const void* gsrc, unsigned lds_dst) { unsigned keep;
    asm volatile("s_mov_b32 %0, m0\n\ts_mov_b32 m0, %2\n\ts_nop 0\n\tglobal_load_lds_dwordx4 %1, off\n\ts_mov_b32 m0, %0" : "=&s"(keep) : "v"(gsrc), "s"(lds_dst) : "memory"); }
typedef float f32x2_t __attribute__((ext_vector_type(2))); typedef __bf16 bf16x2_t __attribute__((ext_vector_type(2)));
__device__ __forceinline__ unsigned cvtpk_s(float lo, float hi) { f32x2_t v = {lo, hi}; bf16x2_t b = __builtin_convertvector(v, bf16x2_t); return __builtin_bit_cast(unsigned, b); }
typedef const LAS char* lds_cptr;
__device__ __forceinline__ void kload2(bf16x8* kf, lds_cptr kp, int j) { kf[2 * j] = *(const LAS bf16x8*)(kp + j * 2048); kf[2 * j + 1] = *(const LAS bf16x8*)(kp + j * 2048 + 512); }

template <int DV, bool FP8> __host__ __device__ constexpr int lds_ws_off() { return (3 * (FP8 ? 4096 : 8192) + 3 * DV * 128) > 512 * DV ? (3 * (FP8 ? 4096 : 8192) + 3 * DV * 128) : 512 * DV; }
template <int DV, bool FP8> __host__ __device__ constexpr int lds_tbl_off() { return lds_ws_off<DV, FP8>() + 2048; }
template <int DV, bool BIAS, int TEST = 0, int MODE = 0, bool FP8 = false, bool TILED = false>
__device__ __forceinline__ void attn_unit(const bf16* Qp, int ldq, const bf16* __restrict__ Kp, int ldk, const bf16* __restrict__ Vp, int ldv, bf16* Op, int ldo, int q0, LAS unsigned char* lds, const LAS float* sgt = nullptr) {
    constexpr int ND = DV / 32, NV = ND / 2, VSLOT = DV * 128, KSLOT = FP8 ? 4096 : 8192, NT = SEQ / 64;
    constexpr int LDS_K = 0, LDS_V = 3 * KSLOT, LDS_WS = lds_ws_off<DV, FP8>(), LDS_TBL = LDS_WS + 2048;
    static_assert(LDS_WS >= LDS_V + 3 * VSLOT && LDS_WS >= 512 * DV && LDS_TBL + 2048 <= STASH_OFF, "LDS map");
    const int tid = threadIdx.x, lane = tid & 63, r32 = lane & 31, hi = lane >> 5; const int wid = __builtin_amdgcn_readfirstlane(tid >> 6);
    const unsigned lds0 = (unsigned)(uintptr_t)lds;
    LAS float* wsf = (LAS float*)(lds + LDS_WS) + wid * 64;
    const LAS float* btbl = (const LAS float*)(lds + LDS_TBL);
    const unsigned char* ksrc = TILED ? (const unsigned char*)Kp + (wid & 3) * 1024 + lane * 16 : FP8 ? (const unsigned char*)Kp + (size_t)lane * ldk + (wid & 3) * 16 : (const unsigned char*)(Kp + (size_t)lane * ldk + wid * 8);
    const bf16* vsrc0 = TILED ? Vp + wid * 512 + lane * 8 : Vp + (size_t)(16 * (wid & 3) + (lane >> 2)) * ldv + (wid >> 2) * 32 + (lane & 3) * 8;
    const bf16* vsrc1 = TILED ? vsrc0 + 4096 : vsrc0 + 64;
    const unsigned kdst = lds0 + LDS_K + wid * 1024, vdst = lds0 + LDS_V + wid * 1024;
#define DMA_K(t, s) if (!(TEST & 8) && (!FP8 || wid < 4)) glds16(ksrc + (size_t)(t) * (TILED ? 4096 : 64 * ldk * (FP8 ? 1 : 2)), (unsigned)__builtin_amdgcn_readfirstlane(kdst + (s) * KSLOT))
#define DMA_V(t, s) do { if (TEST & 8) break; glds16(vsrc0 + (size_t)(t) * (TILED ? (size_t)(DV * 64) : (size_t)64 * ldv), (unsigned)__builtin_amdgcn_readfirstlane(vdst + (s) * VSLOT)); \
        if (NV == 2) glds16(vsrc1 + (size_t)(t) * (TILED ? (size_t)(DV * 64) : (size_t)64 * ldv), (unsigned)__builtin_amdgcn_readfirstlane(vdst + (s) * VSLOT + 8192)); } while (0)
    const lds_cptr kp0 = (lds_cptr)lds + LDS_K + hi * (FP8 ? 2048 : 1024) + r32 * 16;
    const lds_cptr vp0 = (lds_cptr)lds + LDS_V + ((lane >> 4) & 1) * 32 + (lane & 3) * 8 + (4 * hi + ((lane & 15) >> 2)) * 64;
    DMA_K(0, 0); DMA_V(0, 0); DMA_K(1, 1);
    bf16x8 qr[4]; v8i q8 = {0, 0, 0, 0, 0, 0, 0, 0};
    if (FP8) { const unsigned char* qb_ = (const unsigned char*)Qp + (size_t)(wid * 32 + r32) * ldq + hi * 32; const v4u a = *(const v4u*)qb_, b = *(const v4u*)(qb_ + 16);
        q8 = (v8i){(int)a.x, (int)a.y, (int)a.z, (int)a.w, (int)b.x, (int)b.y, (int)b.z, (int)b.w}; }
    else {
#pragma unroll
        for (int d0 = 0; d0 < 4; ++d0) qr[d0] = *(const bf16x8*)(Qp + (size_t)(wid * 32 + r32) * ldq + d0 * 16 + hi * 8); }
    float l_reg = 0.f; f32x16 o[ND];
#pragma unroll
    for (int d = 0; d < ND; ++d) o[d] = f32x16{};
    const f32x16 zero16 = f32x16{};
    const int qw = q0 + wid * 32, qpos = qw + r32;
    int tl = 0, tr = NT; float fL = 1.f;
    if (BIAS) { tl = (qw - 191 >= 0) ? ((qw - 191) >> 6) + 1 : 0; tr = (qw + 158) >> 6; fL = __builtin_amdgcn_exp2f(btbl[0]); }
    f32x16 pA0, pA1, pB0, pB1; bf16x8 kf[8]; v8i kf8[2]; s16x4 vlo[8], vhi[8]; v4u pw0, pw1, pw2, pw3;
#define KLOAD8(n, kp_) do { const v4u a_ = *(const LAS v4u*)((kp_) + (n) * 512), b_ = *(const LAS v4u*)((kp_) + (n) * 512 + 1024); kf8[n] = (v8i){(int)a_.x, (int)a_.y, (int)a_.z, (int)a_.w, (int)b_.x, (int)b_.y, (int)b_.z, (int)b_.w}; } while (0)
#define MF8(kf_, c_) __builtin_amdgcn_mfma_scale_f32_32x32x64_f8f6f4(kf_, q8, c_, 0, 0, 0, 0x7f7f7f7f, 0, 0x7c7c7c7c)
#define WAITB(N) do { if (FP8 && wid >= 4) wait_bar<(N) - 1, (TEST & 16) != 0>(); else wait_bar<(N), (TEST & 16) != 0>(); } while (0)
    if (TEST & 32) { pB0 = f32x16{}; pB1 = f32x16{}; }
    if (TEST & 64) { _Pragma("unroll") for (int i_ = 0; i_ < 8; ++i_) { vlo[i_] = (s16x4){1, 2, 3, 4}; vhi[i_] = (s16x4){4, 3, 2, 1}; } }
    int s_prev = 0, s_cur = 0, s_next = 1;
#define ROT() do { s_prev = s_cur; s_cur = s_next; s_next = (s_next == 2) ? 0 : s_next + 1; } while (0)
#define ADD_BIAS(C0, C1, t) do { if (BIAS && (t) >= tl && (t) <= tr) { const int base_ = (t) * 64 + 4 * hi - qpos; \
        _Pragma("unroll") for (int r = 0; r < 16; ++r) { const int rel0 = base_ + (r & 3) + 8 * (r >> 2); const int rel1 = rel0 + 32; \
            const int i0 = (rel0 < -128 ? -128 : (rel0 > 128 ? 128 : rel0)) + 128, i1 = (rel1 < -128 ? -128 : (rel1 > 128 ? 128 : rel1)) + 128; \
            C0[r] += btbl[i0]; C1[r] += btbl[i1]; } } } while (0)
    DMA_K(2, 2);
    if (FP8) wait_bar<0, (TEST & 16) != 0>(); else wait_bar<NV + 2, (TEST & 16) != 0>();
    {
        if (FP8) { KLOAD8(0, kp0); KLOAD8(1, kp0); pA0 = MF8(kf8[0], zero16); pA1 = MF8(kf8[1], zero16); }
        else {
#pragma unroll
        for (int j = 0; j < 4; ++j) kload2(kf, kp0, j);
        pA0 = __builtin_amdgcn_mfma_f32_32x32x16_bf16(kf[0], qr[0], zero16, 0, 0, 0); pA1 = __builtin_amdgcn_mfma_f32_32x32x16_bf16(kf[1], qr[0], zero16, 0, 0, 0);
#pragma unroll
        for (int d0 = 1; d0 < 4; ++d0) { pA0 = __builtin_amdgcn_mfma_f32_32x32x16_bf16(kf[2 * d0], qr[d0], pA0, 0, 0, 0); pA1 = __builtin_amdgcn_mfma_f32_32x32x16_bf16(kf[2 * d0 + 1], qr[d0], pA1, 0, 0, 0); } }
        ADD_BIAS(pA0, pA1, 0);
#pragma unroll
        for (int r = 0; r < 16; ++r) { pA0[r] = __builtin_amdgcn_exp2f(pA0[r]); pA1[r] = __builtin_amdgcn_exp2f(pA1[r]); }
    }
    wait_bar<0, (TEST & 16) != 0>();
    DMA_K(3, 0); DMA_V(1, 1);
    ROT();
    if (FP8) { KLOAD8(0, kp0 + s_cur * KSLOT); KLOAD8(1, kp0 + s_cur * KSLOT); }
    else {
#pragma unroll
    for (int j = 0; j < 4; ++j) kload2(kf, kp0 + s_cur * KSLOT, j); }
    WAITB(1 + NV);
#define PKW(P, B) ((TEST & 256) ? 0x3f803f80u : cvtpk_s(P[B], P[B + 1]))
#define PAF(k) __builtin_bit_cast(bf16x8, pw##k)
#define VFR(i) (bf16x8){vlo[i][0], vlo[i][1], vlo[i][2], vlo[i][3], vhi[i][0], vhi[i][1], vhi[i][2], vhi[i][3]}
#define MF(a, b, c) __builtin_amdgcn_mfma_f32_32x32x16_bf16(a, b, c, 0, 0, 0)
#define GAPA(MFS, A0, A1, A2, A3, W0, W1, PW) do { if (!(TEST & 32)) { MFS; } if (!(TEST & 2)) { sacc += A0; sacc += A1; sacc += A2; sacc += A3; PIN(sacc); } W0; W1; PIN(PW); SBAR(); } while (0)
#define EX(v) ((TEST & 1) ? (v) : __builtin_amdgcn_exp2f(v))
#define GAPB4(MFS, X, B) do { if (!(TEST & 4)) { MFS; } X[B] = EX(X[B]); X[B + 1] = EX(X[B + 1]); X[B + 2] = EX(X[B + 2]); X[B + 3] = EX(X[B + 3]); PIN(X); SBAR(); } while (0)
#define GAPB2(MFS, X, B) do { if (!(TEST & 4)) { MFS; } X[B] = EX(X[B]); X[B + 1] = EX(X[B + 1]); PIN(X); SBAR(); } while (0)
#define VRD(f, s) do { if (TEST & 64) break; vlo[s] = vtr(vp_ + (((f) >> 2) * 4096 + ((f) & 3) * 1024)); vhi[s] = vtr(vp_ + (((f) >> 2) * 4096 + ((f) & 3) * 1024 + 512)); } while (0)
#define KRD(G, j) do { if ((G) && !(TEST & 128)) { if (FP8) { if ((j) < 2) { KLOAD8(j, kp0 + s_next * KSLOT); } } else kload2(kf, kp0 + s_next * KSLOT, j); SBAR(); } } while (0)
#define FO(m) (ND == 2 ? (((m) >> 1) + 4 * ((m) & 1)) : ((((m) & 7) >> 2) + 2 * ((m) >> 3) + 4 * ((m) & 3)))
#define STEP(C0, C1, P0, P1, t, GK, GV, GL) do { SBAR(); \
    const lds_cptr vp_ = vp0 + s_prev * VSLOT; float sacc; \
    if (FP8) { \
      VRD(FO(0), 0); VRD(FO(1), 1); VRD(FO(2), 2); VRD(FO(3), 3); SBAR(); \
      if (!(TEST & 32)) C0 = MF8(kf8[0], zero16); \
      SBAR();   \
      float sa_ = P0[0] + P0[1], sb_ = P0[2] + P0[3], sc_ = P0[4] + P0[5], sd_ = P0[6] + P0[7]; \
      if (!(TEST & 2)) { sa_ += P0[8]; sb_ += P0[9]; sc_ += P0[10]; sd_ += P0[11]; sa_ += P0[12]; sb_ += P0[13]; sc_ += P0[14]; sd_ += P0[15]; } \
      pw0 = (v4u){PKW(P0, 0), PKW(P0, 2), PKW(P0, 4), PKW(P0, 6)}; pw1 = (v4u){PKW(P0, 8), PKW(P0, 10), PKW(P0, 12), PKW(P0, 14)}; PIN(pw0); PIN(pw1); SBAR(); \
      VRD(FO(4), 4); VRD(FO(5), 5); VRD(FO(6), 6); VRD(FO(7), 7); SBAR(); \
      if (!(TEST & 32)) C1 = MF8(kf8[1], zero16); \
      SBAR(); \
      if (!(TEST & 2)) { sa_ += P1[0]; sb_ += P1[1]; sc_ += P1[2]; sd_ += P1[3]; sa_ += P1[4]; sb_ += P1[5]; sc_ += P1[6]; sd_ += P1[7]; \
                         sa_ += P1[8]; sb_ += P1[9]; sc_ += P1[10]; sd_ += P1[11]; sa_ += P1[12]; sb_ += P1[13]; sc_ += P1[14]; sd_ += P1[15]; } \
      sacc = (sa_ + sb_) + (sc_ + sd_); PIN(sacc); \
      pw2 = (v4u){PKW(P1, 0), PKW(P1, 2), PKW(P1, 4), PKW(P1, 6)}; pw3 = (v4u){PKW(P1, 8), PKW(P1, 10), PKW(P1, 12), PKW(P1, 14)}; PIN(pw2); PIN(pw3); SBAR(); \
    } else { \
    VRD(FO(0), 0); SBAR(); sacc = (P0[0] + P0[1]); \
    GAPA(C0 = MF(kf[0], qr[0], zero16), P0[2], P0[3], P0[4], P0[5],     pw0[0] = PKW(P0, 0), pw0[1] = PKW(P0, 2), pw0); \
    VRD(FO(1), 1); SBAR(); GAPA(C1 = MF(kf[1], qr[0], zero16), P0[6], P0[7], P0[8], P0[9],     pw0[2] = PKW(P0, 4), pw0[3] = PKW(P0, 6), pw0); \
    VRD(FO(2), 2); SBAR(); GAPA(C0 = MF(kf[2], qr[1], C0),   P0[10], P0[11], P0[12], P0[13], pw1[0] = PKW(P0, 8), pw1[1] = PKW(P0, 10), pw1); \
    VRD(FO(3), 3); SBAR(); GAPA(C1 = MF(kf[3], qr[1], C1),   P0[14], P0[15], P1[0], P1[1],   pw1[2] = PKW(P0, 12), pw1[3] = PKW(P0, 14), pw1); \
    VRD(FO(4), 4); SBAR(); GAPA(C0 = MF(kf[4], qr[2], C0),   P1[2], P1[3], P1[4], P1[5],     pw2[0] = PKW(P1, 0), pw2[1] = PKW(P1, 2), pw2); \
    VRD(FO(5), 5); SBAR(); GAPA(C1 = MF(kf[5], qr[2], C1),   P1[6], P1[7], P1[8], P1[9],     pw2[2] = PKW(P1, 4), pw2[3] = PKW(P1, 6), pw2); \
    VRD(FO(6), 6); SBAR(); GAPA(C0 = MF(kf[6], qr[3], C0),   P1[10], P1[11], P1[12], P1[13], pw3[0] = PKW(P1, 8), pw3[1] = PKW(P1, 10), pw3); \
    VRD(FO(7), 7); SBAR(); GAPA(C1 = MF(kf[7], qr[3], C1),   P1[14], P1[15], 0.f, 0.f,       pw3[2] = PKW(P1, 12), pw3[3] = PKW(P1, 14), pw3); \
    } \
    l_reg += sacc; \
    if (GK) { DMA_K((t) + 3, s_cur); } if (GV) { DMA_V((t) + 1, s_next); } \
    ADD_BIAS(C0, C1, t); \
    SBAR(); \
    if (ND == 2) { \
        GAPB4(o[0] = MF(PAF(0), VFR(0), o[0]), C0, 0); \
        GAPB4(o[1] = MF(PAF(0), VFR(1), o[1]), C0, 4); \
        KRD(GL, 0); GAPB4(o[0] = MF(PAF(1), VFR(2), o[0]), C0, 8); \
        KRD(GL, 1); GAPB4(o[1] = MF(PAF(1), VFR(3), o[1]), C0, 12); \
        KRD(GL, 2); GAPB4(o[0] = MF(PAF(2), VFR(4), o[0]), C1, 0); \
        KRD(GL, 3); GAPB4(o[1] = MF(PAF(2), VFR(5), o[1]), C1, 4); \
        GAPB4(o[0] = MF(PAF(3), VFR(6), o[0]), C1, 8); \
        GAPB4(o[1] = MF(PAF(3), VFR(7), o[1]), C1, 12); \
    } else { \
        GAPB2(o[0] = MF(PAF(0), VFR(0), o[0]), C0, 0);  VRD(FO(8), 0); SBAR(); \
        GAPB2(o[1] = MF(PAF(0), VFR(1), o[1]), C0, 2);  VRD(FO(9), 1); SBAR(); \
        GAPB2(o[ND - 2] = MF(PAF(0), VFR(2), o[ND - 2]), C0, 4);  VRD(FO(10), 2); SBAR(); \
        GAPB2(o[ND - 1] = MF(PAF(0), VFR(3), o[ND - 1]), C0, 6);  VRD(FO(11), 3); SBAR(); \
        GAPB2(o[0] = MF(PAF(1), VFR(4), o[0]), C0, 8);  VRD(FO(12), 4); SBAR(); \
        GAPB2(o[1] = MF(PAF(1), VFR(5), o[1]), C0, 10); VRD(FO(13), 5); SBAR(); \
        GAPB2(o[ND - 2] = MF(PAF(1), VFR(6), o[ND - 2]), C0, 12); VRD(FO(14), 6); SBAR(); \
        GAPB2(o[ND - 1] = MF(PAF(1), VFR(7), o[ND - 1]), C0, 14); VRD(FO(15), 7); SBAR(); \
        KRD(GL, 0); GAPB2(o[0] = MF(PAF(2), VFR(0), o[0]), C1, 0); \
        GAPB2(o[1] = MF(PAF(2), VFR(1), o[1]), C1, 2); \
        KRD(GL, 1); GAPB2(o[ND - 2] = MF(PAF(2), VFR(2), o[ND - 2]), C1, 4); \
        GAPB2(o[ND - 1] = MF(PAF(2), VFR(3), o[ND - 1]), C1, 6); \
        KRD(GL, 2); GAPB2(o[0] = MF(PAF(3), VFR(4), o[0]), C1, 8); \
        GAPB2(o[1] = MF(PAF(3), VFR(5), o[1]), C1, 10); \
        KRD(GL, 3); GAPB2(o[ND - 2] = MF(PAF(3), VFR(6), o[ND - 2]), C1, 12); \
        GAPB2(o[ND - 1] = MF(PAF(3), VFR(7), o[ND - 1]), C1, 14); \
    } \
    if (BIAS && (t) == tl) { l_reg *= fL; _Pragma("unroll") for (int d_ = 0; d_ < ND; ++d_) _Pragma("unroll") for (int r = 0; r < 16; ++r) o[d_][r] *= fL; } \
    } while (0)
    int t = 1;
    for (; t + 4 < NT; t += 2) {
        STEP(pB0, pB1, pA0, pA1, t, true, true, true);       WAITB(1 + NV); ROT();
        STEP(pA0, pA1, pB0, pB1, t + 1, true, true, true);   WAITB(1 + NV); ROT();
    }
    STEP(pB0, pB1, pA0, pA1, NT - 3, false, true, true);  wait_bar<NV, (TEST & 16) != 0>(); ROT();
    STEP(pA0, pA1, pB0, pB1, NT - 2, false, true, true);  wait_bar<0, (TEST & 16) != 0>();  ROT();
    STEP(pB0, pB1, pA0, pA1, NT - 1, false, false, false);
    {
        float sacc = pB0[0] + pB0[1];
#pragma unroll
        for (int r = 2; r < 16; ++r) sacc += pB0[r];
#pragma unroll
        for (int r = 0; r < 16; ++r) sacc += pB1[r];
        l_reg += sacc;
        pw0 = (v4u){PKW(pB0, 0), PKW(pB0, 2), PKW(pB0, 4), PKW(pB0, 6)}; pw1 = (v4u){PKW(pB0, 8), PKW(pB0, 10), PKW(pB0, 12), PKW(pB0, 14)};
        pw2 = (v4u){PKW(pB1, 0), PKW(pB1, 2), PKW(pB1, 4), PKW(pB1, 6)}; pw3 = (v4u){PKW(pB1, 8), PKW(pB1, 10), PKW(pB1, 12), PKW(pB1, 14)};
        const lds_cptr vp_ = vp0 + s_cur * VSLOT;
#pragma unroll
        for (int d0 = 0; d0 < ND; ++d0) {
            s16x4 a0 = vtr(vp_ + d0 * 4096), b0 = vtr(vp_ + d0 * 4096 + 512), a1 = vtr(vp_ + d0 * 4096 + 1024), b1 = vtr(vp_ + d0 * 4096 + 1536);
            s16x4 a2 = vtr(vp_ + d0 * 4096 + 2048), b2 = vtr(vp_ + d0 * 4096 + 2560), a3 = vtr(vp_ + d0 * 4096 + 3072), b3 = vtr(vp_ + d0 * 4096 + 3584);
            o[d0] = MF(PAF(0), ((bf16x8){a0[0], a0[1], a0[2], a0[3], b0[0], b0[1], b0[2], b0[3]}), o[d0]);
            o[d0] = MF(PAF(1), ((bf16x8){a1[0], a1[1], a1[2], a1[3], b1[0], b1[1], b1[2], b1[3]}), o[d0]);
            o[d0] = MF(PAF(2), ((bf16x8){a2[0], a2[1], a2[2], a2[3], b2[0], b2[1], b2[2], b2[3]}), o[d0]);
            o[d0] = MF(PAF(3), ((bf16x8){a3[0], a3[1], a3[2], a3[3], b3[0], b3[1], b3[2], b3[3]}), o[d0]);
        }
    }
    l_reg += __shfl_xor(l_reg, 32);
    int lane_e = lane; asm volatile("" : "+v"(lane_e));
    const int r32e = lane_e & 31, hie = lane_e >> 5;
    if (hie == 0) wsf[r32e] = l_reg;
    asm volatile("s_waitcnt lgkmcnt(0)\n\ts_barrier" ::: "memory");
    {
        LAS bf16* stg = (LAS bf16*)(MODE == 1 ? lds + STASH_OFF : lds) + wid * (32 * DV);
#pragma unroll
        for (int r = 0; r < 16; ++r) { const int orow = crow(r, hie); const float rl = __builtin_amdgcn_rcpf(wsf[orow]);
#pragma unroll
            for (int d0 = 0; d0 < ND; ++d0) stg[orow * DV + d0 * 32 + r32e] = (bf16)f2bf(o[d0][r] * rl); }
        asm volatile("s_waitcnt lgkmcnt(0)" ::: "memory");
        if (MODE == 0) {
            constexpr int CPR = DV / 8;
#pragma unroll
            for (int i = 0; i < (32 * CPR) / 64; ++i) { const int row = i * (64 / CPR) + lane_e / CPR, ch = lane_e % CPR;
                const v4u v = *(const LAS v4u*)(stg + row * DV + ch * 8); *(v4u*)(Op + (size_t)(wid * 32 + row) * ldo + ch * 8) = v; }
        } else if (MODE == 2) {
            const int row = lane_e >> 1, half = lane_e & 1; const float lam = sgt[128];
            const LAS bf16* s1 = stg + row * DV + half * 64; const LAS bf16* s0 = (const LAS bf16*)(lds + STASH_OFF) + wid * (32 * DV) + row * DV + half * 64;
            float ov[64]; float ss = 0.f;
#pragma unroll
            for (int q = 0; q < 8; ++q) { const v4u a = *(const LAS v4u*)(s0 + q * 8), c = *(const LAS v4u*)(s1 + q * 8);
#pragma unroll
                for (int j = 0; j < 4; ++j) { const float lo = __builtin_bit_cast(float, a[j] << 16) - lam * __builtin_bit_cast(float, c[j] << 16);
                    const float hh = __builtin_bit_cast(float, a[j] & 0xffff0000u) - lam * __builtin_bit_cast(float, c[j] & 0xffff0000u);
                    ov[q * 8 + 2 * j] = lo; ov[q * 8 + 2 * j + 1] = hh; ss += lo * lo + hh * hh; } }
            ss += dpp_mov<0xB1>(ss);
            const float rstd = 1.0f / sqrtf(ss * (1.f / 128.f) + 1e-5f);
            bf16* yo = Op + (size_t)(wid * 32 + row) * ldo + half * 64;
#pragma unroll
            for (int q = 0; q < 8; ++q) { const f32x4 g0 = *(const LAS f32x4*)(sgt + half * 64 + q * 8), g1 = *(const LAS f32x4*)(sgt + half * 64 + q * 8 + 4);
                v4u w; w.x = pk2(ov[q * 8] * rstd * g0.x, ov[q * 8 + 1] * rstd * g0.y); w.y = pk2(ov[q * 8 + 2] * rstd * g0.z, ov[q * 8 + 3] * rstd * g0.w);
                w.z = pk2(ov[q * 8 + 4] * rstd * g1.x, ov[q * 8 + 5] * rstd * g1.y); w.w = pk2(ov[q * 8 + 6] * rstd * g1.z, ov[q * 8 + 7] * rstd * g1.w);
                *(v4u*)(yo + q * 8) = w; }
        }
    }
    asm volatile("s_waitcnt lgkmcnt(0)\n\ts_barrier" ::: "memory");
#undef KLOAD8
#undef MF8
#undef WAITB
#undef DMA_K
#undef DMA_V
#undef ROT
#undef ADD_BIAS
#undef PKW
#undef PAF
#undef VFR
#undef MF
#undef GAPA
#undef EX
#undef GAPB4
#undef GAPB2
#undef VRD
#undef KRD
#undef FO
#undef STEP
}
#undef SBAR
#undef PIN
}

namespace at3 {
#define SBAR() __builtin_amdgcn_sched_barrier(0)
#define PIN(x) asm volatile("" : "+v"(x))
using at1::glds16; using at1::wait_bar;
typedef const LAS char* lds_cptr; typedef short v2s __attribute__((ext_vector_type(2)));
template <int DV> __host__ __device__ constexpr int lds_ws_off() { return (3 * 4096 + 3 * DV * 64) > 512 * DV ? (3 * 4096 + 3 * DV * 64) : 512 * DV; }
template <int DV> __host__ __device__ constexpr int lds_tbl_off() { return lds_ws_off<DV>() + 2048; }
__device__ __forceinline__ void waitb(int n) { if (n == 0) wait_bar<0>(); else if (n == 1) wait_bar<1>(); else wait_bar<2>(); }
__device__ __forceinline__ v8i ld_frag(lds_cptr p, int second) { const v4u a = *(const LAS v4u*)p, b = *(const LAS v4u*)(p + second); return (v8i){(int)a.x, (int)a.y, (int)a.z, (int)a.w, (int)b.x, (int)b.y, (int)b.z, (int)b.w}; }

template <int DV, bool BIAS, int MODE>
__device__ __forceinline__ void attn_unit(const unsigned char* Qp, int ldq, const unsigned char* __restrict__ K8T, const unsigned char* __restrict__ V8T, bf16* Op, int ldo, int q0, LAS unsigned char* lds, const LAS float* sgt) {
    constexpr int ND = DV / 32, VT = DV * 64, KT = 4096, NT = SEQ / 64, NVP = VT / 1024;
    constexpr int LDS_K = 0, LDS_V = 3 * KT, LDS_WS = lds_ws_off<DV>(), LDS_TBL = LDS_WS + 2048;
    static_assert(LDS_WS >= LDS_V + 3 * VT && LDS_WS >= 512 * DV && LDS_TBL + 2048 <= STASH_OFF, "LDS map");
    const int tid = threadIdx.x, lane = tid & 63, r32 = lane & 31, hi = lane >> 5; const int wid = __builtin_amdgcn_readfirstlane(tid >> 6);
    const unsigned lds0 = (unsigned)(uintptr_t)lds;
    LAS float* wsf = (LAS float*)(lds + LDS_WS) + wid * 64;
    const LAS float* btbl = (const LAS float*)(lds + LDS_TBL);
    const bool doK = wid < 4, doV = (NVP == 8) || wid >= 4; const int vpc = (NVP == 8) ? wid : (wid & 3);
    const unsigned char* ksrc = K8T + (wid & 3) * 1024 + lane * 16; const unsigned char* vsrc = V8T + vpc * 1024 + lane * 16;
    const unsigned kdst = lds0 + LDS_K + (wid & 3) * 1024, vdst = lds0 + LDS_V + vpc * 1024;
    const int ndma = (doK ? 1 : 0) + (doV ? 1 : 0);
#define DMA_K(t, s) do { if (doK) glds16(ksrc + (size_t)(t) * KT, (unsigned)__builtin_amdgcn_readfirstlane(kdst + (s) * KT)); } while (0)
#define DMA_V(t, s) do { if (doV) glds16(vsrc + (size_t)(t) * VT, (unsigned)__builtin_amdgcn_readfirstlane(vdst + (s) * VT)); } while (0)
    const lds_cptr kp0 = (lds_cptr)lds + LDS_K + hi * 2048 + r32 * 16;
    const lds_cptr vq0 = (lds_cptr)lds + LDS_V + hi * (2 * DV * 16) + r32 * 16;
    DMA_K(0, 0); DMA_V(0, 0); DMA_K(1, 1);
    v8i q8;
    { const unsigned char* qb_ = Qp + (size_t)(wid * 32 + r32) * ldq + hi * 32; const v4u a = *(const v4u*)qb_, b = *(const v4u*)(qb_ + 16);
      q8 = (v8i){(int)a.x, (int)a.y, (int)a.z, (int)a.w, (int)b.x, (int)b.y, (int)b.z, (int)b.w}; }
    f32x16 lacc = f32x16{}; f32x16 o[ND];
#pragma unroll
    for (int d = 0; d < ND; ++d) o[d] = f32x16{};
    const f32x16 zero16 = f32x16{};
    const v8i ones8 = {0x38383838, 0x38383838, 0x38383838, 0x38383838, 0x38383838, 0x38383838, 0x38383838, 0x38383838};
    const int qw = q0 + wid * 32, qpos = qw + r32;
    int tl = 0, tr = NT; float fL = 1.f;
    if (BIAS) { tl = (qw - 191 >= 0) ? ((qw - 191) >> 6) + 1 : 0; tr = (qw + 158) >> 6; fL = __builtin_amdgcn_exp2f(btbl[0]); }
    f32x16 pA0, pA1, pB0, pB1; v8i kf8[2]; v8i vf[ND]; v8i pa; int sb = 127;
    int s_prev = 0, s_cur = 0, s_next = 1;
#define ROT() do { s_prev = s_cur; s_cur = s_next; s_next = (s_next == 2) ? 0 : s_next + 1; } while (0)
#define MFQK(kf_) __builtin_amdgcn_mfma_scale_f32_32x32x64_f8f6f4(kf_, q8, zero16, 0, 0, 0, 0x7f7f7f7f, 0, 0x7c7c7c7c)
#define MFPV(d_) o[d_] = __builtin_amdgcn_mfma_scale_f32_32x32x64_f8f6f4(pa, vf[d_], o[d_], 0, 0, 0, sb, 0, 0x7f7f7f7f)
#define MFSUM() lacc = __builtin_amdgcn_mfma_scale_f32_32x32x64_f8f6f4(pa, ones8, lacc, 0, 0, 0, sb, 0, 0x7f7f7f7f)
#define ADD_BIAS(C0, C1, t) do { if (BIAS && (t) >= tl && (t) <= tr) { const int base_ = (t) * 64 + 4 * hi - qpos; \
        _Pragma("unroll") for (int r = 0; r < 16; ++r) { const int rel0 = base_ + (r & 3) + 8 * (r >> 2); const int rel1 = rel0 + 32; \
            const int i0 = (rel0 < -128 ? -128 : (rel0 > 128 ? 128 : rel0)) + 128, i1 = (rel1 < -128 ? -128 : (rel1 > 128 ? 128 : rel1)) + 128; \
            C0[r] += btbl[i0]; C1[r] += btbl[i1]; } } } while (0)
#define MX3(a, b, c) __builtin_fmaxf(__builtin_fmaxf((a), (b)), (c))
#define PMAX(P0, P1) do { float a_ = MX3(P0[0], P0[1], P1[0]), b_ = MX3(P0[2], P0[3], P1[1]); a_ = MX3(a_, P1[2], P1[3]); \
        _Pragma("unroll") for (int r = 4; r < 16; r += 4) { a_ = MX3(a_, P0[r], P0[r + 1]); b_ = MX3(b_, P0[r + 2], P0[r + 3]); a_ = MX3(a_, P1[r], P1[r + 1]); b_ = MX3(b_, P1[r + 2], P1[r + 3]); } \
        float mx_ = __builtin_fmaxf(a_, b_); { auto rr_ = __builtin_amdgcn_permlane32_swap(__float_as_uint(mx_), __float_as_uint(mx_), false, false); mx_ = __builtin_fmaxf(__uint_as_float(rr_[0]), __uint_as_float(rr_[1])); } \
        const int em_ = (int)(__float_as_uint(mx_) >> 23) - 7; sb = em_ < 1 ? 1 : em_; } while (0)
#define PCVT(P0, P1) do { const float scf_ = __uint_as_float((unsigned)sb << 23); \
        _Pragma("unroll") for (int k = 0; k < 4; ++k) { v2s w_ = {0, 0}; w_ = __builtin_amdgcn_cvt_scalef32_pk_fp8_f32(w_, P0[4 * k], P0[4 * k + 1], scf_, false); w_ = __builtin_amdgcn_cvt_scalef32_pk_fp8_f32(w_, P0[4 * k + 2], P0[4 * k + 3], scf_, true); pa[k] = __builtin_bit_cast(int, w_); } \
        _Pragma("unroll") for (int k = 0; k < 4; ++k) { v2s w_ = {0, 0}; w_ = __builtin_amdgcn_cvt_scalef32_pk_fp8_f32(w_, P1[4 * k], P1[4 * k + 1], scf_, false); w_ = __builtin_amdgcn_cvt_scalef32_pk_fp8_f32(w_, P1[4 * k + 2], P1[4 * k + 3], scf_, true); pa[4 + k] = __builtin_bit_cast(int, w_); } } while (0)
#define PSUM(P0, P1) do { float s0_ = P0[0] + P0[1], s1_ = P0[2] + P0[3], s2_ = P1[0] + P1[1], s3_ = P1[2] + P1[3]; \
        _Pragma("unroll") for (int r = 4; r < 16; r += 4) { s0_ += P0[r]; s1_ += P0[r + 1]; s2_ += P0[r + 2]; s3_ += P0[r + 3]; s0_ += P1[r]; s1_ += P1[r + 1]; s2_ += P1[r + 2]; s3_ += P1[r + 3]; } \
        l_reg += (s0_ + s1_) + (s2_ + s3_); } while (0)
#define EXPS(X, B, N) do { _Pragma("unroll") for (int r_ = 0; r_ < (N); ++r_) X[(B) + r_] = __builtin_amdgcn_exp2f(X[(B) + r_]); PIN(X); } while (0)
    DMA_K(2, 2);
    wait_bar<0>();
    kf8[0] = ld_frag(kp0, 1024); kf8[1] = ld_frag(kp0 + 512, 1024);
    pA0 = MFQK(kf8[0]); pA1 = MFQK(kf8[1]);
    ADD_BIAS(pA0, pA1, 0);
#pragma unroll
    for (int r = 0; r < 16; ++r) { pA0[r] = __builtin_amdgcn_exp2f(pA0[r]); pA1[r] = __builtin_amdgcn_exp2f(pA1[r]); }
    wait_bar<0>();
    DMA_K(3, 0); DMA_V(1, 1);
    ROT();
    kf8[0] = ld_frag(kp0 + s_cur * KT, 1024); kf8[1] = ld_frag(kp0 + s_cur * KT + 512, 1024);
    waitb(ndma);
#define STEP(C0, C1, P0, P1, t, GK, GV, GL) do { SBAR(); \
    const lds_cptr vp_ = vq0 + s_prev * VT; \
    _Pragma("unroll") for (int d_ = 0; d_ < ND; ++d_) vf[d_] = ld_frag(vp_ + d_ * 512, DV * 16); \
    SBAR(); \
    C0 = MFQK(kf8[0]); SBAR(); \
    PMAX(P0, P1); PIN(sb); SBAR(); \
    C1 = MFQK(kf8[1]); SBAR(); \
    PCVT(P0, P1); PIN(pa); SBAR(); \
    MFSUM(); SBAR(); \
    if (GK) { DMA_K((t) + 3, s_cur); } if (GV) { DMA_V((t) + 1, s_next); } \
    ADD_BIAS(C0, C1, t); \
    SBAR(); \
    if (ND == 2) { \
        MFPV(0); EXPS(C0, 0, 16); SBAR(); \
        if (GL) { kf8[0] = ld_frag(kp0 + s_next * KT, 1024); kf8[1] = ld_frag(kp0 + s_next * KT + 512, 1024); SBAR(); } \
        MFPV(1); EXPS(C1, 0, 16); SBAR(); \
    } else { \
        MFPV(0); EXPS(C0, 0, 8); SBAR(); \
        if (GL) { kf8[0] = ld_frag(kp0 + s_next * KT, 1024); SBAR(); } \
        MFPV(1); EXPS(C0, 8, 8); SBAR(); \
        if (GL) { kf8[1] = ld_frag(kp0 + s_next * KT + 512, 1024); SBAR(); } \
        MFPV(ND - 2); EXPS(C1, 0, 8); SBAR(); \
        MFPV(ND - 1); EXPS(C1, 8, 8); SBAR(); \
    } \
    if (BIAS && (t) == tl) { _Pragma("unroll") for (int r = 0; r < 16; ++r) lacc[r] *= fL; _Pragma("unroll") for (int d_ = 0; d_ < ND; ++d_) _Pragma("unroll") for (int r = 0; r < 16; ++r) o[d_][r] *= fL; } \
    } while (0)
    int t = 1;
    for (; t + 4 < NT; t += 2) {
        STEP(pB0, pB1, pA0, pA1, t, true, true, true);       waitb(ndma); ROT();
        STEP(pA0, pA1, pB0, pB1, t + 1, true, true, true);   waitb(ndma); ROT();
    }
    STEP(pB0, pB1, pA0, pA1, NT - 3, false, true, true);  waitb(doV ? 1 : 0); ROT();
    STEP(pA0, pA1, pB0, pB1, NT - 2, false, true, true);  wait_bar<0>();  ROT();
    STEP(pB0, pB1, pA0, pA1, NT - 1, false, false, false);
    {
        const lds_cptr vp_ = vq0 + s_cur * VT;
#pragma unroll
        for (int d_ = 0; d_ < ND; ++d_) vf[d_] = ld_frag(vp_ + d_ * 512, DV * 16);
        PMAX(pB0, pB1); PCVT(pB0, pB1); MFSUM();
#pragma unroll
        for (int d_ = 0; d_ < ND; ++d_) MFPV(d_);
    }
    int lane_e = lane; asm volatile("" : "+v"(lane_e));
    const int r32e = lane_e & 31, hie = lane_e >> 5;
    asm volatile("s_waitcnt lgkmcnt(0)\n\ts_barrier" ::: "memory");
    {
        LAS bf16* stg = (LAS bf16*)(MODE == 1 ? lds + STASH_OFF : lds) + wid * (32 * DV);
#pragma unroll
        for (int r = 0; r < 16; ++r) { const int orow = crow(r, hie); const float rl = __builtin_amdgcn_rcpf(lacc[r]);
#pragma unroll
            for (int d0 = 0; d0 < ND; ++d0) stg[orow * DV + d0 * 32 + r32e] = (bf16)f2bf(o[d0][r] * rl); }
        asm volatile("s_waitcnt lgkmcnt(0)" ::: "memory");
        if (MODE == 0) {
            constexpr int CPR = DV / 8;
#pragma unroll
            for (int i = 0; i < (32 * CPR) / 64; ++i) { const int row = i * (64 / CPR) + lane_e / CPR, ch = lane_e % CPR;
                const v4u v = *(const LAS v4u*)(stg + row * DV + ch * 8); *(v4u*)(Op + (size_t)(wid * 32 + row) * ldo + ch * 8) = v; }
        } else if (MODE == 2) {
            const int row = lane_e >> 1, half = lane_e & 1; const float lam = sgt[128];
            const LAS bf16* s1 = stg + row * DV + half * 64; const LAS bf16* s0 = (const LAS bf16*)(lds + STASH_OFF) + wid * (32 * DV) + row * DV + half * 64;
            float ov[64]; float ss = 0.f;
#pragma unroll
            for (int q = 0; q < 8; ++q) { const v4u a = *(const LAS v4u*)(s0 + q * 8), c = *(const LAS v4u*)(s1 + q * 8);
#pragma unroll
                for (int j = 0; j < 4; ++j) { const float lo = __builtin_bit_cast(float, a[j] << 16) - lam * __builtin_bit_cast(float, c[j] << 16);
                    const float hh = __builtin_bit_cast(float, a[j] & 0xffff0000u) - lam * __builtin_bit_cast(float, c[j] & 0xffff0000u);
                    ov[q * 8 + 2 * j] = lo; ov[q * 8 + 2 * j + 1] = hh; ss += lo * lo + hh * hh; } }
            ss += dpp_mov<0xB1>(ss);
            const float rstd = 1.0f / sqrtf(ss * (1.f / 128.f) + 1e-5f);
            bf16* yo = Op + (size_t)(wid * 32 + row) * ldo + half * 64;
#pragma unroll
            for (int q = 0; q < 8; ++q) { const f32x4 g0 = *(const LAS f32x4*)(sgt + half * 64 + q * 8), g1 = *(const LAS f32x4*)(sgt + half * 64 + q * 8 + 4);
                v4u w; w.x = pk2(ov[q * 8] * rstd * g0.x, ov[q * 8 + 1] * rstd * g0.y); w.y = pk2(ov[q * 8 + 2] * rstd * g0.z, ov[q * 8 + 3] * rstd * g0.w);
                w.z = pk2(ov[q * 8 + 4] * rstd * g1.x, ov[q * 8 + 5] * rstd * g1.y); w.w = pk2(ov[q * 8 + 6] * rstd * g1.z, ov[q * 8 + 7] * rstd * g1.w);
                *(v4u*)(yo + q * 8) = w; }
        }
    }
    asm volatile("s_waitcnt lgkmcnt(0)\n\ts_barrier" ::: "memory");
#undef DMA_K
#undef DMA_V
#undef ROT
#undef MFQK
#undef MFPV
#undef MFSUM
#undef ADD_BIAS
#undef MX3
#undef PMAX
#undef PCVT
#undef PSUM
#undef EXPS
#undef STEP
}
#undef SBAR
#undef PIN
}

struct Args { const float* in[27]; float* out; unsigned char* ws; int ph_lo, ph_hi, li, pad; };

constexpr int NPHASE = 17;
constexpr int NWAVES = 8;

#define IN(k) (lo <= (k) && (k) < hi_ph)
#define SEAM(k) do { if (IN(k) && IN((k) + 1)) xcd_barrier(bar); } while (0)
template <int layer>
__device__ __forceinline__ void moe_block(const Args& args, LAS unsigned char* lds, const XcdBarrier& bar, int lo, int hi_ph) {
    volatile LAS unsigned* LC = (volatile LAS unsigned*)(lds + LDSCTL_OFF);
    const int tid = threadIdx.x, lane = tid & 63, wave = __builtin_amdgcn_readfirstlane(tid >> 6);
    const int G = gridDim.x, bx = blockIdx.x;
    const int gw = bx * NWAVES + wave, NGW = G * NWAVES;
    unsigned char* ws = args.ws;
    unsigned* ctl = (unsigned*)(ws + WS_CTL);
    float* xres = args.out;
    bf16* XB = (bf16*)(ws + WS_XB);
    bf16* HB = (bf16*)(ws + WS_HB);
    {
        const int pb = layer == 0 ? 5 : 13;
        unsigned* const gcnt0 = ctl + CW_CNT + layer * 64;
        int* list = (int*)(ws + WS_LIST); int* tokep = (int*)(ws + WS_TOKEP); float* gate = (float*)(ws + WS_GATE);
        if (IN(pb)) REP(pb) {
            unsigned* gcnt = gcnt0 + ((MK_N_LAUNCHES == 1 ? (int)((PROBE_MASK >> pb) & 1u) : 0) - rep_) * 128;
            if (rep_ > 0) xcd_barrier(bar);
            const float* gf = args.in[2] + layer * DM;
            const float* WR = (const float*)(ws + WS_TBL) + TBL_WR + layer * WR_LAYER;
            for (int chunk = bx; chunk < NTOK / 128; chunk += G) {
                __syncthreads();
                if (tid < 32) LC[LC_LCNT + tid] = 0u;
                __syncthreads();
                int my_e0 = 0, my_e1 = 0; float my_g0 = 0.f, my_g1 = 0.f;
                {
                    const int ri = lane & 15, kq = lane >> 4; const int r0w = chunk * 128 + wave * 16;
                    const GAS bf16* xrow = (const GAS bf16*)(XB + (size_t)(r0w + ri) * DM) + 8 * kq;
                    const GAS bf16* wth = (const GAS bf16*)((const unsigned char*)(ws + WS_TBL) + 614400) + (size_t)(layer * 2) * 49152 + ri * 1024 + 8 * kq; const GAS bf16* wtl = wth + 49152;
                    f32x4 acc0 = {0.f, 0.f, 0.f, 0.f}, acc1 = acc0, acc2 = acc0; float ss = 0.f;
                    bf16x8 aA[2], aB[2], bA[12], bB[12];
#define RT_LOAD(a_, b_, g_) do { _Pragma("unroll") for (int c_ = 0; c_ < 2; ++c_) { const int cc_ = 2 * (g_) + c_; a_[c_] = *(const GAS bf16x8*)(xrow + 32 * cc_); \
        _Pragma("unroll") for (int t_ = 0; t_ < 3; ++t_) { b_[c_ * 6 + t_ * 2] = *(const GAS bf16x8*)(wth + t_ * 16384 + 32 * cc_); b_[c_ * 6 + t_ * 2 + 1] = *(const GAS bf16x8*)(wtl + t_ * 16384 + 32 * cc_); } } } while (0)
#define RT_COMP(a_, b_) do { _Pragma("unroll") for (int c_ = 0; c_ < 2; ++c_) { const v4u aw_ = __builtin_bit_cast(v4u, a_[c_]); \
        _Pragma("unroll") for (int j_ = 0; j_ < 4; ++j_) { const float lo_ = __builtin_bit_cast(float, aw_[j_] << 16), hi_ = __builtin_bit_cast(float, aw_[j_] & 0xffff0000u); ss += lo_ * lo_ + hi_ * hi_; } \
        acc0 = __builtin_amdgcn_mfma_f32_16x16x32_bf16(a_[c_], b_[c_ * 6], acc0, 0, 0, 0); acc0 = __builtin_amdgcn_mfma_f32_16x16x32_bf16(a_[c_], b_[c_ * 6 + 1], acc0, 0, 0, 0); \
        acc1 = __builtin_amdgcn_mfma_f32_16x16x32_bf16(a_[c_], b_[c_ * 6 + 2], acc1, 0, 0, 0); acc1 = __builtin_amdgcn_mfma_f32_16x16x32_bf16(a_[c_], b_[c_ * 6 + 3], acc1, 0, 0, 0); \
        acc2 = __builtin_amdgcn_mfma_f32_16x16x32_bf16(a_[c_], b_[c_ * 6 + 4], acc2, 0, 0, 0); acc2 = __builtin_amdgcn_mfma_f32_16x16x32_bf16(a_[c_], b_[c_ * 6 + 5], acc2, 0, 0, 0); } } while (0)
                    if (ROUTER_LDSW) {
                        constexpr int RS = 1040;
                        const unsigned lds0 = (unsigned)(uintptr_t)lds;
                        const unsigned char* tb = (const unsigned char*)(ws + WS_TBL) + 614400 + (size_t)(layer * 2) * 49152 * 2;
                        const LAS unsigned char* bp = lds + ri * RS + kq * 256;
#pragma unroll 1
                        for (int half = 0; half < 2; ++half) {
                            __syncthreads();
#pragma unroll
                            for (int j = 0; j < 12; ++j) { const int R = wave * 12 + j; at1::glds16(tb + (size_t)R * 2048 + half * 1024 + lane * 16, (unsigned)__builtin_amdgcn_readfirstlane(lds0 + R * RS)); }
                            bf16x8 xa[16];
#pragma unroll
                            for (int cc = 0; cc < 16; ++cc) xa[cc] = *(const GAS bf16x8*)(xrow + half * 512 + 32 * cc);
                            asm volatile("s_waitcnt vmcnt(0)" ::: "memory");
                            __syncthreads();
#pragma unroll
                            for (int cc = 0; cc < 16; ++cc) {
                                const v4u aw_ = __builtin_bit_cast(v4u, xa[cc]);
#pragma unroll
                                for (int j_ = 0; j_ < 4; ++j_) { const float lo_ = __builtin_bit_cast(float, aw_[j_] << 16), hi_ = __builtin_bit_cast(float, aw_[j_] & 0xffff0000u); ss += lo_ * lo_ + hi_ * hi_; }
                                const LAS unsigned char* p = bp + cc * 16;
                                acc0 = __builtin_amdgcn_mfma_f32_16x16x32_bf16(xa[cc], *(const LAS bf16x8*)(p), acc0, 0, 0, 0);               acc0 = __builtin_amdgcn_mfma_f32_16x16x32_bf16(xa[cc], *(const LAS bf16x8*)(p + 48 * RS), acc0, 0, 0, 0);
                                acc1 = __builtin_amdgcn_mfma_f32_16x16x32_bf16(xa[cc], *(const LAS bf16x8*)(p + 16 * RS), acc1, 0, 0, 0);     acc1 = __builtin_amdgcn_mfma_f32_16x16x32_bf16(xa[cc], *(const LAS bf16x8*)(p + 64 * RS), acc1, 0, 0, 0);
                                acc2 = __builtin_amdgcn_mfma_f32_16x16x32_bf16(xa[cc], *(const LAS bf16x8*)(p + 32 * RS), acc2, 0, 0, 0);     acc2 = __builtin_amdgcn_mfma_f32_16x16x32_bf16(xa[cc], *(const LAS bf16x8*)(p + 80 * RS), acc2, 0, 0, 0);
                            }
                        }
                        __syncthreads();
                    } else {
                    RT_LOAD(aA, bA, 0);
#pragma unroll 1
                    for (int g = 0; g < 16; g += 2) {
                        RT_LOAD(aB, bB, g + 1);
                        RT_COMP(aA, bA);
                        if (g + 2 < 16) RT_LOAD(aA, bA, g + 2);
                        RT_COMP(aB, bB);
                    }
                    }
#undef RT_LOAD
#undef RT_COMP
                    ss += __shfl_xor(ss, 16); ss += __shfl_xor(ss, 32);
                    const float rstd = 1.0f / sqrtf(ss * (1.f / DM) + 1e-6f);
                    LAS float* Lg = (LAS float*)(lds + wave * 4096);
#pragma unroll
                    for (int r = 0; r < 4; ++r) { Lg[(4 * kq + r) * 49 + ri] = acc0[r]; Lg[(4 * kq + r) * 49 + 16 + ri] = acc1[r]; Lg[(4 * kq + r) * 49 + 32 + ri] = acc2[r]; }
                    LDS_WAIT(); asm volatile("" ::: "memory");
                    if (lane < 16) {
                        const GAS float* bv = (const GAS float*)WR + 1024 * 48;
                        float lg[4], le[32];
#pragma unroll
                        for (int e = 0; e < 4; ++e) lg[e] = Lg[lane * 49 + e] * rstd + bv[e];
#pragma unroll
                        for (int e = 0; e < 32; ++e) le[e] = Lg[lane * 49 + 4 + e] * rstd + bv[4 + e];
                        int gi = 0; float gm = lg[0];
#pragma unroll
                        for (int e = 1; e < 4; ++e) if (lg[e] > gm) { gm = lg[e]; gi = e; }
                        float gs = 0.f;
#pragma unroll
                        for (int e = 0; e < 4; ++e) gs += __expf(lg[e] - gm);
                        const float gval = 1.0f / gs;
                        float ev[8];
#pragma unroll
                        for (int j = 0; j < 8; ++j) ev[j] = gi == 0 ? le[j] : (gi == 1 ? le[8 + j] : (gi == 2 ? le[16 + j] : le[24 + j]));
                        int i0 = 0; float m0 = ev[0];
#pragma unroll
                        for (int j = 1; j < 8; ++j) if (ev[j] > m0) { m0 = ev[j]; i0 = j; }
                        int i1 = -1; float m1 = -3.0e38f;
#pragma unroll
                        for (int j = 0; j < 8; ++j) if (j != i0 && ev[j] > m1) { m1 = ev[j]; i1 = j; }
                        const float t1 = __expf(m1 - m0); const float den = 1.0f / (1.0f + t1);
                        my_e0 = gi * 8 + i0; my_e1 = gi * 8 + i1; my_g0 = gval * den; my_g1 = gval * t1 * den;
                    }
                    if (MOE_FP8 && ROUTER_LDSW) {
                        f32x4 gq[4];
#pragma unroll
                        for (int j = 0; j < 2; ++j) { gq[2 * j] = *(const GAS f32x4*)(gf + 512 * j + 8 * lane); gq[2 * j + 1] = *(const GAS f32x4*)(gf + 512 * j + 8 * lane + 4); }
#pragma unroll
                        for (int i0 = 0; i0 < 16; i0 += 8) {
                            v4u w[8][2];
#pragma unroll
                            for (int r = 0; r < 8; ++r) {
#pragma unroll
                                for (int j = 0; j < 2; ++j) w[r][j] = *(const GAS v4u*)(XB + (size_t)(r0w + i0 + r) * DM + 512 * j + 8 * lane); }
#pragma unroll
                            for (int r = 0; r < 8; ++r) { const float rs = __uint_as_float(__builtin_amdgcn_readlane(__float_as_uint(rstd), i0 + r));
#pragma unroll
                                for (int j = 0; j < 2; ++j) { const v4u a = w[r][j]; const f32x4 g0 = gq[2 * j] * rs, g1 = gq[2 * j + 1] * rs;
                                    int d0 = __builtin_amdgcn_cvt_pk_fp8_f32(__builtin_bit_cast(float, a.x << 16) * g0.x, __builtin_bit_cast(float, a.x & 0xffff0000u) * g0.y, 0, false);
                                    d0 = __builtin_amdgcn_cvt_pk_fp8_f32(__builtin_bit_cast(float, a.y << 16) * g0.z, __builtin_bit_cast(float, a.y & 0xffff0000u) * g0.w, d0, true);
                                    int d1 = __builtin_amdgcn_cvt_pk_fp8_f32(__builtin_bit_cast(float, a.z << 16) * g1.x, __builtin_bit_cast(float, a.z & 0xffff0000u) * g1.y, 0, false);
                                    d1 = __builtin_amdgcn_cvt_pk_fp8_f32(__builtin_bit_cast(float, a.w << 16) * g1.z, __builtin_bit_cast(float, a.w & 0xffff0000u) * g1.w, d1, true);
                                    *(GAS v2u*)((unsigned char*)HB + (size_t)(r0w + i0 + r) * DM + 512 * j + 8 * lane) = (v2u){(unsigned)d0, (unsigned)d1}; } }
                        }
                    } else
                    for (int i = 0; i < 16; ++i) { const int m = r0w + i; f32x4 v[4]; rms_row_b16(XB + (size_t)m * DM, gf, v, lane);
                        if (MOE_FP8) {
#pragma unroll
                            for (int j = 0; j < 4; ++j) { int d = __builtin_amdgcn_cvt_pk_fp8_f32(v[j].x, v[j].y, 0, false); d = __builtin_amdgcn_cvt_pk_fp8_f32(v[j].z, v[j].w, d, true); *(GAS unsigned*)((unsigned char*)HB + (size_t)m * DM + 4 * lane + 256 * j) = (unsigned)d; }
                        } else store_row_bf16(HB + (size_t)m * DM, v, lane); }
                }
                unsigned r0 = 0, r1 = 0;
                if (lane < 16) { r0 = atomicAdd((unsigned*)(LC + LC_LCNT + my_e0), 1u); r1 = atomicAdd((unsigned*)(LC + LC_LCNT + my_e1), 1u); }
                __syncthreads();
                if (tid < 32) { const unsigned c = LC[LC_LCNT + tid]; LC[LC_LBASE + tid] = c ? __hip_atomic_fetch_add(gcnt + tid, c, RLX_AGENT) : 0u; }
                __syncthreads();
                if (lane < 16) { const int m = chunk * 128 + wave * 16 + lane;
                    const unsigned p0 = LC[LC_LBASE + my_e0] + r0, p1 = LC[LC_LBASE + my_e1] + r1;
                    list[(size_t)my_e0 * LIST_CAP + p0] = m; list[(size_t)my_e1 * LIST_CAP + p1] = m;
                    tokep[2 * m] = my_e0 | (int)(p0 << 8); tokep[2 * m + 1] = my_e1 | (int)(p1 << 8);
                    gate[2 * m] = my_g0; gate[2 * m + 1] = my_g1; }
            }
        }
        SEAM(pb);
        if (IN(pb + 1) || IN(pb + 2) || IN(pb + 3)) {
            __syncthreads();
            if (tid == 0) { int acc = 0; for (int e = 0; e < 32; ++e) { const int c = (int)__hip_atomic_load(gcnt0 + e, RLX_AGENT); LC[LC_CNT + e] = (unsigned)c; LC[LC_TP + e] = (unsigned)acc; acc += (c + 255) >> 8; } LC[LC_TP + 32] = (unsigned)acc;
                int la = 0; for (int j = 0; j < 4; ++j) { LC[LC_LP + j] = (unsigned)la; la += ((int)LC[LC_CNT + (bx & 7) + 8 * j] + 255) >> 8; } LC[LC_LP + 4] = (unsigned)la; }
            __syncthreads();
        }
        const LAS int* tp = (const LAS int*)(lds + LDSCTL_OFF) + LC_TP; const LAS int* cn = (const LAS int*)(lds + LDSCTL_OFF) + LC_CNT; const LAS int* lp = (const LAS int*)(lds + LDSCTL_OFF) + LC_LP;
        if (IN(pb + 1)) REP(pb + 1) {
            pg8::Gemm g{HB, (const bf16*)(ws + WS_W13), 0, 1024, MOE_FP8 ? DM / 2 : DM};
            pg8::MoeOrder S{tp, cn, lp, list, G, bx, tp[32] * 4, true, G == 256};
            pg8::EpiSwiglu E{(bf16*)(ws + WS_H), MOE_FP8 != 0};
            if (MOE_FP8) pg8::gemm_phase<pg8::EpiSwiglu, pg8::MoeOrder, true, true, 127, 122>(lds, g, S, E);
            else pg8::gemm_phase<pg8::EpiSwiglu, pg8::MoeOrder, true>(lds, g, S, E);
        }
        SEAM(pb + 1);
        if (IN(pb + 2)) REP(pb + 2) {
            pg8::Gemm g{(const bf16*)(ws + WS_H), (const bf16*)(ws + WS_W2), 0, 1024, MOE_FP8 ? MOE_H / 2 : MOE_H};
            pg8::MoeOrder S{tp, cn, lp, list, G, bx, tp[32] * 4, false, G == 256};
            pg8::EpiBf16 E{(bf16*)(ws + WS_YS), DM, 0, 0, 1.f, 3, MOE_FP8 != 0};
            if (MOE_FP8) pg8::gemm_phase<pg8::EpiBf16, pg8::MoeOrder, true, true, 125, 122>(lds, g, S, E);
            else pg8::gemm_phase<pg8::EpiBf16, pg8::MoeOrder, true>(lds, g, S, E);
        }
        SEAM(pb + 2);
        if (IN(pb + 3)) {
            const bf16* YS = (const bf16*)(ws + WS_YS);
            if (layer == 0) { LAS float* scr = (LAS float*)(lds + wave * 16384);
                transpose_moe(args.in[24] + (size_t)NEXP * 1024 * 512, args.in[25] + (size_t)NEXP * 1024 * 512, args.in[26] + (size_t)NEXP * 1024 * 512, (bf16*)(ws + WS_W13), (bf16*)(ws + WS_W2), scr, gw, NGW, lane); }
            const float* gn = layer == 0 ? args.in[1] + DM : args.in[3];
            for (int m = gw; m < NTOK; m += NGW) {
                const int ep0 = tokep[2 * m], ep1 = tokep[2 * m + 1]; const float g0 = gate[2 * m], g1 = gate[2 * m + 1];
                const size_t s0 = (size_t)(tp[ep0 & 255] * 256 + (ep0 >> 8)), s1 = (size_t)(tp[ep1 & 255] * 256 + (ep1 >> 8));
                GAS f32x4* xr = (GAS f32x4*)(xres + (size_t)m * DM) + lane; GAS v2u* xb = (GAS v2u*)(XB + (size_t)m * DM) + lane;
                const GAS v2u* y0 = (const GAS v2u*)(YS + s0 * DM) + lane; const GAS v2u* y1 = (const GAS v2u*)(YS + s1 * DM) + lane;
                const GAS unsigned* z0 = (const GAS unsigned*)((const unsigned char*)YS + s0 * DM) + lane; const GAS unsigned* z1 = (const GAS unsigned*)((const unsigned char*)YS + s1 * DM) + lane;
                f32x4 v[4]; float ss = 0.f;
#pragma unroll
                for (int j = 0; j < 4; ++j) { const v2u xw = xb[64 * j]; f32x4 xv = (f32x4){__builtin_bit_cast(float, xw.x << 16), __builtin_bit_cast(float, xw.x & 0xffff0000u), __builtin_bit_cast(float, xw.y << 16), __builtin_bit_cast(float, xw.y & 0xffff0000u)};
                    if (MOE_FP8) { typedef float f32x2_ __attribute__((ext_vector_type(2))); const unsigned a = z0[64 * j], c = z1[64 * j]; const float h0 = g0 * 0.125f, h1 = g1 * 0.125f;
                        const f32x2_ al = __builtin_amdgcn_cvt_pk_f32_fp8((int)a, false), ah = __builtin_amdgcn_cvt_pk_f32_fp8((int)a, true), cl = __builtin_amdgcn_cvt_pk_f32_fp8((int)c, false), ch = __builtin_amdgcn_cvt_pk_f32_fp8((int)c, true);
                        xv.x += h0 * al.x + h1 * cl.x; xv.y += h0 * al.y + h1 * cl.y; xv.z += h0 * ah.x + h1 * ch.x; xv.w += h0 * ah.y + h1 * ch.y;
                    } else { const v2u a = y0[64 * j], c = y1[64 * j];
                    xv.x += g0 * __builtin_bit_cast(float, a.x << 16) + g1 * __builtin_bit_cast(float, c.x << 16);
                    xv.y += g0 * __builtin_bit_cast(float, a.x & 0xffff0000u) + g1 * __builtin_bit_cast(float, c.x & 0xffff0000u);
                    xv.z += g0 * __builtin_bit_cast(float, a.y << 16) + g1 * __builtin_bit_cast(float, c.y << 16);
                    xv.w += g0 * __builtin_bit_cast(float, a.y & 0xffff0000u) + g1 * __builtin_bit_cast(float, c.y & 0xffff0000u); }
                    v[j] = xv; ss += (xv.x * xv.x + xv.y * xv.y) + (xv.z * xv.z + xv.w * xv.w); }
                const float rstd = 1.0f / sqrtf(wave_sum(ss) * (1.f / DM) + 1e-6f);
                const GAS f32x4* gr = (const GAS f32x4*)gn + lane;
                if (layer == 0) {
#pragma unroll
                    for (int j = 0; j < 4; ++j) xb[64 * j] = (v2u){pk2(v[j].x, v[j].y), pk2(v[j].z, v[j].w)};
#pragma unroll
                    for (int j = 0; j < 4; ++j) v[j] = v[j] * rstd * gr[64 * j];
                    if (IN1_FP8) {
#pragma unroll
                        for (int j = 0; j < 4; ++j) { int d = __builtin_amdgcn_cvt_pk_fp8_f32(v[j].x, v[j].y, 0, false); d = __builtin_amdgcn_cvt_pk_fp8_f32(v[j].z, v[j].w, d, true); *(GAS unsigned*)((unsigned char*)HB + (size_t)m * DM + 4 * lane + 256 * j) = (unsigned)d; }
                    } else store_row_bf16(HB + (size_t)m * DM, v, lane);
                } else {
#pragma unroll
                    for (int j = 0; j < 4; ++j) xr[64 * j] = v[j] * rstd * gr[64 * j];
                }
            }
        }
    }
}

__global__ void __launch_bounds__(NWAVES * 64, 2) mk_fwd(Args args) {
    extern __shared__ __attribute__((aligned(16))) unsigned char lds_raw[];
    LAS unsigned char* lds = (LAS unsigned char*)lds_raw;
    volatile LAS unsigned* LC = (volatile LAS unsigned*)(lds + LDSCTL_OFF);
    const int tid = threadIdx.x, lane = tid & 63, wave = __builtin_amdgcn_readfirstlane(tid >> 6);
    const int G = gridDim.x, bx = blockIdx.x;
    const int gw = bx * NWAVES + wave, NGW = G * NWAVES;
    unsigned char* ws = args.ws;
    unsigned* ctl = (unsigned*)(ws + WS_CTL);
    const float* x_in = args.in[0];
    float* xres = args.out;
    bf16* XB = (bf16*)(ws + WS_XB);
    bf16* HB = (bf16*)(ws + WS_HB); bf16* Y = (bf16*)(ws + WS_Y);
    float* TBL = (float*)(ws + WS_TBL);

    for (int u = tid; u < (LDS_BYTES - LDSCTL_OFF) / 4; u += NWAVES * 64) LC[u] = 0u;
    __syncthreads();
    XcdBarrier bar; bar.bar = ctl + CW_BAR; bar.x = 0; bar.st = nullptr;
    if (MK_N_LAUNCHES == 1) bar = xcd_barrier_post(ctl + CW_BAR, LC + LC_BAR);
    const int lo = args.ph_lo, hi_ph = args.ph_hi;

    if (IN(0)) REP(0) {
        LAS float* scr = (LAS float*)(lds + wave * 16384);
        transpose_plain(args.in[4], DM, EV_IN, (bf16*)(ws + WS_WIN0), scr, gw, NGW, lane);
        transpose_plain(args.in[11], DM, DM, (bf16*)(ws + WS_WOUT0), scr, gw, NGW, lane);
        transpose_plain<IN1_FP8 != 0>(args.in[12], DM, OD_IN, (bf16*)(ws + WS_WIN1), scr, gw, NGW, lane);
        transpose_plain(args.in[18], DM, DM, (bf16*)(ws + WS_WOUT1), scr, gw, NGW, lane);
        transpose_moe(args.in[24], args.in[25], args.in[26], (bf16*)(ws + WS_W13), (bf16*)(ws + WS_W2), scr, gw, NGW, lane);
        for (int i = bx * 512 + tid; i < 2048; i += G * 512) { const int pos = i >> 4, f = i & 15;
            const float inv = exp2f(-(float)f * (13.287712379549449f / 16.0f));
            const float ang = (float)pos * inv; const float rev = ang * 0.15915494309189535f; const float fr = rev - floorf(rev);
            TBL[TBL_COS + i] = __builtin_amdgcn_cosf(fr); TBL[TBL_SIN + i] = __builtin_amdgcn_sinf(fr); }
        for (int i = bx * 512 + tid; i < 8 * 257; i += G * 512) { const int h = i / 257, j = i % 257;
            TBL[TBL_BIAS + h * BIAS_STRIDE + j] = args.in[19][t5_bucket(j - 128) * 8 + h] * LOG2E; }
        for (int i = bx * 512 + tid; i < 2 * 1024 * 48; i += G * 512) { const int l = i / (1024 * 48), r = i % (1024 * 48), k = r / 48, c = r % 48;
            float w = 0.f; if (c < 4) w = args.in[20][(size_t)l * 4096 + k * 4 + c]; else if (c < 36) w = args.in[22][(size_t)l * 32768 + k * 32 + (c - 4)];
            TBL[TBL_WR + l * WR_LAYER + r] = w * args.in[2][l * DM + k]; }
        {
            bf16* TBH = (bf16*)((unsigned char*)TBL + 614400);
            for (int i = bx * 512 + tid; i < 2 * 48 * 1024; i += G * 512) { const int l = i / (48 * 1024), r = i % (48 * 1024), c = r >> 10; int k = r & 1023;
                if (ROUTER_LDSW) { const int q = k & 511; k = (k & 512) + ((q >> 3) & 15) * 32 + (q >> 7) * 8 + (q & 7); }
                float w = 0.f; if (c < 4) w = args.in[20][(size_t)l * 4096 + k * 4 + c]; else if (c < 36) w = args.in[22][(size_t)l * 32768 + k * 32 + (c - 4)];
                w *= args.in[2][l * DM + k]; const unsigned hb = f2bf(w); const float rem = w - bf2f((unsigned short)hb);
                TBH[(size_t)(l * 2) * 49152 + r] = (bf16)hb; TBH[(size_t)(l * 2 + 1) * 49152 + r] = (bf16)f2bf(rem); }
        }
        for (int i = bx * 512 + tid; i < 2 * 48; i += G * 512) { const int l = i / 48, c = i % 48;
            TBL[TBL_WR + l * WR_LAYER + 1024 * 48 + c] = c < 4 ? args.in[21][l * 4 + c] : (c < 36 ? args.in[23][l * 32 + (c - 4)] : 0.f); }
        for (int m = gw; m < NTOK; m += NGW) { f32x4 v[4]; rms_row(x_in + (size_t)m * DM, args.in[1], v, lane); store_row_bf16(HB + (size_t)m * DM, v, lane); }
    }
    SEAM(0);
    if (IN(1)) REP(1) {
        pg8::Gemm g{HB, (const bf16*)(ws + WS_WIN0), NTOK, EV_IN, DM}; pg8::StaticOrder S; S.init(NTOK, EV_IN, G, bx);
        pg8::EpiBf16 E{(bf16*)(ws + WS_Z0), EV_IN, 0, 0, 1.f, 0xffff, false};
        pg8::gemm_phase<pg8::EpiBf16, pg8::StaticOrder, true>(lds, g, S, E);
    }
    SEAM(1);
    if (IN(2)) REP(2) {
        const bf16* Z0 = (const bf16*)(ws + WS_Z0); bf16* QR = (bf16*)(ws + WS_QR); bf16* KR = (bf16*)(ws + WS_KR);
        if (QK_FP8 && (ATTN_VER == 1 || ATTN_VER == 3)) {
            for (int it = bx * 512 + tid; it < NTOK * 10; it += G * 512) {
                const bool isq = it < NTOK * 8; const int m = isq ? (it >> 3) : ((it - NTOK * 8) >> 1); const int hh = isq ? (it & 7) : 8 + ((it - NTOK * 8) & 1);
                const float* gn = isq ? args.in[5] : args.in[6];
                const GAS v4u* srcp = (const GAS v4u*)(Z0 + (size_t)m * EV_IN + hh * 64);
                float xv[64]; float ss = 0.f;
#pragma unroll
                for (int q = 0; q < 8; ++q) { const v4u a = srcp[q];
#pragma unroll
                    for (int j = 0; j < 4; ++j) { const float lo = __builtin_bit_cast(float, a[j] << 16), hh2 = __builtin_bit_cast(float, a[j] & 0xffff0000u); xv[q * 8 + 2 * j] = lo; xv[q * 8 + 2 * j + 1] = hh2; ss += lo * lo + hh2 * hh2; } }
                const float rs = (1.0f / sqrtf(ss * (1.f / 64.f) + 1e-6f)) * (isq ? C2 * 8.0f : 1.0f);
                const int sp = m & (SEQ - 1);
                unsigned wout[16];
#pragma unroll
                for (int half = 0; half < 2; ++half) { const int pos = half ? (sp & 63) : (sp >> 6);
                    const GAS f32x4* ct = (const GAS f32x4*)(TBL + TBL_COS + pos * 16); const GAS f32x4* st = (const GAS f32x4*)(TBL + TBL_SIN + pos * 16);
                    float ov[32];
#pragma unroll
                    for (int q = 0; q < 4; ++q) { const f32x4 cv = ct[q], sv = st[q];
#pragma unroll
                        for (int j = 0; j < 4; ++j) { const int i = q * 4 + j; const float a = xv[half * 32 + i] * rs * gn[half * 32 + i], b2 = xv[half * 32 + 16 + i] * rs * gn[half * 32 + 16 + i];
                            ov[i] = a * cv[j] - b2 * sv[j]; ov[16 + i] = b2 * cv[j] + a * sv[j]; } }
#pragma unroll
                    for (int q = 0; q < 8; ++q) { int d = __builtin_amdgcn_cvt_pk_fp8_f32(ov[4 * q], ov[4 * q + 1], 0, false); d = __builtin_amdgcn_cvt_pk_fp8_f32(ov[4 * q + 2], ov[4 * q + 3], d, true); wout[half * 8 + q] = (unsigned)d; } }
                if (!isq && ATTN_VER == 3) {
                    const int strm = (m >> 13) * 2 + (hh - 8); unsigned char* kb_ = ws + WS_K8T0 + ((((size_t)strm * 128 + (sp >> 6)) * 4) * 64 + (sp & 63)) * 16;
#pragma unroll
                    for (int q = 0; q < 4; ++q) *(GAS v4u*)(kb_ + q * 1024) = (v4u){wout[4 * q], wout[4 * q + 1], wout[4 * q + 2], wout[4 * q + 3]};
                } else {
                GAS v4u* dst = isq ? (GAS v4u*)(ws + WS_QR8 + (size_t)m * 512 + hh * 64) : (GAS v4u*)(ws + WS_KR8 + (size_t)m * 128 + (hh - 8) * 64);
#pragma unroll
                for (int q = 0; q < 4; ++q) dst[q] = (v4u){wout[4 * q], wout[4 * q + 1], wout[4 * q + 2], wout[4 * q + 3]};
                }
            }
            if (ATTN_VER == 3) {
                for (int it = bx * 512 + tid; it < 8 * 128 * 4 * 64; it += G * 512) { const int d = it & 63, c = (it >> 6) & 3, tt = (it >> 8) & 127, strm = it >> 15;
                    const bf16* vb_ = Z0 + ((size_t)(strm >> 1) * SEQ + tt * 64) * EV_IN + 640 + (strm & 1) * 64 + d; unsigned w4[4];
#pragma unroll
                    for (int q = 0; q < 4; ++q) { float f[4];
#pragma unroll
                        for (int j = 0; j < 4; ++j) { const int bb = q * 4 + j; const int key = 32 * (c & 1) + (bb & 3) + 8 * (bb >> 2) + 4 * (c >> 1); f[j] = bf2f(vb_[(size_t)key * EV_IN]); }
                        int dw = __builtin_amdgcn_cvt_pk_fp8_f32(f[0], f[1], 0, false); dw = __builtin_amdgcn_cvt_pk_fp8_f32(f[2], f[3], dw, true); w4[q] = (unsigned)dw; }
                    *(GAS v4u*)(ws + WS_V8T0 + (size_t)it * 16) = (v4u){w4[0], w4[1], w4[2], w4[3]}; }
            }
        } else {
        const float gq = args.in[5][lane], gk = args.in[6][lane];
        const int fi = lane & 15; const bool first = (lane & 16) == 0, isrow = lane < 32;
        for (int m = gw; m < NTOK; m += NGW) {
            const int s = m & (SEQ - 1); const int pos = isrow ? (s >> 6) : (s & 63);
            const float cs = TBL[TBL_COS + pos * 16 + fi], sn = TBL[TBL_SIN + pos * 16 + fi];
#pragma unroll
            for (int h = 0; h < 10; ++h) {
                const float xv = bf2f(Z0[(size_t)m * EV_IN + h * 64 + lane]);
                const float ss = wave_sum(xv * xv);
                const float y = xv * (1.0f / sqrtf(ss * (1.f / 64.f) + 1e-6f)) * (h < 8 ? gq : gk);
                const float p = __shfl_xor(y, 16);
                float o = first ? (y * cs - p * sn) : (y * cs + p * sn);
                if (!QK_FP8 || ATTN_VER != 1) { if (h < 8) QR[(size_t)m * 512 + h * 64 + lane] = (bf16)f2bf(o * C2);
                else KR[(size_t)m * 128 + (h - 8) * 64 + lane] = (bf16)f2bf(o); }
                if (QK_FP8) { const unsigned w = quad_pack_bytes(fp8_byte(h < 8 ? o * (C2 * 8.0f) : o));
                    if ((lane & 3) == 0) { if (h < 8) *(unsigned*)(ws + WS_QR8 + (size_t)m * 512 + h * 64 + lane) = w; else *(unsigned*)(ws + WS_KR8 + (size_t)m * 128 + (h - 8) * 64 + lane) = w; } }
            }
        }
        }
        LAS float* hbuf = (LAS float*)lds;
        for (int un = bx; un < NBATCH * 64 * 8; un += G) {
            const int grp = un & 7, tt = (un >> 3) & 63, b = un >> 9; const int t0 = tt * 128;
            __syncthreads();
            for (int idx = tid; idx < 158 * 8; idx += 512) { const int r = idx >> 3, c8 = idx & 7; const int s = t0 - 15 + r;
                f32x4 h0 = {0.f, 0.f, 0.f, 0.f}, h1 = h0;
                if (s >= 0 && s < SEQ) { const size_t ro = (size_t)(b * SEQ + s) * EV_IN + grp * 64 + c8 * 8;
                    const v4u av = *(const GAS v4u*)(Z0 + ro + 768), gv = *(const GAS v4u*)(Z0 + ro + 1280);
#pragma unroll
                    for (int j = 0; j < 4; ++j) { const float a0 = __builtin_bit_cast(float, av[j] << 16), a1 = __builtin_bit_cast(float, av[j] & 0xffff0000u);
                        const float g0 = __builtin_bit_cast(float, gv[j] << 16), g1 = __builtin_bit_cast(float, gv[j] & 0xffff0000u);
                        const float x0 = a0 * __builtin_amdgcn_rcpf(1.0f + __builtin_amdgcn_exp2f(-g0 * LOG2E)), x1 = a1 * __builtin_amdgcn_rcpf(1.0f + __builtin_amdgcn_exp2f(-g1 * LOG2E));
                        if (j < 2) { h0[2 * j] = x0; h0[2 * j + 1] = x1; } else { h1[2 * j - 4] = x0; h1[2 * j - 3] = x1; } } }
                *(LAS f32x4*)(hbuf + r * 64 + c8 * 8) = h0; *(LAS f32x4*)(hbuf + r * 64 + c8 * 8 + 4) = h1; }
            __syncthreads();
            const int ch = grp * 64 + lane;
            float wreg[31];
#pragma unroll
            for (int j = 0; j < 31; ++j) wreg[j] = args.in[7][j * 512 + ch];
            typedef float f32x2 __attribute__((ext_vector_type(2)));
            float acc[16]; const float cb = args.in[8][ch];
            {
                f32x2 he[23], ho[22];
#pragma unroll
                for (int k = 0; k < 23; ++k) { he[k].x = hbuf[(wave * 16 + 2 * k) * 64 + lane]; he[k].y = hbuf[(wave * 16 + 2 * k + 1) * 64 + lane]; }
#pragma unroll
                for (int k = 0; k < 22; ++k) { ho[k].x = he[k].y; ho[k].y = he[k + 1].x; }
                f32x2 a2[8];
#pragma unroll
                for (int p = 0; p < 8; ++p) a2[p] = (f32x2){cb, cb};
#pragma unroll
                for (int j = 0; j < 31; ++j) { const f32x2 wj = (f32x2){wreg[j], wreg[j]};
#pragma unroll
                    for (int p = 0; p < 8; ++p) { const int r = 2 * p + j; a2[p] = __builtin_elementwise_fma(wj, (r & 1) ? ho[r >> 1] : he[r >> 1], a2[p]); } }
#pragma unroll
                for (int p = 0; p < 8; ++p) { acc[2 * p] = a2[p].x; acc[2 * p + 1] = a2[p].y; }
            }
            const float gg = args.in[9][ch], gb = args.in[10][ch];
#pragma unroll
            for (int i = 0; i < 16; ++i) { const float mu = wave_sum(acc[i]) * (1.f / 64.f); const float d = acc[i] - mu; const float var = wave_sum(d * d) * (1.f / 64.f);
                const float hn = d * (1.0f / sqrtf(var + 1e-5f)) * gg + gb; const float ov = hn * __builtin_amdgcn_rcpf(1.0f + __builtin_amdgcn_exp2f(-hn * LOG2E));
                Y[(size_t)(b * SEQ + t0 + wave * 16 + i) * DM + 512 + ch] = (bf16)f2bf(ov); }
        }
    }
    SEAM(2);
    if (IN(3)) REP(3) {
        const bf16* QR = (const bf16*)(ws + WS_QR); const bf16* KR = (const bf16*)(ws + WS_KR); const bf16* Z0 = (const bf16*)(ws + WS_Z0);
        if (ATTN_L0_TEST) {
        for (int un = bx; un < NBATCH * 8 * 32; un += G) {
            const int qb = un & 31, h = (un >> 5) & 7, b = un >> 8, kvh = h >> 2;
            const size_t row0 = (size_t)b * SEQ + qb * 256;
            attn_unit_v0<64, false, true>((const bf16*)(ws + WS_QR8 + row0 * 512 + h * 64), 512, (const bf16*)(ws + WS_KR8 + (size_t)b * SEQ * 128 + kvh * 64), 128, Z0 + (size_t)b * SEQ * EV_IN + 640 + kvh * 64, EV_IN,
                                   Y + row0 * DM + h * 64, DM, nullptr, qb * 256, lds);
        }
        } else if (ATTN_VER == 0) {
        for (int un = bx; un < NBATCH * 8 * 32; un += G) {
            const int qb = un & 31, h = (un >> 5) & 7, b = un >> 8, kvh = h >> 2;
            const size_t row0 = (size_t)b * SEQ + qb * 256;
            attn_unit_v0<64, false>(QR + row0 * 512 + h * 64, 512, KR + (size_t)b * SEQ * 128 + kvh * 64, 128, Z0 + (size_t)b * SEQ * EV_IN + 640 + kvh * 64, EV_IN,
                                   Y + row0 * DM + h * 64, DM, nullptr, qb * 256, lds);
        }
        } else {
        constexpr int U = NBATCH * 8 * 32; const int upc = (U + G - 1) / G; const int vcu = (G % 8 == 0) ? (bx % 8) * (G / 8) + bx / 8 : bx;
        for (int i = 0; i < upc; ++i) { const int un = vcu * upc + i; if (un >= U) break;
            const int stream = un >> 7, b = stream >> 1, kvh = stream & 1, h = kvh * 4 + ((un >> 5) & 3), qb = un & 31;
            const size_t row0 = (size_t)b * SEQ + qb * 256;
            if (ATTN_VER == 3) at3::attn_unit<64, false, 0>(ws + WS_QR8 + row0 * 512 + h * 64, 512, ws + WS_K8T0 + (size_t)stream * 128 * 4096, ws + WS_V8T0 + (size_t)stream * 128 * 4096, Y + row0 * DM + h * 64, DM, qb * 256, lds, nullptr);
            else if (QK_FP8) at1::attn_unit<64, false, 0, 0, true>((const bf16*)(ws + WS_QR8 + row0 * 512 + h * 64), 512, (const bf16*)(ws + WS_KR8 + (size_t)b * SEQ * 128 + kvh * 64), 128, Z0 + (size_t)b * SEQ * EV_IN + 640 + kvh * 64, EV_IN,
                                      Y + row0 * DM + h * 64, DM, qb * 256, lds);
            else at1::attn_unit<64, false>(QR + row0 * 512 + h * 64, 512, KR + (size_t)b * SEQ * 128 + kvh * 64, 128, Z0 + (size_t)b * SEQ * EV_IN + 640 + kvh * 64, EV_IN,
                                      Y + row0 * DM + h * 64, DM, qb * 256, lds);
        }
        }
    }
    SEAM(3);
    if (IN(4)) REP(4) {
        pg8::Gemm g{Y, (const bf16*)(ws + WS_WOUT0), NTOK, DM, DM}; pg8::StaticOrder S; S.init(NTOK, DM, G, bx);
        pg8::EpiRes E{x_in, nullptr, XB, DM};
        pg8::gemm_phase<pg8::EpiRes, pg8::StaticOrder, true>(lds, g, S, E);
    }
    SEAM(4);

    moe_block<0>(args, lds, bar, lo, hi_ph);
    SEAM(8);
            if (IN(9)) REP(9) {
                pg8::Gemm g{HB, (const bf16*)(ws + WS_WIN1), NTOK, OD_IN, IN1_FP8 ? DM / 2 : DM}; pg8::StaticOrder S; S.init(NTOK, OD_IN, G, bx);
                if (QK_FP8) { pg8::EpiQKV8 E{ws + WS_Q1, ws + WS_K8T1, (bf16*)(ws + WS_V1), C2 * 8.0f, true};
                    if (IN1_FP8) pg8::gemm_phase<pg8::EpiQKV8, pg8::StaticOrder, true, true, 127, 122>(lds, g, S, E);
                    else pg8::gemm_phase<pg8::EpiQKV8, pg8::StaticOrder, true>(lds, g, S, E); }
                else { pg8::EpiBf16 E{(bf16*)(ws + WS_Q1), DM, DM, (size_t)(WS_K1 - WS_Q1) / 2, C2, 0xffff, false};
                pg8::gemm_phase<pg8::EpiBf16, pg8::StaticOrder, true>(lds, g, S, E); }
            }
            SEAM(9);
            if (ATTN_L1_VER == 3) {
            if (IN(10)) {
                const bf16* V1 = (const bf16*)(ws + WS_V1);
                for (int it = bx * 512 + tid; it < 32 * 128 * 4 * 128; it += G * 512) { const int d = it & 127, c = (it >> 7) & 3, tt = (it >> 9) & 127, bh = it >> 16;
                    const bf16* vb_ = V1 + (((size_t)bh * 128 + tt) * 4 + (d >> 5)) * 2048 + (d & 31); unsigned w4[4];
#pragma unroll
                    for (int q = 0; q < 4; ++q) { float f[4];
#pragma unroll
                        for (int j = 0; j < 4; ++j) { const int bb = q * 4 + j; const int key = 32 * (c & 1) + (bb & 3) + 8 * (bb >> 2) + 4 * (c >> 1); f[j] = bf2f(vb_[(size_t)key * 32]); }
                        int dw = __builtin_amdgcn_cvt_pk_fp8_f32(f[0], f[1], 0, false); dw = __builtin_amdgcn_cvt_pk_fp8_f32(f[2], f[3], dw, true); w4[q] = (unsigned)dw; }
                    *(GAS v4u*)(ws + WS_V8T1 + (size_t)it * 16) = (v4u){w4[0], w4[1], w4[2], w4[3]}; }
            }
            SEAM(10);
            if (IN(11)) REP(11) {
                constexpr int UP = NBATCH * 8 * 32; const int upc = (UP + G - 1) / G; const int vcu = (G % 8 == 0) ? (bx % 8) * (G / 8) + bx / 8 : bx;
                LAS float* btbl = (LAS float*)(lds + at3::lds_tbl_off<128>());
                LAS float* sgt = btbl + 272;
                __syncthreads();
                if (tid < 128) sgt[tid] = args.in[17][tid] * (1.0f - LAM_INIT);
                if (wave == 7) { const float lam = __expf(wave_sum(args.in[13][lane] * args.in[14][lane])) - __expf(wave_sum(args.in[15][lane] * args.in[16][lane])) + LAM_INIT; if (lane == 0) sgt[128] = lam; }
                for (int i = 0; i < upc; ++i) {
                    int up = vcu * upc + i; if (up >= UP) break;
                    if (G == 256) up = ((vcu >> 5) * 4 + i) * 32 + (vcu & 31);
                    const int qb = up & 31, h = (up >> 5) & 7, b = up >> 8;
                    __syncthreads();
                    if (tid < 257) btbl[tid] = TBL[TBL_BIAS + h * BIAS_STRIDE + tid] - TBL[TBL_BIAS + h * BIAS_STRIDE + 256];
                    __syncthreads();
                    const size_t row0 = (size_t)b * SEQ + qb * 256; const int bh = b * 8 + h;
                    const unsigned char* Q8 = ws + WS_Q1 + row0 * DM + h * 128; const unsigned char* V8 = ws + WS_V8T1 + (size_t)bh * 128 * 8192;
                    at3::attn_unit<128, true, 1>(Q8, DM, ws + WS_K8T1 + (size_t)(bh * 2) * 128 * 4096, V8, nullptr, DM, qb * 256, lds, sgt);
                    at3::attn_unit<128, true, 2>(Q8 + 64, DM, ws + WS_K8T1 + (size_t)(bh * 2 + 1) * 128 * 4096, V8, Y + row0 * DM + h * 128, DM, qb * 256, lds, sgt);
                }
            }
            SEAM(11);
            } else {
            if (IN(10)) REP(10) {
                const bf16* Q1 = (const bf16*)(ws + WS_Q1); const bf16* K1 = (const bf16*)(ws + WS_K1); const bf16* V1 = (const bf16*)(ws + WS_V1);
                if (ATTN_L1_VER == 0) {
                LAS float* btbl = (LAS float*)(lds + 65536);
                for (int un = bx; un < NBATCH * 8 * 2 * 32; un += G) {
                    const int qb = un & 31, c = (un >> 5) & 1, h = (un >> 6) & 7, b = un >> 9;
                    __syncthreads();
                    if (tid < 257) btbl[tid] = TBL[TBL_BIAS + h * BIAS_STRIDE + tid];
                    __syncthreads();
                    const size_t row0 = (size_t)b * SEQ + qb * 256, brow = (size_t)b * SEQ;
                    bf16* OC = (bf16*)(ws + (c ? WS_OC1 : WS_OC0));
                    attn_unit_v0<128, true>(Q1 + row0 * DM + h * 128 + c * 64, DM, K1 + brow * DM + h * 128 + c * 64, DM, V1 + brow * DM + h * 128, DM,
                                           OC + row0 * DM + h * 128, DM, btbl, qb * 256, lds);
                }
                } else {
                constexpr int UP = NBATCH * 8 * 32; const int upc = (UP + G - 1) / G; const int vcu = (G % 8 == 0) ? (bx % 8) * (G / 8) + bx / 8 : bx;
                LAS float* btbl = (LAS float*)(lds + at1::lds_tbl_off<128, QK_FP8 != 0>());
                LAS float* sgt = btbl + 272;
                __syncthreads();
                if (tid < 128) sgt[tid] = args.in[17][tid] * (1.0f - LAM_INIT);
                if (wave == 7) { const float lam = __expf(wave_sum(args.in[13][lane] * args.in[14][lane])) - __expf(wave_sum(args.in[15][lane] * args.in[16][lane])) + LAM_INIT; if (lane == 0) sgt[128] = lam; }
                for (int i = 0; i < upc; ++i) {
                    int up = vcu * upc + i; if (up >= UP) break;
                    if (G == 256) up = ((vcu >> 5) * 4 + i) * 32 + (vcu & 31);
                    const int qb = up & 31, h = (up >> 5) & 7, b = up >> 8;
                    __syncthreads();
                    if (tid < 257) btbl[tid] = TBL[TBL_BIAS + h * BIAS_STRIDE + tid] - TBL[TBL_BIAS + h * BIAS_STRIDE + 256];
                    __syncthreads();
                    const size_t row0 = (size_t)b * SEQ + qb * 256, brow = (size_t)b * SEQ;
                    if (QK_FP8) { const unsigned char* Q8 = ws + WS_Q1; const unsigned char* K8 = ws + WS_K1;
                    const int bh = b * 8 + h; const bf16* VT = V1 + (size_t)bh * 128 * 8192; const unsigned char* KT0 = ws + WS_K8T1 + (size_t)(bh * 2) * 128 * 4096; (void)K8; (void)brow;
                    at1::attn_unit<128, true, 0, 1, true, true>((const bf16*)(Q8 + row0 * DM + h * 128), DM, (const bf16*)KT0, DM, VT, DM, nullptr, DM, qb * 256, lds, sgt);
                    at1::attn_unit<128, true, 0, 2, true, true>((const bf16*)(Q8 + row0 * DM + h * 128 + 64), DM, (const bf16*)(KT0 + 128 * 4096), DM, VT, DM, Y + row0 * DM + h * 128, DM, qb * 256, lds, sgt);
                    } else {
                    at1::attn_unit<128, true, 0, 1>(Q1 + row0 * DM + h * 128, DM, K1 + brow * DM + h * 128, DM, V1 + brow * DM + h * 128, DM, nullptr, DM, qb * 256, lds, sgt);
                    at1::attn_unit<128, true, 0, 2>(Q1 + row0 * DM + h * 128 + 64, DM, K1 + brow * DM + h * 128 + 64, DM, V1 + brow * DM + h * 128, DM, Y + row0 * DM + h * 128, DM, qb * 256, lds, sgt);
                    }
                }
                }
            }
            SEAM(10);
            if (PROBE_ATT >= 0 && IN(10)) {
                const bf16* Q1 = (const bf16*)(ws + WS_Q1); const bf16* K1 = (const bf16*)(ws + WS_K1); const bf16* V1 = (const bf16*)(ws + WS_V1);
                constexpr int U = NBATCH * 8 * 2 * 32; const int upc = (U + G - 1) / G; const int vcu = (G % 8 == 0) ? (bx % 8) * (G / 8) + bx / 8 : bx;
                LAS float* btbl = (LAS float*)(lds + 3 * 8192 + 3 * 16384 + 2048);
                for (int i = 0; i < upc; ++i) {
                    int un = vcu * upc + i; if (un >= U) break;
                    if (G == 256) un = ((vcu >> 5) * 4 + (i >> 1)) * 64 + (i & 1) * 32 + (vcu & 31);
                    const int qb = un & 31, c = (un >> 5) & 1, h = (un >> 6) & 7, b = un >> 9;
                    if (tid < 257) btbl[tid] = TBL[TBL_BIAS + h * BIAS_STRIDE + tid] - TBL[TBL_BIAS + h * BIAS_STRIDE + 256];
                    __syncthreads();
                    const size_t row0 = (size_t)b * SEQ + qb * 256, brow = (size_t)b * SEQ;
                    at1::attn_unit<128, true, (PROBE_ATT >= 0 ? PROBE_ATT : 0)>(Q1 + row0 * DM + h * 128 + c * 64, DM, K1 + brow * DM + h * 128 + c * 64, DM, V1 + brow * DM + h * 128, DM,
                                              (bf16*)(ws + WS_OC1) + row0 * DM + h * 128, DM, qb * 256, lds);
                }
                xcd_barrier(bar);
            }
            if (IN(11) && ATTN_L1_VER != 1) REP(11) {
                const bf16* OC0 = (const bf16*)(ws + WS_OC0); const bf16* OC1 = (const bf16*)(ws + WS_OC1);
                const float lam = __expf(wave_sum(args.in[13][lane] * args.in[14][lane])) - __expf(wave_sum(args.in[15][lane] * args.in[16][lane])) + LAM_INIT;
                float sg[16];
#pragma unroll
                for (int j = 0; j < 16; ++j) sg[j] = args.in[17][(lane & 7) * 16 + j] * (1.0f - LAM_INIT);
                for (int m = gw; m < NTOK; m += NGW) {
                    const GAS v4u* a = (const GAS v4u*)(OC0 + (size_t)m * DM) + lane * 2; const GAS v4u* c = (const GAS v4u*)(OC1 + (size_t)m * DM) + lane * 2;
                    float o[16]; float ss = 0.f;
#pragma unroll
                    for (int q = 0; q < 2; ++q) { const v4u av = a[q], cv = c[q];
#pragma unroll
                        for (int j = 0; j < 4; ++j) { const unsigned au = av[j], cu = cv[j];
                            const float lo = __builtin_bit_cast(float, au << 16) - lam * __builtin_bit_cast(float, cu << 16);
                            const float hh = __builtin_bit_cast(float, au & 0xffff0000u) - lam * __builtin_bit_cast(float, cu & 0xffff0000u);
                            o[q * 8 + 2 * j] = lo; o[q * 8 + 2 * j + 1] = hh; ss += lo * lo + hh * hh; } }
                    ss += __shfl_xor(ss, 1); ss += __shfl_xor(ss, 2); ss += __shfl_xor(ss, 4);
                    const float rstd = 1.0f / sqrtf(ss * (1.f / 128.f) + 1e-5f);
                    v4u w0, w1;
                    w0.x = pk2(o[0] * rstd * sg[0], o[1] * rstd * sg[1]); w0.y = pk2(o[2] * rstd * sg[2], o[3] * rstd * sg[3]); w0.z = pk2(o[4] * rstd * sg[4], o[5] * rstd * sg[5]); w0.w = pk2(o[6] * rstd * sg[6], o[7] * rstd * sg[7]);
                    w1.x = pk2(o[8] * rstd * sg[8], o[9] * rstd * sg[9]); w1.y = pk2(o[10] * rstd * sg[10], o[11] * rstd * sg[11]); w1.z = pk2(o[12] * rstd * sg[12], o[13] * rstd * sg[13]); w1.w = pk2(o[14] * rstd * sg[14], o[15] * rstd * sg[15]);
                    GAS v4u* yo = (GAS v4u*)(Y + (size_t)m * DM) + lane * 2; yo[0] = w0; yo[1] = w1;
                }
            }
            if (ATTN_L1_VER != 1) SEAM(11);
            }
            if (IN(12)) {
                pg8::Gemm g{Y, (const bf16*)(ws + WS_WOUT1), NTOK, DM, DM}; pg8::StaticOrder S; S.init(NTOK, DM, G, bx);
                pg8::EpiRes E{nullptr, XB, XB, DM};
                pg8::gemm_phase<pg8::EpiRes, pg8::StaticOrder, true>(lds, g, S, E);
            }
            SEAM(12);
    moe_block<1>(args, lds, bar, lo, hi_ph);
#undef IN
#undef SEAM
}

extern "C" void kernel_launch(void* const* d_in, const int* in_sizes, int n_in, void* d_out, int out_size, void* d_ws, size_t ws_size, hipStream_t stream) {
    static int grid = 0;
    if (grid == 0) {
        if (n_in != 27 || in_sizes[0] != NTOK * DM || out_size != NTOK * DM || ws_size < WS_END) { fprintf(stderr, "kernel_launch: unexpected shapes / workspace (n_in %d, ws %zu)\n", n_in, ws_size); grid = -1; return; }
        int dev = 0, cus = 0, per_cu = 0;
        if (hipGetDevice(&dev) != hipSuccess || hipDeviceGetAttribute(&cus, hipDeviceAttributeMultiprocessorCount, dev) != hipSuccess) { grid = -1; return; }
        if (hipFuncSetAttribute((const void*)mk_fwd, hipFuncAttributeMaxDynamicSharedMemorySize, LDS_BYTES) != hipSuccess) { fprintf(stderr, "kernel_launch: hipFuncSetAttribute failed\n"); grid = -1; return; }
        if (hipOccupancyMaxActiveBlocksPerMultiprocessor(&per_cu, (const void*)mk_fwd, NWAVES * 64, LDS_BYTES) != hipSuccess || per_cu < 1) { fprintf(stderr, "kernel_launch: occupancy query says %d\n", per_cu); }
        (void)hipGetLastError();
        grid = cus;
    }
    if (grid < 0) return;
    if (hipMemsetAsync((char*)d_ws + WS_CTL, 0, CTL_ZERO_BYTES, stream) != hipSuccess) return;
    Args a{};
    for (int i = 0; i < 27; ++i) a.in[i] = (const float*)d_in[i];
    a.out = (float*)d_out; a.ws = (unsigned char*)d_ws;
    if (MK_N_LAUNCHES == 1) { a.ph_lo = 0; a.ph_hi = NPHASE; a.li = 0; hipLaunchKernelGGL(mk_fwd, dim3(grid), dim3(NWAVES * 64), LDS_BYTES, stream, a); }
    else { for (int p = 0; p < NPHASE; ++p) for (int r = 0; r < (int)((PROBE_MASK >> p) & 1u) + 1; ++r) { a.ph_lo = p; a.ph_hi = p + 1; a.li = p; hipLaunchKernelGGL(mk_fwd, dim3(grid), dim3(NWAVES * 64), LDS_BYTES, stream, a); } }
}
```

```cpp
#include <hip/hip_runtime.h>
#include <cstdio>
#include <cstdint>

#ifndef MK_N_LAUNCHES
#define MK_N_LAUNCHES 1
#endif

#ifndef ATTN_VER
#define ATTN_VER 3
#endif
#ifndef PROBE_ATT
#define PROBE_ATT -1
#endif
#ifndef QK_FP8
#define QK_FP8 1
#endif
#ifndef ATTN_L0_TEST
#define ATTN_L0_TEST 0
#endif
#ifndef ATTN_L1_VER
#define ATTN_L1_VER 3
#endif
#ifndef MOE_FP8
#define MOE_FP8 1
#endif
#ifndef IN1_FP8
#define IN1_FP8 1
#endif
#ifndef ROUTER_LDSW
#define ROUTER_LDSW 1
#endif
#ifndef WIDE_F8_STORE
#define WIDE_F8_STORE 1
#endif
#ifndef V_TRANSPOSED_GEMM
#define V_TRANSPOSED_GEMM 1
#endif
#ifndef SIDE_CONV
#define SIDE_CONV 1
#endif
#ifndef MOE_ITEMS_W13_FIRST
#define MOE_ITEMS_W13_FIRST 1
#endif
#ifndef COMBINE_PIPE
#define COMBINE_PIPE 1
#endif
#ifndef PROBE_MASK
#define PROBE_MASK 0u
#endif
#ifndef PROBE_REPS
#define PROBE_REPS 1
#endif
#define REP(k) _Pragma("unroll") for (int rep_ = 0; rep_ < (MK_N_LAUNCHES == 1 ? (int)((PROBE_MASK >> (k)) & 1u) * PROBE_REPS : 0) + 1; ++rep_)
#define GAS __attribute__((address_space(1)))
#define LAS __attribute__((address_space(3)))
typedef unsigned short bf16;
typedef unsigned v4u __attribute__((ext_vector_type(4)));
typedef unsigned v2u __attribute__((ext_vector_type(2)));
typedef float f32x4 __attribute__((ext_vector_type(4)));
typedef float f32x16 __attribute__((ext_vector_type(16)));
typedef short bf16x8 __attribute__((ext_vector_type(8)));
typedef short s16x4 __attribute__((ext_vector_type(4)));
typedef int v8i __attribute__((ext_vector_type(8)));

constexpr int NTOK = 32768, DM = 1024, SEQ = 8192, NBATCH = 4;
constexpr int EV_IN = 1792, OD_IN = 3072;
#ifndef IN0_GLU
#define IN0_GLU 1
#endif
constexpr int Z_LD = IN0_GLU ? 1280 : EV_IN;
constexpr int NEXP = 32, MOE_H = 512, LIST_CAP = 32768;
constexpr float C2 = 0.125f * 1.4426950408889634f;
constexpr float LOG2E = 1.4426950408889634f;
constexpr float LAM_INIT = 0.35550906759f;

constexpr size_t MiB = 1u << 20;
constexpr size_t WS_CTL = 0, CTL_ZERO_BYTES = 1 * MiB;
constexpr size_t WS_WIN0 = 1 * MiB, WS_WOUT0 = 5 * MiB, WS_WIN1 = 7 * MiB, WS_WOUT1 = 13 * MiB, WS_TBL = 15 * MiB;
constexpr size_t WS_W13 = 16 * MiB, WS_W2 = 80 * MiB;
constexpr size_t WS_HB = 112 * MiB;
constexpr size_t WS_Y = 176 * MiB;
constexpr size_t WS_Z0 = 240 * MiB, WS_QR = 352 * MiB, WS_KR = 384 * MiB, WS_QR8 = 392 * MiB, WS_KR8 = 408 * MiB, WS_K8T0 = 408 * MiB, WS_V8T0 = 412 * MiB;
constexpr size_t WS_K8T1 = 304 * MiB, WS_V8T1 = 336 * MiB;
constexpr size_t WS_Q1 = 240 * MiB, WS_K1 = 304 * MiB, WS_V1 = 368 * MiB, WS_OC1 = 432 * MiB, WS_OC0 = WS_HB;
constexpr size_t WS_H = 176 * MiB, WS_YS = 248 * MiB, WS_LIST = 392 * MiB, WS_TOKEP = 396 * MiB, WS_GATE = 396 * MiB + 512 * 1024;
constexpr size_t WS_XB = 432 * MiB;
constexpr size_t WS_END = 496 * MiB;
constexpr int TBL_COS = 0, TBL_SIN = 2048, TBL_BIAS = 4096, BIAS_STRIDE = 272;
constexpr int TBL_WR = 32768, WR_LAYER = 1024 * 48 + 64;
constexpr int CW_BAR = 4096;
constexpr int CW_CNT = 16384;

constexpr int RING_BYTES = 131072;
constexpr int LDS_BYTES = 147456;
constexpr int LDSCTL_OFF = LDS_BYTES - 1024;
constexpr int STASH_OFF = 78 * 1024;
constexpr int LC_BAR = 8;
constexpr int LC_TP = 16;
constexpr int LC_CNT = 64;
constexpr int LC_LCNT = 96;
constexpr int LC_LBASE = 128;
constexpr int LC_LP = 160;

#define LDS_WAIT() asm volatile("s_waitcnt lgkmcnt(0)" ::: "memory")
#define VM_WAIT() asm volatile("s_waitcnt vmcnt(0)" ::: "memory")
#define RLX_AGENT __ATOMIC_RELAXED, __HIP_MEMORY_SCOPE_AGENT

__device__ __forceinline__ unsigned f2bf(float f) { unsigned u = __builtin_bit_cast(unsigned, f); return (u + 0x7fffu + ((u >> 16) & 1u)) >> 16; }
__device__ __forceinline__ unsigned pk2(float lo, float hi) { return f2bf(lo) | (f2bf(hi) << 16); }
__device__ __forceinline__ float bf2f(unsigned short b) { return __builtin_bit_cast(float, (unsigned)b << 16); }
template <int CTRL> __device__ __forceinline__ float dpp_mov(float v) { return __builtin_bit_cast(float, __builtin_amdgcn_update_dpp(0, __builtin_bit_cast(int, v), CTRL, 0xf, 0xf, true)); }
__device__ __forceinline__ float wave_sum(float v) {
    v += dpp_mov<0xB1>(v); v += dpp_mov<0x4E>(v); v += dpp_mov<0x141>(v); v += dpp_mov<0x140>(v);
    { auto rr = __builtin_amdgcn_permlane16_swap(__float_as_uint(v), __float_as_uint(v), false, false); v = __uint_as_float(rr[0]) + __uint_as_float(rr[1]); }
    { auto rr = __builtin_amdgcn_permlane32_swap(__float_as_uint(v), __float_as_uint(v), false, false); v = __uint_as_float(rr[0]) + __uint_as_float(rr[1]); }
    return v;
}


__device__ __forceinline__ unsigned fp8_byte(float v) { return (unsigned)__builtin_amdgcn_cvt_pk_fp8_f32(v, v, 0, false) & 0xffu; }
__device__ __forceinline__ unsigned quad_pack_bytes(unsigned b) {
    const unsigned x0 = (unsigned)__builtin_amdgcn_update_dpp(0, (int)b, 0x00, 0xf, 0xf, true), x1 = (unsigned)__builtin_amdgcn_update_dpp(0, (int)b, 0x55, 0xf, 0xf, true);
    const unsigned x2 = (unsigned)__builtin_amdgcn_update_dpp(0, (int)b, 0xAA, 0xf, 0xf, true), x3 = (unsigned)__builtin_amdgcn_update_dpp(0, (int)b, 0xFF, 0xf, 0xf, true);
    return x0 | (x1 << 8) | (x2 << 16) | (x3 << 24);
}
namespace pg8 {
#define PG8_LAS __attribute__((address_space(3)))
typedef unsigned short bf16_t;
typedef short bf16x8 __attribute__((ext_vector_type(8)));
typedef float f32x4 __attribute__((ext_vector_type(4)));
typedef unsigned u32x4 __attribute__((ext_vector_type(4)));
constexpr int BM = 256, BK = 64, HALF = 128, HTB = HALF * BK * 2, STAGE_BYTES = 8 * HTB, NXCD = 8, WGM = 8;

__host__ __device__ __forceinline__ int lds_byte(int r, int c) { const int st = (r >> 4) * 2 + (c >> 5), rr = r & 15, cc = c & 31, ob = rr * 64 + cc * 2; return st * 1024 + (ob ^ (((ob >> 9) & 1) << 5)); }
__host__ __device__ __forceinline__ void stage_rc(int b, int& R, int& C) { const int st = b / 1024, sb = b % 1024, swz = sb ^ (((sb >> 9) & 1) << 5); R = (st >> 1) * 16 + swz / 64; C = (st & 1) * 32 + (swz % 64) / 2; }
__host__ __device__ __forceinline__ int perm32(int rho) { const int n = rho >> 4, i = rho & 15; return 8 * (i >> 2) + 4 * n + (i & 3); }

struct Unit { int pm, pn, e, rb; };
struct Gemm { const bf16_t* A; const bf16_t* Bt; int M, N, K; };

struct StaticOrder {
    int nM, nN, nwg, G, c;
    __device__ void init(int M, int N, int G_, int c_) { nM = M / BM; nN = N / BM; nwg = nM * nN; G = G_; c = c_; }
    __device__ bool next(int i, Unit& u) const {
        const long L = (long)i * G + c; if (L >= nwg) return false;
        int wgid = (int)L; { const int q = nwg / NXCD, r = nwg % NXCD, xcd = wgid % NXCD, off = wgid / NXCD; wgid = (xcd < r ? xcd * (q + 1) : r * (q + 1) + (xcd - r) * q) + off; }
        const int nig = WGM * nN, gid = wgid / nig, fm = gid * WGM, gsz = (nM - fm) < WGM ? (nM - fm) : WGM;
        u.pm = fm + ((wgid % nig) % gsz); u.pn = (wgid % nig) / gsz; u.e = 0; u.rb = 0; return true;
    }
    __device__ __forceinline__ unsigned arow(const Unit& u, int rr) const { return (unsigned)(u.pm * BM + rr); }
};

struct MoeOrder {
    const PG8_LAS int* tp; const PG8_LAS int* cn; const PG8_LAS int* lp; const int* list; int G, c, nunits; bool gather; bool xcd;
    __device__ __forceinline__ bool next(int i, Unit& u) const {
        int e_, rb_, pm_, pnl_; bool ok;
        if (xcd) {
            const int x = c & 7, y = c >> 3; const int uidx = i * 32 + y; ok = uidx < lp[4] * 4;
            const int rbl = uidx >> 2; pnl_ = uidx & 3; int j = 0;
#pragma unroll
            for (int q = 1; q < 4; ++q) j += (lp[q] <= rbl) ? 1 : 0;
            e_ = x + 8 * j; rb_ = rbl - lp[j]; pm_ = tp[e_] + rb_;
        } else {
            const int L = i * G + c; ok = L < nunits;
            const int rbg = L >> 2; pnl_ = L & 3; int e = 0;
#pragma unroll
            for (int j = 1; j < 32; ++j) e += (tp[j] <= rbg) ? 1 : 0;
            e_ = e; pm_ = rbg; rb_ = rbg - tp[e];
        }
        u.e = __builtin_amdgcn_readfirstlane(e_); u.rb = __builtin_amdgcn_readfirstlane(rb_); u.pm = __builtin_amdgcn_readfirstlane(pm_); u.pn = __builtin_amdgcn_readfirstlane(e_ * 4 + pnl_);
        return ok;
    }
    __device__ __forceinline__ unsigned arow(const Unit& u, int rr) const {
        if (!gather) return (unsigned)(u.pm * BM + rr);
        const int idx = u.rb * BM + rr; unsigned t = 0u;
        if (idx < cn[u.e]) t = (unsigned)list[(size_t)u.e * 32768 + idx];
        return t;
    }
};

__device__ __forceinline__ unsigned cvt_pk_bf16(float lo, float hi) { unsigned r; asm volatile("v_cvt_pk_bf16_f32 %0, %1, %2" : "=v"(r) : "v"(lo), "v"(hi)); return r; }

struct EpiBf16 {
    static constexpr bool PERM = true; static constexpr bool BROWMAP = false;
    bf16_t* O; int ldc; int split_cols; size_t split_stride; float scale0; int pn_mask; bool f8;
    __device__ __forceinline__ void operator()(const f32x4 (&acc)[2][2][4][2], const Unit& u, int wr, int wc, int fr, int fq) const {
        const int row0 = u.pm * BM + wr * 64 + fr; int colt = (u.pn & pn_mask) * BM; bf16_t* base = O;
        float sc = 1.f; if (split_cols) { const int t = colt / split_cols; base += (size_t)t * split_stride; colt -= t * split_cols; if (t == 0) sc = scale0; }
        if (f8) sc = 8.0f;
        const int col0 = colt + wc * 32 + 8 * fq;
#pragma unroll
        for (int ai = 0; ai < 2; ++ai)
#pragma unroll
            for (int m = 0; m < 4; ++m) { const size_t ro = (size_t)(row0 + ai * HALF + m * 16) * ldc + col0;
                if (f8 && WIDE_F8_STORE) {
                    int d[2][2];
#pragma unroll
                    for (int bj = 0; bj < 2; ++bj) { const f32x4 v0 = acc[ai][bj][m][0] * sc, v1 = acc[ai][bj][m][1] * sc;
                        int d0 = __builtin_amdgcn_cvt_pk_fp8_f32(v0[0], v0[1], 0, false); d0 = __builtin_amdgcn_cvt_pk_fp8_f32(v0[2], v0[3], d0, true);
                        int d1 = __builtin_amdgcn_cvt_pk_fp8_f32(v1[0], v1[1], 0, false); d1 = __builtin_amdgcn_cvt_pk_fp8_f32(v1[2], v1[3], d1, true); d[bj][0] = d0; d[bj][1] = d1; }
                    const auto s0 = __builtin_amdgcn_permlane16_swap((unsigned)d[0][0], (unsigned)d[1][0], false, false), s1 = __builtin_amdgcn_permlane16_swap((unsigned)d[0][1], (unsigned)d[1][1], false, false);
                    const size_t ro2 = (size_t)(row0 + ai * HALF + m * 16) * ldc + colt + wc * 32 + 8 * (fq & ~1) + (fq & 1) * HALF;
                    *(u32x4*)((unsigned char*)base + ro2) = (u32x4){s0[0], s1[0], s0[1], s1[1]};
                } else
#pragma unroll
                for (int bj = 0; bj < 2; ++bj) { f32x4 v0 = acc[ai][bj][m][0] * sc, v1 = acc[ai][bj][m][1] * sc;
                    if (f8) { typedef unsigned u32x2 __attribute__((ext_vector_type(2)));
                        int d0 = __builtin_amdgcn_cvt_pk_fp8_f32(v0[0], v0[1], 0, false); d0 = __builtin_amdgcn_cvt_pk_fp8_f32(v0[2], v0[3], d0, true);
                        int d1 = __builtin_amdgcn_cvt_pk_fp8_f32(v1[0], v1[1], 0, false); d1 = __builtin_amdgcn_cvt_pk_fp8_f32(v1[2], v1[3], d1, true);
                        *(u32x2*)((unsigned char*)base + ro + bj * HALF) = (u32x2){(unsigned)d0, (unsigned)d1};
                    } else {
                    u32x4 w; w.x = cvt_pk_bf16(v0[0], v0[1]); w.y = cvt_pk_bf16(v0[2], v0[3]); w.z = cvt_pk_bf16(v1[0], v1[1]); w.w = cvt_pk_bf16(v1[2], v1[3]);
                    *(u32x4*)(base + ro + bj * HALF) = w; } } }
    }
};
struct EpiIn0 {
    static constexpr bool PERM = true; static constexpr bool BROWMAP = false;
    bf16_t* O; int ldc;
    __device__ __forceinline__ void operator()(const f32x4 (&acc)[2][2][4][2], const Unit& u, int wr, int wc, int fr, int fq) const {
        const int row0 = u.pm * BM + wr * 64 + fr;
        if (u.pn < 3) { const int col0 = u.pn * BM + wc * 32 + 8 * fq;
#pragma unroll
            for (int ai = 0; ai < 2; ++ai)
#pragma unroll
                for (int m = 0; m < 4; ++m) { const size_t ro = (size_t)(row0 + ai * HALF + m * 16) * ldc + col0;
#pragma unroll
                    for (int bj = 0; bj < 2; ++bj) { const f32x4 v0 = acc[ai][bj][m][0], v1 = acc[ai][bj][m][1];
                        u32x4 w; w.x = cvt_pk_bf16(v0[0], v0[1]); w.y = cvt_pk_bf16(v0[2], v0[3]); w.z = cvt_pk_bf16(v1[0], v1[1]); w.w = cvt_pk_bf16(v1[2], v1[3]);
                        *(u32x4*)(O + ro + bj * HALF) = w; } }
        } else { const int col0 = 768 + (u.pn - 3) * 128 + wc * 32 + 8 * fq;
#pragma unroll
            for (int ai = 0; ai < 2; ++ai)
#pragma unroll
                for (int m = 0; m < 4; ++m) { const size_t ro = (size_t)(row0 + ai * HALF + m * 16) * ldc + col0;
                    const f32x4 a0 = acc[ai][0][m][0], a1 = acc[ai][0][m][1], g0 = acc[ai][1][m][0], g1 = acc[ai][1][m][1]; float h[8];
#pragma unroll
                    for (int j = 0; j < 4; ++j) { h[j] = a0[j] * __builtin_amdgcn_rcpf(1.0f + __builtin_amdgcn_exp2f(-g0[j] * 1.4426950408889634f)); h[4 + j] = a1[j] * __builtin_amdgcn_rcpf(1.0f + __builtin_amdgcn_exp2f(-g1[j] * 1.4426950408889634f)); }
                    u32x4 w; w.x = cvt_pk_bf16(h[0], h[1]); w.y = cvt_pk_bf16(h[2], h[3]); w.z = cvt_pk_bf16(h[4], h[5]); w.w = cvt_pk_bf16(h[6], h[7]);
                    *(u32x4*)(O + ro) = w; } }
    }
};
struct EpiRes {
    static constexpr bool PERM = true; static constexpr bool BROWMAP = false;
    const float* base32; const bf16_t* base16; bf16_t* out; int ldc;
    __device__ __forceinline__ void operator()(const f32x4 (&acc)[2][2][4][2], const Unit& u, int wr, int wc, int fr, int fq) const {
        const int row0 = u.pm * BM + wr * 64 + fr, col0 = u.pn * BM + wc * 32 + 8 * fq;
#pragma unroll
        for (int ai = 0; ai < 2; ++ai)
#pragma unroll
            for (int m = 0; m < 4; ++m) { const size_t off = (size_t)(row0 + ai * HALF + m * 16) * ldc + col0;
#pragma unroll
                for (int bj = 0; bj < 2; ++bj) { f32x4 b0, b1;
                    if (base32) { b0 = *(const f32x4*)(base32 + off + bj * HALF); b1 = *(const f32x4*)(base32 + off + bj * HALF + 4); }
                    else { const u32x4 w = *(const u32x4*)(base16 + off + bj * HALF);
                        b0 = (f32x4){__builtin_bit_cast(float, w.x << 16), __builtin_bit_cast(float, w.x & 0xffff0000u), __builtin_bit_cast(float, w.y << 16), __builtin_bit_cast(float, w.y & 0xffff0000u)};
                        b1 = (f32x4){__builtin_bit_cast(float, w.z << 16), __builtin_bit_cast(float, w.z & 0xffff0000u), __builtin_bit_cast(float, w.w << 16), __builtin_bit_cast(float, w.w & 0xffff0000u)}; }
                    const f32x4 v0 = b0 + acc[ai][bj][m][0], v1 = b1 + acc[ai][bj][m][1];
                    u32x4 o; o.x = cvt_pk_bf16(v0[0], v0[1]); o.y = cvt_pk_bf16(v0[2], v0[3]); o.z = cvt_pk_bf16(v1[0], v1[1]); o.w = cvt_pk_bf16(v1[2], v1[3]);
                    *(u32x4*)(out + off + bj * HALF) = o; } }
    }
};
struct EpiQKV8 {
    static constexpr bool PERM = true; static constexpr bool BROWMAP = false;
    unsigned char* Q8; unsigned char* K8; bf16_t* V; float qscale; bool ktiled;
    __device__ __forceinline__ void operator()(const f32x4 (&acc)[2][2][4][2], const Unit& u, int wr, int wc, int fr, int fq) const {
        const int row0 = u.pm * BM + wr * 64 + fr; const int colt = u.pn * BM; const int t = colt >> 10; const int col0 = (colt & 1023) + wc * 32 + 8 * fq;
        const float sc = t == 0 ? qscale : 1.0f;
#pragma unroll
        for (int ai = 0; ai < 2; ++ai)
#pragma unroll
            for (int m = 0; m < 4; ++m) { const size_t ro = (size_t)(row0 + ai * HALF + m * 16) * 1024 + col0;
                if (t != 2 && WIDE_F8_STORE) {
                    int d[2][2];
#pragma unroll
                    for (int bj = 0; bj < 2; ++bj) { const f32x4 v0 = acc[ai][bj][m][0] * sc, v1 = acc[ai][bj][m][1] * sc;
                        int d0 = __builtin_amdgcn_cvt_pk_fp8_f32(v0[0], v0[1], 0, false); d0 = __builtin_amdgcn_cvt_pk_fp8_f32(v0[2], v0[3], d0, true);
                        int d1 = __builtin_amdgcn_cvt_pk_fp8_f32(v1[0], v1[1], 0, false); d1 = __builtin_amdgcn_cvt_pk_fp8_f32(v1[2], v1[3], d1, true); d[bj][0] = d0; d[bj][1] = d1; }
                    const auto s0 = __builtin_amdgcn_permlane16_swap((unsigned)d[0][0], (unsigned)d[1][0], false, false), s1 = __builtin_amdgcn_permlane16_swap((unsigned)d[0][1], (unsigned)d[1][1], false, false);
                    const u32x4 w16 = (u32x4){s0[0], s1[0], s0[1], s1[1]};
                    const int mrow = row0 + ai * HALF + m * 16, n = (colt & 1023) + wc * 32 + 8 * (fq & ~1) + (fq & 1) * HALF;
                    if (t == 1 && ktiled) { const int strm = ((mrow >> 13) * 8 + (n >> 7)) * 2 + ((n >> 6) & 1), sq = mrow & 8191, dd = n & 63;
                        *(u32x4*)(K8 + ((((size_t)strm * 128 + (sq >> 6)) * 4 + (dd >> 4)) * 64 + (sq & 63)) * 16) = w16; }
                    else *(u32x4*)((t == 0 ? Q8 : K8) + (size_t)mrow * 1024 + n) = w16;
                } else
#pragma unroll
                for (int bj = 0; bj < 2; ++bj) { const f32x4 v0 = acc[ai][bj][m][0] * sc, v1 = acc[ai][bj][m][1] * sc;
                    if (t == 2) { u32x4 w; w.x = cvt_pk_bf16(v0[0], v0[1]); w.y = cvt_pk_bf16(v0[2], v0[3]); w.z = cvt_pk_bf16(v1[0], v1[1]); w.w = cvt_pk_bf16(v1[2], v1[3]);
                        if (ktiled) { const int mrow = row0 + ai * HALF + m * 16, n = col0 + bj * HALF; const int bh = (mrow >> 13) * 8 + (n >> 7), sq = mrow & 8191, d = n & 127;
                            *(u32x4*)(V + (((size_t)bh * 128 + (sq >> 6)) * 4 + (d >> 5)) * 2048 + (sq & 63) * 32 + (d & 31)) = w; }
                        else *(u32x4*)(V + ro + bj * HALF) = w; }
                    else { int d0 = __builtin_amdgcn_cvt_pk_fp8_f32(v0[0], v0[1], 0, false); d0 = __builtin_amdgcn_cvt_pk_fp8_f32(v0[2], v0[3], d0, true);
                        int d1 = __builtin_amdgcn_cvt_pk_fp8_f32(v1[0], v1[1], 0, false); d1 = __builtin_amdgcn_cvt_pk_fp8_f32(v1[2], v1[3], d1, true);
                        typedef int i32x2 __attribute__((ext_vector_type(2)));
                        if (t == 1 && ktiled) { const int mrow = row0 + ai * HALF + m * 16, n = col0 + bj * HALF; const int strm = ((mrow >> 13) * 8 + (n >> 7)) * 2 + ((n >> 6) & 1), sq = mrow & 8191, dd = n & 63;
                            *(i32x2*)(K8 + ((((size_t)strm * 128 + (sq >> 6)) * 4 + (dd >> 4)) * 64 + (sq & 63)) * 16 + (dd & 15)) = (i32x2){d0, d1}; }
                        else *(i32x2*)((t == 0 ? Q8 : K8) + ro + bj * HALF) = (i32x2){d0, d1}; } } }
    }
};
struct EpiVT {
    static constexpr bool PERM = true; static constexpr bool BROWMAP = true;
    unsigned char* V8T;
    __device__ __forceinline__ void operator()(const f32x4 (&acc)[2][2][4][2], const Unit& u, int wr, int wc, int fr, int fq) const {
        const int c0 = u.pn * BM + (fq & 1) * HALF + wc * 32 + 8 * (fq & ~1);
        const int T = c0 >> 6, b = T >> 7, tt = T & 127, chunk = (c0 & 63) >> 4;
#pragma unroll
        for (int ai = 0; ai < 2; ++ai)
#pragma unroll
            for (int m = 0; m < 4; ++m) { const int d = u.pm * BM + ai * HALF + wr * 64 + m * 16 + fr; const int h = d >> 7, dd = d & 127;
                int q[2][2];
#pragma unroll
                for (int bj = 0; bj < 2; ++bj) { const f32x4 v0 = acc[ai][bj][m][0], v1 = acc[ai][bj][m][1];
                    int d0 = __builtin_amdgcn_cvt_pk_fp8_f32(v0[0], v0[1], 0, false); d0 = __builtin_amdgcn_cvt_pk_fp8_f32(v0[2], v0[3], d0, true);
                    int d1 = __builtin_amdgcn_cvt_pk_fp8_f32(v1[0], v1[1], 0, false); d1 = __builtin_amdgcn_cvt_pk_fp8_f32(v1[2], v1[3], d1, true); q[bj][0] = d0; q[bj][1] = d1; }
                const auto s0 = __builtin_amdgcn_permlane16_swap((unsigned)q[0][0], (unsigned)q[1][0], false, false), s1 = __builtin_amdgcn_permlane16_swap((unsigned)q[0][1], (unsigned)q[1][1], false, false);
                *(u32x4*)(V8T + (((((size_t)(b * 8 + h) * 128 + tt) * 4 + chunk) * 128 + dd) * 16)) = (u32x4){s0[0], s1[0], s0[1], s1[1]}; }
    }
};
__device__ __forceinline__ float silu_mul(float a, float b) { return a * b * __builtin_amdgcn_rcpf(1.0f + __builtin_amdgcn_exp2f(-a * 1.4426950408889634f)); }
struct EpiSwiglu {
    static constexpr bool PERM = true; static constexpr bool BROWMAP = false;
    bf16_t* O; bool f8;
    __device__ __forceinline__ void operator()(const f32x4 (&acc)[2][2][4][2], const Unit& u, int wr, int wc, int fr, int fq) const {
        const int row0 = u.pm * BM + wr * 64 + fr, col0 = (u.pn & 3) * 128 + wc * 32 + 8 * fq;
#pragma unroll
        for (int ai = 0; ai < 2; ++ai)
#pragma unroll
            for (int m = 0; m < 4; ++m) { const size_t ro = (size_t)(row0 + ai * HALF + m * 16) * 512 + col0;
                const f32x4 a0 = acc[ai][0][m][0], a1 = acc[ai][0][m][1], b0 = acc[ai][1][m][0], b1 = acc[ai][1][m][1];
                if (f8 && WIDE_F8_STORE) {
                    if (m & 1) continue;
                    const f32x4 c0 = acc[ai][0][m + 1][0], c1 = acc[ai][0][m + 1][1], e0 = acc[ai][1][m + 1][0], e1 = acc[ai][1][m + 1][1];
                    int p0 = __builtin_amdgcn_cvt_pk_fp8_f32(4.f * silu_mul(a0[0], b0[0]), 4.f * silu_mul(a0[1], b0[1]), 0, false); p0 = __builtin_amdgcn_cvt_pk_fp8_f32(4.f * silu_mul(a0[2], b0[2]), 4.f * silu_mul(a0[3], b0[3]), p0, true);
                    int p1 = __builtin_amdgcn_cvt_pk_fp8_f32(4.f * silu_mul(a1[0], b1[0]), 4.f * silu_mul(a1[1], b1[1]), 0, false); p1 = __builtin_amdgcn_cvt_pk_fp8_f32(4.f * silu_mul(a1[2], b1[2]), 4.f * silu_mul(a1[3], b1[3]), p1, true);
                    int q0 = __builtin_amdgcn_cvt_pk_fp8_f32(4.f * silu_mul(c0[0], e0[0]), 4.f * silu_mul(c0[1], e0[1]), 0, false); q0 = __builtin_amdgcn_cvt_pk_fp8_f32(4.f * silu_mul(c0[2], e0[2]), 4.f * silu_mul(c0[3], e0[3]), q0, true);
                    int q1 = __builtin_amdgcn_cvt_pk_fp8_f32(4.f * silu_mul(c1[0], e1[0]), 4.f * silu_mul(c1[1], e1[1]), 0, false); q1 = __builtin_amdgcn_cvt_pk_fp8_f32(4.f * silu_mul(c1[2], e1[2]), 4.f * silu_mul(c1[3], e1[3]), q1, true);
                    const auto s0 = __builtin_amdgcn_permlane16_swap((unsigned)p0, (unsigned)q0, false, false), s1 = __builtin_amdgcn_permlane16_swap((unsigned)p1, (unsigned)q1, false, false);
                    const size_t ro2 = (size_t)(row0 + ai * HALF + (m + (fq & 1)) * 16) * 512 + (u.pn & 3) * 128 + wc * 32 + 8 * (fq & ~1);
                    *(u32x4*)((unsigned char*)O + ro2) = (u32x4){s0[0], s1[0], s0[1], s1[1]};
                } else
                if (f8) { typedef unsigned u32x2 __attribute__((ext_vector_type(2)));
                    int d0 = __builtin_amdgcn_cvt_pk_fp8_f32(4.f * silu_mul(a0[0], b0[0]), 4.f * silu_mul(a0[1], b0[1]), 0, false); d0 = __builtin_amdgcn_cvt_pk_fp8_f32(4.f * silu_mul(a0[2], b0[2]), 4.f * silu_mul(a0[3], b0[3]), d0, true);
                    int d1 = __builtin_amdgcn_cvt_pk_fp8_f32(4.f * silu_mul(a1[0], b1[0]), 4.f * silu_mul(a1[1], b1[1]), 0, false); d1 = __builtin_amdgcn_cvt_pk_fp8_f32(4.f * silu_mul(a1[2], b1[2]), 4.f * silu_mul(a1[3], b1[3]), d1, true);
                    *(u32x2*)((unsigned char*)O + ro) = (u32x2){(unsigned)d0, (unsigned)d1};
                } else {
                u32x4 w; w.x = cvt_pk_bf16(silu_mul(a0[0], b0[0]), silu_mul(a0[1], b0[1])); w.y = cvt_pk_bf16(silu_mul(a0[2], b0[2]), silu_mul(a0[3], b0[3]));
                w.z = cvt_pk_bf16(silu_mul(a1[0], b1[0]), silu_mul(a1[1], b1[1])); w.w = cvt_pk_bf16(silu_mul(a1[2], b1[2]), silu_mul(a1[3], b1[3]));
                *(u32x4*)(O + ro) = w; } }
    }
};

template <class Epi, class Sched, bool ALIGN_EPI, bool F8 = false, int SCA = 127, int SCB = 127>
__device__ __forceinline__ void gemm_phase(PG8_LAS unsigned char* lds, const Gemm g, const Sched& S, const Epi& E) {
    const int tid = threadIdx.x, wid = __builtin_amdgcn_readfirstlane(tid >> 6), lane = tid & 63, wr = wid >> 2, wc = wid & 3, fr = lane & 15, fq = lane >> 4;
    const int K = g.K, nt = K / BK;
    int RA[2], CA[2]; unsigned voffB[2];
#pragma unroll
    for (int i = 0; i < 2; ++i) { int R, C; stage_rc(tid * 16 + i * 8192, R, C); RA[i] = R; CA[i] = C; int Rb = Epi::PERM ? ((R & ~31) + perm32(R & 31)) : R; if (Epi::BROWMAP) { const int s_ = Rb & 63; Rb = (Rb & ~63) + 32 * ((s_ >> 4) & 1) + 4 * (s_ >> 5) + (s_ & 3) + 8 * ((s_ >> 2) & 3); }
        voffB[i] = (unsigned)(Rb * K + C) * 2u; }
    const size_t kstep = (size_t)(BK * 2);
    const size_t hstep = (size_t)HALF * K * 2;
    const size_t tstep = 2 * hstep;
    const unsigned ldsw = (unsigned)wid * 1024u;
    const int aoff = lds_byte(wr * 64 + fr, fq * 8), boff = lds_byte(wc * 32 + fr, fq * 8);
#define PG8_SA(b, h) (((b) * 2 + (h)) * HTB)
#define PG8_SB(b, h) ((4 + (b) * 2 + (h)) * HTB)
#define PG8_STAGE(bufoff, gbase, voff) do { _Pragma("unroll") for (int _i = 0; _i < 2; ++_i) \
        __builtin_amdgcn_global_load_lds((const unsigned*)((const char*)(gbase) + (voff)[_i]), (PG8_LAS unsigned*)(lds + (bufoff) + ldsw + _i * 8192), 16, 0, 0); } while (0)
#define PG8_LD8(p_) ({ typedef int v4i_ __attribute__((ext_vector_type(4))); const v4i_ lo_ = *(const PG8_LAS v4i_*)(p_), hi_ = *(const PG8_LAS v4i_*)((p_) + 1024); __builtin_shufflevector(lo_, hi_, 0, 1, 2, 3, 4, 5, 6, 7); })
#define PG8_LDA(dst, b, h) do { if (F8) { _Pragma("unroll") for (int m = 0; m < 4; ++m) dst##8[m] = PG8_LD8(lds + PG8_SA(b, h) + aoff + m * 2048); } \
        else { _Pragma("unroll") for (int m = 0; m < 4; ++m) _Pragma("unroll") for (int k = 0; k < 2; ++k) dst[m][k] = *(const PG8_LAS bf16x8*)(lds + PG8_SA(b, h) + aoff + m * 2048 + k * 1024); } } while (0)
#define PG8_LDB(dst, b, h) do { if (F8) { _Pragma("unroll") for (int n = 0; n < 2; ++n) dst##8[n] = PG8_LD8(lds + PG8_SB(b, h) + boff + n * 2048); } \
        else { _Pragma("unroll") for (int n = 0; n < 2; ++n) _Pragma("unroll") for (int k = 0; k < 2; ++k) dst[n][k] = *(const PG8_LAS bf16x8*)(lds + PG8_SB(b, h) + boff + n * 2048 + k * 1024); } } while (0)
#define PG8_MMA(ai, bj, At, Bt) do { __builtin_amdgcn_s_setprio(1); \
        if (F8) { _Pragma("unroll") for (int m = 0; m < 4; ++m) _Pragma("unroll") for (int n = 0; n < 2; ++n) \
            asm volatile("v_mfma_scale_f32_16x16x128_f8f6f4 %0, %1, %2, %0, %3, %4 op_sel_hi:[0,0,0]" : "+v"(acc[ai][bj][m][n]) : "v"(Bt##8[n]), "v"(At##8[m]), "v"(scb_), "v"(sca_)); } \
        else { _Pragma("unroll") for (int m = 0; m < 4; ++m) _Pragma("unroll") for (int n = 0; n < 2; ++n) _Pragma("unroll") for (int k = 0; k < 2; ++k) \
        acc[ai][bj][m][n] = __builtin_amdgcn_mfma_f32_16x16x32_bf16(Bt[n][k], At[m][k], acc[ai][bj][m][n], 0, 0, 0); } __builtin_amdgcn_s_setprio(0); } while (0)
#define PG8_WAIT_V(n) asm volatile("s_waitcnt vmcnt(" #n ")" ::: "memory")
#define PG8_WAIT_L(n) asm volatile("s_waitcnt lgkmcnt(" #n ")" ::: "memory")
#define PG8_BAR __builtin_amdgcn_s_barrier()
#define PG8_SCHED __builtin_amdgcn_sched_barrier(0)
#define PG8_AOFF(dst, u) do { _Pragma("unroll") for (int _h = 0; _h < 2; ++_h) _Pragma("unroll") for (int _i = 0; _i < 2; ++_i) dst[_h][_i] = (S.arow(u, _h * HALF + RA[_i]) * (unsigned)K + (unsigned)CA[_i]) * 2u; } while (0)
    Unit cur, nxt; int ui = 0;
    if (!S.next(0, cur)) return;
    f32x4 acc[2][2][4][2];
#pragma unroll
    for (int a = 0; a < 2; ++a)
#pragma unroll
        for (int b = 0; b < 2; ++b)
#pragma unroll
            for (int m = 0; m < 4; ++m)
#pragma unroll
                for (int n = 0; n < 2; ++n) acc[a][b][m][n] = (f32x4){0.f, 0.f, 0.f, 0.f};
    bf16x8 At[4][2], B0[2][2], B1[2][2]; v8i At8[4], B08[2], B18[2]; const int sca_ = SCA * 0x01010101, scb_ = SCB * 0x01010101;
    unsigned offc[2][2], offn[2][2];
    PG8_AOFF(offc, cur);
    const char* const cA = (const char*)g.A; const char* cB = (const char*)g.Bt + (size_t)cur.pn * tstep;
    PG8_STAGE(PG8_SB(0, 0), cB, voffB); PG8_STAGE(PG8_SB(0, 1), cB + hstep, voffB); PG8_STAGE(PG8_SA(0, 0), cA, offc[0]); PG8_STAGE(PG8_SA(0, 1), cA, offc[1]);
    if (wr == 1) PG8_BAR;
    PG8_WAIT_V(2); PG8_BAR;
    PG8_STAGE(PG8_SB(1, 0), cB + kstep, voffB); PG8_STAGE(PG8_SA(1, 0), cA + kstep, offc[0]); PG8_STAGE(PG8_SB(1, 1), cB + hstep + kstep, voffB);
    PG8_WAIT_V(6); PG8_BAR;
    for (;;) {
        const bool has_next = S.next(ui + 1, nxt);
        if (has_next) { PG8_AOFF(offn, nxt); }
        else {
#pragma unroll
            for (int h = 0; h < 2; ++h)
#pragma unroll
                for (int i = 0; i < 2; ++i) offn[h][i] = offc[h][i]; }
        const char* nB = has_next ? (const char*)g.Bt + (size_t)nxt.pn * tstep : cB;
        for (int t = 0; t < nt; t += 2) {
            const bool last = (t == nt - 2);
            const char* a1 = cA + (size_t)(t + 1) * kstep;
            const char* a2 = last ? cA : cA + (size_t)(t + 2) * kstep; const char* b2 = last ? nB : cB + (size_t)(t + 2) * kstep;
            const char* a3 = a2 + kstep; const char* b3 = b2 + kstep;
            unsigned o2[2][2];
#pragma unroll
            for (int h = 0; h < 2; ++h)
#pragma unroll
                for (int i = 0; i < 2; ++i) o2[h][i] = last ? offn[h][i] : offc[h][i];
            PG8_LDB(B0, 0, 0); PG8_LDB(B1, 0, 1); PG8_SCHED; PG8_LDA(At, 0, 0); PG8_STAGE(PG8_SA(1, 1), a1, offc[1]);
            PG8_WAIT_V(8); PG8_WAIT_L(0); PG8_BAR; PG8_MMA(0, 0, At, B0); PG8_MMA(0, 1, At, B1); PG8_BAR; PG8_SCHED;
            PG8_LDA(At, 0, 1); PG8_STAGE(PG8_SB(0, 0), b2, voffB); PG8_STAGE(PG8_SB(0, 1), b2 + hstep, voffB); PG8_STAGE(PG8_SA(0, 0), a2, o2[0]);
            PG8_WAIT_V(8); PG8_WAIT_L(0); PG8_BAR; PG8_MMA(1, 0, At, B0); PG8_MMA(1, 1, At, B1); PG8_BAR; PG8_SCHED;
            PG8_LDB(B0, 1, 0); PG8_LDB(B1, 1, 1); PG8_SCHED; PG8_LDA(At, 1, 0); PG8_STAGE(PG8_SA(0, 1), a2, o2[1]);
            PG8_WAIT_V(8); PG8_WAIT_L(0); PG8_BAR; PG8_MMA(0, 0, At, B0); PG8_MMA(0, 1, At, B1); PG8_BAR; PG8_SCHED;
            PG8_LDA(At, 1, 1); PG8_STAGE(PG8_SB(1, 0), b3, voffB); PG8_STAGE(PG8_SB(1, 1), b3 + hstep, voffB); PG8_STAGE(PG8_SA(1, 0), a3, o2[0]);
            PG8_WAIT_V(8); PG8_WAIT_L(0); PG8_BAR; PG8_MMA(1, 0, At, B0); PG8_MMA(1, 1, At, B1); PG8_BAR; PG8_SCHED;
        }
        if constexpr (ALIGN_EPI) { if (wr == 0) PG8_BAR; }
        if (F8) asm volatile("s_nop 15\n\ts_nop 15" ::: "memory");
        E(acc, cur, wr, wc, fr, fq);
        if (!has_next) break;
#pragma unroll
        for (int a = 0; a < 2; ++a)
#pragma unroll
            for (int b = 0; b < 2; ++b)
#pragma unroll
                for (int m = 0; m < 4; ++m)
#pragma unroll
                    for (int n = 0; n < 2; ++n) acc[a][b][m][n] = (f32x4){0.f, 0.f, 0.f, 0.f};
        cur = nxt; cB = nB; ++ui;
#pragma unroll
        for (int h = 0; h < 2; ++h)
#pragma unroll
            for (int i = 0; i < 2; ++i) offc[h][i] = offn[h][i];
        if constexpr (ALIGN_EPI) { if (wr == 1) PG8_BAR; }
    }
    PG8_WAIT_V(0);
    if constexpr (!ALIGN_EPI) { if (wr == 0) PG8_BAR; }
    PG8_BAR;
#undef PG8_SA
#undef PG8_SB
#undef PG8_STAGE
#undef PG8_LDA
#undef PG8_LDB
#undef PG8_MMA
#undef PG8_LD8
#undef PG8_WAIT_V
#undef PG8_WAIT_L
#undef PG8_BAR
#undef PG8_SCHED
#undef PG8_AOFF
}
}

#define XB_TMO      128
#define XB_XCNT(j)  (256  + 64 * (j))
#define XB_XSUB(j)  (1280 + 64 * (j))
#define XB_XGEN(j)  (2304 + 64 * (j))
#define XB_TOP      3328
#define XB_TOPGEN   3392
#define XCD_BAR_WORDS 3456
#define XB_SPIN_CAP (1u << 18)

__device__ __forceinline__ unsigned xb_ld(unsigned* p)              { return __hip_atomic_load(p, __ATOMIC_RELAXED, __HIP_MEMORY_SCOPE_AGENT); }
__device__ __forceinline__ unsigned xb_add(unsigned* p, unsigned v) { return __hip_atomic_fetch_add(p, v, __ATOMIC_RELAXED, __HIP_MEMORY_SCOPE_AGENT); }
__device__ __forceinline__ unsigned xb_xcc_id() { return (unsigned)__builtin_amdgcn_s_getreg((3 << 11) | 20) & 0xFu; }
#define XB_SPIN(cond, bar) do { unsigned _sp = 0; while (cond) { __builtin_amdgcn_s_sleep(1); \
    if ((++_sp & 255u) == 0u) { if (xb_ld(&(bar)[XB_TMO])) break; if (_sp > XB_SPIN_CAP) { atomicAdd(&(bar)[XB_TMO], 1u); break; } } } } while (0)

struct XcdBarrier { unsigned* bar; unsigned x; volatile LAS unsigned* st; };

__device__ __forceinline__ XcdBarrier xcd_barrier_post(unsigned* bar, volatile LAS unsigned* st) {
    XcdBarrier b; b.bar = bar; b.x = xb_xcc_id(); b.st = st;
    if (threadIdx.x == 0) (void)xb_add(&bar[XB_XCNT(b.x)], 1u);
    return b;
}
__device__ __forceinline__ void xcd_barrier_complete(unsigned* bar, unsigned x, unsigned& nloc, unsigned& nx) {
    const unsigned G = gridDim.x * gridDim.y * gridDim.z;
    unsigned sum, cnt, mine, sp = 0u;
    for (;;) {
        sum = 0u; cnt = 0u; mine = 0u;
#pragma unroll
        for (unsigned j = 0; j < 16; ++j) { const unsigned c = xb_ld(&bar[XB_XCNT(j)]); sum += c; cnt += (c > 0u) ? 1u : 0u; mine = (j == x) ? c : mine; }
        if (sum == G) break;
        __builtin_amdgcn_s_sleep(1);
        if ((++sp & 255u) == 0u) { if (xb_ld(&bar[XB_TMO])) break; if (sp > XB_SPIN_CAP) { atomicAdd(&bar[XB_TMO], 1u); break; } }
    }
    nloc = mine > 0u ? mine : 1u; nx = cnt > 0u ? cnt : 1u;
}
__device__ __forceinline__ void xcd_barrier(const XcdBarrier& b) {
    asm volatile("s_waitcnt vmcnt(0)" ::: "memory");
    __syncthreads();
    if (threadIdx.x == 0) {
        unsigned* bar = b.bar;
        __builtin_amdgcn_s_waitcnt(0);
        unsigned nloc = b.st[0], nx = b.st[1];
        if (nloc == 0u) { xcd_barrier_complete(bar, b.x, nloc, nx); b.st[0] = nloc; b.st[1] = nx; }
        const unsigned old = xb_add(&bar[XB_XSUB(b.x)], 1u);
        const unsigned gen = old / nloc;
        if (old + 1u == (gen + 1u) * nloc) {
            __builtin_amdgcn_fence(__ATOMIC_RELEASE, "agent");
            asm volatile("s_waitcnt vmcnt(0)" ::: "memory");
            const unsigned og = xb_add(&bar[XB_TOP], 1u);
            const unsigned tg = og / nx;
            if (og + 1u == (tg + 1u) * nx) xb_add(&bar[XB_TOPGEN], 1u);
            else XB_SPIN(xb_ld(&bar[XB_TOPGEN]) == tg, bar);
            __builtin_amdgcn_fence(__ATOMIC_ACQUIRE, "agent");
            xb_add(&bar[XB_XGEN(b.x)], 1u);
            asm volatile("s_waitcnt vmcnt(0)" ::: "memory");
        } else {
            XB_SPIN(xb_ld(&bar[XB_XGEN(b.x)]) == gen, bar);
            __builtin_amdgcn_fence(__ATOMIC_ACQUIRE, "agent");
            asm volatile("s_waitcnt vmcnt(0)" ::: "memory");
        }
    }
    __syncthreads();
}

template <class F>
__device__ __forceinline__ void xcd_barrier_w(const XcdBarrier& b, F&& work) {
    asm volatile("s_waitcnt vmcnt(0)" ::: "memory");
    __syncthreads();
    if (threadIdx.x == 0) {
        unsigned* bar = b.bar;
        __builtin_amdgcn_s_waitcnt(0);
        unsigned nloc = b.st[0], nx = b.st[1];
        if (nloc == 0u) { xcd_barrier_complete(bar, b.x, nloc, nx); b.st[0] = nloc; b.st[1] = nx; }
        const unsigned old = xb_add(&bar[XB_XSUB(b.x)], 1u);
        const unsigned gen = old / nloc;
        const bool leader = (old + 1u == (gen + 1u) * nloc);
        b.st[2] = leader ? 1u : 0u; b.st[3] = gen;
        if (leader) {
            __builtin_amdgcn_fence(__ATOMIC_RELEASE, "agent");
            asm volatile("s_waitcnt vmcnt(0)" ::: "memory");
            const unsigned og = xb_add(&bar[XB_TOP], 1u);
            const unsigned tg = og / nx;
            if (og + 1u == (tg + 1u) * nx) xb_add(&bar[XB_TOPGEN], 1u);
            else XB_SPIN(xb_ld(&bar[XB_TOPGEN]) == tg, bar);
            __builtin_amdgcn_fence(__ATOMIC_ACQUIRE, "agent");
            xb_add(&bar[XB_XGEN(b.x)], 1u);
            asm volatile("s_waitcnt vmcnt(0)" ::: "memory");
        }
    }
    __syncthreads();
    if (b.st[2] == 0u) {
        work();
        if (threadIdx.x == 0) { unsigned* bar = b.bar; const unsigned gen = b.st[3];
            XB_SPIN(xb_ld(&bar[XB_XGEN(b.x)]) == gen, bar);
            __builtin_amdgcn_fence(__ATOMIC_ACQUIRE, "agent");
            asm volatile("s_waitcnt vmcnt(0)" ::: "memory"); }
    }
    __syncthreads();
}

template <bool F8 = false>
__device__ __forceinline__ void transpose_item(const float* W, int K, int N, bf16* WT, int kb, int nb, int dst_row0, LAS float* scr, int lane) {
    const int k0 = 64 * kb, n0 = 32 * nb;
#pragma unroll 8
    for (int i = 0; i < 32; ++i) { const int kk = 2 * i + (lane >> 5); scr[kk * 33 + (lane & 31)] = W[(size_t)(k0 + kk) * N + n0 + (lane & 31)]; }
    LDS_WAIT(); asm volatile("" ::: "memory");
    const int c = lane & 7;
#pragma unroll
    for (int j = 0; j < 4; ++j) { const int n = (lane >> 3) + 8 * j; const LAS float* s = scr + (8 * c) * 33 + n;
        if (F8) {
            int d0 = __builtin_amdgcn_cvt_pk_fp8_f32(s[0 * 33] * 32.f, s[1 * 33] * 32.f, 0, false); d0 = __builtin_amdgcn_cvt_pk_fp8_f32(s[2 * 33] * 32.f, s[3 * 33] * 32.f, d0, true);
            int d1 = __builtin_amdgcn_cvt_pk_fp8_f32(s[4 * 33] * 32.f, s[5 * 33] * 32.f, 0, false); d1 = __builtin_amdgcn_cvt_pk_fp8_f32(s[6 * 33] * 32.f, s[7 * 33] * 32.f, d1, true);
            *(GAS v2u*)((unsigned char*)WT + (size_t)(dst_row0 + n) * K + k0 + 8 * c) = (v2u){(unsigned)d0, (unsigned)d1};
        } else {
        v4u o; o.x = pk2(s[0 * 33], s[1 * 33]); o.y = pk2(s[2 * 33], s[3 * 33]); o.z = pk2(s[4 * 33], s[5 * 33]); o.w = pk2(s[6 * 33], s[7 * 33]);
        *(GAS v4u*)(WT + (size_t)(dst_row0 + n) * K + k0 + 8 * c) = o; } }
    LDS_WAIT(); asm volatile("" ::: "memory");
}
template <bool F8 = false>
__device__ __forceinline__ void transpose_plain(const float* W, int K, int N, bf16* WT, LAS float* scr, int gw, int ngw, int lane) {
    const int nblk = N / 32, nitems = (K / 64) * nblk;
    for (int it = gw; it < nitems; it += ngw) { const int kb = it / nblk, nb = it % nblk; transpose_item<F8>(W, K, N, WT, kb, nb, 32 * nb, scr, lane); }
}
__device__ __forceinline__ void transpose_moe(const float* w1, const float* w3, const float* w2, bf16* W13T, bf16* W2T, LAS float* scr, int gw, int ngw, int lane, int k0 = 0, int k1 = 1 << 20) {
    constexpr int I13 = 16 * 16, I2 = 8 * 32, IPE = 2 * I13 + I2;
    for (int k = k0; k < k1; ++k) { const int it = gw + k * ngw; if (it >= NEXP * IPE) break;
        int e, r;
        if (MOE_ITEMS_W13_FIRST) { if (it < NEXP * 2 * I13) { e = it / (2 * I13); r = it % (2 * I13); } else { const int j = it - NEXP * 2 * I13; e = j / I2; r = 2 * I13 + j % I2; } }
        else { e = it / IPE; r = it % IPE; }
        if (r < 2 * I13) { const int which = r / I13; r %= I13; const int kb = r / 16, nb = r % 16, n0 = 32 * nb;
            const float* W = (which ? w3 : w1) + (size_t)e * 1024 * 512;
            transpose_item<MOE_FP8 != 0>(W, 1024, 512, (bf16*)((unsigned char*)W13T + (size_t)e * 1024 * 1024 * (MOE_FP8 ? 1 : 2)), kb, nb, (n0 >> 7) * 256 + which * 128 + (n0 & 127), scr, lane);
        } else { r -= 2 * I13; const int kb = r / 32, nb = r % 32;
            transpose_item<MOE_FP8 != 0>(w2 + (size_t)e * 512 * 1024, 512, 1024, (bf16*)((unsigned char*)W2T + (size_t)e * 1024 * 512 * (MOE_FP8 ? 1 : 2)), kb, nb, 32 * nb, scr, lane); }
    }
}
__device__ __forceinline__ void rms_row(const float* xrow, const float* g, f32x4 (&v)[4], int lane) {
    const GAS f32x4* xr = (const GAS f32x4*)xrow + lane; const GAS f32x4* gr = (const GAS f32x4*)g + lane;
    float s = 0.f;
#pragma unroll
    for (int j = 0; j < 4; ++j) { v[j] = xr[64 * j]; s += (v[j].x * v[j].x + v[j].y * v[j].y) + (v[j].z * v[j].z + v[j].w * v[j].w); }
    const float rstd = 1.0f / sqrtf(wave_sum(s) * (1.f / DM) + 1e-6f);
#pragma unroll
    for (int j = 0; j < 4; ++j) { const f32x4 gg = gr[64 * j]; v[j] = v[j] * rstd * gg; }
}
__device__ __forceinline__ void rms_row_b16(const bf16* xrow, const float* g, f32x4 (&v)[4], int lane) {
    const GAS v2u* xr = (const GAS v2u*)xrow + lane; const GAS f32x4* gr = (const GAS f32x4*)g + lane;
    float s = 0.f;
#pragma unroll
    for (int j = 0; j < 4; ++j) { const v2u w = xr[64 * j]; v[j] = (f32x4){__builtin_bit_cast(float, w.x << 16), __builtin_bit_cast(float, w.x & 0xffff0000u), __builtin_bit_cast(float, w.y << 16), __builtin_bit_cast(float, w.y & 0xffff0000u)};
        s += (v[j].x * v[j].x + v[j].y * v[j].y) + (v[j].z * v[j].z + v[j].w * v[j].w); }
    const float rstd = 1.0f / sqrtf(wave_sum(s) * (1.f / DM) + 1e-6f);
#pragma unroll
    for (int j = 0; j < 4; ++j) { const f32x4 gg = gr[64 * j]; v[j] = v[j] * rstd * gg; }
}
__device__ __forceinline__ void store_row_bf16(bf16* orow, const f32x4 (&v)[4], int lane) {
    GAS unsigned long long* o8 = (GAS unsigned long long*)orow + lane;
#pragma unroll
    for (int j = 0; j < 4; ++j) o8[64 * j] = (unsigned long long)pk2(v[j].x, v[j].y) | ((unsigned long long)pk2(v[j].z, v[j].w) << 32);
}

__device__ __forceinline__ int t5_bucket(int rel) {
    const int n = rel < 0 ? -rel : rel; int ret = rel > 0 ? 16 : 0;
    int v;
    if (n < 8) v = n;
    else { const float nf = (float)n; int large = 8 + (int)(logf(nf / 8.0f) / 2.772588722239781f * 8.0f); v = large < 15 ? large : 15; }
    return ret + v;
}

__device__ __forceinline__ int crow(int r, int hi) { return (r & 3) + 8 * (r >> 2) + 4 * hi; }
__device__ __forceinline__ unsigned cvtpk(float lo, float hi) { unsigned r; asm volatile("v_cvt_pk_bf16_f32 %0, %1, %2" : "=v"(r) : "v"(lo), "v"(hi)); return r; }
__device__ __forceinline__ s16x4 vtr(const LAS char* p) { typedef short v4i16_t __attribute__((ext_vector_type(4))); return __builtin_bit_cast(s16x4, __builtin_amdgcn_ds_read_tr16_b64_v4i16((LAS v4i16_t*)p)); }

template <int DV, bool BIAS, bool FP8 = false>
__device__ __forceinline__ void attn_unit_v0(const bf16* Qp, int ldq, const bf16* Kp, int ldk, const bf16* Vp, int ldv, bf16* Op, int ldo, const LAS float* btbl, int q0, LAS unsigned char* lds) {
    const int tid = threadIdx.x, lane = tid & 63, r32 = lane & 31, hi = lane >> 5; const int wid = __builtin_amdgcn_readfirstlane(tid >> 6);
    constexpr int ND = DV / 32;
    LAS unsigned char* ldsK = lds; LAS unsigned char* ldsV = lds + 8192; LAS float* wsf = (LAS float*)(lds + 8192 + DV * 128) + wid * 64;
    bf16x8 qr[4]; v8i q8 = {0, 0, 0, 0, 0, 0, 0, 0};
    if (FP8) { const v4u a = *(const v4u*)((const unsigned char*)Qp + (size_t)(wid * 32 + r32) * ldq + hi * 32), b = *(const v4u*)((const unsigned char*)Qp + (size_t)(wid * 32 + r32) * ldq + hi * 32 + 16);
        q8 = (v8i){(int)a.x, (int)a.y, (int)a.z, (int)a.w, (int)b.x, (int)b.y, (int)b.z, (int)b.w}; }
    else {
#pragma unroll
    for (int d0 = 0; d0 < 4; ++d0) qr[d0] = *(const bf16x8*)(Qp + (size_t)(wid * 32 + r32) * ldq + d0 * 16 + hi * 8); }
    f32x16 o[ND];
#pragma unroll
    for (int d = 0; d < ND; ++d)
#pragma unroll
        for (int r = 0; r < 16; ++r) o[d][r] = 0.f;
    float l = 0.f;
    const int qpos = q0 + wid * 32 + r32;
    const LAS char* kp0 = (const LAS char*)ldsK + hi * 1024 + r32 * 16;
    const LAS char* vp0 = (const LAS char*)ldsV + ((lane >> 4) & 1) * 32 + (lane & 3) * 8 + (4 * hi + ((lane & 15) >> 2)) * 64;
    for (int t = 0; t < SEQ / 64; ++t) {
        __syncthreads();
        {
            if (FP8) { if (wid < 4) { const v4u kv = *(const v4u*)((const unsigned char*)Kp + (size_t)(t * 64 + lane) * ldk + wid * 16); *(LAS v4u*)(ldsK + wid * 1024 + lane * 16) = kv; } }
            else { const v4u kv = *(const v4u*)(Kp + (size_t)(t * 64 + lane) * ldk + wid * 8);
            *(LAS v4u*)(ldsK + wid * 1024 + lane * 16) = kv; }
#pragma unroll
            for (int pp = 0; pp < ND / 2; ++pp) { const int p = wid + 8 * pp, dq = p >> 2, rg = p & 3;
                const v4u vv = *(const v4u*)(Vp + (size_t)(t * 64 + 16 * rg + (lane >> 2)) * ldv + dq * 32 + (lane & 3) * 8);
                *(LAS v4u*)(ldsV + p * 1024 + lane * 16) = vv; }
        }
        __syncthreads();
        f32x16 p0, p1;
#pragma unroll
        for (int r = 0; r < 16; ++r) { p0[r] = 0.f; p1[r] = 0.f; }
        if (FP8) {
            const LAS char* k8 = (const LAS char*)ldsK + hi * 2048 + r32 * 16;
            const v4u a0 = *(const LAS v4u*)(k8), a1 = *(const LAS v4u*)(k8 + 1024), b0 = *(const LAS v4u*)(k8 + 512), b1 = *(const LAS v4u*)(k8 + 1024 + 512);
            const v8i ka = (v8i){(int)a0.x, (int)a0.y, (int)a0.z, (int)a0.w, (int)a1.x, (int)a1.y, (int)a1.z, (int)a1.w};
            const v8i kb = (v8i){(int)b0.x, (int)b0.y, (int)b0.z, (int)b0.w, (int)b1.x, (int)b1.y, (int)b1.z, (int)b1.w};
            p0 = __builtin_amdgcn_mfma_scale_f32_32x32x64_f8f6f4(ka, q8, p0, 0, 0, 0, 0x7f7f7f7f, 0, 0x7c7c7c7c);
            p1 = __builtin_amdgcn_mfma_scale_f32_32x32x64_f8f6f4(kb, q8, p1, 0, 0, 0, 0x7f7f7f7f, 0, 0x7c7c7c7c);
        } else {
#pragma unroll
        for (int d0 = 0; d0 < 4; ++d0) {
            const bf16x8 b0 = *(const LAS bf16x8*)(kp0 + d0 * 2048), b1 = *(const LAS bf16x8*)(kp0 + d0 * 2048 + 512);
            p0 = __builtin_amdgcn_mfma_f32_32x32x16_bf16(b0, qr[d0], p0, 0, 0, 0);
            p1 = __builtin_amdgcn_mfma_f32_32x32x16_bf16(b1, qr[d0], p1, 0, 0, 0);
        } }
        if (BIAS) {
            const int base = t * 64 + 4 * hi - qpos;
#pragma unroll
            for (int r = 0; r < 16; ++r) { int rel = base + (r & 3) + 8 * (r >> 2);
                int i0 = rel < -128 ? -128 : (rel > 128 ? 128 : rel); int rel1 = rel + 32; int i1 = rel1 < -128 ? -128 : (rel1 > 128 ? 128 : rel1);
                p0[r] += btbl[i0 + 128]; p1[r] += btbl[i1 + 128]; }
        }
        float sacc = 0.f;
#pragma unroll
        for (int r = 0; r < 16; ++r) { p0[r] = __builtin_amdgcn_exp2f(p0[r]); p1[r] = __builtin_amdgcn_exp2f(p1[r]); sacc += p0[r] + p1[r]; }
        l += sacc;
        v4u pw[4];
#pragma unroll
        for (int k = 0; k < 2; ++k) {
            pw[k]     = (v4u){cvtpk(p0[8 * k + 0], p0[8 * k + 1]), cvtpk(p0[8 * k + 2], p0[8 * k + 3]), cvtpk(p0[8 * k + 4], p0[8 * k + 5]), cvtpk(p0[8 * k + 6], p0[8 * k + 7])};
            pw[2 + k] = (v4u){cvtpk(p1[8 * k + 0], p1[8 * k + 1]), cvtpk(p1[8 * k + 2], p1[8 * k + 3]), cvtpk(p1[8 * k + 4], p1[8 * k + 5]), cvtpk(p1[8 * k + 6], p1[8 * k + 7])};
        }
#pragma unroll
        for (int d0 = 0; d0 < ND; ++d0)
#pragma unroll
            for (int ks = 0; ks < 4; ++ks) {
                const s16x4 lo = vtr(vp0 + d0 * 4096 + ks * 1024), hh = vtr(vp0 + d0 * 4096 + ks * 1024 + 512);
                const bf16x8 vf = (bf16x8){lo[0], lo[1], lo[2], lo[3], hh[0], hh[1], hh[2], hh[3]};
                o[d0] = __builtin_amdgcn_mfma_f32_32x32x16_bf16(__builtin_bit_cast(bf16x8, pw[ks]), vf, o[d0], 0, 0, 0);
            }
    }
    l += __shfl_xor(l, 32);
    if (hi == 0) wsf[r32] = l;
    LDS_WAIT(); asm volatile("" ::: "memory");
#pragma unroll
    for (int r = 0; r < 16; ++r) { const int row = crow(r, hi); const float rl = 1.0f / wsf[row];
#pragma unroll
        for (int d0 = 0; d0 < ND; ++d0) Op[(size_t)(wid * 32 + row) * ldo + d0 * 32 + r32] = (bf16)f2bf(o[d0][r] * rl); }
    LDS_WAIT();
}

namespace at1 {
#define SBAR() __builtin_amdgcn_sched_barrier(0)
#define PIN(x) asm volatile("" : "+v"(x))
template <int N, bool NOBAR = false> __device__ __forceinline__ void wait_bar() { if (NOBAR) asm volatile("s_waitcnt vmcnt(%0) lgkmcnt(0)" :: "n"(N) : "memory"); else asm volatile("s_waitcnt vmcnt(%0) lgkmcnt(0)\n\ts_barrier" :: "n"(N) : "memory"); }
__device__ __forceinline__ void glds16(const void* gsrc, unsigned lds_dst) { unsigned keep;
    asm volatile("s_mov_b32 %0, m0\n\ts_mov_b32 m0, %2\n\ts_nop 0\n\tglobal_load_lds_dwordx4 %1, off\n\ts_mov_b32 m0, %0" : "=&s"(keep) : "v"(gsrc), "s"(lds_dst) : "memory"); }
typedef float f32x2_t __attribute__((ext_vector_type(2))); typedef __bf16 bf16x2_t __attribute__((ext_vector_type(2)));
__device__ __forceinline__ unsigned cvtpk_s(float lo, float hi) { f32x2_t v = {lo, hi}; bf16x2_t b = __builtin_convertvector(v, bf16x2_t); return __builtin_bit_cast(unsigned, b); }
typedef const LAS char* lds_cptr;
__device__ __forceinline__ void kload2(bf16x8* kf, lds_cptr kp, int j) { kf[2 * j] = *(const LAS bf16x8*)(kp + j * 2048); kf[2 * j + 1] = *(const LAS bf16x8*)(kp + j * 2048 + 512); }

template <int DV, bool FP8> __host__ __device__ constexpr int lds_ws_off() { return (3 * (FP8 ? 4096 : 8192) + 3 * DV * 128) > 512 * DV ? (3 * (FP8 ? 4096 : 8192) + 3 * DV * 128) : 512 * DV; }
template <int DV, bool FP8> __host__ __device__ constexpr int lds_tbl_off() { return lds_ws_off<DV, FP8>() + 2048; }
template <int DV, bool BIAS, int TEST = 0, int MODE = 0, bool FP8 = false, bool TILED = false>
__device__ __forceinline__ void attn_unit(const bf16* Qp, int ldq, const bf16* __restrict__ Kp, int ldk, const bf16* __restrict__ Vp, int ldv, bf16* Op, int ldo, int q0, LAS unsigned char* lds, const LAS float* sgt = nullptr) {
    constexpr int ND = DV / 32, NV = ND / 2, VSLOT = DV * 128, KSLOT = FP8 ? 4096 : 8192, NT = SEQ / 64;
    constexpr int LDS_K = 0, LDS_V = 3 * KSLOT, LDS_WS = lds_ws_off<DV, FP8>(), LDS_TBL = LDS_WS + 2048;
    static_assert(LDS_WS >= LDS_V + 3 * VSLOT && LDS_WS >= 512 * DV && LDS_TBL + 2048 <= STASH_OFF, "LDS map");
    const int tid = threadIdx.x, lane = tid & 63, r32 = lane & 31, hi = lane >> 5; const int wid = __builtin_amdgcn_readfirstlane(tid >> 6);
    const unsigned lds0 = (unsigned)(uintptr_t)lds;
    LAS float* wsf = (LAS float*)(lds + LDS_WS) + wid * 64;
    const LAS float* btbl = (const LAS float*)(lds + LDS_TBL);
    const unsigned char* ksrc = TILED ? (const unsigned char*)Kp + (wid & 3) * 1024 + lane * 16 : FP8 ? (const unsigned char*)Kp + (size_t)lane * ldk + (wid & 3) * 16 : (const unsigned char*)(Kp + (size_t)lane * ldk + wid * 8);
    const bf16* vsrc0 = TILED ? Vp + wid * 512 + lane * 8 : Vp + (size_t)(16 * (wid & 3) + (lane >> 2)) * ldv + (wid >> 2) * 32 + (lane & 3) * 8;
    const bf16* vsrc1 = TILED ? vsrc0 + 4096 : vsrc0 + 64;
    const unsigned kdst = lds0 + LDS_K + wid * 1024, vdst = lds0 + LDS_V + wid * 1024;
#define DMA_K(t, s) if (!(TEST & 8) && (!FP8 || wid < 4)) glds16(ksrc + (size_t)(t) * (TILED ? 4096 : 64 * ldk * (FP8 ? 1 : 2)), (unsigned)__builtin_amdgcn_readfirstlane(kdst + (s) * KSLOT))
#define DMA_V(t, s) do { if (TEST & 8) break; glds16(vsrc0 + (size_t)(t) * (TILED ? (size_t)(DV * 64) : (size_t)64 * ldv), (unsigned)__builtin_amdgcn_readfirstlane(vdst + (s) * VSLOT)); \
        if (NV == 2) glds16(vsrc1 + (size_t)(t) * (TILED ? (size_t)(DV * 64) : (size_t)64 * ldv), (unsigned)__builtin_amdgcn_readfirstlane(vdst + (s) * VSLOT + 8192)); } while (0)
    const lds_cptr kp0 = (lds_cptr)lds + LDS_K + hi * (FP8 ? 2048 : 1024) + r32 * 16;
    const lds_cptr vp0 = (lds_cptr)lds + LDS_V + ((lane >> 4) & 1) * 32 + (lane & 3) * 8 + (4 * hi + ((lane & 15) >> 2)) * 64;
    DMA_K(0, 0); DMA_V(0, 0); DMA_K(1, 1);
    bf16x8 qr[4]; v8i q8 = {0, 0, 0, 0, 0, 0, 0, 0};
    if (FP8) { const unsigned char* qb_ = (const unsigned char*)Qp + (size_t)(wid * 32 + r32) * ldq + hi * 32; const v4u a = *(const v4u*)qb_, b = *(const v4u*)(qb_ + 16);
        q8 = (v8i){(int)a.x, (int)a.y, (int)a.z, (int)a.w, (int)b.x, (int)b.y, (int)b.z, (int)b.w}; }
    else {
#pragma unroll
        for (int d0 = 0; d0 < 4; ++d0) qr[d0] = *(const bf16x8*)(Qp + (size_t)(wid * 32 + r32) * ldq + d0 * 16 + hi * 8); }
    float l_reg = 0.f; f32x16 o[ND];
#pragma unroll
    for (int d = 0; d < ND; ++d) o[d] = f32x16{};
    const f32x16 zero16 = f32x16{};
    const int qw = q0 + wid * 32, qpos = qw + r32;
    int tl = 0, tr = NT; float fL = 1.f;
    if (BIAS) { tl = (qw - 191 >= 0) ? ((qw - 191) >> 6) + 1 : 0; tr = (qw + 158) >> 6; fL = __builtin_amdgcn_exp2f(btbl[0]); }
    f32x16 pA0, pA1, pB0, pB1; bf16x8 kf[8]; v8i kf8[2]; s16x4 vlo[8], vhi[8]; v4u pw0, pw1, pw2, pw3;
#define KLOAD8(n, kp_) do { const v4u a_ = *(const LAS v4u*)((kp_) + (n) * 512), b_ = *(const LAS v4u*)((kp_) + (n) * 512 + 1024); kf8[n] = (v8i){(int)a_.x, (int)a_.y, (int)a_.z, (int)a_.w, (int)b_.x, (int)b_.y, (int)b_.z, (int)b_.w}; } while (0)
#define MF8(kf_, c_) __builtin_amdgcn_mfma_scale_f32_32x32x64_f8f6f4(kf_, q8, c_, 0, 0, 0, 0x7f7f7f7f, 0, 0x7c7c7c7c)
#define WAITB(N) do { if (FP8 && wid >= 4) wait_bar<(N) - 1, (TEST & 16) != 0>(); else wait_bar<(N), (TEST & 16) != 0>(); } while (0)
    if (TEST & 32) { pB0 = f32x16{}; pB1 = f32x16{}; }
    if (TEST & 64) { _Pragma("unroll") for (int i_ = 0; i_ < 8; ++i_) { vlo[i_] = (s16x4){1, 2, 3, 4}; vhi[i_] = (s16x4){4, 3, 2, 1}; } }
    int s_prev = 0, s_cur = 0, s_next = 1;
#define ROT() do { s_prev = s_cur; s_cur = s_next; s_next = (s_next == 2) ? 0 : s_next + 1; } while (0)
#define ADD_BIAS(C0, C1, t) do { if (BIAS && (t) >= tl && (t) <= tr) { const int base_ = (t) * 64 + 4 * hi - qpos; \
        _Pragma("unroll") for (int r = 0; r < 16; ++r) { const int rel0 = base_ + (r & 3) + 8 * (r >> 2); const int rel1 = rel0 + 32; \
            const int i0 = (rel0 < -128 ? -128 : (rel0 > 128 ? 128 : rel0)) + 128, i1 = (rel1 < -128 ? -128 : (rel1 > 128 ? 128 : rel1)) + 128; \
            C0[r] += btbl[i0]; C1[r] += btbl[i1]; } } } while (0)
    DMA_K(2, 2);
    if (FP8) wait_bar<0, (TEST & 16) != 0>(); else wait_bar<NV + 2, (TEST & 16) != 0>();
    {
        if (FP8) { KLOAD8(0, kp0); KLOAD8(1, kp0); pA0 = MF8(kf8[0], zero16); pA1 = MF8(kf8[1], zero16); }
        else {
#pragma unroll
        for (int j = 0; j < 4; ++j) kload2(kf, kp0, j);
        pA0 = __builtin_amdgcn_mfma_f32_32x32x16_bf16(kf[0], qr[0], zero16, 0, 0, 0); pA1 = __builtin_amdgcn_mfma_f32_32x32x16_bf16(kf[1], qr[0], zero16, 0, 0, 0);
#pragma unroll
        for (int d0 = 1; d0 < 4; ++d0) { pA0 = __builtin_amdgcn_mfma_f32_32x32x16_bf16(kf[2 * d0], qr[d0], pA0, 0, 0, 0); pA1 = __builtin_amdgcn_mfma_f32_32x32x16_bf16(kf[2 * d0 + 1], qr[d0], pA1, 0, 0, 0); } }
        ADD_BIAS(pA0, pA1, 0);
#pragma unroll
        for (int r = 0; r < 16; ++r) { pA0[r] = __builtin_amdgcn_exp2f(pA0[r]); pA1[r] = __builtin_amdgcn_exp2f(pA1[r]); }
    }
    wait_bar<0, (TEST & 16) != 0>();
    DMA_K(3, 0); DMA_V(1, 1);
    ROT();
    if (FP8) { KLOAD8(0, kp0 + s_cur * KSLOT); KLOAD8(1, kp0 + s_cur * KSLOT); }
    else {
#pragma unroll
    for (int j = 0; j < 4; ++j) kload2(kf, kp0 + s_cur * KSLOT, j); }
    WAITB(1 + NV);
#define PKW(P, B) ((TEST & 256) ? 0x3f803f80u : cvtpk_s(P[B], P[B + 1]))
#define PAF(k) __builtin_bit_cast(bf16x8, pw##k)
#define VFR(i) (bf16x8){vlo[i][0], vlo[i][1], vlo[i][2], vlo[i][3], vhi[i][0], vhi[i][1], vhi[i][2], vhi[i][3]}
#define MF(a, b, c) __builtin_amdgcn_mfma_f32_32x32x16_bf16(a, b, c, 0, 0, 0)
#define GAPA(MFS, A0, A1, A2, A3, W0, W1, PW) do { if (!(TEST & 32)) { MFS; } if (!(TEST & 2)) { sacc += A0; sacc += A1; sacc += A2; sacc += A3; PIN(sacc); } W0; W1; PIN(PW); SBAR(); } while (0)
#define EX(v) ((TEST & 1) ? (v) : __builtin_amdgcn_exp2f(v))
#define GAPB4(MFS, X, B) do { if (!(TEST & 4)) { MFS; } X[B] = EX(X[B]); X[B + 1] = EX(X[B + 1]); X[B + 2] = EX(X[B + 2]); X[B + 3] = EX(X[B + 3]); PIN(X); SBAR(); } while (0)
#define GAPB2(MFS, X, B) do { if (!(TEST & 4)) { MFS; } X[B] = EX(X[B]); X[B + 1] = EX(X[B + 1]); PIN(X); SBAR(); } while (0)
#define VRD(f, s) do { if (TEST & 64) break; vlo[s] = vtr(vp_ + (((f) >> 2) * 4096 + ((f) & 3) * 1024)); vhi[s] = vtr(vp_ + (((f) >> 2) * 4096 + ((f) & 3) * 1024 + 512)); } while (0)
#define KRD(G, j) do { if ((G) && !(TEST & 128)) { if (FP8) { if ((j) < 2) { KLOAD8(j, kp0 + s_next * KSLOT); } } else kload2(kf, kp0 + s_next * KSLOT, j); SBAR(); } } while (0)
#define FO(m) (ND == 2 ? (((m) >> 1) + 4 * ((m) & 1)) : ((((m) & 7) >> 2) + 2 * ((m) >> 3) + 4 * ((m) & 3)))
#define STEP(C0, C1, P0, P1, t, GK, GV, GL) do { SBAR(); \
    const lds_cptr vp_ = vp0 + s_prev * VSLOT; float sacc; \
    if (FP8) { \
      VRD(FO(0), 0); VRD(FO(1), 1); VRD(FO(2), 2); VRD(FO(3), 3); SBAR(); \
      if (!(TEST & 32)) C0 = MF8(kf8[0], zero16); \
      SBAR();   \
      float sa_ = P0[0] + P0[1], sb_ = P0[2] + P0[3], sc_ = P0[4] + P0[5], sd_ = P0[6] + P0[7]; \
      if (!(TEST & 2)) { sa_ += P0[8]; sb_ += P0[9]; sc_ += P0[10]; sd_ += P0[11]; sa_ += P0[12]; sb_ += P0[13]; sc_ += P0[14]; sd_ += P0[15]; } \
      pw0 = (v4u){PKW(P0, 0), PKW(P0, 2), PKW(P0, 4), PKW(P0, 6)}; pw1 = (v4u){PKW(P0, 8), PKW(P0, 10), PKW(P0, 12), PKW(P0, 14)}; PIN(pw0); PIN(pw1); SBAR(); \
      VRD(FO(4), 4); VRD(FO(5), 5); VRD(FO(6), 6); VRD(FO(7), 7); SBAR(); \
      if (!(TEST & 32)) C1 = MF8(kf8[1], zero16); \
      SBAR(); \
      if (!(TEST & 2)) { sa_ += P1[0]; sb_ += P1[1]; sc_ += P1[2]; sd_ += P1[3]; sa_ += P1[4]; sb_ += P1[5]; sc_ += P1[6]; sd_ += P1[7]; \
                         sa_ += P1[8]; sb_ += P1[9]; sc_ += P1[10]; sd_ += P1[11]; sa_ += P1[12]; sb_ += P1[13]; sc_ += P1[14]; sd_ += P1[15]; } \
      sacc = (sa_ + sb_) + (sc_ + sd_); PIN(sacc); \
      pw2 = (v4u){PKW(P1, 0), PKW(P1, 2), PKW(P1, 4), PKW(P1, 6)}; pw3 = (v4u){PKW(P1, 8), PKW(P1, 10), PKW(P1, 12), PKW(P1, 14)}; PIN(pw2); PIN(pw3); SBAR(); \
    } else { \
    VRD(FO(0), 0); SBAR(); sacc = (P0[0] + P0[1]); \
    GAPA(C0 = MF(kf[0], qr[0], zero16), P0[2], P0[3], P0[4], P0[5],     pw0[0] = PKW(P0, 0), pw0[1] = PKW(P0, 2), pw0); \
    VRD(FO(1), 1); SBAR(); GAPA(C1 = MF(kf[1], qr[0], zero16), P0[6], P0[7], P0[8], P0[9],     pw0[2] = PKW(P0, 4), pw0[3] = PKW(P0, 6), pw0); \
    VRD(FO(2), 2); SBAR(); GAPA(C0 = MF(kf[2], qr[1], C0),   P0[10], P0[11], P0[12], P0[13], pw1[0] = PKW(P0, 8), pw1[1] = PKW(P0, 10), pw1); \
    VRD(FO(3), 3); SBAR(); GAPA(C1 = MF(kf[3], qr[1], C1),   P0[14], P0[15], P1[0], P1[1],   pw1[2] = PKW(P0, 12), pw1[3] = PKW(P0, 14), pw1); \
    VRD(FO(4), 4); SBAR(); GAPA(C0 = MF(kf[4], qr[2], C0),   P1[2], P1[3], P1[4], P1[5],     pw2[0] = PKW(P1, 0), pw2[1] = PKW(P1, 2), pw2); \
    VRD(FO(5), 5); SBAR(); GAPA(C1 = MF(kf[5], qr[2], C1),   P1[6], P1[7], P1[8], P1[9],     pw2[2] = PKW(P1, 4), pw2[3] = PKW(P1, 6), pw2); \
    VRD(FO(6), 6); SBAR(); GAPA(C0 = MF(kf[6], qr[3], C0),   P1[10], P1[11], P1[12], P1[13], pw3[0] = PKW(P1, 8), pw3[1] = PKW(P1, 10), pw3); \
    VRD(FO(7), 7); SBAR(); GAPA(C1 = MF(kf[7], qr[3], C1),   P1[14], P1[15], 0.f, 0.f,       pw3[2] = PKW(P1, 12), pw3[3] = PKW(P1, 14), pw3); \
    } \
    l_reg += sacc; \
    if (GK) { DMA_K((t) + 3, s_cur); } if (GV) { DMA_V((t) + 1, s_next); } \
    ADD_BIAS(C0, C1, t); \
    SBAR(); \
    if (ND == 2) { \
        GAPB4(o[0] = MF(PAF(0), VFR(0), o[0]), C0, 0); \
        GAPB4(o[1] = MF(PAF(0), VFR(1), o[1]), C0, 4); \
        KRD(GL, 0); GAPB4(o[0] = MF(PAF(1), VFR(2), o[0]), C0, 8); \
        KRD(GL, 1); GAPB4(o[1] = MF(PAF(1), VFR(3), o[1]), C0, 12); \
        KRD(GL, 2); GAPB4(o[0] = MF(PAF(2), VFR(4), o[0]), C1, 0); \
        KRD(GL, 3); GAPB4(o[1] = MF(PAF(2), VFR(5), o[1]), C1, 4); \
        GAPB4(o[0] = MF(PAF(3), VFR(6), o[0]), C1, 8); \
        GAPB4(o[1] = MF(PAF(3), VFR(7), o[1]), C1, 12); \
    } else { \
        GAPB2(o[0] = MF(PAF(0), VFR(0), o[0]), C0, 0);  VRD(FO(8), 0); SBAR(); \
        GAPB2(o[1] = MF(PAF(0), VFR(1), o[1]), C0, 2);  VRD(FO(9), 1); SBAR(); \
        GAPB2(o[ND - 2] = MF(PAF(0), VFR(2), o[ND - 2]), C0, 4);  VRD(FO(10), 2); SBAR(); \
        GAPB2(o[ND - 1] = MF(PAF(0), VFR(3), o[ND - 1]), C0, 6);  VRD(FO(11), 3); SBAR(); \
        GAPB2(o[0] = MF(PAF(1), VFR(4), o[0]), C0, 8);  VRD(FO(12), 4); SBAR(); \
        GAPB2(o[1] = MF(PAF(1), VFR(5), o[1]), C0, 10); VRD(FO(13), 5); SBAR(); \
        GAPB2(o[ND - 2] = MF(PAF(1), VFR(6), o[ND - 2]), C0, 12); VRD(FO(14), 6); SBAR(); \
        GAPB2(o[ND - 1] = MF(PAF(1), VFR(7), o[ND - 1]), C0, 14); VRD(FO(15), 7); SBAR(); \
        KRD(GL, 0); GAPB2(o[0] = MF(PAF(2), VFR(0), o[0]), C1, 0); \
        GAPB2(o[1] = MF(PAF(2), VFR(1), o[1]), C1, 2); \
        KRD(GL, 1); GAPB2(o[ND - 2] = MF(PAF(2), VFR(2), o[ND - 2]), C1, 4); \
        GAPB2(o[ND - 1] = MF(PAF(2), VFR(3), o[ND - 1]), C1, 6); \
        KRD(GL, 2); GAPB2(o[0] = MF(PAF(3), VFR(4), o[0]), C1, 8); \
        GAPB2(o[1] = MF(PAF(3), VFR(5), o[1]), C1, 10); \
        KRD(GL, 3); GAPB2(o[ND - 2] = MF(PAF(3), VFR(6), o[ND - 2]), C1, 12); \
        GAPB2(o[ND - 1] = MF(PAF(3), VFR(7), o[ND - 1]), C1, 14); \
    } \
    if (BIAS && (t) == tl) { l_reg *= fL; _Pragma("unroll") for (int d_ = 0; d_ < ND; ++d_) _Pragma("unroll") for (int r = 0; r < 16; ++r) o[d_][r] *= fL; } \
    } while (0)
    int t = 1;
    for (; t + 4 < NT; t += 2) {
        STEP(pB0, pB1, pA0, pA1, t, true, true, true);       WAITB(1 + NV); ROT();
        STEP(pA0, pA1, pB0, pB1, t + 1, true, true, true);   WAITB(1 + NV); ROT();
    }
    STEP(pB0, pB1, pA0, pA1, NT - 3, false, true, true);  wait_bar<NV, (TEST & 16) != 0>(); ROT();
    STEP(pA0, pA1, pB0, pB1, NT - 2, false, true, true);  wait_bar<0, (TEST & 16) != 0>();  ROT();
    STEP(pB0, pB1, pA0, pA1, NT - 1, false, false, false);
    {
        float sacc = pB0[0] + pB0[1];
#pragma unroll
        for (int r = 2; r < 16; ++r) sacc += pB0[r];
#pragma unroll
        for (int r = 0; r < 16; ++r) sacc += pB1[r];
        l_reg += sacc;
        pw0 = (v4u){PKW(pB0, 0), PKW(pB0, 2), PKW(pB0, 4), PKW(pB0, 6)}; pw1 = (v4u){PKW(pB0, 8), PKW(pB0, 10), PKW(pB0, 12), PKW(pB0, 14)};
        pw2 = (v4u){PKW(pB1, 0), PKW(pB1, 2), PKW(pB1, 4), PKW(pB1, 6)}; pw3 = (v4u){PKW(pB1, 8), PKW(pB1, 10), PKW(pB1, 12), PKW(pB1, 14)};
        const lds_cptr vp_ = vp0 + s_cur * VSLOT;
#pragma unroll
        for (int d0 = 0; d0 < ND; ++d0) {
            s16x4 a0 = vtr(vp_ + d0 * 4096), b0 = vtr(vp_ + d0 * 4096 + 512), a1 = vtr(vp_ + d0 * 4096 + 1024), b1 = vtr(vp_ + d0 * 4096 + 1536);
            s16x4 a2 = vtr(vp_ + d0 * 4096 + 2048), b2 = vtr(vp_ + d0 * 4096 + 2560), a3 = vtr(vp_ + d0 * 4096 + 3072), b3 = vtr(vp_ + d0 * 4096 + 3584);
            o[d0] = MF(PAF(0), ((bf16x8){a0[0], a0[1], a0[2], a0[3], b0[0], b0[1], b0[2], b0[3]}), o[d0]);
            o[d0] = MF(PAF(1), ((bf16x8){a1[0], a1[1], a1[2], a1[3], b1[0], b1[1], b1[2], b1[3]}), o[d0]);
            o[d0] = MF(PAF(2), ((bf16x8){a2[0], a2[1], a2[2], a2[3], b2[0], b2[1], b2[2], b2[3]}), o[d0]);
            o[d0] = MF(PAF(3), ((bf16x8){a3[0], a3[1], a3[2], a3[3], b3[0], b3[1], b3[2], b3[3]}), o[d0]);
        }
    }
    l_reg += __shfl_xor(l_reg, 32);
    int lane_e = lane; asm volatile("" : "+v"(lane_e));
    const int r32e = lane_e & 31, hie = lane_e >> 5;
    if (hie == 0) wsf[r32e] = l_reg;
    asm volatile("s_waitcnt lgkmcnt(0)\n\ts_barrier" ::: "memory");
    {
        LAS bf16* stg = (LAS bf16*)(MODE == 1 ? lds + STASH_OFF : lds) + wid * (32 * DV);
#pragma unroll
        for (int r = 0; r < 16; ++r) { const int orow = crow(r, hie); const float rl = __builtin_amdgcn_rcpf(wsf[orow]);
#pragma unroll
            for (int d0 = 0; d0 < ND; ++d0) stg[orow * DV + d0 * 32 + r32e] = (bf16)f2bf(o[d0][r] * rl); }
        asm volatile("s_waitcnt lgkmcnt(0)" ::: "memory");
        if (MODE == 0) {
            constexpr int CPR = DV / 8;
#pragma unroll
            for (int i = 0; i < (32 * CPR) / 64; ++i) { const int row = i * (64 / CPR) + lane_e / CPR, ch = lane_e % CPR;
                const v4u v = *(const LAS v4u*)(stg + row * DV + ch * 8); *(v4u*)(Op + (size_t)(wid * 32 + row) * ldo + ch * 8) = v; }
        } else if (MODE == 2) {
            const int row = lane_e >> 1, half = lane_e & 1; const float lam = sgt[128];
            const LAS bf16* s1 = stg + row * DV + half * 64; const LAS bf16* s0 = (const LAS bf16*)(lds + STASH_OFF) + wid * (32 * DV) + row * DV + half * 64;
            float ov[64]; float ss = 0.f;
#pragma unroll
            for (int q = 0; q < 8; ++q) { const v4u a = *(const LAS v4u*)(s0 + q * 8), c = *(const LAS v4u*)(s1 + q * 8);
#pragma unroll
                for (int j = 0; j < 4; ++j) { const float lo = __builtin_bit_cast(float, a[j] << 16) - lam * __builtin_bit_cast(float, c[j] << 16);
                    const float hh = __builtin_bit_cast(float, a[j] & 0xffff0000u) - lam * __builtin_bit_cast(float, c[j] & 0xffff0000u);
                    ov[q * 8 + 2 * j] = lo; ov[q * 8 + 2 * j + 1] = hh; ss += lo * lo + hh * hh; } }
            ss += dpp_mov<0xB1>(ss);
            const float rstd = 1.0f / sqrtf(ss * (1.f / 128.f) + 1e-5f);
            bf16* yo = Op + (size_t)(wid * 32 + row) * ldo + half * 64;
#pragma unroll
            for (int q = 0; q < 8; ++q) { const f32x4 g0 = *(const LAS f32x4*)(sgt + half * 64 + q * 8), g1 = *(const LAS f32x4*)(sgt + half * 64 + q * 8 + 4);
                v4u w; w.x = pk2(ov[q * 8] * rstd * g0.x, ov[q * 8 + 1] * rstd * g0.y); w.y = pk2(ov[q * 8 + 2] * rstd * g0.z, ov[q * 8 + 3] * rstd * g0.w);
                w.z = pk2(ov[q * 8 + 4] * rstd * g1.x, ov[q * 8 + 5] * rstd * g1.y); w.w = pk2(ov[q * 8 + 6] * rstd * g1.z, ov[q * 8 + 7] * rstd * g1.w);
                *(v4u*)(yo + q * 8) = w; }
        }
    }
    asm volatile("s_waitcnt lgkmcnt(0)\n\ts_barrier" ::: "memory");
#undef KLOAD8
#undef MF8
#undef WAITB
#undef DMA_K
#undef DMA_V
#undef ROT
#undef ADD_BIAS
#undef PKW
#undef PAF
#undef VFR
#undef MF
#undef GAPA
#undef EX
#undef GAPB4
#undef GAPB2
#undef VRD
#undef KRD
#undef FO
#undef STEP
}
#undef SBAR
#undef PIN
}

namespace at3 {
#define SBAR() __builtin_amdgcn_sched_barrier(0)
#define PIN(x) asm volatile("" : "+v"(x))
using at1::glds16; using at1::wait_bar;
typedef const LAS char* lds_cptr; typedef short v2s __attribute__((ext_vector_type(2)));
template <int DV> __host__ __device__ constexpr int lds_ws_off() { return (3 * 4096 + 3 * DV * 64) > 512 * DV ? (3 * 4096 + 3 * DV * 64) : 512 * DV; }
template <int DV> __host__ __device__ constexpr int lds_tbl_off() { return lds_ws_off<DV>() + 2048; }
__device__ __forceinline__ void waitb(int n) { if (n == 0) wait_bar<0>(); else if (n == 1) wait_bar<1>(); else wait_bar<2>(); }
__device__ __forceinline__ v8i ld_frag(lds_cptr p, int second) { const v4u a = *(const LAS v4u*)p, b = *(const LAS v4u*)(p + second); return (v8i){(int)a.x, (int)a.y, (int)a.z, (int)a.w, (int)b.x, (int)b.y, (int)b.z, (int)b.w}; }

template <int DV, bool BIAS, int MODE>
__device__ __forceinline__ void attn_unit(const unsigned char* Qp, int ldq, const unsigned char* __restrict__ K8T, const unsigned char* __restrict__ V8T, bf16* Op, int ldo, int q0, LAS unsigned char* lds, const LAS float* sgt) {
    constexpr int ND = DV / 32, VT = DV * 64, KT = 4096, NT = SEQ / 64, NVP = VT / 1024;
    constexpr int LDS_K = 0, LDS_V = 3 * KT, LDS_WS = lds_ws_off<DV>(), LDS_TBL = LDS_WS + 2048;
    static_assert(LDS_WS >= LDS_V + 3 * VT && LDS_WS >= 512 * DV && LDS_TBL + 2048 <= STASH_OFF, "LDS map");
    const int tid = threadIdx.x, lane = tid & 63, r32 = lane & 31, hi = lane >> 5; const int wid = __builtin_amdgcn_readfirstlane(tid >> 6);
    const unsigned lds0 = (unsigned)(uintptr_t)lds;
    LAS float* wsf = (LAS float*)(lds + LDS_WS) + wid * 64;
    const LAS float* btbl = (const LAS float*)(lds + LDS_TBL);
    const bool doK = wid < 4, doV = (NVP == 8) || wid >= 4; const int vpc = (NVP == 8) ? wid : (wid & 3);
    const unsigned char* ksrc = K8T + (wid & 3) * 1024 + lane * 16; const unsigned char* vsrc = V8T + vpc * 1024 + lane * 16;
    const unsigned kdst = lds0 + LDS_K + (wid & 3) * 1024, vdst = lds0 + LDS_V + vpc * 1024;
    const int ndma = (doK ? 1 : 0) + (doV ? 1 : 0);
#define DMA_K(t, s) do { if (doK) glds16(ksrc + (size_t)(t) * KT, (unsigned)__builtin_amdgcn_readfirstlane(kdst + (s) * KT)); } while (0)
#define DMA_V(t, s) do { if (doV) glds16(vsrc + (size_t)(t) * VT, (unsigned)__builtin_amdgcn_readfirstlane(vdst + (s) * VT)); } while (0)
    const lds_cptr kp0 = (lds_cptr)lds + LDS_K + hi * 2048 + r32 * 16;
    const lds_cptr vq0 = (lds_cptr)lds + LDS_V + hi * (2 * DV * 16) + r32 * 16;
    DMA_K(0, 0); DMA_V(0, 0); DMA_K(1, 1);
    v8i q8;
    { const unsigned char* qb_ = Qp + (size_t)(wid * 32 + r32) * ldq + hi * 32; const v4u a = *(const v4u*)qb_, b = *(const v4u*)(qb_ + 16);
      q8 = (v8i){(int)a.x, (int)a.y, (int)a.z, (int)a.w, (int)b.x, (int)b.y, (int)b.z, (int)b.w}; }
    f32x16 lacc = f32x16{}; f32x16 o[ND];
#pragma unroll
    for (int d = 0; d < ND; ++d) o[d] = f32x16{};
    const f32x16 zero16 = f32x16{};
    const v8i ones8 = {0x38383838, 0x38383838, 0x38383838, 0x38383838, 0x38383838, 0x38383838, 0x38383838, 0x38383838};
    const int qw = q0 + wid * 32, qpos = qw + r32;
    int tl = 0, tr = NT; float fL = 1.f;
    if (BIAS) { tl = (qw - 191 >= 0) ? ((qw - 191) >> 6) + 1 : 0; tr = (qw + 158) >> 6; fL = __builtin_amdgcn_exp2f(btbl[0]); }
    f32x16 pA0, pA1, pB0, pB1; v8i kf8[2]; v8i vf[ND]; v8i pa; int sb = 127;
    int s_prev = 0, s_cur = 0, s_next = 1;
#define ROT() do { s_prev = s_cur; s_cur = s_next; s_next = (s_next == 2) ? 0 : s_next + 1; } while (0)
#define MFQK(kf_) __builtin_amdgcn_mfma_scale_f32_32x32x64_f8f6f4(kf_, q8, zero16, 0, 0, 0, 0x7f7f7f7f, 0, 0x7c7c7c7c)
#define MFPV(d_) o[d_] = __builtin_amdgcn_mfma_scale_f32_32x32x64_f8f6f4(pa, vf[d_], o[d_], 0, 0, 0, sb, 0, 0x7f7f7f7f)
#define MFSUM() lacc = __builtin_amdgcn_mfma_scale_f32_32x32x64_f8f6f4(pa, ones8, lacc, 0, 0, 0, sb, 0, 0x7f7f7f7f)
#define ADD_BIAS(C0, C1, t) do { if (BIAS && (t) >= tl && (t) <= tr) { const int base_ = (t) * 64 + 4 * hi - qpos; \
        _Pragma("unroll") for (int r = 0; r < 16; ++r) { const int rel0 = base_ + (r & 3) + 8 * (r >> 2); const int rel1 = rel0 + 32; \
            const int i0 = (rel0 < -128 ? -128 : (rel0 > 128 ? 128 : rel0)) + 128, i1 = (rel1 < -128 ? -128 : (rel1 > 128 ? 128 : rel1)) + 128; \
            C0[r] += btbl[i0]; C1[r] += btbl[i1]; } } } while (0)
#define MX3(a, b, c) __builtin_fmaxf(__builtin_fmaxf((a), (b)), (c))
#define PMAX(P0, P1) do { float a_ = MX3(P0[0], P0[1], P1[0]), b_ = MX3(P0[2], P0[3], P1[1]); a_ = MX3(a_, P1[2], P1[3]); \
        _Pragma("unroll") for (int r = 4; r < 16; r += 4) { a_ = MX3(a_, P0[r], P0[r + 1]); b_ = MX3(b_, P0[r + 2], P0[r + 3]); a_ = MX3(a_, P1[r], P1[r + 1]); b_ = MX3(b_, P1[r + 2], P1[r + 3]); } \
        float mx_ = __builtin_fmaxf(a_, b_); { auto rr_ = __builtin_amdgcn_permlane32_swap(__float_as_uint(mx_), __float_as_uint(mx_), false, false); mx_ = __builtin_fmaxf(__uint_as_float(rr_[0]), __uint_as_float(rr_[1])); } \
        const int em_ = (int)(__float_as_uint(mx_) >> 23) - 7; sb = em_ < 1 ? 1 : em_; } while (0)
#define PCVT(P0, P1) do { const float scf_ = __uint_as_float((unsigned)sb << 23); \
        _Pragma("unroll") for (int k = 0; k < 4; ++k) { v2s w_ = {0, 0}; w_ = __builtin_amdgcn_cvt_scalef32_pk_fp8_f32(w_, P0[4 * k], P0[4 * k + 1], scf_, false); w_ = __builtin_amdgcn_cvt_scalef32_pk_fp8_f32(w_, P0[4 * k + 2], P0[4 * k + 3], scf_, true); pa[k] = __builtin_bit_cast(int, w_); } \
        _Pragma("unroll") for (int k = 0; k < 4; ++k) { v2s w_ = {0, 0}; w_ = __builtin_amdgcn_cvt_scalef32_pk_fp8_f32(w_, P1[4 * k], P1[4 * k + 1], scf_, false); w_ = __builtin_amdgcn_cvt_scalef32_pk_fp8_f32(w_, P1[4 * k + 2], P1[4 * k + 3], scf_, true); pa[4 + k] = __builtin_bit_cast(int, w_); } } while (0)
#define PSUM(P0, P1) do { float s0_ = P0[0] + P0[1], s1_ = P0[2] + P0[3], s2_ = P1[0] + P1[1], s3_ = P1[2] + P1[3]; \
        _Pragma("unroll") for (int r = 4; r < 16; r += 4) { s0_ += P0[r]; s1_ += P0[r + 1]; s2_ += P0[r + 2]; s3_ += P0[r + 3]; s0_ += P1[r]; s1_ += P1[r + 1]; s2_ += P1[r + 2]; s3_ += P1[r + 3]; } \
        l_reg += (s0_ + s1_) + (s2_ + s3_); } while (0)
#define EXPS(X, B, N) do { _Pragma("unroll") for (int r_ = 0; r_ < (N); ++r_) X[(B) + r_] = __builtin_amdgcn_exp2f(X[(B) + r_]); PIN(X); } while (0)
    DMA_K(2, 2);
    wait_bar<0>();
    kf8[0] = ld_frag(kp0, 1024); kf8[1] = ld_frag(kp0 + 512, 1024);
    pA0 = MFQK(kf8[0]); pA1 = MFQK(kf8[1]);
    ADD_BIAS(pA0, pA1, 0);
#pragma unroll
    for (int r = 0; r < 16; ++r) { pA0[r] = __builtin_amdgcn_exp2f(pA0[r]); pA1[r] = __builtin_amdgcn_exp2f(pA1[r]); }
    wait_bar<0>();
    DMA_K(3, 0); DMA_V(1, 1);
    ROT();
    kf8[0] = ld_frag(kp0 + s_cur * KT, 1024); kf8[1] = ld_frag(kp0 + s_cur * KT + 512, 1024);
    waitb(ndma);
#define STEP(C0, C1, P0, P1, t, GK, GV, GL) do { SBAR(); \
    const lds_cptr vp_ = vq0 + s_prev * VT; \
    _Pragma("unroll") for (int d_ = 0; d_ < ND; ++d_) vf[d_] = ld_frag(vp_ + d_ * 512, DV * 16); \
    SBAR(); \
    C0 = MFQK(kf8[0]); SBAR(); \
    PMAX(P0, P1); PIN(sb); SBAR(); \
    C1 = MFQK(kf8[1]); SBAR(); \
    PCVT(P0, P1); PIN(pa); SBAR(); \
    MFSUM(); SBAR(); \
    if (GK) { DMA_K((t) + 3, s_cur); } if (GV) { DMA_V((t) + 1, s_next); } \
    ADD_BIAS(C0, C1, t); \
    SBAR(); \
    if (ND == 2) { \
        MFPV(0); EXPS(C0, 0, 16); SBAR(); \
        if (GL) { kf8[0] = ld_frag(kp0 + s_next * KT, 1024); kf8[1] = ld_frag(kp0 + s_next * KT + 512, 1024); SBAR(); } \
        MFPV(1); EXPS(C1, 0, 16); SBAR(); \
    } else { \
        MFPV(0); EXPS(C0, 0, 8); SBAR(); \
        if (GL) { kf8[0] = ld_frag(kp0 + s_next * KT, 1024); SBAR(); } \
        MFPV(1); EXPS(C0, 8, 8); SBAR(); \
        if (GL) { kf8[1] = ld_frag(kp0 + s_next * KT + 512, 1024); SBAR(); } \
        MFPV(ND - 2); EXPS(C1, 0, 8); SBAR(); \
        MFPV(ND - 1); EXPS(C1, 8, 8); SBAR(); \
    } \
    if (BIAS && (t) == tl) { _Pragma("unroll") for (int r = 0; r < 16; ++r) lacc[r] *= fL; _Pragma("unroll") for (int d_ = 0; d_ < ND; ++d_) _Pragma("unroll") for (int r = 0; r < 16; ++r) o[d_][r] *= fL; } \
    } while (0)
    int t = 1;
    for (; t + 4 < NT; t += 2) {
        STEP(pB0, pB1, pA0, pA1, t, true, true, true);       waitb(ndma); ROT();
        STEP(pA0, pA1, pB0, pB1, t + 1, true, true, true);   waitb(ndma); ROT();
    }
    STEP(pB0, pB1, pA0, pA1, NT - 3, false, true, true);  waitb(doV ? 1 : 0); ROT();
    STEP(pA0, pA1, pB0, pB1, NT - 2, false, true, true);  wait_bar<0>();  ROT();
    STEP(pB0, pB1, pA0, pA1, NT - 1, false, false, false);
    {
        const lds_cptr vp_ = vq0 + s_cur * VT;
#pragma unroll
        for (int d_ = 0; d_ < ND; ++d_) vf[d_] = ld_frag(vp_ + d_ * 512, DV * 16);
        PMAX(pB0, pB1); PCVT(pB0, pB1); MFSUM();
#pragma unroll
        for (int d_ = 0; d_ < ND; ++d_) MFPV(d_);
    }
    int lane_e = lane; asm volatile("" : "+v"(lane_e));
    const int r32e = lane_e & 31, hie = lane_e >> 5;
    asm volatile("s_waitcnt lgkmcnt(0)\n\ts_barrier" ::: "memory");
    {
        LAS bf16* stg = (LAS bf16*)(MODE == 1 ? lds + STASH_OFF : lds) + wid * (32 * DV);
#pragma unroll
        for (int r = 0; r < 16; ++r) { const int orow = crow(r, hie); const float rl = __builtin_amdgcn_rcpf(lacc[r]);
#pragma unroll
            for (int d0 = 0; d0 < ND; ++d0) stg[orow * DV + d0 * 32 + r32e] = (bf16)f2bf(o[d0][r] * rl); }
        asm volatile("s_waitcnt lgkmcnt(0)" ::: "memory");
        if (MODE == 0) {
            constexpr int CPR = DV / 8;
#pragma unroll
            for (int i = 0; i < (32 * CPR) / 64; ++i) { const int row = i * (64 / CPR) + lane_e / CPR, ch = lane_e % CPR;
                const v4u v = *(const LAS v4u*)(stg + row * DV + ch * 8); *(v4u*)(Op + (size_t)(wid * 32 + row) * ldo + ch * 8) = v; }
        } else if (MODE == 2) {
            const int row = lane_e >> 1, half = lane_e & 1; const float lam = sgt[128];
            const LAS bf16* s1 = stg + row * DV + half * 64; const LAS bf16* s0 = (const LAS bf16*)(lds + STASH_OFF) + wid * (32 * DV) + row * DV + half * 64;
            float ov[64]; float ss = 0.f;
#pragma unroll
            for (int q = 0; q < 8; ++q) { const v4u a = *(const LAS v4u*)(s0 + q * 8), c = *(const LAS v4u*)(s1 + q * 8);
#pragma unroll
                for (int j = 0; j < 4; ++j) { const float lo = __builtin_bit_cast(float, a[j] << 16) - lam * __builtin_bit_cast(float, c[j] << 16);
                    const float hh = __builtin_bit_cast(float, a[j] & 0xffff0000u) - lam * __builtin_bit_cast(float, c[j] & 0xffff0000u);
                    ov[q * 8 + 2 * j] = lo; ov[q * 8 + 2 * j + 1] = hh; ss += lo * lo + hh * hh; } }
            ss += dpp_mov<0xB1>(ss);
            const float rstd = 1.0f / sqrtf(ss * (1.f / 128.f) + 1e-5f);
            bf16* yo = Op + (size_t)(wid * 32 + row) * ldo + half * 64;
#pragma unroll
            for (int q = 0; q < 8; ++q) { const f32x4 g0 = *(const LAS f32x4*)(sgt + half * 64 + q * 8), g1 = *(const LAS f32x4*)(sgt + half * 64 + q * 8 + 4);
                v4u w; w.x = pk2(ov[q * 8] * rstd * g0.x, ov[q * 8 + 1] * rstd * g0.y); w.y = pk2(ov[q * 8 + 2] * rstd * g0.z, ov[q * 8 + 3] * rstd * g0.w);
                w.z = pk2(ov[q * 8 + 4] * rstd * g1.x, ov[q * 8 + 5] * rstd * g1.y); w.w = pk2(ov[q * 8 + 6] * rstd * g1.z, ov[q * 8 + 7] * rstd * g1.w);
                *(v4u*)(yo + q * 8) = w; }
        }
    }
    asm volatile("s_waitcnt lgkmcnt(0)\n\ts_barrier" ::: "memory");
#undef DMA_K
#undef DMA_V
#undef ROT
#undef MFQK
#undef MFPV
#undef MFSUM
#undef ADD_BIAS
#undef MX3
#undef PMAX
#undef PCVT
#undef PSUM
#undef EXPS
#undef STEP
}
#undef SBAR
#undef PIN
}

struct Args { const float* in[27]; float* out; unsigned char* ws; int ph_lo, ph_hi, li, pad; };

constexpr int NPHASE = 17;
constexpr int NWAVES = 8;

#define IN(k) (lo <= (k) && (k) < hi_ph)
#define SEAM(k) do { if (IN(k) && IN((k) + 1)) xcd_barrier(bar); } while (0)
constexpr bool SIDE_ON = (SIDE_CONV != 0) && (MOE_FP8 != 0) && (MK_N_LAUNCHES == 1);
constexpr size_t moe_w13_off(int layer) { return WS_W13 + (SIDE_ON ? (size_t)layer * 32 * MiB : 0); }
constexpr size_t moe_w2_off(int layer) { return WS_W2 + (SIDE_ON ? (size_t)layer * 16 * MiB : 0); }
__device__ __forceinline__ void side_items(const Args& args, LAS unsigned char* lds, int layer, int k0, int k1) {
    const int tid = threadIdx.x, lane = tid & 63, wave = __builtin_amdgcn_readfirstlane(tid >> 6); const int gw = blockIdx.x * NWAVES + wave, ngw = gridDim.x * NWAVES;
    LAS float* scr = (LAS float*)(lds + wave * 16384);
    const size_t lo_ = (size_t)layer * NEXP * 1024 * 512;
    transpose_moe(args.in[24] + lo_, args.in[25] + lo_, args.in[26] + lo_, (bf16*)(args.ws + moe_w13_off(layer)), (bf16*)(args.ws + moe_w2_off(layer)), scr, gw, ngw, lane, k0, k1);
}
__device__ __forceinline__ int side_k13() { const int ngw = gridDim.x * NWAVES; return (NEXP * 512 + ngw - 1) / ngw; }
__device__ __forceinline__ int side_kpw() { const int ngw = gridDim.x * NWAVES; return (NEXP * 768 + ngw - 1) / ngw; }
#define SEAM_W(k_, L_, cur_) do { if (IN(k_) && IN((k_) + 1)) { if (SIDE_ON) xcd_barrier_w(bar, [&]() { const int kpw_ = side_kpw(); if ((cur_) < kpw_) { const int ke_ = (cur_) + 2 < kpw_ ? (cur_) + 2 : kpw_; side_items(args, lds, (L_), (cur_), ke_); (cur_) = ke_; } }); \
                                                             else xcd_barrier(bar); } } while (0)
#define SIDE_FINISH_TO(L_, cur_, kend_) do { if (SIDE_ON) { const int ke2_ = (kend_); if ((cur_) < ke2_) { side_items(args, lds, (L_), (cur_), ke2_); (cur_) = ke2_; } } } while (0)
#define SIDE_FINISH(L_, cur_) do { if (SIDE_ON) { const int kpw_ = side_kpw(); if ((cur_) < kpw_) { side_items(args, lds, (L_), (cur_), kpw_); (cur_) = kpw_; } } } while (0)
template <int layer>
__device__ __forceinline__ void moe_block(const Args& args, LAS unsigned char* lds, const XcdBarrier& bar, int lo, int hi_ph, int& sk0, int& sk1) {
    volatile LAS unsigned* LC = (volatile LAS unsigned*)(lds + LDSCTL_OFF);
    const int tid = threadIdx.x, lane = tid & 63, wave = __builtin_amdgcn_readfirstlane(tid >> 6);
    const int G = gridDim.x, bx = blockIdx.x;
    const int gw = bx * NWAVES + wave, NGW = G * NWAVES;
    unsigned char* ws = args.ws;
    unsigned* ctl = (unsigned*)(ws + WS_CTL);
    float* xres = args.out;
    bf16* XB = (bf16*)(ws + WS_XB);
    bf16* HB = (bf16*)(ws + WS_HB);
    {
        const int pb = layer == 0 ? 5 : 13;
        unsigned* const gcnt0 = ctl + CW_CNT + layer * 64;
        int* list = (int*)(ws + WS_LIST); int* tokep = (int*)(ws + WS_TOKEP); float* gate = (float*)(ws + WS_GATE);
        if (IN(pb)) REP(pb) {
            unsigned* gcnt = gcnt0 + ((MK_N_LAUNCHES == 1 ? (int)((PROBE_MASK >> pb) & 1u) : 0) - rep_) * 128;
            if (rep_ > 0) xcd_barrier(bar);
            const float* gf = args.in[2] + layer * DM;
            const float* WR = (const float*)(ws + WS_TBL) + TBL_WR + layer * WR_LAYER;
            for (int chunk = bx; chunk < NTOK / 128; chunk += G) {
                __syncthreads();
                if (tid < 32) LC[LC_LCNT + tid] = 0u;
                __syncthreads();
                int my_e0 = 0, my_e1 = 0; float my_g0 = 0.f, my_g1 = 0.f;
                {
                    const int ri = lane & 15, kq = lane >> 4; const int r0w = chunk * 128 + wave * 16;
                    const GAS bf16* xrow = (const GAS bf16*)(XB + (size_t)(r0w + ri) * DM) + 8 * kq;
                    const GAS bf16* wth = (const GAS bf16*)((const unsigned char*)(ws + WS_TBL) + 614400) + (size_t)(layer * 2) * 49152 + ri * 1024 + 8 * kq; const GAS bf16* wtl = wth + 49152;
                    f32x4 acc0 = {0.f, 0.f, 0.f, 0.f}, acc1 = acc0, acc2 = acc0; float ss = 0.f;
                    bf16x8 aA[2], aB[2], bA[12], bB[12];
#define RT_LOAD(a_, b_, g_) do { _Pragma("unroll") for (int c_ = 0; c_ < 2; ++c_) { const int cc_ = 2 * (g_) + c_; a_[c_] = *(const GAS bf16x8*)(xrow + 32 * cc_); \
        _Pragma("unroll") for (int t_ = 0; t_ < 3; ++t_) { b_[c_ * 6 + t_ * 2] = *(const GAS bf16x8*)(wth + t_ * 16384 + 32 * cc_); b_[c_ * 6 + t_ * 2 + 1] = *(const GAS bf16x8*)(wtl + t_ * 16384 + 32 * cc_); } } } while (0)
#define RT_COMP(a_, b_) do { _Pragma("unroll") for (int c_ = 0; c_ < 2; ++c_) { const v4u aw_ = __builtin_bit_cast(v4u, a_[c_]); \
        _Pragma("unroll") for (int j_ = 0; j_ < 4; ++j_) { const float lo_ = __builtin_bit_cast(float, aw_[j_] << 16), hi_ = __builtin_bit_cast(float, aw_[j_] & 0xffff0000u); ss += lo_ * lo_ + hi_ * hi_; } \
        acc0 = __builtin_amdgcn_mfma_f32_16x16x32_bf16(a_[c_], b_[c_ * 6], acc0, 0, 0, 0); acc0 = __builtin_amdgcn_mfma_f32_16x16x32_bf16(a_[c_], b_[c_ * 6 + 1], acc0, 0, 0, 0); \
        acc1 = __builtin_amdgcn_mfma_f32_16x16x32_bf16(a_[c_], b_[c_ * 6 + 2], acc1, 0, 0, 0); acc1 = __builtin_amdgcn_mfma_f32_16x16x32_bf16(a_[c_], b_[c_ * 6 + 3], acc1, 0, 0, 0); \
        acc2 = __builtin_amdgcn_mfma_f32_16x16x32_bf16(a_[c_], b_[c_ * 6 + 4], acc2, 0, 0, 0); acc2 = __builtin_amdgcn_mfma_f32_16x16x32_bf16(a_[c_], b_[c_ * 6 + 5], acc2, 0, 0, 0); } } while (0)
                    if (ROUTER_LDSW) {
                        constexpr int RS = 1040;
                        const unsigned lds0 = (unsigned)(uintptr_t)lds;
                        const unsigned char* tb = (const unsigned char*)(ws + WS_TBL) + 614400 + (size_t)(layer * 2) * 49152 * 2;
                        const LAS unsigned char* bp = lds + ri * RS + kq * 256;
#pragma unroll 1
                        for (int half = 0; half < 2; ++half) {
                            __syncthreads();
#pragma unroll
                            for (int j = 0; j < 12; ++j) { const int R = wave * 12 + j; at1::glds16(tb + (size_t)R * 2048 + half * 1024 + lane * 16, (unsigned)__builtin_amdgcn_readfirstlane(lds0 + R * RS)); }
                            bf16x8 xa[16];
#pragma unroll
                            for (int cc = 0; cc < 16; ++cc) xa[cc] = *(const GAS bf16x8*)(xrow + half * 512 + 32 * cc);
                            asm volatile("s_waitcnt vmcnt(0)" ::: "memory");
                            __syncthreads();
#pragma unroll
                            for (int cc = 0; cc < 16; ++cc) {
                                const v4u aw_ = __builtin_bit_cast(v4u, xa[cc]);
#pragma unroll
                                for (int j_ = 0; j_ < 4; ++j_) { const float lo_ = __builtin_bit_cast(float, aw_[j_] << 16), hi_ = __builtin_bit_cast(float, aw_[j_] & 0xffff0000u); ss += lo_ * lo_ + hi_ * hi_; }
                                const LAS unsigned char* p = bp + cc * 16;
                                acc0 = __builtin_amdgcn_mfma_f32_16x16x32_bf16(xa[cc], *(const LAS bf16x8*)(p), acc0, 0, 0, 0);               acc0 = __builtin_amdgcn_mfma_f32_16x16x32_bf16(xa[cc], *(const LAS bf16x8*)(p + 48 * RS), acc0, 0, 0, 0);
                                acc1 = __builtin_amdgcn_mfma_f32_16x16x32_bf16(xa[cc], *(const LAS bf16x8*)(p + 16 * RS), acc1, 0, 0, 0);     acc1 = __builtin_amdgcn_mfma_f32_16x16x32_bf16(xa[cc], *(const LAS bf16x8*)(p + 64 * RS), acc1, 0, 0, 0);
                                acc2 = __builtin_amdgcn_mfma_f32_16x16x32_bf16(xa[cc], *(const LAS bf16x8*)(p + 32 * RS), acc2, 0, 0, 0);     acc2 = __builtin_amdgcn_mfma_f32_16x16x32_bf16(xa[cc], *(const LAS bf16x8*)(p + 80 * RS), acc2, 0, 0, 0);
                            }
                        }
                        __syncthreads();
                    } else {
                    RT_LOAD(aA, bA, 0);
#pragma unroll 1
                    for (int g = 0; g < 16; g += 2) {
                        RT_LOAD(aB, bB, g + 1);
                        RT_COMP(aA, bA);
                        if (g + 2 < 16) RT_LOAD(aA, bA, g + 2);
                        RT_COMP(aB, bB);
                    }
                    }
#undef RT_LOAD
#undef RT_COMP
                    ss += __shfl_xor(ss, 16); ss += __shfl_xor(ss, 32);
                    const float rstd = 1.0f / sqrtf(ss * (1.f / DM) + 1e-6f);
                    LAS float* Lg = (LAS float*)(lds + wave * 4096);
#pragma unroll
                    for (int r = 0; r < 4; ++r) { Lg[(4 * kq + r) * 49 + ri] = acc0[r]; Lg[(4 * kq + r) * 49 + 16 + ri] = acc1[r]; Lg[(4 * kq + r) * 49 + 32 + ri] = acc2[r]; }
                    LDS_WAIT(); asm volatile("" ::: "memory");
                    if (lane < 16) {
                        const GAS float* bv = (const GAS float*)WR + 1024 * 48;
                        float lg[4], le[32];
#pragma unroll
                        for (int e = 0; e < 4; ++e) lg[e] = Lg[lane * 49 + e] * rstd + bv[e];
#pragma unroll
                        for (int e = 0; e < 32; ++e) le[e] = Lg[lane * 49 + 4 + e] * rstd + bv[4 + e];
                        int gi = 0; float gm = lg[0];
#pragma unroll
                        for (int e = 1; e < 4; ++e) if (lg[e] > gm) { gm = lg[e]; gi = e; }
                        float gs = 0.f;
#pragma unroll
                        for (int e = 0; e < 4; ++e) gs += __expf(lg[e] - gm);
                        const float gval = 1.0f / gs;
                        float ev[8];
#pragma unroll
                        for (int j = 0; j < 8; ++j) ev[j] = gi == 0 ? le[j] : (gi == 1 ? le[8 + j] : (gi == 2 ? le[16 + j] : le[24 + j]));
                        int i0 = 0; float m0 = ev[0];
#pragma unroll
                        for (int j = 1; j < 8; ++j) if (ev[j] > m0) { m0 = ev[j]; i0 = j; }
                        int i1 = -1; float m1 = -3.0e38f;
#pragma unroll
                        for (int j = 0; j < 8; ++j) if (j != i0 && ev[j] > m1) { m1 = ev[j]; i1 = j; }
                        const float t1 = __expf(m1 - m0); const float den = 1.0f / (1.0f + t1);
                        my_e0 = gi * 8 + i0; my_e1 = gi * 8 + i1; my_g0 = gval * den; my_g1 = gval * t1 * den;
                    }
                    if (MOE_FP8 && ROUTER_LDSW) {
                        f32x4 gq[4];
#pragma unroll
                        for (int j = 0; j < 2; ++j) { gq[2 * j] = *(const GAS f32x4*)(gf + 512 * j + 8 * lane); gq[2 * j + 1] = *(const GAS f32x4*)(gf + 512 * j + 8 * lane + 4); }
#pragma unroll
                        for (int i0 = 0; i0 < 16; i0 += 8) {
                            v4u w[8][2];
#pragma unroll
                            for (int r = 0; r < 8; ++r) {
#pragma unroll
                                for (int j = 0; j < 2; ++j) w[r][j] = *(const GAS v4u*)(XB + (size_t)(r0w + i0 + r) * DM + 512 * j + 8 * lane); }
#pragma unroll
                            for (int r = 0; r < 8; ++r) { const float rs = __uint_as_float(__builtin_amdgcn_readlane(__float_as_uint(rstd), i0 + r));
#pragma unroll
                                for (int j = 0; j < 2; ++j) { const v4u a = w[r][j]; const f32x4 g0 = gq[2 * j] * rs, g1 = gq[2 * j + 1] * rs;
                                    int d0 = __builtin_amdgcn_cvt_pk_fp8_f32(__builtin_bit_cast(float, a.x << 16) * g0.x, __builtin_bit_cast(float, a.x & 0xffff0000u) * g0.y, 0, false);
                                    d0 = __builtin_amdgcn_cvt_pk_fp8_f32(__builtin_bit_cast(float, a.y << 16) * g0.z, __builtin_bit_cast(float, a.y & 0xffff0000u) * g0.w, d0, true);
                                    int d1 = __builtin_amdgcn_cvt_pk_fp8_f32(__builtin_bit_cast(float, a.z << 16) * g1.x, __builtin_bit_cast(float, a.z & 0xffff0000u) * g1.y, 0, false);
                                    d1 = __builtin_amdgcn_cvt_pk_fp8_f32(__builtin_bit_cast(float, a.w << 16) * g1.z, __builtin_bit_cast(float, a.w & 0xffff0000u) * g1.w, d1, true);
                                    *(GAS v2u*)((unsigned char*)HB + (size_t)(r0w + i0 + r) * DM + 512 * j + 8 * lane) = (v2u){(unsigned)d0, (unsigned)d1}; } }
                        }
                    } else
                    for (int i = 0; i < 16; ++i) { const int m = r0w + i; f32x4 v[4]; rms_row_b16(XB + (size_t)m * DM, gf, v, lane);
                        if (MOE_FP8) {
#pragma unroll
                            for (int j = 0; j < 4; ++j) { int d = __builtin_amdgcn_cvt_pk_fp8_f32(v[j].x, v[j].y, 0, false); d = __builtin_amdgcn_cvt_pk_fp8_f32(v[j].z, v[j].w, d, true); *(GAS unsigned*)((unsigned char*)HB + (size_t)m * DM + 4 * lane + 256 * j) = (unsigned)d; }
                        } else store_row_bf16(HB + (size_t)m * DM, v, lane); }
                }
                unsigned r0 = 0, r1 = 0;
                if (lane < 16) { r0 = atomicAdd((unsigned*)(LC + LC_LCNT + my_e0), 1u); r1 = atomicAdd((unsigned*)(LC + LC_LCNT + my_e1), 1u); }
                __syncthreads();
                if (tid < 32) { const unsigned c = LC[LC_LCNT + tid]; LC[LC_LBASE + tid] = c ? __hip_atomic_fetch_add(gcnt + tid, c, RLX_AGENT) : 0u; }
                __syncthreads();
                if (lane < 16) { const int m = chunk * 128 + wave * 16 + lane;
                    const unsigned p0 = LC[LC_LBASE + my_e0] + r0, p1 = LC[LC_LBASE + my_e1] + r1;
                    list[(size_t)my_e0 * LIST_CAP + p0] = m; list[(size_t)my_e1 * LIST_CAP + p1] = m;
                    tokep[2 * m] = my_e0 | (int)(p0 << 8); tokep[2 * m + 1] = my_e1 | (int)(p1 << 8);
                    gate[2 * m] = my_g0; gate[2 * m + 1] = my_g1; }
            }
        }
        if (layer == 0) { if (IN(pb)) SIDE_FINISH_TO(0, sk0, side_k13());
            if (IN(pb) && IN(pb + 1)) { if (SIDE_ON) xcd_barrier_w(bar, [&]() { const int kpw_ = side_kpw();
                    if (sk0 < kpw_) { const int ke_ = sk0 + 2 < kpw_ ? sk0 + 2 : kpw_; side_items(args, lds, 0, sk0, ke_); sk0 = ke_; }
                    else if (sk1 < kpw_) { const int ke_ = sk1 + 2 < kpw_ ? sk1 + 2 : kpw_; side_items(args, lds, 1, sk1, ke_); sk1 = ke_; } });
                else xcd_barrier(bar); }
        } else { if (IN(pb)) SIDE_FINISH(1, sk1); SEAM(pb); }
        if (IN(pb + 1) || IN(pb + 2) || IN(pb + 3)) {
            __syncthreads();
            if (tid == 0) { int acc = 0; for (int e = 0; e < 32; ++e) { const int c = (int)__hip_atomic_load(gcnt0 + e, RLX_AGENT); LC[LC_CNT + e] = (unsigned)c; LC[LC_TP + e] = (unsigned)acc; acc += (c + 255) >> 8; } LC[LC_TP + 32] = (unsigned)acc;
                int la = 0; for (int j = 0; j < 4; ++j) { LC[LC_LP + j] = (unsigned)la; la += ((int)LC[LC_CNT + (bx & 7) + 8 * j] + 255) >> 8; } LC[LC_LP + 4] = (unsigned)la; }
            __syncthreads();
        }
        const LAS int* tp = (const LAS int*)(lds + LDSCTL_OFF) + LC_TP; const LAS int* cn = (const LAS int*)(lds + LDSCTL_OFF) + LC_CNT; const LAS int* lp = (const LAS int*)(lds + LDSCTL_OFF) + LC_LP;
        if (IN(pb + 1)) REP(pb + 1) {
            pg8::Gemm g{HB, (const bf16*)(ws + moe_w13_off(layer)), 0, 1024, MOE_FP8 ? DM / 2 : DM};
            pg8::MoeOrder S{tp, cn, lp, list, G, bx, tp[32] * 4, true, G == 256};
            pg8::EpiSwiglu E{(bf16*)(ws + WS_H), MOE_FP8 != 0};
            if (MOE_FP8) pg8::gemm_phase<pg8::EpiSwiglu, pg8::MoeOrder, true, true, 127, 122>(lds, g, S, E);
            else pg8::gemm_phase<pg8::EpiSwiglu, pg8::MoeOrder, true>(lds, g, S, E);
        }
        if (layer == 0) { if (IN(pb + 1)) SIDE_FINISH(0, sk0); SEAM_W(pb + 1, 1, sk1); } else SEAM(pb + 1);
        if (IN(pb + 2)) REP(pb + 2) {
            pg8::Gemm g{(const bf16*)(ws + WS_H), (const bf16*)(ws + moe_w2_off(layer)), 0, 1024, MOE_FP8 ? MOE_H / 2 : MOE_H};
            pg8::MoeOrder S{tp, cn, lp, list, G, bx, tp[32] * 4, false, G == 256};
            pg8::EpiBf16 E{(bf16*)(ws + WS_YS), DM, 0, 0, 1.f, 3, MOE_FP8 != 0};
            if (MOE_FP8) pg8::gemm_phase<pg8::EpiBf16, pg8::MoeOrder, true, true, 125, 122>(lds, g, S, E);
            else pg8::gemm_phase<pg8::EpiBf16, pg8::MoeOrder, true>(lds, g, S, E);
        }
        if (layer == 0) SEAM_W(pb + 2, 1, sk1); else SEAM(pb + 2);
        if (IN(pb + 3)) {
            const bf16* YS = (const bf16*)(ws + WS_YS);
            if (layer == 0 && !SIDE_ON) { LAS float* scr = (LAS float*)(lds + wave * 16384);
                transpose_moe(args.in[24] + (size_t)NEXP * 1024 * 512, args.in[25] + (size_t)NEXP * 1024 * 512, args.in[26] + (size_t)NEXP * 1024 * 512, (bf16*)(ws + WS_W13), (bf16*)(ws + WS_W2), scr, gw, NGW, lane); }
            const float* gn = layer == 0 ? args.in[1] + DM : args.in[3];
            if (MOE_FP8 && COMBINE_PIPE) {
                const int RPW = gw < NTOK ? (NTOK - gw + NGW - 1) / NGW : 0;
                const GAS f32x4* gr = (const GAS f32x4*)gn + lane;
                for (int kb = 0; kb < RPW; kb += 16) {
                    int epl0 = 0, epl1 = 0; float gl0 = 0.f, gl1 = 0.f;
                    { const int k = kb + lane; if (lane < 16 && k < RPW) { const int m = gw + k * NGW; epl0 = tokep[2 * m]; epl1 = tokep[2 * m + 1]; gl0 = gate[2 * m]; gl1 = gate[2 * m + 1]; } }
                    const int kn = RPW - kb < 16 ? RPW - kb : 16;
                    for (int k2 = 0; k2 < kn; k2 += 2) {
                        v2u xw[2][4]; unsigned za[2][4], zc[2][4]; float h0[2], h1[2]; int mm[2]; bool ok[2];
#pragma unroll
                        for (int r = 0; r < 2; ++r) { ok[r] = k2 + r < kn; const int kk = ok[r] ? k2 + r : k2; mm[r] = gw + (kb + kk) * NGW;
                            const int ep0 = __builtin_amdgcn_readlane(epl0, kk), ep1 = __builtin_amdgcn_readlane(epl1, kk);
                            h0[r] = __uint_as_float(__builtin_amdgcn_readlane(__float_as_uint(gl0), kk)) * 0.125f; h1[r] = __uint_as_float(__builtin_amdgcn_readlane(__float_as_uint(gl1), kk)) * 0.125f;
                            const size_t s0 = (size_t)(tp[ep0 & 255] * 256 + (ep0 >> 8)), s1 = (size_t)(tp[ep1 & 255] * 256 + (ep1 >> 8));
                            const GAS v2u* xb = (const GAS v2u*)(XB + (size_t)mm[r] * DM) + lane;
                            const GAS unsigned* z0 = (const GAS unsigned*)((const unsigned char*)YS + s0 * DM) + lane; const GAS unsigned* z1 = (const GAS unsigned*)((const unsigned char*)YS + s1 * DM) + lane;
#pragma unroll
                            for (int j = 0; j < 4; ++j) { xw[r][j] = xb[64 * j]; za[r][j] = z0[64 * j]; zc[r][j] = z1[64 * j]; } }
#pragma unroll
                        for (int r = 0; r < 2; ++r) { typedef float f32x2_ __attribute__((ext_vector_type(2)));
                            f32x4 v[4]; float ss = 0.f;
#pragma unroll
                            for (int j = 0; j < 4; ++j) { const v2u w = xw[r][j]; f32x4 xv = (f32x4){__builtin_bit_cast(float, w.x << 16), __builtin_bit_cast(float, w.x & 0xffff0000u), __builtin_bit_cast(float, w.y << 16), __builtin_bit_cast(float, w.y & 0xffff0000u)};
                                const f32x2_ al = __builtin_amdgcn_cvt_pk_f32_fp8((int)za[r][j], false), ah = __builtin_amdgcn_cvt_pk_f32_fp8((int)za[r][j], true), cl = __builtin_amdgcn_cvt_pk_f32_fp8((int)zc[r][j], false), ch = __builtin_amdgcn_cvt_pk_f32_fp8((int)zc[r][j], true);
                                xv.x += h0[r] * al.x + h1[r] * cl.x; xv.y += h0[r] * al.y + h1[r] * cl.y; xv.z += h0[r] * ah.x + h1[r] * ch.x; xv.w += h0[r] * ah.y + h1[r] * ch.y;
                                v[j] = xv; ss += (xv.x * xv.x + xv.y * xv.y) + (xv.z * xv.z + xv.w * xv.w); }
                            const float rstd = 1.0f / sqrtf(wave_sum(ss) * (1.f / DM) + 1e-6f);
                            if (ok[r]) {
                                const int m = mm[r];
                                if (layer == 0) { GAS v2u* xb = (GAS v2u*)(XB + (size_t)m * DM) + lane;
#pragma unroll
                                    for (int j = 0; j < 4; ++j) xb[64 * j] = (v2u){pk2(v[j].x, v[j].y), pk2(v[j].z, v[j].w)};
#pragma unroll
                                    for (int j = 0; j < 4; ++j) v[j] = v[j] * rstd * gr[64 * j];
                                    if (IN1_FP8) {
#pragma unroll
                                        for (int j = 0; j < 4; ++j) { int d = __builtin_amdgcn_cvt_pk_fp8_f32(v[j].x, v[j].y, 0, false); d = __builtin_amdgcn_cvt_pk_fp8_f32(v[j].z, v[j].w, d, true); *(GAS unsigned*)((unsigned char*)HB + (size_t)m * DM + 4 * lane + 256 * j) = (unsigned)d; }
                                    } else store_row_bf16(HB + (size_t)m * DM, v, lane);
                                } else { GAS f32x4* xr = (GAS f32x4*)(xres + (size_t)m * DM) + lane;
#pragma unroll
                                    for (int j = 0; j < 4; ++j) xr[64 * j] = v[j] * rstd * gr[64 * j]; }
                            }
                        }
                    }
                }
            } else
            for (int m = gw; m < NTOK; m += NGW) {
                const int ep0 = tokep[2 * m], ep1 = tokep[2 * m + 1]; const float g0 = gate[2 * m], g1 = gate[2 * m + 1];
                const size_t s0 = (size_t)(tp[ep0 & 255] * 256 + (ep0 >> 8)), s1 = (size_t)(tp[ep1 & 255] * 256 + (ep1 >> 8));
                GAS f32x4* xr = (GAS f32x4*)(xres + (size_t)m * DM) + lane; GAS v2u* xb = (GAS v2u*)(XB + (size_t)m * DM) + lane;
                const GAS v2u* y0 = (const GAS v2u*)(YS + s0 * DM) + lane; const GAS v2u* y1 = (const GAS v2u*)(YS + s1 * DM) + lane;
                const GAS unsigned* z0 = (const GAS unsigned*)((const unsigned char*)YS + s0 * DM) + lane; const GAS unsigned* z1 = (const GAS unsigned*)((const unsigned char*)YS + s1 * DM) + lane;
                f32x4 v[4]; float ss = 0.f;
#pragma unroll
                for (int j = 0; j < 4; ++j) { const v2u xw = xb[64 * j]; f32x4 xv = (f32x4){__builtin_bit_cast(float, xw.x << 16), __builtin_bit_cast(float, xw.x & 0xffff0000u), __builtin_bit_cast(float, xw.y << 16), __builtin_bit_cast(float, xw.y & 0xffff0000u)};
                    if (MOE_FP8) { typedef float f32x2_ __attribute__((ext_vector_type(2))); const unsigned a = z0[64 * j], c = z1[64 * j]; const float h0 = g0 * 0.125f, h1 = g1 * 0.125f;
                        const f32x2_ al = __builtin_amdgcn_cvt_pk_f32_fp8((int)a, false), ah = __builtin_amdgcn_cvt_pk_f32_fp8((int)a, true), cl = __builtin_amdgcn_cvt_pk_f32_fp8((int)c, false), ch = __builtin_amdgcn_cvt_pk_f32_fp8((int)c, true);
                        xv.x += h0 * al.x + h1 * cl.x; xv.y += h0 * al.y + h1 * cl.y; xv.z += h0 * ah.x + h1 * ch.x; xv.w += h0 * ah.y + h1 * ch.y;
                    } else { const v2u a = y0[64 * j], c = y1[64 * j];
                    xv.x += g0 * __builtin_bit_cast(float, a.x << 16) + g1 * __builtin_bit_cast(float, c.x << 16);
                    xv.y += g0 * __builtin_bit_cast(float, a.x & 0xffff0000u) + g1 * __builtin_bit_cast(float, c.x & 0xffff0000u);
                    xv.z += g0 * __builtin_bit_cast(float, a.y << 16) + g1 * __builtin_bit_cast(float, c.y << 16);
                    xv.w += g0 * __builtin_bit_cast(float, a.y & 0xffff0000u) + g1 * __builtin_bit_cast(float, c.y & 0xffff0000u); }
                    v[j] = xv; ss += (xv.x * xv.x + xv.y * xv.y) + (xv.z * xv.z + xv.w * xv.w); }
                const float rstd = 1.0f / sqrtf(wave_sum(ss) * (1.f / DM) + 1e-6f);
                const GAS f32x4* gr = (const GAS f32x4*)gn + lane;
                if (layer == 0) {
#pragma unroll
                    for (int j = 0; j < 4; ++j) xb[64 * j] = (v2u){pk2(v[j].x, v[j].y), pk2(v[j].z, v[j].w)};
#pragma unroll
                    for (int j = 0; j < 4; ++j) v[j] = v[j] * rstd * gr[64 * j];
                    if (IN1_FP8) {
#pragma unroll
                        for (int j = 0; j < 4; ++j) { int d = __builtin_amdgcn_cvt_pk_fp8_f32(v[j].x, v[j].y, 0, false); d = __builtin_amdgcn_cvt_pk_fp8_f32(v[j].z, v[j].w, d, true); *(GAS unsigned*)((unsigned char*)HB + (size_t)m * DM + 4 * lane + 256 * j) = (unsigned)d; }
                    } else store_row_bf16(HB + (size_t)m * DM, v, lane);
                } else {
#pragma unroll
                    for (int j = 0; j < 4; ++j) xr[64 * j] = v[j] * rstd * gr[64 * j];
                }
            }
        }
    }
}

__global__ void __launch_bounds__(NWAVES * 64, 2) mk_fwd(Args args) {
    extern __shared__ __attribute__((aligned(16))) unsigned char lds_raw[];
    LAS unsigned char* lds = (LAS unsigned char*)lds_raw;
    volatile LAS unsigned* LC = (volatile LAS unsigned*)(lds + LDSCTL_OFF);
    const int tid = threadIdx.x, lane = tid & 63, wave = __builtin_amdgcn_readfirstlane(tid >> 6);
    const int G = gridDim.x, bx = blockIdx.x;
    const int gw = bx * NWAVES + wave, NGW = G * NWAVES;
    unsigned char* ws = args.ws;
    unsigned* ctl = (unsigned*)(ws + WS_CTL);
    const float* x_in = args.in[0];
    float* xres = args.out;
    bf16* XB = (bf16*)(ws + WS_XB);
    bf16* HB = (bf16*)(ws + WS_HB); bf16* Y = (bf16*)(ws + WS_Y);
    float* TBL = (float*)(ws + WS_TBL);

    for (int u = tid; u < (LDS_BYTES - LDSCTL_OFF) / 4; u += NWAVES * 64) LC[u] = 0u;
    __syncthreads();
    XcdBarrier bar; bar.bar = ctl + CW_BAR; bar.x = 0; bar.st = nullptr;
    if (MK_N_LAUNCHES == 1) bar = xcd_barrier_post(ctl + CW_BAR, LC + LC_BAR);
    const int lo = args.ph_lo, hi_ph = args.ph_hi;
    int sk0 = 0, sk1 = 0;

    if (IN(0)) REP(0) {
        LAS float* scr = (LAS float*)(lds + wave * 16384);
        if (IN0_GLU) { const int nblk = EV_IN / 32, nitems = (DM / 64) * nblk;
            for (int it = gw; it < nitems; it += NGW) { const int kb = it / nblk, nb = it % nblk, n0 = 32 * nb;
                const int dst = n0 < 768 ? n0 : (n0 < 1280 ? 768 + ((n0 - 768) >> 7) * 256 + ((n0 - 768) & 127) : 768 + ((n0 - 1280) >> 7) * 256 + 128 + ((n0 - 1280) & 127));
                transpose_item(args.in[4], DM, EV_IN, (bf16*)(ws + WS_WIN0), kb, nb, dst, scr, lane); } }
        else transpose_plain(args.in[4], DM, EV_IN, (bf16*)(ws + WS_WIN0), scr, gw, NGW, lane);
        transpose_plain(args.in[11], DM, DM, (bf16*)(ws + WS_WOUT0), scr, gw, NGW, lane);
        transpose_plain<IN1_FP8 != 0>(args.in[12], DM, OD_IN, (bf16*)(ws + WS_WIN1), scr, gw, NGW, lane);
        transpose_plain(args.in[18], DM, DM, (bf16*)(ws + WS_WOUT1), scr, gw, NGW, lane);
        transpose_moe(args.in[24], args.in[25], args.in[26], (bf16*)(ws + WS_W13), (bf16*)(ws + WS_W2), scr, gw, NGW, lane, 0, SIDE_ON ? 0 : (1 << 20));
        for (int i = bx * 512 + tid; i < 2048; i += G * 512) { const int pos = i >> 4, f = i & 15;
            const float inv = exp2f(-(float)f * (13.287712379549449f / 16.0f));
            const float ang = (float)pos * inv; const float rev = ang * 0.15915494309189535f; const float fr = rev - floorf(rev);
            TBL[TBL_COS + i] = __builtin_amdgcn_cosf(fr); TBL[TBL_SIN + i] = __builtin_amdgcn_sinf(fr); }
        for (int i = bx * 512 + tid; i < 8 * 257; i += G * 512) { const int h = i / 257, j = i % 257;
            TBL[TBL_BIAS + h * BIAS_STRIDE + j] = args.in[19][t5_bucket(j - 128) * 8 + h] * LOG2E; }
        for (int i = bx * 512 + tid; i < 2 * 1024 * 48; i += G * 512) { const int l = i / (1024 * 48), r = i % (1024 * 48), k = r / 48, c = r % 48;
            float w = 0.f; if (c < 4) w = args.in[20][(size_t)l * 4096 + k * 4 + c]; else if (c < 36) w = args.in[22][(size_t)l * 32768 + k * 32 + (c - 4)];
            TBL[TBL_WR + l * WR_LAYER + r] = w * args.in[2][l * DM + k]; }
        {
            bf16* TBH = (bf16*)((unsigned char*)TBL + 614400);
            for (int i = bx * 512 + tid; i < 2 * 48 * 1024; i += G * 512) { const int l = i / (48 * 1024), r = i % (48 * 1024), c = r >> 10; int k = r & 1023;
                if (ROUTER_LDSW) { const int q = k & 511; k = (k & 512) + ((q >> 3) & 15) * 32 + (q >> 7) * 8 + (q & 7); }
                float w = 0.f; if (c < 4) w = args.in[20][(size_t)l * 4096 + k * 4 + c]; else if (c < 36) w = args.in[22][(size_t)l * 32768 + k * 32 + (c - 4)];
                w *= args.in[2][l * DM + k]; const unsigned hb = f2bf(w); const float rem = w - bf2f((unsigned short)hb);
                TBH[(size_t)(l * 2) * 49152 + r] = (bf16)hb; TBH[(size_t)(l * 2 + 1) * 49152 + r] = (bf16)f2bf(rem); }
        }
        for (int i = bx * 512 + tid; i < 2 * 48; i += G * 512) { const int l = i / 48, c = i % 48;
            TBL[TBL_WR + l * WR_LAYER + 1024 * 48 + c] = c < 4 ? args.in[21][l * 4 + c] : (c < 36 ? args.in[23][l * 32 + (c - 4)] : 0.f); }
        for (int m = gw; m < NTOK; m += NGW) { f32x4 v[4]; rms_row(x_in + (size_t)m * DM, args.in[1], v, lane); store_row_bf16(HB + (size_t)m * DM, v, lane); }
    }
    SEAM_W(0, 0, sk0);
    if (IN(1)) REP(1) {
        pg8::Gemm g{HB, (const bf16*)(ws + WS_WIN0), NTOK, EV_IN, DM}; pg8::StaticOrder S; S.init(NTOK, EV_IN, G, bx);
        if (IN0_GLU) { pg8::EpiIn0 E{(bf16*)(ws + WS_Z0), Z_LD}; pg8::gemm_phase<pg8::EpiIn0, pg8::StaticOrder, true>(lds, g, S, E); }
        else { pg8::EpiBf16 E{(bf16*)(ws + WS_Z0), EV_IN, 0, 0, 1.f, 0xffff, false};
        pg8::gemm_phase<pg8::EpiBf16, pg8::StaticOrder, true>(lds, g, S, E); }
    }
    SEAM_W(1, 0, sk0);
    if (IN(2)) REP(2) {
        const bf16* Z0 = (const bf16*)(ws + WS_Z0); bf16* QR = (bf16*)(ws + WS_QR); bf16* KR = (bf16*)(ws + WS_KR);
        if (QK_FP8 && (ATTN_VER == 1 || ATTN_VER == 3)) {
            for (int it = bx * 512 + tid; it < NTOK * 10; it += G * 512) {
                const bool isq = it < NTOK * 8; const int m = isq ? (it >> 3) : ((it - NTOK * 8) >> 1); const int hh = isq ? (it & 7) : 8 + ((it - NTOK * 8) & 1);
                const float* gn = isq ? args.in[5] : args.in[6];
                const GAS v4u* srcp = (const GAS v4u*)(Z0 + (size_t)m * Z_LD + hh * 64);
                float xv[64]; float ss = 0.f;
#pragma unroll
                for (int q = 0; q < 8; ++q) { const v4u a = srcp[q];
#pragma unroll
                    for (int j = 0; j < 4; ++j) { const float lo = __builtin_bit_cast(float, a[j] << 16), hh2 = __builtin_bit_cast(float, a[j] & 0xffff0000u); xv[q * 8 + 2 * j] = lo; xv[q * 8 + 2 * j + 1] = hh2; ss += lo * lo + hh2 * hh2; } }
                const float rs = (1.0f / sqrtf(ss * (1.f / 64.f) + 1e-6f)) * (isq ? C2 * 8.0f : 1.0f);
                const int sp = m & (SEQ - 1);
                unsigned wout[16];
#pragma unroll
                for (int half = 0; half < 2; ++half) { const int pos = half ? (sp & 63) : (sp >> 6);
                    const GAS f32x4* ct = (const GAS f32x4*)(TBL + TBL_COS + pos * 16); const GAS f32x4* st = (const GAS f32x4*)(TBL + TBL_SIN + pos * 16);
                    float ov[32];
#pragma unroll
                    for (int q = 0; q < 4; ++q) { const f32x4 cv = ct[q], sv = st[q];
#pragma unroll
                        for (int j = 0; j < 4; ++j) { const int i = q * 4 + j; const float a = xv[half * 32 + i] * rs * gn[half * 32 + i], b2 = xv[half * 32 + 16 + i] * rs * gn[half * 32 + 16 + i];
                            ov[i] = a * cv[j] - b2 * sv[j]; ov[16 + i] = b2 * cv[j] + a * sv[j]; } }
#pragma unroll
                    for (int q = 0; q < 8; ++q) { int d = __builtin_amdgcn_cvt_pk_fp8_f32(ov[4 * q], ov[4 * q + 1], 0, false); d = __builtin_amdgcn_cvt_pk_fp8_f32(ov[4 * q + 2], ov[4 * q + 3], d, true); wout[half * 8 + q] = (unsigned)d; } }
                if (!isq && ATTN_VER == 3) {
                    const int strm = (m >> 13) * 2 + (hh - 8); unsigned char* kb_ = ws + WS_K8T0 + ((((size_t)strm * 128 + (sp >> 6)) * 4) * 64 + (sp & 63)) * 16;
#pragma unroll
                    for (int q = 0; q < 4; ++q) *(GAS v4u*)(kb_ + q * 1024) = (v4u){wout[4 * q], wout[4 * q + 1], wout[4 * q + 2], wout[4 * q + 3]};
                } else {
                GAS v4u* dst = isq ? (GAS v4u*)(ws + WS_QR8 + (size_t)m * 512 + hh * 64) : (GAS v4u*)(ws + WS_KR8 + (size_t)m * 128 + (hh - 8) * 64);
#pragma unroll
                for (int q = 0; q < 4; ++q) dst[q] = (v4u){wout[4 * q], wout[4 * q + 1], wout[4 * q + 2], wout[4 * q + 3]};
                }
            }
            if (ATTN_VER == 3) {
                for (int it = bx * 512 + tid; it < 8 * 128 * 4 * 64; it += G * 512) { const int d = it & 63, c = (it >> 6) & 3, tt = (it >> 8) & 127, strm = it >> 15;
                    const bf16* vb_ = Z0 + ((size_t)(strm >> 1) * SEQ + tt * 64) * Z_LD + 640 + (strm & 1) * 64 + d; unsigned w4[4];
#pragma unroll
                    for (int q = 0; q < 4; ++q) { float f[4];
#pragma unroll
                        for (int j = 0; j < 4; ++j) { const int bb = q * 4 + j; const int key = 32 * (c & 1) + (bb & 3) + 8 * (bb >> 2) + 4 * (c >> 1); f[j] = bf2f(vb_[(size_t)key * Z_LD]); }
                        int dw = __builtin_amdgcn_cvt_pk_fp8_f32(f[0], f[1], 0, false); dw = __builtin_amdgcn_cvt_pk_fp8_f32(f[2], f[3], dw, true); w4[q] = (unsigned)dw; }
                    *(GAS v4u*)(ws + WS_V8T0 + (size_t)it * 16) = (v4u){w4[0], w4[1], w4[2], w4[3]}; }
            }
        } else {
        const float gq = args.in[5][lane], gk = args.in[6][lane];
        const int fi = lane & 15; const bool first = (lane & 16) == 0, isrow = lane < 32;
        for (int m = gw; m < NTOK; m += NGW) {
            const int s = m & (SEQ - 1); const int pos = isrow ? (s >> 6) : (s & 63);
            const float cs = TBL[TBL_COS + pos * 16 + fi], sn = TBL[TBL_SIN + pos * 16 + fi];
#pragma unroll
            for (int h = 0; h < 10; ++h) {
                const float xv = bf2f(Z0[(size_t)m * Z_LD + h * 64 + lane]);
                const float ss = wave_sum(xv * xv);
                const float y = xv * (1.0f / sqrtf(ss * (1.f / 64.f) + 1e-6f)) * (h < 8 ? gq : gk);
                const float p = __shfl_xor(y, 16);
                float o = first ? (y * cs - p * sn) : (y * cs + p * sn);
                if (!QK_FP8 || ATTN_VER != 1) { if (h < 8) QR[(size_t)m * 512 + h * 64 + lane] = (bf16)f2bf(o * C2);
                else KR[(size_t)m * 128 + (h - 8) * 64 + lane] = (bf16)f2bf(o); }
                if (QK_FP8) { const unsigned w = quad_pack_bytes(fp8_byte(h < 8 ? o * (C2 * 8.0f) : o));
                    if ((lane & 3) == 0) { if (h < 8) *(unsigned*)(ws + WS_QR8 + (size_t)m * 512 + h * 64 + lane) = w; else *(unsigned*)(ws + WS_KR8 + (size_t)m * 128 + (h - 8) * 64 + lane) = w; } }
            }
        }
        }
        {
        typedef float f32x2 __attribute__((ext_vector_type(2)));
        constexpr int NU = NBATCH * 64 * 8;
        v4u pa_[3], pg_[3]; bool pv_[3];
#define CONV_FETCH(un_) do { const int grp_ = (un_) & 7, tt_ = ((un_) >> 3) & 63, b_ = (un_) >> 9; _Pragma("unroll") for (int q_ = 0; q_ < 3; ++q_) { const int idx_ = tid + q_ * 512; const int r_ = idx_ >> 3, c8_ = idx_ & 7; const int s_ = tt_ * 128 - 15 + r_; \
            pv_[q_] = idx_ < 158 * 8 && s_ >= 0 && s_ < SEQ; if (pv_[q_]) { const size_t ro_ = (size_t)(b_ * SEQ + s_) * Z_LD + grp_ * 64 + c8_ * 8; pa_[q_] = *(const GAS v4u*)(Z0 + ro_ + 768); if (!IN0_GLU) pg_[q_] = *(const GAS v4u*)(Z0 + ro_ + 1280); } } } while (0)
        int grp_loaded = -1; float wreg[31]; float cb = 0.f, gg = 0.f, gb = 0.f;
        int buf = 0;
        if (bx < NU) CONV_FETCH(bx);
        for (int un = bx; un < NU; un += G) {
            const int grp = un & 7, tt = (un >> 3) & 63, b = un >> 9; const int t0 = tt * 128;
            LAS float* hbuf = (LAS float*)(lds + buf * 40960);
#pragma unroll
            for (int q = 0; q < 3; ++q) { const int idx = tid + q * 512; if (idx < 158 * 8) { const int r = idx >> 3, c8 = idx & 7;
                f32x4 h0 = {0.f, 0.f, 0.f, 0.f}, h1 = h0;
                if (pv_[q] && IN0_GLU) { const v4u av = pa_[q];
                    h0 = (f32x4){__builtin_bit_cast(float, av[0] << 16), __builtin_bit_cast(float, av[0] & 0xffff0000u), __builtin_bit_cast(float, av[1] << 16), __builtin_bit_cast(float, av[1] & 0xffff0000u)};
                    h1 = (f32x4){__builtin_bit_cast(float, av[2] << 16), __builtin_bit_cast(float, av[2] & 0xffff0000u), __builtin_bit_cast(float, av[3] << 16), __builtin_bit_cast(float, av[3] & 0xffff0000u)}; }
                else if (pv_[q]) { const v4u av = pa_[q], gv = pg_[q];
#pragma unroll
                    for (int j = 0; j < 4; ++j) { const float a0 = __builtin_bit_cast(float, av[j] << 16), a1 = __builtin_bit_cast(float, av[j] & 0xffff0000u);
                        const float g0 = __builtin_bit_cast(float, gv[j] << 16), g1 = __builtin_bit_cast(float, gv[j] & 0xffff0000u);
                        const float x0 = a0 * __builtin_amdgcn_rcpf(1.0f + __builtin_amdgcn_exp2f(-g0 * LOG2E)), x1 = a1 * __builtin_amdgcn_rcpf(1.0f + __builtin_amdgcn_exp2f(-g1 * LOG2E));
                        if (j < 2) { h0[2 * j] = x0; h0[2 * j + 1] = x1; } else { h1[2 * j - 4] = x0; h1[2 * j - 3] = x1; } } }
                *(LAS f32x4*)(hbuf + r * 64 + c8 * 8) = h0; *(LAS f32x4*)(hbuf + r * 64 + c8 * 8 + 4) = h1; } }
            if (un + G < NU) CONV_FETCH(un + G);
            __syncthreads();
            const int ch = grp * 64 + lane;
            if (grp != grp_loaded) { grp_loaded = grp;
#pragma unroll
                for (int j = 0; j < 31; ++j) wreg[j] = args.in[7][j * 512 + ch];
                cb = args.in[8][ch]; gg = args.in[9][ch]; gb = args.in[10][ch]; }
            float acc[16];
            {
                f32x2 he[23], ho[22];
#pragma unroll
                for (int k = 0; k < 23; ++k) { he[k].x = hbuf[(wave * 16 + 2 * k) * 64 + lane]; he[k].y = hbuf[(wave * 16 + 2 * k + 1) * 64 + lane]; }
#pragma unroll
                for (int k = 0; k < 22; ++k) { ho[k].x = he[k].y; ho[k].y = he[k + 1].x; }
                f32x2 a2[8];
#pragma unroll
                for (int p = 0; p < 8; ++p) a2[p] = (f32x2){cb, cb};
#pragma unroll
                for (int j = 0; j < 31; ++j) { const f32x2 wj = (f32x2){wreg[j], wreg[j]};
#pragma unroll
                    for (int p = 0; p < 8; ++p) { const int r = 2 * p + j; a2[p] = __builtin_elementwise_fma(wj, (r & 1) ? ho[r >> 1] : he[r >> 1], a2[p]); } }
#pragma unroll
                for (int p = 0; p < 8; ++p) { acc[2 * p] = a2[p].x; acc[2 * p + 1] = a2[p].y; }
            }
#pragma unroll
            for (int i = 0; i < 16; ++i) { const float mu = wave_sum(acc[i]) * (1.f / 64.f); const float d = acc[i] - mu; const float var = wave_sum(d * d) * (1.f / 64.f);
                const float hn = d * (1.0f / sqrtf(var + 1e-5f)) * gg + gb; const float ov = hn * __builtin_amdgcn_rcpf(1.0f + __builtin_amdgcn_exp2f(-hn * LOG2E));
                Y[(size_t)(b * SEQ + t0 + wave * 16 + i) * DM + 512 + ch] = (bf16)f2bf(ov); }
            buf ^= 1;
        }
#undef CONV_FETCH
        __syncthreads();
        }
    }
    SEAM_W(2, 0, sk0);
    if (IN(3)) REP(3) {
        const bf16* QR = (const bf16*)(ws + WS_QR); const bf16* KR = (const bf16*)(ws + WS_KR); const bf16* Z0 = (const bf16*)(ws + WS_Z0);
        if (ATTN_L0_TEST) {
        for (int un = bx; un < NBATCH * 8 * 32; un += G) {
            const int qb = un & 31, h = (un >> 5) & 7, b = un >> 8, kvh = h >> 2;
            const size_t row0 = (size_t)b * SEQ + qb * 256;
            attn_unit_v0<64, false, true>((const bf16*)(ws + WS_QR8 + row0 * 512 + h * 64), 512, (const bf16*)(ws + WS_KR8 + (size_t)b * SEQ * 128 + kvh * 64), 128, Z0 + (size_t)b * SEQ * Z_LD + 640 + kvh * 64, Z_LD,
                                   Y + row0 * DM + h * 64, DM, nullptr, qb * 256, lds);
        }
        } else if (ATTN_VER == 0) {
        for (int un = bx; un < NBATCH * 8 * 32; un += G) {
            const int qb = un & 31, h = (un >> 5) & 7, b = un >> 8, kvh = h >> 2;
            const size_t row0 = (size_t)b * SEQ + qb * 256;
            attn_unit_v0<64, false>(QR + row0 * 512 + h * 64, 512, KR + (size_t)b * SEQ * 128 + kvh * 64, 128, Z0 + (size_t)b * SEQ * Z_LD + 640 + kvh * 64, Z_LD,
                                   Y + row0 * DM + h * 64, DM, nullptr, qb * 256, lds);
        }
        } else {
        constexpr int U = NBATCH * 8 * 32; const int upc = (U + G - 1) / G; const int vcu = (G % 8 == 0) ? (bx % 8) * (G / 8) + bx / 8 : bx;
        for (int i = 0; i < upc; ++i) { const int un = vcu * upc + i; if (un >= U) break;
            const int stream = un >> 7, b = stream >> 1, kvh = stream & 1, h = kvh * 4 + ((un >> 5) & 3), qb = un & 31;
            const size_t row0 = (size_t)b * SEQ + qb * 256;
            if (ATTN_VER == 3) at3::attn_unit<64, false, 0>(ws + WS_QR8 + row0 * 512 + h * 64, 512, ws + WS_K8T0 + (size_t)stream * 128 * 4096, ws + WS_V8T0 + (size_t)stream * 128 * 4096, Y + row0 * DM + h * 64, DM, qb * 256, lds, nullptr);
            else if (QK_FP8) at1::attn_unit<64, false, 0, 0, true>((const bf16*)(ws + WS_QR8 + row0 * 512 + h * 64), 512, (const bf16*)(ws + WS_KR8 + (size_t)b * SEQ * 128 + kvh * 64), 128, Z0 + (size_t)b * SEQ * Z_LD + 640 + kvh * 64, Z_LD,
                                      Y + row0 * DM + h * 64, DM, qb * 256, lds);
            else at1::attn_unit<64, false>(QR + row0 * 512 + h * 64, 512, KR + (size_t)b * SEQ * 128 + kvh * 64, 128, Z0 + (size_t)b * SEQ * Z_LD + 640 + kvh * 64, Z_LD,
                                      Y + row0 * DM + h * 64, DM, qb * 256, lds);
        }
        }
    }
    SEAM_W(3, 0, sk0);
    if (IN(4)) REP(4) {
        pg8::Gemm g{Y, (const bf16*)(ws + WS_WOUT0), NTOK, DM, DM}; pg8::StaticOrder S; S.init(NTOK, DM, G, bx);
        pg8::EpiRes E{x_in, nullptr, XB, DM};
        pg8::gemm_phase<pg8::EpiRes, pg8::StaticOrder, true>(lds, g, S, E);
    }
    SEAM_W(4, 0, sk0);

    moe_block<0>(args, lds, bar, lo, hi_ph, sk0, sk1);
    SEAM_W(8, 1, sk1);
            if (IN(9)) REP(9) {
                constexpr bool VT = V_TRANSPOSED_GEMM && IN1_FP8 && QK_FP8 && ATTN_L1_VER == 3;
                pg8::Gemm g{HB, (const bf16*)(ws + WS_WIN1), NTOK, VT ? 2048 : OD_IN, IN1_FP8 ? DM / 2 : DM}; pg8::StaticOrder S; S.init(NTOK, VT ? 2048 : OD_IN, G, bx);
                if (QK_FP8) { pg8::EpiQKV8 E{ws + WS_Q1, ws + WS_K8T1, (bf16*)(ws + WS_V1), C2 * 8.0f, true};
                    if (IN1_FP8) pg8::gemm_phase<pg8::EpiQKV8, pg8::StaticOrder, true, true, 127, 122>(lds, g, S, E);
                    else pg8::gemm_phase<pg8::EpiQKV8, pg8::StaticOrder, true>(lds, g, S, E);
                    if (VT) {
                        pg8::Gemm gv{(const bf16*)(ws + WS_WIN1 + (size_t)2048 * DM), HB, DM, NTOK, DM / 2}; pg8::StaticOrder Sv; Sv.init(DM, NTOK, G, bx);
                        pg8::EpiVT Ev{ws + WS_V8T1};
                        pg8::gemm_phase<pg8::EpiVT, pg8::StaticOrder, true, true, 122, 127>(lds, gv, Sv, Ev); } }
                else { pg8::EpiBf16 E{(bf16*)(ws + WS_Q1), DM, DM, (size_t)(WS_K1 - WS_Q1) / 2, C2, 0xffff, false};
                pg8::gemm_phase<pg8::EpiBf16, pg8::StaticOrder, true>(lds, g, S, E); }
            }
            SEAM_W(9, 1, sk1);
            if (ATTN_L1_VER == 3) {
            if (IN(10) && !(V_TRANSPOSED_GEMM && IN1_FP8 && QK_FP8)) {
                const bf16* V1 = (const bf16*)(ws + WS_V1);
                for (int it = bx * 512 + tid; it < 32 * 128 * 4 * 128; it += G * 512) { const int d = it & 127, c = (it >> 7) & 3, tt = (it >> 9) & 127, bh = it >> 16;
                    const bf16* vb_ = V1 + (((size_t)bh * 128 + tt) * 4 + (d >> 5)) * 2048 + (d & 31); unsigned w4[4];
#pragma unroll
                    for (int q = 0; q < 4; ++q) { float f[4];
#pragma unroll
                        for (int j = 0; j < 4; ++j) { const int bb = q * 4 + j; const int key = 32 * (c & 1) + (bb & 3) + 8 * (bb >> 2) + 4 * (c >> 1); f[j] = bf2f(vb_[(size_t)key * 32]); }
                        int dw = __builtin_amdgcn_cvt_pk_fp8_f32(f[0], f[1], 0, false); dw = __builtin_amdgcn_cvt_pk_fp8_f32(f[2], f[3], dw, true); w4[q] = (unsigned)dw; }
                    *(GAS v4u*)(ws + WS_V8T1 + (size_t)it * 16) = (v4u){w4[0], w4[1], w4[2], w4[3]}; }
            }
            if (!(V_TRANSPOSED_GEMM && IN1_FP8 && QK_FP8)) SEAM(10);
            if (IN(11)) REP(11) {
                constexpr int UP = NBATCH * 8 * 32; const int upc = (UP + G - 1) / G; const int vcu = (G % 8 == 0) ? (bx % 8) * (G / 8) + bx / 8 : bx;
                LAS float* btbl = (LAS float*)(lds + at3::lds_tbl_off<128>());
                LAS float* sgt = btbl + 272;
                __syncthreads();
                if (tid < 128) sgt[tid] = args.in[17][tid] * (1.0f - LAM_INIT);
                if (wave == 7) { const float lam = __expf(wave_sum(args.in[13][lane] * args.in[14][lane])) - __expf(wave_sum(args.in[15][lane] * args.in[16][lane])) + LAM_INIT; if (lane == 0) sgt[128] = lam; }
                for (int i = 0; i < upc; ++i) {
                    int up = vcu * upc + i; if (up >= UP) break;
                    if (G == 256) up = ((vcu >> 5) * 4 + i) * 32 + (vcu & 31);
                    const int qb = up & 31, h = (up >> 5) & 7, b = up >> 8;
                    __syncthreads();
                    if (tid < 257) btbl[tid] = TBL[TBL_BIAS + h * BIAS_STRIDE + tid] - TBL[TBL_BIAS + h * BIAS_STRIDE + 256];
                    __syncthreads();
                    const size_t row0 = (size_t)b * SEQ + qb * 256; const int bh = b * 8 + h;
                    const unsigned char* Q8 = ws + WS_Q1 + row0 * DM + h * 128; const unsigned char* V8 = ws + WS_V8T1 + (size_t)bh * 128 * 8192;
                    at3::attn_unit<128, true, 1>(Q8, DM, ws + WS_K8T1 + (size_t)(bh * 2) * 128 * 4096, V8, nullptr, DM, qb * 256, lds, sgt);
                    at3::attn_unit<128, true, 2>(Q8 + 64, DM, ws + WS_K8T1 + (size_t)(bh * 2 + 1) * 128 * 4096, V8, Y + row0 * DM + h * 128, DM, qb * 256, lds, sgt);
                }
            }
            SEAM_W(11, 1, sk1);
            } else {
            if (IN(10)) REP(10) {
                const bf16* Q1 = (const bf16*)(ws + WS_Q1); const bf16* K1 = (const bf16*)(ws + WS_K1); const bf16* V1 = (const bf16*)(ws + WS_V1);
                if (ATTN_L1_VER == 0) {
                LAS float* btbl = (LAS float*)(lds + 65536);
                for (int un = bx; un < NBATCH * 8 * 2 * 32; un += G) {
                    const int qb = un & 31, c = (un >> 5) & 1, h = (un >> 6) & 7, b = un >> 9;
                    __syncthreads();
                    if (tid < 257) btbl[tid] = TBL[TBL_BIAS + h * BIAS_STRIDE + tid];
                    __syncthreads();
                    const size_t row0 = (size_t)b * SEQ + qb * 256, brow = (size_t)b * SEQ;
                    bf16* OC = (bf16*)(ws + (c ? WS_OC1 : WS_OC0));
                    attn_unit_v0<128, true>(Q1 + row0 * DM + h * 128 + c * 64, DM, K1 + brow * DM + h * 128 + c * 64, DM, V1 + brow * DM + h * 128, DM,
                                           OC + row0 * DM + h * 128, DM, btbl, qb * 256, lds);
                }
                } else {
                constexpr int UP = NBATCH * 8 * 32; const int upc = (UP + G - 1) / G; const int vcu = (G % 8 == 0) ? (bx % 8) * (G / 8) + bx / 8 : bx;
                LAS float* btbl = (LAS float*)(lds + at1::lds_tbl_off<128, QK_FP8 != 0>());
                LAS float* sgt = btbl + 272;
                __syncthreads();
                if (tid < 128) sgt[tid] = args.in[17][tid] * (1.0f - LAM_INIT);
                if (wave == 7) { const float lam = __expf(wave_sum(args.in[13][lane] * args.in[14][lane])) - __expf(wave_sum(args.in[15][lane] * args.in[16][lane])) + LAM_INIT; if (lane == 0) sgt[128] = lam; }
                for (int i = 0; i < upc; ++i) {
                    int up = vcu * upc + i; if (up >= UP) break;
                    if (G == 256) up = ((vcu >> 5) * 4 + i) * 32 + (vcu & 31);
                    const int qb = up & 31, h = (up >> 5) & 7, b = up >> 8;
                    __syncthreads();
                    if (tid < 257) btbl[tid] = TBL[TBL_BIAS + h * BIAS_STRIDE + tid] - TBL[TBL_BIAS + h * BIAS_STRIDE + 256];
                    __syncthreads();
                    const size_t row0 = (size_t)b * SEQ + qb * 256, brow = (size_t)b * SEQ;
                    if (QK_FP8) { const unsigned char* Q8 = ws + WS_Q1; const unsigned char* K8 = ws + WS_K1;
                    const int bh = b * 8 + h; const bf16* VT = V1 + (size_t)bh * 128 * 8192; const unsigned char* KT0 = ws + WS_K8T1 + (size_t)(bh * 2) * 128 * 4096; (void)K8; (void)brow;
                    at1::attn_unit<128, true, 0, 1, true, true>((const bf16*)(Q8 + row0 * DM + h * 128), DM, (const bf16*)KT0, DM, VT, DM, nullptr, DM, qb * 256, lds, sgt);
                    at1::attn_unit<128, true, 0, 2, true, true>((const bf16*)(Q8 + row0 * DM + h * 128 + 64), DM, (const bf16*)(KT0 + 128 * 4096), DM, VT, DM, Y + row0 * DM + h * 128, DM, qb * 256, lds, sgt);
                    } else {
                    at1::attn_unit<128, true, 0, 1>(Q1 + row0 * DM + h * 128, DM, K1 + brow * DM + h * 128, DM, V1 + brow * DM + h * 128, DM, nullptr, DM, qb * 256, lds, sgt);
                    at1::attn_unit<128, true, 0, 2>(Q1 + row0 * DM + h * 128 + 64, DM, K1 + brow * DM + h * 128 + 64, DM, V1 + brow * DM + h * 128, DM, Y + row0 * DM + h * 128, DM, qb * 256, lds, sgt);
                    }
                }
                }
            }
            SEAM(10);
            if (PROBE_ATT >= 0 && IN(10)) {
                const bf16* Q1 = (const bf16*)(ws + WS_Q1); const bf16* K1 = (const bf16*)(ws + WS_K1); const bf16* V1 = (const bf16*)(ws + WS_V1);
                constexpr int U = NBATCH * 8 * 2 * 32; const int upc = (U + G - 1) / G; const int vcu = (G % 8 == 0) ? (bx % 8) * (G / 8) + bx / 8 : bx;
                LAS float* btbl = (LAS float*)(lds + 3 * 8192 + 3 * 16384 + 2048);
                for (int i = 0; i < upc; ++i) {
                    int un = vcu * upc + i; if (un >= U) break;
                    if (G == 256) un = ((vcu >> 5) * 4 + (i >> 1)) * 64 + (i & 1) * 32 + (vcu & 31);
                    const int qb = un & 31, c = (un >> 5) & 1, h = (un >> 6) & 7, b = un >> 9;
                    if (tid < 257) btbl[tid] = TBL[TBL_BIAS + h * BIAS_STRIDE + tid] - TBL[TBL_BIAS + h * BIAS_STRIDE + 256];
                    __syncthreads();
                    const size_t row0 = (size_t)b * SEQ + qb * 256, brow = (size_t)b * SEQ;
                    at1::attn_unit<128, true, (PROBE_ATT >= 0 ? PROBE_ATT : 0)>(Q1 + row0 * DM + h * 128 + c * 64, DM, K1 + brow * DM + h * 128 + c * 64, DM, V1 + brow * DM + h * 128, DM,
                                              (bf16*)(ws + WS_OC1) + row0 * DM + h * 128, DM, qb * 256, lds);
                }
                xcd_barrier(bar);
            }
            if (IN(11) && ATTN_L1_VER != 1) REP(11) {
                const bf16* OC0 = (const bf16*)(ws + WS_OC0); const bf16* OC1 = (const bf16*)(ws + WS_OC1);
                const float lam = __expf(wave_sum(args.in[13][lane] * args.in[14][lane])) - __expf(wave_sum(args.in[15][lane] * args.in[16][lane])) + LAM_INIT;
                float sg[16];
#pragma unroll
                for (int j = 0; j < 16; ++j) sg[j] = args.in[17][(lane & 7) * 16 + j] * (1.0f - LAM_INIT);
                for (int m = gw; m < NTOK; m += NGW) {
                    const GAS v4u* a = (const GAS v4u*)(OC0 + (size_t)m * DM) + lane * 2; const GAS v4u* c = (const GAS v4u*)(OC1 + (size_t)m * DM) + lane * 2;
                    float o[16]; float ss = 0.f;
#pragma unroll
                    for (int q = 0; q < 2; ++q) { const v4u av = a[q], cv = c[q];
#pragma unroll
                        for (int j = 0; j < 4; ++j) { const unsigned au = av[j], cu = cv[j];
                            const float lo = __builtin_bit_cast(float, au << 16) - lam * __builtin_bit_cast(float, cu << 16);
                            const float hh = __builtin_bit_cast(float, au & 0xffff0000u) - lam * __builtin_bit_cast(float, cu & 0xffff0000u);
                            o[q * 8 + 2 * j] = lo; o[q * 8 + 2 * j + 1] = hh; ss += lo * lo + hh * hh; } }
                    ss += __shfl_xor(ss, 1); ss += __shfl_xor(ss, 2); ss += __shfl_xor(ss, 4);
                    const float rstd = 1.0f / sqrtf(ss * (1.f / 128.f) + 1e-5f);
                    v4u w0, w1;
                    w0.x = pk2(o[0] * rstd * sg[0], o[1] * rstd * sg[1]); w0.y = pk2(o[2] * rstd * sg[2], o[3] * rstd * sg[3]); w0.z = pk2(o[4] * rstd * sg[4], o[5] * rstd * sg[5]); w0.w = pk2(o[6] * rstd * sg[6], o[7] * rstd * sg[7]);
                    w1.x = pk2(o[8] * rstd * sg[8], o[9] * rstd * sg[9]); w1.y = pk2(o[10] * rstd * sg[10], o[11] * rstd * sg[11]); w1.z = pk2(o[12] * rstd * sg[12], o[13] * rstd * sg[13]); w1.w = pk2(o[14] * rstd * sg[14], o[15] * rstd * sg[15]);
                    GAS v4u* yo = (GAS v4u*)(Y + (size_t)m * DM) + lane * 2; yo[0] = w0; yo[1] = w1;
                }
            }
            if (ATTN_L1_VER != 1) SEAM(11);
            }
            if (IN(12)) {
                pg8::Gemm g{Y, (const bf16*)(ws + WS_WOUT1), NTOK, DM, DM}; pg8::StaticOrder S; S.init(NTOK, DM, G, bx);
                pg8::EpiRes E{nullptr, XB, XB, DM};
                pg8::gemm_phase<pg8::EpiRes, pg8::StaticOrder, true>(lds, g, S, E);
            }
            SEAM_W(12, 1, sk1);
    moe_block<1>(args, lds, bar, lo, hi_ph, sk0, sk1);
#undef IN
#undef SEAM
}

extern "C" void kernel_launch(void* const* d_in, const int* in_sizes, int n_in, void* d_out, int out_size, void* d_ws, size_t ws_size, hipStream_t stream) {
    static int grid = 0;
    if (grid == 0) {
        if (n_in != 27 || in_sizes[0] != NTOK * DM || out_size != NTOK * DM || ws_size < WS_END) { fprintf(stderr, "kernel_launch: unexpected shapes / workspace (n_in %d, ws %zu)\n", n_in, ws_size); grid = -1; return; }
        int dev = 0, cus = 0, per_cu = 0;
        if (hipGetDevice(&dev) != hipSuccess || hipDeviceGetAttribute(&cus, hipDeviceAttributeMultiprocessorCount, dev) != hipSuccess) { grid = -1; return; }
        if (hipFuncSetAttribute((const void*)mk_fwd, hipFuncAttributeMaxDynamicSharedMemorySize, LDS_BYTES) != hipSuccess) { fprintf(stderr, "kernel_launch: hipFuncSetAttribute failed\n"); grid = -1; return; }
        if (hipOccupancyMaxActiveBlocksPerMultiprocessor(&per_cu, (const void*)mk_fwd, NWAVES * 64, LDS_BYTES) != hipSuccess || per_cu < 1) { fprintf(stderr, "kernel_launch: occupancy query says %d\n", per_cu); }
        (void)hipGetLastError();
        grid = cus;
    }
    if (grid < 0) return;
    if (hipMemsetAsync((char*)d_ws + WS_CTL, 0, CTL_ZERO_BYTES, stream) != hipSuccess) return;
    Args a{};
    for (int i = 0; i < 27; ++i) a.in[i] = (const float*)d_in[i];
    a.out = (float*)d_out; a.ws = (unsigned char*)d_ws;
    if (MK_N_LAUNCHES == 1) { a.ph_lo = 0; a.ph_hi = NPHASE; a.li = 0; hipLaunchKernelGGL(mk_fwd, dim3(grid), dim3(NWAVES * 64), LDS_BYTES, stream, a); }
    else { for (int p = 0; p < NPHASE; ++p) for (int r = 0; r < (int)((PROBE_MASK >> p) & 1u) + 1; ++r) { a.ph_lo = p; a.ph_hi = p + 1; a.li = p; hipLaunchKernelGGL(mk_fwd, dim3(grid), dim3(NWAVES * 64), LDS_BYTES, stream, a); } }
}
```
